# Optimizing an MI355X kernel written in HIP

```python
import math
import jax, jax.numpy as jnp
from jax import lax
import numpy as np

D_MODEL = 1024
BATCH = 16
SEQ = 2048
DEPTH = 1

RET_HEADS = 4
RET_DK = 128
RET_DV = 256
RET_CHUNK = 128
ROPE_BASE = 10000.0
ATT_HEADS = 8
ATT_DH = 64
DILATED_PATTERNS = ((128, 1), (512, 4), (2048, 16))
NUM_BUCKETS = 32
MAX_DISTANCE = 1024
N_GROUPS = 4
EXPERTS_PER_GROUP = 4
N_EXPERTS = N_GROUPS * EXPERTS_PER_GROUP
TOP_K = 2
D_EXPERT = 512
MOE_BLOCK = 128
DEEPNORM_ALPHA = (2.0 * DEPTH) ** 0.25
DEEPNORM_BETA = (8.0 * DEPTH) ** -0.25
LN_EPS = 1e-5
NEG_INF = -1e30

RET_QK_W = RET_HEADS * RET_DK
RET_V_W = RET_HEADS * RET_DV
ATT_W = ATT_HEADS * ATT_DH
IN_SPLITS = (RET_QK_W, RET_QK_W, RET_V_W, RET_V_W, ATT_W, ATT_W, ATT_W, D_MODEL, D_MODEL)
IN_OFFSETS = tuple(int(v) for v in np.cumsum((0,) + IN_SPLITS))
IN_COLS = IN_OFFSETS[-1]
SPLIT_POINTS = list(IN_OFFSETS[1:-1])

kernel_name = 'hybrid_retention_dilated_hmoe_block'


def layer_norm(x, g, b):
    xf = x.astype(jnp.float32)
    mu = jnp.mean(xf, axis=-1, keepdims=True)
    var = jnp.mean(jnp.square(xf - mu), axis=-1, keepdims=True)
    y = (xf - mu) * lax.rsqrt(var + LN_EPS) * g.astype(jnp.float32) + b.astype(jnp.float32)
    return y.astype(x.dtype)


def rotary(t):
    s, dh = t.shape[1], t.shape[-1]
    half = dh // 2
    inv = ROPE_BASE ** (-jnp.arange(half, dtype=jnp.float32) / half)
    ang = jnp.arange(s, dtype=jnp.float32)[:, None] * inv[None, :]
    cos = jnp.cos(ang)[None, :, None, :]
    sin = jnp.sin(ang)[None, :, None, :]
    t1 = t[..., :half].astype(jnp.float32)
    t2 = t[..., half:].astype(jnp.float32)
    return jnp.concatenate([t1 * cos - t2 * sin, t1 * sin + t2 * cos], axis=-1).astype(t.dtype)


def retention_chunkwise(q, k, v, log_gamma):
    b, h, s, dk = q.shape
    dv = v.shape[-1]
    c = RET_CHUNK
    n = s // c
    qc = q.reshape(b, h, n, c, dk)
    kc = k.reshape(b, h, n, c, dk)
    vc = v.reshape(b, h, n, c, dv)
    pos = jnp.arange(c, dtype=jnp.float32)
    diff = pos[:, None] - pos[None, :]
    lg = log_gamma[:, None, None]
    decay = jnp.where(diff >= 0, jnp.exp(lg * jnp.maximum(diff, 0.0)), 0.0).astype(q.dtype)
    scores = jnp.einsum('bhnqd,bhnkd->bhnqk', qc, kc) * decay[None, :, None]
    inner = jnp.einsum('bhnqk,bhnkv->bhnqv', scores, vc)
    zeta = jnp.exp(log_gamma[:, None] * (c - 1 - pos)).astype(q.dtype)
    xi = jnp.exp(log_gamma[:, None] * (pos + 1)).astype(q.dtype)
    chunk_decay = jnp.exp(log_gamma * c).astype(q.dtype)[None, :, None, None]
    kv = jnp.einsum('bhnkd,hk,bhnkv->nbhdv', kc, zeta, vc)

    def step(state, kv_n):
        return state * chunk_decay + kv_n, state

    _, prev = lax.scan(step, jnp.zeros((b, h, dk, dv), q.dtype), kv)
    cross = jnp.einsum('bhnqd,nbhdv,hq->bhnqv', qc, prev, xi)
    return (inner + cross).reshape(b, h, s, dv)


def head_group_norm(o, g):
    of = o.astype(jnp.float32)
    mu = jnp.mean(of, axis=-1, keepdims=True)
    var = jnp.mean(jnp.square(of - mu), axis=-1, keepdims=True)
    y = ((of - mu) * lax.rsqrt(var + LN_EPS)).reshape(o.shape[0], o.shape[1], -1)
    return (y * g.astype(jnp.float32)).astype(o.dtype)


def t5_bucket(rel):
    half = NUM_BUCKETS // 2
    max_exact = half // 2
    side = jnp.where(rel > 0, half, 0)
    n = jnp.abs(rel)
    large = max_exact + (jnp.log(jnp.maximum(n, 1).astype(jnp.float32) / max_exact)
                         / math.log(MAX_DISTANCE / max_exact) * (half - max_exact)).astype(jnp.int32)
    large = jnp.minimum(large, half - 1)
    return side + jnp.where(n < max_exact, n, large)


def dilated_pattern(q, k, v, rel_bias, window, dil):
    b, s, h, dh = q.shape
    radius = window // (2 * dil)
    blk = radius
    n = s // dil
    nb = -(-n // blk)
    pad_n = nb * blk - n

    def by_stride(t):
        return t.reshape(b, n, dil, h, dh).transpose(0, 2, 1, 3, 4)

    qs, ks, vs = by_stride(q), by_stride(k), by_stride(v)
    qb = jnp.pad(qs, ((0, 0), (0, 0), (0, pad_n), (0, 0), (0, 0))).reshape(b, dil, nb, blk, h, dh)

    def band(t):
        tp = jnp.pad(t, ((0, 0), (0, 0), (blk, blk + pad_n), (0, 0), (0, 0)))
        blocks = tp.reshape(b, dil, nb + 2, blk, h, dh)
        return jnp.concatenate([blocks[:, :, :-2], blocks[:, :, 1:-1], blocks[:, :, 2:]], axis=3)

    kb, vb = band(ks), band(vs)
    qi = np.arange(blk)
    kk = np.arange(3 * blk)
    delta = kk[None, :] - blk - qi[:, None]
    in_window = np.abs(delta) <= radius
    key_sub = np.arange(nb)[:, None] * blk + kk[None, :] - blk
    valid = (key_sub >= 0) & (key_sub < n)
    mask = jnp.asarray(in_window[None, :, :] & valid[:, None, :])
    bias = rel_bias[t5_bucket(jnp.asarray(delta * dil))].astype(jnp.float32).transpose(2, 0, 1)

    logits = jnp.einsum('brnqhe,brnkhe->brnhqk', qb, kb).astype(jnp.float32) + bias[None, None, None]
    logits = jnp.where(mask[None, None, :, None], logits, NEG_INF)
    m = jnp.max(logits, axis=-1, keepdims=True)
    p = jnp.exp(logits - m)
    denom = jnp.sum(p, axis=-1, keepdims=True)
    o = jnp.einsum('brnhqk,brnkhe->brnhqe', p.astype(v.dtype), vb) / denom.astype(v.dtype)
    lse = (m + jnp.log(denom))[..., 0]
    o = o.transpose(0, 2, 4, 1, 3, 5).reshape(b, nb * blk, dil, h, dh)[:, :n].reshape(b, s, h, dh)
    lse = lse.transpose(0, 2, 4, 1, 3).reshape(b, nb * blk, dil, h)[:, :n].reshape(b, s, h)
    return o, lse


def dilated_attention(q, k, v, rel_bias):
    outs, lses = [], []
    for window, dil in DILATED_PATTERNS:
        o, lse = dilated_pattern(q, k, v, rel_bias, window, dil)
        outs.append(o)
        lses.append(lse)
    w = jax.nn.softmax(jnp.stack(lses, axis=0), axis=0)
    return jnp.sum(w[..., None].astype(q.dtype) * jnp.stack(outs, axis=0), axis=0)


def token_mixers(x, w_in, ret_decay_fwd, ret_decay_bwd, ret_gn_g, w_proj_ret, rel_bias, w_proj_attn, w_out):
    b, s, _ = x.shape
    hcat = x @ w_in
    q_r, k_r, v_r, g_r, q_a, k_a, v_a, gate_r, gate_a = jnp.split(hcat, SPLIT_POINTS, axis=-1)
    q_r = rotary(q_r.reshape(b, s, RET_HEADS, RET_DK))
    k_r = rotary(k_r.reshape(b, s, RET_HEADS, RET_DK)) * (RET_DK ** -0.5)
    v_r = v_r.reshape(b, s, RET_HEADS, RET_DV)
    qh, kh, vh = (t.transpose(0, 2, 1, 3) for t in (q_r, k_r, v_r))
    lg_f = jax.nn.log_sigmoid(ret_decay_fwd.astype(jnp.float32))
    lg_b = jax.nn.log_sigmoid(ret_decay_bwd.astype(jnp.float32))
    o_f = retention_chunkwise(qh, kh, vh, lg_f)
    o_b = jnp.flip(retention_chunkwise(jnp.flip(qh, 2), jnp.flip(kh, 2), jnp.flip(vh, 2), lg_b), 2)
    o_r = head_group_norm((o_f + o_b).transpose(0, 2, 1, 3), ret_gn_g)
    y_r = (jax.nn.silu(g_r) * o_r) @ w_proj_ret
    q_a = q_a.reshape(b, s, ATT_HEADS, ATT_DH) * (ATT_DH ** -0.5)
    k_a = k_a.reshape(b, s, ATT_HEADS, ATT_DH)
    v_a = v_a.reshape(b, s, ATT_HEADS, ATT_DH)
    y_a = dilated_attention(q_a, k_a, v_a, rel_bias).reshape(b, s, ATT_W) @ w_proj_attn
    merged = jax.nn.sigmoid(gate_r) * y_r + jax.nn.sigmoid(gate_a) * y_a
    return merged @ w_out


def hierarchical_moe(x, router_w_group, router_b_group, router_w_expert, router_b_expert, w_gate, w_up, w_down):
    b, s, d = x.shape
    t = b * s
    xt = x.reshape(t, d)
    g_logits = (xt @ router_w_group).astype(jnp.float32) + router_b_group.astype(jnp.float32)
    g_prob = jax.nn.softmax(g_logits, axis=-1)
    g_idx = jnp.argmax(g_logits, axis=-1)
    g_w = jnp.take_along_axis(g_prob, g_idx[:, None], axis=-1)
    e_logits = ((xt @ router_w_expert).astype(jnp.float32) + router_b_expert.astype(jnp.float32)).reshape(t, N_GROUPS, EXPERTS_PER_GROUP)
    e_logits = jnp.take_along_axis(e_logits, g_idx[:, None, None], axis=1)[:, 0]
    top_v, top_i = lax.top_k(e_logits, TOP_K)
    weights = g_w * jax.nn.softmax(top_v, axis=-1)
    expert_id = g_idx[:, None].astype(jnp.int32) * EXPERTS_PER_GROUP + top_i.astype(jnp.int32)
    a = t * TOP_K
    flat_e = expert_id.reshape(a)
    flat_w = weights.reshape(a)
    order = jnp.argsort(flat_e)
    e_sorted = flat_e[order]
    tok_sorted = (order // TOP_K).astype(jnp.int32)
    counts = jnp.zeros((N_EXPERTS,), jnp.int32).at[flat_e].add(1)
    padded = (counts + MOE_BLOCK - 1) // MOE_BLOCK * MOE_BLOCK
    start = jnp.cumsum(counts) - counts
    ends = jnp.cumsum(padded)
    pstart = ends - padded
    dest = pstart[e_sorted] + jnp.arange(a, dtype=jnp.int32) - start[e_sorted]
    n_blocks = -(-a // MOE_BLOCK) + N_EXPERTS
    slot_tok = jnp.full((n_blocks * MOE_BLOCK,), t, jnp.int32).at[dest].set(tok_sorted)
    block_start = jnp.arange(n_blocks, dtype=jnp.int32) * MOE_BLOCK
    block_expert = jnp.minimum(jnp.sum(ends[None, :] <= block_start[:, None], axis=1), N_EXPERTS - 1).astype(jnp.int32)
    x_pad = jnp.concatenate([xt, jnp.zeros((1, d), xt.dtype)], axis=0)
    xb = x_pad[slot_tok].reshape(n_blocks, MOE_BLOCK, d)

    def expert_block(args):
        xblk, e = args
        hid = jax.nn.silu(xblk @ w_gate[e]) * (xblk @ w_up[e])
        return hid @ w_down[e]

    yb = lax.map(expert_block, (xb, block_expert)).reshape(n_blocks * MOE_BLOCK, d)
    y_assign = yb[dest] * flat_w[order][:, None].astype(yb.dtype)
    out = jnp.zeros((t, d), yb.dtype).at[tok_sorted].add(y_assign)
    return out.reshape(b, s, d)


def setup_inputs(seed: int = 0) -> dict:
    key = jax.random.key(seed)
    ks = jax.random.split(key, 24)
    L = DEPTH

    def nrm(k, shape, scale):
        return jax.random.normal(k, shape, jnp.float32) * scale

    x = nrm(ks[0], (BATCH, SEQ, D_MODEL), 1.0)
    col = jnp.arange(IN_COLS)
    v_cols = ((col >= IN_OFFSETS[2]) & (col < IN_OFFSETS[3])) | ((col >= IN_OFFSETS[6]) & (col < IN_OFFSETS[7]))
    w_in = nrm(ks[1], (L, D_MODEL, IN_COLS), D_MODEL ** -0.5) * jnp.where(v_cols, DEEPNORM_BETA, 1.0)
    gamma = 1.0 - jnp.exp(jnp.linspace(math.log(1.0 / 32), math.log(1.0 / 512), RET_HEADS))
    logit = jnp.log(gamma) - jnp.log1p(-gamma)
    ret_decay_fwd = logit[None, :] + nrm(ks[2], (L, RET_HEADS), 0.05)
    ret_decay_bwd = logit[None, :] + nrm(ks[3], (L, RET_HEADS), 0.05)
    ret_gn_g = 1.0 + nrm(ks[4], (L, RET_V_W), 0.02)
    w_proj_ret = nrm(ks[5], (L, RET_V_W, D_MODEL), RET_V_W ** -0.5 * DEEPNORM_BETA)
    rel_bias = nrm(ks[6], (NUM_BUCKETS, ATT_HEADS), 0.5)
    w_proj_attn = nrm(ks[7], (L, ATT_W, D_MODEL), ATT_W ** -0.5 * DEEPNORM_BETA)
    w_out = nrm(ks[8], (L, D_MODEL, D_MODEL), D_MODEL ** -0.5 * DEEPNORM_BETA)
    ln1_g = 1.0 + nrm(ks[9], (L, D_MODEL), 0.02)
    ln1_b = nrm(ks[10], (L, D_MODEL), 0.02)
    router_w_group = nrm(ks[11], (L, D_MODEL, N_GROUPS), D_MODEL ** -0.5)
    router_b_group = nrm(ks[12], (L, N_GROUPS), 0.01)
    router_w_expert = nrm(ks[13], (L, D_MODEL, N_EXPERTS), D_MODEL ** -0.5)
    router_b_expert = nrm(ks[14], (L, N_EXPERTS), 0.01)
    w_gate = nrm(ks[15], (L, N_EXPERTS, D_MODEL, D_EXPERT), D_MODEL ** -0.5)
    w_up = nrm(ks[16], (L, N_EXPERTS, D_MODEL, D_EXPERT), D_MODEL ** -0.5)
    w_down = nrm(ks[17], (L, N_EXPERTS, D_EXPERT, D_MODEL), D_EXPERT ** -0.5 * DEEPNORM_BETA)
    ln2_g = 1.0 + nrm(ks[18], (L, D_MODEL), 0.02)
    ln2_b = nrm(ks[19], (L, D_MODEL), 0.02)
    return {'x': x, 'w_in': w_in, 'ret_decay_fwd': ret_decay_fwd, 'ret_decay_bwd': ret_decay_bwd,
            'ret_gn_g': ret_gn_g, 'w_proj_ret': w_proj_ret, 'rel_bias': rel_bias, 'w_proj_attn': w_proj_attn,
            'w_out': w_out, 'ln1_g': ln1_g, 'ln1_b': ln1_b, 'router_w_group': router_w_group,
            'router_b_group': router_b_group, 'router_w_expert': router_w_expert, 'router_b_expert': router_b_expert,
            'w_gate': w_gate, 'w_up': w_up, 'w_down': w_down, 'ln2_g': ln2_g, 'ln2_b': ln2_b}


def reference(x, w_in, ret_decay_fwd, ret_decay_bwd, ret_gn_g, w_proj_ret, rel_bias, w_proj_attn, w_out,
              ln1_g, ln1_b, router_w_group, router_b_group, router_w_expert, router_b_expert,
              w_gate, w_up, w_down, ln2_g, ln2_b):
    for l in range(DEPTH):
        mix = token_mixers(x, w_in[l], ret_decay_fwd[l], ret_decay_bwd[l], ret_gn_g[l], w_proj_ret[l],
                           rel_bias, w_proj_attn[l], w_out[l])
        x = layer_norm(DEEPNORM_ALPHA * x + mix, ln1_g[l], ln1_b[l])
        ffn = hierarchical_moe(x, router_w_group[l], router_b_group[l], router_w_expert[l], router_b_expert[l],
                               w_gate[l], w_up[l], w_down[l])
        x = layer_norm(DEEPNORM_ALPHA * x + ffn, ln2_g[l], ln2_b[l])
    return x
```

```cpp
#include <hip/hip_runtime.h>
#include <cstdio>
#include <cstdint>

constexpr int TT = 32768, DM = 1024, SEQ = 2048, NB = 16;
constexpr float DN_ALPHA = 1.189207115002721f;
constexpr float LN_EPSF = 1e-5f;
constexpr size_t MiB = 1u << 20;
constexpr size_t CTL_ZERO_BYTES = 1 * MiB;
constexpr size_t WS_ROT = 1 * MiB;
constexpr size_t WS_BIAS = 2 * MiB;
constexpr size_t WS_LTOK = 3 * MiB;
constexpr size_t WS_LW = 5 * MiB;
constexpr size_t WS_TINFO = 7 * MiB;
constexpr size_t WS_WSLOT = 7 * MiB + 512 * 1024;
constexpr size_t WS_WIN = 8 * MiB;
constexpr size_t WS_WR = 21 * MiB;
constexpr size_t WS_WA = 23 * MiB;
constexpr size_t WS_WO = 24 * MiB;
constexpr size_t WS_WGU = 26 * MiB;
constexpr size_t WS_WD = 58 * MiB;
constexpr size_t WS_XB = 80 * MiB;
constexpr size_t WS_QR = 144 * MiB;
constexpr size_t WS_KR = 176 * MiB;
constexpr size_t WS_VR = 208 * MiB;
constexpr size_t WS_GR = 272 * MiB;
constexpr size_t WS_QA = 336 * MiB, WS_KA = 368 * MiB, WS_VA = 400 * MiB, WS_OA = 432 * MiB;
constexpr size_t WS_GATE_R = 144 * MiB, WS_GATE_A = 208 * MiB;
constexpr size_t WS_MERGED = 336 * MiB;
constexpr size_t WS_XG = 144 * MiB;
constexpr size_t WS_Y = 144 * MiB;
constexpr size_t WS_H = 336 * MiB;
constexpr size_t WS_END = 512 * MiB;
constexpr int MAXSLOT = 69632;
constexpr int CW_BAR = 4096;
constexpr int CW_CNT = 8192;
constexpr int CW_CHK = 12288;
namespace pg8 {
#define PG8_LAS __attribute__((address_space(3)))
typedef unsigned short bf16_t;
typedef short bf16x8 __attribute__((ext_vector_type(8)));
typedef float f32x4 __attribute__((ext_vector_type(4)));
typedef unsigned u32x4 __attribute__((ext_vector_type(4)));
constexpr int BM = 256, BK = 64, HALF = 128, HTB = HALF * BK * 2  , STAGE_BYTES = 8 * HTB, NXCD = 8, WGM = 8;

__host__ __device__ __forceinline__ int lds_byte(int r, int c) { const int st = (r >> 4) * 2 + (c >> 5), rr = r & 15, cc = c & 31, ob = rr * 64 + cc * 2; return st * 1024 + (ob ^ (((ob >> 9) & 1) << 5)); }
__host__ __device__ __forceinline__ void stage_rc(int b, int& R, int& C) { const int st = b / 1024, sb = b % 1024, swz = sb ^ (((sb >> 9) & 1) << 5); R = (st >> 1) * 16 + swz / 64; C = (st & 1) * 32 + (swz % 64) / 2; }
__host__ __device__ __forceinline__ int perm32(int rho) { const int n = rho >> 4, i = rho & 15; return 8 * (i >> 2) + 4 * n + (i & 3); }

struct Unit { int pm, pn; };
struct Gemm { const bf16_t* A; const bf16_t* Bt; int M, N, K; };

struct StaticOrder {
    int nM, nN, nwg, G, c;
    __host__ __device__ void init(int M, int N, int G_, int c_) { nM = M / BM; nN = N / BM; nwg = nM * nN; G = G_; c = c_; }
    __host__ __device__ bool next(int i, Unit& u) const {
        const long L = (long)i * G + c; if (L >= nwg) return false;
        int wgid = (int)L; { const int q = nwg / NXCD, r = nwg % NXCD, xcd = wgid % NXCD, off = wgid / NXCD; wgid = (xcd < r ? xcd * (q + 1) : r * (q + 1) + (xcd - r) * q) + off; }
        const int nig = WGM * nN, gid = wgid / nig, fm = gid * WGM, gsz = (nM - fm) < WGM ? (nM - fm) : WGM;
        u.pm = fm + ((wgid % nig) % gsz); u.pn = (wgid % nig) / gsz; return true;
    }
    __device__ __forceinline__ void a_ready(const Unit&) const {}
    __device__ __forceinline__ void done(const Unit&) const {}
};

__device__ __forceinline__ unsigned cvt_pk_bf16(float lo, float hi) { unsigned r; asm volatile("v_cvt_pk_bf16_f32 %0, %1, %2" : "=v"(r) : "v"(lo), "v"(hi)); return r; }
__device__ __forceinline__ float bflo(unsigned w) { return __uint_as_float(w << 16); }
__device__ __forceinline__ float bfhi(unsigned w) { return __uint_as_float(w & 0xffff0000u); }
__device__ __forceinline__ float fsigmoid(float x) { return __builtin_amdgcn_rcpf(1.f + __expf(-x)); }
__device__ __forceinline__ float fsilu(float x) { return x * __builtin_amdgcn_rcpf(1.f + __expf(-x)); }

struct EpiHcat {
    static constexpr bool PERM = true, AFTER_DRAIN = false;
    unsigned char* ws; const float* rot; int tile_off;
    __device__ __forceinline__ void operator()(const f32x4 (&acc)[2][2][4][2], const Unit& u, int wr, int wc, int fr, int fq) const {
        const int gt = u.pn + tile_off;
        size_t base_off; int pitch, ct, mode; float sc = 1.f;
        if (gt < 2)       { base_off = WS_QR; pitch = 512;  ct = gt;      mode = 1; }
        else if (gt < 4)  { base_off = WS_KR; pitch = 512;  ct = gt - 2;  mode = 1; sc = 0.08838834764831845f; }
        else if (gt < 8)  { base_off = WS_VR; pitch = 1024; ct = gt - 4;  mode = 0; }
        else if (gt < 12) { base_off = WS_GR; pitch = 1024; ct = gt - 8;  mode = 2; }
        else if (gt < 14) { base_off = WS_QA; pitch = 512;  ct = gt - 12; mode = 0; sc = 0.125f; }
        else if (gt < 16) { base_off = WS_KA; pitch = 512;  ct = gt - 14; mode = 0; }
        else if (gt < 18) { base_off = WS_VA; pitch = 512;  ct = gt - 16; mode = 0; }
        else if (gt < 22) { base_off = WS_GATE_R; pitch = 1024; ct = gt - 18; mode = 3; }
        else              { base_off = WS_GATE_A; pitch = 1024; ct = gt - 22; mode = 3; }
        bf16_t* O = (bf16_t*)(ws + base_off);
        const int row0 = u.pm * BM + wr * 64 + fr, col0 = ct * BM + wc * 32 + 8 * fq;
#pragma unroll
        for (int ai = 0; ai < 2; ++ai)
#pragma unroll
            for (int m = 0; m < 4; ++m) {
                const int row = row0 + ai * HALF + m * 16;
                bf16_t* rowp = O + (size_t)row * pitch + col0;
                f32x4 cs = (f32x4){1.f, 1.f, 1.f, 1.f}, sn = (f32x4){0.f, 0.f, 0.f, 0.f};
                if (mode == 1) { const f32x4* rt = (const f32x4*)(rot + ((size_t)(row & (SEQ - 1)) * 16 + (4 * wc + fq)) * 8); cs = rt[0]; sn = rt[1]; }
#pragma unroll
                for (int bj = 0; bj < 2; ++bj) {
                    f32x4 v0 = acc[ai][bj][m][0], v1 = acc[ai][bj][m][1];
                    if (mode == 1) { const f32x4 a = v0 * cs - v1 * sn, b = v0 * sn + v1 * cs; v0 = a * sc; v1 = b * sc; }
                    else if (mode == 2) {
#pragma unroll
                        for (int e = 0; e < 4; ++e) { v0[e] = fsilu(v0[e]); v1[e] = fsilu(v1[e]); } }
                    else if (mode == 3) {
#pragma unroll
                        for (int e = 0; e < 4; ++e) { v0[e] = fsigmoid(v0[e]); v1[e] = fsigmoid(v1[e]); } }
                    else { v0 = v0 * sc; v1 = v1 * sc; }
                    u32x4 w; w.x = cvt_pk_bf16(v0[0], v0[1]); w.y = cvt_pk_bf16(v0[2], v0[3]); w.z = cvt_pk_bf16(v1[0], v1[1]); w.w = cvt_pk_bf16(v1[2], v1[3]);
                    *(u32x4*)(rowp + bj * HALF) = w;
                }
            }
    }
};

template <bool ADD> struct EpiGate {
    static constexpr bool PERM = true, AFTER_DRAIN = false;
    const bf16_t* gate; bf16_t* O;
    __device__ __forceinline__ void operator()(const f32x4 (&acc)[2][2][4][2], const Unit& u, int wr, int wc, int fr, int fq) const {
        const int row0 = u.pm * BM + wr * 64 + fr, col0 = u.pn * BM + wc * 32 + 8 * fq;
#pragma unroll
        for (int ai = 0; ai < 2; ++ai)
#pragma unroll
            for (int m = 0; m < 4; ++m)
#pragma unroll
                for (int bj = 0; bj < 2; ++bj) {
                    const size_t p = (size_t)(row0 + ai * HALF + m * 16) * 1024 + col0 + bj * HALF;
                    const u32x4 g = *(const u32x4*)(gate + p);
                    f32x4 v0 = acc[ai][bj][m][0], v1 = acc[ai][bj][m][1];
                    v0[0] *= bflo(g.x); v0[1] *= bfhi(g.x); v0[2] *= bflo(g.y); v0[3] *= bfhi(g.y);
                    v1[0] *= bflo(g.z); v1[1] *= bfhi(g.z); v1[2] *= bflo(g.w); v1[3] *= bfhi(g.w);
                    if (ADD) { const u32x4 o = *(const u32x4*)(O + p);
                        v0[0] += bflo(o.x); v0[1] += bfhi(o.x); v0[2] += bflo(o.y); v0[3] += bfhi(o.y);
                        v1[0] += bflo(o.z); v1[1] += bfhi(o.z); v1[2] += bflo(o.w); v1[3] += bfhi(o.w); }
                    u32x4 w; w.x = cvt_pk_bf16(v0[0], v0[1]); w.y = cvt_pk_bf16(v0[2], v0[3]); w.z = cvt_pk_bf16(v1[0], v1[1]); w.w = cvt_pk_bf16(v1[2], v1[3]);
                    *(u32x4*)(O + p) = w;
                }
    }
};

struct EpiResF32 {
    static constexpr bool PERM = false, AFTER_DRAIN = false;
    const float* x; float* out; float alpha;
    __device__ __forceinline__ void operator()(const f32x4 (&acc)[2][2][4][2], const Unit& u, int wr, int wc, int fr, int fq) const {
        const int row0 = u.pm * BM + wr * 64 + fr, col0 = u.pn * BM + wc * 32 + 4 * fq;
#pragma unroll
        for (int ai = 0; ai < 2; ++ai)
#pragma unroll
            for (int m = 0; m < 4; ++m)
#pragma unroll
                for (int bj = 0; bj < 2; ++bj)
#pragma unroll
                    for (int n = 0; n < 2; ++n) {
                        const size_t p = (size_t)(row0 + ai * HALF + m * 16) * 1024 + col0 + bj * HALF + n * 16;
                        const f32x4 xv = *(const f32x4*)(x + p);
                        *(f32x4*)(out + p) = xv * alpha + acc[ai][bj][m][n];
                    }
    }
};

struct EpiSwiGLU {
    static constexpr bool PERM = true, AFTER_DRAIN = false;
    bf16_t* H;
    __device__ __forceinline__ void operator()(const f32x4 (&acc)[2][2][4][2], const Unit& u, int wr, int wc, int fr, int fq) const {
        typedef unsigned u32x2v __attribute__((ext_vector_type(2)));
        const int row0 = u.pm * BM + wr * 64 + fr, col0 = (u.pn & 3) * 128 + wc * 16 + 4 * fq;
#pragma unroll
        for (int ai = 0; ai < 2; ++ai)
#pragma unroll
            for (int m = 0; m < 4; ++m)
#pragma unroll
                for (int bj = 0; bj < 2; ++bj) {
                    const f32x4 g = acc[ai][bj][m][0], up = acc[ai][bj][m][1];
                    u32x2v w; w.x = cvt_pk_bf16(fsilu(g[0]) * up[0], fsilu(g[1]) * up[1]); w.y = cvt_pk_bf16(fsilu(g[2]) * up[2], fsilu(g[3]) * up[3]);
                    *(u32x2v*)(H + (size_t)(row0 + ai * HALF + m * 16) * 512 + col0 + bj * 64) = w;
                }
    }
};

struct EpiRowScale {
    static constexpr bool PERM = true, AFTER_DRAIN = false;
    bf16_t* Y; const float* wslot;
    __device__ __forceinline__ void operator()(const f32x4 (&acc)[2][2][4][2], const Unit& u, int wr, int wc, int fr, int fq) const {
        const int row0 = u.pm * BM + wr * 64 + fr, col0 = (u.pn & 3) * BM + wc * 32 + 8 * fq;
#pragma unroll
        for (int ai = 0; ai < 2; ++ai)
#pragma unroll
            for (int m = 0; m < 4; ++m) {
                const int row = row0 + ai * HALF + m * 16; const float s = wslot[row];
#pragma unroll
                for (int bj = 0; bj < 2; ++bj) {
                    const f32x4 v0 = acc[ai][bj][m][0] * s, v1 = acc[ai][bj][m][1] * s;
                    u32x4 w; w.x = cvt_pk_bf16(v0[0], v0[1]); w.y = cvt_pk_bf16(v0[2], v0[3]); w.z = cvt_pk_bf16(v1[0], v1[1]); w.w = cvt_pk_bf16(v1[2], v1[3]);
                    *(u32x4*)(Y + (size_t)row * 1024 + col0 + bj * HALF) = w;
                }
            }
    }
};

struct MoeOrder {
    int nunits, G, c; const PG8_LAS int* te;
    __device__ __forceinline__ bool next(int i, Unit& u) const {
        const int L = i * G + c; if (L >= nunits) return false;
        const int rt = L >> 2; u.pm = rt; u.pn = te[rt] * 4 + (L & 3); return true;
    }
    __device__ __forceinline__ void a_ready(const Unit&) const {}
    __device__ __forceinline__ void done(const Unit&) const {}
};

template <class Epi, class Sched, bool ALIGN_EPI = false, bool SP2 = false>
__device__ __forceinline__ void gemm_phase(PG8_LAS unsigned char* lds, const Gemm g, const Sched& S, const Epi& E) {
    const int tid = threadIdx.x, wid = __builtin_amdgcn_readfirstlane(tid >> 6), lane = tid & 63, wr = wid >> 2, wc = wid & 3, fr = lane & 15, fq = lane >> 4;
    const int K = g.K, nt = K / BK;
    unsigned voffA[2], voffB[2];
#pragma unroll
    for (int i = 0; i < 2; ++i) { int R, C; stage_rc(tid * 16 + i * 8192, R, C); const int Rb = Epi::PERM ? ((R & ~31) + perm32(R & 31)) : R;
        voffA[i] = (unsigned)(R * K + C) * 2u; voffB[i] = (unsigned)(Rb * K + C) * 2u; }
    const size_t kstep = (size_t)(BK * 2);
    const size_t hstep = (size_t)HALF * K * 2;
    const size_t tstep = 2 * hstep;
    const unsigned ldsw = (unsigned)wid * 1024u;
    const int aoff = lds_byte(wr * 64 + fr, fq * 8), boff = lds_byte(wc * 32 + fr, fq * 8);
#define PG8_SA(b, h) (((b) * 2 + (h)) * HTB)
#define PG8_SB(b, h) ((4 + (b) * 2 + (h)) * HTB)
#define PG8_STAGE(bufoff, gbase, voff) do { _Pragma("unroll") for (int _i = 0; _i < 2; ++_i) \
        __builtin_amdgcn_global_load_lds((const unsigned*)((const char*)(gbase) + (voff)[_i]), (PG8_LAS unsigned*)(lds + (bufoff) + ldsw + _i * 8192), 16, 0, 0); } while (0)
#define PG8_LDA(dst, b, h) do { _Pragma("unroll") for (int m = 0; m < 4; ++m) _Pragma("unroll") for (int k = 0; k < 2; ++k) dst[m][k] = *(const PG8_LAS bf16x8*)(lds + PG8_SA(b, h) + aoff + m * 2048 + k * 1024); } while (0)
#define PG8_LDB(dst, b, h) do { _Pragma("unroll") for (int n = 0; n < 2; ++n) _Pragma("unroll") for (int k = 0; k < 2; ++k) dst[n][k] = *(const PG8_LAS bf16x8*)(lds + PG8_SB(b, h) + boff + n * 2048 + k * 1024); } while (0)
#define PG8_MMA(ai, bj, At, Bt) do { __builtin_amdgcn_s_setprio(1); _Pragma("unroll") for (int m = 0; m < 4; ++m) _Pragma("unroll") for (int n = 0; n < 2; ++n) _Pragma("unroll") for (int k = 0; k < 2; ++k) \
        acc[ai][bj][m][n] = __builtin_amdgcn_mfma_f32_16x16x32_bf16(Bt[n][k], At[m][k], acc[ai][bj][m][n], 0, 0, 0); __builtin_amdgcn_s_setprio(0); } while (0)
#define PG8_WAIT_V(n) asm volatile("s_waitcnt vmcnt(" #n ")" ::: "memory")
#define PG8_WAIT_L(n) asm volatile("s_waitcnt lgkmcnt(" #n ")" ::: "memory")
#define PG8_BAR __builtin_amdgcn_s_barrier()
#define PG8_SCHED __builtin_amdgcn_sched_barrier(0)
    Unit cur, nxt; int ui = 0;
    if (!S.next(0, cur)) return;
    f32x4 acc[2][2][4][2];
#pragma unroll
    for (int a = 0; a < 2; ++a)
#pragma unroll
        for (int b = 0; b < 2; ++b)
#pragma unroll
            for (int m = 0; m < 4; ++m)
#pragma unroll
                for (int n = 0; n < 2; ++n) acc[a][b][m][n] = (f32x4){0.f, 0.f, 0.f, 0.f};
    bf16x8 At[4][2], B0[2][2], B1[2][2];
    const char* cA = (const char*)g.A + (size_t)cur.pm * tstep; const char* cB = (const char*)g.Bt + (size_t)cur.pn * tstep;
    S.a_ready(cur);
    if constexpr (SP2) {
        PG8_STAGE(PG8_SB(0, 0), cB, voffB); PG8_STAGE(PG8_SB(0, 1), cB + hstep, voffB); PG8_STAGE(PG8_SA(0, 0), cA, voffA); PG8_STAGE(PG8_SA(0, 1), cA + hstep, voffA);
        if (wr == 1) PG8_BAR;
        PG8_WAIT_V(2); PG8_BAR;
        PG8_STAGE(PG8_SB(1, 0), cB + kstep, voffB); PG8_STAGE(PG8_SA(1, 0), cA + kstep, voffA); PG8_STAGE(PG8_SB(1, 1), cB + hstep + kstep, voffB);
        PG8_WAIT_V(6); PG8_BAR;
    } else {
        PG8_STAGE(PG8_SB(0, 0), cB, voffB); PG8_STAGE(PG8_SA(0, 0), cA, voffA); PG8_STAGE(PG8_SB(0, 1), cB + hstep, voffB); PG8_STAGE(PG8_SA(0, 1), cA + hstep, voffA);
        if (wr == 1) PG8_BAR;
        PG8_WAIT_V(4); PG8_BAR;
        PG8_STAGE(PG8_SB(1, 0), cB + kstep, voffB); PG8_STAGE(PG8_SA(1, 0), cA + kstep, voffA); PG8_STAGE(PG8_SB(1, 1), cB + hstep + kstep, voffB);
        PG8_WAIT_V(6); PG8_BAR;
    }
    for (;;) {
        const bool has_next = S.next(ui + 1, nxt);
        const char* nA = has_next ? (const char*)g.A + (size_t)nxt.pm * tstep : cA; const char* nB = has_next ? (const char*)g.Bt + (size_t)nxt.pn * tstep : cB;
        for (int t = 0; t < nt; t += 2) {
            const bool last = (t == nt - 2);
            const char* a1 = cA + (size_t)(t + 1) * kstep;
            const char* a2 = last ? nA : cA + (size_t)(t + 2) * kstep; const char* b2 = last ? nB : cB + (size_t)(t + 2) * kstep;
            const char* a3 = a2 + kstep; const char* b3 = b2 + kstep;
            if (last && has_next) S.a_ready(nxt);
            if constexpr (SP2) {
            PG8_LDB(B0, 0, 0); PG8_LDB(B1, 0, 1); PG8_SCHED; PG8_LDA(At, 0, 0); PG8_STAGE(PG8_SA(1, 1), a1 + hstep, voffA);
            PG8_WAIT_V(8); PG8_WAIT_L(0); PG8_BAR; PG8_MMA(0, 0, At, B0); PG8_MMA(0, 1, At, B1); PG8_BAR; PG8_SCHED;
            PG8_LDA(At, 0, 1); PG8_STAGE(PG8_SB(0, 0), b2, voffB); PG8_STAGE(PG8_SB(0, 1), b2 + hstep, voffB); PG8_STAGE(PG8_SA(0, 0), a2, voffA);
            PG8_WAIT_V(8); PG8_WAIT_L(0); PG8_BAR; PG8_MMA(1, 0, At, B0); PG8_MMA(1, 1, At, B1); PG8_BAR; PG8_SCHED;
            PG8_LDB(B0, 1, 0); PG8_LDB(B1, 1, 1); PG8_SCHED; PG8_LDA(At, 1, 0); PG8_STAGE(PG8_SA(0, 1), a2 + hstep, voffA);
            PG8_WAIT_V(8); PG8_WAIT_L(0); PG8_BAR; PG8_MMA(0, 0, At, B0); PG8_MMA(0, 1, At, B1); PG8_BAR; PG8_SCHED;
            PG8_LDA(At, 1, 1); PG8_STAGE(PG8_SB(1, 0), b3, voffB); PG8_STAGE(PG8_SB(1, 1), b3 + hstep, voffB); PG8_STAGE(PG8_SA(1, 0), a3, voffA);
            PG8_WAIT_V(8); PG8_WAIT_L(0); PG8_BAR; PG8_MMA(1, 0, At, B0); PG8_MMA(1, 1, At, B1); PG8_BAR; PG8_SCHED;
            } else {
            PG8_LDB(B0, 0, 0); PG8_SCHED; PG8_LDA(At, 0, 0); PG8_STAGE(PG8_SA(1, 1), a1 + hstep, voffA);
            PG8_WAIT_L(8); PG8_BAR; PG8_WAIT_L(0); PG8_MMA(0, 0, At, B0); PG8_BAR; PG8_SCHED;
            PG8_LDB(B1, 0, 1); PG8_STAGE(PG8_SB(0, 0), b2, voffB);
            PG8_BAR; PG8_WAIT_L(0); PG8_MMA(0, 1, At, B1); PG8_BAR;
            PG8_LDA(At, 0, 1); PG8_STAGE(PG8_SA(0, 0), a2, voffA);
            PG8_BAR; PG8_WAIT_L(0); PG8_MMA(1, 0, At, B0); PG8_BAR; PG8_SCHED;
            PG8_STAGE(PG8_SB(0, 1), b2 + hstep, voffB);
            PG8_WAIT_V(6); PG8_BAR; PG8_MMA(1, 1, At, B1); PG8_BAR;
            PG8_LDB(B0, 1, 0); PG8_SCHED; PG8_LDA(At, 1, 0); PG8_STAGE(PG8_SA(0, 1), a2 + hstep, voffA);
            PG8_WAIT_L(8); PG8_BAR; PG8_WAIT_L(0); PG8_MMA(0, 0, At, B0); PG8_BAR; PG8_SCHED;
            PG8_LDB(B1, 1, 1); PG8_STAGE(PG8_SB(1, 0), b3, voffB);
            PG8_BAR; PG8_WAIT_L(0); PG8_MMA(0, 1, At, B1); PG8_BAR;
            PG8_LDA(At, 1, 1); PG8_STAGE(PG8_SA(1, 0), a3, voffA);
            PG8_BAR; PG8_WAIT_L(0); PG8_MMA(1, 0, At, B0); PG8_BAR; PG8_SCHED;
            PG8_STAGE(PG8_SB(1, 1), b3 + hstep, voffB);
            PG8_WAIT_V(6); PG8_BAR; PG8_MMA(1, 1, At, B1); PG8_BAR;
            }
        }
        if constexpr (ALIGN_EPI) { if (wr == 0) PG8_BAR; }
        if constexpr (!Epi::AFTER_DRAIN) { E(acc, cur, wr, wc, fr, fq); S.done(cur); }
        if (!has_next) break;
#pragma unroll
        for (int a = 0; a < 2; ++a)
#pragma unroll
            for (int b = 0; b < 2; ++b)
#pragma unroll
                for (int m = 0; m < 4; ++m)
#pragma unroll
                    for (int n = 0; n < 2; ++n) acc[a][b][m][n] = (f32x4){0.f, 0.f, 0.f, 0.f};
        cur = nxt; cA = nA; cB = nB; ++ui;
        if constexpr (ALIGN_EPI) { if (wr == 1) PG8_BAR; }
    }
    PG8_WAIT_V(0);
    if constexpr (!ALIGN_EPI) { if (wr == 0) PG8_BAR; }
    PG8_BAR;
    if constexpr (Epi::AFTER_DRAIN) { E.fused(acc, cur, wr, wc, fr, fq, lds, wid, lane); S.done(cur); }
#undef PG8_SA
#undef PG8_SB
#undef PG8_STAGE
#undef PG8_LDA
#undef PG8_LDB
#undef PG8_MMA
#undef PG8_WAIT_V
#undef PG8_WAIT_L
#undef PG8_BAR
#undef PG8_SCHED
}
}
#define GAS __attribute__((address_space(1)))
#define LAS __attribute__((address_space(3)))
typedef unsigned short bf16;
typedef unsigned v4u __attribute__((ext_vector_type(4)));
typedef float f32x4 __attribute__((ext_vector_type(4)));
typedef short bf16x8 __attribute__((ext_vector_type(8)));
typedef GAS unsigned gu32;
typedef GAS unsigned long long gu64;
#define RLX_AGENT __ATOMIC_RELAXED, __HIP_MEMORY_SCOPE_AGENT
#define LDS_WAIT() asm volatile("s_waitcnt lgkmcnt(0)" ::: "memory")
#define VM_WAIT() asm volatile("s_waitcnt vmcnt(0)" ::: "memory")
__device__ __forceinline__ unsigned long long rt() { return __builtin_amdgcn_s_memrealtime(); }
__device__ __forceinline__ unsigned f2bf(float f) { unsigned u = __builtin_bit_cast(unsigned, f); return (u + 0x7fffu + ((u >> 16) & 1u)) >> 16; }
__device__ __forceinline__ unsigned pk2(float lo, float hi) { return f2bf(lo) | (f2bf(hi) << 16); }

#define XB_TMO      128
#define XB_XCNT(j)  (256  + 64 * (j))
#define XB_XSUB(j)  (1280 + 64 * (j))
#define XB_XGEN(j)  (2304 + 64 * (j))
#define XB_TOP      3328
#define XB_TOPGEN   3392
#define XCD_BAR_WORDS 3456
#define XB_SPIN_CAP (1u << 18)

__device__ __forceinline__ unsigned xb_ld(unsigned* p)              { return __hip_atomic_load(p, __ATOMIC_RELAXED, __HIP_MEMORY_SCOPE_AGENT); }
__device__ __forceinline__ unsigned xb_add(unsigned* p, unsigned v) { return __hip_atomic_fetch_add(p, v, __ATOMIC_RELAXED, __HIP_MEMORY_SCOPE_AGENT); }
__device__ __forceinline__ unsigned xb_xcc_id() { return (unsigned)__builtin_amdgcn_s_getreg((3 << 11) | 20) & 0xFu; }
#define XB_SPIN(cond, bar) do { unsigned _sp = 0; while (cond) { __builtin_amdgcn_s_sleep(1); \
    if ((++_sp & 255u) == 0u) { if (xb_ld(&(bar)[XB_TMO])) break; if (_sp > XB_SPIN_CAP) { atomicAdd(&(bar)[XB_TMO], 1u); break; } } } } while (0)

struct XcdBarrier {
    unsigned* bar; unsigned x;
    volatile LAS unsigned* st;
};

__device__ __forceinline__ XcdBarrier xcd_barrier_post(unsigned* bar, volatile LAS unsigned* st) {
    XcdBarrier b; b.bar = bar; b.x = xb_xcc_id(); b.st = st;
    if (threadIdx.x == 0) (void)xb_add(&bar[XB_XCNT(b.x)], 1u);
    return b;
}
__device__ __forceinline__ void xcd_barrier_complete(unsigned* bar, unsigned x, unsigned& nloc, unsigned& nx) {
    const unsigned G = gridDim.x * gridDim.y * gridDim.z;
    unsigned sum, cnt, mine, sp = 0u;
    for (;;) {
        sum = 0u; cnt = 0u; mine = 0u;
#pragma unroll
        for (unsigned j = 0; j < 16; ++j) { const unsigned c = xb_ld(&bar[XB_XCNT(j)]); sum += c; cnt += (c > 0u) ? 1u : 0u; mine = (j == x) ? c : mine; }
        if (sum == G) break;
        __builtin_amdgcn_s_sleep(1);
        if ((++sp & 255u) == 0u) { if (xb_ld(&bar[XB_TMO])) break; if (sp > XB_SPIN_CAP) { atomicAdd(&bar[XB_TMO], 1u); break; } }
    }
    nloc = mine > 0u ? mine : 1u; nx = cnt > 0u ? cnt : 1u;
}

__device__ __forceinline__ void xcd_barrier(const XcdBarrier& b) {
    asm volatile("s_waitcnt vmcnt(0)" ::: "memory");
    __syncthreads();
    if (threadIdx.x == 0) {
        unsigned* bar = b.bar;
        __builtin_amdgcn_s_waitcnt(0);
        unsigned nloc = b.st[0], nx = b.st[1];
        if (nloc == 0u) { xcd_barrier_complete(bar, b.x, nloc, nx); b.st[0] = nloc; b.st[1] = nx; }
        const unsigned old = xb_add(&bar[XB_XSUB(b.x)], 1u);
        const unsigned gen = old / nloc;
        if (old + 1u == (gen + 1u) * nloc) {
            __builtin_amdgcn_fence(__ATOMIC_RELEASE, "agent");
            asm volatile("s_waitcnt vmcnt(0)" ::: "memory");
            const unsigned og = xb_add(&bar[XB_TOP], 1u);
            const unsigned tg = og / nx;
            if (og + 1u == (tg + 1u) * nx) xb_add(&bar[XB_TOPGEN], 1u);
            else XB_SPIN(xb_ld(&bar[XB_TOPGEN]) == tg, bar);
            __builtin_amdgcn_fence(__ATOMIC_ACQUIRE, "agent");
            xb_add(&bar[XB_XGEN(b.x)], 1u);
            asm volatile("s_waitcnt vmcnt(0)" ::: "memory");
        } else {
            XB_SPIN(xb_ld(&bar[XB_XGEN(b.x)]) == gen, bar);
            __builtin_amdgcn_fence(__ATOMIC_ACQUIRE, "agent");
            asm volatile("s_waitcnt vmcnt(0)" ::: "memory");
        }
    }
    __syncthreads();
}


constexpr int NWAVES = 8;
constexpr int RING_BYTES = 131072;
constexpr int LDSCTL_OFF = RING_BYTES, MISC_OFF = LDSCTL_OFF + 320;
constexpr int LDS_TS_OFF = LDSCTL_OFF + 1024;
constexpr int LDS_TE_OFF = LDSCTL_OFF + 2048;
constexpr int LDS_BYTES = 147456;

typedef short s16x4 __attribute__((ext_vector_type(4)));
typedef unsigned u32x2 __attribute__((ext_vector_type(2)));

struct Args { const float* in[20]; float* out; unsigned char* ws; int pad0, pad1; };

__device__ __forceinline__ float bflo(unsigned w) { return __uint_as_float(w << 16); }
__device__ __forceinline__ float bfhi(unsigned w) { return __uint_as_float(w & 0xffff0000u); }
__device__ __forceinline__ unsigned cvtpk(float lo, float hi) { return pg8::cvt_pk_bf16(lo, hi); }
__device__ __forceinline__ float wave_sum(float v) {
#pragma unroll
    for (int o = 1; o < 64; o <<= 1) v += __shfl_xor(v, o);
    return v;
}
__device__ __forceinline__ unsigned offb(unsigned row, unsigned ch) { return 256u * row + 16u * (ch ^ (((row & 3u) << 2) | ((row >> 2) & 3u))); }
__device__ __forceinline__ s16x4 ldtr(const LAS unsigned char* p) { return __builtin_amdgcn_ds_read_tr16_b64_v4i16((LAS s16x4*)p); }
__device__ __forceinline__ bf16x8 cat8(s16x4 a, s16x4 b) { return (bf16x8){a[0], a[1], a[2], a[3], b[0], b[1], b[2], b[3]}; }
#define MFMA16(a, b, c) __builtin_amdgcn_mfma_f32_16x16x32_bf16((a), (b), (c), 0, 0, 0)

template <int MODE> __device__ __forceinline__ int dest_row(int n) {
    if (MODE == 1) { if (n >= 1024) return n; const int hb = n & ~127, d = n & 127, jr = d & 63, half = d >> 6; return hb + 8 * (jr >> 2) + 4 * half + (jr & 3); }
    if (MODE == 2) return ((n >> 2) << 3) + (n & 3);
    if (MODE == 3) return ((n >> 2) << 3) + 4 + (n & 3);
    return n;
}
template <int MODE> __device__ __forceinline__ void p0_transpose_item(const float* W, int K, int N, bf16* WT, LAS float* scr, int item, int lane) {
    const int nblk = N / 32, kb = item / nblk, nb = item % nblk, k0 = 64 * kb, n0 = 32 * nb;
#pragma unroll 8
    for (int i = 0; i < 32; ++i) { const int kk = 2 * i + (lane >> 5); scr[kk * 33 + (lane & 31)] = W[(size_t)(k0 + kk) * N + n0 + (lane & 31)]; }
    LDS_WAIT(); asm volatile("" ::: "memory");
    const int c = lane & 7;
#pragma unroll
    for (int j = 0; j < 4; ++j) { const int n = (lane >> 3) + 8 * j; const LAS float* s = scr + (8 * c) * 33 + n;
        v4u o; o.x = pk2(s[0 * 33], s[1 * 33]); o.y = pk2(s[2 * 33], s[3 * 33]); o.z = pk2(s[4 * 33], s[5 * 33]); o.w = pk2(s[6 * 33], s[7 * 33]);
        *(GAS v4u*)(WT + (size_t)dest_row<MODE>(n0 + n) * K + k0 + 8 * c) = o; }
    LDS_WAIT(); asm volatile("" ::: "memory");
}
__device__ __forceinline__ int t5_bucket(int rel) {
    const int n = rel < 0 ? -rel : rel;
    int large = 8 + (n >= 15) + (n >= 27) + (n >= 50) + (n >= 91) + (n >= 166) + (n >= 305) + (n >= 559);
    large = large < 15 ? large : 15;
    return (rel > 0 ? 16 : 0) + (n < 8 ? n : large);
}
__device__ __forceinline__ void p0_prologue(const Args& a, LAS unsigned char* lds, int vcu, int G, int tid, int wave, int lane) {
    unsigned char* ws = a.ws;
    LAS float* scr = (LAS float*)(lds + wave * 16384);
    const int gw = vcu * NWAVES + wave, NGW = G * NWAVES;
    constexpr int I_IN = 16 * 208, I_R = 16 * 32, I_A = 8 * 32, I_O = 16 * 32, I_G = 16 * 16, I_D = 8 * 32;
    constexpr int NITEMS = I_IN + I_R + I_A + I_O + 16 * (2 * I_G + I_D);
    for (int it = gw; it < NITEMS; it += NGW) {
        int r = it;
        if (r < I_IN) { p0_transpose_item<1>(a.in[1], 1024, 6656, (bf16*)(ws + WS_WIN), scr, r, lane); continue; } r -= I_IN;
        if (r < I_R) { p0_transpose_item<0>(a.in[5], 1024, 1024, (bf16*)(ws + WS_WR), scr, r, lane); continue; } r -= I_R;
        if (r < I_A) { p0_transpose_item<0>(a.in[7], 512, 1024, (bf16*)(ws + WS_WA), scr, r, lane); continue; } r -= I_A;
        if (r < I_O) { p0_transpose_item<0>(a.in[8], 1024, 1024, (bf16*)(ws + WS_WO), scr, r, lane); continue; } r -= I_O;
        const int e = r / (2 * I_G + I_D); r -= e * (2 * I_G + I_D);
        if (r < I_G) { p0_transpose_item<2>(a.in[15] + (size_t)e * 1024 * 512, 1024, 512, (bf16*)(ws + WS_WGU) + (size_t)e * 1024 * 1024, scr, r, lane); continue; } r -= I_G;
        if (r < I_G) { p0_transpose_item<3>(a.in[16] + (size_t)e * 1024 * 512, 1024, 512, (bf16*)(ws + WS_WGU) + (size_t)e * 1024 * 1024, scr, r, lane); continue; } r -= I_G;
        p0_transpose_item<0>(a.in[17] + (size_t)e * 512 * 1024, 512, 1024, (bf16*)(ws + WS_WD) + (size_t)e * 1024 * 512, scr, r, lane);
    }
    {
        const f32x4* x4 = (const f32x4*)a.in[0]; u32x2* xb = (u32x2*)(ws + WS_XB);
        for (size_t i = (size_t)vcu * 512 + tid; i < (size_t)TT * DM / 4; i += (size_t)G * 512) { const f32x4 v = x4[i]; u32x2 o; o.x = cvtpk(v.x, v.y); o.y = cvtpk(v.z, v.w); xb[i] = o; }
    }
    {
        float* rot = (float*)(ws + WS_ROT);
        for (int idx = vcu * 512 + tid; idx < SEQ * 64; idx += G * 512) {
            const int pos = idx >> 6, jr = idx & 63;
            double iv = 1.0; for (int k = 0; k < jr; ++k) iv *= 0.86596432336006535;
            const float ang = (float)pos * (float)iv;
            const double xx = (double)ang; const double qd = __builtin_rint(xx * 0.63661977236758134); const int qi = (int)qd;
            const double r = (xx - qd * 1.5707963267948966) - qd * 6.123233995736766e-17, r2 = r * r;
            const double sp = r * (1.0 + r2 * (-1.0 / 6 + r2 * (1.0 / 120 + r2 * (-1.0 / 5040 + r2 * (1.0 / 362880 + r2 * (-1.0 / 39916800 + r2 * (1.0 / 6227020800.0)))))));
            const double cp = 1.0 + r2 * (-0.5 + r2 * (1.0 / 24 + r2 * (-1.0 / 720 + r2 * (1.0 / 40320 + r2 * (-1.0 / 3628800 + r2 * (1.0 / 479001600.0))))));
            const int qq = qi & 3; const double s = qq == 0 ? sp : (qq == 1 ? cp : (qq == 2 ? -sp : -cp)), c = qq == 0 ? cp : (qq == 1 ? -sp : (qq == 2 ? -cp : sp));
            float* o = rot + ((size_t)pos * 16 + (jr >> 2)) * 8 + (jr & 3); o[0] = (float)c; o[4] = (float)s;
        }
    }
    if (vcu == 0) {
        float* bt = (float*)(ws + WS_BIAS); const float* rb = a.in[6];
        for (int idx = tid; idx < 3 * 8 * 129; idx += 512) { const int p = idx / (8 * 129), h = (idx / 129) % 8, d = idx % 129; const int dil = p == 0 ? 1 : (p == 1 ? 4 : 16);
            bt[(p * 8 + h) * 132 + d] = rb[t5_bucket((d - 64) * dil) * 8 + h]; }
    }
}

__device__ __forceinline__ float log2_gamma(const float* dec, int h) {
    const float x = dec[h]; return -__log2f(1.f + __expf(-x));
}
__device__ __forceinline__ void chain_item(const Args& a, LAS unsigned char* lds, int item, int tid, int wid, int lane) {
    unsigned char* ws = a.ws;
    const int b = item >> 4, h = (item >> 2) & 3, dir = (item >> 1) & 1, vh = item & 1;
    const float lg2 = log2_gamma(dir ? a.in[3] : a.in[2], h);
    const float cd = __builtin_amdgcn_exp2f(lg2 * 128.f);
    const int g = lane >> 4, i16 = lane & 15, q = i16 >> 2, p = lane & 3;
    const int wd = wid >> 1, wv = wid & 1;
    LAS unsigned char* Kt = lds; LAS unsigned char* Vt = lds + 32768;
    const bf16* kr = (const bf16*)(ws + WS_KR); const bf16* vr = (const bf16*)(ws + WS_VR);
    bf16* states = (bf16*)a.out;
    f32x4 acc[2][4];
#pragma unroll
    for (int i = 0; i < 2; ++i)
#pragma unroll
        for (int j = 0; j < 4; ++j) acc[i][j] = (f32x4){0.f, 0.f, 0.f, 0.f};
    for (int step = 0; step < 16; ++step) {
        const int n = dir ? 15 - step : step;
        bf16* sb = states + ((((size_t)(b * 4 + h) * 16 + n) * 2 + dir) * 256) * 128;
#pragma unroll
        for (int dt = 0; dt < 2; ++dt)
#pragma unroll
            for (int vt = 0; vt < 4; ++vt) {
                const int v = vh * 128 + 64 * wv + 16 * vt + i16, d0 = 32 * wd + 16 * dt + 4 * g;
                u32x2 w; w.x = cvtpk(acc[dt][vt][0], acc[dt][vt][1]); w.y = cvtpk(acc[dt][vt][2], acc[dt][vt][3]);
                *(u32x2*)(sb + (size_t)v * 128 + d0) = w;
            }
        const size_t tok0 = (size_t)b * SEQ + n * 128;
#pragma unroll
        for (int j = 0; j < 4; ++j) {
            const int id = tid + 512 * j, row = id >> 4, ch = id & 15;
            const v4u kv = *(const v4u*)(kr + (tok0 + row) * 512 + h * 128 + ch * 8);
            const float z = __builtin_amdgcn_exp2f(lg2 * (float)(dir ? row : 127 - row));
            v4u ko; ko.x = cvtpk(bflo(kv.x) * z, bfhi(kv.x) * z); ko.y = cvtpk(bflo(kv.y) * z, bfhi(kv.y) * z); ko.z = cvtpk(bflo(kv.z) * z, bfhi(kv.z) * z); ko.w = cvtpk(bflo(kv.w) * z, bfhi(kv.w) * z);
            *(LAS v4u*)(Kt + offb(row, ch)) = ko;
            const v4u vv = *(const v4u*)(vr + (tok0 + row) * 1024 + h * 256 + vh * 128 + ch * 8);
            *(LAS v4u*)(Vt + offb(row, ch)) = vv;
        }
        __syncthreads();
#pragma unroll
        for (int i = 0; i < 2; ++i)
#pragma unroll
            for (int j = 0; j < 4; ++j) acc[i][j] = acc[i][j] * cd;
#pragma unroll
        for (int ks = 0; ks < 4; ++ks) {
            const unsigned r0 = 32 * ks + 8 * g + q, r1 = r0 + 4;
            bf16x8 af[2], bfr[4];
#pragma unroll
            for (int dt = 0; dt < 2; ++dt) { const unsigned c = 2 * wd + dt;
                af[dt] = cat8(ldtr(Kt + offb(r0, 2 * c + (p >> 1)) + 8 * (p & 1)), ldtr(Kt + offb(r1, 2 * c + (p >> 1)) + 8 * (p & 1))); }
#pragma unroll
            for (int vt = 0; vt < 4; ++vt) { const unsigned c = 4 * wv + vt;
                bfr[vt] = cat8(ldtr(Vt + offb(r0, 2 * c + (p >> 1)) + 8 * (p & 1)), ldtr(Vt + offb(r1, 2 * c + (p >> 1)) + 8 * (p & 1))); }
#pragma unroll
            for (int dt = 0; dt < 2; ++dt)
#pragma unroll
                for (int vt = 0; vt < 4; ++vt) acc[dt][vt] = MFMA16(af[dt], bfr[vt], acc[dt][vt]);
        }
        __syncthreads();
    }
}

constexpr int AT_OSTR = 68;
constexpr int AT_O = 0, AT_M = 256 * AT_OSTR * 4, AT_L = AT_M + 1024, AT_AB = AT_L + 1024, AT_V = AT_AB + 1024, AT_BIAS = AT_V + 8 * 4096, AT_END = AT_BIAS + 3 * 132 * 4;
static_assert(AT_END <= RING_BYTES, "attention LDS");
__device__ __forceinline__ void attn_group(const Args& a, LAS unsigned char* lds, int b, int h, int s0, int pat, int rho, int m0, int wid, int lane) {
    unsigned char* ws = a.ws;
    const int dil = pat == 0 ? 1 : (pat == 1 ? 4 : 16), nsub = SEQ / dil;
    const int g = lane >> 4, i16 = lane & 15, q4 = i16 >> 2, p = lane & 3;
    const bf16* qa = (const bf16*)(ws + WS_QA); const bf16* ka = (const bf16*)(ws + WS_KA); const bf16* va = (const bf16*)(ws + WS_VA);
    const size_t rowb = (size_t)b * SEQ;
    bf16x8 qf[2];
    { const size_t qpos = rowb + (size_t)(m0 + i16) * dil + rho;
#pragma unroll
      for (int s = 0; s < 2; ++s) qf[s] = *(const bf16x8*)(qa + qpos * 512 + h * 64 + 32 * s + 8 * g); }
    f32x4 D[10];
#pragma unroll
    for (int kt = 0; kt < 10; ++kt) {
        int ks = m0 - 64 + 16 * kt + i16; ks = ks < 0 ? 0 : (ks >= nsub ? nsub - 1 : ks);
        const bf16* kp = ka + (rowb + (size_t)ks * dil + rho) * 512 + h * 64 + 8 * g;
        const bf16x8 k0 = *(const bf16x8*)kp, k1 = *(const bf16x8*)(kp + 32);
        f32x4 d = (f32x4){0.f, 0.f, 0.f, 0.f};
        d = MFMA16(k0, qf[0], d); d = MFMA16(k1, qf[1], d); D[kt] = d;
        if (kt == 4) asm volatile("" ::: "memory");
    }
    const LAS float* biasL = (const LAS float*)(lds + AT_BIAS) + pat * 132;
    float mx = -1e30f;
#pragma unroll
    for (int kt = 0; kt < 10; ++kt)
#pragma unroll
        for (int r = 0; r < 4; ++r) {
            const int delta = 16 * kt + 4 * g + r - 64 - i16, ksub = m0 + i16 + delta;
            const bool valid = delta >= -64 && delta <= 64 && ksub >= 0 && ksub < nsub;
            const int bi = delta < -64 ? 0 : (delta > 64 ? 128 : delta + 64);
            const float lg = valid ? D[kt][r] + biasL[bi] : -1e30f;
            D[kt][r] = lg; mx = fmaxf(mx, lg);
        }
    mx = fmaxf(mx, __shfl_xor(mx, 16)); mx = fmaxf(mx, __shfl_xor(mx, 32));
    float lsum = 0.f;
#pragma unroll
    for (int kt = 0; kt < 10; ++kt)
#pragma unroll
        for (int r = 0; r < 4; ++r) { const float e = __expf(D[kt][r] - mx); D[kt][r] = e; lsum += e; }
    lsum += __shfl_xor(lsum, 16); lsum += __shfl_xor(lsum, 32);
    f32x4 O[4];
#pragma unroll
    for (int c = 0; c < 4; ++c) O[c] = (f32x4){0.f, 0.f, 0.f, 0.f};
    LAS unsigned char* vb = lds + AT_V + wid * 4096;
#pragma unroll
    for (int kk = 0; kk < 5; ++kk) {
#pragma unroll
        for (int j = 0; j < 4; ++j) {
            const int id = lane + 64 * j, row = id >> 3, ch = id & 7;
            int ks = m0 - 64 + 32 * kk + row; ks = ks < 0 ? 0 : (ks >= nsub ? nsub - 1 : ks);
            const v4u vv = *(const v4u*)(va + (rowb + (size_t)ks * dil + rho) * 512 + h * 64 + ch * 8);
            *(LAS v4u*)(vb + row * 128 + (((ch >> 1) ^ ((row >> 1) & 3)) * 32) + (ch & 1) * 16) = vv;
        }
        const f32x4 e0 = D[2 * kk], e1 = D[2 * kk + 1];
        v4u pw; pw.x = cvtpk(e0[0], e0[1]); pw.y = cvtpk(e0[2], e0[3]); pw.z = cvtpk(e1[0], e1[1]); pw.w = cvtpk(e1[2], e1[3]);
        const bf16x8 pf = __builtin_bit_cast(bf16x8, pw);
        const int ra = 4 * g + q4, rb = 16 + 4 * g + q4;
#pragma unroll
        for (int c = 0; c < 4; ++c) {
            const s16x4 lo = ldtr(vb + ra * 128 + ((c ^ ((ra >> 1) & 3)) * 32) + p * 8);
            const s16x4 hi = ldtr(vb + rb * 128 + ((c ^ ((rb >> 1) & 3)) * 32) + p * 8);
            O[c] = MFMA16(pf, cat8(lo, hi), O[c]);
        }
    }
    LAS float* Ost = (LAS float*)(lds + AT_O); LAS float* Mst = (LAS float*)(lds + AT_M); LAS float* Lst = (LAS float*)(lds + AT_L); LAS float* ab = (LAS float*)(lds + AT_AB) + wid * 32;
    if (g == 0) {
        const int ql = (m0 + i16) * dil + rho - s0;
        const float mo = Mst[ql], lo = Lst[ql], mn = fmaxf(mo, mx), fa = __expf(mo - mn), fb = __expf(mx - mn);
        Mst[ql] = mn; Lst[ql] = fa * lo + fb * lsum; ab[i16] = fa; ab[16 + i16] = fb;
    }
    asm volatile("s_waitcnt lgkmcnt(0)" ::: "memory");
#pragma unroll
    for (int r = 0; r < 4; ++r) {
        const int i = 4 * g + r; const float fa = ab[i], fb = ab[16 + i];
        LAS float* orow = Ost + ((m0 + i) * dil + rho - s0) * AT_OSTR + i16;
#pragma unroll
        for (int c = 0; c < 4; ++c) orow[16 * c] = fa * orow[16 * c] + fb * O[c][r];
    }
    asm volatile("s_waitcnt lgkmcnt(0)" ::: "memory");
}
__device__ __forceinline__ void attn_item(const Args& a, LAS unsigned char* lds, int item, int tid, int wid, int lane) {
    unsigned char* ws = a.ws;
    const int b = item >> 6, h = (item >> 3) & 7, s0 = (item & 7) * 256;
    LAS float* Ost = (LAS float*)(lds + AT_O); LAS float* Mst = (LAS float*)(lds + AT_M); LAS float* Lst = (LAS float*)(lds + AT_L);
    for (int i = tid; i < 256 * AT_OSTR; i += 512) Ost[i] = 0.f;
    if (tid < 256) { Mst[tid] = -1e30f; Lst[tid] = 0.f; }
    { const float* bt = (const float*)(ws + WS_BIAS); LAS float* bl = (LAS float*)(lds + AT_BIAS);
      if (tid < 3 * 132) { const int pp = tid / 132, d = tid % 132; bl[tid] = d < 129 ? bt[(pp * 8 + h) * 132 + d] : 0.f; } }
    __syncthreads();
    for (int pat = 0; pat < 3; ++pat) {
        for (int gi = wid; gi < 16; gi += 8) {
            const int rho = pat == 0 ? 0 : (pat == 1 ? gi >> 2 : gi), m0 = pat == 0 ? s0 + 16 * gi : (pat == 1 ? (s0 >> 2) + 16 * (gi & 3) : s0 >> 4);
            attn_group(a, lds, b, h, s0, pat, rho, m0, wid, lane);
        }
        __syncthreads();
    }
    {
        const int ql = tid >> 1, d0 = (tid & 1) * 32; const float inv = 1.f / Lst[ql];
        const LAS float* orow = Ost + ql * AT_OSTR + d0;
        bf16* op = (bf16*)(ws + WS_OA) + ((size_t)b * SEQ + s0 + ql) * 512 + h * 64 + d0;
#pragma unroll
        for (int j = 0; j < 4; ++j) { const f32x4 x0 = *(const LAS f32x4*)(orow + 8 * j), x1 = *(const LAS f32x4*)(orow + 8 * j + 4);
            v4u w; w.x = cvtpk(x0[0] * inv, x0[1] * inv); w.y = cvtpk(x0[2] * inv, x0[3] * inv); w.z = cvtpk(x1[0] * inv, x1[1] * inv); w.w = cvtpk(x1[2] * inv, x1[3] * inv);
            *(v4u*)(op + 8 * j) = w; }
    }
    __syncthreads();
}

#define OPAQUE(x) asm volatile("" : "+v"(x))
__device__ __forceinline__ void p3_item(const Args& a, LAS unsigned char* lds, int item, int tid, int wid, int lane) {
    unsigned char* ws = a.ws;
    const int b = item >> 6, h = (item >> 4) & 3, n = item & 15;
    const float lf2 = log2_gamma(a.in[2], h), lb2 = log2_gamma(a.in[3], h);
    const int g = lane >> 4, i16 = lane & 15, q4 = i16 >> 2, p = lane & 3;
    const size_t tok0 = (size_t)b * SEQ + n * 128;
    const bf16* qr = (const bf16*)(ws + WS_QR); const bf16* kr = (const bf16*)(ws + WS_KR); const bf16* vr = (const bf16*)(ws + WS_VR);
    LAS unsigned char* Kt = lds; LAS unsigned char* Vt = lds + 32768;
    {
        const int row = tid >> 4, ch = tid & 15; LAS unsigned char* kd = Kt + offb(row, ch); const bf16* ks_ = kr + (tok0 + row) * 512 + h * 128 + ch * 8;
#pragma unroll
        for (int j = 0; j < 4; ++j) *(LAS v4u*)(kd + j * 8192) = *(const v4u*)(ks_ + (size_t)j * 32 * 512);
        const int vrow = tid >> 5, vch = tid & 31; LAS unsigned char* vd = Vt + (vch >> 4) * 32768 + offb(vrow, vch & 15); const bf16* vs_ = vr + (tok0 + vrow) * 1024 + h * 256 + vch * 8;
#pragma unroll
        for (int j = 0; j < 8; ++j) *(LAS v4u*)(vd + j * 4096) = *(const v4u*)(vs_ + (size_t)j * 16 * 1024);
    }
    bf16x8 qf[4];
#pragma unroll
    for (int s = 0; s < 4; ++s) qf[s] = *(const bf16x8*)(qr + (tok0 + 16 * wid + i16) * 512 + h * 128 + 32 * s + 8 * g);
    __syncthreads();
    f32x4 D[8];
    {
        const unsigned X = ((i16 & 3) << 2) | (i16 >> 2);
        const LAS unsigned char* kb[4];
#pragma unroll
        for (int s = 0; s < 4; ++s) kb[s] = Kt + 256 * i16 + 16 * (((4 * s) ^ (X & 12)) | (g ^ (X & 3)));
#pragma unroll
        for (int jt = 0; jt < 8; ++jt) {
            f32x4 d = (f32x4){0.f, 0.f, 0.f, 0.f};
#pragma unroll
            for (int s = 0; s < 4; ++s) { const bf16x8 kf = *(const LAS bf16x8*)(kb[s] + jt * 4096); d = MFMA16(kf, qf[s], d); }
            D[jt] = d;
        }
    }
    int iq = 16 * wid + i16; OPAQUE(iq);
    bf16x8 pf[4];
#pragma unroll
    for (int ks = 0; ks < 4; ++ks) {
        float e[8];
#pragma unroll
        for (int t = 0; t < 2; ++t)
#pragma unroll
            for (int r = 0; r < 4; ++r) {
                const int j = 16 * (2 * ks + t) + 4 * g + r; const float fdf = (float)(iq - j), ad = fabsf(fdf);
                const float pos = fminf(fmaxf(fdf, 0.f), 1.f), isz = 1.f - fminf(ad, 1.f);
                const float w = __builtin_amdgcn_exp2f((lb2 + (lf2 - lb2) * pos) * ad) + isz;
                e[4 * t + r] = D[2 * ks + t][r] * w;
            }
        v4u pw; pw.x = cvtpk(e[0], e[1]); pw.y = cvtpk(e[2], e[3]); pw.z = cvtpk(e[4], e[5]); pw.w = cvtpk(e[6], e[7]);
        pf[ks] = __builtin_bit_cast(bf16x8, pw);
    }
    f32x4 acc[16];
#pragma unroll
    for (int vt = 0; vt < 16; ++vt) acc[vt] = (f32x4){0.f, 0.f, 0.f, 0.f};
    const GAS bf16* sf = (const GAS bf16*)a.out + ((((size_t)(b * 4 + h) * 16 + n) * 2 + 0) * 256) * 128;
    float xb_[4], xr_[4];
#pragma unroll
    for (int r = 0; r < 4; ++r) { const int i = 16 * wid + 4 * g + r; const float lxf = lf2 * (float)(i + 1), lxb = lb2 * (float)(128 - i); xb_[r] = __builtin_amdgcn_exp2f(lxb); xr_[r] = __builtin_amdgcn_exp2f(lxf - lxb); }
#pragma unroll
    for (int dirn = 0; dirn < 2; ++dirn) {
        const GAS bf16* sp = sf + (size_t)dirn * 256 * 128 + (size_t)i16 * 128 + 8 * g; bf16x8 nx[4];
#pragma unroll
        for (int s = 0; s < 4; ++s) nx[s] = *(const GAS bf16x8*)(sp + 32 * s);
#pragma unroll
        for (int vt = 0; vt < 16; ++vt) {
            bf16x8 cu[4];
#pragma unroll
            for (int s = 0; s < 4; ++s) cu[s] = nx[s];
            if (vt < 15) { sp += 16 * 128; OPAQUE(sp);
#pragma unroll
                for (int s = 0; s < 4; ++s) nx[s] = *(const GAS bf16x8*)(sp + 32 * s); }
            asm volatile("" ::: "memory");
#pragma unroll
            for (int s = 0; s < 4; ++s) acc[vt] = MFMA16(qf[s], cu[s], acc[vt]);
        }
#pragma unroll
        for (int vt = 0; vt < 16; ++vt)
#pragma unroll
            for (int r = 0; r < 4; ++r) acc[vt][r] *= (dirn == 0 ? xr_[r] : xb_[r]);
    }
    {
        const unsigned X = (q4 << 2) | g;
        const LAS unsigned char* vbs[8];
#pragma unroll
        for (int c = 0; c < 8; ++c) vbs[c] = Vt + 256 * (4 * g + q4) + 16 * (((2 * c) ^ (X & 14)) | ((p >> 1) ^ (X & 1))) + 8 * (p & 1);
#pragma unroll
        for (int vt = 0; vt < 16; ++vt) {
#pragma unroll
            for (int ks = 0; ks < 4; ++ks) {
                const s16x4 lo = ldtr(vbs[vt & 7] + (vt >> 3) * 32768 + ks * 8192), hi = ldtr(vbs[vt & 7] + (vt >> 3) * 32768 + ks * 8192 + 4096);
                acc[vt] = MFMA16(pf[ks], cat8(lo, hi), acc[vt]);
            }
            asm volatile("" ::: "memory");
        }
    }
    float mu[4], rs[4];
#pragma unroll
    for (int r = 0; r < 4; ++r) {
        float s = 0.f;
#pragma unroll
        for (int vt = 0; vt < 16; ++vt) s += acc[vt][r];
        s += __shfl_xor(s, 1); s += __shfl_xor(s, 2); s += __shfl_xor(s, 4); s += __shfl_xor(s, 8);
        const float m = s * (1.f / 256.f); float qv = 0.f;
#pragma unroll
        for (int vt = 0; vt < 16; ++vt) { const float d = acc[vt][r] - m; qv += d * d; }
        qv += __shfl_xor(qv, 1); qv += __shfl_xor(qv, 2); qv += __shfl_xor(qv, 4); qv += __shfl_xor(qv, 8);
        mu[r] = m; rs[r] = 1.f / sqrtf(qv * (1.f / 256.f) + LN_EPSF);
    }
    __syncthreads();
    LAS bf16* st = (LAS bf16*)(lds + 32768 + wid * 8192);
    {
        LAS bf16* sp_ = st + (4 * g) * 256 + i16;
#pragma unroll
        for (int vt = 0; vt < 16; ++vt)
#pragma unroll
            for (int r = 0; r < 4; ++r) sp_[r * 256 + 16 * vt] = (bf16)(cvtpk((acc[vt][r] - mu[r]) * rs[r], 0.f) & 0xffffu);
    }
    asm volatile("s_waitcnt lgkmcnt(0)" ::: "memory");
    const float* gn = a.in[4] + h * 256; bf16* gr = (bf16*)(ws + WS_GR);
    {
        const int row = lane >> 5, ch = lane & 31;
        const f32x4 g0 = *(const f32x4*)(gn + ch * 8), g1 = *(const f32x4*)(gn + ch * 8 + 4);
        const LAS bf16* yp = st + row * 256 + ch * 8; bf16* gp = gr + (tok0 + 16 * wid + row) * 1024 + h * 256 + ch * 8;
#pragma unroll
        for (int j = 0; j < 8; ++j) {
            const v4u y = *(const LAS v4u*)(yp + j * 512);
            const v4u sg = *(const v4u*)(gp + (size_t)j * 2048);
            v4u o; o.x = cvtpk(bflo(y.x) * g0[0] * bflo(sg.x), bfhi(y.x) * g0[1] * bfhi(sg.x)); o.y = cvtpk(bflo(y.y) * g0[2] * bflo(sg.y), bfhi(y.y) * g0[3] * bfhi(sg.y));
            o.z = cvtpk(bflo(y.z) * g1[0] * bflo(sg.z), bfhi(y.z) * g1[1] * bfhi(sg.z)); o.w = cvtpk(bflo(y.w) * g1[2] * bflo(sg.w), bfhi(y.w) * g1[3] * bfhi(sg.w));
            *(v4u*)(gp + (size_t)j * 2048) = o;
        }
    }
    __syncthreads();
}

__device__ __forceinline__ void p6a_phase(const Args& a, LAS unsigned char* lds, int vcu, int G, int tid, int wave, int lane) {
    unsigned char* ws = a.ws;
    LAS float* RW = (LAS float*)lds;
    for (int i = tid; i < 1024 * 4; i += 512) { const int c = i >> 2, k = i & 3; RW[c * 20 + k] = a.in[11][i]; }
    for (int i = tid; i < 1024 * 16; i += 512) { const int c = i >> 4, k = i & 15; RW[c * 20 + 4 + k] = a.in[13][i]; }
    __syncthreads();
    float* x1 = a.out; u32x2* x1b = (u32x2*)(ws + WS_XB);
    gu32* ctl = (gu32*)ws;
    int* ltok = (int*)(ws + WS_LTOK); float* lw = (float*)(ws + WS_LW); unsigned* tinfo = (unsigned*)(ws + WS_TINFO);
    const float* g1 = a.in[9]; const float* b1 = a.in[10];
    const int gw = vcu * NWAVES + wave, NGW = G * NWAVES;
    for (int t = gw; t < TT; t += NGW) {
        f32x4* xr = (f32x4*)(x1 + (size_t)t * DM) + lane;
        f32x4 v[4]; float s = 0.f;
#pragma unroll
        for (int j = 0; j < 4; ++j) { v[j] = xr[64 * j]; s += (v[j].x + v[j].y) + (v[j].z + v[j].w); }
        const float mean = wave_sum(s) * (1.f / DM); float s2 = 0.f;
#pragma unroll
        for (int j = 0; j < 4; ++j) { v[j] = v[j] - mean; s2 += (v[j].x * v[j].x + v[j].y * v[j].y) + (v[j].z * v[j].z + v[j].w * v[j].w); }
        const float rstd = 1.f / sqrtf(wave_sum(s2) * (1.f / DM) + LN_EPSF);
        float lg[20];
#pragma unroll
        for (int k = 0; k < 20; ++k) lg[k] = 0.f;
#pragma unroll
        for (int j = 0; j < 4; ++j) {
            const f32x4 gg = *(const f32x4*)(g1 + 4 * lane + 256 * j), bb = *(const f32x4*)(b1 + 4 * lane + 256 * j);
            v[j] = v[j] * rstd * gg + bb;
            xr[64 * j] = v[j];
            u32x2 o; o.x = cvtpk(v[j].x, v[j].y); o.y = cvtpk(v[j].z, v[j].w); x1b[(size_t)t * 256 + lane + 64 * j] = o;
#pragma unroll
            for (int e = 0; e < 4; ++e) {
                const LAS f32x4* wr_ = (const LAS f32x4*)(RW + (4 * lane + 256 * j + e) * 20);
#pragma unroll
                for (int k4 = 0; k4 < 5; ++k4) { const f32x4 w = wr_[k4];
                    lg[4 * k4 + 0] += v[j][e] * w[0]; lg[4 * k4 + 1] += v[j][e] * w[1]; lg[4 * k4 + 2] += v[j][e] * w[2]; lg[4 * k4 + 3] += v[j][e] * w[3]; }
            }
        }
#pragma unroll
        for (int k = 0; k < 20; ++k) lg[k] = wave_sum(lg[k]);
        float gl[4];
#pragma unroll
        for (int k = 0; k < 4; ++k) gl[k] = lg[k] + a.in[12][k];
        int gi = 0; float gm = gl[0];
#pragma unroll
        for (int k = 1; k < 4; ++k) if (gl[k] > gm) { gm = gl[k]; gi = k; }
        float gs = 0.f;
#pragma unroll
        for (int k = 0; k < 4; ++k) gs += __expf(gl[k] - gm);
        const float gwt = 1.f / gs;
        float el[4];
#pragma unroll
        for (int k = 0; k < 4; ++k) { const float sel = gi == 0 ? lg[4 + k] : (gi == 1 ? lg[8 + k] : (gi == 2 ? lg[12 + k] : lg[16 + k])); el[k] = sel + a.in[14][4 * gi + k]; }
        int i1 = 0; float v1 = el[0];
#pragma unroll
        for (int k = 1; k < 4; ++k) if (el[k] > v1) { v1 = el[k]; i1 = k; }
        int i2 = -1; float v2 = -3.0e38f;
#pragma unroll
        for (int k = 0; k < 4; ++k) if (k != i1 && el[k] > v2) { v2 = el[k]; i2 = k; }
        const float ex = __expf(v2 - v1), w1 = gwt / (1.f + ex), w2 = gwt * ex / (1.f + ex);
        if (lane == 0) {
            const int e1 = 4 * gi + i1, e2 = 4 * gi + i2;
            const unsigned p1 = __hip_atomic_fetch_add(ctl + CW_CNT + 64 * e1, 1u, __ATOMIC_RELAXED, __HIP_MEMORY_SCOPE_AGENT);
            const unsigned p2 = __hip_atomic_fetch_add(ctl + CW_CNT + 64 * e2, 1u, __ATOMIC_RELAXED, __HIP_MEMORY_SCOPE_AGENT);
            ltok[e1 * TT + p1] = t; lw[e1 * TT + p1] = w1; ltok[e2 * TT + p2] = t; lw[e2 * TT + p2] = w2;
            tinfo[2 * t] = ((unsigned)e1 << 16) | p1; tinfo[2 * t + 1] = ((unsigned)e2 << 16) | p2;
        }
    }
}
__device__ __forceinline__ void build_tile_tables(const Args& a, LAS unsigned char* lds, int tid) {
    LAS int* ts = (LAS int*)(lds + LDS_TS_OFF); LAS int* te = (LAS int*)(lds + LDS_TE_OFF);
    gu32* ctl = (gu32*)a.ws;
    if (tid == 0) { int acc = 0;
        for (int e = 0; e < 16; ++e) { ts[e] = acc; const int c = (int)__hip_atomic_load(ctl + CW_CNT + 64 * e, __ATOMIC_RELAXED, __HIP_MEMORY_SCOPE_AGENT); const int nt = (c + 255) >> 8;
            for (int k = 0; k < nt; ++k) te[acc + k] = e; acc += nt; }
        ts[16] = acc; }
    __syncthreads();
}
__device__ __forceinline__ void p6b_phase(const Args& a, LAS unsigned char* lds, int vcu, int G, int wave, int lane) {
    unsigned char* ws = a.ws; gu32* ctl = (gu32*)ws;
    const LAS int* ts = (const LAS int*)(lds + LDS_TS_OFF);
    const int* ltok = (const int*)(ws + WS_LTOK); const float* lw = (const float*)(ws + WS_LW); float* wslot = (float*)(ws + WS_WSLOT);
    const v4u* x1b = (const v4u*)(ws + WS_XB); v4u* xg = (v4u*)(ws + WS_XG);
    const int gw = vcu * NWAVES + wave, NGW = G * NWAVES;
    for (int e = 0; e < 16; ++e) {
        const int cnt = (int)__hip_atomic_load(ctl + CW_CNT + 64 * e, __ATOMIC_RELAXED, __HIP_MEMORY_SCOPE_AGENT), s0 = ts[e] * 256;
        for (int pos = gw; pos < cnt; pos += NGW) {
            const int tok = ltok[e * TT + pos];
            const v4u r0 = x1b[(size_t)tok * 128 + lane], r1 = x1b[(size_t)tok * 128 + 64 + lane];
            xg[(size_t)(s0 + pos) * 128 + lane] = r0; xg[(size_t)(s0 + pos) * 128 + 64 + lane] = r1;
            if (lane == 0) wslot[s0 + pos] = lw[e * TT + pos];
        }
    }
}
__device__ __forceinline__ void p9_phase(const Args& a, LAS unsigned char* lds, int vcu, int G, int wave, int lane) {
    unsigned char* ws = a.ws;
    const LAS int* ts = (const LAS int*)(lds + LDS_TS_OFF);
    const unsigned* tinfo = (const unsigned*)(ws + WS_TINFO); const u32x2* Y = (const u32x2*)(ws + WS_Y);
    const float* g2 = a.in[18]; const float* b2 = a.in[19];
    const int gw = vcu * NWAVES + wave, NGW = G * NWAVES;
    for (int t = gw; t < TT; t += NGW) {
        const unsigned i0 = tinfo[2 * t], i1 = tinfo[2 * t + 1];
        const size_t s0 = (size_t)ts[i0 >> 16] * 256 + (i0 & 0xffffu), s1 = (size_t)ts[i1 >> 16] * 256 + (i1 & 0xffffu);
        f32x4* xr = (f32x4*)(a.out + (size_t)t * DM) + lane;
        f32x4 v[4]; float s = 0.f;
#pragma unroll
        for (int j = 0; j < 4; ++j) {
            const u32x2 y0 = Y[s0 * 256 + lane + 64 * j], y1 = Y[s1 * 256 + lane + 64 * j];
            f32x4 x = xr[64 * j] * DN_ALPHA;
            x.x += bflo(y0.x) + bflo(y1.x); x.y += bfhi(y0.x) + bfhi(y1.x); x.z += bflo(y0.y) + bflo(y1.y); x.w += bfhi(y0.y) + bfhi(y1.y);
            v[j] = x; s += (x.x + x.y) + (x.z + x.w);
        }
        const float mean = wave_sum(s) * (1.f / DM); float s2 = 0.f;
#pragma unroll
        for (int j = 0; j < 4; ++j) { v[j] = v[j] - mean; s2 += (v[j].x * v[j].x + v[j].y * v[j].y) + (v[j].z * v[j].z + v[j].w * v[j].w); }
        const float rstd = 1.f / sqrtf(wave_sum(s2) * (1.f / DM) + LN_EPSF);
#pragma unroll
        for (int j = 0; j < 4; ++j) { const f32x4 gg = *(const f32x4*)(g2 + 4 * lane + 256 * j), bb = *(const f32x4*)(b2 + 4 * lane + 256 * j); xr[64 * j] = v[j] * rstd * gg + bb; }
    }
}

__global__ void __launch_bounds__(NWAVES * 64, 2) mega_fwd(Args args) {
    extern __shared__ __attribute__((aligned(16))) unsigned char lds_raw[];
    LAS unsigned char* lds = (LAS unsigned char*)lds_raw;
    volatile LAS unsigned* MISC = (volatile LAS unsigned*)(lds + MISC_OFF);
    const int tid = threadIdx.x, lane = tid & 63, wave = __builtin_amdgcn_readfirstlane(tid >> 6);
    const int G = gridDim.x, bx = blockIdx.x, vcu = (G % 8 == 0) ? (bx % 8) * (G / 8) + bx / 8 : bx;
    for (int u = tid; u < (LDS_BYTES - LDSCTL_OFF) / 4; u += NWAVES * 64) ((LAS unsigned*)(lds + LDSCTL_OFF))[u] = 0u;
    __syncthreads();
    unsigned char* ws = args.ws;
    gu32* ctl = (gu32*)ws;
    XcdBarrier bar = xcd_barrier_post((unsigned*)(ctl + CW_BAR), MISC + 8);
#define GRID_BAR() xcd_barrier(bar)
#ifndef PH_LAST
#define PH_LAST 99
#endif
#ifdef ONLY
#define EN(k) (ONLY == (k))
#else
#define EN(k) true
#endif
    if (EN(0)) p0_prologue(args, lds, vcu, G, tid, wave, lane);
    GRID_BAR();
    if (EN(1)) {
        pg8::Gemm g{(const pg8::bf16_t*)(ws + WS_XB), (const pg8::bf16_t*)(ws + WS_WIN), TT, 4608, 1024}; pg8::StaticOrder S; S.init(TT, 4608, G, bx);
        pg8::EpiHcat E{ws, (const float*)(ws + WS_ROT), 0};
        pg8::gemm_phase<pg8::EpiHcat, pg8::StaticOrder, true, true>(lds, g, S, E);
    }
    GRID_BAR();
    if (PH_LAST >= 2) {
        if (EN(2)) for (int it = vcu; it < 256; it += G) chain_item(args, lds, it, tid, wave, lane);
        if (EN(3)) for (int it = vcu; it < 1024; it += G) attn_item(args, lds, it, tid, wave, lane);
    }
    GRID_BAR();
    if (PH_LAST >= 3 && EN(4)) for (int it = vcu; it < 1024; it += G) p3_item(args, lds, it, tid, wave, lane);
    GRID_BAR();
    if (PH_LAST >= 4 && EN(5)) {
        pg8::Gemm g{(const pg8::bf16_t*)(ws + WS_XB), (const pg8::bf16_t*)(ws + WS_WIN) + (size_t)4608 * 1024, TT, 2048, 1024}; pg8::StaticOrder S; S.init(TT, 2048, G, bx);
        pg8::EpiHcat E{ws, (const float*)(ws + WS_ROT), 18};
        pg8::gemm_phase<pg8::EpiHcat, pg8::StaticOrder, true, true>(lds, g, S, E);
    }
    GRID_BAR();
    if (PH_LAST >= 5 && EN(6)) {
        pg8::StaticOrder S; S.init(TT, 1024, G, bx);
        { pg8::Gemm g{(const pg8::bf16_t*)(ws + WS_OA), (const pg8::bf16_t*)(ws + WS_WA), TT, 1024, 512};
          pg8::EpiGate<false> E{(const pg8::bf16_t*)(ws + WS_GATE_A), (pg8::bf16_t*)(ws + WS_MERGED)};
          pg8::gemm_phase<pg8::EpiGate<false>, pg8::StaticOrder, true, true>(lds, g, S, E); }
        asm volatile("s_waitcnt vmcnt(0)" ::: "memory"); __syncthreads();
        { pg8::Gemm g{(const pg8::bf16_t*)(ws + WS_GR), (const pg8::bf16_t*)(ws + WS_WR), TT, 1024, 1024};
          pg8::EpiGate<true> E{(const pg8::bf16_t*)(ws + WS_GATE_R), (pg8::bf16_t*)(ws + WS_MERGED)};
          pg8::gemm_phase<pg8::EpiGate<true>, pg8::StaticOrder, true, true>(lds, g, S, E); }
    }
    GRID_BAR();
    if (PH_LAST >= 6 && EN(7)) {
        pg8::Gemm g{(const pg8::bf16_t*)(ws + WS_MERGED), (const pg8::bf16_t*)(ws + WS_WO), TT, 1024, 1024}; pg8::StaticOrder S; S.init(TT, 1024, G, bx);
        pg8::EpiResF32 E{args.in[0], args.out, DN_ALPHA};
        pg8::gemm_phase<pg8::EpiResF32, pg8::StaticOrder, true, true>(lds, g, S, E);
    }
    GRID_BAR();
    if (PH_LAST >= 7 && EN(8)) p6a_phase(args, lds, vcu, G, tid, wave, lane);
    GRID_BAR();
    build_tile_tables(args, lds, tid);
    if (PH_LAST >= 8 && EN(9)) p6b_phase(args, lds, vcu, G, wave, lane);
    GRID_BAR();
    const int nrt = ((const LAS int*)(lds + LDS_TS_OFF))[16];
    if (PH_LAST >= 9 && EN(10)) {
        pg8::Gemm g{(const pg8::bf16_t*)(ws + WS_XG), (const pg8::bf16_t*)(ws + WS_WGU), MAXSLOT, 1024, 1024};
        pg8::MoeOrder S{nrt * 4, G, bx, (const LAS int*)(lds + LDS_TE_OFF)};
        pg8::EpiSwiGLU E{(pg8::bf16_t*)(ws + WS_H)};
        pg8::gemm_phase<pg8::EpiSwiGLU, pg8::MoeOrder, true, true>(lds, g, S, E);
    }
    GRID_BAR();
    if (PH_LAST >= 10 && EN(11)) {
        pg8::Gemm g{(const pg8::bf16_t*)(ws + WS_H), (const pg8::bf16_t*)(ws + WS_WD), MAXSLOT, 1024, 512};
        pg8::MoeOrder S{nrt * 4, G, bx, (const LAS int*)(lds + LDS_TE_OFF)};
        pg8::EpiRowScale E{(pg8::bf16_t*)(ws + WS_Y), (const float*)(ws + WS_WSLOT)};
        pg8::gemm_phase<pg8::EpiRowScale, pg8::MoeOrder, true, true>(lds, g, S, E);
    }
    GRID_BAR();
    if (PH_LAST >= 11 && EN(12)) p9_phase(args, lds, vcu, G, wave, lane);
}

extern "C" void kernel_launch(void* const* d_in, const int* in_sizes, int n_in, void* d_out, int out_size, void* d_ws, size_t ws_size, hipStream_t stream) {
    static int grid = 0;
    if (grid == 0) {
        if (n_in != 20 || in_sizes[0] != TT * DM || out_size != TT * DM || ws_size < WS_END) { fprintf(stderr, "kernel_launch: unexpected shapes: n_in %d in0 %d out %d ws %zu; nothing launched\n", n_in, n_in > 0 ? in_sizes[0] : -1, out_size, ws_size); grid = -1; return; }
        int dev = 0, cus = 0;
        if (hipGetDevice(&dev) != hipSuccess || hipDeviceGetAttribute(&cus, hipDeviceAttributeMultiprocessorCount, dev) != hipSuccess) { grid = -1; return; }
        if (hipFuncSetAttribute((const void*)mega_fwd, hipFuncAttributeMaxDynamicSharedMemorySize, LDS_BYTES) != hipSuccess) { fprintf(stderr, "kernel_launch: hipFuncSetAttribute failed\n"); grid = -1; return; }
        (void)hipGetLastError();
        grid = cus;
    }
    if (grid < 0) return;
    if (hipMemsetAsync((char*)d_ws, 0, CTL_ZERO_BYTES, stream) != hipSuccess) return;
    Args a{};
    for (int i = 0; i < 20; ++i) a.in[i] = (const float*)d_in[i];
    a.out = (float*)d_out; a.ws = (unsigned char*)d_ws;
    hipLaunchKernelGGL(mega_fwd, dim3(grid), dim3(NWAVES * 64), LDS_BYTES, stream, a);
}
```

```cpp
#include <hip/hip_runtime.h>
#include <cstdio>
#include <cstdint>

constexpr int TT = 32768, DM = 1024, SEQ = 2048, NB = 16;
constexpr float DN_ALPHA = 1.189207115002721f;
constexpr float LN_EPSF = 1e-5f;
constexpr size_t MiB = 1u << 20;
constexpr size_t CTL_ZERO_BYTES = 1 * MiB;
constexpr size_t WS_ROT = 1 * MiB;
constexpr size_t WS_BIAS = 2 * MiB;
constexpr size_t WS_LTOK = 3 * MiB;
constexpr size_t WS_TINFO = 7 * MiB;
constexpr size_t WS_WSLOT = 7 * MiB + 512 * 1024;
constexpr size_t WS_WIN = 8 * MiB;
constexpr size_t WS_WR = 21 * MiB;
constexpr size_t WS_WA = 23 * MiB;
constexpr size_t WS_WO = 24 * MiB;
constexpr size_t WS_WGU = 26 * MiB;
constexpr size_t WS_WD = 58 * MiB;
constexpr size_t WS_XB = 80 * MiB;
constexpr size_t WS_QR = 144 * MiB;
constexpr size_t WS_KR = 176 * MiB;
constexpr size_t WS_VR = 208 * MiB;
constexpr size_t WS_GR = 272 * MiB;
constexpr size_t WS_QA = 336 * MiB, WS_KA = 368 * MiB, WS_VA = 400 * MiB, WS_OA = 432 * MiB;
constexpr size_t WS_GATE_R = 144 * MiB, WS_GATE_A = 208 * MiB;
constexpr size_t WS_MERGED = 336 * MiB;
constexpr size_t WS_Y = 144 * MiB;
constexpr size_t WS_H = 336 * MiB;
constexpr size_t WS_X1F8 = 464 * MiB;
constexpr size_t WS_O2 = 26 * MiB;
constexpr size_t WS_O3 = 464 * MiB;
constexpr size_t WS_LSE2 = 496 * MiB, WS_LSE3 = 497 * MiB;
constexpr size_t WS_END = 512 * MiB;
#ifndef M1_FP8
#define M1_FP8 0
#endif
constexpr int MAXSLOT = 69632;
constexpr int CW_BAR = 4096;
constexpr int CW_CNT = 16384;
constexpr int CW_CHK = 24576;
namespace pg8 {
#define PG8_LAS __attribute__((address_space(3)))
typedef unsigned short bf16_t;
typedef short bf16x8 __attribute__((ext_vector_type(8)));
typedef float f32x4 __attribute__((ext_vector_type(4)));
typedef unsigned u32x4 __attribute__((ext_vector_type(4)));
constexpr int BM = 256, BK = 64, HALF = 128, HTB = HALF * BK * 2  , STAGE_BYTES = 8 * HTB, NXCD = 8, WGM = 8;

__host__ __device__ __forceinline__ int lds_byte(int r, int c) { const int st = (r >> 4) * 2 + (c >> 5), rr = r & 15, cc = c & 31, ob = rr * 64 + cc * 2; return st * 1024 + (ob ^ (((ob >> 9) & 1) << 5)); }
__host__ __device__ __forceinline__ void stage_rc(int b, int& R, int& C) { const int st = b / 1024, sb = b % 1024, swz = sb ^ (((sb >> 9) & 1) << 5); R = (st >> 1) * 16 + swz / 64; C = (st & 1) * 32 + (swz % 64) / 2; }
__host__ __device__ __forceinline__ int perm32(int rho) { const int n = rho >> 4, i = rho & 15; return 8 * (i >> 2) + 4 * n + (i & 3); }

struct Unit { int pm, pn; };
struct Gemm { const bf16_t* A; const bf16_t* Bt; int M, N, K; };

struct StaticOrder {
    int nM, nN, nwg, G, c;
    __host__ __device__ void init(int M, int N, int G_, int c_) { nM = M / BM; nN = N / BM; nwg = nM * nN; G = G_; c = c_; }
    __host__ __device__ bool next(int i, Unit& u) const {
        const long L = (long)i * G + c; if (L >= nwg) return false;
        int wgid = (int)L; { const int q = nwg / NXCD, r = nwg % NXCD, xcd = wgid % NXCD, off = wgid / NXCD; wgid = (xcd < r ? xcd * (q + 1) : r * (q + 1) + (xcd - r) * q) + off; }
        const int nig = WGM * nN, gid = wgid / nig, fm = gid * WGM, gsz = (nM - fm) < WGM ? (nM - fm) : WGM;
        u.pm = fm + ((wgid % nig) % gsz); u.pn = (wgid % nig) / gsz; return true;
    }
    __device__ __forceinline__ void a_ready(const Unit&) const {}
    __device__ __forceinline__ void done(const Unit&) const {}
};

__device__ __forceinline__ unsigned cvt_pk_bf16(float lo, float hi) { unsigned r; asm volatile("v_cvt_pk_bf16_f32 %0, %1, %2" : "=v"(r) : "v"(lo), "v"(hi)); return r; }
typedef float cvt_f32x2_t __attribute__((ext_vector_type(2))); typedef __bf16 cvt_bf16x2_t __attribute__((ext_vector_type(2)));
__device__ __forceinline__ unsigned cvt_pk_bf16_acc(float lo, float hi) { const cvt_f32x2_t v = {lo, hi}; const cvt_bf16x2_t b = __builtin_convertvector(v, cvt_bf16x2_t); return __builtin_bit_cast(unsigned, b); }
__device__ __forceinline__ float bflo(unsigned w) { return __uint_as_float(w << 16); }
__device__ __forceinline__ float bfhi(unsigned w) { return __uint_as_float(w & 0xffff0000u); }
__device__ __forceinline__ float fsigmoid(float x) { return __builtin_amdgcn_rcpf(1.f + __expf(-x)); }
__device__ __forceinline__ float fsilu(float x) { return x * __builtin_amdgcn_rcpf(1.f + __expf(-x)); }

template <int VAR = 0> struct EpiHcatT {
    static constexpr bool PERM = true, AFTER_DRAIN = false; static constexpr int NSTORE = 16;
    unsigned char* ws; const float* rot; int tile_off;
    __device__ __forceinline__ void operator()(const f32x4 (&acc)[2][2][4][2], const Unit& u, int wr, int wc, int fr, int fq) const {
        if (VAR == 1) {
            float s = 0.f;
#pragma unroll
            for (int ai = 0; ai < 2; ++ai)
#pragma unroll
                for (int bj = 0; bj < 2; ++bj)
#pragma unroll
                    for (int m = 0; m < 4; ++m)
#pragma unroll
                        for (int n = 0; n < 2; ++n) s += (acc[ai][bj][m][n][0] + acc[ai][bj][m][n][1]) + (acc[ai][bj][m][n][2] + acc[ai][bj][m][n][3]);
            ((float*)(ws + WS_O3))[(size_t)(u.pm * 64 + u.pn) * 512 + wr * 256 + wc * 64 + fq * 16 + fr] = s; return;
        }
        const int gt = u.pn + tile_off;
        size_t base_off; int pitch, ct, mode; float sc = 1.f;
        if (gt < 2)       { base_off = WS_QR; pitch = 512;  ct = gt;      mode = 1; }
        else if (gt < 4)  { base_off = WS_KR; pitch = 512;  ct = gt - 2;  mode = 1; sc = 0.08838834764831845f; }
        else if (gt < 8)  { base_off = WS_VR; pitch = 1024; ct = gt - 4;  mode = 0; }
        else if (gt < 12) { base_off = WS_GR; pitch = 1024; ct = gt - 8;  mode = 2; }
        else if (gt < 14) { base_off = WS_QA; pitch = 512;  ct = gt - 12; mode = 0; sc = 0.18033688011112042f; }
        else if (gt < 16) { base_off = WS_KA; pitch = 512;  ct = gt - 14; mode = 0; }
        else if (gt < 18) { base_off = WS_VA; pitch = 512;  ct = gt - 16; mode = 0; }
        else if (gt < 22) { base_off = WS_GATE_R; pitch = 1024; ct = gt - 18; mode = 3; }
        else              { base_off = WS_GATE_A; pitch = 1024; ct = gt - 22; mode = 3; }
        bf16_t* O = (bf16_t*)(ws + base_off);
        const int row0 = u.pm * BM + wr * 64 + fr, col0 = ct * BM + wc * 32 + 8 * fq;
#pragma unroll
        for (int ai = 0; ai < 2; ++ai)
#pragma unroll
            for (int m = 0; m < 4; ++m) {
                const int row = row0 + ai * HALF + m * 16;
                bf16_t* rowp = O + (size_t)row * pitch + col0;
                f32x4 cs = (f32x4){1.f, 1.f, 1.f, 1.f}, sn = (f32x4){0.f, 0.f, 0.f, 0.f};
                if (mode == 1) { const f32x4* rt = (const f32x4*)(rot + ((size_t)(row & (SEQ - 1)) * 16 + (4 * wc + fq)) * 8); cs = rt[0]; sn = rt[1]; }
#pragma unroll
                for (int bj = 0; bj < 2; ++bj) {
                    f32x4 v0 = acc[ai][bj][m][0], v1 = acc[ai][bj][m][1];
                    if (mode == 1) { const f32x4 a = v0 * cs - v1 * sn, b = v0 * sn + v1 * cs; v0 = a * sc; v1 = b * sc; }
                    else if (mode == 2) {
#pragma unroll
                        for (int e = 0; e < 4; ++e) { v0[e] = fsilu(v0[e]); v1[e] = fsilu(v1[e]); } }
                    else if (mode == 3) {
#pragma unroll
                        for (int e = 0; e < 4; ++e) { v0[e] = fsigmoid(v0[e]); v1[e] = fsigmoid(v1[e]); } }
                    else { v0 = v0 * sc; v1 = v1 * sc; }
                    u32x4 w; w.x = cvt_pk_bf16(v0[0], v0[1]); w.y = cvt_pk_bf16(v0[2], v0[3]); w.z = cvt_pk_bf16(v1[0], v1[1]); w.w = cvt_pk_bf16(v1[2], v1[3]);
                    *(u32x4*)(rowp + bj * HALF) = w;
                }
            }
    }
};

typedef EpiHcatT<0> EpiHcat;

template <bool ADD> struct EpiGate {
    static constexpr bool PERM = true, AFTER_DRAIN = false; static constexpr int NSTORE = 16;
    const bf16_t* gate; bf16_t* O;
    __device__ __forceinline__ void operator()(const f32x4 (&acc)[2][2][4][2], const Unit& u, int wr, int wc, int fr, int fq) const {
        const int row0 = u.pm * BM + wr * 64 + fr, col0 = u.pn * BM + wc * 32 + 8 * fq;
#pragma unroll
        for (int ai = 0; ai < 2; ++ai)
#pragma unroll
            for (int m = 0; m < 4; ++m)
#pragma unroll
                for (int bj = 0; bj < 2; ++bj) {
                    const size_t p = (size_t)(row0 + ai * HALF + m * 16) * 1024 + col0 + bj * HALF;
                    const u32x4 g = *(const u32x4*)(gate + p);
                    f32x4 v0 = acc[ai][bj][m][0], v1 = acc[ai][bj][m][1];
                    v0[0] *= bflo(g.x); v0[1] *= bfhi(g.x); v0[2] *= bflo(g.y); v0[3] *= bfhi(g.y);
                    v1[0] *= bflo(g.z); v1[1] *= bfhi(g.z); v1[2] *= bflo(g.w); v1[3] *= bfhi(g.w);
                    if (ADD) { const u32x4 o = *(const u32x4*)(O + p);
                        v0[0] += bflo(o.x); v0[1] += bfhi(o.x); v0[2] += bflo(o.y); v0[3] += bfhi(o.y);
                        v1[0] += bflo(o.z); v1[1] += bfhi(o.z); v1[2] += bflo(o.w); v1[3] += bfhi(o.w); }
                    u32x4 w; w.x = cvt_pk_bf16(v0[0], v0[1]); w.y = cvt_pk_bf16(v0[2], v0[3]); w.z = cvt_pk_bf16(v1[0], v1[1]); w.w = cvt_pk_bf16(v1[2], v1[3]);
                    *(u32x4*)(O + p) = w;
                }
    }
};

struct EpiResBf16 {
    static constexpr bool PERM = true, AFTER_DRAIN = false; static constexpr int NSTORE = 16;
    const bf16_t* x; bf16_t* out; float alpha;
    __device__ __forceinline__ void operator()(const f32x4 (&acc)[2][2][4][2], const Unit& u, int wr, int wc, int fr, int fq) const {
        const int row0 = u.pm * BM + wr * 64 + fr, col0 = u.pn * BM + wc * 32 + 8 * fq;
#pragma unroll
        for (int ai = 0; ai < 2; ++ai)
#pragma unroll
            for (int m = 0; m < 4; ++m)
#pragma unroll
                for (int bj = 0; bj < 2; ++bj) {
                    const size_t p = (size_t)(row0 + ai * HALF + m * 16) * 1024 + col0 + bj * HALF;
                    const u32x4 xw = *(const u32x4*)(x + p);
                    const f32x4 x0 = (f32x4){bflo(xw.x), bfhi(xw.x), bflo(xw.y), bfhi(xw.y)}, x1 = (f32x4){bflo(xw.z), bfhi(xw.z), bflo(xw.w), bfhi(xw.w)};
                    const f32x4 v0 = x0 * alpha + acc[ai][bj][m][0], v1 = x1 * alpha + acc[ai][bj][m][1];
                    u32x4 w; w.x = cvt_pk_bf16(v0[0], v0[1]); w.y = cvt_pk_bf16(v0[2], v0[3]); w.z = cvt_pk_bf16(v1[0], v1[1]); w.w = cvt_pk_bf16(v1[2], v1[3]);
                    *(u32x4*)(out + p) = w;
                }
    }
};

struct EpiSwiGLU {
    static constexpr bool PERM = true, AFTER_DRAIN = false; static constexpr int NSTORE = 16;
    unsigned char* H;
    __device__ __forceinline__ void operator()(const f32x4 (&acc)[2][2][4][2], const Unit& u, int wr, int wc, int fr, int fq) const {
        const int row0 = u.pm * BM + wr * 64 + fr, col0 = (u.pn & 3) * 128 + wc * 16 + 4 * fq;
#pragma unroll
        for (int ai = 0; ai < 2; ++ai)
#pragma unroll
            for (int m = 0; m < 4; ++m)
#pragma unroll
                for (int bj = 0; bj < 2; ++bj) {
                    const f32x4 g = acc[ai][bj][m][0], up = acc[ai][bj][m][1];
                    float h0 = fsilu(g[0]) * up[0] * 8.f, h1 = fsilu(g[1]) * up[1] * 8.f, h2 = fsilu(g[2]) * up[2] * 8.f, h3 = fsilu(g[3]) * up[3] * 8.f;
                    h0 = fminf(fmaxf(h0, -448.f), 448.f); h1 = fminf(fmaxf(h1, -448.f), 448.f); h2 = fminf(fmaxf(h2, -448.f), 448.f); h3 = fminf(fmaxf(h3, -448.f), 448.f);
                    unsigned w = 0u; w = __builtin_amdgcn_cvt_pk_fp8_f32(h0, h1, w, false); w = __builtin_amdgcn_cvt_pk_fp8_f32(h2, h3, w, true);
                    *(unsigned*)(H + (size_t)(row0 + ai * HALF + m * 16) * 512 + col0 + bj * 64) = w;
                }
    }
};

struct EpiRowScale {
    static constexpr bool PERM = true, AFTER_DRAIN = false; static constexpr int NSTORE = 16;
    bf16_t* Y;
    __device__ __forceinline__ void operator()(const f32x4 (&acc)[2][2][4][2], const Unit& u, int wr, int wc, int fr, int fq) const {
        const int row0 = u.pm * BM + wr * 64 + fr, col0 = (u.pn & 3) * BM + wc * 32 + 8 * fq;
#pragma unroll
        for (int ai = 0; ai < 2; ++ai)
#pragma unroll
            for (int m = 0; m < 4; ++m) {
                const int row = row0 + ai * HALF + m * 16;
#pragma unroll
                for (int bj = 0; bj < 2; ++bj) {
                    const f32x4 v0 = acc[ai][bj][m][0], v1 = acc[ai][bj][m][1];
                    u32x4 w; w.x = cvt_pk_bf16_acc(v0[0], v0[1]); w.y = cvt_pk_bf16_acc(v0[2], v0[3]); w.z = cvt_pk_bf16_acc(v1[0], v1[1]); w.w = cvt_pk_bf16_acc(v1[2], v1[3]);
                    *(u32x4*)(Y + (size_t)row * 1024 + col0 + bj * HALF) = w;
                }
            }
    }
};

struct MoeOrder {
    int nunits, G, c; const PG8_LAS int* te; const PG8_LAS int* ts; const PG8_LAS int* cnt; const int* ltok; unsigned rowbytes;
    __device__ __forceinline__ bool next(int i, Unit& u) const {
        const int L = i * G + c, rt = (L >> 5) * 8 + (L & 7); if (rt >= (nunits >> 2)) return false;
        u.pm = rt; u.pn = te[rt] * 4 + ((L >> 3) & 3); return true;
    }
    __device__ __forceinline__ unsigned a_row_off(const Unit& u, int row) const {
        const int ex = te[u.pm], pos = (u.pm - ts[ex]) * 256 + row;
        const int tok = pos < cnt[ex] ? ltok[ex * 32768 + pos] : 0;
        return (unsigned)tok * rowbytes;
    }
    __device__ __forceinline__ void a_ready(const Unit&) const {}
    __device__ __forceinline__ void done(const Unit&) const {}
};

struct GateOrder {
    StaticOrder S4;
    __device__ __forceinline__ bool next(int i, Unit& u) const { Unit t; if (!S4.next(i >> 1, t)) return false; u.pm = t.pm; u.pn = t.pn + 4 * (i & 1); return true; }
    __device__ __forceinline__ void a_ready(const Unit&) const {}
    __device__ __forceinline__ void done(const Unit&) const {}
};

template <class Epi, class Sched, bool ALIGN_EPI = false, bool SP2 = false, bool GATHER = false, bool FP8 = false, int SCALE_W = 0x7f7f7f7f, int SCALE_X = 0x7f7f7f7f>
__device__ __forceinline__ void gemm_phase(PG8_LAS unsigned char* lds, const Gemm g, const Sched& S, const Epi& E) {
    int tid = threadIdx.x; asm volatile("" : "+v"(tid));
    const int wid = __builtin_amdgcn_readfirstlane(tid >> 6), lane = tid & 63, wr = wid >> 2, wc = wid & 3, fr = lane & 15, fq = lane >> 4;
    static_assert(SP2, "only the two-super-phase loop is kept");
    typedef int i32x4_ __attribute__((ext_vector_type(4)));
    const int K = g.K, nt = K / BK;
    unsigned voffB[2]; int rA[2], cA2[2];
#pragma unroll
    for (int i = 0; i < 2; ++i) { int R, C; stage_rc(tid * 16 + i * 8192, R, C); const int Rb = Epi::PERM ? ((R & ~31) + perm32(R & 31)) : R;
        rA[i] = R; cA2[i] = C * 2; voffB[i] = (unsigned)(Rb * K + C) * 2u; }
    unsigned vAc[2][2], vAn[2][2];
    const size_t kstep = (size_t)(BK * 2);
    const size_t hstep = (size_t)HALF * K * 2;
    const size_t tstep = 2 * hstep;
    const unsigned ldsw = (unsigned)wid * 1024u;
    const int aoff0 = lds_byte(wr * 64 + fr, fq * 8), aoff1 = aoff0 + 1024;
    const int boff0 = lds_byte(wc * 32 + fr, fq * 8), boff1 = boff0 + 1024;
#define PG8_SA(b, h) (((b) * 2 + (h)) * HTB)
#define PG8_SB(b, h) ((4 + (b) * 2 + (h)) * HTB)
#define PG8_STAGE(bufoff, gbase, voff) do { _Pragma("unroll") for (int _i = 0; _i < 2; ++_i) \
        __builtin_amdgcn_global_load_lds((const unsigned*)((const char*)(gbase) + (voff)[_i]), (PG8_LAS unsigned*)(lds + (bufoff) + ldsw + _i * 8192), 16, 0, 0); } while (0)
#define PG8_LDA(dst, b, h) do { _Pragma("unroll") for (int m = 0; m < 4; ++m) { dst[m][0] = *(const PG8_LAS bf16x8*)(lds + PG8_SA(b, h) + aoff0 + m * 2048); dst[m][1] = *(const PG8_LAS bf16x8*)(lds + PG8_SA(b, h) + aoff1 + m * 2048); } } while (0)
#define PG8_LDB(dst, b, h) do { _Pragma("unroll") for (int n = 0; n < 2; ++n) { dst[n][0] = *(const PG8_LAS bf16x8*)(lds + PG8_SB(b, h) + boff0 + n * 2048); dst[n][1] = *(const PG8_LAS bf16x8*)(lds + PG8_SB(b, h) + boff1 + n * 2048); } } while (0)
#define PG8_CAT8(x) __builtin_shufflevector(__builtin_bit_cast(i32x4_, (x)[0]), __builtin_bit_cast(i32x4_, (x)[1]), 0, 1, 2, 3, 4, 5, 6, 7)
#define PG8_MMA(ai, bj, At, Bt) do { __builtin_amdgcn_s_setprio(1); \
        if constexpr (FP8) { _Pragma("unroll") for (int m = 0; m < 4; ++m) _Pragma("unroll") for (int n = 0; n < 2; ++n) \
            acc[ai][bj][m][n] = __builtin_amdgcn_mfma_scale_f32_16x16x128_f8f6f4(PG8_CAT8(Bt[n]), PG8_CAT8(At[m]), acc[ai][bj][m][n], 0, 0, 0, SCALE_W, 0, SCALE_X); } \
        else { _Pragma("unroll") for (int m = 0; m < 4; ++m) _Pragma("unroll") for (int n = 0; n < 2; ++n) _Pragma("unroll") for (int k = 0; k < 2; ++k) \
            acc[ai][bj][m][n] = __builtin_amdgcn_mfma_f32_16x16x32_bf16(Bt[n][k], At[m][k], acc[ai][bj][m][n], 0, 0, 0); } \
        __builtin_amdgcn_s_setprio(0); } while (0)
#define PG8_WAIT_V(n) asm volatile("s_waitcnt vmcnt(" #n ")" ::: "memory")
#define PG8_WAIT_VN(n) asm volatile("s_waitcnt vmcnt(%0)" :: "i"(n) : "memory")
#define PG8_WAIT_L(n) asm volatile("s_waitcnt lgkmcnt(" #n ")" ::: "memory")
#define PG8_BAR __builtin_amdgcn_s_barrier()
#define PG8_SCHED __builtin_amdgcn_sched_barrier(0)
    Unit cur, nxt; int ui = 0;
    if (!S.next(0, cur)) return;
    f32x4 acc[2][2][4][2];
#pragma unroll
    for (int a = 0; a < 2; ++a)
#pragma unroll
        for (int b = 0; b < 2; ++b)
#pragma unroll
            for (int m = 0; m < 4; ++m)
#pragma unroll
                for (int n = 0; n < 2; ++n) acc[a][b][m][n] = (f32x4){0.f, 0.f, 0.f, 0.f};
    bf16x8 At[4][2], B0[2][2], B1[2][2];
    const char* cA = GATHER ? (const char*)g.A : (const char*)g.A + (size_t)cur.pm * tstep; const char* cB = (const char*)g.Bt + (size_t)cur.pn * tstep;
#pragma unroll
    for (int h = 0; h < 2; ++h)
#pragma unroll
        for (int i = 0; i < 2; ++i) { if constexpr (GATHER) vAc[h][i] = S.a_row_off(cur, h * HALF + rA[i]) + (unsigned)cA2[i]; else vAc[h][i] = (unsigned)((h * HALF + rA[i]) * K) * 2u + (unsigned)cA2[i]; vAn[h][i] = vAc[h][i]; }
    S.a_ready(cur);
    if constexpr (SP2) {
        PG8_STAGE(PG8_SB(0, 0), cB, voffB); PG8_STAGE(PG8_SB(0, 1), cB + hstep, voffB); PG8_STAGE(PG8_SA(0, 0), cA, vAc[0]); PG8_STAGE(PG8_SA(0, 1), cA, vAc[1]);
        if (wr == 1) PG8_BAR;
        PG8_WAIT_V(2); PG8_BAR;
        PG8_STAGE(PG8_SB(1, 0), cB + kstep, voffB); PG8_STAGE(PG8_SA(1, 0), cA + kstep, vAc[0]); PG8_STAGE(PG8_SB(1, 1), cB + hstep + kstep, voffB);
        PG8_WAIT_V(6); PG8_BAR;
    }
    for (;;) {
        const bool has_next = S.next(ui + 1, nxt);
        const char* nA = GATHER ? cA : (has_next ? (const char*)g.A + (size_t)nxt.pm * tstep : cA); const char* nB = has_next ? (const char*)g.Bt + (size_t)nxt.pn * tstep : cB;
        if constexpr (GATHER) { if (has_next) {
#pragma unroll
            for (int h = 0; h < 2; ++h)
#pragma unroll
                for (int i = 0; i < 2; ++i) vAn[h][i] = S.a_row_off(nxt, h * HALF + rA[i]) + (unsigned)cA2[i]; } }
#pragma unroll 1
        for (int t = 0; t < nt; t += 2) {
            const bool last = (t == nt - 2);
            const char* a1 = cA + (size_t)(t + 1) * kstep;
            const char* a2 = last ? nA : cA + (size_t)(t + 2) * kstep; const char* b2 = last ? nB : cB + (size_t)(t + 2) * kstep;
            const char* a3 = a2 + kstep; const char* b3 = b2 + kstep;
            unsigned vA2[2][2];
#pragma unroll
            for (int h = 0; h < 2; ++h)
#pragma unroll
                for (int i = 0; i < 2; ++i) vA2[h][i] = vAc[h][i];
            if constexpr (GATHER) { if (last) {
                asm volatile("" : "+v"(vAn[0][0]), "+v"(vAn[0][1]), "+v"(vAn[1][0]), "+v"(vAn[1][1]));
#pragma unroll
                for (int h = 0; h < 2; ++h)
#pragma unroll
                    for (int i = 0; i < 2; ++i) vA2[h][i] = vAn[h][i]; } }
            if (last && has_next) S.a_ready(nxt);
            if constexpr (SP2) {
            const int lenient = __builtin_amdgcn_readfirstlane((ui > 0 && t == 0) ? 1 : 0);
#define PG8_WAIT_V8L() asm volatile("s_cmp_eq_u32 %0, 0\n\ts_cbranch_scc0 .Lpg8skip%=\n\ts_waitcnt vmcnt(8)\n.Lpg8skip%=:\n\ts_waitcnt vmcnt(%1)" :: "s"(lenient), "i"(8 + Epi::NSTORE) : "memory", "scc")
            PG8_LDB(B0, 0, 0); PG8_LDB(B1, 0, 1); PG8_SCHED; PG8_LDA(At, 0, 0); PG8_STAGE(PG8_SA(1, 1), a1, vAc[1]);
            PG8_WAIT_V8L(); PG8_WAIT_L(0); PG8_BAR; PG8_MMA(0, 0, At, B0); PG8_MMA(0, 1, At, B1); PG8_BAR; PG8_SCHED;
            PG8_LDA(At, 0, 1); PG8_STAGE(PG8_SB(0, 0), b2, voffB); PG8_STAGE(PG8_SB(0, 1), b2 + hstep, voffB); PG8_STAGE(PG8_SA(0, 0), a2, vA2[0]);
            PG8_WAIT_V8L(); PG8_WAIT_L(0); PG8_BAR; PG8_MMA(1, 0, At, B0); PG8_MMA(1, 1, At, B1); PG8_BAR; PG8_SCHED;
            PG8_LDB(B0, 1, 0); PG8_LDB(B1, 1, 1); PG8_SCHED; PG8_LDA(At, 1, 0); PG8_STAGE(PG8_SA(0, 1), a2, vA2[1]);
            PG8_WAIT_V(8); PG8_WAIT_L(0); PG8_BAR; PG8_MMA(0, 0, At, B0); PG8_MMA(0, 1, At, B1); PG8_BAR; PG8_SCHED;
            PG8_LDA(At, 1, 1); PG8_STAGE(PG8_SB(1, 0), b3, voffB); PG8_STAGE(PG8_SB(1, 1), b3 + hstep, voffB); PG8_STAGE(PG8_SA(1, 0), a3, vA2[0]);
            PG8_WAIT_V(8); PG8_WAIT_L(0); PG8_BAR; PG8_MMA(1, 0, At, B0); PG8_MMA(1, 1, At, B1); PG8_BAR; PG8_SCHED;
#undef PG8_WAIT_V8L
            }
        }
        if constexpr (ALIGN_EPI) { if (wr == 0) PG8_BAR; }
        if constexpr (!Epi::AFTER_DRAIN) { E(acc, cur, wr, wc, fr, fq); S.done(cur); }
        if (!has_next) break;
#pragma unroll
        for (int a = 0; a < 2; ++a)
#pragma unroll
            for (int b = 0; b < 2; ++b)
#pragma unroll
                for (int m = 0; m < 4; ++m)
#pragma unroll
                    for (int n = 0; n < 2; ++n) acc[a][b][m][n] = (f32x4){0.f, 0.f, 0.f, 0.f};
        cur = nxt; cA = nA; cB = nB; ++ui;
        if constexpr (GATHER) {
#pragma unroll
            for (int h = 0; h < 2; ++h)
#pragma unroll
                for (int i = 0; i < 2; ++i) vAc[h][i] = vAn[h][i]; }
        if constexpr (ALIGN_EPI) { if (wr == 1) PG8_BAR; }
    }
    PG8_WAIT_V(0);
    if constexpr (!ALIGN_EPI) { if (wr == 0) PG8_BAR; }
    PG8_BAR;
    if constexpr (Epi::AFTER_DRAIN) { E.fused(acc, cur, wr, wc, fr, fq, lds, wid, lane); S.done(cur); }
#undef PG8_SA
#undef PG8_SB
#undef PG8_STAGE
#undef PG8_LDA
#undef PG8_LDB
#undef PG8_MMA
#undef PG8_CAT8
#undef PG8_WAIT_V
#undef PG8_WAIT_VN
#undef PG8_WAIT_L
#undef PG8_BAR
#undef PG8_SCHED
}
}
#define GAS __attribute__((address_space(1)))
#define LAS __attribute__((address_space(3)))
typedef unsigned short bf16;
typedef unsigned v4u __attribute__((ext_vector_type(4)));
typedef float f32x4 __attribute__((ext_vector_type(4)));
typedef short bf16x8 __attribute__((ext_vector_type(8)));
typedef GAS unsigned gu32;
typedef GAS unsigned long long gu64;
#define RLX_AGENT __ATOMIC_RELAXED, __HIP_MEMORY_SCOPE_AGENT
#define LDS_WAIT() asm volatile("s_waitcnt lgkmcnt(0)" ::: "memory")
#define VM_WAIT() asm volatile("s_waitcnt vmcnt(0)" ::: "memory")
__device__ __forceinline__ unsigned long long rt() { return __builtin_amdgcn_s_memrealtime(); }
__device__ __forceinline__ unsigned f2bf(float f) { unsigned u = __builtin_bit_cast(unsigned, f); return (u + 0x7fffu + ((u >> 16) & 1u)) >> 16; }
__device__ __forceinline__ unsigned pk2(float lo, float hi) { return f2bf(lo) | (f2bf(hi) << 16); }

#define XB_TMO      128
#define XB_XCNT(j)  (256  + 64 * (j))
#define XB_XSUB(j)  (1280 + 64 * (j))
#define XB_XGEN(j)  (2304 + 64 * (j))
#define XB_TOP      3328
#define XB_TOPGEN   3392
#define XCD_BAR_WORDS 3456
#define XB_SPIN_CAP (1u << 18)

__device__ __forceinline__ unsigned xb_ld(unsigned* p)              { return __hip_atomic_load(p, __ATOMIC_RELAXED, __HIP_MEMORY_SCOPE_AGENT); }
__device__ __forceinline__ unsigned xb_add(unsigned* p, unsigned v) { return __hip_atomic_fetch_add(p, v, __ATOMIC_RELAXED, __HIP_MEMORY_SCOPE_AGENT); }
__device__ __forceinline__ unsigned xb_xcc_id() { return (unsigned)__builtin_amdgcn_s_getreg((3 << 11) | 20) & 0xFu; }
#define XB_SPIN(cond, bar) do { unsigned _sp = 0; while (cond) { __builtin_amdgcn_s_sleep(1); \
    if ((++_sp & 255u) == 0u) { if (xb_ld(&(bar)[XB_TMO])) break; if (_sp > XB_SPIN_CAP) { atomicAdd(&(bar)[XB_TMO], 1u); break; } } } } while (0)

struct XcdBarrier {
    unsigned* bar; unsigned x;
    volatile LAS unsigned* st;
};

__device__ __forceinline__ XcdBarrier xcd_barrier_post(unsigned* bar, volatile LAS unsigned* st) {
    XcdBarrier b; b.bar = bar; b.x = xb_xcc_id(); b.st = st;
    if (threadIdx.x == 0) (void)xb_add(&bar[XB_XCNT(b.x)], 1u);
    return b;
}
__device__ __forceinline__ void xcd_barrier_complete(unsigned* bar, unsigned x, unsigned& nloc, unsigned& nx) {
    const unsigned G = gridDim.x * gridDim.y * gridDim.z;
    unsigned sum, cnt, mine, sp = 0u;
    for (;;) {
        sum = 0u; cnt = 0u; mine = 0u;
#pragma unroll
        for (unsigned j = 0; j < 16; ++j) { const unsigned c = xb_ld(&bar[XB_XCNT(j)]); sum += c; cnt += (c > 0u) ? 1u : 0u; mine = (j == x) ? c : mine; }
        if (sum == G) break;
        __builtin_amdgcn_s_sleep(1);
        if ((++sp & 255u) == 0u) { if (xb_ld(&bar[XB_TMO])) break; if (sp > XB_SPIN_CAP) { atomicAdd(&bar[XB_TMO], 1u); break; } }
    }
    nloc = mine > 0u ? mine : 1u; nx = cnt > 0u ? cnt : 1u;
}

__device__ __forceinline__ void xcd_barrier(const XcdBarrier& b) {
    asm volatile("s_waitcnt vmcnt(0)" ::: "memory");
    __syncthreads();
    if (threadIdx.x == 0) {
        unsigned* bar = b.bar;
        __builtin_amdgcn_s_waitcnt(0);
        unsigned nloc = b.st[0], nx = b.st[1];
        if (nloc == 0u) { xcd_barrier_complete(bar, b.x, nloc, nx); b.st[0] = nloc; b.st[1] = nx; }
        const unsigned old = xb_add(&bar[XB_XSUB(b.x)], 1u);
        const unsigned gen = old / nloc;
        if (old + 1u == (gen + 1u) * nloc) {
            __builtin_amdgcn_fence(__ATOMIC_RELEASE, "agent");
            asm volatile("s_waitcnt vmcnt(0)" ::: "memory");
            const unsigned og = xb_add(&bar[XB_TOP], 1u);
            const unsigned tg = og / nx;
            if (og + 1u == (tg + 1u) * nx) xb_add(&bar[XB_TOPGEN], 1u);
            else XB_SPIN(xb_ld(&bar[XB_TOPGEN]) == tg, bar);
            __builtin_amdgcn_fence(__ATOMIC_ACQUIRE, "agent");
            xb_add(&bar[XB_XGEN(b.x)], 1u);
            asm volatile("s_waitcnt vmcnt(0)" ::: "memory");
        } else {
            XB_SPIN(xb_ld(&bar[XB_XGEN(b.x)]) == gen, bar);
            __builtin_amdgcn_fence(__ATOMIC_ACQUIRE, "agent");
            asm volatile("s_waitcnt vmcnt(0)" ::: "memory");
        }
    }
    __syncthreads();
}


constexpr int NWAVES = 8;
constexpr int RING_BYTES = 131072;
constexpr int LDSCTL_OFF = RING_BYTES, MISC_OFF = LDSCTL_OFF + 320;
constexpr int LDS_TS_OFF = LDSCTL_OFF + 1024;
constexpr int LDS_TE_OFF = LDSCTL_OFF + 2048;
constexpr int LDS_CNT_OFF = LDSCTL_OFF + 1024 + 128;
constexpr int LDS_BYTES = 163840;

typedef short s16x4 __attribute__((ext_vector_type(4)));
typedef unsigned u32x2 __attribute__((ext_vector_type(2)));

struct Args { const float* in[20]; float* out; unsigned char* ws; unsigned mask; int bar_region; };

__device__ __forceinline__ float bflo(unsigned w) { return __uint_as_float(w << 16); }
__device__ __forceinline__ float bfhi(unsigned w) { return __uint_as_float(w & 0xffff0000u); }
__device__ __forceinline__ unsigned cvtpk(float lo, float hi) { return pg8::cvt_pk_bf16(lo, hi); }
__device__ __forceinline__ float wave_sum(float v) {
#pragma unroll
    for (int o = 1; o < 64; o <<= 1) v += __shfl_xor(v, o);
    return v;
}
__device__ __forceinline__ unsigned offb(unsigned row, unsigned ch) { return 256u * row + 16u * (ch ^ (((row & 3u) << 2) | ((row >> 2) & 3u))); }
__device__ __forceinline__ s16x4 ldtr(const LAS unsigned char* p) { return __builtin_amdgcn_ds_read_tr16_b64_v4i16((LAS s16x4*)p); }
__device__ __forceinline__ bf16x8 cat8(s16x4 a, s16x4 b) { return (bf16x8){a[0], a[1], a[2], a[3], b[0], b[1], b[2], b[3]}; }
#define MFMA16(a, b, c) __builtin_amdgcn_mfma_f32_16x16x32_bf16((a), (b), (c), 0, 0, 0)

template <int MODE> __device__ __forceinline__ int dest_row(int n) {
    if (MODE == 1) { if (n >= 1024) return n; const int hb = n & ~127, d = n & 127, jr = d & 63, half = d >> 6; return hb + 8 * (jr >> 2) + 4 * half + (jr & 3); }
    if (MODE == 2) return ((n >> 2) << 3) + (n & 3);
    if (MODE == 3) return ((n >> 2) << 3) + 4 + (n & 3);
    return n;
}
template <int MODE> __device__ __forceinline__ void p0_transpose_item(const float* W, int K, int N, bf16* WT, LAS float* scr, int item, int lane) {
    const int nblk = N / 32, kb = item / nblk, nb = item % nblk, k0 = 64 * kb, n0 = 32 * nb;
    {
        const GAS f32x4* src = (const GAS f32x4*)(W + (size_t)(k0 + (lane >> 3)) * N + n0) + (lane & 7);
        f32x4 t[8];
#pragma unroll
        for (int j = 0; j < 8; ++j) t[j] = src[(size_t)j * 2 * N];
#pragma unroll
        for (int j = 0; j < 8; ++j) { LAS float* d = scr + ((lane >> 3) + 8 * j) * 33 + 4 * (lane & 7); d[0] = t[j].x; d[1] = t[j].y; d[2] = t[j].z; d[3] = t[j].w; }
    }
    LDS_WAIT(); asm volatile("" ::: "memory");
    const int c = lane & 7;
#pragma unroll
    for (int j = 0; j < 4; ++j) { const int n = (lane >> 3) + 8 * j; const LAS float* s = scr + (8 * c) * 33 + n;
        v4u o; o.x = pk2(s[0 * 33], s[1 * 33]); o.y = pk2(s[2 * 33], s[3 * 33]); o.z = pk2(s[4 * 33], s[5 * 33]); o.w = pk2(s[6 * 33], s[7 * 33]);
        *(GAS v4u*)(WT + (size_t)dest_row<MODE>(n0 + n) * K + k0 + 8 * c) = o; }
    LDS_WAIT(); asm volatile("" ::: "memory");
}
__device__ __forceinline__ unsigned pk_fp8x4(float a, float b, float c, float d) {
    a = fminf(fmaxf(a, -448.f), 448.f); b = fminf(fmaxf(b, -448.f), 448.f); c = fminf(fmaxf(c, -448.f), 448.f); d = fminf(fmaxf(d, -448.f), 448.f);
    unsigned w = 0u; w = __builtin_amdgcn_cvt_pk_fp8_f32(a, b, w, false); w = __builtin_amdgcn_cvt_pk_fp8_f32(c, d, w, true); return w;
}
template <int MODE> __device__ __forceinline__ void p0_transpose_item_fp8(const float* W, int K, int N, unsigned char* WT, LAS float* scr, int item, int lane, float scale) {
    const int nblk = N / 32, kb = item / nblk, nb = item % nblk, k0 = 64 * kb, n0 = 32 * nb;
    {
        const GAS f32x4* src = (const GAS f32x4*)(W + (size_t)(k0 + (lane >> 3)) * N + n0) + (lane & 7);
        f32x4 t[8];
#pragma unroll
        for (int j = 0; j < 8; ++j) t[j] = src[(size_t)j * 2 * N];
#pragma unroll
        for (int j = 0; j < 8; ++j) { LAS float* d = scr + ((lane >> 3) + 8 * j) * 33 + 4 * (lane & 7); d[0] = t[j].x; d[1] = t[j].y; d[2] = t[j].z; d[3] = t[j].w; }
    }
    LDS_WAIT(); asm volatile("" ::: "memory");
    const int c = lane & 7;
#pragma unroll
    for (int j = 0; j < 4; ++j) { const int n = (lane >> 3) + 8 * j; const LAS float* s = scr + (8 * c) * 33 + n;
        u32x2 o; o.x = pk_fp8x4(s[0 * 33] * scale, s[1 * 33] * scale, s[2 * 33] * scale, s[3 * 33] * scale); o.y = pk_fp8x4(s[4 * 33] * scale, s[5 * 33] * scale, s[6 * 33] * scale, s[7 * 33] * scale);
        *(GAS u32x2*)(WT + (size_t)dest_row<MODE>(n0 + n) * K + k0 + 8 * c) = o; }
    LDS_WAIT(); asm volatile("" ::: "memory");
}
__device__ __forceinline__ int t5_bucket(int rel) {
    const int n = rel < 0 ? -rel : rel;
    int large = 8 + (n >= 15) + (n >= 27) + (n >= 50) + (n >= 91) + (n >= 166) + (n >= 305) + (n >= 559);
    large = large < 15 ? large : 15;
    return (rel > 0 ? 16 : 0) + (n < 8 ? n : large);
}
__device__ __forceinline__ void p0_prologue(const Args& a, LAS unsigned char* lds, int vcu, int G, int tid, int wave, int lane) {
    unsigned char* ws = a.ws;
    LAS float* scr = (LAS float*)(lds + wave * 16384);
    const int gw = vcu * NWAVES + wave, NGW = G * NWAVES;
    constexpr int I_IN = 16 * 208, I_R = 16 * 32, I_A = 8 * 32, I_O = 16 * 32;
    constexpr int NITEMS = I_IN + I_R + I_A + I_O;
    for (int it = gw; it < NITEMS; it += NGW) {
        int r = it;
        if (r < I_IN) { p0_transpose_item<1>(a.in[1], 1024, 6656, (bf16*)(ws + WS_WIN), scr, r, lane); continue; } r -= I_IN;
        if (r < I_R) { p0_transpose_item<0>(a.in[5], 1024, 1024, (bf16*)(ws + WS_WR), scr, r, lane); continue; } r -= I_R;
        if (r < I_A) { p0_transpose_item<0>(a.in[7], 512, 1024, (bf16*)(ws + WS_WA), scr, r, lane); continue; } r -= I_A;
        p0_transpose_item<0>(a.in[8], 1024, 1024, (bf16*)(ws + WS_WO), scr, r, lane);
    }
    {
        const f32x4* x4 = (const f32x4*)a.in[0]; u32x2* xb = (u32x2*)(ws + WS_XB);
        for (size_t i = (size_t)vcu * 512 + tid; i < (size_t)TT * DM / 4; i += (size_t)G * 512) { const f32x4 v = x4[i]; u32x2 o; o.x = cvtpk(v.x, v.y); o.y = cvtpk(v.z, v.w); xb[i] = o; }
    }
    {
        float* rot = (float*)(ws + WS_ROT);
        for (int idx = vcu * 512 + tid; idx < SEQ * 64; idx += G * 512) {
            const int pos = idx >> 6, jr = idx & 63;
            double iv = 1.0; for (int k = 0; k < jr; ++k) iv *= 0.86596432336006535;
            const float ang = (float)pos * (float)iv;
            const double xx = (double)ang; const double qd = __builtin_rint(xx * 0.63661977236758134); const int qi = (int)qd;
            const double r = (xx - qd * 1.5707963267948966) - qd * 6.123233995736766e-17, r2 = r * r;
            const double sp = r * (1.0 + r2 * (-1.0 / 6 + r2 * (1.0 / 120 + r2 * (-1.0 / 5040 + r2 * (1.0 / 362880 + r2 * (-1.0 / 39916800 + r2 * (1.0 / 6227020800.0)))))));
            const double cp = 1.0 + r2 * (-0.5 + r2 * (1.0 / 24 + r2 * (-1.0 / 720 + r2 * (1.0 / 40320 + r2 * (-1.0 / 3628800 + r2 * (1.0 / 479001600.0))))));
            const int qq = qi & 3; const double s = qq == 0 ? sp : (qq == 1 ? cp : (qq == 2 ? -sp : -cp)), c = qq == 0 ? cp : (qq == 1 ? -sp : (qq == 2 ? -cp : sp));
            float* o = rot + ((size_t)pos * 16 + (jr >> 2)) * 8 + (jr & 3); o[0] = (float)c; o[4] = (float)s;
        }
    }
    if (vcu == 0) {
        float* bt = (float*)(ws + WS_BIAS); const float* rb = a.in[6];
        for (int idx = tid; idx < 3 * 8 * 160; idx += 512) { const int p = idx / (8 * 160), h = (idx / 160) % 8, d = idx % 160 - 80; const int dil = p == 0 ? 1 : (p == 1 ? 4 : 16);
            bt[idx] = (d >= -64 && d <= 64) ? rb[t5_bucket(d * dil) * 8 + h] * 1.4426950408889634f : -1e30f; }
    }
}
__device__ __forceinline__ void p0_expert_weights(const Args& a, LAS unsigned char* lds, int vcu, int G, int wave, int lane) {
    unsigned char* ws = a.ws;
    LAS float* scr = (LAS float*)(lds + wave * 16384);
    const int gw = vcu * NWAVES + wave, NGW = G * NWAVES;
    constexpr int I_G = 16 * 16, I_D = 8 * 32, PER_E = 2 * I_G + I_D;
    for (int it = gw; it < 16 * PER_E; it += NGW) {
        const int e = it / PER_E; int r = it - e * PER_E;
#if M1_FP8
        if (r < I_G) { p0_transpose_item_fp8<2>(a.in[15] + (size_t)e * 1024 * 512, 1024, 512, ws + WS_WGU + (size_t)e * 1024 * 1024, scr, r, lane, 64.f); continue; } r -= I_G;
        if (r < I_G) { p0_transpose_item_fp8<3>(a.in[16] + (size_t)e * 1024 * 512, 1024, 512, ws + WS_WGU + (size_t)e * 1024 * 1024, scr, r, lane, 64.f); continue; } r -= I_G;
#else
        if (r < I_G) { p0_transpose_item<2>(a.in[15] + (size_t)e * 1024 * 512, 1024, 512, (bf16*)(ws + WS_WGU) + (size_t)e * 1024 * 1024, scr, r, lane); continue; } r -= I_G;
        if (r < I_G) { p0_transpose_item<3>(a.in[16] + (size_t)e * 1024 * 512, 1024, 512, (bf16*)(ws + WS_WGU) + (size_t)e * 1024 * 1024, scr, r, lane); continue; } r -= I_G;
#endif
        p0_transpose_item_fp8<0>(a.in[17] + (size_t)e * 512 * 1024, 512, 1024, ws + WS_WD + (size_t)e * 1024 * 512, scr, r, lane, 64.f);
    }
    __syncthreads();
}

__device__ __forceinline__ float log2_gamma(const float* dec, int h) {
    const float x = dec[h]; return -__log2f(1.f + __expf(-x));
}
__device__ __forceinline__ void chain_item(const Args& a, LAS unsigned char* lds, int item, int tid, int wid, int lane) {
    unsigned char* ws = a.ws;
    const int b = item >> 4, h = (item >> 2) & 3, dir = (item >> 1) & 1, vh = item & 1;
    const float lg2 = log2_gamma(dir ? a.in[3] : a.in[2], h);
    const float cd = __builtin_amdgcn_exp2f(lg2 * 128.f);
    const int g = lane >> 4, i16 = lane & 15, q = i16 >> 2, p = lane & 3;
    const int wd = wid >> 1, wv = wid & 1;
    const GAS bf16* kr = (const GAS bf16*)(ws + WS_KR); const GAS bf16* vr = (const GAS bf16*)(ws + WS_VR);
    GAS bf16* states = (GAS bf16*)a.out;
    f32x4 acc[2][4];
#pragma unroll
    for (int i = 0; i < 2; ++i)
#pragma unroll
        for (int j = 0; j < 4; ++j) acc[i][j] = (f32x4){0.f, 0.f, 0.f, 0.f};
    const int srow = tid >> 4, sch = tid & 15; const unsigned soff = offb(srow, sch);
    const GAS bf16* kp = kr + ((size_t)b * SEQ + srow) * 512 + h * 128 + sch * 8;
    const GAS bf16* vp = vr + ((size_t)b * SEQ + srow) * 1024 + h * 256 + vh * 128 + sch * 8;
    v4u kq[4], vq[4];
    { const int n0 = dir ? 15 : 0;
#pragma unroll
      for (int j = 0; j < 4; ++j) { kq[j] = *(const GAS v4u*)(kp + (size_t)(n0 * 128 + 32 * j) * 512); vq[j] = *(const GAS v4u*)(vp + (size_t)(n0 * 128 + 32 * j) * 1024); } }
    unsigned abase[2][2], bbase[4][2];
#pragma unroll
    for (int t = 0; t < 2; ++t) { const unsigned r = 8 * g + 4 * t + q;
#pragma unroll
        for (int dt = 0; dt < 2; ++dt) abase[dt][t] = offb(r, 2 * (2 * wd + dt) + (p >> 1)) + 8 * (p & 1);
#pragma unroll
        for (int vt = 0; vt < 4; ++vt) bbase[vt][t] = offb(r, 2 * (4 * wv + vt) + (p >> 1)) + 8 * (p & 1); }
#define CH_STAGE(BUFOFF) do { _Pragma("unroll") for (int j = 0; j < 4; ++j) { \
            const int row = srow + 32 * j; const float z = __builtin_amdgcn_exp2f(lg2 * (float)(dir ? row : 127 - row)); const v4u kv = kq[j]; \
            v4u ko; ko.x = cvtpk(bflo(kv.x) * z, bfhi(kv.x) * z); ko.y = cvtpk(bflo(kv.y) * z, bfhi(kv.y) * z); ko.z = cvtpk(bflo(kv.z) * z, bfhi(kv.z) * z); ko.w = cvtpk(bflo(kv.w) * z, bfhi(kv.w) * z); \
            *(LAS v4u*)(lds + (BUFOFF) + soff + j * 8192) = ko; *(LAS v4u*)(lds + (BUFOFF) + 32768 + soff + j * 8192) = vq[j]; } } while (0)
#define CH_FETCH(NN) do { _Pragma("unroll") for (int j = 0; j < 4; ++j) { kq[j] = *(const GAS v4u*)(kp + (size_t)((NN) * 128 + 32 * j) * 512); vq[j] = *(const GAS v4u*)(vp + (size_t)((NN) * 128 + 32 * j) * 1024); } } while (0)
#define CH_STEP(STEP, CUR, OTH) do { const int step_ = (STEP); const int n_ = dir ? 15 - step_ : step_; \
        GAS bf16* sb_ = states + ((((size_t)(b * 4 + h) * 16 + n_) * 2 + dir) * 256) * 128; \
        _Pragma("unroll") for (int dt = 0; dt < 2; ++dt) _Pragma("unroll") for (int vt = 0; vt < 4; ++vt) { \
            const int v_ = vh * 128 + 64 * wv + 16 * vt + i16, d0_ = 32 * wd + 16 * dt + 4 * g; \
            u32x2 w_; w_.x = pg8::cvt_pk_bf16_acc(acc[dt][vt][0], acc[dt][vt][1]); w_.y = pg8::cvt_pk_bf16_acc(acc[dt][vt][2], acc[dt][vt][3]);   \
            *(GAS u32x2*)(sb_ + (size_t)v_ * 128 + d0_) = w_; } \
        if (step_ < 15) CH_STAGE(OTH); \
        if (step_ < 14) CH_FETCH(dir ? 13 - step_ : step_ + 2); \
        _Pragma("unroll") for (int i = 0; i < 2; ++i) _Pragma("unroll") for (int j = 0; j < 4; ++j) acc[i][j] = acc[i][j] * cd; \
        _Pragma("unroll") for (int ks = 0; ks < 4; ++ks) { bf16x8 af[2], bfr[4]; \
            _Pragma("unroll") for (int dt = 0; dt < 2; ++dt) af[dt] = cat8(ldtr(lds + (CUR) + abase[dt][0] + ks * 8192), ldtr(lds + (CUR) + abase[dt][1] + ks * 8192)); \
            _Pragma("unroll") for (int vt = 0; vt < 4; ++vt) bfr[vt] = cat8(ldtr(lds + (CUR) + 32768 + bbase[vt][0] + ks * 8192), ldtr(lds + (CUR) + 32768 + bbase[vt][1] + ks * 8192)); \
            _Pragma("unroll") for (int dt = 0; dt < 2; ++dt) _Pragma("unroll") for (int vt = 0; vt < 4; ++vt) acc[dt][vt] = MFMA16(af[dt], bfr[vt], acc[dt][vt]); } \
        __syncthreads(); } while (0)
    CH_STAGE(0);
    CH_FETCH(dir ? 14 : 1);
    __syncthreads();
    for (int sp = 0; sp < 8; ++sp) { CH_STEP(2 * sp, 0, 65536); CH_STEP(2 * sp + 1, 65536, 0); }
#undef CH_STEP
#undef CH_STAGE
#undef CH_FETCH
}

constexpr int AT_OST = 135168, AT_SCR = AT_OST + 8 * 2048;
constexpr int ATB_N = 160;
struct AttnLane { unsigned kb[2]; unsigned vb[4]; };
__device__ __forceinline__ AttnLane attn_lane(int lane) {
    const int g = lane >> 4, i16 = lane & 15, q4 = i16 >> 2, p = lane & 3; AttnLane L;
#pragma unroll
    for (int s = 0; s < 2; ++s) L.kb[s] = i16 * 128 + (((4 * s + g) ^ ((i16 >> 1) & 7)) * 16);
    const int sw = (2 * g + (q4 >> 1)) & 3;
#pragma unroll
    for (int c = 0; c < 4; ++c) L.vb[c] = (4 * g + q4) * 128 + ((c ^ sw) * 32) + p * 8;
    return L;
}
__device__ __forceinline__ unsigned kimg_off(int row, int c) { return row * 128 + ((c ^ ((row >> 1) & 7)) * 16); }
__device__ __forceinline__ unsigned vimg_off(int row, int c) { return row * 128 + (((c >> 1) ^ ((row >> 1) & 3)) * 32) + (c & 1) * 16; }
__device__ __forceinline__ void attn_core(const LAS unsigned char* Kimg, const LAS unsigned char* Vimg, int R0, int nrows, unsigned tvalid, const bf16x8 (&qf)[2],
                                          const float (&biasr)[36], const AttnLane& L, f32x4 (&O)[4], float& mx, float& lsum) {
    f32x4 D[9];
#pragma unroll
    for (int kt = 0; kt < 9; ++kt) {
        int R = R0 + 16 * kt; R = R < 0 ? 0 : (R > nrows - 16 ? nrows - 16 : R);
        const LAS unsigned char* kp = Kimg + R * 128;
        const bf16x8 k0 = *(const LAS bf16x8*)(kp + L.kb[0]), k1 = *(const LAS bf16x8*)(kp + L.kb[1]);
        f32x4 d = (f32x4){0.f, 0.f, 0.f, 0.f};
        d = MFMA16(k0, qf[0], d); d = MFMA16(k1, qf[1], d); D[kt] = d;
    }
    mx = -1e30f;
#pragma unroll
    for (int kt = 0; kt < 9; ++kt) {
        const float tb = ((tvalid >> kt) & 1u) ? 0.f : -1e30f;
#pragma unroll
        for (int r = 0; r < 4; ++r) { const float x = D[kt][r] + (biasr[4 * kt + r] + tb); D[kt][r] = x; mx = fmaxf(mx, x); }
    }
    mx = fmaxf(mx, __shfl_xor(mx, 16)); mx = fmaxf(mx, __shfl_xor(mx, 32));
    lsum = 0.f;
#pragma unroll
    for (int kt = 0; kt < 9; ++kt)
#pragma unroll
        for (int r = 0; r < 4; ++r) { const float e = __builtin_amdgcn_exp2f(D[kt][r] - mx); D[kt][r] = e; lsum += e; }
    lsum += __shfl_xor(lsum, 16); lsum += __shfl_xor(lsum, 32);
#pragma unroll
    for (int c = 0; c < 4; ++c) O[c] = (f32x4){0.f, 0.f, 0.f, 0.f};
#pragma unroll
    for (int kk = 0; kk < 5; ++kk) {
        int Ra = R0 + 32 * kk; Ra = Ra < 0 ? 0 : (Ra > nrows - 16 ? nrows - 16 : Ra);
        int Rb = R0 + 32 * kk + 16; Rb = Rb < 0 ? 0 : (Rb > nrows - 16 ? nrows - 16 : Rb);
        if (kk == 4) Rb = Ra;
        const f32x4 e0 = D[2 * kk], e1 = kk < 4 ? D[2 * kk + 1] : (f32x4){0.f, 0.f, 0.f, 0.f};
        v4u pw; pw.x = cvtpk(e0[0], e0[1]); pw.y = cvtpk(e0[2], e0[3]); pw.z = cvtpk(e1[0], e1[1]); pw.w = cvtpk(e1[2], e1[3]);
        const bf16x8 pf = __builtin_bit_cast(bf16x8, pw);
        const LAS unsigned char* va_ = Vimg + Ra * 128; const LAS unsigned char* vb_ = Vimg + Rb * 128;
#pragma unroll
        for (int c = 0; c < 4; ++c) O[c] = MFMA16(pf, cat8(ldtr(va_ + L.vb[c]), ldtr(vb_ + L.vb[c])), O[c]);
    }
}
__device__ __forceinline__ void attn_stage_out(LAS unsigned char* lds, int wid, int lane, const f32x4 (&O)[4], float lsum) {
    const int g = lane >> 4, i16 = lane & 15;
    const float linv = 1.f / lsum;
    LAS bf16* st = (LAS bf16*)(lds + AT_OST + wid * 2048);
#pragma unroll
    for (int r = 0; r < 4; ++r) { const float li = __shfl(linv, 4 * g + r);
#pragma unroll
        for (int c = 0; c < 4; ++c) st[(4 * g + r) * 64 + 16 * c + i16] = (bf16)(cvtpk(O[c][r] * li, 0.f) & 0xffffu); }
}
__device__ __forceinline__ void attn_load_bias(const Args& a, int pat, int h, int lane, float (&biasr)[36]) {
    const GAS float* bt = (const GAS float*)(a.ws + WS_BIAS) + (pat * 8 + h) * ATB_N; const int g = lane >> 4, i16 = lane & 15;
#pragma unroll
    for (int kt = 0; kt < 9; ++kt)
#pragma unroll
        for (int r = 0; r < 4; ++r) biasr[4 * kt + r] = bt[16 * kt + 4 * g + r - 64 - i16 + 80];
}
template <int DIL, int VAR = 0> __device__ __forceinline__ void attn_dil_phase(const Args& a, LAS unsigned char* lds, int vcu, int G, int tid, int wid, int lane) {
    unsigned char* ws = a.ws;
    constexpr int NR = SEQ / DIL, PAT = DIL == 4 ? 1 : 2, CH = NR * 8 / 512, NITEM = NB * 8 * DIL;
    constexpr int NBUF = DIL == 16 ? 2 : 1, BUFB = 2 * NR * 128;
    const GAS bf16* qa = (const GAS bf16*)(ws + WS_QA); const GAS bf16* ka = (const GAS bf16*)(ws + WS_KA); const GAS bf16* va = (const GAS bf16*)(ws + WS_VA);
    bf16* op = (bf16*)(ws + (DIL == 4 ? WS_O2 : WS_O3)); float* lsep = (float*)(ws + (DIL == 4 ? WS_LSE2 : WS_LSE3));
    if (vcu >= NITEM) return;
    const int h = vcu & 7;
    float biasr[36]; attn_load_bias(a, PAT, h, lane, biasr);
    const AttnLane L = attn_lane(lane);
    const int g = lane >> 4, i16 = lane & 15;
    v4u kq[CH], vq[CH]; bf16x8 qn[2];
    auto issue = [&](int item, int gi) {
        const int rho = (item >> 3) % DIL, b = item / (8 * DIL); const size_t rowb = (size_t)b * SEQ;
#pragma unroll
        for (int j = 0; j < CH; ++j) { const int id = tid + 512 * j, row = id >> 3, c = id & 7; const size_t go = (rowb + (size_t)row * DIL + rho) * 512 + h * 64 + c * 8;
            kq[j] = *(const GAS v4u*)(ka + go); vq[j] = *(const GAS v4u*)(va + go); }
        const size_t qpos = rowb + (size_t)(16 * gi + i16) * DIL + rho;
#pragma unroll
        for (int s = 0; s < 2; ++s) qn[s] = *(const GAS bf16x8*)(qa + qpos * 512 + h * 64 + 32 * s + 8 * g);
    };
    issue(vcu, wid);
    int buf = 0;
    for (int item = vcu; item < NITEM; item += G) {
        const int rho = (item >> 3) % DIL, b = item / (8 * DIL); const size_t rowb = (size_t)b * SEQ;
        LAS unsigned char* Kimg = lds + buf * BUFB; LAS unsigned char* Vimg = Kimg + NR * 128;
        if (NBUF == 1) __syncthreads();
#pragma unroll
        for (int j = 0; j < CH; ++j) { const int id = tid + 512 * j, row = id >> 3, c = id & 7;
            *(LAS v4u*)(Kimg + kimg_off(row, c)) = kq[j]; *(LAS v4u*)(Vimg + vimg_off(row, c)) = vq[j]; }
        bf16x8 qf[2] = {qn[0], qn[1]};
        __syncthreads();
        if (NBUF == 2 && item + G < NITEM) issue(item + G, wid);
        for (int gi = wid; gi < NR / 16; gi += 8) {
            const int m0 = 16 * gi;
            if (NBUF == 1 && gi + 8 < NR / 16) {
                const size_t qpos = rowb + (size_t)(m0 + 128 + i16) * DIL + rho;
#pragma unroll
                for (int s = 0; s < 2; ++s) qn[s] = *(const GAS bf16x8*)(qa + qpos * 512 + h * 64 + 32 * s + 8 * g); }
            unsigned tvalid = 0u;
#pragma unroll
            for (int kt = 0; kt < 9; ++kt) { const int t0 = m0 - 64 + 16 * kt; tvalid |= (t0 >= 0 && t0 < NR) ? (1u << kt) : 0u; }
            f32x4 O[4]; float mx, lsum;
            if (VAR == 1) { mx = 0.f; lsum = 1.f;
#pragma unroll
                for (int c = 0; c < 4; ++c) O[c] = (f32x4){__builtin_bit_cast(float, qf[0][0] + c), 0.f, 0.f, 0.f}; }
            else attn_core(Kimg, Vimg, m0 - 64, NR, tvalid, qf, biasr, L, O, mx, lsum);
            attn_stage_out(lds, wid, lane, O, lsum);
            if (g == 0) lsep[(rowb + (size_t)(m0 + i16) * DIL + rho) * 8 + h] = mx + __log2f(lsum);
            asm volatile("s_waitcnt lgkmcnt(0)" ::: "memory");
            { const int q = lane >> 2, qt = lane & 3; const LAS v4u* sp = (const LAS v4u*)(lds + AT_OST + wid * 2048 + q * 128 + qt * 32);
              const v4u x0 = sp[0], x1 = sp[1]; bf16* dst = op + (rowb + (size_t)(m0 + q) * DIL + rho) * 512 + h * 64 + qt * 16;
              *(v4u*)dst = x0; *(v4u*)(dst + 8) = x1; }
            asm volatile("s_waitcnt lgkmcnt(0)" ::: "memory");
            if (NBUF == 1) { qf[0] = qn[0]; qf[1] = qn[1]; }
        }
        if (NBUF == 1 && item + G < NITEM) issue(item + G, wid);
        buf ^= (NBUF - 1);
    }
    __syncthreads();
}
__device__ __forceinline__ void attn_p1_phase(const Args& a, LAS unsigned char* lds, int vcu, int G, int tid, int wid, int lane) {
    unsigned char* ws = a.ws;
    LAS unsigned char* Kimg = lds; LAS unsigned char* Vimg = lds + 384 * 128;
    const GAS bf16* qa = (const GAS bf16*)(ws + WS_QA); const GAS bf16* ka = (const GAS bf16*)(ws + WS_KA); const GAS bf16* va = (const GAS bf16*)(ws + WS_VA);
    const GAS bf16* o2 = (const GAS bf16*)(ws + WS_O2); const GAS bf16* o3 = (const GAS bf16*)(ws + WS_O3);
    const GAS float* lse2 = (const GAS float*)(ws + WS_LSE2); const GAS float* lse3 = (const GAS float*)(ws + WS_LSE3);
    bf16* oa = (bf16*)(ws + WS_OA);
    if (vcu >= 1024) return;
    const int h = vcu & 7;
    float biasr[36]; attn_load_bias(a, 0, h, lane, biasr);
    const AttnLane L = attn_lane(lane);
    const int g = lane >> 4, i16 = lane & 15;
    LAS float* scr = (LAS float*)(lds + AT_SCR) + wid * 16;
    v4u kq[6], vq[6];
    auto issue = [&](int item) { const int b = item >> 6, s0 = ((item >> 3) & 7) * 256; const size_t rowb = (size_t)b * SEQ;
#pragma unroll
        for (int j = 0; j < 6; ++j) { const int id = tid + 512 * j, row = id >> 3, c = id & 7, pos = s0 - 64 + row; const bool ok = pos >= 0 && pos < SEQ;
            const size_t go = (rowb + (size_t)(ok ? pos : 0)) * 512 + h * 64 + c * 8;
            kq[j] = *(const GAS v4u*)(ka + go); vq[j] = *(const GAS v4u*)(va + go);
            if (!ok) { kq[j] = (v4u){0u, 0u, 0u, 0u}; vq[j] = (v4u){0u, 0u, 0u, 0u}; } } };
    issue(vcu);
    for (int item = vcu; item < 1024; item += G) {
        const int b = item >> 6, s0 = ((item >> 3) & 7) * 256; const size_t rowb = (size_t)b * SEQ;
        __syncthreads();
#pragma unroll
        for (int j = 0; j < 6; ++j) { const int id = tid + 512 * j, row = id >> 3, c = id & 7;
            *(LAS v4u*)(Kimg + kimg_off(row, c)) = kq[j]; *(LAS v4u*)(Vimg + vimg_off(row, c)) = vq[j]; }
        __syncthreads();
        if (item + G < 1024) issue(item + G);
        for (int gi = wid; gi < 16; gi += 8) {
            const int m0 = s0 + 16 * gi;
            const int q = lane >> 2, qt = lane & 3; const size_t tq = rowb + m0 + q;
            const v4u a20 = *(const GAS v4u*)(o2 + tq * 512 + h * 64 + qt * 16), a21 = *(const GAS v4u*)(o2 + tq * 512 + h * 64 + qt * 16 + 8);
            const v4u a30 = *(const GAS v4u*)(o3 + tq * 512 + h * 64 + qt * 16), a31 = *(const GAS v4u*)(o3 + tq * 512 + h * 64 + qt * 16 + 8);
            const float l2 = lse2[tq * 8 + h], l3 = lse3[tq * 8 + h];
            bf16x8 qf[2];
#pragma unroll
            for (int s = 0; s < 2; ++s) qf[s] = *(const GAS bf16x8*)(qa + (rowb + m0 + i16) * 512 + h * 64 + 32 * s + 8 * g);
            unsigned tvalid = 0u;
#pragma unroll
            for (int kt = 0; kt < 9; ++kt) { const int t0 = m0 - 64 + 16 * kt; tvalid |= (t0 >= 0 && t0 < SEQ) ? (1u << kt) : 0u; }
            f32x4 O[4]; float mx, lsum;
            attn_core(Kimg, Vimg, 16 * gi, 384, tvalid, qf, biasr, L, O, mx, lsum);
            attn_stage_out(lds, wid, lane, O, lsum);
            if (g == 0) scr[i16] = mx + __log2f(lsum);
            asm volatile("s_waitcnt lgkmcnt(0)" ::: "memory");
            {
                const float l1 = scr[q], M = fmaxf(l1, fmaxf(l2, l3));
                float w1 = __builtin_amdgcn_exp2f(l1 - M), w2 = __builtin_amdgcn_exp2f(l2 - M), w3 = __builtin_amdgcn_exp2f(l3 - M); const float wi = 1.f / (w1 + w2 + w3); w1 *= wi; w2 *= wi; w3 *= wi;
                const LAS v4u* sp = (const LAS v4u*)(lds + AT_OST + wid * 2048 + q * 128 + qt * 32);
                const v4u x0 = sp[0], x1 = sp[1];
                v4u r0, r1;
#define MRG(d, x, y, z) d = cvtpk(w1 * bflo(x) + w2 * bflo(y) + w3 * bflo(z), w1 * bfhi(x) + w2 * bfhi(y) + w3 * bfhi(z))
                MRG(r0.x, x0.x, a20.x, a30.x); MRG(r0.y, x0.y, a20.y, a30.y); MRG(r0.z, x0.z, a20.z, a30.z); MRG(r0.w, x0.w, a20.w, a30.w);
                MRG(r1.x, x1.x, a21.x, a31.x); MRG(r1.y, x1.y, a21.y, a31.y); MRG(r1.z, x1.z, a21.z, a31.z); MRG(r1.w, x1.w, a21.w, a31.w);
#undef MRG
                bf16* dst = oa + tq * 512 + h * 64 + qt * 16;
                *(v4u*)dst = r0; *(v4u*)(dst + 8) = r1;
            }
            asm volatile("s_waitcnt lgkmcnt(0)" ::: "memory");
        }
    }
    __syncthreads();
}

#define OPAQUE(x) asm volatile("" : "+v"(x))
template <int VAR = 0> __device__ __forceinline__ void p3_phase(const Args& a, LAS unsigned char* lds, int vcu, int G, int tid, int wid, int lane) {
    unsigned char* ws = a.ws;
    const int g = lane >> 4, i16 = lane & 15, q4 = i16 >> 2, p = lane & 3;
    const GAS bf16* qr = (const GAS bf16*)(ws + WS_QR); const GAS bf16* kr = (const GAS bf16*)(ws + WS_KR); const GAS bf16* vr = (const GAS bf16*)(ws + WS_VR);
    GAS bf16* gr = (GAS bf16*)(ws + WS_GR);
    LAS unsigned char* Kt = lds; LAS unsigned char* Sg = lds + 32768;
    if (vcu >= 1024) return;
    const unsigned kdst = offb(tid >> 4, tid & 15);
    unsigned rfo[4];
    { const unsigned X = ((i16 & 3) << 2) | (i16 >> 2);
#pragma unroll
      for (int s = 0; s < 4; ++s) rfo[s] = 256 * i16 + 16 * (((4 * s) ^ (X & 12)) | (g ^ (X & 3))); }
    v4u sreg[8], kreg[4]; bf16x8 qn[4];
    auto item_ptrs = [&](int item, size_t& tok0, const GAS bf16*& sf, int& h) { const int b = item >> 6; h = (item >> 4) & 3; const int n = item & 15; tok0 = (size_t)b * SEQ + n * 128;
        sf = (const GAS bf16*)a.out + ((((size_t)(b * 4 + h) * 16 + n) * 2 + 0) * 256) * 128; };
    auto issue_k = [&](int item) { size_t tok0; const GAS bf16* sf; int h; item_ptrs(item, tok0, sf, h);
        const GAS bf16* ks_ = kr + (tok0 + (tid >> 4)) * 512 + h * 128 + (tid & 15) * 8;
#pragma unroll
        for (int j = 0; j < 4; ++j) kreg[j] = *(const GAS v4u*)(ks_ + (size_t)j * 32 * 512); };
    auto issue_q = [&](int item) { size_t tok0; const GAS bf16* sf; int h; item_ptrs(item, tok0, sf, h);
#pragma unroll
        for (int s = 0; s < 4; ++s) qn[s] = *(const GAS bf16x8*)(qr + (tok0 + 16 * wid + i16) * 512 + h * 128 + 32 * s + 8 * g); };
    auto issue_state = [&](const GAS bf16* sf, int dirn) { const GAS bf16* sld = sf + (size_t)dirn * 256 * 128 + (size_t)(tid >> 4) * 128 + (tid & 15) * 8;
#pragma unroll
        for (int j = 0; j < 8; ++j) sreg[j] = *(const GAS v4u*)(sld + (size_t)j * 32 * 128); };
    auto write_state = [&]() {
#pragma unroll
        for (int j = 0; j < 8; ++j) *(LAS v4u*)(Sg + (j >> 2) * 32768 + kdst + (j & 3) * 8192) = sreg[j]; };
    { size_t tok0; const GAS bf16* sf; int h; item_ptrs(vcu, tok0, sf, h); issue_k(vcu); issue_q(vcu); issue_state(sf, 0); }
#pragma unroll
    for (int j = 0; j < 4; ++j) *(LAS v4u*)(Kt + kdst + j * 8192) = kreg[j];
    for (int item = vcu; item < 1024; item += G) {
        size_t tok0; const GAS bf16* sf; int h; item_ptrs(item, tok0, sf, h);
        const float lf2 = log2_gamma(a.in[2], h), lb2 = log2_gamma(a.in[3], h);
        bf16x8 qf[4];
#pragma unroll
        for (int s = 0; s < 4; ++s) qf[s] = qn[s];
        const bool has_next = item + G < 1024;
        __syncthreads();
        f32x4 D[8];
#pragma unroll
        for (int jt = 0; jt < 8; ++jt) {
            f32x4 d = (f32x4){0.f, 0.f, 0.f, 0.f};
#pragma unroll
            for (int s = 0; s < 4; ++s) { if (VAR != 1) { const bf16x8 kf = *(const LAS bf16x8*)(Kt + rfo[s] + jt * 4096); d = MFMA16(kf, qf[s], d); } else d[s] = __builtin_bit_cast(float, (int)qf[s][0]); }
            D[jt] = d;
        }
        int iq = 16 * wid + i16; OPAQUE(iq);
        bf16x8 pf[4];
#pragma unroll
        for (int ks = 0; ks < 4; ++ks) {
            float e[8];
#pragma unroll
            for (int t = 0; t < 2; ++t)
#pragma unroll
                for (int r = 0; r < 4; ++r) {
                    const int j = 16 * (2 * ks + t) + 4 * g + r; const float fdf = (float)(iq - j), ad = fabsf(fdf);
                    const float pos = fminf(fmaxf(fdf, 0.f), 1.f), isz = 1.f - fminf(ad, 1.f);
                    const float w = __builtin_amdgcn_exp2f((lb2 + (lf2 - lb2) * pos) * ad) + isz;
                    e[4 * t + r] = D[2 * ks + t][r] * w;
                }
            v4u pw; pw.x = cvtpk(e[0], e[1]); pw.y = cvtpk(e[2], e[3]); pw.z = cvtpk(e[4], e[5]); pw.w = cvtpk(e[6], e[7]);
            pf[ks] = __builtin_bit_cast(bf16x8, pw);
        }
        f32x4 acc[16];
#pragma unroll
        for (int vt = 0; vt < 16; ++vt) acc[vt] = (f32x4){0.f, 0.f, 0.f, 0.f};
#pragma unroll
        for (int dirn = 0; dirn < 2; ++dirn) {
            if (dirn == 1) __syncthreads();
            write_state();
            if (dirn == 0) { issue_state(sf, 1); if (has_next) issue_k(item + G); }
            else {
                if (has_next) {
#pragma unroll
                    for (int j = 0; j < 4; ++j) *(LAS v4u*)(Kt + kdst + j * 8192) = kreg[j]; }
                const GAS bf16* vs_ = vr + (tok0 + (tid >> 5)) * 1024 + h * 256 + (tid & 31) * 8;
#pragma unroll
                for (int j = 0; j < 8; ++j) sreg[j] = *(const GAS v4u*)(vs_ + (size_t)j * 16 * 1024);
            }
            __syncthreads();
#pragma unroll
            for (int vt = 0; vt < 16; ++vt) {
#pragma unroll
                for (int s = 0; s < 4; ++s) { if (VAR != 1) { const bf16x8 sfr = *(const LAS bf16x8*)(Sg + (vt >> 3) * 32768 + rfo[s] + (vt & 7) * 4096); acc[vt] = MFMA16(qf[s], sfr, acc[vt]); } }
            }
            float xs[4];
            { int ib = 16 * wid + 4 * g; OPAQUE(ib);
#pragma unroll
              for (int r = 0; r < 4; ++r) { const float lxf = lf2 * (float)(ib + r + 1), lxb = lb2 * (float)(128 - ib - r); xs[r] = __builtin_amdgcn_exp2f(dirn == 0 ? lxf - lxb : lxb); } }
#pragma unroll
            for (int vt = 0; vt < 16; ++vt)
#pragma unroll
                for (int r = 0; r < 4; ++r) acc[vt][r] *= xs[r];
        }
        __syncthreads();
        { int t2 = tid; OPAQUE(t2); const unsigned vd2 = (unsigned)((t2 & 31) >> 4) * 32768u + offb(t2 >> 5, t2 & 15);
#pragma unroll
          for (int j = 0; j < 8; ++j) *(LAS v4u*)(Sg + vd2 + j * 4096) = sreg[j]; }
        GAS bf16* gp = gr + (tok0 + 16 * wid + (lane >> 5)) * 1024 + h * 256 + (lane & 31) * 8;
        __syncthreads();
        unsigned vbs[8];
        { int l2 = lane; OPAQUE(l2); const unsigned g2 = l2 >> 4, q2 = (l2 & 15) >> 2, p2 = l2 & 3, X = (q2 << 2) | g2;
#pragma unroll
          for (int c = 0; c < 8; ++c) vbs[c] = 256 * (4 * g2 + q2) + 16 * (((2 * c) ^ (X & 14)) | ((p2 >> 1) ^ (X & 1))) + 8 * (p2 & 1); }
#pragma unroll
        for (int vt = 0; vt < 16; ++vt) {
#pragma unroll
            for (int ks = 0; ks < 4; ++ks) { if (VAR != 1) {
                const s16x4 lo = ldtr(Sg + vbs[vt & 7] + (vt >> 3) * 32768 + ks * 8192), hi = ldtr(Sg + vbs[vt & 7] + (vt >> 3) * 32768 + ks * 8192 + 4096);
                acc[vt] = MFMA16(pf[ks], cat8(lo, hi), acc[vt]); }
            }
            asm volatile("" ::: "memory");
        }
        float mu[4], rs[4];
#pragma unroll
        for (int r = 0; r < 4; ++r) {
            float s = 0.f;
#pragma unroll
            for (int vt = 0; vt < 16; ++vt) s += acc[vt][r];
            s += __shfl_xor(s, 1); s += __shfl_xor(s, 2); s += __shfl_xor(s, 4); s += __shfl_xor(s, 8);
            const float m = s * (1.f / 256.f); float qv = 0.f;
#pragma unroll
            for (int vt = 0; vt < 16; ++vt) { const float d = acc[vt][r] - m; qv += d * d; }
            qv += __shfl_xor(qv, 1); qv += __shfl_xor(qv, 2); qv += __shfl_xor(qv, 4); qv += __shfl_xor(qv, 8);
            mu[r] = m; rs[r] = 1.f / sqrtf(qv * (1.f / 256.f) + LN_EPSF);
        }
        v4u greg[8];
#pragma unroll
        for (int j = 0; j < 8; ++j) greg[j] = *(const GAS v4u*)(gp + (size_t)j * 2048);
        __syncthreads();
        if (has_next) { size_t tk; const GAS bf16* sfn; int hn; item_ptrs(item + G, tk, sfn, hn); issue_state(sfn, 0); issue_q(item + G); }
        LAS bf16* st = (LAS bf16*)(Sg + wid * 8192);
        { LAS bf16* sp_ = st + (4 * g) * 256 + i16;
#pragma unroll
          for (int vt = 0; vt < 16; ++vt)
#pragma unroll
              for (int r = 0; r < 4; ++r) sp_[r * 256 + 16 * vt] = (bf16)(cvtpk((acc[vt][r] - mu[r]) * rs[r], 0.f) & 0xffffu); }
        asm volatile("s_waitcnt lgkmcnt(0)" ::: "memory");
        {
            const float* gn = a.in[4] + h * 256; const int ch = lane & 31;
            const f32x4 g0 = *(const f32x4*)(gn + ch * 8), g1 = *(const f32x4*)(gn + ch * 8 + 4);
            const LAS bf16* yp = st + (lane >> 5) * 256 + ch * 8;
#pragma unroll
            for (int j = 0; j < 8; ++j) {
                const v4u y = *(const LAS v4u*)(yp + j * 512); const v4u sg = greg[j];
                v4u o; o.x = cvtpk(bflo(y.x) * g0[0] * bflo(sg.x), bfhi(y.x) * g0[1] * bfhi(sg.x)); o.y = cvtpk(bflo(y.y) * g0[2] * bflo(sg.y), bfhi(y.y) * g0[3] * bfhi(sg.y));
                o.z = cvtpk(bflo(y.z) * g1[0] * bflo(sg.z), bfhi(y.z) * g1[1] * bfhi(sg.z)); o.w = cvtpk(bflo(y.w) * g1[2] * bflo(sg.w), bfhi(y.w) * g1[3] * bfhi(sg.w));
                *(GAS v4u*)(gp + (size_t)j * 2048) = o;
            }
        }
        __syncthreads();
    }
}

constexpr int P6_RS = 81920, P6_CNT = P6_RS + 8 * 512, P6_BASE = P6_CNT + 64, P6_ROW = P6_BASE + 64;
#define P6_BUTTERFLY(lg, out) do { float r10[10], r5[5], r3[3], r2[2]; const float z = 0.f; \
    _Pragma("unroll") for (int k = 0; k < 10; ++k) { const float keep = h32 ? lg[10 + k] : lg[k], send = h32 ? lg[k] : lg[10 + k]; r10[k] = keep + __shfl_xor(send, 32); } \
    _Pragma("unroll") for (int k = 0; k < 5; ++k) { const float keep = h16 ? r10[5 + k] : r10[k], send = h16 ? r10[k] : r10[5 + k]; r5[k] = keep + __shfl_xor(send, 16); } \
    { const float keep = h8 ? r5[3] : r5[0], send = h8 ? r5[0] : r5[3]; r3[0] = keep + __shfl_xor(send, 8); } \
    { const float keep = h8 ? r5[4] : r5[1], send = h8 ? r5[1] : r5[4]; r3[1] = keep + __shfl_xor(send, 8); } \
    { const float keep = h8 ? z : r5[2], send = h8 ? r5[2] : z; r3[2] = keep + __shfl_xor(send, 8); } \
    { const float keep = h4 ? r3[2] : r3[0], send = h4 ? r3[0] : r3[2]; r2[0] = keep + __shfl_xor(send, 4); } \
    { const float keep = h4 ? z : r3[1], send = h4 ? r3[1] : z; r2[1] = keep + __shfl_xor(send, 4); } \
    { const float keep = h2 ? r2[1] : r2[0], send = h2 ? r2[0] : r2[1]; out = keep + __shfl_xor(send, 2); } \
    out += __shfl_xor(out, 1); } while (0)
__device__ __forceinline__ void p6a_phase(const Args& a, LAS unsigned char* lds, int vcu, int G, int tid, int wave, int lane) {
    unsigned char* ws = a.ws;
    LAS float* RW = (LAS float*)lds;
    LAS float* RS = (LAS float*)(lds + P6_RS) + wave * 128;
    LAS unsigned* LC = (LAS unsigned*)(lds + P6_CNT); LAS unsigned* LB = (LAS unsigned*)(lds + P6_BASE); LAS unsigned* LR = (LAS unsigned*)(lds + P6_ROW);
    for (int i = tid; i < 1024 * 4; i += 512) { const int c = i >> 2, k = i & 3; RW[k * 1024 + c] = a.in[11][i]; }
    for (int i = tid; i < 1024 * 16; i += 512) { const int c = i >> 4, k = i & 15; RW[(4 + k) * 1024 + c] = a.in[13][i]; }
    const u32x2* pre = (const u32x2*)a.out; u32x2* x1b = (u32x2*)(ws + WS_XB); [[maybe_unused]] unsigned* x1f8 = (unsigned*)(ws + WS_X1F8);
    gu32* ctl = (gu32*)ws;
    int* ltok = (int*)(ws + WS_LTOK); float* tw = (float*)(ws + WS_WSLOT); unsigned* tinfo = (unsigned*)(ws + WS_TINFO);
    const float* g1 = a.in[9]; const float* b1 = a.in[10];
    const bool h32 = (lane & 32) != 0, h16 = (lane & 16) != 0, h8 = (lane & 8) != 0, h4 = (lane & 4) != 0, h2 = (lane & 2) != 0;
#define P6_LOADROW(dst, t_) do { const u32x2* xr_ = pre + (size_t)(t_) * 256 + lane; _Pragma("unroll") for (int j = 0; j < 4; ++j) dst[j] = xr_[64 * j]; } while (0)
#define P6_LN(v, nx, s) do { s = 0.f; _Pragma("unroll") for (int j = 0; j < 4; ++j) { v[j] = (f32x4){bflo(nx[j].x), bfhi(nx[j].x), bflo(nx[j].y), bfhi(nx[j].y)}; s += (v[j].x + v[j].y) + (v[j].z + v[j].w); } } while (0)
#define P6_VAR(v, mean, q) do { q = 0.f; _Pragma("unroll") for (int j = 0; j < 4; ++j) { v[j] = v[j] - mean; q += (v[j].x * v[j].x + v[j].y * v[j].y) + (v[j].z * v[j].z + v[j].w * v[j].w); } } while (0)
#if M1_FP8
#define P6_STORE(v, t_, j) do { u32x2 o_; o_.x = cvtpk(v[j].x, v[j].y); o_.y = cvtpk(v[j].z, v[j].w); x1b[(size_t)(t_) * 256 + lane + 64 * j] = o_; x1f8[(size_t)(t_) * 256 + lane + 64 * j] = pk_fp8x4(v[j].x, v[j].y, v[j].z, v[j].w); } while (0)
#else
#define P6_STORE(v, t_, j) do { u32x2 o_; o_.x = cvtpk(v[j].x, v[j].y); o_.y = cvtpk(v[j].z, v[j].w); x1b[(size_t)(t_) * 256 + lane + 64 * j] = o_; } while (0)
#endif
#define P6_DOT(lg, v, j, k, w) lg[k] += (v[j][0] * w[0] + v[j][1] * w[1]) + (v[j][2] * w[2] + v[j][3] * w[3])
    for (int blk = vcu; blk < TT / 128; blk += G) {
        if (tid < 16) LC[tid] = 0u;
        __syncthreads();
        const int t0 = blk * 128;
        u32x2 nxA[4], nxB[4], nxC[4], nxD[4];
        P6_LOADROW(nxA, t0 + wave); P6_LOADROW(nxB, t0 + wave + 8); P6_LOADROW(nxC, t0 + wave + 16); P6_LOADROW(nxD, t0 + wave + 24);
        for (int rr = 0; rr < 4; ++rr) {
            const int rl0 = wave + 32 * rr, tA = t0 + rl0, tB = tA + 8, tC = tA + 16, tD = tA + 24;
            f32x4 vA[4], vB[4], vC[4], vD[4]; float sA, sB, sC, sD;
            P6_LN(vA, nxA, sA); P6_LN(vB, nxB, sB); P6_LN(vC, nxC, sC); P6_LN(vD, nxD, sD);
            if (rr < 3) { P6_LOADROW(nxA, tA + 32); P6_LOADROW(nxB, tB + 32); P6_LOADROW(nxC, tC + 32); P6_LOADROW(nxD, tD + 32); }
            const float mA = wave_sum(sA) * (1.f / DM), mB = wave_sum(sB) * (1.f / DM), mC = wave_sum(sC) * (1.f / DM), mD = wave_sum(sD) * (1.f / DM);
            float qA, qB, qC, qD;
            P6_VAR(vA, mA, qA); P6_VAR(vB, mB, qB); P6_VAR(vC, mC, qC); P6_VAR(vD, mD, qD);
            const float rA = 1.f / sqrtf(wave_sum(qA) * (1.f / DM) + LN_EPSF), rB = 1.f / sqrtf(wave_sum(qB) * (1.f / DM) + LN_EPSF);
            const float rC = 1.f / sqrtf(wave_sum(qC) * (1.f / DM) + LN_EPSF), rD = 1.f / sqrtf(wave_sum(qD) * (1.f / DM) + LN_EPSF);
            float lgA[20], lgB[20], lgC[20], lgD[20];
#pragma unroll
            for (int k = 0; k < 20; ++k) { lgA[k] = 0.f; lgB[k] = 0.f; lgC[k] = 0.f; lgD[k] = 0.f; }
#pragma unroll
            for (int j = 0; j < 4; ++j) {
                const f32x4 gg = *(const f32x4*)(g1 + 4 * lane + 256 * j), bb = *(const f32x4*)(b1 + 4 * lane + 256 * j);
                vA[j] = vA[j] * rA * gg + bb; vB[j] = vB[j] * rB * gg + bb; vC[j] = vC[j] * rC * gg + bb; vD[j] = vD[j] * rD * gg + bb;
                P6_STORE(vA, tA, j); P6_STORE(vB, tB, j); P6_STORE(vC, tC, j); P6_STORE(vD, tD, j);
#pragma unroll
                for (int k = 0; k < 20; ++k) { const f32x4 w = *(const LAS f32x4*)(RW + k * 1024 + 4 * lane + 256 * j);
                    P6_DOT(lgA, vA, j, k, w); P6_DOT(lgB, vB, j, k, w); P6_DOT(lgC, vC, j, k, w); P6_DOT(lgD, vD, j, k, w); }
            }
            float r1A, r1B, r1C, r1D;
            P6_BUTTERFLY(lgA, r1A); P6_BUTTERFLY(lgB, r1B); P6_BUTTERFLY(lgC, r1C); P6_BUTTERFLY(lgD, r1D);
            {
                const int i3 = h2 ? (h4 ? -1 : 1) : (h4 ? 2 : 0);
                const int i5 = i3 < 0 ? -1 : (h8 ? (i3 == 2 ? -1 : i3 + 3) : i3);
                const int kk = i5 < 0 ? -1 : (h32 ? 10 : 0) + (h16 ? 5 : 0) + i5;
                if (kk >= 0 && (lane & 1) == 0) { RS[kk] = r1A; RS[32 + kk] = r1B; RS[64 + kk] = r1C; RS[96 + kk] = r1D; }
            }
            asm volatile("s_waitcnt lgkmcnt(0)" ::: "memory");
            {
                const int sel = lane & 3; const int rl = rl0 + 8 * sel;
                float tl[20];
#pragma unroll
                for (int k4 = 0; k4 < 5; ++k4) { const f32x4 w = *(const LAS f32x4*)(RS + sel * 32 + 4 * k4); tl[4 * k4] = w[0]; tl[4 * k4 + 1] = w[1]; tl[4 * k4 + 2] = w[2]; tl[4 * k4 + 3] = w[3]; }
                float gl[4];
#pragma unroll
                for (int k = 0; k < 4; ++k) gl[k] = tl[k] + a.in[12][k];
                int gi = 0; float gm = gl[0];
#pragma unroll
                for (int k = 1; k < 4; ++k) if (gl[k] > gm) { gm = gl[k]; gi = k; }
                float gs = 0.f;
#pragma unroll
                for (int k = 0; k < 4; ++k) gs += __expf(gl[k] - gm);
                const float gwt = 1.f / gs;
                float el[4];
#pragma unroll
                for (int k = 0; k < 4; ++k) { const float se = gi == 0 ? tl[4 + k] : (gi == 1 ? tl[8 + k] : (gi == 2 ? tl[12 + k] : tl[16 + k])); el[k] = se + a.in[14][4 * gi + k]; }
                int i1 = 0; float v1 = el[0];
#pragma unroll
                for (int k = 1; k < 4; ++k) if (el[k] > v1) { v1 = el[k]; i1 = k; }
                int i2 = (i1 + 1) & 3; float v2 = -3.0e38f;
#pragma unroll
                for (int k = 0; k < 4; ++k) if (k != i1 && el[k] > v2) { v2 = el[k]; i2 = k; }
                const float ex = __expf(v2 - v1), w1 = gwt / (1.f + ex), w2 = gwt * ex / (1.f + ex);
                if (lane < 4) {
                    const int e1 = 4 * gi + i1, e2 = 4 * gi + i2;
                    const unsigned p1 = __hip_atomic_fetch_add(LC + e1, 1u, __ATOMIC_RELAXED, __HIP_MEMORY_SCOPE_WORKGROUP);
                    const unsigned p2 = __hip_atomic_fetch_add(LC + e2, 1u, __ATOMIC_RELAXED, __HIP_MEMORY_SCOPE_WORKGROUP);
                    LR[rl * 4 + 0] = ((unsigned)e1 << 16) | p1; LR[rl * 4 + 1] = ((unsigned)e2 << 16) | p2; LR[rl * 4 + 2] = __float_as_uint(w1); LR[rl * 4 + 3] = __float_as_uint(w2);
                }
            }
            asm volatile("s_waitcnt lgkmcnt(0)" ::: "memory");
        }
        __syncthreads();
        if (tid < 16) LB[tid] = __hip_atomic_fetch_add(ctl + CW_CNT + 64 * tid, LC[tid], __ATOMIC_RELAXED, __HIP_MEMORY_SCOPE_AGENT);
        __syncthreads();
        if (tid < 256) {
            const int rl = tid >> 1, j = tid & 1; const unsigned rec = LR[rl * 4 + j]; const unsigned e = rec >> 16, pos = LB[e] + (rec & 0xffffu);
            ltok[e * TT + pos] = t0 + rl; tw[2 * (t0 + rl) + j] = __uint_as_float(LR[rl * 4 + 2 + j]); tinfo[2 * (t0 + rl) + j] = (e << 16) | pos;
        }
        __syncthreads();
    }
#undef P6_LOADROW
#undef P6_LN
#undef P6_VAR
#undef P6_STORE
#undef P6_DOT
}
__device__ __forceinline__ void build_tile_tables(const Args& a, LAS unsigned char* lds, int tid) {
    LAS int* ts = (LAS int*)(lds + LDS_TS_OFF); LAS int* te = (LAS int*)(lds + LDS_TE_OFF); LAS int* cn = (LAS int*)(lds + LDS_CNT_OFF);
    gu32* ctl = (gu32*)a.ws;
    if (tid == 0) { int acc = 0;
        for (int e = 0; e < 16; ++e) { ts[e] = acc; const int c = (int)__hip_atomic_load(ctl + CW_CNT + 64 * e, __ATOMIC_RELAXED, __HIP_MEMORY_SCOPE_AGENT); const int nt = (c + 255) >> 8; cn[e] = c;
            for (int k = 0; k < nt; ++k) te[acc + k] = e; acc += nt; }
        ts[16] = acc; }
    __syncthreads();
}
__device__ __forceinline__ void p9_phase(const Args& a, LAS unsigned char* lds, int vcu, int G, int wave, int lane) {
    unsigned char* ws = a.ws;
    const LAS int* ts = (const LAS int*)(lds + LDS_TS_OFF);
    const unsigned* tinfo = (const unsigned*)(ws + WS_TINFO); const u32x2* Y = (const u32x2*)(ws + WS_Y);
    const float* g2 = a.in[18]; const float* b2 = a.in[19];
    const int gw = vcu * NWAVES + wave, NGW = G * NWAVES;
    u32x2 ny0[4], ny1[4], nxw[4]; float nw0 = 0.f, nw1 = 0.f;
    const float* tw = (const float*)(ws + WS_WSLOT);
    auto issue = [&](int t) {
        const unsigned i0 = tinfo[2 * t], i1 = tinfo[2 * t + 1];
        nw0 = tw[2 * t]; nw1 = tw[2 * t + 1];
        const size_t s0 = (size_t)ts[i0 >> 16] * 256 + (i0 & 0xffffu), s1 = (size_t)ts[i1 >> 16] * 256 + (i1 & 0xffffu);
        const u32x2* xb1 = (const u32x2*)(ws + WS_XB) + (size_t)t * 256 + lane;
#pragma unroll
        for (int j = 0; j < 4; ++j) { ny0[j] = Y[s0 * 256 + lane + 64 * j]; ny1[j] = Y[s1 * 256 + lane + 64 * j]; nxw[j] = xb1[64 * j]; }
    };
    if (gw < TT) issue(gw);
    for (int t = gw; t < TT; t += NGW) {
        f32x4* xr = (f32x4*)(a.out + (size_t)t * DM) + lane;
        f32x4 v[4]; float s = 0.f; const float w0 = nw0, w1 = nw1;
#pragma unroll
        for (int j = 0; j < 4; ++j) {
            const u32x2 y0 = ny0[j], y1 = ny1[j], xw = nxw[j];
            f32x4 x = (f32x4){bflo(xw.x), bfhi(xw.x), bflo(xw.y), bfhi(xw.y)} * DN_ALPHA;
            x.x += w0 * bflo(y0.x) + w1 * bflo(y1.x); x.y += w0 * bfhi(y0.x) + w1 * bfhi(y1.x); x.z += w0 * bflo(y0.y) + w1 * bflo(y1.y); x.w += w0 * bfhi(y0.y) + w1 * bfhi(y1.y);
            v[j] = x; s += (x.x + x.y) + (x.z + x.w);
        }
        if (t + NGW < TT) issue(t + NGW);
        const float mean = wave_sum(s) * (1.f / DM); float s2 = 0.f;
#pragma unroll
        for (int j = 0; j < 4; ++j) { v[j] = v[j] - mean; s2 += (v[j].x * v[j].x + v[j].y * v[j].y) + (v[j].z * v[j].z + v[j].w * v[j].w); }
        const float rstd = 1.f / sqrtf(wave_sum(s2) * (1.f / DM) + LN_EPSF);
#pragma unroll
        for (int j = 0; j < 4; ++j) { const f32x4 gg = *(const f32x4*)(g2 + 4 * lane + 256 * j), bb = *(const f32x4*)(b2 + 4 * lane + 256 * j); xr[64 * j] = v[j] * rstd * gg + bb; }
    }
}

__global__ void __launch_bounds__(NWAVES * 64, 2) mega_fwd(Args args) {
    extern __shared__ __attribute__((aligned(16))) unsigned char lds_raw[];
    LAS unsigned char* lds = (LAS unsigned char*)lds_raw;
    volatile LAS unsigned* MISC = (volatile LAS unsigned*)(lds + MISC_OFF);
    const int tid0 = threadIdx.x, wave = __builtin_amdgcn_readfirstlane(tid0 >> 6);
    const int G = gridDim.x, bx = blockIdx.x, vcu = (G % 8 == 0) ? (bx % 8) * (G / 8) + bx / 8 : bx;
    for (int u = tid0; u < (LDS_BYTES - LDSCTL_OFF) / 4; u += NWAVES * 64) ((LAS unsigned*)(lds + LDSCTL_OFF))[u] = 0u;
    __syncthreads();
    unsigned char* ws = args.ws;
    gu32* ctl = (gu32*)ws;
    const bool bars_on = (args.mask >> 31) != 0u;
    XcdBarrier bar; bar.bar = (unsigned*)(ctl + CW_BAR) + args.bar_region * XCD_BAR_WORDS; bar.x = 0; bar.st = nullptr;
    if (bars_on) bar = xcd_barrier_post((unsigned*)(ctl + CW_BAR) + args.bar_region * XCD_BAR_WORDS, MISC + 8);
#define GRID_BAR() do { if (bars_on) xcd_barrier(bar); } while (0)
#ifndef PH_LAST
#define PH_LAST 99
#endif
#define FRESH() int tid = threadIdx.x; asm volatile("" : "+v"(tid)); const int lane = tid & 63; (void)lane
#ifndef RMASK
#define RMASK 0
#endif
#define REP(k) _Pragma("unroll") for (int rep_ = 0; rep_ < 1 + ((RMASK >> (k)) & 1); ++rep_)
#ifndef STAMP_SCALE
#define STAMP_SCALE 1.0f
#endif
#ifdef STAMP_PH
#define ST_B(k) if ((k) == STAMP_PH) { st_a = rt(); }
#define ST_E(k) if ((k) == STAMP_PH) { st_b = rt(); }
#else
#define ST_B(k)
#define ST_E(k)
#endif
#ifdef ONLY
#define EN(k) (ONLY == (k))
#else
#define EN(k) ((args.mask >> (k)) & 1u)
#endif
    unsigned long long st_a = 0, st_b = 0; (void)st_a; (void)st_b;
    REP(0) if (EN(0)) { FRESH(); p0_prologue(args, lds, vcu, G, tid, wave, lane); }
    GRID_BAR();
#ifdef STAGGER_TICKS
    if (EN(1) && (bx & 8)) { const unsigned long long t0_ = rt(); while (rt() - t0_ < STAGGER_TICKS) __builtin_amdgcn_s_sleep(32); }
#endif
    REP(1) if (EN(1)) {
        pg8::Gemm g{(const pg8::bf16_t*)(ws + WS_XB), (const pg8::bf16_t*)(ws + WS_WIN), TT, 4608, 1024}; pg8::StaticOrder S; S.init(TT, 4608, G, bx);
        pg8::EpiHcat E{ws, (const float*)(ws + WS_ROT), 0};
        pg8::gemm_phase<pg8::EpiHcat, pg8::StaticOrder, true, true>(lds, g, S, E);
    }
    GRID_BAR();
    if (PH_LAST >= 2) {
        REP(2) if (EN(2)) { FRESH(); for (int it = vcu; it < 256; it += G) chain_item(args, lds, it, tid, wave, lane); }
        if (EN(3)) { { FRESH(); attn_dil_phase<16>(args, lds, vcu, G, tid, wave, lane); }
                     { FRESH(); attn_dil_phase<4>(args, lds, vcu, G, tid, wave, lane); } }
    }
    GRID_BAR();
    ST_B(4) if (PH_LAST >= 3 && EN(4)) { FRESH(); p3_phase<0>(args, lds, vcu, G, tid, wave, lane); }
    if (EN(13)) { FRESH(); attn_p1_phase(args, lds, vcu, G, tid, wave, lane); }
    GRID_BAR(); ST_E(4)
    if (EN(14)) { FRESH(); p0_expert_weights(args, lds, vcu, G, wave, lane); }
    REP(5) if (PH_LAST >= 4 && EN(5)) {
        pg8::Gemm g{(const pg8::bf16_t*)(ws + WS_XB), (const pg8::bf16_t*)(ws + WS_WIN) + (size_t)4608 * 1024, TT, 2048, 1024}; pg8::GateOrder S; S.S4.init(TT, 1024, G, bx);
        pg8::EpiHcat E{ws, (const float*)(ws + WS_ROT), 18};
        pg8::gemm_phase<pg8::EpiHcat, pg8::GateOrder, true, true>(lds, g, S, E);
        asm volatile("s_waitcnt vmcnt(0)" ::: "memory"); __syncthreads();
    }
    REP(6) if (PH_LAST >= 5 && EN(6)) {
        pg8::StaticOrder S; S.init(TT, 1024, G, bx);
        { pg8::Gemm g{(const pg8::bf16_t*)(ws + WS_OA), (const pg8::bf16_t*)(ws + WS_WA), TT, 1024, 512};
          pg8::EpiGate<false> E{(const pg8::bf16_t*)(ws + WS_GATE_A), (pg8::bf16_t*)(ws + WS_MERGED)};
          pg8::gemm_phase<pg8::EpiGate<false>, pg8::StaticOrder, true, true>(lds, g, S, E); }
        asm volatile("s_waitcnt vmcnt(0)" ::: "memory"); __syncthreads();
        { pg8::Gemm g{(const pg8::bf16_t*)(ws + WS_GR), (const pg8::bf16_t*)(ws + WS_WR), TT, 1024, 1024};
          pg8::EpiGate<true> E{(const pg8::bf16_t*)(ws + WS_GATE_R), (pg8::bf16_t*)(ws + WS_MERGED)};
          pg8::gemm_phase<pg8::EpiGate<true>, pg8::StaticOrder, true, true>(lds, g, S, E); }
    }
    GRID_BAR();
    REP(7) if (PH_LAST >= 6 && EN(7)) {
        pg8::Gemm g{(const pg8::bf16_t*)(ws + WS_MERGED), (const pg8::bf16_t*)(ws + WS_WO), TT, 1024, 1024}; pg8::StaticOrder S; S.init(TT, 1024, G, bx);
        pg8::EpiResBf16 E{(const pg8::bf16_t*)(ws + WS_XB), (pg8::bf16_t*)args.out, DN_ALPHA};
        pg8::gemm_phase<pg8::EpiResBf16, pg8::StaticOrder, true, true>(lds, g, S, E);
    }
    GRID_BAR();
    ST_B(8) if (PH_LAST >= 7 && EN(8)) { FRESH(); p6a_phase(args, lds, vcu, G, tid, wave, lane); }
    GRID_BAR(); ST_E(8)
    build_tile_tables(args, lds, tid0);
    const int nrt = ((const LAS int*)(lds + LDS_TS_OFF))[16];
    REP(10) if (PH_LAST >= 9 && EN(10)) {
#if M1_FP8
        pg8::Gemm g{(const pg8::bf16_t*)(ws + WS_X1F8), (const pg8::bf16_t*)(ws + WS_WGU), MAXSLOT, 1024, 512};
        pg8::MoeOrder S{nrt * 4, G, vcu, (const LAS int*)(lds + LDS_TE_OFF), (const LAS int*)(lds + LDS_TS_OFF), (const LAS int*)(lds + LDS_CNT_OFF), (const int*)(ws + WS_LTOK), 1024u};
        pg8::EpiSwiGLU E{ws + WS_H};
        pg8::gemm_phase<pg8::EpiSwiGLU, pg8::MoeOrder, true, true, true, true, 0x79797979, 0x7f7f7f7f>(lds, g, S, E);
#else
        pg8::Gemm g{(const pg8::bf16_t*)(ws + WS_XB), (const pg8::bf16_t*)(ws + WS_WGU), MAXSLOT, 1024, 1024};
        pg8::MoeOrder S{nrt * 4, G, vcu, (const LAS int*)(lds + LDS_TE_OFF), (const LAS int*)(lds + LDS_TS_OFF), (const LAS int*)(lds + LDS_CNT_OFF), (const int*)(ws + WS_LTOK), 2048u};
        pg8::EpiSwiGLU E{ws + WS_H};
        pg8::gemm_phase<pg8::EpiSwiGLU, pg8::MoeOrder, true, true, true>(lds, g, S, E);
#endif
    }
    GRID_BAR();
    REP(11) if (PH_LAST >= 10 && EN(11)) {
        pg8::Gemm g{(const pg8::bf16_t*)(ws + WS_H), (const pg8::bf16_t*)(ws + WS_WD), MAXSLOT, 1024, 256};
        pg8::MoeOrder S{nrt * 4, G, vcu, (const LAS int*)(lds + LDS_TE_OFF), (const LAS int*)(lds + LDS_TS_OFF), (const LAS int*)(lds + LDS_CNT_OFF), (const int*)(ws + WS_LTOK), 1024u};
        pg8::EpiRowScale E{(pg8::bf16_t*)(ws + WS_Y)};
        pg8::gemm_phase<pg8::EpiRowScale, pg8::MoeOrder, true, true, false, true, 0x79797979, 0x7c7c7c7c>(lds, g, S, E);
    }
    GRID_BAR();
    ST_B(12) if (PH_LAST >= 11 && EN(12)) { FRESH(); p9_phase(args, lds, vcu, G, wave, lane); }
#ifdef STAMP_PH
    GRID_BAR(); ST_E(12)
    if (STAMP_PH == 13) { st_a = rt(); GRID_BAR(); GRID_BAR(); GRID_BAR(); GRID_BAR(); st_b = rt(); }
    if (bx == 0 && tid0 == 0) { const float us = (float)(st_b - st_a) * 0.01f * STAMP_SCALE; int k = 0; float lim = 30.f; while (us >= lim && k < 12) { lim *= 1.5f; ++k; }
        __hip_atomic_store(ctl + CW_CHK, __float_as_uint(sqrtf(2.f * k + 2.f)), RLX_AGENT); }
    GRID_BAR();
    { const float c = __uint_as_float(__hip_atomic_load(ctl + CW_CHK, RLX_AGENT)); f32x4* o4 = (f32x4*)args.out;
      for (size_t i = (size_t)bx * 512 + tid0; i < (size_t)TT * DM / 4; i += (size_t)G * 512) o4[i] = (f32x4){c, c, c, c}; }
#endif
}

#ifdef PROBE_VAR
__global__ void __launch_bounds__(NWAVES * 64, 2) probe_kernel(Args args) {
    extern __shared__ __attribute__((aligned(16))) unsigned char lds_raw[];
    LAS unsigned char* lds = (LAS unsigned char*)lds_raw;
    const int tid0 = threadIdx.x, wave = __builtin_amdgcn_readfirstlane(tid0 >> 6);
    const int G = gridDim.x, bx = blockIdx.x, vcu = (G % 8 == 0) ? (bx % 8) * (G / 8) + bx / 8 : bx;
    FRESH();
    if (PROBE_VAR == 20 || PROBE_VAR == 21) {
        unsigned char* ws = args.ws;
        pg8::Gemm g{(const pg8::bf16_t*)(ws + WS_XB), (const pg8::bf16_t*)(ws + WS_WIN), TT, 4608, 1024}; pg8::StaticOrder S; S.init(TT, 4608, G, bx);
        pg8::EpiHcatT<PROBE_VAR == 21 ? 1 : 0> E{ws, (const float*)(ws + WS_ROT), 0};
        pg8::gemm_phase<pg8::EpiHcatT<PROBE_VAR == 21 ? 1 : 0>, pg8::StaticOrder, true, true>(lds, g, S, E);
    }
    if (PROBE_VAR == 10) p3_phase<0>(args, lds, vcu, G, tid, wave, lane);
    if (PROBE_VAR == 11) p3_phase<1>(args, lds, vcu, G, tid, wave, lane);
    if (PROBE_VAR == 0) attn_dil_phase<16, 0>(args, lds, vcu, G, tid, wave, lane);
    if (PROBE_VAR == 1) attn_dil_phase<16, 1>(args, lds, vcu, G, tid, wave, lane);
    if (PROBE_VAR == 2) attn_dil_phase<4, 0>(args, lds, vcu, G, tid, wave, lane);
    if (PROBE_VAR == 3) attn_dil_phase<4, 1>(args, lds, vcu, G, tid, wave, lane);
}
#endif
extern "C" void kernel_launch(void* const* d_in, const int* in_sizes, int n_in, void* d_out, int out_size, void* d_ws, size_t ws_size, hipStream_t stream) {
    static int grid = 0;
    if (grid == 0) {
        if (n_in != 20 || in_sizes[0] != TT * DM || out_size != TT * DM || ws_size < WS_END) { fprintf(stderr, "kernel_launch: unexpected shapes: n_in %d in0 %d out %d ws %zu; nothing launched\n", n_in, n_in > 0 ? in_sizes[0] : -1, out_size, ws_size); grid = -1; return; }
        int dev = 0, cus = 0;
        if (hipGetDevice(&dev) != hipSuccess || hipDeviceGetAttribute(&cus, hipDeviceAttributeMultiprocessorCount, dev) != hipSuccess) { grid = -1; return; }
        if (hipFuncSetAttribute((const void*)mega_fwd, hipFuncAttributeMaxDynamicSharedMemorySize, LDS_BYTES) != hipSuccess) { fprintf(stderr, "kernel_launch: hipFuncSetAttribute failed\n"); grid = -1; return; }
        (void)hipGetLastError();
        grid = cus;
    }
    if (grid < 0) return;
    if (hipMemsetAsync((char*)d_ws, 0, CTL_ZERO_BYTES, stream) != hipSuccess) return;
    Args a{};
    for (int i = 0; i < 20; ++i) a.in[i] = (const float*)d_in[i];
    a.out = (float*)d_out; a.ws = (unsigned char*)d_ws; a.mask = 0x80007fffu; a.bar_region = 0;
#if defined(XTRA_FIRST)
    { Args x = a; x.mask = XTRA_FIRST; x.bar_region = 1; for (int r = 0; r < XTRA_REP; ++r) hipLaunchKernelGGL(mega_fwd, dim3(grid), dim3(NWAVES * 64), LDS_BYTES, stream, x);
      if (hipMemsetAsync((char*)d_ws, 0, CTL_ZERO_BYTES, stream) != hipSuccess) return; }
#endif
    hipLaunchKernelGGL(mega_fwd, dim3(grid), dim3(NWAVES * 64), LDS_BYTES, stream, a);
#if defined(PROBE_VAR)
    { hipFuncSetAttribute((const void*)probe_kernel, hipFuncAttributeMaxDynamicSharedMemorySize, LDS_BYTES);
      for (int r = 0; r < 4; ++r) hipLaunchKernelGGL(probe_kernel, dim3(grid), dim3(NWAVES * 64), LDS_BYTES, stream, a); }
#endif
#if defined(XTRA_AFTER)
    { Args x = a; x.mask = XTRA_AFTER; x.bar_region = 1; for (int r = 0; r < XTRA_REP; ++r) hipLaunchKernelGGL(mega_fwd, dim3(grid), dim3(NWAVES * 64), LDS_BYTES, stream, x); }
#endif
}
```

```cpp
#define M1_FP8 1
#include <hip/hip_runtime.h>
#include <cstdio>
#include <cstdint>

constexpr int TT = 32768, DM = 1024, SEQ = 2048, NB = 16;
constexpr float DN_ALPHA = 1.189207115002721f;
constexpr float LN_EPSF = 1e-5f;
constexpr size_t MiB = 1u << 20;
constexpr size_t CTL_ZERO_BYTES = 1 * MiB;
constexpr size_t WS_ROT = 1 * MiB;
constexpr size_t WS_BIAS = 2 * MiB;
constexpr size_t WS_LTOK = 3 * MiB;
constexpr size_t WS_TINFO = 7 * MiB;
constexpr size_t WS_WSLOT = 7 * MiB + 512 * 1024;
constexpr size_t WS_WIN = 8 * MiB;
constexpr size_t WS_WR = 21 * MiB;
constexpr size_t WS_WA = 23 * MiB;
constexpr size_t WS_WO = 24 * MiB;
constexpr size_t WS_WGU = 26 * MiB;
constexpr size_t WS_WD = 58 * MiB;
constexpr size_t WS_XB = 80 * MiB;
constexpr size_t WS_QR = 144 * MiB;
constexpr size_t WS_KR = 176 * MiB;
constexpr size_t WS_VR = 208 * MiB;
constexpr size_t WS_GR = 272 * MiB;
constexpr size_t WS_QA = 336 * MiB, WS_KA = 368 * MiB, WS_VA = 400 * MiB, WS_OA = 432 * MiB;
constexpr size_t WS_GATE_R = 144 * MiB, WS_GATE_A = 208 * MiB;
constexpr size_t WS_MERGED = 336 * MiB;
constexpr size_t WS_Y = 144 * MiB;
constexpr size_t WS_H = 336 * MiB;
constexpr size_t WS_X1F8 = 464 * MiB;
constexpr size_t WS_O2 = 26 * MiB;
constexpr size_t WS_O3 = 464 * MiB;
constexpr size_t WS_LSE2 = 496 * MiB, WS_LSE3 = 497 * MiB;
constexpr size_t WS_END = 512 * MiB;
#ifndef M1_FP8
#define M1_FP8 0
#endif
constexpr int MAXSLOT = 69632;
constexpr int CW_BAR = 4096;
constexpr int CW_CNT = 16384;
constexpr int CW_CHK = 24576;
namespace pg8 {
#define PG8_LAS __attribute__((address_space(3)))
typedef unsigned short bf16_t;
typedef short bf16x8 __attribute__((ext_vector_type(8)));
typedef float f32x4 __attribute__((ext_vector_type(4)));
typedef unsigned u32x4 __attribute__((ext_vector_type(4)));
constexpr int BM = 256, BK = 64, HALF = 128, HTB = HALF * BK * 2  , STAGE_BYTES = 8 * HTB, NXCD = 8, WGM = 8;

__device__ __forceinline__ int lane_id() { int x; asm volatile("v_mbcnt_lo_u32_b32 %0, -1, 0\n\tv_mbcnt_hi_u32_b32 %0, -1, %0" : "=v"(x)); return x; }
__host__ __device__ __forceinline__ int lds_byte(int r, int c) { const int st = (r >> 4) * 2 + (c >> 5), rr = r & 15, cc = c & 31, ob = rr * 64 + cc * 2; return st * 1024 + (ob ^ (((ob >> 9) & 1) << 5)); }
__host__ __device__ __forceinline__ void stage_rc(int b, int& R, int& C) { const int st = b / 1024, sb = b % 1024, swz = sb ^ (((sb >> 9) & 1) << 5); R = (st >> 1) * 16 + swz / 64; C = (st & 1) * 32 + (swz % 64) / 2; }
__host__ __device__ __forceinline__ int perm32(int rho) { const int n = rho >> 4, i = rho & 15; return 8 * (i >> 2) + 4 * n + (i & 3); }

struct Unit { int pm, pn; };
struct Gemm { const bf16_t* A; const bf16_t* Bt; int M, N, K; };

struct StaticOrder {
    int nM, nN, nwg, G, c;
    __host__ __device__ void init(int M, int N, int G_, int c_) { nM = M / BM; nN = N / BM; nwg = nM * nN; G = G_; c = c_; }
    __host__ __device__ bool next(int i, Unit& u) const {
        const long L = (long)i * G + c; if (L >= nwg) return false;
        int wgid = (int)L; { const int q = nwg / NXCD, r = nwg % NXCD, xcd = wgid % NXCD, off = wgid / NXCD; wgid = (xcd < r ? xcd * (q + 1) : r * (q + 1) + (xcd - r) * q) + off; }
        const int nig = WGM * nN, gid = wgid / nig, fm = gid * WGM, gsz = (nM - fm) < WGM ? (nM - fm) : WGM;
        u.pm = fm + ((wgid % nig) % gsz); u.pn = (wgid % nig) / gsz; return true;
    }
    __device__ __forceinline__ void a_ready(const Unit&) const {}
    __device__ __forceinline__ void done(const Unit&) const {}
};

__device__ __forceinline__ unsigned cvt_pk_bf16(float lo, float hi) { unsigned r; asm volatile("v_cvt_pk_bf16_f32 %0, %1, %2" : "=v"(r) : "v"(lo), "v"(hi)); return r; }
typedef float cvt_f32x2_t __attribute__((ext_vector_type(2))); typedef __bf16 cvt_bf16x2_t __attribute__((ext_vector_type(2)));
__device__ __forceinline__ unsigned cvt_pk_bf16_acc(float lo, float hi) { const cvt_f32x2_t v = {lo, hi}; const cvt_bf16x2_t b = __builtin_convertvector(v, cvt_bf16x2_t); return __builtin_bit_cast(unsigned, b); }
__device__ __forceinline__ float bflo(unsigned w) { return __uint_as_float(w << 16); }
__device__ __forceinline__ float bfhi(unsigned w) { return __uint_as_float(w & 0xffff0000u); }
__device__ __forceinline__ float fsigmoid(float x) { return __builtin_amdgcn_rcpf(1.f + __expf(-x)); }
__device__ __forceinline__ float fsilu(float x) { return x * __builtin_amdgcn_rcpf(1.f + __expf(-x)); }

template <int VAR = 0> struct EpiHcatT {
    static constexpr bool PERM = true, AFTER_DRAIN = false; static constexpr int NSTORE = 16;
    unsigned char* ws; const float* rot; int tile_off;
    __device__ __forceinline__ void operator()(const f32x4 (&acc)[2][2][4][2], const Unit& u, int wr, int wc, int fr, int fq) const {
        if (VAR == 1) {
            float s = 0.f;
#pragma unroll
            for (int ai = 0; ai < 2; ++ai)
#pragma unroll
                for (int bj = 0; bj < 2; ++bj)
#pragma unroll
                    for (int m = 0; m < 4; ++m)
#pragma unroll
                        for (int n = 0; n < 2; ++n) s += (acc[ai][bj][m][n][0] + acc[ai][bj][m][n][1]) + (acc[ai][bj][m][n][2] + acc[ai][bj][m][n][3]);
            ((float*)(ws + WS_O3))[(size_t)(u.pm * 64 + u.pn) * 512 + wr * 256 + wc * 64 + fq * 16 + fr] = s; return;
        }
        const int gt = u.pn + tile_off;
        size_t base_off; int pitch, ct, mode; float sc = 1.f;
        if (gt < 2)       { base_off = WS_QR; pitch = 512;  ct = gt;      mode = 1; }
        else if (gt < 4)  { base_off = WS_KR; pitch = 512;  ct = gt - 2;  mode = 1; sc = 0.08838834764831845f; }
        else if (gt < 8)  { base_off = WS_VR; pitch = 1024; ct = gt - 4;  mode = 0; }
        else if (gt < 12) { base_off = WS_GR; pitch = 1024; ct = gt - 8;  mode = 2; }
        else if (gt < 14) { base_off = WS_QA; pitch = 512;  ct = gt - 12; mode = 0; sc = 0.18033688011112042f; }
        else if (gt < 16) { base_off = WS_KA; pitch = 512;  ct = gt - 14; mode = 0; }
        else if (gt < 18) { base_off = WS_VA; pitch = 512;  ct = gt - 16; mode = 0; }
        else if (gt < 22) { base_off = WS_GATE_R; pitch = 1024; ct = gt - 18; mode = 3; }
        else              { base_off = WS_GATE_A; pitch = 1024; ct = gt - 22; mode = 3; }
        bf16_t* O = (bf16_t*)(ws + base_off);
        const int row0 = u.pm * BM + wr * 64 + fr, col0 = ct * BM + wc * 32 + 8 * fq;
#pragma unroll
        for (int ai = 0; ai < 2; ++ai)
#pragma unroll
            for (int m = 0; m < 4; ++m) {
                const int row = row0 + ai * HALF + m * 16;
                bf16_t* rowp = O + (size_t)row * pitch + col0;
                f32x4 cs = (f32x4){1.f, 1.f, 1.f, 1.f}, sn = (f32x4){0.f, 0.f, 0.f, 0.f};
                if (mode == 1) { const f32x4* rt = (const f32x4*)(rot + ((size_t)(row & (SEQ - 1)) * 16 + (4 * wc + fq)) * 8); cs = rt[0]; sn = rt[1]; }
#pragma unroll
                for (int bj = 0; bj < 2; ++bj) {
                    f32x4 v0 = acc[ai][bj][m][0], v1 = acc[ai][bj][m][1];
                    if (mode == 1) { const f32x4 a = v0 * cs - v1 * sn, b = v0 * sn + v1 * cs; v0 = a * sc; v1 = b * sc; }
                    else if (mode == 2) {
#pragma unroll
                        for (int e = 0; e < 4; ++e) { v0[e] = fsilu(v0[e]); v1[e] = fsilu(v1[e]); } }
                    else if (mode == 3) {
#pragma unroll
                        for (int e = 0; e < 4; ++e) { v0[e] = fsigmoid(v0[e]); v1[e] = fsigmoid(v1[e]); } }
                    else { v0 = v0 * sc; v1 = v1 * sc; }
                    u32x4 w; w.x = cvt_pk_bf16(v0[0], v0[1]); w.y = cvt_pk_bf16(v0[2], v0[3]); w.z = cvt_pk_bf16(v1[0], v1[1]); w.w = cvt_pk_bf16(v1[2], v1[3]);
                    *(u32x4*)(rowp + bj * HALF) = w;
                }
            }
    }
};

typedef EpiHcatT<0> EpiHcat;

template <bool ADD> struct EpiGate {
    static constexpr bool PERM = true, AFTER_DRAIN = false; static constexpr int NSTORE = 16;
    const bf16_t* gate; bf16_t* O;
    __device__ __forceinline__ void operator()(const f32x4 (&acc)[2][2][4][2], const Unit& u, int wr, int wc, int fr, int fq) const {
        const int row0 = u.pm * BM + wr * 64 + fr, col0 = u.pn * BM + wc * 32 + 8 * fq;
#pragma unroll
        for (int ai = 0; ai < 2; ++ai)
#pragma unroll
            for (int m = 0; m < 4; ++m)
#pragma unroll
                for (int bj = 0; bj < 2; ++bj) {
                    const size_t p = (size_t)(row0 + ai * HALF + m * 16) * 1024 + col0 + bj * HALF;
                    const u32x4 g = *(const u32x4*)(gate + p);
                    f32x4 v0 = acc[ai][bj][m][0], v1 = acc[ai][bj][m][1];
                    v0[0] *= bflo(g.x); v0[1] *= bfhi(g.x); v0[2] *= bflo(g.y); v0[3] *= bfhi(g.y);
                    v1[0] *= bflo(g.z); v1[1] *= bfhi(g.z); v1[2] *= bflo(g.w); v1[3] *= bfhi(g.w);
                    if (ADD) { const u32x4 o = *(const u32x4*)(O + p);
                        v0[0] += bflo(o.x); v0[1] += bfhi(o.x); v0[2] += bflo(o.y); v0[3] += bfhi(o.y);
                        v1[0] += bflo(o.z); v1[1] += bfhi(o.z); v1[2] += bflo(o.w); v1[3] += bfhi(o.w); }
                    u32x4 w; w.x = cvt_pk_bf16(v0[0], v0[1]); w.y = cvt_pk_bf16(v0[2], v0[3]); w.z = cvt_pk_bf16(v1[0], v1[1]); w.w = cvt_pk_bf16(v1[2], v1[3]);
                    *(u32x4*)(O + p) = w;
                }
    }
};

struct EpiResBf16 {
    static constexpr bool PERM = true, AFTER_DRAIN = false; static constexpr int NSTORE = 16;
    const bf16_t* x; bf16_t* out; float alpha;
    __device__ __forceinline__ void operator()(const f32x4 (&acc)[2][2][4][2], const Unit& u, int wr, int wc, int fr, int fq) const {
        const int row0 = u.pm * BM + wr * 64 + fr, col0 = u.pn * BM + wc * 32 + 8 * fq;
#pragma unroll
        for (int ai = 0; ai < 2; ++ai)
#pragma unroll
            for (int m = 0; m < 4; ++m)
#pragma unroll
                for (int bj = 0; bj < 2; ++bj) {
                    const size_t p = (size_t)(row0 + ai * HALF + m * 16) * 1024 + col0 + bj * HALF;
                    const u32x4 xw = *(const u32x4*)(x + p);
                    const f32x4 x0 = (f32x4){bflo(xw.x), bfhi(xw.x), bflo(xw.y), bfhi(xw.y)}, x1 = (f32x4){bflo(xw.z), bfhi(xw.z), bflo(xw.w), bfhi(xw.w)};
                    const f32x4 v0 = x0 * alpha + acc[ai][bj][m][0], v1 = x1 * alpha + acc[ai][bj][m][1];
                    u32x4 w; w.x = cvt_pk_bf16(v0[0], v0[1]); w.y = cvt_pk_bf16(v0[2], v0[3]); w.z = cvt_pk_bf16(v1[0], v1[1]); w.w = cvt_pk_bf16(v1[2], v1[3]);
                    *(u32x4*)(out + p) = w;
                }
    }
};

struct EpiSwiGLU {
    static constexpr bool PERM = true, AFTER_DRAIN = false; static constexpr int NSTORE = 16;
    unsigned char* H;
    __device__ __forceinline__ void operator()(const f32x4 (&acc)[2][2][4][2], const Unit& u, int wr, int wc, int fr, int fq) const {
        const int row0 = u.pm * BM + wr * 64 + fr, col0 = (u.pn & 3) * 128 + wc * 16 + 4 * fq;
#pragma unroll
        for (int ai = 0; ai < 2; ++ai)
#pragma unroll
            for (int m = 0; m < 4; ++m)
#pragma unroll
                for (int bj = 0; bj < 2; ++bj) {
                    const f32x4 g = acc[ai][bj][m][0], up = acc[ai][bj][m][1];
                    float h0 = fsilu(g[0]) * up[0] * 8.f, h1 = fsilu(g[1]) * up[1] * 8.f, h2 = fsilu(g[2]) * up[2] * 8.f, h3 = fsilu(g[3]) * up[3] * 8.f;
                    h0 = fminf(fmaxf(h0, -448.f), 448.f); h1 = fminf(fmaxf(h1, -448.f), 448.f); h2 = fminf(fmaxf(h2, -448.f), 448.f); h3 = fminf(fmaxf(h3, -448.f), 448.f);
                    unsigned w = 0u; w = __builtin_amdgcn_cvt_pk_fp8_f32(h0, h1, w, false); w = __builtin_amdgcn_cvt_pk_fp8_f32(h2, h3, w, true);
                    *(unsigned*)(H + (size_t)(row0 + ai * HALF + m * 16) * 512 + col0 + bj * 64) = w;
                }
    }
};

struct EpiRowScale {
    static constexpr bool PERM = true, AFTER_DRAIN = false; static constexpr int NSTORE = 16;
    bf16_t* Y;
    __device__ __forceinline__ void operator()(const f32x4 (&acc)[2][2][4][2], const Unit& u, int wr, int wc, int fr, int fq) const {
        const int row0 = u.pm * BM + wr * 64 + fr, col0 = (u.pn & 3) * BM + wc * 32 + 8 * fq;
#pragma unroll
        for (int ai = 0; ai < 2; ++ai)
#pragma unroll
            for (int m = 0; m < 4; ++m) {
                const int row = row0 + ai * HALF + m * 16;
#pragma unroll
                for (int bj = 0; bj < 2; ++bj) {
                    const f32x4 v0 = acc[ai][bj][m][0], v1 = acc[ai][bj][m][1];
                    u32x4 w; w.x = cvt_pk_bf16_acc(v0[0], v0[1]); w.y = cvt_pk_bf16_acc(v0[2], v0[3]); w.z = cvt_pk_bf16_acc(v1[0], v1[1]); w.w = cvt_pk_bf16_acc(v1[2], v1[3]);
                    *(u32x4*)(Y + (size_t)row * 1024 + col0 + bj * HALF) = w;
                }
            }
    }
};

struct MoeOrder {
    int nunits, G, c; const PG8_LAS int* te; const PG8_LAS int* ts; const PG8_LAS int* cnt; const int* ltok; unsigned rowbytes;
    __device__ __forceinline__ bool next(int i, Unit& u) const {
        const int L = i * G + c, rt = (L >> 5) * 8 + (L & 7); if (rt >= (nunits >> 2)) return false;
        u.pm = rt; u.pn = te[rt] * 4 + ((L >> 3) & 3); return true;
    }
    __device__ __forceinline__ unsigned a_row_off(const Unit& u, int row) const {
        const int ex = te[u.pm], pos = (u.pm - ts[ex]) * 256 + row;
        const int tok = pos < cnt[ex] ? ltok[ex * 32768 + pos] : 0;
        return (unsigned)tok * rowbytes;
    }
    __device__ __forceinline__ void a_ready(const Unit&) const {}
    __device__ __forceinline__ void done(const Unit&) const {}
};

struct GateOrder {
    StaticOrder S4;
    __device__ __forceinline__ bool next(int i, Unit& u) const { Unit t; if (!S4.next(i >> 1, t)) return false; u.pm = t.pm; u.pn = t.pn + 4 * (i & 1); return true; }
    __device__ __forceinline__ void a_ready(const Unit&) const {}
    __device__ __forceinline__ void done(const Unit&) const {}
};

template <class Epi, class Sched, bool ALIGN_EPI = false, bool SP2 = false, bool GATHER = false, bool FP8 = false, int SEL_W = 0, int SEL_X = 0>
__device__ __forceinline__ void gemm_phase(PG8_LAS unsigned char* lds, const Gemm g, const Sched& S, const Epi& E, const int wid) {
    int tid = wid * 64 + lane_id(); asm volatile("" : "+v"(tid));
    const int lane = tid & 63, wr = wid >> 2, wc = wid & 3, fr = lane & 15, fq = lane >> 4;
    static_assert(SP2, "only the two-super-phase loop is kept");
    typedef int i32x4_ __attribute__((ext_vector_type(4)));
    const int K = g.K, nt = K / BK;
    unsigned voffB[2]; int rA[2], cA2[2];
#pragma unroll
    for (int i = 0; i < 2; ++i) { int R, C; stage_rc(tid * 16 + i * 8192, R, C); const int Rb = Epi::PERM ? ((R & ~31) + perm32(R & 31)) : R;
        rA[i] = R; cA2[i] = C * 2; voffB[i] = (unsigned)(Rb * K + C) * 2u; }
    unsigned vAc[2][2], vAn[2][2];
    const size_t kstep = (size_t)(BK * 2);
    const size_t hstep = (size_t)HALF * K * 2;
    const size_t tstep = 2 * hstep;
    const unsigned ldsw = (unsigned)wid * 1024u;
    const int aoff0 = lds_byte(wr * 64 + fr, fq * 8), aoff1 = aoff0 + 1024;
    const int boff0 = lds_byte(wc * 32 + fr, fq * 8), boff1 = boff0 + 1024;
#define PG8_SA(b, h) (((b) * 2 + (h)) * HTB)
#define PG8_SB(b, h) ((4 + (b) * 2 + (h)) * HTB)
#define PG8_STAGE(bufoff, gbase, voff) do { _Pragma("unroll") for (int _i = 0; _i < 2; ++_i) \
        __builtin_amdgcn_global_load_lds((const unsigned*)((const char*)(gbase) + (voff)[_i]), (PG8_LAS unsigned*)(lds + (bufoff) + ldsw + _i * 8192), 16, 0, 0); } while (0)
#define PG8_LDA(dst, b, h) do { _Pragma("unroll") for (int m = 0; m < 4; ++m) { dst[m][0] = *(const PG8_LAS bf16x8*)(lds + PG8_SA(b, h) + aoff0 + m * 2048); dst[m][1] = *(const PG8_LAS bf16x8*)(lds + PG8_SA(b, h) + aoff1 + m * 2048); } } while (0)
#define PG8_LDB(dst, b, h) do { _Pragma("unroll") for (int n = 0; n < 2; ++n) { dst[n][0] = *(const PG8_LAS bf16x8*)(lds + PG8_SB(b, h) + boff0 + n * 2048); dst[n][1] = *(const PG8_LAS bf16x8*)(lds + PG8_SB(b, h) + boff1 + n * 2048); } } while (0)
#define PG8_CAT8(x) __builtin_shufflevector(__builtin_bit_cast(i32x4_, (x)[0]), __builtin_bit_cast(i32x4_, (x)[1]), 0, 1, 2, 3, 4, 5, 6, 7)
#define PG8_MMA(ai, bj, At, Bt) do { __builtin_amdgcn_s_setprio(1); \
        if constexpr (FP8) { _Pragma("unroll") for (int m = 0; m < 4; ++m) _Pragma("unroll") for (int n = 0; n < 2; ++n) \
            acc[ai][bj][m][n] = __builtin_amdgcn_mfma_scale_f32_16x16x128_f8f6f4(PG8_CAT8(Bt[n]), PG8_CAT8(At[m]), acc[ai][bj][m][n], 0, 0, SEL_W, scl, SEL_X, scl); \
            asm volatile("" : "+v"(acc[ai][bj][0][0]), "+v"(acc[ai][bj][0][1]), "+v"(acc[ai][bj][1][0]), "+v"(acc[ai][bj][1][1]), "+v"(acc[ai][bj][2][0]), "+v"(acc[ai][bj][2][1]), "+v"(acc[ai][bj][3][0]), "+v"(acc[ai][bj][3][1])); } \
        else { _Pragma("unroll") for (int m = 0; m < 4; ++m) _Pragma("unroll") for (int n = 0; n < 2; ++n) _Pragma("unroll") for (int k = 0; k < 2; ++k) \
            acc[ai][bj][m][n] = __builtin_amdgcn_mfma_f32_16x16x32_bf16(Bt[n][k], At[m][k], acc[ai][bj][m][n], 0, 0, 0); } \
        __builtin_amdgcn_s_setprio(0); } while (0)
#define PG8_WAIT_V(n) asm volatile("s_waitcnt vmcnt(" #n ")" ::: "memory")
#define PG8_WAIT_VN(n) asm volatile("s_waitcnt vmcnt(%0)" :: "i"(n) : "memory")
#define PG8_WAIT_L(n) asm volatile("s_waitcnt lgkmcnt(" #n ")" ::: "memory")
#define PG8_BAR __builtin_amdgcn_s_barrier()
#define PG8_SCHED __builtin_amdgcn_sched_barrier(0)
    [[maybe_unused]] int scl = 0x7f7c797f; asm volatile("" : "+v"(scl));
    Unit cur, nxt; int ui = 0;
    if (!S.next(0, cur)) return;
    f32x4 acc[2][2][4][2];
#pragma unroll
    for (int a = 0; a < 2; ++a)
#pragma unroll
        for (int b = 0; b < 2; ++b)
#pragma unroll
            for (int m = 0; m < 4; ++m)
#pragma unroll
                for (int n = 0; n < 2; ++n) acc[a][b][m][n] = (f32x4){0.f, 0.f, 0.f, 0.f};
    bf16x8 At[4][2], B0[2][2], B1[2][2];
    const char* cA = GATHER ? (const char*)g.A : (const char*)g.A + (size_t)cur.pm * tstep; const char* cB = (const char*)g.Bt + (size_t)cur.pn * tstep;
#pragma unroll
    for (int h = 0; h < 2; ++h)
#pragma unroll
        for (int i = 0; i < 2; ++i) { if constexpr (GATHER) vAc[h][i] = S.a_row_off(cur, h * HALF + rA[i]) + (unsigned)cA2[i]; else vAc[h][i] = (unsigned)((h * HALF + rA[i]) * K) * 2u + (unsigned)cA2[i]; vAn[h][i] = vAc[h][i]; }
    S.a_ready(cur);
    if constexpr (SP2) {
        PG8_STAGE(PG8_SB(0, 0), cB, voffB); PG8_STAGE(PG8_SB(0, 1), cB + hstep, voffB); PG8_STAGE(PG8_SA(0, 0), cA, vAc[0]); PG8_STAGE(PG8_SA(0, 1), cA, vAc[1]);
        if (wr == 1) PG8_BAR;
        PG8_WAIT_V(2); PG8_BAR;
        PG8_STAGE(PG8_SB(1, 0), cB + kstep, voffB); PG8_STAGE(PG8_SA(1, 0), cA + kstep, vAc[0]); PG8_STAGE(PG8_SB(1, 1), cB + hstep + kstep, voffB);
        PG8_WAIT_V(6); PG8_BAR;
    }
    for (;;) {
        const bool has_next = S.next(ui + 1, nxt);
        const char* nA = GATHER ? cA : (has_next ? (const char*)g.A + (size_t)nxt.pm * tstep : cA); const char* nB = has_next ? (const char*)g.Bt + (size_t)nxt.pn * tstep : cB;
        if constexpr (GATHER) { if (has_next) {
#pragma unroll
            for (int h = 0; h < 2; ++h)
#pragma unroll
                for (int i = 0; i < 2; ++i) vAn[h][i] = S.a_row_off(nxt, h * HALF + rA[i]) + (unsigned)cA2[i]; } }
#pragma unroll 1
        for (int t = 0; t < nt; t += 2) {
            const bool last = (t == nt - 2);
            asm volatile("" : "+v"(voffB[0]), "+v"(voffB[1]), "+v"(vAc[0][0]), "+v"(vAc[0][1]), "+v"(vAc[1][0]), "+v"(vAc[1][1]));
            const char* a1 = cA + (size_t)(t + 1) * kstep;
            const char* a2 = last ? nA : cA + (size_t)(t + 2) * kstep; const char* b2 = last ? nB : cB + (size_t)(t + 2) * kstep;
            const char* a3 = a2 + kstep; const char* b3 = b2 + kstep;
            unsigned vA2[2][2];
#pragma unroll
            for (int h = 0; h < 2; ++h)
#pragma unroll
                for (int i = 0; i < 2; ++i) vA2[h][i] = vAc[h][i];
            if constexpr (GATHER) { if (last) {
                asm volatile("" : "+v"(vAn[0][0]), "+v"(vAn[0][1]), "+v"(vAn[1][0]), "+v"(vAn[1][1]));
#pragma unroll
                for (int h = 0; h < 2; ++h)
#pragma unroll
                    for (int i = 0; i < 2; ++i) vA2[h][i] = vAn[h][i]; } }
            if (last && has_next) S.a_ready(nxt);
            if constexpr (SP2) {
            const int lenient = __builtin_amdgcn_readfirstlane((ui > 0 && t == 0) ? 1 : 0);
#define PG8_WAIT_V8L() asm volatile("s_cmp_eq_u32 %0, 0\n\ts_cbranch_scc0 .Lpg8skip%=\n\ts_waitcnt vmcnt(8)\n.Lpg8skip%=:\n\ts_waitcnt vmcnt(%1)" :: "s"(lenient), "i"(8 + Epi::NSTORE) : "memory", "scc")
            PG8_LDB(B0, 0, 0); PG8_LDB(B1, 0, 1); PG8_SCHED; PG8_LDA(At, 0, 0); PG8_STAGE(PG8_SA(1, 1), a1, vAc[1]);
            PG8_WAIT_V8L(); PG8_WAIT_L(0); PG8_BAR; PG8_MMA(0, 0, At, B0); PG8_MMA(0, 1, At, B1); PG8_BAR; PG8_SCHED;
            PG8_LDA(At, 0, 1); PG8_STAGE(PG8_SB(0, 0), b2, voffB); PG8_STAGE(PG8_SB(0, 1), b2 + hstep, voffB); PG8_STAGE(PG8_SA(0, 0), a2, vA2[0]);
            PG8_WAIT_V8L(); PG8_WAIT_L(0); PG8_BAR; PG8_MMA(1, 0, At, B0); PG8_MMA(1, 1, At, B1); PG8_BAR; PG8_SCHED;
            PG8_LDB(B0, 1, 0); PG8_LDB(B1, 1, 1); PG8_SCHED; PG8_LDA(At, 1, 0); PG8_STAGE(PG8_SA(0, 1), a2, vA2[1]);
            PG8_WAIT_V(8); PG8_WAIT_L(0); PG8_BAR; PG8_MMA(0, 0, At, B0); PG8_MMA(0, 1, At, B1); PG8_BAR; PG8_SCHED;
            PG8_LDA(At, 1, 1); PG8_STAGE(PG8_SB(1, 0), b3, voffB); PG8_STAGE(PG8_SB(1, 1), b3 + hstep, voffB); PG8_STAGE(PG8_SA(1, 0), a3, vA2[0]);
            PG8_WAIT_V(8); PG8_WAIT_L(0); PG8_BAR; PG8_MMA(1, 0, At, B0); PG8_MMA(1, 1, At, B1); PG8_BAR; PG8_SCHED;
#undef PG8_WAIT_V8L
            }
        }
        if constexpr (ALIGN_EPI) { if (wr == 0) PG8_BAR; }
        if constexpr (!Epi::AFTER_DRAIN) { E(acc, cur, wr, wc, fr, fq); S.done(cur); }
        if (!has_next) break;
#pragma unroll
        for (int a = 0; a < 2; ++a)
#pragma unroll
            for (int b = 0; b < 2; ++b)
#pragma unroll
                for (int m = 0; m < 4; ++m)
#pragma unroll
                    for (int n = 0; n < 2; ++n) acc[a][b][m][n] = (f32x4){0.f, 0.f, 0.f, 0.f};
        cur = nxt; cA = nA; cB = nB; ++ui;
        if constexpr (GATHER) {
#pragma unroll
            for (int h = 0; h < 2; ++h)
#pragma unroll
                for (int i = 0; i < 2; ++i) vAc[h][i] = vAn[h][i]; }
        if constexpr (ALIGN_EPI) { if (wr == 1) PG8_BAR; }
    }
    PG8_WAIT_V(0);
    if constexpr (!ALIGN_EPI) { if (wr == 0) PG8_BAR; }
    PG8_BAR;
    if constexpr (Epi::AFTER_DRAIN) { E.fused(acc, cur, wr, wc, fr, fq, lds, wid, lane); S.done(cur); }
#undef PG8_SA
#undef PG8_SB
#undef PG8_STAGE
#undef PG8_LDA
#undef PG8_LDB
#undef PG8_MMA
#undef PG8_CAT8
#undef PG8_WAIT_V
#undef PG8_WAIT_VN
#undef PG8_WAIT_L
#undef PG8_BAR
#undef PG8_SCHED
}
}
#define GAS __attribute__((address_space(1)))
#define LAS __attribute__((address_space(3)))
typedef unsigned short bf16;
typedef unsigned v4u __attribute__((ext_vector_type(4)));
typedef float f32x4 __attribute__((ext_vector_type(4)));
typedef short bf16x8 __attribute__((ext_vector_type(8)));
typedef GAS unsigned gu32;
typedef GAS unsigned long long gu64;
#define RLX_AGENT __ATOMIC_RELAXED, __HIP_MEMORY_SCOPE_AGENT
#define LDS_WAIT() asm volatile("s_waitcnt lgkmcnt(0)" ::: "memory")
#define VM_WAIT() asm volatile("s_waitcnt vmcnt(0)" ::: "memory")
__device__ __forceinline__ unsigned long long rt() { return __builtin_amdgcn_s_memrealtime(); }
__device__ __forceinline__ unsigned f2bf(float f) { unsigned u = __builtin_bit_cast(unsigned, f); return (u + 0x7fffu + ((u >> 16) & 1u)) >> 16; }
__device__ __forceinline__ unsigned pk2(float lo, float hi) { return f2bf(lo) | (f2bf(hi) << 16); }

#define XB_TMO      128
#define XB_XCNT(j)  (256  + 64 * (j))
#define XB_XSUB(j)  (1280 + 64 * (j))
#define XB_XGEN(j)  (2304 + 64 * (j))
#define XB_TOP      3328
#define XB_TOPGEN   3392
#define XCD_BAR_WORDS 3456
#define XB_SPIN_CAP (1u << 18)

__device__ __forceinline__ unsigned xb_ld(unsigned* p)              { return __hip_atomic_load(p, __ATOMIC_RELAXED, __HIP_MEMORY_SCOPE_AGENT); }
__device__ __forceinline__ unsigned xb_add(unsigned* p, unsigned v) { return __hip_atomic_fetch_add(p, v, __ATOMIC_RELAXED, __HIP_MEMORY_SCOPE_AGENT); }
__device__ __forceinline__ unsigned xb_xcc_id() { return (unsigned)__builtin_amdgcn_s_getreg((3 << 11) | 20) & 0xFu; }
#define XB_SPIN(cond, bar) do { unsigned _sp = 0; while (cond) { __builtin_amdgcn_s_sleep(1); \
    if ((++_sp & 255u) == 0u) { if (xb_ld(&(bar)[XB_TMO])) break; if (_sp > XB_SPIN_CAP) { atomicAdd(&(bar)[XB_TMO], 1u); break; } } } } while (0)

struct XcdBarrier {
    unsigned* bar; unsigned x; int wv;
    volatile LAS unsigned* st;
};

__device__ __forceinline__ XcdBarrier xcd_barrier_post(unsigned* bar, volatile LAS unsigned* st) {
    XcdBarrier b; b.bar = bar; b.x = xb_xcc_id(); b.st = st; b.wv = 0;
    if (threadIdx.x == 0) (void)xb_add(&bar[XB_XCNT(b.x)], 1u);
    return b;
}
__device__ __forceinline__ void xcd_barrier_complete(unsigned* bar, unsigned x, unsigned& nloc, unsigned& nx) {
    const unsigned G = gridDim.x * gridDim.y * gridDim.z;
    unsigned sum, cnt, mine, sp = 0u;
    for (;;) {
        sum = 0u; cnt = 0u; mine = 0u;
#pragma unroll
        for (unsigned j = 0; j < 16; ++j) { const unsigned c = xb_ld(&bar[XB_XCNT(j)]); sum += c; cnt += (c > 0u) ? 1u : 0u; mine = (j == x) ? c : mine; }
        if (sum == G) break;
        __builtin_amdgcn_s_sleep(1);
        if ((++sp & 255u) == 0u) { if (xb_ld(&bar[XB_TMO])) break; if (sp > XB_SPIN_CAP) { atomicAdd(&bar[XB_TMO], 1u); break; } }
    }
    nloc = mine > 0u ? mine : 1u; nx = cnt > 0u ? cnt : 1u;
}

__device__ __forceinline__ void xcd_barrier(const XcdBarrier& b) {
    asm volatile("s_waitcnt vmcnt(0)" ::: "memory");
    __syncthreads();
    if (b.wv == 0 && (int)__builtin_amdgcn_mbcnt_hi(~0u, __builtin_amdgcn_mbcnt_lo(~0u, 0u)) == 0) {
        unsigned* bar = b.bar;
        __builtin_amdgcn_s_waitcnt(0);
        unsigned nloc = b.st[0], nx = b.st[1];
        if (nloc == 0u) { xcd_barrier_complete(bar, b.x, nloc, nx); b.st[0] = nloc; b.st[1] = nx; }
        const unsigned old = xb_add(&bar[XB_XSUB(b.x)], 1u);
        const unsigned gen = old / nloc;
        if (old + 1u == (gen + 1u) * nloc) {
            __builtin_amdgcn_fence(__ATOMIC_RELEASE, "agent");
            asm volatile("s_waitcnt vmcnt(0)" ::: "memory");
            const unsigned og = xb_add(&bar[XB_TOP], 1u);
            const unsigned tg = og / nx;
            if (og + 1u == (tg + 1u) * nx) xb_add(&bar[XB_TOPGEN], 1u);
            else XB_SPIN(xb_ld(&bar[XB_TOPGEN]) == tg, bar);
            __builtin_amdgcn_fence(__ATOMIC_ACQUIRE, "agent");
            xb_add(&bar[XB_XGEN(b.x)], 1u);
            asm volatile("s_waitcnt vmcnt(0)" ::: "memory");
        } else {
            XB_SPIN(xb_ld(&bar[XB_XGEN(b.x)]) == gen, bar);
            __builtin_amdgcn_fence(__ATOMIC_ACQUIRE, "agent");
            asm volatile("s_waitcnt vmcnt(0)" ::: "memory");
        }
    }
    __syncthreads();
}


constexpr int NWAVES = 8;
constexpr int RING_BYTES = 131072;
constexpr int LDSCTL_OFF = RING_BYTES, MISC_OFF = LDSCTL_OFF + 320;
constexpr int LDS_TS_OFF = LDSCTL_OFF + 1024;
constexpr int LDS_TE_OFF = LDSCTL_OFF + 2048;
constexpr int LDS_CNT_OFF = LDSCTL_OFF + 1024 + 128;
constexpr int LDS_BYTES = 163840;

typedef short s16x4 __attribute__((ext_vector_type(4)));
typedef unsigned u32x2 __attribute__((ext_vector_type(2)));

struct Args { const float* in[20]; float* out; unsigned char* ws; unsigned mask; int bar_region; };

__device__ __forceinline__ float bflo(unsigned w) { return __uint_as_float(w << 16); }
__device__ __forceinline__ float bfhi(unsigned w) { return __uint_as_float(w & 0xffff0000u); }
__device__ __forceinline__ unsigned cvtpk(float lo, float hi) { return pg8::cvt_pk_bf16(lo, hi); }
__device__ __forceinline__ float wave_sum(float v) {
#pragma unroll
    for (int o = 1; o < 64; o <<= 1) v += __shfl_xor(v, o);
    return v;
}
__device__ __forceinline__ unsigned offb(unsigned row, unsigned ch) { return 256u * row + 16u * (ch ^ (((row & 3u) << 2) | ((row >> 2) & 3u))); }
__device__ __forceinline__ s16x4 ldtr(const LAS unsigned char* p) { return __builtin_amdgcn_ds_read_tr16_b64_v4i16((LAS s16x4*)p); }
__device__ __forceinline__ bf16x8 cat8(s16x4 a, s16x4 b) { return (bf16x8){a[0], a[1], a[2], a[3], b[0], b[1], b[2], b[3]}; }
#define MFMA16(a, b, c) __builtin_amdgcn_mfma_f32_16x16x32_bf16((a), (b), (c), 0, 0, 0)

template <int MODE> __device__ __forceinline__ int dest_row(int n) {
    if (MODE == 1) { if (n >= 1024) return n; const int hb = n & ~127, d = n & 127, jr = d & 63, half = d >> 6; return hb + 8 * (jr >> 2) + 4 * half + (jr & 3); }
    if (MODE == 2) return ((n >> 2) << 3) + (n & 3);
    if (MODE == 3) return ((n >> 2) << 3) + 4 + (n & 3);
    return n;
}
template <int MODE> __device__ __forceinline__ void p0_transpose_item(const float* W, int K, int N, bf16* WT, LAS float* scr, int item, int lane) {
    const int nblk = N / 32, kb = item / nblk, nb = item % nblk, k0 = 64 * kb, n0 = 32 * nb;
    {
        const GAS f32x4* src = (const GAS f32x4*)(W + (size_t)(k0 + (lane >> 3)) * N + n0) + (lane & 7);
        f32x4 t[8];
#pragma unroll
        for (int j = 0; j < 8; ++j) t[j] = src[(size_t)j * 2 * N];
#pragma unroll
        for (int j = 0; j < 8; ++j) { LAS float* d = scr + ((lane >> 3) + 8 * j) * 33 + 4 * (lane & 7); d[0] = t[j].x; d[1] = t[j].y; d[2] = t[j].z; d[3] = t[j].w; }
    }
    LDS_WAIT(); asm volatile("" ::: "memory");
    const int c = lane & 7;
#pragma unroll
    for (int j = 0; j < 4; ++j) { const int n = (lane >> 3) + 8 * j; const LAS float* s = scr + (8 * c) * 33 + n;
        v4u o; o.x = pk2(s[0 * 33], s[1 * 33]); o.y = pk2(s[2 * 33], s[3 * 33]); o.z = pk2(s[4 * 33], s[5 * 33]); o.w = pk2(s[6 * 33], s[7 * 33]);
        *(GAS v4u*)(WT + (size_t)dest_row<MODE>(n0 + n) * K + k0 + 8 * c) = o; }
    LDS_WAIT(); asm volatile("" ::: "memory");
}
__device__ __forceinline__ unsigned pk_fp8x4(float a, float b, float c, float d) {
    a = fminf(fmaxf(a, -448.f), 448.f); b = fminf(fmaxf(b, -448.f), 448.f); c = fminf(fmaxf(c, -448.f), 448.f); d = fminf(fmaxf(d, -448.f), 448.f);
    unsigned w = 0u; w = __builtin_amdgcn_cvt_pk_fp8_f32(a, b, w, false); w = __builtin_amdgcn_cvt_pk_fp8_f32(c, d, w, true); return w;
}
template <int MODE> __device__ __forceinline__ void p0_transpose_item_fp8(const float* W, int K, int N, unsigned char* WT, LAS float* scr, int item, int lane, float scale) {
    const int nblk = N / 32, kb = item / nblk, nb = item % nblk, k0 = 64 * kb, n0 = 32 * nb;
    {
        const GAS f32x4* src = (const GAS f32x4*)(W + (size_t)(k0 + (lane >> 3)) * N + n0) + (lane & 7);
        f32x4 t[8];
#pragma unroll
        for (int j = 0; j < 8; ++j) t[j] = src[(size_t)j * 2 * N];
#pragma unroll
        for (int j = 0; j < 8; ++j) { LAS float* d = scr + ((lane >> 3) + 8 * j) * 33 + 4 * (lane & 7); d[0] = t[j].x; d[1] = t[j].y; d[2] = t[j].z; d[3] = t[j].w; }
    }
    LDS_WAIT(); asm volatile("" ::: "memory");
    const int c = lane & 7;
#pragma unroll
    for (int j = 0; j < 4; ++j) { const int n = (lane >> 3) + 8 * j; const LAS float* s = scr + (8 * c) * 33 + n;
        u32x2 o; o.x = pk_fp8x4(s[0 * 33] * scale, s[1 * 33] * scale, s[2 * 33] * scale, s[3 * 33] * scale); o.y = pk_fp8x4(s[4 * 33] * scale, s[5 * 33] * scale, s[6 * 33] * scale, s[7 * 33] * scale);
        *(GAS u32x2*)(WT + (size_t)dest_row<MODE>(n0 + n) * K + k0 + 8 * c) = o; }
    LDS_WAIT(); asm volatile("" ::: "memory");
}
__device__ __forceinline__ int t5_bucket(int rel) {
    const int n = rel < 0 ? -rel : rel;
    int large = 8 + (n >= 15) + (n >= 27) + (n >= 50) + (n >= 91) + (n >= 166) + (n >= 305) + (n >= 559);
    large = large < 15 ? large : 15;
    return (rel > 0 ? 16 : 0) + (n < 8 ? n : large);
}
__device__ __forceinline__ void p0_prologue(const Args& a, LAS unsigned char* lds, int vcu, int G, int tid, int wave, int lane) {
    unsigned char* ws = a.ws;
    LAS float* scr = (LAS float*)(lds + wave * 16384);
    const int gw = vcu * NWAVES + wave, NGW = G * NWAVES;
    constexpr int I_IN = 16 * 208, I_R = 16 * 32, I_A = 8 * 32, I_O = 16 * 32;
    constexpr int NITEMS = I_IN + I_R + I_A + I_O;
    for (int it = gw; it < NITEMS; it += NGW) {
        int r = it;
        if (r < I_IN) { p0_transpose_item<1>(a.in[1], 1024, 6656, (bf16*)(ws + WS_WIN), scr, r, lane); continue; } r -= I_IN;
        if (r < I_R) { p0_transpose_item<0>(a.in[5], 1024, 1024, (bf16*)(ws + WS_WR), scr, r, lane); continue; } r -= I_R;
        if (r < I_A) { p0_transpose_item<0>(a.in[7], 512, 1024, (bf16*)(ws + WS_WA), scr, r, lane); continue; } r -= I_A;
        p0_transpose_item<0>(a.in[8], 1024, 1024, (bf16*)(ws + WS_WO), scr, r, lane);
    }
    {
        const f32x4* x4 = (const f32x4*)a.in[0]; u32x2* xb = (u32x2*)(ws + WS_XB);
        for (size_t i = (size_t)vcu * 512 + tid; i < (size_t)TT * DM / 4; i += (size_t)G * 512) { const f32x4 v = x4[i]; u32x2 o; o.x = cvtpk(v.x, v.y); o.y = cvtpk(v.z, v.w); xb[i] = o; }
    }
    {
        float* rot = (float*)(ws + WS_ROT);
        for (int idx = vcu * 512 + tid; idx < SEQ * 64; idx += G * 512) {
            const int pos = idx >> 6, jr = idx & 63;
            double iv = 1.0; for (int k = 0; k < jr; ++k) iv *= 0.86596432336006535;
            const float ang = (float)pos * (float)iv;
            const double xx = (double)ang; const double qd = __builtin_rint(xx * 0.63661977236758134); const int qi = (int)qd;
            const double r = (xx - qd * 1.5707963267948966) - qd * 6.123233995736766e-17, r2 = r * r;
            const double sp = r * (1.0 + r2 * (-1.0 / 6 + r2 * (1.0 / 120 + r2 * (-1.0 / 5040 + r2 * (1.0 / 362880 + r2 * (-1.0 / 39916800 + r2 * (1.0 / 6227020800.0)))))));
            const double cp = 1.0 + r2 * (-0.5 + r2 * (1.0 / 24 + r2 * (-1.0 / 720 + r2 * (1.0 / 40320 + r2 * (-1.0 / 3628800 + r2 * (1.0 / 479001600.0))))));
            const int qq = qi & 3; const double s = qq == 0 ? sp : (qq == 1 ? cp : (qq == 2 ? -sp : -cp)), c = qq == 0 ? cp : (qq == 1 ? -sp : (qq == 2 ? -cp : sp));
            float* o = rot + ((size_t)pos * 16 + (jr >> 2)) * 8 + (jr & 3); o[0] = (float)c; o[4] = (float)s;
        }
    }
    if (vcu == 0) {
        float* bt = (float*)(ws + WS_BIAS); const float* rb = a.in[6];
        for (int idx = tid; idx < 3 * 8 * 160; idx += 512) { const int p = idx / (8 * 160), h = (idx / 160) % 8, d = idx % 160 - 80; const int dil = p == 0 ? 1 : (p == 1 ? 4 : 16);
            bt[idx] = (d >= -64 && d <= 64) ? rb[t5_bucket(d * dil) * 8 + h] * 1.4426950408889634f : -1e30f; }
    }
}
__device__ __forceinline__ void p0_expert_weights(const Args& a, LAS unsigned char* lds, int vcu, int G, int wave, int lane) {
    unsigned char* ws = a.ws;
    LAS float* scr = (LAS float*)(lds + wave * 16384);
    const int gw = vcu * NWAVES + wave, NGW = G * NWAVES;
    constexpr int I_G = 16 * 16, I_D = 8 * 32, PER_E = 2 * I_G + I_D;
    for (int it = gw; it < 16 * PER_E; it += NGW) {
        const int e = it / PER_E; int r = it - e * PER_E;
#if M1_FP8
        if (r < I_G) { p0_transpose_item_fp8<2>(a.in[15] + (size_t)e * 1024 * 512, 1024, 512, ws + WS_WGU + (size_t)e * 1024 * 1024, scr, r, lane, 64.f); continue; } r -= I_G;
        if (r < I_G) { p0_transpose_item_fp8<3>(a.in[16] + (size_t)e * 1024 * 512, 1024, 512, ws + WS_WGU + (size_t)e * 1024 * 1024, scr, r, lane, 64.f); continue; } r -= I_G;
#else
        if (r < I_G) { p0_transpose_item<2>(a.in[15] + (size_t)e * 1024 * 512, 1024, 512, (bf16*)(ws + WS_WGU) + (size_t)e * 1024 * 1024, scr, r, lane); continue; } r -= I_G;
        if (r < I_G) { p0_transpose_item<3>(a.in[16] + (size_t)e * 1024 * 512, 1024, 512, (bf16*)(ws + WS_WGU) + (size_t)e * 1024 * 1024, scr, r, lane); continue; } r -= I_G;
#endif
        p0_transpose_item_fp8<0>(a.in[17] + (size_t)e * 512 * 1024, 512, 1024, ws + WS_WD + (size_t)e * 1024 * 512, scr, r, lane, 64.f);
    }
    __syncthreads();
}

__device__ __forceinline__ float log2_gamma(const float* dec, int h) {
    const float x = dec[h]; return -__log2f(1.f + __expf(-x));
}
__device__ __forceinline__ void chain_item(const Args& a, LAS unsigned char* lds, int item, int tid, int wid, int lane) {
    unsigned char* ws = a.ws;
    const int b = item >> 4, h = (item >> 2) & 3, dir = (item >> 1) & 1, vh = item & 1;
    const float lg2 = log2_gamma(dir ? a.in[3] : a.in[2], h);
    const float cd = __builtin_amdgcn_exp2f(lg2 * 128.f);
    const int g = lane >> 4, i16 = lane & 15, q = i16 >> 2, p = lane & 3;
    const int wd = wid >> 1, wv = wid & 1;
    const GAS bf16* kr = (const GAS bf16*)(ws + WS_KR); const GAS bf16* vr = (const GAS bf16*)(ws + WS_VR);
    GAS bf16* states = (GAS bf16*)a.out;
    f32x4 acc[2][4];
#pragma unroll
    for (int i = 0; i < 2; ++i)
#pragma unroll
        for (int j = 0; j < 4; ++j) acc[i][j] = (f32x4){0.f, 0.f, 0.f, 0.f};
    const int srow = tid >> 4, sch = tid & 15; const unsigned soff = offb(srow, sch);
    const GAS bf16* kp = kr + ((size_t)b * SEQ + srow) * 512 + h * 128 + sch * 8;
    const GAS bf16* vp = vr + ((size_t)b * SEQ + srow) * 1024 + h * 256 + vh * 128 + sch * 8;
    v4u kq[4], vq[4];
    { const int n0 = dir ? 15 : 0;
#pragma unroll
      for (int j = 0; j < 4; ++j) { kq[j] = *(const GAS v4u*)(kp + (size_t)(n0 * 128 + 32 * j) * 512); vq[j] = *(const GAS v4u*)(vp + (size_t)(n0 * 128 + 32 * j) * 1024); } }
    unsigned abase[2][2], bbase[4][2];
#pragma unroll
    for (int t = 0; t < 2; ++t) { const unsigned r = 8 * g + 4 * t + q;
#pragma unroll
        for (int dt = 0; dt < 2; ++dt) abase[dt][t] = offb(r, 2 * (2 * wd + dt) + (p >> 1)) + 8 * (p & 1);
#pragma unroll
        for (int vt = 0; vt < 4; ++vt) bbase[vt][t] = offb(r, 2 * (4 * wv + vt) + (p >> 1)) + 8 * (p & 1); }
#define CH_STAGE(BUFOFF) do { _Pragma("unroll") for (int j = 0; j < 4; ++j) { \
            const int row = srow + 32 * j; const float z = __builtin_amdgcn_exp2f(lg2 * (float)(dir ? row : 127 - row)); const v4u kv = kq[j]; \
            v4u ko; ko.x = cvtpk(bflo(kv.x) * z, bfhi(kv.x) * z); ko.y = cvtpk(bflo(kv.y) * z, bfhi(kv.y) * z); ko.z = cvtpk(bflo(kv.z) * z, bfhi(kv.z) * z); ko.w = cvtpk(bflo(kv.w) * z, bfhi(kv.w) * z); \
            *(LAS v4u*)(lds + (BUFOFF) + soff + j * 8192) = ko; *(LAS v4u*)(lds + (BUFOFF) + 32768 + soff + j * 8192) = vq[j]; } } while (0)
#define CH_FETCH(NN) do { _Pragma("unroll") for (int j = 0; j < 4; ++j) { kq[j] = *(const GAS v4u*)(kp + (size_t)((NN) * 128 + 32 * j) * 512); vq[j] = *(const GAS v4u*)(vp + (size_t)((NN) * 128 + 32 * j) * 1024); } } while (0)
#define CH_STEP(STEP, CUR, OTH) do { const int step_ = (STEP); const int n_ = dir ? 15 - step_ : step_; \
        GAS bf16* sb_ = states + ((((size_t)(b * 4 + h) * 16 + n_) * 2 + dir) * 256) * 128; \
        _Pragma("unroll") for (int dt = 0; dt < 2; ++dt) _Pragma("unroll") for (int vt = 0; vt < 4; ++vt) { \
            const int v_ = vh * 128 + 64 * wv + 16 * vt + i16, d0_ = 32 * wd + 16 * dt + 4 * g; \
            u32x2 w_; w_.x = pg8::cvt_pk_bf16_acc(acc[dt][vt][0], acc[dt][vt][1]); w_.y = pg8::cvt_pk_bf16_acc(acc[dt][vt][2], acc[dt][vt][3]);   \
            *(GAS u32x2*)(sb_ + (size_t)v_ * 128 + d0_) = w_; } \
        if (step_ < 15) CH_STAGE(OTH); \
        if (step_ < 14) CH_FETCH(dir ? 13 - step_ : step_ + 2); \
        _Pragma("unroll") for (int i = 0; i < 2; ++i) _Pragma("unroll") for (int j = 0; j < 4; ++j) acc[i][j] = acc[i][j] * cd; \
        _Pragma("unroll") for (int ks = 0; ks < 4; ++ks) { bf16x8 af[2], bfr[4]; \
            _Pragma("unroll") for (int dt = 0; dt < 2; ++dt) af[dt] = cat8(ldtr(lds + (CUR) + abase[dt][0] + ks * 8192), ldtr(lds + (CUR) + abase[dt][1] + ks * 8192)); \
            _Pragma("unroll") for (int vt = 0; vt < 4; ++vt) bfr[vt] = cat8(ldtr(lds + (CUR) + 32768 + bbase[vt][0] + ks * 8192), ldtr(lds + (CUR) + 32768 + bbase[vt][1] + ks * 8192)); \
            _Pragma("unroll") for (int dt = 0; dt < 2; ++dt) _Pragma("unroll") for (int vt = 0; vt < 4; ++vt) acc[dt][vt] = MFMA16(af[dt], bfr[vt], acc[dt][vt]); } \
        __syncthreads(); } while (0)
    CH_STAGE(0);
    CH_FETCH(dir ? 14 : 1);
    __syncthreads();
    for (int sp = 0; sp < 8; ++sp) { CH_STEP(2 * sp, 0, 65536); CH_STEP(2 * sp + 1, 65536, 0); }
#undef CH_STEP
#undef CH_STAGE
#undef CH_FETCH
}

constexpr int AT_OST = 135168, AT_SCR = AT_OST + 8 * 2048;
constexpr int ATB_N = 160;
struct AttnLane { unsigned kb[2]; unsigned vb[4]; };
__device__ __forceinline__ AttnLane attn_lane(int lane) {
    const int g = lane >> 4, i16 = lane & 15, q4 = i16 >> 2, p = lane & 3; AttnLane L;
#pragma unroll
    for (int s = 0; s < 2; ++s) L.kb[s] = i16 * 128 + (((4 * s + g) ^ ((i16 >> 1) & 7)) * 16);
    const int sw = (2 * g + (q4 >> 1)) & 3;
#pragma unroll
    for (int c = 0; c < 4; ++c) L.vb[c] = (4 * g + q4) * 128 + ((c ^ sw) * 32) + p * 8;
    return L;
}
__device__ __forceinline__ unsigned kimg_off(int row, int c) { return row * 128 + ((c ^ ((row >> 1) & 7)) * 16); }
__device__ __forceinline__ unsigned vimg_off(int row, int c) { return row * 128 + (((c >> 1) ^ ((row >> 1) & 3)) * 32) + (c & 1) * 16; }
__device__ __forceinline__ void attn_core(const LAS unsigned char* Kimg, const LAS unsigned char* Vimg, int R0, int nrows, unsigned tvalid, const bf16x8 (&qf)[2],
                                          const float (&biasr)[36], const AttnLane& L, f32x4 (&O)[4], float& mx, float& lsum) {
    f32x4 D[9];
#pragma unroll
    for (int kt = 0; kt < 9; ++kt) {
        int R = R0 + 16 * kt; R = R < 0 ? 0 : (R > nrows - 16 ? nrows - 16 : R);
        const LAS unsigned char* kp = Kimg + R * 128;
        const bf16x8 k0 = *(const LAS bf16x8*)(kp + L.kb[0]), k1 = *(const LAS bf16x8*)(kp + L.kb[1]);
        f32x4 d = (f32x4){0.f, 0.f, 0.f, 0.f};
        d = MFMA16(k0, qf[0], d); d = MFMA16(k1, qf[1], d); D[kt] = d;
    }
    mx = -1e30f;
#pragma unroll
    for (int kt = 0; kt < 9; ++kt) {
        const float tb = ((tvalid >> kt) & 1u) ? 0.f : -1e30f;
#pragma unroll
        for (int r = 0; r < 4; ++r) { const float x = D[kt][r] + (biasr[4 * kt + r] + tb); D[kt][r] = x; mx = fmaxf(mx, x); }
    }
    mx = fmaxf(mx, __shfl_xor(mx, 16)); mx = fmaxf(mx, __shfl_xor(mx, 32));
    lsum = 0.f;
#pragma unroll
    for (int kt = 0; kt < 9; ++kt)
#pragma unroll
        for (int r = 0; r < 4; ++r) { const float e = __builtin_amdgcn_exp2f(D[kt][r] - mx); D[kt][r] = e; lsum += e; }
    lsum += __shfl_xor(lsum, 16); lsum += __shfl_xor(lsum, 32);
#pragma unroll
    for (int c = 0; c < 4; ++c) O[c] = (f32x4){0.f, 0.f, 0.f, 0.f};
#pragma unroll
    for (int kk = 0; kk < 5; ++kk) {
        int Ra = R0 + 32 * kk; Ra = Ra < 0 ? 0 : (Ra > nrows - 16 ? nrows - 16 : Ra);
        int Rb = R0 + 32 * kk + 16; Rb = Rb < 0 ? 0 : (Rb > nrows - 16 ? nrows - 16 : Rb);
        if (kk == 4) Rb = Ra;
        const f32x4 e0 = D[2 * kk], e1 = kk < 4 ? D[2 * kk + 1] : (f32x4){0.f, 0.f, 0.f, 0.f};
        v4u pw; pw.x = cvtpk(e0[0], e0[1]); pw.y = cvtpk(e0[2], e0[3]); pw.z = cvtpk(e1[0], e1[1]); pw.w = cvtpk(e1[2], e1[3]);
        const bf16x8 pf = __builtin_bit_cast(bf16x8, pw);
        const LAS unsigned char* va_ = Vimg + Ra * 128; const LAS unsigned char* vb_ = Vimg + Rb * 128;
#pragma unroll
        for (int c = 0; c < 4; ++c) O[c] = MFMA16(pf, cat8(ldtr(va_ + L.vb[c]), ldtr(vb_ + L.vb[c])), O[c]);
    }
}
__device__ __forceinline__ void attn_stage_out(LAS unsigned char* lds, int wid, int lane, const f32x4 (&O)[4], float lsum) {
    const int g = lane >> 4, i16 = lane & 15;
    const float linv = 1.f / lsum;
    LAS bf16* st = (LAS bf16*)(lds + AT_OST + wid * 2048);
#pragma unroll
    for (int r = 0; r < 4; ++r) { const float li = __shfl(linv, 4 * g + r);
#pragma unroll
        for (int c = 0; c < 4; ++c) st[(4 * g + r) * 64 + 16 * c + i16] = (bf16)(cvtpk(O[c][r] * li, 0.f) & 0xffffu); }
}
__device__ __forceinline__ void attn_load_bias(const Args& a, int pat, int h, int lane, float (&biasr)[36]) {
    const GAS float* bt = (const GAS float*)(a.ws + WS_BIAS) + (pat * 8 + h) * ATB_N; const int g = lane >> 4, i16 = lane & 15;
#pragma unroll
    for (int kt = 0; kt < 9; ++kt)
#pragma unroll
        for (int r = 0; r < 4; ++r) biasr[4 * kt + r] = bt[16 * kt + 4 * g + r - 64 - i16 + 80];
}
template <int DIL, int VAR = 0> __device__ __forceinline__ void attn_dil_phase(const Args& a, LAS unsigned char* lds, int vcu, int G, int tid, int wid, int lane) {
    unsigned char* ws = a.ws;
    constexpr int NR = SEQ / DIL, PAT = DIL == 4 ? 1 : 2, CH = NR * 8 / 512, NITEM = NB * 8 * DIL;
    constexpr int NBUF = DIL == 16 ? 2 : 1, BUFB = 2 * NR * 128;
    const GAS bf16* qa = (const GAS bf16*)(ws + WS_QA); const GAS bf16* ka = (const GAS bf16*)(ws + WS_KA); const GAS bf16* va = (const GAS bf16*)(ws + WS_VA);
    bf16* op = (bf16*)(ws + (DIL == 4 ? WS_O2 : WS_O3)); float* lsep = (float*)(ws + (DIL == 4 ? WS_LSE2 : WS_LSE3));
    if (vcu >= NITEM) return;
    const int h = vcu & 7;
    float biasr[36]; attn_load_bias(a, PAT, h, lane, biasr);
    const AttnLane L = attn_lane(lane);
    const int g = lane >> 4, i16 = lane & 15;
    v4u kq[CH], vq[CH]; bf16x8 qn[2];
    auto issue = [&](int item, int gi) {
        const int rho = (item >> 3) % DIL, b = item / (8 * DIL); const size_t rowb = (size_t)b * SEQ;
#pragma unroll
        for (int j = 0; j < CH; ++j) { const int id = tid + 512 * j, row = id >> 3, c = id & 7; const size_t go = (rowb + (size_t)row * DIL + rho) * 512 + h * 64 + c * 8;
            kq[j] = *(const GAS v4u*)(ka + go); vq[j] = *(const GAS v4u*)(va + go); }
        const size_t qpos = rowb + (size_t)(16 * gi + i16) * DIL + rho;
#pragma unroll
        for (int s = 0; s < 2; ++s) qn[s] = *(const GAS bf16x8*)(qa + qpos * 512 + h * 64 + 32 * s + 8 * g);
    };
    issue(vcu, wid);
    int buf = 0;
    for (int item = vcu; item < NITEM; item += G) {
        const int rho = (item >> 3) % DIL, b = item / (8 * DIL); const size_t rowb = (size_t)b * SEQ;
        LAS unsigned char* Kimg = lds + buf * BUFB; LAS unsigned char* Vimg = Kimg + NR * 128;
        if (NBUF == 1) __syncthreads();
#pragma unroll
        for (int j = 0; j < CH; ++j) { const int id = tid + 512 * j, row = id >> 3, c = id & 7;
            *(LAS v4u*)(Kimg + kimg_off(row, c)) = kq[j]; *(LAS v4u*)(Vimg + vimg_off(row, c)) = vq[j]; }
        bf16x8 qf[2] = {qn[0], qn[1]};
        __syncthreads();
        if (NBUF == 2 && item + G < NITEM) issue(item + G, wid);
        for (int gi = wid; gi < NR / 16; gi += 8) {
            const int m0 = 16 * gi;
            if (NBUF == 1 && gi + 8 < NR / 16) {
                const size_t qpos = rowb + (size_t)(m0 + 128 + i16) * DIL + rho;
#pragma unroll
                for (int s = 0; s < 2; ++s) qn[s] = *(const GAS bf16x8*)(qa + qpos * 512 + h * 64 + 32 * s + 8 * g); }
            unsigned tvalid = 0u;
#pragma unroll
            for (int kt = 0; kt < 9; ++kt) { const int t0 = m0 - 64 + 16 * kt; tvalid |= (t0 >= 0 && t0 < NR) ? (1u << kt) : 0u; }
            f32x4 O[4]; float mx, lsum;
            if (VAR == 1) { mx = 0.f; lsum = 1.f;
#pragma unroll
                for (int c = 0; c < 4; ++c) O[c] = (f32x4){__builtin_bit_cast(float, qf[0][0] + c), 0.f, 0.f, 0.f}; }
            else attn_core(Kimg, Vimg, m0 - 64, NR, tvalid, qf, biasr, L, O, mx, lsum);
            attn_stage_out(lds, wid, lane, O, lsum);
            if (g == 0) lsep[(rowb + (size_t)(m0 + i16) * DIL + rho) * 8 + h] = mx + __log2f(lsum);
            asm volatile("s_waitcnt lgkmcnt(0)" ::: "memory");
            { const int q = lane >> 2, qt = lane & 3; const LAS v4u* sp = (const LAS v4u*)(lds + AT_OST + wid * 2048 + q * 128 + qt * 32);
              const v4u x0 = sp[0], x1 = sp[1]; bf16* dst = op + (rowb + (size_t)(m0 + q) * DIL + rho) * 512 + h * 64 + qt * 16;
              *(v4u*)dst = x0; *(v4u*)(dst + 8) = x1; }
            asm volatile("s_waitcnt lgkmcnt(0)" ::: "memory");
            if (NBUF == 1) { qf[0] = qn[0]; qf[1] = qn[1]; }
        }
        if (NBUF == 1 && item + G < NITEM) issue(item + G, wid);
        buf ^= (NBUF - 1);
    }
    __syncthreads();
}
__device__ __forceinline__ void attn_p1_phase(const Args& a, LAS unsigned char* lds, int vcu, int G, int tid, int wid, int lane) {
    unsigned char* ws = a.ws;
    LAS unsigned char* Kimg = lds; LAS unsigned char* Vimg = lds + 384 * 128;
    const GAS bf16* qa = (const GAS bf16*)(ws + WS_QA); const GAS bf16* ka = (const GAS bf16*)(ws + WS_KA); const GAS bf16* va = (const GAS bf16*)(ws + WS_VA);
    const GAS bf16* o2 = (const GAS bf16*)(ws + WS_O2); const GAS bf16* o3 = (const GAS bf16*)(ws + WS_O3);
    const GAS float* lse2 = (const GAS float*)(ws + WS_LSE2); const GAS float* lse3 = (const GAS float*)(ws + WS_LSE3);
    bf16* oa = (bf16*)(ws + WS_OA);
    if (vcu >= 1024) return;
    const int h = vcu & 7;
    float biasr[36]; attn_load_bias(a, 0, h, lane, biasr);
    const AttnLane L = attn_lane(lane);
    const int g = lane >> 4, i16 = lane & 15;
    LAS float* scr = (LAS float*)(lds + AT_SCR) + wid * 16;
    v4u kq[6], vq[6];
    auto issue = [&](int item) { const int b = item >> 6, s0 = ((item >> 3) & 7) * 256; const size_t rowb = (size_t)b * SEQ;
#pragma unroll
        for (int j = 0; j < 6; ++j) { const int id = tid + 512 * j, row = id >> 3, c = id & 7, pos = s0 - 64 + row; const bool ok = pos >= 0 && pos < SEQ;
            const size_t go = (rowb + (size_t)(ok ? pos : 0)) * 512 + h * 64 + c * 8;
            kq[j] = *(const GAS v4u*)(ka + go); vq[j] = *(const GAS v4u*)(va + go);
            if (!ok) { kq[j] = (v4u){0u, 0u, 0u, 0u}; vq[j] = (v4u){0u, 0u, 0u, 0u}; } } };
    issue(vcu);
    for (int item = vcu; item < 1024; item += G) {
        const int b = item >> 6, s0 = ((item >> 3) & 7) * 256; const size_t rowb = (size_t)b * SEQ;
        __syncthreads();
#pragma unroll
        for (int j = 0; j < 6; ++j) { const int id = tid + 512 * j, row = id >> 3, c = id & 7;
            *(LAS v4u*)(Kimg + kimg_off(row, c)) = kq[j]; *(LAS v4u*)(Vimg + vimg_off(row, c)) = vq[j]; }
        __syncthreads();
        if (item + G < 1024) issue(item + G);
        for (int gi = wid; gi < 16; gi += 8) {
            const int m0 = s0 + 16 * gi;
            const int q = lane >> 2, qt = lane & 3; const size_t tq = rowb + m0 + q;
            const v4u a20 = *(const GAS v4u*)(o2 + tq * 512 + h * 64 + qt * 16), a21 = *(const GAS v4u*)(o2 + tq * 512 + h * 64 + qt * 16 + 8);
            const v4u a30 = *(const GAS v4u*)(o3 + tq * 512 + h * 64 + qt * 16), a31 = *(const GAS v4u*)(o3 + tq * 512 + h * 64 + qt * 16 + 8);
            const float l2 = lse2[tq * 8 + h], l3 = lse3[tq * 8 + h];
            bf16x8 qf[2];
#pragma unroll
            for (int s = 0; s < 2; ++s) qf[s] = *(const GAS bf16x8*)(qa + (rowb + m0 + i16) * 512 + h * 64 + 32 * s + 8 * g);
            unsigned tvalid = 0u;
#pragma unroll
            for (int kt = 0; kt < 9; ++kt) { const int t0 = m0 - 64 + 16 * kt; tvalid |= (t0 >= 0 && t0 < SEQ) ? (1u << kt) : 0u; }
            f32x4 O[4]; float mx, lsum;
            attn_core(Kimg, Vimg, 16 * gi, 384, tvalid, qf, biasr, L, O, mx, lsum);
            attn_stage_out(lds, wid, lane, O, lsum);
            if (g == 0) scr[i16] = mx + __log2f(lsum);
            asm volatile("s_waitcnt lgkmcnt(0)" ::: "memory");
            {
                const float l1 = scr[q], M = fmaxf(l1, fmaxf(l2, l3));
                float w1 = __builtin_amdgcn_exp2f(l1 - M), w2 = __builtin_amdgcn_exp2f(l2 - M), w3 = __builtin_amdgcn_exp2f(l3 - M); const float wi = 1.f / (w1 + w2 + w3); w1 *= wi; w2 *= wi; w3 *= wi;
                const LAS v4u* sp = (const LAS v4u*)(lds + AT_OST + wid * 2048 + q * 128 + qt * 32);
                const v4u x0 = sp[0], x1 = sp[1];
                v4u r0, r1;
#define MRG(d, x, y, z) d = cvtpk(w1 * bflo(x) + w2 * bflo(y) + w3 * bflo(z), w1 * bfhi(x) + w2 * bfhi(y) + w3 * bfhi(z))
                MRG(r0.x, x0.x, a20.x, a30.x); MRG(r0.y, x0.y, a20.y, a30.y); MRG(r0.z, x0.z, a20.z, a30.z); MRG(r0.w, x0.w, a20.w, a30.w);
                MRG(r1.x, x1.x, a21.x, a31.x); MRG(r1.y, x1.y, a21.y, a31.y); MRG(r1.z, x1.z, a21.z, a31.z); MRG(r1.w, x1.w, a21.w, a31.w);
#undef MRG
                bf16* dst = oa + tq * 512 + h * 64 + qt * 16;
                *(v4u*)dst = r0; *(v4u*)(dst + 8) = r1;
            }
            asm volatile("s_waitcnt lgkmcnt(0)" ::: "memory");
        }
    }
    __syncthreads();
}

#define OPAQUE(x) asm volatile("" : "+v"(x))
template <int VAR = 0> __device__ __forceinline__ void p3_phase(const Args& a, LAS unsigned char* lds, int vcu, int G, int tid, int wid, int lane) {
    unsigned char* ws = a.ws;
    const int g = lane >> 4, i16 = lane & 15, q4 = i16 >> 2, p = lane & 3;
    const GAS bf16* qr = (const GAS bf16*)(ws + WS_QR); const GAS bf16* kr = (const GAS bf16*)(ws + WS_KR); const GAS bf16* vr = (const GAS bf16*)(ws + WS_VR);
    GAS bf16* gr = (GAS bf16*)(ws + WS_GR);
    LAS unsigned char* Kt = lds; LAS unsigned char* Sg = lds + 32768;
    if (vcu >= 1024) return;
    const unsigned kdst = offb(tid >> 4, tid & 15);
    unsigned rfo[4];
    { const unsigned X = ((i16 & 3) << 2) | (i16 >> 2);
#pragma unroll
      for (int s = 0; s < 4; ++s) rfo[s] = 256 * i16 + 16 * (((4 * s) ^ (X & 12)) | (g ^ (X & 3))); }
    v4u sreg[8], kreg[4]; bf16x8 qn[4];
    auto item_ptrs = [&](int item, size_t& tok0, const GAS bf16*& sf, int& h) { const int b = item >> 6; h = (item >> 4) & 3; const int n = item & 15; tok0 = (size_t)b * SEQ + n * 128;
        sf = (const GAS bf16*)a.out + ((((size_t)(b * 4 + h) * 16 + n) * 2 + 0) * 256) * 128; };
    auto issue_k = [&](int item) { size_t tok0; const GAS bf16* sf; int h; item_ptrs(item, tok0, sf, h);
        const GAS bf16* ks_ = kr + (tok0 + (tid >> 4)) * 512 + h * 128 + (tid & 15) * 8;
#pragma unroll
        for (int j = 0; j < 4; ++j) kreg[j] = *(const GAS v4u*)(ks_ + (size_t)j * 32 * 512); };
    auto issue_q = [&](int item) { size_t tok0; const GAS bf16* sf; int h; item_ptrs(item, tok0, sf, h);
#pragma unroll
        for (int s = 0; s < 4; ++s) qn[s] = *(const GAS bf16x8*)(qr + (tok0 + 16 * wid + i16) * 512 + h * 128 + 32 * s + 8 * g); };
    auto issue_state = [&](const GAS bf16* sf, int dirn) { const GAS bf16* sld = sf + (size_t)dirn * 256 * 128 + (size_t)(tid >> 4) * 128 + (tid & 15) * 8;
#pragma unroll
        for (int j = 0; j < 8; ++j) sreg[j] = *(const GAS v4u*)(sld + (size_t)j * 32 * 128); };
    auto write_state = [&]() {
#pragma unroll
        for (int j = 0; j < 8; ++j) *(LAS v4u*)(Sg + (j >> 2) * 32768 + kdst + (j & 3) * 8192) = sreg[j]; };
    { size_t tok0; const GAS bf16* sf; int h; item_ptrs(vcu, tok0, sf, h); issue_k(vcu); issue_q(vcu); issue_state(sf, 0); }
#pragma unroll
    for (int j = 0; j < 4; ++j) *(LAS v4u*)(Kt + kdst + j * 8192) = kreg[j];
    for (int item = vcu; item < 1024; item += G) {
        size_t tok0; const GAS bf16* sf; int h; item_ptrs(item, tok0, sf, h);
        const float lf2 = log2_gamma(a.in[2], h), lb2 = log2_gamma(a.in[3], h);
        bf16x8 qf[4];
#pragma unroll
        for (int s = 0; s < 4; ++s) qf[s] = qn[s];
        const bool has_next = item + G < 1024;
        __syncthreads();
        f32x4 D[8];
#pragma unroll
        for (int jt = 0; jt < 8; ++jt) {
            f32x4 d = (f32x4){0.f, 0.f, 0.f, 0.f};
#pragma unroll
            for (int s = 0; s < 4; ++s) { if (VAR != 1) { const bf16x8 kf = *(const LAS bf16x8*)(Kt + rfo[s] + jt * 4096); d = MFMA16(kf, qf[s], d); } else d[s] = __builtin_bit_cast(float, (int)qf[s][0]); }
            D[jt] = d;
        }
        int iq = 16 * wid + i16; OPAQUE(iq);
        bf16x8 pf[4];
#pragma unroll
        for (int ks = 0; ks < 4; ++ks) {
            float e[8];
#pragma unroll
            for (int t = 0; t < 2; ++t)
#pragma unroll
                for (int r = 0; r < 4; ++r) {
                    const int j = 16 * (2 * ks + t) + 4 * g + r; const float fdf = (float)(iq - j), ad = fabsf(fdf);
                    const float pos = fminf(fmaxf(fdf, 0.f), 1.f), isz = 1.f - fminf(ad, 1.f);
                    const float w = __builtin_amdgcn_exp2f((lb2 + (lf2 - lb2) * pos) * ad) + isz;
                    e[4 * t + r] = D[2 * ks + t][r] * w;
                }
            v4u pw; pw.x = cvtpk(e[0], e[1]); pw.y = cvtpk(e[2], e[3]); pw.z = cvtpk(e[4], e[5]); pw.w = cvtpk(e[6], e[7]);
            pf[ks] = __builtin_bit_cast(bf16x8, pw);
        }
        f32x4 acc[16];
#pragma unroll
        for (int vt = 0; vt < 16; ++vt) acc[vt] = (f32x4){0.f, 0.f, 0.f, 0.f};
#pragma unroll
        for (int dirn = 0; dirn < 2; ++dirn) {
            if (dirn == 1) __syncthreads();
            write_state();
            if (dirn == 0) { issue_state(sf, 1); if (has_next) issue_k(item + G); }
            else {
                if (has_next) {
#pragma unroll
                    for (int j = 0; j < 4; ++j) *(LAS v4u*)(Kt + kdst + j * 8192) = kreg[j]; }
                const GAS bf16* vs_ = vr + (tok0 + (tid >> 5)) * 1024 + h * 256 + (tid & 31) * 8;
#pragma unroll
                for (int j = 0; j < 8; ++j) sreg[j] = *(const GAS v4u*)(vs_ + (size_t)j * 16 * 1024);
            }
            __syncthreads();
#pragma unroll
            for (int vt = 0; vt < 16; ++vt) {
#pragma unroll
                for (int s = 0; s < 4; ++s) { if (VAR != 1) { const bf16x8 sfr = *(const LAS bf16x8*)(Sg + (vt >> 3) * 32768 + rfo[s] + (vt & 7) * 4096); acc[vt] = MFMA16(qf[s], sfr, acc[vt]); } }
            }
            float xs[4];
            { int ib = 16 * wid + 4 * g; OPAQUE(ib);
#pragma unroll
              for (int r = 0; r < 4; ++r) { const float lxf = lf2 * (float)(ib + r + 1), lxb = lb2 * (float)(128 - ib - r); xs[r] = __builtin_amdgcn_exp2f(dirn == 0 ? lxf - lxb : lxb); } }
#pragma unroll
            for (int vt = 0; vt < 16; ++vt)
#pragma unroll
                for (int r = 0; r < 4; ++r) acc[vt][r] *= xs[r];
        }
        __syncthreads();
        { int t2 = tid; OPAQUE(t2); const unsigned vd2 = (unsigned)((t2 & 31) >> 4) * 32768u + offb(t2 >> 5, t2 & 15);
#pragma unroll
          for (int j = 0; j < 8; ++j) *(LAS v4u*)(Sg + vd2 + j * 4096) = sreg[j]; }
        GAS bf16* gp = gr + (tok0 + 16 * wid + (lane >> 5)) * 1024 + h * 256 + (lane & 31) * 8;
        __syncthreads();
        unsigned vbs[8];
        { int l2 = lane; OPAQUE(l2); const unsigned g2 = l2 >> 4, q2 = (l2 & 15) >> 2, p2 = l2 & 3, X = (q2 << 2) | g2;
#pragma unroll
          for (int c = 0; c < 8; ++c) vbs[c] = 256 * (4 * g2 + q2) + 16 * (((2 * c) ^ (X & 14)) | ((p2 >> 1) ^ (X & 1))) + 8 * (p2 & 1); }
#pragma unroll
        for (int vt = 0; vt < 16; ++vt) {
#pragma unroll
            for (int ks = 0; ks < 4; ++ks) { if (VAR != 1) {
                const s16x4 lo = ldtr(Sg + vbs[vt & 7] + (vt >> 3) * 32768 + ks * 8192), hi = ldtr(Sg + vbs[vt & 7] + (vt >> 3) * 32768 + ks * 8192 + 4096);
                acc[vt] = MFMA16(pf[ks], cat8(lo, hi), acc[vt]); }
            }
            asm volatile("" ::: "memory");
        }
        float mu[4], rs[4];
#pragma unroll
        for (int r = 0; r < 4; ++r) {
            float s = 0.f;
#pragma unroll
            for (int vt = 0; vt < 16; ++vt) s += acc[vt][r];
            s += __shfl_xor(s, 1); s += __shfl_xor(s, 2); s += __shfl_xor(s, 4); s += __shfl_xor(s, 8);
            const float m = s * (1.f / 256.f); float qv = 0.f;
#pragma unroll
            for (int vt = 0; vt < 16; ++vt) { const float d = acc[vt][r] - m; qv += d * d; }
            qv += __shfl_xor(qv, 1); qv += __shfl_xor(qv, 2); qv += __shfl_xor(qv, 4); qv += __shfl_xor(qv, 8);
            mu[r] = m; rs[r] = 1.f / sqrtf(qv * (1.f / 256.f) + LN_EPSF);
        }
        v4u greg[8];
#pragma unroll
        for (int j = 0; j < 8; ++j) greg[j] = *(const GAS v4u*)(gp + (size_t)j * 2048);
        __syncthreads();
        if (has_next) { size_t tk; const GAS bf16* sfn; int hn; item_ptrs(item + G, tk, sfn, hn); issue_state(sfn, 0); issue_q(item + G); }
        LAS bf16* st = (LAS bf16*)(Sg + wid * 8192);
        { LAS bf16* sp_ = st + (4 * g) * 256 + i16;
#pragma unroll
          for (int vt = 0; vt < 16; ++vt)
#pragma unroll
              for (int r = 0; r < 4; ++r) sp_[r * 256 + 16 * vt] = (bf16)(cvtpk((acc[vt][r] - mu[r]) * rs[r], 0.f) & 0xffffu); }
        asm volatile("s_waitcnt lgkmcnt(0)" ::: "memory");
        {
            const float* gn = a.in[4] + h * 256; const int ch = lane & 31;
            const f32x4 g0 = *(const f32x4*)(gn + ch * 8), g1 = *(const f32x4*)(gn + ch * 8 + 4);
            const LAS bf16* yp = st + (lane >> 5) * 256 + ch * 8;
#pragma unroll
            for (int j = 0; j < 8; ++j) {
                const v4u y = *(const LAS v4u*)(yp + j * 512); const v4u sg = greg[j];
                v4u o; o.x = cvtpk(bflo(y.x) * g0[0] * bflo(sg.x), bfhi(y.x) * g0[1] * bfhi(sg.x)); o.y = cvtpk(bflo(y.y) * g0[2] * bflo(sg.y), bfhi(y.y) * g0[3] * bfhi(sg.y));
                o.z = cvtpk(bflo(y.z) * g1[0] * bflo(sg.z), bfhi(y.z) * g1[1] * bfhi(sg.z)); o.w = cvtpk(bflo(y.w) * g1[2] * bflo(sg.w), bfhi(y.w) * g1[3] * bfhi(sg.w));
                *(GAS v4u*)(gp + (size_t)j * 2048) = o;
            }
        }
        __syncthreads();
    }
}

constexpr int P6_RS = 81920, P6_CNT = P6_RS + 8 * 512, P6_BASE = P6_CNT + 64, P6_ROW = P6_BASE + 64;
#define P6_BUTTERFLY(lg, out) do { float r10[10], r5[5], r3[3], r2[2]; const float z = 0.f; \
    _Pragma("unroll") for (int k = 0; k < 10; ++k) { const float keep = h32 ? lg[10 + k] : lg[k], send = h32 ? lg[k] : lg[10 + k]; r10[k] = keep + __shfl_xor(send, 32); } \
    _Pragma("unroll") for (int k = 0; k < 5; ++k) { const float keep = h16 ? r10[5 + k] : r10[k], send = h16 ? r10[k] : r10[5 + k]; r5[k] = keep + __shfl_xor(send, 16); } \
    { const float keep = h8 ? r5[3] : r5[0], send = h8 ? r5[0] : r5[3]; r3[0] = keep + __shfl_xor(send, 8); } \
    { const float keep = h8 ? r5[4] : r5[1], send = h8 ? r5[1] : r5[4]; r3[1] = keep + __shfl_xor(send, 8); } \
    { const float keep = h8 ? z : r5[2], send = h8 ? r5[2] : z; r3[2] = keep + __shfl_xor(send, 8); } \
    { const float keep = h4 ? r3[2] : r3[0], send = h4 ? r3[0] : r3[2]; r2[0] = keep + __shfl_xor(send, 4); } \
    { const float keep = h4 ? z : r3[1], send = h4 ? r3[1] : z; r2[1] = keep + __shfl_xor(send, 4); } \
    { const float keep = h2 ? r2[1] : r2[0], send = h2 ? r2[0] : r2[1]; out = keep + __shfl_xor(send, 2); } \
    out += __shfl_xor(out, 1); } while (0)
__device__ __forceinline__ void p6a_phase(const Args& a, LAS unsigned char* lds, int vcu, int G, int tid, int wave, int lane) {
    unsigned char* ws = a.ws;
    LAS float* RW = (LAS float*)lds;
    LAS float* RS = (LAS float*)(lds + P6_RS) + wave * 128;
    LAS unsigned* LC = (LAS unsigned*)(lds + P6_CNT); LAS unsigned* LB = (LAS unsigned*)(lds + P6_BASE); LAS unsigned* LR = (LAS unsigned*)(lds + P6_ROW);
    for (int i = tid; i < 1024 * 4; i += 512) { const int c = i >> 2, k = i & 3; RW[k * 1024 + c] = a.in[11][i]; }
    for (int i = tid; i < 1024 * 16; i += 512) { const int c = i >> 4, k = i & 15; RW[(4 + k) * 1024 + c] = a.in[13][i]; }
    const u32x2* pre = (const u32x2*)a.out; u32x2* x1b = (u32x2*)(ws + WS_XB); [[maybe_unused]] unsigned* x1f8 = (unsigned*)(ws + WS_X1F8);
    gu32* ctl = (gu32*)ws;
    int* ltok = (int*)(ws + WS_LTOK); float* tw = (float*)(ws + WS_WSLOT); unsigned* tinfo = (unsigned*)(ws + WS_TINFO);
    const float* g1 = a.in[9]; const float* b1 = a.in[10];
    const bool h32 = (lane & 32) != 0, h16 = (lane & 16) != 0, h8 = (lane & 8) != 0, h4 = (lane & 4) != 0, h2 = (lane & 2) != 0;
#define P6_LOADROW(dst, t_) do { const u32x2* xr_ = pre + (size_t)(t_) * 256 + lane; _Pragma("unroll") for (int j = 0; j < 4; ++j) dst[j] = xr_[64 * j]; } while (0)
#define P6_LN(v, nx, s) do { s = 0.f; _Pragma("unroll") for (int j = 0; j < 4; ++j) { v[j] = (f32x4){bflo(nx[j].x), bfhi(nx[j].x), bflo(nx[j].y), bfhi(nx[j].y)}; s += (v[j].x + v[j].y) + (v[j].z + v[j].w); } } while (0)
#define P6_VAR(v, mean, q) do { q = 0.f; _Pragma("unroll") for (int j = 0; j < 4; ++j) { v[j] = v[j] - mean; q += (v[j].x * v[j].x + v[j].y * v[j].y) + (v[j].z * v[j].z + v[j].w * v[j].w); } } while (0)
#if M1_FP8
#define P6_STORE(v, t_, j) do { u32x2 o_; o_.x = cvtpk(v[j].x, v[j].y); o_.y = cvtpk(v[j].z, v[j].w); x1b[(size_t)(t_) * 256 + lane + 64 * j] = o_; x1f8[(size_t)(t_) * 256 + lane + 64 * j] = pk_fp8x4(v[j].x, v[j].y, v[j].z, v[j].w); } while (0)
#else
#define P6_STORE(v, t_, j) do { u32x2 o_; o_.x = cvtpk(v[j].x, v[j].y); o_.y = cvtpk(v[j].z, v[j].w); x1b[(size_t)(t_) * 256 + lane + 64 * j] = o_; } while (0)
#endif
#define P6_DOT(lg, v, j, k, w) lg[k] += (v[j][0] * w[0] + v[j][1] * w[1]) + (v[j][2] * w[2] + v[j][3] * w[3])
    for (int blk = vcu; blk < TT / 128; blk += G) {
        if (tid < 16) LC[tid] = 0u;
        __syncthreads();
        const int t0 = blk * 128;
        u32x2 nxA[4], nxB[4], nxC[4], nxD[4];
        P6_LOADROW(nxA, t0 + wave); P6_LOADROW(nxB, t0 + wave + 8); P6_LOADROW(nxC, t0 + wave + 16); P6_LOADROW(nxD, t0 + wave + 24);
        for (int rr = 0; rr < 4; ++rr) {
            const int rl0 = wave + 32 * rr, tA = t0 + rl0, tB = tA + 8, tC = tA + 16, tD = tA + 24;
            f32x4 vA[4], vB[4], vC[4], vD[4]; float sA, sB, sC, sD;
            P6_LN(vA, nxA, sA); P6_LN(vB, nxB, sB); P6_LN(vC, nxC, sC); P6_LN(vD, nxD, sD);
            if (rr < 3) { P6_LOADROW(nxA, tA + 32); P6_LOADROW(nxB, tB + 32); P6_LOADROW(nxC, tC + 32); P6_LOADROW(nxD, tD + 32); }
            const float mA = wave_sum(sA) * (1.f / DM), mB = wave_sum(sB) * (1.f / DM), mC = wave_sum(sC) * (1.f / DM), mD = wave_sum(sD) * (1.f / DM);
            float qA, qB, qC, qD;
            P6_VAR(vA, mA, qA); P6_VAR(vB, mB, qB); P6_VAR(vC, mC, qC); P6_VAR(vD, mD, qD);
            const float rA = 1.f / sqrtf(wave_sum(qA) * (1.f / DM) + LN_EPSF), rB = 1.f / sqrtf(wave_sum(qB) * (1.f / DM) + LN_EPSF);
            const float rC = 1.f / sqrtf(wave_sum(qC) * (1.f / DM) + LN_EPSF), rD = 1.f / sqrtf(wave_sum(qD) * (1.f / DM) + LN_EPSF);
            float lgA[20], lgB[20], lgC[20], lgD[20];
#pragma unroll
            for (int k = 0; k < 20; ++k) { lgA[k] = 0.f; lgB[k] = 0.f; lgC[k] = 0.f; lgD[k] = 0.f; }
#pragma unroll
            for (int j = 0; j < 4; ++j) {
                const f32x4 gg = *(const f32x4*)(g1 + 4 * lane + 256 * j), bb = *(const f32x4*)(b1 + 4 * lane + 256 * j);
                vA[j] = vA[j] * rA * gg + bb; vB[j] = vB[j] * rB * gg + bb; vC[j] = vC[j] * rC * gg + bb; vD[j] = vD[j] * rD * gg + bb;
                P6_STORE(vA, tA, j); P6_STORE(vB, tB, j); P6_STORE(vC, tC, j); P6_STORE(vD, tD, j);
#pragma unroll
                for (int k = 0; k < 20; ++k) { const f32x4 w = *(const LAS f32x4*)(RW + k * 1024 + 4 * lane + 256 * j);
                    P6_DOT(lgA, vA, j, k, w); P6_DOT(lgB, vB, j, k, w); P6_DOT(lgC, vC, j, k, w); P6_DOT(lgD, vD, j, k, w); }
            }
            float r1A, r1B, r1C, r1D;
            P6_BUTTERFLY(lgA, r1A); P6_BUTTERFLY(lgB, r1B); P6_BUTTERFLY(lgC, r1C); P6_BUTTERFLY(lgD, r1D);
            {
                const int i3 = h2 ? (h4 ? -1 : 1) : (h4 ? 2 : 0);
                const int i5 = i3 < 0 ? -1 : (h8 ? (i3 == 2 ? -1 : i3 + 3) : i3);
                const int kk = i5 < 0 ? -1 : (h32 ? 10 : 0) + (h16 ? 5 : 0) + i5;
                if (kk >= 0 && (lane & 1) == 0) { RS[kk] = r1A; RS[32 + kk] = r1B; RS[64 + kk] = r1C; RS[96 + kk] = r1D; }
            }
            asm volatile("s_waitcnt lgkmcnt(0)" ::: "memory");
            {
                const int sel = lane & 3; const int rl = rl0 + 8 * sel;
                float tl[20];
#pragma unroll
                for (int k4 = 0; k4 < 5; ++k4) { const f32x4 w = *(const LAS f32x4*)(RS + sel * 32 + 4 * k4); tl[4 * k4] = w[0]; tl[4 * k4 + 1] = w[1]; tl[4 * k4 + 2] = w[2]; tl[4 * k4 + 3] = w[3]; }
                float gl[4];
#pragma unroll
                for (int k = 0; k < 4; ++k) gl[k] = tl[k] + a.in[12][k];
                int gi = 0; float gm = gl[0];
#pragma unroll
                for (int k = 1; k < 4; ++k) if (gl[k] > gm) { gm = gl[k]; gi = k; }
                float gs = 0.f;
#pragma unroll
                for (int k = 0; k < 4; ++k) gs += __expf(gl[k] - gm);
                const float gwt = 1.f / gs;
                float el[4];
#pragma unroll
                for (int k = 0; k < 4; ++k) { const float se = gi == 0 ? tl[4 + k] : (gi == 1 ? tl[8 + k] : (gi == 2 ? tl[12 + k] : tl[16 + k])); el[k] = se + a.in[14][4 * gi + k]; }
                int i1 = 0; float v1 = el[0];
#pragma unroll
                for (int k = 1; k < 4; ++k) if (el[k] > v1) { v1 = el[k]; i1 = k; }
                int i2 = (i1 + 1) & 3; float v2 = -3.0e38f;
#pragma unroll
                for (int k = 0; k < 4; ++k) if (k != i1 && el[k] > v2) { v2 = el[k]; i2 = k; }
                const float ex = __expf(v2 - v1), w1 = gwt / (1.f + ex), w2 = gwt * ex / (1.f + ex);
                if (lane < 4) {
                    const int e1 = 4 * gi + i1, e2 = 4 * gi + i2;
                    const unsigned p1 = __hip_atomic_fetch_add(LC + e1, 1u, __ATOMIC_RELAXED, __HIP_MEMORY_SCOPE_WORKGROUP);
                    const unsigned p2 = __hip_atomic_fetch_add(LC + e2, 1u, __ATOMIC_RELAXED, __HIP_MEMORY_SCOPE_WORKGROUP);
                    LR[rl * 4 + 0] = ((unsigned)e1 << 16) | p1; LR[rl * 4 + 1] = ((unsigned)e2 << 16) | p2; LR[rl * 4 + 2] = __float_as_uint(w1); LR[rl * 4 + 3] = __float_as_uint(w2);
                }
            }
            asm volatile("s_waitcnt lgkmcnt(0)" ::: "memory");
        }
        __syncthreads();
        if (tid < 16) LB[tid] = __hip_atomic_fetch_add(ctl + CW_CNT + 64 * tid, LC[tid], __ATOMIC_RELAXED, __HIP_MEMORY_SCOPE_AGENT);
        __syncthreads();
        if (tid < 256) {
            const int rl = tid >> 1, j = tid & 1; const unsigned rec = LR[rl * 4 + j]; const unsigned e = rec >> 16, pos = LB[e] + (rec & 0xffffu);
            ltok[e * TT + pos] = t0 + rl; tw[2 * (t0 + rl) + j] = __uint_as_float(LR[rl * 4 + 2 + j]); tinfo[2 * (t0 + rl) + j] = (e << 16) | pos;
        }
        __syncthreads();
    }
#undef P6_LOADROW
#undef P6_LN
#undef P6_VAR
#undef P6_STORE
#undef P6_DOT
}
__device__ __forceinline__ void build_tile_tables(const Args& a, LAS unsigned char* lds, int tid) {
    LAS int* ts = (LAS int*)(lds + LDS_TS_OFF); LAS int* te = (LAS int*)(lds + LDS_TE_OFF); LAS int* cn = (LAS int*)(lds + LDS_CNT_OFF);
    gu32* ctl = (gu32*)a.ws;
    if (tid == 0) { int acc = 0;
        for (int e = 0; e < 16; ++e) { ts[e] = acc; const int c = (int)__hip_atomic_load(ctl + CW_CNT + 64 * e, __ATOMIC_RELAXED, __HIP_MEMORY_SCOPE_AGENT); const int nt = (c + 255) >> 8; cn[e] = c;
            for (int k = 0; k < nt; ++k) te[acc + k] = e; acc += nt; }
        ts[16] = acc; }
    __syncthreads();
}
__device__ __forceinline__ void p9_phase(const Args& a, LAS unsigned char* lds, int vcu, int G, int wave, int lane) {
    unsigned char* ws = a.ws;
    const LAS int* ts = (const LAS int*)(lds + LDS_TS_OFF);
    const unsigned* tinfo = (const unsigned*)(ws + WS_TINFO); const u32x2* Y = (const u32x2*)(ws + WS_Y);
    const float* g2 = a.in[18]; const float* b2 = a.in[19];
    const int gw = vcu * NWAVES + wave, NGW = G * NWAVES;
    u32x2 ny0[4], ny1[4], nxw[4]; float nw0 = 0.f, nw1 = 0.f;
    const float* tw = (const float*)(ws + WS_WSLOT);
    auto issue = [&](int t) {
        const unsigned i0 = tinfo[2 * t], i1 = tinfo[2 * t + 1];
        nw0 = tw[2 * t]; nw1 = tw[2 * t + 1];
        const size_t s0 = (size_t)ts[i0 >> 16] * 256 + (i0 & 0xffffu), s1 = (size_t)ts[i1 >> 16] * 256 + (i1 & 0xffffu);
        const u32x2* xb1 = (const u32x2*)(ws + WS_XB) + (size_t)t * 256 + lane;
#pragma unroll
        for (int j = 0; j < 4; ++j) { ny0[j] = Y[s0 * 256 + lane + 64 * j]; ny1[j] = Y[s1 * 256 + lane + 64 * j]; nxw[j] = xb1[64 * j]; }
    };
    if (gw < TT) issue(gw);
    for (int t = gw; t < TT; t += NGW) {
        f32x4* xr = (f32x4*)(a.out + (size_t)t * DM) + lane;
        f32x4 v[4]; float s = 0.f; const float w0 = nw0, w1 = nw1;
#pragma unroll
        for (int j = 0; j < 4; ++j) {
            const u32x2 y0 = ny0[j], y1 = ny1[j], xw = nxw[j];
            f32x4 x = (f32x4){bflo(xw.x), bfhi(xw.x), bflo(xw.y), bfhi(xw.y)} * DN_ALPHA;
            x.x += w0 * bflo(y0.x) + w1 * bflo(y1.x); x.y += w0 * bfhi(y0.x) + w1 * bfhi(y1.x); x.z += w0 * bflo(y0.y) + w1 * bflo(y1.y); x.w += w0 * bfhi(y0.y) + w1 * bfhi(y1.y);
            v[j] = x; s += (x.x + x.y) + (x.z + x.w);
        }
        if (t + NGW < TT) issue(t + NGW);
        const float mean = wave_sum(s) * (1.f / DM); float s2 = 0.f;
#pragma unroll
        for (int j = 0; j < 4; ++j) { v[j] = v[j] - mean; s2 += (v[j].x * v[j].x + v[j].y * v[j].y) + (v[j].z * v[j].z + v[j].w * v[j].w); }
        const float rstd = 1.f / sqrtf(wave_sum(s2) * (1.f / DM) + LN_EPSF);
#pragma unroll
        for (int j = 0; j < 4; ++j) { const f32x4 gg = *(const f32x4*)(g2 + 4 * lane + 256 * j), bb = *(const f32x4*)(b2 + 4 * lane + 256 * j); xr[64 * j] = v[j] * rstd * gg + bb; }
    }
}

__global__ void __launch_bounds__(NWAVES * 64, 2) mega_fwd(Args args) {
    extern __shared__ __attribute__((aligned(16))) unsigned char lds_raw[];
    LAS unsigned char* lds = (LAS unsigned char*)lds_raw;
    volatile LAS unsigned* MISC = (volatile LAS unsigned*)(lds + MISC_OFF);
    const int tid0 = threadIdx.x, wave = __builtin_amdgcn_readfirstlane(tid0 >> 6);
    const int G = gridDim.x, bx = blockIdx.x, vcu = (G % 8 == 0) ? (bx % 8) * (G / 8) + bx / 8 : bx;
    for (int u = tid0; u < (LDS_BYTES - LDSCTL_OFF) / 4; u += NWAVES * 64) ((LAS unsigned*)(lds + LDSCTL_OFF))[u] = 0u;
    __syncthreads();
    unsigned char* ws = args.ws;
    gu32* ctl = (gu32*)ws;
    const bool bars_on = (args.mask >> 31) != 0u;
    XcdBarrier bar; bar.bar = (unsigned*)(ctl + CW_BAR) + args.bar_region * XCD_BAR_WORDS; bar.x = 0; bar.st = nullptr;
    if (bars_on) bar = xcd_barrier_post((unsigned*)(ctl + CW_BAR) + args.bar_region * XCD_BAR_WORDS, MISC + 8);
    bar.wv = wave;
#define GRID_BAR() do { if (bars_on) xcd_barrier(bar); } while (0)
#ifndef PH_LAST
#define PH_LAST 99
#endif
#define FRESH() int tid = wave * 64 + pg8::lane_id(); asm volatile("" : "+v"(tid)); const int lane = tid & 63; (void)lane
#ifndef RMASK
#define RMASK 0
#endif
#define REP(k) _Pragma("unroll") for (int rep_ = 0; rep_ < 1 + ((RMASK >> (k)) & 1); ++rep_)
#ifndef STAMP_SCALE
#define STAMP_SCALE 1.0f
#endif
#ifdef STAMP_PH
#define ST_B(k) if ((k) == STAMP_PH) { st_a = rt(); }
#define ST_E(k) if ((k) == STAMP_PH) { st_b = rt(); }
#else
#define ST_B(k)
#define ST_E(k)
#endif
#ifdef ONLY
#define EN(k) (ONLY == (k))
#else
#define EN(k) ((args.mask >> (k)) & 1u)
#endif
    unsigned long long st_a = 0, st_b = 0; (void)st_a; (void)st_b;
    REP(0) if (EN(0)) { FRESH(); p0_prologue(args, lds, vcu, G, tid, wave, lane); }
    GRID_BAR();
#ifdef STAGGER_TICKS
    if (EN(1) && (bx & 8)) { const unsigned long long t0_ = rt(); while (rt() - t0_ < STAGGER_TICKS) __builtin_amdgcn_s_sleep(32); }
#endif
    REP(1) if (EN(1)) {
        pg8::Gemm g{(const pg8::bf16_t*)(ws + WS_XB), (const pg8::bf16_t*)(ws + WS_WIN), TT, 4608, 1024}; pg8::StaticOrder S; S.init(TT, 4608, G, bx);
        pg8::EpiHcat E{ws, (const float*)(ws + WS_ROT), 0};
        pg8::gemm_phase<pg8::EpiHcat, pg8::StaticOrder, true, true>(lds, g, S, E, wave);
    }
    GRID_BAR();
    if (PH_LAST >= 2) {
        REP(2) if (EN(2)) { FRESH(); for (int it = vcu; it < 256; it += G) chain_item(args, lds, it, tid, wave, lane); }
        if (EN(3)) { { FRESH(); attn_dil_phase<16>(args, lds, vcu, G, tid, wave, lane); }
                     { FRESH(); attn_dil_phase<4>(args, lds, vcu, G, tid, wave, lane); } }
    }
    GRID_BAR();
    ST_B(4) if (PH_LAST >= 3 && EN(4)) { FRESH(); p3_phase<0>(args, lds, vcu, G, tid, wave, lane); }
    if (EN(13)) { FRESH(); attn_p1_phase(args, lds, vcu, G, tid, wave, lane); }
    GRID_BAR(); ST_E(4)
    if (EN(14)) { FRESH(); p0_expert_weights(args, lds, vcu, G, wave, lane); }
    REP(5) if (PH_LAST >= 4 && EN(5)) {
        pg8::Gemm g{(const pg8::bf16_t*)(ws + WS_XB), (const pg8::bf16_t*)(ws + WS_WIN) + (size_t)4608 * 1024, TT, 2048, 1024}; pg8::GateOrder S; S.S4.init(TT, 1024, G, bx);
        pg8::EpiHcat E{ws, (const float*)(ws + WS_ROT), 18};
        pg8::gemm_phase<pg8::EpiHcat, pg8::GateOrder, true, true>(lds, g, S, E, wave);
        asm volatile("s_waitcnt vmcnt(0)" ::: "memory"); __syncthreads();
    }
    REP(6) if (PH_LAST >= 5 && EN(6)) {
        pg8::StaticOrder S; S.init(TT, 1024, G, bx);
        { pg8::Gemm g{(const pg8::bf16_t*)(ws + WS_OA), (const pg8::bf16_t*)(ws + WS_WA), TT, 1024, 512};
          pg8::EpiGate<false> E{(const pg8::bf16_t*)(ws + WS_GATE_A), (pg8::bf16_t*)(ws + WS_MERGED)};
          pg8::gemm_phase<pg8::EpiGate<false>, pg8::StaticOrder, true, true>(lds, g, S, E, wave); }
        asm volatile("s_waitcnt vmcnt(0)" ::: "memory"); __syncthreads();
        { pg8::Gemm g{(const pg8::bf16_t*)(ws + WS_GR), (const pg8::bf16_t*)(ws + WS_WR), TT, 1024, 1024};
          pg8::EpiGate<true> E{(const pg8::bf16_t*)(ws + WS_GATE_R), (pg8::bf16_t*)(ws + WS_MERGED)};
          pg8::gemm_phase<pg8::EpiGate<true>, pg8::StaticOrder, true, true>(lds, g, S, E, wave); }
    }
    GRID_BAR();
    REP(7) if (PH_LAST >= 6 && EN(7)) {
        pg8::Gemm g{(const pg8::bf16_t*)(ws + WS_MERGED), (const pg8::bf16_t*)(ws + WS_WO), TT, 1024, 1024}; pg8::StaticOrder S; S.init(TT, 1024, G, bx);
        pg8::EpiResBf16 E{(const pg8::bf16_t*)(ws + WS_XB), (pg8::bf16_t*)args.out, DN_ALPHA};
        pg8::gemm_phase<pg8::EpiResBf16, pg8::StaticOrder, true, true>(lds, g, S, E, wave);
    }
    GRID_BAR();
    ST_B(8) if (PH_LAST >= 7 && EN(8)) { FRESH(); p6a_phase(args, lds, vcu, G, tid, wave, lane); }
    GRID_BAR(); ST_E(8)
    { FRESH(); build_tile_tables(args, lds, tid); }
    const int nrt = ((const LAS int*)(lds + LDS_TS_OFF))[16];
    REP(10) if (PH_LAST >= 9 && EN(10)) {
#if M1_FP8
        pg8::Gemm g{(const pg8::bf16_t*)(ws + WS_X1F8), (const pg8::bf16_t*)(ws + WS_WGU), MAXSLOT, 1024, 512};
        pg8::MoeOrder S{nrt * 4, G, vcu, (const LAS int*)(lds + LDS_TE_OFF), (const LAS int*)(lds + LDS_TS_OFF), (const LAS int*)(lds + LDS_CNT_OFF), (const int*)(ws + WS_LTOK), 1024u};
        pg8::EpiSwiGLU E{ws + WS_H};
        pg8::gemm_phase<pg8::EpiSwiGLU, pg8::MoeOrder, true, true, true, true, 1, 0>(lds, g, S, E, wave);
#else
        pg8::Gemm g{(const pg8::bf16_t*)(ws + WS_XB), (const pg8::bf16_t*)(ws + WS_WGU), MAXSLOT, 1024, 1024};
        pg8::MoeOrder S{nrt * 4, G, vcu, (const LAS int*)(lds + LDS_TE_OFF), (const LAS int*)(lds + LDS_TS_OFF), (const LAS int*)(lds + LDS_CNT_OFF), (const int*)(ws + WS_LTOK), 2048u};
        pg8::EpiSwiGLU E{ws + WS_H};
        pg8::gemm_phase<pg8::EpiSwiGLU, pg8::MoeOrder, true, true, true>(lds, g, S, E, wave);
#endif
    }
    GRID_BAR();
    REP(11) if (PH_LAST >= 10 && EN(11)) {
        pg8::Gemm g{(const pg8::bf16_t*)(ws + WS_H), (const pg8::bf16_t*)(ws + WS_WD), MAXSLOT, 1024, 256};
        pg8::MoeOrder S{nrt * 4, G, vcu, (const LAS int*)(lds + LDS_TE_OFF), (const LAS int*)(lds + LDS_TS_OFF), (const LAS int*)(lds + LDS_CNT_OFF), (const int*)(ws + WS_LTOK), 1024u};
        pg8::EpiRowScale E{(pg8::bf16_t*)(ws + WS_Y)};
        pg8::gemm_phase<pg8::EpiRowScale, pg8::MoeOrder, true, true, false, true, 1, 2>(lds, g, S, E, wave);
    }
    GRID_BAR();
    ST_B(12) if (PH_LAST >= 11 && EN(12)) { FRESH(); p9_phase(args, lds, vcu, G, wave, lane); }
#ifdef STAMP_PH
    GRID_BAR(); ST_E(12)
    if (STAMP_PH == 13) { st_a = rt(); GRID_BAR(); GRID_BAR(); GRID_BAR(); GRID_BAR(); st_b = rt(); }
    if (bx == 0 && tid0 == 0) { const float us = (float)(st_b - st_a) * 0.01f * STAMP_SCALE; int k = 0; float lim = 30.f; while (us >= lim && k < 12) { lim *= 1.5f; ++k; }
        __hip_atomic_store(ctl + CW_CHK, __float_as_uint(sqrtf(2.f * k + 2.f)), RLX_AGENT); }
    GRID_BAR();
    { const float c = __uint_as_float(__hip_atomic_load(ctl + CW_CHK, RLX_AGENT)); f32x4* o4 = (f32x4*)args.out;
      for (size_t i = (size_t)bx * 512 + tid0; i < (size_t)TT * DM / 4; i += (size_t)G * 512) o4[i] = (f32x4){c, c, c, c}; }
#endif
}

#ifdef PROBE_VAR
__global__ void __launch_bounds__(NWAVES * 64, 2) probe_kernel(Args args) {
    extern __shared__ __attribute__((aligned(16))) unsigned char lds_raw[];
    LAS unsigned char* lds = (LAS unsigned char*)lds_raw;
    const int tid0 = threadIdx.x, wave = __builtin_amdgcn_readfirstlane(tid0 >> 6);
    const int G = gridDim.x, bx = blockIdx.x, vcu = (G % 8 == 0) ? (bx % 8) * (G / 8) + bx / 8 : bx;
    FRESH();
    if (PROBE_VAR == 20 || PROBE_VAR == 21) {
        unsigned char* ws = args.ws;
        pg8::Gemm g{(const pg8::bf16_t*)(ws + WS_XB), (const pg8::bf16_t*)(ws + WS_WIN), TT, 4608, 1024}; pg8::StaticOrder S; S.init(TT, 4608, G, bx);
        pg8::EpiHcatT<PROBE_VAR == 21 ? 1 : 0> E{ws, (const float*)(ws + WS_ROT), 0};
        pg8::gemm_phase<pg8::EpiHcatT<PROBE_VAR == 21 ? 1 : 0>, pg8::StaticOrder, true, true>(lds, g, S, E, wave);
    }
    if (PROBE_VAR == 10) p3_phase<0>(args, lds, vcu, G, tid, wave, lane);
    if (PROBE_VAR == 11) p3_phase<1>(args, lds, vcu, G, tid, wave, lane);
    if (PROBE_VAR == 0) attn_dil_phase<16, 0>(args, lds, vcu, G, tid, wave, lane);
    if (PROBE_VAR == 1) attn_dil_phase<16, 1>(args, lds, vcu, G, tid, wave, lane);
    if (PROBE_VAR == 2) attn_dil_phase<4, 0>(args, lds, vcu, G, tid, wave, lane);
    if (PROBE_VAR == 3) attn_dil_phase<4, 1>(args, lds, vcu, G, tid, wave, lane);
}
#endif
extern "C" void kernel_launch(void* const* d_in, const int* in_sizes, int n_in, void* d_out, int out_size, void* d_ws, size_t ws_size, hipStream_t stream) {
    static int grid = 0;
    if (grid == 0) {
        if (n_in != 20 || in_sizes[0] != TT * DM || out_size != TT * DM || ws_size < WS_END) { fprintf(stderr, "kernel_launch: unexpected shapes: n_in %d in0 %d out %d ws %zu; nothing launched\n", n_in, n_in > 0 ? in_sizes[0] : -1, out_size, ws_size); grid = -1; return; }
        int dev = 0, cus = 0;
        if (hipGetDevice(&dev) != hipSuccess || hipDeviceGetAttribute(&cus, hipDeviceAttributeMultiprocessorCount, dev) != hipSuccess) { grid = -1; return; }
        if (hipFuncSetAttribute((const void*)mega_fwd, hipFuncAttributeMaxDynamicSharedMemorySize, LDS_BYTES) != hipSuccess) { fprintf(stderr, "kernel_launch: hipFuncSetAttribute failed\n"); grid = -1; return; }
        (void)hipGetLastError();
        grid = cus;
    }
    if (grid < 0) return;
    if (hipMemsetAsync((char*)d_ws, 0, CTL_ZERO_BYTES, stream) != hipSuccess) return;
    Args a{};
    for (int i = 0; i < 20; ++i) a.in[i] = (const float*)d_in[i];
    a.out = (float*)d_out; a.ws = (unsigned char*)d_ws; a.mask = 0x80007fffu; a.bar_region = 0;
#if defined(XTRA_FIRST)
    { Args x = a; x.mask = XTRA_FIRST; x.bar_region = 1; for (int r = 0; r < XTRA_REP; ++r) hipLaunchKernelGGL(mega_fwd, dim3(grid), dim3(NWAVES * 64), LDS_BYTES, stream, x);
      if (hipMemsetAsync((char*)d_ws, 0, CTL_ZERO_BYTES, stream) != hipSuccess) return; }
#endif
    hipLaunchKernelGGL(mega_fwd, dim3(grid), dim3(NWAVES * 64), LDS_BYTES, stream, a);
#if defined(PROBE_VAR)
    { hipFuncSetAttribute((const void*)probe_kernel, hipFuncAttributeMaxDynamicSharedMemorySize, LDS_BYTES);
      for (int r = 0; r < 4; ++r) hipLaunchKernelGGL(probe_kernel, dim3(grid), dim3(NWAVES * 64), LDS_BYTES, stream, a); }
#endif
#if defined(XTRA_AFTER)
    { Args x = a; x.mask = XTRA_AFTER; x.bar_region = 1; for (int r = 0; r < XTRA_REP; ++r) hipLaunchKernelGGL(mega_fwd, dim3(grid), dim3(NWAVES * 64), LDS_BYTES, stream, x); }
#endif
}
```

```cpp
#define P1_FP8 1
#define P1_FP8_FROM 4
#include <hip/hip_runtime.h>
#include <cstdio>
#include <cstdint>

constexpr int TT = 32768, DM = 1024, SEQ = 2048, NB = 16;
constexpr float DN_ALPHA = 1.189207115002721f;
constexpr float LN_EPSF = 1e-5f;
constexpr size_t MiB = 1u << 20;
constexpr size_t CTL_ZERO_BYTES = 1 * MiB;
constexpr size_t WS_ROT = 1 * MiB;
constexpr size_t WS_BIAS = 2 * MiB;
constexpr size_t WS_LTOK = 3 * MiB;
constexpr size_t WS_TINFO = 7 * MiB;
constexpr size_t WS_WSLOT = 7 * MiB + 512 * 1024;
constexpr size_t WS_WIN = 8 * MiB;
constexpr size_t WS_WIN8 = 66 * MiB;
constexpr size_t WS_WR = 21 * MiB;
constexpr size_t WS_WA = 23 * MiB;
constexpr size_t WS_WO = 24 * MiB;
constexpr size_t WS_WGU = 26 * MiB;
constexpr size_t WS_WD = 58 * MiB;
constexpr size_t WS_XB = 80 * MiB;
constexpr size_t WS_QR = 144 * MiB;
constexpr size_t WS_KR = 176 * MiB;
constexpr size_t WS_VR = 208 * MiB;
constexpr size_t WS_GR = 272 * MiB;
constexpr size_t WS_QA = 336 * MiB, WS_KA = 368 * MiB, WS_VA = 400 * MiB, WS_OA = 432 * MiB;
constexpr size_t WS_GATE_R = 144 * MiB, WS_GATE_A = 208 * MiB;
constexpr size_t WS_MERGED = 336 * MiB;
constexpr size_t WS_Y = 144 * MiB;
constexpr size_t WS_H = 336 * MiB;
constexpr size_t WS_X1F8 = 464 * MiB;
constexpr size_t WS_O2 = 26 * MiB;
constexpr size_t WS_O3 = 464 * MiB;
constexpr size_t WS_LSE2 = 496 * MiB, WS_LSE3 = 497 * MiB;
constexpr size_t WS_END = 512 * MiB;
#ifndef M1_FP8
#define M1_FP8 1
#endif
#ifndef P1_FP8
#define P1_FP8 0
#endif
#ifndef P1_FP8_FROM
#define P1_FP8_FROM 0
#endif
constexpr int MAXSLOT = 69632;
constexpr int CW_BAR = 4096;
constexpr int CW_CNT = 16384;
constexpr int CW_CHK = 24576;
namespace pg8 {
#define PG8_LAS __attribute__((address_space(3)))
typedef unsigned short bf16_t;
typedef short bf16x8 __attribute__((ext_vector_type(8)));
typedef float f32x4 __attribute__((ext_vector_type(4)));
typedef unsigned u32x4 __attribute__((ext_vector_type(4)));
constexpr int BM = 256, BK = 64, HALF = 128, HTB = HALF * BK * 2  , STAGE_BYTES = 8 * HTB, NXCD = 8, WGM = 8;

__device__ __forceinline__ int lane_id() { int x; asm volatile("v_mbcnt_lo_u32_b32 %0, -1, 0\n\tv_mbcnt_hi_u32_b32 %0, -1, %0" : "=v"(x)); return x; }
__host__ __device__ __forceinline__ int lds_byte(int r, int c) { const int st = (r >> 4) * 2 + (c >> 5), rr = r & 15, cc = c & 31, ob = rr * 64 + cc * 2; return st * 1024 + (ob ^ (((ob >> 9) & 1) << 5)); }
__host__ __device__ __forceinline__ void stage_rc(int b, int& R, int& C) { const int st = b / 1024, sb = b % 1024, swz = sb ^ (((sb >> 9) & 1) << 5); R = (st >> 1) * 16 + swz / 64; C = (st & 1) * 32 + (swz % 64) / 2; }
__host__ __device__ __forceinline__ int perm32(int rho) { const int n = rho >> 4, i = rho & 15; return 8 * (i >> 2) + 4 * n + (i & 3); }

struct Unit { int pm, pn; };
struct Gemm { const bf16_t* A; const bf16_t* Bt; int M, N, K; };

struct StaticOrder {
    int nM, nN, nwg, G, c, pn0;
    __host__ __device__ void init(int M, int N, int G_, int c_, int pn0_ = 0) { nM = M / BM; nN = N / BM; nwg = nM * nN; G = G_; c = c_; pn0 = pn0_; }
    __host__ __device__ bool next(int i, Unit& u) const {
        const long L = (long)i * G + c; if (L >= nwg) return false;
        int wgid = (int)L; { const int q = nwg / NXCD, r = nwg % NXCD, xcd = wgid % NXCD, off = wgid / NXCD; wgid = (xcd < r ? xcd * (q + 1) : r * (q + 1) + (xcd - r) * q) + off; }
        const int nig = WGM * nN, gid = wgid / nig, fm = gid * WGM, gsz = (nM - fm) < WGM ? (nM - fm) : WGM;
        u.pm = fm + ((wgid % nig) % gsz); u.pn = pn0 + (wgid % nig) / gsz; return true;
    }
    __device__ __forceinline__ void a_ready(const Unit&) const {}
    __device__ __forceinline__ void done(const Unit&) const {}
};

__device__ __forceinline__ unsigned cvt_pk_bf16(float lo, float hi) { unsigned r; asm volatile("v_cvt_pk_bf16_f32 %0, %1, %2" : "=v"(r) : "v"(lo), "v"(hi)); return r; }
typedef float cvt_f32x2_t __attribute__((ext_vector_type(2))); typedef __bf16 cvt_bf16x2_t __attribute__((ext_vector_type(2)));
__device__ __forceinline__ unsigned cvt_pk_bf16_acc(float lo, float hi) { const cvt_f32x2_t v = {lo, hi}; const cvt_bf16x2_t b = __builtin_convertvector(v, cvt_bf16x2_t); return __builtin_bit_cast(unsigned, b); }
__device__ __forceinline__ float bflo(unsigned w) { return __uint_as_float(w << 16); }
__device__ __forceinline__ float bfhi(unsigned w) { return __uint_as_float(w & 0xffff0000u); }
__device__ __forceinline__ float fsigmoid(float x) { return __builtin_amdgcn_rcpf(1.f + __expf(-x)); }
__device__ __forceinline__ float fsilu(float x) { return x * __builtin_amdgcn_rcpf(1.f + __expf(-x)); }

template <int VAR = 0> struct EpiHcatT {
    static constexpr bool PERM = true, AFTER_DRAIN = false; static constexpr int NSTORE = 16;
    unsigned char* ws; const float* rot; int tile_off;
    __device__ __forceinline__ void operator()(const f32x4 (&acc)[2][2][4][2], const Unit& u, int wr, int wc, int fr, int fq) const {
        if (VAR == 1) {
            float s = 0.f;
#pragma unroll
            for (int ai = 0; ai < 2; ++ai)
#pragma unroll
                for (int bj = 0; bj < 2; ++bj)
#pragma unroll
                    for (int m = 0; m < 4; ++m)
#pragma unroll
                        for (int n = 0; n < 2; ++n) s += (acc[ai][bj][m][n][0] + acc[ai][bj][m][n][1]) + (acc[ai][bj][m][n][2] + acc[ai][bj][m][n][3]);
            ((float*)(ws + WS_O3))[(size_t)(u.pm * 64 + u.pn) * 512 + wr * 256 + wc * 64 + fq * 16 + fr] = s; return;
        }
        const int gt = u.pn + tile_off;
        size_t base_off; int pitch, ct, mode; float sc = 1.f;
        if (gt < 2)       { base_off = WS_QR; pitch = 512;  ct = gt;      mode = 1; }
        else if (gt < 4)  { base_off = WS_KR; pitch = 512;  ct = gt - 2;  mode = 1; sc = 0.08838834764831845f; }
        else if (gt < 8)  { base_off = WS_VR; pitch = 1024; ct = gt - 4;  mode = 0; }
        else if (gt < 12) { base_off = WS_GR; pitch = 1024; ct = gt - 8;  mode = 2; }
        else if (gt < 14) { base_off = WS_QA; pitch = 512;  ct = gt - 12; mode = 0; sc = 0.18033688011112042f; }
        else if (gt < 16) { base_off = WS_KA; pitch = 512;  ct = gt - 14; mode = 0; }
        else if (gt < 18) { base_off = WS_VA; pitch = 512;  ct = gt - 16; mode = 0; }
        else if (gt < 22) { base_off = WS_GATE_R; pitch = 1024; ct = gt - 18; mode = 3; }
        else              { base_off = WS_GATE_A; pitch = 1024; ct = gt - 22; mode = 3; }
        bf16_t* O = (bf16_t*)(ws + base_off);
        const int row0 = u.pm * BM + wr * 64 + fr, col0 = ct * BM + wc * 32 + 8 * fq;
#pragma unroll
        for (int ai = 0; ai < 2; ++ai)
#pragma unroll
            for (int m = 0; m < 4; ++m) {
                const int row = row0 + ai * HALF + m * 16;
                bf16_t* rowp = O + (size_t)row * pitch + col0;
                f32x4 cs = (f32x4){1.f, 1.f, 1.f, 1.f}, sn = (f32x4){0.f, 0.f, 0.f, 0.f};
                if (mode == 1) { const f32x4* rt = (const f32x4*)(rot + ((size_t)(row & (SEQ - 1)) * 16 + (4 * wc + fq)) * 8); cs = rt[0]; sn = rt[1]; }
#pragma unroll
                for (int bj = 0; bj < 2; ++bj) {
                    f32x4 v0 = acc[ai][bj][m][0], v1 = acc[ai][bj][m][1];
                    if (mode == 1) { const f32x4 a = v0 * cs - v1 * sn, b = v0 * sn + v1 * cs; v0 = a * sc; v1 = b * sc; }
                    else if (mode == 2) {
#pragma unroll
                        for (int e = 0; e < 4; ++e) { v0[e] = fsilu(v0[e]); v1[e] = fsilu(v1[e]); } }
                    else if (mode == 3) {
#pragma unroll
                        for (int e = 0; e < 4; ++e) { v0[e] = fsigmoid(v0[e]); v1[e] = fsigmoid(v1[e]); } }
                    else { v0 = v0 * sc; v1 = v1 * sc; }
                    u32x4 w; w.x = cvt_pk_bf16(v0[0], v0[1]); w.y = cvt_pk_bf16(v0[2], v0[3]); w.z = cvt_pk_bf16(v1[0], v1[1]); w.w = cvt_pk_bf16(v1[2], v1[3]);
                    *(u32x4*)(rowp + bj * HALF) = w;
                }
            }
    }
};

typedef EpiHcatT<0> EpiHcat;

template <bool ADD> struct EpiGate {
    static constexpr bool PERM = true, AFTER_DRAIN = false; static constexpr int NSTORE = 16;
    const bf16_t* gate; bf16_t* O;
    __device__ __forceinline__ void operator()(const f32x4 (&acc)[2][2][4][2], const Unit& u, int wr, int wc, int fr, int fq) const {
        const int row0 = u.pm * BM + wr * 64 + fr, col0 = u.pn * BM + wc * 32 + 8 * fq;
#pragma unroll
        for (int ai = 0; ai < 2; ++ai)
#pragma unroll
            for (int m = 0; m < 4; ++m)
#pragma unroll
                for (int bj = 0; bj < 2; ++bj) {
                    const size_t p = (size_t)(row0 + ai * HALF + m * 16) * 1024 + col0 + bj * HALF;
                    const u32x4 g = *(const u32x4*)(gate + p);
                    f32x4 v0 = acc[ai][bj][m][0], v1 = acc[ai][bj][m][1];
                    v0[0] *= bflo(g.x); v0[1] *= bfhi(g.x); v0[2] *= bflo(g.y); v0[3] *= bfhi(g.y);
                    v1[0] *= bflo(g.z); v1[1] *= bfhi(g.z); v1[2] *= bflo(g.w); v1[3] *= bfhi(g.w);
                    if (ADD) { const u32x4 o = *(const u32x4*)(O + p);
                        v0[0] += bflo(o.x); v0[1] += bfhi(o.x); v0[2] += bflo(o.y); v0[3] += bfhi(o.y);
                        v1[0] += bflo(o.z); v1[1] += bfhi(o.z); v1[2] += bflo(o.w); v1[3] += bfhi(o.w); }
                    u32x4 w; w.x = cvt_pk_bf16(v0[0], v0[1]); w.y = cvt_pk_bf16(v0[2], v0[3]); w.z = cvt_pk_bf16(v1[0], v1[1]); w.w = cvt_pk_bf16(v1[2], v1[3]);
                    *(u32x4*)(O + p) = w;
                }
    }
};

struct EpiResBf16 {
    static constexpr bool PERM = true, AFTER_DRAIN = false; static constexpr int NSTORE = 16;
    const bf16_t* x; bf16_t* out; float alpha;
    __device__ __forceinline__ void operator()(const f32x4 (&acc)[2][2][4][2], const Unit& u, int wr, int wc, int fr, int fq) const {
        const int row0 = u.pm * BM + wr * 64 + fr, col0 = u.pn * BM + wc * 32 + 8 * fq;
#pragma unroll
        for (int ai = 0; ai < 2; ++ai)
#pragma unroll
            for (int m = 0; m < 4; ++m)
#pragma unroll
                for (int bj = 0; bj < 2; ++bj) {
                    const size_t p = (size_t)(row0 + ai * HALF + m * 16) * 1024 + col0 + bj * HALF;
                    const u32x4 xw = *(const u32x4*)(x + p);
                    const f32x4 x0 = (f32x4){bflo(xw.x), bfhi(xw.x), bflo(xw.y), bfhi(xw.y)}, x1 = (f32x4){bflo(xw.z), bfhi(xw.z), bflo(xw.w), bfhi(xw.w)};
                    const f32x4 v0 = x0 * alpha + acc[ai][bj][m][0], v1 = x1 * alpha + acc[ai][bj][m][1];
                    u32x4 w; w.x = cvt_pk_bf16(v0[0], v0[1]); w.y = cvt_pk_bf16(v0[2], v0[3]); w.z = cvt_pk_bf16(v1[0], v1[1]); w.w = cvt_pk_bf16(v1[2], v1[3]);
                    *(u32x4*)(out + p) = w;
                }
    }
};

struct EpiSwiGLU {
    static constexpr bool PERM = true, AFTER_DRAIN = false; static constexpr int NSTORE = 16;
    unsigned char* H;
    __device__ __forceinline__ void operator()(const f32x4 (&acc)[2][2][4][2], const Unit& u, int wr, int wc, int fr, int fq) const {
        const int row0 = u.pm * BM + wr * 64 + fr, col0 = (u.pn & 3) * 128 + wc * 16 + 4 * fq;
#pragma unroll
        for (int ai = 0; ai < 2; ++ai)
#pragma unroll
            for (int m = 0; m < 4; ++m)
#pragma unroll
                for (int bj = 0; bj < 2; ++bj) {
                    const f32x4 g = acc[ai][bj][m][0], up = acc[ai][bj][m][1];
                    float h0 = fsilu(g[0]) * up[0] * 8.f, h1 = fsilu(g[1]) * up[1] * 8.f, h2 = fsilu(g[2]) * up[2] * 8.f, h3 = fsilu(g[3]) * up[3] * 8.f;
                    h0 = fminf(fmaxf(h0, -448.f), 448.f); h1 = fminf(fmaxf(h1, -448.f), 448.f); h2 = fminf(fmaxf(h2, -448.f), 448.f); h3 = fminf(fmaxf(h3, -448.f), 448.f);
                    unsigned w = 0u; w = __builtin_amdgcn_cvt_pk_fp8_f32(h0, h1, w, false); w = __builtin_amdgcn_cvt_pk_fp8_f32(h2, h3, w, true);
                    *(unsigned*)(H + (size_t)(row0 + ai * HALF + m * 16) * 512 + col0 + bj * 64) = w;
                }
    }
};

struct EpiRowScale {
    static constexpr bool PERM = true, AFTER_DRAIN = false; static constexpr int NSTORE = 16;
    bf16_t* Y;
    __device__ __forceinline__ void operator()(const f32x4 (&acc)[2][2][4][2], const Unit& u, int wr, int wc, int fr, int fq) const {
        const int row0 = u.pm * BM + wr * 64 + fr, col0 = (u.pn & 3) * BM + wc * 32 + 8 * fq;
#pragma unroll
        for (int ai = 0; ai < 2; ++ai)
#pragma unroll
            for (int m = 0; m < 4; ++m) {
                const int row = row0 + ai * HALF + m * 16;
#pragma unroll
                for (int bj = 0; bj < 2; ++bj) {
                    const f32x4 v0 = acc[ai][bj][m][0], v1 = acc[ai][bj][m][1];
                    u32x4 w; w.x = cvt_pk_bf16_acc(v0[0], v0[1]); w.y = cvt_pk_bf16_acc(v0[2], v0[3]); w.z = cvt_pk_bf16_acc(v1[0], v1[1]); w.w = cvt_pk_bf16_acc(v1[2], v1[3]);
                    *(u32x4*)(Y + (size_t)row * 1024 + col0 + bj * HALF) = w;
                }
            }
    }
};

struct MoeOrder {
    int nunits, G, c; const PG8_LAS int* te; const PG8_LAS int* ts; const PG8_LAS int* cnt; const int* ltok; unsigned rowbytes;
    __device__ __forceinline__ bool next(int i, Unit& u) const {
        const int L = i * G + c, rt = (L >> 5) * 8 + (L & 7); if (rt >= (nunits >> 2)) return false;
        u.pm = rt; u.pn = te[rt] * 4 + ((L >> 3) & 3); return true;
    }
    __device__ __forceinline__ unsigned a_row_off(const Unit& u, int row) const {
        const int ex = te[u.pm], pos = (u.pm - ts[ex]) * 256 + row;
        const int tok = pos < cnt[ex] ? ltok[ex * 32768 + pos] : 0;
        return (unsigned)tok * rowbytes;
    }
    __device__ __forceinline__ void a_ready(const Unit&) const {}
    __device__ __forceinline__ void done(const Unit&) const {}
};

struct GateOrder {
    StaticOrder S4;
    __device__ __forceinline__ bool next(int i, Unit& u) const { Unit t; if (!S4.next(i >> 1, t)) return false; u.pm = t.pm; u.pn = t.pn + 4 * (i & 1); return true; }
    __device__ __forceinline__ void a_ready(const Unit&) const {}
    __device__ __forceinline__ void done(const Unit&) const {}
};

template <class Epi, class Sched, bool ALIGN_EPI = false, bool SP2 = false, bool GATHER = false, bool FP8 = false, int SEL_W = 0, int SEL_X = 0>
__device__ __forceinline__ void gemm_phase(PG8_LAS unsigned char* lds, const Gemm g, const Sched& S, const Epi& E, const int wid) {
    int tid = wid * 64 + lane_id(); asm volatile("" : "+v"(tid));
    const int lane = tid & 63, wr = wid >> 2, wc = wid & 3, fr = lane & 15, fq = lane >> 4;
    static_assert(SP2, "only the two-super-phase loop is kept");
    typedef int i32x4_ __attribute__((ext_vector_type(4)));
    const int K = g.K, nt = K / BK;
    unsigned voffB[2]; int rA[2], cA2[2];
#pragma unroll
    for (int i = 0; i < 2; ++i) { int R, C; stage_rc(tid * 16 + i * 8192, R, C); const int Rb = Epi::PERM ? ((R & ~31) + perm32(R & 31)) : R;
        rA[i] = R; cA2[i] = C * 2; voffB[i] = (unsigned)(Rb * K + C) * 2u; }
    unsigned vAc[2][2], vAn[2][2];
    const size_t kstep = (size_t)(BK * 2);
    const size_t hstep = (size_t)HALF * K * 2;
    const size_t tstep = 2 * hstep;
    const unsigned ldsw = (unsigned)wid * 1024u;
    const int aoff0 = lds_byte(wr * 64 + fr, fq * 8), aoff1 = aoff0 + 1024;
    const int boff0 = lds_byte(wc * 32 + fr, fq * 8), boff1 = boff0 + 1024;
#define PG8_SA(b, h) (((b) * 2 + (h)) * HTB)
#define PG8_SB(b, h) ((4 + (b) * 2 + (h)) * HTB)
#define PG8_STAGE(bufoff, gbase, voff) do { _Pragma("unroll") for (int _i = 0; _i < 2; ++_i) \
        __builtin_amdgcn_global_load_lds((const unsigned*)((const char*)(gbase) + (voff)[_i]), (PG8_LAS unsigned*)(lds + (bufoff) + ldsw + _i * 8192), 16, 0, 0); } while (0)
#define PG8_LDA(dst, b, h) do { _Pragma("unroll") for (int m = 0; m < 4; ++m) { dst[m][0] = *(const PG8_LAS bf16x8*)(lds + PG8_SA(b, h) + aoff0 + m * 2048); dst[m][1] = *(const PG8_LAS bf16x8*)(lds + PG8_SA(b, h) + aoff1 + m * 2048); } } while (0)
#define PG8_LDB(dst, b, h) do { _Pragma("unroll") for (int n = 0; n < 2; ++n) { dst[n][0] = *(const PG8_LAS bf16x8*)(lds + PG8_SB(b, h) + boff0 + n * 2048); dst[n][1] = *(const PG8_LAS bf16x8*)(lds + PG8_SB(b, h) + boff1 + n * 2048); } } while (0)
#define PG8_CAT8(x) __builtin_shufflevector(__builtin_bit_cast(i32x4_, (x)[0]), __builtin_bit_cast(i32x4_, (x)[1]), 0, 1, 2, 3, 4, 5, 6, 7)
#define PG8_MMA(ai, bj, At, Bt) do { __builtin_amdgcn_s_setprio(1); \
        if constexpr (FP8) { _Pragma("unroll") for (int m = 0; m < 4; ++m) _Pragma("unroll") for (int n = 0; n < 2; ++n) \
            acc[ai][bj][m][n] = __builtin_amdgcn_mfma_scale_f32_16x16x128_f8f6f4(PG8_CAT8(Bt[n]), PG8_CAT8(At[m]), acc[ai][bj][m][n], 0, 0, SEL_W, scl, SEL_X, scl); \
            asm volatile("" : "+v"(acc[ai][bj][0][0]), "+v"(acc[ai][bj][0][1]), "+v"(acc[ai][bj][1][0]), "+v"(acc[ai][bj][1][1]), "+v"(acc[ai][bj][2][0]), "+v"(acc[ai][bj][2][1]), "+v"(acc[ai][bj][3][0]), "+v"(acc[ai][bj][3][1])); } \
        else { _Pragma("unroll") for (int m = 0; m < 4; ++m) _Pragma("unroll") for (int n = 0; n < 2; ++n) _Pragma("unroll") for (int k = 0; k < 2; ++k) \
            acc[ai][bj][m][n] = __builtin_amdgcn_mfma_f32_16x16x32_bf16(Bt[n][k], At[m][k], acc[ai][bj][m][n], 0, 0, 0); } \
        __builtin_amdgcn_s_setprio(0); } while (0)
#define PG8_WAIT_V(n) asm volatile("s_waitcnt vmcnt(" #n ")" ::: "memory")
#define PG8_WAIT_VN(n) asm volatile("s_waitcnt vmcnt(%0)" :: "i"(n) : "memory")
#define PG8_WAIT_L(n) asm volatile("s_waitcnt lgkmcnt(" #n ")" ::: "memory")
#define PG8_BAR __builtin_amdgcn_s_barrier()
#define PG8_SCHED __builtin_amdgcn_sched_barrier(0)
    [[maybe_unused]] int scl = 0x7f7c797f; asm volatile("" : "+v"(scl));
    Unit cur, nxt; int ui = 0;
    if (!S.next(0, cur)) return;
    f32x4 acc[2][2][4][2];
#pragma unroll
    for (int a = 0; a < 2; ++a)
#pragma unroll
        for (int b = 0; b < 2; ++b)
#pragma unroll
            for (int m = 0; m < 4; ++m)
#pragma unroll
                for (int n = 0; n < 2; ++n) acc[a][b][m][n] = (f32x4){0.f, 0.f, 0.f, 0.f};
    bf16x8 At[4][2], B0[2][2], B1[2][2];
    const char* cA = GATHER ? (const char*)g.A : (const char*)g.A + (size_t)cur.pm * tstep; const char* cB = (const char*)g.Bt + (size_t)cur.pn * tstep;
#pragma unroll
    for (int h = 0; h < 2; ++h)
#pragma unroll
        for (int i = 0; i < 2; ++i) { if constexpr (GATHER) vAc[h][i] = S.a_row_off(cur, h * HALF + rA[i]) + (unsigned)cA2[i]; else vAc[h][i] = (unsigned)((h * HALF + rA[i]) * K) * 2u + (unsigned)cA2[i]; vAn[h][i] = vAc[h][i]; }
    S.a_ready(cur);
    if constexpr (SP2) {
        PG8_STAGE(PG8_SB(0, 0), cB, voffB); PG8_STAGE(PG8_SB(0, 1), cB + hstep, voffB); PG8_STAGE(PG8_SA(0, 0), cA, vAc[0]); PG8_STAGE(PG8_SA(0, 1), cA, vAc[1]);
        if (wr == 1) PG8_BAR;
        PG8_WAIT_V(2); PG8_BAR;
        PG8_STAGE(PG8_SB(1, 0), cB + kstep, voffB); PG8_STAGE(PG8_SA(1, 0), cA + kstep, vAc[0]); PG8_STAGE(PG8_SB(1, 1), cB + hstep + kstep, voffB);
        PG8_WAIT_V(6); PG8_BAR;
    }
    for (;;) {
        const bool has_next = S.next(ui + 1, nxt);
        const char* nA = GATHER ? cA : (has_next ? (const char*)g.A + (size_t)nxt.pm * tstep : cA); const char* nB = has_next ? (const char*)g.Bt + (size_t)nxt.pn * tstep : cB;
        if constexpr (GATHER) { if (has_next) {
#pragma unroll
            for (int h = 0; h < 2; ++h)
#pragma unroll
                for (int i = 0; i < 2; ++i) vAn[h][i] = S.a_row_off(nxt, h * HALF + rA[i]) + (unsigned)cA2[i]; } }
#pragma unroll 1
        for (int t = 0; t < nt; t += 2) {
            const bool last = (t == nt - 2);
            asm volatile("" : "+v"(voffB[0]), "+v"(voffB[1]), "+v"(vAc[0][0]), "+v"(vAc[0][1]), "+v"(vAc[1][0]), "+v"(vAc[1][1]));
            const char* a1 = cA + (size_t)(t + 1) * kstep;
            const char* a2 = last ? nA : cA + (size_t)(t + 2) * kstep; const char* b2 = last ? nB : cB + (size_t)(t + 2) * kstep;
            const char* a3 = a2 + kstep; const char* b3 = b2 + kstep;
            unsigned vA2[2][2];
#pragma unroll
            for (int h = 0; h < 2; ++h)
#pragma unroll
                for (int i = 0; i < 2; ++i) vA2[h][i] = vAc[h][i];
            if constexpr (GATHER) { if (last) {
                asm volatile("" : "+v"(vAn[0][0]), "+v"(vAn[0][1]), "+v"(vAn[1][0]), "+v"(vAn[1][1]));
#pragma unroll
                for (int h = 0; h < 2; ++h)
#pragma unroll
                    for (int i = 0; i < 2; ++i) vA2[h][i] = vAn[h][i]; } }
            if (last && has_next) S.a_ready(nxt);
            if constexpr (SP2) {
            const int lenient = __builtin_amdgcn_readfirstlane((ui > 0 && t == 0) ? 1 : 0);
#define PG8_WAIT_V8L() asm volatile("s_cmp_eq_u32 %0, 0\n\ts_cbranch_scc0 .Lpg8skip%=\n\ts_waitcnt vmcnt(8)\n.Lpg8skip%=:\n\ts_waitcnt vmcnt(%1)" :: "s"(lenient), "i"(8 + Epi::NSTORE) : "memory", "scc")
            PG8_LDB(B0, 0, 0); PG8_LDB(B1, 0, 1); PG8_SCHED; PG8_LDA(At, 0, 0); PG8_STAGE(PG8_SA(1, 1), a1, vAc[1]);
            PG8_WAIT_V8L(); PG8_WAIT_L(0); PG8_BAR; PG8_MMA(0, 0, At, B0); PG8_MMA(0, 1, At, B1); PG8_BAR; PG8_SCHED;
            PG8_LDA(At, 0, 1); PG8_STAGE(PG8_SB(0, 0), b2, voffB); PG8_STAGE(PG8_SB(0, 1), b2 + hstep, voffB); PG8_STAGE(PG8_SA(0, 0), a2, vA2[0]);
            PG8_WAIT_V8L(); PG8_WAIT_L(0); PG8_BAR; PG8_MMA(1, 0, At, B0); PG8_MMA(1, 1, At, B1); PG8_BAR; PG8_SCHED;
            PG8_LDB(B0, 1, 0); PG8_LDB(B1, 1, 1); PG8_SCHED; PG8_LDA(At, 1, 0); PG8_STAGE(PG8_SA(0, 1), a2, vA2[1]);
            PG8_WAIT_V(8); PG8_WAIT_L(0); PG8_BAR; PG8_MMA(0, 0, At, B0); PG8_MMA(0, 1, At, B1); PG8_BAR; PG8_SCHED;
            PG8_LDA(At, 1, 1); PG8_STAGE(PG8_SB(1, 0), b3, voffB); PG8_STAGE(PG8_SB(1, 1), b3 + hstep, voffB); PG8_STAGE(PG8_SA(1, 0), a3, vA2[0]);
            PG8_WAIT_V(8); PG8_WAIT_L(0); PG8_BAR; PG8_MMA(1, 0, At, B0); PG8_MMA(1, 1, At, B1); PG8_BAR; PG8_SCHED;
#undef PG8_WAIT_V8L
            }
        }
        if constexpr (ALIGN_EPI) { if (wr == 0) PG8_BAR; }
        if constexpr (!Epi::AFTER_DRAIN) { E(acc, cur, wr, wc, fr, fq); S.done(cur); }
        if (!has_next) break;
#pragma unroll
        for (int a = 0; a < 2; ++a)
#pragma unroll
            for (int b = 0; b < 2; ++b)
#pragma unroll
                for (int m = 0; m < 4; ++m)
#pragma unroll
                    for (int n = 0; n < 2; ++n) acc[a][b][m][n] = (f32x4){0.f, 0.f, 0.f, 0.f};
        cur = nxt; cA = nA; cB = nB; ++ui;
        if constexpr (GATHER) {
#pragma unroll
            for (int h = 0; h < 2; ++h)
#pragma unroll
                for (int i = 0; i < 2; ++i) vAc[h][i] = vAn[h][i]; }
        if constexpr (ALIGN_EPI) { if (wr == 1) PG8_BAR; }
    }
    PG8_WAIT_V(0);
    if constexpr (!ALIGN_EPI) { if (wr == 0) PG8_BAR; }
    PG8_BAR;
    if constexpr (Epi::AFTER_DRAIN) { E.fused(acc, cur, wr, wc, fr, fq, lds, wid, lane); S.done(cur); }
#undef PG8_SA
#undef PG8_SB
#undef PG8_STAGE
#undef PG8_LDA
#undef PG8_LDB
#undef PG8_MMA
#undef PG8_CAT8
#undef PG8_WAIT_V
#undef PG8_WAIT_VN
#undef PG8_WAIT_L
#undef PG8_BAR
#undef PG8_SCHED
}
}
#define GAS __attribute__((address_space(1)))
#define LAS __attribute__((address_space(3)))
typedef unsigned short bf16;
typedef unsigned v4u __attribute__((ext_vector_type(4)));
typedef float f32x4 __attribute__((ext_vector_type(4)));
typedef short bf16x8 __attribute__((ext_vector_type(8)));
typedef GAS unsigned gu32;
typedef GAS unsigned long long gu64;
#define RLX_AGENT __ATOMIC_RELAXED, __HIP_MEMORY_SCOPE_AGENT
#define LDS_WAIT() asm volatile("s_waitcnt lgkmcnt(0)" ::: "memory")
#define VM_WAIT() asm volatile("s_waitcnt vmcnt(0)" ::: "memory")
__device__ __forceinline__ unsigned long long rt() { return __builtin_amdgcn_s_memrealtime(); }
__device__ __forceinline__ unsigned f2bf(float f) { unsigned u = __builtin_bit_cast(unsigned, f); return (u + 0x7fffu + ((u >> 16) & 1u)) >> 16; }
__device__ __forceinline__ unsigned pk2(float lo, float hi) { return f2bf(lo) | (f2bf(hi) << 16); }

#define XB_TMO      128
#define XB_XCNT(j)  (256  + 64 * (j))
#define XB_XSUB(j)  (1280 + 64 * (j))
#define XB_XGEN(j)  (2304 + 64 * (j))
#define XB_TOP      3328
#define XB_TOPGEN   3392
#define XCD_BAR_WORDS 3456
#define XB_SPIN_CAP (1u << 18)

__device__ __forceinline__ unsigned xb_ld(unsigned* p)              { return __hip_atomic_load(p, __ATOMIC_RELAXED, __HIP_MEMORY_SCOPE_AGENT); }
__device__ __forceinline__ unsigned xb_add(unsigned* p, unsigned v) { return __hip_atomic_fetch_add(p, v, __ATOMIC_RELAXED, __HIP_MEMORY_SCOPE_AGENT); }
__device__ __forceinline__ unsigned xb_xcc_id() { return (unsigned)__builtin_amdgcn_s_getreg((3 << 11) | 20) & 0xFu; }
#define XB_SPIN(cond, bar) do { unsigned _sp = 0; while (cond) { __builtin_amdgcn_s_sleep(1); \
    if ((++_sp & 255u) == 0u) { if (xb_ld(&(bar)[XB_TMO])) break; if (_sp > XB_SPIN_CAP) { atomicAdd(&(bar)[XB_TMO], 1u); break; } } } } while (0)

struct XcdBarrier {
    unsigned* bar; unsigned x; int wv;
    volatile LAS unsigned* st;
};

__device__ __forceinline__ XcdBarrier xcd_barrier_post(unsigned* bar, volatile LAS unsigned* st) {
    XcdBarrier b; b.bar = bar; b.x = xb_xcc_id(); b.st = st; b.wv = 0;
    if (threadIdx.x == 0) (void)xb_add(&bar[XB_XCNT(b.x)], 1u);
    return b;
}
__device__ __forceinline__ void xcd_barrier_complete(unsigned* bar, unsigned x, unsigned& nloc, unsigned& nx) {
    const unsigned G = gridDim.x * gridDim.y * gridDim.z;
    unsigned sum, cnt, mine, sp = 0u;
    for (;;) {
        sum = 0u; cnt = 0u; mine = 0u;
#pragma unroll
        for (unsigned j = 0; j < 16; ++j) { const unsigned c = xb_ld(&bar[XB_XCNT(j)]); sum += c; cnt += (c > 0u) ? 1u : 0u; mine = (j == x) ? c : mine; }
        if (sum == G) break;
        __builtin_amdgcn_s_sleep(1);
        if ((++sp & 255u) == 0u) { if (xb_ld(&bar[XB_TMO])) break; if (sp > XB_SPIN_CAP) { atomicAdd(&bar[XB_TMO], 1u); break; } }
    }
    nloc = mine > 0u ? mine : 1u; nx = cnt > 0u ? cnt : 1u;
}

__device__ __forceinline__ void xcd_barrier(const XcdBarrier& b) {
    asm volatile("s_waitcnt vmcnt(0)" ::: "memory");
    __syncthreads();
    if (b.wv == 0 && (int)__builtin_amdgcn_mbcnt_hi(~0u, __builtin_amdgcn_mbcnt_lo(~0u, 0u)) == 0) {
        unsigned* bar = b.bar;
        __builtin_amdgcn_s_waitcnt(0);
        unsigned nloc = b.st[0], nx = b.st[1];
        if (nloc == 0u) { xcd_barrier_complete(bar, b.x, nloc, nx); b.st[0] = nloc; b.st[1] = nx; }
        const unsigned old = xb_add(&bar[XB_XSUB(b.x)], 1u);
        const unsigned gen = old / nloc;
        if (old + 1u == (gen + 1u) * nloc) {
            __builtin_amdgcn_fence(__ATOMIC_RELEASE, "agent");
            asm volatile("s_waitcnt vmcnt(0)" ::: "memory");
            const unsigned og = xb_add(&bar[XB_TOP], 1u);
            const unsigned tg = og / nx;
            if (og + 1u == (tg + 1u) * nx) xb_add(&bar[XB_TOPGEN], 1u);
            else XB_SPIN(xb_ld(&bar[XB_TOPGEN]) == tg, bar);
            __builtin_amdgcn_fence(__ATOMIC_ACQUIRE, "agent");
            xb_add(&bar[XB_XGEN(b.x)], 1u);
            asm volatile("s_waitcnt vmcnt(0)" ::: "memory");
        } else {
            XB_SPIN(xb_ld(&bar[XB_XGEN(b.x)]) == gen, bar);
            __builtin_amdgcn_fence(__ATOMIC_ACQUIRE, "agent");
            asm volatile("s_waitcnt vmcnt(0)" ::: "memory");
        }
    }
    __syncthreads();
}


constexpr int NWAVES = 8;
constexpr int RING_BYTES = 131072;
constexpr int LDSCTL_OFF = RING_BYTES, MISC_OFF = LDSCTL_OFF + 320;
constexpr int LDS_TS_OFF = LDSCTL_OFF + 1024;
constexpr int LDS_TE_OFF = LDSCTL_OFF + 2048;
constexpr int LDS_CNT_OFF = LDSCTL_OFF + 1024 + 128;
constexpr int LDS_BYTES = 163840;

typedef short s16x4 __attribute__((ext_vector_type(4)));
typedef unsigned u32x2 __attribute__((ext_vector_type(2)));

struct Args { const float* in[20]; float* out; unsigned char* ws; unsigned mask; int bar_region; };

__device__ __forceinline__ float bflo(unsigned w) { return __uint_as_float(w << 16); }
__device__ __forceinline__ float bfhi(unsigned w) { return __uint_as_float(w & 0xffff0000u); }
__device__ __forceinline__ unsigned cvtpk(float lo, float hi) { return pg8::cvt_pk_bf16(lo, hi); }
__device__ __forceinline__ float wave_sum(float v) {
#pragma unroll
    for (int o = 1; o < 64; o <<= 1) v += __shfl_xor(v, o);
    return v;
}
__device__ __forceinline__ unsigned offb(unsigned row, unsigned ch) { return 256u * row + 16u * (ch ^ (((row & 3u) << 2) | ((row >> 2) & 3u))); }
__device__ __forceinline__ s16x4 ldtr(const LAS unsigned char* p) { return __builtin_amdgcn_ds_read_tr16_b64_v4i16((LAS s16x4*)p); }
__device__ __forceinline__ bf16x8 cat8(s16x4 a, s16x4 b) { return (bf16x8){a[0], a[1], a[2], a[3], b[0], b[1], b[2], b[3]}; }
#define MFMA16(a, b, c) __builtin_amdgcn_mfma_f32_16x16x32_bf16((a), (b), (c), 0, 0, 0)

template <int MODE> __device__ __forceinline__ int dest_row(int n) {
    if (MODE == 1) { if (n >= 1024) return n; const int hb = n & ~127, d = n & 127, jr = d & 63, half = d >> 6; return hb + 8 * (jr >> 2) + 4 * half + (jr & 3); }
    if (MODE == 2) return ((n >> 2) << 3) + (n & 3);
    if (MODE == 3) return ((n >> 2) << 3) + 4 + (n & 3);
    return n;
}
template <int MODE> __device__ __forceinline__ void p0_transpose_item(const float* W, int K, int N, bf16* WT, LAS float* scr, int item, int lane) {
    const int nblk = N / 32, kb = item / nblk, nb = item % nblk, k0 = 64 * kb, n0 = 32 * nb;
    {
        const GAS f32x4* src = (const GAS f32x4*)(W + (size_t)(k0 + (lane >> 3)) * N + n0) + (lane & 7);
        f32x4 t[8];
#pragma unroll
        for (int j = 0; j < 8; ++j) t[j] = src[(size_t)j * 2 * N];
#pragma unroll
        for (int j = 0; j < 8; ++j) { LAS float* d = scr + ((lane >> 3) + 8 * j) * 33 + 4 * (lane & 7); d[0] = t[j].x; d[1] = t[j].y; d[2] = t[j].z; d[3] = t[j].w; }
    }
    LDS_WAIT(); asm volatile("" ::: "memory");
    const int c = lane & 7;
#pragma unroll
    for (int j = 0; j < 4; ++j) { const int n = (lane >> 3) + 8 * j; const LAS float* s = scr + (8 * c) * 33 + n;
        v4u o; o.x = pk2(s[0 * 33], s[1 * 33]); o.y = pk2(s[2 * 33], s[3 * 33]); o.z = pk2(s[4 * 33], s[5 * 33]); o.w = pk2(s[6 * 33], s[7 * 33]);
        *(GAS v4u*)(WT + (size_t)dest_row<MODE>(n0 + n) * K + k0 + 8 * c) = o; }
    LDS_WAIT(); asm volatile("" ::: "memory");
}
__device__ __forceinline__ unsigned pk_fp8x4(float a, float b, float c, float d) {
    a = fminf(fmaxf(a, -448.f), 448.f); b = fminf(fmaxf(b, -448.f), 448.f); c = fminf(fmaxf(c, -448.f), 448.f); d = fminf(fmaxf(d, -448.f), 448.f);
    unsigned w = 0u; w = __builtin_amdgcn_cvt_pk_fp8_f32(a, b, w, false); w = __builtin_amdgcn_cvt_pk_fp8_f32(c, d, w, true); return w;
}
template <int MODE> __device__ __forceinline__ void p0_transpose_item_fp8(const float* W, int K, int N, unsigned char* WT, LAS float* scr, int item, int lane, float scale) {
    const int nblk = N / 32, kb = item / nblk, nb = item % nblk, k0 = 64 * kb, n0 = 32 * nb;
    {
        const GAS f32x4* src = (const GAS f32x4*)(W + (size_t)(k0 + (lane >> 3)) * N + n0) + (lane & 7);
        f32x4 t[8];
#pragma unroll
        for (int j = 0; j < 8; ++j) t[j] = src[(size_t)j * 2 * N];
#pragma unroll
        for (int j = 0; j < 8; ++j) { LAS float* d = scr + ((lane >> 3) + 8 * j) * 33 + 4 * (lane & 7); d[0] = t[j].x; d[1] = t[j].y; d[2] = t[j].z; d[3] = t[j].w; }
    }
    LDS_WAIT(); asm volatile("" ::: "memory");
    const int c = lane & 7;
#pragma unroll
    for (int j = 0; j < 4; ++j) { const int n = (lane >> 3) + 8 * j; const LAS float* s = scr + (8 * c) * 33 + n;
        u32x2 o; o.x = pk_fp8x4(s[0 * 33] * scale, s[1 * 33] * scale, s[2 * 33] * scale, s[3 * 33] * scale); o.y = pk_fp8x4(s[4 * 33] * scale, s[5 * 33] * scale, s[6 * 33] * scale, s[7 * 33] * scale);
        *(GAS u32x2*)(WT + (size_t)dest_row<MODE>(n0 + n) * K + k0 + 8 * c) = o; }
    LDS_WAIT(); asm volatile("" ::: "memory");
}
__device__ __forceinline__ int t5_bucket(int rel) {
    const int n = rel < 0 ? -rel : rel;
    int large = 8 + (n >= 15) + (n >= 27) + (n >= 50) + (n >= 91) + (n >= 166) + (n >= 305) + (n >= 559);
    large = large < 15 ? large : 15;
    return (rel > 0 ? 16 : 0) + (n < 8 ? n : large);
}
__device__ __forceinline__ void p0_prologue(const Args& a, LAS unsigned char* lds, int vcu, int G, int tid, int wave, int lane) {
    unsigned char* ws = a.ws;
    LAS float* scr = (LAS float*)(lds + wave * 16384);
    const int gw = vcu * NWAVES + wave, NGW = G * NWAVES;
    constexpr int I_IN = 16 * 208, I_R = 16 * 32, I_A = 8 * 32, I_O = 16 * 32;
    constexpr int NITEMS = I_IN + I_R + I_A + I_O;
    for (int it = gw; it < NITEMS; it += NGW) {
        int r = it;
#if P1_FP8
        if (r < I_IN) { if (r % 208 < 144 && r % 208 >= 8 * P1_FP8_FROM) p0_transpose_item_fp8<1>(a.in[1], 1024, 6656, ws + WS_WIN8, scr, r, lane, 64.f);
                        else p0_transpose_item<1>(a.in[1], 1024, 6656, (bf16*)(ws + WS_WIN), scr, r, lane); continue; } r -= I_IN;
#else
        if (r < I_IN) { p0_transpose_item<1>(a.in[1], 1024, 6656, (bf16*)(ws + WS_WIN), scr, r, lane); continue; } r -= I_IN;
#endif
        if (r < I_R) { p0_transpose_item<0>(a.in[5], 1024, 1024, (bf16*)(ws + WS_WR), scr, r, lane); continue; } r -= I_R;
        if (r < I_A) { p0_transpose_item<0>(a.in[7], 512, 1024, (bf16*)(ws + WS_WA), scr, r, lane); continue; } r -= I_A;
        p0_transpose_item<0>(a.in[8], 1024, 1024, (bf16*)(ws + WS_WO), scr, r, lane);
    }
    {
        const f32x4* x4 = (const f32x4*)a.in[0]; u32x2* xb = (u32x2*)(ws + WS_XB);
#if P1_FP8
        unsigned* xf8 = (unsigned*)a.out;
        for (size_t i = (size_t)vcu * 512 + tid; i < (size_t)TT * DM / 4; i += (size_t)G * 512) { const f32x4 v = x4[i]; u32x2 o; o.x = cvtpk(v.x, v.y); o.y = cvtpk(v.z, v.w); xb[i] = o; xf8[i] = pk_fp8x4(v.x, v.y, v.z, v.w); }
#else
        for (size_t i = (size_t)vcu * 512 + tid; i < (size_t)TT * DM / 4; i += (size_t)G * 512) { const f32x4 v = x4[i]; u32x2 o; o.x = cvtpk(v.x, v.y); o.y = cvtpk(v.z, v.w); xb[i] = o; }
#endif
    }
    {
        float* rot = (float*)(ws + WS_ROT);
        for (int idx = vcu * 512 + tid; idx < SEQ * 64; idx += G * 512) {
            const int pos = idx >> 6, jr = idx & 63;
            double iv = 1.0; for (int k = 0; k < jr; ++k) iv *= 0.86596432336006535;
            const float ang = (float)pos * (float)iv;
            const double xx = (double)ang; const double qd = __builtin_rint(xx * 0.63661977236758134); const int qi = (int)qd;
            const double r = (xx - qd * 1.5707963267948966) - qd * 6.123233995736766e-17, r2 = r * r;
            const double sp = r * (1.0 + r2 * (-1.0 / 6 + r2 * (1.0 / 120 + r2 * (-1.0 / 5040 + r2 * (1.0 / 362880 + r2 * (-1.0 / 39916800 + r2 * (1.0 / 6227020800.0)))))));
            const double cp = 1.0 + r2 * (-0.5 + r2 * (1.0 / 24 + r2 * (-1.0 / 720 + r2 * (1.0 / 40320 + r2 * (-1.0 / 3628800 + r2 * (1.0 / 479001600.0))))));
            const int qq = qi & 3; const double s = qq == 0 ? sp : (qq == 1 ? cp : (qq == 2 ? -sp : -cp)), c = qq == 0 ? cp : (qq == 1 ? -sp : (qq == 2 ? -cp : sp));
            float* o = rot + ((size_t)pos * 16 + (jr >> 2)) * 8 + (jr & 3); o[0] = (float)c; o[4] = (float)s;
        }
    }
    if (vcu == 0) {
        float* bt = (float*)(ws + WS_BIAS); const float* rb = a.in[6];
        for (int idx = tid; idx < 3 * 8 * 160; idx += 512) { const int p = idx / (8 * 160), h = (idx / 160) % 8, d = idx % 160 - 80; const int dil = p == 0 ? 1 : (p == 1 ? 4 : 16);
            bt[idx] = (d >= -64 && d <= 64) ? rb[t5_bucket(d * dil) * 8 + h] * 1.4426950408889634f : -1e30f; }
    }
}
__device__ __forceinline__ void p0_expert_weights(const Args& a, LAS unsigned char* lds, int vcu, int G, int wave, int lane) {
    unsigned char* ws = a.ws;
    LAS float* scr = (LAS float*)(lds + wave * 16384);
    const int gw = vcu * NWAVES + wave, NGW = G * NWAVES;
    constexpr int I_G = 16 * 16, I_D = 8 * 32, PER_E = 2 * I_G + I_D;
    for (int it = gw; it < 16 * PER_E; it += NGW) {
        const int e = it / PER_E; int r = it - e * PER_E;
#if M1_FP8
        if (r < I_G) { p0_transpose_item_fp8<2>(a.in[15] + (size_t)e * 1024 * 512, 1024, 512, ws + WS_WGU + (size_t)e * 1024 * 1024, scr, r, lane, 64.f); continue; } r -= I_G;
        if (r < I_G) { p0_transpose_item_fp8<3>(a.in[16] + (size_t)e * 1024 * 512, 1024, 512, ws + WS_WGU + (size_t)e * 1024 * 1024, scr, r, lane, 64.f); continue; } r -= I_G;
#else
        if (r < I_G) { p0_transpose_item<2>(a.in[15] + (size_t)e * 1024 * 512, 1024, 512, (bf16*)(ws + WS_WGU) + (size_t)e * 1024 * 1024, scr, r, lane); continue; } r -= I_G;
        if (r < I_G) { p0_transpose_item<3>(a.in[16] + (size_t)e * 1024 * 512, 1024, 512, (bf16*)(ws + WS_WGU) + (size_t)e * 1024 * 1024, scr, r, lane); continue; } r -= I_G;
#endif
        p0_transpose_item_fp8<0>(a.in[17] + (size_t)e * 512 * 1024, 512, 1024, ws + WS_WD + (size_t)e * 1024 * 512, scr, r, lane, 64.f);
    }
    __syncthreads();
}

__device__ __forceinline__ float log2_gamma(const float* dec, int h) {
    const float x = dec[h]; return -__log2f(1.f + __expf(-x));
}
__device__ __forceinline__ void chain_item(const Args& a, LAS unsigned char* lds, int item, int tid, int wid, int lane) {
    unsigned char* ws = a.ws;
    const int b = item >> 4, h = (item >> 2) & 3, dir = (item >> 1) & 1, vh = item & 1;
    const float lg2 = log2_gamma(dir ? a.in[3] : a.in[2], h);
    const float cd = __builtin_amdgcn_exp2f(lg2 * 128.f);
    const int g = lane >> 4, i16 = lane & 15, q = i16 >> 2, p = lane & 3;
    const int wd = wid >> 1, wv = wid & 1;
    const GAS bf16* kr = (const GAS bf16*)(ws + WS_KR); const GAS bf16* vr = (const GAS bf16*)(ws + WS_VR);
    GAS bf16* states = (GAS bf16*)a.out;
    f32x4 acc[2][4];
#pragma unroll
    for (int i = 0; i < 2; ++i)
#pragma unroll
        for (int j = 0; j < 4; ++j) acc[i][j] = (f32x4){0.f, 0.f, 0.f, 0.f};
    const int srow = tid >> 4, sch = tid & 15; const unsigned soff = offb(srow, sch);
    const GAS bf16* kp = kr + ((size_t)b * SEQ + srow) * 512 + h * 128 + sch * 8;
    const GAS bf16* vp = vr + ((size_t)b * SEQ + srow) * 1024 + h * 256 + vh * 128 + sch * 8;
    v4u kq[4], vq[4];
    { const int n0 = dir ? 15 : 0;
#pragma unroll
      for (int j = 0; j < 4; ++j) { kq[j] = *(const GAS v4u*)(kp + (size_t)(n0 * 128 + 32 * j) * 512); vq[j] = *(const GAS v4u*)(vp + (size_t)(n0 * 128 + 32 * j) * 1024); } }
    unsigned abase[2][2], bbase[4][2];
#pragma unroll
    for (int t = 0; t < 2; ++t) { const unsigned r = 8 * g + 4 * t + q;
#pragma unroll
        for (int dt = 0; dt < 2; ++dt) abase[dt][t] = offb(r, 2 * (2 * wd + dt) + (p >> 1)) + 8 * (p & 1);
#pragma unroll
        for (int vt = 0; vt < 4; ++vt) bbase[vt][t] = offb(r, 2 * (4 * wv + vt) + (p >> 1)) + 8 * (p & 1); }
#define CH_STAGE(BUFOFF) do { _Pragma("unroll") for (int j = 0; j < 4; ++j) { \
            const int row = srow + 32 * j; const float z = __builtin_amdgcn_exp2f(lg2 * (float)(dir ? row : 127 - row)); const v4u kv = kq[j]; \
            v4u ko; ko.x = cvtpk(bflo(kv.x) * z, bfhi(kv.x) * z); ko.y = cvtpk(bflo(kv.y) * z, bfhi(kv.y) * z); ko.z = cvtpk(bflo(kv.z) * z, bfhi(kv.z) * z); ko.w = cvtpk(bflo(kv.w) * z, bfhi(kv.w) * z); \
            *(LAS v4u*)(lds + (BUFOFF) + soff + j * 8192) = ko; *(LAS v4u*)(lds + (BUFOFF) + 32768 + soff + j * 8192) = vq[j]; } } while (0)
#define CH_FETCH(NN) do { _Pragma("unroll") for (int j = 0; j < 4; ++j) { kq[j] = *(const GAS v4u*)(kp + (size_t)((NN) * 128 + 32 * j) * 512); vq[j] = *(const GAS v4u*)(vp + (size_t)((NN) * 128 + 32 * j) * 1024); } } while (0)
#define CH_STEP(STEP, CUR, OTH) do { const int step_ = (STEP); const int n_ = dir ? 15 - step_ : step_; \
        GAS bf16* sb_ = states + ((((size_t)(b * 4 + h) * 16 + n_) * 2 + dir) * 256) * 128; \
        _Pragma("unroll") for (int dt = 0; dt < 2; ++dt) _Pragma("unroll") for (int vt = 0; vt < 4; ++vt) { \
            const int v_ = vh * 128 + 64 * wv + 16 * vt + i16, d0_ = 32 * wd + 16 * dt + 4 * g; \
            u32x2 w_; w_.x = pg8::cvt_pk_bf16_acc(acc[dt][vt][0], acc[dt][vt][1]); w_.y = pg8::cvt_pk_bf16_acc(acc[dt][vt][2], acc[dt][vt][3]);   \
            *(GAS u32x2*)(sb_ + (size_t)v_ * 128 + d0_) = w_; } \
        if (step_ < 15) CH_STAGE(OTH); \
        if (step_ < 14) CH_FETCH(dir ? 13 - step_ : step_ + 2); \
        _Pragma("unroll") for (int i = 0; i < 2; ++i) _Pragma("unroll") for (int j = 0; j < 4; ++j) acc[i][j] = acc[i][j] * cd; \
        _Pragma("unroll") for (int ks = 0; ks < 4; ++ks) { bf16x8 af[2], bfr[4]; \
            _Pragma("unroll") for (int dt = 0; dt < 2; ++dt) af[dt] = cat8(ldtr(lds + (CUR) + abase[dt][0] + ks * 8192), ldtr(lds + (CUR) + abase[dt][1] + ks * 8192)); \
            _Pragma("unroll") for (int vt = 0; vt < 4; ++vt) bfr[vt] = cat8(ldtr(lds + (CUR) + 32768 + bbase[vt][0] + ks * 8192), ldtr(lds + (CUR) + 32768 + bbase[vt][1] + ks * 8192)); \
            _Pragma("unroll") for (int dt = 0; dt < 2; ++dt) _Pragma("unroll") for (int vt = 0; vt < 4; ++vt) acc[dt][vt] = MFMA16(af[dt], bfr[vt], acc[dt][vt]); } \
        __syncthreads(); } while (0)
    CH_STAGE(0);
    CH_FETCH(dir ? 14 : 1);
    __syncthreads();
    for (int sp = 0; sp < 8; ++sp) { CH_STEP(2 * sp, 0, 65536); CH_STEP(2 * sp + 1, 65536, 0); }
#undef CH_STEP
#undef CH_STAGE
#undef CH_FETCH
}

constexpr int AT_OST = 135168, AT_SCR = AT_OST + 8 * 2048;
constexpr int ATB_N = 160;
struct AttnLane { unsigned kb[2]; unsigned vb[4]; };
__device__ __forceinline__ AttnLane attn_lane(int lane) {
    const int g = lane >> 4, i16 = lane & 15, q4 = i16 >> 2, p = lane & 3; AttnLane L;
#pragma unroll
    for (int s = 0; s < 2; ++s) L.kb[s] = i16 * 128 + (((4 * s + g) ^ ((i16 >> 1) & 7)) * 16);
    const int sw = (2 * g + (q4 >> 1)) & 3;
#pragma unroll
    for (int c = 0; c < 4; ++c) L.vb[c] = (4 * g + q4) * 128 + ((c ^ sw) * 32) + p * 8;
    return L;
}
__device__ __forceinline__ unsigned kimg_off(int row, int c) { return row * 128 + ((c ^ ((row >> 1) & 7)) * 16); }
__device__ __forceinline__ unsigned vimg_off(int row, int c) { return row * 128 + (((c >> 1) ^ ((row >> 1) & 3)) * 32) + (c & 1) * 16; }
__device__ __forceinline__ void attn_core(const LAS unsigned char* Kimg, const LAS unsigned char* Vimg, int R0, int nrows, unsigned tvalid, const bf16x8 (&qf)[2],
                                          const float (&biasr)[36], const AttnLane& L, f32x4 (&O)[4], float& mx, float& lsum) {
    f32x4 D[9];
#pragma unroll
    for (int kt = 0; kt < 9; ++kt) {
        int R = R0 + 16 * kt; R = R < 0 ? 0 : (R > nrows - 16 ? nrows - 16 : R);
        const LAS unsigned char* kp = Kimg + R * 128;
        const bf16x8 k0 = *(const LAS bf16x8*)(kp + L.kb[0]), k1 = *(const LAS bf16x8*)(kp + L.kb[1]);
        f32x4 d = (f32x4){0.f, 0.f, 0.f, 0.f};
        d = MFMA16(k0, qf[0], d); d = MFMA16(k1, qf[1], d); D[kt] = d;
    }
    mx = -1e30f;
#pragma unroll
    for (int kt = 0; kt < 9; ++kt) {
        const float tb = ((tvalid >> kt) & 1u) ? 0.f : -1e30f;
#pragma unroll
        for (int r = 0; r < 4; ++r) { const float x = D[kt][r] + (biasr[4 * kt + r] + tb); D[kt][r] = x; mx = fmaxf(mx, x); }
    }
    mx = fmaxf(mx, __shfl_xor(mx, 16)); mx = fmaxf(mx, __shfl_xor(mx, 32));
    lsum = 0.f;
#pragma unroll
    for (int kt = 0; kt < 9; ++kt)
#pragma unroll
        for (int r = 0; r < 4; ++r) { const float e = __builtin_amdgcn_exp2f(D[kt][r] - mx); D[kt][r] = e; lsum += e; }
    lsum += __shfl_xor(lsum, 16); lsum += __shfl_xor(lsum, 32);
#pragma unroll
    for (int c = 0; c < 4; ++c) O[c] = (f32x4){0.f, 0.f, 0.f, 0.f};
#pragma unroll
    for (int kk = 0; kk < 5; ++kk) {
        int Ra = R0 + 32 * kk; Ra = Ra < 0 ? 0 : (Ra > nrows - 16 ? nrows - 16 : Ra);
        int Rb = R0 + 32 * kk + 16; Rb = Rb < 0 ? 0 : (Rb > nrows - 16 ? nrows - 16 : Rb);
        if (kk == 4) Rb = Ra;
        const f32x4 e0 = D[2 * kk], e1 = kk < 4 ? D[2 * kk + 1] : (f32x4){0.f, 0.f, 0.f, 0.f};
        v4u pw; pw.x = cvtpk(e0[0], e0[1]); pw.y = cvtpk(e0[2], e0[3]); pw.z = cvtpk(e1[0], e1[1]); pw.w = cvtpk(e1[2], e1[3]);
        const bf16x8 pf = __builtin_bit_cast(bf16x8, pw);
        const LAS unsigned char* va_ = Vimg + Ra * 128; const LAS unsigned char* vb_ = Vimg + Rb * 128;
#pragma unroll
        for (int c = 0; c < 4; ++c) O[c] = MFMA16(pf, cat8(ldtr(va_ + L.vb[c]), ldtr(vb_ + L.vb[c])), O[c]);
    }
}
__device__ __forceinline__ void attn_stage_out(LAS unsigned char* lds, int wid, int lane, const f32x4 (&O)[4], float lsum) {
    const int g = lane >> 4, i16 = lane & 15;
    const float linv = 1.f / lsum;
    LAS bf16* st = (LAS bf16*)(lds + AT_OST + wid * 2048);
#pragma unroll
    for (int r = 0; r < 4; ++r) { const float li = __shfl(linv, 4 * g + r);
#pragma unroll
        for (int c = 0; c < 4; ++c) st[(4 * g + r) * 64 + 16 * c + i16] = (bf16)(cvtpk(O[c][r] * li, 0.f) & 0xffffu); }
}
__device__ __forceinline__ void attn_load_bias(const Args& a, int pat, int h, int lane, float (&biasr)[36]) {
    const GAS float* bt = (const GAS float*)(a.ws + WS_BIAS) + (pat * 8 + h) * ATB_N; const int g = lane >> 4, i16 = lane & 15;
#pragma unroll
    for (int kt = 0; kt < 9; ++kt)
#pragma unroll
        for (int r = 0; r < 4; ++r) biasr[4 * kt + r] = bt[16 * kt + 4 * g + r - 64 - i16 + 80];
}
template <int DIL, int VAR = 0> __device__ __forceinline__ void attn_dil_phase(const Args& a, LAS unsigned char* lds, int vcu, int G, int tid, int wid, int lane) {
    unsigned char* ws = a.ws;
    constexpr int NR = SEQ / DIL, PAT = DIL == 4 ? 1 : 2, CH = NR * 8 / 512, NITEM = NB * 8 * DIL;
    constexpr int NBUF = DIL == 16 ? 2 : 1, BUFB = 2 * NR * 128;
    const GAS bf16* qa = (const GAS bf16*)(ws + WS_QA); const GAS bf16* ka = (const GAS bf16*)(ws + WS_KA); const GAS bf16* va = (const GAS bf16*)(ws + WS_VA);
    bf16* op = (bf16*)(ws + (DIL == 4 ? WS_O2 : WS_O3)); float* lsep = (float*)(ws + (DIL == 4 ? WS_LSE2 : WS_LSE3));
    if (vcu >= NITEM) return;
    const int h = vcu & 7;
    float biasr[36]; attn_load_bias(a, PAT, h, lane, biasr);
    const AttnLane L = attn_lane(lane);
    const int g = lane >> 4, i16 = lane & 15;
    v4u kq[CH], vq[CH]; bf16x8 qn[2];
    auto issue = [&](int item, int gi) {
        const int rho = (item >> 3) % DIL, b = item / (8 * DIL); const size_t rowb = (size_t)b * SEQ;
#pragma unroll
        for (int j = 0; j < CH; ++j) { const int id = tid + 512 * j, row = id >> 3, c = id & 7; const size_t go = (rowb + (size_t)row * DIL + rho) * 512 + h * 64 + c * 8;
            kq[j] = *(const GAS v4u*)(ka + go); vq[j] = *(const GAS v4u*)(va + go); }
        const size_t qpos = rowb + (size_t)(16 * gi + i16) * DIL + rho;
#pragma unroll
        for (int s = 0; s < 2; ++s) qn[s] = *(const GAS bf16x8*)(qa + qpos * 512 + h * 64 + 32 * s + 8 * g);
    };
    issue(vcu, wid);
    int buf = 0;
    for (int item = vcu; item < NITEM; item += G) {
        const int rho = (item >> 3) % DIL, b = item / (8 * DIL); const size_t rowb = (size_t)b * SEQ;
        LAS unsigned char* Kimg = lds + buf * BUFB; LAS unsigned char* Vimg = Kimg + NR * 128;
        if (NBUF == 1) __syncthreads();
#pragma unroll
        for (int j = 0; j < CH; ++j) { const int id = tid + 512 * j, row = id >> 3, c = id & 7;
            *(LAS v4u*)(Kimg + kimg_off(row, c)) = kq[j]; *(LAS v4u*)(Vimg + vimg_off(row, c)) = vq[j]; }
        bf16x8 qf[2] = {qn[0], qn[1]};
        __syncthreads();
        if (NBUF == 2 && item + G < NITEM) issue(item + G, wid);
        for (int gi = wid; gi < NR / 16; gi += 8) {
            const int m0 = 16 * gi;
            if (NBUF == 1 && gi + 8 < NR / 16) {
                const size_t qpos = rowb + (size_t)(m0 + 128 + i16) * DIL + rho;
#pragma unroll
                for (int s = 0; s < 2; ++s) qn[s] = *(const GAS bf16x8*)(qa + qpos * 512 + h * 64 + 32 * s + 8 * g); }
            unsigned tvalid = 0u;
#pragma unroll
            for (int kt = 0; kt < 9; ++kt) { const int t0 = m0 - 64 + 16 * kt; tvalid |= (t0 >= 0 && t0 < NR) ? (1u << kt) : 0u; }
            f32x4 O[4]; float mx, lsum;
            if (VAR == 1) { mx = 0.f; lsum = 1.f;
#pragma unroll
                for (int c = 0; c < 4; ++c) O[c] = (f32x4){__builtin_bit_cast(float, qf[0][0] + c), 0.f, 0.f, 0.f}; }
            else attn_core(Kimg, Vimg, m0 - 64, NR, tvalid, qf, biasr, L, O, mx, lsum);
            attn_stage_out(lds, wid, lane, O, lsum);
            if (g == 0) lsep[(rowb + (size_t)(m0 + i16) * DIL + rho) * 8 + h] = mx + __log2f(lsum);
            asm volatile("s_waitcnt lgkmcnt(0)" ::: "memory");
            { const int q = lane >> 2, qt = lane & 3; const LAS v4u* sp = (const LAS v4u*)(lds + AT_OST + wid * 2048 + q * 128 + qt * 32);
              const v4u x0 = sp[0], x1 = sp[1]; bf16* dst = op + (rowb + (size_t)(m0 + q) * DIL + rho) * 512 + h * 64 + qt * 16;
              *(v4u*)dst = x0; *(v4u*)(dst + 8) = x1; }
            asm volatile("s_waitcnt lgkmcnt(0)" ::: "memory");
            if (NBUF == 1) { qf[0] = qn[0]; qf[1] = qn[1]; }
        }
        if (NBUF == 1 && item + G < NITEM) issue(item + G, wid);
        buf ^= (NBUF - 1);
    }
    __syncthreads();
}
__device__ __forceinline__ void attn_p1_phase(const Args& a, LAS unsigned char* lds, int vcu, int G, int tid, int wid, int lane) {
    unsigned char* ws = a.ws;
    LAS unsigned char* Kimg = lds; LAS unsigned char* Vimg = lds + 384 * 128;
    const GAS bf16* qa = (const GAS bf16*)(ws + WS_QA); const GAS bf16* ka = (const GAS bf16*)(ws + WS_KA); const GAS bf16* va = (const GAS bf16*)(ws + WS_VA);
    const GAS bf16* o2 = (const GAS bf16*)(ws + WS_O2); const GAS bf16* o3 = (const GAS bf16*)(ws + WS_O3);
    const GAS float* lse2 = (const GAS float*)(ws + WS_LSE2); const GAS float* lse3 = (const GAS float*)(ws + WS_LSE3);
    bf16* oa = (bf16*)(ws + WS_OA);
    if (vcu >= 1024) return;
    const int h = vcu & 7;
    float biasr[36]; attn_load_bias(a, 0, h, lane, biasr);
    const AttnLane L = attn_lane(lane);
    const int g = lane >> 4, i16 = lane & 15;
    LAS float* scr = (LAS float*)(lds + AT_SCR) + wid * 16;
    v4u kq[6], vq[6];
    auto issue = [&](int item) { const int b = item >> 6, s0 = ((item >> 3) & 7) * 256; const size_t rowb = (size_t)b * SEQ;
#pragma unroll
        for (int j = 0; j < 6; ++j) { const int id = tid + 512 * j, row = id >> 3, c = id & 7, pos = s0 - 64 + row; const bool ok = pos >= 0 && pos < SEQ;
            const size_t go = (rowb + (size_t)(ok ? pos : 0)) * 512 + h * 64 + c * 8;
            kq[j] = *(const GAS v4u*)(ka + go); vq[j] = *(const GAS v4u*)(va + go);
            if (!ok) { kq[j] = (v4u){0u, 0u, 0u, 0u}; vq[j] = (v4u){0u, 0u, 0u, 0u}; } } };
    issue(vcu);
    for (int item = vcu; item < 1024; item += G) {
        const int b = item >> 6, s0 = ((item >> 3) & 7) * 256; const size_t rowb = (size_t)b * SEQ;
        __syncthreads();
#pragma unroll
        for (int j = 0; j < 6; ++j) { const int id = tid + 512 * j, row = id >> 3, c = id & 7;
            *(LAS v4u*)(Kimg + kimg_off(row, c)) = kq[j]; *(LAS v4u*)(Vimg + vimg_off(row, c)) = vq[j]; }
        __syncthreads();
        if (item + G < 1024) issue(item + G);
        for (int gi = wid; gi < 16; gi += 8) {
            const int m0 = s0 + 16 * gi;
            const int q = lane >> 2, qt = lane & 3; const size_t tq = rowb + m0 + q;
            const v4u a20 = *(const GAS v4u*)(o2 + tq * 512 + h * 64 + qt * 16), a21 = *(const GAS v4u*)(o2 + tq * 512 + h * 64 + qt * 16 + 8);
            const v4u a30 = *(const GAS v4u*)(o3 + tq * 512 + h * 64 + qt * 16), a31 = *(const GAS v4u*)(o3 + tq * 512 + h * 64 + qt * 16 + 8);
            const float l2 = lse2[tq * 8 + h], l3 = lse3[tq * 8 + h];
            bf16x8 qf[2];
#pragma unroll
            for (int s = 0; s < 2; ++s) qf[s] = *(const GAS bf16x8*)(qa + (rowb + m0 + i16) * 512 + h * 64 + 32 * s + 8 * g);
            unsigned tvalid = 0u;
#pragma unroll
            for (int kt = 0; kt < 9; ++kt) { const int t0 = m0 - 64 + 16 * kt; tvalid |= (t0 >= 0 && t0 < SEQ) ? (1u << kt) : 0u; }
            f32x4 O[4]; float mx, lsum;
            attn_core(Kimg, Vimg, 16 * gi, 384, tvalid, qf, biasr, L, O, mx, lsum);
            attn_stage_out(lds, wid, lane, O, lsum);
            if (g == 0) scr[i16] = mx + __log2f(lsum);
            asm volatile("s_waitcnt lgkmcnt(0)" ::: "memory");
            {
                const float l1 = scr[q], M = fmaxf(l1, fmaxf(l2, l3));
                float w1 = __builtin_amdgcn_exp2f(l1 - M), w2 = __builtin_amdgcn_exp2f(l2 - M), w3 = __builtin_amdgcn_exp2f(l3 - M); const float wi = 1.f / (w1 + w2 + w3); w1 *= wi; w2 *= wi; w3 *= wi;
                const LAS v4u* sp = (const LAS v4u*)(lds + AT_OST + wid * 2048 + q * 128 + qt * 32);
                const v4u x0 = sp[0], x1 = sp[1];
                v4u r0, r1;
#define MRG(d, x, y, z) d = cvtpk(w1 * bflo(x) + w2 * bflo(y) + w3 * bflo(z), w1 * bfhi(x) + w2 * bfhi(y) + w3 * bfhi(z))
                MRG(r0.x, x0.x, a20.x, a30.x); MRG(r0.y, x0.y, a20.y, a30.y); MRG(r0.z, x0.z, a20.z, a30.z); MRG(r0.w, x0.w, a20.w, a30.w);
                MRG(r1.x, x1.x, a21.x, a31.x); MRG(r1.y, x1.y, a21.y, a31.y); MRG(r1.z, x1.z, a21.z, a31.z); MRG(r1.w, x1.w, a21.w, a31.w);
#undef MRG
                bf16* dst = oa + tq * 512 + h * 64 + qt * 16;
                *(v4u*)dst = r0; *(v4u*)(dst + 8) = r1;
            }
            asm volatile("s_waitcnt lgkmcnt(0)" ::: "memory");
        }
    }
    __syncthreads();
}

#define OPAQUE(x) asm volatile("" : "+v"(x))
template <int VAR = 0> __device__ __forceinline__ void p3_phase(const Args& a, LAS unsigned char* lds, int vcu, int G, int tid, int wid, int lane) {
    unsigned char* ws = a.ws;
    const int g = lane >> 4, i16 = lane & 15, q4 = i16 >> 2, p = lane & 3;
    const GAS bf16* qr = (const GAS bf16*)(ws + WS_QR); const GAS bf16* kr = (const GAS bf16*)(ws + WS_KR); const GAS bf16* vr = (const GAS bf16*)(ws + WS_VR);
    GAS bf16* gr = (GAS bf16*)(ws + WS_GR);
    LAS unsigned char* Kt = lds; LAS unsigned char* Sg = lds + 32768;
    if (vcu >= 1024) return;
    const unsigned kdst = offb(tid >> 4, tid & 15);
    unsigned rfo[4];
    { const unsigned X = ((i16 & 3) << 2) | (i16 >> 2);
#pragma unroll
      for (int s = 0; s < 4; ++s) rfo[s] = 256 * i16 + 16 * (((4 * s) ^ (X & 12)) | (g ^ (X & 3))); }
    v4u sreg[8], kreg[4]; bf16x8 qn[4];
    auto item_ptrs = [&](int item, size_t& tok0, const GAS bf16*& sf, int& h) { const int b = item >> 6; h = (item >> 4) & 3; const int n = item & 15; tok0 = (size_t)b * SEQ + n * 128;
        sf = (const GAS bf16*)a.out + ((((size_t)(b * 4 + h) * 16 + n) * 2 + 0) * 256) * 128; };
    auto issue_k = [&](int item) { size_t tok0; const GAS bf16* sf; int h; item_ptrs(item, tok0, sf, h);
        const GAS bf16* ks_ = kr + (tok0 + (tid >> 4)) * 512 + h * 128 + (tid & 15) * 8;
#pragma unroll
        for (int j = 0; j < 4; ++j) kreg[j] = *(const GAS v4u*)(ks_ + (size_t)j * 32 * 512); };
    auto issue_q = [&](int item) { size_t tok0; const GAS bf16* sf; int h; item_ptrs(item, tok0, sf, h);
#pragma unroll
        for (int s = 0; s < 4; ++s) qn[s] = *(const GAS bf16x8*)(qr + (tok0 + 16 * wid + i16) * 512 + h * 128 + 32 * s + 8 * g); };
    auto issue_state = [&](const GAS bf16* sf, int dirn) { const GAS bf16* sld = sf + (size_t)dirn * 256 * 128 + (size_t)(tid >> 4) * 128 + (tid & 15) * 8;
#pragma unroll
        for (int j = 0; j < 8; ++j) sreg[j] = *(const GAS v4u*)(sld + (size_t)j * 32 * 128); };
    auto write_state = [&]() {
#pragma unroll
        for (int j = 0; j < 8; ++j) *(LAS v4u*)(Sg + (j >> 2) * 32768 + kdst + (j & 3) * 8192) = sreg[j]; };
    { size_t tok0; const GAS bf16* sf; int h; item_ptrs(vcu, tok0, sf, h); issue_k(vcu); issue_q(vcu); issue_state(sf, 0); }
#pragma unroll
    for (int j = 0; j < 4; ++j) *(LAS v4u*)(Kt + kdst + j * 8192) = kreg[j];
    for (int item = vcu; item < 1024; item += G) {
        size_t tok0; const GAS bf16* sf; int h; item_ptrs(item, tok0, sf, h);
        const float lf2 = log2_gamma(a.in[2], h), lb2 = log2_gamma(a.in[3], h);
        bf16x8 qf[4];
#pragma unroll
        for (int s = 0; s < 4; ++s) qf[s] = qn[s];
        const bool has_next = item + G < 1024;
        __syncthreads();
        f32x4 D[8];
#pragma unroll
        for (int jt = 0; jt < 8; ++jt) {
            f32x4 d = (f32x4){0.f, 0.f, 0.f, 0.f};
#pragma unroll
            for (int s = 0; s < 4; ++s) { if (VAR != 1) { const bf16x8 kf = *(const LAS bf16x8*)(Kt + rfo[s] + jt * 4096); d = MFMA16(kf, qf[s], d); } else d[s] = __builtin_bit_cast(float, (int)qf[s][0]); }
            D[jt] = d;
        }
        int iq = 16 * wid + i16; OPAQUE(iq);
        bf16x8 pf[4];
#pragma unroll
        for (int ks = 0; ks < 4; ++ks) {
            float e[8];
#pragma unroll
            for (int t = 0; t < 2; ++t)
#pragma unroll
                for (int r = 0; r < 4; ++r) {
                    const int j = 16 * (2 * ks + t) + 4 * g + r; const float fdf = (float)(iq - j), ad = fabsf(fdf);
                    const float pos = fminf(fmaxf(fdf, 0.f), 1.f), isz = 1.f - fminf(ad, 1.f);
                    const float w = __builtin_amdgcn_exp2f((lb2 + (lf2 - lb2) * pos) * ad) + isz;
                    e[4 * t + r] = D[2 * ks + t][r] * w;
                }
            v4u pw; pw.x = cvtpk(e[0], e[1]); pw.y = cvtpk(e[2], e[3]); pw.z = cvtpk(e[4], e[5]); pw.w = cvtpk(e[6], e[7]);
            pf[ks] = __builtin_bit_cast(bf16x8, pw);
        }
        f32x4 acc[16];
#pragma unroll
        for (int vt = 0; vt < 16; ++vt) acc[vt] = (f32x4){0.f, 0.f, 0.f, 0.f};
#pragma unroll
        for (int dirn = 0; dirn < 2; ++dirn) {
            if (dirn == 1) __syncthreads();
            write_state();
            if (dirn == 0) { issue_state(sf, 1); if (has_next) issue_k(item + G); }
            else {
                if (has_next) {
#pragma unroll
                    for (int j = 0; j < 4; ++j) *(LAS v4u*)(Kt + kdst + j * 8192) = kreg[j]; }
                const GAS bf16* vs_ = vr + (tok0 + (tid >> 5)) * 1024 + h * 256 + (tid & 31) * 8;
#pragma unroll
                for (int j = 0; j < 8; ++j) sreg[j] = *(const GAS v4u*)(vs_ + (size_t)j * 16 * 1024);
            }
            __syncthreads();
#pragma unroll
            for (int vt = 0; vt < 16; ++vt) {
#pragma unroll
                for (int s = 0; s < 4; ++s) { if (VAR != 1) { const bf16x8 sfr = *(const LAS bf16x8*)(Sg + (vt >> 3) * 32768 + rfo[s] + (vt & 7) * 4096); acc[vt] = MFMA16(qf[s], sfr, acc[vt]); } }
            }
            float xs[4];
            { int ib = 16 * wid + 4 * g; OPAQUE(ib);
#pragma unroll
              for (int r = 0; r < 4; ++r) { const float lxf = lf2 * (float)(ib + r + 1), lxb = lb2 * (float)(128 - ib - r); xs[r] = __builtin_amdgcn_exp2f(dirn == 0 ? lxf - lxb : lxb); } }
#pragma unroll
            for (int vt = 0; vt < 16; ++vt)
#pragma unroll
                for (int r = 0; r < 4; ++r) acc[vt][r] *= xs[r];
        }
        __syncthreads();
        { int t2 = tid; OPAQUE(t2); const unsigned vd2 = (unsigned)((t2 & 31) >> 4) * 32768u + offb(t2 >> 5, t2 & 15);
#pragma unroll
          for (int j = 0; j < 8; ++j) *(LAS v4u*)(Sg + vd2 + j * 4096) = sreg[j]; }
        GAS bf16* gp = gr + (tok0 + 16 * wid + (lane >> 5)) * 1024 + h * 256 + (lane & 31) * 8;
        __syncthreads();
        unsigned vbs[8];
        { int l2 = lane; OPAQUE(l2); const unsigned g2 = l2 >> 4, q2 = (l2 & 15) >> 2, p2 = l2 & 3, X = (q2 << 2) | g2;
#pragma unroll
          for (int c = 0; c < 8; ++c) vbs[c] = 256 * (4 * g2 + q2) + 16 * (((2 * c) ^ (X & 14)) | ((p2 >> 1) ^ (X & 1))) + 8 * (p2 & 1); }
#pragma unroll
        for (int vt = 0; vt < 16; ++vt) {
#pragma unroll
            for (int ks = 0; ks < 4; ++ks) { if (VAR != 1) {
                const s16x4 lo = ldtr(Sg + vbs[vt & 7] + (vt >> 3) * 32768 + ks * 8192), hi = ldtr(Sg + vbs[vt & 7] + (vt >> 3) * 32768 + ks * 8192 + 4096);
                acc[vt] = MFMA16(pf[ks], cat8(lo, hi), acc[vt]); }
            }
            asm volatile("" ::: "memory");
        }
        float mu[4], rs[4];
#pragma unroll
        for (int r = 0; r < 4; ++r) {
            float s = 0.f;
#pragma unroll
            for (int vt = 0; vt < 16; ++vt) s += acc[vt][r];
            s += __shfl_xor(s, 1); s += __shfl_xor(s, 2); s += __shfl_xor(s, 4); s += __shfl_xor(s, 8);
            const float m = s * (1.f / 256.f); float qv = 0.f;
#pragma unroll
            for (int vt = 0; vt < 16; ++vt) { const float d = acc[vt][r] - m; qv += d * d; }
            qv += __shfl_xor(qv, 1); qv += __shfl_xor(qv, 2); qv += __shfl_xor(qv, 4); qv += __shfl_xor(qv, 8);
            mu[r] = m; rs[r] = 1.f / sqrtf(qv * (1.f / 256.f) + LN_EPSF);
        }
        v4u greg[8];
#pragma unroll
        for (int j = 0; j < 8; ++j) greg[j] = *(const GAS v4u*)(gp + (size_t)j * 2048);
        __syncthreads();
        if (has_next) { size_t tk; const GAS bf16* sfn; int hn; item_ptrs(item + G, tk, sfn, hn); issue_state(sfn, 0); issue_q(item + G); }
        LAS bf16* st = (LAS bf16*)(Sg + wid * 8192);
        { LAS bf16* sp_ = st + (4 * g) * 256 + i16;
#pragma unroll
          for (int vt = 0; vt < 16; ++vt)
#pragma unroll
              for (int r = 0; r < 4; ++r) sp_[r * 256 + 16 * vt] = (bf16)(cvtpk((acc[vt][r] - mu[r]) * rs[r], 0.f) & 0xffffu); }
        asm volatile("s_waitcnt lgkmcnt(0)" ::: "memory");
        {
            const float* gn = a.in[4] + h * 256; const int ch = lane & 31;
            const f32x4 g0 = *(const f32x4*)(gn + ch * 8), g1 = *(const f32x4*)(gn + ch * 8 + 4);
            const LAS bf16* yp = st + (lane >> 5) * 256 + ch * 8;
#pragma unroll
            for (int j = 0; j < 8; ++j) {
                const v4u y = *(const LAS v4u*)(yp + j * 512); const v4u sg = greg[j];
                v4u o; o.x = cvtpk(bflo(y.x) * g0[0] * bflo(sg.x), bfhi(y.x) * g0[1] * bfhi(sg.x)); o.y = cvtpk(bflo(y.y) * g0[2] * bflo(sg.y), bfhi(y.y) * g0[3] * bfhi(sg.y));
                o.z = cvtpk(bflo(y.z) * g1[0] * bflo(sg.z), bfhi(y.z) * g1[1] * bfhi(sg.z)); o.w = cvtpk(bflo(y.w) * g1[2] * bflo(sg.w), bfhi(y.w) * g1[3] * bfhi(sg.w));
                *(GAS v4u*)(gp + (size_t)j * 2048) = o;
            }
        }
        __syncthreads();
    }
}

constexpr int P6_RS = 81920, P6_CNT = P6_RS + 8 * 512, P6_BASE = P6_CNT + 64, P6_ROW = P6_BASE + 64;
#define P6_BUTTERFLY(lg, out) do { float r10[10], r5[5], r3[3], r2[2]; const float z = 0.f; \
    _Pragma("unroll") for (int k = 0; k < 10; ++k) { const float keep = h32 ? lg[10 + k] : lg[k], send = h32 ? lg[k] : lg[10 + k]; r10[k] = keep + __shfl_xor(send, 32); } \
    _Pragma("unroll") for (int k = 0; k < 5; ++k) { const float keep = h16 ? r10[5 + k] : r10[k], send = h16 ? r10[k] : r10[5 + k]; r5[k] = keep + __shfl_xor(send, 16); } \
    { const float keep = h8 ? r5[3] : r5[0], send = h8 ? r5[0] : r5[3]; r3[0] = keep + __shfl_xor(send, 8); } \
    { const float keep = h8 ? r5[4] : r5[1], send = h8 ? r5[1] : r5[4]; r3[1] = keep + __shfl_xor(send, 8); } \
    { const float keep = h8 ? z : r5[2], send = h8 ? r5[2] : z; r3[2] = keep + __shfl_xor(send, 8); } \
    { const float keep = h4 ? r3[2] : r3[0], send = h4 ? r3[0] : r3[2]; r2[0] = keep + __shfl_xor(send, 4); } \
    { const float keep = h4 ? z : r3[1], send = h4 ? r3[1] : z; r2[1] = keep + __shfl_xor(send, 4); } \
    { const float keep = h2 ? r2[1] : r2[0], send = h2 ? r2[0] : r2[1]; out = keep + __shfl_xor(send, 2); } \
    out += __shfl_xor(out, 1); } while (0)
__device__ __forceinline__ void p6a_phase(const Args& a, LAS unsigned char* lds, int vcu, int G, int tid, int wave, int lane) {
    unsigned char* ws = a.ws;
    LAS float* RW = (LAS float*)lds;
    LAS float* RS = (LAS float*)(lds + P6_RS) + wave * 128;
    LAS unsigned* LC = (LAS unsigned*)(lds + P6_CNT); LAS unsigned* LB = (LAS unsigned*)(lds + P6_BASE); LAS unsigned* LR = (LAS unsigned*)(lds + P6_ROW);
    for (int i = tid; i < 1024 * 4; i += 512) { const int c = i >> 2, k = i & 3; RW[k * 1024 + c] = a.in[11][i]; }
    for (int i = tid; i < 1024 * 16; i += 512) { const int c = i >> 4, k = i & 15; RW[(4 + k) * 1024 + c] = a.in[13][i]; }
    const u32x2* pre = (const u32x2*)a.out; u32x2* x1b = (u32x2*)(ws + WS_XB); [[maybe_unused]] unsigned* x1f8 = (unsigned*)(ws + WS_X1F8);
    gu32* ctl = (gu32*)ws;
    int* ltok = (int*)(ws + WS_LTOK); float* tw = (float*)(ws + WS_WSLOT); unsigned* tinfo = (unsigned*)(ws + WS_TINFO);
    const float* g1 = a.in[9]; const float* b1 = a.in[10];
    const bool h32 = (lane & 32) != 0, h16 = (lane & 16) != 0, h8 = (lane & 8) != 0, h4 = (lane & 4) != 0, h2 = (lane & 2) != 0;
#define P6_LOADROW(dst, t_) do { const u32x2* xr_ = pre + (size_t)(t_) * 256 + lane; _Pragma("unroll") for (int j = 0; j < 4; ++j) dst[j] = xr_[64 * j]; } while (0)
#define P6_LN(v, nx, s) do { s = 0.f; _Pragma("unroll") for (int j = 0; j < 4; ++j) { v[j] = (f32x4){bflo(nx[j].x), bfhi(nx[j].x), bflo(nx[j].y), bfhi(nx[j].y)}; s += (v[j].x + v[j].y) + (v[j].z + v[j].w); } } while (0)
#define P6_VAR(v, mean, q) do { q = 0.f; _Pragma("unroll") for (int j = 0; j < 4; ++j) { v[j] = v[j] - mean; q += (v[j].x * v[j].x + v[j].y * v[j].y) + (v[j].z * v[j].z + v[j].w * v[j].w); } } while (0)
#if M1_FP8
#define P6_STORE(v, t_, j) do { u32x2 o_; o_.x = cvtpk(v[j].x, v[j].y); o_.y = cvtpk(v[j].z, v[j].w); x1b[(size_t)(t_) * 256 + lane + 64 * j] = o_; x1f8[(size_t)(t_) * 256 + lane + 64 * j] = pk_fp8x4(v[j].x, v[j].y, v[j].z, v[j].w); } while (0)
#else
#define P6_STORE(v, t_, j) do { u32x2 o_; o_.x = cvtpk(v[j].x, v[j].y); o_.y = cvtpk(v[j].z, v[j].w); x1b[(size_t)(t_) * 256 + lane + 64 * j] = o_; } while (0)
#endif
#define P6_DOT(lg, v, j, k, w) lg[k] += (v[j][0] * w[0] + v[j][1] * w[1]) + (v[j][2] * w[2] + v[j][3] * w[3])
    for (int blk = vcu; blk < TT / 128; blk += G) {
        if (tid < 16) LC[tid] = 0u;
        __syncthreads();
        const int t0 = blk * 128;
        u32x2 nxA[4], nxB[4], nxC[4], nxD[4];
        P6_LOADROW(nxA, t0 + wave); P6_LOADROW(nxB, t0 + wave + 8); P6_LOADROW(nxC, t0 + wave + 16); P6_LOADROW(nxD, t0 + wave + 24);
        for (int rr = 0; rr < 4; ++rr) {
            const int rl0 = wave + 32 * rr, tA = t0 + rl0, tB = tA + 8, tC = tA + 16, tD = tA + 24;
            f32x4 vA[4], vB[4], vC[4], vD[4]; float sA, sB, sC, sD;
            P6_LN(vA, nxA, sA); P6_LN(vB, nxB, sB); P6_LN(vC, nxC, sC); P6_LN(vD, nxD, sD);
            if (rr < 3) { P6_LOADROW(nxA, tA + 32); P6_LOADROW(nxB, tB + 32); P6_LOADROW(nxC, tC + 32); P6_LOADROW(nxD, tD + 32); }
            const float mA = wave_sum(sA) * (1.f / DM), mB = wave_sum(sB) * (1.f / DM), mC = wave_sum(sC) * (1.f / DM), mD = wave_sum(sD) * (1.f / DM);
            float qA, qB, qC, qD;
            P6_VAR(vA, mA, qA); P6_VAR(vB, mB, qB); P6_VAR(vC, mC, qC); P6_VAR(vD, mD, qD);
            const float rA = 1.f / sqrtf(wave_sum(qA) * (1.f / DM) + LN_EPSF), rB = 1.f / sqrtf(wave_sum(qB) * (1.f / DM) + LN_EPSF);
            const float rC = 1.f / sqrtf(wave_sum(qC) * (1.f / DM) + LN_EPSF), rD = 1.f / sqrtf(wave_sum(qD) * (1.f / DM) + LN_EPSF);
            float lgA[20], lgB[20], lgC[20], lgD[20];
#pragma unroll
            for (int k = 0; k < 20; ++k) { lgA[k] = 0.f; lgB[k] = 0.f; lgC[k] = 0.f; lgD[k] = 0.f; }
#pragma unroll
            for (int j = 0; j < 4; ++j) {
                const f32x4 gg = *(const f32x4*)(g1 + 4 * lane + 256 * j), bb = *(const f32x4*)(b1 + 4 * lane + 256 * j);
                vA[j] = vA[j] * rA * gg + bb; vB[j] = vB[j] * rB * gg + bb; vC[j] = vC[j] * rC * gg + bb; vD[j] = vD[j] * rD * gg + bb;
                P6_STORE(vA, tA, j); P6_STORE(vB, tB, j); P6_STORE(vC, tC, j); P6_STORE(vD, tD, j);
#pragma unroll
                for (int k = 0; k < 20; ++k) { const f32x4 w = *(const LAS f32x4*)(RW + k * 1024 + 4 * lane + 256 * j);
                    P6_DOT(lgA, vA, j, k, w); P6_DOT(lgB, vB, j, k, w); P6_DOT(lgC, vC, j, k, w); P6_DOT(lgD, vD, j, k, w); }
            }
            float r1A, r1B, r1C, r1D;
            P6_BUTTERFLY(lgA, r1A); P6_BUTTERFLY(lgB, r1B); P6_BUTTERFLY(lgC, r1C); P6_BUTTERFLY(lgD, r1D);
            {
                const int i3 = h2 ? (h4 ? -1 : 1) : (h4 ? 2 : 0);
                const int i5 = i3 < 0 ? -1 : (h8 ? (i3 == 2 ? -1 : i3 + 3) : i3);
                const int kk = i5 < 0 ? -1 : (h32 ? 10 : 0) + (h16 ? 5 : 0) + i5;
                if (kk >= 0 && (lane & 1) == 0) { RS[kk] = r1A; RS[32 + kk] = r1B; RS[64 + kk] = r1C; RS[96 + kk] = r1D; }
            }
            asm volatile("s_waitcnt lgkmcnt(0)" ::: "memory");
            {
                const int sel = lane & 3; const int rl = rl0 + 8 * sel;
                float tl[20];
#pragma unroll
                for (int k4 = 0; k4 < 5; ++k4) { const f32x4 w = *(const LAS f32x4*)(RS + sel * 32 + 4 * k4); tl[4 * k4] = w[0]; tl[4 * k4 + 1] = w[1]; tl[4 * k4 + 2] = w[2]; tl[4 * k4 + 3] = w[3]; }
                float gl[4];
#pragma unroll
                for (int k = 0; k < 4; ++k) gl[k] = tl[k] + a.in[12][k];
                int gi = 0; float gm = gl[0];
#pragma unroll
                for (int k = 1; k < 4; ++k) if (gl[k] > gm) { gm = gl[k]; gi = k; }
                float gs = 0.f;
#pragma unroll
                for (int k = 0; k < 4; ++k) gs += __expf(gl[k] - gm);
                const float gwt = 1.f / gs;
                float el[4];
#pragma unroll
                for (int k = 0; k < 4; ++k) { const float se = gi == 0 ? tl[4 + k] : (gi == 1 ? tl[8 + k] : (gi == 2 ? tl[12 + k] : tl[16 + k])); el[k] = se + a.in[14][4 * gi + k]; }
                int i1 = 0; float v1 = el[0];
#pragma unroll
                for (int k = 1; k < 4; ++k) if (el[k] > v1) { v1 = el[k]; i1 = k; }
                int i2 = (i1 + 1) & 3; float v2 = -3.0e38f;
#pragma unroll
                for (int k = 0; k < 4; ++k) if (k != i1 && el[k] > v2) { v2 = el[k]; i2 = k; }
                const float ex = __expf(v2 - v1), w1 = gwt / (1.f + ex), w2 = gwt * ex / (1.f + ex);
                if (lane < 4) {
                    const int e1 = 4 * gi + i1, e2 = 4 * gi + i2;
                    const unsigned p1 = __hip_atomic_fetch_add(LC + e1, 1u, __ATOMIC_RELAXED, __HIP_MEMORY_SCOPE_WORKGROUP);
                    const unsigned p2 = __hip_atomic_fetch_add(LC + e2, 1u, __ATOMIC_RELAXED, __HIP_MEMORY_SCOPE_WORKGROUP);
                    LR[rl * 4 + 0] = ((unsigned)e1 << 16) | p1; LR[rl * 4 + 1] = ((unsigned)e2 << 16) | p2; LR[rl * 4 + 2] = __float_as_uint(w1); LR[rl * 4 + 3] = __float_as_uint(w2);
                }
            }
            asm volatile("s_waitcnt lgkmcnt(0)" ::: "memory");
        }
        __syncthreads();
        if (tid < 16) LB[tid] = __hip_atomic_fetch_add(ctl + CW_CNT + 64 * tid, LC[tid], __ATOMIC_RELAXED, __HIP_MEMORY_SCOPE_AGENT);
        __syncthreads();
        if (tid < 256) {
            const int rl = tid >> 1, j = tid & 1; const unsigned rec = LR[rl * 4 + j]; const unsigned e = rec >> 16, pos = LB[e] + (rec & 0xffffu);
            ltok[e * TT + pos] = t0 + rl; tw[2 * (t0 + rl) + j] = __uint_as_float(LR[rl * 4 + 2 + j]); tinfo[2 * (t0 + rl) + j] = (e << 16) | pos;
        }
        __syncthreads();
    }
#undef P6_LOADROW
#undef P6_LN
#undef P6_VAR
#undef P6_STORE
#undef P6_DOT
}
__device__ __forceinline__ void build_tile_tables(const Args& a, LAS unsigned char* lds, int tid) {
    LAS int* ts = (LAS int*)(lds + LDS_TS_OFF); LAS int* te = (LAS int*)(lds + LDS_TE_OFF); LAS int* cn = (LAS int*)(lds + LDS_CNT_OFF);
    gu32* ctl = (gu32*)a.ws;
    if (tid == 0) { int acc = 0;
        for (int e = 0; e < 16; ++e) { ts[e] = acc; const int c = (int)__hip_atomic_load(ctl + CW_CNT + 64 * e, __ATOMIC_RELAXED, __HIP_MEMORY_SCOPE_AGENT); const int nt = (c + 255) >> 8; cn[e] = c;
            for (int k = 0; k < nt; ++k) te[acc + k] = e; acc += nt; }
        ts[16] = acc; }
    __syncthreads();
}
__device__ __forceinline__ void p9_phase(const Args& a, LAS unsigned char* lds, int vcu, int G, int wave, int lane) {
    unsigned char* ws = a.ws;
    const LAS int* ts = (const LAS int*)(lds + LDS_TS_OFF);
    const unsigned* tinfo = (const unsigned*)(ws + WS_TINFO); const u32x2* Y = (const u32x2*)(ws + WS_Y);
    const float* g2 = a.in[18]; const float* b2 = a.in[19];
    const int gw = vcu * NWAVES + wave, NGW = G * NWAVES;
    u32x2 ny0[4], ny1[4], nxw[4]; float nw0 = 0.f, nw1 = 0.f;
    const float* tw = (const float*)(ws + WS_WSLOT);
    auto issue = [&](int t) {
        const unsigned i0 = tinfo[2 * t], i1 = tinfo[2 * t + 1];
        nw0 = tw[2 * t]; nw1 = tw[2 * t + 1];
        const size_t s0 = (size_t)ts[i0 >> 16] * 256 + (i0 & 0xffffu), s1 = (size_t)ts[i1 >> 16] * 256 + (i1 & 0xffffu);
        const u32x2* xb1 = (const u32x2*)(ws + WS_XB) + (size_t)t * 256 + lane;
#pragma unroll
        for (int j = 0; j < 4; ++j) { ny0[j] = Y[s0 * 256 + lane + 64 * j]; ny1[j] = Y[s1 * 256 + lane + 64 * j]; nxw[j] = xb1[64 * j]; }
    };
    if (gw < TT) issue(gw);
    for (int t = gw; t < TT; t += NGW) {
        f32x4* xr = (f32x4*)(a.out + (size_t)t * DM) + lane;
        f32x4 v[4]; float s = 0.f; const float w0 = nw0, w1 = nw1;
#pragma unroll
        for (int j = 0; j < 4; ++j) {
            const u32x2 y0 = ny0[j], y1 = ny1[j], xw = nxw[j];
            f32x4 x = (f32x4){bflo(xw.x), bfhi(xw.x), bflo(xw.y), bfhi(xw.y)} * DN_ALPHA;
            x.x += w0 * bflo(y0.x) + w1 * bflo(y1.x); x.y += w0 * bfhi(y0.x) + w1 * bfhi(y1.x); x.z += w0 * bflo(y0.y) + w1 * bflo(y1.y); x.w += w0 * bfhi(y0.y) + w1 * bfhi(y1.y);
            v[j] = x; s += (x.x + x.y) + (x.z + x.w);
        }
        if (t + NGW < TT) issue(t + NGW);
        const float mean = wave_sum(s) * (1.f / DM); float s2 = 0.f;
#pragma unroll
        for (int j = 0; j < 4; ++j) { v[j] = v[j] - mean; s2 += (v[j].x * v[j].x + v[j].y * v[j].y) + (v[j].z * v[j].z + v[j].w * v[j].w); }
        const float rstd = 1.f / sqrtf(wave_sum(s2) * (1.f / DM) + LN_EPSF);
#pragma unroll
        for (int j = 0; j < 4; ++j) { const f32x4 gg = *(const f32x4*)(g2 + 4 * lane + 256 * j), bb = *(const f32x4*)(b2 + 4 * lane + 256 * j); xr[64 * j] = v[j] * rstd * gg + bb; }
    }
}

__global__ void __launch_bounds__(NWAVES * 64, 2) mega_fwd(Args args) {
    extern __shared__ __attribute__((aligned(16))) unsigned char lds_raw[];
    LAS unsigned char* lds = (LAS unsigned char*)lds_raw;
    volatile LAS unsigned* MISC = (volatile LAS unsigned*)(lds + MISC_OFF);
    const int tid0 = threadIdx.x, wave = __builtin_amdgcn_readfirstlane(tid0 >> 6);
    const int G = gridDim.x, bx = blockIdx.x, vcu = (G % 8 == 0) ? (bx % 8) * (G / 8) + bx / 8 : bx;
    for (int u = tid0; u < (LDS_BYTES - LDSCTL_OFF) / 4; u += NWAVES * 64) ((LAS unsigned*)(lds + LDSCTL_OFF))[u] = 0u;
    __syncthreads();
    unsigned char* ws = args.ws;
    gu32* ctl = (gu32*)ws;
    const bool bars_on = (args.mask >> 31) != 0u;
    XcdBarrier bar; bar.bar = (unsigned*)(ctl + CW_BAR) + args.bar_region * XCD_BAR_WORDS; bar.x = 0; bar.st = nullptr;
    if (bars_on) bar = xcd_barrier_post((unsigned*)(ctl + CW_BAR) + args.bar_region * XCD_BAR_WORDS, MISC + 8);
    bar.wv = wave;
#define GRID_BAR() do { if (bars_on) xcd_barrier(bar); } while (0)
#ifndef PH_LAST
#define PH_LAST 99
#endif
#define FRESH() int tid = wave * 64 + pg8::lane_id(); asm volatile("" : "+v"(tid)); const int lane = tid & 63; (void)lane
#ifndef RMASK
#define RMASK 0
#endif
#define REP(k) _Pragma("unroll") for (int rep_ = 0; rep_ < 1 + ((RMASK >> (k)) & 1); ++rep_)
#ifndef STAMP_SCALE
#define STAMP_SCALE 1.0f
#endif
#ifdef STAMP_PH
#define ST_B(k) if ((k) == STAMP_PH) { st_a = rt(); }
#define ST_E(k) if ((k) == STAMP_PH) { st_b = rt(); }
#else
#define ST_B(k)
#define ST_E(k)
#endif
#ifdef ONLY
#define EN(k) (ONLY == (k))
#else
#define EN(k) ((args.mask >> (k)) & 1u)
#endif
    unsigned long long st_a = 0, st_b = 0; (void)st_a; (void)st_b;
    REP(0) if (EN(0)) { FRESH(); p0_prologue(args, lds, vcu, G, tid, wave, lane); }
    GRID_BAR();
#ifdef STAGGER_TICKS
    if (EN(1) && (bx & 8)) { const unsigned long long t0_ = rt(); while (rt() - t0_ < STAGGER_TICKS) __builtin_amdgcn_s_sleep(32); }
#endif
    REP(1) if (EN(1)) {
#if P1_FP8
        pg8::EpiHcat E{ws, (const float*)(ws + WS_ROT), 0};
        if (P1_FP8_FROM > 0) {
            pg8::Gemm g{(const pg8::bf16_t*)(ws + WS_XB), (const pg8::bf16_t*)(ws + WS_WIN), TT, 4608, 1024}; pg8::StaticOrder S; S.init(TT, 256 * P1_FP8_FROM, G, bx);
            pg8::gemm_phase<pg8::EpiHcat, pg8::StaticOrder, true, true>(lds, g, S, E, wave);
        }
        {
            pg8::Gemm g{(const pg8::bf16_t*)args.out, (const pg8::bf16_t*)(ws + WS_WIN8), TT, 4608, 512}; pg8::StaticOrder S; S.init(TT, 4608 - 256 * P1_FP8_FROM, G, bx, P1_FP8_FROM);
            pg8::gemm_phase<pg8::EpiHcat, pg8::StaticOrder, true, true, false, true, 1, 0>(lds, g, S, E, wave);
        }
#else
        pg8::Gemm g{(const pg8::bf16_t*)(ws + WS_XB), (const pg8::bf16_t*)(ws + WS_WIN), TT, 4608, 1024}; pg8::StaticOrder S; S.init(TT, 4608, G, bx);
        pg8::EpiHcat E{ws, (const float*)(ws + WS_ROT), 0};
        pg8::gemm_phase<pg8::EpiHcat, pg8::StaticOrder, true, true>(lds, g, S, E, wave);
#endif
    }
    GRID_BAR();
    if (PH_LAST >= 2) {
        REP(2) if (EN(2)) { FRESH(); for (int it = vcu; it < 256; it += G) chain_item(args, lds, it, tid, wave, lane); }
        if (EN(3)) { { FRESH(); attn_dil_phase<16>(args, lds, vcu, G, tid, wave, lane); }
                     { FRESH(); attn_dil_phase<4>(args, lds, vcu, G, tid, wave, lane); } }
    }
    GRID_BAR();
    ST_B(4) if (PH_LAST >= 3 && EN(4)) { FRESH(); p3_phase<0>(args, lds, vcu, G, tid, wave, lane); }
    if (EN(13)) { FRESH(); attn_p1_phase(args, lds, vcu, G, tid, wave, lane); }
    GRID_BAR(); ST_E(4)
    if (EN(14)) { FRESH(); p0_expert_weights(args, lds, vcu, G, wave, lane); }
    REP(5) if (PH_LAST >= 4 && EN(5)) {
        pg8::Gemm g{(const pg8::bf16_t*)(ws + WS_XB), (const pg8::bf16_t*)(ws + WS_WIN) + (size_t)4608 * 1024, TT, 2048, 1024}; pg8::GateOrder S; S.S4.init(TT, 1024, G, bx);
        pg8::EpiHcat E{ws, (const float*)(ws + WS_ROT), 18};
        pg8::gemm_phase<pg8::EpiHcat, pg8::GateOrder, true, true>(lds, g, S, E, wave);
        asm volatile("s_waitcnt vmcnt(0)" ::: "memory"); __syncthreads();
    }
    REP(6) if (PH_LAST >= 5 && EN(6)) {
        pg8::StaticOrder S; S.init(TT, 1024, G, bx);
        { pg8::Gemm g{(const pg8::bf16_t*)(ws + WS_OA), (const pg8::bf16_t*)(ws + WS_WA), TT, 1024, 512};
          pg8::EpiGate<false> E{(const pg8::bf16_t*)(ws + WS_GATE_A), (pg8::bf16_t*)(ws + WS_MERGED)};
          pg8::gemm_phase<pg8::EpiGate<false>, pg8::StaticOrder, true, true>(lds, g, S, E, wave); }
        asm volatile("s_waitcnt vmcnt(0)" ::: "memory"); __syncthreads();
        { pg8::Gemm g{(const pg8::bf16_t*)(ws + WS_GR), (const pg8::bf16_t*)(ws + WS_WR), TT, 1024, 1024};
          pg8::EpiGate<true> E{(const pg8::bf16_t*)(ws + WS_GATE_R), (pg8::bf16_t*)(ws + WS_MERGED)};
          pg8::gemm_phase<pg8::EpiGate<true>, pg8::StaticOrder, true, true>(lds, g, S, E, wave); }
    }
    GRID_BAR();
    REP(7) if (PH_LAST >= 6 && EN(7)) {
        pg8::Gemm g{(const pg8::bf16_t*)(ws + WS_MERGED), (const pg8::bf16_t*)(ws + WS_WO), TT, 1024, 1024}; pg8::StaticOrder S; S.init(TT, 1024, G, bx);
        pg8::EpiResBf16 E{(const pg8::bf16_t*)(ws + WS_XB), (pg8::bf16_t*)args.out, DN_ALPHA};
        pg8::gemm_phase<pg8::EpiResBf16, pg8::StaticOrder, true, true>(lds, g, S, E, wave);
    }
    GRID_BAR();
    ST_B(8) if (PH_LAST >= 7 && EN(8)) { FRESH(); p6a_phase(args, lds, vcu, G, tid, wave, lane); }
    GRID_BAR(); ST_E(8)
    { FRESH(); build_tile_tables(args, lds, tid); }
    const int nrt = ((const LAS int*)(lds + LDS_TS_OFF))[16];
    REP(10) if (PH_LAST >= 9 && EN(10)) {
#if M1_FP8
        pg8::Gemm g{(const pg8::bf16_t*)(ws + WS_X1F8), (const pg8::bf16_t*)(ws + WS_WGU), MAXSLOT, 1024, 512};
        pg8::MoeOrder S{nrt * 4, G, vcu, (const LAS int*)(lds + LDS_TE_OFF), (const LAS int*)(lds + LDS_TS_OFF), (const LAS int*)(lds + LDS_CNT_OFF), (const int*)(ws + WS_LTOK), 1024u};
        pg8::EpiSwiGLU E{ws + WS_H};
        pg8::gemm_phase<pg8::EpiSwiGLU, pg8::MoeOrder, true, true, true, true, 1, 0>(lds, g, S, E, wave);
#else
        pg8::Gemm g{(const pg8::bf16_t*)(ws + WS_XB), (const pg8::bf16_t*)(ws + WS_WGU), MAXSLOT, 1024, 1024};
        pg8::MoeOrder S{nrt * 4, G, vcu, (const LAS int*)(lds + LDS_TE_OFF), (const LAS int*)(lds + LDS_TS_OFF), (const LAS int*)(lds + LDS_CNT_OFF), (const int*)(ws + WS_LTOK), 2048u};
        pg8::EpiSwiGLU E{ws + WS_H};
        pg8::gemm_phase<pg8::EpiSwiGLU, pg8::MoeOrder, true, true, true>(lds, g, S, E, wave);
#endif
    }
    GRID_BAR();
    REP(11) if (PH_LAST >= 10 && EN(11)) {
        pg8::Gemm g{(const pg8::bf16_t*)(ws + WS_H), (const pg8::bf16_t*)(ws + WS_WD), MAXSLOT, 1024, 256};
        pg8::MoeOrder S{nrt * 4, G, vcu, (const LAS int*)(lds + LDS_TE_OFF), (const LAS int*)(lds + LDS_TS_OFF), (const LAS int*)(lds + LDS_CNT_OFF), (const int*)(ws + WS_LTOK), 1024u};
        pg8::EpiRowScale E{(pg8::bf16_t*)(ws + WS_Y)};
        pg8::gemm_phase<pg8::EpiRowScale, pg8::MoeOrder, true, true, false, true, 1, 2>(lds, g, S, E, wave);
    }
    GRID_BAR();
    ST_B(12) if (PH_LAST >= 11 && EN(12)) { FRESH(); p9_phase(args, lds, vcu, G, wave, lane); }
#ifdef STAMP_PH
    GRID_BAR(); ST_E(12)
    if (STAMP_PH == 13) { st_a = rt(); GRID_BAR(); GRID_BAR(); GRID_BAR(); GRID_BAR(); st_b = rt(); }
    if (bx == 0 && tid0 == 0) { const float us = (float)(st_b - st_a) * 0.01f * STAMP_SCALE; int k = 0; float lim = 30.f; while (us >= lim && k < 12) { lim *= 1.5f; ++k; }
        __hip_atomic_store(ctl + CW_CHK, __float_as_uint(sqrtf(2.f * k + 2.f)), RLX_AGENT); }
    GRID_BAR();
    { const float c = __uint_as_float(__hip_atomic_load(ctl + CW_CHK, RLX_AGENT)); f32x4* o4 = (f32x4*)args.out;
      for (size_t i = (size_t)bx * 512 + tid0; i < (size_t)TT * DM / 4; i += (size_t)G * 512) o4[i] = (f32x4){c, c, c, c}; }
#endif
}

#ifdef PROBE_VAR
__global__ void __launch_bounds__(NWAVES * 64, 2) probe_kernel(Args args) {
    extern __shared__ __attribute__((aligned(16))) unsigned char lds_raw[];
    LAS unsigned char* lds = (LAS unsigned char*)lds_raw;
    const int tid0 = threadIdx.x, wave = __builtin_amdgcn_readfirstlane(tid0 >> 6);
    const int G = gridDim.x, bx = blockIdx.x, vcu = (G % 8 == 0) ? (bx % 8) * (G / 8) + bx / 8 : bx;
    FRESH();
    if (PROBE_VAR == 20 || PROBE_VAR == 21) {
        unsigned char* ws = args.ws;
        pg8::Gemm g{(const pg8::bf16_t*)(ws + WS_XB), (const pg8::bf16_t*)(ws + WS_WIN), TT, 4608, 1024}; pg8::StaticOrder S; S.init(TT, 4608, G, bx);
        pg8::EpiHcatT<PROBE_VAR == 21 ? 1 : 0> E{ws, (const float*)(ws + WS_ROT), 0};
        pg8::gemm_phase<pg8::EpiHcatT<PROBE_VAR == 21 ? 1 : 0>, pg8::StaticOrder, true, true>(lds, g, S, E, wave);
    }
    if (PROBE_VAR == 10) p3_phase<0>(args, lds, vcu, G, tid, wave, lane);
    if (PROBE_VAR == 11) p3_phase<1>(args, lds, vcu, G, tid, wave, lane);
    if (PROBE_VAR == 0) attn_dil_phase<16, 0>(args, lds, vcu, G, tid, wave, lane);
    if (PROBE_VAR == 1) attn_dil_phase<16, 1>(args, lds, vcu, G, tid, wave, lane);
    if (PROBE_VAR == 2) attn_dil_phase<4, 0>(args, lds, vcu, G, tid, wave, lane);
    if (PROBE_VAR == 3) attn_dil_phase<4, 1>(args, lds, vcu, G, tid, wave, lane);
}
#endif
extern "C" void kernel_launch(void* const* d_in, const int* in_sizes, int n_in, void* d_out, int out_size, void* d_ws, size_t ws_size, hipStream_t stream) {
    static int grid = 0;
    if (grid == 0) {
        if (n_in != 20 || in_sizes[0] != TT * DM || out_size != TT * DM || ws_size < WS_END) { fprintf(stderr, "kernel_launch: unexpected shapes: n_in %d in0 %d out %d ws %zu; nothing launched\n", n_in, n_in > 0 ? in_sizes[0] : -1, out_size, ws_size); grid = -1; return; }
        int dev = 0, cus = 0;
        if (hipGetDevice(&dev) != hipSuccess || hipDeviceGetAttribute(&cus, hipDeviceAttributeMultiprocessorCount, dev) != hipSuccess) { grid = -1; return; }
        if (hipFuncSetAttribute((const void*)mega_fwd, hipFuncAttributeMaxDynamicSharedMemorySize, LDS_BYTES) != hipSuccess) { fprintf(stderr, "kernel_launch: hipFuncSetAttribute failed\n"); grid = -1; return; }
        (void)hipGetLastError();
        grid = cus;
    }
    if (grid < 0) return;
    if (hipMemsetAsync((char*)d_ws, 0, CTL_ZERO_BYTES, stream) != hipSuccess) return;
    Args a{};
    for (int i = 0; i < 20; ++i) a.in[i] = (const float*)d_in[i];
    a.out = (float*)d_out; a.ws = (unsigned char*)d_ws; a.mask = 0x80007fffu; a.bar_region = 0;
#if defined(XTRA_FIRST)
    { Args x = a; x.mask = XTRA_FIRST; x.bar_region = 1; for (int r = 0; r < XTRA_REP; ++r) hipLaunchKernelGGL(mega_fwd, dim3(grid), dim3(NWAVES * 64), LDS_BYTES, stream, x);
      if (hipMemsetAsync((char*)d_ws, 0, CTL_ZERO_BYTES, stream) != hipSuccess) return; }
#endif
    hipLaunchKernelGGL(mega_fwd, dim3(grid), dim3(NWAVES * 64), LDS_BYTES, stream, a);
#if defined(PROBE_VAR)
    { hipFuncSetAttribute((const void*)probe_kernel, hipFuncAttributeMaxDynamicSharedMemorySize, LDS_BYTES);
      for (int r = 0; r < 4; ++r) hipLaunchKernelGGL(probe_kernel, dim3(grid), dim3(NWAVES * 64), LDS_BYTES, stream, a); }
#endif
#if defined(XTRA_AFTER)
    { Args x = a; x.mask = XTRA_AFTER; x.bar_region = 1; for (int r = 0; r < XTRA_REP; ++r) hipLaunchKernelGGL(mega_fwd, dim3(grid), dim3(NWAVES * 64), LDS_BYTES, stream, x); }
#endif
}
```

```cpp
#define P1_FP8 1
#define P1_FP8_FROM 4
#define MIX_FP8 7
#include <hip/hip_runtime.h>
#include <cstdio>
#include <cstdint>

constexpr int TT = 32768, DM = 1024, SEQ = 2048, NB = 16;
constexpr float DN_ALPHA = 1.189207115002721f;
constexpr float LN_EPSF = 1e-5f;
constexpr size_t MiB = 1u << 20;
constexpr size_t CTL_ZERO_BYTES = 1 * MiB;
constexpr size_t WS_ROT = 1 * MiB;
constexpr size_t WS_BIAS = 2 * MiB;
constexpr size_t WS_LTOK = 3 * MiB;
constexpr size_t WS_TINFO = 7 * MiB;
constexpr size_t WS_WSLOT = 7 * MiB + 512 * 1024;
constexpr size_t WS_WIN = 8 * MiB;
constexpr size_t WS_WIN8 = 66 * MiB;
constexpr size_t WS_WR = 21 * MiB;
constexpr size_t WS_WA = 23 * MiB;
constexpr size_t WS_WO = 24 * MiB;
constexpr size_t WS_WGU = 26 * MiB;
constexpr size_t WS_WD = 58 * MiB;
constexpr size_t WS_XB = 80 * MiB;
constexpr size_t WS_QR = 144 * MiB;
constexpr size_t WS_KR = 176 * MiB;
constexpr size_t WS_VR = 208 * MiB;
constexpr size_t WS_GR = 272 * MiB;
constexpr size_t WS_QA = 336 * MiB, WS_KA = 368 * MiB, WS_VA = 400 * MiB, WS_OA = 432 * MiB;
#if MIX_FP8 & 4
constexpr size_t WS_AR8 = 144 * MiB;
constexpr size_t WS_GATE_R = 176 * MiB, WS_GATE_A = 240 * MiB;
#else
constexpr size_t WS_GATE_R = 144 * MiB, WS_GATE_A = 208 * MiB;
#endif
constexpr size_t WS_MERGED8 = 464 * MiB;
constexpr size_t WS_MERGED = 336 * MiB;
constexpr size_t WS_Y = 144 * MiB;
constexpr size_t WS_H = 336 * MiB;
constexpr size_t WS_X1F8 = 464 * MiB;
constexpr size_t WS_O2 = 26 * MiB;
constexpr size_t WS_O3 = 464 * MiB;
constexpr size_t WS_LSE2 = 496 * MiB, WS_LSE3 = 497 * MiB;
constexpr size_t WS_END = 512 * MiB;
#ifndef M1_FP8
#define M1_FP8 1
#endif
#ifndef P1_FP8
#define P1_FP8 0
#endif
#ifndef MIX_FP8
#define MIX_FP8 0
#endif
#ifndef P1_FP8_FROM
#define P1_FP8_FROM 0
#endif
constexpr int MAXSLOT = 69632;
constexpr int CW_BAR = 4096;
constexpr int CW_CNT = 16384;
constexpr int CW_CHK = 24576;
namespace pg8 {
#define PG8_LAS __attribute__((address_space(3)))
typedef unsigned short bf16_t;
typedef short bf16x8 __attribute__((ext_vector_type(8)));
typedef float f32x4 __attribute__((ext_vector_type(4)));
typedef unsigned u32x4 __attribute__((ext_vector_type(4)));
typedef unsigned u32x2_ __attribute__((ext_vector_type(2)));
constexpr int BM = 256, BK = 64, HALF = 128, HTB = HALF * BK * 2  , STAGE_BYTES = 8 * HTB, NXCD = 8, WGM = 8;

__device__ __forceinline__ int lane_id() { int x; asm volatile("v_mbcnt_lo_u32_b32 %0, -1, 0\n\tv_mbcnt_hi_u32_b32 %0, -1, %0" : "=v"(x)); return x; }
__host__ __device__ __forceinline__ int lds_byte(int r, int c) { const int st = (r >> 4) * 2 + (c >> 5), rr = r & 15, cc = c & 31, ob = rr * 64 + cc * 2; return st * 1024 + (ob ^ (((ob >> 9) & 1) << 5)); }
__host__ __device__ __forceinline__ void stage_rc(int b, int& R, int& C) { const int st = b / 1024, sb = b % 1024, swz = sb ^ (((sb >> 9) & 1) << 5); R = (st >> 1) * 16 + swz / 64; C = (st & 1) * 32 + (swz % 64) / 2; }
__host__ __device__ __forceinline__ int perm32(int rho) { const int n = rho >> 4, i = rho & 15; return 8 * (i >> 2) + 4 * n + (i & 3); }

struct Unit { int pm, pn; };
struct Gemm { const bf16_t* A; const bf16_t* Bt; int M, N, K; };

struct StaticOrder {
    int nM, nN, nwg, G, c, pn0;
    __host__ __device__ void init(int M, int N, int G_, int c_, int pn0_ = 0) { nM = M / BM; nN = N / BM; nwg = nM * nN; G = G_; c = c_; pn0 = pn0_; }
    __host__ __device__ bool next(int i, Unit& u) const {
        const long L = (long)i * G + c; if (L >= nwg) return false;
        int wgid = (int)L; { const int q = nwg / NXCD, r = nwg % NXCD, xcd = wgid % NXCD, off = wgid / NXCD; wgid = (xcd < r ? xcd * (q + 1) : r * (q + 1) + (xcd - r) * q) + off; }
        const int nig = WGM * nN, gid = wgid / nig, fm = gid * WGM, gsz = (nM - fm) < WGM ? (nM - fm) : WGM;
        u.pm = fm + ((wgid % nig) % gsz); u.pn = pn0 + (wgid % nig) / gsz; return true;
    }
    __device__ __forceinline__ void a_ready(const Unit&) const {}
    __device__ __forceinline__ void done(const Unit&) const {}
};

__device__ __forceinline__ unsigned cvt_pk_bf16(float lo, float hi) { unsigned r; asm volatile("v_cvt_pk_bf16_f32 %0, %1, %2" : "=v"(r) : "v"(lo), "v"(hi)); return r; }
typedef float cvt_f32x2_t __attribute__((ext_vector_type(2))); typedef __bf16 cvt_bf16x2_t __attribute__((ext_vector_type(2)));
__device__ __forceinline__ unsigned cvt_pk_bf16_acc(float lo, float hi) { const cvt_f32x2_t v = {lo, hi}; const cvt_bf16x2_t b = __builtin_convertvector(v, cvt_bf16x2_t); return __builtin_bit_cast(unsigned, b); }
__device__ __forceinline__ float bflo(unsigned w) { return __uint_as_float(w << 16); }
__device__ __forceinline__ float bfhi(unsigned w) { return __uint_as_float(w & 0xffff0000u); }
__device__ __forceinline__ float fsigmoid(float x) { return __builtin_amdgcn_rcpf(1.f + __expf(-x)); }
__device__ __forceinline__ float fsilu(float x) { return x * __builtin_amdgcn_rcpf(1.f + __expf(-x)); }

template <int VAR = 0> struct EpiHcatT {
    static constexpr bool PERM = true, AFTER_DRAIN = false; static constexpr int NSTORE = 16;
    unsigned char* ws; const float* rot; int tile_off;
    __device__ __forceinline__ void operator()(const f32x4 (&acc)[2][2][4][2], const Unit& u, int wr, int wc, int fr, int fq) const {
        if (VAR == 1) {
            float s = 0.f;
#pragma unroll
            for (int ai = 0; ai < 2; ++ai)
#pragma unroll
                for (int bj = 0; bj < 2; ++bj)
#pragma unroll
                    for (int m = 0; m < 4; ++m)
#pragma unroll
                        for (int n = 0; n < 2; ++n) s += (acc[ai][bj][m][n][0] + acc[ai][bj][m][n][1]) + (acc[ai][bj][m][n][2] + acc[ai][bj][m][n][3]);
            ((float*)(ws + WS_O3))[(size_t)(u.pm * 64 + u.pn) * 512 + wr * 256 + wc * 64 + fq * 16 + fr] = s; return;
        }
        const int gt = u.pn + tile_off;
        size_t base_off; int pitch, ct, mode; float sc = 1.f;
        if (gt < 2)       { base_off = WS_QR; pitch = 512;  ct = gt;      mode = 1; }
        else if (gt < 4)  { base_off = WS_KR; pitch = 512;  ct = gt - 2;  mode = 1; sc = 0.08838834764831845f; }
        else if (gt < 8)  { base_off = WS_VR; pitch = 1024; ct = gt - 4;  mode = 0; }
        else if (gt < 12) { base_off = WS_GR; pitch = 1024; ct = gt - 8;  mode = 2; }
        else if (gt < 14) { base_off = WS_QA; pitch = 512;  ct = gt - 12; mode = 0; sc = 0.18033688011112042f; }
        else if (gt < 16) { base_off = WS_KA; pitch = 512;  ct = gt - 14; mode = 0; }
        else if (gt < 18) { base_off = WS_VA; pitch = 512;  ct = gt - 16; mode = 0; }
        else if (gt < 22) { base_off = WS_GATE_R; pitch = 1024; ct = gt - 18; mode = 3; }
        else              { base_off = WS_GATE_A; pitch = 1024; ct = gt - 22; mode = 3; }
        bf16_t* O = (bf16_t*)(ws + base_off);
        const int row0 = u.pm * BM + wr * 64 + fr, col0 = ct * BM + wc * 32 + 8 * fq;
#pragma unroll
        for (int ai = 0; ai < 2; ++ai)
#pragma unroll
            for (int m = 0; m < 4; ++m) {
                const int row = row0 + ai * HALF + m * 16;
                bf16_t* rowp = O + (size_t)row * pitch + col0;
                f32x4 cs = (f32x4){1.f, 1.f, 1.f, 1.f}, sn = (f32x4){0.f, 0.f, 0.f, 0.f};
                if (mode == 1) { const f32x4* rt = (const f32x4*)(rot + ((size_t)(row & (SEQ - 1)) * 16 + (4 * wc + fq)) * 8); cs = rt[0]; sn = rt[1]; }
#pragma unroll
                for (int bj = 0; bj < 2; ++bj) {
                    f32x4 v0 = acc[ai][bj][m][0], v1 = acc[ai][bj][m][1];
                    if (mode == 1) { const f32x4 a = v0 * cs - v1 * sn, b = v0 * sn + v1 * cs; v0 = a * sc; v1 = b * sc; }
                    else if (mode == 2) {
#pragma unroll
                        for (int e = 0; e < 4; ++e) { v0[e] = fsilu(v0[e]); v1[e] = fsilu(v1[e]); } }
                    else if (mode == 3) {
#pragma unroll
                        for (int e = 0; e < 4; ++e) { v0[e] = fsigmoid(v0[e]); v1[e] = fsigmoid(v1[e]); } }
                    else { v0 = v0 * sc; v1 = v1 * sc; }
                    u32x4 w; w.x = cvt_pk_bf16(v0[0], v0[1]); w.y = cvt_pk_bf16(v0[2], v0[3]); w.z = cvt_pk_bf16(v1[0], v1[1]); w.w = cvt_pk_bf16(v1[2], v1[3]);
                    *(u32x4*)(rowp + bj * HALF) = w;
                }
            }
    }
};

typedef EpiHcatT<0> EpiHcat;

__device__ __forceinline__ unsigned fp8x4_sat(float a, float b, float c, float d) {
    a = __builtin_amdgcn_fmed3f(a, -448.f, 448.f); b = __builtin_amdgcn_fmed3f(b, -448.f, 448.f); c = __builtin_amdgcn_fmed3f(c, -448.f, 448.f); d = __builtin_amdgcn_fmed3f(d, -448.f, 448.f);
    unsigned w = 0u; w = __builtin_amdgcn_cvt_pk_fp8_f32(a, b, w, false); w = __builtin_amdgcn_cvt_pk_fp8_f32(c, d, w, true); return w;
}
template <bool ADD, bool OUT8 = false> struct EpiGate {
    static constexpr bool PERM = true, AFTER_DRAIN = false; static constexpr int NSTORE = 16;
    const bf16_t* gate; bf16_t* O; unsigned char* O8;
    __device__ __forceinline__ void operator()(const f32x4 (&acc)[2][2][4][2], const Unit& u, int wr, int wc, int fr, int fq) const {
        const int row0 = u.pm * BM + wr * 64 + fr, col0 = u.pn * BM + wc * 32 + 8 * fq;
#pragma unroll
        for (int ai = 0; ai < 2; ++ai)
#pragma unroll
            for (int m = 0; m < 4; ++m)
#pragma unroll
                for (int bj = 0; bj < 2; ++bj) {
                    const size_t p = (size_t)(row0 + ai * HALF + m * 16) * 1024 + col0 + bj * HALF;
                    const u32x4 g = *(const u32x4*)(gate + p);
                    f32x4 v0 = acc[ai][bj][m][0], v1 = acc[ai][bj][m][1];
                    v0[0] *= bflo(g.x); v0[1] *= bfhi(g.x); v0[2] *= bflo(g.y); v0[3] *= bfhi(g.y);
                    v1[0] *= bflo(g.z); v1[1] *= bfhi(g.z); v1[2] *= bflo(g.w); v1[3] *= bfhi(g.w);
                    if (ADD) { const u32x4 o = *(const u32x4*)(O + p);
                        v0[0] += bflo(o.x); v0[1] += bfhi(o.x); v0[2] += bflo(o.y); v0[3] += bfhi(o.y);
                        v1[0] += bflo(o.z); v1[1] += bfhi(o.z); v1[2] += bflo(o.w); v1[3] += bfhi(o.w); }
                    if (OUT8) { u32x2_ w8;
                        w8.x = fp8x4_sat(v0[0] * 16.f, v0[1] * 16.f, v0[2] * 16.f, v0[3] * 16.f); w8.y = fp8x4_sat(v1[0] * 16.f, v1[1] * 16.f, v1[2] * 16.f, v1[3] * 16.f);
                        *(u32x2_*)(O8 + p) = w8; }
                    else { u32x4 w; w.x = cvt_pk_bf16(v0[0], v0[1]); w.y = cvt_pk_bf16(v0[2], v0[3]); w.z = cvt_pk_bf16(v1[0], v1[1]); w.w = cvt_pk_bf16(v1[2], v1[3]);
                        *(u32x4*)(O + p) = w; }
                }
    }
};

struct EpiResBf16 {
    static constexpr bool PERM = true, AFTER_DRAIN = false; static constexpr int NSTORE = 16;
    const bf16_t* x; bf16_t* out; float alpha;
    __device__ __forceinline__ void operator()(const f32x4 (&acc)[2][2][4][2], const Unit& u, int wr, int wc, int fr, int fq) const {
        const int row0 = u.pm * BM + wr * 64 + fr, col0 = u.pn * BM + wc * 32 + 8 * fq;
#pragma unroll
        for (int ai = 0; ai < 2; ++ai)
#pragma unroll
            for (int m = 0; m < 4; ++m)
#pragma unroll
                for (int bj = 0; bj < 2; ++bj) {
                    const size_t p = (size_t)(row0 + ai * HALF + m * 16) * 1024 + col0 + bj * HALF;
                    const u32x4 xw = *(const u32x4*)(x + p);
                    const f32x4 x0 = (f32x4){bflo(xw.x), bfhi(xw.x), bflo(xw.y), bfhi(xw.y)}, x1 = (f32x4){bflo(xw.z), bfhi(xw.z), bflo(xw.w), bfhi(xw.w)};
                    const f32x4 v0 = x0 * alpha + acc[ai][bj][m][0], v1 = x1 * alpha + acc[ai][bj][m][1];
                    u32x4 w; w.x = cvt_pk_bf16(v0[0], v0[1]); w.y = cvt_pk_bf16(v0[2], v0[3]); w.z = cvt_pk_bf16(v1[0], v1[1]); w.w = cvt_pk_bf16(v1[2], v1[3]);
                    *(u32x4*)(out + p) = w;
                }
    }
};

struct EpiSwiGLU {
    static constexpr bool PERM = true, AFTER_DRAIN = false; static constexpr int NSTORE = 16;
    unsigned char* H;
    __device__ __forceinline__ void operator()(const f32x4 (&acc)[2][2][4][2], const Unit& u, int wr, int wc, int fr, int fq) const {
        const int row0 = u.pm * BM + wr * 64 + fr, col0 = (u.pn & 3) * 128 + wc * 16 + 4 * fq;
#pragma unroll
        for (int ai = 0; ai < 2; ++ai)
#pragma unroll
            for (int m = 0; m < 4; ++m)
#pragma unroll
                for (int bj = 0; bj < 2; ++bj) {
                    const f32x4 g = acc[ai][bj][m][0], up = acc[ai][bj][m][1];
                    float h0 = fsilu(g[0]) * up[0] * 8.f, h1 = fsilu(g[1]) * up[1] * 8.f, h2 = fsilu(g[2]) * up[2] * 8.f, h3 = fsilu(g[3]) * up[3] * 8.f;
                    h0 = fminf(fmaxf(h0, -448.f), 448.f); h1 = fminf(fmaxf(h1, -448.f), 448.f); h2 = fminf(fmaxf(h2, -448.f), 448.f); h3 = fminf(fmaxf(h3, -448.f), 448.f);
                    unsigned w = 0u; w = __builtin_amdgcn_cvt_pk_fp8_f32(h0, h1, w, false); w = __builtin_amdgcn_cvt_pk_fp8_f32(h2, h3, w, true);
                    *(unsigned*)(H + (size_t)(row0 + ai * HALF + m * 16) * 512 + col0 + bj * 64) = w;
                }
    }
};

struct EpiRowScale {
    static constexpr bool PERM = true, AFTER_DRAIN = false; static constexpr int NSTORE = 16;
    bf16_t* Y;
    __device__ __forceinline__ void operator()(const f32x4 (&acc)[2][2][4][2], const Unit& u, int wr, int wc, int fr, int fq) const {
        const int row0 = u.pm * BM + wr * 64 + fr, col0 = (u.pn & 3) * BM + wc * 32 + 8 * fq;
#pragma unroll
        for (int ai = 0; ai < 2; ++ai)
#pragma unroll
            for (int m = 0; m < 4; ++m) {
                const int row = row0 + ai * HALF + m * 16;
#pragma unroll
                for (int bj = 0; bj < 2; ++bj) {
                    const f32x4 v0 = acc[ai][bj][m][0], v1 = acc[ai][bj][m][1];
                    u32x4 w; w.x = cvt_pk_bf16_acc(v0[0], v0[1]); w.y = cvt_pk_bf16_acc(v0[2], v0[3]); w.z = cvt_pk_bf16_acc(v1[0], v1[1]); w.w = cvt_pk_bf16_acc(v1[2], v1[3]);
                    *(u32x4*)(Y + (size_t)row * 1024 + col0 + bj * HALF) = w;
                }
            }
    }
};

struct MoeOrder {
    int nunits, G, c; const PG8_LAS int* te; const PG8_LAS int* ts; const PG8_LAS int* cnt; const int* ltok; unsigned rowbytes;
    __device__ __forceinline__ bool next(int i, Unit& u) const {
        const int L = i * G + c, rt = (L >> 5) * 8 + (L & 7); if (rt >= (nunits >> 2)) return false;
        u.pm = rt; u.pn = te[rt] * 4 + ((L >> 3) & 3); return true;
    }
    __device__ __forceinline__ unsigned a_row_off(const Unit& u, int row) const {
        const int ex = te[u.pm], pos = (u.pm - ts[ex]) * 256 + row;
        const int tok = pos < cnt[ex] ? ltok[ex * 32768 + pos] : 0;
        return (unsigned)tok * rowbytes;
    }
    __device__ __forceinline__ void a_ready(const Unit&) const {}
    __device__ __forceinline__ void done(const Unit&) const {}
};

struct GateOrder {
    StaticOrder S4;
    __device__ __forceinline__ bool next(int i, Unit& u) const { Unit t; if (!S4.next(i >> 1, t)) return false; u.pm = t.pm; u.pn = t.pn + 4 * (i & 1); return true; }
    __device__ __forceinline__ void a_ready(const Unit&) const {}
    __device__ __forceinline__ void done(const Unit&) const {}
};

template <class Epi, class Sched, bool ALIGN_EPI = false, bool SP2 = false, bool GATHER = false, bool FP8 = false, int SEL_W = 0, int SEL_X = 0>
__device__ __forceinline__ void gemm_phase(PG8_LAS unsigned char* lds, const Gemm g, const Sched& S, const Epi& E, const int wid) {
    int tid = wid * 64 + lane_id(); asm volatile("" : "+v"(tid));
    const int lane = tid & 63, wr = wid >> 2, wc = wid & 3, fr = lane & 15, fq = lane >> 4;
    static_assert(SP2, "only the two-super-phase loop is kept");
    typedef int i32x4_ __attribute__((ext_vector_type(4)));
    const int K = g.K, nt = K / BK;
    unsigned voffB[2]; int rA[2], cA2[2];
#pragma unroll
    for (int i = 0; i < 2; ++i) { int R, C; stage_rc(tid * 16 + i * 8192, R, C); const int Rb = Epi::PERM ? ((R & ~31) + perm32(R & 31)) : R;
        rA[i] = R; cA2[i] = C * 2; voffB[i] = (unsigned)(Rb * K + C) * 2u; }
    unsigned vAc[2][2], vAn[2][2];
    const size_t kstep = (size_t)(BK * 2);
    const size_t hstep = (size_t)HALF * K * 2;
    const size_t tstep = 2 * hstep;
    const unsigned ldsw = (unsigned)wid * 1024u;
    const int aoff0 = lds_byte(wr * 64 + fr, fq * 8), aoff1 = aoff0 + 1024;
    const int boff0 = lds_byte(wc * 32 + fr, fq * 8), boff1 = boff0 + 1024;
#define PG8_SA(b, h) (((b) * 2 + (h)) * HTB)
#define PG8_SB(b, h) ((4 + (b) * 2 + (h)) * HTB)
#define PG8_STAGE(bufoff, gbase, voff) do { _Pragma("unroll") for (int _i = 0; _i < 2; ++_i) \
        __builtin_amdgcn_global_load_lds((const unsigned*)((const char*)(gbase) + (voff)[_i]), (PG8_LAS unsigned*)(lds + (bufoff) + ldsw + _i * 8192), 16, 0, 0); } while (0)
#define PG8_LDA(dst, b, h) do { _Pragma("unroll") for (int m = 0; m < 4; ++m) { dst[m][0] = *(const PG8_LAS bf16x8*)(lds + PG8_SA(b, h) + aoff0 + m * 2048); dst[m][1] = *(const PG8_LAS bf16x8*)(lds + PG8_SA(b, h) + aoff1 + m * 2048); } } while (0)
#define PG8_LDB(dst, b, h) do { _Pragma("unroll") for (int n = 0; n < 2; ++n) { dst[n][0] = *(const PG8_LAS bf16x8*)(lds + PG8_SB(b, h) + boff0 + n * 2048); dst[n][1] = *(const PG8_LAS bf16x8*)(lds + PG8_SB(b, h) + boff1 + n * 2048); } } while (0)
#define PG8_CAT8(x) __builtin_shufflevector(__builtin_bit_cast(i32x4_, (x)[0]), __builtin_bit_cast(i32x4_, (x)[1]), 0, 1, 2, 3, 4, 5, 6, 7)
#define PG8_MMA(ai, bj, At, Bt) do { __builtin_amdgcn_s_setprio(1); \
        if constexpr (FP8) { _Pragma("unroll") for (int m = 0; m < 4; ++m) _Pragma("unroll") for (int n = 0; n < 2; ++n) \
            acc[ai][bj][m][n] = __builtin_amdgcn_mfma_scale_f32_16x16x128_f8f6f4(PG8_CAT8(Bt[n]), PG8_CAT8(At[m]), acc[ai][bj][m][n], 0, 0, SEL_W, scl, SEL_X, scl); \
            asm volatile("" : "+v"(acc[ai][bj][0][0]), "+v"(acc[ai][bj][0][1]), "+v"(acc[ai][bj][1][0]), "+v"(acc[ai][bj][1][1]), "+v"(acc[ai][bj][2][0]), "+v"(acc[ai][bj][2][1]), "+v"(acc[ai][bj][3][0]), "+v"(acc[ai][bj][3][1])); } \
        else { _Pragma("unroll") for (int m = 0; m < 4; ++m) _Pragma("unroll") for (int n = 0; n < 2; ++n) _Pragma("unroll") for (int k = 0; k < 2; ++k) \
            acc[ai][bj][m][n] = __builtin_amdgcn_mfma_f32_16x16x32_bf16(Bt[n][k], At[m][k], acc[ai][bj][m][n], 0, 0, 0); } \
        __builtin_amdgcn_s_setprio(0); } while (0)
#define PG8_WAIT_V(n) asm volatile("s_waitcnt vmcnt(" #n ")" ::: "memory")
#define PG8_WAIT_VN(n) asm volatile("s_waitcnt vmcnt(%0)" :: "i"(n) : "memory")
#define PG8_WAIT_L(n) asm volatile("s_waitcnt lgkmcnt(" #n ")" ::: "memory")
#define PG8_BAR __builtin_amdgcn_s_barrier()
#define PG8_SCHED __builtin_amdgcn_sched_barrier(0)
    [[maybe_unused]] int scl = 0x7b7c797f; asm volatile("" : "+v"(scl));
    Unit cur, nxt; int ui = 0;
    if (!S.next(0, cur)) return;
    f32x4 acc[2][2][4][2];
#pragma unroll
    for (int a = 0; a < 2; ++a)
#pragma unroll
        for (int b = 0; b < 2; ++b)
#pragma unroll
            for (int m = 0; m < 4; ++m)
#pragma unroll
                for (int n = 0; n < 2; ++n) acc[a][b][m][n] = (f32x4){0.f, 0.f, 0.f, 0.f};
    bf16x8 At[4][2], B0[2][2], B1[2][2];
    const char* cA = GATHER ? (const char*)g.A : (const char*)g.A + (size_t)cur.pm * tstep; const char* cB = (const char*)g.Bt + (size_t)cur.pn * tstep;
#pragma unroll
    for (int h = 0; h < 2; ++h)
#pragma unroll
        for (int i = 0; i < 2; ++i) { if constexpr (GATHER) vAc[h][i] = S.a_row_off(cur, h * HALF + rA[i]) + (unsigned)cA2[i]; else vAc[h][i] = (unsigned)((h * HALF + rA[i]) * K) * 2u + (unsigned)cA2[i]; vAn[h][i] = vAc[h][i]; }
    S.a_ready(cur);
    if constexpr (SP2) {
        PG8_STAGE(PG8_SB(0, 0), cB, voffB); PG8_STAGE(PG8_SB(0, 1), cB + hstep, voffB); PG8_STAGE(PG8_SA(0, 0), cA, vAc[0]); PG8_STAGE(PG8_SA(0, 1), cA, vAc[1]);
        if (wr == 1) PG8_BAR;
        PG8_WAIT_V(2); PG8_BAR;
        PG8_STAGE(PG8_SB(1, 0), cB + kstep, voffB); PG8_STAGE(PG8_SA(1, 0), cA + kstep, vAc[0]); PG8_STAGE(PG8_SB(1, 1), cB + hstep + kstep, voffB);
        PG8_WAIT_V(6); PG8_BAR;
    }
    for (;;) {
        const bool has_next = S.next(ui + 1, nxt);
        const char* nA = GATHER ? cA : (has_next ? (const char*)g.A + (size_t)nxt.pm * tstep : cA); const char* nB = has_next ? (const char*)g.Bt + (size_t)nxt.pn * tstep : cB;
        if constexpr (GATHER) { if (has_next) {
#pragma unroll
            for (int h = 0; h < 2; ++h)
#pragma unroll
                for (int i = 0; i < 2; ++i) vAn[h][i] = S.a_row_off(nxt, h * HALF + rA[i]) + (unsigned)cA2[i]; } }
#pragma unroll 1
        for (int t = 0; t < nt; t += 2) {
            const bool last = (t == nt - 2);
            asm volatile("" : "+v"(voffB[0]), "+v"(voffB[1]), "+v"(vAc[0][0]), "+v"(vAc[0][1]), "+v"(vAc[1][0]), "+v"(vAc[1][1]));
            const char* a1 = cA + (size_t)(t + 1) * kstep;
            const char* a2 = last ? nA : cA + (size_t)(t + 2) * kstep; const char* b2 = last ? nB : cB + (size_t)(t + 2) * kstep;
            const char* a3 = a2 + kstep; const char* b3 = b2 + kstep;
            unsigned vA2[2][2];
#pragma unroll
            for (int h = 0; h < 2; ++h)
#pragma unroll
                for (int i = 0; i < 2; ++i) vA2[h][i] = vAc[h][i];
            if constexpr (GATHER) { if (last) {
                asm volatile("" : "+v"(vAn[0][0]), "+v"(vAn[0][1]), "+v"(vAn[1][0]), "+v"(vAn[1][1]));
#pragma unroll
                for (int h = 0; h < 2; ++h)
#pragma unroll
                    for (int i = 0; i < 2; ++i) vA2[h][i] = vAn[h][i]; } }
            if (last && has_next) S.a_ready(nxt);
            if constexpr (SP2) {
            const int lenient = __builtin_amdgcn_readfirstlane((ui > 0 && t == 0) ? 1 : 0);
#define PG8_WAIT_V8L() asm volatile("s_cmp_eq_u32 %0, 0\n\ts_cbranch_scc0 .Lpg8skip%=\n\ts_waitcnt vmcnt(8)\n.Lpg8skip%=:\n\ts_waitcnt vmcnt(%1)" :: "s"(lenient), "i"(8 + Epi::NSTORE) : "memory", "scc")
            PG8_LDB(B0, 0, 0); PG8_LDB(B1, 0, 1); PG8_SCHED; PG8_LDA(At, 0, 0); PG8_STAGE(PG8_SA(1, 1), a1, vAc[1]);
            PG8_WAIT_V8L(); PG8_WAIT_L(0); PG8_BAR; PG8_MMA(0, 0, At, B0); PG8_MMA(0, 1, At, B1); PG8_BAR; PG8_SCHED;
            PG8_LDA(At, 0, 1); PG8_STAGE(PG8_SB(0, 0), b2, voffB); PG8_STAGE(PG8_SB(0, 1), b2 + hstep, voffB); PG8_STAGE(PG8_SA(0, 0), a2, vA2[0]);
            PG8_WAIT_V8L(); PG8_WAIT_L(0); PG8_BAR; PG8_MMA(1, 0, At, B0); PG8_MMA(1, 1, At, B1); PG8_BAR; PG8_SCHED;
            PG8_LDB(B0, 1, 0); PG8_LDB(B1, 1, 1); PG8_SCHED; PG8_LDA(At, 1, 0); PG8_STAGE(PG8_SA(0, 1), a2, vA2[1]);
            PG8_WAIT_V(8); PG8_WAIT_L(0); PG8_BAR; PG8_MMA(0, 0, At, B0); PG8_MMA(0, 1, At, B1); PG8_BAR; PG8_SCHED;
            PG8_LDA(At, 1, 1); PG8_STAGE(PG8_SB(1, 0), b3, voffB); PG8_STAGE(PG8_SB(1, 1), b3 + hstep, voffB); PG8_STAGE(PG8_SA(1, 0), a3, vA2[0]);
            PG8_WAIT_V(8); PG8_WAIT_L(0); PG8_BAR; PG8_MMA(1, 0, At, B0); PG8_MMA(1, 1, At, B1); PG8_BAR; PG8_SCHED;
#undef PG8_WAIT_V8L
            }
        }
        if constexpr (ALIGN_EPI) { if (wr == 0) PG8_BAR; }
        if constexpr (!Epi::AFTER_DRAIN) { E(acc, cur, wr, wc, fr, fq); S.done(cur); }
        if (!has_next) break;
#pragma unroll
        for (int a = 0; a < 2; ++a)
#pragma unroll
            for (int b = 0; b < 2; ++b)
#pragma unroll
                for (int m = 0; m < 4; ++m)
#pragma unroll
                    for (int n = 0; n < 2; ++n) acc[a][b][m][n] = (f32x4){0.f, 0.f, 0.f, 0.f};
        cur = nxt; cA = nA; cB = nB; ++ui;
        if constexpr (GATHER) {
#pragma unroll
            for (int h = 0; h < 2; ++h)
#pragma unroll
                for (int i = 0; i < 2; ++i) vAc[h][i] = vAn[h][i]; }
        if constexpr (ALIGN_EPI) { if (wr == 1) PG8_BAR; }
    }
    PG8_WAIT_V(0);
    if constexpr (!ALIGN_EPI) { if (wr == 0) PG8_BAR; }
    PG8_BAR;
    if constexpr (Epi::AFTER_DRAIN) { E.fused(acc, cur, wr, wc, fr, fq, lds, wid, lane); S.done(cur); }
#undef PG8_SA
#undef PG8_SB
#undef PG8_STAGE
#undef PG8_LDA
#undef PG8_LDB
#undef PG8_MMA
#undef PG8_CAT8
#undef PG8_WAIT_V
#undef PG8_WAIT_VN
#undef PG8_WAIT_L
#undef PG8_BAR
#undef PG8_SCHED
}
}
#define GAS __attribute__((address_space(1)))
#define LAS __attribute__((address_space(3)))
typedef unsigned short bf16;
typedef unsigned v4u __attribute__((ext_vector_type(4)));
typedef float f32x4 __attribute__((ext_vector_type(4)));
typedef short bf16x8 __attribute__((ext_vector_type(8)));
typedef GAS unsigned gu32;
typedef GAS unsigned long long gu64;
#define RLX_AGENT __ATOMIC_RELAXED, __HIP_MEMORY_SCOPE_AGENT
#define LDS_WAIT() asm volatile("s_waitcnt lgkmcnt(0)" ::: "memory")
#define VM_WAIT() asm volatile("s_waitcnt vmcnt(0)" ::: "memory")
__device__ __forceinline__ unsigned long long rt() { return __builtin_amdgcn_s_memrealtime(); }
__device__ __forceinline__ unsigned f2bf(float f) { unsigned u = __builtin_bit_cast(unsigned, f); return (u + 0x7fffu + ((u >> 16) & 1u)) >> 16; }
__device__ __forceinline__ unsigned pk2(float lo, float hi) { return f2bf(lo) | (f2bf(hi) << 16); }

#define XB_TMO      128
#define XB_XCNT(j)  (256  + 64 * (j))
#define XB_XSUB(j)  (1280 + 64 * (j))
#define XB_XGEN(j)  (2304 + 64 * (j))
#define XB_TOP      3328
#define XB_TOPGEN   3392
#define XCD_BAR_WORDS 3456
#define XB_SPIN_CAP (1u << 18)

__device__ __forceinline__ unsigned xb_ld(unsigned* p)              { return __hip_atomic_load(p, __ATOMIC_RELAXED, __HIP_MEMORY_SCOPE_AGENT); }
__device__ __forceinline__ unsigned xb_add(unsigned* p, unsigned v) { return __hip_atomic_fetch_add(p, v, __ATOMIC_RELAXED, __HIP_MEMORY_SCOPE_AGENT); }
__device__ __forceinline__ unsigned xb_xcc_id() { return (unsigned)__builtin_amdgcn_s_getreg((3 << 11) | 20) & 0xFu; }
#define XB_SPIN(cond, bar) do { unsigned _sp = 0; while (cond) { __builtin_amdgcn_s_sleep(1); \
    if ((++_sp & 255u) == 0u) { if (xb_ld(&(bar)[XB_TMO])) break; if (_sp > XB_SPIN_CAP) { atomicAdd(&(bar)[XB_TMO], 1u); break; } } } } while (0)

struct XcdBarrier {
    unsigned* bar; unsigned x; int wv;
    volatile LAS unsigned* st;
};

__device__ __forceinline__ XcdBarrier xcd_barrier_post(unsigned* bar, volatile LAS unsigned* st) {
    XcdBarrier b; b.bar = bar; b.x = xb_xcc_id(); b.st = st; b.wv = 0;
    if (threadIdx.x == 0) (void)xb_add(&bar[XB_XCNT(b.x)], 1u);
    return b;
}
__device__ __forceinline__ void xcd_barrier_complete(unsigned* bar, unsigned x, unsigned& nloc, unsigned& nx) {
    const unsigned G = gridDim.x * gridDim.y * gridDim.z;
    unsigned sum, cnt, mine, sp = 0u;
    for (;;) {
        sum = 0u; cnt = 0u; mine = 0u;
#pragma unroll
        for (unsigned j = 0; j < 16; ++j) { const unsigned c = xb_ld(&bar[XB_XCNT(j)]); sum += c; cnt += (c > 0u) ? 1u : 0u; mine = (j == x) ? c : mine; }
        if (sum == G) break;
        __builtin_amdgcn_s_sleep(1);
        if ((++sp & 255u) == 0u) { if (xb_ld(&bar[XB_TMO])) break; if (sp > XB_SPIN_CAP) { atomicAdd(&bar[XB_TMO], 1u); break; } }
    }
    nloc = mine > 0u ? mine : 1u; nx = cnt > 0u ? cnt : 1u;
}

__device__ __forceinline__ void xcd_barrier(const XcdBarrier& b) {
    asm volatile("s_waitcnt vmcnt(0)" ::: "memory");
    __syncthreads();
    if (b.wv == 0 && (int)__builtin_amdgcn_mbcnt_hi(~0u, __builtin_amdgcn_mbcnt_lo(~0u, 0u)) == 0) {
        unsigned* bar = b.bar;
        __builtin_amdgcn_s_waitcnt(0);
        unsigned nloc = b.st[0], nx = b.st[1];
        if (nloc == 0u) { xcd_barrier_complete(bar, b.x, nloc, nx); b.st[0] = nloc; b.st[1] = nx; }
        const unsigned old = xb_add(&bar[XB_XSUB(b.x)], 1u);
        const unsigned gen = old / nloc;
        if (old + 1u == (gen + 1u) * nloc) {
            __builtin_amdgcn_fence(__ATOMIC_RELEASE, "agent");
            asm volatile("s_waitcnt vmcnt(0)" ::: "memory");
            const unsigned og = xb_add(&bar[XB_TOP], 1u);
            const unsigned tg = og / nx;
            if (og + 1u == (tg + 1u) * nx) xb_add(&bar[XB_TOPGEN], 1u);
            else XB_SPIN(xb_ld(&bar[XB_TOPGEN]) == tg, bar);
            __builtin_amdgcn_fence(__ATOMIC_ACQUIRE, "agent");
            xb_add(&bar[XB_XGEN(b.x)], 1u);
            asm volatile("s_waitcnt vmcnt(0)" ::: "memory");
        } else {
            XB_SPIN(xb_ld(&bar[XB_XGEN(b.x)]) == gen, bar);
            __builtin_amdgcn_fence(__ATOMIC_ACQUIRE, "agent");
            asm volatile("s_waitcnt vmcnt(0)" ::: "memory");
        }
    }
    __syncthreads();
}


constexpr int NWAVES = 8;
constexpr int RING_BYTES = 131072;
constexpr int LDSCTL_OFF = RING_BYTES, MISC_OFF = LDSCTL_OFF + 320;
constexpr int LDS_TS_OFF = LDSCTL_OFF + 1024;
constexpr int LDS_TE_OFF = LDSCTL_OFF + 2048;
constexpr int LDS_CNT_OFF = LDSCTL_OFF + 1024 + 128;
constexpr int LDS_BYTES = 163840;

typedef short s16x4 __attribute__((ext_vector_type(4)));
typedef unsigned u32x2 __attribute__((ext_vector_type(2)));

struct Args { const float* in[20]; float* out; unsigned char* ws; unsigned mask; int bar_region; };

__device__ __forceinline__ float bflo(unsigned w) { return __uint_as_float(w << 16); }
__device__ __forceinline__ float bfhi(unsigned w) { return __uint_as_float(w & 0xffff0000u); }
__device__ __forceinline__ unsigned cvtpk(float lo, float hi) { return pg8::cvt_pk_bf16(lo, hi); }
__device__ __forceinline__ float wave_sum(float v) {
#pragma unroll
    for (int o = 1; o < 64; o <<= 1) v += __shfl_xor(v, o);
    return v;
}
__device__ __forceinline__ unsigned offb(unsigned row, unsigned ch) { return 256u * row + 16u * (ch ^ (((row & 3u) << 2) | ((row >> 2) & 3u))); }
__device__ __forceinline__ s16x4 ldtr(const LAS unsigned char* p) { return __builtin_amdgcn_ds_read_tr16_b64_v4i16((LAS s16x4*)p); }
__device__ __forceinline__ bf16x8 cat8(s16x4 a, s16x4 b) { return (bf16x8){a[0], a[1], a[2], a[3], b[0], b[1], b[2], b[3]}; }
#define MFMA16(a, b, c) __builtin_amdgcn_mfma_f32_16x16x32_bf16((a), (b), (c), 0, 0, 0)

template <int MODE> __device__ __forceinline__ int dest_row(int n) {
    if (MODE == 1) { if (n >= 1024) return n; const int hb = n & ~127, d = n & 127, jr = d & 63, half = d >> 6; return hb + 8 * (jr >> 2) + 4 * half + (jr & 3); }
    if (MODE == 2) return ((n >> 2) << 3) + (n & 3);
    if (MODE == 3) return ((n >> 2) << 3) + 4 + (n & 3);
    return n;
}
template <int MODE> __device__ __forceinline__ void p0_transpose_item(const float* W, int K, int N, bf16* WT, LAS float* scr, int item, int lane) {
    const int nblk = N / 32, kb = item / nblk, nb = item % nblk, k0 = 64 * kb, n0 = 32 * nb;
    {
        const GAS f32x4* src = (const GAS f32x4*)(W + (size_t)(k0 + (lane >> 3)) * N + n0) + (lane & 7);
        f32x4 t[8];
#pragma unroll
        for (int j = 0; j < 8; ++j) t[j] = src[(size_t)j * 2 * N];
#pragma unroll
        for (int j = 0; j < 8; ++j) { LAS float* d = scr + ((lane >> 3) + 8 * j) * 33 + 4 * (lane & 7); d[0] = t[j].x; d[1] = t[j].y; d[2] = t[j].z; d[3] = t[j].w; }
    }
    LDS_WAIT(); asm volatile("" ::: "memory");
    const int c = lane & 7;
#pragma unroll
    for (int j = 0; j < 4; ++j) { const int n = (lane >> 3) + 8 * j; const LAS float* s = scr + (8 * c) * 33 + n;
        v4u o; o.x = pk2(s[0 * 33], s[1 * 33]); o.y = pk2(s[2 * 33], s[3 * 33]); o.z = pk2(s[4 * 33], s[5 * 33]); o.w = pk2(s[6 * 33], s[7 * 33]);
        *(GAS v4u*)(WT + (size_t)dest_row<MODE>(n0 + n) * K + k0 + 8 * c) = o; }
    LDS_WAIT(); asm volatile("" ::: "memory");
}
__device__ __forceinline__ unsigned pk_fp8x4(float a, float b, float c, float d) {
    a = fminf(fmaxf(a, -448.f), 448.f); b = fminf(fmaxf(b, -448.f), 448.f); c = fminf(fmaxf(c, -448.f), 448.f); d = fminf(fmaxf(d, -448.f), 448.f);
    unsigned w = 0u; w = __builtin_amdgcn_cvt_pk_fp8_f32(a, b, w, false); w = __builtin_amdgcn_cvt_pk_fp8_f32(c, d, w, true); return w;
}
template <int MODE> __device__ __forceinline__ void p0_transpose_item_fp8(const float* W, int K, int N, unsigned char* WT, LAS float* scr, int item, int lane, float scale) {
    const int nblk = N / 32, kb = item / nblk, nb = item % nblk, k0 = 64 * kb, n0 = 32 * nb;
    {
        const GAS f32x4* src = (const GAS f32x4*)(W + (size_t)(k0 + (lane >> 3)) * N + n0) + (lane & 7);
        f32x4 t[8];
#pragma unroll
        for (int j = 0; j < 8; ++j) t[j] = src[(size_t)j * 2 * N];
#pragma unroll
        for (int j = 0; j < 8; ++j) { LAS float* d = scr + ((lane >> 3) + 8 * j) * 33 + 4 * (lane & 7); d[0] = t[j].x; d[1] = t[j].y; d[2] = t[j].z; d[3] = t[j].w; }
    }
    LDS_WAIT(); asm volatile("" ::: "memory");
    const int c = lane & 7;
#pragma unroll
    for (int j = 0; j < 4; ++j) { const int n = (lane >> 3) + 8 * j; const LAS float* s = scr + (8 * c) * 33 + n;
        u32x2 o; o.x = pk_fp8x4(s[0 * 33] * scale, s[1 * 33] * scale, s[2 * 33] * scale, s[3 * 33] * scale); o.y = pk_fp8x4(s[4 * 33] * scale, s[5 * 33] * scale, s[6 * 33] * scale, s[7 * 33] * scale);
        *(GAS u32x2*)(WT + (size_t)dest_row<MODE>(n0 + n) * K + k0 + 8 * c) = o; }
    LDS_WAIT(); asm volatile("" ::: "memory");
}
__device__ __forceinline__ int t5_bucket(int rel) {
    const int n = rel < 0 ? -rel : rel;
    int large = 8 + (n >= 15) + (n >= 27) + (n >= 50) + (n >= 91) + (n >= 166) + (n >= 305) + (n >= 559);
    large = large < 15 ? large : 15;
    return (rel > 0 ? 16 : 0) + (n < 8 ? n : large);
}
__device__ __forceinline__ void p0_prologue(const Args& a, LAS unsigned char* lds, int vcu, int G, int tid, int wave, int lane) {
    unsigned char* ws = a.ws;
    LAS float* scr = (LAS float*)(lds + wave * 16384);
    const int gw = vcu * NWAVES + wave, NGW = G * NWAVES;
    constexpr int I_IN = 16 * 208, I_R = 16 * 32, I_A = 8 * 32, I_O = 16 * 32;
    constexpr int NITEMS = I_IN + I_R + I_A + I_O;
    for (int it = gw; it < NITEMS; it += NGW) {
        int r = it;
#if P1_FP8
        if (r < I_IN) { if (r % 208 < 144 && r % 208 >= 8 * P1_FP8_FROM) p0_transpose_item_fp8<1>(a.in[1], 1024, 6656, ws + WS_WIN8, scr, r, lane, 64.f);
                        else p0_transpose_item<1>(a.in[1], 1024, 6656, (bf16*)(ws + WS_WIN), scr, r, lane); continue; } r -= I_IN;
#else
        if (r < I_IN) { p0_transpose_item<1>(a.in[1], 1024, 6656, (bf16*)(ws + WS_WIN), scr, r, lane); continue; } r -= I_IN;
#endif
        if (r < I_R) { if (MIX_FP8 & 4) p0_transpose_item_fp8<0>(a.in[5], 1024, 1024, ws + WS_WR, scr, r, lane, 64.f); else p0_transpose_item<0>(a.in[5], 1024, 1024, (bf16*)(ws + WS_WR), scr, r, lane); continue; } r -= I_R;
        if (r < I_A) { if (MIX_FP8 & 2) p0_transpose_item_fp8<0>(a.in[7], 512, 1024, ws + WS_WA, scr, r, lane, 64.f); else p0_transpose_item<0>(a.in[7], 512, 1024, (bf16*)(ws + WS_WA), scr, r, lane); continue; } r -= I_A;
        if (MIX_FP8 & 1) p0_transpose_item_fp8<0>(a.in[8], 1024, 1024, ws + WS_WO, scr, r, lane, 64.f); else p0_transpose_item<0>(a.in[8], 1024, 1024, (bf16*)(ws + WS_WO), scr, r, lane);
    }
    {
        const f32x4* x4 = (const f32x4*)a.in[0]; u32x2* xb = (u32x2*)(ws + WS_XB);
#if P1_FP8
        unsigned* xf8 = (unsigned*)a.out;
        for (size_t i = (size_t)vcu * 512 + tid; i < (size_t)TT * DM / 4; i += (size_t)G * 512) { const f32x4 v = x4[i]; u32x2 o; o.x = cvtpk(v.x, v.y); o.y = cvtpk(v.z, v.w); xb[i] = o; xf8[i] = pk_fp8x4(v.x, v.y, v.z, v.w); }
#else
        for (size_t i = (size_t)vcu * 512 + tid; i < (size_t)TT * DM / 4; i += (size_t)G * 512) { const f32x4 v = x4[i]; u32x2 o; o.x = cvtpk(v.x, v.y); o.y = cvtpk(v.z, v.w); xb[i] = o; }
#endif
    }
    {
        float* rot = (float*)(ws + WS_ROT);
        for (int idx = vcu * 512 + tid; idx < SEQ * 64; idx += G * 512) {
            const int pos = idx >> 6, jr = idx & 63;
            double iv = 1.0; for (int k = 0; k < jr; ++k) iv *= 0.86596432336006535;
            const float ang = (float)pos * (float)iv;
            const double xx = (double)ang; const double qd = __builtin_rint(xx * 0.63661977236758134); const int qi = (int)qd;
            const double r = (xx - qd * 1.5707963267948966) - qd * 6.123233995736766e-17, r2 = r * r;
            const double sp = r * (1.0 + r2 * (-1.0 / 6 + r2 * (1.0 / 120 + r2 * (-1.0 / 5040 + r2 * (1.0 / 362880 + r2 * (-1.0 / 39916800 + r2 * (1.0 / 6227020800.0)))))));
            const double cp = 1.0 + r2 * (-0.5 + r2 * (1.0 / 24 + r2 * (-1.0 / 720 + r2 * (1.0 / 40320 + r2 * (-1.0 / 3628800 + r2 * (1.0 / 479001600.0))))));
            const int qq = qi & 3; const double s = qq == 0 ? sp : (qq == 1 ? cp : (qq == 2 ? -sp : -cp)), c = qq == 0 ? cp : (qq == 1 ? -sp : (qq == 2 ? -cp : sp));
            float* o = rot + ((size_t)pos * 16 + (jr >> 2)) * 8 + (jr & 3); o[0] = (float)c; o[4] = (float)s;
        }
    }
    if (vcu == 0) {
        float* bt = (float*)(ws + WS_BIAS); const float* rb = a.in[6];
        for (int idx = tid; idx < 3 * 8 * 160; idx += 512) { const int p = idx / (8 * 160), h = (idx / 160) % 8, d = idx % 160 - 80; const int dil = p == 0 ? 1 : (p == 1 ? 4 : 16);
            bt[idx] = (d >= -64 && d <= 64) ? rb[t5_bucket(d * dil) * 8 + h] * 1.4426950408889634f : -1e30f; }
    }
}
__device__ __forceinline__ void p0_expert_weights(const Args& a, LAS unsigned char* lds, int vcu, int G, int wave, int lane) {
    unsigned char* ws = a.ws;
    LAS float* scr = (LAS float*)(lds + wave * 16384);
    const int gw = vcu * NWAVES + wave, NGW = G * NWAVES;
    constexpr int I_G = 16 * 16, I_D = 8 * 32, PER_E = 2 * I_G + I_D;
    for (int it = gw; it < 16 * PER_E; it += NGW) {
        const int e = it / PER_E; int r = it - e * PER_E;
#if M1_FP8
        if (r < I_G) { p0_transpose_item_fp8<2>(a.in[15] + (size_t)e * 1024 * 512, 1024, 512, ws + WS_WGU + (size_t)e * 1024 * 1024, scr, r, lane, 64.f); continue; } r -= I_G;
        if (r < I_G) { p0_transpose_item_fp8<3>(a.in[16] + (size_t)e * 1024 * 512, 1024, 512, ws + WS_WGU + (size_t)e * 1024 * 1024, scr, r, lane, 64.f); continue; } r -= I_G;
#else
        if (r < I_G) { p0_transpose_item<2>(a.in[15] + (size_t)e * 1024 * 512, 1024, 512, (bf16*)(ws + WS_WGU) + (size_t)e * 1024 * 1024, scr, r, lane); continue; } r -= I_G;
        if (r < I_G) { p0_transpose_item<3>(a.in[16] + (size_t)e * 1024 * 512, 1024, 512, (bf16*)(ws + WS_WGU) + (size_t)e * 1024 * 1024, scr, r, lane); continue; } r -= I_G;
#endif
        p0_transpose_item_fp8<0>(a.in[17] + (size_t)e * 512 * 1024, 512, 1024, ws + WS_WD + (size_t)e * 1024 * 512, scr, r, lane, 64.f);
    }
    __syncthreads();
}

__device__ __forceinline__ float log2_gamma(const float* dec, int h) {
    const float x = dec[h]; return -__log2f(1.f + __expf(-x));
}
__device__ __forceinline__ void chain_item(const Args& a, LAS unsigned char* lds, int item, int tid, int wid, int lane) {
    unsigned char* ws = a.ws;
    const int b = item >> 4, h = (item >> 2) & 3, dir = (item >> 1) & 1, vh = item & 1;
    const float lg2 = log2_gamma(dir ? a.in[3] : a.in[2], h);
    const float cd = __builtin_amdgcn_exp2f(lg2 * 128.f);
    const int g = lane >> 4, i16 = lane & 15, q = i16 >> 2, p = lane & 3;
    const int wd = wid >> 1, wv = wid & 1;
    const GAS bf16* kr = (const GAS bf16*)(ws + WS_KR); const GAS bf16* vr = (const GAS bf16*)(ws + WS_VR);
    GAS bf16* states = (GAS bf16*)a.out;
    f32x4 acc[2][4];
#pragma unroll
    for (int i = 0; i < 2; ++i)
#pragma unroll
        for (int j = 0; j < 4; ++j) acc[i][j] = (f32x4){0.f, 0.f, 0.f, 0.f};
    const int srow = tid >> 4, sch = tid & 15; const unsigned soff = offb(srow, sch);
    const GAS bf16* kp = kr + ((size_t)b * SEQ + srow) * 512 + h * 128 + sch * 8;
    const GAS bf16* vp = vr + ((size_t)b * SEQ + srow) * 1024 + h * 256 + vh * 128 + sch * 8;
    v4u kq[4], vq[4];
    { const int n0 = dir ? 15 : 0;
#pragma unroll
      for (int j = 0; j < 4; ++j) { kq[j] = *(const GAS v4u*)(kp + (size_t)(n0 * 128 + 32 * j) * 512); vq[j] = *(const GAS v4u*)(vp + (size_t)(n0 * 128 + 32 * j) * 1024); } }
    unsigned abase[2][2], bbase[4][2];
#pragma unroll
    for (int t = 0; t < 2; ++t) { const unsigned r = 8 * g + 4 * t + q;
#pragma unroll
        for (int dt = 0; dt < 2; ++dt) abase[dt][t] = offb(r, 2 * (2 * wd + dt) + (p >> 1)) + 8 * (p & 1);
#pragma unroll
        for (int vt = 0; vt < 4; ++vt) bbase[vt][t] = offb(r, 2 * (4 * wv + vt) + (p >> 1)) + 8 * (p & 1); }
#define CH_STAGE(BUFOFF) do { _Pragma("unroll") for (int j = 0; j < 4; ++j) { \
            const int row = srow + 32 * j; const float z = __builtin_amdgcn_exp2f(lg2 * (float)(dir ? row : 127 - row)); const v4u kv = kq[j]; \
            v4u ko; ko.x = cvtpk(bflo(kv.x) * z, bfhi(kv.x) * z); ko.y = cvtpk(bflo(kv.y) * z, bfhi(kv.y) * z); ko.z = cvtpk(bflo(kv.z) * z, bfhi(kv.z) * z); ko.w = cvtpk(bflo(kv.w) * z, bfhi(kv.w) * z); \
            *(LAS v4u*)(lds + (BUFOFF) + soff + j * 8192) = ko; *(LAS v4u*)(lds + (BUFOFF) + 32768 + soff + j * 8192) = vq[j]; } } while (0)
#define CH_FETCH(NN) do { _Pragma("unroll") for (int j = 0; j < 4; ++j) { kq[j] = *(const GAS v4u*)(kp + (size_t)((NN) * 128 + 32 * j) * 512); vq[j] = *(const GAS v4u*)(vp + (size_t)((NN) * 128 + 32 * j) * 1024); } } while (0)
#define CH_STEP(STEP, CUR, OTH) do { const int step_ = (STEP); const int n_ = dir ? 15 - step_ : step_; \
        GAS bf16* sb_ = states + ((((size_t)(b * 4 + h) * 16 + n_) * 2 + dir) * 256) * 128; \
        _Pragma("unroll") for (int dt = 0; dt < 2; ++dt) _Pragma("unroll") for (int vt = 0; vt < 4; ++vt) { \
            const int v_ = vh * 128 + 64 * wv + 16 * vt + i16, d0_ = 32 * wd + 16 * dt + 4 * g; \
            u32x2 w_; w_.x = pg8::cvt_pk_bf16_acc(acc[dt][vt][0], acc[dt][vt][1]); w_.y = pg8::cvt_pk_bf16_acc(acc[dt][vt][2], acc[dt][vt][3]);   \
            *(GAS u32x2*)(sb_ + (size_t)v_ * 128 + d0_) = w_; } \
        if (step_ < 15) CH_STAGE(OTH); \
        if (step_ < 14) CH_FETCH(dir ? 13 - step_ : step_ + 2); \
        _Pragma("unroll") for (int i = 0; i < 2; ++i) _Pragma("unroll") for (int j = 0; j < 4; ++j) acc[i][j] = acc[i][j] * cd; \
        _Pragma("unroll") for (int ks = 0; ks < 4; ++ks) { bf16x8 af[2], bfr[4]; \
            _Pragma("unroll") for (int dt = 0; dt < 2; ++dt) af[dt] = cat8(ldtr(lds + (CUR) + abase[dt][0] + ks * 8192), ldtr(lds + (CUR) + abase[dt][1] + ks * 8192)); \
            _Pragma("unroll") for (int vt = 0; vt < 4; ++vt) bfr[vt] = cat8(ldtr(lds + (CUR) + 32768 + bbase[vt][0] + ks * 8192), ldtr(lds + (CUR) + 32768 + bbase[vt][1] + ks * 8192)); \
            _Pragma("unroll") for (int dt = 0; dt < 2; ++dt) _Pragma("unroll") for (int vt = 0; vt < 4; ++vt) acc[dt][vt] = MFMA16(af[dt], bfr[vt], acc[dt][vt]); } \
        __syncthreads(); } while (0)
    CH_STAGE(0);
    CH_FETCH(dir ? 14 : 1);
    __syncthreads();
    for (int sp = 0; sp < 8; ++sp) { CH_STEP(2 * sp, 0, 65536); CH_STEP(2 * sp + 1, 65536, 0); }
#undef CH_STEP
#undef CH_STAGE
#undef CH_FETCH
}

constexpr int AT_OST = 135168, AT_SCR = AT_OST + 8 * 2048;
constexpr int ATB_N = 160;
struct AttnLane { unsigned kb[2]; unsigned vb[4]; };
__device__ __forceinline__ AttnLane attn_lane(int lane) {
    const int g = lane >> 4, i16 = lane & 15, q4 = i16 >> 2, p = lane & 3; AttnLane L;
#pragma unroll
    for (int s = 0; s < 2; ++s) L.kb[s] = i16 * 128 + (((4 * s + g) ^ ((i16 >> 1) & 7)) * 16);
    const int sw = (2 * g + (q4 >> 1)) & 3;
#pragma unroll
    for (int c = 0; c < 4; ++c) L.vb[c] = (4 * g + q4) * 128 + ((c ^ sw) * 32) + p * 8;
    return L;
}
__device__ __forceinline__ unsigned kimg_off(int row, int c) { return row * 128 + ((c ^ ((row >> 1) & 7)) * 16); }
__device__ __forceinline__ unsigned vimg_off(int row, int c) { return row * 128 + (((c >> 1) ^ ((row >> 1) & 3)) * 32) + (c & 1) * 16; }
__device__ __forceinline__ void attn_core(const LAS unsigned char* Kimg, const LAS unsigned char* Vimg, int R0, int nrows, unsigned tvalid, const bf16x8 (&qf)[2],
                                          const float (&biasr)[36], const AttnLane& L, f32x4 (&O)[4], float& mx, float& lsum) {
    f32x4 D[9];
#pragma unroll
    for (int kt = 0; kt < 9; ++kt) {
        int R = R0 + 16 * kt; R = R < 0 ? 0 : (R > nrows - 16 ? nrows - 16 : R);
        const LAS unsigned char* kp = Kimg + R * 128;
        const bf16x8 k0 = *(const LAS bf16x8*)(kp + L.kb[0]), k1 = *(const LAS bf16x8*)(kp + L.kb[1]);
        f32x4 d = (f32x4){0.f, 0.f, 0.f, 0.f};
        d = MFMA16(k0, qf[0], d); d = MFMA16(k1, qf[1], d); D[kt] = d;
    }
    mx = -1e30f;
#pragma unroll
    for (int kt = 0; kt < 9; ++kt) {
        const float tb = ((tvalid >> kt) & 1u) ? 0.f : -1e30f;
#pragma unroll
        for (int r = 0; r < 4; ++r) { const float x = D[kt][r] + (biasr[4 * kt + r] + tb); D[kt][r] = x; mx = fmaxf(mx, x); }
    }
    mx = fmaxf(mx, __shfl_xor(mx, 16)); mx = fmaxf(mx, __shfl_xor(mx, 32));
    lsum = 0.f;
#pragma unroll
    for (int kt = 0; kt < 9; ++kt)
#pragma unroll
        for (int r = 0; r < 4; ++r) { const float e = __builtin_amdgcn_exp2f(D[kt][r] - mx); D[kt][r] = e; lsum += e; }
    lsum += __shfl_xor(lsum, 16); lsum += __shfl_xor(lsum, 32);
#pragma unroll
    for (int c = 0; c < 4; ++c) O[c] = (f32x4){0.f, 0.f, 0.f, 0.f};
#pragma unroll
    for (int kk = 0; kk < 5; ++kk) {
        int Ra = R0 + 32 * kk; Ra = Ra < 0 ? 0 : (Ra > nrows - 16 ? nrows - 16 : Ra);
        int Rb = R0 + 32 * kk + 16; Rb = Rb < 0 ? 0 : (Rb > nrows - 16 ? nrows - 16 : Rb);
        if (kk == 4) Rb = Ra;
        const f32x4 e0 = D[2 * kk], e1 = kk < 4 ? D[2 * kk + 1] : (f32x4){0.f, 0.f, 0.f, 0.f};
        v4u pw; pw.x = cvtpk(e0[0], e0[1]); pw.y = cvtpk(e0[2], e0[3]); pw.z = cvtpk(e1[0], e1[1]); pw.w = cvtpk(e1[2], e1[3]);
        const bf16x8 pf = __builtin_bit_cast(bf16x8, pw);
        const LAS unsigned char* va_ = Vimg + Ra * 128; const LAS unsigned char* vb_ = Vimg + Rb * 128;
#pragma unroll
        for (int c = 0; c < 4; ++c) O[c] = MFMA16(pf, cat8(ldtr(va_ + L.vb[c]), ldtr(vb_ + L.vb[c])), O[c]);
    }
}
__device__ __forceinline__ void attn_stage_out(LAS unsigned char* lds, int wid, int lane, const f32x4 (&O)[4], float lsum) {
    const int g = lane >> 4, i16 = lane & 15;
    const float linv = 1.f / lsum;
    LAS bf16* st = (LAS bf16*)(lds + AT_OST + wid * 2048);
#pragma unroll
    for (int r = 0; r < 4; ++r) { const float li = __shfl(linv, 4 * g + r);
#pragma unroll
        for (int c = 0; c < 4; ++c) st[(4 * g + r) * 64 + 16 * c + i16] = (bf16)(cvtpk(O[c][r] * li, 0.f) & 0xffffu); }
}
__device__ __forceinline__ void attn_load_bias(const Args& a, int pat, int h, int lane, float (&biasr)[36]) {
    const GAS float* bt = (const GAS float*)(a.ws + WS_BIAS) + (pat * 8 + h) * ATB_N; const int g = lane >> 4, i16 = lane & 15;
#pragma unroll
    for (int kt = 0; kt < 9; ++kt)
#pragma unroll
        for (int r = 0; r < 4; ++r) biasr[4 * kt + r] = bt[16 * kt + 4 * g + r - 64 - i16 + 80];
}
template <int DIL, int VAR = 0> __device__ __forceinline__ void attn_dil_phase(const Args& a, LAS unsigned char* lds, int vcu, int G, int tid, int wid, int lane) {
    unsigned char* ws = a.ws;
    constexpr int NR = SEQ / DIL, PAT = DIL == 4 ? 1 : 2, CH = NR * 8 / 512, NITEM = NB * 8 * DIL;
    constexpr int NBUF = DIL == 16 ? 2 : 1, BUFB = 2 * NR * 128;
    const GAS bf16* qa = (const GAS bf16*)(ws + WS_QA); const GAS bf16* ka = (const GAS bf16*)(ws + WS_KA); const GAS bf16* va = (const GAS bf16*)(ws + WS_VA);
    bf16* op = (bf16*)(ws + (DIL == 4 ? WS_O2 : WS_O3)); float* lsep = (float*)(ws + (DIL == 4 ? WS_LSE2 : WS_LSE3));
    if (vcu >= NITEM) return;
    const int h = vcu & 7;
    float biasr[36]; attn_load_bias(a, PAT, h, lane, biasr);
    const AttnLane L = attn_lane(lane);
    const int g = lane >> 4, i16 = lane & 15;
    v4u kq[CH], vq[CH]; bf16x8 qn[2];
    auto issue = [&](int item, int gi) {
        const int rho = (item >> 3) % DIL, b = item / (8 * DIL); const size_t rowb = (size_t)b * SEQ;
#pragma unroll
        for (int j = 0; j < CH; ++j) { const int id = tid + 512 * j, row = id >> 3, c = id & 7; const size_t go = (rowb + (size_t)row * DIL + rho) * 512 + h * 64 + c * 8;
            kq[j] = *(const GAS v4u*)(ka + go); vq[j] = *(const GAS v4u*)(va + go); }
        const size_t qpos = rowb + (size_t)(16 * gi + i16) * DIL + rho;
#pragma unroll
        for (int s = 0; s < 2; ++s) qn[s] = *(const GAS bf16x8*)(qa + qpos * 512 + h * 64 + 32 * s + 8 * g);
    };
    issue(vcu, wid);
    int buf = 0;
    for (int item = vcu; item < NITEM; item += G) {
        const int rho = (item >> 3) % DIL, b = item / (8 * DIL); const size_t rowb = (size_t)b * SEQ;
        LAS unsigned char* Kimg = lds + buf * BUFB; LAS unsigned char* Vimg = Kimg + NR * 128;
        if (NBUF == 1) __syncthreads();
#pragma unroll
        for (int j = 0; j < CH; ++j) { const int id = tid + 512 * j, row = id >> 3, c = id & 7;
            *(LAS v4u*)(Kimg + kimg_off(row, c)) = kq[j]; *(LAS v4u*)(Vimg + vimg_off(row, c)) = vq[j]; }
        bf16x8 qf[2] = {qn[0], qn[1]};
        __syncthreads();
        if (NBUF == 2 && item + G < NITEM) issue(item + G, wid);
        for (int gi = wid; gi < NR / 16; gi += 8) {
            const int m0 = 16 * gi;
            if (NBUF == 1 && gi + 8 < NR / 16) {
                const size_t qpos = rowb + (size_t)(m0 + 128 + i16) * DIL + rho;
#pragma unroll
                for (int s = 0; s < 2; ++s) qn[s] = *(const GAS bf16x8*)(qa + qpos * 512 + h * 64 + 32 * s + 8 * g); }
            unsigned tvalid = 0u;
#pragma unroll
            for (int kt = 0; kt < 9; ++kt) { const int t0 = m0 - 64 + 16 * kt; tvalid |= (t0 >= 0 && t0 < NR) ? (1u << kt) : 0u; }
            f32x4 O[4]; float mx, lsum;
            if (VAR == 1) { mx = 0.f; lsum = 1.f;
#pragma unroll
                for (int c = 0; c < 4; ++c) O[c] = (f32x4){__builtin_bit_cast(float, qf[0][0] + c), 0.f, 0.f, 0.f}; }
            else attn_core(Kimg, Vimg, m0 - 64, NR, tvalid, qf, biasr, L, O, mx, lsum);
            attn_stage_out(lds, wid, lane, O, lsum);
            if (g == 0) lsep[(rowb + (size_t)(m0 + i16) * DIL + rho) * 8 + h] = mx + __log2f(lsum);
            asm volatile("s_waitcnt lgkmcnt(0)" ::: "memory");
            { const int q = lane >> 2, qt = lane & 3; const LAS v4u* sp = (const LAS v4u*)(lds + AT_OST + wid * 2048 + q * 128 + qt * 32);
              const v4u x0 = sp[0], x1 = sp[1]; bf16* dst = op + (rowb + (size_t)(m0 + q) * DIL + rho) * 512 + h * 64 + qt * 16;
              *(v4u*)dst = x0; *(v4u*)(dst + 8) = x1; }
            asm volatile("s_waitcnt lgkmcnt(0)" ::: "memory");
            if (NBUF == 1) { qf[0] = qn[0]; qf[1] = qn[1]; }
        }
        if (NBUF == 1 && item + G < NITEM) issue(item + G, wid);
        buf ^= (NBUF - 1);
    }
    __syncthreads();
}
__device__ __forceinline__ void attn_p1_phase(const Args& a, LAS unsigned char* lds, int vcu, int G, int tid, int wid, int lane) {
    unsigned char* ws = a.ws;
    LAS unsigned char* Kimg = lds; LAS unsigned char* Vimg = lds + 384 * 128;
    const GAS bf16* qa = (const GAS bf16*)(ws + WS_QA); const GAS bf16* ka = (const GAS bf16*)(ws + WS_KA); const GAS bf16* va = (const GAS bf16*)(ws + WS_VA);
    const GAS bf16* o2 = (const GAS bf16*)(ws + WS_O2); const GAS bf16* o3 = (const GAS bf16*)(ws + WS_O3);
    const GAS float* lse2 = (const GAS float*)(ws + WS_LSE2); const GAS float* lse3 = (const GAS float*)(ws + WS_LSE3);
    bf16* oa = (bf16*)(ws + WS_OA);
    if (vcu >= 1024) return;
    const int h = vcu & 7;
    float biasr[36]; attn_load_bias(a, 0, h, lane, biasr);
    const AttnLane L = attn_lane(lane);
    const int g = lane >> 4, i16 = lane & 15;
    LAS float* scr = (LAS float*)(lds + AT_SCR) + wid * 16;
    v4u kq[6], vq[6];
    auto issue = [&](int item) { const int b = item >> 6, s0 = ((item >> 3) & 7) * 256; const size_t rowb = (size_t)b * SEQ;
#pragma unroll
        for (int j = 0; j < 6; ++j) { const int id = tid + 512 * j, row = id >> 3, c = id & 7, pos = s0 - 64 + row; const bool ok = pos >= 0 && pos < SEQ;
            const size_t go = (rowb + (size_t)(ok ? pos : 0)) * 512 + h * 64 + c * 8;
            kq[j] = *(const GAS v4u*)(ka + go); vq[j] = *(const GAS v4u*)(va + go);
            if (!ok) { kq[j] = (v4u){0u, 0u, 0u, 0u}; vq[j] = (v4u){0u, 0u, 0u, 0u}; } } };
    issue(vcu);
    for (int item = vcu; item < 1024; item += G) {
        const int b = item >> 6, s0 = ((item >> 3) & 7) * 256; const size_t rowb = (size_t)b * SEQ;
        __syncthreads();
#pragma unroll
        for (int j = 0; j < 6; ++j) { const int id = tid + 512 * j, row = id >> 3, c = id & 7;
            *(LAS v4u*)(Kimg + kimg_off(row, c)) = kq[j]; *(LAS v4u*)(Vimg + vimg_off(row, c)) = vq[j]; }
        __syncthreads();
        if (item + G < 1024) issue(item + G);
        for (int gi = wid; gi < 16; gi += 8) {
            const int m0 = s0 + 16 * gi;
            const int q = lane >> 2, qt = lane & 3; const size_t tq = rowb + m0 + q;
            const v4u a20 = *(const GAS v4u*)(o2 + tq * 512 + h * 64 + qt * 16), a21 = *(const GAS v4u*)(o2 + tq * 512 + h * 64 + qt * 16 + 8);
            const v4u a30 = *(const GAS v4u*)(o3 + tq * 512 + h * 64 + qt * 16), a31 = *(const GAS v4u*)(o3 + tq * 512 + h * 64 + qt * 16 + 8);
            const float l2 = lse2[tq * 8 + h], l3 = lse3[tq * 8 + h];
            bf16x8 qf[2];
#pragma unroll
            for (int s = 0; s < 2; ++s) qf[s] = *(const GAS bf16x8*)(qa + (rowb + m0 + i16) * 512 + h * 64 + 32 * s + 8 * g);
            unsigned tvalid = 0u;
#pragma unroll
            for (int kt = 0; kt < 9; ++kt) { const int t0 = m0 - 64 + 16 * kt; tvalid |= (t0 >= 0 && t0 < SEQ) ? (1u << kt) : 0u; }
            f32x4 O[4]; float mx, lsum;
            attn_core(Kimg, Vimg, 16 * gi, 384, tvalid, qf, biasr, L, O, mx, lsum);
            attn_stage_out(lds, wid, lane, O, lsum);
            if (g == 0) scr[i16] = mx + __log2f(lsum);
            asm volatile("s_waitcnt lgkmcnt(0)" ::: "memory");
            {
                const float l1 = scr[q], M = fmaxf(l1, fmaxf(l2, l3));
                float w1 = __builtin_amdgcn_exp2f(l1 - M), w2 = __builtin_amdgcn_exp2f(l2 - M), w3 = __builtin_amdgcn_exp2f(l3 - M); const float wi = 1.f / (w1 + w2 + w3); w1 *= wi; w2 *= wi; w3 *= wi;
                const LAS v4u* sp = (const LAS v4u*)(lds + AT_OST + wid * 2048 + q * 128 + qt * 32);
                const v4u x0 = sp[0], x1 = sp[1];
                v4u r0, r1;
#define MRG(d, x, y, z) d = cvtpk(w1 * bflo(x) + w2 * bflo(y) + w3 * bflo(z), w1 * bfhi(x) + w2 * bfhi(y) + w3 * bfhi(z))
                MRG(r0.x, x0.x, a20.x, a30.x); MRG(r0.y, x0.y, a20.y, a30.y); MRG(r0.z, x0.z, a20.z, a30.z); MRG(r0.w, x0.w, a20.w, a30.w);
                MRG(r1.x, x1.x, a21.x, a31.x); MRG(r1.y, x1.y, a21.y, a31.y); MRG(r1.z, x1.z, a21.z, a31.z); MRG(r1.w, x1.w, a21.w, a31.w);
#undef MRG
#if MIX_FP8 & 2
                v4u o8;
                o8.x = pk_fp8x4(16.f * bflo(r0.x), 16.f * bfhi(r0.x), 16.f * bflo(r0.y), 16.f * bfhi(r0.y)); o8.y = pk_fp8x4(16.f * bflo(r0.z), 16.f * bfhi(r0.z), 16.f * bflo(r0.w), 16.f * bfhi(r0.w));
                o8.z = pk_fp8x4(16.f * bflo(r1.x), 16.f * bfhi(r1.x), 16.f * bflo(r1.y), 16.f * bfhi(r1.y)); o8.w = pk_fp8x4(16.f * bflo(r1.z), 16.f * bfhi(r1.z), 16.f * bflo(r1.w), 16.f * bfhi(r1.w));
                *(v4u*)((unsigned char*)oa + tq * 512 + h * 64 + qt * 16) = o8;
#else
                bf16* dst = oa + tq * 512 + h * 64 + qt * 16;
                *(v4u*)dst = r0; *(v4u*)(dst + 8) = r1;
#endif
            }
            asm volatile("s_waitcnt lgkmcnt(0)" ::: "memory");
        }
    }
    __syncthreads();
}

#define OPAQUE(x) asm volatile("" : "+v"(x))
template <int VAR = 0> __device__ __forceinline__ void p3_phase(const Args& a, LAS unsigned char* lds, int vcu, int G, int tid, int wid, int lane) {
    unsigned char* ws = a.ws;
    const int g = lane >> 4, i16 = lane & 15, q4 = i16 >> 2, p = lane & 3;
    const GAS bf16* qr = (const GAS bf16*)(ws + WS_QR); const GAS bf16* kr = (const GAS bf16*)(ws + WS_KR); const GAS bf16* vr = (const GAS bf16*)(ws + WS_VR);
    GAS bf16* gr = (GAS bf16*)(ws + WS_GR);
    LAS unsigned char* Kt = lds; LAS unsigned char* Sg = lds + 32768;
    if (vcu >= 1024) return;
    const unsigned kdst = offb(tid >> 4, tid & 15);
    unsigned rfo[4];
    { const unsigned X = ((i16 & 3) << 2) | (i16 >> 2);
#pragma unroll
      for (int s = 0; s < 4; ++s) rfo[s] = 256 * i16 + 16 * (((4 * s) ^ (X & 12)) | (g ^ (X & 3))); }
    v4u sreg[8], kreg[4]; bf16x8 qn[4];
    auto item_ptrs = [&](int item, size_t& tok0, const GAS bf16*& sf, int& h) { const int b = item >> 6; h = (item >> 4) & 3; const int n = item & 15; tok0 = (size_t)b * SEQ + n * 128;
        sf = (const GAS bf16*)a.out + ((((size_t)(b * 4 + h) * 16 + n) * 2 + 0) * 256) * 128; };
    auto issue_k = [&](int item) { size_t tok0; const GAS bf16* sf; int h; item_ptrs(item, tok0, sf, h);
        const GAS bf16* ks_ = kr + (tok0 + (tid >> 4)) * 512 + h * 128 + (tid & 15) * 8;
#pragma unroll
        for (int j = 0; j < 4; ++j) kreg[j] = *(const GAS v4u*)(ks_ + (size_t)j * 32 * 512); };
    auto issue_q = [&](int item) { size_t tok0; const GAS bf16* sf; int h; item_ptrs(item, tok0, sf, h);
#pragma unroll
        for (int s = 0; s < 4; ++s) qn[s] = *(const GAS bf16x8*)(qr + (tok0 + 16 * wid + i16) * 512 + h * 128 + 32 * s + 8 * g); };
    auto issue_state = [&](const GAS bf16* sf, int dirn) { const GAS bf16* sld = sf + (size_t)dirn * 256 * 128 + (size_t)(tid >> 4) * 128 + (tid & 15) * 8;
#pragma unroll
        for (int j = 0; j < 8; ++j) sreg[j] = *(const GAS v4u*)(sld + (size_t)j * 32 * 128); };
    auto write_state = [&]() {
#pragma unroll
        for (int j = 0; j < 8; ++j) *(LAS v4u*)(Sg + (j >> 2) * 32768 + kdst + (j & 3) * 8192) = sreg[j]; };
    { size_t tok0; const GAS bf16* sf; int h; item_ptrs(vcu, tok0, sf, h); issue_k(vcu); issue_q(vcu); issue_state(sf, 0); }
#pragma unroll
    for (int j = 0; j < 4; ++j) *(LAS v4u*)(Kt + kdst + j * 8192) = kreg[j];
    for (int item = vcu; item < 1024; item += G) {
        size_t tok0; const GAS bf16* sf; int h; item_ptrs(item, tok0, sf, h);
        const float lf2 = log2_gamma(a.in[2], h), lb2 = log2_gamma(a.in[3], h);
        bf16x8 qf[4];
#pragma unroll
        for (int s = 0; s < 4; ++s) qf[s] = qn[s];
        const bool has_next = item + G < 1024;
        __syncthreads();
        f32x4 D[8];
#pragma unroll
        for (int jt = 0; jt < 8; ++jt) {
            f32x4 d = (f32x4){0.f, 0.f, 0.f, 0.f};
#pragma unroll
            for (int s = 0; s < 4; ++s) { if (VAR != 1) { const bf16x8 kf = *(const LAS bf16x8*)(Kt + rfo[s] + jt * 4096); d = MFMA16(kf, qf[s], d); } else d[s] = __builtin_bit_cast(float, (int)qf[s][0]); }
            D[jt] = d;
        }
        int iq = 16 * wid + i16; OPAQUE(iq);
        bf16x8 pf[4];
#pragma unroll
        for (int ks = 0; ks < 4; ++ks) {
            float e[8];
#pragma unroll
            for (int t = 0; t < 2; ++t)
#pragma unroll
                for (int r = 0; r < 4; ++r) {
                    const int j = 16 * (2 * ks + t) + 4 * g + r; const float fdf = (float)(iq - j), ad = fabsf(fdf);
                    const float pos = fminf(fmaxf(fdf, 0.f), 1.f), isz = 1.f - fminf(ad, 1.f);
                    const float w = __builtin_amdgcn_exp2f((lb2 + (lf2 - lb2) * pos) * ad) + isz;
                    e[4 * t + r] = D[2 * ks + t][r] * w;
                }
            v4u pw; pw.x = cvtpk(e[0], e[1]); pw.y = cvtpk(e[2], e[3]); pw.z = cvtpk(e[4], e[5]); pw.w = cvtpk(e[6], e[7]);
            pf[ks] = __builtin_bit_cast(bf16x8, pw);
        }
        f32x4 acc[16];
#pragma unroll
        for (int vt = 0; vt < 16; ++vt) acc[vt] = (f32x4){0.f, 0.f, 0.f, 0.f};
#pragma unroll
        for (int dirn = 0; dirn < 2; ++dirn) {
            if (dirn == 1) __syncthreads();
            write_state();
            if (dirn == 0) { issue_state(sf, 1); if (has_next) issue_k(item + G); }
            else {
                if (has_next) {
#pragma unroll
                    for (int j = 0; j < 4; ++j) *(LAS v4u*)(Kt + kdst + j * 8192) = kreg[j]; }
                const GAS bf16* vs_ = vr + (tok0 + (tid >> 5)) * 1024 + h * 256 + (tid & 31) * 8;
#pragma unroll
                for (int j = 0; j < 8; ++j) sreg[j] = *(const GAS v4u*)(vs_ + (size_t)j * 16 * 1024);
            }
            __syncthreads();
#pragma unroll
            for (int vt = 0; vt < 16; ++vt) {
#pragma unroll
                for (int s = 0; s < 4; ++s) { if (VAR != 1) { const bf16x8 sfr = *(const LAS bf16x8*)(Sg + (vt >> 3) * 32768 + rfo[s] + (vt & 7) * 4096); acc[vt] = MFMA16(qf[s], sfr, acc[vt]); } }
            }
            float xs[4];
            { int ib = 16 * wid + 4 * g; OPAQUE(ib);
#pragma unroll
              for (int r = 0; r < 4; ++r) { const float lxf = lf2 * (float)(ib + r + 1), lxb = lb2 * (float)(128 - ib - r); xs[r] = __builtin_amdgcn_exp2f(dirn == 0 ? lxf - lxb : lxb); } }
#pragma unroll
            for (int vt = 0; vt < 16; ++vt)
#pragma unroll
                for (int r = 0; r < 4; ++r) acc[vt][r] *= xs[r];
        }
        __syncthreads();
        { int t2 = tid; OPAQUE(t2); const unsigned vd2 = (unsigned)((t2 & 31) >> 4) * 32768u + offb(t2 >> 5, t2 & 15);
#pragma unroll
          for (int j = 0; j < 8; ++j) *(LAS v4u*)(Sg + vd2 + j * 4096) = sreg[j]; }
        GAS bf16* gp = gr + (tok0 + 16 * wid + (lane >> 5)) * 1024 + h * 256 + (lane & 31) * 8;
#if MIX_FP8 & 4
        GAS unsigned char* ar8 = (GAS unsigned char*)(ws + WS_AR8) + (tok0 + 16 * wid + (lane >> 5)) * 1024 + h * 256 + (lane & 31) * 8;
#endif
        __syncthreads();
        unsigned vbs[8];
        { int l2 = lane; OPAQUE(l2); const unsigned g2 = l2 >> 4, q2 = (l2 & 15) >> 2, p2 = l2 & 3, X = (q2 << 2) | g2;
#pragma unroll
          for (int c = 0; c < 8; ++c) vbs[c] = 256 * (4 * g2 + q2) + 16 * (((2 * c) ^ (X & 14)) | ((p2 >> 1) ^ (X & 1))) + 8 * (p2 & 1); }
#pragma unroll
        for (int vt = 0; vt < 16; ++vt) {
#pragma unroll
            for (int ks = 0; ks < 4; ++ks) { if (VAR != 1) {
                const s16x4 lo = ldtr(Sg + vbs[vt & 7] + (vt >> 3) * 32768 + ks * 8192), hi = ldtr(Sg + vbs[vt & 7] + (vt >> 3) * 32768 + ks * 8192 + 4096);
                acc[vt] = MFMA16(pf[ks], cat8(lo, hi), acc[vt]); }
            }
            asm volatile("" ::: "memory");
        }
        float mu[4], rs[4];
#pragma unroll
        for (int r = 0; r < 4; ++r) {
            float s = 0.f;
#pragma unroll
            for (int vt = 0; vt < 16; ++vt) s += acc[vt][r];
            s += __shfl_xor(s, 1); s += __shfl_xor(s, 2); s += __shfl_xor(s, 4); s += __shfl_xor(s, 8);
            const float m = s * (1.f / 256.f); float qv = 0.f;
#pragma unroll
            for (int vt = 0; vt < 16; ++vt) { const float d = acc[vt][r] - m; qv += d * d; }
            qv += __shfl_xor(qv, 1); qv += __shfl_xor(qv, 2); qv += __shfl_xor(qv, 4); qv += __shfl_xor(qv, 8);
            mu[r] = m; rs[r] = 1.f / sqrtf(qv * (1.f / 256.f) + LN_EPSF);
        }
        v4u greg[8];
#pragma unroll
        for (int j = 0; j < 8; ++j) greg[j] = *(const GAS v4u*)(gp + (size_t)j * 2048);
        __syncthreads();
        if (has_next) { size_t tk; const GAS bf16* sfn; int hn; item_ptrs(item + G, tk, sfn, hn); issue_state(sfn, 0); issue_q(item + G); }
        LAS bf16* st = (LAS bf16*)(Sg + wid * 8192);
        { LAS bf16* sp_ = st + (4 * g) * 256 + i16;
#pragma unroll
          for (int vt = 0; vt < 16; ++vt)
#pragma unroll
              for (int r = 0; r < 4; ++r) sp_[r * 256 + 16 * vt] = (bf16)(cvtpk((acc[vt][r] - mu[r]) * rs[r], 0.f) & 0xffffu); }
        asm volatile("s_waitcnt lgkmcnt(0)" ::: "memory");
        {
            const float* gn = a.in[4] + h * 256; const int ch = lane & 31;
            const f32x4 g0 = *(const f32x4*)(gn + ch * 8), g1 = *(const f32x4*)(gn + ch * 8 + 4);
            const LAS bf16* yp = st + (lane >> 5) * 256 + ch * 8;
#pragma unroll
            for (int j = 0; j < 8; ++j) {
                const v4u y = *(const LAS v4u*)(yp + j * 512); const v4u sg = greg[j];
                v4u o; o.x = cvtpk(bflo(y.x) * g0[0] * bflo(sg.x), bfhi(y.x) * g0[1] * bfhi(sg.x)); o.y = cvtpk(bflo(y.y) * g0[2] * bflo(sg.y), bfhi(y.y) * g0[3] * bfhi(sg.y));
                o.z = cvtpk(bflo(y.z) * g1[0] * bflo(sg.z), bfhi(y.z) * g1[1] * bfhi(sg.z)); o.w = cvtpk(bflo(y.w) * g1[2] * bflo(sg.w), bfhi(y.w) * g1[3] * bfhi(sg.w));
#if MIX_FP8 & 4
                u32x2 o8; o8.x = pk_fp8x4(bflo(o.x), bfhi(o.x), bflo(o.y), bfhi(o.y)); o8.y = pk_fp8x4(bflo(o.z), bfhi(o.z), bflo(o.w), bfhi(o.w));
                *(GAS u32x2*)(ar8 + (size_t)j * 2048) = o8;
#else
                *(GAS v4u*)(gp + (size_t)j * 2048) = o;
#endif
            }
        }
        __syncthreads();
    }
}

constexpr int P6_RS = 81920, P6_CNT = P6_RS + 8 * 512, P6_BASE = P6_CNT + 64, P6_ROW = P6_BASE + 64;
#define P6_BUTTERFLY(lg, out) do { float r10[10], r5[5], r3[3], r2[2]; const float z = 0.f; \
    _Pragma("unroll") for (int k = 0; k < 10; ++k) { const float keep = h32 ? lg[10 + k] : lg[k], send = h32 ? lg[k] : lg[10 + k]; r10[k] = keep + __shfl_xor(send, 32); } \
    _Pragma("unroll") for (int k = 0; k < 5; ++k) { const float keep = h16 ? r10[5 + k] : r10[k], send = h16 ? r10[k] : r10[5 + k]; r5[k] = keep + __shfl_xor(send, 16); } \
    { const float keep = h8 ? r5[3] : r5[0], send = h8 ? r5[0] : r5[3]; r3[0] = keep + __shfl_xor(send, 8); } \
    { const float keep = h8 ? r5[4] : r5[1], send = h8 ? r5[1] : r5[4]; r3[1] = keep + __shfl_xor(send, 8); } \
    { const float keep = h8 ? z : r5[2], send = h8 ? r5[2] : z; r3[2] = keep + __shfl_xor(send, 8); } \
    { const float keep = h4 ? r3[2] : r3[0], send = h4 ? r3[0] : r3[2]; r2[0] = keep + __shfl_xor(send, 4); } \
    { const float keep = h4 ? z : r3[1], send = h4 ? r3[1] : z; r2[1] = keep + __shfl_xor(send, 4); } \
    { const float keep = h2 ? r2[1] : r2[0], send = h2 ? r2[0] : r2[1]; out = keep + __shfl_xor(send, 2); } \
    out += __shfl_xor(out, 1); } while (0)
__device__ __forceinline__ void p6a_phase(const Args& a, LAS unsigned char* lds, int vcu, int G, int tid, int wave, int lane) {
    unsigned char* ws = a.ws;
    LAS float* RW = (LAS float*)lds;
    LAS float* RS = (LAS float*)(lds + P6_RS) + wave * 128;
    LAS unsigned* LC = (LAS unsigned*)(lds + P6_CNT); LAS unsigned* LB = (LAS unsigned*)(lds + P6_BASE); LAS unsigned* LR = (LAS unsigned*)(lds + P6_ROW);
    for (int i = tid; i < 1024 * 4; i += 512) { const int c = i >> 2, k = i & 3; RW[k * 1024 + c] = a.in[11][i]; }
    for (int i = tid; i < 1024 * 16; i += 512) { const int c = i >> 4, k = i & 15; RW[(4 + k) * 1024 + c] = a.in[13][i]; }
    const u32x2* pre = (const u32x2*)a.out; u32x2* x1b = (u32x2*)(ws + WS_XB); [[maybe_unused]] unsigned* x1f8 = (unsigned*)(ws + WS_X1F8);
    gu32* ctl = (gu32*)ws;
    int* ltok = (int*)(ws + WS_LTOK); float* tw = (float*)(ws + WS_WSLOT); unsigned* tinfo = (unsigned*)(ws + WS_TINFO);
    const float* g1 = a.in[9]; const float* b1 = a.in[10];
    const bool h32 = (lane & 32) != 0, h16 = (lane & 16) != 0, h8 = (lane & 8) != 0, h4 = (lane & 4) != 0, h2 = (lane & 2) != 0;
#define P6_LOADROW(dst, t_) do { const u32x2* xr_ = pre + (size_t)(t_) * 256 + lane; _Pragma("unroll") for (int j = 0; j < 4; ++j) dst[j] = xr_[64 * j]; } while (0)
#define P6_LN(v, nx, s) do { s = 0.f; _Pragma("unroll") for (int j = 0; j < 4; ++j) { v[j] = (f32x4){bflo(nx[j].x), bfhi(nx[j].x), bflo(nx[j].y), bfhi(nx[j].y)}; s += (v[j].x + v[j].y) + (v[j].z + v[j].w); } } while (0)
#define P6_VAR(v, mean, q) do { q = 0.f; _Pragma("unroll") for (int j = 0; j < 4; ++j) { v[j] = v[j] - mean; q += (v[j].x * v[j].x + v[j].y * v[j].y) + (v[j].z * v[j].z + v[j].w * v[j].w); } } while (0)
#if M1_FP8
#define P6_STORE(v, t_, j) do { u32x2 o_; o_.x = cvtpk(v[j].x, v[j].y); o_.y = cvtpk(v[j].z, v[j].w); x1b[(size_t)(t_) * 256 + lane + 64 * j] = o_; x1f8[(size_t)(t_) * 256 + lane + 64 * j] = pk_fp8x4(v[j].x, v[j].y, v[j].z, v[j].w); } while (0)
#else
#define P6_STORE(v, t_, j) do { u32x2 o_; o_.x = cvtpk(v[j].x, v[j].y); o_.y = cvtpk(v[j].z, v[j].w); x1b[(size_t)(t_) * 256 + lane + 64 * j] = o_; } while (0)
#endif
#define P6_DOT(lg, v, j, k, w) lg[k] += (v[j][0] * w[0] + v[j][1] * w[1]) + (v[j][2] * w[2] + v[j][3] * w[3])
    for (int blk = vcu; blk < TT / 128; blk += G) {
        if (tid < 16) LC[tid] = 0u;
        __syncthreads();
        const int t0 = blk * 128;
        u32x2 nxA[4], nxB[4], nxC[4], nxD[4];
        P6_LOADROW(nxA, t0 + wave); P6_LOADROW(nxB, t0 + wave + 8); P6_LOADROW(nxC, t0 + wave + 16); P6_LOADROW(nxD, t0 + wave + 24);
        for (int rr = 0; rr < 4; ++rr) {
            const int rl0 = wave + 32 * rr, tA = t0 + rl0, tB = tA + 8, tC = tA + 16, tD = tA + 24;
            f32x4 vA[4], vB[4], vC[4], vD[4]; float sA, sB, sC, sD;
            P6_LN(vA, nxA, sA); P6_LN(vB, nxB, sB); P6_LN(vC, nxC, sC); P6_LN(vD, nxD, sD);
            if (rr < 3) { P6_LOADROW(nxA, tA + 32); P6_LOADROW(nxB, tB + 32); P6_LOADROW(nxC, tC + 32); P6_LOADROW(nxD, tD + 32); }
            const float mA = wave_sum(sA) * (1.f / DM), mB = wave_sum(sB) * (1.f / DM), mC = wave_sum(sC) * (1.f / DM), mD = wave_sum(sD) * (1.f / DM);
            float qA, qB, qC, qD;
            P6_VAR(vA, mA, qA); P6_VAR(vB, mB, qB); P6_VAR(vC, mC, qC); P6_VAR(vD, mD, qD);
            const float rA = 1.f / sqrtf(wave_sum(qA) * (1.f / DM) + LN_EPSF), rB = 1.f / sqrtf(wave_sum(qB) * (1.f / DM) + LN_EPSF);
            const float rC = 1.f / sqrtf(wave_sum(qC) * (1.f / DM) + LN_EPSF), rD = 1.f / sqrtf(wave_sum(qD) * (1.f / DM) + LN_EPSF);
            float lgA[20], lgB[20], lgC[20], lgD[20];
#pragma unroll
            for (int k = 0; k < 20; ++k) { lgA[k] = 0.f; lgB[k] = 0.f; lgC[k] = 0.f; lgD[k] = 0.f; }
#pragma unroll
            for (int j = 0; j < 4; ++j) {
                const f32x4 gg = *(const f32x4*)(g1 + 4 * lane + 256 * j), bb = *(const f32x4*)(b1 + 4 * lane + 256 * j);
                vA[j] = vA[j] * rA * gg + bb; vB[j] = vB[j] * rB * gg + bb; vC[j] = vC[j] * rC * gg + bb; vD[j] = vD[j] * rD * gg + bb;
                P6_STORE(vA, tA, j); P6_STORE(vB, tB, j); P6_STORE(vC, tC, j); P6_STORE(vD, tD, j);
#pragma unroll
                for (int k = 0; k < 20; ++k) { const f32x4 w = *(const LAS f32x4*)(RW + k * 1024 + 4 * lane + 256 * j);
                    P6_DOT(lgA, vA, j, k, w); P6_DOT(lgB, vB, j, k, w); P6_DOT(lgC, vC, j, k, w); P6_DOT(lgD, vD, j, k, w); }
            }
            float r1A, r1B, r1C, r1D;
            P6_BUTTERFLY(lgA, r1A); P6_BUTTERFLY(lgB, r1B); P6_BUTTERFLY(lgC, r1C); P6_BUTTERFLY(lgD, r1D);
            {
                const int i3 = h2 ? (h4 ? -1 : 1) : (h4 ? 2 : 0);
                const int i5 = i3 < 0 ? -1 : (h8 ? (i3 == 2 ? -1 : i3 + 3) : i3);
                const int kk = i5 < 0 ? -1 : (h32 ? 10 : 0) + (h16 ? 5 : 0) + i5;
                if (kk >= 0 && (lane & 1) == 0) { RS[kk] = r1A; RS[32 + kk] = r1B; RS[64 + kk] = r1C; RS[96 + kk] = r1D; }
            }
            asm volatile("s_waitcnt lgkmcnt(0)" ::: "memory");
            {
                const int sel = lane & 3; const int rl = rl0 + 8 * sel;
                float tl[20];
#pragma unroll
                for (int k4 = 0; k4 < 5; ++k4) { const f32x4 w = *(const LAS f32x4*)(RS + sel * 32 + 4 * k4); tl[4 * k4] = w[0]; tl[4 * k4 + 1] = w[1]; tl[4 * k4 + 2] = w[2]; tl[4 * k4 + 3] = w[3]; }
                float gl[4];
#pragma unroll
                for (int k = 0; k < 4; ++k) gl[k] = tl[k] + a.in[12][k];
                int gi = 0; float gm = gl[0];
#pragma unroll
                for (int k = 1; k < 4; ++k) if (gl[k] > gm) { gm = gl[k]; gi = k; }
                float gs = 0.f;
#pragma unroll
                for (int k = 0; k < 4; ++k) gs += __expf(gl[k] - gm);
                const float gwt = 1.f / gs;
                float el[4];
#pragma unroll
                for (int k = 0; k < 4; ++k) { const float se = gi == 0 ? tl[4 + k] : (gi == 1 ? tl[8 + k] : (gi == 2 ? tl[12 + k] : tl[16 + k])); el[k] = se + a.in[14][4 * gi + k]; }
                int i1 = 0; float v1 = el[0];
#pragma unroll
                for (int k = 1; k < 4; ++k) if (el[k] > v1) { v1 = el[k]; i1 = k; }
                int i2 = (i1 + 1) & 3; float v2 = -3.0e38f;
#pragma unroll
                for (int k = 0; k < 4; ++k) if (k != i1 && el[k] > v2) { v2 = el[k]; i2 = k; }
                const float ex = __expf(v2 - v1), w1 = gwt / (1.f + ex), w2 = gwt * ex / (1.f + ex);
                if (lane < 4) {
                    const int e1 = 4 * gi + i1, e2 = 4 * gi + i2;
                    const unsigned p1 = __hip_atomic_fetch_add(LC + e1, 1u, __ATOMIC_RELAXED, __HIP_MEMORY_SCOPE_WORKGROUP);
                    const unsigned p2 = __hip_atomic_fetch_add(LC + e2, 1u, __ATOMIC_RELAXED, __HIP_MEMORY_SCOPE_WORKGROUP);
                    LR[rl * 4 + 0] = ((unsigned)e1 << 16) | p1; LR[rl * 4 + 1] = ((unsigned)e2 << 16) | p2; LR[rl * 4 + 2] = __float_as_uint(w1); LR[rl * 4 + 3] = __float_as_uint(w2);
                }
            }
            asm volatile("s_waitcnt lgkmcnt(0)" ::: "memory");
        }
        __syncthreads();
        if (tid < 16) LB[tid] = __hip_atomic_fetch_add(ctl + CW_CNT + 64 * tid, LC[tid], __ATOMIC_RELAXED, __HIP_MEMORY_SCOPE_AGENT);
        __syncthreads();
        if (tid < 256) {
            const int rl = tid >> 1, j = tid & 1; const unsigned rec = LR[rl * 4 + j]; const unsigned e = rec >> 16, pos = LB[e] + (rec & 0xffffu);
            ltok[e * TT + pos] = t0 + rl; tw[2 * (t0 + rl) + j] = __uint_as_float(LR[rl * 4 + 2 + j]); tinfo[2 * (t0 + rl) + j] = (e << 16) | pos;
        }
        __syncthreads();
    }
#undef P6_LOADROW
#undef P6_LN
#undef P6_VAR
#undef P6_STORE
#undef P6_DOT
}
__device__ __forceinline__ void build_tile_tables(const Args& a, LAS unsigned char* lds, int tid) {
    LAS int* ts = (LAS int*)(lds + LDS_TS_OFF); LAS int* te = (LAS int*)(lds + LDS_TE_OFF); LAS int* cn = (LAS int*)(lds + LDS_CNT_OFF);
    gu32* ctl = (gu32*)a.ws;
    if (tid == 0) { int acc = 0;
        for (int e = 0; e < 16; ++e) { ts[e] = acc; const int c = (int)__hip_atomic_load(ctl + CW_CNT + 64 * e, __ATOMIC_RELAXED, __HIP_MEMORY_SCOPE_AGENT); const int nt = (c + 255) >> 8; cn[e] = c;
            for (int k = 0; k < nt; ++k) te[acc + k] = e; acc += nt; }
        ts[16] = acc; }
    __syncthreads();
}
__device__ __forceinline__ void p9_phase(const Args& a, LAS unsigned char* lds, int vcu, int G, int wave, int lane) {
    unsigned char* ws = a.ws;
    const LAS int* ts = (const LAS int*)(lds + LDS_TS_OFF);
    const unsigned* tinfo = (const unsigned*)(ws + WS_TINFO); const u32x2* Y = (const u32x2*)(ws + WS_Y);
    const float* g2 = a.in[18]; const float* b2 = a.in[19];
    const int gw = vcu * NWAVES + wave, NGW = G * NWAVES;
    u32x2 ny0[4], ny1[4], nxw[4]; float nw0 = 0.f, nw1 = 0.f;
    const float* tw = (const float*)(ws + WS_WSLOT);
    auto issue = [&](int t) {
        const unsigned i0 = tinfo[2 * t], i1 = tinfo[2 * t + 1];
        nw0 = tw[2 * t]; nw1 = tw[2 * t + 1];
        const size_t s0 = (size_t)ts[i0 >> 16] * 256 + (i0 & 0xffffu), s1 = (size_t)ts[i1 >> 16] * 256 + (i1 & 0xffffu);
        const u32x2* xb1 = (const u32x2*)(ws + WS_XB) + (size_t)t * 256 + lane;
#pragma unroll
        for (int j = 0; j < 4; ++j) { ny0[j] = Y[s0 * 256 + lane + 64 * j]; ny1[j] = Y[s1 * 256 + lane + 64 * j]; nxw[j] = xb1[64 * j]; }
    };
    if (gw < TT) issue(gw);
    for (int t = gw; t < TT; t += NGW) {
        f32x4* xr = (f32x4*)(a.out + (size_t)t * DM) + lane;
        f32x4 v[4]; float s = 0.f; const float w0 = nw0, w1 = nw1;
#pragma unroll
        for (int j = 0; j < 4; ++j) {
            const u32x2 y0 = ny0[j], y1 = ny1[j], xw = nxw[j];
            f32x4 x = (f32x4){bflo(xw.x), bfhi(xw.x), bflo(xw.y), bfhi(xw.y)} * DN_ALPHA;
            x.x += w0 * bflo(y0.x) + w1 * bflo(y1.x); x.y += w0 * bfhi(y0.x) + w1 * bfhi(y1.x); x.z += w0 * bflo(y0.y) + w1 * bflo(y1.y); x.w += w0 * bfhi(y0.y) + w1 * bfhi(y1.y);
            v[j] = x; s += (x.x + x.y) + (x.z + x.w);
        }
        if (t + NGW < TT) issue(t + NGW);
        const float mean = wave_sum(s) * (1.f / DM); float s2 = 0.f;
#pragma unroll
        for (int j = 0; j < 4; ++j) { v[j] = v[j] - mean; s2 += (v[j].x * v[j].x + v[j].y * v[j].y) + (v[j].z * v[j].z + v[j].w * v[j].w); }
        const float rstd = 1.f / sqrtf(wave_sum(s2) * (1.f / DM) + LN_EPSF);
#pragma unroll
        for (int j = 0; j < 4; ++j) { const f32x4 gg = *(const f32x4*)(g2 + 4 * lane + 256 * j), bb = *(const f32x4*)(b2 + 4 * lane + 256 * j); xr[64 * j] = v[j] * rstd * gg + bb; }
    }
}

__global__ void __launch_bounds__(NWAVES * 64, 2) mega_fwd(Args args) {
    extern __shared__ __attribute__((aligned(16))) unsigned char lds_raw[];
    LAS unsigned char* lds = (LAS unsigned char*)lds_raw;
    volatile LAS unsigned* MISC = (volatile LAS unsigned*)(lds + MISC_OFF);
    const int tid0 = threadIdx.x, wave = __builtin_amdgcn_readfirstlane(tid0 >> 6);
    const int G = gridDim.x, bx = blockIdx.x, vcu = (G % 8 == 0) ? (bx % 8) * (G / 8) + bx / 8 : bx;
    for (int u = tid0; u < (LDS_BYTES - LDSCTL_OFF) / 4; u += NWAVES * 64) ((LAS unsigned*)(lds + LDSCTL_OFF))[u] = 0u;
    __syncthreads();
    unsigned char* ws = args.ws;
    gu32* ctl = (gu32*)ws;
    const bool bars_on = (args.mask >> 31) != 0u;
    XcdBarrier bar; bar.bar = (unsigned*)(ctl + CW_BAR) + args.bar_region * XCD_BAR_WORDS; bar.x = 0; bar.st = nullptr;
    if (bars_on) bar = xcd_barrier_post((unsigned*)(ctl + CW_BAR) + args.bar_region * XCD_BAR_WORDS, MISC + 8);
    bar.wv = wave;
#define GRID_BAR() do { if (bars_on) xcd_barrier(bar); } while (0)
#ifndef PH_LAST
#define PH_LAST 99
#endif
#define FRESH() int tid = wave * 64 + pg8::lane_id(); asm volatile("" : "+v"(tid)); const int lane = tid & 63; (void)lane
#ifndef RMASK
#define RMASK 0
#endif
#define REP(k) _Pragma("unroll") for (int rep_ = 0; rep_ < 1 + ((RMASK >> (k)) & 1); ++rep_)
#ifndef STAMP_SCALE
#define STAMP_SCALE 1.0f
#endif
#ifdef STAMP_PH
#define ST_B(k) if ((k) == STAMP_PH) { st_a = rt(); }
#define ST_E(k) if ((k) == STAMP_PH) { st_b = rt(); }
#else
#define ST_B(k)
#define ST_E(k)
#endif
#ifdef ONLY
#define EN(k) (ONLY == (k))
#else
#define EN(k) ((args.mask >> (k)) & 1u)
#endif
    unsigned long long st_a = 0, st_b = 0; (void)st_a; (void)st_b;
    REP(0) if (EN(0)) { FRESH(); p0_prologue(args, lds, vcu, G, tid, wave, lane); }
    GRID_BAR();
#ifdef STAGGER_TICKS
    if (EN(1) && (bx & 8)) { const unsigned long long t0_ = rt(); while (rt() - t0_ < STAGGER_TICKS) __builtin_amdgcn_s_sleep(32); }
#endif
    REP(1) if (EN(1)) {
#if P1_FP8
        pg8::EpiHcat E{ws, (const float*)(ws + WS_ROT), 0};
        if (P1_FP8_FROM > 0) {
            pg8::Gemm g{(const pg8::bf16_t*)(ws + WS_XB), (const pg8::bf16_t*)(ws + WS_WIN), TT, 4608, 1024}; pg8::StaticOrder S; S.init(TT, 256 * P1_FP8_FROM, G, bx);
            pg8::gemm_phase<pg8::EpiHcat, pg8::StaticOrder, true, true>(lds, g, S, E, wave);
        }
        {
            pg8::Gemm g{(const pg8::bf16_t*)args.out, (const pg8::bf16_t*)(ws + WS_WIN8), TT, 4608, 512}; pg8::StaticOrder S; S.init(TT, 4608 - 256 * P1_FP8_FROM, G, bx, P1_FP8_FROM);
            pg8::gemm_phase<pg8::EpiHcat, pg8::StaticOrder, true, true, false, true, 1, 0>(lds, g, S, E, wave);
        }
#else
        pg8::Gemm g{(const pg8::bf16_t*)(ws + WS_XB), (const pg8::bf16_t*)(ws + WS_WIN), TT, 4608, 1024}; pg8::StaticOrder S; S.init(TT, 4608, G, bx);
        pg8::EpiHcat E{ws, (const float*)(ws + WS_ROT), 0};
        pg8::gemm_phase<pg8::EpiHcat, pg8::StaticOrder, true, true>(lds, g, S, E, wave);
#endif
    }
    GRID_BAR();
    if (PH_LAST >= 2) {
        REP(2) if (EN(2)) { FRESH(); for (int it = vcu; it < 256; it += G) chain_item(args, lds, it, tid, wave, lane); }
        if (EN(3)) { { FRESH(); attn_dil_phase<16>(args, lds, vcu, G, tid, wave, lane); }
                     { FRESH(); attn_dil_phase<4>(args, lds, vcu, G, tid, wave, lane); } }
    }
    GRID_BAR();
    ST_B(4) if (PH_LAST >= 3 && EN(4)) { FRESH(); p3_phase<0>(args, lds, vcu, G, tid, wave, lane); }
    if (EN(13)) { FRESH(); attn_p1_phase(args, lds, vcu, G, tid, wave, lane); }
    GRID_BAR(); ST_E(4)
    if (EN(14)) { FRESH(); p0_expert_weights(args, lds, vcu, G, wave, lane); }
    REP(5) if (PH_LAST >= 4 && EN(5)) {
        pg8::Gemm g{(const pg8::bf16_t*)(ws + WS_XB), (const pg8::bf16_t*)(ws + WS_WIN) + (size_t)4608 * 1024, TT, 2048, 1024}; pg8::GateOrder S; S.S4.init(TT, 1024, G, bx);
        pg8::EpiHcat E{ws, (const float*)(ws + WS_ROT), 18};
        pg8::gemm_phase<pg8::EpiHcat, pg8::GateOrder, true, true>(lds, g, S, E, wave);
        asm volatile("s_waitcnt vmcnt(0)" ::: "memory"); __syncthreads();
    }
    REP(6) if (PH_LAST >= 5 && EN(6)) {
        pg8::StaticOrder S; S.init(TT, 1024, G, bx);
        { pg8::EpiGate<false> E{(const pg8::bf16_t*)(ws + WS_GATE_A), (pg8::bf16_t*)(ws + WS_MERGED), nullptr};
#if MIX_FP8 & 2
          pg8::Gemm g{(const pg8::bf16_t*)(ws + WS_OA), (const pg8::bf16_t*)(ws + WS_WA), TT, 1024, 256};
          pg8::gemm_phase<pg8::EpiGate<false>, pg8::StaticOrder, true, true, false, true, 1, 3>(lds, g, S, E, wave);
#else
          pg8::Gemm g{(const pg8::bf16_t*)(ws + WS_OA), (const pg8::bf16_t*)(ws + WS_WA), TT, 1024, 512};
          pg8::gemm_phase<pg8::EpiGate<false>, pg8::StaticOrder, true, true>(lds, g, S, E, wave);
#endif
        }
        asm volatile("s_waitcnt vmcnt(0)" ::: "memory"); __syncthreads();
        { typedef pg8::EpiGate<true, (MIX_FP8 & 1) != 0> EpiC;
          EpiC E{(const pg8::bf16_t*)(ws + WS_GATE_R), (pg8::bf16_t*)(ws + WS_MERGED), ws + WS_MERGED8};
#if MIX_FP8 & 4
          pg8::Gemm g{(const pg8::bf16_t*)(ws + WS_AR8), (const pg8::bf16_t*)(ws + WS_WR), TT, 1024, 512};
          pg8::gemm_phase<EpiC, pg8::StaticOrder, true, true, false, true, 1, 0>(lds, g, S, E, wave);
#else
          pg8::Gemm g{(const pg8::bf16_t*)(ws + WS_GR), (const pg8::bf16_t*)(ws + WS_WR), TT, 1024, 1024};
          pg8::gemm_phase<EpiC, pg8::StaticOrder, true, true>(lds, g, S, E, wave);
#endif
        }
    }
    GRID_BAR();
    REP(7) if (PH_LAST >= 6 && EN(7)) {
        pg8::StaticOrder S; S.init(TT, 1024, G, bx);
        pg8::EpiResBf16 E{(const pg8::bf16_t*)(ws + WS_XB), (pg8::bf16_t*)args.out, DN_ALPHA};
#if MIX_FP8 & 1
        pg8::Gemm g{(const pg8::bf16_t*)(ws + WS_MERGED8), (const pg8::bf16_t*)(ws + WS_WO), TT, 1024, 512};
        pg8::gemm_phase<pg8::EpiResBf16, pg8::StaticOrder, true, true, false, true, 1, 3>(lds, g, S, E, wave);
#else
        pg8::Gemm g{(const pg8::bf16_t*)(ws + WS_MERGED), (const pg8::bf16_t*)(ws + WS_WO), TT, 1024, 1024};
        pg8::gemm_phase<pg8::EpiResBf16, pg8::StaticOrder, true, true>(lds, g, S, E, wave);
#endif
    }
    GRID_BAR();
    ST_B(8) if (PH_LAST >= 7 && EN(8)) { FRESH(); p6a_phase(args, lds, vcu, G, tid, wave, lane); }
    GRID_BAR(); ST_E(8)
    { FRESH(); build_tile_tables(args, lds, tid); }
    const int nrt = ((const LAS int*)(lds + LDS_TS_OFF))[16];
    REP(10) if (PH_LAST >= 9 && EN(10)) {
#if M1_FP8
        pg8::Gemm g{(const pg8::bf16_t*)(ws + WS_X1F8), (const pg8::bf16_t*)(ws + WS_WGU), MAXSLOT, 1024, 512};
        pg8::MoeOrder S{nrt * 4, G, vcu, (const LAS int*)(lds + LDS_TE_OFF), (const LAS int*)(lds + LDS_TS_OFF), (const LAS int*)(lds + LDS_CNT_OFF), (const int*)(ws + WS_LTOK), 1024u};
        pg8::EpiSwiGLU E{ws + WS_H};
        pg8::gemm_phase<pg8::EpiSwiGLU, pg8::MoeOrder, true, true, true, true, 1, 0>(lds, g, S, E, wave);
#else
        pg8::Gemm g{(const pg8::bf16_t*)(ws + WS_XB), (const pg8::bf16_t*)(ws + WS_WGU), MAXSLOT, 1024, 1024};
        pg8::MoeOrder S{nrt * 4, G, vcu, (const LAS int*)(lds + LDS_TE_OFF), (const LAS int*)(lds + LDS_TS_OFF), (const LAS int*)(lds + LDS_CNT_OFF), (const int*)(ws + WS_LTOK), 2048u};
        pg8::EpiSwiGLU E{ws + WS_H};
        pg8::gemm_phase<pg8::EpiSwiGLU, pg8::MoeOrder, true, true, true>(lds, g, S, E, wave);
#endif
    }
    GRID_BAR();
    REP(11) if (PH_LAST >= 10 && EN(11)) {
        pg8::Gemm g{(const pg8::bf16_t*)(ws + WS_H), (const pg8::bf16_t*)(ws + WS_WD), MAXSLOT, 1024, 256};
        pg8::MoeOrder S{nrt * 4, G, vcu, (const LAS int*)(lds + LDS_TE_OFF), (const LAS int*)(lds + LDS_TS_OFF), (const LAS int*)(lds + LDS_CNT_OFF), (const int*)(ws + WS_LTOK), 1024u};
        pg8::EpiRowScale E{(pg8::bf16_t*)(ws + WS_Y)};
        pg8::gemm_phase<pg8::EpiRowScale, pg8::MoeOrder, true, true, false, true, 1, 2>(lds, g, S, E, wave);
    }
    GRID_BAR();
    ST_B(12) if (PH_LAST >= 11 && EN(12)) { FRESH(); p9_phase(args, lds, vcu, G, wave, lane); }
#ifdef STAMP_PH
    GRID_BAR(); ST_E(12)
    if (STAMP_PH == 13) { st_a = rt(); GRID_BAR(); GRID_BAR(); GRID_BAR(); GRID_BAR(); st_b = rt(); }
    if (bx == 0 && tid0 == 0) { const float us = (float)(st_b - st_a) * 0.01f * STAMP_SCALE; int k = 0; float lim = 30.f; while (us >= lim && k < 12) { lim *= 1.5f; ++k; }
        __hip_atomic_store(ctl + CW_CHK, __float_as_uint(sqrtf(2.f * k + 2.f)), RLX_AGENT); }
    GRID_BAR();
    { const float c = __uint_as_float(__hip_atomic_load(ctl + CW_CHK, RLX_AGENT)); f32x4* o4 = (f32x4*)args.out;
      for (size_t i = (size_t)bx * 512 + tid0; i < (size_t)TT * DM / 4; i += (size_t)G * 512) o4[i] = (f32x4){c, c, c, c}; }
#endif
}

#ifdef PROBE_VAR
__global__ void __launch_bounds__(NWAVES * 64, 2) probe_kernel(Args args) {
    extern __shared__ __attribute__((aligned(16))) unsigned char lds_raw[];
    LAS unsigned char* lds = (LAS unsigned char*)lds_raw;
    const int tid0 = threadIdx.x, wave = __builtin_amdgcn_readfirstlane(tid0 >> 6);
    const int G = gridDim.x, bx = blockIdx.x, vcu = (G % 8 == 0) ? (bx % 8) * (G / 8) + bx / 8 : bx;
    FRESH();
    if (PROBE_VAR == 20 || PROBE_VAR == 21) {
        unsigned char* ws = args.ws;
        pg8::Gemm g{(const pg8::bf16_t*)(ws + WS_XB), (const pg8::bf16_t*)(ws + WS_WIN), TT, 4608, 1024}; pg8::StaticOrder S; S.init(TT, 4608, G, bx);
        pg8::EpiHcatT<PROBE_VAR == 21 ? 1 : 0> E{ws, (const float*)(ws + WS_ROT), 0};
        pg8::gemm_phase<pg8::EpiHcatT<PROBE_VAR == 21 ? 1 : 0>, pg8::StaticOrder, true, true>(lds, g, S, E, wave);
    }
    if (PROBE_VAR == 10) p3_phase<0>(args, lds, vcu, G, tid, wave, lane);
    if (PROBE_VAR == 11) p3_phase<1>(args, lds, vcu, G, tid, wave, lane);
    if (PROBE_VAR == 0) attn_dil_phase<16, 0>(args, lds, vcu, G, tid, wave, lane);
    if (PROBE_VAR == 1) attn_dil_phase<16, 1>(args, lds, vcu, G, tid, wave, lane);
    if (PROBE_VAR == 2) attn_dil_phase<4, 0>(args, lds, vcu, G, tid, wave, lane);
    if (PROBE_VAR == 3) attn_dil_phase<4, 1>(args, lds, vcu, G, tid, wave, lane);
}
#endif
extern "C" void kernel_launch(void* const* d_in, const int* in_sizes, int n_in, void* d_out, int out_size, void* d_ws, size_t ws_size, hipStream_t stream) {
    static int grid = 0;
    if (grid == 0) {
        if (n_in != 20 || in_sizes[0] != TT * DM || out_size != TT * DM || ws_size < WS_END) { fprintf(stderr, "kernel_launch: unexpected shapes: n_in %d in0 %d out %d ws %zu; nothing launched\n", n_in, n_in > 0 ? in_sizes[0] : -1, out_size, ws_size); grid = -1; return; }
        int dev = 0, cus = 0;
        if (hipGetDevice(&dev) != hipSuccess || hipDeviceGetAttribute(&cus, hipDeviceAttributeMultiprocessorCount, dev) != hipSuccess) { grid = -1; return; }
        if (hipFuncSetAttribute((const void*)mega_fwd, hipFuncAttributeMaxDynamicSharedMemorySize, LDS_BYTES) != hipSuccess) { fprintf(stderr, "kernel_launch: hipFuncSetAttribute failed\n"); grid = -1; return; }
        (void)hipGetLastError();
        grid = cus;
    }
    if (grid < 0) return;
    if (hipMemsetAsync((char*)d_ws, 0, CTL_ZERO_BYTES, stream) != hipSuccess) return;
    Args a{};
    for (int i = 0; i < 20; ++i) a.in[i] = (const float*)d_in[i];
    a.out = (float*)d_out; a.ws = (unsigned char*)d_ws; a.mask = 0x80007fffu; a.bar_region = 0;
#if defined(XTRA_FIRST)
    { Args x = a; x.mask = XTRA_FIRST; x.bar_region = 1; for (int r = 0; r < XTRA_REP; ++r) hipLaunchKernelGGL(mega_fwd, dim3(grid), dim3(NWAVES * 64), LDS_BYTES, stream, x);
      if (hipMemsetAsync((char*)d_ws, 0, CTL_ZERO_BYTES, stream) != hipSuccess) return; }
#endif
    hipLaunchKernelGGL(mega_fwd, dim3(grid), dim3(NWAVES * 64), LDS_BYTES, stream, a);
#if defined(PROBE_VAR)
    { hipFuncSetAttribute((const void*)probe_kernel, hipFuncAttributeMaxDynamicSharedMemorySize, LDS_BYTES);
      for (int r = 0; r < 4; ++r) hipLaunchKernelGGL(probe_kernel, dim3(grid), dim3(NWAVES * 64), LDS_BYTES, stream, a); }
#endif
#if defined(XTRA_AFTER)
    { Args x = a; x.mask = XTRA_AFTER; x.bar_region = 1; for (int r = 0; r < XTRA_REP; ++r) hipLaunchKernelGGL(mega_fwd, dim3(grid), dim3(NWAVES * 64), LDS_BYTES, stream, x); }
#endif
}
```

```cpp
#define P1_FP8 1
#define P1_FP8_FROM 4
#define MIX_FP8 7
#define GATE_FP8 1
#include <hip/hip_runtime.h>
#include <cstdio>
#include <cstdint>

constexpr int TT = 32768, DM = 1024, SEQ = 2048, NB = 16;
constexpr float DN_ALPHA = 1.189207115002721f;
constexpr float LN_EPSF = 1e-5f;
#ifndef M1_FP8
#define M1_FP8 1
#endif
#ifndef P1_FP8
#define P1_FP8 0
#endif
#ifndef GATE_FP8
#define GATE_FP8 0
#endif
#ifndef MIX_FP8
#define MIX_FP8 0
#endif
#ifndef P1_FP8_FROM
#define P1_FP8_FROM 0
#endif
constexpr size_t MiB = 1u << 20;
constexpr size_t CTL_ZERO_BYTES = 1 * MiB;
constexpr size_t WS_ROT = 1 * MiB;
constexpr size_t WS_BIAS = 2 * MiB;
constexpr size_t WS_LTOK = 3 * MiB;
constexpr size_t WS_TINFO = 7 * MiB;
constexpr size_t WS_WSLOT = 7 * MiB + 512 * 1024;
constexpr size_t WS_WIN = 8 * MiB;
constexpr size_t WS_WIN8 = 12 * MiB;
constexpr size_t WS_WR = 21 * MiB;
constexpr size_t WS_WA = 23 * MiB;
constexpr size_t WS_WO = 24 * MiB;
constexpr size_t WS_WGU = 26 * MiB;
constexpr size_t WS_WD = 42 * MiB;
constexpr size_t WS_XB = 80 * MiB;
constexpr size_t WS_QR = 144 * MiB;
constexpr size_t WS_KR = 176 * MiB;
constexpr size_t WS_VR = 208 * MiB;
constexpr size_t WS_GR = 272 * MiB;
constexpr size_t WS_QA = 336 * MiB, WS_KA = 368 * MiB, WS_VA = 400 * MiB, WS_OA = 432 * MiB;
#if MIX_FP8 & 4
constexpr size_t WS_AR8 = 144 * MiB;
constexpr size_t WS_GATE_R = 176 * MiB, WS_GATE_A = 240 * MiB;
#else
constexpr size_t WS_GATE_R = 144 * MiB, WS_GATE_A = 208 * MiB;
#endif
constexpr size_t WS_X8_LO = 448 * MiB, WS_X8_HI = 58 * MiB;
static_assert(!GATE_FP8 || (P1_FP8 && (MIX_FP8 & 2) && M1_FP8), "GATE_FP8 needs the fp8 mixer-input GEMM, the fp8 o_a (room behind it) and the fp8 expert weights (room behind them)");
constexpr size_t WS_MERGED8 = 464 * MiB;
constexpr size_t WS_MERGED = 336 * MiB;
constexpr size_t WS_Y = 144 * MiB;
constexpr size_t WS_H = 336 * MiB;
constexpr size_t WS_X1F8 = 464 * MiB;
constexpr size_t WS_O2 = 26 * MiB;
constexpr size_t WS_O3 = 464 * MiB;
constexpr size_t WS_LSE2 = 496 * MiB, WS_LSE3 = 497 * MiB;
constexpr size_t WS_END = 512 * MiB;
constexpr int MAXSLOT = 69632;
constexpr int CW_BAR = 4096;
constexpr int CW_CNT = 16384;
constexpr int CW_CHK = 24576;
namespace pg8 {
#define PG8_LAS __attribute__((address_space(3)))
typedef unsigned short bf16_t;
typedef short bf16x8 __attribute__((ext_vector_type(8)));
typedef float f32x4 __attribute__((ext_vector_type(4)));
typedef unsigned u32x4 __attribute__((ext_vector_type(4)));
typedef unsigned u32x2_ __attribute__((ext_vector_type(2)));
constexpr int BM = 256, BK = 64, HALF = 128, HTB = HALF * BK * 2  , STAGE_BYTES = 8 * HTB, NXCD = 8, WGM = 8;

__device__ __forceinline__ int lane_id() { int x; asm volatile("v_mbcnt_lo_u32_b32 %0, -1, 0\n\tv_mbcnt_hi_u32_b32 %0, -1, %0" : "=v"(x)); return x; }
__host__ __device__ __forceinline__ int lds_byte(int r, int c) { const int st = (r >> 4) * 2 + (c >> 5), rr = r & 15, cc = c & 31, ob = rr * 64 + cc * 2; return st * 1024 + (ob ^ (((ob >> 9) & 1) << 5)); }
__host__ __device__ __forceinline__ void stage_rc(int b, int& R, int& C) { const int st = b / 1024, sb = b % 1024, swz = sb ^ (((sb >> 9) & 1) << 5); R = (st >> 1) * 16 + swz / 64; C = (st & 1) * 32 + (swz % 64) / 2; }
__host__ __device__ __forceinline__ int perm32(int rho) { const int n = rho >> 4, i = rho & 15; return 8 * (i >> 2) + 4 * n + (i & 3); }

struct Unit { int pm, pn; };
struct Gemm { const bf16_t* A; const bf16_t* Bt; int M, N, K; int spm = 1 << 30; long sdelta = 0; };

struct StaticOrder {
    int nM, nN, nwg, G, c, pn0;
    __host__ __device__ void init(int M, int N, int G_, int c_, int pn0_ = 0) { nM = M / BM; nN = N / BM; nwg = nM * nN; G = G_; c = c_; pn0 = pn0_; }
    __host__ __device__ bool next(int i, Unit& u) const {
        const long L = (long)i * G + c; if (L >= nwg) return false;
        int wgid = (int)L; { const int q = nwg / NXCD, r = nwg % NXCD, xcd = wgid % NXCD, off = wgid / NXCD; wgid = (xcd < r ? xcd * (q + 1) : r * (q + 1) + (xcd - r) * q) + off; }
        const int nig = WGM * nN, gid = wgid / nig, fm = gid * WGM, gsz = (nM - fm) < WGM ? (nM - fm) : WGM;
        u.pm = fm + ((wgid % nig) % gsz); u.pn = pn0 + (wgid % nig) / gsz; return true;
    }
    __device__ __forceinline__ void a_ready(const Unit&) const {}
    __device__ __forceinline__ void done(const Unit&) const {}
};

__device__ __forceinline__ unsigned cvt_pk_bf16(float lo, float hi) { unsigned r; asm volatile("v_cvt_pk_bf16_f32 %0, %1, %2" : "=v"(r) : "v"(lo), "v"(hi)); return r; }
typedef float cvt_f32x2_t __attribute__((ext_vector_type(2))); typedef __bf16 cvt_bf16x2_t __attribute__((ext_vector_type(2)));
__device__ __forceinline__ unsigned cvt_pk_bf16_acc(float lo, float hi) { const cvt_f32x2_t v = {lo, hi}; const cvt_bf16x2_t b = __builtin_convertvector(v, cvt_bf16x2_t); return __builtin_bit_cast(unsigned, b); }
__device__ __forceinline__ float bflo(unsigned w) { return __uint_as_float(w << 16); }
__device__ __forceinline__ float bfhi(unsigned w) { return __uint_as_float(w & 0xffff0000u); }
__device__ __forceinline__ float fsigmoid(float x) { return __builtin_amdgcn_rcpf(1.f + __expf(-x)); }
__device__ __forceinline__ float fsilu(float x) { return x * __builtin_amdgcn_rcpf(1.f + __expf(-x)); }

template <int VAR = 0> struct EpiHcatT {
    static constexpr bool PERM = true, AFTER_DRAIN = false; static constexpr int NSTORE = 16;
    unsigned char* ws; const float* rot; int tile_off;
    __device__ __forceinline__ void operator()(const f32x4 (&acc)[2][2][4][2], const Unit& u, int wr, int wc, int fr, int fq) const {
        if (VAR == 1) {
            float s = 0.f;
#pragma unroll
            for (int ai = 0; ai < 2; ++ai)
#pragma unroll
                for (int bj = 0; bj < 2; ++bj)
#pragma unroll
                    for (int m = 0; m < 4; ++m)
#pragma unroll
                        for (int n = 0; n < 2; ++n) s += (acc[ai][bj][m][n][0] + acc[ai][bj][m][n][1]) + (acc[ai][bj][m][n][2] + acc[ai][bj][m][n][3]);
            ((float*)(ws + WS_O3))[(size_t)(u.pm * 64 + u.pn) * 512 + wr * 256 + wc * 64 + fq * 16 + fr] = s; return;
        }
        const int gt = u.pn + tile_off;
        size_t base_off; int pitch, ct, mode; float sc = 1.f;
        if (gt < 2)       { base_off = WS_QR; pitch = 512;  ct = gt;      mode = 1; }
        else if (gt < 4)  { base_off = WS_KR; pitch = 512;  ct = gt - 2;  mode = 1; sc = 0.08838834764831845f; }
        else if (gt < 8)  { base_off = WS_VR; pitch = 1024; ct = gt - 4;  mode = 0; }
        else if (gt < 12) { base_off = WS_GR; pitch = 1024; ct = gt - 8;  mode = 2; }
        else if (gt < 14) { base_off = WS_QA; pitch = 512;  ct = gt - 12; mode = 0; sc = 0.18033688011112042f; }
        else if (gt < 16) { base_off = WS_KA; pitch = 512;  ct = gt - 14; mode = 0; }
        else if (gt < 18) { base_off = WS_VA; pitch = 512;  ct = gt - 16; mode = 0; }
        else if (gt < 22) { base_off = WS_GATE_R; pitch = 1024; ct = gt - 18; mode = 3; }
        else              { base_off = WS_GATE_A; pitch = 1024; ct = gt - 22; mode = 3; }
        bf16_t* O = (bf16_t*)(ws + base_off);
        const int row0 = u.pm * BM + wr * 64 + fr, col0 = ct * BM + wc * 32 + 8 * fq;
#pragma unroll
        for (int ai = 0; ai < 2; ++ai)
#pragma unroll
            for (int m = 0; m < 4; ++m) {
                const int row = row0 + ai * HALF + m * 16;
                bf16_t* rowp = O + (size_t)row * pitch + col0;
                f32x4 cs = (f32x4){1.f, 1.f, 1.f, 1.f}, sn = (f32x4){0.f, 0.f, 0.f, 0.f};
                if (mode == 1) { const f32x4* rt = (const f32x4*)(rot + ((size_t)(row & (SEQ - 1)) * 16 + (4 * wc + fq)) * 8); cs = rt[0]; sn = rt[1]; }
#pragma unroll
                for (int bj = 0; bj < 2; ++bj) {
                    f32x4 v0 = acc[ai][bj][m][0], v1 = acc[ai][bj][m][1];
                    if (mode == 1) { const f32x4 a = v0 * cs - v1 * sn, b = v0 * sn + v1 * cs; v0 = a * sc; v1 = b * sc; }
                    else if (mode == 2) {
#pragma unroll
                        for (int e = 0; e < 4; ++e) { v0[e] = fsilu(v0[e]); v1[e] = fsilu(v1[e]); } }
                    else if (mode == 3) {
#pragma unroll
                        for (int e = 0; e < 4; ++e) { v0[e] = fsigmoid(v0[e]); v1[e] = fsigmoid(v1[e]); } }
                    else { v0 = v0 * sc; v1 = v1 * sc; }
                    u32x4 w; w.x = cvt_pk_bf16(v0[0], v0[1]); w.y = cvt_pk_bf16(v0[2], v0[3]); w.z = cvt_pk_bf16(v1[0], v1[1]); w.w = cvt_pk_bf16(v1[2], v1[3]);
                    *(u32x4*)(rowp + bj * HALF) = w;
                }
            }
    }
};

typedef EpiHcatT<0> EpiHcat;

__device__ __forceinline__ unsigned fp8x4_sat(float a, float b, float c, float d) {
    a = __builtin_amdgcn_fmed3f(a, -448.f, 448.f); b = __builtin_amdgcn_fmed3f(b, -448.f, 448.f); c = __builtin_amdgcn_fmed3f(c, -448.f, 448.f); d = __builtin_amdgcn_fmed3f(d, -448.f, 448.f);
    unsigned w = 0u; w = __builtin_amdgcn_cvt_pk_fp8_f32(a, b, w, false); w = __builtin_amdgcn_cvt_pk_fp8_f32(c, d, w, true); return w;
}
template <bool ADD, bool OUT8 = false> struct EpiGate {
    static constexpr bool PERM = true, AFTER_DRAIN = false; static constexpr int NSTORE = 16;
    const bf16_t* gate; bf16_t* O; unsigned char* O8;
    __device__ __forceinline__ void operator()(const f32x4 (&acc)[2][2][4][2], const Unit& u, int wr, int wc, int fr, int fq) const {
        const int row0 = u.pm * BM + wr * 64 + fr, col0 = u.pn * BM + wc * 32 + 8 * fq;
#pragma unroll
        for (int ai = 0; ai < 2; ++ai)
#pragma unroll
            for (int m = 0; m < 4; ++m)
#pragma unroll
                for (int bj = 0; bj < 2; ++bj) {
                    const size_t p = (size_t)(row0 + ai * HALF + m * 16) * 1024 + col0 + bj * HALF;
                    const u32x4 g = *(const u32x4*)(gate + p);
                    f32x4 v0 = acc[ai][bj][m][0], v1 = acc[ai][bj][m][1];
                    v0[0] *= bflo(g.x); v0[1] *= bfhi(g.x); v0[2] *= bflo(g.y); v0[3] *= bfhi(g.y);
                    v1[0] *= bflo(g.z); v1[1] *= bfhi(g.z); v1[2] *= bflo(g.w); v1[3] *= bfhi(g.w);
                    if (ADD) { const u32x4 o = *(const u32x4*)(O + p);
                        v0[0] += bflo(o.x); v0[1] += bfhi(o.x); v0[2] += bflo(o.y); v0[3] += bfhi(o.y);
                        v1[0] += bflo(o.z); v1[1] += bfhi(o.z); v1[2] += bflo(o.w); v1[3] += bfhi(o.w); }
                    if (OUT8) { u32x2_ w8;
                        w8.x = fp8x4_sat(v0[0] * 16.f, v0[1] * 16.f, v0[2] * 16.f, v0[3] * 16.f); w8.y = fp8x4_sat(v1[0] * 16.f, v1[1] * 16.f, v1[2] * 16.f, v1[3] * 16.f);
                        *(u32x2_*)(O8 + p) = w8; }
                    else { u32x4 w; w.x = cvt_pk_bf16(v0[0], v0[1]); w.y = cvt_pk_bf16(v0[2], v0[3]); w.z = cvt_pk_bf16(v1[0], v1[1]); w.w = cvt_pk_bf16(v1[2], v1[3]);
                        *(u32x4*)(O + p) = w; }
                }
    }
};

struct EpiResBf16 {
    static constexpr bool PERM = true, AFTER_DRAIN = false; static constexpr int NSTORE = 16;
    const bf16_t* x; bf16_t* out; float alpha;
    __device__ __forceinline__ void operator()(const f32x4 (&acc)[2][2][4][2], const Unit& u, int wr, int wc, int fr, int fq) const {
        const int row0 = u.pm * BM + wr * 64 + fr, col0 = u.pn * BM + wc * 32 + 8 * fq;
#pragma unroll
        for (int ai = 0; ai < 2; ++ai)
#pragma unroll
            for (int m = 0; m < 4; ++m)
#pragma unroll
                for (int bj = 0; bj < 2; ++bj) {
                    const size_t p = (size_t)(row0 + ai * HALF + m * 16) * 1024 + col0 + bj * HALF;
                    const u32x4 xw = *(const u32x4*)(x + p);
                    const f32x4 x0 = (f32x4){bflo(xw.x), bfhi(xw.x), bflo(xw.y), bfhi(xw.y)}, x1 = (f32x4){bflo(xw.z), bfhi(xw.z), bflo(xw.w), bfhi(xw.w)};
                    const f32x4 v0 = x0 * alpha + acc[ai][bj][m][0], v1 = x1 * alpha + acc[ai][bj][m][1];
                    u32x4 w; w.x = cvt_pk_bf16(v0[0], v0[1]); w.y = cvt_pk_bf16(v0[2], v0[3]); w.z = cvt_pk_bf16(v1[0], v1[1]); w.w = cvt_pk_bf16(v1[2], v1[3]);
                    *(u32x4*)(out + p) = w;
                }
    }
};

struct EpiSwiGLU {
    static constexpr bool PERM = true, AFTER_DRAIN = false; static constexpr int NSTORE = 16;
    unsigned char* H;
    __device__ __forceinline__ void operator()(const f32x4 (&acc)[2][2][4][2], const Unit& u, int wr, int wc, int fr, int fq) const {
        const int row0 = u.pm * BM + wr * 64 + fr, col0 = (u.pn & 3) * 128 + wc * 16 + 4 * fq;
#pragma unroll
        for (int ai = 0; ai < 2; ++ai)
#pragma unroll
            for (int m = 0; m < 4; ++m)
#pragma unroll
                for (int bj = 0; bj < 2; ++bj) {
                    const f32x4 g = acc[ai][bj][m][0], up = acc[ai][bj][m][1];
                    float h0 = fsilu(g[0]) * up[0] * 8.f, h1 = fsilu(g[1]) * up[1] * 8.f, h2 = fsilu(g[2]) * up[2] * 8.f, h3 = fsilu(g[3]) * up[3] * 8.f;
                    h0 = fminf(fmaxf(h0, -448.f), 448.f); h1 = fminf(fmaxf(h1, -448.f), 448.f); h2 = fminf(fmaxf(h2, -448.f), 448.f); h3 = fminf(fmaxf(h3, -448.f), 448.f);
                    unsigned w = 0u; w = __builtin_amdgcn_cvt_pk_fp8_f32(h0, h1, w, false); w = __builtin_amdgcn_cvt_pk_fp8_f32(h2, h3, w, true);
                    *(unsigned*)(H + (size_t)(row0 + ai * HALF + m * 16) * 512 + col0 + bj * 64) = w;
                }
    }
};

struct EpiRowScale {
    static constexpr bool PERM = true, AFTER_DRAIN = false; static constexpr int NSTORE = 16;
    bf16_t* Y;
    __device__ __forceinline__ void operator()(const f32x4 (&acc)[2][2][4][2], const Unit& u, int wr, int wc, int fr, int fq) const {
        const int row0 = u.pm * BM + wr * 64 + fr, col0 = (u.pn & 3) * BM + wc * 32 + 8 * fq;
#pragma unroll
        for (int ai = 0; ai < 2; ++ai)
#pragma unroll
            for (int m = 0; m < 4; ++m) {
                const int row = row0 + ai * HALF + m * 16;
#pragma unroll
                for (int bj = 0; bj < 2; ++bj) {
                    const f32x4 v0 = acc[ai][bj][m][0], v1 = acc[ai][bj][m][1];
                    u32x4 w; w.x = cvt_pk_bf16_acc(v0[0], v0[1]); w.y = cvt_pk_bf16_acc(v0[2], v0[3]); w.z = cvt_pk_bf16_acc(v1[0], v1[1]); w.w = cvt_pk_bf16_acc(v1[2], v1[3]);
                    *(u32x4*)(Y + (size_t)row * 1024 + col0 + bj * HALF) = w;
                }
            }
    }
};

struct MoeOrder {
    int nunits, G, c; const PG8_LAS int* te; const PG8_LAS int* ts; const PG8_LAS int* cnt; const int* ltok; unsigned rowbytes;
    __device__ __forceinline__ bool next(int i, Unit& u) const {
        const int L = i * G + c, rt = (L >> 5) * 8 + (L & 7); if (rt >= (nunits >> 2)) return false;
        u.pm = rt; u.pn = te[rt] * 4 + ((L >> 3) & 3); return true;
    }
    __device__ __forceinline__ unsigned a_row_off(const Unit& u, int row) const {
        const int ex = te[u.pm], pos = (u.pm - ts[ex]) * 256 + row;
        const int tok = pos < cnt[ex] ? ltok[ex * 32768 + pos] : 0;
        return (unsigned)tok * rowbytes;
    }
    __device__ __forceinline__ void a_ready(const Unit&) const {}
    __device__ __forceinline__ void done(const Unit&) const {}
};

struct GateOrder {
    StaticOrder S4;
    __device__ __forceinline__ bool next(int i, Unit& u) const { Unit t; if (!S4.next(i >> 1, t)) return false; u.pm = t.pm; u.pn = t.pn + 4 * (i & 1); return true; }
    __device__ __forceinline__ void a_ready(const Unit&) const {}
    __device__ __forceinline__ void done(const Unit&) const {}
};

template <class Epi, class Sched, bool ALIGN_EPI = false, bool SP2 = false, bool GATHER = false, bool FP8 = false, int SEL_W = 0, int SEL_X = 0>
__device__ __forceinline__ void gemm_phase(PG8_LAS unsigned char* lds, const Gemm g, const Sched& S, const Epi& E, const int wid) {
    int tid = wid * 64 + lane_id(); asm volatile("" : "+v"(tid));
    const int lane = tid & 63, wr = wid >> 2, wc = wid & 3, fr = lane & 15, fq = lane >> 4;
    static_assert(SP2, "only the two-super-phase loop is kept");
    typedef int i32x4_ __attribute__((ext_vector_type(4)));
    const int K = g.K, nt = K / BK;
    unsigned voffB[2]; int rA[2], cA2[2];
#pragma unroll
    for (int i = 0; i < 2; ++i) { int R, C; stage_rc(tid * 16 + i * 8192, R, C); const int Rb = Epi::PERM ? ((R & ~31) + perm32(R & 31)) : R;
        rA[i] = R; cA2[i] = C * 2; voffB[i] = (unsigned)(Rb * K + C) * 2u; }
    unsigned vAc[2][2], vAn[2][2];
    const size_t kstep = (size_t)(BK * 2);
    const size_t hstep = (size_t)HALF * K * 2;
    const size_t tstep = 2 * hstep;
    const unsigned ldsw = (unsigned)wid * 1024u;
    const int aoff0 = lds_byte(wr * 64 + fr, fq * 8), aoff1 = aoff0 + 1024;
    const int boff0 = lds_byte(wc * 32 + fr, fq * 8), boff1 = boff0 + 1024;
#define PG8_SA(b, h) (((b) * 2 + (h)) * HTB)
#define PG8_SB(b, h) ((4 + (b) * 2 + (h)) * HTB)
#define PG8_STAGE(bufoff, gbase, voff) do { _Pragma("unroll") for (int _i = 0; _i < 2; ++_i) \
        __builtin_amdgcn_global_load_lds((const unsigned*)((const char*)(gbase) + (voff)[_i]), (PG8_LAS unsigned*)(lds + (bufoff) + ldsw + _i * 8192), 16, 0, 0); } while (0)
#define PG8_LDA(dst, b, h) do { _Pragma("unroll") for (int m = 0; m < 4; ++m) { dst[m][0] = *(const PG8_LAS bf16x8*)(lds + PG8_SA(b, h) + aoff0 + m * 2048); dst[m][1] = *(const PG8_LAS bf16x8*)(lds + PG8_SA(b, h) + aoff1 + m * 2048); } } while (0)
#define PG8_LDB(dst, b, h) do { _Pragma("unroll") for (int n = 0; n < 2; ++n) { dst[n][0] = *(const PG8_LAS bf16x8*)(lds + PG8_SB(b, h) + boff0 + n * 2048); dst[n][1] = *(const PG8_LAS bf16x8*)(lds + PG8_SB(b, h) + boff1 + n * 2048); } } while (0)
#define PG8_CAT8(x) __builtin_shufflevector(__builtin_bit_cast(i32x4_, (x)[0]), __builtin_bit_cast(i32x4_, (x)[1]), 0, 1, 2, 3, 4, 5, 6, 7)
#define PG8_MMA(ai, bj, At, Bt) do { __builtin_amdgcn_s_setprio(1); \
        if constexpr (FP8) { _Pragma("unroll") for (int m = 0; m < 4; ++m) _Pragma("unroll") for (int n = 0; n < 2; ++n) \
            acc[ai][bj][m][n] = __builtin_amdgcn_mfma_scale_f32_16x16x128_f8f6f4(PG8_CAT8(Bt[n]), PG8_CAT8(At[m]), acc[ai][bj][m][n], 0, 0, SEL_W, scl, SEL_X, scl); \
            asm volatile("" : "+v"(acc[ai][bj][0][0]), "+v"(acc[ai][bj][0][1]), "+v"(acc[ai][bj][1][0]), "+v"(acc[ai][bj][1][1]), "+v"(acc[ai][bj][2][0]), "+v"(acc[ai][bj][2][1]), "+v"(acc[ai][bj][3][0]), "+v"(acc[ai][bj][3][1])); } \
        else { _Pragma("unroll") for (int m = 0; m < 4; ++m) _Pragma("unroll") for (int n = 0; n < 2; ++n) _Pragma("unroll") for (int k = 0; k < 2; ++k) \
            acc[ai][bj][m][n] = __builtin_amdgcn_mfma_f32_16x16x32_bf16(Bt[n][k], At[m][k], acc[ai][bj][m][n], 0, 0, 0); } \
        __builtin_amdgcn_s_setprio(0); } while (0)
#define PG8_WAIT_V(n) asm volatile("s_waitcnt vmcnt(" #n ")" ::: "memory")
#define PG8_WAIT_VN(n) asm volatile("s_waitcnt vmcnt(%0)" :: "i"(n) : "memory")
#define PG8_WAIT_L(n) asm volatile("s_waitcnt lgkmcnt(" #n ")" ::: "memory")
#define PG8_BAR __builtin_amdgcn_s_barrier()
#define PG8_SCHED __builtin_amdgcn_sched_barrier(0)
    [[maybe_unused]] int scl = 0x7b7c797f; asm volatile("" : "+v"(scl));
    Unit cur, nxt; int ui = 0;
    if (!S.next(0, cur)) return;
    f32x4 acc[2][2][4][2];
#pragma unroll
    for (int a = 0; a < 2; ++a)
#pragma unroll
        for (int b = 0; b < 2; ++b)
#pragma unroll
            for (int m = 0; m < 4; ++m)
#pragma unroll
                for (int n = 0; n < 2; ++n) acc[a][b][m][n] = (f32x4){0.f, 0.f, 0.f, 0.f};
    bf16x8 At[4][2], B0[2][2], B1[2][2];
    const char* cA = GATHER ? (const char*)g.A : (const char*)g.A + (size_t)cur.pm * tstep + (cur.pm >= g.spm ? g.sdelta : 0L); const char* cB = (const char*)g.Bt + (size_t)cur.pn * tstep;
#pragma unroll
    for (int h = 0; h < 2; ++h)
#pragma unroll
        for (int i = 0; i < 2; ++i) { if constexpr (GATHER) vAc[h][i] = S.a_row_off(cur, h * HALF + rA[i]) + (unsigned)cA2[i]; else vAc[h][i] = (unsigned)((h * HALF + rA[i]) * K) * 2u + (unsigned)cA2[i]; vAn[h][i] = vAc[h][i]; }
    S.a_ready(cur);
    if constexpr (SP2) {
        PG8_STAGE(PG8_SB(0, 0), cB, voffB); PG8_STAGE(PG8_SB(0, 1), cB + hstep, voffB); PG8_STAGE(PG8_SA(0, 0), cA, vAc[0]); PG8_STAGE(PG8_SA(0, 1), cA, vAc[1]);
        if (wr == 1) PG8_BAR;
        PG8_WAIT_V(2); PG8_BAR;
        PG8_STAGE(PG8_SB(1, 0), cB + kstep, voffB); PG8_STAGE(PG8_SA(1, 0), cA + kstep, vAc[0]); PG8_STAGE(PG8_SB(1, 1), cB + hstep + kstep, voffB);
        PG8_WAIT_V(6); PG8_BAR;
    }
    for (;;) {
        const bool has_next = S.next(ui + 1, nxt);
        const char* nA = GATHER ? cA : (has_next ? (const char*)g.A + (size_t)nxt.pm * tstep + (nxt.pm >= g.spm ? g.sdelta : 0L) : cA); const char* nB = has_next ? (const char*)g.Bt + (size_t)nxt.pn * tstep : cB;
        if constexpr (GATHER) { if (has_next) {
#pragma unroll
            for (int h = 0; h < 2; ++h)
#pragma unroll
                for (int i = 0; i < 2; ++i) vAn[h][i] = S.a_row_off(nxt, h * HALF + rA[i]) + (unsigned)cA2[i]; } }
#pragma unroll 1
        for (int t = 0; t < nt; t += 2) {
            const bool last = (t == nt - 2);
            asm volatile("" : "+v"(voffB[0]), "+v"(voffB[1]), "+v"(vAc[0][0]), "+v"(vAc[0][1]), "+v"(vAc[1][0]), "+v"(vAc[1][1]));
            const char* a1 = cA + (size_t)(t + 1) * kstep;
            const char* a2 = last ? nA : cA + (size_t)(t + 2) * kstep; const char* b2 = last ? nB : cB + (size_t)(t + 2) * kstep;
            const char* a3 = a2 + kstep; const char* b3 = b2 + kstep;
            unsigned vA2[2][2];
#pragma unroll
            for (int h = 0; h < 2; ++h)
#pragma unroll
                for (int i = 0; i < 2; ++i) vA2[h][i] = vAc[h][i];
            if constexpr (GATHER) { if (last) {
                asm volatile("" : "+v"(vAn[0][0]), "+v"(vAn[0][1]), "+v"(vAn[1][0]), "+v"(vAn[1][1]));
#pragma unroll
                for (int h = 0; h < 2; ++h)
#pragma unroll
                    for (int i = 0; i < 2; ++i) vA2[h][i] = vAn[h][i]; } }
            if (last && has_next) S.a_ready(nxt);
            if constexpr (SP2) {
            const int lenient = __builtin_amdgcn_readfirstlane((ui > 0 && t == 0) ? 1 : 0);
#define PG8_WAIT_V8L() asm volatile("s_cmp_eq_u32 %0, 0\n\ts_cbranch_scc0 .Lpg8skip%=\n\ts_waitcnt vmcnt(8)\n.Lpg8skip%=:\n\ts_waitcnt vmcnt(%1)" :: "s"(lenient), "i"(8 + Epi::NSTORE) : "memory", "scc")
            PG8_LDB(B0, 0, 0); PG8_LDB(B1, 0, 1); PG8_SCHED; PG8_LDA(At, 0, 0); PG8_STAGE(PG8_SA(1, 1), a1, vAc[1]);
            PG8_WAIT_V8L(); PG8_WAIT_L(0); PG8_BAR; PG8_MMA(0, 0, At, B0); PG8_MMA(0, 1, At, B1); PG8_BAR; PG8_SCHED;
            PG8_LDA(At, 0, 1); PG8_STAGE(PG8_SB(0, 0), b2, voffB); PG8_STAGE(PG8_SB(0, 1), b2 + hstep, voffB); PG8_STAGE(PG8_SA(0, 0), a2, vA2[0]);
            PG8_WAIT_V8L(); PG8_WAIT_L(0); PG8_BAR; PG8_MMA(1, 0, At, B0); PG8_MMA(1, 1, At, B1); PG8_BAR; PG8_SCHED;
            PG8_LDB(B0, 1, 0); PG8_LDB(B1, 1, 1); PG8_SCHED; PG8_LDA(At, 1, 0); PG8_STAGE(PG8_SA(0, 1), a2, vA2[1]);
            PG8_WAIT_V(8); PG8_WAIT_L(0); PG8_BAR; PG8_MMA(0, 0, At, B0); PG8_MMA(0, 1, At, B1); PG8_BAR; PG8_SCHED;
            PG8_LDA(At, 1, 1); PG8_STAGE(PG8_SB(1, 0), b3, voffB); PG8_STAGE(PG8_SB(1, 1), b3 + hstep, voffB); PG8_STAGE(PG8_SA(1, 0), a3, vA2[0]);
            PG8_WAIT_V(8); PG8_WAIT_L(0); PG8_BAR; PG8_MMA(1, 0, At, B0); PG8_MMA(1, 1, At, B1); PG8_BAR; PG8_SCHED;
#undef PG8_WAIT_V8L
            }
        }
        if constexpr (ALIGN_EPI) { if (wr == 0) PG8_BAR; }
        if constexpr (!Epi::AFTER_DRAIN) { E(acc, cur, wr, wc, fr, fq); S.done(cur); }
        if (!has_next) break;
#pragma unroll
        for (int a = 0; a < 2; ++a)
#pragma unroll
            for (int b = 0; b < 2; ++b)
#pragma unroll
                for (int m = 0; m < 4; ++m)
#pragma unroll
                    for (int n = 0; n < 2; ++n) acc[a][b][m][n] = (f32x4){0.f, 0.f, 0.f, 0.f};
        cur = nxt; cA = nA; cB = nB; ++ui;
        if constexpr (GATHER) {
#pragma unroll
            for (int h = 0; h < 2; ++h)
#pragma unroll
                for (int i = 0; i < 2; ++i) vAc[h][i] = vAn[h][i]; }
        if constexpr (ALIGN_EPI) { if (wr == 1) PG8_BAR; }
    }
    PG8_WAIT_V(0);
    if constexpr (!ALIGN_EPI) { if (wr == 0) PG8_BAR; }
    PG8_BAR;
    if constexpr (Epi::AFTER_DRAIN) { E.fused(acc, cur, wr, wc, fr, fq, lds, wid, lane); S.done(cur); }
#undef PG8_SA
#undef PG8_SB
#undef PG8_STAGE
#undef PG8_LDA
#undef PG8_LDB
#undef PG8_MMA
#undef PG8_CAT8
#undef PG8_WAIT_V
#undef PG8_WAIT_VN
#undef PG8_WAIT_L
#undef PG8_BAR
#undef PG8_SCHED
}
}
#define GAS __attribute__((address_space(1)))
#define LAS __attribute__((address_space(3)))
typedef unsigned short bf16;
typedef unsigned v4u __attribute__((ext_vector_type(4)));
typedef float f32x4 __attribute__((ext_vector_type(4)));
typedef short bf16x8 __attribute__((ext_vector_type(8)));
typedef GAS unsigned gu32;
typedef GAS unsigned long long gu64;
#define RLX_AGENT __ATOMIC_RELAXED, __HIP_MEMORY_SCOPE_AGENT
#define LDS_WAIT() asm volatile("s_waitcnt lgkmcnt(0)" ::: "memory")
#define VM_WAIT() asm volatile("s_waitcnt vmcnt(0)" ::: "memory")
__device__ __forceinline__ unsigned long long rt() { return __builtin_amdgcn_s_memrealtime(); }
__device__ __forceinline__ unsigned f2bf(float f) { unsigned u = __builtin_bit_cast(unsigned, f); return (u + 0x7fffu + ((u >> 16) & 1u)) >> 16; }
__device__ __forceinline__ unsigned pk2(float lo, float hi) { return f2bf(lo) | (f2bf(hi) << 16); }

#define XB_TMO      128
#define XB_XCNT(j)  (256  + 64 * (j))
#define XB_XSUB(j)  (1280 + 64 * (j))
#define XB_XGEN(j)  (2304 + 64 * (j))
#define XB_TOP      3328
#define XB_TOPGEN   3392
#define XCD_BAR_WORDS 3456
#define XB_SPIN_CAP (1u << 18)

__device__ __forceinline__ unsigned xb_ld(unsigned* p)              { return __hip_atomic_load(p, __ATOMIC_RELAXED, __HIP_MEMORY_SCOPE_AGENT); }
__device__ __forceinline__ unsigned xb_add(unsigned* p, unsigned v) { return __hip_atomic_fetch_add(p, v, __ATOMIC_RELAXED, __HIP_MEMORY_SCOPE_AGENT); }
__device__ __forceinline__ unsigned xb_xcc_id() { return (unsigned)__builtin_amdgcn_s_getreg((3 << 11) | 20) & 0xFu; }
#define XB_SPIN(cond, bar) do { unsigned _sp = 0; while (cond) { __builtin_amdgcn_s_sleep(1); \
    if ((++_sp & 255u) == 0u) { if (xb_ld(&(bar)[XB_TMO])) break; if (_sp > XB_SPIN_CAP) { atomicAdd(&(bar)[XB_TMO], 1u); break; } } } } while (0)

struct XcdBarrier {
    unsigned* bar; unsigned x; int wv;
    volatile LAS unsigned* st;
};

__device__ __forceinline__ XcdBarrier xcd_barrier_post(unsigned* bar, volatile LAS unsigned* st) {
    XcdBarrier b; b.bar = bar; b.x = xb_xcc_id(); b.st = st; b.wv = 0;
    if (threadIdx.x == 0) (void)xb_add(&bar[XB_XCNT(b.x)], 1u);
    return b;
}
__device__ __forceinline__ void xcd_barrier_complete(unsigned* bar, unsigned x, unsigned& nloc, unsigned& nx) {
    const unsigned G = gridDim.x * gridDim.y * gridDim.z;
    unsigned sum, cnt, mine, sp = 0u;
    for (;;) {
        sum = 0u; cnt = 0u; mine = 0u;
#pragma unroll
        for (unsigned j = 0; j < 16; ++j) { const unsigned c = xb_ld(&bar[XB_XCNT(j)]); sum += c; cnt += (c > 0u) ? 1u : 0u; mine = (j == x) ? c : mine; }
        if (sum == G) break;
        __builtin_amdgcn_s_sleep(1);
        if ((++sp & 255u) == 0u) { if (xb_ld(&bar[XB_TMO])) break; if (sp > XB_SPIN_CAP) { atomicAdd(&bar[XB_TMO], 1u); break; } }
    }
    nloc = mine > 0u ? mine : 1u; nx = cnt > 0u ? cnt : 1u;
}

__device__ __forceinline__ void xcd_barrier(const XcdBarrier& b) {
    asm volatile("s_waitcnt vmcnt(0)" ::: "memory");
    __syncthreads();
    if (b.wv == 0 && (int)__builtin_amdgcn_mbcnt_hi(~0u, __builtin_amdgcn_mbcnt_lo(~0u, 0u)) == 0) {
        unsigned* bar = b.bar;
        __builtin_amdgcn_s_waitcnt(0);
        unsigned nloc = b.st[0], nx = b.st[1];
        if (nloc == 0u) { xcd_barrier_complete(bar, b.x, nloc, nx); b.st[0] = nloc; b.st[1] = nx; }
        const unsigned old = xb_add(&bar[XB_XSUB(b.x)], 1u);
        const unsigned gen = old / nloc;
        if (old + 1u == (gen + 1u) * nloc) {
            __builtin_amdgcn_fence(__ATOMIC_RELEASE, "agent");
            asm volatile("s_waitcnt vmcnt(0)" ::: "memory");
            const unsigned og = xb_add(&bar[XB_TOP], 1u);
            const unsigned tg = og / nx;
            if (og + 1u == (tg + 1u) * nx) xb_add(&bar[XB_TOPGEN], 1u);
            else XB_SPIN(xb_ld(&bar[XB_TOPGEN]) == tg, bar);
            __builtin_amdgcn_fence(__ATOMIC_ACQUIRE, "agent");
            xb_add(&bar[XB_XGEN(b.x)], 1u);
            asm volatile("s_waitcnt vmcnt(0)" ::: "memory");
        } else {
            XB_SPIN(xb_ld(&bar[XB_XGEN(b.x)]) == gen, bar);
            __builtin_amdgcn_fence(__ATOMIC_ACQUIRE, "agent");
            asm volatile("s_waitcnt vmcnt(0)" ::: "memory");
        }
    }
    __syncthreads();
}


constexpr int NWAVES = 8;
constexpr int RING_BYTES = 131072;
constexpr int LDSCTL_OFF = RING_BYTES, MISC_OFF = LDSCTL_OFF + 320;
constexpr int LDS_TS_OFF = LDSCTL_OFF + 1024;
constexpr int LDS_TE_OFF = LDSCTL_OFF + 2048;
constexpr int LDS_CNT_OFF = LDSCTL_OFF + 1024 + 128;
constexpr int LDS_BYTES = 163840;

typedef short s16x4 __attribute__((ext_vector_type(4)));
typedef unsigned u32x2 __attribute__((ext_vector_type(2)));

struct Args { const float* in[20]; float* out; unsigned char* ws; unsigned mask; int bar_region; };

__device__ __forceinline__ float bflo(unsigned w) { return __uint_as_float(w << 16); }
__device__ __forceinline__ float bfhi(unsigned w) { return __uint_as_float(w & 0xffff0000u); }
__device__ __forceinline__ unsigned cvtpk(float lo, float hi) { return pg8::cvt_pk_bf16(lo, hi); }
__device__ __forceinline__ float wave_sum(float v) {
#pragma unroll
    for (int o = 1; o < 64; o <<= 1) v += __shfl_xor(v, o);
    return v;
}
__device__ __forceinline__ unsigned offb(unsigned row, unsigned ch) { return 256u * row + 16u * (ch ^ (((row & 3u) << 2) | ((row >> 2) & 3u))); }
__device__ __forceinline__ s16x4 ldtr(const LAS unsigned char* p) { return __builtin_amdgcn_ds_read_tr16_b64_v4i16((LAS s16x4*)p); }
__device__ __forceinline__ bf16x8 cat8(s16x4 a, s16x4 b) { return (bf16x8){a[0], a[1], a[2], a[3], b[0], b[1], b[2], b[3]}; }
#define MFMA16(a, b, c) __builtin_amdgcn_mfma_f32_16x16x32_bf16((a), (b), (c), 0, 0, 0)

template <int MODE> __device__ __forceinline__ int dest_row(int n) {
    if (MODE == 1) { if (n >= 1024) return n; const int hb = n & ~127, d = n & 127, jr = d & 63, half = d >> 6; return hb + 8 * (jr >> 2) + 4 * half + (jr & 3); }
    if (MODE == 2) return ((n >> 2) << 3) + (n & 3);
    if (MODE == 3) return ((n >> 2) << 3) + 4 + (n & 3);
    return n;
}
template <int MODE> __device__ __forceinline__ void p0_transpose_item(const float* W, int K, int N, bf16* WT, LAS float* scr, int item, int lane) {
    const int nblk = N / 32, kb = item / nblk, nb = item % nblk, k0 = 64 * kb, n0 = 32 * nb;
    {
        const GAS f32x4* src = (const GAS f32x4*)(W + (size_t)(k0 + (lane >> 3)) * N + n0) + (lane & 7);
        f32x4 t[8];
#pragma unroll
        for (int j = 0; j < 8; ++j) t[j] = src[(size_t)j * 2 * N];
#pragma unroll
        for (int j = 0; j < 8; ++j) { LAS float* d = scr + ((lane >> 3) + 8 * j) * 33 + 4 * (lane & 7); d[0] = t[j].x; d[1] = t[j].y; d[2] = t[j].z; d[3] = t[j].w; }
    }
    LDS_WAIT(); asm volatile("" ::: "memory");
    const int c = lane & 7;
#pragma unroll
    for (int j = 0; j < 4; ++j) { const int n = (lane >> 3) + 8 * j; const LAS float* s = scr + (8 * c) * 33 + n;
        v4u o; o.x = pk2(s[0 * 33], s[1 * 33]); o.y = pk2(s[2 * 33], s[3 * 33]); o.z = pk2(s[4 * 33], s[5 * 33]); o.w = pk2(s[6 * 33], s[7 * 33]);
        *(GAS v4u*)(WT + (size_t)dest_row<MODE>(n0 + n) * K + k0 + 8 * c) = o; }
    LDS_WAIT(); asm volatile("" ::: "memory");
}
__device__ __forceinline__ unsigned pk_fp8x4(float a, float b, float c, float d) {
    a = fminf(fmaxf(a, -448.f), 448.f); b = fminf(fmaxf(b, -448.f), 448.f); c = fminf(fmaxf(c, -448.f), 448.f); d = fminf(fmaxf(d, -448.f), 448.f);
    unsigned w = 0u; w = __builtin_amdgcn_cvt_pk_fp8_f32(a, b, w, false); w = __builtin_amdgcn_cvt_pk_fp8_f32(c, d, w, true); return w;
}
template <int MODE> __device__ __forceinline__ void p0_transpose_item_fp8(const float* W, int K, int N, unsigned char* WT, LAS float* scr, int item, int lane, float scale) {
    const int nblk = N / 32, kb = item / nblk, nb = item % nblk, k0 = 64 * kb, n0 = 32 * nb;
    {
        const GAS f32x4* src = (const GAS f32x4*)(W + (size_t)(k0 + (lane >> 3)) * N + n0) + (lane & 7);
        f32x4 t[8];
#pragma unroll
        for (int j = 0; j < 8; ++j) t[j] = src[(size_t)j * 2 * N];
#pragma unroll
        for (int j = 0; j < 8; ++j) { LAS float* d = scr + ((lane >> 3) + 8 * j) * 33 + 4 * (lane & 7); d[0] = t[j].x; d[1] = t[j].y; d[2] = t[j].z; d[3] = t[j].w; }
    }
    LDS_WAIT(); asm volatile("" ::: "memory");
    const int c = lane & 7;
#pragma unroll
    for (int j = 0; j < 4; ++j) { const int n = (lane >> 3) + 8 * j; const LAS float* s = scr + (8 * c) * 33 + n;
        u32x2 o; o.x = pk_fp8x4(s[0 * 33] * scale, s[1 * 33] * scale, s[2 * 33] * scale, s[3 * 33] * scale); o.y = pk_fp8x4(s[4 * 33] * scale, s[5 * 33] * scale, s[6 * 33] * scale, s[7 * 33] * scale);
        *(GAS u32x2*)(WT + (size_t)dest_row<MODE>(n0 + n) * K + k0 + 8 * c) = o; }
    LDS_WAIT(); asm volatile("" ::: "memory");
}
__device__ __forceinline__ int t5_bucket(int rel) {
    const int n = rel < 0 ? -rel : rel;
    int large = 8 + (n >= 15) + (n >= 27) + (n >= 50) + (n >= 91) + (n >= 166) + (n >= 305) + (n >= 559);
    large = large < 15 ? large : 15;
    return (rel > 0 ? 16 : 0) + (n < 8 ? n : large);
}
__device__ __forceinline__ void p0_prologue(const Args& a, LAS unsigned char* lds, int vcu, int G, int tid, int wave, int lane) {
    unsigned char* ws = a.ws;
    LAS float* scr = (LAS float*)(lds + wave * 16384);
    const int gw = vcu * NWAVES + wave, NGW = G * NWAVES;
    constexpr int I_IN = 16 * 208, I_R = 16 * 32, I_A = 8 * 32, I_O = 16 * 32;
    constexpr int NITEMS = I_IN + I_R + I_A + I_O;
    for (int it = gw; it < NITEMS; it += NGW) {
        int r = it;
#if P1_FP8
        if (r < I_IN) { if ((GATE_FP8 || r % 208 < 144) && r % 208 >= 8 * P1_FP8_FROM) p0_transpose_item_fp8<1>(a.in[1], 1024, 6656, ws + WS_WIN8, scr, r, lane, 64.f);
                        else p0_transpose_item<1>(a.in[1], 1024, 6656, (bf16*)(ws + WS_WIN), scr, r, lane); continue; } r -= I_IN;
#else
        if (r < I_IN) { p0_transpose_item<1>(a.in[1], 1024, 6656, (bf16*)(ws + WS_WIN), scr, r, lane); continue; } r -= I_IN;
#endif
        if (r < I_R) { if (MIX_FP8 & 4) p0_transpose_item_fp8<0>(a.in[5], 1024, 1024, ws + WS_WR, scr, r, lane, 64.f); else p0_transpose_item<0>(a.in[5], 1024, 1024, (bf16*)(ws + WS_WR), scr, r, lane); continue; } r -= I_R;
        if (r < I_A) { if (MIX_FP8 & 2) p0_transpose_item_fp8<0>(a.in[7], 512, 1024, ws + WS_WA, scr, r, lane, 64.f); else p0_transpose_item<0>(a.in[7], 512, 1024, (bf16*)(ws + WS_WA), scr, r, lane); continue; } r -= I_A;
        if (MIX_FP8 & 1) p0_transpose_item_fp8<0>(a.in[8], 1024, 1024, ws + WS_WO, scr, r, lane, 64.f); else p0_transpose_item<0>(a.in[8], 1024, 1024, (bf16*)(ws + WS_WO), scr, r, lane);
    }
    {
        const f32x4* x4 = (const f32x4*)a.in[0]; u32x2* xb = (u32x2*)(ws + WS_XB);
#if P1_FP8
#if GATE_FP8
        unsigned* xf8 = (unsigned*)(ws + WS_X8_LO);
#define XF8_AT(i) xf8[(long)(i) + ((i) >= (size_t)16384 * 256 ? ((long)WS_X8_HI - (long)WS_X8_LO - (long)(16 * MiB)) / 4 : 0L)]
#else
        unsigned* xf8 = (unsigned*)a.out;
#define XF8_AT(i) xf8[i]
#endif
        for (size_t i = (size_t)vcu * 512 + tid; i < (size_t)TT * DM / 4; i += (size_t)G * 512) { const f32x4 v = x4[i]; u32x2 o; o.x = cvtpk(v.x, v.y); o.y = cvtpk(v.z, v.w); xb[i] = o; XF8_AT(i) = pk_fp8x4(v.x, v.y, v.z, v.w); }
#undef XF8_AT
#else
        for (size_t i = (size_t)vcu * 512 + tid; i < (size_t)TT * DM / 4; i += (size_t)G * 512) { const f32x4 v = x4[i]; u32x2 o; o.x = cvtpk(v.x, v.y); o.y = cvtpk(v.z, v.w); xb[i] = o; }
#endif
    }
    {
        float* rot = (float*)(ws + WS_ROT);
        for (int idx = vcu * 512 + tid; idx < SEQ * 64; idx += G * 512) {
            const int pos = idx >> 6, jr = idx & 63;
            double iv = 1.0; for (int k = 0; k < jr; ++k) iv *= 0.86596432336006535;
            const float ang = (float)pos * (float)iv;
            const double xx = (double)ang; const double qd = __builtin_rint(xx * 0.63661977236758134); const int qi = (int)qd;
            const double r = (xx - qd * 1.5707963267948966) - qd * 6.123233995736766e-17, r2 = r * r;
            const double sp = r * (1.0 + r2 * (-1.0 / 6 + r2 * (1.0 / 120 + r2 * (-1.0 / 5040 + r2 * (1.0 / 362880 + r2 * (-1.0 / 39916800 + r2 * (1.0 / 6227020800.0)))))));
            const double cp = 1.0 + r2 * (-0.5 + r2 * (1.0 / 24 + r2 * (-1.0 / 720 + r2 * (1.0 / 40320 + r2 * (-1.0 / 3628800 + r2 * (1.0 / 479001600.0))))));
            const int qq = qi & 3; const double s = qq == 0 ? sp : (qq == 1 ? cp : (qq == 2 ? -sp : -cp)), c = qq == 0 ? cp : (qq == 1 ? -sp : (qq == 2 ? -cp : sp));
            float* o = rot + ((size_t)pos * 16 + (jr >> 2)) * 8 + (jr & 3); o[0] = (float)c; o[4] = (float)s;
        }
    }
    if (vcu == 0) {
        float* bt = (float*)(ws + WS_BIAS); const float* rb = a.in[6];
        for (int idx = tid; idx < 3 * 8 * 160; idx += 512) { const int p = idx / (8 * 160), h = (idx / 160) % 8, d = idx % 160 - 80; const int dil = p == 0 ? 1 : (p == 1 ? 4 : 16);
            bt[idx] = (d >= -64 && d <= 64) ? rb[t5_bucket(d * dil) * 8 + h] * 1.4426950408889634f : -1e30f; }
    }
}
__device__ __forceinline__ void p0_expert_weights(const Args& a, LAS unsigned char* lds, int vcu, int G, int wave, int lane) {
    unsigned char* ws = a.ws;
    LAS float* scr = (LAS float*)(lds + wave * 16384);
    const int gw = vcu * NWAVES + wave, NGW = G * NWAVES;
    constexpr int I_G = 16 * 16, I_D = 8 * 32, PER_E = 2 * I_G + I_D;
    for (int it = gw; it < 16 * PER_E; it += NGW) {
        const int e = it / PER_E; int r = it - e * PER_E;
#if M1_FP8
        if (r < I_G) { p0_transpose_item_fp8<2>(a.in[15] + (size_t)e * 1024 * 512, 1024, 512, ws + WS_WGU + (size_t)e * 1024 * 1024, scr, r, lane, 64.f); continue; } r -= I_G;
        if (r < I_G) { p0_transpose_item_fp8<3>(a.in[16] + (size_t)e * 1024 * 512, 1024, 512, ws + WS_WGU + (size_t)e * 1024 * 1024, scr, r, lane, 64.f); continue; } r -= I_G;
#else
        if (r < I_G) { p0_transpose_item<2>(a.in[15] + (size_t)e * 1024 * 512, 1024, 512, (bf16*)(ws + WS_WGU) + (size_t)e * 1024 * 1024, scr, r, lane); continue; } r -= I_G;
        if (r < I_G) { p0_transpose_item<3>(a.in[16] + (size_t)e * 1024 * 512, 1024, 512, (bf16*)(ws + WS_WGU) + (size_t)e * 1024 * 1024, scr, r, lane); continue; } r -= I_G;
#endif
        p0_transpose_item_fp8<0>(a.in[17] + (size_t)e * 512 * 1024, 512, 1024, ws + WS_WD + (size_t)e * 1024 * 512, scr, r, lane, 64.f);
    }
    __syncthreads();
}

__device__ __forceinline__ float log2_gamma(const float* dec, int h) {
    const float x = dec[h]; return -__log2f(1.f + __expf(-x));
}
__device__ __forceinline__ void chain_item(const Args& a, LAS unsigned char* lds, int item, int tid, int wid, int lane) {
    unsigned char* ws = a.ws;
    const int b = item >> 4, h = (item >> 2) & 3, dir = (item >> 1) & 1, vh = item & 1;
    const float lg2 = log2_gamma(dir ? a.in[3] : a.in[2], h);
    const float cd = __builtin_amdgcn_exp2f(lg2 * 128.f);
    const int g = lane >> 4, i16 = lane & 15, q = i16 >> 2, p = lane & 3;
    const int wd = wid >> 1, wv = wid & 1;
    const GAS bf16* kr = (const GAS bf16*)(ws + WS_KR); const GAS bf16* vr = (const GAS bf16*)(ws + WS_VR);
    GAS bf16* states = (GAS bf16*)a.out;
    f32x4 acc[2][4];
#pragma unroll
    for (int i = 0; i < 2; ++i)
#pragma unroll
        for (int j = 0; j < 4; ++j) acc[i][j] = (f32x4){0.f, 0.f, 0.f, 0.f};
    const int srow = tid >> 4, sch = tid & 15; const unsigned soff = offb(srow, sch);
    const GAS bf16* kp = kr + ((size_t)b * SEQ + srow) * 512 + h * 128 + sch * 8;
    const GAS bf16* vp = vr + ((size_t)b * SEQ + srow) * 1024 + h * 256 + vh * 128 + sch * 8;
    v4u kq[4], vq[4];
    { const int n0 = dir ? 15 : 0;
#pragma unroll
      for (int j = 0; j < 4; ++j) { kq[j] = *(const GAS v4u*)(kp + (size_t)(n0 * 128 + 32 * j) * 512); vq[j] = *(const GAS v4u*)(vp + (size_t)(n0 * 128 + 32 * j) * 1024); } }
    unsigned abase[2][2], bbase[4][2];
#pragma unroll
    for (int t = 0; t < 2; ++t) { const unsigned r = 8 * g + 4 * t + q;
#pragma unroll
        for (int dt = 0; dt < 2; ++dt) abase[dt][t] = offb(r, 2 * (2 * wd + dt) + (p >> 1)) + 8 * (p & 1);
#pragma unroll
        for (int vt = 0; vt < 4; ++vt) bbase[vt][t] = offb(r, 2 * (4 * wv + vt) + (p >> 1)) + 8 * (p & 1); }
#define CH_STAGE(BUFOFF) do { _Pragma("unroll") for (int j = 0; j < 4; ++j) { \
            const int row = srow + 32 * j; const float z = __builtin_amdgcn_exp2f(lg2 * (float)(dir ? row : 127 - row)); const v4u kv = kq[j]; \
            v4u ko; ko.x = cvtpk(bflo(kv.x) * z, bfhi(kv.x) * z); ko.y = cvtpk(bflo(kv.y) * z, bfhi(kv.y) * z); ko.z = cvtpk(bflo(kv.z) * z, bfhi(kv.z) * z); ko.w = cvtpk(bflo(kv.w) * z, bfhi(kv.w) * z); \
            *(LAS v4u*)(lds + (BUFOFF) + soff + j * 8192) = ko; *(LAS v4u*)(lds + (BUFOFF) + 32768 + soff + j * 8192) = vq[j]; } } while (0)
#define CH_FETCH(NN) do { _Pragma("unroll") for (int j = 0; j < 4; ++j) { kq[j] = *(const GAS v4u*)(kp + (size_t)((NN) * 128 + 32 * j) * 512); vq[j] = *(const GAS v4u*)(vp + (size_t)((NN) * 128 + 32 * j) * 1024); } } while (0)
#define CH_STEP(STEP, CUR, OTH) do { const int step_ = (STEP); const int n_ = dir ? 15 - step_ : step_; \
        GAS bf16* sb_ = states + ((((size_t)(b * 4 + h) * 16 + n_) * 2 + dir) * 256) * 128; \
        _Pragma("unroll") for (int dt = 0; dt < 2; ++dt) _Pragma("unroll") for (int vt = 0; vt < 4; ++vt) { \
            const int v_ = vh * 128 + 64 * wv + 16 * vt + i16, d0_ = 32 * wd + 16 * dt + 4 * g; \
            u32x2 w_; w_.x = pg8::cvt_pk_bf16_acc(acc[dt][vt][0], acc[dt][vt][1]); w_.y = pg8::cvt_pk_bf16_acc(acc[dt][vt][2], acc[dt][vt][3]);   \
            *(GAS u32x2*)(sb_ + (size_t)v_ * 128 + d0_) = w_; } \
        if (step_ < 15) CH_STAGE(OTH); \
        if (step_ < 14) CH_FETCH(dir ? 13 - step_ : step_ + 2); \
        _Pragma("unroll") for (int i = 0; i < 2; ++i) _Pragma("unroll") for (int j = 0; j < 4; ++j) acc[i][j] = acc[i][j] * cd; \
        _Pragma("unroll") for (int ks = 0; ks < 4; ++ks) { bf16x8 af[2], bfr[4]; \
            _Pragma("unroll") for (int dt = 0; dt < 2; ++dt) af[dt] = cat8(ldtr(lds + (CUR) + abase[dt][0] + ks * 8192), ldtr(lds + (CUR) + abase[dt][1] + ks * 8192)); \
            _Pragma("unroll") for (int vt = 0; vt < 4; ++vt) bfr[vt] = cat8(ldtr(lds + (CUR) + 32768 + bbase[vt][0] + ks * 8192), ldtr(lds + (CUR) + 32768 + bbase[vt][1] + ks * 8192)); \
            _Pragma("unroll") for (int dt = 0; dt < 2; ++dt) _Pragma("unroll") for (int vt = 0; vt < 4; ++vt) acc[dt][vt] = MFMA16(af[dt], bfr[vt], acc[dt][vt]); } \
        __syncthreads(); } while (0)
    CH_STAGE(0);
    CH_FETCH(dir ? 14 : 1);
    __syncthreads();
    for (int sp = 0; sp < 8; ++sp) { CH_STEP(2 * sp, 0, 65536); CH_STEP(2 * sp + 1, 65536, 0); }
#undef CH_STEP
#undef CH_STAGE
#undef CH_FETCH
}

constexpr int AT_OST = 135168, AT_SCR = AT_OST + 8 * 2048;
constexpr int ATB_N = 160;
struct AttnLane { unsigned kb[2]; unsigned vb[4]; };
__device__ __forceinline__ AttnLane attn_lane(int lane) {
    const int g = lane >> 4, i16 = lane & 15, q4 = i16 >> 2, p = lane & 3; AttnLane L;
#pragma unroll
    for (int s = 0; s < 2; ++s) L.kb[s] = i16 * 128 + (((4 * s + g) ^ ((i16 >> 1) & 7)) * 16);
    const int sw = (2 * g + (q4 >> 1)) & 3;
#pragma unroll
    for (int c = 0; c < 4; ++c) L.vb[c] = (4 * g + q4) * 128 + ((c ^ sw) * 32) + p * 8;
    return L;
}
__device__ __forceinline__ unsigned kimg_off(int row, int c) { return row * 128 + ((c ^ ((row >> 1) & 7)) * 16); }
__device__ __forceinline__ unsigned vimg_off(int row, int c) { return row * 128 + (((c >> 1) ^ ((row >> 1) & 3)) * 32) + (c & 1) * 16; }
__device__ __forceinline__ void attn_core(const LAS unsigned char* Kimg, const LAS unsigned char* Vimg, int R0, int nrows, unsigned tvalid, const bf16x8 (&qf)[2],
                                          const float (&biasr)[36], const AttnLane& L, f32x4 (&O)[4], float& mx, float& lsum) {
    f32x4 D[9];
#pragma unroll
    for (int kt = 0; kt < 9; ++kt) {
        int R = R0 + 16 * kt; R = R < 0 ? 0 : (R > nrows - 16 ? nrows - 16 : R);
        const LAS unsigned char* kp = Kimg + R * 128;
        const bf16x8 k0 = *(const LAS bf16x8*)(kp + L.kb[0]), k1 = *(const LAS bf16x8*)(kp + L.kb[1]);
        f32x4 d = (f32x4){0.f, 0.f, 0.f, 0.f};
        d = MFMA16(k0, qf[0], d); d = MFMA16(k1, qf[1], d); D[kt] = d;
    }
    mx = -1e30f;
#pragma unroll
    for (int kt = 0; kt < 9; ++kt) {
        const float tb = ((tvalid >> kt) & 1u) ? 0.f : -1e30f;
#pragma unroll
        for (int r = 0; r < 4; ++r) { const float x = D[kt][r] + (biasr[4 * kt + r] + tb); D[kt][r] = x; mx = fmaxf(mx, x); }
    }
    mx = fmaxf(mx, __shfl_xor(mx, 16)); mx = fmaxf(mx, __shfl_xor(mx, 32));
    lsum = 0.f;
#pragma unroll
    for (int kt = 0; kt < 9; ++kt)
#pragma unroll
        for (int r = 0; r < 4; ++r) { const float e = __builtin_amdgcn_exp2f(D[kt][r] - mx); D[kt][r] = e; lsum += e; }
    lsum += __shfl_xor(lsum, 16); lsum += __shfl_xor(lsum, 32);
#pragma unroll
    for (int c = 0; c < 4; ++c) O[c] = (f32x4){0.f, 0.f, 0.f, 0.f};
#pragma unroll
    for (int kk = 0; kk < 5; ++kk) {
        int Ra = R0 + 32 * kk; Ra = Ra < 0 ? 0 : (Ra > nrows - 16 ? nrows - 16 : Ra);
        int Rb = R0 + 32 * kk + 16; Rb = Rb < 0 ? 0 : (Rb > nrows - 16 ? nrows - 16 : Rb);
        if (kk == 4) Rb = Ra;
        const f32x4 e0 = D[2 * kk], e1 = kk < 4 ? D[2 * kk + 1] : (f32x4){0.f, 0.f, 0.f, 0.f};
        v4u pw; pw.x = cvtpk(e0[0], e0[1]); pw.y = cvtpk(e0[2], e0[3]); pw.z = cvtpk(e1[0], e1[1]); pw.w = cvtpk(e1[2], e1[3]);
        const bf16x8 pf = __builtin_bit_cast(bf16x8, pw);
        const LAS unsigned char* va_ = Vimg + Ra * 128; const LAS unsigned char* vb_ = Vimg + Rb * 128;
#pragma unroll
        for (int c = 0; c < 4; ++c) O[c] = MFMA16(pf, cat8(ldtr(va_ + L.vb[c]), ldtr(vb_ + L.vb[c])), O[c]);
    }
}
__device__ __forceinline__ void attn_stage_out(LAS unsigned char* lds, int wid, int lane, const f32x4 (&O)[4], float lsum) {
    const int g = lane >> 4, i16 = lane & 15;
    const float linv = 1.f / lsum;
    LAS bf16* st = (LAS bf16*)(lds + AT_OST + wid * 2048);
#pragma unroll
    for (int r = 0; r < 4; ++r) { const float li = __shfl(linv, 4 * g + r);
#pragma unroll
        for (int c = 0; c < 4; ++c) st[(4 * g + r) * 64 + 16 * c + i16] = (bf16)(cvtpk(O[c][r] * li, 0.f) & 0xffffu); }
}
__device__ __forceinline__ void attn_load_bias(const Args& a, int pat, int h, int lane, float (&biasr)[36]) {
    const GAS float* bt = (const GAS float*)(a.ws + WS_BIAS) + (pat * 8 + h) * ATB_N; const int g = lane >> 4, i16 = lane & 15;
#pragma unroll
    for (int kt = 0; kt < 9; ++kt)
#pragma unroll
        for (int r = 0; r < 4; ++r) biasr[4 * kt + r] = bt[16 * kt + 4 * g + r - 64 - i16 + 80];
}
template <int DIL, int VAR = 0> __device__ __forceinline__ void attn_dil_phase(const Args& a, LAS unsigned char* lds, int vcu, int G, int tid, int wid, int lane) {
    unsigned char* ws = a.ws;
    constexpr int NR = SEQ / DIL, PAT = DIL == 4 ? 1 : 2, CH = NR * 8 / 512, NITEM = NB * 8 * DIL;
    constexpr int NBUF = DIL == 16 ? 2 : 1, BUFB = 2 * NR * 128;
    const GAS bf16* qa = (const GAS bf16*)(ws + WS_QA); const GAS bf16* ka = (const GAS bf16*)(ws + WS_KA); const GAS bf16* va = (const GAS bf16*)(ws + WS_VA);
    bf16* op = (bf16*)(ws + (DIL == 4 ? WS_O2 : WS_O3)); float* lsep = (float*)(ws + (DIL == 4 ? WS_LSE2 : WS_LSE3));
    if (vcu >= NITEM) return;
    const int h = vcu & 7;
    float biasr[36]; attn_load_bias(a, PAT, h, lane, biasr);
    const AttnLane L = attn_lane(lane);
    const int g = lane >> 4, i16 = lane & 15;
    v4u kq[CH], vq[CH]; bf16x8 qn[2];
    auto issue = [&](int item, int gi) {
        const int rho = (item >> 3) % DIL, b = item / (8 * DIL); const size_t rowb = (size_t)b * SEQ;
#pragma unroll
        for (int j = 0; j < CH; ++j) { const int id = tid + 512 * j, row = id >> 3, c = id & 7; const size_t go = (rowb + (size_t)row * DIL + rho) * 512 + h * 64 + c * 8;
            kq[j] = *(const GAS v4u*)(ka + go); vq[j] = *(const GAS v4u*)(va + go); }
        const size_t qpos = rowb + (size_t)(16 * gi + i16) * DIL + rho;
#pragma unroll
        for (int s = 0; s < 2; ++s) qn[s] = *(const GAS bf16x8*)(qa + qpos * 512 + h * 64 + 32 * s + 8 * g);
    };
    issue(vcu, wid);
    int buf = 0;
    for (int item = vcu; item < NITEM; item += G) {
        const int rho = (item >> 3) % DIL, b = item / (8 * DIL); const size_t rowb = (size_t)b * SEQ;
        LAS unsigned char* Kimg = lds + buf * BUFB; LAS unsigned char* Vimg = Kimg + NR * 128;
        if (NBUF == 1) __syncthreads();
#pragma unroll
        for (int j = 0; j < CH; ++j) { const int id = tid + 512 * j, row = id >> 3, c = id & 7;
            *(LAS v4u*)(Kimg + kimg_off(row, c)) = kq[j]; *(LAS v4u*)(Vimg + vimg_off(row, c)) = vq[j]; }
        bf16x8 qf[2] = {qn[0], qn[1]};
        __syncthreads();
        if (NBUF == 2 && item + G < NITEM) issue(item + G, wid);
        for (int gi = wid; gi < NR / 16; gi += 8) {
            const int m0 = 16 * gi;
            if (NBUF == 1 && gi + 8 < NR / 16) {
                const size_t qpos = rowb + (size_t)(m0 + 128 + i16) * DIL + rho;
#pragma unroll
                for (int s = 0; s < 2; ++s) qn[s] = *(const GAS bf16x8*)(qa + qpos * 512 + h * 64 + 32 * s + 8 * g); }
            unsigned tvalid = 0u;
#pragma unroll
            for (int kt = 0; kt < 9; ++kt) { const int t0 = m0 - 64 + 16 * kt; tvalid |= (t0 >= 0 && t0 < NR) ? (1u << kt) : 0u; }
            f32x4 O[4]; float mx, lsum;
            if (VAR == 1) { mx = 0.f; lsum = 1.f;
#pragma unroll
                for (int c = 0; c < 4; ++c) O[c] = (f32x4){__builtin_bit_cast(float, qf[0][0] + c), 0.f, 0.f, 0.f}; }
            else attn_core(Kimg, Vimg, m0 - 64, NR, tvalid, qf, biasr, L, O, mx, lsum);
            attn_stage_out(lds, wid, lane, O, lsum);
            if (g == 0) lsep[(rowb + (size_t)(m0 + i16) * DIL + rho) * 8 + h] = mx + __log2f(lsum);
            asm volatile("s_waitcnt lgkmcnt(0)" ::: "memory");
            { const int q = lane >> 2, qt = lane & 3; const LAS v4u* sp = (const LAS v4u*)(lds + AT_OST + wid * 2048 + q * 128 + qt * 32);
              const v4u x0 = sp[0], x1 = sp[1]; bf16* dst = op + (rowb + (size_t)(m0 + q) * DIL + rho) * 512 + h * 64 + qt * 16;
              *(v4u*)dst = x0; *(v4u*)(dst + 8) = x1; }
            asm volatile("s_waitcnt lgkmcnt(0)" ::: "memory");
            if (NBUF == 1) { qf[0] = qn[0]; qf[1] = qn[1]; }
        }
        if (NBUF == 1 && item + G < NITEM) issue(item + G, wid);
        buf ^= (NBUF - 1);
    }
    __syncthreads();
}
__device__ __forceinline__ void attn_p1_phase(const Args& a, LAS unsigned char* lds, int vcu, int G, int tid, int wid, int lane) {
    unsigned char* ws = a.ws;
    LAS unsigned char* Kimg = lds; LAS unsigned char* Vimg = lds + 384 * 128;
    const GAS bf16* qa = (const GAS bf16*)(ws + WS_QA); const GAS bf16* ka = (const GAS bf16*)(ws + WS_KA); const GAS bf16* va = (const GAS bf16*)(ws + WS_VA);
    const GAS bf16* o2 = (const GAS bf16*)(ws + WS_O2); const GAS bf16* o3 = (const GAS bf16*)(ws + WS_O3);
    const GAS float* lse2 = (const GAS float*)(ws + WS_LSE2); const GAS float* lse3 = (const GAS float*)(ws + WS_LSE3);
    bf16* oa = (bf16*)(ws + WS_OA);
    if (vcu >= 1024) return;
    const int h = vcu & 7;
    float biasr[36]; attn_load_bias(a, 0, h, lane, biasr);
    const AttnLane L = attn_lane(lane);
    const int g = lane >> 4, i16 = lane & 15;
    LAS float* scr = (LAS float*)(lds + AT_SCR) + wid * 16;
    v4u kq[6], vq[6];
    auto issue = [&](int item) { const int b = item >> 6, s0 = ((item >> 3) & 7) * 256; const size_t rowb = (size_t)b * SEQ;
#pragma unroll
        for (int j = 0; j < 6; ++j) { const int id = tid + 512 * j, row = id >> 3, c = id & 7, pos = s0 - 64 + row; const bool ok = pos >= 0 && pos < SEQ;
            const size_t go = (rowb + (size_t)(ok ? pos : 0)) * 512 + h * 64 + c * 8;
            kq[j] = *(const GAS v4u*)(ka + go); vq[j] = *(const GAS v4u*)(va + go);
            if (!ok) { kq[j] = (v4u){0u, 0u, 0u, 0u}; vq[j] = (v4u){0u, 0u, 0u, 0u}; } } };
    issue(vcu);
    for (int item = vcu; item < 1024; item += G) {
        const int b = item >> 6, s0 = ((item >> 3) & 7) * 256; const size_t rowb = (size_t)b * SEQ;
        __syncthreads();
#pragma unroll
        for (int j = 0; j < 6; ++j) { const int id = tid + 512 * j, row = id >> 3, c = id & 7;
            *(LAS v4u*)(Kimg + kimg_off(row, c)) = kq[j]; *(LAS v4u*)(Vimg + vimg_off(row, c)) = vq[j]; }
        __syncthreads();
        if (item + G < 1024) issue(item + G);
        for (int gi = wid; gi < 16; gi += 8) {
            const int m0 = s0 + 16 * gi;
            const int q = lane >> 2, qt = lane & 3; const size_t tq = rowb + m0 + q;
            const v4u a20 = *(const GAS v4u*)(o2 + tq * 512 + h * 64 + qt * 16), a21 = *(const GAS v4u*)(o2 + tq * 512 + h * 64 + qt * 16 + 8);
            const v4u a30 = *(const GAS v4u*)(o3 + tq * 512 + h * 64 + qt * 16), a31 = *(const GAS v4u*)(o3 + tq * 512 + h * 64 + qt * 16 + 8);
            const float l2 = lse2[tq * 8 + h], l3 = lse3[tq * 8 + h];
            bf16x8 qf[2];
#pragma unroll
            for (int s = 0; s < 2; ++s) qf[s] = *(const GAS bf16x8*)(qa + (rowb + m0 + i16) * 512 + h * 64 + 32 * s + 8 * g);
            unsigned tvalid = 0u;
#pragma unroll
            for (int kt = 0; kt < 9; ++kt) { const int t0 = m0 - 64 + 16 * kt; tvalid |= (t0 >= 0 && t0 < SEQ) ? (1u << kt) : 0u; }
            f32x4 O[4]; float mx, lsum;
            attn_core(Kimg, Vimg, 16 * gi, 384, tvalid, qf, biasr, L, O, mx, lsum);
            attn_stage_out(lds, wid, lane, O, lsum);
            if (g == 0) scr[i16] = mx + __log2f(lsum);
            asm volatile("s_waitcnt lgkmcnt(0)" ::: "memory");
            {
                const float l1 = scr[q], M = fmaxf(l1, fmaxf(l2, l3));
                float w1 = __builtin_amdgcn_exp2f(l1 - M), w2 = __builtin_amdgcn_exp2f(l2 - M), w3 = __builtin_amdgcn_exp2f(l3 - M); const float wi = 1.f / (w1 + w2 + w3); w1 *= wi; w2 *= wi; w3 *= wi;
                const LAS v4u* sp = (const LAS v4u*)(lds + AT_OST + wid * 2048 + q * 128 + qt * 32);
                const v4u x0 = sp[0], x1 = sp[1];
                v4u r0, r1;
#define MRG(d, x, y, z) d = cvtpk(w1 * bflo(x) + w2 * bflo(y) + w3 * bflo(z), w1 * bfhi(x) + w2 * bfhi(y) + w3 * bfhi(z))
                MRG(r0.x, x0.x, a20.x, a30.x); MRG(r0.y, x0.y, a20.y, a30.y); MRG(r0.z, x0.z, a20.z, a30.z); MRG(r0.w, x0.w, a20.w, a30.w);
                MRG(r1.x, x1.x, a21.x, a31.x); MRG(r1.y, x1.y, a21.y, a31.y); MRG(r1.z, x1.z, a21.z, a31.z); MRG(r1.w, x1.w, a21.w, a31.w);
#undef MRG
#if MIX_FP8 & 2
                v4u o8;
                o8.x = pk_fp8x4(16.f * bflo(r0.x), 16.f * bfhi(r0.x), 16.f * bflo(r0.y), 16.f * bfhi(r0.y)); o8.y = pk_fp8x4(16.f * bflo(r0.z), 16.f * bfhi(r0.z), 16.f * bflo(r0.w), 16.f * bfhi(r0.w));
                o8.z = pk_fp8x4(16.f * bflo(r1.x), 16.f * bfhi(r1.x), 16.f * bflo(r1.y), 16.f * bfhi(r1.y)); o8.w = pk_fp8x4(16.f * bflo(r1.z), 16.f * bfhi(r1.z), 16.f * bflo(r1.w), 16.f * bfhi(r1.w));
                *(v4u*)((unsigned char*)oa + tq * 512 + h * 64 + qt * 16) = o8;
#else
                bf16* dst = oa + tq * 512 + h * 64 + qt * 16;
                *(v4u*)dst = r0; *(v4u*)(dst + 8) = r1;
#endif
            }
            asm volatile("s_waitcnt lgkmcnt(0)" ::: "memory");
        }
    }
    __syncthreads();
}

#define OPAQUE(x) asm volatile("" : "+v"(x))
template <int VAR = 0> __device__ __forceinline__ void p3_phase(const Args& a, LAS unsigned char* lds, int vcu, int G, int tid, int wid, int lane) {
    unsigned char* ws = a.ws;
    const int g = lane >> 4, i16 = lane & 15, q4 = i16 >> 2, p = lane & 3;
    const GAS bf16* qr = (const GAS bf16*)(ws + WS_QR); const GAS bf16* kr = (const GAS bf16*)(ws + WS_KR); const GAS bf16* vr = (const GAS bf16*)(ws + WS_VR);
    GAS bf16* gr = (GAS bf16*)(ws + WS_GR);
    LAS unsigned char* Kt = lds; LAS unsigned char* Sg = lds + 32768;
    if (vcu >= 1024) return;
    const unsigned kdst = offb(tid >> 4, tid & 15);
    unsigned rfo[4];
    { const unsigned X = ((i16 & 3) << 2) | (i16 >> 2);
#pragma unroll
      for (int s = 0; s < 4; ++s) rfo[s] = 256 * i16 + 16 * (((4 * s) ^ (X & 12)) | (g ^ (X & 3))); }
    v4u sreg[8], kreg[4]; bf16x8 qn[4];
    auto item_ptrs = [&](int item, size_t& tok0, const GAS bf16*& sf, int& h) { const int b = item >> 6; h = (item >> 4) & 3; const int n = item & 15; tok0 = (size_t)b * SEQ + n * 128;
        sf = (const GAS bf16*)a.out + ((((size_t)(b * 4 + h) * 16 + n) * 2 + 0) * 256) * 128; };
    auto issue_k = [&](int item) { size_t tok0; const GAS bf16* sf; int h; item_ptrs(item, tok0, sf, h);
        const GAS bf16* ks_ = kr + (tok0 + (tid >> 4)) * 512 + h * 128 + (tid & 15) * 8;
#pragma unroll
        for (int j = 0; j < 4; ++j) kreg[j] = *(const GAS v4u*)(ks_ + (size_t)j * 32 * 512); };
    auto issue_q = [&](int item) { size_t tok0; const GAS bf16* sf; int h; item_ptrs(item, tok0, sf, h);
#pragma unroll
        for (int s = 0; s < 4; ++s) qn[s] = *(const GAS bf16x8*)(qr + (tok0 + 16 * wid + i16) * 512 + h * 128 + 32 * s + 8 * g); };
    auto issue_state = [&](const GAS bf16* sf, int dirn) { const GAS bf16* sld = sf + (size_t)dirn * 256 * 128 + (size_t)(tid >> 4) * 128 + (tid & 15) * 8;
#pragma unroll
        for (int j = 0; j < 8; ++j) sreg[j] = *(const GAS v4u*)(sld + (size_t)j * 32 * 128); };
    auto write_state = [&]() {
#pragma unroll
        for (int j = 0; j < 8; ++j) *(LAS v4u*)(Sg + (j >> 2) * 32768 + kdst + (j & 3) * 8192) = sreg[j]; };
    { size_t tok0; const GAS bf16* sf; int h; item_ptrs(vcu, tok0, sf, h); issue_k(vcu); issue_q(vcu); issue_state(sf, 0); }
#pragma unroll
    for (int j = 0; j < 4; ++j) *(LAS v4u*)(Kt + kdst + j * 8192) = kreg[j];
    for (int item = vcu; item < 1024; item += G) {
        size_t tok0; const GAS bf16* sf; int h; item_ptrs(item, tok0, sf, h);
        const float lf2 = log2_gamma(a.in[2], h), lb2 = log2_gamma(a.in[3], h);
        bf16x8 qf[4];
#pragma unroll
        for (int s = 0; s < 4; ++s) qf[s] = qn[s];
        const bool has_next = item + G < 1024;
        __syncthreads();
        f32x4 D[8];
#pragma unroll
        for (int jt = 0; jt < 8; ++jt) {
            f32x4 d = (f32x4){0.f, 0.f, 0.f, 0.f};
#pragma unroll
            for (int s = 0; s < 4; ++s) { if (VAR != 1) { const bf16x8 kf = *(const LAS bf16x8*)(Kt + rfo[s] + jt * 4096); d = MFMA16(kf, qf[s], d); } else d[s] = __builtin_bit_cast(float, (int)qf[s][0]); }
            D[jt] = d;
        }
        int iq = 16 * wid + i16; OPAQUE(iq);
        bf16x8 pf[4];
#pragma unroll
        for (int ks = 0; ks < 4; ++ks) {
            float e[8];
#pragma unroll
            for (int t = 0; t < 2; ++t)
#pragma unroll
                for (int r = 0; r < 4; ++r) {
                    const int j = 16 * (2 * ks + t) + 4 * g + r; const float fdf = (float)(iq - j), ad = fabsf(fdf);
                    const float pos = fminf(fmaxf(fdf, 0.f), 1.f), isz = 1.f - fminf(ad, 1.f);
                    const float w = __builtin_amdgcn_exp2f((lb2 + (lf2 - lb2) * pos) * ad) + isz;
                    e[4 * t + r] = D[2 * ks + t][r] * w;
                }
            v4u pw; pw.x = cvtpk(e[0], e[1]); pw.y = cvtpk(e[2], e[3]); pw.z = cvtpk(e[4], e[5]); pw.w = cvtpk(e[6], e[7]);
            pf[ks] = __builtin_bit_cast(bf16x8, pw);
        }
        f32x4 acc[16];
#pragma unroll
        for (int vt = 0; vt < 16; ++vt) acc[vt] = (f32x4){0.f, 0.f, 0.f, 0.f};
#pragma unroll
        for (int dirn = 0; dirn < 2; ++dirn) {
            if (dirn == 1) __syncthreads();
            write_state();
            if (dirn == 0) { issue_state(sf, 1); if (has_next) issue_k(item + G); }
            else {
                if (has_next) {
#pragma unroll
                    for (int j = 0; j < 4; ++j) *(LAS v4u*)(Kt + kdst + j * 8192) = kreg[j]; }
                const GAS bf16* vs_ = vr + (tok0 + (tid >> 5)) * 1024 + h * 256 + (tid & 31) * 8;
#pragma unroll
                for (int j = 0; j < 8; ++j) sreg[j] = *(const GAS v4u*)(vs_ + (size_t)j * 16 * 1024);
            }
            __syncthreads();
#pragma unroll
            for (int vt = 0; vt < 16; ++vt) {
#pragma unroll
                for (int s = 0; s < 4; ++s) { if (VAR != 1) { const bf16x8 sfr = *(const LAS bf16x8*)(Sg + (vt >> 3) * 32768 + rfo[s] + (vt & 7) * 4096); acc[vt] = MFMA16(qf[s], sfr, acc[vt]); } }
            }
            float xs[4];
            { int ib = 16 * wid + 4 * g; OPAQUE(ib);
#pragma unroll
              for (int r = 0; r < 4; ++r) { const float lxf = lf2 * (float)(ib + r + 1), lxb = lb2 * (float)(128 - ib - r); xs[r] = __builtin_amdgcn_exp2f(dirn == 0 ? lxf - lxb : lxb); } }
#pragma unroll
            for (int vt = 0; vt < 16; ++vt)
#pragma unroll
                for (int r = 0; r < 4; ++r) acc[vt][r] *= xs[r];
        }
        __syncthreads();
        { int t2 = tid; OPAQUE(t2); const unsigned vd2 = (unsigned)((t2 & 31) >> 4) * 32768u + offb(t2 >> 5, t2 & 15);
#pragma unroll
          for (int j = 0; j < 8; ++j) *(LAS v4u*)(Sg + vd2 + j * 4096) = sreg[j]; }
        GAS bf16* gp = gr + (tok0 + 16 * wid + (lane >> 5)) * 1024 + h * 256 + (lane & 31) * 8;
#if MIX_FP8 & 4
        GAS unsigned char* ar8 = (GAS unsigned char*)(ws + WS_AR8) + (tok0 + 16 * wid + (lane >> 5)) * 1024 + h * 256 + (lane & 31) * 8;
#endif
        __syncthreads();
        unsigned vbs[8];
        { int l2 = lane; OPAQUE(l2); const unsigned g2 = l2 >> 4, q2 = (l2 & 15) >> 2, p2 = l2 & 3, X = (q2 << 2) | g2;
#pragma unroll
          for (int c = 0; c < 8; ++c) vbs[c] = 256 * (4 * g2 + q2) + 16 * (((2 * c) ^ (X & 14)) | ((p2 >> 1) ^ (X & 1))) + 8 * (p2 & 1); }
#pragma unroll
        for (int vt = 0; vt < 16; ++vt) {
#pragma unroll
            for (int ks = 0; ks < 4; ++ks) { if (VAR != 1) {
                const s16x4 lo = ldtr(Sg + vbs[vt & 7] + (vt >> 3) * 32768 + ks * 8192), hi = ldtr(Sg + vbs[vt & 7] + (vt >> 3) * 32768 + ks * 8192 + 4096);
                acc[vt] = MFMA16(pf[ks], cat8(lo, hi), acc[vt]); }
            }
            asm volatile("" ::: "memory");
        }
        float mu[4], rs[4];
#pragma unroll
        for (int r = 0; r < 4; ++r) {
            float s = 0.f;
#pragma unroll
            for (int vt = 0; vt < 16; ++vt) s += acc[vt][r];
            s += __shfl_xor(s, 1); s += __shfl_xor(s, 2); s += __shfl_xor(s, 4); s += __shfl_xor(s, 8);
            const float m = s * (1.f / 256.f); float qv = 0.f;
#pragma unroll
            for (int vt = 0; vt < 16; ++vt) { const float d = acc[vt][r] - m; qv += d * d; }
            qv += __shfl_xor(qv, 1); qv += __shfl_xor(qv, 2); qv += __shfl_xor(qv, 4); qv += __shfl_xor(qv, 8);
            mu[r] = m; rs[r] = 1.f / sqrtf(qv * (1.f / 256.f) + LN_EPSF);
        }
        v4u greg[8];
#pragma unroll
        for (int j = 0; j < 8; ++j) greg[j] = *(const GAS v4u*)(gp + (size_t)j * 2048);
        __syncthreads();
        if (has_next) { size_t tk; const GAS bf16* sfn; int hn; item_ptrs(item + G, tk, sfn, hn); issue_state(sfn, 0); issue_q(item + G); }
        LAS bf16* st = (LAS bf16*)(Sg + wid * 8192);
        { LAS bf16* sp_ = st + (4 * g) * 256 + i16;
#pragma unroll
          for (int vt = 0; vt < 16; ++vt)
#pragma unroll
              for (int r = 0; r < 4; ++r) sp_[r * 256 + 16 * vt] = (bf16)(cvtpk((acc[vt][r] - mu[r]) * rs[r], 0.f) & 0xffffu); }
        asm volatile("s_waitcnt lgkmcnt(0)" ::: "memory");
        {
            const float* gn = a.in[4] + h * 256; const int ch = lane & 31;
            const f32x4 g0 = *(const f32x4*)(gn + ch * 8), g1 = *(const f32x4*)(gn + ch * 8 + 4);
            const LAS bf16* yp = st + (lane >> 5) * 256 + ch * 8;
#pragma unroll
            for (int j = 0; j < 8; ++j) {
                const v4u y = *(const LAS v4u*)(yp + j * 512); const v4u sg = greg[j];
                v4u o; o.x = cvtpk(bflo(y.x) * g0[0] * bflo(sg.x), bfhi(y.x) * g0[1] * bfhi(sg.x)); o.y = cvtpk(bflo(y.y) * g0[2] * bflo(sg.y), bfhi(y.y) * g0[3] * bfhi(sg.y));
                o.z = cvtpk(bflo(y.z) * g1[0] * bflo(sg.z), bfhi(y.z) * g1[1] * bfhi(sg.z)); o.w = cvtpk(bflo(y.w) * g1[2] * bflo(sg.w), bfhi(y.w) * g1[3] * bfhi(sg.w));
#if MIX_FP8 & 4
                u32x2 o8; o8.x = pk_fp8x4(bflo(o.x), bfhi(o.x), bflo(o.y), bfhi(o.y)); o8.y = pk_fp8x4(bflo(o.z), bfhi(o.z), bflo(o.w), bfhi(o.w));
                *(GAS u32x2*)(ar8 + (size_t)j * 2048) = o8;
#else
                *(GAS v4u*)(gp + (size_t)j * 2048) = o;
#endif
            }
        }
        __syncthreads();
    }
}

constexpr int P6_RS = 81920, P6_CNT = P6_RS + 8 * 512, P6_BASE = P6_CNT + 64, P6_ROW = P6_BASE + 64;
#define P6_BUTTERFLY(lg, out) do { float r10[10], r5[5], r3[3], r2[2]; const float z = 0.f; \
    _Pragma("unroll") for (int k = 0; k < 10; ++k) { const float keep = h32 ? lg[10 + k] : lg[k], send = h32 ? lg[k] : lg[10 + k]; r10[k] = keep + __shfl_xor(send, 32); } \
    _Pragma("unroll") for (int k = 0; k < 5; ++k) { const float keep = h16 ? r10[5 + k] : r10[k], send = h16 ? r10[k] : r10[5 + k]; r5[k] = keep + __shfl_xor(send, 16); } \
    { const float keep = h8 ? r5[3] : r5[0], send = h8 ? r5[0] : r5[3]; r3[0] = keep + __shfl_xor(send, 8); } \
    { const float keep = h8 ? r5[4] : r5[1], send = h8 ? r5[1] : r5[4]; r3[1] = keep + __shfl_xor(send, 8); } \
    { const float keep = h8 ? z : r5[2], send = h8 ? r5[2] : z; r3[2] = keep + __shfl_xor(send, 8); } \
    { const float keep = h4 ? r3[2] : r3[0], send = h4 ? r3[0] : r3[2]; r2[0] = keep + __shfl_xor(send, 4); } \
    { const float keep = h4 ? z : r3[1], send = h4 ? r3[1] : z; r2[1] = keep + __shfl_xor(send, 4); } \
    { const float keep = h2 ? r2[1] : r2[0], send = h2 ? r2[0] : r2[1]; out = keep + __shfl_xor(send, 2); } \
    out += __shfl_xor(out, 1); } while (0)
__device__ __forceinline__ void p6a_phase(const Args& a, LAS unsigned char* lds, int vcu, int G, int tid, int wave, int lane) {
    unsigned char* ws = a.ws;
    LAS float* RW = (LAS float*)lds;
    LAS float* RS = (LAS float*)(lds + P6_RS) + wave * 128;
    LAS unsigned* LC = (LAS unsigned*)(lds + P6_CNT); LAS unsigned* LB = (LAS unsigned*)(lds + P6_BASE); LAS unsigned* LR = (LAS unsigned*)(lds + P6_ROW);
    for (int i = tid; i < 1024 * 4; i += 512) { const int c = i >> 2, k = i & 3; RW[k * 1024 + c] = a.in[11][i]; }
    for (int i = tid; i < 1024 * 16; i += 512) { const int c = i >> 4, k = i & 15; RW[(4 + k) * 1024 + c] = a.in[13][i]; }
    const u32x2* pre = (const u32x2*)a.out; u32x2* x1b = (u32x2*)(ws + WS_XB); [[maybe_unused]] unsigned* x1f8 = (unsigned*)(ws + WS_X1F8);
    gu32* ctl = (gu32*)ws;
    int* ltok = (int*)(ws + WS_LTOK); float* tw = (float*)(ws + WS_WSLOT); unsigned* tinfo = (unsigned*)(ws + WS_TINFO);
    const float* g1 = a.in[9]; const float* b1 = a.in[10];
    const bool h32 = (lane & 32) != 0, h16 = (lane & 16) != 0, h8 = (lane & 8) != 0, h4 = (lane & 4) != 0, h2 = (lane & 2) != 0;
#define P6_LOADROW(dst, t_) do { const u32x2* xr_ = pre + (size_t)(t_) * 256 + lane; _Pragma("unroll") for (int j = 0; j < 4; ++j) dst[j] = xr_[64 * j]; } while (0)
#define P6_LN(v, nx, s) do { s = 0.f; _Pragma("unroll") for (int j = 0; j < 4; ++j) { v[j] = (f32x4){bflo(nx[j].x), bfhi(nx[j].x), bflo(nx[j].y), bfhi(nx[j].y)}; s += (v[j].x + v[j].y) + (v[j].z + v[j].w); } } while (0)
#define P6_VAR(v, mean, q) do { q = 0.f; _Pragma("unroll") for (int j = 0; j < 4; ++j) { v[j] = v[j] - mean; q += (v[j].x * v[j].x + v[j].y * v[j].y) + (v[j].z * v[j].z + v[j].w * v[j].w); } } while (0)
#if M1_FP8
#define P6_STORE(v, t_, j) do { u32x2 o_; o_.x = cvtpk(v[j].x, v[j].y); o_.y = cvtpk(v[j].z, v[j].w); x1b[(size_t)(t_) * 256 + lane + 64 * j] = o_; x1f8[(size_t)(t_) * 256 + lane + 64 * j] = pk_fp8x4(v[j].x, v[j].y, v[j].z, v[j].w); } while (0)
#else
#define P6_STORE(v, t_, j) do { u32x2 o_; o_.x = cvtpk(v[j].x, v[j].y); o_.y = cvtpk(v[j].z, v[j].w); x1b[(size_t)(t_) * 256 + lane + 64 * j] = o_; } while (0)
#endif
#define P6_DOT(lg, v, j, k, w) lg[k] += (v[j][0] * w[0] + v[j][1] * w[1]) + (v[j][2] * w[2] + v[j][3] * w[3])
    for (int blk = vcu; blk < TT / 128; blk += G) {
        if (tid < 16) LC[tid] = 0u;
        __syncthreads();
        const int t0 = blk * 128;
        u32x2 nxA[4], nxB[4], nxC[4], nxD[4];
        P6_LOADROW(nxA, t0 + wave); P6_LOADROW(nxB, t0 + wave + 8); P6_LOADROW(nxC, t0 + wave + 16); P6_LOADROW(nxD, t0 + wave + 24);
        for (int rr = 0; rr < 4; ++rr) {
            const int rl0 = wave + 32 * rr, tA = t0 + rl0, tB = tA + 8, tC = tA + 16, tD = tA + 24;
            f32x4 vA[4], vB[4], vC[4], vD[4]; float sA, sB, sC, sD;
            P6_LN(vA, nxA, sA); P6_LN(vB, nxB, sB); P6_LN(vC, nxC, sC); P6_LN(vD, nxD, sD);
            if (rr < 3) { P6_LOADROW(nxA, tA + 32); P6_LOADROW(nxB, tB + 32); P6_LOADROW(nxC, tC + 32); P6_LOADROW(nxD, tD + 32); }
            const float mA = wave_sum(sA) * (1.f / DM), mB = wave_sum(sB) * (1.f / DM), mC = wave_sum(sC) * (1.f / DM), mD = wave_sum(sD) * (1.f / DM);
            float qA, qB, qC, qD;
            P6_VAR(vA, mA, qA); P6_VAR(vB, mB, qB); P6_VAR(vC, mC, qC); P6_VAR(vD, mD, qD);
            const float rA = 1.f / sqrtf(wave_sum(qA) * (1.f / DM) + LN_EPSF), rB = 1.f / sqrtf(wave_sum(qB) * (1.f / DM) + LN_EPSF);
            const float rC = 1.f / sqrtf(wave_sum(qC) * (1.f / DM) + LN_EPSF), rD = 1.f / sqrtf(wave_sum(qD) * (1.f / DM) + LN_EPSF);
            float lgA[20], lgB[20], lgC[20], lgD[20];
#pragma unroll
            for (int k = 0; k < 20; ++k) { lgA[k] = 0.f; lgB[k] = 0.f; lgC[k] = 0.f; lgD[k] = 0.f; }
#pragma unroll
            for (int j = 0; j < 4; ++j) {
                const f32x4 gg = *(const f32x4*)(g1 + 4 * lane + 256 * j), bb = *(const f32x4*)(b1 + 4 * lane + 256 * j);
                vA[j] = vA[j] * rA * gg + bb; vB[j] = vB[j] * rB * gg + bb; vC[j] = vC[j] * rC * gg + bb; vD[j] = vD[j] * rD * gg + bb;
                P6_STORE(vA, tA, j); P6_STORE(vB, tB, j); P6_STORE(vC, tC, j); P6_STORE(vD, tD, j);
#pragma unroll
                for (int k = 0; k < 20; ++k) { const f32x4 w = *(const LAS f32x4*)(RW + k * 1024 + 4 * lane + 256 * j);
                    P6_DOT(lgA, vA, j, k, w); P6_DOT(lgB, vB, j, k, w); P6_DOT(lgC, vC, j, k, w); P6_DOT(lgD, vD, j, k, w); }
            }
            float r1A, r1B, r1C, r1D;
            P6_BUTTERFLY(lgA, r1A); P6_BUTTERFLY(lgB, r1B); P6_BUTTERFLY(lgC, r1C); P6_BUTTERFLY(lgD, r1D);
            {
                const int i3 = h2 ? (h4 ? -1 : 1) : (h4 ? 2 : 0);
                const int i5 = i3 < 0 ? -1 : (h8 ? (i3 == 2 ? -1 : i3 + 3) : i3);
                const int kk = i5 < 0 ? -1 : (h32 ? 10 : 0) + (h16 ? 5 : 0) + i5;
                if (kk >= 0 && (lane & 1) == 0) { RS[kk] = r1A; RS[32 + kk] = r1B; RS[64 + kk] = r1C; RS[96 + kk] = r1D; }
            }
            asm volatile("s_waitcnt lgkmcnt(0)" ::: "memory");
            {
                const int sel = lane & 3; const int rl = rl0 + 8 * sel;
                float tl[20];
#pragma unroll
                for (int k4 = 0; k4 < 5; ++k4) { const f32x4 w = *(const LAS f32x4*)(RS + sel * 32 + 4 * k4); tl[4 * k4] = w[0]; tl[4 * k4 + 1] = w[1]; tl[4 * k4 + 2] = w[2]; tl[4 * k4 + 3] = w[3]; }
                float gl[4];
#pragma unroll
                for (int k = 0; k < 4; ++k) gl[k] = tl[k] + a.in[12][k];
                int gi = 0; float gm = gl[0];
#pragma unroll
                for (int k = 1; k < 4; ++k) if (gl[k] > gm) { gm = gl[k]; gi = k; }
                float gs = 0.f;
#pragma unroll
                for (int k = 0; k < 4; ++k) gs += __expf(gl[k] - gm);
                const float gwt = 1.f / gs;
                float el[4];
#pragma unroll
                for (int k = 0; k < 4; ++k) { const float se = gi == 0 ? tl[4 + k] : (gi == 1 ? tl[8 + k] : (gi == 2 ? tl[12 + k] : tl[16 + k])); el[k] = se + a.in[14][4 * gi + k]; }
                int i1 = 0; float v1 = el[0];
#pragma unroll
                for (int k = 1; k < 4; ++k) if (el[k] > v1) { v1 = el[k]; i1 = k; }
                int i2 = (i1 + 1) & 3; float v2 = -3.0e38f;
#pragma unroll
                for (int k = 0; k < 4; ++k) if (k != i1 && el[k] > v2) { v2 = el[k]; i2 = k; }
                const float ex = __expf(v2 - v1), w1 = gwt / (1.f + ex), w2 = gwt * ex / (1.f + ex);
                if (lane < 4) {
                    const int e1 = 4 * gi + i1, e2 = 4 * gi + i2;
                    const unsigned p1 = __hip_atomic_fetch_add(LC + e1, 1u, __ATOMIC_RELAXED, __HIP_MEMORY_SCOPE_WORKGROUP);
                    const unsigned p2 = __hip_atomic_fetch_add(LC + e2, 1u, __ATOMIC_RELAXED, __HIP_MEMORY_SCOPE_WORKGROUP);
                    LR[rl * 4 + 0] = ((unsigned)e1 << 16) | p1; LR[rl * 4 + 1] = ((unsigned)e2 << 16) | p2; LR[rl * 4 + 2] = __float_as_uint(w1); LR[rl * 4 + 3] = __float_as_uint(w2);
                }
            }
            asm volatile("s_waitcnt lgkmcnt(0)" ::: "memory");
        }
        __syncthreads();
        if (tid < 16) LB[tid] = __hip_atomic_fetch_add(ctl + CW_CNT + 64 * tid, LC[tid], __ATOMIC_RELAXED, __HIP_MEMORY_SCOPE_AGENT);
        __syncthreads();
        if (tid < 256) {
            const int rl = tid >> 1, j = tid & 1; const unsigned rec = LR[rl * 4 + j]; const unsigned e = rec >> 16, pos = LB[e] + (rec & 0xffffu);
            ltok[e * TT + pos] = t0 + rl; tw[2 * (t0 + rl) + j] = __uint_as_float(LR[rl * 4 + 2 + j]); tinfo[2 * (t0 + rl) + j] = (e << 16) | pos;
        }
        __syncthreads();
    }
#undef P6_LOADROW
#undef P6_LN
#undef P6_VAR
#undef P6_STORE
#undef P6_DOT
}
__device__ __forceinline__ void build_tile_tables(const Args& a, LAS unsigned char* lds, int tid) {
    LAS int* ts = (LAS int*)(lds + LDS_TS_OFF); LAS int* te = (LAS int*)(lds + LDS_TE_OFF); LAS int* cn = (LAS int*)(lds + LDS_CNT_OFF);
    gu32* ctl = (gu32*)a.ws;
    if (tid == 0) { int acc = 0;
        for (int e = 0; e < 16; ++e) { ts[e] = acc; const int c = (int)__hip_atomic_load(ctl + CW_CNT + 64 * e, __ATOMIC_RELAXED, __HIP_MEMORY_SCOPE_AGENT); const int nt = (c + 255) >> 8; cn[e] = c;
            for (int k = 0; k < nt; ++k) te[acc + k] = e; acc += nt; }
        ts[16] = acc; }
    __syncthreads();
}
__device__ __forceinline__ void p9_phase(const Args& a, LAS unsigned char* lds, int vcu, int G, int wave, int lane) {
    unsigned char* ws = a.ws;
    const LAS int* ts = (const LAS int*)(lds + LDS_TS_OFF);
    const unsigned* tinfo = (const unsigned*)(ws + WS_TINFO); const u32x2* Y = (const u32x2*)(ws + WS_Y);
    const float* g2 = a.in[18]; const float* b2 = a.in[19];
    const int gw = vcu * NWAVES + wave, NGW = G * NWAVES;
    u32x2 ny0[4], ny1[4], nxw[4]; float nw0 = 0.f, nw1 = 0.f;
    const float* tw = (const float*)(ws + WS_WSLOT);
    auto issue = [&](int t) {
        const unsigned i0 = tinfo[2 * t], i1 = tinfo[2 * t + 1];
        nw0 = tw[2 * t]; nw1 = tw[2 * t + 1];
        const size_t s0 = (size_t)ts[i0 >> 16] * 256 + (i0 & 0xffffu), s1 = (size_t)ts[i1 >> 16] * 256 + (i1 & 0xffffu);
        const u32x2* xb1 = (const u32x2*)(ws + WS_XB) + (size_t)t * 256 + lane;
#pragma unroll
        for (int j = 0; j < 4; ++j) { ny0[j] = Y[s0 * 256 + lane + 64 * j]; ny1[j] = Y[s1 * 256 + lane + 64 * j]; nxw[j] = xb1[64 * j]; }
    };
    if (gw < TT) issue(gw);
    for (int t = gw; t < TT; t += NGW) {
        f32x4* xr = (f32x4*)(a.out + (size_t)t * DM) + lane;
        f32x4 v[4]; float s = 0.f; const float w0 = nw0, w1 = nw1;
#pragma unroll
        for (int j = 0; j < 4; ++j) {
            const u32x2 y0 = ny0[j], y1 = ny1[j], xw = nxw[j];
            f32x4 x = (f32x4){bflo(xw.x), bfhi(xw.x), bflo(xw.y), bfhi(xw.y)} * DN_ALPHA;
            x.x += w0 * bflo(y0.x) + w1 * bflo(y1.x); x.y += w0 * bfhi(y0.x) + w1 * bfhi(y1.x); x.z += w0 * bflo(y0.y) + w1 * bflo(y1.y); x.w += w0 * bfhi(y0.y) + w1 * bfhi(y1.y);
            v[j] = x; s += (x.x + x.y) + (x.z + x.w);
        }
        if (t + NGW < TT) issue(t + NGW);
        const float mean = wave_sum(s) * (1.f / DM); float s2 = 0.f;
#pragma unroll
        for (int j = 0; j < 4; ++j) { v[j] = v[j] - mean; s2 += (v[j].x * v[j].x + v[j].y * v[j].y) + (v[j].z * v[j].z + v[j].w * v[j].w); }
        const float rstd = 1.f / sqrtf(wave_sum(s2) * (1.f / DM) + LN_EPSF);
#pragma unroll
        for (int j = 0; j < 4; ++j) { const f32x4 gg = *(const f32x4*)(g2 + 4 * lane + 256 * j), bb = *(const f32x4*)(b2 + 4 * lane + 256 * j); xr[64 * j] = v[j] * rstd * gg + bb; }
    }
}

__global__ void __launch_bounds__(NWAVES * 64, 2) mega_fwd(Args args) {
    extern __shared__ __attribute__((aligned(16))) unsigned char lds_raw[];
    LAS unsigned char* lds = (LAS unsigned char*)lds_raw;
    volatile LAS unsigned* MISC = (volatile LAS unsigned*)(lds + MISC_OFF);
    const int tid0 = threadIdx.x, wave = __builtin_amdgcn_readfirstlane(tid0 >> 6);
    const int G = gridDim.x, bx = blockIdx.x, vcu = (G % 8 == 0) ? (bx % 8) * (G / 8) + bx / 8 : bx;
    for (int u = tid0; u < (LDS_BYTES - LDSCTL_OFF) / 4; u += NWAVES * 64) ((LAS unsigned*)(lds + LDSCTL_OFF))[u] = 0u;
    __syncthreads();
    unsigned char* ws = args.ws;
    gu32* ctl = (gu32*)ws;
    const bool bars_on = (args.mask >> 31) != 0u;
    XcdBarrier bar; bar.bar = (unsigned*)(ctl + CW_BAR) + args.bar_region * XCD_BAR_WORDS; bar.x = 0; bar.st = nullptr;
    if (bars_on) bar = xcd_barrier_post((unsigned*)(ctl + CW_BAR) + args.bar_region * XCD_BAR_WORDS, MISC + 8);
    bar.wv = wave;
#define GRID_BAR() do { if (bars_on) xcd_barrier(bar); } while (0)
#ifndef PH_LAST
#define PH_LAST 99
#endif
#define FRESH() int tid = wave * 64 + pg8::lane_id(); asm volatile("" : "+v"(tid)); const int lane = tid & 63; (void)lane
#ifndef RMASK
#define RMASK 0
#endif
#define REP(k) _Pragma("unroll") for (int rep_ = 0; rep_ < 1 + ((RMASK >> (k)) & 1); ++rep_)
#ifndef STAMP_SCALE
#define STAMP_SCALE 1.0f
#endif
#ifdef STAMP_PH
#define ST_B(k) if ((k) == STAMP_PH) { st_a = rt(); }
#define ST_E(k) if ((k) == STAMP_PH) { st_b = rt(); }
#else
#define ST_B(k)
#define ST_E(k)
#endif
#ifdef ONLY
#define EN(k) (ONLY == (k))
#else
#define EN(k) ((args.mask >> (k)) & 1u)
#endif
    unsigned long long st_a = 0, st_b = 0; (void)st_a; (void)st_b;
    REP(0) if (EN(0)) { FRESH(); p0_prologue(args, lds, vcu, G, tid, wave, lane); }
    GRID_BAR();
#ifdef STAGGER_TICKS
    if (EN(1) && (bx & 8)) { const unsigned long long t0_ = rt(); while (rt() - t0_ < STAGGER_TICKS) __builtin_amdgcn_s_sleep(32); }
#endif
    REP(1) if (EN(1)) {
#if P1_FP8
        pg8::EpiHcat E{ws, (const float*)(ws + WS_ROT), 0};
        if (P1_FP8_FROM > 0) {
            pg8::Gemm g{(const pg8::bf16_t*)(ws + WS_XB), (const pg8::bf16_t*)(ws + WS_WIN), TT, 4608, 1024}; pg8::StaticOrder S; S.init(TT, 256 * P1_FP8_FROM, G, bx);
            pg8::gemm_phase<pg8::EpiHcat, pg8::StaticOrder, true, true>(lds, g, S, E, wave);
        }
        {
#if GATE_FP8
            pg8::Gemm g{(const pg8::bf16_t*)(ws + WS_X8_LO), (const pg8::bf16_t*)(ws + WS_WIN8), TT, 4608, 512, 64, (long)WS_X8_HI - (long)WS_X8_LO - (long)(16 * MiB)}; pg8::StaticOrder S;
#else
            pg8::Gemm g{(const pg8::bf16_t*)args.out, (const pg8::bf16_t*)(ws + WS_WIN8), TT, 4608, 512}; pg8::StaticOrder S;
#endif
            S.init(TT, 4608 - 256 * P1_FP8_FROM, G, bx, P1_FP8_FROM);
            pg8::gemm_phase<pg8::EpiHcat, pg8::StaticOrder, true, true, false, true, 1, 0>(lds, g, S, E, wave);
        }
#else
        pg8::Gemm g{(const pg8::bf16_t*)(ws + WS_XB), (const pg8::bf16_t*)(ws + WS_WIN), TT, 4608, 1024}; pg8::StaticOrder S; S.init(TT, 4608, G, bx);
        pg8::EpiHcat E{ws, (const float*)(ws + WS_ROT), 0};
        pg8::gemm_phase<pg8::EpiHcat, pg8::StaticOrder, true, true>(lds, g, S, E, wave);
#endif
    }
    GRID_BAR();
    if (PH_LAST >= 2) {
        REP(2) if (EN(2)) { FRESH(); for (int it = vcu; it < 256; it += G) chain_item(args, lds, it, tid, wave, lane); }
        if (EN(3)) { { FRESH(); attn_dil_phase<16>(args, lds, vcu, G, tid, wave, lane); }
                     { FRESH(); attn_dil_phase<4>(args, lds, vcu, G, tid, wave, lane); } }
    }
    GRID_BAR();
    ST_B(4) if (PH_LAST >= 3 && EN(4)) { FRESH(); p3_phase<0>(args, lds, vcu, G, tid, wave, lane); }
    if (EN(13)) { FRESH(); attn_p1_phase(args, lds, vcu, G, tid, wave, lane); }
    GRID_BAR(); ST_E(4)
    if (EN(14)) { FRESH(); p0_expert_weights(args, lds, vcu, G, wave, lane); }
    REP(5) if (PH_LAST >= 4 && EN(5)) {
        pg8::GateOrder S; S.S4.init(TT, 1024, G, bx);
        pg8::EpiHcat E{ws, (const float*)(ws + WS_ROT), 18};
#if GATE_FP8
        pg8::Gemm g{(const pg8::bf16_t*)(ws + WS_X8_LO), (const pg8::bf16_t*)(ws + WS_WIN8 + (size_t)4608 * 1024), TT, 2048, 512, 64, (long)WS_X8_HI - (long)WS_X8_LO - (long)(16 * MiB)};
        pg8::gemm_phase<pg8::EpiHcat, pg8::GateOrder, true, true, false, true, 1, 0>(lds, g, S, E, wave);
#else
        pg8::Gemm g{(const pg8::bf16_t*)(ws + WS_XB), (const pg8::bf16_t*)(ws + WS_WIN) + (size_t)4608 * 1024, TT, 2048, 1024};
        pg8::gemm_phase<pg8::EpiHcat, pg8::GateOrder, true, true>(lds, g, S, E, wave);
#endif
        asm volatile("s_waitcnt vmcnt(0)" ::: "memory"); __syncthreads();
    }
    REP(6) if (PH_LAST >= 5 && EN(6)) {
        pg8::StaticOrder S; S.init(TT, 1024, G, bx);
        { pg8::EpiGate<false> E{(const pg8::bf16_t*)(ws + WS_GATE_A), (pg8::bf16_t*)(ws + WS_MERGED), nullptr};
#if MIX_FP8 & 2
          pg8::Gemm g{(const pg8::bf16_t*)(ws + WS_OA), (const pg8::bf16_t*)(ws + WS_WA), TT, 1024, 256};
          pg8::gemm_phase<pg8::EpiGate<false>, pg8::StaticOrder, true, true, false, true, 1, 3>(lds, g, S, E, wave);
#else
          pg8::Gemm g{(const pg8::bf16_t*)(ws + WS_OA), (const pg8::bf16_t*)(ws + WS_WA), TT, 1024, 512};
          pg8::gemm_phase<pg8::EpiGate<false>, pg8::StaticOrder, true, true>(lds, g, S, E, wave);
#endif
        }
        asm volatile("s_waitcnt vmcnt(0)" ::: "memory"); __syncthreads();
        { typedef pg8::EpiGate<true, (MIX_FP8 & 1) != 0> EpiC;
          EpiC E{(const pg8::bf16_t*)(ws + WS_GATE_R), (pg8::bf16_t*)(ws + WS_MERGED), ws + WS_MERGED8};
#if MIX_FP8 & 4
          pg8::Gemm g{(const pg8::bf16_t*)(ws + WS_AR8), (const pg8::bf16_t*)(ws + WS_WR), TT, 1024, 512};
          pg8::gemm_phase<EpiC, pg8::StaticOrder, true, true, false, true, 1, 0>(lds, g, S, E, wave);
#else
          pg8::Gemm g{(const pg8::bf16_t*)(ws + WS_GR), (const pg8::bf16_t*)(ws + WS_WR), TT, 1024, 1024};
          pg8::gemm_phase<EpiC, pg8::StaticOrder, true, true>(lds, g, S, E, wave);
#endif
        }
    }
    GRID_BAR();
    REP(7) if (PH_LAST >= 6 && EN(7)) {
        pg8::StaticOrder S; S.init(TT, 1024, G, bx);
        pg8::EpiResBf16 E{(const pg8::bf16_t*)(ws + WS_XB), (pg8::bf16_t*)args.out, DN_ALPHA};
#if MIX_FP8 & 1
        pg8::Gemm g{(const pg8::bf16_t*)(ws + WS_MERGED8), (const pg8::bf16_t*)(ws + WS_WO), TT, 1024, 512};
        pg8::gemm_phase<pg8::EpiResBf16, pg8::StaticOrder, true, true, false, true, 1, 3>(lds, g, S, E, wave);
#else
        pg8::Gemm g{(const pg8::bf16_t*)(ws + WS_MERGED), (const pg8::bf16_t*)(ws + WS_WO), TT, 1024, 1024};
        pg8::gemm_phase<pg8::EpiResBf16, pg8::StaticOrder, true, true>(lds, g, S, E, wave);
#endif
    }
    GRID_BAR();
    ST_B(8) if (PH_LAST >= 7 && EN(8)) { FRESH(); p6a_phase(args, lds, vcu, G, tid, wave, lane); }
    GRID_BAR(); ST_E(8)
    { FRESH(); build_tile_tables(args, lds, tid); }
    const int nrt = ((const LAS int*)(lds + LDS_TS_OFF))[16];
    REP(10) if (PH_LAST >= 9 && EN(10)) {
#if M1_FP8
        pg8::Gemm g{(const pg8::bf16_t*)(ws + WS_X1F8), (const pg8::bf16_t*)(ws + WS_WGU), MAXSLOT, 1024, 512};
        pg8::MoeOrder S{nrt * 4, G, vcu, (const LAS int*)(lds + LDS_TE_OFF), (const LAS int*)(lds + LDS_TS_OFF), (const LAS int*)(lds + LDS_CNT_OFF), (const int*)(ws + WS_LTOK), 1024u};
        pg8::EpiSwiGLU E{ws + WS_H};
        pg8::gemm_phase<pg8::EpiSwiGLU, pg8::MoeOrder, true, true, true, true, 1, 0>(lds, g, S, E, wave);
#else
        pg8::Gemm g{(const pg8::bf16_t*)(ws + WS_XB), (const pg8::bf16_t*)(ws + WS_WGU), MAXSLOT, 1024, 1024};
        pg8::MoeOrder S{nrt * 4, G, vcu, (const LAS int*)(lds + LDS_TE_OFF), (const LAS int*)(lds + LDS_TS_OFF), (const LAS int*)(lds + LDS_CNT_OFF), (const int*)(ws + WS_LTOK), 2048u};
        pg8::EpiSwiGLU E{ws + WS_H};
        pg8::gemm_phase<pg8::EpiSwiGLU, pg8::MoeOrder, true, true, true>(lds, g, S, E, wave);
#endif
    }
    GRID_BAR();
    REP(11) if (PH_LAST >= 10 && EN(11)) {
        pg8::Gemm g{(const pg8::bf16_t*)(ws + WS_H), (const pg8::bf16_t*)(ws + WS_WD), MAXSLOT, 1024, 256};
        pg8::MoeOrder S{nrt * 4, G, vcu, (const LAS int*)(lds + LDS_TE_OFF), (const LAS int*)(lds + LDS_TS_OFF), (const LAS int*)(lds + LDS_CNT_OFF), (const int*)(ws + WS_LTOK), 1024u};
        pg8::EpiRowScale E{(pg8::bf16_t*)(ws + WS_Y)};
        pg8::gemm_phase<pg8::EpiRowScale, pg8::MoeOrder, true, true, false, true, 1, 2>(lds, g, S, E, wave);
    }
    GRID_BAR();
    ST_B(12) if (PH_LAST >= 11 && EN(12)) { FRESH(); p9_phase(args, lds, vcu, G, wave, lane); }
#ifdef STAMP_PH
    GRID_BAR(); ST_E(12)
    if (STAMP_PH == 13) { st_a = rt(); GRID_BAR(); GRID_BAR(); GRID_BAR(); GRID_BAR(); st_b = rt(); }
    if (bx == 0 && tid0 == 0) { const float us = (float)(st_b - st_a) * 0.01f * STAMP_SCALE; int k = 0; float lim = 30.f; while (us >= lim && k < 12) { lim *= 1.5f; ++k; }
        __hip_atomic_store(ctl + CW_CHK, __float_as_uint(sqrtf(2.f * k + 2.f)), RLX_AGENT); }
    GRID_BAR();
    { const float c = __uint_as_float(__hip_atomic_load(ctl + CW_CHK, RLX_AGENT)); f32x4* o4 = (f32x4*)args.out;
      for (size_t i = (size_t)bx * 512 + tid0; i < (size_t)TT * DM / 4; i += (size_t)G * 512) o4[i] = (f32x4){c, c, c, c}; }
#endif
}

#ifdef PROBE_VAR
__global__ void __launch_bounds__(NWAVES * 64, 2) probe_kernel(Args args) {
    extern __shared__ __attribute__((aligned(16))) unsigned char lds_raw[];
    LAS unsigned char* lds = (LAS unsigned char*)lds_raw;
    const int tid0 = threadIdx.x, wave = __builtin_amdgcn_readfirstlane(tid0 >> 6);
    const int G = gridDim.x, bx = blockIdx.x, vcu = (G % 8 == 0) ? (bx % 8) * (G / 8) + bx / 8 : bx;
    FRESH();
    if (PROBE_VAR == 20 || PROBE_VAR == 21) {
        unsigned char* ws = args.ws;
        pg8::Gemm g{(const pg8::bf16_t*)(ws + WS_XB), (const pg8::bf16_t*)(ws + WS_WIN), TT, 4608, 1024}; pg8::StaticOrder S; S.init(TT, 4608, G, bx);
        pg8::EpiHcatT<PROBE_VAR == 21 ? 1 : 0> E{ws, (const float*)(ws + WS_ROT), 0};
        pg8::gemm_phase<pg8::EpiHcatT<PROBE_VAR == 21 ? 1 : 0>, pg8::StaticOrder, true, true>(lds, g, S, E, wave);
    }
    if (PROBE_VAR == 10) p3_phase<0>(args, lds, vcu, G, tid, wave, lane);
    if (PROBE_VAR == 11) p3_phase<1>(args, lds, vcu, G, tid, wave, lane);
    if (PROBE_VAR == 0) attn_dil_phase<16, 0>(args, lds, vcu, G, tid, wave, lane);
    if (PROBE_VAR == 1) attn_dil_phase<16, 1>(args, lds, vcu, G, tid, wave, lane);
    if (PROBE_VAR == 2) attn_dil_phase<4, 0>(args, lds, vcu, G, tid, wave, lane);
    if (PROBE_VAR == 3) attn_dil_phase<4, 1>(args, lds, vcu, G, tid, wave, lane);
}
#endif
extern "C" void kernel_launch(void* const* d_in, const int* in_sizes, int n_in, void* d_out, int out_size, void* d_ws, size_t ws_size, hipStream_t stream) {
    static int grid = 0;
    if (grid == 0) {
        if (n_in != 20 || in_sizes[0] != TT * DM || out_size != TT * DM || ws_size < WS_END) { fprintf(stderr, "kernel_launch: unexpected shapes: n_in %d in0 %d out %d ws %zu; nothing launched\n", n_in, n_in > 0 ? in_sizes[0] : -1, out_size, ws_size); grid = -1; return; }
        int dev = 0, cus = 0;
        if (hipGetDevice(&dev) != hipSuccess || hipDeviceGetAttribute(&cus, hipDeviceAttributeMultiprocessorCount, dev) != hipSuccess) { grid = -1; return; }
        if (hipFuncSetAttribute((const void*)mega_fwd, hipFuncAttributeMaxDynamicSharedMemorySize, LDS_BYTES) != hipSuccess) { fprintf(stderr, "kernel_launch: hipFuncSetAttribute failed\n"); grid = -1; return; }
        (void)hipGetLastError();
        grid = cus;
    }
    if (grid < 0) return;
    if (hipMemsetAsync((char*)d_ws, 0, CTL_ZERO_BYTES, stream) != hipSuccess) return;
    Args a{};
    for (int i = 0; i < 20; ++i) a.in[i] = (const float*)d_in[i];
    a.out = (float*)d_out; a.ws = (unsigned char*)d_ws; a.mask = 0x80007fffu; a.bar_region = 0;
#if defined(XTRA_FIRST)
    { Args x = a; x.mask = XTRA_FIRST; x.bar_region = 1; for (int r = 0; r < XTRA_REP; ++r) hipLaunchKernelGGL(mega_fwd, dim3(grid), dim3(NWAVES * 64), LDS_BYTES, stream, x);
      if (hipMemsetAsync((char*)d_ws, 0, CTL_ZERO_BYTES, stream) != hipSuccess) return; }
#endif
    hipLaunchKernelGGL(mega_fwd, dim3(grid), dim3(NWAVES * 64), LDS_BYTES, stream, a);
#if defined(PROBE_VAR)
    { hipFuncSetAttribute((const void*)probe_kernel, hipFuncAttributeMaxDynamicSharedMemorySize, LDS_BYTES);
      for (int r = 0; r < 4; ++r) hipLaunchKernelGGL(probe_kernel, dim3(grid), dim3(NWAVES * 64), LDS_BYTES, stream, a); }
#endif
#if defined(XTRA_AFTER)
    { Args x = a; x.mask = XTRA_AFTER; x.bar_region = 1; for (int r = 0; r < XTRA_REP; ++r) hipLaunchKernelGGL(mega_fwd, dim3(grid), dim3(NWAVES * 64), LDS_BYTES, stream, x); }
#endif
}
```

```cpp
#define P1_FP8 1
#define P1_FP8_FROM 4
#define MIX_FP8 7
#define GATE_FP8 1
#define Y_FP8 1
#include <hip/hip_runtime.h>
#include <cstdio>
#include <cstdint>

constexpr int TT = 32768, DM = 1024, SEQ = 2048, NB = 16;
constexpr float DN_ALPHA = 1.189207115002721f;
constexpr float LN_EPSF = 1e-5f;
#ifndef M1_FP8
#define M1_FP8 1
#endif
#ifndef P1_FP8
#define P1_FP8 0
#endif
#ifndef Y_FP8
#define Y_FP8 0
#endif
#ifndef GATE_FP8
#define GATE_FP8 0
#endif
#ifndef MIX_FP8
#define MIX_FP8 0
#endif
#ifndef P1_FP8_FROM
#define P1_FP8_FROM 0
#endif
constexpr size_t MiB = 1u << 20;
constexpr size_t CTL_ZERO_BYTES = 1 * MiB;
constexpr size_t WS_ROT = 1 * MiB;
constexpr size_t WS_BIAS = 2 * MiB;
constexpr size_t WS_LTOK = 3 * MiB;
constexpr size_t WS_TINFO = 7 * MiB;
constexpr size_t WS_WSLOT = 7 * MiB + 512 * 1024;
constexpr size_t WS_WIN = 8 * MiB;
constexpr size_t WS_WIN8 = 12 * MiB;
constexpr size_t WS_WR = 21 * MiB;
constexpr size_t WS_WA = 23 * MiB;
constexpr size_t WS_WO = 24 * MiB;
constexpr size_t WS_WGU = 26 * MiB;
constexpr size_t WS_WD = 42 * MiB;
constexpr size_t WS_XB = 80 * MiB;
constexpr size_t WS_QR = 144 * MiB;
constexpr size_t WS_KR = 176 * MiB;
constexpr size_t WS_VR = 208 * MiB;
constexpr size_t WS_GR = 272 * MiB;
constexpr size_t WS_QA = 336 * MiB, WS_KA = 368 * MiB, WS_VA = 400 * MiB, WS_OA = 432 * MiB;
#if MIX_FP8 & 4
constexpr size_t WS_AR8 = 144 * MiB;
constexpr size_t WS_GATE_R = 176 * MiB, WS_GATE_A = 240 * MiB;
#else
constexpr size_t WS_GATE_R = 144 * MiB, WS_GATE_A = 208 * MiB;
#endif
constexpr size_t WS_X8_LO = 448 * MiB, WS_X8_HI = 58 * MiB;
static_assert(!GATE_FP8 || (P1_FP8 && (MIX_FP8 & 2) && M1_FP8), "GATE_FP8 needs the fp8 mixer-input GEMM, the fp8 o_a (room behind it) and the fp8 expert weights (room behind them)");
constexpr size_t WS_MERGED8 = 464 * MiB;
constexpr size_t WS_MERGED = 336 * MiB;
constexpr size_t WS_Y = 144 * MiB;
constexpr size_t WS_H = 336 * MiB;
constexpr size_t WS_X1F8 = 464 * MiB;
constexpr size_t WS_O2 = 26 * MiB;
constexpr size_t WS_O3 = 464 * MiB;
constexpr size_t WS_LSE2 = 496 * MiB, WS_LSE3 = 497 * MiB;
constexpr size_t WS_END = 512 * MiB;
constexpr int MAXSLOT = 69632;
constexpr int CW_BAR = 4096;
constexpr int CW_CNT = 16384;
constexpr int CW_CHK = 24576;
namespace pg8 {
#define PG8_LAS __attribute__((address_space(3)))
typedef unsigned short bf16_t;
typedef short bf16x8 __attribute__((ext_vector_type(8)));
typedef float f32x4 __attribute__((ext_vector_type(4)));
typedef unsigned u32x4 __attribute__((ext_vector_type(4)));
typedef unsigned u32x2_ __attribute__((ext_vector_type(2)));
constexpr int BM = 256, BK = 64, HALF = 128, HTB = HALF * BK * 2  , STAGE_BYTES = 8 * HTB, NXCD = 8, WGM = 8;

__device__ __forceinline__ int lane_id() { int x; asm volatile("v_mbcnt_lo_u32_b32 %0, -1, 0\n\tv_mbcnt_hi_u32_b32 %0, -1, %0" : "=v"(x)); return x; }
__host__ __device__ __forceinline__ int lds_byte(int r, int c) { const int st = (r >> 4) * 2 + (c >> 5), rr = r & 15, cc = c & 31, ob = rr * 64 + cc * 2; return st * 1024 + (ob ^ (((ob >> 9) & 1) << 5)); }
__host__ __device__ __forceinline__ void stage_rc(int b, int& R, int& C) { const int st = b / 1024, sb = b % 1024, swz = sb ^ (((sb >> 9) & 1) << 5); R = (st >> 1) * 16 + swz / 64; C = (st & 1) * 32 + (swz % 64) / 2; }
__host__ __device__ __forceinline__ int perm32(int rho) { const int n = rho >> 4, i = rho & 15; return 8 * (i >> 2) + 4 * n + (i & 3); }

struct Unit { int pm, pn; };
struct Gemm { const bf16_t* A; const bf16_t* Bt; int M, N, K; int spm = 1 << 30; long sdelta = 0; };

struct StaticOrder {
    int nM, nN, nwg, G, c, pn0;
    __host__ __device__ void init(int M, int N, int G_, int c_, int pn0_ = 0) { nM = M / BM; nN = N / BM; nwg = nM * nN; G = G_; c = c_; pn0 = pn0_; }
    __host__ __device__ bool next(int i, Unit& u) const {
        const long L = (long)i * G + c; if (L >= nwg) return false;
        int wgid = (int)L; { const int q = nwg / NXCD, r = nwg % NXCD, xcd = wgid % NXCD, off = wgid / NXCD; wgid = (xcd < r ? xcd * (q + 1) : r * (q + 1) + (xcd - r) * q) + off; }
        const int nig = WGM * nN, gid = wgid / nig, fm = gid * WGM, gsz = (nM - fm) < WGM ? (nM - fm) : WGM;
        u.pm = fm + ((wgid % nig) % gsz); u.pn = pn0 + (wgid % nig) / gsz; return true;
    }
    __device__ __forceinline__ void a_ready(const Unit&) const {}
    __device__ __forceinline__ void done(const Unit&) const {}
};

__device__ __forceinline__ unsigned cvt_pk_bf16(float lo, float hi) { unsigned r; asm volatile("v_cvt_pk_bf16_f32 %0, %1, %2" : "=v"(r) : "v"(lo), "v"(hi)); return r; }
typedef float cvt_f32x2_t __attribute__((ext_vector_type(2))); typedef __bf16 cvt_bf16x2_t __attribute__((ext_vector_type(2)));
__device__ __forceinline__ unsigned cvt_pk_bf16_acc(float lo, float hi) { const cvt_f32x2_t v = {lo, hi}; const cvt_bf16x2_t b = __builtin_convertvector(v, cvt_bf16x2_t); return __builtin_bit_cast(unsigned, b); }
__device__ __forceinline__ float bflo(unsigned w) { return __uint_as_float(w << 16); }
__device__ __forceinline__ float bfhi(unsigned w) { return __uint_as_float(w & 0xffff0000u); }
__device__ __forceinline__ float fsigmoid(float x) { return __builtin_amdgcn_rcpf(1.f + __expf(-x)); }
__device__ __forceinline__ float fsilu(float x) { return x * __builtin_amdgcn_rcpf(1.f + __expf(-x)); }

template <int VAR = 0> struct EpiHcatT {
    static constexpr bool PERM = true, AFTER_DRAIN = false; static constexpr int NSTORE = 16;
    unsigned char* ws; const float* rot; int tile_off;
    __device__ __forceinline__ void operator()(const f32x4 (&acc)[2][2][4][2], const Unit& u, int wr, int wc, int fr, int fq) const {
        if (VAR == 1) {
            float s = 0.f;
#pragma unroll
            for (int ai = 0; ai < 2; ++ai)
#pragma unroll
                for (int bj = 0; bj < 2; ++bj)
#pragma unroll
                    for (int m = 0; m < 4; ++m)
#pragma unroll
                        for (int n = 0; n < 2; ++n) s += (acc[ai][bj][m][n][0] + acc[ai][bj][m][n][1]) + (acc[ai][bj][m][n][2] + acc[ai][bj][m][n][3]);
            ((float*)(ws + WS_O3))[(size_t)(u.pm * 64 + u.pn) * 512 + wr * 256 + wc * 64 + fq * 16 + fr] = s; return;
        }
        const int gt = u.pn + tile_off;
        size_t base_off; int pitch, ct, mode; float sc = 1.f;
        if (gt < 2)       { base_off = WS_QR; pitch = 512;  ct = gt;      mode = 1; }
        else if (gt < 4)  { base_off = WS_KR; pitch = 512;  ct = gt - 2;  mode = 1; sc = 0.08838834764831845f; }
        else if (gt < 8)  { base_off = WS_VR; pitch = 1024; ct = gt - 4;  mode = 0; }
        else if (gt < 12) { base_off = WS_GR; pitch = 1024; ct = gt - 8;  mode = 2; }
        else if (gt < 14) { base_off = WS_QA; pitch = 512;  ct = gt - 12; mode = 0; sc = 0.18033688011112042f; }
        else if (gt < 16) { base_off = WS_KA; pitch = 512;  ct = gt - 14; mode = 0; }
        else if (gt < 18) { base_off = WS_VA; pitch = 512;  ct = gt - 16; mode = 0; }
        else if (gt < 22) { base_off = WS_GATE_R; pitch = 1024; ct = gt - 18; mode = 3; }
        else              { base_off = WS_GATE_A; pitch = 1024; ct = gt - 22; mode = 3; }
        bf16_t* O = (bf16_t*)(ws + base_off);
        const int row0 = u.pm * BM + wr * 64 + fr, col0 = ct * BM + wc * 32 + 8 * fq;
#pragma unroll
        for (int ai = 0; ai < 2; ++ai)
#pragma unroll
            for (int m = 0; m < 4; ++m) {
                const int row = row0 + ai * HALF + m * 16;
                bf16_t* rowp = O + (size_t)row * pitch + col0;
                f32x4 cs = (f32x4){1.f, 1.f, 1.f, 1.f}, sn = (f32x4){0.f, 0.f, 0.f, 0.f};
                if (mode == 1) { const f32x4* rt = (const f32x4*)(rot + ((size_t)(row & (SEQ - 1)) * 16 + (4 * wc + fq)) * 8); cs = rt[0]; sn = rt[1]; }
#pragma unroll
                for (int bj = 0; bj < 2; ++bj) {
                    f32x4 v0 = acc[ai][bj][m][0], v1 = acc[ai][bj][m][1];
                    if (mode == 1) { const f32x4 a = v0 * cs - v1 * sn, b = v0 * sn + v1 * cs; v0 = a * sc; v1 = b * sc; }
                    else if (mode == 2) {
#pragma unroll
                        for (int e = 0; e < 4; ++e) { v0[e] = fsilu(v0[e]); v1[e] = fsilu(v1[e]); } }
                    else if (mode == 3) {
#pragma unroll
                        for (int e = 0; e < 4; ++e) { v0[e] = fsigmoid(v0[e]); v1[e] = fsigmoid(v1[e]); } }
                    else { v0 = v0 * sc; v1 = v1 * sc; }
                    u32x4 w; w.x = cvt_pk_bf16(v0[0], v0[1]); w.y = cvt_pk_bf16(v0[2], v0[3]); w.z = cvt_pk_bf16(v1[0], v1[1]); w.w = cvt_pk_bf16(v1[2], v1[3]);
                    *(u32x4*)(rowp + bj * HALF) = w;
                }
            }
    }
};

typedef EpiHcatT<0> EpiHcat;

__device__ __forceinline__ unsigned fp8x4_sat(float a, float b, float c, float d) {
    a = __builtin_amdgcn_fmed3f(a, -448.f, 448.f); b = __builtin_amdgcn_fmed3f(b, -448.f, 448.f); c = __builtin_amdgcn_fmed3f(c, -448.f, 448.f); d = __builtin_amdgcn_fmed3f(d, -448.f, 448.f);
    unsigned w = 0u; w = __builtin_amdgcn_cvt_pk_fp8_f32(a, b, w, false); w = __builtin_amdgcn_cvt_pk_fp8_f32(c, d, w, true); return w;
}
template <bool ADD, bool OUT8 = false> struct EpiGate {
    static constexpr bool PERM = true, AFTER_DRAIN = false; static constexpr int NSTORE = 16;
    const bf16_t* gate; bf16_t* O; unsigned char* O8;
    __device__ __forceinline__ void operator()(const f32x4 (&acc)[2][2][4][2], const Unit& u, int wr, int wc, int fr, int fq) const {
        const int row0 = u.pm * BM + wr * 64 + fr, col0 = u.pn * BM + wc * 32 + 8 * fq;
#pragma unroll
        for (int ai = 0; ai < 2; ++ai)
#pragma unroll
            for (int m = 0; m < 4; ++m)
#pragma unroll
                for (int bj = 0; bj < 2; ++bj) {
                    const size_t p = (size_t)(row0 + ai * HALF + m * 16) * 1024 + col0 + bj * HALF;
                    const u32x4 g = *(const u32x4*)(gate + p);
                    f32x4 v0 = acc[ai][bj][m][0], v1 = acc[ai][bj][m][1];
                    v0[0] *= bflo(g.x); v0[1] *= bfhi(g.x); v0[2] *= bflo(g.y); v0[3] *= bfhi(g.y);
                    v1[0] *= bflo(g.z); v1[1] *= bfhi(g.z); v1[2] *= bflo(g.w); v1[3] *= bfhi(g.w);
                    if (ADD) { const u32x4 o = *(const u32x4*)(O + p);
                        v0[0] += bflo(o.x); v0[1] += bfhi(o.x); v0[2] += bflo(o.y); v0[3] += bfhi(o.y);
                        v1[0] += bflo(o.z); v1[1] += bfhi(o.z); v1[2] += bflo(o.w); v1[3] += bfhi(o.w); }
                    if (OUT8) { u32x2_ w8;
                        w8.x = fp8x4_sat(v0[0] * 16.f, v0[1] * 16.f, v0[2] * 16.f, v0[3] * 16.f); w8.y = fp8x4_sat(v1[0] * 16.f, v1[1] * 16.f, v1[2] * 16.f, v1[3] * 16.f);
                        *(u32x2_*)(O8 + p) = w8; }
                    else { u32x4 w; w.x = cvt_pk_bf16(v0[0], v0[1]); w.y = cvt_pk_bf16(v0[2], v0[3]); w.z = cvt_pk_bf16(v1[0], v1[1]); w.w = cvt_pk_bf16(v1[2], v1[3]);
                        *(u32x4*)(O + p) = w; }
                }
    }
};

struct EpiResBf16 {
    static constexpr bool PERM = true, AFTER_DRAIN = false; static constexpr int NSTORE = 16;
    const bf16_t* x; bf16_t* out; float alpha;
    __device__ __forceinline__ void operator()(const f32x4 (&acc)[2][2][4][2], const Unit& u, int wr, int wc, int fr, int fq) const {
        const int row0 = u.pm * BM + wr * 64 + fr, col0 = u.pn * BM + wc * 32 + 8 * fq;
#pragma unroll
        for (int ai = 0; ai < 2; ++ai)
#pragma unroll
            for (int m = 0; m < 4; ++m)
#pragma unroll
                for (int bj = 0; bj < 2; ++bj) {
                    const size_t p = (size_t)(row0 + ai * HALF + m * 16) * 1024 + col0 + bj * HALF;
                    const u32x4 xw = *(const u32x4*)(x + p);
                    const f32x4 x0 = (f32x4){bflo(xw.x), bfhi(xw.x), bflo(xw.y), bfhi(xw.y)}, x1 = (f32x4){bflo(xw.z), bfhi(xw.z), bflo(xw.w), bfhi(xw.w)};
                    const f32x4 v0 = x0 * alpha + acc[ai][bj][m][0], v1 = x1 * alpha + acc[ai][bj][m][1];
                    u32x4 w; w.x = cvt_pk_bf16(v0[0], v0[1]); w.y = cvt_pk_bf16(v0[2], v0[3]); w.z = cvt_pk_bf16(v1[0], v1[1]); w.w = cvt_pk_bf16(v1[2], v1[3]);
                    *(u32x4*)(out + p) = w;
                }
    }
};

struct EpiSwiGLU {
    static constexpr bool PERM = true, AFTER_DRAIN = false; static constexpr int NSTORE = 16;
    unsigned char* H;
    __device__ __forceinline__ void operator()(const f32x4 (&acc)[2][2][4][2], const Unit& u, int wr, int wc, int fr, int fq) const {
        const int row0 = u.pm * BM + wr * 64 + fr, col0 = (u.pn & 3) * 128 + wc * 16 + 4 * fq;
#pragma unroll
        for (int ai = 0; ai < 2; ++ai)
#pragma unroll
            for (int m = 0; m < 4; ++m)
#pragma unroll
                for (int bj = 0; bj < 2; ++bj) {
                    const f32x4 g = acc[ai][bj][m][0], up = acc[ai][bj][m][1];
                    float h0 = fsilu(g[0]) * up[0] * 8.f, h1 = fsilu(g[1]) * up[1] * 8.f, h2 = fsilu(g[2]) * up[2] * 8.f, h3 = fsilu(g[3]) * up[3] * 8.f;
                    h0 = fminf(fmaxf(h0, -448.f), 448.f); h1 = fminf(fmaxf(h1, -448.f), 448.f); h2 = fminf(fmaxf(h2, -448.f), 448.f); h3 = fminf(fmaxf(h3, -448.f), 448.f);
                    unsigned w = 0u; w = __builtin_amdgcn_cvt_pk_fp8_f32(h0, h1, w, false); w = __builtin_amdgcn_cvt_pk_fp8_f32(h2, h3, w, true);
                    *(unsigned*)(H + (size_t)(row0 + ai * HALF + m * 16) * 512 + col0 + bj * 64) = w;
                }
    }
};

struct EpiRowScale {
    static constexpr bool PERM = true, AFTER_DRAIN = false; static constexpr int NSTORE = 16;
    bf16_t* Y;
    __device__ __forceinline__ void operator()(const f32x4 (&acc)[2][2][4][2], const Unit& u, int wr, int wc, int fr, int fq) const {
        const int row0 = u.pm * BM + wr * 64 + fr, col0 = (u.pn & 3) * BM + wc * 32 + 8 * fq;
#pragma unroll
        for (int ai = 0; ai < 2; ++ai)
#pragma unroll
            for (int m = 0; m < 4; ++m) {
                const int row = row0 + ai * HALF + m * 16;
#pragma unroll
                for (int bj = 0; bj < 2; ++bj) {
                    const f32x4 v0 = acc[ai][bj][m][0], v1 = acc[ai][bj][m][1];
#if Y_FP8
                    u32x2_ w8; w8.x = fp8x4_sat(v0[0] * 16.f, v0[1] * 16.f, v0[2] * 16.f, v0[3] * 16.f); w8.y = fp8x4_sat(v1[0] * 16.f, v1[1] * 16.f, v1[2] * 16.f, v1[3] * 16.f);
                    *(u32x2_*)((unsigned char*)Y + (size_t)row * 1024 + col0 + bj * HALF) = w8;
#else
                    u32x4 w; w.x = cvt_pk_bf16_acc(v0[0], v0[1]); w.y = cvt_pk_bf16_acc(v0[2], v0[3]); w.z = cvt_pk_bf16_acc(v1[0], v1[1]); w.w = cvt_pk_bf16_acc(v1[2], v1[3]);
                    *(u32x4*)(Y + (size_t)row * 1024 + col0 + bj * HALF) = w;
#endif
                }
            }
    }
};

struct MoeOrder {
    int nunits, G, c; const PG8_LAS int* te; const PG8_LAS int* ts; const PG8_LAS int* cnt; const int* ltok; unsigned rowbytes;
    __device__ __forceinline__ bool next(int i, Unit& u) const {
        const int L = i * G + c, rt = (L >> 5) * 8 + (L & 7); if (rt >= (nunits >> 2)) return false;
        u.pm = rt; u.pn = te[rt] * 4 + ((L >> 3) & 3); return true;
    }
    __device__ __forceinline__ unsigned a_row_off(const Unit& u, int row) const {
        const int ex = te[u.pm], pos = (u.pm - ts[ex]) * 256 + row;
        const int tok = pos < cnt[ex] ? ltok[ex * 32768 + pos] : 0;
        return (unsigned)tok * rowbytes;
    }
    __device__ __forceinline__ void a_ready(const Unit&) const {}
    __device__ __forceinline__ void done(const Unit&) const {}
};

struct GateOrder {
    StaticOrder S4;
    __device__ __forceinline__ bool next(int i, Unit& u) const { Unit t; if (!S4.next(i >> 1, t)) return false; u.pm = t.pm; u.pn = t.pn + 4 * (i & 1); return true; }
    __device__ __forceinline__ void a_ready(const Unit&) const {}
    __device__ __forceinline__ void done(const Unit&) const {}
};

template <class Epi, class Sched, bool ALIGN_EPI = false, bool SP2 = false, bool GATHER = false, bool FP8 = false, int SEL_W = 0, int SEL_X = 0>
__device__ __forceinline__ void gemm_phase(PG8_LAS unsigned char* lds, const Gemm g, const Sched& S, const Epi& E, const int wid) {
    int tid = wid * 64 + lane_id(); asm volatile("" : "+v"(tid));
    const int lane = tid & 63, wr = wid >> 2, wc = wid & 3, fr = lane & 15, fq = lane >> 4;
    static_assert(SP2, "only the two-super-phase loop is kept");
    typedef int i32x4_ __attribute__((ext_vector_type(4)));
    const int K = g.K, nt = K / BK;
    unsigned voffB[2]; int rA[2], cA2[2];
#pragma unroll
    for (int i = 0; i < 2; ++i) { int R, C; stage_rc(tid * 16 + i * 8192, R, C); const int Rb = Epi::PERM ? ((R & ~31) + perm32(R & 31)) : R;
        rA[i] = R; cA2[i] = C * 2; voffB[i] = (unsigned)(Rb * K + C) * 2u; }
    unsigned vAc[2][2], vAn[2][2];
    const size_t kstep = (size_t)(BK * 2);
    const size_t hstep = (size_t)HALF * K * 2;
    const size_t tstep = 2 * hstep;
    const unsigned ldsw = (unsigned)wid * 1024u;
    const int aoff0 = lds_byte(wr * 64 + fr, fq * 8), aoff1 = aoff0 + 1024;
    const int boff0 = lds_byte(wc * 32 + fr, fq * 8), boff1 = boff0 + 1024;
#define PG8_SA(b, h) (((b) * 2 + (h)) * HTB)
#define PG8_SB(b, h) ((4 + (b) * 2 + (h)) * HTB)
#define PG8_STAGE(bufoff, gbase, voff) do { _Pragma("unroll") for (int _i = 0; _i < 2; ++_i) \
        __builtin_amdgcn_global_load_lds((const unsigned*)((const char*)(gbase) + (voff)[_i]), (PG8_LAS unsigned*)(lds + (bufoff) + ldsw + _i * 8192), 16, 0, 0); } while (0)
#define PG8_LDA(dst, b, h) do { _Pragma("unroll") for (int m = 0; m < 4; ++m) { dst[m][0] = *(const PG8_LAS bf16x8*)(lds + PG8_SA(b, h) + aoff0 + m * 2048); dst[m][1] = *(const PG8_LAS bf16x8*)(lds + PG8_SA(b, h) + aoff1 + m * 2048); } } while (0)
#define PG8_LDB(dst, b, h) do { _Pragma("unroll") for (int n = 0; n < 2; ++n) { dst[n][0] = *(const PG8_LAS bf16x8*)(lds + PG8_SB(b, h) + boff0 + n * 2048); dst[n][1] = *(const PG8_LAS bf16x8*)(lds + PG8_SB(b, h) + boff1 + n * 2048); } } while (0)
#define PG8_CAT8(x) __builtin_shufflevector(__builtin_bit_cast(i32x4_, (x)[0]), __builtin_bit_cast(i32x4_, (x)[1]), 0, 1, 2, 3, 4, 5, 6, 7)
#define PG8_MMA(ai, bj, At, Bt) do { __builtin_amdgcn_s_setprio(1); \
        if constexpr (FP8) { _Pragma("unroll") for (int m = 0; m < 4; ++m) _Pragma("unroll") for (int n = 0; n < 2; ++n) \
            acc[ai][bj][m][n] = __builtin_amdgcn_mfma_scale_f32_16x16x128_f8f6f4(PG8_CAT8(Bt[n]), PG8_CAT8(At[m]), acc[ai][bj][m][n], 0, 0, SEL_W, scl, SEL_X, scl); \
            asm volatile("" : "+v"(acc[ai][bj][0][0]), "+v"(acc[ai][bj][0][1]), "+v"(acc[ai][bj][1][0]), "+v"(acc[ai][bj][1][1]), "+v"(acc[ai][bj][2][0]), "+v"(acc[ai][bj][2][1]), "+v"(acc[ai][bj][3][0]), "+v"(acc[ai][bj][3][1])); } \
        else { _Pragma("unroll") for (int m = 0; m < 4; ++m) _Pragma("unroll") for (int n = 0; n < 2; ++n) _Pragma("unroll") for (int k = 0; k < 2; ++k) \
            acc[ai][bj][m][n] = __builtin_amdgcn_mfma_f32_16x16x32_bf16(Bt[n][k], At[m][k], acc[ai][bj][m][n], 0, 0, 0); } \
        __builtin_amdgcn_s_setprio(0); } while (0)
#define PG8_WAIT_V(n) asm volatile("s_waitcnt vmcnt(" #n ")" ::: "memory")
#define PG8_WAIT_VN(n) asm volatile("s_waitcnt vmcnt(%0)" :: "i"(n) : "memory")
#define PG8_WAIT_L(n) asm volatile("s_waitcnt lgkmcnt(" #n ")" ::: "memory")
#define PG8_BAR __builtin_amdgcn_s_barrier()
#define PG8_SCHED __builtin_amdgcn_sched_barrier(0)
    [[maybe_unused]] int scl = 0x7b7c797f; asm volatile("" : "+v"(scl));
    Unit cur, nxt; int ui = 0;
    if (!S.next(0, cur)) return;
    f32x4 acc[2][2][4][2];
#pragma unroll
    for (int a = 0; a < 2; ++a)
#pragma unroll
        for (int b = 0; b < 2; ++b)
#pragma unroll
            for (int m = 0; m < 4; ++m)
#pragma unroll
                for (int n = 0; n < 2; ++n) acc[a][b][m][n] = (f32x4){0.f, 0.f, 0.f, 0.f};
    bf16x8 At[4][2], B0[2][2], B1[2][2];
    const char* cA = GATHER ? (const char*)g.A : (const char*)g.A + (size_t)cur.pm * tstep + (cur.pm >= g.spm ? g.sdelta : 0L); const char* cB = (const char*)g.Bt + (size_t)cur.pn * tstep;
#pragma unroll
    for (int h = 0; h < 2; ++h)
#pragma unroll
        for (int i = 0; i < 2; ++i) { if constexpr (GATHER) vAc[h][i] = S.a_row_off(cur, h * HALF + rA[i]) + (unsigned)cA2[i]; else vAc[h][i] = (unsigned)((h * HALF + rA[i]) * K) * 2u + (unsigned)cA2[i]; vAn[h][i] = vAc[h][i]; }
    S.a_ready(cur);
    if constexpr (SP2) {
        PG8_STAGE(PG8_SB(0, 0), cB, voffB); PG8_STAGE(PG8_SB(0, 1), cB + hstep, voffB); PG8_STAGE(PG8_SA(0, 0), cA, vAc[0]); PG8_STAGE(PG8_SA(0, 1), cA, vAc[1]);
        if (wr == 1) PG8_BAR;
        PG8_WAIT_V(2); PG8_BAR;
        PG8_STAGE(PG8_SB(1, 0), cB + kstep, voffB); PG8_STAGE(PG8_SA(1, 0), cA + kstep, vAc[0]); PG8_STAGE(PG8_SB(1, 1), cB + hstep + kstep, voffB);
        PG8_WAIT_V(6); PG8_BAR;
    }
    for (;;) {
        const bool has_next = S.next(ui + 1, nxt);
        const char* nA = GATHER ? cA : (has_next ? (const char*)g.A + (size_t)nxt.pm * tstep + (nxt.pm >= g.spm ? g.sdelta : 0L) : cA); const char* nB = has_next ? (const char*)g.Bt + (size_t)nxt.pn * tstep : cB;
        if constexpr (GATHER) { if (has_next) {
#pragma unroll
            for (int h = 0; h < 2; ++h)
#pragma unroll
                for (int i = 0; i < 2; ++i) vAn[h][i] = S.a_row_off(nxt, h * HALF + rA[i]) + (unsigned)cA2[i]; } }
#pragma unroll 1
        for (int t = 0; t < nt; t += 2) {
            const bool last = (t == nt - 2);
            asm volatile("" : "+v"(voffB[0]), "+v"(voffB[1]), "+v"(vAc[0][0]), "+v"(vAc[0][1]), "+v"(vAc[1][0]), "+v"(vAc[1][1]));
            const char* a1 = cA + (size_t)(t + 1) * kstep;
            const char* a2 = last ? nA : cA + (size_t)(t + 2) * kstep; const char* b2 = last ? nB : cB + (size_t)(t + 2) * kstep;
            const char* a3 = a2 + kstep; const char* b3 = b2 + kstep;
            unsigned vA2[2][2];
#pragma unroll
            for (int h = 0; h < 2; ++h)
#pragma unroll
                for (int i = 0; i < 2; ++i) vA2[h][i] = vAc[h][i];
            if constexpr (GATHER) { if (last) {
                asm volatile("" : "+v"(vAn[0][0]), "+v"(vAn[0][1]), "+v"(vAn[1][0]), "+v"(vAn[1][1]));
#pragma unroll
                for (int h = 0; h < 2; ++h)
#pragma unroll
                    for (int i = 0; i < 2; ++i) vA2[h][i] = vAn[h][i]; } }
            if (last && has_next) S.a_ready(nxt);
            if constexpr (SP2) {
            const int lenient = __builtin_amdgcn_readfirstlane((ui > 0 && t == 0) ? 1 : 0);
#define PG8_WAIT_V8L() asm volatile("s_cmp_eq_u32 %0, 0\n\ts_cbranch_scc0 .Lpg8skip%=\n\ts_waitcnt vmcnt(8)\n.Lpg8skip%=:\n\ts_waitcnt vmcnt(%1)" :: "s"(lenient), "i"(8 + Epi::NSTORE) : "memory", "scc")
            PG8_LDB(B0, 0, 0); PG8_LDB(B1, 0, 1); PG8_SCHED; PG8_LDA(At, 0, 0); PG8_STAGE(PG8_SA(1, 1), a1, vAc[1]);
            PG8_WAIT_V8L(); PG8_WAIT_L(0); PG8_BAR; PG8_MMA(0, 0, At, B0); PG8_MMA(0, 1, At, B1); PG8_BAR; PG8_SCHED;
            PG8_LDA(At, 0, 1); PG8_STAGE(PG8_SB(0, 0), b2, voffB); PG8_STAGE(PG8_SB(0, 1), b2 + hstep, voffB); PG8_STAGE(PG8_SA(0, 0), a2, vA2[0]);
            PG8_WAIT_V8L(); PG8_WAIT_L(0); PG8_BAR; PG8_MMA(1, 0, At, B0); PG8_MMA(1, 1, At, B1); PG8_BAR; PG8_SCHED;
            PG8_LDB(B0, 1, 0); PG8_LDB(B1, 1, 1); PG8_SCHED; PG8_LDA(At, 1, 0); PG8_STAGE(PG8_SA(0, 1), a2, vA2[1]);
            PG8_WAIT_V(8); PG8_WAIT_L(0); PG8_BAR; PG8_MMA(0, 0, At, B0); PG8_MMA(0, 1, At, B1); PG8_BAR; PG8_SCHED;
            PG8_LDA(At, 1, 1); PG8_STAGE(PG8_SB(1, 0), b3, voffB); PG8_STAGE(PG8_SB(1, 1), b3 + hstep, voffB); PG8_STAGE(PG8_SA(1, 0), a3, vA2[0]);
            PG8_WAIT_V(8); PG8_WAIT_L(0); PG8_BAR; PG8_MMA(1, 0, At, B0); PG8_MMA(1, 1, At, B1); PG8_BAR; PG8_SCHED;
#undef PG8_WAIT_V8L
            }
        }
        if constexpr (ALIGN_EPI) { if (wr == 0) PG8_BAR; }
        if constexpr (!Epi::AFTER_DRAIN) { E(acc, cur, wr, wc, fr, fq); S.done(cur); }
        if (!has_next) break;
#pragma unroll
        for (int a = 0; a < 2; ++a)
#pragma unroll
            for (int b = 0; b < 2; ++b)
#pragma unroll
                for (int m = 0; m < 4; ++m)
#pragma unroll
                    for (int n = 0; n < 2; ++n) acc[a][b][m][n] = (f32x4){0.f, 0.f, 0.f, 0.f};
        cur = nxt; cA = nA; cB = nB; ++ui;
        if constexpr (GATHER) {
#pragma unroll
            for (int h = 0; h < 2; ++h)
#pragma unroll
                for (int i = 0; i < 2; ++i) vAc[h][i] = vAn[h][i]; }
        if constexpr (ALIGN_EPI) { if (wr == 1) PG8_BAR; }
    }
    PG8_WAIT_V(0);
    if constexpr (!ALIGN_EPI) { if (wr == 0) PG8_BAR; }
    PG8_BAR;
    if constexpr (Epi::AFTER_DRAIN) { E.fused(acc, cur, wr, wc, fr, fq, lds, wid, lane); S.done(cur); }
#undef PG8_SA
#undef PG8_SB
#undef PG8_STAGE
#undef PG8_LDA
#undef PG8_LDB
#undef PG8_MMA
#undef PG8_CAT8
#undef PG8_WAIT_V
#undef PG8_WAIT_VN
#undef PG8_WAIT_L
#undef PG8_BAR
#undef PG8_SCHED
}
}
#define GAS __attribute__((address_space(1)))
#define LAS __attribute__((address_space(3)))
typedef unsigned short bf16;
typedef unsigned v4u __attribute__((ext_vector_type(4)));
typedef float f32x4 __attribute__((ext_vector_type(4)));
typedef short bf16x8 __attribute__((ext_vector_type(8)));
typedef GAS unsigned gu32;
typedef GAS unsigned long long gu64;
#define RLX_AGENT __ATOMIC_RELAXED, __HIP_MEMORY_SCOPE_AGENT
#define LDS_WAIT() asm volatile("s_waitcnt lgkmcnt(0)" ::: "memory")
#define VM_WAIT() asm volatile("s_waitcnt vmcnt(0)" ::: "memory")
__device__ __forceinline__ unsigned long long rt() { return __builtin_amdgcn_s_memrealtime(); }
__device__ __forceinline__ unsigned f2bf(float f) { unsigned u = __builtin_bit_cast(unsigned, f); return (u + 0x7fffu + ((u >> 16) & 1u)) >> 16; }
__device__ __forceinline__ unsigned pk2(float lo, float hi) { return f2bf(lo) | (f2bf(hi) << 16); }

#define XB_TMO      128
#define XB_XCNT(j)  (256  + 64 * (j))
#define XB_XSUB(j)  (1280 + 64 * (j))
#define XB_XGEN(j)  (2304 + 64 * (j))
#define XB_TOP      3328
#define XB_TOPGEN   3392
#define XCD_BAR_WORDS 3456
#define XB_SPIN_CAP (1u << 18)

__device__ __forceinline__ unsigned xb_ld(unsigned* p)              { return __hip_atomic_load(p, __ATOMIC_RELAXED, __HIP_MEMORY_SCOPE_AGENT); }
__device__ __forceinline__ unsigned xb_add(unsigned* p, unsigned v) { return __hip_atomic_fetch_add(p, v, __ATOMIC_RELAXED, __HIP_MEMORY_SCOPE_AGENT); }
__device__ __forceinline__ unsigned xb_xcc_id() { return (unsigned)__builtin_amdgcn_s_getreg((3 << 11) | 20) & 0xFu; }
#define XB_SPIN(cond, bar) do { unsigned _sp = 0; while (cond) { __builtin_amdgcn_s_sleep(1); \
    if ((++_sp & 255u) == 0u) { if (xb_ld(&(bar)[XB_TMO])) break; if (_sp > XB_SPIN_CAP) { atomicAdd(&(bar)[XB_TMO], 1u); break; } } } } while (0)

struct XcdBarrier {
    unsigned* bar; unsigned x; int wv;
    volatile LAS unsigned* st;
};

__device__ __forceinline__ XcdBarrier xcd_barrier_post(unsigned* bar, volatile LAS unsigned* st) {
    XcdBarrier b; b.bar = bar; b.x = xb_xcc_id(); b.st = st; b.wv = 0;
    if (threadIdx.x == 0) (void)xb_add(&bar[XB_XCNT(b.x)], 1u);
    return b;
}
__device__ __forceinline__ void xcd_barrier_complete(unsigned* bar, unsigned x, unsigned& nloc, unsigned& nx) {
    const unsigned G = gridDim.x * gridDim.y * gridDim.z;
    unsigned sum, cnt, mine, sp = 0u;
    for (;;) {
        sum = 0u; cnt = 0u; mine = 0u;
#pragma unroll
        for (unsigned j = 0; j < 16; ++j) { const unsigned c = xb_ld(&bar[XB_XCNT(j)]); sum += c; cnt += (c > 0u) ? 1u : 0u; mine = (j == x) ? c : mine; }
        if (sum == G) break;
        __builtin_amdgcn_s_sleep(1);
        if ((++sp & 255u) == 0u) { if (xb_ld(&bar[XB_TMO])) break; if (sp > XB_SPIN_CAP) { atomicAdd(&bar[XB_TMO], 1u); break; } }
    }
    nloc = mine > 0u ? mine : 1u; nx = cnt > 0u ? cnt : 1u;
}

__device__ __forceinline__ void xcd_barrier(const XcdBarrier& b) {
    asm volatile("s_waitcnt vmcnt(0)" ::: "memory");
    __syncthreads();
    if (b.wv == 0 && (int)__builtin_amdgcn_mbcnt_hi(~0u, __builtin_amdgcn_mbcnt_lo(~0u, 0u)) == 0) {
        unsigned* bar = b.bar;
        __builtin_amdgcn_s_waitcnt(0);
        unsigned nloc = b.st[0], nx = b.st[1];
        if (nloc == 0u) { xcd_barrier_complete(bar, b.x, nloc, nx); b.st[0] = nloc; b.st[1] = nx; }
        const unsigned old = xb_add(&bar[XB_XSUB(b.x)], 1u);
        const unsigned gen = old / nloc;
        if (old + 1u == (gen + 1u) * nloc) {
            __builtin_amdgcn_fence(__ATOMIC_RELEASE, "agent");
            asm volatile("s_waitcnt vmcnt(0)" ::: "memory");
            const unsigned og = xb_add(&bar[XB_TOP], 1u);
            const unsigned tg = og / nx;
            if (og + 1u == (tg + 1u) * nx) xb_add(&bar[XB_TOPGEN], 1u);
            else XB_SPIN(xb_ld(&bar[XB_TOPGEN]) == tg, bar);
            __builtin_amdgcn_fence(__ATOMIC_ACQUIRE, "agent");
            xb_add(&bar[XB_XGEN(b.x)], 1u);
            asm volatile("s_waitcnt vmcnt(0)" ::: "memory");
        } else {
            XB_SPIN(xb_ld(&bar[XB_XGEN(b.x)]) == gen, bar);
            __builtin_amdgcn_fence(__ATOMIC_ACQUIRE, "agent");
            asm volatile("s_waitcnt vmcnt(0)" ::: "memory");
        }
    }
    __syncthreads();
}


constexpr int NWAVES = 8;
constexpr int RING_BYTES = 131072;
constexpr int LDSCTL_OFF = RING_BYTES, MISC_OFF = LDSCTL_OFF + 320;
constexpr int LDS_TS_OFF = LDSCTL_OFF + 1024;
constexpr int LDS_TE_OFF = LDSCTL_OFF + 2048;
constexpr int LDS_CNT_OFF = LDSCTL_OFF + 1024 + 128;
constexpr int LDS_BYTES = 163840;

typedef short s16x4 __attribute__((ext_vector_type(4)));
typedef unsigned u32x2 __attribute__((ext_vector_type(2)));

struct Args { const float* in[20]; float* out; unsigned char* ws; unsigned mask; int bar_region; };

__device__ __forceinline__ float bflo(unsigned w) { return __uint_as_float(w << 16); }
__device__ __forceinline__ float bfhi(unsigned w) { return __uint_as_float(w & 0xffff0000u); }
__device__ __forceinline__ unsigned cvtpk(float lo, float hi) { return pg8::cvt_pk_bf16(lo, hi); }
__device__ __forceinline__ float wave_sum(float v) {
#pragma unroll
    for (int o = 1; o < 64; o <<= 1) v += __shfl_xor(v, o);
    return v;
}
__device__ __forceinline__ unsigned offb(unsigned row, unsigned ch) { return 256u * row + 16u * (ch ^ (((row & 3u) << 2) | ((row >> 2) & 3u))); }
__device__ __forceinline__ s16x4 ldtr(const LAS unsigned char* p) { return __builtin_amdgcn_ds_read_tr16_b64_v4i16((LAS s16x4*)p); }
__device__ __forceinline__ bf16x8 cat8(s16x4 a, s16x4 b) { return (bf16x8){a[0], a[1], a[2], a[3], b[0], b[1], b[2], b[3]}; }
#define MFMA16(a, b, c) __builtin_amdgcn_mfma_f32_16x16x32_bf16((a), (b), (c), 0, 0, 0)

template <int MODE> __device__ __forceinline__ int dest_row(int n) {
    if (MODE == 1) { if (n >= 1024) return n; const int hb = n & ~127, d = n & 127, jr = d & 63, half = d >> 6; return hb + 8 * (jr >> 2) + 4 * half + (jr & 3); }
    if (MODE == 2) return ((n >> 2) << 3) + (n & 3);
    if (MODE == 3) return ((n >> 2) << 3) + 4 + (n & 3);
    return n;
}
template <int MODE> __device__ __forceinline__ void p0_transpose_item(const float* W, int K, int N, bf16* WT, LAS float* scr, int item, int lane) {
    const int nblk = N / 32, kb = item / nblk, nb = item % nblk, k0 = 64 * kb, n0 = 32 * nb;
    {
        const GAS f32x4* src = (const GAS f32x4*)(W + (size_t)(k0 + (lane >> 3)) * N + n0) + (lane & 7);
        f32x4 t[8];
#pragma unroll
        for (int j = 0; j < 8; ++j) t[j] = src[(size_t)j * 2 * N];
#pragma unroll
        for (int j = 0; j < 8; ++j) { LAS float* d = scr + ((lane >> 3) + 8 * j) * 33 + 4 * (lane & 7); d[0] = t[j].x; d[1] = t[j].y; d[2] = t[j].z; d[3] = t[j].w; }
    }
    LDS_WAIT(); asm volatile("" ::: "memory");
    const int c = lane & 7;
#pragma unroll
    for (int j = 0; j < 4; ++j) { const int n = (lane >> 3) + 8 * j; const LAS float* s = scr + (8 * c) * 33 + n;
        v4u o; o.x = pk2(s[0 * 33], s[1 * 33]); o.y = pk2(s[2 * 33], s[3 * 33]); o.z = pk2(s[4 * 33], s[5 * 33]); o.w = pk2(s[6 * 33], s[7 * 33]);
        *(GAS v4u*)(WT + (size_t)dest_row<MODE>(n0 + n) * K + k0 + 8 * c) = o; }
    LDS_WAIT(); asm volatile("" ::: "memory");
}
__device__ __forceinline__ unsigned pk_fp8x4(float a, float b, float c, float d) {
    a = fminf(fmaxf(a, -448.f), 448.f); b = fminf(fmaxf(b, -448.f), 448.f); c = fminf(fmaxf(c, -448.f), 448.f); d = fminf(fmaxf(d, -448.f), 448.f);
    unsigned w = 0u; w = __builtin_amdgcn_cvt_pk_fp8_f32(a, b, w, false); w = __builtin_amdgcn_cvt_pk_fp8_f32(c, d, w, true); return w;
}
template <int MODE> __device__ __forceinline__ void p0_transpose_item_fp8(const float* W, int K, int N, unsigned char* WT, LAS float* scr, int item, int lane, float scale) {
    const int nblk = N / 32, kb = item / nblk, nb = item % nblk, k0 = 64 * kb, n0 = 32 * nb;
    {
        const GAS f32x4* src = (const GAS f32x4*)(W + (size_t)(k0 + (lane >> 3)) * N + n0) + (lane & 7);
        f32x4 t[8];
#pragma unroll
        for (int j = 0; j < 8; ++j) t[j] = src[(size_t)j * 2 * N];
#pragma unroll
        for (int j = 0; j < 8; ++j) { LAS float* d = scr + ((lane >> 3) + 8 * j) * 33 + 4 * (lane & 7); d[0] = t[j].x; d[1] = t[j].y; d[2] = t[j].z; d[3] = t[j].w; }
    }
    LDS_WAIT(); asm volatile("" ::: "memory");
    const int c = lane & 7;
#pragma unroll
    for (int j = 0; j < 4; ++j) { const int n = (lane >> 3) + 8 * j; const LAS float* s = scr + (8 * c) * 33 + n;
        u32x2 o; o.x = pk_fp8x4(s[0 * 33] * scale, s[1 * 33] * scale, s[2 * 33] * scale, s[3 * 33] * scale); o.y = pk_fp8x4(s[4 * 33] * scale, s[5 * 33] * scale, s[6 * 33] * scale, s[7 * 33] * scale);
        *(GAS u32x2*)(WT + (size_t)dest_row<MODE>(n0 + n) * K + k0 + 8 * c) = o; }
    LDS_WAIT(); asm volatile("" ::: "memory");
}
__device__ __forceinline__ int t5_bucket(int rel) {
    const int n = rel < 0 ? -rel : rel;
    int large = 8 + (n >= 15) + (n >= 27) + (n >= 50) + (n >= 91) + (n >= 166) + (n >= 305) + (n >= 559);
    large = large < 15 ? large : 15;
    return (rel > 0 ? 16 : 0) + (n < 8 ? n : large);
}
__device__ __forceinline__ void p0_prologue(const Args& a, LAS unsigned char* lds, int vcu, int G, int tid, int wave, int lane) {
    unsigned char* ws = a.ws;
    LAS float* scr = (LAS float*)(lds + wave * 16384);
    const int gw = vcu * NWAVES + wave, NGW = G * NWAVES;
    constexpr int I_IN = 16 * 208, I_R = 16 * 32, I_A = 8 * 32, I_O = 16 * 32;
    constexpr int NITEMS = I_IN + I_R + I_A + I_O;
    for (int it = gw; it < NITEMS; it += NGW) {
        int r = it;
#if P1_FP8
        if (r < I_IN) { if ((GATE_FP8 || r % 208 < 144) && r % 208 >= 8 * P1_FP8_FROM) p0_transpose_item_fp8<1>(a.in[1], 1024, 6656, ws + WS_WIN8, scr, r, lane, 64.f);
                        else p0_transpose_item<1>(a.in[1], 1024, 6656, (bf16*)(ws + WS_WIN), scr, r, lane); continue; } r -= I_IN;
#else
        if (r < I_IN) { p0_transpose_item<1>(a.in[1], 1024, 6656, (bf16*)(ws + WS_WIN), scr, r, lane); continue; } r -= I_IN;
#endif
        if (r < I_R) { if (MIX_FP8 & 4) p0_transpose_item_fp8<0>(a.in[5], 1024, 1024, ws + WS_WR, scr, r, lane, 64.f); else p0_transpose_item<0>(a.in[5], 1024, 1024, (bf16*)(ws + WS_WR), scr, r, lane); continue; } r -= I_R;
        if (r < I_A) { if (MIX_FP8 & 2) p0_transpose_item_fp8<0>(a.in[7], 512, 1024, ws + WS_WA, scr, r, lane, 64.f); else p0_transpose_item<0>(a.in[7], 512, 1024, (bf16*)(ws + WS_WA), scr, r, lane); continue; } r -= I_A;
        if (MIX_FP8 & 1) p0_transpose_item_fp8<0>(a.in[8], 1024, 1024, ws + WS_WO, scr, r, lane, 64.f); else p0_transpose_item<0>(a.in[8], 1024, 1024, (bf16*)(ws + WS_WO), scr, r, lane);
    }
    {
        const f32x4* x4 = (const f32x4*)a.in[0]; u32x2* xb = (u32x2*)(ws + WS_XB);
#if P1_FP8
#if GATE_FP8
        unsigned* xf8 = (unsigned*)(ws + WS_X8_LO);
#define XF8_AT(i) xf8[(long)(i) + ((i) >= (size_t)16384 * 256 ? ((long)WS_X8_HI - (long)WS_X8_LO - (long)(16 * MiB)) / 4 : 0L)]
#else
        unsigned* xf8 = (unsigned*)a.out;
#define XF8_AT(i) xf8[i]
#endif
        for (size_t i = (size_t)vcu * 512 + tid; i < (size_t)TT * DM / 4; i += (size_t)G * 512) { const f32x4 v = x4[i]; u32x2 o; o.x = cvtpk(v.x, v.y); o.y = cvtpk(v.z, v.w); xb[i] = o; XF8_AT(i) = pk_fp8x4(v.x, v.y, v.z, v.w); }
#undef XF8_AT
#else
        for (size_t i = (size_t)vcu * 512 + tid; i < (size_t)TT * DM / 4; i += (size_t)G * 512) { const f32x4 v = x4[i]; u32x2 o; o.x = cvtpk(v.x, v.y); o.y = cvtpk(v.z, v.w); xb[i] = o; }
#endif
    }
    {
        float* rot = (float*)(ws + WS_ROT);
        for (int idx = vcu * 512 + tid; idx < SEQ * 64; idx += G * 512) {
            const int pos = idx >> 6, jr = idx & 63;
            double iv = 1.0; for (int k = 0; k < jr; ++k) iv *= 0.86596432336006535;
            const float ang = (float)pos * (float)iv;
            const double xx = (double)ang; const double qd = __builtin_rint(xx * 0.63661977236758134); const int qi = (int)qd;
            const double r = (xx - qd * 1.5707963267948966) - qd * 6.123233995736766e-17, r2 = r * r;
            const double sp = r * (1.0 + r2 * (-1.0 / 6 + r2 * (1.0 / 120 + r2 * (-1.0 / 5040 + r2 * (1.0 / 362880 + r2 * (-1.0 / 39916800 + r2 * (1.0 / 6227020800.0)))))));
            const double cp = 1.0 + r2 * (-0.5 + r2 * (1.0 / 24 + r2 * (-1.0 / 720 + r2 * (1.0 / 40320 + r2 * (-1.0 / 3628800 + r2 * (1.0 / 479001600.0))))));
            const int qq = qi & 3; const double s = qq == 0 ? sp : (qq == 1 ? cp : (qq == 2 ? -sp : -cp)), c = qq == 0 ? cp : (qq == 1 ? -sp : (qq == 2 ? -cp : sp));
            float* o = rot + ((size_t)pos * 16 + (jr >> 2)) * 8 + (jr & 3); o[0] = (float)c; o[4] = (float)s;
        }
    }
    if (vcu == 0) {
        float* bt = (float*)(ws + WS_BIAS); const float* rb = a.in[6];
        for (int idx = tid; idx < 3 * 8 * 160; idx += 512) { const int p = idx / (8 * 160), h = (idx / 160) % 8, d = idx % 160 - 80; const int dil = p == 0 ? 1 : (p == 1 ? 4 : 16);
            bt[idx] = (d >= -64 && d <= 64) ? rb[t5_bucket(d * dil) * 8 + h] * 1.4426950408889634f : -1e30f; }
    }
}
__device__ __forceinline__ void p0_expert_weights(const Args& a, LAS unsigned char* lds, int vcu, int G, int wave, int lane) {
    unsigned char* ws = a.ws;
    LAS float* scr = (LAS float*)(lds + wave * 16384);
    const int gw = vcu * NWAVES + wave, NGW = G * NWAVES;
    constexpr int I_G = 16 * 16, I_D = 8 * 32, PER_E = 2 * I_G + I_D;
    for (int it = gw; it < 16 * PER_E; it += NGW) {
        const int e = it / PER_E; int r = it - e * PER_E;
#if M1_FP8
        if (r < I_G) { p0_transpose_item_fp8<2>(a.in[15] + (size_t)e * 1024 * 512, 1024, 512, ws + WS_WGU + (size_t)e * 1024 * 1024, scr, r, lane, 64.f); continue; } r -= I_G;
        if (r < I_G) { p0_transpose_item_fp8<3>(a.in[16] + (size_t)e * 1024 * 512, 1024, 512, ws + WS_WGU + (size_t)e * 1024 * 1024, scr, r, lane, 64.f); continue; } r -= I_G;
#else
        if (r < I_G) { p0_transpose_item<2>(a.in[15] + (size_t)e * 1024 * 512, 1024, 512, (bf16*)(ws + WS_WGU) + (size_t)e * 1024 * 1024, scr, r, lane); continue; } r -= I_G;
        if (r < I_G) { p0_transpose_item<3>(a.in[16] + (size_t)e * 1024 * 512, 1024, 512, (bf16*)(ws + WS_WGU) + (size_t)e * 1024 * 1024, scr, r, lane); continue; } r -= I_G;
#endif
        p0_transpose_item_fp8<0>(a.in[17] + (size_t)e * 512 * 1024, 512, 1024, ws + WS_WD + (size_t)e * 1024 * 512, scr, r, lane, 64.f);
    }
    __syncthreads();
}

__device__ __forceinline__ float log2_gamma(const float* dec, int h) {
    const float x = dec[h]; return -__log2f(1.f + __expf(-x));
}
__device__ __forceinline__ void chain_item(const Args& a, LAS unsigned char* lds, int item, int tid, int wid, int lane) {
    unsigned char* ws = a.ws;
    const int b = item >> 4, h = (item >> 2) & 3, dir = (item >> 1) & 1, vh = item & 1;
    const float lg2 = log2_gamma(dir ? a.in[3] : a.in[2], h);
    const float cd = __builtin_amdgcn_exp2f(lg2 * 128.f);
    const int g = lane >> 4, i16 = lane & 15, q = i16 >> 2, p = lane & 3;
    const int wd = wid >> 1, wv = wid & 1;
    const GAS bf16* kr = (const GAS bf16*)(ws + WS_KR); const GAS bf16* vr = (const GAS bf16*)(ws + WS_VR);
    GAS bf16* states = (GAS bf16*)a.out;
    f32x4 acc[2][4];
#pragma unroll
    for (int i = 0; i < 2; ++i)
#pragma unroll
        for (int j = 0; j < 4; ++j) acc[i][j] = (f32x4){0.f, 0.f, 0.f, 0.f};
    const int srow = tid >> 4, sch = tid & 15; const unsigned soff = offb(srow, sch);
    const GAS bf16* kp = kr + ((size_t)b * SEQ + srow) * 512 + h * 128 + sch * 8;
    const GAS bf16* vp = vr + ((size_t)b * SEQ + srow) * 1024 + h * 256 + vh * 128 + sch * 8;
    v4u kq[4], vq[4];
    { const int n0 = dir ? 15 : 0;
#pragma unroll
      for (int j = 0; j < 4; ++j) { kq[j] = *(const GAS v4u*)(kp + (size_t)(n0 * 128 + 32 * j) * 512); vq[j] = *(const GAS v4u*)(vp + (size_t)(n0 * 128 + 32 * j) * 1024); } }
    unsigned abase[2][2], bbase[4][2];
#pragma unroll
    for (int t = 0; t < 2; ++t) { const unsigned r = 8 * g + 4 * t + q;
#pragma unroll
        for (int dt = 0; dt < 2; ++dt) abase[dt][t] = offb(r, 2 * (2 * wd + dt) + (p >> 1)) + 8 * (p & 1);
#pragma unroll
        for (int vt = 0; vt < 4; ++vt) bbase[vt][t] = offb(r, 2 * (4 * wv + vt) + (p >> 1)) + 8 * (p & 1); }
#define CH_STAGE(BUFOFF) do { _Pragma("unroll") for (int j = 0; j < 4; ++j) { \
            const int row = srow + 32 * j; const float z = __builtin_amdgcn_exp2f(lg2 * (float)(dir ? row : 127 - row)); const v4u kv = kq[j]; \
            v4u ko; ko.x = cvtpk(bflo(kv.x) * z, bfhi(kv.x) * z); ko.y = cvtpk(bflo(kv.y) * z, bfhi(kv.y) * z); ko.z = cvtpk(bflo(kv.z) * z, bfhi(kv.z) * z); ko.w = cvtpk(bflo(kv.w) * z, bfhi(kv.w) * z); \
            *(LAS v4u*)(lds + (BUFOFF) + soff + j * 8192) = ko; *(LAS v4u*)(lds + (BUFOFF) + 32768 + soff + j * 8192) = vq[j]; } } while (0)
#define CH_FETCH(NN) do { _Pragma("unroll") for (int j = 0; j < 4; ++j) { kq[j] = *(const GAS v4u*)(kp + (size_t)((NN) * 128 + 32 * j) * 512); vq[j] = *(const GAS v4u*)(vp + (size_t)((NN) * 128 + 32 * j) * 1024); } } while (0)
#define CH_STEP(STEP, CUR, OTH) do { const int step_ = (STEP); const int n_ = dir ? 15 - step_ : step_; \
        GAS bf16* sb_ = states + ((((size_t)(b * 4 + h) * 16 + n_) * 2 + dir) * 256) * 128; \
        _Pragma("unroll") for (int dt = 0; dt < 2; ++dt) _Pragma("unroll") for (int vt = 0; vt < 4; ++vt) { \
            const int v_ = vh * 128 + 64 * wv + 16 * vt + i16, d0_ = 32 * wd + 16 * dt + 4 * g; \
            u32x2 w_; w_.x = pg8::cvt_pk_bf16_acc(acc[dt][vt][0], acc[dt][vt][1]); w_.y = pg8::cvt_pk_bf16_acc(acc[dt][vt][2], acc[dt][vt][3]);   \
            *(GAS u32x2*)(sb_ + (size_t)v_ * 128 + d0_) = w_; } \
        if (step_ < 15) CH_STAGE(OTH); \
        if (step_ < 14) CH_FETCH(dir ? 13 - step_ : step_ + 2); \
        _Pragma("unroll") for (int i = 0; i < 2; ++i) _Pragma("unroll") for (int j = 0; j < 4; ++j) acc[i][j] = acc[i][j] * cd; \
        _Pragma("unroll") for (int ks = 0; ks < 4; ++ks) { bf16x8 af[2], bfr[4]; \
            _Pragma("unroll") for (int dt = 0; dt < 2; ++dt) af[dt] = cat8(ldtr(lds + (CUR) + abase[dt][0] + ks * 8192), ldtr(lds + (CUR) + abase[dt][1] + ks * 8192)); \
            _Pragma("unroll") for (int vt = 0; vt < 4; ++vt) bfr[vt] = cat8(ldtr(lds + (CUR) + 32768 + bbase[vt][0] + ks * 8192), ldtr(lds + (CUR) + 32768 + bbase[vt][1] + ks * 8192)); \
            _Pragma("unroll") for (int dt = 0; dt < 2; ++dt) _Pragma("unroll") for (int vt = 0; vt < 4; ++vt) acc[dt][vt] = MFMA16(af[dt], bfr[vt], acc[dt][vt]); } \
        __syncthreads(); } while (0)
    CH_STAGE(0);
    CH_FETCH(dir ? 14 : 1);
    __syncthreads();
    for (int sp = 0; sp < 8; ++sp) { CH_STEP(2 * sp, 0, 65536); CH_STEP(2 * sp + 1, 65536, 0); }
#undef CH_STEP
#undef CH_STAGE
#undef CH_FETCH
}

constexpr int AT_OST = 135168, AT_SCR = AT_OST + 8 * 2048;
constexpr int ATB_N = 160;
struct AttnLane { unsigned kb[2]; unsigned vb[4]; };
__device__ __forceinline__ AttnLane attn_lane(int lane) {
    const int g = lane >> 4, i16 = lane & 15, q4 = i16 >> 2, p = lane & 3; AttnLane L;
#pragma unroll
    for (int s = 0; s < 2; ++s) L.kb[s] = i16 * 128 + (((4 * s + g) ^ ((i16 >> 1) & 7)) * 16);
    const int sw = (2 * g + (q4 >> 1)) & 3;
#pragma unroll
    for (int c = 0; c < 4; ++c) L.vb[c] = (4 * g + q4) * 128 + ((c ^ sw) * 32) + p * 8;
    return L;
}
__device__ __forceinline__ unsigned kimg_off(int row, int c) { return row * 128 + ((c ^ ((row >> 1) & 7)) * 16); }
__device__ __forceinline__ unsigned vimg_off(int row, int c) { return row * 128 + (((c >> 1) ^ ((row >> 1) & 3)) * 32) + (c & 1) * 16; }
__device__ __forceinline__ void attn_core(const LAS unsigned char* Kimg, const LAS unsigned char* Vimg, int R0, int nrows, unsigned tvalid, const bf16x8 (&qf)[2],
                                          const float (&biasr)[36], const AttnLane& L, f32x4 (&O)[4], float& mx, float& lsum) {
    f32x4 D[9];
#pragma unroll
    for (int kt = 0; kt < 9; ++kt) {
        int R = R0 + 16 * kt; R = R < 0 ? 0 : (R > nrows - 16 ? nrows - 16 : R);
        const LAS unsigned char* kp = Kimg + R * 128;
        const bf16x8 k0 = *(const LAS bf16x8*)(kp + L.kb[0]), k1 = *(const LAS bf16x8*)(kp + L.kb[1]);
        f32x4 d = (f32x4){0.f, 0.f, 0.f, 0.f};
        d = MFMA16(k0, qf[0], d); d = MFMA16(k1, qf[1], d); D[kt] = d;
    }
    mx = -1e30f;
#pragma unroll
    for (int kt = 0; kt < 9; ++kt) {
        const float tb = ((tvalid >> kt) & 1u) ? 0.f : -1e30f;
#pragma unroll
        for (int r = 0; r < 4; ++r) { const float x = D[kt][r] + (biasr[4 * kt + r] + tb); D[kt][r] = x; mx = fmaxf(mx, x); }
    }
    mx = fmaxf(mx, __shfl_xor(mx, 16)); mx = fmaxf(mx, __shfl_xor(mx, 32));
    lsum = 0.f;
#pragma unroll
    for (int kt = 0; kt < 9; ++kt)
#pragma unroll
        for (int r = 0; r < 4; ++r) { const float e = __builtin_amdgcn_exp2f(D[kt][r] - mx); D[kt][r] = e; lsum += e; }
    lsum += __shfl_xor(lsum, 16); lsum += __shfl_xor(lsum, 32);
#pragma unroll
    for (int c = 0; c < 4; ++c) O[c] = (f32x4){0.f, 0.f, 0.f, 0.f};
#pragma unroll
    for (int kk = 0; kk < 5; ++kk) {
        int Ra = R0 + 32 * kk; Ra = Ra < 0 ? 0 : (Ra > nrows - 16 ? nrows - 16 : Ra);
        int Rb = R0 + 32 * kk + 16; Rb = Rb < 0 ? 0 : (Rb > nrows - 16 ? nrows - 16 : Rb);
        if (kk == 4) Rb = Ra;
        const f32x4 e0 = D[2 * kk], e1 = kk < 4 ? D[2 * kk + 1] : (f32x4){0.f, 0.f, 0.f, 0.f};
        v4u pw; pw.x = cvtpk(e0[0], e0[1]); pw.y = cvtpk(e0[2], e0[3]); pw.z = cvtpk(e1[0], e1[1]); pw.w = cvtpk(e1[2], e1[3]);
        const bf16x8 pf = __builtin_bit_cast(bf16x8, pw);
        const LAS unsigned char* va_ = Vimg + Ra * 128; const LAS unsigned char* vb_ = Vimg + Rb * 128;
#pragma unroll
        for (int c = 0; c < 4; ++c) O[c] = MFMA16(pf, cat8(ldtr(va_ + L.vb[c]), ldtr(vb_ + L.vb[c])), O[c]);
    }
}
__device__ __forceinline__ void attn_stage_out(LAS unsigned char* lds, int wid, int lane, const f32x4 (&O)[4], float lsum) {
    const int g = lane >> 4, i16 = lane & 15;
    const float linv = 1.f / lsum;
    LAS bf16* st = (LAS bf16*)(lds + AT_OST + wid * 2048);
#pragma unroll
    for (int r = 0; r < 4; ++r) { const float li = __shfl(linv, 4 * g + r);
#pragma unroll
        for (int c = 0; c < 4; ++c) st[(4 * g + r) * 64 + 16 * c + i16] = (bf16)(cvtpk(O[c][r] * li, 0.f) & 0xffffu); }
}
__device__ __forceinline__ void attn_load_bias(const Args& a, int pat, int h, int lane, float (&biasr)[36]) {
    const GAS float* bt = (const GAS float*)(a.ws + WS_BIAS) + (pat * 8 + h) * ATB_N; const int g = lane >> 4, i16 = lane & 15;
#pragma unroll
    for (int kt = 0; kt < 9; ++kt)
#pragma unroll
        for (int r = 0; r < 4; ++r) biasr[4 * kt + r] = bt[16 * kt + 4 * g + r - 64 - i16 + 80];
}
template <int DIL, int VAR = 0> __device__ __forceinline__ void attn_dil_phase(const Args& a, LAS unsigned char* lds, int vcu, int G, int tid, int wid, int lane) {
    unsigned char* ws = a.ws;
    constexpr int NR = SEQ / DIL, PAT = DIL == 4 ? 1 : 2, CH = NR * 8 / 512, NITEM = NB * 8 * DIL;
    constexpr int NBUF = DIL == 16 ? 2 : 1, BUFB = 2 * NR * 128;
    const GAS bf16* qa = (const GAS bf16*)(ws + WS_QA); const GAS bf16* ka = (const GAS bf16*)(ws + WS_KA); const GAS bf16* va = (const GAS bf16*)(ws + WS_VA);
    bf16* op = (bf16*)(ws + (DIL == 4 ? WS_O2 : WS_O3)); float* lsep = (float*)(ws + (DIL == 4 ? WS_LSE2 : WS_LSE3));
    if (vcu >= NITEM) return;
    const int h = vcu & 7;
    float biasr[36]; attn_load_bias(a, PAT, h, lane, biasr);
    const AttnLane L = attn_lane(lane);
    const int g = lane >> 4, i16 = lane & 15;
    v4u kq[CH], vq[CH]; bf16x8 qn[2];
    auto issue = [&](int item, int gi) {
        const int rho = (item >> 3) % DIL, b = item / (8 * DIL); const size_t rowb = (size_t)b * SEQ;
#pragma unroll
        for (int j = 0; j < CH; ++j) { const int id = tid + 512 * j, row = id >> 3, c = id & 7; const size_t go = (rowb + (size_t)row * DIL + rho) * 512 + h * 64 + c * 8;
            kq[j] = *(const GAS v4u*)(ka + go); vq[j] = *(const GAS v4u*)(va + go); }
        const size_t qpos = rowb + (size_t)(16 * gi + i16) * DIL + rho;
#pragma unroll
        for (int s = 0; s < 2; ++s) qn[s] = *(const GAS bf16x8*)(qa + qpos * 512 + h * 64 + 32 * s + 8 * g);
    };
    issue(vcu, wid);
    int buf = 0;
    for (int item = vcu; item < NITEM; item += G) {
        const int rho = (item >> 3) % DIL, b = item / (8 * DIL); const size_t rowb = (size_t)b * SEQ;
        LAS unsigned char* Kimg = lds + buf * BUFB; LAS unsigned char* Vimg = Kimg + NR * 128;
        if (NBUF == 1) __syncthreads();
#pragma unroll
        for (int j = 0; j < CH; ++j) { const int id = tid + 512 * j, row = id >> 3, c = id & 7;
            *(LAS v4u*)(Kimg + kimg_off(row, c)) = kq[j]; *(LAS v4u*)(Vimg + vimg_off(row, c)) = vq[j]; }
        bf16x8 qf[2] = {qn[0], qn[1]};
        __syncthreads();
        if (NBUF == 2 && item + G < NITEM) issue(item + G, wid);
        for (int gi = wid; gi < NR / 16; gi += 8) {
            const int m0 = 16 * gi;
            if (NBUF == 1 && gi + 8 < NR / 16) {
                const size_t qpos = rowb + (size_t)(m0 + 128 + i16) * DIL + rho;
#pragma unroll
                for (int s = 0; s < 2; ++s) qn[s] = *(const GAS bf16x8*)(qa + qpos * 512 + h * 64 + 32 * s + 8 * g); }
            unsigned tvalid = 0u;
#pragma unroll
            for (int kt = 0; kt < 9; ++kt) { const int t0 = m0 - 64 + 16 * kt; tvalid |= (t0 >= 0 && t0 < NR) ? (1u << kt) : 0u; }
            f32x4 O[4]; float mx, lsum;
            if (VAR == 1) { mx = 0.f; lsum = 1.f;
#pragma unroll
                for (int c = 0; c < 4; ++c) O[c] = (f32x4){__builtin_bit_cast(float, qf[0][0] + c), 0.f, 0.f, 0.f}; }
            else attn_core(Kimg, Vimg, m0 - 64, NR, tvalid, qf, biasr, L, O, mx, lsum);
            attn_stage_out(lds, wid, lane, O, lsum);
            if (g == 0) lsep[(rowb + (size_t)(m0 + i16) * DIL + rho) * 8 + h] = mx + __log2f(lsum);
            asm volatile("s_waitcnt lgkmcnt(0)" ::: "memory");
            { const int q = lane >> 2, qt = lane & 3; const LAS v4u* sp = (const LAS v4u*)(lds + AT_OST + wid * 2048 + q * 128 + qt * 32);
              const v4u x0 = sp[0], x1 = sp[1]; bf16* dst = op + (rowb + (size_t)(m0 + q) * DIL + rho) * 512 + h * 64 + qt * 16;
              *(v4u*)dst = x0; *(v4u*)(dst + 8) = x1; }
            asm volatile("s_waitcnt lgkmcnt(0)" ::: "memory");
            if (NBUF == 1) { qf[0] = qn[0]; qf[1] = qn[1]; }
        }
        if (NBUF == 1 && item + G < NITEM) issue(item + G, wid);
        buf ^= (NBUF - 1);
    }
    __syncthreads();
}
__device__ __forceinline__ void attn_p1_phase(const Args& a, LAS unsigned char* lds, int vcu, int G, int tid, int wid, int lane) {
    unsigned char* ws = a.ws;
    LAS unsigned char* Kimg = lds; LAS unsigned char* Vimg = lds + 384 * 128;
    const GAS bf16* qa = (const GAS bf16*)(ws + WS_QA); const GAS bf16* ka = (const GAS bf16*)(ws + WS_KA); const GAS bf16* va = (const GAS bf16*)(ws + WS_VA);
    const GAS bf16* o2 = (const GAS bf16*)(ws + WS_O2); const GAS bf16* o3 = (const GAS bf16*)(ws + WS_O3);
    const GAS float* lse2 = (const GAS float*)(ws + WS_LSE2); const GAS float* lse3 = (const GAS float*)(ws + WS_LSE3);
    bf16* oa = (bf16*)(ws + WS_OA);
    if (vcu >= 1024) return;
    const int h = vcu & 7;
    float biasr[36]; attn_load_bias(a, 0, h, lane, biasr);
    const AttnLane L = attn_lane(lane);
    const int g = lane >> 4, i16 = lane & 15;
    LAS float* scr = (LAS float*)(lds + AT_SCR) + wid * 16;
    v4u kq[6], vq[6];
    auto issue = [&](int item) { const int b = item >> 6, s0 = ((item >> 3) & 7) * 256; const size_t rowb = (size_t)b * SEQ;
#pragma unroll
        for (int j = 0; j < 6; ++j) { const int id = tid + 512 * j, row = id >> 3, c = id & 7, pos = s0 - 64 + row; const bool ok = pos >= 0 && pos < SEQ;
            const size_t go = (rowb + (size_t)(ok ? pos : 0)) * 512 + h * 64 + c * 8;
            kq[j] = *(const GAS v4u*)(ka + go); vq[j] = *(const GAS v4u*)(va + go);
            if (!ok) { kq[j] = (v4u){0u, 0u, 0u, 0u}; vq[j] = (v4u){0u, 0u, 0u, 0u}; } } };
    issue(vcu);
    for (int item = vcu; item < 1024; item += G) {
        const int b = item >> 6, s0 = ((item >> 3) & 7) * 256; const size_t rowb = (size_t)b * SEQ;
        __syncthreads();
#pragma unroll
        for (int j = 0; j < 6; ++j) { const int id = tid + 512 * j, row = id >> 3, c = id & 7;
            *(LAS v4u*)(Kimg + kimg_off(row, c)) = kq[j]; *(LAS v4u*)(Vimg + vimg_off(row, c)) = vq[j]; }
        __syncthreads();
        if (item + G < 1024) issue(item + G);
        for (int gi = wid; gi < 16; gi += 8) {
            const int m0 = s0 + 16 * gi;
            const int q = lane >> 2, qt = lane & 3; const size_t tq = rowb + m0 + q;
            const v4u a20 = *(const GAS v4u*)(o2 + tq * 512 + h * 64 + qt * 16), a21 = *(const GAS v4u*)(o2 + tq * 512 + h * 64 + qt * 16 + 8);
            const v4u a30 = *(const GAS v4u*)(o3 + tq * 512 + h * 64 + qt * 16), a31 = *(const GAS v4u*)(o3 + tq * 512 + h * 64 + qt * 16 + 8);
            const float l2 = lse2[tq * 8 + h], l3 = lse3[tq * 8 + h];
            bf16x8 qf[2];
#pragma unroll
            for (int s = 0; s < 2; ++s) qf[s] = *(const GAS bf16x8*)(qa + (rowb + m0 + i16) * 512 + h * 64 + 32 * s + 8 * g);
            unsigned tvalid = 0u;
#pragma unroll
            for (int kt = 0; kt < 9; ++kt) { const int t0 = m0 - 64 + 16 * kt; tvalid |= (t0 >= 0 && t0 < SEQ) ? (1u << kt) : 0u; }
            f32x4 O[4]; float mx, lsum;
            attn_core(Kimg, Vimg, 16 * gi, 384, tvalid, qf, biasr, L, O, mx, lsum);
            attn_stage_out(lds, wid, lane, O, lsum);
            if (g == 0) scr[i16] = mx + __log2f(lsum);
            asm volatile("s_waitcnt lgkmcnt(0)" ::: "memory");
            {
                const float l1 = scr[q], M = fmaxf(l1, fmaxf(l2, l3));
                float w1 = __builtin_amdgcn_exp2f(l1 - M), w2 = __builtin_amdgcn_exp2f(l2 - M), w3 = __builtin_amdgcn_exp2f(l3 - M); const float wi = 1.f / (w1 + w2 + w3); w1 *= wi; w2 *= wi; w3 *= wi;
                const LAS v4u* sp = (const LAS v4u*)(lds + AT_OST + wid * 2048 + q * 128 + qt * 32);
                const v4u x0 = sp[0], x1 = sp[1];
                v4u r0, r1;
#define MRG(d, x, y, z) d = cvtpk(w1 * bflo(x) + w2 * bflo(y) + w3 * bflo(z), w1 * bfhi(x) + w2 * bfhi(y) + w3 * bfhi(z))
                MRG(r0.x, x0.x, a20.x, a30.x); MRG(r0.y, x0.y, a20.y, a30.y); MRG(r0.z, x0.z, a20.z, a30.z); MRG(r0.w, x0.w, a20.w, a30.w);
                MRG(r1.x, x1.x, a21.x, a31.x); MRG(r1.y, x1.y, a21.y, a31.y); MRG(r1.z, x1.z, a21.z, a31.z); MRG(r1.w, x1.w, a21.w, a31.w);
#undef MRG
#if MIX_FP8 & 2
                v4u o8;
                o8.x = pk_fp8x4(16.f * bflo(r0.x), 16.f * bfhi(r0.x), 16.f * bflo(r0.y), 16.f * bfhi(r0.y)); o8.y = pk_fp8x4(16.f * bflo(r0.z), 16.f * bfhi(r0.z), 16.f * bflo(r0.w), 16.f * bfhi(r0.w));
                o8.z = pk_fp8x4(16.f * bflo(r1.x), 16.f * bfhi(r1.x), 16.f * bflo(r1.y), 16.f * bfhi(r1.y)); o8.w = pk_fp8x4(16.f * bflo(r1.z), 16.f * bfhi(r1.z), 16.f * bflo(r1.w), 16.f * bfhi(r1.w));
                *(v4u*)((unsigned char*)oa + tq * 512 + h * 64 + qt * 16) = o8;
#else
                bf16* dst = oa + tq * 512 + h * 64 + qt * 16;
                *(v4u*)dst = r0; *(v4u*)(dst + 8) = r1;
#endif
            }
            asm volatile("s_waitcnt lgkmcnt(0)" ::: "memory");
        }
    }
    __syncthreads();
}

#define OPAQUE(x) asm volatile("" : "+v"(x))
template <int VAR = 0> __device__ __forceinline__ void p3_phase(const Args& a, LAS unsigned char* lds, int vcu, int G, int tid, int wid, int lane) {
    unsigned char* ws = a.ws;
    const int g = lane >> 4, i16 = lane & 15, q4 = i16 >> 2, p = lane & 3;
    const GAS bf16* qr = (const GAS bf16*)(ws + WS_QR); const GAS bf16* kr = (const GAS bf16*)(ws + WS_KR); const GAS bf16* vr = (const GAS bf16*)(ws + WS_VR);
    GAS bf16* gr = (GAS bf16*)(ws + WS_GR);
    LAS unsigned char* Kt = lds; LAS unsigned char* Sg = lds + 32768;
    if (vcu >= 1024) return;
    const unsigned kdst = offb(tid >> 4, tid & 15);
    unsigned rfo[4];
    { const unsigned X = ((i16 & 3) << 2) | (i16 >> 2);
#pragma unroll
      for (int s = 0; s < 4; ++s) rfo[s] = 256 * i16 + 16 * (((4 * s) ^ (X & 12)) | (g ^ (X & 3))); }
    v4u sreg[8], kreg[4]; bf16x8 qn[4];
    auto item_ptrs = [&](int item, size_t& tok0, const GAS bf16*& sf, int& h) { const int b = item >> 6; h = (item >> 4) & 3; const int n = item & 15; tok0 = (size_t)b * SEQ + n * 128;
        sf = (const GAS bf16*)a.out + ((((size_t)(b * 4 + h) * 16 + n) * 2 + 0) * 256) * 128; };
    auto issue_k = [&](int item) { size_t tok0; const GAS bf16* sf; int h; item_ptrs(item, tok0, sf, h);
        const GAS bf16* ks_ = kr + (tok0 + (tid >> 4)) * 512 + h * 128 + (tid & 15) * 8;
#pragma unroll
        for (int j = 0; j < 4; ++j) kreg[j] = *(const GAS v4u*)(ks_ + (size_t)j * 32 * 512); };
    auto issue_q = [&](int item) { size_t tok0; const GAS bf16* sf; int h; item_ptrs(item, tok0, sf, h);
#pragma unroll
        for (int s = 0; s < 4; ++s) qn[s] = *(const GAS bf16x8*)(qr + (tok0 + 16 * wid + i16) * 512 + h * 128 + 32 * s + 8 * g); };
    auto issue_state = [&](const GAS bf16* sf, int dirn) { const GAS bf16* sld = sf + (size_t)dirn * 256 * 128 + (size_t)(tid >> 4) * 128 + (tid & 15) * 8;
#pragma unroll
        for (int j = 0; j < 8; ++j) sreg[j] = *(const GAS v4u*)(sld + (size_t)j * 32 * 128); };
    auto write_state = [&]() {
#pragma unroll
        for (int j = 0; j < 8; ++j) *(LAS v4u*)(Sg + (j >> 2) * 32768 + kdst + (j & 3) * 8192) = sreg[j]; };
    { size_t tok0; const GAS bf16* sf; int h; item_ptrs(vcu, tok0, sf, h); issue_k(vcu); issue_q(vcu); issue_state(sf, 0); }
#pragma unroll
    for (int j = 0; j < 4; ++j) *(LAS v4u*)(Kt + kdst + j * 8192) = kreg[j];
    for (int item = vcu; item < 1024; item += G) {
        size_t tok0; const GAS bf16* sf; int h; item_ptrs(item, tok0, sf, h);
        const float lf2 = log2_gamma(a.in[2], h), lb2 = log2_gamma(a.in[3], h);
        bf16x8 qf[4];
#pragma unroll
        for (int s = 0; s < 4; ++s) qf[s] = qn[s];
        const bool has_next = item + G < 1024;
        __syncthreads();
        f32x4 D[8];
#pragma unroll
        for (int jt = 0; jt < 8; ++jt) {
            f32x4 d = (f32x4){0.f, 0.f, 0.f, 0.f};
#pragma unroll
            for (int s = 0; s < 4; ++s) { if (VAR != 1) { const bf16x8 kf = *(const LAS bf16x8*)(Kt + rfo[s] + jt * 4096); d = MFMA16(kf, qf[s], d); } else d[s] = __builtin_bit_cast(float, (int)qf[s][0]); }
            D[jt] = d;
        }
        int iq = 16 * wid + i16; OPAQUE(iq);
        bf16x8 pf[4];
#pragma unroll
        for (int ks = 0; ks < 4; ++ks) {
            float e[8];
#pragma unroll
            for (int t = 0; t < 2; ++t)
#pragma unroll
                for (int r = 0; r < 4; ++r) {
                    const int j = 16 * (2 * ks + t) + 4 * g + r; const float fdf = (float)(iq - j), ad = fabsf(fdf);
                    const float pos = fminf(fmaxf(fdf, 0.f), 1.f), isz = 1.f - fminf(ad, 1.f);
                    const float w = __builtin_amdgcn_exp2f((lb2 + (lf2 - lb2) * pos) * ad) + isz;
                    e[4 * t + r] = D[2 * ks + t][r] * w;
                }
            v4u pw; pw.x = cvtpk(e[0], e[1]); pw.y = cvtpk(e[2], e[3]); pw.z = cvtpk(e[4], e[5]); pw.w = cvtpk(e[6], e[7]);
            pf[ks] = __builtin_bit_cast(bf16x8, pw);
        }
        f32x4 acc[16];
#pragma unroll
        for (int vt = 0; vt < 16; ++vt) acc[vt] = (f32x4){0.f, 0.f, 0.f, 0.f};
#pragma unroll
        for (int dirn = 0; dirn < 2; ++dirn) {
            if (dirn == 1) __syncthreads();
            write_state();
            if (dirn == 0) { issue_state(sf, 1); if (has_next) issue_k(item + G); }
            else {
                if (has_next) {
#pragma unroll
                    for (int j = 0; j < 4; ++j) *(LAS v4u*)(Kt + kdst + j * 8192) = kreg[j]; }
                const GAS bf16* vs_ = vr + (tok0 + (tid >> 5)) * 1024 + h * 256 + (tid & 31) * 8;
#pragma unroll
                for (int j = 0; j < 8; ++j) sreg[j] = *(const GAS v4u*)(vs_ + (size_t)j * 16 * 1024);
            }
            __syncthreads();
#pragma unroll
            for (int vt = 0; vt < 16; ++vt) {
#pragma unroll
                for (int s = 0; s < 4; ++s) { if (VAR != 1) { const bf16x8 sfr = *(const LAS bf16x8*)(Sg + (vt >> 3) * 32768 + rfo[s] + (vt & 7) * 4096); acc[vt] = MFMA16(qf[s], sfr, acc[vt]); } }
            }
            float xs[4];
            { int ib = 16 * wid + 4 * g; OPAQUE(ib);
#pragma unroll
              for (int r = 0; r < 4; ++r) { const float lxf = lf2 * (float)(ib + r + 1), lxb = lb2 * (float)(128 - ib - r); xs[r] = __builtin_amdgcn_exp2f(dirn == 0 ? lxf - lxb : lxb); } }
#pragma unroll
            for (int vt = 0; vt < 16; ++vt)
#pragma unroll
                for (int r = 0; r < 4; ++r) acc[vt][r] *= xs[r];
        }
        __syncthreads();
        { int t2 = tid; OPAQUE(t2); const unsigned vd2 = (unsigned)((t2 & 31) >> 4) * 32768u + offb(t2 >> 5, t2 & 15);
#pragma unroll
          for (int j = 0; j < 8; ++j) *(LAS v4u*)(Sg + vd2 + j * 4096) = sreg[j]; }
        GAS bf16* gp = gr + (tok0 + 16 * wid + (lane >> 5)) * 1024 + h * 256 + (lane & 31) * 8;
#if MIX_FP8 & 4
        GAS unsigned char* ar8 = (GAS unsigned char*)(ws + WS_AR8) + (tok0 + 16 * wid + (lane >> 5)) * 1024 + h * 256 + (lane & 31) * 8;
#endif
        __syncthreads();
        unsigned vbs[8];
        { int l2 = lane; OPAQUE(l2); const unsigned g2 = l2 >> 4, q2 = (l2 & 15) >> 2, p2 = l2 & 3, X = (q2 << 2) | g2;
#pragma unroll
          for (int c = 0; c < 8; ++c) vbs[c] = 256 * (4 * g2 + q2) + 16 * (((2 * c) ^ (X & 14)) | ((p2 >> 1) ^ (X & 1))) + 8 * (p2 & 1); }
#pragma unroll
        for (int vt = 0; vt < 16; ++vt) {
#pragma unroll
            for (int ks = 0; ks < 4; ++ks) { if (VAR != 1) {
                const s16x4 lo = ldtr(Sg + vbs[vt & 7] + (vt >> 3) * 32768 + ks * 8192), hi = ldtr(Sg + vbs[vt & 7] + (vt >> 3) * 32768 + ks * 8192 + 4096);
                acc[vt] = MFMA16(pf[ks], cat8(lo, hi), acc[vt]); }
            }
            asm volatile("" ::: "memory");
        }
        float mu[4], rs[4];
#pragma unroll
        for (int r = 0; r < 4; ++r) {
            float s = 0.f;
#pragma unroll
            for (int vt = 0; vt < 16; ++vt) s += acc[vt][r];
            s += __shfl_xor(s, 1); s += __shfl_xor(s, 2); s += __shfl_xor(s, 4); s += __shfl_xor(s, 8);
            const float m = s * (1.f / 256.f); float qv = 0.f;
#pragma unroll
            for (int vt = 0; vt < 16; ++vt) { const float d = acc[vt][r] - m; qv += d * d; }
            qv += __shfl_xor(qv, 1); qv += __shfl_xor(qv, 2); qv += __shfl_xor(qv, 4); qv += __shfl_xor(qv, 8);
            mu[r] = m; rs[r] = 1.f / sqrtf(qv * (1.f / 256.f) + LN_EPSF);
        }
        v4u greg[8];
#pragma unroll
        for (int j = 0; j < 8; ++j) greg[j] = *(const GAS v4u*)(gp + (size_t)j * 2048);
        __syncthreads();
        if (has_next) { size_t tk; const GAS bf16* sfn; int hn; item_ptrs(item + G, tk, sfn, hn); issue_state(sfn, 0); issue_q(item + G); }
        LAS bf16* st = (LAS bf16*)(Sg + wid * 8192);
        { LAS bf16* sp_ = st + (4 * g) * 256 + i16;
#pragma unroll
          for (int vt = 0; vt < 16; ++vt)
#pragma unroll
              for (int r = 0; r < 4; ++r) sp_[r * 256 + 16 * vt] = (bf16)(cvtpk((acc[vt][r] - mu[r]) * rs[r], 0.f) & 0xffffu); }
        asm volatile("s_waitcnt lgkmcnt(0)" ::: "memory");
        {
            const float* gn = a.in[4] + h * 256; const int ch = lane & 31;
            const f32x4 g0 = *(const f32x4*)(gn + ch * 8), g1 = *(const f32x4*)(gn + ch * 8 + 4);
            const LAS bf16* yp = st + (lane >> 5) * 256 + ch * 8;
#pragma unroll
            for (int j = 0; j < 8; ++j) {
                const v4u y = *(const LAS v4u*)(yp + j * 512); const v4u sg = greg[j];
                v4u o; o.x = cvtpk(bflo(y.x) * g0[0] * bflo(sg.x), bfhi(y.x) * g0[1] * bfhi(sg.x)); o.y = cvtpk(bflo(y.y) * g0[2] * bflo(sg.y), bfhi(y.y) * g0[3] * bfhi(sg.y));
                o.z = cvtpk(bflo(y.z) * g1[0] * bflo(sg.z), bfhi(y.z) * g1[1] * bfhi(sg.z)); o.w = cvtpk(bflo(y.w) * g1[2] * bflo(sg.w), bfhi(y.w) * g1[3] * bfhi(sg.w));
#if MIX_FP8 & 4
                u32x2 o8; o8.x = pk_fp8x4(bflo(o.x), bfhi(o.x), bflo(o.y), bfhi(o.y)); o8.y = pk_fp8x4(bflo(o.z), bfhi(o.z), bflo(o.w), bfhi(o.w));
                *(GAS u32x2*)(ar8 + (size_t)j * 2048) = o8;
#else
                *(GAS v4u*)(gp + (size_t)j * 2048) = o;
#endif
            }
        }
        __syncthreads();
    }
}

constexpr int P6_RS = 81920, P6_CNT = P6_RS + 8 * 512, P6_BASE = P6_CNT + 64, P6_ROW = P6_BASE + 64;
#define P6_BUTTERFLY(lg, out) do { float r10[10], r5[5], r3[3], r2[2]; const float z = 0.f; \
    _Pragma("unroll") for (int k = 0; k < 10; ++k) { const float keep = h32 ? lg[10 + k] : lg[k], send = h32 ? lg[k] : lg[10 + k]; r10[k] = keep + __shfl_xor(send, 32); } \
    _Pragma("unroll") for (int k = 0; k < 5; ++k) { const float keep = h16 ? r10[5 + k] : r10[k], send = h16 ? r10[k] : r10[5 + k]; r5[k] = keep + __shfl_xor(send, 16); } \
    { const float keep = h8 ? r5[3] : r5[0], send = h8 ? r5[0] : r5[3]; r3[0] = keep + __shfl_xor(send, 8); } \
    { const float keep = h8 ? r5[4] : r5[1], send = h8 ? r5[1] : r5[4]; r3[1] = keep + __shfl_xor(send, 8); } \
    { const float keep = h8 ? z : r5[2], send = h8 ? r5[2] : z; r3[2] = keep + __shfl_xor(send, 8); } \
    { const float keep = h4 ? r3[2] : r3[0], send = h4 ? r3[0] : r3[2]; r2[0] = keep + __shfl_xor(send, 4); } \
    { const float keep = h4 ? z : r3[1], send = h4 ? r3[1] : z; r2[1] = keep + __shfl_xor(send, 4); } \
    { const float keep = h2 ? r2[1] : r2[0], send = h2 ? r2[0] : r2[1]; out = keep + __shfl_xor(send, 2); } \
    out += __shfl_xor(out, 1); } while (0)
__device__ __forceinline__ void p6a_phase(const Args& a, LAS unsigned char* lds, int vcu, int G, int tid, int wave, int lane) {
    unsigned char* ws = a.ws;
    LAS float* RW = (LAS float*)lds;
    LAS float* RS = (LAS float*)(lds + P6_RS) + wave * 128;
    LAS unsigned* LC = (LAS unsigned*)(lds + P6_CNT); LAS unsigned* LB = (LAS unsigned*)(lds + P6_BASE); LAS unsigned* LR = (LAS unsigned*)(lds + P6_ROW);
    for (int i = tid; i < 1024 * 4; i += 512) { const int c = i >> 2, k = i & 3; RW[k * 1024 + c] = a.in[11][i]; }
    for (int i = tid; i < 1024 * 16; i += 512) { const int c = i >> 4, k = i & 15; RW[(4 + k) * 1024 + c] = a.in[13][i]; }
    const u32x2* pre = (const u32x2*)a.out; u32x2* x1b = (u32x2*)(ws + WS_XB); [[maybe_unused]] unsigned* x1f8 = (unsigned*)(ws + WS_X1F8);
    gu32* ctl = (gu32*)ws;
    int* ltok = (int*)(ws + WS_LTOK); float* tw = (float*)(ws + WS_WSLOT); unsigned* tinfo = (unsigned*)(ws + WS_TINFO);
    const float* g1 = a.in[9]; const float* b1 = a.in[10];
    const bool h32 = (lane & 32) != 0, h16 = (lane & 16) != 0, h8 = (lane & 8) != 0, h4 = (lane & 4) != 0, h2 = (lane & 2) != 0;
#define P6_LOADROW(dst, t_) do { const u32x2* xr_ = pre + (size_t)(t_) * 256 + lane; _Pragma("unroll") for (int j = 0; j < 4; ++j) dst[j] = xr_[64 * j]; } while (0)
#define P6_LN(v, nx, s) do { s = 0.f; _Pragma("unroll") for (int j = 0; j < 4; ++j) { v[j] = (f32x4){bflo(nx[j].x), bfhi(nx[j].x), bflo(nx[j].y), bfhi(nx[j].y)}; s += (v[j].x + v[j].y) + (v[j].z + v[j].w); } } while (0)
#define P6_VAR(v, mean, q) do { q = 0.f; _Pragma("unroll") for (int j = 0; j < 4; ++j) { v[j] = v[j] - mean; q += (v[j].x * v[j].x + v[j].y * v[j].y) + (v[j].z * v[j].z + v[j].w * v[j].w); } } while (0)
#if M1_FP8
#define P6_STORE(v, t_, j) do { u32x2 o_; o_.x = cvtpk(v[j].x, v[j].y); o_.y = cvtpk(v[j].z, v[j].w); x1b[(size_t)(t_) * 256 + lane + 64 * j] = o_; x1f8[(size_t)(t_) * 256 + lane + 64 * j] = pk_fp8x4(v[j].x, v[j].y, v[j].z, v[j].w); } while (0)
#else
#define P6_STORE(v, t_, j) do { u32x2 o_; o_.x = cvtpk(v[j].x, v[j].y); o_.y = cvtpk(v[j].z, v[j].w); x1b[(size_t)(t_) * 256 + lane + 64 * j] = o_; } while (0)
#endif
#define P6_DOT(lg, v, j, k, w) lg[k] += (v[j][0] * w[0] + v[j][1] * w[1]) + (v[j][2] * w[2] + v[j][3] * w[3])
    for (int blk = vcu; blk < TT / 128; blk += G) {
        if (tid < 16) LC[tid] = 0u;
        __syncthreads();
        const int t0 = blk * 128;
        u32x2 nxA[4], nxB[4], nxC[4], nxD[4];
        P6_LOADROW(nxA, t0 + wave); P6_LOADROW(nxB, t0 + wave + 8); P6_LOADROW(nxC, t0 + wave + 16); P6_LOADROW(nxD, t0 + wave + 24);
        for (int rr = 0; rr < 4; ++rr) {
            const int rl0 = wave + 32 * rr, tA = t0 + rl0, tB = tA + 8, tC = tA + 16, tD = tA + 24;
            f32x4 vA[4], vB[4], vC[4], vD[4]; float sA, sB, sC, sD;
            P6_LN(vA, nxA, sA); P6_LN(vB, nxB, sB); P6_LN(vC, nxC, sC); P6_LN(vD, nxD, sD);
            if (rr < 3) { P6_LOADROW(nxA, tA + 32); P6_LOADROW(nxB, tB + 32); P6_LOADROW(nxC, tC + 32); P6_LOADROW(nxD, tD + 32); }
            const float mA = wave_sum(sA) * (1.f / DM), mB = wave_sum(sB) * (1.f / DM), mC = wave_sum(sC) * (1.f / DM), mD = wave_sum(sD) * (1.f / DM);
            float qA, qB, qC, qD;
            P6_VAR(vA, mA, qA); P6_VAR(vB, mB, qB); P6_VAR(vC, mC, qC); P6_VAR(vD, mD, qD);
            const float rA = 1.f / sqrtf(wave_sum(qA) * (1.f / DM) + LN_EPSF), rB = 1.f / sqrtf(wave_sum(qB) * (1.f / DM) + LN_EPSF);
            const float rC = 1.f / sqrtf(wave_sum(qC) * (1.f / DM) + LN_EPSF), rD = 1.f / sqrtf(wave_sum(qD) * (1.f / DM) + LN_EPSF);
            float lgA[20], lgB[20], lgC[20], lgD[20];
#pragma unroll
            for (int k = 0; k < 20; ++k) { lgA[k] = 0.f; lgB[k] = 0.f; lgC[k] = 0.f; lgD[k] = 0.f; }
#pragma unroll
            for (int j = 0; j < 4; ++j) {
                const f32x4 gg = *(const f32x4*)(g1 + 4 * lane + 256 * j), bb = *(const f32x4*)(b1 + 4 * lane + 256 * j);
                vA[j] = vA[j] * rA * gg + bb; vB[j] = vB[j] * rB * gg + bb; vC[j] = vC[j] * rC * gg + bb; vD[j] = vD[j] * rD * gg + bb;
                P6_STORE(vA, tA, j); P6_STORE(vB, tB, j); P6_STORE(vC, tC, j); P6_STORE(vD, tD, j);
#pragma unroll
                for (int k = 0; k < 20; ++k) { const f32x4 w = *(const LAS f32x4*)(RW + k * 1024 + 4 * lane + 256 * j);
                    P6_DOT(lgA, vA, j, k, w); P6_DOT(lgB, vB, j, k, w); P6_DOT(lgC, vC, j, k, w); P6_DOT(lgD, vD, j, k, w); }
            }
            float r1A, r1B, r1C, r1D;
            P6_BUTTERFLY(lgA, r1A); P6_BUTTERFLY(lgB, r1B); P6_BUTTERFLY(lgC, r1C); P6_BUTTERFLY(lgD, r1D);
            {
                const int i3 = h2 ? (h4 ? -1 : 1) : (h4 ? 2 : 0);
                const int i5 = i3 < 0 ? -1 : (h8 ? (i3 == 2 ? -1 : i3 + 3) : i3);
                const int kk = i5 < 0 ? -1 : (h32 ? 10 : 0) + (h16 ? 5 : 0) + i5;
                if (kk >= 0 && (lane & 1) == 0) { RS[kk] = r1A; RS[32 + kk] = r1B; RS[64 + kk] = r1C; RS[96 + kk] = r1D; }
            }
            asm volatile("s_waitcnt lgkmcnt(0)" ::: "memory");
            {
                const int sel = lane & 3; const int rl = rl0 + 8 * sel;
                float tl[20];
#pragma unroll
                for (int k4 = 0; k4 < 5; ++k4) { const f32x4 w = *(const LAS f32x4*)(RS + sel * 32 + 4 * k4); tl[4 * k4] = w[0]; tl[4 * k4 + 1] = w[1]; tl[4 * k4 + 2] = w[2]; tl[4 * k4 + 3] = w[3]; }
                float gl[4];
#pragma unroll
                for (int k = 0; k < 4; ++k) gl[k] = tl[k] + a.in[12][k];
                int gi = 0; float gm = gl[0];
#pragma unroll
                for (int k = 1; k < 4; ++k) if (gl[k] > gm) { gm = gl[k]; gi = k; }
                float gs = 0.f;
#pragma unroll
                for (int k = 0; k < 4; ++k) gs += __expf(gl[k] - gm);
                const float gwt = 1.f / gs;
                float el[4];
#pragma unroll
                for (int k = 0; k < 4; ++k) { const float se = gi == 0 ? tl[4 + k] : (gi == 1 ? tl[8 + k] : (gi == 2 ? tl[12 + k] : tl[16 + k])); el[k] = se + a.in[14][4 * gi + k]; }
                int i1 = 0; float v1 = el[0];
#pragma unroll
                for (int k = 1; k < 4; ++k) if (el[k] > v1) { v1 = el[k]; i1 = k; }
                int i2 = (i1 + 1) & 3; float v2 = -3.0e38f;
#pragma unroll
                for (int k = 0; k < 4; ++k) if (k != i1 && el[k] > v2) { v2 = el[k]; i2 = k; }
                const float ex = __expf(v2 - v1), w1 = gwt / (1.f + ex), w2 = gwt * ex / (1.f + ex);
                if (lane < 4) {
                    const int e1 = 4 * gi + i1, e2 = 4 * gi + i2;
                    const unsigned p1 = __hip_atomic_fetch_add(LC + e1, 1u, __ATOMIC_RELAXED, __HIP_MEMORY_SCOPE_WORKGROUP);
                    const unsigned p2 = __hip_atomic_fetch_add(LC + e2, 1u, __ATOMIC_RELAXED, __HIP_MEMORY_SCOPE_WORKGROUP);
                    LR[rl * 4 + 0] = ((unsigned)e1 << 16) | p1; LR[rl * 4 + 1] = ((unsigned)e2 << 16) | p2; LR[rl * 4 + 2] = __float_as_uint(w1); LR[rl * 4 + 3] = __float_as_uint(w2);
                }
            }
            asm volatile("s_waitcnt lgkmcnt(0)" ::: "memory");
        }
        __syncthreads();
        if (tid < 16) LB[tid] = __hip_atomic_fetch_add(ctl + CW_CNT + 64 * tid, LC[tid], __ATOMIC_RELAXED, __HIP_MEMORY_SCOPE_AGENT);
        __syncthreads();
        if (tid < 256) {
            const int rl = tid >> 1, j = tid & 1; const unsigned rec = LR[rl * 4 + j]; const unsigned e = rec >> 16, pos = LB[e] + (rec & 0xffffu);
            ltok[e * TT + pos] = t0 + rl; tw[2 * (t0 + rl) + j] = __uint_as_float(LR[rl * 4 + 2 + j]); tinfo[2 * (t0 + rl) + j] = (e << 16) | pos;
        }
        __syncthreads();
    }
#undef P6_LOADROW
#undef P6_LN
#undef P6_VAR
#undef P6_STORE
#undef P6_DOT
}
__device__ __forceinline__ void build_tile_tables(const Args& a, LAS unsigned char* lds, int tid) {
    LAS int* ts = (LAS int*)(lds + LDS_TS_OFF); LAS int* te = (LAS int*)(lds + LDS_TE_OFF); LAS int* cn = (LAS int*)(lds + LDS_CNT_OFF);
    gu32* ctl = (gu32*)a.ws;
    if (tid == 0) { int acc = 0;
        for (int e = 0; e < 16; ++e) { ts[e] = acc; const int c = (int)__hip_atomic_load(ctl + CW_CNT + 64 * e, __ATOMIC_RELAXED, __HIP_MEMORY_SCOPE_AGENT); const int nt = (c + 255) >> 8; cn[e] = c;
            for (int k = 0; k < nt; ++k) te[acc + k] = e; acc += nt; }
        ts[16] = acc; }
    __syncthreads();
}
__device__ __forceinline__ void p9_phase(const Args& a, LAS unsigned char* lds, int vcu, int G, int wave, int lane) {
    unsigned char* ws = a.ws;
    const LAS int* ts = (const LAS int*)(lds + LDS_TS_OFF);
    const unsigned* tinfo = (const unsigned*)(ws + WS_TINFO); const u32x2* Y = (const u32x2*)(ws + WS_Y);
    const float* g2 = a.in[18]; const float* b2 = a.in[19];
    const int gw = vcu * NWAVES + wave, NGW = G * NWAVES;
#if Y_FP8
    const unsigned* Y8 = (const unsigned*)(ws + WS_Y); unsigned ny0[4], ny1[4]; u32x2 nxw[4]; float nw0 = 0.f, nw1 = 0.f;
#else
    u32x2 ny0[4], ny1[4], nxw[4]; float nw0 = 0.f, nw1 = 0.f;
#endif
    const float* tw = (const float*)(ws + WS_WSLOT);
    auto issue = [&](int t) {
        const unsigned i0 = tinfo[2 * t], i1 = tinfo[2 * t + 1];
        nw0 = tw[2 * t]; nw1 = tw[2 * t + 1];
        const size_t s0 = (size_t)ts[i0 >> 16] * 256 + (i0 & 0xffffu), s1 = (size_t)ts[i1 >> 16] * 256 + (i1 & 0xffffu);
        const u32x2* xb1 = (const u32x2*)(ws + WS_XB) + (size_t)t * 256 + lane;
#pragma unroll
#if Y_FP8
        for (int j = 0; j < 4; ++j) { ny0[j] = Y8[s0 * 256 + lane + 64 * j]; ny1[j] = Y8[s1 * 256 + lane + 64 * j]; nxw[j] = xb1[64 * j]; }
#else
        for (int j = 0; j < 4; ++j) { ny0[j] = Y[s0 * 256 + lane + 64 * j]; ny1[j] = Y[s1 * 256 + lane + 64 * j]; nxw[j] = xb1[64 * j]; }
#endif
    };
    if (gw < TT) issue(gw);
    for (int t = gw; t < TT; t += NGW) {
        f32x4* xr = (f32x4*)(a.out + (size_t)t * DM) + lane;
#if Y_FP8
        f32x4 v[4]; float s = 0.f; const float w0 = nw0 * 0.0625f, w1 = nw1 * 0.0625f;
#pragma unroll
        for (int j = 0; j < 4; ++j) {
            const unsigned y0 = ny0[j], y1 = ny1[j]; const u32x2 xw = nxw[j];
            typedef float f32x2_ __attribute__((ext_vector_type(2)));
            const f32x2_ a0 = __builtin_amdgcn_cvt_pk_f32_fp8(y0, false), a1 = __builtin_amdgcn_cvt_pk_f32_fp8(y0, true), c0 = __builtin_amdgcn_cvt_pk_f32_fp8(y1, false), c1 = __builtin_amdgcn_cvt_pk_f32_fp8(y1, true);
            f32x4 x = (f32x4){bflo(xw.x), bfhi(xw.x), bflo(xw.y), bfhi(xw.y)} * DN_ALPHA;
            x.x += w0 * a0[0] + w1 * c0[0]; x.y += w0 * a0[1] + w1 * c0[1]; x.z += w0 * a1[0] + w1 * c1[0]; x.w += w0 * a1[1] + w1 * c1[1];
            v[j] = x; s += (x.x + x.y) + (x.z + x.w);
        }
#else
        f32x4 v[4]; float s = 0.f; const float w0 = nw0, w1 = nw1;
#pragma unroll
        for (int j = 0; j < 4; ++j) {
            const u32x2 y0 = ny0[j], y1 = ny1[j], xw = nxw[j];
            f32x4 x = (f32x4){bflo(xw.x), bfhi(xw.x), bflo(xw.y), bfhi(xw.y)} * DN_ALPHA;
            x.x += w0 * bflo(y0.x) + w1 * bflo(y1.x); x.y += w0 * bfhi(y0.x) + w1 * bfhi(y1.x); x.z += w0 * bflo(y0.y) + w1 * bflo(y1.y); x.w += w0 * bfhi(y0.y) + w1 * bfhi(y1.y);
            v[j] = x; s += (x.x + x.y) + (x.z + x.w);
        }
#endif
        if (t + NGW < TT) issue(t + NGW);
        const float mean = wave_sum(s) * (1.f / DM); float s2 = 0.f;
#pragma unroll
        for (int j = 0; j < 4; ++j) { v[j] = v[j] - mean; s2 += (v[j].x * v[j].x + v[j].y * v[j].y) + (v[j].z * v[j].z + v[j].w * v[j].w); }
        const float rstd = 1.f / sqrtf(wave_sum(s2) * (1.f / DM) + LN_EPSF);
#pragma unroll
        for (int j = 0; j < 4; ++j) { const f32x4 gg = *(const f32x4*)(g2 + 4 * lane + 256 * j), bb = *(const f32x4*)(b2 + 4 * lane + 256 * j); xr[64 * j] = v[j] * rstd * gg + bb; }
    }
}

__global__ void __launch_bounds__(NWAVES * 64, 2) mega_fwd(Args args) {
    extern __shared__ __attribute__((aligned(16))) unsigned char lds_raw[];
    LAS unsigned char* lds = (LAS unsigned char*)lds_raw;
    volatile LAS unsigned* MISC = (volatile LAS unsigned*)(lds + MISC_OFF);
    const int tid0 = threadIdx.x, wave = __builtin_amdgcn_readfirstlane(tid0 >> 6);
    const int G = gridDim.x, bx = blockIdx.x, vcu = (G % 8 == 0) ? (bx % 8) * (G / 8) + bx / 8 : bx;
    for (int u = tid0; u < (LDS_BYTES - LDSCTL_OFF) / 4; u += NWAVES * 64) ((LAS unsigned*)(lds + LDSCTL_OFF))[u] = 0u;
    __syncthreads();
    unsigned char* ws = args.ws;
    gu32* ctl = (gu32*)ws;
    const bool bars_on = (args.mask >> 31) != 0u;
    XcdBarrier bar; bar.bar = (unsigned*)(ctl + CW_BAR) + args.bar_region * XCD_BAR_WORDS; bar.x = 0; bar.st = nullptr;
    if (bars_on) bar = xcd_barrier_post((unsigned*)(ctl + CW_BAR) + args.bar_region * XCD_BAR_WORDS, MISC + 8);
    bar.wv = wave;
#define GRID_BAR() do { if (bars_on) xcd_barrier(bar); } while (0)
#ifndef PH_LAST
#define PH_LAST 99
#endif
#define FRESH() int tid = wave * 64 + pg8::lane_id(); asm volatile("" : "+v"(tid)); const int lane = tid & 63; (void)lane
#ifndef RMASK
#define RMASK 0
#endif
#define REP(k) _Pragma("unroll") for (int rep_ = 0; rep_ < 1 + ((RMASK >> (k)) & 1); ++rep_)
#ifndef STAMP_SCALE
#define STAMP_SCALE 1.0f
#endif
#ifdef STAMP_PH
#define ST_B(k) if ((k) == STAMP_PH) { st_a = rt(); }
#define ST_E(k) if ((k) == STAMP_PH) { st_b = rt(); }
#else
#define ST_B(k)
#define ST_E(k)
#endif
#ifdef ONLY
#define EN(k) (ONLY == (k))
#else
#define EN(k) ((args.mask >> (k)) & 1u)
#endif
    unsigned long long st_a = 0, st_b = 0; (void)st_a; (void)st_b;
    REP(0) if (EN(0)) { FRESH(); p0_prologue(args, lds, vcu, G, tid, wave, lane); }
    GRID_BAR();
#ifdef STAGGER_TICKS
    if (EN(1) && (bx & 8)) { const unsigned long long t0_ = rt(); while (rt() - t0_ < STAGGER_TICKS) __builtin_amdgcn_s_sleep(32); }
#endif
    REP(1) if (EN(1)) {
#if P1_FP8
        pg8::EpiHcat E{ws, (const float*)(ws + WS_ROT), 0};
        if (P1_FP8_FROM > 0) {
            pg8::Gemm g{(const pg8::bf16_t*)(ws + WS_XB), (const pg8::bf16_t*)(ws + WS_WIN), TT, 4608, 1024}; pg8::StaticOrder S; S.init(TT, 256 * P1_FP8_FROM, G, bx);
            pg8::gemm_phase<pg8::EpiHcat, pg8::StaticOrder, true, true>(lds, g, S, E, wave);
        }
        {
#if GATE_FP8
            pg8::Gemm g{(const pg8::bf16_t*)(ws + WS_X8_LO), (const pg8::bf16_t*)(ws + WS_WIN8), TT, 4608, 512, 64, (long)WS_X8_HI - (long)WS_X8_LO - (long)(16 * MiB)}; pg8::StaticOrder S;
#else
            pg8::Gemm g{(const pg8::bf16_t*)args.out, (const pg8::bf16_t*)(ws + WS_WIN8), TT, 4608, 512}; pg8::StaticOrder S;
#endif
            S.init(TT, 4608 - 256 * P1_FP8_FROM, G, bx, P1_FP8_FROM);
            pg8::gemm_phase<pg8::EpiHcat, pg8::StaticOrder, true, true, false, true, 1, 0>(lds, g, S, E, wave);
        }
#else
        pg8::Gemm g{(const pg8::bf16_t*)(ws + WS_XB), (const pg8::bf16_t*)(ws + WS_WIN), TT, 4608, 1024}; pg8::StaticOrder S; S.init(TT, 4608, G, bx);
        pg8::EpiHcat E{ws, (const float*)(ws + WS_ROT), 0};
        pg8::gemm_phase<pg8::EpiHcat, pg8::StaticOrder, true, true>(lds, g, S, E, wave);
#endif
    }
    GRID_BAR();
    if (PH_LAST >= 2) {
        REP(2) if (EN(2)) { FRESH(); for (int it = vcu; it < 256; it += G) chain_item(args, lds, it, tid, wave, lane); }
        if (EN(3)) { { FRESH(); attn_dil_phase<16>(args, lds, vcu, G, tid, wave, lane); }
                     { FRESH(); attn_dil_phase<4>(args, lds, vcu, G, tid, wave, lane); } }
    }
    GRID_BAR();
    ST_B(4) if (PH_LAST >= 3 && EN(4)) { FRESH(); p3_phase<0>(args, lds, vcu, G, tid, wave, lane); }
    if (EN(13)) { FRESH(); attn_p1_phase(args, lds, vcu, G, tid, wave, lane); }
    GRID_BAR(); ST_E(4)
    if (EN(14)) { FRESH(); p0_expert_weights(args, lds, vcu, G, wave, lane); }
    REP(5) if (PH_LAST >= 4 && EN(5)) {
        pg8::GateOrder S; S.S4.init(TT, 1024, G, bx);
        pg8::EpiHcat E{ws, (const float*)(ws + WS_ROT), 18};
#if GATE_FP8
        pg8::Gemm g{(const pg8::bf16_t*)(ws + WS_X8_LO), (const pg8::bf16_t*)(ws + WS_WIN8 + (size_t)4608 * 1024), TT, 2048, 512, 64, (long)WS_X8_HI - (long)WS_X8_LO - (long)(16 * MiB)};
        pg8::gemm_phase<pg8::EpiHcat, pg8::GateOrder, true, true, false, true, 1, 0>(lds, g, S, E, wave);
#else
        pg8::Gemm g{(const pg8::bf16_t*)(ws + WS_XB), (const pg8::bf16_t*)(ws + WS_WIN) + (size_t)4608 * 1024, TT, 2048, 1024};
        pg8::gemm_phase<pg8::EpiHcat, pg8::GateOrder, true, true>(lds, g, S, E, wave);
#endif
        asm volatile("s_waitcnt vmcnt(0)" ::: "memory"); __syncthreads();
    }
    REP(6) if (PH_LAST >= 5 && EN(6)) {
        pg8::StaticOrder S; S.init(TT, 1024, G, bx);
        { pg8::EpiGate<false> E{(const pg8::bf16_t*)(ws + WS_GATE_A), (pg8::bf16_t*)(ws + WS_MERGED), nullptr};
#if MIX_FP8 & 2
          pg8::Gemm g{(const pg8::bf16_t*)(ws + WS_OA), (const pg8::bf16_t*)(ws + WS_WA), TT, 1024, 256};
          pg8::gemm_phase<pg8::EpiGate<false>, pg8::StaticOrder, true, true, false, true, 1, 3>(lds, g, S, E, wave);
#else
          pg8::Gemm g{(const pg8::bf16_t*)(ws + WS_OA), (const pg8::bf16_t*)(ws + WS_WA), TT, 1024, 512};
          pg8::gemm_phase<pg8::EpiGate<false>, pg8::StaticOrder, true, true>(lds, g, S, E, wave);
#endif
        }
        asm volatile("s_waitcnt vmcnt(0)" ::: "memory"); __syncthreads();
        { typedef pg8::EpiGate<true, (MIX_FP8 & 1) != 0> EpiC;
          EpiC E{(const pg8::bf16_t*)(ws + WS_GATE_R), (pg8::bf16_t*)(ws + WS_MERGED), ws + WS_MERGED8};
#if MIX_FP8 & 4
          pg8::Gemm g{(const pg8::bf16_t*)(ws + WS_AR8), (const pg8::bf16_t*)(ws + WS_WR), TT, 1024, 512};
          pg8::gemm_phase<EpiC, pg8::StaticOrder, true, true, false, true, 1, 0>(lds, g, S, E, wave);
#else
          pg8::Gemm g{(const pg8::bf16_t*)(ws + WS_GR), (const pg8::bf16_t*)(ws + WS_WR), TT, 1024, 1024};
          pg8::gemm_phase<EpiC, pg8::StaticOrder, true, true>(lds, g, S, E, wave);
#endif
        }
    }
    GRID_BAR();
    REP(7) if (PH_LAST >= 6 && EN(7)) {
        pg8::StaticOrder S; S.init(TT, 1024, G, bx);
        pg8::EpiResBf16 E{(const pg8::bf16_t*)(ws + WS_XB), (pg8::bf16_t*)args.out, DN_ALPHA};
#if MIX_FP8 & 1
        pg8::Gemm g{(const pg8::bf16_t*)(ws + WS_MERGED8), (const pg8::bf16_t*)(ws + WS_WO), TT, 1024, 512};
        pg8::gemm_phase<pg8::EpiResBf16, pg8::StaticOrder, true, true, false, true, 1, 3>(lds, g, S, E, wave);
#else
        pg8::Gemm g{(const pg8::bf16_t*)(ws + WS_MERGED), (const pg8::bf16_t*)(ws + WS_WO), TT, 1024, 1024};
        pg8::gemm_phase<pg8::EpiResBf16, pg8::StaticOrder, true, true>(lds, g, S, E, wave);
#endif
    }
    GRID_BAR();
    ST_B(8) if (PH_LAST >= 7 && EN(8)) { FRESH(); p6a_phase(args, lds, vcu, G, tid, wave, lane); }
    GRID_BAR(); ST_E(8)
    { FRESH(); build_tile_tables(args, lds, tid); }
    const int nrt = ((const LAS int*)(lds + LDS_TS_OFF))[16];
    REP(10) if (PH_LAST >= 9 && EN(10)) {
#if M1_FP8
        pg8::Gemm g{(const pg8::bf16_t*)(ws + WS_X1F8), (const pg8::bf16_t*)(ws + WS_WGU), MAXSLOT, 1024, 512};
        pg8::MoeOrder S{nrt * 4, G, vcu, (const LAS int*)(lds + LDS_TE_OFF), (const LAS int*)(lds + LDS_TS_OFF), (const LAS int*)(lds + LDS_CNT_OFF), (const int*)(ws + WS_LTOK), 1024u};
        pg8::EpiSwiGLU E{ws + WS_H};
        pg8::gemm_phase<pg8::EpiSwiGLU, pg8::MoeOrder, true, true, true, true, 1, 0>(lds, g, S, E, wave);
#else
        pg8::Gemm g{(const pg8::bf16_t*)(ws + WS_XB), (const pg8::bf16_t*)(ws + WS_WGU), MAXSLOT, 1024, 1024};
        pg8::MoeOrder S{nrt * 4, G, vcu, (const LAS int*)(lds + LDS_TE_OFF), (const LAS int*)(lds + LDS_TS_OFF), (const LAS int*)(lds + LDS_CNT_OFF), (const int*)(ws + WS_LTOK), 2048u};
        pg8::EpiSwiGLU E{ws + WS_H};
        pg8::gemm_phase<pg8::EpiSwiGLU, pg8::MoeOrder, true, true, true>(lds, g, S, E, wave);
#endif
    }
    GRID_BAR();
    REP(11) if (PH_LAST >= 10 && EN(11)) {
        pg8::Gemm g{(const pg8::bf16_t*)(ws + WS_H), (const pg8::bf16_t*)(ws + WS_WD), MAXSLOT, 1024, 256};
        pg8::MoeOrder S{nrt * 4, G, vcu, (const LAS int*)(lds + LDS_TE_OFF), (const LAS int*)(lds + LDS_TS_OFF), (const LAS int*)(lds + LDS_CNT_OFF), (const int*)(ws + WS_LTOK), 1024u};
        pg8::EpiRowScale E{(pg8::bf16_t*)(ws + WS_Y)};
        pg8::gemm_phase<pg8::EpiRowScale, pg8::MoeOrder, true, true, false, true, 1, 2>(lds, g, S, E, wave);
    }
    GRID_BAR();
    ST_B(12) if (PH_LAST >= 11 && EN(12)) { FRESH(); p9_phase(args, lds, vcu, G, wave, lane); }
#ifdef STAMP_PH
    GRID_BAR(); ST_E(12)
    if (STAMP_PH == 13) { st_a = rt(); GRID_BAR(); GRID_BAR(); GRID_BAR(); GRID_BAR(); st_b = rt(); }
    if (bx == 0 && tid0 == 0) { const float us = (float)(st_b - st_a) * 0.01f * STAMP_SCALE; int k = 0; float lim = 30.f; while (us >= lim && k < 12) { lim *= 1.5f; ++k; }
        __hip_atomic_store(ctl + CW_CHK, __float_as_uint(sqrtf(2.f * k + 2.f)), RLX_AGENT); }
    GRID_BAR();
    { const float c = __uint_as_float(__hip_atomic_load(ctl + CW_CHK, RLX_AGENT)); f32x4* o4 = (f32x4*)args.out;
      for (size_t i = (size_t)bx * 512 + tid0; i < (size_t)TT * DM / 4; i += (size_t)G * 512) o4[i] = (f32x4){c, c, c, c}; }
#endif
}

#ifdef PROBE_VAR
__global__ void __launch_bounds__(NWAVES * 64, 2) probe_kernel(Args args) {
    extern __shared__ __attribute__((aligned(16))) unsigned char lds_raw[];
    LAS unsigned char* lds = (LAS unsigned char*)lds_raw;
    const int tid0 = threadIdx.x, wave = __builtin_amdgcn_readfirstlane(tid0 >> 6);
    const int G = gridDim.x, bx = blockIdx.x, vcu = (G % 8 == 0) ? (bx % 8) * (G / 8) + bx / 8 : bx;
    FRESH();
    if (PROBE_VAR == 20 || PROBE_VAR == 21) {
        unsigned char* ws = args.ws;
        pg8::Gemm g{(const pg8::bf16_t*)(ws + WS_XB), (const pg8::bf16_t*)(ws + WS_WIN), TT, 4608, 1024}; pg8::StaticOrder S; S.init(TT, 4608, G, bx);
        pg8::EpiHcatT<PROBE_VAR == 21 ? 1 : 0> E{ws, (const float*)(ws + WS_ROT), 0};
        pg8::gemm_phase<pg8::EpiHcatT<PROBE_VAR == 21 ? 1 : 0>, pg8::StaticOrder, true, true>(lds, g, S, E, wave);
    }
    if (PROBE_VAR == 10) p3_phase<0>(args, lds, vcu, G, tid, wave, lane);
    if (PROBE_VAR == 11) p3_phase<1>(args, lds, vcu, G, tid, wave, lane);
    if (PROBE_VAR == 0) attn_dil_phase<16, 0>(args, lds, vcu, G, tid, wave, lane);
    if (PROBE_VAR == 1) attn_dil_phase<16, 1>(args, lds, vcu, G, tid, wave, lane);
    if (PROBE_VAR == 2) attn_dil_phase<4, 0>(args, lds, vcu, G, tid, wave, lane);
    if (PROBE_VAR == 3) attn_dil_phase<4, 1>(args, lds, vcu, G, tid, wave, lane);
}
#endif
extern "C" void kernel_launch(void* const* d_in, const int* in_sizes, int n_in, void* d_out, int out_size, void* d_ws, size_t ws_size, hipStream_t stream) {
    static int grid = 0;
    if (grid == 0) {
        if (n_in != 20 || in_sizes[0] != TT * DM || out_size != TT * DM || ws_size < WS_END) { fprintf(stderr, "kernel_launch: unexpected shapes: n_in %d in0 %d out %d ws %zu; nothing launched\n", n_in, n_in > 0 ? in_sizes[0] : -1, out_size, ws_size); grid = -1; return; }
        int dev = 0, cus = 0;
        if (hipGetDevice(&dev) != hipSuccess || hipDeviceGetAttribute(&cus, hipDeviceAttributeMultiprocessorCount, dev) != hipSuccess) { grid = -1; return; }
        if (hipFuncSetAttribute((const void*)mega_fwd, hipFuncAttributeMaxDynamicSharedMemorySize, LDS_BYTES) != hipSuccess) { fprintf(stderr, "kernel_launch: hipFuncSetAttribute failed\n"); grid = -1; return; }
        (void)hipGetLastError();
        grid = cus;
    }
    if (grid < 0) return;
    if (hipMemsetAsync((char*)d_ws, 0, CTL_ZERO_BYTES, stream) != hipSuccess) return;
    Args a{};
    for (int i = 0; i < 20; ++i) a.in[i] = (const float*)d_in[i];
    a.out = (float*)d_out; a.ws = (unsigned char*)d_ws; a.mask = 0x80007fffu; a.bar_region = 0;
#if defined(XTRA_FIRST)
    { Args x = a; x.mask = XTRA_FIRST; x.bar_region = 1; for (int r = 0; r < XTRA_REP; ++r) hipLaunchKernelGGL(mega_fwd, dim3(grid), dim3(NWAVES * 64), LDS_BYTES, stream, x);
      if (hipMemsetAsync((char*)d_ws, 0, CTL_ZERO_BYTES, stream) != hipSuccess) return; }
#endif
    hipLaunchKernelGGL(mega_fwd, dim3(grid), dim3(NWAVES * 64), LDS_BYTES, stream, a);
#if defined(PROBE_VAR)
    { hipFuncSetAttribute((const void*)probe_kernel, hipFuncAttributeMaxDynamicSharedMemorySize, LDS_BYTES);
      for (int r = 0; r < 4; ++r) hipLaunchKernelGGL(probe_kernel, dim3(grid), dim3(NWAVES * 64), LDS_BYTES, stream, a); }
#endif
#if defined(XTRA_AFTER)
    { Args x = a; x.mask = XTRA_AFTER; x.bar_region = 1; for (int r = 0; r < XTRA_REP; ++r) hipLaunchKernelGGL(mega_fwd, dim3(grid), dim3(NWAVES * 64), LDS_BYTES, stream, x); }
#endif
}
```

```cpp
#define P1_FP8 1
#define P1_FP8_FROM 0
#define MIX_FP8 7
#define GATE_FP8 1
#define Y_FP8 1
#include <hip/hip_runtime.h>
#include <cstdio>
#include <cstdint>

constexpr int TT = 32768, DM = 1024, SEQ = 2048, NB = 16;
constexpr float DN_ALPHA = 1.189207115002721f;
constexpr float LN_EPSF = 1e-5f;
#ifndef M1_FP8
#define M1_FP8 1
#endif
#ifndef P1_FP8
#define P1_FP8 0
#endif
#ifndef Y_FP8
#define Y_FP8 0
#endif
#ifndef GATE_FP8
#define GATE_FP8 0
#endif
#ifndef MIX_FP8
#define MIX_FP8 0
#endif
#ifndef P1_FP8_FROM
#define P1_FP8_FROM 0
#endif
#define X_F32_RES (P1_FP8 && P1_FP8_FROM == 0 && GATE_FP8)
constexpr size_t MiB = 1u << 20;
constexpr size_t CTL_ZERO_BYTES = 1 * MiB;
constexpr size_t WS_ROT = 1 * MiB;
constexpr size_t WS_BIAS = 2 * MiB;
constexpr size_t WS_LTOK = 3 * MiB;
constexpr size_t WS_TINFO = 7 * MiB;
constexpr size_t WS_WSLOT = 7 * MiB + 512 * 1024;
constexpr size_t WS_WIN = 8 * MiB;
constexpr size_t WS_WIN8 = 12 * MiB;
constexpr size_t WS_WR = 21 * MiB;
constexpr size_t WS_WA = 23 * MiB;
constexpr size_t WS_WO = 24 * MiB;
constexpr size_t WS_WGU = 26 * MiB;
constexpr size_t WS_WD = 42 * MiB;
constexpr size_t WS_XB = 80 * MiB;
constexpr size_t WS_QR = 144 * MiB;
constexpr size_t WS_KR = 176 * MiB;
constexpr size_t WS_VR = 208 * MiB;
constexpr size_t WS_GR = 272 * MiB;
constexpr size_t WS_QA = 336 * MiB, WS_KA = 368 * MiB, WS_VA = 400 * MiB, WS_OA = 432 * MiB;
#if MIX_FP8 & 4
constexpr size_t WS_AR8 = 144 * MiB;
constexpr size_t WS_GATE_R = 176 * MiB, WS_GATE_A = 240 * MiB;
#else
constexpr size_t WS_GATE_R = 144 * MiB, WS_GATE_A = 208 * MiB;
#endif
constexpr size_t WS_X8_LO = 448 * MiB, WS_X8_HI = 58 * MiB;
static_assert(!GATE_FP8 || (P1_FP8 && (MIX_FP8 & 2) && M1_FP8), "GATE_FP8 needs the fp8 mixer-input GEMM, the fp8 o_a (room behind it) and the fp8 expert weights (room behind them)");
constexpr size_t WS_MERGED8 = 464 * MiB;
constexpr size_t WS_MERGED = 336 * MiB;
constexpr size_t WS_Y = 144 * MiB;
constexpr size_t WS_H = 336 * MiB;
constexpr size_t WS_X1F8 = 464 * MiB;
constexpr size_t WS_O2 = 26 * MiB;
constexpr size_t WS_O3 = 464 * MiB;
constexpr size_t WS_LSE2 = 496 * MiB, WS_LSE3 = 497 * MiB;
constexpr size_t WS_END = 512 * MiB;
constexpr int MAXSLOT = 69632;
constexpr int CW_BAR = 4096;
constexpr int CW_CNT = 16384;
constexpr int CW_CHK = 24576;
namespace pg8 {
#define PG8_LAS __attribute__((address_space(3)))
typedef unsigned short bf16_t;
typedef short bf16x8 __attribute__((ext_vector_type(8)));
typedef float f32x4 __attribute__((ext_vector_type(4)));
typedef unsigned u32x4 __attribute__((ext_vector_type(4)));
typedef unsigned u32x2_ __attribute__((ext_vector_type(2)));
constexpr int BM = 256, BK = 64, HALF = 128, HTB = HALF * BK * 2  , STAGE_BYTES = 8 * HTB, NXCD = 8, WGM = 8;

__device__ __forceinline__ int lane_id() { int x; asm volatile("v_mbcnt_lo_u32_b32 %0, -1, 0\n\tv_mbcnt_hi_u32_b32 %0, -1, %0" : "=v"(x)); return x; }
__host__ __device__ __forceinline__ int lds_byte(int r, int c) { const int st = (r >> 4) * 2 + (c >> 5), rr = r & 15, cc = c & 31, ob = rr * 64 + cc * 2; return st * 1024 + (ob ^ (((ob >> 9) & 1) << 5)); }
__host__ __device__ __forceinline__ void stage_rc(int b, int& R, int& C) { const int st = b / 1024, sb = b % 1024, swz = sb ^ (((sb >> 9) & 1) << 5); R = (st >> 1) * 16 + swz / 64; C = (st & 1) * 32 + (swz % 64) / 2; }
__host__ __device__ __forceinline__ int perm32(int rho) { const int n = rho >> 4, i = rho & 15; return 8 * (i >> 2) + 4 * n + (i & 3); }

struct Unit { int pm, pn; };
struct Gemm { const bf16_t* A; const bf16_t* Bt; int M, N, K; int spm = 1 << 30; long sdelta = 0; };

struct StaticOrder {
    int nM, nN, nwg, G, c, pn0;
    __host__ __device__ void init(int M, int N, int G_, int c_, int pn0_ = 0) { nM = M / BM; nN = N / BM; nwg = nM * nN; G = G_; c = c_; pn0 = pn0_; }
    __host__ __device__ bool next(int i, Unit& u) const {
        const long L = (long)i * G + c; if (L >= nwg) return false;
        int wgid = (int)L; { const int q = nwg / NXCD, r = nwg % NXCD, xcd = wgid % NXCD, off = wgid / NXCD; wgid = (xcd < r ? xcd * (q + 1) : r * (q + 1) + (xcd - r) * q) + off; }
        const int nig = WGM * nN, gid = wgid / nig, fm = gid * WGM, gsz = (nM - fm) < WGM ? (nM - fm) : WGM;
        u.pm = fm + ((wgid % nig) % gsz); u.pn = pn0 + (wgid % nig) / gsz; return true;
    }
    __device__ __forceinline__ void a_ready(const Unit&) const {}
    __device__ __forceinline__ void done(const Unit&) const {}
};

__device__ __forceinline__ unsigned cvt_pk_bf16(float lo, float hi) { unsigned r; asm volatile("v_cvt_pk_bf16_f32 %0, %1, %2" : "=v"(r) : "v"(lo), "v"(hi)); return r; }
typedef float cvt_f32x2_t __attribute__((ext_vector_type(2))); typedef __bf16 cvt_bf16x2_t __attribute__((ext_vector_type(2)));
__device__ __forceinline__ unsigned cvt_pk_bf16_acc(float lo, float hi) { const cvt_f32x2_t v = {lo, hi}; const cvt_bf16x2_t b = __builtin_convertvector(v, cvt_bf16x2_t); return __builtin_bit_cast(unsigned, b); }
__device__ __forceinline__ float bflo(unsigned w) { return __uint_as_float(w << 16); }
__device__ __forceinline__ float bfhi(unsigned w) { return __uint_as_float(w & 0xffff0000u); }
__device__ __forceinline__ float fsigmoid(float x) { return __builtin_amdgcn_rcpf(1.f + __expf(-x)); }
__device__ __forceinline__ float fsilu(float x) { return x * __builtin_amdgcn_rcpf(1.f + __expf(-x)); }

template <int VAR = 0> struct EpiHcatT {
    static constexpr bool PERM = true, AFTER_DRAIN = false; static constexpr int NSTORE = 16;
    unsigned char* ws; const float* rot; int tile_off;
    __device__ __forceinline__ void operator()(const f32x4 (&acc)[2][2][4][2], const Unit& u, int wr, int wc, int fr, int fq) const {
        if (VAR == 1) {
            float s = 0.f;
#pragma unroll
            for (int ai = 0; ai < 2; ++ai)
#pragma unroll
                for (int bj = 0; bj < 2; ++bj)
#pragma unroll
                    for (int m = 0; m < 4; ++m)
#pragma unroll
                        for (int n = 0; n < 2; ++n) s += (acc[ai][bj][m][n][0] + acc[ai][bj][m][n][1]) + (acc[ai][bj][m][n][2] + acc[ai][bj][m][n][3]);
            ((float*)(ws + WS_O3))[(size_t)(u.pm * 64 + u.pn) * 512 + wr * 256 + wc * 64 + fq * 16 + fr] = s; return;
        }
        const int gt = u.pn + tile_off;
        size_t base_off; int pitch, ct, mode; float sc = 1.f;
        if (gt < 2)       { base_off = WS_QR; pitch = 512;  ct = gt;      mode = 1; }
        else if (gt < 4)  { base_off = WS_KR; pitch = 512;  ct = gt - 2;  mode = 1; sc = 0.08838834764831845f; }
        else if (gt < 8)  { base_off = WS_VR; pitch = 1024; ct = gt - 4;  mode = 0; }
        else if (gt < 12) { base_off = WS_GR; pitch = 1024; ct = gt - 8;  mode = 2; }
        else if (gt < 14) { base_off = WS_QA; pitch = 512;  ct = gt - 12; mode = 0; sc = 0.18033688011112042f; }
        else if (gt < 16) { base_off = WS_KA; pitch = 512;  ct = gt - 14; mode = 0; }
        else if (gt < 18) { base_off = WS_VA; pitch = 512;  ct = gt - 16; mode = 0; }
        else if (gt < 22) { base_off = WS_GATE_R; pitch = 1024; ct = gt - 18; mode = 3; }
        else              { base_off = WS_GATE_A; pitch = 1024; ct = gt - 22; mode = 3; }
        bf16_t* O = (bf16_t*)(ws + base_off);
        const int row0 = u.pm * BM + wr * 64 + fr, col0 = ct * BM + wc * 32 + 8 * fq;
#pragma unroll
        for (int ai = 0; ai < 2; ++ai)
#pragma unroll
            for (int m = 0; m < 4; ++m) {
                const int row = row0 + ai * HALF + m * 16;
                bf16_t* rowp = O + (size_t)row * pitch + col0;
                f32x4 cs = (f32x4){1.f, 1.f, 1.f, 1.f}, sn = (f32x4){0.f, 0.f, 0.f, 0.f};
                if (mode == 1) { const f32x4* rt = (const f32x4*)(rot + ((size_t)(row & (SEQ - 1)) * 16 + (4 * wc + fq)) * 8); cs = rt[0]; sn = rt[1]; }
#pragma unroll
                for (int bj = 0; bj < 2; ++bj) {
                    f32x4 v0 = acc[ai][bj][m][0], v1 = acc[ai][bj][m][1];
                    if (mode == 1) { const f32x4 a = v0 * cs - v1 * sn, b = v0 * sn + v1 * cs; v0 = a * sc; v1 = b * sc; }
                    else if (mode == 2) {
#pragma unroll
                        for (int e = 0; e < 4; ++e) { v0[e] = fsilu(v0[e]); v1[e] = fsilu(v1[e]); } }
                    else if (mode == 3) {
#pragma unroll
                        for (int e = 0; e < 4; ++e) { v0[e] = fsigmoid(v0[e]); v1[e] = fsigmoid(v1[e]); } }
                    else { v0 = v0 * sc; v1 = v1 * sc; }
                    u32x4 w; w.x = cvt_pk_bf16(v0[0], v0[1]); w.y = cvt_pk_bf16(v0[2], v0[3]); w.z = cvt_pk_bf16(v1[0], v1[1]); w.w = cvt_pk_bf16(v1[2], v1[3]);
                    *(u32x4*)(rowp + bj * HALF) = w;
                }
            }
    }
};

typedef EpiHcatT<0> EpiHcat;

__device__ __forceinline__ unsigned fp8x4_sat(float a, float b, float c, float d) {
    a = __builtin_amdgcn_fmed3f(a, -448.f, 448.f); b = __builtin_amdgcn_fmed3f(b, -448.f, 448.f); c = __builtin_amdgcn_fmed3f(c, -448.f, 448.f); d = __builtin_amdgcn_fmed3f(d, -448.f, 448.f);
    unsigned w = 0u; w = __builtin_amdgcn_cvt_pk_fp8_f32(a, b, w, false); w = __builtin_amdgcn_cvt_pk_fp8_f32(c, d, w, true); return w;
}
template <bool ADD, bool OUT8 = false> struct EpiGate {
    static constexpr bool PERM = true, AFTER_DRAIN = false; static constexpr int NSTORE = 16;
    const bf16_t* gate; bf16_t* O; unsigned char* O8;
    __device__ __forceinline__ void operator()(const f32x4 (&acc)[2][2][4][2], const Unit& u, int wr, int wc, int fr, int fq) const {
        const int row0 = u.pm * BM + wr * 64 + fr, col0 = u.pn * BM + wc * 32 + 8 * fq;
#pragma unroll
        for (int ai = 0; ai < 2; ++ai)
#pragma unroll
            for (int m = 0; m < 4; ++m)
#pragma unroll
                for (int bj = 0; bj < 2; ++bj) {
                    const size_t p = (size_t)(row0 + ai * HALF + m * 16) * 1024 + col0 + bj * HALF;
                    const u32x4 g = *(const u32x4*)(gate + p);
                    f32x4 v0 = acc[ai][bj][m][0], v1 = acc[ai][bj][m][1];
                    v0[0] *= bflo(g.x); v0[1] *= bfhi(g.x); v0[2] *= bflo(g.y); v0[3] *= bfhi(g.y);
                    v1[0] *= bflo(g.z); v1[1] *= bfhi(g.z); v1[2] *= bflo(g.w); v1[3] *= bfhi(g.w);
                    if (ADD) { const u32x4 o = *(const u32x4*)(O + p);
                        v0[0] += bflo(o.x); v0[1] += bfhi(o.x); v0[2] += bflo(o.y); v0[3] += bfhi(o.y);
                        v1[0] += bflo(o.z); v1[1] += bfhi(o.z); v1[2] += bflo(o.w); v1[3] += bfhi(o.w); }
                    if (OUT8) { u32x2_ w8;
                        w8.x = fp8x4_sat(v0[0] * 16.f, v0[1] * 16.f, v0[2] * 16.f, v0[3] * 16.f); w8.y = fp8x4_sat(v1[0] * 16.f, v1[1] * 16.f, v1[2] * 16.f, v1[3] * 16.f);
                        *(u32x2_*)(O8 + p) = w8; }
                    else { u32x4 w; w.x = cvt_pk_bf16(v0[0], v0[1]); w.y = cvt_pk_bf16(v0[2], v0[3]); w.z = cvt_pk_bf16(v1[0], v1[1]); w.w = cvt_pk_bf16(v1[2], v1[3]);
                        *(u32x4*)(O + p) = w; }
                }
    }
};

struct EpiResBf16 {
    static constexpr bool PERM = true, AFTER_DRAIN = false; static constexpr int NSTORE = 16;
    const bf16_t* x; bf16_t* out; float alpha;
    __device__ __forceinline__ void operator()(const f32x4 (&acc)[2][2][4][2], const Unit& u, int wr, int wc, int fr, int fq) const {
        const int row0 = u.pm * BM + wr * 64 + fr, col0 = u.pn * BM + wc * 32 + 8 * fq;
#pragma unroll
        for (int ai = 0; ai < 2; ++ai)
#pragma unroll
            for (int m = 0; m < 4; ++m)
#pragma unroll
                for (int bj = 0; bj < 2; ++bj) {
                    const size_t p = (size_t)(row0 + ai * HALF + m * 16) * 1024 + col0 + bj * HALF;
#if X_F32_RES
                    const f32x4 x0 = *(const f32x4*)((const float*)x + p), x1 = *(const f32x4*)((const float*)x + p + 4);
#else
                    const u32x4 xw = *(const u32x4*)(x + p);
                    const f32x4 x0 = (f32x4){bflo(xw.x), bfhi(xw.x), bflo(xw.y), bfhi(xw.y)}, x1 = (f32x4){bflo(xw.z), bfhi(xw.z), bflo(xw.w), bfhi(xw.w)};
#endif
                    const f32x4 v0 = x0 * alpha + acc[ai][bj][m][0], v1 = x1 * alpha + acc[ai][bj][m][1];
                    u32x4 w; w.x = cvt_pk_bf16(v0[0], v0[1]); w.y = cvt_pk_bf16(v0[2], v0[3]); w.z = cvt_pk_bf16(v1[0], v1[1]); w.w = cvt_pk_bf16(v1[2], v1[3]);
                    *(u32x4*)(out + p) = w;
                }
    }
};

struct EpiSwiGLU {
    static constexpr bool PERM = true, AFTER_DRAIN = false; static constexpr int NSTORE = 16;
    unsigned char* H;
    __device__ __forceinline__ void operator()(const f32x4 (&acc)[2][2][4][2], const Unit& u, int wr, int wc, int fr, int fq) const {
        const int row0 = u.pm * BM + wr * 64 + fr, col0 = (u.pn & 3) * 128 + wc * 16 + 4 * fq;
#pragma unroll
        for (int ai = 0; ai < 2; ++ai)
#pragma unroll
            for (int m = 0; m < 4; ++m)
#pragma unroll
                for (int bj = 0; bj < 2; ++bj) {
                    const f32x4 g = acc[ai][bj][m][0], up = acc[ai][bj][m][1];
                    float h0 = fsilu(g[0]) * up[0] * 8.f, h1 = fsilu(g[1]) * up[1] * 8.f, h2 = fsilu(g[2]) * up[2] * 8.f, h3 = fsilu(g[3]) * up[3] * 8.f;
                    h0 = fminf(fmaxf(h0, -448.f), 448.f); h1 = fminf(fmaxf(h1, -448.f), 448.f); h2 = fminf(fmaxf(h2, -448.f), 448.f); h3 = fminf(fmaxf(h3, -448.f), 448.f);
                    unsigned w = 0u; w = __builtin_amdgcn_cvt_pk_fp8_f32(h0, h1, w, false); w = __builtin_amdgcn_cvt_pk_fp8_f32(h2, h3, w, true);
                    *(unsigned*)(H + (size_t)(row0 + ai * HALF + m * 16) * 512 + col0 + bj * 64) = w;
                }
    }
};

struct EpiRowScale {
    static constexpr bool PERM = true, AFTER_DRAIN = false; static constexpr int NSTORE = 16;
    bf16_t* Y;
    __device__ __forceinline__ void operator()(const f32x4 (&acc)[2][2][4][2], const Unit& u, int wr, int wc, int fr, int fq) const {
        const int row0 = u.pm * BM + wr * 64 + fr, col0 = (u.pn & 3) * BM + wc * 32 + 8 * fq;
#pragma unroll
        for (int ai = 0; ai < 2; ++ai)
#pragma unroll
            for (int m = 0; m < 4; ++m) {
                const int row = row0 + ai * HALF + m * 16;
#pragma unroll
                for (int bj = 0; bj < 2; ++bj) {
                    const f32x4 v0 = acc[ai][bj][m][0], v1 = acc[ai][bj][m][1];
#if Y_FP8
                    u32x2_ w8; w8.x = fp8x4_sat(v0[0] * 16.f, v0[1] * 16.f, v0[2] * 16.f, v0[3] * 16.f); w8.y = fp8x4_sat(v1[0] * 16.f, v1[1] * 16.f, v1[2] * 16.f, v1[3] * 16.f);
                    *(u32x2_*)((unsigned char*)Y + (size_t)row * 1024 + col0 + bj * HALF) = w8;
#else
                    u32x4 w; w.x = cvt_pk_bf16_acc(v0[0], v0[1]); w.y = cvt_pk_bf16_acc(v0[2], v0[3]); w.z = cvt_pk_bf16_acc(v1[0], v1[1]); w.w = cvt_pk_bf16_acc(v1[2], v1[3]);
                    *(u32x4*)(Y + (size_t)row * 1024 + col0 + bj * HALF) = w;
#endif
                }
            }
    }
};

struct MoeOrder {
    int nunits, G, c; const PG8_LAS int* te; const PG8_LAS int* ts; const PG8_LAS int* cnt; const int* ltok; unsigned rowbytes;
    __device__ __forceinline__ bool next(int i, Unit& u) const {
        const int L = i * G + c, rt = (L >> 5) * 8 + (L & 7); if (rt >= (nunits >> 2)) return false;
        u.pm = rt; u.pn = te[rt] * 4 + ((L >> 3) & 3); return true;
    }
    __device__ __forceinline__ unsigned a_row_off(const Unit& u, int row) const {
        const int ex = te[u.pm], pos = (u.pm - ts[ex]) * 256 + row;
        const int tok = pos < cnt[ex] ? ltok[ex * 32768 + pos] : 0;
        return (unsigned)tok * rowbytes;
    }
    __device__ __forceinline__ void a_ready(const Unit&) const {}
    __device__ __forceinline__ void done(const Unit&) const {}
};

struct GateOrder {
    StaticOrder S4;
    __device__ __forceinline__ bool next(int i, Unit& u) const { Unit t; if (!S4.next(i >> 1, t)) return false; u.pm = t.pm; u.pn = t.pn + 4 * (i & 1); return true; }
    __device__ __forceinline__ void a_ready(const Unit&) const {}
    __device__ __forceinline__ void done(const Unit&) const {}
};

template <class Epi, class Sched, bool ALIGN_EPI = false, bool SP2 = false, bool GATHER = false, bool FP8 = false, int SEL_W = 0, int SEL_X = 0>
__device__ __forceinline__ void gemm_phase(PG8_LAS unsigned char* lds, const Gemm g, const Sched& S, const Epi& E, const int wid) {
    int tid = wid * 64 + lane_id(); asm volatile("" : "+v"(tid));
    const int lane = tid & 63, wr = wid >> 2, wc = wid & 3, fr = lane & 15, fq = lane >> 4;
    static_assert(SP2, "only the two-super-phase loop is kept");
    typedef int i32x4_ __attribute__((ext_vector_type(4)));
    const int K = g.K, nt = K / BK;
    unsigned voffB[2]; int rA[2], cA2[2];
#pragma unroll
    for (int i = 0; i < 2; ++i) { int R, C; stage_rc(tid * 16 + i * 8192, R, C); const int Rb = Epi::PERM ? ((R & ~31) + perm32(R & 31)) : R;
        rA[i] = R; cA2[i] = C * 2; voffB[i] = (unsigned)(Rb * K + C) * 2u; }
    unsigned vAc[2][2], vAn[2][2];
    const size_t kstep = (size_t)(BK * 2);
    const size_t hstep = (size_t)HALF * K * 2;
    const size_t tstep = 2 * hstep;
    const unsigned ldsw = (unsigned)wid * 1024u;
    const int aoff0 = lds_byte(wr * 64 + fr, fq * 8), aoff1 = aoff0 + 1024;
    const int boff0 = lds_byte(wc * 32 + fr, fq * 8), boff1 = boff0 + 1024;
#define PG8_SA(b, h) (((b) * 2 + (h)) * HTB)
#define PG8_SB(b, h) ((4 + (b) * 2 + (h)) * HTB)
#define PG8_STAGE(bufoff, gbase, voff) do { _Pragma("unroll") for (int _i = 0; _i < 2; ++_i) \
        __builtin_amdgcn_global_load_lds((const unsigned*)((const char*)(gbase) + (voff)[_i]), (PG8_LAS unsigned*)(lds + (bufoff) + ldsw + _i * 8192), 16, 0, 0); } while (0)
#define PG8_LDA(dst, b, h) do { _Pragma("unroll") for (int m = 0; m < 4; ++m) { dst[m][0] = *(const PG8_LAS bf16x8*)(lds + PG8_SA(b, h) + aoff0 + m * 2048); dst[m][1] = *(const PG8_LAS bf16x8*)(lds + PG8_SA(b, h) + aoff1 + m * 2048); } } while (0)
#define PG8_LDB(dst, b, h) do { _Pragma("unroll") for (int n = 0; n < 2; ++n) { dst[n][0] = *(const PG8_LAS bf16x8*)(lds + PG8_SB(b, h) + boff0 + n * 2048); dst[n][1] = *(const PG8_LAS bf16x8*)(lds + PG8_SB(b, h) + boff1 + n * 2048); } } while (0)
#define PG8_CAT8(x) __builtin_shufflevector(__builtin_bit_cast(i32x4_, (x)[0]), __builtin_bit_cast(i32x4_, (x)[1]), 0, 1, 2, 3, 4, 5, 6, 7)
#define PG8_MMA(ai, bj, At, Bt) do { __builtin_amdgcn_s_setprio(1); \
        if constexpr (FP8) { _Pragma("unroll") for (int m = 0; m < 4; ++m) _Pragma("unroll") for (int n = 0; n < 2; ++n) \
            acc[ai][bj][m][n] = __builtin_amdgcn_mfma_scale_f32_16x16x128_f8f6f4(PG8_CAT8(Bt[n]), PG8_CAT8(At[m]), acc[ai][bj][m][n], 0, 0, SEL_W, scl, SEL_X, scl); \
            asm volatile("" : "+v"(acc[ai][bj][0][0]), "+v"(acc[ai][bj][0][1]), "+v"(acc[ai][bj][1][0]), "+v"(acc[ai][bj][1][1]), "+v"(acc[ai][bj][2][0]), "+v"(acc[ai][bj][2][1]), "+v"(acc[ai][bj][3][0]), "+v"(acc[ai][bj][3][1])); } \
        else { _Pragma("unroll") for (int m = 0; m < 4; ++m) _Pragma("unroll") for (int n = 0; n < 2; ++n) _Pragma("unroll") for (int k = 0; k < 2; ++k) \
            acc[ai][bj][m][n] = __builtin_amdgcn_mfma_f32_16x16x32_bf16(Bt[n][k], At[m][k], acc[ai][bj][m][n], 0, 0, 0); } \
        __builtin_amdgcn_s_setprio(0); } while (0)
#define PG8_WAIT_V(n) asm volatile("s_waitcnt vmcnt(" #n ")" ::: "memory")
#define PG8_WAIT_VN(n) asm volatile("s_waitcnt vmcnt(%0)" :: "i"(n) : "memory")
#define PG8_WAIT_L(n) asm volatile("s_waitcnt lgkmcnt(" #n ")" ::: "memory")
#define PG8_BAR __builtin_amdgcn_s_barrier()
#define PG8_SCHED __builtin_amdgcn_sched_barrier(0)
    [[maybe_unused]] int scl = 0x7b7c797f; asm volatile("" : "+v"(scl));
    Unit cur, nxt; int ui = 0;
    if (!S.next(0, cur)) return;
    f32x4 acc[2][2][4][2];
#pragma unroll
    for (int a = 0; a < 2; ++a)
#pragma unroll
        for (int b = 0; b < 2; ++b)
#pragma unroll
            for (int m = 0; m < 4; ++m)
#pragma unroll
                for (int n = 0; n < 2; ++n) acc[a][b][m][n] = (f32x4){0.f, 0.f, 0.f, 0.f};
    bf16x8 At[4][2], B0[2][2], B1[2][2];
    const char* cA = GATHER ? (const char*)g.A : (const char*)g.A + (size_t)cur.pm * tstep + (cur.pm >= g.spm ? g.sdelta : 0L); const char* cB = (const char*)g.Bt + (size_t)cur.pn * tstep;
#pragma unroll
    for (int h = 0; h < 2; ++h)
#pragma unroll
        for (int i = 0; i < 2; ++i) { if constexpr (GATHER) vAc[h][i] = S.a_row_off(cur, h * HALF + rA[i]) + (unsigned)cA2[i]; else vAc[h][i] = (unsigned)((h * HALF + rA[i]) * K) * 2u + (unsigned)cA2[i]; vAn[h][i] = vAc[h][i]; }
    S.a_ready(cur);
    if constexpr (SP2) {
        PG8_STAGE(PG8_SB(0, 0), cB, voffB); PG8_STAGE(PG8_SB(0, 1), cB + hstep, voffB); PG8_STAGE(PG8_SA(0, 0), cA, vAc[0]); PG8_STAGE(PG8_SA(0, 1), cA, vAc[1]);
        if (wr == 1) PG8_BAR;
        PG8_WAIT_V(2); PG8_BAR;
        PG8_STAGE(PG8_SB(1, 0), cB + kstep, voffB); PG8_STAGE(PG8_SA(1, 0), cA + kstep, vAc[0]); PG8_STAGE(PG8_SB(1, 1), cB + hstep + kstep, voffB);
        PG8_WAIT_V(6); PG8_BAR;
    }
    for (;;) {
        const bool has_next = S.next(ui + 1, nxt);
        const char* nA = GATHER ? cA : (has_next ? (const char*)g.A + (size_t)nxt.pm * tstep + (nxt.pm >= g.spm ? g.sdelta : 0L) : cA); const char* nB = has_next ? (const char*)g.Bt + (size_t)nxt.pn * tstep : cB;
        if constexpr (GATHER) { if (has_next) {
#pragma unroll
            for (int h = 0; h < 2; ++h)
#pragma unroll
                for (int i = 0; i < 2; ++i) vAn[h][i] = S.a_row_off(nxt, h * HALF + rA[i]) + (unsigned)cA2[i]; } }
#pragma unroll 1
        for (int t = 0; t < nt; t += 2) {
            const bool last = (t == nt - 2);
            asm volatile("" : "+v"(voffB[0]), "+v"(voffB[1]), "+v"(vAc[0][0]), "+v"(vAc[0][1]), "+v"(vAc[1][0]), "+v"(vAc[1][1]));
            const char* a1 = cA + (size_t)(t + 1) * kstep;
            const char* a2 = last ? nA : cA + (size_t)(t + 2) * kstep; const char* b2 = last ? nB : cB + (size_t)(t + 2) * kstep;
            const char* a3 = a2 + kstep; const char* b3 = b2 + kstep;
            unsigned vA2[2][2];
#pragma unroll
            for (int h = 0; h < 2; ++h)
#pragma unroll
                for (int i = 0; i < 2; ++i) vA2[h][i] = vAc[h][i];
            if constexpr (GATHER) { if (last) {
                asm volatile("" : "+v"(vAn[0][0]), "+v"(vAn[0][1]), "+v"(vAn[1][0]), "+v"(vAn[1][1]));
#pragma unroll
                for (int h = 0; h < 2; ++h)
#pragma unroll
                    for (int i = 0; i < 2; ++i) vA2[h][i] = vAn[h][i]; } }
            if (last && has_next) S.a_ready(nxt);
            if constexpr (SP2) {
            const int lenient = __builtin_amdgcn_readfirstlane((ui > 0 && t == 0) ? 1 : 0);
#define PG8_WAIT_V8L() asm volatile("s_cmp_eq_u32 %0, 0\n\ts_cbranch_scc0 .Lpg8skip%=\n\ts_waitcnt vmcnt(8)\n.Lpg8skip%=:\n\ts_waitcnt vmcnt(%1)" :: "s"(lenient), "i"(8 + Epi::NSTORE) : "memory", "scc")
            PG8_LDB(B0, 0, 0); PG8_LDB(B1, 0, 1); PG8_SCHED; PG8_LDA(At, 0, 0); PG8_STAGE(PG8_SA(1, 1), a1, vAc[1]);
            PG8_WAIT_V8L(); PG8_WAIT_L(0); PG8_BAR; PG8_MMA(0, 0, At, B0); PG8_MMA(0, 1, At, B1); PG8_BAR; PG8_SCHED;
            PG8_LDA(At, 0, 1); PG8_STAGE(PG8_SB(0, 0), b2, voffB); PG8_STAGE(PG8_SB(0, 1), b2 + hstep, voffB); PG8_STAGE(PG8_SA(0, 0), a2, vA2[0]);
            PG8_WAIT_V8L(); PG8_WAIT_L(0); PG8_BAR; PG8_MMA(1, 0, At, B0); PG8_MMA(1, 1, At, B1); PG8_BAR; PG8_SCHED;
            PG8_LDB(B0, 1, 0); PG8_LDB(B1, 1, 1); PG8_SCHED; PG8_LDA(At, 1, 0); PG8_STAGE(PG8_SA(0, 1), a2, vA2[1]);
            PG8_WAIT_V(8); PG8_WAIT_L(0); PG8_BAR; PG8_MMA(0, 0, At, B0); PG8_MMA(0, 1, At, B1); PG8_BAR; PG8_SCHED;
            PG8_LDA(At, 1, 1); PG8_STAGE(PG8_SB(1, 0), b3, voffB); PG8_STAGE(PG8_SB(1, 1), b3 + hstep, voffB); PG8_STAGE(PG8_SA(1, 0), a3, vA2[0]);
            PG8_WAIT_V(8); PG8_WAIT_L(0); PG8_BAR; PG8_MMA(1, 0, At, B0); PG8_MMA(1, 1, At, B1); PG8_BAR; PG8_SCHED;
#undef PG8_WAIT_V8L
            }
        }
        if constexpr (ALIGN_EPI) { if (wr == 0) PG8_BAR; }
        if constexpr (!Epi::AFTER_DRAIN) { E(acc, cur, wr, wc, fr, fq); S.done(cur); }
        if (!has_next) break;
#pragma unroll
        for (int a = 0; a < 2; ++a)
#pragma unroll
            for (int b = 0; b < 2; ++b)
#pragma unroll
                for (int m = 0; m < 4; ++m)
#pragma unroll
                    for (int n = 0; n < 2; ++n) acc[a][b][m][n] = (f32x4){0.f, 0.f, 0.f, 0.f};
        cur = nxt; cA = nA; cB = nB; ++ui;
        if constexpr (GATHER) {
#pragma unroll
            for (int h = 0; h < 2; ++h)
#pragma unroll
                for (int i = 0; i < 2; ++i) vAc[h][i] = vAn[h][i]; }
        if constexpr (ALIGN_EPI) { if (wr == 1) PG8_BAR; }
    }
    PG8_WAIT_V(0);
    if constexpr (!ALIGN_EPI) { if (wr == 0) PG8_BAR; }
    PG8_BAR;
    if constexpr (Epi::AFTER_DRAIN) { E.fused(acc, cur, wr, wc, fr, fq, lds, wid, lane); S.done(cur); }
#undef PG8_SA
#undef PG8_SB
#undef PG8_STAGE
#undef PG8_LDA
#undef PG8_LDB
#undef PG8_MMA
#undef PG8_CAT8
#undef PG8_WAIT_V
#undef PG8_WAIT_VN
#undef PG8_WAIT_L
#undef PG8_BAR
#undef PG8_SCHED
}
}
#define GAS __attribute__((address_space(1)))
#define LAS __attribute__((address_space(3)))
typedef unsigned short bf16;
typedef unsigned v4u __attribute__((ext_vector_type(4)));
typedef float f32x4 __attribute__((ext_vector_type(4)));
typedef short bf16x8 __attribute__((ext_vector_type(8)));
typedef GAS unsigned gu32;
typedef GAS unsigned long long gu64;
#define RLX_AGENT __ATOMIC_RELAXED, __HIP_MEMORY_SCOPE_AGENT
#define LDS_WAIT() asm volatile("s_waitcnt lgkmcnt(0)" ::: "memory")
#define VM_WAIT() asm volatile("s_waitcnt vmcnt(0)" ::: "memory")
__device__ __forceinline__ unsigned long long rt() { return __builtin_amdgcn_s_memrealtime(); }
__device__ __forceinline__ unsigned f2bf(float f) { unsigned u = __builtin_bit_cast(unsigned, f); return (u + 0x7fffu + ((u >> 16) & 1u)) >> 16; }
__device__ __forceinline__ unsigned pk2(float lo, float hi) { return f2bf(lo) | (f2bf(hi) << 16); }

#define XB_TMO      128
#define XB_XCNT(j)  (256  + 64 * (j))
#define XB_XSUB(j)  (1280 + 64 * (j))
#define XB_XGEN(j)  (2304 + 64 * (j))
#define XB_TOP      3328
#define XB_TOPGEN   3392
#define XCD_BAR_WORDS 3456
#define XB_SPIN_CAP (1u << 18)

__device__ __forceinline__ unsigned xb_ld(unsigned* p)              { return __hip_atomic_load(p, __ATOMIC_RELAXED, __HIP_MEMORY_SCOPE_AGENT); }
__device__ __forceinline__ unsigned xb_add(unsigned* p, unsigned v) { return __hip_atomic_fetch_add(p, v, __ATOMIC_RELAXED, __HIP_MEMORY_SCOPE_AGENT); }
__device__ __forceinline__ unsigned xb_xcc_id() { return (unsigned)__builtin_amdgcn_s_getreg((3 << 11) | 20) & 0xFu; }
#define XB_SPIN(cond, bar) do { unsigned _sp = 0; while (cond) { __builtin_amdgcn_s_sleep(1); \
    if ((++_sp & 255u) == 0u) { if (xb_ld(&(bar)[XB_TMO])) break; if (_sp > XB_SPIN_CAP) { atomicAdd(&(bar)[XB_TMO], 1u); break; } } } } while (0)

struct XcdBarrier {
    unsigned* bar; unsigned x; int wv;
    volatile LAS unsigned* st;
};

__device__ __forceinline__ XcdBarrier xcd_barrier_post(unsigned* bar, volatile LAS unsigned* st) {
    XcdBarrier b; b.bar = bar; b.x = xb_xcc_id(); b.st = st; b.wv = 0;
    if (threadIdx.x == 0) (void)xb_add(&bar[XB_XCNT(b.x)], 1u);
    return b;
}
__device__ __forceinline__ void xcd_barrier_complete(unsigned* bar, unsigned x, unsigned& nloc, unsigned& nx) {
    const unsigned G = gridDim.x * gridDim.y * gridDim.z;
    unsigned sum, cnt, mine, sp = 0u;
    for (;;) {
        sum = 0u; cnt = 0u; mine = 0u;
#pragma unroll
        for (unsigned j = 0; j < 16; ++j) { const unsigned c = xb_ld(&bar[XB_XCNT(j)]); sum += c; cnt += (c > 0u) ? 1u : 0u; mine = (j == x) ? c : mine; }
        if (sum == G) break;
        __builtin_amdgcn_s_sleep(1);
        if ((++sp & 255u) == 0u) { if (xb_ld(&bar[XB_TMO])) break; if (sp > XB_SPIN_CAP) { atomicAdd(&bar[XB_TMO], 1u); break; } }
    }
    nloc = mine > 0u ? mine : 1u; nx = cnt > 0u ? cnt : 1u;
}

__device__ __forceinline__ void xcd_barrier(const XcdBarrier& b) {
    asm volatile("s_waitcnt vmcnt(0)" ::: "memory");
    __syncthreads();
    if (b.wv == 0 && (int)__builtin_amdgcn_mbcnt_hi(~0u, __builtin_amdgcn_mbcnt_lo(~0u, 0u)) == 0) {
        unsigned* bar = b.bar;
        __builtin_amdgcn_s_waitcnt(0);
        unsigned nloc = b.st[0], nx = b.st[1];
        if (nloc == 0u) { xcd_barrier_complete(bar, b.x, nloc, nx); b.st[0] = nloc; b.st[1] = nx; }
        const unsigned old = xb_add(&bar[XB_XSUB(b.x)], 1u);
        const unsigned gen = old / nloc;
        if (old + 1u == (gen + 1u) * nloc) {
            __builtin_amdgcn_fence(__ATOMIC_RELEASE, "agent");
            asm volatile("s_waitcnt vmcnt(0)" ::: "memory");
            const unsigned og = xb_add(&bar[XB_TOP], 1u);
            const unsigned tg = og / nx;
            if (og + 1u == (tg + 1u) * nx) xb_add(&bar[XB_TOPGEN], 1u);
            else XB_SPIN(xb_ld(&bar[XB_TOPGEN]) == tg, bar);
            __builtin_amdgcn_fence(__ATOMIC_ACQUIRE, "agent");
            xb_add(&bar[XB_XGEN(b.x)], 1u);
            asm volatile("s_waitcnt vmcnt(0)" ::: "memory");
        } else {
            XB_SPIN(xb_ld(&bar[XB_XGEN(b.x)]) == gen, bar);
            __builtin_amdgcn_fence(__ATOMIC_ACQUIRE, "agent");
            asm volatile("s_waitcnt vmcnt(0)" ::: "memory");
        }
    }
    __syncthreads();
}


constexpr int NWAVES = 8;
constexpr int RING_BYTES = 131072;
constexpr int LDSCTL_OFF = RING_BYTES, MISC_OFF = LDSCTL_OFF + 320;
constexpr int LDS_TS_OFF = LDSCTL_OFF + 1024;
constexpr int LDS_TE_OFF = LDSCTL_OFF + 2048;
constexpr int LDS_CNT_OFF = LDSCTL_OFF + 1024 + 128;
constexpr int LDS_BYTES = 163840;

typedef short s16x4 __attribute__((ext_vector_type(4)));
typedef unsigned u32x2 __attribute__((ext_vector_type(2)));

struct Args { const float* in[20]; float* out; unsigned char* ws; unsigned mask; int bar_region; };

__device__ __forceinline__ float bflo(unsigned w) { return __uint_as_float(w << 16); }
__device__ __forceinline__ float bfhi(unsigned w) { return __uint_as_float(w & 0xffff0000u); }
__device__ __forceinline__ unsigned cvtpk(float lo, float hi) { return pg8::cvt_pk_bf16(lo, hi); }
__device__ __forceinline__ float wave_sum(float v) {
#pragma unroll
    for (int o = 1; o < 64; o <<= 1) v += __shfl_xor(v, o);
    return v;
}
__device__ __forceinline__ unsigned offb(unsigned row, unsigned ch) { return 256u * row + 16u * (ch ^ (((row & 3u) << 2) | ((row >> 2) & 3u))); }
__device__ __forceinline__ s16x4 ldtr(const LAS unsigned char* p) { return __builtin_amdgcn_ds_read_tr16_b64_v4i16((LAS s16x4*)p); }
__device__ __forceinline__ bf16x8 cat8(s16x4 a, s16x4 b) { return (bf16x8){a[0], a[1], a[2], a[3], b[0], b[1], b[2], b[3]}; }
#define MFMA16(a, b, c) __builtin_amdgcn_mfma_f32_16x16x32_bf16((a), (b), (c), 0, 0, 0)

template <int MODE> __device__ __forceinline__ int dest_row(int n) {
    if (MODE == 1) { if (n >= 1024) return n; const int hb = n & ~127, d = n & 127, jr = d & 63, half = d >> 6; return hb + 8 * (jr >> 2) + 4 * half + (jr & 3); }
    if (MODE == 2) return ((n >> 2) << 3) + (n & 3);
    if (MODE == 3) return ((n >> 2) << 3) + 4 + (n & 3);
    return n;
}
template <int MODE> __device__ __forceinline__ void p0_transpose_item(const float* W, int K, int N, bf16* WT, LAS float* scr, int item, int lane) {
    const int nblk = N / 32, kb = item / nblk, nb = item % nblk, k0 = 64 * kb, n0 = 32 * nb;
    {
        const GAS f32x4* src = (const GAS f32x4*)(W + (size_t)(k0 + (lane >> 3)) * N + n0) + (lane & 7);
        f32x4 t[8];
#pragma unroll
        for (int j = 0; j < 8; ++j) t[j] = src[(size_t)j * 2 * N];
#pragma unroll
        for (int j = 0; j < 8; ++j) { LAS float* d = scr + ((lane >> 3) + 8 * j) * 33 + 4 * (lane & 7); d[0] = t[j].x; d[1] = t[j].y; d[2] = t[j].z; d[3] = t[j].w; }
    }
    LDS_WAIT(); asm volatile("" ::: "memory");
    const int c = lane & 7;
#pragma unroll
    for (int j = 0; j < 4; ++j) { const int n = (lane >> 3) + 8 * j; const LAS float* s = scr + (8 * c) * 33 + n;
        v4u o; o.x = pk2(s[0 * 33], s[1 * 33]); o.y = pk2(s[2 * 33], s[3 * 33]); o.z = pk2(s[4 * 33], s[5 * 33]); o.w = pk2(s[6 * 33], s[7 * 33]);
        *(GAS v4u*)(WT + (size_t)dest_row<MODE>(n0 + n) * K + k0 + 8 * c) = o; }
    LDS_WAIT(); asm volatile("" ::: "memory");
}
__device__ __forceinline__ unsigned pk_fp8x4(float a, float b, float c, float d) {
    a = fminf(fmaxf(a, -448.f), 448.f); b = fminf(fmaxf(b, -448.f), 448.f); c = fminf(fmaxf(c, -448.f), 448.f); d = fminf(fmaxf(d, -448.f), 448.f);
    unsigned w = 0u; w = __builtin_amdgcn_cvt_pk_fp8_f32(a, b, w, false); w = __builtin_amdgcn_cvt_pk_fp8_f32(c, d, w, true); return w;
}
template <int MODE> __device__ __forceinline__ void p0_transpose_item_fp8(const float* W, int K, int N, unsigned char* WT, LAS float* scr, int item, int lane, float scale) {
    const int nblk = N / 32, kb = item / nblk, nb = item % nblk, k0 = 64 * kb, n0 = 32 * nb;
    {
        const GAS f32x4* src = (const GAS f32x4*)(W + (size_t)(k0 + (lane >> 3)) * N + n0) + (lane & 7);
        f32x4 t[8];
#pragma unroll
        for (int j = 0; j < 8; ++j) t[j] = src[(size_t)j * 2 * N];
#pragma unroll
        for (int j = 0; j < 8; ++j) { LAS float* d = scr + ((lane >> 3) + 8 * j) * 33 + 4 * (lane & 7); d[0] = t[j].x; d[1] = t[j].y; d[2] = t[j].z; d[3] = t[j].w; }
    }
    LDS_WAIT(); asm volatile("" ::: "memory");
    const int c = lane & 7;
#pragma unroll
    for (int j = 0; j < 4; ++j) { const int n = (lane >> 3) + 8 * j; const LAS float* s = scr + (8 * c) * 33 + n;
        u32x2 o; o.x = pk_fp8x4(s[0 * 33] * scale, s[1 * 33] * scale, s[2 * 33] * scale, s[3 * 33] * scale); o.y = pk_fp8x4(s[4 * 33] * scale, s[5 * 33] * scale, s[6 * 33] * scale, s[7 * 33] * scale);
        *(GAS u32x2*)(WT + (size_t)dest_row<MODE>(n0 + n) * K + k0 + 8 * c) = o; }
    LDS_WAIT(); asm volatile("" ::: "memory");
}
__device__ __forceinline__ int t5_bucket(int rel) {
    const int n = rel < 0 ? -rel : rel;
    int large = 8 + (n >= 15) + (n >= 27) + (n >= 50) + (n >= 91) + (n >= 166) + (n >= 305) + (n >= 559);
    large = large < 15 ? large : 15;
    return (rel > 0 ? 16 : 0) + (n < 8 ? n : large);
}
__device__ __forceinline__ void p0_prologue(const Args& a, LAS unsigned char* lds, int vcu, int G, int tid, int wave, int lane) {
    unsigned char* ws = a.ws;
    LAS float* scr = (LAS float*)(lds + wave * 16384);
    const int gw = vcu * NWAVES + wave, NGW = G * NWAVES;
    constexpr int I_IN = 16 * 208, I_R = 16 * 32, I_A = 8 * 32, I_O = 16 * 32;
    constexpr int NITEMS = I_IN + I_R + I_A + I_O;
    for (int it = gw; it < NITEMS; it += NGW) {
        int r = it;
#if P1_FP8
        if (r < I_IN) { if ((GATE_FP8 || r % 208 < 144) && r % 208 >= 8 * P1_FP8_FROM) p0_transpose_item_fp8<1>(a.in[1], 1024, 6656, ws + WS_WIN8, scr, r, lane, 64.f);
                        else p0_transpose_item<1>(a.in[1], 1024, 6656, (bf16*)(ws + WS_WIN), scr, r, lane); continue; } r -= I_IN;
#else
        if (r < I_IN) { p0_transpose_item<1>(a.in[1], 1024, 6656, (bf16*)(ws + WS_WIN), scr, r, lane); continue; } r -= I_IN;
#endif
        if (r < I_R) { if (MIX_FP8 & 4) p0_transpose_item_fp8<0>(a.in[5], 1024, 1024, ws + WS_WR, scr, r, lane, 64.f); else p0_transpose_item<0>(a.in[5], 1024, 1024, (bf16*)(ws + WS_WR), scr, r, lane); continue; } r -= I_R;
        if (r < I_A) { if (MIX_FP8 & 2) p0_transpose_item_fp8<0>(a.in[7], 512, 1024, ws + WS_WA, scr, r, lane, 64.f); else p0_transpose_item<0>(a.in[7], 512, 1024, (bf16*)(ws + WS_WA), scr, r, lane); continue; } r -= I_A;
        if (MIX_FP8 & 1) p0_transpose_item_fp8<0>(a.in[8], 1024, 1024, ws + WS_WO, scr, r, lane, 64.f); else p0_transpose_item<0>(a.in[8], 1024, 1024, (bf16*)(ws + WS_WO), scr, r, lane);
    }
    {
        const f32x4* x4 = (const f32x4*)a.in[0]; u32x2* xb = (u32x2*)(ws + WS_XB);
#if P1_FP8
#if GATE_FP8
        unsigned* xf8 = (unsigned*)(ws + WS_X8_LO);
#define XF8_AT(i) xf8[(long)(i) + ((i) >= (size_t)16384 * 256 ? ((long)WS_X8_HI - (long)WS_X8_LO - (long)(16 * MiB)) / 4 : 0L)]
#else
        unsigned* xf8 = (unsigned*)a.out;
#define XF8_AT(i) xf8[i]
#endif
        for (size_t i = (size_t)vcu * 512 + tid; i < (size_t)TT * DM / 4; i += (size_t)G * 512) { const f32x4 v = x4[i]; u32x2 o; o.x = cvtpk(v.x, v.y); o.y = cvtpk(v.z, v.w); if (!X_F32_RES) xb[i] = o; XF8_AT(i) = pk_fp8x4(v.x, v.y, v.z, v.w); }
#undef XF8_AT
#else
        for (size_t i = (size_t)vcu * 512 + tid; i < (size_t)TT * DM / 4; i += (size_t)G * 512) { const f32x4 v = x4[i]; u32x2 o; o.x = cvtpk(v.x, v.y); o.y = cvtpk(v.z, v.w); xb[i] = o; }
#endif
    }
    {
        float* rot = (float*)(ws + WS_ROT);
        for (int idx = vcu * 512 + tid; idx < SEQ * 64; idx += G * 512) {
            const int pos = idx >> 6, jr = idx & 63;
            double iv = 1.0; for (int k = 0; k < jr; ++k) iv *= 0.86596432336006535;
            const float ang = (float)pos * (float)iv;
            const double xx = (double)ang; const double qd = __builtin_rint(xx * 0.63661977236758134); const int qi = (int)qd;
            const double r = (xx - qd * 1.5707963267948966) - qd * 6.123233995736766e-17, r2 = r * r;
            const double sp = r * (1.0 + r2 * (-1.0 / 6 + r2 * (1.0 / 120 + r2 * (-1.0 / 5040 + r2 * (1.0 / 362880 + r2 * (-1.0 / 39916800 + r2 * (1.0 / 6227020800.0)))))));
            const double cp = 1.0 + r2 * (-0.5 + r2 * (1.0 / 24 + r2 * (-1.0 / 720 + r2 * (1.0 / 40320 + r2 * (-1.0 / 3628800 + r2 * (1.0 / 479001600.0))))));
            const int qq = qi & 3; const double s = qq == 0 ? sp : (qq == 1 ? cp : (qq == 2 ? -sp : -cp)), c = qq == 0 ? cp : (qq == 1 ? -sp : (qq == 2 ? -cp : sp));
            float* o = rot + ((size_t)pos * 16 + (jr >> 2)) * 8 + (jr & 3); o[0] = (float)c; o[4] = (float)s;
        }
    }
    if (vcu == 0) {
        float* bt = (float*)(ws + WS_BIAS); const float* rb = a.in[6];
        for (int idx = tid; idx < 3 * 8 * 160; idx += 512) { const int p = idx / (8 * 160), h = (idx / 160) % 8, d = idx % 160 - 80; const int dil = p == 0 ? 1 : (p == 1 ? 4 : 16);
            bt[idx] = (d >= -64 && d <= 64) ? rb[t5_bucket(d * dil) * 8 + h] * 1.4426950408889634f : -1e30f; }
    }
}
__device__ __forceinline__ void p0_expert_weights(const Args& a, LAS unsigned char* lds, int vcu, int G, int wave, int lane) {
    unsigned char* ws = a.ws;
    LAS float* scr = (LAS float*)(lds + wave * 16384);
    const int gw = vcu * NWAVES + wave, NGW = G * NWAVES;
    constexpr int I_G = 16 * 16, I_D = 8 * 32, PER_E = 2 * I_G + I_D;
    for (int it = gw; it < 16 * PER_E; it += NGW) {
        const int e = it / PER_E; int r = it - e * PER_E;
#if M1_FP8
        if (r < I_G) { p0_transpose_item_fp8<2>(a.in[15] + (size_t)e * 1024 * 512, 1024, 512, ws + WS_WGU + (size_t)e * 1024 * 1024, scr, r, lane, 64.f); continue; } r -= I_G;
        if (r < I_G) { p0_transpose_item_fp8<3>(a.in[16] + (size_t)e * 1024 * 512, 1024, 512, ws + WS_WGU + (size_t)e * 1024 * 1024, scr, r, lane, 64.f); continue; } r -= I_G;
#else
        if (r < I_G) { p0_transpose_item<2>(a.in[15] + (size_t)e * 1024 * 512, 1024, 512, (bf16*)(ws + WS_WGU) + (size_t)e * 1024 * 1024, scr, r, lane); continue; } r -= I_G;
        if (r < I_G) { p0_transpose_item<3>(a.in[16] + (size_t)e * 1024 * 512, 1024, 512, (bf16*)(ws + WS_WGU) + (size_t)e * 1024 * 1024, scr, r, lane); continue; } r -= I_G;
#endif
        p0_transpose_item_fp8<0>(a.in[17] + (size_t)e * 512 * 1024, 512, 1024, ws + WS_WD + (size_t)e * 1024 * 512, scr, r, lane, 64.f);
    }
    __syncthreads();
}

__device__ __forceinline__ float log2_gamma(const float* dec, int h) {
    const float x = dec[h]; return -__log2f(1.f + __expf(-x));
}
__device__ __forceinline__ void chain_item(const Args& a, LAS unsigned char* lds, int item, int tid, int wid, int lane) {
    unsigned char* ws = a.ws;
    const int b = item >> 4, h = (item >> 2) & 3, dir = (item >> 1) & 1, vh = item & 1;
    const float lg2 = log2_gamma(dir ? a.in[3] : a.in[2], h);
    const float cd = __builtin_amdgcn_exp2f(lg2 * 128.f);
    const int g = lane >> 4, i16 = lane & 15, q = i16 >> 2, p = lane & 3;
    const int wd = wid >> 1, wv = wid & 1;
    const GAS bf16* kr = (const GAS bf16*)(ws + WS_KR); const GAS bf16* vr = (const GAS bf16*)(ws + WS_VR);
    GAS bf16* states = (GAS bf16*)a.out;
    f32x4 acc[2][4];
#pragma unroll
    for (int i = 0; i < 2; ++i)
#pragma unroll
        for (int j = 0; j < 4; ++j) acc[i][j] = (f32x4){0.f, 0.f, 0.f, 0.f};
    const int srow = tid >> 4, sch = tid & 15; const unsigned soff = offb(srow, sch);
    const GAS bf16* kp = kr + ((size_t)b * SEQ + srow) * 512 + h * 128 + sch * 8;
    const GAS bf16* vp = vr + ((size_t)b * SEQ + srow) * 1024 + h * 256 + vh * 128 + sch * 8;
    v4u kq[4], vq[4];
    { const int n0 = dir ? 15 : 0;
#pragma unroll
      for (int j = 0; j < 4; ++j) { kq[j] = *(const GAS v4u*)(kp + (size_t)(n0 * 128 + 32 * j) * 512); vq[j] = *(const GAS v4u*)(vp + (size_t)(n0 * 128 + 32 * j) * 1024); } }
    unsigned abase[2][2], bbase[4][2];
#pragma unroll
    for (int t = 0; t < 2; ++t) { const unsigned r = 8 * g + 4 * t + q;
#pragma unroll
        for (int dt = 0; dt < 2; ++dt) abase[dt][t] = offb(r, 2 * (2 * wd + dt) + (p >> 1)) + 8 * (p & 1);
#pragma unroll
        for (int vt = 0; vt < 4; ++vt) bbase[vt][t] = offb(r, 2 * (4 * wv + vt) + (p >> 1)) + 8 * (p & 1); }
#define CH_STAGE(BUFOFF) do { _Pragma("unroll") for (int j = 0; j < 4; ++j) { \
            const int row = srow + 32 * j; const float z = __builtin_amdgcn_exp2f(lg2 * (float)(dir ? row : 127 - row)); const v4u kv = kq[j]; \
            v4u ko; ko.x = cvtpk(bflo(kv.x) * z, bfhi(kv.x) * z); ko.y = cvtpk(bflo(kv.y) * z, bfhi(kv.y) * z); ko.z = cvtpk(bflo(kv.z) * z, bfhi(kv.z) * z); ko.w = cvtpk(bflo(kv.w) * z, bfhi(kv.w) * z); \
            *(LAS v4u*)(lds + (BUFOFF) + soff + j * 8192) = ko; *(LAS v4u*)(lds + (BUFOFF) + 32768 + soff + j * 8192) = vq[j]; } } while (0)
#define CH_FETCH(NN) do { _Pragma("unroll") for (int j = 0; j < 4; ++j) { kq[j] = *(const GAS v4u*)(kp + (size_t)((NN) * 128 + 32 * j) * 512); vq[j] = *(const GAS v4u*)(vp + (size_t)((NN) * 128 + 32 * j) * 1024); } } while (0)
#define CH_STEP(STEP, CUR, OTH) do { const int step_ = (STEP); const int n_ = dir ? 15 - step_ : step_; \
        GAS bf16* sb_ = states + ((((size_t)(b * 4 + h) * 16 + n_) * 2 + dir) * 256) * 128; \
        _Pragma("unroll") for (int dt = 0; dt < 2; ++dt) _Pragma("unroll") for (int vt = 0; vt < 4; ++vt) { \
            const int v_ = vh * 128 + 64 * wv + 16 * vt + i16, d0_ = 32 * wd + 16 * dt + 4 * g; \
            u32x2 w_; w_.x = pg8::cvt_pk_bf16_acc(acc[dt][vt][0], acc[dt][vt][1]); w_.y = pg8::cvt_pk_bf16_acc(acc[dt][vt][2], acc[dt][vt][3]);   \
            *(GAS u32x2*)(sb_ + (size_t)v_ * 128 + d0_) = w_; } \
        if (step_ < 15) CH_STAGE(OTH); \
        if (step_ < 14) CH_FETCH(dir ? 13 - step_ : step_ + 2); \
        _Pragma("unroll") for (int i = 0; i < 2; ++i) _Pragma("unroll") for (int j = 0; j < 4; ++j) acc[i][j] = acc[i][j] * cd; \
        _Pragma("unroll") for (int ks = 0; ks < 4; ++ks) { bf16x8 af[2], bfr[4]; \
            _Pragma("unroll") for (int dt = 0; dt < 2; ++dt) af[dt] = cat8(ldtr(lds + (CUR) + abase[dt][0] + ks * 8192), ldtr(lds + (CUR) + abase[dt][1] + ks * 8192)); \
            _Pragma("unroll") for (int vt = 0; vt < 4; ++vt) bfr[vt] = cat8(ldtr(lds + (CUR) + 32768 + bbase[vt][0] + ks * 8192), ldtr(lds + (CUR) + 32768 + bbase[vt][1] + ks * 8192)); \
            _Pragma("unroll") for (int dt = 0; dt < 2; ++dt) _Pragma("unroll") for (int vt = 0; vt < 4; ++vt) acc[dt][vt] = MFMA16(af[dt], bfr[vt], acc[dt][vt]); } \
        __syncthreads(); } while (0)
    CH_STAGE(0);
    CH_FETCH(dir ? 14 : 1);
    __syncthreads();
    for (int sp = 0; sp < 8; ++sp) { CH_STEP(2 * sp, 0, 65536); CH_STEP(2 * sp + 1, 65536, 0); }
#undef CH_STEP
#undef CH_STAGE
#undef CH_FETCH
}

constexpr int AT_OST = 135168, AT_SCR = AT_OST + 8 * 2048;
constexpr int ATB_N = 160;
struct AttnLane { unsigned kb[2]; unsigned vb[4]; };
__device__ __forceinline__ AttnLane attn_lane(int lane) {
    const int g = lane >> 4, i16 = lane & 15, q4 = i16 >> 2, p = lane & 3; AttnLane L;
#pragma unroll
    for (int s = 0; s < 2; ++s) L.kb[s] = i16 * 128 + (((4 * s + g) ^ ((i16 >> 1) & 7)) * 16);
    const int sw = (2 * g + (q4 >> 1)) & 3;
#pragma unroll
    for (int c = 0; c < 4; ++c) L.vb[c] = (4 * g + q4) * 128 + ((c ^ sw) * 32) + p * 8;
    return L;
}
__device__ __forceinline__ unsigned kimg_off(int row, int c) { return row * 128 + ((c ^ ((row >> 1) & 7)) * 16); }
__device__ __forceinline__ unsigned vimg_off(int row, int c) { return row * 128 + (((c >> 1) ^ ((row >> 1) & 3)) * 32) + (c & 1) * 16; }
__device__ __forceinline__ void attn_core(const LAS unsigned char* Kimg, const LAS unsigned char* Vimg, int R0, int nrows, unsigned tvalid, const bf16x8 (&qf)[2],
                                          const float (&biasr)[36], const AttnLane& L, f32x4 (&O)[4], float& mx, float& lsum) {
    f32x4 D[9];
#pragma unroll
    for (int kt = 0; kt < 9; ++kt) {
        int R = R0 + 16 * kt; R = R < 0 ? 0 : (R > nrows - 16 ? nrows - 16 : R);
        const LAS unsigned char* kp = Kimg + R * 128;
        const bf16x8 k0 = *(const LAS bf16x8*)(kp + L.kb[0]), k1 = *(const LAS bf16x8*)(kp + L.kb[1]);
        f32x4 d = (f32x4){0.f, 0.f, 0.f, 0.f};
        d = MFMA16(k0, qf[0], d); d = MFMA16(k1, qf[1], d); D[kt] = d;
    }
    mx = -1e30f;
#pragma unroll
    for (int kt = 0; kt < 9; ++kt) {
        const float tb = ((tvalid >> kt) & 1u) ? 0.f : -1e30f;
#pragma unroll
        for (int r = 0; r < 4; ++r) { const float x = D[kt][r] + (biasr[4 * kt + r] + tb); D[kt][r] = x; mx = fmaxf(mx, x); }
    }
    mx = fmaxf(mx, __shfl_xor(mx, 16)); mx = fmaxf(mx, __shfl_xor(mx, 32));
    lsum = 0.f;
#pragma unroll
    for (int kt = 0; kt < 9; ++kt)
#pragma unroll
        for (int r = 0; r < 4; ++r) { const float e = __builtin_amdgcn_exp2f(D[kt][r] - mx); D[kt][r] = e; lsum += e; }
    lsum += __shfl_xor(lsum, 16); lsum += __shfl_xor(lsum, 32);
#pragma unroll
    for (int c = 0; c < 4; ++c) O[c] = (f32x4){0.f, 0.f, 0.f, 0.f};
#pragma unroll
    for (int kk = 0; kk < 5; ++kk) {
        int Ra = R0 + 32 * kk; Ra = Ra < 0 ? 0 : (Ra > nrows - 16 ? nrows - 16 : Ra);
        int Rb = R0 + 32 * kk + 16; Rb = Rb < 0 ? 0 : (Rb > nrows - 16 ? nrows - 16 : Rb);
        if (kk == 4) Rb = Ra;
        const f32x4 e0 = D[2 * kk], e1 = kk < 4 ? D[2 * kk + 1] : (f32x4){0.f, 0.f, 0.f, 0.f};
        v4u pw; pw.x = cvtpk(e0[0], e0[1]); pw.y = cvtpk(e0[2], e0[3]); pw.z = cvtpk(e1[0], e1[1]); pw.w = cvtpk(e1[2], e1[3]);
        const bf16x8 pf = __builtin_bit_cast(bf16x8, pw);
        const LAS unsigned char* va_ = Vimg + Ra * 128; const LAS unsigned char* vb_ = Vimg + Rb * 128;
#pragma unroll
        for (int c = 0; c < 4; ++c) O[c] = MFMA16(pf, cat8(ldtr(va_ + L.vb[c]), ldtr(vb_ + L.vb[c])), O[c]);
    }
}
__device__ __forceinline__ void attn_stage_out(LAS unsigned char* lds, int wid, int lane, const f32x4 (&O)[4], float lsum) {
    const int g = lane >> 4, i16 = lane & 15;
    const float linv = 1.f / lsum;
    LAS bf16* st = (LAS bf16*)(lds + AT_OST + wid * 2048);
#pragma unroll
    for (int r = 0; r < 4; ++r) { const float li = __shfl(linv, 4 * g + r);
#pragma unroll
        for (int c = 0; c < 4; ++c) st[(4 * g + r) * 64 + 16 * c + i16] = (bf16)(cvtpk(O[c][r] * li, 0.f) & 0xffffu); }
}
__device__ __forceinline__ void attn_load_bias(const Args& a, int pat, int h, int lane, float (&biasr)[36]) {
    const GAS float* bt = (const GAS float*)(a.ws + WS_BIAS) + (pat * 8 + h) * ATB_N; const int g = lane >> 4, i16 = lane & 15;
#pragma unroll
    for (int kt = 0; kt < 9; ++kt)
#pragma unroll
        for (int r = 0; r < 4; ++r) biasr[4 * kt + r] = bt[16 * kt + 4 * g + r - 64 - i16 + 80];
}
template <int DIL, int VAR = 0> __device__ __forceinline__ void attn_dil_phase(const Args& a, LAS unsigned char* lds, int vcu, int G, int tid, int wid, int lane) {
    unsigned char* ws = a.ws;
    constexpr int NR = SEQ / DIL, PAT = DIL == 4 ? 1 : 2, CH = NR * 8 / 512, NITEM = NB * 8 * DIL;
    constexpr int NBUF = DIL == 16 ? 2 : 1, BUFB = 2 * NR * 128;
    const GAS bf16* qa = (const GAS bf16*)(ws + WS_QA); const GAS bf16* ka = (const GAS bf16*)(ws + WS_KA); const GAS bf16* va = (const GAS bf16*)(ws + WS_VA);
    bf16* op = (bf16*)(ws + (DIL == 4 ? WS_O2 : WS_O3)); float* lsep = (float*)(ws + (DIL == 4 ? WS_LSE2 : WS_LSE3));
    if (vcu >= NITEM) return;
    const int h = vcu & 7;
    float biasr[36]; attn_load_bias(a, PAT, h, lane, biasr);
    const AttnLane L = attn_lane(lane);
    const int g = lane >> 4, i16 = lane & 15;
    v4u kq[CH], vq[CH]; bf16x8 qn[2];
    auto issue = [&](int item, int gi) {
        const int rho = (item >> 3) % DIL, b = item / (8 * DIL); const size_t rowb = (size_t)b * SEQ;
#pragma unroll
        for (int j = 0; j < CH; ++j) { const int id = tid + 512 * j, row = id >> 3, c = id & 7; const size_t go = (rowb + (size_t)row * DIL + rho) * 512 + h * 64 + c * 8;
            kq[j] = *(const GAS v4u*)(ka + go); vq[j] = *(const GAS v4u*)(va + go); }
        const size_t qpos = rowb + (size_t)(16 * gi + i16) * DIL + rho;
#pragma unroll
        for (int s = 0; s < 2; ++s) qn[s] = *(const GAS bf16x8*)(qa + qpos * 512 + h * 64 + 32 * s + 8 * g);
    };
    issue(vcu, wid);
    int buf = 0;
    for (int item = vcu; item < NITEM; item += G) {
        const int rho = (item >> 3) % DIL, b = item / (8 * DIL); const size_t rowb = (size_t)b * SEQ;
        LAS unsigned char* Kimg = lds + buf * BUFB; LAS unsigned char* Vimg = Kimg + NR * 128;
        if (NBUF == 1) __syncthreads();
#pragma unroll
        for (int j = 0; j < CH; ++j) { const int id = tid + 512 * j, row = id >> 3, c = id & 7;
            *(LAS v4u*)(Kimg + kimg_off(row, c)) = kq[j]; *(LAS v4u*)(Vimg + vimg_off(row, c)) = vq[j]; }
        bf16x8 qf[2] = {qn[0], qn[1]};
        __syncthreads();
        if (NBUF == 2 && item + G < NITEM) issue(item + G, wid);
        for (int gi = wid; gi < NR / 16; gi += 8) {
            const int m0 = 16 * gi;
            if (NBUF == 1 && gi + 8 < NR / 16) {
                const size_t qpos = rowb + (size_t)(m0 + 128 + i16) * DIL + rho;
#pragma unroll
                for (int s = 0; s < 2; ++s) qn[s] = *(const GAS bf16x8*)(qa + qpos * 512 + h * 64 + 32 * s + 8 * g); }
            unsigned tvalid = 0u;
#pragma unroll
            for (int kt = 0; kt < 9; ++kt) { const int t0 = m0 - 64 + 16 * kt; tvalid |= (t0 >= 0 && t0 < NR) ? (1u << kt) : 0u; }
            f32x4 O[4]; float mx, lsum;
            if (VAR == 1) { mx = 0.f; lsum = 1.f;
#pragma unroll
                for (int c = 0; c < 4; ++c) O[c] = (f32x4){__builtin_bit_cast(float, qf[0][0] + c), 0.f, 0.f, 0.f}; }
            else attn_core(Kimg, Vimg, m0 - 64, NR, tvalid, qf, biasr, L, O, mx, lsum);
            attn_stage_out(lds, wid, lane, O, lsum);
            if (g == 0) lsep[(rowb + (size_t)(m0 + i16) * DIL + rho) * 8 + h] = mx + __log2f(lsum);
            asm volatile("s_waitcnt lgkmcnt(0)" ::: "memory");
            { const int q = lane >> 2, qt = lane & 3; const LAS v4u* sp = (const LAS v4u*)(lds + AT_OST + wid * 2048 + q * 128 + qt * 32);
              const v4u x0 = sp[0], x1 = sp[1]; bf16* dst = op + (rowb + (size_t)(m0 + q) * DIL + rho) * 512 + h * 64 + qt * 16;
              *(v4u*)dst = x0; *(v4u*)(dst + 8) = x1; }
            asm volatile("s_waitcnt lgkmcnt(0)" ::: "memory");
            if (NBUF == 1) { qf[0] = qn[0]; qf[1] = qn[1]; }
        }
        if (NBUF == 1 && item + G < NITEM) issue(item + G, wid);
        buf ^= (NBUF - 1);
    }
    __syncthreads();
}
__device__ __forceinline__ void attn_p1_phase(const Args& a, LAS unsigned char* lds, int vcu, int G, int tid, int wid, int lane) {
    unsigned char* ws = a.ws;
    LAS unsigned char* Kimg = lds; LAS unsigned char* Vimg = lds + 384 * 128;
    const GAS bf16* qa = (const GAS bf16*)(ws + WS_QA); const GAS bf16* ka = (const GAS bf16*)(ws + WS_KA); const GAS bf16* va = (const GAS bf16*)(ws + WS_VA);
    const GAS bf16* o2 = (const GAS bf16*)(ws + WS_O2); const GAS bf16* o3 = (const GAS bf16*)(ws + WS_O3);
    const GAS float* lse2 = (const GAS float*)(ws + WS_LSE2); const GAS float* lse3 = (const GAS float*)(ws + WS_LSE3);
    bf16* oa = (bf16*)(ws + WS_OA);
    if (vcu >= 1024) return;
    const int h = vcu & 7;
    float biasr[36]; attn_load_bias(a, 0, h, lane, biasr);
    const AttnLane L = attn_lane(lane);
    const int g = lane >> 4, i16 = lane & 15;
    LAS float* scr = (LAS float*)(lds + AT_SCR) + wid * 16;
    v4u kq[6], vq[6];
    auto issue = [&](int item) { const int b = item >> 6, s0 = ((item >> 3) & 7) * 256; const size_t rowb = (size_t)b * SEQ;
#pragma unroll
        for (int j = 0; j < 6; ++j) { const int id = tid + 512 * j, row = id >> 3, c = id & 7, pos = s0 - 64 + row; const bool ok = pos >= 0 && pos < SEQ;
            const size_t go = (rowb + (size_t)(ok ? pos : 0)) * 512 + h * 64 + c * 8;
            kq[j] = *(const GAS v4u*)(ka + go); vq[j] = *(const GAS v4u*)(va + go);
            if (!ok) { kq[j] = (v4u){0u, 0u, 0u, 0u}; vq[j] = (v4u){0u, 0u, 0u, 0u}; } } };
    issue(vcu);
    for (int item = vcu; item < 1024; item += G) {
        const int b = item >> 6, s0 = ((item >> 3) & 7) * 256; const size_t rowb = (size_t)b * SEQ;
        __syncthreads();
#pragma unroll
        for (int j = 0; j < 6; ++j) { const int id = tid + 512 * j, row = id >> 3, c = id & 7;
            *(LAS v4u*)(Kimg + kimg_off(row, c)) = kq[j]; *(LAS v4u*)(Vimg + vimg_off(row, c)) = vq[j]; }
        __syncthreads();
        if (item + G < 1024) issue(item + G);
        for (int gi = wid; gi < 16; gi += 8) {
            const int m0 = s0 + 16 * gi;
            const int q = lane >> 2, qt = lane & 3; const size_t tq = rowb + m0 + q;
            const v4u a20 = *(const GAS v4u*)(o2 + tq * 512 + h * 64 + qt * 16), a21 = *(const GAS v4u*)(o2 + tq * 512 + h * 64 + qt * 16 + 8);
            const v4u a30 = *(const GAS v4u*)(o3 + tq * 512 + h * 64 + qt * 16), a31 = *(const GAS v4u*)(o3 + tq * 512 + h * 64 + qt * 16 + 8);
            const float l2 = lse2[tq * 8 + h], l3 = lse3[tq * 8 + h];
            bf16x8 qf[2];
#pragma unroll
            for (int s = 0; s < 2; ++s) qf[s] = *(const GAS bf16x8*)(qa + (rowb + m0 + i16) * 512 + h * 64 + 32 * s + 8 * g);
            unsigned tvalid = 0u;
#pragma unroll
            for (int kt = 0; kt < 9; ++kt) { const int t0 = m0 - 64 + 16 * kt; tvalid |= (t0 >= 0 && t0 < SEQ) ? (1u << kt) : 0u; }
            f32x4 O[4]; float mx, lsum;
            attn_core(Kimg, Vimg, 16 * gi, 384, tvalid, qf, biasr, L, O, mx, lsum);
            attn_stage_out(lds, wid, lane, O, lsum);
            if (g == 0) scr[i16] = mx + __log2f(lsum);
            asm volatile("s_waitcnt lgkmcnt(0)" ::: "memory");
            {
                const float l1 = scr[q], M = fmaxf(l1, fmaxf(l2, l3));
                float w1 = __builtin_amdgcn_exp2f(l1 - M), w2 = __builtin_amdgcn_exp2f(l2 - M), w3 = __builtin_amdgcn_exp2f(l3 - M); const float wi = 1.f / (w1 + w2 + w3); w1 *= wi; w2 *= wi; w3 *= wi;
                const LAS v4u* sp = (const LAS v4u*)(lds + AT_OST + wid * 2048 + q * 128 + qt * 32);
                const v4u x0 = sp[0], x1 = sp[1];
                v4u r0, r1;
#define MRG(d, x, y, z) d = cvtpk(w1 * bflo(x) + w2 * bflo(y) + w3 * bflo(z), w1 * bfhi(x) + w2 * bfhi(y) + w3 * bfhi(z))
                MRG(r0.x, x0.x, a20.x, a30.x); MRG(r0.y, x0.y, a20.y, a30.y); MRG(r0.z, x0.z, a20.z, a30.z); MRG(r0.w, x0.w, a20.w, a30.w);
                MRG(r1.x, x1.x, a21.x, a31.x); MRG(r1.y, x1.y, a21.y, a31.y); MRG(r1.z, x1.z, a21.z, a31.z); MRG(r1.w, x1.w, a21.w, a31.w);
#undef MRG
#if MIX_FP8 & 2
                v4u o8;
                o8.x = pk_fp8x4(16.f * bflo(r0.x), 16.f * bfhi(r0.x), 16.f * bflo(r0.y), 16.f * bfhi(r0.y)); o8.y = pk_fp8x4(16.f * bflo(r0.z), 16.f * bfhi(r0.z), 16.f * bflo(r0.w), 16.f * bfhi(r0.w));
                o8.z = pk_fp8x4(16.f * bflo(r1.x), 16.f * bfhi(r1.x), 16.f * bflo(r1.y), 16.f * bfhi(r1.y)); o8.w = pk_fp8x4(16.f * bflo(r1.z), 16.f * bfhi(r1.z), 16.f * bflo(r1.w), 16.f * bfhi(r1.w));
                *(v4u*)((unsigned char*)oa + tq * 512 + h * 64 + qt * 16) = o8;
#else
                bf16* dst = oa + tq * 512 + h * 64 + qt * 16;
                *(v4u*)dst = r0; *(v4u*)(dst + 8) = r1;
#endif
            }
            asm volatile("s_waitcnt lgkmcnt(0)" ::: "memory");
        }
    }
    __syncthreads();
}

#define OPAQUE(x) asm volatile("" : "+v"(x))
template <int VAR = 0> __device__ __forceinline__ void p3_phase(const Args& a, LAS unsigned char* lds, int vcu, int G, int tid, int wid, int lane) {
    unsigned char* ws = a.ws;
    const int g = lane >> 4, i16 = lane & 15, q4 = i16 >> 2, p = lane & 3;
    const GAS bf16* qr = (const GAS bf16*)(ws + WS_QR); const GAS bf16* kr = (const GAS bf16*)(ws + WS_KR); const GAS bf16* vr = (const GAS bf16*)(ws + WS_VR);
    GAS bf16* gr = (GAS bf16*)(ws + WS_GR);
    LAS unsigned char* Kt = lds; LAS unsigned char* Sg = lds + 32768;
    if (vcu >= 1024) return;
    const unsigned kdst = offb(tid >> 4, tid & 15);
    unsigned rfo[4];
    { const unsigned X = ((i16 & 3) << 2) | (i16 >> 2);
#pragma unroll
      for (int s = 0; s < 4; ++s) rfo[s] = 256 * i16 + 16 * (((4 * s) ^ (X & 12)) | (g ^ (X & 3))); }
    v4u sreg[8], kreg[4]; bf16x8 qn[4];
    auto item_ptrs = [&](int item, size_t& tok0, const GAS bf16*& sf, int& h) { const int b = item >> 6; h = (item >> 4) & 3; const int n = item & 15; tok0 = (size_t)b * SEQ + n * 128;
        sf = (const GAS bf16*)a.out + ((((size_t)(b * 4 + h) * 16 + n) * 2 + 0) * 256) * 128; };
    auto issue_k = [&](int item) { size_t tok0; const GAS bf16* sf; int h; item_ptrs(item, tok0, sf, h);
        const GAS bf16* ks_ = kr + (tok0 + (tid >> 4)) * 512 + h * 128 + (tid & 15) * 8;
#pragma unroll
        for (int j = 0; j < 4; ++j) kreg[j] = *(const GAS v4u*)(ks_ + (size_t)j * 32 * 512); };
    auto issue_q = [&](int item) { size_t tok0; const GAS bf16* sf; int h; item_ptrs(item, tok0, sf, h);
#pragma unroll
        for (int s = 0; s < 4; ++s) qn[s] = *(const GAS bf16x8*)(qr + (tok0 + 16 * wid + i16) * 512 + h * 128 + 32 * s + 8 * g); };
    auto issue_state = [&](const GAS bf16* sf, int dirn) { const GAS bf16* sld = sf + (size_t)dirn * 256 * 128 + (size_t)(tid >> 4) * 128 + (tid & 15) * 8;
#pragma unroll
        for (int j = 0; j < 8; ++j) sreg[j] = *(const GAS v4u*)(sld + (size_t)j * 32 * 128); };
    auto write_state = [&]() {
#pragma unroll
        for (int j = 0; j < 8; ++j) *(LAS v4u*)(Sg + (j >> 2) * 32768 + kdst + (j & 3) * 8192) = sreg[j]; };
    { size_t tok0; const GAS bf16* sf; int h; item_ptrs(vcu, tok0, sf, h); issue_k(vcu); issue_q(vcu); issue_state(sf, 0); }
#pragma unroll
    for (int j = 0; j < 4; ++j) *(LAS v4u*)(Kt + kdst + j * 8192) = kreg[j];
    for (int item = vcu; item < 1024; item += G) {
        size_t tok0; const GAS bf16* sf; int h; item_ptrs(item, tok0, sf, h);
        const float lf2 = log2_gamma(a.in[2], h), lb2 = log2_gamma(a.in[3], h);
        bf16x8 qf[4];
#pragma unroll
        for (int s = 0; s < 4; ++s) qf[s] = qn[s];
        const bool has_next = item + G < 1024;
        __syncthreads();
        f32x4 D[8];
#pragma unroll
        for (int jt = 0; jt < 8; ++jt) {
            f32x4 d = (f32x4){0.f, 0.f, 0.f, 0.f};
#pragma unroll
            for (int s = 0; s < 4; ++s) { if (VAR != 1) { const bf16x8 kf = *(const LAS bf16x8*)(Kt + rfo[s] + jt * 4096); d = MFMA16(kf, qf[s], d); } else d[s] = __builtin_bit_cast(float, (int)qf[s][0]); }
            D[jt] = d;
        }
        int iq = 16 * wid + i16; OPAQUE(iq);
        bf16x8 pf[4];
#pragma unroll
        for (int ks = 0; ks < 4; ++ks) {
            float e[8];
#pragma unroll
            for (int t = 0; t < 2; ++t)
#pragma unroll
                for (int r = 0; r < 4; ++r) {
                    const int j = 16 * (2 * ks + t) + 4 * g + r; const float fdf = (float)(iq - j), ad = fabsf(fdf);
                    const float pos = fminf(fmaxf(fdf, 0.f), 1.f), isz = 1.f - fminf(ad, 1.f);
                    const float w = __builtin_amdgcn_exp2f((lb2 + (lf2 - lb2) * pos) * ad) + isz;
                    e[4 * t + r] = D[2 * ks + t][r] * w;
                }
            v4u pw; pw.x = cvtpk(e[0], e[1]); pw.y = cvtpk(e[2], e[3]); pw.z = cvtpk(e[4], e[5]); pw.w = cvtpk(e[6], e[7]);
            pf[ks] = __builtin_bit_cast(bf16x8, pw);
        }
        f32x4 acc[16];
#pragma unroll
        for (int vt = 0; vt < 16; ++vt) acc[vt] = (f32x4){0.f, 0.f, 0.f, 0.f};
#pragma unroll
        for (int dirn = 0; dirn < 2; ++dirn) {
            if (dirn == 1) __syncthreads();
            write_state();
            if (dirn == 0) { issue_state(sf, 1); if (has_next) issue_k(item + G); }
            else {
                if (has_next) {
#pragma unroll
                    for (int j = 0; j < 4; ++j) *(LAS v4u*)(Kt + kdst + j * 8192) = kreg[j]; }
                const GAS bf16* vs_ = vr + (tok0 + (tid >> 5)) * 1024 + h * 256 + (tid & 31) * 8;
#pragma unroll
                for (int j = 0; j < 8; ++j) sreg[j] = *(const GAS v4u*)(vs_ + (size_t)j * 16 * 1024);
            }
            __syncthreads();
#pragma unroll
            for (int vt = 0; vt < 16; ++vt) {
#pragma unroll
                for (int s = 0; s < 4; ++s) { if (VAR != 1) { const bf16x8 sfr = *(const LAS bf16x8*)(Sg + (vt >> 3) * 32768 + rfo[s] + (vt & 7) * 4096); acc[vt] = MFMA16(qf[s], sfr, acc[vt]); } }
            }
            float xs[4];
            { int ib = 16 * wid + 4 * g; OPAQUE(ib);
#pragma unroll
              for (int r = 0; r < 4; ++r) { const float lxf = lf2 * (float)(ib + r + 1), lxb = lb2 * (float)(128 - ib - r); xs[r] = __builtin_amdgcn_exp2f(dirn == 0 ? lxf - lxb : lxb); } }
#pragma unroll
            for (int vt = 0; vt < 16; ++vt)
#pragma unroll
                for (int r = 0; r < 4; ++r) acc[vt][r] *= xs[r];
        }
        __syncthreads();
        { int t2 = tid; OPAQUE(t2); const unsigned vd2 = (unsigned)((t2 & 31) >> 4) * 32768u + offb(t2 >> 5, t2 & 15);
#pragma unroll
          for (int j = 0; j < 8; ++j) *(LAS v4u*)(Sg + vd2 + j * 4096) = sreg[j]; }
        GAS bf16* gp = gr + (tok0 + 16 * wid + (lane >> 5)) * 1024 + h * 256 + (lane & 31) * 8;
#if MIX_FP8 & 4
        GAS unsigned char* ar8 = (GAS unsigned char*)(ws + WS_AR8) + (tok0 + 16 * wid + (lane >> 5)) * 1024 + h * 256 + (lane & 31) * 8;
#endif
        __syncthreads();
        unsigned vbs[8];
        { int l2 = lane; OPAQUE(l2); const unsigned g2 = l2 >> 4, q2 = (l2 & 15) >> 2, p2 = l2 & 3, X = (q2 << 2) | g2;
#pragma unroll
          for (int c = 0; c < 8; ++c) vbs[c] = 256 * (4 * g2 + q2) + 16 * (((2 * c) ^ (X & 14)) | ((p2 >> 1) ^ (X & 1))) + 8 * (p2 & 1); }
#pragma unroll
        for (int vt = 0; vt < 16; ++vt) {
#pragma unroll
            for (int ks = 0; ks < 4; ++ks) { if (VAR != 1) {
                const s16x4 lo = ldtr(Sg + vbs[vt & 7] + (vt >> 3) * 32768 + ks * 8192), hi = ldtr(Sg + vbs[vt & 7] + (vt >> 3) * 32768 + ks * 8192 + 4096);
                acc[vt] = MFMA16(pf[ks], cat8(lo, hi), acc[vt]); }
            }
            asm volatile("" ::: "memory");
        }
        float mu[4], rs[4];
#pragma unroll
        for (int r = 0; r < 4; ++r) {
            float s = 0.f;
#pragma unroll
            for (int vt = 0; vt < 16; ++vt) s += acc[vt][r];
            s += __shfl_xor(s, 1); s += __shfl_xor(s, 2); s += __shfl_xor(s, 4); s += __shfl_xor(s, 8);
            const float m = s * (1.f / 256.f); float qv = 0.f;
#pragma unroll
            for (int vt = 0; vt < 16; ++vt) { const float d = acc[vt][r] - m; qv += d * d; }
            qv += __shfl_xor(qv, 1); qv += __shfl_xor(qv, 2); qv += __shfl_xor(qv, 4); qv += __shfl_xor(qv, 8);
            mu[r] = m; rs[r] = 1.f / sqrtf(qv * (1.f / 256.f) + LN_EPSF);
        }
        v4u greg[8];
#pragma unroll
        for (int j = 0; j < 8; ++j) greg[j] = *(const GAS v4u*)(gp + (size_t)j * 2048);
        __syncthreads();
        if (has_next) { size_t tk; const GAS bf16* sfn; int hn; item_ptrs(item + G, tk, sfn, hn); issue_state(sfn, 0); issue_q(item + G); }
        LAS bf16* st = (LAS bf16*)(Sg + wid * 8192);
        { LAS bf16* sp_ = st + (4 * g) * 256 + i16;
#pragma unroll
          for (int vt = 0; vt < 16; ++vt)
#pragma unroll
              for (int r = 0; r < 4; ++r) sp_[r * 256 + 16 * vt] = (bf16)(cvtpk((acc[vt][r] - mu[r]) * rs[r], 0.f) & 0xffffu); }
        asm volatile("s_waitcnt lgkmcnt(0)" ::: "memory");
        {
            const float* gn = a.in[4] + h * 256; const int ch = lane & 31;
            const f32x4 g0 = *(const f32x4*)(gn + ch * 8), g1 = *(const f32x4*)(gn + ch * 8 + 4);
            const LAS bf16* yp = st + (lane >> 5) * 256 + ch * 8;
#pragma unroll
            for (int j = 0; j < 8; ++j) {
                const v4u y = *(const LAS v4u*)(yp + j * 512); const v4u sg = greg[j];
                v4u o; o.x = cvtpk(bflo(y.x) * g0[0] * bflo(sg.x), bfhi(y.x) * g0[1] * bfhi(sg.x)); o.y = cvtpk(bflo(y.y) * g0[2] * bflo(sg.y), bfhi(y.y) * g0[3] * bfhi(sg.y));
                o.z = cvtpk(bflo(y.z) * g1[0] * bflo(sg.z), bfhi(y.z) * g1[1] * bfhi(sg.z)); o.w = cvtpk(bflo(y.w) * g1[2] * bflo(sg.w), bfhi(y.w) * g1[3] * bfhi(sg.w));
#if MIX_FP8 & 4
                u32x2 o8; o8.x = pk_fp8x4(bflo(o.x), bfhi(o.x), bflo(o.y), bfhi(o.y)); o8.y = pk_fp8x4(bflo(o.z), bfhi(o.z), bflo(o.w), bfhi(o.w));
                *(GAS u32x2*)(ar8 + (size_t)j * 2048) = o8;
#else
                *(GAS v4u*)(gp + (size_t)j * 2048) = o;
#endif
            }
        }
        __syncthreads();
    }
}

constexpr int P6_RS = 81920, P6_CNT = P6_RS + 8 * 512, P6_BASE = P6_CNT + 64, P6_ROW = P6_BASE + 64;
#define P6_BUTTERFLY(lg, out) do { float r10[10], r5[5], r3[3], r2[2]; const float z = 0.f; \
    _Pragma("unroll") for (int k = 0; k < 10; ++k) { const float keep = h32 ? lg[10 + k] : lg[k], send = h32 ? lg[k] : lg[10 + k]; r10[k] = keep + __shfl_xor(send, 32); } \
    _Pragma("unroll") for (int k = 0; k < 5; ++k) { const float keep = h16 ? r10[5 + k] : r10[k], send = h16 ? r10[k] : r10[5 + k]; r5[k] = keep + __shfl_xor(send, 16); } \
    { const float keep = h8 ? r5[3] : r5[0], send = h8 ? r5[0] : r5[3]; r3[0] = keep + __shfl_xor(send, 8); } \
    { const float keep = h8 ? r5[4] : r5[1], send = h8 ? r5[1] : r5[4]; r3[1] = keep + __shfl_xor(send, 8); } \
    { const float keep = h8 ? z : r5[2], send = h8 ? r5[2] : z; r3[2] = keep + __shfl_xor(send, 8); } \
    { const float keep = h4 ? r3[2] : r3[0], send = h4 ? r3[0] : r3[2]; r2[0] = keep + __shfl_xor(send, 4); } \
    { const float keep = h4 ? z : r3[1], send = h4 ? r3[1] : z; r2[1] = keep + __shfl_xor(send, 4); } \
    { const float keep = h2 ? r2[1] : r2[0], send = h2 ? r2[0] : r2[1]; out = keep + __shfl_xor(send, 2); } \
    out += __shfl_xor(out, 1); } while (0)
__device__ __forceinline__ void p6a_phase(const Args& a, LAS unsigned char* lds, int vcu, int G, int tid, int wave, int lane) {
    unsigned char* ws = a.ws;
    LAS float* RW = (LAS float*)lds;
    LAS float* RS = (LAS float*)(lds + P6_RS) + wave * 128;
    LAS unsigned* LC = (LAS unsigned*)(lds + P6_CNT); LAS unsigned* LB = (LAS unsigned*)(lds + P6_BASE); LAS unsigned* LR = (LAS unsigned*)(lds + P6_ROW);
    for (int i = tid; i < 1024 * 4; i += 512) { const int c = i >> 2, k = i & 3; RW[k * 1024 + c] = a.in[11][i]; }
    for (int i = tid; i < 1024 * 16; i += 512) { const int c = i >> 4, k = i & 15; RW[(4 + k) * 1024 + c] = a.in[13][i]; }
    const u32x2* pre = (const u32x2*)a.out; u32x2* x1b = (u32x2*)(ws + WS_XB); [[maybe_unused]] unsigned* x1f8 = (unsigned*)(ws + WS_X1F8);
    gu32* ctl = (gu32*)ws;
    int* ltok = (int*)(ws + WS_LTOK); float* tw = (float*)(ws + WS_WSLOT); unsigned* tinfo = (unsigned*)(ws + WS_TINFO);
    const float* g1 = a.in[9]; const float* b1 = a.in[10];
    const bool h32 = (lane & 32) != 0, h16 = (lane & 16) != 0, h8 = (lane & 8) != 0, h4 = (lane & 4) != 0, h2 = (lane & 2) != 0;
#define P6_LOADROW(dst, t_) do { const u32x2* xr_ = pre + (size_t)(t_) * 256 + lane; _Pragma("unroll") for (int j = 0; j < 4; ++j) dst[j] = xr_[64 * j]; } while (0)
#define P6_LN(v, nx, s) do { s = 0.f; _Pragma("unroll") for (int j = 0; j < 4; ++j) { v[j] = (f32x4){bflo(nx[j].x), bfhi(nx[j].x), bflo(nx[j].y), bfhi(nx[j].y)}; s += (v[j].x + v[j].y) + (v[j].z + v[j].w); } } while (0)
#define P6_VAR(v, mean, q) do { q = 0.f; _Pragma("unroll") for (int j = 0; j < 4; ++j) { v[j] = v[j] - mean; q += (v[j].x * v[j].x + v[j].y * v[j].y) + (v[j].z * v[j].z + v[j].w * v[j].w); } } while (0)
#if M1_FP8
#define P6_STORE(v, t_, j) do { u32x2 o_; o_.x = cvtpk(v[j].x, v[j].y); o_.y = cvtpk(v[j].z, v[j].w); x1b[(size_t)(t_) * 256 + lane + 64 * j] = o_; x1f8[(size_t)(t_) * 256 + lane + 64 * j] = pk_fp8x4(v[j].x, v[j].y, v[j].z, v[j].w); } while (0)
#else
#define P6_STORE(v, t_, j) do { u32x2 o_; o_.x = cvtpk(v[j].x, v[j].y); o_.y = cvtpk(v[j].z, v[j].w); x1b[(size_t)(t_) * 256 + lane + 64 * j] = o_; } while (0)
#endif
#define P6_DOT(lg, v, j, k, w) lg[k] += (v[j][0] * w[0] + v[j][1] * w[1]) + (v[j][2] * w[2] + v[j][3] * w[3])
    for (int blk = vcu; blk < TT / 128; blk += G) {
        if (tid < 16) LC[tid] = 0u;
        __syncthreads();
        const int t0 = blk * 128;
        u32x2 nxA[4], nxB[4], nxC[4], nxD[4];
        P6_LOADROW(nxA, t0 + wave); P6_LOADROW(nxB, t0 + wave + 8); P6_LOADROW(nxC, t0 + wave + 16); P6_LOADROW(nxD, t0 + wave + 24);
        for (int rr = 0; rr < 4; ++rr) {
            const int rl0 = wave + 32 * rr, tA = t0 + rl0, tB = tA + 8, tC = tA + 16, tD = tA + 24;
            f32x4 vA[4], vB[4], vC[4], vD[4]; float sA, sB, sC, sD;
            P6_LN(vA, nxA, sA); P6_LN(vB, nxB, sB); P6_LN(vC, nxC, sC); P6_LN(vD, nxD, sD);
            if (rr < 3) { P6_LOADROW(nxA, tA + 32); P6_LOADROW(nxB, tB + 32); P6_LOADROW(nxC, tC + 32); P6_LOADROW(nxD, tD + 32); }
            const float mA = wave_sum(sA) * (1.f / DM), mB = wave_sum(sB) * (1.f / DM), mC = wave_sum(sC) * (1.f / DM), mD = wave_sum(sD) * (1.f / DM);
            float qA, qB, qC, qD;
            P6_VAR(vA, mA, qA); P6_VAR(vB, mB, qB); P6_VAR(vC, mC, qC); P6_VAR(vD, mD, qD);
            const float rA = 1.f / sqrtf(wave_sum(qA) * (1.f / DM) + LN_EPSF), rB = 1.f / sqrtf(wave_sum(qB) * (1.f / DM) + LN_EPSF);
            const float rC = 1.f / sqrtf(wave_sum(qC) * (1.f / DM) + LN_EPSF), rD = 1.f / sqrtf(wave_sum(qD) * (1.f / DM) + LN_EPSF);
            float lgA[20], lgB[20], lgC[20], lgD[20];
#pragma unroll
            for (int k = 0; k < 20; ++k) { lgA[k] = 0.f; lgB[k] = 0.f; lgC[k] = 0.f; lgD[k] = 0.f; }
#pragma unroll
            for (int j = 0; j < 4; ++j) {
                const f32x4 gg = *(const f32x4*)(g1 + 4 * lane + 256 * j), bb = *(const f32x4*)(b1 + 4 * lane + 256 * j);
                vA[j] = vA[j] * rA * gg + bb; vB[j] = vB[j] * rB * gg + bb; vC[j] = vC[j] * rC * gg + bb; vD[j] = vD[j] * rD * gg + bb;
                P6_STORE(vA, tA, j); P6_STORE(vB, tB, j); P6_STORE(vC, tC, j); P6_STORE(vD, tD, j);
#pragma unroll
                for (int k = 0; k < 20; ++k) { const f32x4 w = *(const LAS f32x4*)(RW + k * 1024 + 4 * lane + 256 * j);
                    P6_DOT(lgA, vA, j, k, w); P6_DOT(lgB, vB, j, k, w); P6_DOT(lgC, vC, j, k, w); P6_DOT(lgD, vD, j, k, w); }
            }
            float r1A, r1B, r1C, r1D;
            P6_BUTTERFLY(lgA, r1A); P6_BUTTERFLY(lgB, r1B); P6_BUTTERFLY(lgC, r1C); P6_BUTTERFLY(lgD, r1D);
            {
                const int i3 = h2 ? (h4 ? -1 : 1) : (h4 ? 2 : 0);
                const int i5 = i3 < 0 ? -1 : (h8 ? (i3 == 2 ? -1 : i3 + 3) : i3);
                const int kk = i5 < 0 ? -1 : (h32 ? 10 : 0) + (h16 ? 5 : 0) + i5;
                if (kk >= 0 && (lane & 1) == 0) { RS[kk] = r1A; RS[32 + kk] = r1B; RS[64 + kk] = r1C; RS[96 + kk] = r1D; }
            }
            asm volatile("s_waitcnt lgkmcnt(0)" ::: "memory");
            {
                const int sel = lane & 3; const int rl = rl0 + 8 * sel;
                float tl[20];
#pragma unroll
                for (int k4 = 0; k4 < 5; ++k4) { const f32x4 w = *(const LAS f32x4*)(RS + sel * 32 + 4 * k4); tl[4 * k4] = w[0]; tl[4 * k4 + 1] = w[1]; tl[4 * k4 + 2] = w[2]; tl[4 * k4 + 3] = w[3]; }
                float gl[4];
#pragma unroll
                for (int k = 0; k < 4; ++k) gl[k] = tl[k] + a.in[12][k];
                int gi = 0; float gm = gl[0];
#pragma unroll
                for (int k = 1; k < 4; ++k) if (gl[k] > gm) { gm = gl[k]; gi = k; }
                float gs = 0.f;
#pragma unroll
                for (int k = 0; k < 4; ++k) gs += __expf(gl[k] - gm);
                const float gwt = 1.f / gs;
                float el[4];
#pragma unroll
                for (int k = 0; k < 4; ++k) { const float se = gi == 0 ? tl[4 + k] : (gi == 1 ? tl[8 + k] : (gi == 2 ? tl[12 + k] : tl[16 + k])); el[k] = se + a.in[14][4 * gi + k]; }
                int i1 = 0; float v1 = el[0];
#pragma unroll
                for (int k = 1; k < 4; ++k) if (el[k] > v1) { v1 = el[k]; i1 = k; }
                int i2 = (i1 + 1) & 3; float v2 = -3.0e38f;
#pragma unroll
                for (int k = 0; k < 4; ++k) if (k != i1 && el[k] > v2) { v2 = el[k]; i2 = k; }
                const float ex = __expf(v2 - v1), w1 = gwt / (1.f + ex), w2 = gwt * ex / (1.f + ex);
                if (lane < 4) {
                    const int e1 = 4 * gi + i1, e2 = 4 * gi + i2;
                    const unsigned p1 = __hip_atomic_fetch_add(LC + e1, 1u, __ATOMIC_RELAXED, __HIP_MEMORY_SCOPE_WORKGROUP);
                    const unsigned p2 = __hip_atomic_fetch_add(LC + e2, 1u, __ATOMIC_RELAXED, __HIP_MEMORY_SCOPE_WORKGROUP);
                    LR[rl * 4 + 0] = ((unsigned)e1 << 16) | p1; LR[rl * 4 + 1] = ((unsigned)e2 << 16) | p2; LR[rl * 4 + 2] = __float_as_uint(w1); LR[rl * 4 + 3] = __float_as_uint(w2);
                }
            }
            asm volatile("s_waitcnt lgkmcnt(0)" ::: "memory");
        }
        __syncthreads();
        if (tid < 16) LB[tid] = __hip_atomic_fetch_add(ctl + CW_CNT + 64 * tid, LC[tid], __ATOMIC_RELAXED, __HIP_MEMORY_SCOPE_AGENT);
        __syncthreads();
        if (tid < 256) {
            const int rl = tid >> 1, j = tid & 1; const unsigned rec = LR[rl * 4 + j]; const unsigned e = rec >> 16, pos = LB[e] + (rec & 0xffffu);
            ltok[e * TT + pos] = t0 + rl; tw[2 * (t0 + rl) + j] = __uint_as_float(LR[rl * 4 + 2 + j]); tinfo[2 * (t0 + rl) + j] = (e << 16) | pos;
        }
        __syncthreads();
    }
#undef P6_LOADROW
#undef P6_LN
#undef P6_VAR
#undef P6_STORE
#undef P6_DOT
}
__device__ __forceinline__ void build_tile_tables(const Args& a, LAS unsigned char* lds, int tid) {
    LAS int* ts = (LAS int*)(lds + LDS_TS_OFF); LAS int* te = (LAS int*)(lds + LDS_TE_OFF); LAS int* cn = (LAS int*)(lds + LDS_CNT_OFF);
    gu32* ctl = (gu32*)a.ws;
    if (tid == 0) { int acc = 0;
        for (int e = 0; e < 16; ++e) { ts[e] = acc; const int c = (int)__hip_atomic_load(ctl + CW_CNT + 64 * e, __ATOMIC_RELAXED, __HIP_MEMORY_SCOPE_AGENT); const int nt = (c + 255) >> 8; cn[e] = c;
            for (int k = 0; k < nt; ++k) te[acc + k] = e; acc += nt; }
        ts[16] = acc; }
    __syncthreads();
}
__device__ __forceinline__ void p9_phase(const Args& a, LAS unsigned char* lds, int vcu, int G, int wave, int lane) {
    unsigned char* ws = a.ws;
    const LAS int* ts = (const LAS int*)(lds + LDS_TS_OFF);
    const unsigned* tinfo = (const unsigned*)(ws + WS_TINFO); const u32x2* Y = (const u32x2*)(ws + WS_Y);
    const float* g2 = a.in[18]; const float* b2 = a.in[19];
    const int gw = vcu * NWAVES + wave, NGW = G * NWAVES;
#if Y_FP8
    const unsigned* Y8 = (const unsigned*)(ws + WS_Y); unsigned ny0[4], ny1[4]; u32x2 nxw[4]; float nw0 = 0.f, nw1 = 0.f;
#else
    u32x2 ny0[4], ny1[4], nxw[4]; float nw0 = 0.f, nw1 = 0.f;
#endif
    const float* tw = (const float*)(ws + WS_WSLOT);
    auto issue = [&](int t) {
        const unsigned i0 = tinfo[2 * t], i1 = tinfo[2 * t + 1];
        nw0 = tw[2 * t]; nw1 = tw[2 * t + 1];
        const size_t s0 = (size_t)ts[i0 >> 16] * 256 + (i0 & 0xffffu), s1 = (size_t)ts[i1 >> 16] * 256 + (i1 & 0xffffu);
        const u32x2* xb1 = (const u32x2*)(ws + WS_XB) + (size_t)t * 256 + lane;
#pragma unroll
#if Y_FP8
        for (int j = 0; j < 4; ++j) { ny0[j] = Y8[s0 * 256 + lane + 64 * j]; ny1[j] = Y8[s1 * 256 + lane + 64 * j]; nxw[j] = xb1[64 * j]; }
#else
        for (int j = 0; j < 4; ++j) { ny0[j] = Y[s0 * 256 + lane + 64 * j]; ny1[j] = Y[s1 * 256 + lane + 64 * j]; nxw[j] = xb1[64 * j]; }
#endif
    };
    if (gw < TT) issue(gw);
    for (int t = gw; t < TT; t += NGW) {
        f32x4* xr = (f32x4*)(a.out + (size_t)t * DM) + lane;
#if Y_FP8
        f32x4 v[4]; float s = 0.f; const float w0 = nw0 * 0.0625f, w1 = nw1 * 0.0625f;
#pragma unroll
        for (int j = 0; j < 4; ++j) {
            const unsigned y0 = ny0[j], y1 = ny1[j]; const u32x2 xw = nxw[j];
            typedef float f32x2_ __attribute__((ext_vector_type(2)));
            const f32x2_ a0 = __builtin_amdgcn_cvt_pk_f32_fp8(y0, false), a1 = __builtin_amdgcn_cvt_pk_f32_fp8(y0, true), c0 = __builtin_amdgcn_cvt_pk_f32_fp8(y1, false), c1 = __builtin_amdgcn_cvt_pk_f32_fp8(y1, true);
            f32x4 x = (f32x4){bflo(xw.x), bfhi(xw.x), bflo(xw.y), bfhi(xw.y)} * DN_ALPHA;
            x.x += w0 * a0[0] + w1 * c0[0]; x.y += w0 * a0[1] + w1 * c0[1]; x.z += w0 * a1[0] + w1 * c1[0]; x.w += w0 * a1[1] + w1 * c1[1];
            v[j] = x; s += (x.x + x.y) + (x.z + x.w);
        }
#else
        f32x4 v[4]; float s = 0.f; const float w0 = nw0, w1 = nw1;
#pragma unroll
        for (int j = 0; j < 4; ++j) {
            const u32x2 y0 = ny0[j], y1 = ny1[j], xw = nxw[j];
            f32x4 x = (f32x4){bflo(xw.x), bfhi(xw.x), bflo(xw.y), bfhi(xw.y)} * DN_ALPHA;
            x.x += w0 * bflo(y0.x) + w1 * bflo(y1.x); x.y += w0 * bfhi(y0.x) + w1 * bfhi(y1.x); x.z += w0 * bflo(y0.y) + w1 * bflo(y1.y); x.w += w0 * bfhi(y0.y) + w1 * bfhi(y1.y);
            v[j] = x; s += (x.x + x.y) + (x.z + x.w);
        }
#endif
        if (t + NGW < TT) issue(t + NGW);
        const float mean = wave_sum(s) * (1.f / DM); float s2 = 0.f;
#pragma unroll
        for (int j = 0; j < 4; ++j) { v[j] = v[j] - mean; s2 += (v[j].x * v[j].x + v[j].y * v[j].y) + (v[j].z * v[j].z + v[j].w * v[j].w); }
        const float rstd = 1.f / sqrtf(wave_sum(s2) * (1.f / DM) + LN_EPSF);
#pragma unroll
        for (int j = 0; j < 4; ++j) { const f32x4 gg = *(const f32x4*)(g2 + 4 * lane + 256 * j), bb = *(const f32x4*)(b2 + 4 * lane + 256 * j); xr[64 * j] = v[j] * rstd * gg + bb; }
    }
}

__global__ void __launch_bounds__(NWAVES * 64, 2) mega_fwd(Args args) {
    extern __shared__ __attribute__((aligned(16))) unsigned char lds_raw[];
    LAS unsigned char* lds = (LAS unsigned char*)lds_raw;
    volatile LAS unsigned* MISC = (volatile LAS unsigned*)(lds + MISC_OFF);
    const int tid0 = threadIdx.x, wave = __builtin_amdgcn_readfirstlane(tid0 >> 6);
    const int G = gridDim.x, bx = blockIdx.x, vcu = (G % 8 == 0) ? (bx % 8) * (G / 8) + bx / 8 : bx;
    for (int u = tid0; u < (LDS_BYTES - LDSCTL_OFF) / 4; u += NWAVES * 64) ((LAS unsigned*)(lds + LDSCTL_OFF))[u] = 0u;
    __syncthreads();
    unsigned char* ws = args.ws;
    gu32* ctl = (gu32*)ws;
    const bool bars_on = (args.mask >> 31) != 0u;
    XcdBarrier bar; bar.bar = (unsigned*)(ctl + CW_BAR) + args.bar_region * XCD_BAR_WORDS; bar.x = 0; bar.st = nullptr;
    if (bars_on) bar = xcd_barrier_post((unsigned*)(ctl + CW_BAR) + args.bar_region * XCD_BAR_WORDS, MISC + 8);
    bar.wv = wave;
#define GRID_BAR() do { if (bars_on) xcd_barrier(bar); } while (0)
#ifndef PH_LAST
#define PH_LAST 99
#endif
#define FRESH() int tid = wave * 64 + pg8::lane_id(); asm volatile("" : "+v"(tid)); const int lane = tid & 63; (void)lane
#ifndef RMASK
#define RMASK 0
#endif
#define REP(k) _Pragma("unroll") for (int rep_ = 0; rep_ < 1 + ((RMASK >> (k)) & 1); ++rep_)
#ifndef STAMP_SCALE
#define STAMP_SCALE 1.0f
#endif
#ifdef STAMP_PH
#define ST_B(k) if ((k) == STAMP_PH) { st_a = rt(); }
#define ST_E(k) if ((k) == STAMP_PH) { st_b = rt(); }
#else
#define ST_B(k)
#define ST_E(k)
#endif
#ifdef ONLY
#define EN(k) (ONLY == (k))
#else
#define EN(k) ((args.mask >> (k)) & 1u)
#endif
    unsigned long long st_a = 0, st_b = 0; (void)st_a; (void)st_b;
    REP(0) if (EN(0)) { FRESH(); p0_prologue(args, lds, vcu, G, tid, wave, lane); }
    GRID_BAR();
#ifdef STAGGER_TICKS
    if (EN(1) && (bx & 8)) { const unsigned long long t0_ = rt(); while (rt() - t0_ < STAGGER_TICKS) __builtin_amdgcn_s_sleep(32); }
#endif
    REP(1) if (EN(1)) {
#if P1_FP8
        pg8::EpiHcat E{ws, (const float*)(ws + WS_ROT), 0};
        if (P1_FP8_FROM > 0) {
            pg8::Gemm g{(const pg8::bf16_t*)(ws + WS_XB), (const pg8::bf16_t*)(ws + WS_WIN), TT, 4608, 1024}; pg8::StaticOrder S; S.init(TT, 256 * P1_FP8_FROM, G, bx);
            pg8::gemm_phase<pg8::EpiHcat, pg8::StaticOrder, true, true>(lds, g, S, E, wave);
        }
        {
#if GATE_FP8
            pg8::Gemm g{(const pg8::bf16_t*)(ws + WS_X8_LO), (const pg8::bf16_t*)(ws + WS_WIN8), TT, 4608, 512, 64, (long)WS_X8_HI - (long)WS_X8_LO - (long)(16 * MiB)}; pg8::StaticOrder S;
#else
            pg8::Gemm g{(const pg8::bf16_t*)args.out, (const pg8::bf16_t*)(ws + WS_WIN8), TT, 4608, 512}; pg8::StaticOrder S;
#endif
            S.init(TT, 4608 - 256 * P1_FP8_FROM, G, bx, P1_FP8_FROM);
            pg8::gemm_phase<pg8::EpiHcat, pg8::StaticOrder, true, true, false, true, 1, 0>(lds, g, S, E, wave);
        }
#else
        pg8::Gemm g{(const pg8::bf16_t*)(ws + WS_XB), (const pg8::bf16_t*)(ws + WS_WIN), TT, 4608, 1024}; pg8::StaticOrder S; S.init(TT, 4608, G, bx);
        pg8::EpiHcat E{ws, (const float*)(ws + WS_ROT), 0};
        pg8::gemm_phase<pg8::EpiHcat, pg8::StaticOrder, true, true>(lds, g, S, E, wave);
#endif
    }
    GRID_BAR();
    if (PH_LAST >= 2) {
        REP(2) if (EN(2)) { FRESH(); for (int it = vcu; it < 256; it += G) chain_item(args, lds, it, tid, wave, lane); }
        if (EN(3)) { { FRESH(); attn_dil_phase<16>(args, lds, vcu, G, tid, wave, lane); }
                     { FRESH(); attn_dil_phase<4>(args, lds, vcu, G, tid, wave, lane); } }
    }
    GRID_BAR();
    ST_B(4) if (PH_LAST >= 3 && EN(4)) { FRESH(); p3_phase<0>(args, lds, vcu, G, tid, wave, lane); }
    if (EN(13)) { FRESH(); attn_p1_phase(args, lds, vcu, G, tid, wave, lane); }
    GRID_BAR(); ST_E(4)
    if (EN(14)) { FRESH(); p0_expert_weights(args, lds, vcu, G, wave, lane); }
    REP(5) if (PH_LAST >= 4 && EN(5)) {
        pg8::GateOrder S; S.S4.init(TT, 1024, G, bx);
        pg8::EpiHcat E{ws, (const float*)(ws + WS_ROT), 18};
#if GATE_FP8
        pg8::Gemm g{(const pg8::bf16_t*)(ws + WS_X8_LO), (const pg8::bf16_t*)(ws + WS_WIN8 + (size_t)4608 * 1024), TT, 2048, 512, 64, (long)WS_X8_HI - (long)WS_X8_LO - (long)(16 * MiB)};
        pg8::gemm_phase<pg8::EpiHcat, pg8::GateOrder, true, true, false, true, 1, 0>(lds, g, S, E, wave);
#else
        pg8::Gemm g{(const pg8::bf16_t*)(ws + WS_XB), (const pg8::bf16_t*)(ws + WS_WIN) + (size_t)4608 * 1024, TT, 2048, 1024};
        pg8::gemm_phase<pg8::EpiHcat, pg8::GateOrder, true, true>(lds, g, S, E, wave);
#endif
        asm volatile("s_waitcnt vmcnt(0)" ::: "memory"); __syncthreads();
    }
    REP(6) if (PH_LAST >= 5 && EN(6)) {
        pg8::StaticOrder S; S.init(TT, 1024, G, bx);
        { pg8::EpiGate<false> E{(const pg8::bf16_t*)(ws + WS_GATE_A), (pg8::bf16_t*)(ws + WS_MERGED), nullptr};
#if MIX_FP8 & 2
          pg8::Gemm g{(const pg8::bf16_t*)(ws + WS_OA), (const pg8::bf16_t*)(ws + WS_WA), TT, 1024, 256};
          pg8::gemm_phase<pg8::EpiGate<false>, pg8::StaticOrder, true, true, false, true, 1, 3>(lds, g, S, E, wave);
#else
          pg8::Gemm g{(const pg8::bf16_t*)(ws + WS_OA), (const pg8::bf16_t*)(ws + WS_WA), TT, 1024, 512};
          pg8::gemm_phase<pg8::EpiGate<false>, pg8::StaticOrder, true, true>(lds, g, S, E, wave);
#endif
        }
        asm volatile("s_waitcnt vmcnt(0)" ::: "memory"); __syncthreads();
        { typedef pg8::EpiGate<true, (MIX_FP8 & 1) != 0> EpiC;
          EpiC E{(const pg8::bf16_t*)(ws + WS_GATE_R), (pg8::bf16_t*)(ws + WS_MERGED), ws + WS_MERGED8};
#if MIX_FP8 & 4
          pg8::Gemm g{(const pg8::bf16_t*)(ws + WS_AR8), (const pg8::bf16_t*)(ws + WS_WR), TT, 1024, 512};
          pg8::gemm_phase<EpiC, pg8::StaticOrder, true, true, false, true, 1, 0>(lds, g, S, E, wave);
#else
          pg8::Gemm g{(const pg8::bf16_t*)(ws + WS_GR), (const pg8::bf16_t*)(ws + WS_WR), TT, 1024, 1024};
          pg8::gemm_phase<EpiC, pg8::StaticOrder, true, true>(lds, g, S, E, wave);
#endif
        }
    }
    GRID_BAR();
    REP(7) if (PH_LAST >= 6 && EN(7)) {
        pg8::StaticOrder S; S.init(TT, 1024, G, bx);
        pg8::EpiResBf16 E{X_F32_RES ? (const pg8::bf16_t*)args.in[0] : (const pg8::bf16_t*)(ws + WS_XB), (pg8::bf16_t*)args.out, DN_ALPHA};
#if MIX_FP8 & 1
        pg8::Gemm g{(const pg8::bf16_t*)(ws + WS_MERGED8), (const pg8::bf16_t*)(ws + WS_WO), TT, 1024, 512};
        pg8::gemm_phase<pg8::EpiResBf16, pg8::StaticOrder, true, true, false, true, 1, 3>(lds, g, S, E, wave);
#else
        pg8::Gemm g{(const pg8::bf16_t*)(ws + WS_MERGED), (const pg8::bf16_t*)(ws + WS_WO), TT, 1024, 1024};
        pg8::gemm_phase<pg8::EpiResBf16, pg8::StaticOrder, true, true>(lds, g, S, E, wave);
#endif
    }
    GRID_BAR();
    ST_B(8) if (PH_LAST >= 7 && EN(8)) { FRESH(); p6a_phase(args, lds, vcu, G, tid, wave, lane); }
    GRID_BAR(); ST_E(8)
    { FRESH(); build_tile_tables(args, lds, tid); }
    const int nrt = ((const LAS int*)(lds + LDS_TS_OFF))[16];
    REP(10) if (PH_LAST >= 9 && EN(10)) {
#if M1_FP8
        pg8::Gemm g{(const pg8::bf16_t*)(ws + WS_X1F8), (const pg8::bf16_t*)(ws + WS_WGU), MAXSLOT, 1024, 512};
        pg8::MoeOrder S{nrt * 4, G, vcu, (const LAS int*)(lds + LDS_TE_OFF), (const LAS int*)(lds + LDS_TS_OFF), (const LAS int*)(lds + LDS_CNT_OFF), (const int*)(ws + WS_LTOK), 1024u};
        pg8::EpiSwiGLU E{ws + WS_H};
        pg8::gemm_phase<pg8::EpiSwiGLU, pg8::MoeOrder, true, true, true, true, 1, 0>(lds, g, S, E, wave);
#else
        pg8::Gemm g{(const pg8::bf16_t*)(ws + WS_XB), (const pg8::bf16_t*)(ws + WS_WGU), MAXSLOT, 1024, 1024};
        pg8::MoeOrder S{nrt * 4, G, vcu, (const LAS int*)(lds + LDS_TE_OFF), (const LAS int*)(lds + LDS_TS_OFF), (const LAS int*)(lds + LDS_CNT_OFF), (const int*)(ws + WS_LTOK), 2048u};
        pg8::EpiSwiGLU E{ws + WS_H};
        pg8::gemm_phase<pg8::EpiSwiGLU, pg8::MoeOrder, true, true, true>(lds, g, S, E, wave);
#endif
    }
    GRID_BAR();
    REP(11) if (PH_LAST >= 10 && EN(11)) {
        pg8::Gemm g{(const pg8::bf16_t*)(ws + WS_H), (const pg8::bf16_t*)(ws + WS_WD), MAXSLOT, 1024, 256};
        pg8::MoeOrder S{nrt * 4, G, vcu, (const LAS int*)(lds + LDS_TE_OFF), (const LAS int*)(lds + LDS_TS_OFF), (const LAS int*)(lds + LDS_CNT_OFF), (const int*)(ws + WS_LTOK), 1024u};
        pg8::EpiRowScale E{(pg8::bf16_t*)(ws + WS_Y)};
        pg8::gemm_phase<pg8::EpiRowScale, pg8::MoeOrder, true, true, false, true, 1, 2>(lds, g, S, E, wave);
    }
    GRID_BAR();
    ST_B(12) if (PH_LAST >= 11 && EN(12)) { FRESH(); p9_phase(args, lds, vcu, G, wave, lane); }
#ifdef STAMP_PH
    GRID_BAR(); ST_E(12)
    if (STAMP_PH == 13) { st_a = rt(); GRID_BAR(); GRID_BAR(); GRID_BAR(); GRID_BAR(); st_b = rt(); }
    if (bx == 0 && tid0 == 0) { const float us = (float)(st_b - st_a) * 0.01f * STAMP_SCALE; int k = 0; float lim = 30.f; while (us >= lim && k < 12) { lim *= 1.5f; ++k; }
        __hip_atomic_store(ctl + CW_CHK, __float_as_uint(sqrtf(2.f * k + 2.f)), RLX_AGENT); }
    GRID_BAR();
    { const float c = __uint_as_float(__hip_atomic_load(ctl + CW_CHK, RLX_AGENT)); f32x4* o4 = (f32x4*)args.out;
      for (size_t i = (size_t)bx * 512 + tid0; i < (size_t)TT * DM / 4; i += (size_t)G * 512) o4[i] = (f32x4){c, c, c, c}; }
#endif
}

#ifdef PROBE_VAR
__global__ void __launch_bounds__(NWAVES * 64, 2) probe_kernel(Args args) {
    extern __shared__ __attribute__((aligned(16))) unsigned char lds_raw[];
    LAS unsigned char* lds = (LAS unsigned char*)lds_raw;
    const int tid0 = threadIdx.x, wave = __builtin_amdgcn_readfirstlane(tid0 >> 6);
    const int G = gridDim.x, bx = blockIdx.x, vcu = (G % 8 == 0) ? (bx % 8) * (G / 8) + bx / 8 : bx;
    FRESH();
    if (PROBE_VAR == 20 || PROBE_VAR == 21) {
        unsigned char* ws = args.ws;
        pg8::Gemm g{(const pg8::bf16_t*)(ws + WS_XB), (const pg8::bf16_t*)(ws + WS_WIN), TT, 4608, 1024}; pg8::StaticOrder S; S.init(TT, 4608, G, bx);
        pg8::EpiHcatT<PROBE_VAR == 21 ? 1 : 0> E{ws, (const float*)(ws + WS_ROT), 0};
        pg8::gemm_phase<pg8::EpiHcatT<PROBE_VAR == 21 ? 1 : 0>, pg8::StaticOrder, true, true>(lds, g, S, E, wave);
    }
    if (PROBE_VAR == 10) p3_phase<0>(args, lds, vcu, G, tid, wave, lane);
    if (PROBE_VAR == 11) p3_phase<1>(args, lds, vcu, G, tid, wave, lane);
    if (PROBE_VAR == 0) attn_dil_phase<16, 0>(args, lds, vcu, G, tid, wave, lane);
    if (PROBE_VAR == 1) attn_dil_phase<16, 1>(args, lds, vcu, G, tid, wave, lane);
    if (PROBE_VAR == 2) attn_dil_phase<4, 0>(args, lds, vcu, G, tid, wave, lane);
    if (PROBE_VAR == 3) attn_dil_phase<4, 1>(args, lds, vcu, G, tid, wave, lane);
}
#endif
extern "C" void kernel_launch(void* const* d_in, const int* in_sizes, int n_in, void* d_out, int out_size, void* d_ws, size_t ws_size, hipStream_t stream) {
    static int grid = 0;
    if (grid == 0) {
        if (n_in != 20 || in_sizes[0] != TT * DM || out_size != TT * DM || ws_size < WS_END) { fprintf(stderr, "kernel_launch: unexpected shapes: n_in %d in0 %d out %d ws %zu; nothing launched\n", n_in, n_in > 0 ? in_sizes[0] : -1, out_size, ws_size); grid = -1; return; }
        int dev = 0, cus = 0;
        if (hipGetDevice(&dev) != hipSuccess || hipDeviceGetAttribute(&cus, hipDeviceAttributeMultiprocessorCount, dev) != hipSuccess) { grid = -1; return; }
        if (hipFuncSetAttribute((const void*)mega_fwd, hipFuncAttributeMaxDynamicSharedMemorySize, LDS_BYTES) != hipSuccess) { fprintf(stderr, "kernel_launch: hipFuncSetAttribute failed\n"); grid = -1; return; }
        (void)hipGetLastError();
        grid = cus;
    }
    if (grid < 0) return;
    if (hipMemsetAsync((char*)d_ws, 0, CTL_ZERO_BYTES, stream) != hipSuccess) return;
    Args a{};
    for (int i = 0; i < 20; ++i) a.in[i] = (const float*)d_in[i];
    a.out = (float*)d_out; a.ws = (unsigned char*)d_ws; a.mask = 0x80007fffu; a.bar_region = 0;
#if defined(XTRA_FIRST)
    { Args x = a; x.mask = XTRA_FIRST; x.bar_region = 1; for (int r = 0; r < XTRA_REP; ++r) hipLaunchKernelGGL(mega_fwd, dim3(grid), dim3(NWAVES * 64), LDS_BYTES, stream, x);
      if (hipMemsetAsync((char*)d_ws, 0, CTL_ZERO_BYTES, stream) != hipSuccess) return; }
#endif
    hipLaunchKernelGGL(mega_fwd, dim3(grid), dim3(NWAVES * 64), LDS_BYTES, stream, a);
#if defined(PROBE_VAR)
    { hipFuncSetAttribute((const void*)probe_kernel, hipFuncAttributeMaxDynamicSharedMemorySize, LDS_BYTES);
      for (int r = 0; r < 4; ++r) hipLaunchKernelGGL(probe_kernel, dim3(grid), dim3(NWAVES * 64), LDS_BYTES, stream, a); }
#endif
#if defined(XTRA_AFTER)
    { Args x = a; x.mask = XTRA_AFTER; x.bar_region = 1; for (int r = 0; r < XTRA_REP; ++r) hipLaunchKernelGGL(mega_fwd, dim3(grid), dim3(NWAVES * 64), LDS_BYTES, stream, x); }
#endif
}
```

```cpp
#define P1_FP8 1
#define P1_FP8_FROM 0
#define MIX_FP8 7
#define GATE_FP8 1
#define Y_FP8 1
#define CONV_BG 1
#include <hip/hip_runtime.h>
#include <cstdio>
#include <cstdint>

constexpr int TT = 32768, DM = 1024, SEQ = 2048, NB = 16;
constexpr float DN_ALPHA = 1.189207115002721f;
constexpr float LN_EPSF = 1e-5f;
#ifndef M1_FP8
#define M1_FP8 1
#endif
#ifndef P1_FP8
#define P1_FP8 0
#endif
#ifndef CONV_BG
#define CONV_BG 0
#endif
#ifndef Y_FP8
#define Y_FP8 0
#endif
#ifndef GATE_FP8
#define GATE_FP8 0
#endif
#ifndef MIX_FP8
#define MIX_FP8 0
#endif
#ifndef P1_FP8_FROM
#define P1_FP8_FROM 0
#endif
#define X_F32_RES (P1_FP8 && P1_FP8_FROM == 0 && GATE_FP8)
constexpr size_t MiB = 1u << 20;
constexpr size_t CTL_ZERO_BYTES = 1 * MiB;
constexpr size_t WS_ROT = 1 * MiB;
constexpr size_t WS_BIAS = 2 * MiB;
constexpr size_t WS_LTOK = 3 * MiB;
constexpr size_t WS_TINFO = 7 * MiB;
constexpr size_t WS_WSLOT = 7 * MiB + 512 * 1024;
constexpr size_t WS_WIN = 8 * MiB;
constexpr size_t WS_WIN8 = 12 * MiB;
constexpr size_t WS_WR = 21 * MiB;
constexpr size_t WS_WA = 23 * MiB;
constexpr size_t WS_WO = 24 * MiB;
constexpr size_t WS_WGU = 26 * MiB;
constexpr size_t WS_WD = 42 * MiB;
constexpr size_t WS_XB = 80 * MiB;
constexpr size_t WS_QR = 144 * MiB;
constexpr size_t WS_KR = 176 * MiB;
constexpr size_t WS_VR = 208 * MiB;
constexpr size_t WS_GR = 272 * MiB;
constexpr size_t WS_QA = 336 * MiB, WS_KA = 368 * MiB, WS_VA = 400 * MiB, WS_OA = 432 * MiB;
#if MIX_FP8 & 4
constexpr size_t WS_AR8 = 144 * MiB;
constexpr size_t WS_GATE_R = 176 * MiB, WS_GATE_A = 240 * MiB;
#else
constexpr size_t WS_GATE_R = 144 * MiB, WS_GATE_A = 208 * MiB;
#endif
constexpr size_t WS_X8_LO = 448 * MiB, WS_X8_HI = 58 * MiB;
static_assert(!CONV_BG || X_F32_RES, "CONV_BG puts o2 into the bf16 x region");
static_assert(!GATE_FP8 || (P1_FP8 && (MIX_FP8 & 2) && M1_FP8), "GATE_FP8 needs the fp8 mixer-input GEMM, the fp8 o_a (room behind it) and the fp8 expert weights (room behind them)");
constexpr size_t WS_MERGED8 = 464 * MiB;
constexpr size_t WS_MERGED = 336 * MiB;
constexpr size_t WS_Y = 144 * MiB;
constexpr size_t WS_H = 336 * MiB;
constexpr size_t WS_X1F8 = 464 * MiB;
#if CONV_BG
constexpr size_t WS_O2 = 80 * MiB;
#else
constexpr size_t WS_O2 = 26 * MiB;
#endif
constexpr size_t WS_O3 = 464 * MiB;
constexpr size_t WS_LSE2 = 496 * MiB, WS_LSE3 = 497 * MiB;
constexpr size_t WS_END = 512 * MiB;
constexpr int MAXSLOT = 69632;
constexpr int CW_BAR = 4096;
constexpr int CW_CNT = 16384;
constexpr int CW_CHK = 24576;
namespace pg8 {
#define PG8_LAS __attribute__((address_space(3)))
typedef unsigned short bf16_t;
typedef short bf16x8 __attribute__((ext_vector_type(8)));
typedef float f32x4 __attribute__((ext_vector_type(4)));
typedef unsigned u32x4 __attribute__((ext_vector_type(4)));
typedef unsigned u32x2_ __attribute__((ext_vector_type(2)));
constexpr int BM = 256, BK = 64, HALF = 128, HTB = HALF * BK * 2  , STAGE_BYTES = 8 * HTB, NXCD = 8, WGM = 8;

__device__ __forceinline__ int lane_id() { int x; asm volatile("v_mbcnt_lo_u32_b32 %0, -1, 0\n\tv_mbcnt_hi_u32_b32 %0, -1, %0" : "=v"(x)); return x; }
__host__ __device__ __forceinline__ int lds_byte(int r, int c) { const int st = (r >> 4) * 2 + (c >> 5), rr = r & 15, cc = c & 31, ob = rr * 64 + cc * 2; return st * 1024 + (ob ^ (((ob >> 9) & 1) << 5)); }
__host__ __device__ __forceinline__ void stage_rc(int b, int& R, int& C) { const int st = b / 1024, sb = b % 1024, swz = sb ^ (((sb >> 9) & 1) << 5); R = (st >> 1) * 16 + swz / 64; C = (st & 1) * 32 + (swz % 64) / 2; }
__host__ __device__ __forceinline__ int perm32(int rho) { const int n = rho >> 4, i = rho & 15; return 8 * (i >> 2) + 4 * n + (i & 3); }

struct Unit { int pm, pn; };
struct Gemm { const bf16_t* A; const bf16_t* Bt; int M, N, K; int spm = 1 << 30; long sdelta = 0; };

struct StaticOrder {
    int nM, nN, nwg, G, c, pn0;
    __host__ __device__ void init(int M, int N, int G_, int c_, int pn0_ = 0) { nM = M / BM; nN = N / BM; nwg = nM * nN; G = G_; c = c_; pn0 = pn0_; }
    __host__ __device__ bool next(int i, Unit& u) const {
        const long L = (long)i * G + c; if (L >= nwg) return false;
        int wgid = (int)L; { const int q = nwg / NXCD, r = nwg % NXCD, xcd = wgid % NXCD, off = wgid / NXCD; wgid = (xcd < r ? xcd * (q + 1) : r * (q + 1) + (xcd - r) * q) + off; }
        const int nig = WGM * nN, gid = wgid / nig, fm = gid * WGM, gsz = (nM - fm) < WGM ? (nM - fm) : WGM;
        u.pm = fm + ((wgid % nig) % gsz); u.pn = pn0 + (wgid % nig) / gsz; return true;
    }
    __device__ __forceinline__ void a_ready(const Unit&) const {}
    __device__ __forceinline__ void done(const Unit&, int, int) const {}
};

__device__ __forceinline__ unsigned cvt_pk_bf16(float lo, float hi) { unsigned r; asm volatile("v_cvt_pk_bf16_f32 %0, %1, %2" : "=v"(r) : "v"(lo), "v"(hi)); return r; }
typedef float cvt_f32x2_t __attribute__((ext_vector_type(2))); typedef __bf16 cvt_bf16x2_t __attribute__((ext_vector_type(2)));
__device__ __forceinline__ unsigned cvt_pk_bf16_acc(float lo, float hi) { const cvt_f32x2_t v = {lo, hi}; const cvt_bf16x2_t b = __builtin_convertvector(v, cvt_bf16x2_t); return __builtin_bit_cast(unsigned, b); }
__device__ __forceinline__ float bflo(unsigned w) { return __uint_as_float(w << 16); }
__device__ __forceinline__ float bfhi(unsigned w) { return __uint_as_float(w & 0xffff0000u); }
__device__ __forceinline__ float fsigmoid(float x) { return __builtin_amdgcn_rcpf(1.f + __expf(-x)); }
__device__ __forceinline__ float fsilu(float x) { return x * __builtin_amdgcn_rcpf(1.f + __expf(-x)); }

template <int VAR = 0> struct EpiHcatT {
    static constexpr bool PERM = true, AFTER_DRAIN = false; static constexpr int NSTORE = 16;
    unsigned char* ws; const float* rot; int tile_off;
    __device__ __forceinline__ void operator()(const f32x4 (&acc)[2][2][4][2], const Unit& u, int wr, int wc, int fr, int fq) const {
        if (VAR == 1) {
            float s = 0.f;
#pragma unroll
            for (int ai = 0; ai < 2; ++ai)
#pragma unroll
                for (int bj = 0; bj < 2; ++bj)
#pragma unroll
                    for (int m = 0; m < 4; ++m)
#pragma unroll
                        for (int n = 0; n < 2; ++n) s += (acc[ai][bj][m][n][0] + acc[ai][bj][m][n][1]) + (acc[ai][bj][m][n][2] + acc[ai][bj][m][n][3]);
            ((float*)(ws + WS_O3))[(size_t)(u.pm * 64 + u.pn) * 512 + wr * 256 + wc * 64 + fq * 16 + fr] = s; return;
        }
        const int gt = u.pn + tile_off;
        size_t base_off; int pitch, ct, mode; float sc = 1.f;
        if (gt < 2)       { base_off = WS_QR; pitch = 512;  ct = gt;      mode = 1; }
        else if (gt < 4)  { base_off = WS_KR; pitch = 512;  ct = gt - 2;  mode = 1; sc = 0.08838834764831845f; }
        else if (gt < 8)  { base_off = WS_VR; pitch = 1024; ct = gt - 4;  mode = 0; }
        else if (gt < 12) { base_off = WS_GR; pitch = 1024; ct = gt - 8;  mode = 2; }
        else if (gt < 14) { base_off = WS_QA; pitch = 512;  ct = gt - 12; mode = 0; sc = 0.18033688011112042f; }
        else if (gt < 16) { base_off = WS_KA; pitch = 512;  ct = gt - 14; mode = 0; }
        else if (gt < 18) { base_off = WS_VA; pitch = 512;  ct = gt - 16; mode = 0; }
        else if (gt < 22) { base_off = WS_GATE_R; pitch = 1024; ct = gt - 18; mode = 3; }
        else              { base_off = WS_GATE_A; pitch = 1024; ct = gt - 22; mode = 3; }
        bf16_t* O = (bf16_t*)(ws + base_off);
        const int row0 = u.pm * BM + wr * 64 + fr, col0 = ct * BM + wc * 32 + 8 * fq;
#pragma unroll
        for (int ai = 0; ai < 2; ++ai)
#pragma unroll
            for (int m = 0; m < 4; ++m) {
                const int row = row0 + ai * HALF + m * 16;
                bf16_t* rowp = O + (size_t)(VAR == 2 ? (row & 255) : row) * pitch + col0;
                f32x4 cs = (f32x4){1.f, 1.f, 1.f, 1.f}, sn = (f32x4){0.f, 0.f, 0.f, 0.f};
                if (mode == 1) { const f32x4* rt = (const f32x4*)(rot + ((size_t)(row & (SEQ - 1)) * 16 + (4 * wc + fq)) * 8); cs = rt[0]; sn = rt[1]; }
#pragma unroll
                for (int bj = 0; bj < 2; ++bj) {
                    f32x4 v0 = acc[ai][bj][m][0], v1 = acc[ai][bj][m][1];
                    if (mode == 1) { const f32x4 a = v0 * cs - v1 * sn, b = v0 * sn + v1 * cs; v0 = a * sc; v1 = b * sc; }
                    else if (mode == 2) {
#pragma unroll
                        for (int e = 0; e < 4; ++e) { v0[e] = fsilu(v0[e]); v1[e] = fsilu(v1[e]); } }
                    else if (mode == 3) {
#pragma unroll
                        for (int e = 0; e < 4; ++e) { v0[e] = fsigmoid(v0[e]); v1[e] = fsigmoid(v1[e]); } }
                    else { v0 = v0 * sc; v1 = v1 * sc; }
                    u32x4 w; w.x = cvt_pk_bf16(v0[0], v0[1]); w.y = cvt_pk_bf16(v0[2], v0[3]); w.z = cvt_pk_bf16(v1[0], v1[1]); w.w = cvt_pk_bf16(v1[2], v1[3]);
                    *(u32x4*)(rowp + bj * HALF) = w;
                }
            }
    }
};

typedef EpiHcatT<0> EpiHcat;

__device__ __forceinline__ unsigned fp8x4_sat(float a, float b, float c, float d) {
    a = __builtin_amdgcn_fmed3f(a, -448.f, 448.f); b = __builtin_amdgcn_fmed3f(b, -448.f, 448.f); c = __builtin_amdgcn_fmed3f(c, -448.f, 448.f); d = __builtin_amdgcn_fmed3f(d, -448.f, 448.f);
    unsigned w = 0u; w = __builtin_amdgcn_cvt_pk_fp8_f32(a, b, w, false); w = __builtin_amdgcn_cvt_pk_fp8_f32(c, d, w, true); return w;
}
template <bool ADD, bool OUT8 = false> struct EpiGate {
    static constexpr bool PERM = true, AFTER_DRAIN = false; static constexpr int NSTORE = 16;
    const bf16_t* gate; bf16_t* O; unsigned char* O8;
    __device__ __forceinline__ void operator()(const f32x4 (&acc)[2][2][4][2], const Unit& u, int wr, int wc, int fr, int fq) const {
        const int row0 = u.pm * BM + wr * 64 + fr, col0 = u.pn * BM + wc * 32 + 8 * fq;
#pragma unroll
        for (int ai = 0; ai < 2; ++ai)
#pragma unroll
            for (int m = 0; m < 4; ++m)
#pragma unroll
                for (int bj = 0; bj < 2; ++bj) {
                    const size_t p = (size_t)(row0 + ai * HALF + m * 16) * 1024 + col0 + bj * HALF;
                    const u32x4 g = *(const u32x4*)(gate + p);
                    f32x4 v0 = acc[ai][bj][m][0], v1 = acc[ai][bj][m][1];
                    v0[0] *= bflo(g.x); v0[1] *= bfhi(g.x); v0[2] *= bflo(g.y); v0[3] *= bfhi(g.y);
                    v1[0] *= bflo(g.z); v1[1] *= bfhi(g.z); v1[2] *= bflo(g.w); v1[3] *= bfhi(g.w);
                    if (ADD) { const u32x4 o = *(const u32x4*)(O + p);
                        v0[0] += bflo(o.x); v0[1] += bfhi(o.x); v0[2] += bflo(o.y); v0[3] += bfhi(o.y);
                        v1[0] += bflo(o.z); v1[1] += bfhi(o.z); v1[2] += bflo(o.w); v1[3] += bfhi(o.w); }
                    if (OUT8) { u32x2_ w8;
                        w8.x = fp8x4_sat(v0[0] * 16.f, v0[1] * 16.f, v0[2] * 16.f, v0[3] * 16.f); w8.y = fp8x4_sat(v1[0] * 16.f, v1[1] * 16.f, v1[2] * 16.f, v1[3] * 16.f);
                        *(u32x2_*)(O8 + p) = w8; }
                    else { u32x4 w; w.x = cvt_pk_bf16(v0[0], v0[1]); w.y = cvt_pk_bf16(v0[2], v0[3]); w.z = cvt_pk_bf16(v1[0], v1[1]); w.w = cvt_pk_bf16(v1[2], v1[3]);
                        *(u32x4*)(O + p) = w; }
                }
    }
};

struct EpiResBf16 {
    static constexpr bool PERM = true, AFTER_DRAIN = false; static constexpr int NSTORE = 16;
    const bf16_t* x; bf16_t* out; float alpha;
    __device__ __forceinline__ void operator()(const f32x4 (&acc)[2][2][4][2], const Unit& u, int wr, int wc, int fr, int fq) const {
        const int row0 = u.pm * BM + wr * 64 + fr, col0 = u.pn * BM + wc * 32 + 8 * fq;
#pragma unroll
        for (int ai = 0; ai < 2; ++ai)
#pragma unroll
            for (int m = 0; m < 4; ++m)
#pragma unroll
                for (int bj = 0; bj < 2; ++bj) {
                    const size_t p = (size_t)(row0 + ai * HALF + m * 16) * 1024 + col0 + bj * HALF;
#if X_F32_RES
                    const f32x4 x0 = *(const f32x4*)((const float*)x + p), x1 = *(const f32x4*)((const float*)x + p + 4);
#else
                    const u32x4 xw = *(const u32x4*)(x + p);
                    const f32x4 x0 = (f32x4){bflo(xw.x), bfhi(xw.x), bflo(xw.y), bfhi(xw.y)}, x1 = (f32x4){bflo(xw.z), bfhi(xw.z), bflo(xw.w), bfhi(xw.w)};
#endif
                    const f32x4 v0 = x0 * alpha + acc[ai][bj][m][0], v1 = x1 * alpha + acc[ai][bj][m][1];
                    u32x4 w; w.x = cvt_pk_bf16(v0[0], v0[1]); w.y = cvt_pk_bf16(v0[2], v0[3]); w.z = cvt_pk_bf16(v1[0], v1[1]); w.w = cvt_pk_bf16(v1[2], v1[3]);
                    *(u32x4*)(out + p) = w;
                }
    }
};

struct EpiSwiGLU {
    static constexpr bool PERM = true, AFTER_DRAIN = false; static constexpr int NSTORE = 16;
    unsigned char* H;
    __device__ __forceinline__ void operator()(const f32x4 (&acc)[2][2][4][2], const Unit& u, int wr, int wc, int fr, int fq) const {
        const int row0 = u.pm * BM + wr * 64 + fr, col0 = (u.pn & 3) * 128 + wc * 16 + 4 * fq;
#pragma unroll
        for (int ai = 0; ai < 2; ++ai)
#pragma unroll
            for (int m = 0; m < 4; ++m)
#pragma unroll
                for (int bj = 0; bj < 2; ++bj) {
                    const f32x4 g = acc[ai][bj][m][0], up = acc[ai][bj][m][1];
                    float h0 = fsilu(g[0]) * up[0] * 8.f, h1 = fsilu(g[1]) * up[1] * 8.f, h2 = fsilu(g[2]) * up[2] * 8.f, h3 = fsilu(g[3]) * up[3] * 8.f;
                    h0 = fminf(fmaxf(h0, -448.f), 448.f); h1 = fminf(fmaxf(h1, -448.f), 448.f); h2 = fminf(fmaxf(h2, -448.f), 448.f); h3 = fminf(fmaxf(h3, -448.f), 448.f);
                    unsigned w = 0u; w = __builtin_amdgcn_cvt_pk_fp8_f32(h0, h1, w, false); w = __builtin_amdgcn_cvt_pk_fp8_f32(h2, h3, w, true);
                    *(unsigned*)(H + (size_t)(row0 + ai * HALF + m * 16) * 512 + col0 + bj * 64) = w;
                }
    }
};

struct EpiRowScale {
    static constexpr bool PERM = true, AFTER_DRAIN = false; static constexpr int NSTORE = 16;
    bf16_t* Y;
    __device__ __forceinline__ void operator()(const f32x4 (&acc)[2][2][4][2], const Unit& u, int wr, int wc, int fr, int fq) const {
        const int row0 = u.pm * BM + wr * 64 + fr, col0 = (u.pn & 3) * BM + wc * 32 + 8 * fq;
#pragma unroll
        for (int ai = 0; ai < 2; ++ai)
#pragma unroll
            for (int m = 0; m < 4; ++m) {
                const int row = row0 + ai * HALF + m * 16;
#pragma unroll
                for (int bj = 0; bj < 2; ++bj) {
                    const f32x4 v0 = acc[ai][bj][m][0], v1 = acc[ai][bj][m][1];
#if Y_FP8
                    u32x2_ w8; w8.x = fp8x4_sat(v0[0] * 16.f, v0[1] * 16.f, v0[2] * 16.f, v0[3] * 16.f); w8.y = fp8x4_sat(v1[0] * 16.f, v1[1] * 16.f, v1[2] * 16.f, v1[3] * 16.f);
                    *(u32x2_*)((unsigned char*)Y + (size_t)row * 1024 + col0 + bj * HALF) = w8;
#else
                    u32x4 w; w.x = cvt_pk_bf16_acc(v0[0], v0[1]); w.y = cvt_pk_bf16_acc(v0[2], v0[3]); w.z = cvt_pk_bf16_acc(v1[0], v1[1]); w.w = cvt_pk_bf16_acc(v1[2], v1[3]);
                    *(u32x4*)(Y + (size_t)row * 1024 + col0 + bj * HALF) = w;
#endif
                }
            }
    }
};

struct MoeOrder {
    int nunits, G, c; const PG8_LAS int* te; const PG8_LAS int* ts; const PG8_LAS int* cnt; const int* ltok; unsigned rowbytes;
    __device__ __forceinline__ bool next(int i, Unit& u) const {
        const int L = i * G + c, rt = (L >> 5) * 8 + (L & 7); if (rt >= (nunits >> 2)) return false;
        u.pm = rt; u.pn = te[rt] * 4 + ((L >> 3) & 3); return true;
    }
    __device__ __forceinline__ unsigned a_row_off(const Unit& u, int row) const {
        const int ex = te[u.pm], pos = (u.pm - ts[ex]) * 256 + row;
        const int tok = pos < cnt[ex] ? ltok[ex * 32768 + pos] : 0;
        return (unsigned)tok * rowbytes;
    }
    __device__ __forceinline__ void a_ready(const Unit&) const {}
    __device__ __forceinline__ void done(const Unit&, int, int) const {}
};

struct ExpertConv { const float* wg; const float* wu; const float* wd; unsigned char* WGU; unsigned char* WD; int gw, nw, grp; };
__device__ __forceinline__ void expert_conv_item(const ExpertConv& c, int j, int lane) {
    const int it = j * c.nw + c.gw, e = it / 384, r = it % 384;
    const float* src; unsigned char* dst; int K, N, mode, nb, kb;
    if (r < 128)      { src = c.wg + (size_t)e * 1024 * 512; dst = c.WGU + (size_t)e * 1024 * 1024; K = 1024; N = 512;  mode = 2; nb = r >> 4; kb = r & 15; }
    else if (r < 256) { src = c.wu + (size_t)e * 1024 * 512; dst = c.WGU + (size_t)e * 1024 * 1024; K = 1024; N = 512;  mode = 3; nb = (r - 128) >> 4; kb = (r - 128) & 15; }
    else              { src = c.wd + (size_t)e * 512 * 1024; dst = c.WD + (size_t)e * 1024 * 512;   K = 512;  N = 1024; mode = 0; nb = (r - 256) >> 3; kb = (r - 256) & 7; }
    const int n4 = nb * 64 + 4 * (lane & 15), k0 = kb * 64 + 16 * (lane >> 4);
    const float* s = src + (size_t)k0 * N + n4;
    f32x4 v[16];
#pragma unroll
    for (int i = 0; i < 16; ++i) v[i] = *(const f32x4*)(s + (size_t)i * N);
#pragma unroll
    for (int jn = 0; jn < 4; ++jn) {
        const int n = n4 + jn, row = mode == 0 ? n : ((n >> 2) << 3) + (n & 3) + (mode == 3 ? 4 : 0);
        u32x4 w;
        w.x = fp8x4_sat(v[0][jn] * 64.f, v[1][jn] * 64.f, v[2][jn] * 64.f, v[3][jn] * 64.f);     w.y = fp8x4_sat(v[4][jn] * 64.f, v[5][jn] * 64.f, v[6][jn] * 64.f, v[7][jn] * 64.f);
        w.z = fp8x4_sat(v[8][jn] * 64.f, v[9][jn] * 64.f, v[10][jn] * 64.f, v[11][jn] * 64.f); w.w = fp8x4_sat(v[12][jn] * 64.f, v[13][jn] * 64.f, v[14][jn] * 64.f, v[15][jn] * 64.f);
        *(u32x4*)(dst + (size_t)row * K + k0) = w;
    }
}
struct GateOrder {
    StaticOrder S4;
    __device__ __forceinline__ bool next(int i, Unit& u) const { Unit t; if (!S4.next(i >> 1, t)) return false; u.pm = t.pm; u.pn = t.pn + 4 * (i & 1); return true; }
    __device__ __forceinline__ void a_ready(const Unit&) const {}
    __device__ __forceinline__ void done(const Unit&, int, int) const {}
};
struct P1Order {
    StaticOrder S; ExpertConv cv;
    __device__ __forceinline__ bool next(int i, Unit& u) const { return S.next(i, u); }
    __device__ __forceinline__ void a_ready(const Unit&) const {}
    __device__ __forceinline__ static int unit_of(int grp, int k) { return (grp + 3 * k) % 9; }
    __device__ __forceinline__ void done(const Unit&, int ui, int lane) const {
        const int d = (ui + 9 - cv.grp) % 9;
        if (ui < 9 && d % 3 == 0 && cv.gw + (d / 3) * cv.nw < 6144) expert_conv_item(cv, d / 3, lane);
    }
};

template <class Epi, class Sched, bool ALIGN_EPI = false, bool SP2 = false, bool GATHER = false, bool FP8 = false, int SEL_W = 0, int SEL_X = 0>
__device__ __forceinline__ void gemm_phase(PG8_LAS unsigned char* lds, const Gemm g, const Sched& S, const Epi& E, const int wid) {
    int tid = wid * 64 + lane_id(); asm volatile("" : "+v"(tid));
    const int lane = tid & 63, wr = wid >> 2, wc = wid & 3, fr = lane & 15, fq = lane >> 4;
    static_assert(SP2, "only the two-super-phase loop is kept");
    typedef int i32x4_ __attribute__((ext_vector_type(4)));
    const int K = g.K, nt = K / BK;
    unsigned voffB[2]; int rA[2], cA2[2];
#pragma unroll
    for (int i = 0; i < 2; ++i) { int R, C; stage_rc(tid * 16 + i * 8192, R, C); const int Rb = Epi::PERM ? ((R & ~31) + perm32(R & 31)) : R;
        rA[i] = R; cA2[i] = C * 2; voffB[i] = (unsigned)(Rb * K + C) * 2u; }
    unsigned vAc[2][2], vAn[2][2];
    const size_t kstep = (size_t)(BK * 2);
    const size_t hstep = (size_t)HALF * K * 2;
    const size_t tstep = 2 * hstep;
    const unsigned ldsw = (unsigned)wid * 1024u;
    const int aoff0 = lds_byte(wr * 64 + fr, fq * 8), aoff1 = aoff0 + 1024;
    const int boff0 = lds_byte(wc * 32 + fr, fq * 8), boff1 = boff0 + 1024;
#define PG8_SA(b, h) (((b) * 2 + (h)) * HTB)
#define PG8_SB(b, h) ((4 + (b) * 2 + (h)) * HTB)
#define PG8_STAGE(bufoff, gbase, voff) do { _Pragma("unroll") for (int _i = 0; _i < 2; ++_i) \
        __builtin_amdgcn_global_load_lds((const unsigned*)((const char*)(gbase) + (voff)[_i]), (PG8_LAS unsigned*)(lds + (bufoff) + ldsw + _i * 8192), 16, 0, 0); } while (0)
#define PG8_LDA(dst, b, h) do { _Pragma("unroll") for (int m = 0; m < 4; ++m) { dst[m][0] = *(const PG8_LAS bf16x8*)(lds + PG8_SA(b, h) + aoff0 + m * 2048); dst[m][1] = *(const PG8_LAS bf16x8*)(lds + PG8_SA(b, h) + aoff1 + m * 2048); } } while (0)
#define PG8_LDB(dst, b, h) do { _Pragma("unroll") for (int n = 0; n < 2; ++n) { dst[n][0] = *(const PG8_LAS bf16x8*)(lds + PG8_SB(b, h) + boff0 + n * 2048); dst[n][1] = *(const PG8_LAS bf16x8*)(lds + PG8_SB(b, h) + boff1 + n * 2048); } } while (0)
#define PG8_CAT8(x) __builtin_shufflevector(__builtin_bit_cast(i32x4_, (x)[0]), __builtin_bit_cast(i32x4_, (x)[1]), 0, 1, 2, 3, 4, 5, 6, 7)
#define PG8_MMA(ai, bj, At, Bt) do { __builtin_amdgcn_s_setprio(1); \
        if constexpr (FP8) { _Pragma("unroll") for (int m = 0; m < 4; ++m) _Pragma("unroll") for (int n = 0; n < 2; ++n) \
            acc[ai][bj][m][n] = __builtin_amdgcn_mfma_scale_f32_16x16x128_f8f6f4(PG8_CAT8(Bt[n]), PG8_CAT8(At[m]), acc[ai][bj][m][n], 0, 0, SEL_W, scl, SEL_X, scl); \
            asm volatile("" : "+v"(acc[ai][bj][0][0]), "+v"(acc[ai][bj][0][1]), "+v"(acc[ai][bj][1][0]), "+v"(acc[ai][bj][1][1]), "+v"(acc[ai][bj][2][0]), "+v"(acc[ai][bj][2][1]), "+v"(acc[ai][bj][3][0]), "+v"(acc[ai][bj][3][1])); } \
        else { _Pragma("unroll") for (int m = 0; m < 4; ++m) _Pragma("unroll") for (int n = 0; n < 2; ++n) _Pragma("unroll") for (int k = 0; k < 2; ++k) \
            acc[ai][bj][m][n] = __builtin_amdgcn_mfma_f32_16x16x32_bf16(Bt[n][k], At[m][k], acc[ai][bj][m][n], 0, 0, 0); } \
        __builtin_amdgcn_s_setprio(0); } while (0)
#define PG8_WAIT_V(n) asm volatile("s_waitcnt vmcnt(" #n ")" ::: "memory")
#define PG8_WAIT_VN(n) asm volatile("s_waitcnt vmcnt(%0)" :: "i"(n) : "memory")
#define PG8_WAIT_L(n) asm volatile("s_waitcnt lgkmcnt(" #n ")" ::: "memory")
#define PG8_BAR __builtin_amdgcn_s_barrier()
#define PG8_SCHED __builtin_amdgcn_sched_barrier(0)
    [[maybe_unused]] int scl = 0x7b7c797f; asm volatile("" : "+v"(scl));
    Unit cur, nxt; int ui = 0;
    if (!S.next(0, cur)) return;
    f32x4 acc[2][2][4][2];
#pragma unroll
    for (int a = 0; a < 2; ++a)
#pragma unroll
        for (int b = 0; b < 2; ++b)
#pragma unroll
            for (int m = 0; m < 4; ++m)
#pragma unroll
                for (int n = 0; n < 2; ++n) acc[a][b][m][n] = (f32x4){0.f, 0.f, 0.f, 0.f};
    bf16x8 At[4][2], B0[2][2], B1[2][2];
    const char* cA = GATHER ? (const char*)g.A : (const char*)g.A + (size_t)cur.pm * tstep + (cur.pm >= g.spm ? g.sdelta : 0L); const char* cB = (const char*)g.Bt + (size_t)cur.pn * tstep;
#pragma unroll
    for (int h = 0; h < 2; ++h)
#pragma unroll
        for (int i = 0; i < 2; ++i) { if constexpr (GATHER) vAc[h][i] = S.a_row_off(cur, h * HALF + rA[i]) + (unsigned)cA2[i]; else vAc[h][i] = (unsigned)((h * HALF + rA[i]) * K) * 2u + (unsigned)cA2[i]; vAn[h][i] = vAc[h][i]; }
    S.a_ready(cur);
    if constexpr (SP2) {
        PG8_STAGE(PG8_SB(0, 0), cB, voffB); PG8_STAGE(PG8_SB(0, 1), cB + hstep, voffB); PG8_STAGE(PG8_SA(0, 0), cA, vAc[0]); PG8_STAGE(PG8_SA(0, 1), cA, vAc[1]);
        if (wr == 1) PG8_BAR;
        PG8_WAIT_V(2); PG8_BAR;
        PG8_STAGE(PG8_SB(1, 0), cB + kstep, voffB); PG8_STAGE(PG8_SA(1, 0), cA + kstep, vAc[0]); PG8_STAGE(PG8_SB(1, 1), cB + hstep + kstep, voffB);
        PG8_WAIT_V(6); PG8_BAR;
    }
    for (;;) {
        const bool has_next = S.next(ui + 1, nxt);
        const char* nA = GATHER ? cA : (has_next ? (const char*)g.A + (size_t)nxt.pm * tstep + (nxt.pm >= g.spm ? g.sdelta : 0L) : cA); const char* nB = has_next ? (const char*)g.Bt + (size_t)nxt.pn * tstep : cB;
        if constexpr (GATHER) { if (has_next) {
#pragma unroll
            for (int h = 0; h < 2; ++h)
#pragma unroll
                for (int i = 0; i < 2; ++i) vAn[h][i] = S.a_row_off(nxt, h * HALF + rA[i]) + (unsigned)cA2[i]; } }
#pragma unroll 1
        for (int t = 0; t < nt; t += 2) {
            const bool last = (t == nt - 2);
            asm volatile("" : "+v"(voffB[0]), "+v"(voffB[1]), "+v"(vAc[0][0]), "+v"(vAc[0][1]), "+v"(vAc[1][0]), "+v"(vAc[1][1]));
            const char* a1 = cA + (size_t)(t + 1) * kstep;
            const char* a2 = last ? nA : cA + (size_t)(t + 2) * kstep; const char* b2 = last ? nB : cB + (size_t)(t + 2) * kstep;
            const char* a3 = a2 + kstep; const char* b3 = b2 + kstep;
            unsigned vA2[2][2];
#pragma unroll
            for (int h = 0; h < 2; ++h)
#pragma unroll
                for (int i = 0; i < 2; ++i) vA2[h][i] = vAc[h][i];
            if constexpr (GATHER) { if (last) {
                asm volatile("" : "+v"(vAn[0][0]), "+v"(vAn[0][1]), "+v"(vAn[1][0]), "+v"(vAn[1][1]));
#pragma unroll
                for (int h = 0; h < 2; ++h)
#pragma unroll
                    for (int i = 0; i < 2; ++i) vA2[h][i] = vAn[h][i]; } }
            if (last && has_next) S.a_ready(nxt);
            if constexpr (SP2) {
            const int lenient = __builtin_amdgcn_readfirstlane((ui > 0 && t == 0) ? 1 : 0);
#define PG8_WAIT_V8L() asm volatile("s_cmp_eq_u32 %0, 0\n\ts_cbranch_scc0 .Lpg8skip%=\n\ts_waitcnt vmcnt(8)\n.Lpg8skip%=:\n\ts_waitcnt vmcnt(%1)" :: "s"(lenient), "i"(8 + Epi::NSTORE) : "memory", "scc")
            PG8_LDB(B0, 0, 0); PG8_LDB(B1, 0, 1); PG8_SCHED; PG8_LDA(At, 0, 0); PG8_STAGE(PG8_SA(1, 1), a1, vAc[1]);
            PG8_WAIT_V8L(); PG8_WAIT_L(0); PG8_BAR; PG8_MMA(0, 0, At, B0); PG8_MMA(0, 1, At, B1); PG8_BAR; PG8_SCHED;
            PG8_LDA(At, 0, 1); PG8_STAGE(PG8_SB(0, 0), b2, voffB); PG8_STAGE(PG8_SB(0, 1), b2 + hstep, voffB); PG8_STAGE(PG8_SA(0, 0), a2, vA2[0]);
            PG8_WAIT_V8L(); PG8_WAIT_L(0); PG8_BAR; PG8_MMA(1, 0, At, B0); PG8_MMA(1, 1, At, B1); PG8_BAR; PG8_SCHED;
            PG8_LDB(B0, 1, 0); PG8_LDB(B1, 1, 1); PG8_SCHED; PG8_LDA(At, 1, 0); PG8_STAGE(PG8_SA(0, 1), a2, vA2[1]);
            PG8_WAIT_V(8); PG8_WAIT_L(0); PG8_BAR; PG8_MMA(0, 0, At, B0); PG8_MMA(0, 1, At, B1); PG8_BAR; PG8_SCHED;
            PG8_LDA(At, 1, 1); PG8_STAGE(PG8_SB(1, 0), b3, voffB); PG8_STAGE(PG8_SB(1, 1), b3 + hstep, voffB); PG8_STAGE(PG8_SA(1, 0), a3, vA2[0]);
            PG8_WAIT_V(8); PG8_WAIT_L(0); PG8_BAR; PG8_MMA(1, 0, At, B0); PG8_MMA(1, 1, At, B1); PG8_BAR; PG8_SCHED;
#undef PG8_WAIT_V8L
            }
        }
        if constexpr (ALIGN_EPI) { if (wr == 0) PG8_BAR; }
        if constexpr (!Epi::AFTER_DRAIN) { E(acc, cur, wr, wc, fr, fq); S.done(cur, ui, lane); }
        if (!has_next) break;
#pragma unroll
        for (int a = 0; a < 2; ++a)
#pragma unroll
            for (int b = 0; b < 2; ++b)
#pragma unroll
                for (int m = 0; m < 4; ++m)
#pragma unroll
                    for (int n = 0; n < 2; ++n) acc[a][b][m][n] = (f32x4){0.f, 0.f, 0.f, 0.f};
        cur = nxt; cA = nA; cB = nB; ++ui;
        if constexpr (GATHER) {
#pragma unroll
            for (int h = 0; h < 2; ++h)
#pragma unroll
                for (int i = 0; i < 2; ++i) vAc[h][i] = vAn[h][i]; }
        if constexpr (ALIGN_EPI) { if (wr == 1) PG8_BAR; }
    }
    PG8_WAIT_V(0);
    if constexpr (!ALIGN_EPI) { if (wr == 0) PG8_BAR; }
    PG8_BAR;
    if constexpr (Epi::AFTER_DRAIN) { E.fused(acc, cur, wr, wc, fr, fq, lds, wid, lane); S.done(cur, ui, lane); }
#undef PG8_SA
#undef PG8_SB
#undef PG8_STAGE
#undef PG8_LDA
#undef PG8_LDB
#undef PG8_MMA
#undef PG8_CAT8
#undef PG8_WAIT_V
#undef PG8_WAIT_VN
#undef PG8_WAIT_L
#undef PG8_BAR
#undef PG8_SCHED
}
}
#define GAS __attribute__((address_space(1)))
#define LAS __attribute__((address_space(3)))
typedef unsigned short bf16;
typedef unsigned v4u __attribute__((ext_vector_type(4)));
typedef float f32x4 __attribute__((ext_vector_type(4)));
typedef short bf16x8 __attribute__((ext_vector_type(8)));
typedef GAS unsigned gu32;
typedef GAS unsigned long long gu64;
#define RLX_AGENT __ATOMIC_RELAXED, __HIP_MEMORY_SCOPE_AGENT
#define LDS_WAIT() asm volatile("s_waitcnt lgkmcnt(0)" ::: "memory")
#define VM_WAIT() asm volatile("s_waitcnt vmcnt(0)" ::: "memory")
__device__ __forceinline__ unsigned long long rt() { return __builtin_amdgcn_s_memrealtime(); }
__device__ __forceinline__ unsigned f2bf(float f) { unsigned u = __builtin_bit_cast(unsigned, f); return (u + 0x7fffu + ((u >> 16) & 1u)) >> 16; }
__device__ __forceinline__ unsigned pk2(float lo, float hi) { return f2bf(lo) | (f2bf(hi) << 16); }

#define XB_TMO      128
#define XB_XCNT(j)  (256  + 64 * (j))
#define XB_XSUB(j)  (1280 + 64 * (j))
#define XB_XGEN(j)  (2304 + 64 * (j))
#define XB_TOP      3328
#define XB_TOPGEN   3392
#define XCD_BAR_WORDS 3456
#define XB_SPIN_CAP (1u << 18)

__device__ __forceinline__ unsigned xb_ld(unsigned* p)              { return __hip_atomic_load(p, __ATOMIC_RELAXED, __HIP_MEMORY_SCOPE_AGENT); }
__device__ __forceinline__ unsigned xb_add(unsigned* p, unsigned v) { return __hip_atomic_fetch_add(p, v, __ATOMIC_RELAXED, __HIP_MEMORY_SCOPE_AGENT); }
__device__ __forceinline__ unsigned xb_xcc_id() { return (unsigned)__builtin_amdgcn_s_getreg((3 << 11) | 20) & 0xFu; }
#define XB_SPIN(cond, bar) do { unsigned _sp = 0; while (cond) { __builtin_amdgcn_s_sleep(1); \
    if ((++_sp & 255u) == 0u) { if (xb_ld(&(bar)[XB_TMO])) break; if (_sp > XB_SPIN_CAP) { atomicAdd(&(bar)[XB_TMO], 1u); break; } } } } while (0)

struct XcdBarrier {
    unsigned* bar; unsigned x; int wv;
    volatile LAS unsigned* st;
};

__device__ __forceinline__ XcdBarrier xcd_barrier_post(unsigned* bar, volatile LAS unsigned* st) {
    XcdBarrier b; b.bar = bar; b.x = xb_xcc_id(); b.st = st; b.wv = 0;
    if (threadIdx.x == 0) (void)xb_add(&bar[XB_XCNT(b.x)], 1u);
    return b;
}
__device__ __forceinline__ void xcd_barrier_complete(unsigned* bar, unsigned x, unsigned& nloc, unsigned& nx) {
    const unsigned G = gridDim.x * gridDim.y * gridDim.z;
    unsigned sum, cnt, mine, sp = 0u;
    for (;;) {
        sum = 0u; cnt = 0u; mine = 0u;
#pragma unroll
        for (unsigned j = 0; j < 16; ++j) { const unsigned c = xb_ld(&bar[XB_XCNT(j)]); sum += c; cnt += (c > 0u) ? 1u : 0u; mine = (j == x) ? c : mine; }
        if (sum == G) break;
        __builtin_amdgcn_s_sleep(1);
        if ((++sp & 255u) == 0u) { if (xb_ld(&bar[XB_TMO])) break; if (sp > XB_SPIN_CAP) { atomicAdd(&bar[XB_TMO], 1u); break; } }
    }
    nloc = mine > 0u ? mine : 1u; nx = cnt > 0u ? cnt : 1u;
}

__device__ __forceinline__ void xcd_barrier(const XcdBarrier& b) {
    asm volatile("s_waitcnt vmcnt(0)" ::: "memory");
    __syncthreads();
    if (b.wv == 0 && (int)__builtin_amdgcn_mbcnt_hi(~0u, __builtin_amdgcn_mbcnt_lo(~0u, 0u)) == 0) {
        unsigned* bar = b.bar;
        __builtin_amdgcn_s_waitcnt(0);
        unsigned nloc = b.st[0], nx = b.st[1];
        if (nloc == 0u) { xcd_barrier_complete(bar, b.x, nloc, nx); b.st[0] = nloc; b.st[1] = nx; }
        const unsigned old = xb_add(&bar[XB_XSUB(b.x)], 1u);
        const unsigned gen = old / nloc;
        if (old + 1u == (gen + 1u) * nloc) {
            __builtin_amdgcn_fence(__ATOMIC_RELEASE, "agent");
            asm volatile("s_waitcnt vmcnt(0)" ::: "memory");
            const unsigned og = xb_add(&bar[XB_TOP], 1u);
            const unsigned tg = og / nx;
            if (og + 1u == (tg + 1u) * nx) xb_add(&bar[XB_TOPGEN], 1u);
            else XB_SPIN(xb_ld(&bar[XB_TOPGEN]) == tg, bar);
            __builtin_amdgcn_fence(__ATOMIC_ACQUIRE, "agent");
            xb_add(&bar[XB_XGEN(b.x)], 1u);
            asm volatile("s_waitcnt vmcnt(0)" ::: "memory");
        } else {
            XB_SPIN(xb_ld(&bar[XB_XGEN(b.x)]) == gen, bar);
            __builtin_amdgcn_fence(__ATOMIC_ACQUIRE, "agent");
            asm volatile("s_waitcnt vmcnt(0)" ::: "memory");
        }
    }
    __syncthreads();
}


constexpr int NWAVES = 8;
constexpr int RING_BYTES = 131072;
constexpr int LDSCTL_OFF = RING_BYTES, MISC_OFF = LDSCTL_OFF + 320;
constexpr int LDS_TS_OFF = LDSCTL_OFF + 1024;
constexpr int LDS_TE_OFF = LDSCTL_OFF + 2048;
constexpr int LDS_CNT_OFF = LDSCTL_OFF + 1024 + 128;
constexpr int LDS_BYTES = 163840;

typedef short s16x4 __attribute__((ext_vector_type(4)));
typedef unsigned u32x2 __attribute__((ext_vector_type(2)));

struct Args { const float* in[20]; float* out; unsigned char* ws; unsigned mask; int bar_region; };

__device__ __forceinline__ float bflo(unsigned w) { return __uint_as_float(w << 16); }
__device__ __forceinline__ float bfhi(unsigned w) { return __uint_as_float(w & 0xffff0000u); }
__device__ __forceinline__ unsigned cvtpk(float lo, float hi) { return pg8::cvt_pk_bf16(lo, hi); }
__device__ __forceinline__ float wave_sum(float v) {
#pragma unroll
    for (int o = 1; o < 64; o <<= 1) v += __shfl_xor(v, o);
    return v;
}
__device__ __forceinline__ unsigned offb(unsigned row, unsigned ch) { return 256u * row + 16u * (ch ^ (((row & 3u) << 2) | ((row >> 2) & 3u))); }
__device__ __forceinline__ s16x4 ldtr(const LAS unsigned char* p) { return __builtin_amdgcn_ds_read_tr16_b64_v4i16((LAS s16x4*)p); }
__device__ __forceinline__ bf16x8 cat8(s16x4 a, s16x4 b) { return (bf16x8){a[0], a[1], a[2], a[3], b[0], b[1], b[2], b[3]}; }
#define MFMA16(a, b, c) __builtin_amdgcn_mfma_f32_16x16x32_bf16((a), (b), (c), 0, 0, 0)

template <int MODE> __device__ __forceinline__ int dest_row(int n) {
    if (MODE == 1) { if (n >= 1024) return n; const int hb = n & ~127, d = n & 127, jr = d & 63, half = d >> 6; return hb + 8 * (jr >> 2) + 4 * half + (jr & 3); }
    if (MODE == 2) return ((n >> 2) << 3) + (n & 3);
    if (MODE == 3) return ((n >> 2) << 3) + 4 + (n & 3);
    return n;
}
template <int MODE> __device__ __forceinline__ void p0_transpose_item(const float* W, int K, int N, bf16* WT, LAS float* scr, int item, int lane) {
    const int nblk = N / 32, kb = item / nblk, nb = item % nblk, k0 = 64 * kb, n0 = 32 * nb;
    {
        const GAS f32x4* src = (const GAS f32x4*)(W + (size_t)(k0 + (lane >> 3)) * N + n0) + (lane & 7);
        f32x4 t[8];
#pragma unroll
        for (int j = 0; j < 8; ++j) t[j] = src[(size_t)j * 2 * N];
#pragma unroll
        for (int j = 0; j < 8; ++j) { LAS float* d = scr + ((lane >> 3) + 8 * j) * 33 + 4 * (lane & 7); d[0] = t[j].x; d[1] = t[j].y; d[2] = t[j].z; d[3] = t[j].w; }
    }
    LDS_WAIT(); asm volatile("" ::: "memory");
    const int c = lane & 7;
#pragma unroll
    for (int j = 0; j < 4; ++j) { const int n = (lane >> 3) + 8 * j; const LAS float* s = scr + (8 * c) * 33 + n;
        v4u o; o.x = pk2(s[0 * 33], s[1 * 33]); o.y = pk2(s[2 * 33], s[3 * 33]); o.z = pk2(s[4 * 33], s[5 * 33]); o.w = pk2(s[6 * 33], s[7 * 33]);
        *(GAS v4u*)(WT + (size_t)dest_row<MODE>(n0 + n) * K + k0 + 8 * c) = o; }
    LDS_WAIT(); asm volatile("" ::: "memory");
}
__device__ __forceinline__ unsigned pk_fp8x4(float a, float b, float c, float d) {
    a = fminf(fmaxf(a, -448.f), 448.f); b = fminf(fmaxf(b, -448.f), 448.f); c = fminf(fmaxf(c, -448.f), 448.f); d = fminf(fmaxf(d, -448.f), 448.f);
    unsigned w = 0u; w = __builtin_amdgcn_cvt_pk_fp8_f32(a, b, w, false); w = __builtin_amdgcn_cvt_pk_fp8_f32(c, d, w, true); return w;
}
template <int MODE> __device__ __forceinline__ void p0_transpose_item_fp8(const float* W, int K, int N, unsigned char* WT, LAS float* scr, int item, int lane, float scale) {
    const int nblk = N / 32, kb = item / nblk, nb = item % nblk, k0 = 64 * kb, n0 = 32 * nb;
    {
        const GAS f32x4* src = (const GAS f32x4*)(W + (size_t)(k0 + (lane >> 3)) * N + n0) + (lane & 7);
        f32x4 t[8];
#pragma unroll
        for (int j = 0; j < 8; ++j) t[j] = src[(size_t)j * 2 * N];
#pragma unroll
        for (int j = 0; j < 8; ++j) { LAS float* d = scr + ((lane >> 3) + 8 * j) * 33 + 4 * (lane & 7); d[0] = t[j].x; d[1] = t[j].y; d[2] = t[j].z; d[3] = t[j].w; }
    }
    LDS_WAIT(); asm volatile("" ::: "memory");
    const int c = lane & 7;
#pragma unroll
    for (int j = 0; j < 4; ++j) { const int n = (lane >> 3) + 8 * j; const LAS float* s = scr + (8 * c) * 33 + n;
        u32x2 o; o.x = pk_fp8x4(s[0 * 33] * scale, s[1 * 33] * scale, s[2 * 33] * scale, s[3 * 33] * scale); o.y = pk_fp8x4(s[4 * 33] * scale, s[5 * 33] * scale, s[6 * 33] * scale, s[7 * 33] * scale);
        *(GAS u32x2*)(WT + (size_t)dest_row<MODE>(n0 + n) * K + k0 + 8 * c) = o; }
    LDS_WAIT(); asm volatile("" ::: "memory");
}
__device__ __forceinline__ int t5_bucket(int rel) {
    const int n = rel < 0 ? -rel : rel;
    int large = 8 + (n >= 15) + (n >= 27) + (n >= 50) + (n >= 91) + (n >= 166) + (n >= 305) + (n >= 559);
    large = large < 15 ? large : 15;
    return (rel > 0 ? 16 : 0) + (n < 8 ? n : large);
}
__device__ __forceinline__ void p0_prologue(const Args& a, LAS unsigned char* lds, int vcu, int G, int tid, int wave, int lane) {
    unsigned char* ws = a.ws;
    LAS float* scr = (LAS float*)(lds + wave * 16384);
    const int gw = vcu * NWAVES + wave, NGW = G * NWAVES;
    constexpr int I_IN = 16 * 208, I_R = 16 * 32, I_A = 8 * 32, I_O = 16 * 32;
    constexpr int NITEMS = I_IN + I_R + I_A + I_O;
    for (int it = gw; it < NITEMS; it += NGW) {
        int r = it;
#if P1_FP8
        if (r < I_IN) { if ((GATE_FP8 || r % 208 < 144) && r % 208 >= 8 * P1_FP8_FROM) p0_transpose_item_fp8<1>(a.in[1], 1024, 6656, ws + WS_WIN8, scr, r, lane, 64.f);
                        else p0_transpose_item<1>(a.in[1], 1024, 6656, (bf16*)(ws + WS_WIN), scr, r, lane); continue; } r -= I_IN;
#else
        if (r < I_IN) { p0_transpose_item<1>(a.in[1], 1024, 6656, (bf16*)(ws + WS_WIN), scr, r, lane); continue; } r -= I_IN;
#endif
        if (r < I_R) { if (MIX_FP8 & 4) p0_transpose_item_fp8<0>(a.in[5], 1024, 1024, ws + WS_WR, scr, r, lane, 64.f); else p0_transpose_item<0>(a.in[5], 1024, 1024, (bf16*)(ws + WS_WR), scr, r, lane); continue; } r -= I_R;
        if (r < I_A) { if (MIX_FP8 & 2) p0_transpose_item_fp8<0>(a.in[7], 512, 1024, ws + WS_WA, scr, r, lane, 64.f); else p0_transpose_item<0>(a.in[7], 512, 1024, (bf16*)(ws + WS_WA), scr, r, lane); continue; } r -= I_A;
        if (MIX_FP8 & 1) p0_transpose_item_fp8<0>(a.in[8], 1024, 1024, ws + WS_WO, scr, r, lane, 64.f); else p0_transpose_item<0>(a.in[8], 1024, 1024, (bf16*)(ws + WS_WO), scr, r, lane);
    }
    {
        const f32x4* x4 = (const f32x4*)a.in[0]; u32x2* xb = (u32x2*)(ws + WS_XB);
#if P1_FP8
#if GATE_FP8
        unsigned* xf8 = (unsigned*)(ws + WS_X8_LO);
#define XF8_AT(i) xf8[(long)(i) + ((i) >= (size_t)16384 * 256 ? ((long)WS_X8_HI - (long)WS_X8_LO - (long)(16 * MiB)) / 4 : 0L)]
#else
        unsigned* xf8 = (unsigned*)a.out;
#define XF8_AT(i) xf8[i]
#endif
        for (size_t i = (size_t)vcu * 512 + tid; i < (size_t)TT * DM / 4; i += (size_t)G * 512) { const f32x4 v = x4[i]; u32x2 o; o.x = cvtpk(v.x, v.y); o.y = cvtpk(v.z, v.w); if (!X_F32_RES) xb[i] = o; XF8_AT(i) = pk_fp8x4(v.x, v.y, v.z, v.w); }
#undef XF8_AT
#else
        for (size_t i = (size_t)vcu * 512 + tid; i < (size_t)TT * DM / 4; i += (size_t)G * 512) { const f32x4 v = x4[i]; u32x2 o; o.x = cvtpk(v.x, v.y); o.y = cvtpk(v.z, v.w); xb[i] = o; }
#endif
    }
    {
        float* rot = (float*)(ws + WS_ROT);
        for (int idx = vcu * 512 + tid; idx < SEQ * 64; idx += G * 512) {
            const int pos = idx >> 6, jr = idx & 63;
            double iv = 1.0; for (int k = 0; k < jr; ++k) iv *= 0.86596432336006535;
            const float ang = (float)pos * (float)iv;
            const double xx = (double)ang; const double qd = __builtin_rint(xx * 0.63661977236758134); const int qi = (int)qd;
            const double r = (xx - qd * 1.5707963267948966) - qd * 6.123233995736766e-17, r2 = r * r;
            const double sp = r * (1.0 + r2 * (-1.0 / 6 + r2 * (1.0 / 120 + r2 * (-1.0 / 5040 + r2 * (1.0 / 362880 + r2 * (-1.0 / 39916800 + r2 * (1.0 / 6227020800.0)))))));
            const double cp = 1.0 + r2 * (-0.5 + r2 * (1.0 / 24 + r2 * (-1.0 / 720 + r2 * (1.0 / 40320 + r2 * (-1.0 / 3628800 + r2 * (1.0 / 479001600.0))))));
            const int qq = qi & 3; const double s = qq == 0 ? sp : (qq == 1 ? cp : (qq == 2 ? -sp : -cp)), c = qq == 0 ? cp : (qq == 1 ? -sp : (qq == 2 ? -cp : sp));
            float* o = rot + ((size_t)pos * 16 + (jr >> 2)) * 8 + (jr & 3); o[0] = (float)c; o[4] = (float)s;
        }
    }
    if (vcu == 0) {
        float* bt = (float*)(ws + WS_BIAS); const float* rb = a.in[6];
        for (int idx = tid; idx < 3 * 8 * 160; idx += 512) { const int p = idx / (8 * 160), h = (idx / 160) % 8, d = idx % 160 - 80; const int dil = p == 0 ? 1 : (p == 1 ? 4 : 16);
            bt[idx] = (d >= -64 && d <= 64) ? rb[t5_bucket(d * dil) * 8 + h] * 1.4426950408889634f : -1e30f; }
    }
}
__device__ __forceinline__ void p0_expert_weights(const Args& a, LAS unsigned char* lds, int vcu, int G, int wave, int lane) {
    unsigned char* ws = a.ws;
    LAS float* scr = (LAS float*)(lds + wave * 16384);
    const int gw = vcu * NWAVES + wave, NGW = G * NWAVES;
    constexpr int I_G = 16 * 16, I_D = 8 * 32, PER_E = 2 * I_G + I_D;
    for (int it = gw; it < 16 * PER_E; it += NGW) {
        const int e = it / PER_E; int r = it - e * PER_E;
#if M1_FP8
        if (r < I_G) { p0_transpose_item_fp8<2>(a.in[15] + (size_t)e * 1024 * 512, 1024, 512, ws + WS_WGU + (size_t)e * 1024 * 1024, scr, r, lane, 64.f); continue; } r -= I_G;
        if (r < I_G) { p0_transpose_item_fp8<3>(a.in[16] + (size_t)e * 1024 * 512, 1024, 512, ws + WS_WGU + (size_t)e * 1024 * 1024, scr, r, lane, 64.f); continue; } r -= I_G;
#else
        if (r < I_G) { p0_transpose_item<2>(a.in[15] + (size_t)e * 1024 * 512, 1024, 512, (bf16*)(ws + WS_WGU) + (size_t)e * 1024 * 1024, scr, r, lane); continue; } r -= I_G;
        if (r < I_G) { p0_transpose_item<3>(a.in[16] + (size_t)e * 1024 * 512, 1024, 512, (bf16*)(ws + WS_WGU) + (size_t)e * 1024 * 1024, scr, r, lane); continue; } r -= I_G;
#endif
        p0_transpose_item_fp8<0>(a.in[17] + (size_t)e * 512 * 1024, 512, 1024, ws + WS_WD + (size_t)e * 1024 * 512, scr, r, lane, 64.f);
    }
    __syncthreads();
}

__device__ __forceinline__ float log2_gamma(const float* dec, int h) {
    const float x = dec[h]; return -__log2f(1.f + __expf(-x));
}
__device__ __forceinline__ void chain_item(const Args& a, LAS unsigned char* lds, int item, int tid, int wid, int lane) {
    unsigned char* ws = a.ws;
    const int b = item >> 4, h = (item >> 2) & 3, dir = (item >> 1) & 1, vh = item & 1;
    const float lg2 = log2_gamma(dir ? a.in[3] : a.in[2], h);
    const float cd = __builtin_amdgcn_exp2f(lg2 * 128.f);
    const int g = lane >> 4, i16 = lane & 15, q = i16 >> 2, p = lane & 3;
    const int wd = wid >> 1, wv = wid & 1;
    const GAS bf16* kr = (const GAS bf16*)(ws + WS_KR); const GAS bf16* vr = (const GAS bf16*)(ws + WS_VR);
    GAS bf16* states = (GAS bf16*)a.out;
    f32x4 acc[2][4];
#pragma unroll
    for (int i = 0; i < 2; ++i)
#pragma unroll
        for (int j = 0; j < 4; ++j) acc[i][j] = (f32x4){0.f, 0.f, 0.f, 0.f};
    const int srow = tid >> 4, sch = tid & 15; const unsigned soff = offb(srow, sch);
    const GAS bf16* kp = kr + ((size_t)b * SEQ + srow) * 512 + h * 128 + sch * 8;
    const GAS bf16* vp = vr + ((size_t)b * SEQ + srow) * 1024 + h * 256 + vh * 128 + sch * 8;
    v4u kq[4], vq[4];
    { const int n0 = dir ? 15 : 0;
#pragma unroll
      for (int j = 0; j < 4; ++j) { kq[j] = *(const GAS v4u*)(kp + (size_t)(n0 * 128 + 32 * j) * 512); vq[j] = *(const GAS v4u*)(vp + (size_t)(n0 * 128 + 32 * j) * 1024); } }
    unsigned abase[2][2], bbase[4][2];
#pragma unroll
    for (int t = 0; t < 2; ++t) { const unsigned r = 8 * g + 4 * t + q;
#pragma unroll
        for (int dt = 0; dt < 2; ++dt) abase[dt][t] = offb(r, 2 * (2 * wd + dt) + (p >> 1)) + 8 * (p & 1);
#pragma unroll
        for (int vt = 0; vt < 4; ++vt) bbase[vt][t] = offb(r, 2 * (4 * wv + vt) + (p >> 1)) + 8 * (p & 1); }
#define CH_STAGE(BUFOFF) do { _Pragma("unroll") for (int j = 0; j < 4; ++j) { \
            const int row = srow + 32 * j; const float z = __builtin_amdgcn_exp2f(lg2 * (float)(dir ? row : 127 - row)); const v4u kv = kq[j]; \
            v4u ko; ko.x = cvtpk(bflo(kv.x) * z, bfhi(kv.x) * z); ko.y = cvtpk(bflo(kv.y) * z, bfhi(kv.y) * z); ko.z = cvtpk(bflo(kv.z) * z, bfhi(kv.z) * z); ko.w = cvtpk(bflo(kv.w) * z, bfhi(kv.w) * z); \
            *(LAS v4u*)(lds + (BUFOFF) + soff + j * 8192) = ko; *(LAS v4u*)(lds + (BUFOFF) + 32768 + soff + j * 8192) = vq[j]; } } while (0)
#define CH_FETCH(NN) do { _Pragma("unroll") for (int j = 0; j < 4; ++j) { kq[j] = *(const GAS v4u*)(kp + (size_t)((NN) * 128 + 32 * j) * 512); vq[j] = *(const GAS v4u*)(vp + (size_t)((NN) * 128 + 32 * j) * 1024); } } while (0)
#define CH_STEP(STEP, CUR, OTH) do { const int step_ = (STEP); const int n_ = dir ? 15 - step_ : step_; \
        GAS bf16* sb_ = states + ((((size_t)(b * 4 + h) * 16 + n_) * 2 + dir) * 256) * 128; \
        _Pragma("unroll") for (int dt = 0; dt < 2; ++dt) _Pragma("unroll") for (int vt = 0; vt < 4; ++vt) { \
            const int v_ = vh * 128 + 64 * wv + 16 * vt + i16, d0_ = 32 * wd + 16 * dt + 4 * g; \
            u32x2 w_; w_.x = pg8::cvt_pk_bf16_acc(acc[dt][vt][0], acc[dt][vt][1]); w_.y = pg8::cvt_pk_bf16_acc(acc[dt][vt][2], acc[dt][vt][3]);   \
            *(GAS u32x2*)(sb_ + (size_t)v_ * 128 + d0_) = w_; } \
        if (step_ < 15) CH_STAGE(OTH); \
        if (step_ < 14) CH_FETCH(dir ? 13 - step_ : step_ + 2); \
        _Pragma("unroll") for (int i = 0; i < 2; ++i) _Pragma("unroll") for (int j = 0; j < 4; ++j) acc[i][j] = acc[i][j] * cd; \
        _Pragma("unroll") for (int ks = 0; ks < 4; ++ks) { bf16x8 af[2], bfr[4]; \
            _Pragma("unroll") for (int dt = 0; dt < 2; ++dt) af[dt] = cat8(ldtr(lds + (CUR) + abase[dt][0] + ks * 8192), ldtr(lds + (CUR) + abase[dt][1] + ks * 8192)); \
            _Pragma("unroll") for (int vt = 0; vt < 4; ++vt) bfr[vt] = cat8(ldtr(lds + (CUR) + 32768 + bbase[vt][0] + ks * 8192), ldtr(lds + (CUR) + 32768 + bbase[vt][1] + ks * 8192)); \
            _Pragma("unroll") for (int dt = 0; dt < 2; ++dt) _Pragma("unroll") for (int vt = 0; vt < 4; ++vt) acc[dt][vt] = MFMA16(af[dt], bfr[vt], acc[dt][vt]); } \
        __syncthreads(); } while (0)
    CH_STAGE(0);
    CH_FETCH(dir ? 14 : 1);
    __syncthreads();
    for (int sp = 0; sp < 8; ++sp) { CH_STEP(2 * sp, 0, 65536); CH_STEP(2 * sp + 1, 65536, 0); }
#undef CH_STEP
#undef CH_STAGE
#undef CH_FETCH
}

constexpr int AT_OST = 135168, AT_SCR = AT_OST + 8 * 2048;
constexpr int ATB_N = 160;
struct AttnLane { unsigned kb[2]; unsigned vb[4]; };
__device__ __forceinline__ AttnLane attn_lane(int lane) {
    const int g = lane >> 4, i16 = lane & 15, q4 = i16 >> 2, p = lane & 3; AttnLane L;
#pragma unroll
    for (int s = 0; s < 2; ++s) L.kb[s] = i16 * 128 + (((4 * s + g) ^ ((i16 >> 1) & 7)) * 16);
    const int sw = (2 * g + (q4 >> 1)) & 3;
#pragma unroll
    for (int c = 0; c < 4; ++c) L.vb[c] = (4 * g + q4) * 128 + ((c ^ sw) * 32) + p * 8;
    return L;
}
__device__ __forceinline__ unsigned kimg_off(int row, int c) { return row * 128 + ((c ^ ((row >> 1) & 7)) * 16); }
__device__ __forceinline__ unsigned vimg_off(int row, int c) { return row * 128 + (((c >> 1) ^ ((row >> 1) & 3)) * 32) + (c & 1) * 16; }
__device__ __forceinline__ void attn_core(const LAS unsigned char* Kimg, const LAS unsigned char* Vimg, int R0, int nrows, unsigned tvalid, const bf16x8 (&qf)[2],
                                          const float (&biasr)[36], const AttnLane& L, f32x4 (&O)[4], float& mx, float& lsum) {
    f32x4 D[9];
#pragma unroll
    for (int kt = 0; kt < 9; ++kt) {
        int R = R0 + 16 * kt; R = R < 0 ? 0 : (R > nrows - 16 ? nrows - 16 : R);
        const LAS unsigned char* kp = Kimg + R * 128;
        const bf16x8 k0 = *(const LAS bf16x8*)(kp + L.kb[0]), k1 = *(const LAS bf16x8*)(kp + L.kb[1]);
        f32x4 d = (f32x4){0.f, 0.f, 0.f, 0.f};
        d = MFMA16(k0, qf[0], d); d = MFMA16(k1, qf[1], d); D[kt] = d;
    }
    mx = -1e30f;
#pragma unroll
    for (int kt = 0; kt < 9; ++kt) {
        const float tb = ((tvalid >> kt) & 1u) ? 0.f : -1e30f;
#pragma unroll
        for (int r = 0; r < 4; ++r) { const float x = D[kt][r] + (biasr[4 * kt + r] + tb); D[kt][r] = x; mx = fmaxf(mx, x); }
    }
    mx = fmaxf(mx, __shfl_xor(mx, 16)); mx = fmaxf(mx, __shfl_xor(mx, 32));
    lsum = 0.f;
#pragma unroll
    for (int kt = 0; kt < 9; ++kt)
#pragma unroll
        for (int r = 0; r < 4; ++r) { const float e = __builtin_amdgcn_exp2f(D[kt][r] - mx); D[kt][r] = e; lsum += e; }
    lsum += __shfl_xor(lsum, 16); lsum += __shfl_xor(lsum, 32);
#pragma unroll
    for (int c = 0; c < 4; ++c) O[c] = (f32x4){0.f, 0.f, 0.f, 0.f};
#pragma unroll
    for (int kk = 0; kk < 5; ++kk) {
        int Ra = R0 + 32 * kk; Ra = Ra < 0 ? 0 : (Ra > nrows - 16 ? nrows - 16 : Ra);
        int Rb = R0 + 32 * kk + 16; Rb = Rb < 0 ? 0 : (Rb > nrows - 16 ? nrows - 16 : Rb);
        if (kk == 4) Rb = Ra;
        const f32x4 e0 = D[2 * kk], e1 = kk < 4 ? D[2 * kk + 1] : (f32x4){0.f, 0.f, 0.f, 0.f};
        v4u pw; pw.x = cvtpk(e0[0], e0[1]); pw.y = cvtpk(e0[2], e0[3]); pw.z = cvtpk(e1[0], e1[1]); pw.w = cvtpk(e1[2], e1[3]);
        const bf16x8 pf = __builtin_bit_cast(bf16x8, pw);
        const LAS unsigned char* va_ = Vimg + Ra * 128; const LAS unsigned char* vb_ = Vimg + Rb * 128;
#pragma unroll
        for (int c = 0; c < 4; ++c) O[c] = MFMA16(pf, cat8(ldtr(va_ + L.vb[c]), ldtr(vb_ + L.vb[c])), O[c]);
    }
}
__device__ __forceinline__ void attn_stage_out(LAS unsigned char* lds, int wid, int lane, const f32x4 (&O)[4], float lsum) {
    const int g = lane >> 4, i16 = lane & 15;
    const float linv = 1.f / lsum;
    LAS bf16* st = (LAS bf16*)(lds + AT_OST + wid * 2048);
#pragma unroll
    for (int r = 0; r < 4; ++r) { const float li = __shfl(linv, 4 * g + r);
#pragma unroll
        for (int c = 0; c < 4; ++c) st[(4 * g + r) * 64 + 16 * c + i16] = (bf16)(cvtpk(O[c][r] * li, 0.f) & 0xffffu); }
}
__device__ __forceinline__ void attn_load_bias(const Args& a, int pat, int h, int lane, float (&biasr)[36]) {
    const GAS float* bt = (const GAS float*)(a.ws + WS_BIAS) + (pat * 8 + h) * ATB_N; const int g = lane >> 4, i16 = lane & 15;
#pragma unroll
    for (int kt = 0; kt < 9; ++kt)
#pragma unroll
        for (int r = 0; r < 4; ++r) biasr[4 * kt + r] = bt[16 * kt + 4 * g + r - 64 - i16 + 80];
}
template <int DIL, int VAR = 0> __device__ __forceinline__ void attn_dil_phase(const Args& a, LAS unsigned char* lds, int vcu, int G, int tid, int wid, int lane) {
    unsigned char* ws = a.ws;
    constexpr int NR = SEQ / DIL, PAT = DIL == 4 ? 1 : 2, CH = NR * 8 / 512, NITEM = NB * 8 * DIL;
    constexpr int NBUF = DIL == 16 ? 2 : 1, BUFB = 2 * NR * 128;
    const GAS bf16* qa = (const GAS bf16*)(ws + WS_QA); const GAS bf16* ka = (const GAS bf16*)(ws + WS_KA); const GAS bf16* va = (const GAS bf16*)(ws + WS_VA);
    bf16* op = (bf16*)(ws + (DIL == 4 ? WS_O2 : WS_O3)); float* lsep = (float*)(ws + (DIL == 4 ? WS_LSE2 : WS_LSE3));
    if (vcu >= NITEM) return;
    const int h = vcu & 7;
    float biasr[36]; attn_load_bias(a, PAT, h, lane, biasr);
    const AttnLane L = attn_lane(lane);
    const int g = lane >> 4, i16 = lane & 15;
    v4u kq[CH], vq[CH]; bf16x8 qn[2];
    auto issue = [&](int item, int gi) {
        const int rho = (item >> 3) % DIL, b = item / (8 * DIL); const size_t rowb = (size_t)b * SEQ;
#pragma unroll
        for (int j = 0; j < CH; ++j) { const int id = tid + 512 * j, row = id >> 3, c = id & 7; const size_t go = (rowb + (size_t)row * DIL + rho) * 512 + h * 64 + c * 8;
            kq[j] = *(const GAS v4u*)(ka + go); vq[j] = *(const GAS v4u*)(va + go); }
        const size_t qpos = rowb + (size_t)(16 * gi + i16) * DIL + rho;
#pragma unroll
        for (int s = 0; s < 2; ++s) qn[s] = *(const GAS bf16x8*)(qa + qpos * 512 + h * 64 + 32 * s + 8 * g);
    };
    issue(vcu, wid);
    int buf = 0;
    for (int item = vcu; item < NITEM; item += G) {
        const int rho = (item >> 3) % DIL, b = item / (8 * DIL); const size_t rowb = (size_t)b * SEQ;
        LAS unsigned char* Kimg = lds + buf * BUFB; LAS unsigned char* Vimg = Kimg + NR * 128;
        if (NBUF == 1) __syncthreads();
#pragma unroll
        for (int j = 0; j < CH; ++j) { const int id = tid + 512 * j, row = id >> 3, c = id & 7;
            *(LAS v4u*)(Kimg + kimg_off(row, c)) = kq[j]; *(LAS v4u*)(Vimg + vimg_off(row, c)) = vq[j]; }
        bf16x8 qf[2] = {qn[0], qn[1]};
        __syncthreads();
        if (NBUF == 2 && item + G < NITEM) issue(item + G, wid);
        for (int gi = wid; gi < NR / 16; gi += 8) {
            const int m0 = 16 * gi;
            if (NBUF == 1 && gi + 8 < NR / 16) {
                const size_t qpos = rowb + (size_t)(m0 + 128 + i16) * DIL + rho;
#pragma unroll
                for (int s = 0; s < 2; ++s) qn[s] = *(const GAS bf16x8*)(qa + qpos * 512 + h * 64 + 32 * s + 8 * g); }
            unsigned tvalid = 0u;
#pragma unroll
            for (int kt = 0; kt < 9; ++kt) { const int t0 = m0 - 64 + 16 * kt; tvalid |= (t0 >= 0 && t0 < NR) ? (1u << kt) : 0u; }
            f32x4 O[4]; float mx, lsum;
            if (VAR == 1) { mx = 0.f; lsum = 1.f;
#pragma unroll
                for (int c = 0; c < 4; ++c) O[c] = (f32x4){__builtin_bit_cast(float, qf[0][0] + c), 0.f, 0.f, 0.f}; }
            else attn_core(Kimg, Vimg, m0 - 64, NR, tvalid, qf, biasr, L, O, mx, lsum);
            attn_stage_out(lds, wid, lane, O, lsum);
            if (g == 0) lsep[(rowb + (size_t)(m0 + i16) * DIL + rho) * 8 + h] = mx + __log2f(lsum);
            asm volatile("s_waitcnt lgkmcnt(0)" ::: "memory");
            { const int q = lane >> 2, qt = lane & 3; const LAS v4u* sp = (const LAS v4u*)(lds + AT_OST + wid * 2048 + q * 128 + qt * 32);
              const v4u x0 = sp[0], x1 = sp[1]; bf16* dst = op + (rowb + (size_t)(m0 + q) * DIL + rho) * 512 + h * 64 + qt * 16;
              *(v4u*)dst = x0; *(v4u*)(dst + 8) = x1; }
            asm volatile("s_waitcnt lgkmcnt(0)" ::: "memory");
            if (NBUF == 1) { qf[0] = qn[0]; qf[1] = qn[1]; }
        }
        if (NBUF == 1 && item + G < NITEM) issue(item + G, wid);
        buf ^= (NBUF - 1);
    }
    __syncthreads();
}
__device__ __forceinline__ void attn_p1_phase(const Args& a, LAS unsigned char* lds, int vcu, int G, int tid, int wid, int lane) {
    unsigned char* ws = a.ws;
    LAS unsigned char* Kimg = lds; LAS unsigned char* Vimg = lds + 384 * 128;
    const GAS bf16* qa = (const GAS bf16*)(ws + WS_QA); const GAS bf16* ka = (const GAS bf16*)(ws + WS_KA); const GAS bf16* va = (const GAS bf16*)(ws + WS_VA);
    const GAS bf16* o2 = (const GAS bf16*)(ws + WS_O2); const GAS bf16* o3 = (const GAS bf16*)(ws + WS_O3);
    const GAS float* lse2 = (const GAS float*)(ws + WS_LSE2); const GAS float* lse3 = (const GAS float*)(ws + WS_LSE3);
    bf16* oa = (bf16*)(ws + WS_OA);
    if (vcu >= 1024) return;
    const int h = vcu & 7;
    float biasr[36]; attn_load_bias(a, 0, h, lane, biasr);
    const AttnLane L = attn_lane(lane);
    const int g = lane >> 4, i16 = lane & 15;
    LAS float* scr = (LAS float*)(lds + AT_SCR) + wid * 16;
    v4u kq[6], vq[6];
    auto issue = [&](int item) { const int b = item >> 6, s0 = ((item >> 3) & 7) * 256; const size_t rowb = (size_t)b * SEQ;
#pragma unroll
        for (int j = 0; j < 6; ++j) { const int id = tid + 512 * j, row = id >> 3, c = id & 7, pos = s0 - 64 + row; const bool ok = pos >= 0 && pos < SEQ;
            const size_t go = (rowb + (size_t)(ok ? pos : 0)) * 512 + h * 64 + c * 8;
            kq[j] = *(const GAS v4u*)(ka + go); vq[j] = *(const GAS v4u*)(va + go);
            if (!ok) { kq[j] = (v4u){0u, 0u, 0u, 0u}; vq[j] = (v4u){0u, 0u, 0u, 0u}; } } };
    issue(vcu);
    for (int item = vcu; item < 1024; item += G) {
        const int b = item >> 6, s0 = ((item >> 3) & 7) * 256; const size_t rowb = (size_t)b * SEQ;
        __syncthreads();
#pragma unroll
        for (int j = 0; j < 6; ++j) { const int id = tid + 512 * j, row = id >> 3, c = id & 7;
            *(LAS v4u*)(Kimg + kimg_off(row, c)) = kq[j]; *(LAS v4u*)(Vimg + vimg_off(row, c)) = vq[j]; }
        __syncthreads();
        if (item + G < 1024) issue(item + G);
        for (int gi = wid; gi < 16; gi += 8) {
            const int m0 = s0 + 16 * gi;
            const int q = lane >> 2, qt = lane & 3; const size_t tq = rowb + m0 + q;
            const v4u a20 = *(const GAS v4u*)(o2 + tq * 512 + h * 64 + qt * 16), a21 = *(const GAS v4u*)(o2 + tq * 512 + h * 64 + qt * 16 + 8);
            const v4u a30 = *(const GAS v4u*)(o3 + tq * 512 + h * 64 + qt * 16), a31 = *(const GAS v4u*)(o3 + tq * 512 + h * 64 + qt * 16 + 8);
            const float l2 = lse2[tq * 8 + h], l3 = lse3[tq * 8 + h];
            bf16x8 qf[2];
#pragma unroll
            for (int s = 0; s < 2; ++s) qf[s] = *(const GAS bf16x8*)(qa + (rowb + m0 + i16) * 512 + h * 64 + 32 * s + 8 * g);
            unsigned tvalid = 0u;
#pragma unroll
            for (int kt = 0; kt < 9; ++kt) { const int t0 = m0 - 64 + 16 * kt; tvalid |= (t0 >= 0 && t0 < SEQ) ? (1u << kt) : 0u; }
            f32x4 O[4]; float mx, lsum;
            attn_core(Kimg, Vimg, 16 * gi, 384, tvalid, qf, biasr, L, O, mx, lsum);
            attn_stage_out(lds, wid, lane, O, lsum);
            if (g == 0) scr[i16] = mx + __log2f(lsum);
            asm volatile("s_waitcnt lgkmcnt(0)" ::: "memory");
            {
                const float l1 = scr[q], M = fmaxf(l1, fmaxf(l2, l3));
                float w1 = __builtin_amdgcn_exp2f(l1 - M), w2 = __builtin_amdgcn_exp2f(l2 - M), w3 = __builtin_amdgcn_exp2f(l3 - M); const float wi = 1.f / (w1 + w2 + w3); w1 *= wi; w2 *= wi; w3 *= wi;
                const LAS v4u* sp = (const LAS v4u*)(lds + AT_OST + wid * 2048 + q * 128 + qt * 32);
                const v4u x0 = sp[0], x1 = sp[1];
                v4u r0, r1;
#define MRG(d, x, y, z) d = cvtpk(w1 * bflo(x) + w2 * bflo(y) + w3 * bflo(z), w1 * bfhi(x) + w2 * bfhi(y) + w3 * bfhi(z))
                MRG(r0.x, x0.x, a20.x, a30.x); MRG(r0.y, x0.y, a20.y, a30.y); MRG(r0.z, x0.z, a20.z, a30.z); MRG(r0.w, x0.w, a20.w, a30.w);
                MRG(r1.x, x1.x, a21.x, a31.x); MRG(r1.y, x1.y, a21.y, a31.y); MRG(r1.z, x1.z, a21.z, a31.z); MRG(r1.w, x1.w, a21.w, a31.w);
#undef MRG
#if MIX_FP8 & 2
                v4u o8;
                o8.x = pk_fp8x4(16.f * bflo(r0.x), 16.f * bfhi(r0.x), 16.f * bflo(r0.y), 16.f * bfhi(r0.y)); o8.y = pk_fp8x4(16.f * bflo(r0.z), 16.f * bfhi(r0.z), 16.f * bflo(r0.w), 16.f * bfhi(r0.w));
                o8.z = pk_fp8x4(16.f * bflo(r1.x), 16.f * bfhi(r1.x), 16.f * bflo(r1.y), 16.f * bfhi(r1.y)); o8.w = pk_fp8x4(16.f * bflo(r1.z), 16.f * bfhi(r1.z), 16.f * bflo(r1.w), 16.f * bfhi(r1.w));
                *(v4u*)((unsigned char*)oa + tq * 512 + h * 64 + qt * 16) = o8;
#else
                bf16* dst = oa + tq * 512 + h * 64 + qt * 16;
                *(v4u*)dst = r0; *(v4u*)(dst + 8) = r1;
#endif
            }
            asm volatile("s_waitcnt lgkmcnt(0)" ::: "memory");
        }
    }
    __syncthreads();
}

#define OPAQUE(x) asm volatile("" : "+v"(x))
template <int VAR = 0> __device__ __forceinline__ void p3_phase(const Args& a, LAS unsigned char* lds, int vcu, int G, int tid, int wid, int lane) {
    unsigned char* ws = a.ws;
    const int g = lane >> 4, i16 = lane & 15, q4 = i16 >> 2, p = lane & 3;
    const GAS bf16* qr = (const GAS bf16*)(ws + WS_QR); const GAS bf16* kr = (const GAS bf16*)(ws + WS_KR); const GAS bf16* vr = (const GAS bf16*)(ws + WS_VR);
    GAS bf16* gr = (GAS bf16*)(ws + WS_GR);
    LAS unsigned char* Kt = lds; LAS unsigned char* Sg = lds + 32768;
    if (vcu >= 1024) return;
    const unsigned kdst = offb(tid >> 4, tid & 15);
    unsigned rfo[4];
    { const unsigned X = ((i16 & 3) << 2) | (i16 >> 2);
#pragma unroll
      for (int s = 0; s < 4; ++s) rfo[s] = 256 * i16 + 16 * (((4 * s) ^ (X & 12)) | (g ^ (X & 3))); }
    v4u sreg[8], kreg[4]; bf16x8 qn[4];
    auto item_ptrs = [&](int item, size_t& tok0, const GAS bf16*& sf, int& h) { const int b = item >> 6; h = (item >> 4) & 3; const int n = item & 15; tok0 = (size_t)b * SEQ + n * 128;
        sf = (const GAS bf16*)a.out + ((((size_t)(b * 4 + h) * 16 + n) * 2 + 0) * 256) * 128; };
    auto issue_k = [&](int item) { size_t tok0; const GAS bf16* sf; int h; item_ptrs(item, tok0, sf, h);
        const GAS bf16* ks_ = kr + (tok0 + (tid >> 4)) * 512 + h * 128 + (tid & 15) * 8;
#pragma unroll
        for (int j = 0; j < 4; ++j) kreg[j] = *(const GAS v4u*)(ks_ + (size_t)j * 32 * 512); };
    auto issue_q = [&](int item) { size_t tok0; const GAS bf16* sf; int h; item_ptrs(item, tok0, sf, h);
#pragma unroll
        for (int s = 0; s < 4; ++s) qn[s] = *(const GAS bf16x8*)(qr + (tok0 + 16 * wid + i16) * 512 + h * 128 + 32 * s + 8 * g); };
    auto issue_state = [&](const GAS bf16* sf, int dirn) { const GAS bf16* sld = sf + (size_t)dirn * 256 * 128 + (size_t)(tid >> 4) * 128 + (tid & 15) * 8;
#pragma unroll
        for (int j = 0; j < 8; ++j) sreg[j] = *(const GAS v4u*)(sld + (size_t)j * 32 * 128); };
    auto write_state = [&]() {
#pragma unroll
        for (int j = 0; j < 8; ++j) *(LAS v4u*)(Sg + (j >> 2) * 32768 + kdst + (j & 3) * 8192) = sreg[j]; };
    { size_t tok0; const GAS bf16* sf; int h; item_ptrs(vcu, tok0, sf, h); issue_k(vcu); issue_q(vcu); issue_state(sf, 0); }
#pragma unroll
    for (int j = 0; j < 4; ++j) *(LAS v4u*)(Kt + kdst + j * 8192) = kreg[j];
    for (int item = vcu; item < 1024; item += G) {
        size_t tok0; const GAS bf16* sf; int h; item_ptrs(item, tok0, sf, h);
        const float lf2 = log2_gamma(a.in[2], h), lb2 = log2_gamma(a.in[3], h);
        bf16x8 qf[4];
#pragma unroll
        for (int s = 0; s < 4; ++s) qf[s] = qn[s];
        const bool has_next = item + G < 1024;
        __syncthreads();
        f32x4 D[8];
#pragma unroll
        for (int jt = 0; jt < 8; ++jt) {
            f32x4 d = (f32x4){0.f, 0.f, 0.f, 0.f};
#pragma unroll
            for (int s = 0; s < 4; ++s) { if (VAR != 1) { const bf16x8 kf = *(const LAS bf16x8*)(Kt + rfo[s] + jt * 4096); d = MFMA16(kf, qf[s], d); } else d[s] = __builtin_bit_cast(float, (int)qf[s][0]); }
            D[jt] = d;
        }
        int iq = 16 * wid + i16; OPAQUE(iq);
        bf16x8 pf[4];
#pragma unroll
        for (int ks = 0; ks < 4; ++ks) {
            float e[8];
#pragma unroll
            for (int t = 0; t < 2; ++t)
#pragma unroll
                for (int r = 0; r < 4; ++r) {
                    const int j = 16 * (2 * ks + t) + 4 * g + r; const float fdf = (float)(iq - j), ad = fabsf(fdf);
                    const float pos = fminf(fmaxf(fdf, 0.f), 1.f), isz = 1.f - fminf(ad, 1.f);
                    const float w = __builtin_amdgcn_exp2f((lb2 + (lf2 - lb2) * pos) * ad) + isz;
                    e[4 * t + r] = D[2 * ks + t][r] * w;
                }
            v4u pw; pw.x = cvtpk(e[0], e[1]); pw.y = cvtpk(e[2], e[3]); pw.z = cvtpk(e[4], e[5]); pw.w = cvtpk(e[6], e[7]);
            pf[ks] = __builtin_bit_cast(bf16x8, pw);
        }
        f32x4 acc[16];
#pragma unroll
        for (int vt = 0; vt < 16; ++vt) acc[vt] = (f32x4){0.f, 0.f, 0.f, 0.f};
#pragma unroll
        for (int dirn = 0; dirn < 2; ++dirn) {
            if (dirn == 1) __syncthreads();
            write_state();
            if (dirn == 0) { issue_state(sf, 1); if (has_next) issue_k(item + G); }
            else {
                if (has_next) {
#pragma unroll
                    for (int j = 0; j < 4; ++j) *(LAS v4u*)(Kt + kdst + j * 8192) = kreg[j]; }
                const GAS bf16* vs_ = vr + (tok0 + (tid >> 5)) * 1024 + h * 256 + (tid & 31) * 8;
#pragma unroll
                for (int j = 0; j < 8; ++j) sreg[j] = *(const GAS v4u*)(vs_ + (size_t)j * 16 * 1024);
            }
            __syncthreads();
#pragma unroll
            for (int vt = 0; vt < 16; ++vt) {
#pragma unroll
                for (int s = 0; s < 4; ++s) { if (VAR != 1) { const bf16x8 sfr = *(const LAS bf16x8*)(Sg + (vt >> 3) * 32768 + rfo[s] + (vt & 7) * 4096); acc[vt] = MFMA16(qf[s], sfr, acc[vt]); } }
            }
            float xs[4];
            { int ib = 16 * wid + 4 * g; OPAQUE(ib);
#pragma unroll
              for (int r = 0; r < 4; ++r) { const float lxf = lf2 * (float)(ib + r + 1), lxb = lb2 * (float)(128 - ib - r); xs[r] = __builtin_amdgcn_exp2f(dirn == 0 ? lxf - lxb : lxb); } }
#pragma unroll
            for (int vt = 0; vt < 16; ++vt)
#pragma unroll
                for (int r = 0; r < 4; ++r) acc[vt][r] *= xs[r];
        }
        __syncthreads();
        { int t2 = tid; OPAQUE(t2); const unsigned vd2 = (unsigned)((t2 & 31) >> 4) * 32768u + offb(t2 >> 5, t2 & 15);
#pragma unroll
          for (int j = 0; j < 8; ++j) *(LAS v4u*)(Sg + vd2 + j * 4096) = sreg[j]; }
        GAS bf16* gp = gr + (tok0 + 16 * wid + (lane >> 5)) * 1024 + h * 256 + (lane & 31) * 8;
#if MIX_FP8 & 4
        GAS unsigned char* ar8 = (GAS unsigned char*)(ws + WS_AR8) + (tok0 + 16 * wid + (lane >> 5)) * 1024 + h * 256 + (lane & 31) * 8;
#endif
        __syncthreads();
        unsigned vbs[8];
        { int l2 = lane; OPAQUE(l2); const unsigned g2 = l2 >> 4, q2 = (l2 & 15) >> 2, p2 = l2 & 3, X = (q2 << 2) | g2;
#pragma unroll
          for (int c = 0; c < 8; ++c) vbs[c] = 256 * (4 * g2 + q2) + 16 * (((2 * c) ^ (X & 14)) | ((p2 >> 1) ^ (X & 1))) + 8 * (p2 & 1); }
#pragma unroll
        for (int vt = 0; vt < 16; ++vt) {
#pragma unroll
            for (int ks = 0; ks < 4; ++ks) { if (VAR != 1) {
                const s16x4 lo = ldtr(Sg + vbs[vt & 7] + (vt >> 3) * 32768 + ks * 8192), hi = ldtr(Sg + vbs[vt & 7] + (vt >> 3) * 32768 + ks * 8192 + 4096);
                acc[vt] = MFMA16(pf[ks], cat8(lo, hi), acc[vt]); }
            }
            asm volatile("" ::: "memory");
        }
        float mu[4], rs[4];
#pragma unroll
        for (int r = 0; r < 4; ++r) {
            float s = 0.f;
#pragma unroll
            for (int vt = 0; vt < 16; ++vt) s += acc[vt][r];
            s += __shfl_xor(s, 1); s += __shfl_xor(s, 2); s += __shfl_xor(s, 4); s += __shfl_xor(s, 8);
            const float m = s * (1.f / 256.f); float qv = 0.f;
#pragma unroll
            for (int vt = 0; vt < 16; ++vt) { const float d = acc[vt][r] - m; qv += d * d; }
            qv += __shfl_xor(qv, 1); qv += __shfl_xor(qv, 2); qv += __shfl_xor(qv, 4); qv += __shfl_xor(qv, 8);
            mu[r] = m; rs[r] = 1.f / sqrtf(qv * (1.f / 256.f) + LN_EPSF);
        }
        v4u greg[8];
#pragma unroll
        for (int j = 0; j < 8; ++j) greg[j] = *(const GAS v4u*)(gp + (size_t)j * 2048);
        __syncthreads();
        if (has_next) { size_t tk; const GAS bf16* sfn; int hn; item_ptrs(item + G, tk, sfn, hn); issue_state(sfn, 0); issue_q(item + G); }
        LAS bf16* st = (LAS bf16*)(Sg + wid * 8192);
        { LAS bf16* sp_ = st + (4 * g) * 256 + i16;
#pragma unroll
          for (int vt = 0; vt < 16; ++vt)
#pragma unroll
              for (int r = 0; r < 4; ++r) sp_[r * 256 + 16 * vt] = (bf16)(cvtpk((acc[vt][r] - mu[r]) * rs[r], 0.f) & 0xffffu); }
        asm volatile("s_waitcnt lgkmcnt(0)" ::: "memory");
        {
            const float* gn = a.in[4] + h * 256; const int ch = lane & 31;
            const f32x4 g0 = *(const f32x4*)(gn + ch * 8), g1 = *(const f32x4*)(gn + ch * 8 + 4);
            const LAS bf16* yp = st + (lane >> 5) * 256 + ch * 8;
#pragma unroll
            for (int j = 0; j < 8; ++j) {
                const v4u y = *(const LAS v4u*)(yp + j * 512); const v4u sg = greg[j];
                v4u o; o.x = cvtpk(bflo(y.x) * g0[0] * bflo(sg.x), bfhi(y.x) * g0[1] * bfhi(sg.x)); o.y = cvtpk(bflo(y.y) * g0[2] * bflo(sg.y), bfhi(y.y) * g0[3] * bfhi(sg.y));
                o.z = cvtpk(bflo(y.z) * g1[0] * bflo(sg.z), bfhi(y.z) * g1[1] * bfhi(sg.z)); o.w = cvtpk(bflo(y.w) * g1[2] * bflo(sg.w), bfhi(y.w) * g1[3] * bfhi(sg.w));
#if MIX_FP8 & 4
                u32x2 o8; o8.x = pk_fp8x4(bflo(o.x), bfhi(o.x), bflo(o.y), bfhi(o.y)); o8.y = pk_fp8x4(bflo(o.z), bfhi(o.z), bflo(o.w), bfhi(o.w));
                *(GAS u32x2*)(ar8 + (size_t)j * 2048) = o8;
#else
                *(GAS v4u*)(gp + (size_t)j * 2048) = o;
#endif
            }
        }
        __syncthreads();
    }
}

constexpr int P6_RS = 81920, P6_CNT = P6_RS + 8 * 512, P6_BASE = P6_CNT + 64, P6_ROW = P6_BASE + 64;
#define P6_BUTTERFLY(lg, out) do { float r10[10], r5[5], r3[3], r2[2]; const float z = 0.f; \
    _Pragma("unroll") for (int k = 0; k < 10; ++k) { const float keep = h32 ? lg[10 + k] : lg[k], send = h32 ? lg[k] : lg[10 + k]; r10[k] = keep + __shfl_xor(send, 32); } \
    _Pragma("unroll") for (int k = 0; k < 5; ++k) { const float keep = h16 ? r10[5 + k] : r10[k], send = h16 ? r10[k] : r10[5 + k]; r5[k] = keep + __shfl_xor(send, 16); } \
    { const float keep = h8 ? r5[3] : r5[0], send = h8 ? r5[0] : r5[3]; r3[0] = keep + __shfl_xor(send, 8); } \
    { const float keep = h8 ? r5[4] : r5[1], send = h8 ? r5[1] : r5[4]; r3[1] = keep + __shfl_xor(send, 8); } \
    { const float keep = h8 ? z : r5[2], send = h8 ? r5[2] : z; r3[2] = keep + __shfl_xor(send, 8); } \
    { const float keep = h4 ? r3[2] : r3[0], send = h4 ? r3[0] : r3[2]; r2[0] = keep + __shfl_xor(send, 4); } \
    { const float keep = h4 ? z : r3[1], send = h4 ? r3[1] : z; r2[1] = keep + __shfl_xor(send, 4); } \
    { const float keep = h2 ? r2[1] : r2[0], send = h2 ? r2[0] : r2[1]; out = keep + __shfl_xor(send, 2); } \
    out += __shfl_xor(out, 1); } while (0)
__device__ __forceinline__ void p6a_phase(const Args& a, LAS unsigned char* lds, int vcu, int G, int tid, int wave, int lane) {
    unsigned char* ws = a.ws;
    LAS float* RW = (LAS float*)lds;
    LAS float* RS = (LAS float*)(lds + P6_RS) + wave * 128;
    LAS unsigned* LC = (LAS unsigned*)(lds + P6_CNT); LAS unsigned* LB = (LAS unsigned*)(lds + P6_BASE); LAS unsigned* LR = (LAS unsigned*)(lds + P6_ROW);
    for (int i = tid; i < 1024 * 4; i += 512) { const int c = i >> 2, k = i & 3; RW[k * 1024 + c] = a.in[11][i]; }
    for (int i = tid; i < 1024 * 16; i += 512) { const int c = i >> 4, k = i & 15; RW[(4 + k) * 1024 + c] = a.in[13][i]; }
    const u32x2* pre = (const u32x2*)a.out; u32x2* x1b = (u32x2*)(ws + WS_XB); [[maybe_unused]] unsigned* x1f8 = (unsigned*)(ws + WS_X1F8);
    gu32* ctl = (gu32*)ws;
    int* ltok = (int*)(ws + WS_LTOK); float* tw = (float*)(ws + WS_WSLOT); unsigned* tinfo = (unsigned*)(ws + WS_TINFO);
    const float* g1 = a.in[9]; const float* b1 = a.in[10];
    const bool h32 = (lane & 32) != 0, h16 = (lane & 16) != 0, h8 = (lane & 8) != 0, h4 = (lane & 4) != 0, h2 = (lane & 2) != 0;
#define P6_LOADROW(dst, t_) do { const u32x2* xr_ = pre + (size_t)(t_) * 256 + lane; _Pragma("unroll") for (int j = 0; j < 4; ++j) dst[j] = xr_[64 * j]; } while (0)
#define P6_LN(v, nx, s) do { s = 0.f; _Pragma("unroll") for (int j = 0; j < 4; ++j) { v[j] = (f32x4){bflo(nx[j].x), bfhi(nx[j].x), bflo(nx[j].y), bfhi(nx[j].y)}; s += (v[j].x + v[j].y) + (v[j].z + v[j].w); } } while (0)
#define P6_VAR(v, mean, q) do { q = 0.f; _Pragma("unroll") for (int j = 0; j < 4; ++j) { v[j] = v[j] - mean; q += (v[j].x * v[j].x + v[j].y * v[j].y) + (v[j].z * v[j].z + v[j].w * v[j].w); } } while (0)
#if M1_FP8
#define P6_STORE(v, t_, j) do { u32x2 o_; o_.x = cvtpk(v[j].x, v[j].y); o_.y = cvtpk(v[j].z, v[j].w); x1b[(size_t)(t_) * 256 + lane + 64 * j] = o_; x1f8[(size_t)(t_) * 256 + lane + 64 * j] = pk_fp8x4(v[j].x, v[j].y, v[j].z, v[j].w); } while (0)
#else
#define P6_STORE(v, t_, j) do { u32x2 o_; o_.x = cvtpk(v[j].x, v[j].y); o_.y = cvtpk(v[j].z, v[j].w); x1b[(size_t)(t_) * 256 + lane + 64 * j] = o_; } while (0)
#endif
#define P6_DOT(lg, v, j, k, w) lg[k] += (v[j][0] * w[0] + v[j][1] * w[1]) + (v[j][2] * w[2] + v[j][3] * w[3])
    for (int blk = vcu; blk < TT / 128; blk += G) {
        if (tid < 16) LC[tid] = 0u;
        __syncthreads();
        const int t0 = blk * 128;
        u32x2 nxA[4], nxB[4], nxC[4], nxD[4];
        P6_LOADROW(nxA, t0 + wave); P6_LOADROW(nxB, t0 + wave + 8); P6_LOADROW(nxC, t0 + wave + 16); P6_LOADROW(nxD, t0 + wave + 24);
        for (int rr = 0; rr < 4; ++rr) {
            const int rl0 = wave + 32 * rr, tA = t0 + rl0, tB = tA + 8, tC = tA + 16, tD = tA + 24;
            f32x4 vA[4], vB[4], vC[4], vD[4]; float sA, sB, sC, sD;
            P6_LN(vA, nxA, sA); P6_LN(vB, nxB, sB); P6_LN(vC, nxC, sC); P6_LN(vD, nxD, sD);
            if (rr < 3) { P6_LOADROW(nxA, tA + 32); P6_LOADROW(nxB, tB + 32); P6_LOADROW(nxC, tC + 32); P6_LOADROW(nxD, tD + 32); }
            const float mA = wave_sum(sA) * (1.f / DM), mB = wave_sum(sB) * (1.f / DM), mC = wave_sum(sC) * (1.f / DM), mD = wave_sum(sD) * (1.f / DM);
            float qA, qB, qC, qD;
            P6_VAR(vA, mA, qA); P6_VAR(vB, mB, qB); P6_VAR(vC, mC, qC); P6_VAR(vD, mD, qD);
            const float rA = 1.f / sqrtf(wave_sum(qA) * (1.f / DM) + LN_EPSF), rB = 1.f / sqrtf(wave_sum(qB) * (1.f / DM) + LN_EPSF);
            const float rC = 1.f / sqrtf(wave_sum(qC) * (1.f / DM) + LN_EPSF), rD = 1.f / sqrtf(wave_sum(qD) * (1.f / DM) + LN_EPSF);
            float lgA[20], lgB[20], lgC[20], lgD[20];
#pragma unroll
            for (int k = 0; k < 20; ++k) { lgA[k] = 0.f; lgB[k] = 0.f; lgC[k] = 0.f; lgD[k] = 0.f; }
#pragma unroll
            for (int j = 0; j < 4; ++j) {
                const f32x4 gg = *(const f32x4*)(g1 + 4 * lane + 256 * j), bb = *(const f32x4*)(b1 + 4 * lane + 256 * j);
                vA[j] = vA[j] * rA * gg + bb; vB[j] = vB[j] * rB * gg + bb; vC[j] = vC[j] * rC * gg + bb; vD[j] = vD[j] * rD * gg + bb;
                P6_STORE(vA, tA, j); P6_STORE(vB, tB, j); P6_STORE(vC, tC, j); P6_STORE(vD, tD, j);
#pragma unroll
                for (int k = 0; k < 20; ++k) { const f32x4 w = *(const LAS f32x4*)(RW + k * 1024 + 4 * lane + 256 * j);
                    P6_DOT(lgA, vA, j, k, w); P6_DOT(lgB, vB, j, k, w); P6_DOT(lgC, vC, j, k, w); P6_DOT(lgD, vD, j, k, w); }
            }
            float r1A, r1B, r1C, r1D;
            P6_BUTTERFLY(lgA, r1A); P6_BUTTERFLY(lgB, r1B); P6_BUTTERFLY(lgC, r1C); P6_BUTTERFLY(lgD, r1D);
            {
                const int i3 = h2 ? (h4 ? -1 : 1) : (h4 ? 2 : 0);
                const int i5 = i3 < 0 ? -1 : (h8 ? (i3 == 2 ? -1 : i3 + 3) : i3);
                const int kk = i5 < 0 ? -1 : (h32 ? 10 : 0) + (h16 ? 5 : 0) + i5;
                if (kk >= 0 && (lane & 1) == 0) { RS[kk] = r1A; RS[32 + kk] = r1B; RS[64 + kk] = r1C; RS[96 + kk] = r1D; }
            }
            asm volatile("s_waitcnt lgkmcnt(0)" ::: "memory");
            {
                const int sel = lane & 3; const int rl = rl0 + 8 * sel;
                float tl[20];
#pragma unroll
                for (int k4 = 0; k4 < 5; ++k4) { const f32x4 w = *(const LAS f32x4*)(RS + sel * 32 + 4 * k4); tl[4 * k4] = w[0]; tl[4 * k4 + 1] = w[1]; tl[4 * k4 + 2] = w[2]; tl[4 * k4 + 3] = w[3]; }
                float gl[4];
#pragma unroll
                for (int k = 0; k < 4; ++k) gl[k] = tl[k] + a.in[12][k];
                int gi = 0; float gm = gl[0];
#pragma unroll
                for (int k = 1; k < 4; ++k) if (gl[k] > gm) { gm = gl[k]; gi = k; }
                float gs = 0.f;
#pragma unroll
                for (int k = 0; k < 4; ++k) gs += __expf(gl[k] - gm);
                const float gwt = 1.f / gs;
                float el[4];
#pragma unroll
                for (int k = 0; k < 4; ++k) { const float se = gi == 0 ? tl[4 + k] : (gi == 1 ? tl[8 + k] : (gi == 2 ? tl[12 + k] : tl[16 + k])); el[k] = se + a.in[14][4 * gi + k]; }
                int i1 = 0; float v1 = el[0];
#pragma unroll
                for (int k = 1; k < 4; ++k) if (el[k] > v1) { v1 = el[k]; i1 = k; }
                int i2 = (i1 + 1) & 3; float v2 = -3.0e38f;
#pragma unroll
                for (int k = 0; k < 4; ++k) if (k != i1 && el[k] > v2) { v2 = el[k]; i2 = k; }
                const float ex = __expf(v2 - v1), w1 = gwt / (1.f + ex), w2 = gwt * ex / (1.f + ex);
                if (lane < 4) {
                    const int e1 = 4 * gi + i1, e2 = 4 * gi + i2;
                    const unsigned p1 = __hip_atomic_fetch_add(LC + e1, 1u, __ATOMIC_RELAXED, __HIP_MEMORY_SCOPE_WORKGROUP);
                    const unsigned p2 = __hip_atomic_fetch_add(LC + e2, 1u, __ATOMIC_RELAXED, __HIP_MEMORY_SCOPE_WORKGROUP);
                    LR[rl * 4 + 0] = ((unsigned)e1 << 16) | p1; LR[rl * 4 + 1] = ((unsigned)e2 << 16) | p2; LR[rl * 4 + 2] = __float_as_uint(w1); LR[rl * 4 + 3] = __float_as_uint(w2);
                }
            }
            asm volatile("s_waitcnt lgkmcnt(0)" ::: "memory");
        }
        __syncthreads();
        if (tid < 16) LB[tid] = __hip_atomic_fetch_add(ctl + CW_CNT + 64 * tid, LC[tid], __ATOMIC_RELAXED, __HIP_MEMORY_SCOPE_AGENT);
        __syncthreads();
        if (tid < 256) {
            const int rl = tid >> 1, j = tid & 1; const unsigned rec = LR[rl * 4 + j]; const unsigned e = rec >> 16, pos = LB[e] + (rec & 0xffffu);
            ltok[e * TT + pos] = t0 + rl; tw[2 * (t0 + rl) + j] = __uint_as_float(LR[rl * 4 + 2 + j]); tinfo[2 * (t0 + rl) + j] = (e << 16) | pos;
        }
        __syncthreads();
    }
#undef P6_LOADROW
#undef P6_LN
#undef P6_VAR
#undef P6_STORE
#undef P6_DOT
}
__device__ __forceinline__ void build_tile_tables(const Args& a, LAS unsigned char* lds, int tid) {
    LAS int* ts = (LAS int*)(lds + LDS_TS_OFF); LAS int* te = (LAS int*)(lds + LDS_TE_OFF); LAS int* cn = (LAS int*)(lds + LDS_CNT_OFF);
    gu32* ctl = (gu32*)a.ws;
    if (tid == 0) { int acc = 0;
        for (int e = 0; e < 16; ++e) { ts[e] = acc; const int c = (int)__hip_atomic_load(ctl + CW_CNT + 64 * e, __ATOMIC_RELAXED, __HIP_MEMORY_SCOPE_AGENT); const int nt = (c + 255) >> 8; cn[e] = c;
            for (int k = 0; k < nt; ++k) te[acc + k] = e; acc += nt; }
        ts[16] = acc; }
    __syncthreads();
}
__device__ __forceinline__ void p9_phase(const Args& a, LAS unsigned char* lds, int vcu, int G, int wave, int lane) {
    unsigned char* ws = a.ws;
    const LAS int* ts = (const LAS int*)(lds + LDS_TS_OFF);
    const unsigned* tinfo = (const unsigned*)(ws + WS_TINFO); const u32x2* Y = (const u32x2*)(ws + WS_Y);
    const float* g2 = a.in[18]; const float* b2 = a.in[19];
    const int gw = vcu * NWAVES + wave, NGW = G * NWAVES;
#if Y_FP8
    const unsigned* Y8 = (const unsigned*)(ws + WS_Y); unsigned ny0[4], ny1[4]; u32x2 nxw[4]; float nw0 = 0.f, nw1 = 0.f;
#else
    u32x2 ny0[4], ny1[4], nxw[4]; float nw0 = 0.f, nw1 = 0.f;
#endif
    const float* tw = (const float*)(ws + WS_WSLOT);
    auto issue = [&](int t) {
        const unsigned i0 = tinfo[2 * t], i1 = tinfo[2 * t + 1];
        nw0 = tw[2 * t]; nw1 = tw[2 * t + 1];
        const size_t s0 = (size_t)ts[i0 >> 16] * 256 + (i0 & 0xffffu), s1 = (size_t)ts[i1 >> 16] * 256 + (i1 & 0xffffu);
        const u32x2* xb1 = (const u32x2*)(ws + WS_XB) + (size_t)t * 256 + lane;
#pragma unroll
#if Y_FP8
        for (int j = 0; j < 4; ++j) { ny0[j] = Y8[s0 * 256 + lane + 64 * j]; ny1[j] = Y8[s1 * 256 + lane + 64 * j]; nxw[j] = xb1[64 * j]; }
#else
        for (int j = 0; j < 4; ++j) { ny0[j] = Y[s0 * 256 + lane + 64 * j]; ny1[j] = Y[s1 * 256 + lane + 64 * j]; nxw[j] = xb1[64 * j]; }
#endif
    };
    if (gw < TT) issue(gw);
    for (int t = gw; t < TT; t += NGW) {
        f32x4* xr = (f32x4*)(a.out + (size_t)t * DM) + lane;
#if Y_FP8
        f32x4 v[4]; float s = 0.f; const float w0 = nw0 * 0.0625f, w1 = nw1 * 0.0625f;
#pragma unroll
        for (int j = 0; j < 4; ++j) {
            const unsigned y0 = ny0[j], y1 = ny1[j]; const u32x2 xw = nxw[j];
            typedef float f32x2_ __attribute__((ext_vector_type(2)));
            const f32x2_ a0 = __builtin_amdgcn_cvt_pk_f32_fp8(y0, false), a1 = __builtin_amdgcn_cvt_pk_f32_fp8(y0, true), c0 = __builtin_amdgcn_cvt_pk_f32_fp8(y1, false), c1 = __builtin_amdgcn_cvt_pk_f32_fp8(y1, true);
            f32x4 x = (f32x4){bflo(xw.x), bfhi(xw.x), bflo(xw.y), bfhi(xw.y)} * DN_ALPHA;
            x.x += w0 * a0[0] + w1 * c0[0]; x.y += w0 * a0[1] + w1 * c0[1]; x.z += w0 * a1[0] + w1 * c1[0]; x.w += w0 * a1[1] + w1 * c1[1];
            v[j] = x; s += (x.x + x.y) + (x.z + x.w);
        }
#else
        f32x4 v[4]; float s = 0.f; const float w0 = nw0, w1 = nw1;
#pragma unroll
        for (int j = 0; j < 4; ++j) {
            const u32x2 y0 = ny0[j], y1 = ny1[j], xw = nxw[j];
            f32x4 x = (f32x4){bflo(xw.x), bfhi(xw.x), bflo(xw.y), bfhi(xw.y)} * DN_ALPHA;
            x.x += w0 * bflo(y0.x) + w1 * bflo(y1.x); x.y += w0 * bfhi(y0.x) + w1 * bfhi(y1.x); x.z += w0 * bflo(y0.y) + w1 * bflo(y1.y); x.w += w0 * bfhi(y0.y) + w1 * bfhi(y1.y);
            v[j] = x; s += (x.x + x.y) + (x.z + x.w);
        }
#endif
        if (t + NGW < TT) issue(t + NGW);
        const float mean = wave_sum(s) * (1.f / DM); float s2 = 0.f;
#pragma unroll
        for (int j = 0; j < 4; ++j) { v[j] = v[j] - mean; s2 += (v[j].x * v[j].x + v[j].y * v[j].y) + (v[j].z * v[j].z + v[j].w * v[j].w); }
        const float rstd = 1.f / sqrtf(wave_sum(s2) * (1.f / DM) + LN_EPSF);
#pragma unroll
        for (int j = 0; j < 4; ++j) { const f32x4 gg = *(const f32x4*)(g2 + 4 * lane + 256 * j), bb = *(const f32x4*)(b2 + 4 * lane + 256 * j); xr[64 * j] = v[j] * rstd * gg + bb; }
    }
}

__global__ void __launch_bounds__(NWAVES * 64, 2) mega_fwd(Args args) {
    extern __shared__ __attribute__((aligned(16))) unsigned char lds_raw[];
    LAS unsigned char* lds = (LAS unsigned char*)lds_raw;
    volatile LAS unsigned* MISC = (volatile LAS unsigned*)(lds + MISC_OFF);
    const int tid0 = threadIdx.x, wave = __builtin_amdgcn_readfirstlane(tid0 >> 6);
    const int G = gridDim.x, bx = blockIdx.x, vcu = (G % 8 == 0) ? (bx % 8) * (G / 8) + bx / 8 : bx;
    for (int u = tid0; u < (LDS_BYTES - LDSCTL_OFF) / 4; u += NWAVES * 64) ((LAS unsigned*)(lds + LDSCTL_OFF))[u] = 0u;
    __syncthreads();
    unsigned char* ws = args.ws;
    gu32* ctl = (gu32*)ws;
    const bool bars_on = (args.mask >> 31) != 0u;
    XcdBarrier bar; bar.bar = (unsigned*)(ctl + CW_BAR) + args.bar_region * XCD_BAR_WORDS; bar.x = 0; bar.st = nullptr;
    if (bars_on) bar = xcd_barrier_post((unsigned*)(ctl + CW_BAR) + args.bar_region * XCD_BAR_WORDS, MISC + 8);
    bar.wv = wave;
#define GRID_BAR() do { if (bars_on) xcd_barrier(bar); } while (0)
#ifndef PH_LAST
#define PH_LAST 99
#endif
#define FRESH() int tid = wave * 64 + pg8::lane_id(); asm volatile("" : "+v"(tid)); const int lane = tid & 63; (void)lane
#ifndef RMASK
#define RMASK 0
#endif
#define REP(k) _Pragma("unroll") for (int rep_ = 0; rep_ < 1 + ((RMASK >> (k)) & 1); ++rep_)
#ifndef STAMP_SCALE
#define STAMP_SCALE 1.0f
#endif
#ifdef STAMP_PH
#define ST_B(k) if ((k) == STAMP_PH) { st_a = rt(); }
#define ST_E(k) if ((k) == STAMP_PH) { st_b = rt(); }
#else
#define ST_B(k)
#define ST_E(k)
#endif
#ifdef ONLY
#define EN(k) (ONLY == (k))
#else
#define EN(k) ((args.mask >> (k)) & 1u)
#endif
    unsigned long long st_a = 0, st_b = 0; (void)st_a; (void)st_b;
    REP(0) if (EN(0)) { FRESH(); p0_prologue(args, lds, vcu, G, tid, wave, lane); }
    GRID_BAR();
#ifdef STAGGER_TICKS
    if (EN(1) && (bx & 8)) { const unsigned long long t0_ = rt(); while (rt() - t0_ < STAGGER_TICKS) __builtin_amdgcn_s_sleep(32); }
#endif
    REP(1) if (EN(1)) {
#if P1_FP8
        pg8::EpiHcat E{ws, (const float*)(ws + WS_ROT), 0};
        if (P1_FP8_FROM > 0) {
            pg8::Gemm g{(const pg8::bf16_t*)(ws + WS_XB), (const pg8::bf16_t*)(ws + WS_WIN), TT, 4608, 1024}; pg8::StaticOrder S; S.init(TT, 256 * P1_FP8_FROM, G, bx);
            pg8::gemm_phase<pg8::EpiHcat, pg8::StaticOrder, true, true>(lds, g, S, E, wave);
        }
        {
#if GATE_FP8
            pg8::Gemm g{(const pg8::bf16_t*)(ws + WS_X8_LO), (const pg8::bf16_t*)(ws + WS_WIN8), TT, 4608, 512, 64, (long)WS_X8_HI - (long)WS_X8_LO - (long)(16 * MiB)}; pg8::StaticOrder S;
#else
            pg8::Gemm g{(const pg8::bf16_t*)args.out, (const pg8::bf16_t*)(ws + WS_WIN8), TT, 4608, 512}; pg8::StaticOrder S;
#endif
            S.init(TT, 4608 - 256 * P1_FP8_FROM, G, bx, P1_FP8_FROM);
#if CONV_BG
            pg8::P1Order SB; SB.S = S; SB.cv = pg8::ExpertConv{args.in[15], args.in[16], args.in[17], ws + WS_WGU, ws + WS_WD, vcu * NWAVES + wave, G * NWAVES, vcu % 9};
            pg8::gemm_phase<pg8::EpiHcat, pg8::P1Order, true, true, false, true, 1, 0>(lds, g, SB, E, wave);
            { FRESH();
              for (int k = 0; SB.cv.gw + k * SB.cv.nw < 6144; ++k) { pg8::Unit tu; const bool in_gap = k < 3 && S.next(pg8::P1Order::unit_of(SB.cv.grp, k), tu) && pg8::P1Order::unit_of(SB.cv.grp, k) < 9;
                  if (!in_gap) pg8::expert_conv_item(SB.cv, k, lane); } }
#else
            pg8::gemm_phase<pg8::EpiHcat, pg8::StaticOrder, true, true, false, true, 1, 0>(lds, g, S, E, wave);
#endif
        }
#else
        pg8::Gemm g{(const pg8::bf16_t*)(ws + WS_XB), (const pg8::bf16_t*)(ws + WS_WIN), TT, 4608, 1024}; pg8::StaticOrder S; S.init(TT, 4608, G, bx);
        pg8::EpiHcat E{ws, (const float*)(ws + WS_ROT), 0};
        pg8::gemm_phase<pg8::EpiHcat, pg8::StaticOrder, true, true>(lds, g, S, E, wave);
#endif
    }
    GRID_BAR();
    if (PH_LAST >= 2) {
        REP(2) if (EN(2)) { FRESH(); for (int it = vcu; it < 256; it += G) chain_item(args, lds, it, tid, wave, lane); }
        if (EN(3)) { { FRESH(); attn_dil_phase<16>(args, lds, vcu, G, tid, wave, lane); }
                     { FRESH(); attn_dil_phase<4>(args, lds, vcu, G, tid, wave, lane); } }
    }
    GRID_BAR();
    ST_B(4) if (PH_LAST >= 3 && EN(4)) { FRESH(); p3_phase<0>(args, lds, vcu, G, tid, wave, lane); }
    if (EN(13)) { FRESH(); attn_p1_phase(args, lds, vcu, G, tid, wave, lane); }
    GRID_BAR(); ST_E(4)
#if !CONV_BG
    if (EN(14)) { FRESH(); p0_expert_weights(args, lds, vcu, G, wave, lane); }
#endif
    REP(5) if (PH_LAST >= 4 && EN(5)) {
        pg8::GateOrder S; S.S4.init(TT, 1024, G, bx);
        pg8::EpiHcat E{ws, (const float*)(ws + WS_ROT), 18};
#if GATE_FP8
        pg8::Gemm g{(const pg8::bf16_t*)(ws + WS_X8_LO), (const pg8::bf16_t*)(ws + WS_WIN8 + (size_t)4608 * 1024), TT, 2048, 512, 64, (long)WS_X8_HI - (long)WS_X8_LO - (long)(16 * MiB)};
        pg8::gemm_phase<pg8::EpiHcat, pg8::GateOrder, true, true, false, true, 1, 0>(lds, g, S, E, wave);
#else
        pg8::Gemm g{(const pg8::bf16_t*)(ws + WS_XB), (const pg8::bf16_t*)(ws + WS_WIN) + (size_t)4608 * 1024, TT, 2048, 1024};
        pg8::gemm_phase<pg8::EpiHcat, pg8::GateOrder, true, true>(lds, g, S, E, wave);
#endif
        asm volatile("s_waitcnt vmcnt(0)" ::: "memory"); __syncthreads();
    }
    REP(6) if (PH_LAST >= 5 && EN(6)) {
        pg8::StaticOrder S; S.init(TT, 1024, G, bx);
        { pg8::EpiGate<false> E{(const pg8::bf16_t*)(ws + WS_GATE_A), (pg8::bf16_t*)(ws + WS_MERGED), nullptr};
#if MIX_FP8 & 2
          pg8::Gemm g{(const pg8::bf16_t*)(ws + WS_OA), (const pg8::bf16_t*)(ws + WS_WA), TT, 1024, 256};
          pg8::gemm_phase<pg8::EpiGate<false>, pg8::StaticOrder, true, true, false, true, 1, 3>(lds, g, S, E, wave);
#else
          pg8::Gemm g{(const pg8::bf16_t*)(ws + WS_OA), (const pg8::bf16_t*)(ws + WS_WA), TT, 1024, 512};
          pg8::gemm_phase<pg8::EpiGate<false>, pg8::StaticOrder, true, true>(lds, g, S, E, wave);
#endif
        }
        asm volatile("s_waitcnt vmcnt(0)" ::: "memory"); __syncthreads();
        { typedef pg8::EpiGate<true, (MIX_FP8 & 1) != 0> EpiC;
          EpiC E{(const pg8::bf16_t*)(ws + WS_GATE_R), (pg8::bf16_t*)(ws + WS_MERGED), ws + WS_MERGED8};
#if MIX_FP8 & 4
          pg8::Gemm g{(const pg8::bf16_t*)(ws + WS_AR8), (const pg8::bf16_t*)(ws + WS_WR), TT, 1024, 512};
          pg8::gemm_phase<EpiC, pg8::StaticOrder, true, true, false, true, 1, 0>(lds, g, S, E, wave);
#else
          pg8::Gemm g{(const pg8::bf16_t*)(ws + WS_GR), (const pg8::bf16_t*)(ws + WS_WR), TT, 1024, 1024};
          pg8::gemm_phase<EpiC, pg8::StaticOrder, true, true>(lds, g, S, E, wave);
#endif
        }
    }
    GRID_BAR();
    REP(7) if (PH_LAST >= 6 && EN(7)) {
        pg8::StaticOrder S; S.init(TT, 1024, G, bx);
        pg8::EpiResBf16 E{X_F32_RES ? (const pg8::bf16_t*)args.in[0] : (const pg8::bf16_t*)(ws + WS_XB), (pg8::bf16_t*)args.out, DN_ALPHA};
#if MIX_FP8 & 1
        pg8::Gemm g{(const pg8::bf16_t*)(ws + WS_MERGED8), (const pg8::bf16_t*)(ws + WS_WO), TT, 1024, 512};
        pg8::gemm_phase<pg8::EpiResBf16, pg8::StaticOrder, true, true, false, true, 1, 3>(lds, g, S, E, wave);
#else
        pg8::Gemm g{(const pg8::bf16_t*)(ws + WS_MERGED), (const pg8::bf16_t*)(ws + WS_WO), TT, 1024, 1024};
        pg8::gemm_phase<pg8::EpiResBf16, pg8::StaticOrder, true, true>(lds, g, S, E, wave);
#endif
    }
    GRID_BAR();
    ST_B(8) if (PH_LAST >= 7 && EN(8)) { FRESH(); p6a_phase(args, lds, vcu, G, tid, wave, lane); }
    GRID_BAR(); ST_E(8)
    { FRESH(); build_tile_tables(args, lds, tid); }
    const int nrt = ((const LAS int*)(lds + LDS_TS_OFF))[16];
    REP(10) if (PH_LAST >= 9 && EN(10)) {
#if M1_FP8
        pg8::Gemm g{(const pg8::bf16_t*)(ws + WS_X1F8), (const pg8::bf16_t*)(ws + WS_WGU), MAXSLOT, 1024, 512};
        pg8::MoeOrder S{nrt * 4, G, vcu, (const LAS int*)(lds + LDS_TE_OFF), (const LAS int*)(lds + LDS_TS_OFF), (const LAS int*)(lds + LDS_CNT_OFF), (const int*)(ws + WS_LTOK), 1024u};
        pg8::EpiSwiGLU E{ws + WS_H};
        pg8::gemm_phase<pg8::EpiSwiGLU, pg8::MoeOrder, true, true, true, true, 1, 0>(lds, g, S, E, wave);
#else
        pg8::Gemm g{(const pg8::bf16_t*)(ws + WS_XB), (const pg8::bf16_t*)(ws + WS_WGU), MAXSLOT, 1024, 1024};
        pg8::MoeOrder S{nrt * 4, G, vcu, (const LAS int*)(lds + LDS_TE_OFF), (const LAS int*)(lds + LDS_TS_OFF), (const LAS int*)(lds + LDS_CNT_OFF), (const int*)(ws + WS_LTOK), 2048u};
        pg8::EpiSwiGLU E{ws + WS_H};
        pg8::gemm_phase<pg8::EpiSwiGLU, pg8::MoeOrder, true, true, true>(lds, g, S, E, wave);
#endif
    }
    GRID_BAR();
    REP(11) if (PH_LAST >= 10 && EN(11)) {
        pg8::Gemm g{(const pg8::bf16_t*)(ws + WS_H), (const pg8::bf16_t*)(ws + WS_WD), MAXSLOT, 1024, 256};
        pg8::MoeOrder S{nrt * 4, G, vcu, (const LAS int*)(lds + LDS_TE_OFF), (const LAS int*)(lds + LDS_TS_OFF), (const LAS int*)(lds + LDS_CNT_OFF), (const int*)(ws + WS_LTOK), 1024u};
        pg8::EpiRowScale E{(pg8::bf16_t*)(ws + WS_Y)};
        pg8::gemm_phase<pg8::EpiRowScale, pg8::MoeOrder, true, true, false, true, 1, 2>(lds, g, S, E, wave);
    }
    GRID_BAR();
    ST_B(12) if (PH_LAST >= 11 && EN(12)) { FRESH(); p9_phase(args, lds, vcu, G, wave, lane); }
#ifdef STAMP_PH
    GRID_BAR(); ST_E(12)
    if (STAMP_PH == 13) { st_a = rt(); GRID_BAR(); GRID_BAR(); GRID_BAR(); GRID_BAR(); st_b = rt(); }
    if (bx == 0 && tid0 == 0) { const float us = (float)(st_b - st_a) * 0.01f * STAMP_SCALE; int k = 0; float lim = 30.f; while (us >= lim && k < 12) { lim *= 1.5f; ++k; }
        __hip_atomic_store(ctl + CW_CHK, __float_as_uint(sqrtf(2.f * k + 2.f)), RLX_AGENT); }
    GRID_BAR();
    { const float c = __uint_as_float(__hip_atomic_load(ctl + CW_CHK, RLX_AGENT)); f32x4* o4 = (f32x4*)args.out;
      for (size_t i = (size_t)bx * 512 + tid0; i < (size_t)TT * DM / 4; i += (size_t)G * 512) o4[i] = (f32x4){c, c, c, c}; }
#endif
}

#ifdef PROBE_VAR
__global__ void __launch_bounds__(NWAVES * 64, 2) probe_kernel(Args args) {
    extern __shared__ __attribute__((aligned(16))) unsigned char lds_raw[];
    LAS unsigned char* lds = (LAS unsigned char*)lds_raw;
    const int tid0 = threadIdx.x, wave = __builtin_amdgcn_readfirstlane(tid0 >> 6);
    const int G = gridDim.x, bx = blockIdx.x, vcu = (G % 8 == 0) ? (bx % 8) * (G / 8) + bx / 8 : bx;
    FRESH();
    if (PROBE_VAR >= 20 && PROBE_VAR <= 22) {
        unsigned char* ws = args.ws;
        pg8::Gemm g{(const pg8::bf16_t*)(ws + WS_X8_LO), (const pg8::bf16_t*)(ws + WS_WIN8), TT, 4608, 512, 64, (long)WS_X8_HI - (long)WS_X8_LO - (long)(16 * MiB)}; pg8::StaticOrder S; S.init(TT, 4608, G, bx);
        typedef pg8::EpiHcatT<PROBE_VAR - 20> EpiP;
        EpiP E{ws, (const float*)(ws + WS_ROT), 0};
        pg8::gemm_phase<EpiP, pg8::StaticOrder, true, true, false, true, 1, 0>(lds, g, S, E, wave);
    }
    if (PROBE_VAR == 10) p3_phase<0>(args, lds, vcu, G, tid, wave, lane);
    if (PROBE_VAR == 11) p3_phase<1>(args, lds, vcu, G, tid, wave, lane);
    if (PROBE_VAR == 0) attn_dil_phase<16, 0>(args, lds, vcu, G, tid, wave, lane);
    if (PROBE_VAR == 1) attn_dil_phase<16, 1>(args, lds, vcu, G, tid, wave, lane);
    if (PROBE_VAR == 2) attn_dil_phase<4, 0>(args, lds, vcu, G, tid, wave, lane);
    if (PROBE_VAR == 3) attn_dil_phase<4, 1>(args, lds, vcu, G, tid, wave, lane);
}
#endif
extern "C" void kernel_launch(void* const* d_in, const int* in_sizes, int n_in, void* d_out, int out_size, void* d_ws, size_t ws_size, hipStream_t stream) {
    static int grid = 0;
    if (grid == 0) {
        if (n_in != 20 || in_sizes[0] != TT * DM || out_size != TT * DM || ws_size < WS_END) { fprintf(stderr, "kernel_launch: unexpected shapes: n_in %d in0 %d out %d ws %zu; nothing launched\n", n_in, n_in > 0 ? in_sizes[0] : -1, out_size, ws_size); grid = -1; return; }
        int dev = 0, cus = 0;
        if (hipGetDevice(&dev) != hipSuccess || hipDeviceGetAttribute(&cus, hipDeviceAttributeMultiprocessorCount, dev) != hipSuccess) { grid = -1; return; }
        if (hipFuncSetAttribute((const void*)mega_fwd, hipFuncAttributeMaxDynamicSharedMemorySize, LDS_BYTES) != hipSuccess) { fprintf(stderr, "kernel_launch: hipFuncSetAttribute failed\n"); grid = -1; return; }
        (void)hipGetLastError();
        grid = cus;
    }
    if (grid < 0) return;
    if (hipMemsetAsync((char*)d_ws, 0, CTL_ZERO_BYTES, stream) != hipSuccess) return;
    Args a{};
    for (int i = 0; i < 20; ++i) a.in[i] = (const float*)d_in[i];
    a.out = (float*)d_out; a.ws = (unsigned char*)d_ws; a.mask = 0x80007fffu; a.bar_region = 0;
#if defined(XTRA_FIRST)
    { Args x = a; x.mask = XTRA_FIRST; x.bar_region = 1; for (int r = 0; r < XTRA_REP; ++r) hipLaunchKernelGGL(mega_fwd, dim3(grid), dim3(NWAVES * 64), LDS_BYTES, stream, x);
      if (hipMemsetAsync((char*)d_ws, 0, CTL_ZERO_BYTES, stream) != hipSuccess) return; }
#endif
    hipLaunchKernelGGL(mega_fwd, dim3(grid), dim3(NWAVES * 64), LDS_BYTES, stream, a);
#if defined(PROBE_VAR)
    { hipFuncSetAttribute((const void*)probe_kernel, hipFuncAttributeMaxDynamicSharedMemorySize, LDS_BYTES);
      for (int r = 0; r < 4; ++r) hipLaunchKernelGGL(probe_kernel, dim3(grid), dim3(NWAVES * 64), LDS_BYTES, stream, a); }
#endif
#if defined(XTRA_AFTER)
    { Args x = a; x.mask = XTRA_AFTER; x.bar_region = 1; for (int r = 0; r < XTRA_REP; ++r) hipLaunchKernelGGL(mega_fwd, dim3(grid), dim3(NWAVES * 64), LDS_BYTES, stream, x); }
#endif
}
```

```cpp
#include <hip/hip_runtime.h>
#include <cstdio>
#include <cstdint>

constexpr int TT = 32768, DM = 1024, SEQ = 2048, NB = 16;
constexpr float DN_ALPHA = 1.189207115002721f;
constexpr float LN_EPSF = 1e-5f;
#ifndef M1_FP8
#define M1_FP8 1
#endif
#ifndef P1_FP8
#define P1_FP8 1
#endif
#ifndef SILU_IN_P3
#define SILU_IN_P3 1
#endif
#ifndef CONV_BG
#define CONV_BG 1
#endif
#ifndef Y_FP8
#define Y_FP8 1
#endif
#ifndef GATE_FP8
#define GATE_FP8 1
#endif
#ifndef MIX_FP8
#define MIX_FP8 7
#endif
#ifndef P1_FP8_FROM
#define P1_FP8_FROM 0
#endif
#define X_F32_RES (P1_FP8 && P1_FP8_FROM == 0 && GATE_FP8)
constexpr size_t MiB = 1u << 20;
constexpr size_t CTL_ZERO_BYTES = 1 * MiB;
constexpr size_t WS_ROT = 1 * MiB;
constexpr size_t WS_BIAS = 2 * MiB;
constexpr size_t WS_LTOK = 3 * MiB;
constexpr size_t WS_TINFO = 7 * MiB;
constexpr size_t WS_WSLOT = 7 * MiB + 512 * 1024;
constexpr size_t WS_WIN = 8 * MiB;
constexpr size_t WS_WIN8 = 12 * MiB;
constexpr size_t WS_WR = 21 * MiB;
constexpr size_t WS_WA = 23 * MiB;
constexpr size_t WS_WO = 24 * MiB;
constexpr size_t WS_WGU = 26 * MiB;
constexpr size_t WS_WD = 42 * MiB;
constexpr size_t WS_XB = 80 * MiB;
constexpr size_t WS_QR = 144 * MiB;
constexpr size_t WS_KR = 176 * MiB;
constexpr size_t WS_VR = 208 * MiB;
constexpr size_t WS_GR = 272 * MiB;
constexpr size_t WS_QA = 336 * MiB, WS_KA = 368 * MiB, WS_VA = 400 * MiB, WS_OA = 432 * MiB;
#if MIX_FP8 & 4
constexpr size_t WS_AR8 = 144 * MiB;
constexpr size_t WS_GATE_R = 176 * MiB, WS_GATE_A = 240 * MiB;
#else
constexpr size_t WS_GATE_R = 144 * MiB, WS_GATE_A = 208 * MiB;
#endif
constexpr size_t WS_X8_LO = 448 * MiB, WS_X8_HI = 58 * MiB;
static_assert(M1_FP8, "the workspace map is laid out for fp8 expert weights");
static_assert(!CONV_BG || X_F32_RES, "CONV_BG puts o2 into the bf16 x region");
static_assert(!GATE_FP8 || (P1_FP8 && (MIX_FP8 & 2) && M1_FP8), "GATE_FP8 needs the fp8 mixer-input GEMM, the fp8 o_a (room behind it) and the fp8 expert weights (room behind them)");
constexpr size_t WS_MERGED8 = 464 * MiB;
constexpr size_t WS_MERGED = 336 * MiB;
constexpr size_t WS_Y = 144 * MiB;
constexpr size_t WS_H = 336 * MiB;
constexpr size_t WS_X1F8 = 464 * MiB;
#if CONV_BG
constexpr size_t WS_O2 = 80 * MiB;
#else
constexpr size_t WS_O2 = 26 * MiB;
#endif
constexpr size_t WS_O3 = 464 * MiB;
constexpr size_t WS_LSE2 = 496 * MiB, WS_LSE3 = 497 * MiB;
constexpr size_t WS_END = 512 * MiB;
constexpr int MAXSLOT = 69632;
constexpr int CW_BAR = 4096;
constexpr int CW_CNT = 16384;
constexpr int CW_CHK = 24576;
namespace pg8 {
#define PG8_LAS __attribute__((address_space(3)))
typedef unsigned short bf16_t;
typedef short bf16x8 __attribute__((ext_vector_type(8)));
typedef float f32x4 __attribute__((ext_vector_type(4)));
typedef unsigned u32x4 __attribute__((ext_vector_type(4)));
typedef unsigned u32x2_ __attribute__((ext_vector_type(2)));
constexpr int BM = 256, BK = 64, HALF = 128, HTB = HALF * BK * 2  , STAGE_BYTES = 8 * HTB, NXCD = 8, WGM = 8;

__device__ __forceinline__ int lane_id() { int x; asm volatile("v_mbcnt_lo_u32_b32 %0, -1, 0\n\tv_mbcnt_hi_u32_b32 %0, -1, %0" : "=v"(x)); return x; }
__host__ __device__ __forceinline__ int lds_byte(int r, int c) { const int st = (r >> 4) * 2 + (c >> 5), rr = r & 15, cc = c & 31, ob = rr * 64 + cc * 2; return st * 1024 + (ob ^ (((ob >> 9) & 1) << 5)); }
__host__ __device__ __forceinline__ void stage_rc(int b, int& R, int& C) { const int st = b / 1024, sb = b % 1024, swz = sb ^ (((sb >> 9) & 1) << 5); R = (st >> 1) * 16 + swz / 64; C = (st & 1) * 32 + (swz % 64) / 2; }
__host__ __device__ __forceinline__ int perm32(int rho) { const int n = rho >> 4, i = rho & 15; return 8 * (i >> 2) + 4 * n + (i & 3); }

struct Unit { int pm, pn; };
struct Gemm { const bf16_t* A; const bf16_t* Bt; int M, N, K; int spm = 1 << 30; long sdelta = 0; };

struct StaticOrder {
    int nM, nN, nwg, G, c, pn0;
    __host__ __device__ void init(int M, int N, int G_, int c_, int pn0_ = 0) { nM = M / BM; nN = N / BM; nwg = nM * nN; G = G_; c = c_; pn0 = pn0_; }
    __host__ __device__ bool next(int i, Unit& u) const {
        const long L = (long)i * G + c; if (L >= nwg) return false;
        int wgid = (int)L; { const int q = nwg / NXCD, r = nwg % NXCD, xcd = wgid % NXCD, off = wgid / NXCD; wgid = (xcd < r ? xcd * (q + 1) : r * (q + 1) + (xcd - r) * q) + off; }
        const int nig = WGM * nN, gid = wgid / nig, fm = gid * WGM, gsz = (nM - fm) < WGM ? (nM - fm) : WGM;
        u.pm = fm + ((wgid % nig) % gsz); u.pn = pn0 + (wgid % nig) / gsz; return true;
    }
    __device__ __forceinline__ void a_ready(const Unit&) const {}
    __device__ __forceinline__ void done(const Unit&, int, int) const {}
};

__device__ __forceinline__ unsigned cvt_pk_bf16(float lo, float hi) { unsigned r; asm volatile("v_cvt_pk_bf16_f32 %0, %1, %2" : "=v"(r) : "v"(lo), "v"(hi)); return r; }
typedef float cvt_f32x2_t __attribute__((ext_vector_type(2))); typedef __bf16 cvt_bf16x2_t __attribute__((ext_vector_type(2)));
__device__ __forceinline__ unsigned cvt_pk_bf16_acc(float lo, float hi) { const cvt_f32x2_t v = {lo, hi}; const cvt_bf16x2_t b = __builtin_convertvector(v, cvt_bf16x2_t); return __builtin_bit_cast(unsigned, b); }
__device__ __forceinline__ float bflo(unsigned w) { return __uint_as_float(w << 16); }
__device__ __forceinline__ float bfhi(unsigned w) { return __uint_as_float(w & 0xffff0000u); }
__device__ __forceinline__ float fsigmoid(float x) { return __builtin_amdgcn_rcpf(1.f + __expf(-x)); }
__device__ __forceinline__ float fsilu(float x) { return x * __builtin_amdgcn_rcpf(1.f + __expf(-x)); }

template <int VAR = 0> struct EpiHcatT {
    static constexpr bool PERM = true, AFTER_DRAIN = false; static constexpr int NSTORE = 16;
    unsigned char* ws; const float* rot; int tile_off;
    __device__ __forceinline__ void operator()(const f32x4 (&acc)[2][2][4][2], const Unit& u, int wr, int wc, int fr, int fq) const {
        if (VAR == 1) {
            float s = 0.f;
#pragma unroll
            for (int ai = 0; ai < 2; ++ai)
#pragma unroll
                for (int bj = 0; bj < 2; ++bj)
#pragma unroll
                    for (int m = 0; m < 4; ++m)
#pragma unroll
                        for (int n = 0; n < 2; ++n) s += (acc[ai][bj][m][n][0] + acc[ai][bj][m][n][1]) + (acc[ai][bj][m][n][2] + acc[ai][bj][m][n][3]);
            ((float*)(ws + WS_O3))[(size_t)(u.pm * 64 + u.pn) * 512 + wr * 256 + wc * 64 + fq * 16 + fr] = s; return;
        }
        const int gt = u.pn + tile_off;
        size_t base_off; int pitch, ct, mode; float sc = 1.f;
        if (gt < 2)       { base_off = WS_QR; pitch = 512;  ct = gt;      mode = 1; }
        else if (gt < 4)  { base_off = WS_KR; pitch = 512;  ct = gt - 2;  mode = 1; sc = 0.08838834764831845f; }
        else if (gt < 8)  { base_off = WS_VR; pitch = 1024; ct = gt - 4;  mode = 0; }
        else if (gt < 12) { base_off = WS_GR; pitch = 1024; ct = gt - 8;  mode = SILU_IN_P3 ? 0 : 2; }
        else if (gt < 14) { base_off = WS_QA; pitch = 512;  ct = gt - 12; mode = 0; sc = 0.18033688011112042f; }
        else if (gt < 16) { base_off = WS_KA; pitch = 512;  ct = gt - 14; mode = 0; }
        else if (gt < 18) { base_off = WS_VA; pitch = 512;  ct = gt - 16; mode = 0; }
        else if (gt < 22) { base_off = WS_GATE_R; pitch = 1024; ct = gt - 18; mode = 3; }
        else              { base_off = WS_GATE_A; pitch = 1024; ct = gt - 22; mode = 3; }
        bf16_t* O = (bf16_t*)(ws + base_off);
        const int row0 = u.pm * BM + wr * 64 + fr, col0 = ct * BM + wc * 32 + 8 * fq;
#pragma unroll
        for (int ai = 0; ai < 2; ++ai)
#pragma unroll
            for (int m = 0; m < 4; ++m) {
                const int row = row0 + ai * HALF + m * 16;
                bf16_t* rowp = O + (size_t)(VAR == 2 ? (row & 255) : row) * pitch + col0;
                f32x4 cs = (f32x4){1.f, 1.f, 1.f, 1.f}, sn = (f32x4){0.f, 0.f, 0.f, 0.f};
                if (mode == 1) { const f32x4* rt = (const f32x4*)(rot + ((size_t)(row & (SEQ - 1)) * 16 + (4 * wc + fq)) * 8); cs = rt[0]; sn = rt[1]; }
#pragma unroll
                for (int bj = 0; bj < 2; ++bj) {
                    f32x4 v0 = acc[ai][bj][m][0], v1 = acc[ai][bj][m][1];
                    if (mode == 1) { const f32x4 a = v0 * cs - v1 * sn, b = v0 * sn + v1 * cs; v0 = a * sc; v1 = b * sc; }
                    else if (mode == 2) {
#pragma unroll
                        for (int e = 0; e < 4; ++e) { v0[e] = fsilu(v0[e]); v1[e] = fsilu(v1[e]); } }
                    else if (mode == 3) {
#pragma unroll
                        for (int e = 0; e < 4; ++e) { v0[e] = fsigmoid(v0[e]); v1[e] = fsigmoid(v1[e]); } }
                    else { v0 = v0 * sc; v1 = v1 * sc; }
                    u32x4 w; w.x = cvt_pk_bf16(v0[0], v0[1]); w.y = cvt_pk_bf16(v0[2], v0[3]); w.z = cvt_pk_bf16(v1[0], v1[1]); w.w = cvt_pk_bf16(v1[2], v1[3]);
                    *(u32x4*)(rowp + bj * HALF) = w;
                }
            }
    }
};

typedef EpiHcatT<0> EpiHcat;

__device__ __forceinline__ unsigned fp8x4_sat(float a, float b, float c, float d) {
    a = __builtin_amdgcn_fmed3f(a, -448.f, 448.f); b = __builtin_amdgcn_fmed3f(b, -448.f, 448.f); c = __builtin_amdgcn_fmed3f(c, -448.f, 448.f); d = __builtin_amdgcn_fmed3f(d, -448.f, 448.f);
    unsigned w = 0u; w = __builtin_amdgcn_cvt_pk_fp8_f32(a, b, w, false); w = __builtin_amdgcn_cvt_pk_fp8_f32(c, d, w, true); return w;
}
template <bool ADD, bool OUT8 = false> struct EpiGate {
    static constexpr bool PERM = true, AFTER_DRAIN = false; static constexpr int NSTORE = 16;
    const bf16_t* gate; bf16_t* O; unsigned char* O8;
    __device__ __forceinline__ void operator()(const f32x4 (&acc)[2][2][4][2], const Unit& u, int wr, int wc, int fr, int fq) const {
        const int row0 = u.pm * BM + wr * 64 + fr, col0 = u.pn * BM + wc * 32 + 8 * fq;
#pragma unroll
        for (int ai = 0; ai < 2; ++ai)
#pragma unroll
            for (int m = 0; m < 4; ++m)
#pragma unroll
                for (int bj = 0; bj < 2; ++bj) {
                    const size_t p = (size_t)(row0 + ai * HALF + m * 16) * 1024 + col0 + bj * HALF;
                    const u32x4 g = *(const u32x4*)(gate + p);
                    f32x4 v0 = acc[ai][bj][m][0], v1 = acc[ai][bj][m][1];
                    v0[0] *= bflo(g.x); v0[1] *= bfhi(g.x); v0[2] *= bflo(g.y); v0[3] *= bfhi(g.y);
                    v1[0] *= bflo(g.z); v1[1] *= bfhi(g.z); v1[2] *= bflo(g.w); v1[3] *= bfhi(g.w);
                    if (ADD) { const u32x4 o = *(const u32x4*)(O + p);
                        v0[0] += bflo(o.x); v0[1] += bfhi(o.x); v0[2] += bflo(o.y); v0[3] += bfhi(o.y);
                        v1[0] += bflo(o.z); v1[1] += bfhi(o.z); v1[2] += bflo(o.w); v1[3] += bfhi(o.w); }
                    if (OUT8) { u32x2_ w8;
                        w8.x = fp8x4_sat(v0[0] * 16.f, v0[1] * 16.f, v0[2] * 16.f, v0[3] * 16.f); w8.y = fp8x4_sat(v1[0] * 16.f, v1[1] * 16.f, v1[2] * 16.f, v1[3] * 16.f);
                        *(u32x2_*)(O8 + p) = w8; }
                    else { u32x4 w; w.x = cvt_pk_bf16(v0[0], v0[1]); w.y = cvt_pk_bf16(v0[2], v0[3]); w.z = cvt_pk_bf16(v1[0], v1[1]); w.w = cvt_pk_bf16(v1[2], v1[3]);
                        *(u32x4*)(O + p) = w; }
                }
    }
};

struct EpiResBf16 {
    static constexpr bool PERM = true, AFTER_DRAIN = false; static constexpr int NSTORE = 16;
    const bf16_t* x; bf16_t* out; float alpha;
    __device__ __forceinline__ void operator()(const f32x4 (&acc)[2][2][4][2], const Unit& u, int wr, int wc, int fr, int fq) const {
        const int row0 = u.pm * BM + wr * 64 + fr, col0 = u.pn * BM + wc * 32 + 8 * fq;
#pragma unroll
        for (int ai = 0; ai < 2; ++ai)
#pragma unroll
            for (int m = 0; m < 4; ++m)
#pragma unroll
                for (int bj = 0; bj < 2; ++bj) {
                    const size_t p = (size_t)(row0 + ai * HALF + m * 16) * 1024 + col0 + bj * HALF;
#if X_F32_RES
                    const f32x4 x0 = *(const f32x4*)((const float*)x + p), x1 = *(const f32x4*)((const float*)x + p + 4);
#else
                    const u32x4 xw = *(const u32x4*)(x + p);
                    const f32x4 x0 = (f32x4){bflo(xw.x), bfhi(xw.x), bflo(xw.y), bfhi(xw.y)}, x1 = (f32x4){bflo(xw.z), bfhi(xw.z), bflo(xw.w), bfhi(xw.w)};
#endif
                    const f32x4 v0 = x0 * alpha + acc[ai][bj][m][0], v1 = x1 * alpha + acc[ai][bj][m][1];
                    u32x4 w; w.x = cvt_pk_bf16(v0[0], v0[1]); w.y = cvt_pk_bf16(v0[2], v0[3]); w.z = cvt_pk_bf16(v1[0], v1[1]); w.w = cvt_pk_bf16(v1[2], v1[3]);
                    *(u32x4*)(out + p) = w;
                }
    }
};

struct EpiSwiGLU {
    static constexpr bool PERM = true, AFTER_DRAIN = false; static constexpr int NSTORE = 16;
    unsigned char* H;
    __device__ __forceinline__ void operator()(const f32x4 (&acc)[2][2][4][2], const Unit& u, int wr, int wc, int fr, int fq) const {
        const int row0 = u.pm * BM + wr * 64 + fr, col0 = (u.pn & 3) * 128 + wc * 16 + 4 * fq;
#pragma unroll
        for (int ai = 0; ai < 2; ++ai)
#pragma unroll
            for (int m = 0; m < 4; ++m)
#pragma unroll
                for (int bj = 0; bj < 2; ++bj) {
                    const f32x4 g = acc[ai][bj][m][0], up = acc[ai][bj][m][1];
                    float h0 = fsilu(g[0]) * up[0] * 8.f, h1 = fsilu(g[1]) * up[1] * 8.f, h2 = fsilu(g[2]) * up[2] * 8.f, h3 = fsilu(g[3]) * up[3] * 8.f;
                    h0 = fminf(fmaxf(h0, -448.f), 448.f); h1 = fminf(fmaxf(h1, -448.f), 448.f); h2 = fminf(fmaxf(h2, -448.f), 448.f); h3 = fminf(fmaxf(h3, -448.f), 448.f);
                    unsigned w = 0u; w = __builtin_amdgcn_cvt_pk_fp8_f32(h0, h1, w, false); w = __builtin_amdgcn_cvt_pk_fp8_f32(h2, h3, w, true);
                    *(unsigned*)(H + (size_t)(row0 + ai * HALF + m * 16) * 512 + col0 + bj * 64) = w;
                }
    }
};

struct EpiRowScale {
    static constexpr bool PERM = true, AFTER_DRAIN = false; static constexpr int NSTORE = 16;
    bf16_t* Y;
    __device__ __forceinline__ void operator()(const f32x4 (&acc)[2][2][4][2], const Unit& u, int wr, int wc, int fr, int fq) const {
        const int row0 = u.pm * BM + wr * 64 + fr, col0 = (u.pn & 3) * BM + wc * 32 + 8 * fq;
#pragma unroll
        for (int ai = 0; ai < 2; ++ai)
#pragma unroll
            for (int m = 0; m < 4; ++m) {
                const int row = row0 + ai * HALF + m * 16;
#pragma unroll
                for (int bj = 0; bj < 2; ++bj) {
                    const f32x4 v0 = acc[ai][bj][m][0], v1 = acc[ai][bj][m][1];
#if Y_FP8
                    u32x2_ w8; w8.x = fp8x4_sat(v0[0] * 16.f, v0[1] * 16.f, v0[2] * 16.f, v0[3] * 16.f); w8.y = fp8x4_sat(v1[0] * 16.f, v1[1] * 16.f, v1[2] * 16.f, v1[3] * 16.f);
                    *(u32x2_*)((unsigned char*)Y + (size_t)row * 1024 + col0 + bj * HALF) = w8;
#else
                    u32x4 w; w.x = cvt_pk_bf16_acc(v0[0], v0[1]); w.y = cvt_pk_bf16_acc(v0[2], v0[3]); w.z = cvt_pk_bf16_acc(v1[0], v1[1]); w.w = cvt_pk_bf16_acc(v1[2], v1[3]);
                    *(u32x4*)(Y + (size_t)row * 1024 + col0 + bj * HALF) = w;
#endif
                }
            }
    }
};

struct MoeOrder {
    int nunits, G, c; const PG8_LAS int* te; const PG8_LAS int* ts; const PG8_LAS int* cnt; const int* ltok; unsigned rowbytes;
    __device__ __forceinline__ bool next(int i, Unit& u) const {
        const int L = i * G + c, rt = (L >> 5) * 8 + (L & 7); if (rt >= (nunits >> 2)) return false;
        u.pm = rt; u.pn = te[rt] * 4 + ((L >> 3) & 3); return true;
    }
    __device__ __forceinline__ unsigned a_row_off(const Unit& u, int row) const {
        const int ex = te[u.pm], pos = (u.pm - ts[ex]) * 256 + row;
        const int tok = pos < cnt[ex] ? ltok[ex * 32768 + pos] : 0;
        return (unsigned)tok * rowbytes;
    }
    __device__ __forceinline__ void a_ready(const Unit&) const {}
    __device__ __forceinline__ void done(const Unit&, int, int) const {}
};

struct ExpertConv { const float* wg; const float* wu; const float* wd; unsigned char* WGU; unsigned char* WD; int gw, nw, grp; };
__device__ __forceinline__ void expert_conv_item(const ExpertConv& c, int j, int lane) {
    const int it = j * c.nw + c.gw, e = it / 384, r = it % 384;
    const float* src; unsigned char* dst; int K, N, mode, nb, kb;
    if (r < 128)      { src = c.wg + (size_t)e * 1024 * 512; dst = c.WGU + (size_t)e * 1024 * 1024; K = 1024; N = 512;  mode = 2; nb = r >> 4; kb = r & 15; }
    else if (r < 256) { src = c.wu + (size_t)e * 1024 * 512; dst = c.WGU + (size_t)e * 1024 * 1024; K = 1024; N = 512;  mode = 3; nb = (r - 128) >> 4; kb = (r - 128) & 15; }
    else              { src = c.wd + (size_t)e * 512 * 1024; dst = c.WD + (size_t)e * 1024 * 512;   K = 512;  N = 1024; mode = 0; nb = (r - 256) >> 3; kb = (r - 256) & 7; }
    const int n4 = nb * 64 + 4 * (lane & 15), k0 = kb * 64 + 16 * (lane >> 4);
    const float* s = src + (size_t)k0 * N + n4;
    f32x4 v[16];
#pragma unroll
    for (int i = 0; i < 16; ++i) v[i] = *(const f32x4*)(s + (size_t)i * N);
#pragma unroll
    for (int jn = 0; jn < 4; ++jn) {
        const int n = n4 + jn, row = mode == 0 ? n : ((n >> 2) << 3) + (n & 3) + (mode == 3 ? 4 : 0);
        u32x4 w;
        w.x = fp8x4_sat(v[0][jn] * 64.f, v[1][jn] * 64.f, v[2][jn] * 64.f, v[3][jn] * 64.f);     w.y = fp8x4_sat(v[4][jn] * 64.f, v[5][jn] * 64.f, v[6][jn] * 64.f, v[7][jn] * 64.f);
        w.z = fp8x4_sat(v[8][jn] * 64.f, v[9][jn] * 64.f, v[10][jn] * 64.f, v[11][jn] * 64.f); w.w = fp8x4_sat(v[12][jn] * 64.f, v[13][jn] * 64.f, v[14][jn] * 64.f, v[15][jn] * 64.f);
        *(u32x4*)(dst + (size_t)row * K + k0) = w;
    }
}
struct GateOrder {
    StaticOrder S4;
    __device__ __forceinline__ bool next(int i, Unit& u) const { Unit t; if (!S4.next(i >> 1, t)) return false; u.pm = t.pm; u.pn = t.pn + 4 * (i & 1); return true; }
    __device__ __forceinline__ void a_ready(const Unit&) const {}
    __device__ __forceinline__ void done(const Unit&, int, int) const {}
};
struct P1Order {
    StaticOrder S; ExpertConv cv;
    __device__ __forceinline__ bool next(int i, Unit& u) const { return S.next(i, u); }
    __device__ __forceinline__ void a_ready(const Unit&) const {}
    __device__ __forceinline__ static int unit_of(int grp, int k) { return (grp + 3 * k) % 9; }
    __device__ __forceinline__ void done(const Unit&, int ui, int lane) const {
        const int d = (ui + 9 - cv.grp) % 9;
        if (ui < 9 && d % 3 == 0 && cv.gw + (d / 3) * cv.nw < 6144) expert_conv_item(cv, d / 3, lane);
    }
};

template <class Epi, class Sched, bool ALIGN_EPI = false, bool SP2 = false, bool GATHER = false, bool FP8 = false, int SEL_W = 0, int SEL_X = 0>
__device__ __forceinline__ void gemm_phase(PG8_LAS unsigned char* lds, const Gemm g, const Sched& S, const Epi& E, const int wid) {
    int tid = wid * 64 + lane_id(); asm volatile("" : "+v"(tid));
    const int lane = tid & 63, wr = wid >> 2, wc = wid & 3, fr = lane & 15, fq = lane >> 4;
    static_assert(SP2, "only the two-super-phase loop is kept");
    typedef int i32x4_ __attribute__((ext_vector_type(4)));
    const int K = g.K, nt = K / BK;
    unsigned voffB[2]; int rA[2], cA2[2];
#pragma unroll
    for (int i = 0; i < 2; ++i) { int R, C; stage_rc(tid * 16 + i * 8192, R, C); const int Rb = Epi::PERM ? ((R & ~31) + perm32(R & 31)) : R;
        rA[i] = R; cA2[i] = C * 2; voffB[i] = (unsigned)(Rb * K + C) * 2u; }
    unsigned vAc[2][2], vAn[2][2];
    const size_t kstep = (size_t)(BK * 2);
    const size_t hstep = (size_t)HALF * K * 2;
    const size_t tstep = 2 * hstep;
    const unsigned ldsw = (unsigned)wid * 1024u;
    const int aoff0 = lds_byte(wr * 64 + fr, fq * 8), aoff1 = aoff0 + 1024;
    const int boff0 = lds_byte(wc * 32 + fr, fq * 8), boff1 = boff0 + 1024;
#define PG8_SA(b, h) (((b) * 2 + (h)) * HTB)
#define PG8_SB(b, h) ((4 + (b) * 2 + (h)) * HTB)
#define PG8_STAGE(bufoff, gbase, voff) do { _Pragma("unroll") for (int _i = 0; _i < 2; ++_i) \
        __builtin_amdgcn_global_load_lds((const unsigned*)((const char*)(gbase) + (voff)[_i]), (PG8_LAS unsigned*)(lds + (bufoff) + ldsw + _i * 8192), 16, 0, 0); } while (0)
#define PG8_LDA(dst, b, h) do { _Pragma("unroll") for (int m = 0; m < 4; ++m) { dst[m][0] = *(const PG8_LAS bf16x8*)(lds + PG8_SA(b, h) + aoff0 + m * 2048); dst[m][1] = *(const PG8_LAS bf16x8*)(lds + PG8_SA(b, h) + aoff1 + m * 2048); } } while (0)
#define PG8_LDB(dst, b, h) do { _Pragma("unroll") for (int n = 0; n < 2; ++n) { dst[n][0] = *(const PG8_LAS bf16x8*)(lds + PG8_SB(b, h) + boff0 + n * 2048); dst[n][1] = *(const PG8_LAS bf16x8*)(lds + PG8_SB(b, h) + boff1 + n * 2048); } } while (0)
#define PG8_CAT8(x) __builtin_shufflevector(__builtin_bit_cast(i32x4_, (x)[0]), __builtin_bit_cast(i32x4_, (x)[1]), 0, 1, 2, 3, 4, 5, 6, 7)
#define PG8_MMA(ai, bj, At, Bt) do { __builtin_amdgcn_s_setprio(1); \
        if constexpr (FP8) { _Pragma("unroll") for (int m = 0; m < 4; ++m) _Pragma("unroll") for (int n = 0; n < 2; ++n) \
            acc[ai][bj][m][n] = __builtin_amdgcn_mfma_scale_f32_16x16x128_f8f6f4(PG8_CAT8(Bt[n]), PG8_CAT8(At[m]), acc[ai][bj][m][n], 0, 0, SEL_W, scl, SEL_X, scl); \
            asm volatile("" : "+v"(acc[ai][bj][0][0]), "+v"(acc[ai][bj][0][1]), "+v"(acc[ai][bj][1][0]), "+v"(acc[ai][bj][1][1]), "+v"(acc[ai][bj][2][0]), "+v"(acc[ai][bj][2][1]), "+v"(acc[ai][bj][3][0]), "+v"(acc[ai][bj][3][1])); } \
        else { _Pragma("unroll") for (int m = 0; m < 4; ++m) _Pragma("unroll") for (int n = 0; n < 2; ++n) _Pragma("unroll") for (int k = 0; k < 2; ++k) \
            acc[ai][bj][m][n] = __builtin_amdgcn_mfma_f32_16x16x32_bf16(Bt[n][k], At[m][k], acc[ai][bj][m][n], 0, 0, 0); } \
        __builtin_amdgcn_s_setprio(0); } while (0)
#define PG8_WAIT_V(n) asm volatile("s_waitcnt vmcnt(" #n ")" ::: "memory")
#define PG8_WAIT_VN(n) asm volatile("s_waitcnt vmcnt(%0)" :: "i"(n) : "memory")
#define PG8_WAIT_L(n) asm volatile("s_waitcnt lgkmcnt(" #n ")" ::: "memory")
#define PG8_BAR __builtin_amdgcn_s_barrier()
#define PG8_SCHED __builtin_amdgcn_sched_barrier(0)
    [[maybe_unused]] int scl = 0x7b7c797f; asm volatile("" : "+v"(scl));
    Unit cur, nxt; int ui = 0;
    if (!S.next(0, cur)) return;
    f32x4 acc[2][2][4][2];
#pragma unroll
    for (int a = 0; a < 2; ++a)
#pragma unroll
        for (int b = 0; b < 2; ++b)
#pragma unroll
            for (int m = 0; m < 4; ++m)
#pragma unroll
                for (int n = 0; n < 2; ++n) acc[a][b][m][n] = (f32x4){0.f, 0.f, 0.f, 0.f};
    bf16x8 At[4][2], B0[2][2], B1[2][2];
    const char* cA = GATHER ? (const char*)g.A : (const char*)g.A + (size_t)cur.pm * tstep + (cur.pm >= g.spm ? g.sdelta : 0L); const char* cB = (const char*)g.Bt + (size_t)cur.pn * tstep;
#pragma unroll
    for (int h = 0; h < 2; ++h)
#pragma unroll
        for (int i = 0; i < 2; ++i) { if constexpr (GATHER) vAc[h][i] = S.a_row_off(cur, h * HALF + rA[i]) + (unsigned)cA2[i]; else vAc[h][i] = (unsigned)((h * HALF + rA[i]) * K) * 2u + (unsigned)cA2[i]; vAn[h][i] = vAc[h][i]; }
    S.a_ready(cur);
    if constexpr (SP2) {
        PG8_STAGE(PG8_SB(0, 0), cB, voffB); PG8_STAGE(PG8_SB(0, 1), cB + hstep, voffB); PG8_STAGE(PG8_SA(0, 0), cA, vAc[0]); PG8_STAGE(PG8_SA(0, 1), cA, vAc[1]);
        if (wr == 1) PG8_BAR;
        PG8_WAIT_V(2); PG8_BAR;
        PG8_STAGE(PG8_SB(1, 0), cB + kstep, voffB); PG8_STAGE(PG8_SA(1, 0), cA + kstep, vAc[0]); PG8_STAGE(PG8_SB(1, 1), cB + hstep + kstep, voffB);
        PG8_WAIT_V(6); PG8_BAR;
    }
    for (;;) {
        const bool has_next = S.next(ui + 1, nxt);
        const char* nA = GATHER ? cA : (has_next ? (const char*)g.A + (size_t)nxt.pm * tstep + (nxt.pm >= g.spm ? g.sdelta : 0L) : cA); const char* nB = has_next ? (const char*)g.Bt + (size_t)nxt.pn * tstep : cB;
        if constexpr (GATHER) { if (has_next) {
#pragma unroll
            for (int h = 0; h < 2; ++h)
#pragma unroll
                for (int i = 0; i < 2; ++i) vAn[h][i] = S.a_row_off(nxt, h * HALF + rA[i]) + (unsigned)cA2[i]; } }
#pragma unroll 1
        for (int t = 0; t < nt; t += 2) {
            const bool last = (t == nt - 2);
            asm volatile("" : "+v"(voffB[0]), "+v"(voffB[1]), "+v"(vAc[0][0]), "+v"(vAc[0][1]), "+v"(vAc[1][0]), "+v"(vAc[1][1]));
            const char* a1 = cA + (size_t)(t + 1) * kstep;
            const char* a2 = last ? nA : cA + (size_t)(t + 2) * kstep; const char* b2 = last ? nB : cB + (size_t)(t + 2) * kstep;
            const char* a3 = a2 + kstep; const char* b3 = b2 + kstep;
            unsigned vA2[2][2];
#pragma unroll
            for (int h = 0; h < 2; ++h)
#pragma unroll
                for (int i = 0; i < 2; ++i) vA2[h][i] = vAc[h][i];
            if constexpr (GATHER) { if (last) {
                asm volatile("" : "+v"(vAn[0][0]), "+v"(vAn[0][1]), "+v"(vAn[1][0]), "+v"(vAn[1][1]));
#pragma unroll
                for (int h = 0; h < 2; ++h)
#pragma unroll
                    for (int i = 0; i < 2; ++i) vA2[h][i] = vAn[h][i]; } }
            if (last && has_next) S.a_ready(nxt);
            if constexpr (SP2) {
            const int lenient = __builtin_amdgcn_readfirstlane((ui > 0 && t == 0) ? 1 : 0);
#define PG8_WAIT_V8L() asm volatile("s_cmp_eq_u32 %0, 0\n\ts_cbranch_scc0 .Lpg8skip%=\n\ts_waitcnt vmcnt(8)\n.Lpg8skip%=:\n\ts_waitcnt vmcnt(%1)" :: "s"(lenient), "i"(8 + Epi::NSTORE) : "memory", "scc")
            PG8_LDB(B0, 0, 0); PG8_LDB(B1, 0, 1); PG8_SCHED; PG8_LDA(At, 0, 0); PG8_STAGE(PG8_SA(1, 1), a1, vAc[1]);
            PG8_WAIT_V8L(); PG8_WAIT_L(0); PG8_BAR; PG8_MMA(0, 0, At, B0); PG8_MMA(0, 1, At, B1); PG8_BAR; PG8_SCHED;
            PG8_LDA(At, 0, 1); PG8_STAGE(PG8_SB(0, 0), b2, voffB); PG8_STAGE(PG8_SB(0, 1), b2 + hstep, voffB); PG8_STAGE(PG8_SA(0, 0), a2, vA2[0]);
            PG8_WAIT_V8L(); PG8_WAIT_L(0); PG8_BAR; PG8_MMA(1, 0, At, B0); PG8_MMA(1, 1, At, B1); PG8_BAR; PG8_SCHED;
            PG8_LDB(B0, 1, 0); PG8_LDB(B1, 1, 1); PG8_SCHED; PG8_LDA(At, 1, 0); PG8_STAGE(PG8_SA(0, 1), a2, vA2[1]);
            PG8_WAIT_V(8); PG8_WAIT_L(0); PG8_BAR; PG8_MMA(0, 0, At, B0); PG8_MMA(0, 1, At, B1); PG8_BAR; PG8_SCHED;
            PG8_LDA(At, 1, 1); PG8_STAGE(PG8_SB(1, 0), b3, voffB); PG8_STAGE(PG8_SB(1, 1), b3 + hstep, voffB); PG8_STAGE(PG8_SA(1, 0), a3, vA2[0]);
            PG8_WAIT_V(8); PG8_WAIT_L(0); PG8_BAR; PG8_MMA(1, 0, At, B0); PG8_MMA(1, 1, At, B1); PG8_BAR; PG8_SCHED;
#undef PG8_WAIT_V8L
            }
        }
        if constexpr (ALIGN_EPI) { if (wr == 0) PG8_BAR; }
        if constexpr (!Epi::AFTER_DRAIN) { const int le = lane_id(); E(acc, cur, wr, wc, le & 15, le >> 4); S.done(cur, ui, le); }
        if (!has_next) break;
#pragma unroll
        for (int a = 0; a < 2; ++a)
#pragma unroll
            for (int b = 0; b < 2; ++b)
#pragma unroll
                for (int m = 0; m < 4; ++m)
#pragma unroll
                    for (int n = 0; n < 2; ++n) acc[a][b][m][n] = (f32x4){0.f, 0.f, 0.f, 0.f};
        cur = nxt; cA = nA; cB = nB; ++ui;
        if constexpr (GATHER) {
#pragma unroll
            for (int h = 0; h < 2; ++h)
#pragma unroll
                for (int i = 0; i < 2; ++i) vAc[h][i] = vAn[h][i]; }
        if constexpr (ALIGN_EPI) { if (wr == 1) PG8_BAR; }
    }
    PG8_WAIT_V(0);
    if constexpr (!ALIGN_EPI) { if (wr == 0) PG8_BAR; }
    PG8_BAR;
    if constexpr (Epi::AFTER_DRAIN) { E.fused(acc, cur, wr, wc, fr, fq, lds, wid, lane); S.done(cur, ui, lane); }
#undef PG8_SA
#undef PG8_SB
#undef PG8_STAGE
#undef PG8_LDA
#undef PG8_LDB
#undef PG8_MMA
#undef PG8_CAT8
#undef PG8_WAIT_V
#undef PG8_WAIT_VN
#undef PG8_WAIT_L
#undef PG8_BAR
#undef PG8_SCHED
}
}
#define GAS __attribute__((address_space(1)))
#define LAS __attribute__((address_space(3)))
typedef unsigned short bf16;
typedef unsigned v4u __attribute__((ext_vector_type(4)));
typedef float f32x4 __attribute__((ext_vector_type(4)));
typedef short bf16x8 __attribute__((ext_vector_type(8)));
typedef GAS unsigned gu32;
typedef GAS unsigned long long gu64;
#define RLX_AGENT __ATOMIC_RELAXED, __HIP_MEMORY_SCOPE_AGENT
#define LDS_WAIT() asm volatile("s_waitcnt lgkmcnt(0)" ::: "memory")
#define VM_WAIT() asm volatile("s_waitcnt vmcnt(0)" ::: "memory")
__device__ __forceinline__ unsigned long long rt() { return __builtin_amdgcn_s_memrealtime(); }
__device__ __forceinline__ unsigned f2bf(float f) { unsigned u = __builtin_bit_cast(unsigned, f); return (u + 0x7fffu + ((u >> 16) & 1u)) >> 16; }
__device__ __forceinline__ unsigned pk2(float lo, float hi) { return f2bf(lo) | (f2bf(hi) << 16); }

#define XB_TMO      128
#define XB_XCNT(j)  (256  + 64 * (j))
#define XB_XSUB(j)  (1280 + 64 * (j))
#define XB_XGEN(j)  (2304 + 64 * (j))
#define XB_TOP      3328
#define XB_TOPGEN   3392
#define XCD_BAR_WORDS 3456
#define XB_SPIN_CAP (1u << 18)

__device__ __forceinline__ unsigned xb_ld(unsigned* p)              { return __hip_atomic_load(p, __ATOMIC_RELAXED, __HIP_MEMORY_SCOPE_AGENT); }
__device__ __forceinline__ unsigned xb_add(unsigned* p, unsigned v) { return __hip_atomic_fetch_add(p, v, __ATOMIC_RELAXED, __HIP_MEMORY_SCOPE_AGENT); }
__device__ __forceinline__ unsigned xb_xcc_id() { return (unsigned)__builtin_amdgcn_s_getreg((3 << 11) | 20) & 0xFu; }
#define XB_SPIN(cond, bar) do { unsigned _sp = 0; while (cond) { __builtin_amdgcn_s_sleep(1); \
    if ((++_sp & 255u) == 0u) { if (xb_ld(&(bar)[XB_TMO])) break; if (_sp > XB_SPIN_CAP) { atomicAdd(&(bar)[XB_TMO], 1u); break; } } } } while (0)

struct XcdBarrier {
    unsigned* bar; unsigned x; int wv;
    volatile LAS unsigned* st;
};

__device__ __forceinline__ XcdBarrier xcd_barrier_post(unsigned* bar, volatile LAS unsigned* st) {
    XcdBarrier b; b.bar = bar; b.x = xb_xcc_id(); b.st = st; b.wv = 0;
    if (threadIdx.x == 0) (void)xb_add(&bar[XB_XCNT(b.x)], 1u);
    return b;
}
__device__ __forceinline__ void xcd_barrier_complete(unsigned* bar, unsigned x, unsigned& nloc, unsigned& nx) {
    const unsigned G = gridDim.x * gridDim.y * gridDim.z;
    unsigned sum, cnt, mine, sp = 0u;
    for (;;) {
        sum = 0u; cnt = 0u; mine = 0u;
#pragma unroll
        for (unsigned j = 0; j < 16; ++j) { const unsigned c = xb_ld(&bar[XB_XCNT(j)]); sum += c; cnt += (c > 0u) ? 1u : 0u; mine = (j == x) ? c : mine; }
        if (sum == G) break;
        __builtin_amdgcn_s_sleep(1);
        if ((++sp & 255u) == 0u) { if (xb_ld(&bar[XB_TMO])) break; if (sp > XB_SPIN_CAP) { atomicAdd(&bar[XB_TMO], 1u); break; } }
    }
    nloc = mine > 0u ? mine : 1u; nx = cnt > 0u ? cnt : 1u;
}

__device__ __forceinline__ void xcd_barrier(const XcdBarrier& b) {
    asm volatile("s_waitcnt vmcnt(0)" ::: "memory");
    __syncthreads();
    if (b.wv == 0 && (int)__builtin_amdgcn_mbcnt_hi(~0u, __builtin_amdgcn_mbcnt_lo(~0u, 0u)) == 0) {
        unsigned* bar = b.bar;
        __builtin_amdgcn_s_waitcnt(0);
        unsigned nloc = b.st[0], nx = b.st[1];
        if (nloc == 0u) { xcd_barrier_complete(bar, b.x, nloc, nx); b.st[0] = nloc; b.st[1] = nx; }
        const unsigned old = xb_add(&bar[XB_XSUB(b.x)], 1u);
        const unsigned gen = old / nloc;
        if (old + 1u == (gen + 1u) * nloc) {
            __builtin_amdgcn_fence(__ATOMIC_RELEASE, "agent");
            asm volatile("s_waitcnt vmcnt(0)" ::: "memory");
            const unsigned og = xb_add(&bar[XB_TOP], 1u);
            const unsigned tg = og / nx;
            if (og + 1u == (tg + 1u) * nx) xb_add(&bar[XB_TOPGEN], 1u);
            else XB_SPIN(xb_ld(&bar[XB_TOPGEN]) == tg, bar);
            __builtin_amdgcn_fence(__ATOMIC_ACQUIRE, "agent");
            xb_add(&bar[XB_XGEN(b.x)], 1u);
            asm volatile("s_waitcnt vmcnt(0)" ::: "memory");
        } else {
            XB_SPIN(xb_ld(&bar[XB_XGEN(b.x)]) == gen, bar);
            __builtin_amdgcn_fence(__ATOMIC_ACQUIRE, "agent");
            asm volatile("s_waitcnt vmcnt(0)" ::: "memory");
        }
    }
    __syncthreads();
}


constexpr int NWAVES = 8;
constexpr int RING_BYTES = 131072;
constexpr int LDSCTL_OFF = RING_BYTES, MISC_OFF = LDSCTL_OFF + 320;
constexpr int LDS_TS_OFF = LDSCTL_OFF + 1024;
constexpr int LDS_TE_OFF = LDSCTL_OFF + 2048;
constexpr int LDS_CNT_OFF = LDSCTL_OFF + 1024 + 128;
constexpr int LDS_BYTES = 163840;

typedef short s16x4 __attribute__((ext_vector_type(4)));
typedef unsigned u32x2 __attribute__((ext_vector_type(2)));

struct Args { const float* in[20]; float* out; unsigned char* ws; unsigned mask; int bar_region; };

__device__ __forceinline__ float bflo(unsigned w) { return __uint_as_float(w << 16); }
__device__ __forceinline__ float bfhi(unsigned w) { return __uint_as_float(w & 0xffff0000u); }
__device__ __forceinline__ unsigned cvtpk(float lo, float hi) { return pg8::cvt_pk_bf16(lo, hi); }
__device__ __forceinline__ float wave_sum(float v) {
#pragma unroll
    for (int o = 1; o < 64; o <<= 1) v += __shfl_xor(v, o);
    return v;
}
__device__ __forceinline__ unsigned offb(unsigned row, unsigned ch) { return 256u * row + 16u * (ch ^ (((row & 3u) << 2) | ((row >> 2) & 3u))); }
__device__ __forceinline__ s16x4 ldtr(const LAS unsigned char* p) { return __builtin_amdgcn_ds_read_tr16_b64_v4i16((LAS s16x4*)p); }
__device__ __forceinline__ bf16x8 cat8(s16x4 a, s16x4 b) { return (bf16x8){a[0], a[1], a[2], a[3], b[0], b[1], b[2], b[3]}; }
#define MFMA16(a, b, c) __builtin_amdgcn_mfma_f32_16x16x32_bf16((a), (b), (c), 0, 0, 0)

template <int MODE> __device__ __forceinline__ int dest_row(int n) {
    if (MODE == 1) { if (n >= 1024) return n; const int hb = n & ~127, d = n & 127, jr = d & 63, half = d >> 6; return hb + 8 * (jr >> 2) + 4 * half + (jr & 3); }
    if (MODE == 2) return ((n >> 2) << 3) + (n & 3);
    if (MODE == 3) return ((n >> 2) << 3) + 4 + (n & 3);
    return n;
}
template <int MODE> __device__ __forceinline__ void p0_transpose_item(const float* W, int K, int N, bf16* WT, LAS float* scr, int item, int lane) {
    const int nblk = N / 32, kb = item / nblk, nb = item % nblk, k0 = 64 * kb, n0 = 32 * nb;
    {
        const GAS f32x4* src = (const GAS f32x4*)(W + (size_t)(k0 + (lane >> 3)) * N + n0) + (lane & 7);
        f32x4 t[8];
#pragma unroll
        for (int j = 0; j < 8; ++j) t[j] = src[(size_t)j * 2 * N];
#pragma unroll
        for (int j = 0; j < 8; ++j) { LAS float* d = scr + ((lane >> 3) + 8 * j) * 33 + 4 * (lane & 7); d[0] = t[j].x; d[1] = t[j].y; d[2] = t[j].z; d[3] = t[j].w; }
    }
    LDS_WAIT(); asm volatile("" ::: "memory");
    const int c = lane & 7;
#pragma unroll
    for (int j = 0; j < 4; ++j) { const int n = (lane >> 3) + 8 * j; const LAS float* s = scr + (8 * c) * 33 + n;
        v4u o; o.x = pk2(s[0 * 33], s[1 * 33]); o.y = pk2(s[2 * 33], s[3 * 33]); o.z = pk2(s[4 * 33], s[5 * 33]); o.w = pk2(s[6 * 33], s[7 * 33]);
        *(GAS v4u*)(WT + (size_t)dest_row<MODE>(n0 + n) * K + k0 + 8 * c) = o; }
    LDS_WAIT(); asm volatile("" ::: "memory");
}
__device__ __forceinline__ unsigned pk_fp8x4(float a, float b, float c, float d) {
    a = fminf(fmaxf(a, -448.f), 448.f); b = fminf(fmaxf(b, -448.f), 448.f); c = fminf(fmaxf(c, -448.f), 448.f); d = fminf(fmaxf(d, -448.f), 448.f);
    unsigned w = 0u; w = __builtin_amdgcn_cvt_pk_fp8_f32(a, b, w, false); w = __builtin_amdgcn_cvt_pk_fp8_f32(c, d, w, true); return w;
}
template <int MODE> __device__ __forceinline__ void p0_transpose_item_fp8(const float* W, int K, int N, unsigned char* WT, LAS float* scr, int item, int lane, float scale) {
    const int nblk = N / 32, kb = item / nblk, nb = item % nblk, k0 = 64 * kb, n0 = 32 * nb;
    {
        const GAS f32x4* src = (const GAS f32x4*)(W + (size_t)(k0 + (lane >> 3)) * N + n0) + (lane & 7);
        f32x4 t[8];
#pragma unroll
        for (int j = 0; j < 8; ++j) t[j] = src[(size_t)j * 2 * N];
#pragma unroll
        for (int j = 0; j < 8; ++j) { LAS float* d = scr + ((lane >> 3) + 8 * j) * 33 + 4 * (lane & 7); d[0] = t[j].x; d[1] = t[j].y; d[2] = t[j].z; d[3] = t[j].w; }
    }
    LDS_WAIT(); asm volatile("" ::: "memory");
    const int c = lane & 7;
#pragma unroll
    for (int j = 0; j < 4; ++j) { const int n = (lane >> 3) + 8 * j; const LAS float* s = scr + (8 * c) * 33 + n;
        u32x2 o; o.x = pk_fp8x4(s[0 * 33] * scale, s[1 * 33] * scale, s[2 * 33] * scale, s[3 * 33] * scale); o.y = pk_fp8x4(s[4 * 33] * scale, s[5 * 33] * scale, s[6 * 33] * scale, s[7 * 33] * scale);
        *(GAS u32x2*)(WT + (size_t)dest_row<MODE>(n0 + n) * K + k0 + 8 * c) = o; }
    LDS_WAIT(); asm volatile("" ::: "memory");
}
__device__ __forceinline__ int t5_bucket(int rel) {
    const int n = rel < 0 ? -rel : rel;
    int large = 8 + (n >= 15) + (n >= 27) + (n >= 50) + (n >= 91) + (n >= 166) + (n >= 305) + (n >= 559);
    large = large < 15 ? large : 15;
    return (rel > 0 ? 16 : 0) + (n < 8 ? n : large);
}
__device__ __forceinline__ void p0_prologue(const Args& a, LAS unsigned char* lds, int vcu, int G, int tid, int wave, int lane) {
    unsigned char* ws = a.ws;
    LAS float* scr = (LAS float*)(lds + wave * 16384);
    const int gw = vcu * NWAVES + wave, NGW = G * NWAVES;
    constexpr int I_IN = 16 * 208, I_R = 16 * 32, I_A = 8 * 32, I_O = 16 * 32;
    constexpr int NITEMS = I_IN + I_R + I_A + I_O;
    for (int it = gw; it < NITEMS; it += NGW) {
        int r = it;
#if P1_FP8
        if (r < I_IN) { if ((GATE_FP8 || r % 208 < 144) && r % 208 >= 8 * P1_FP8_FROM) p0_transpose_item_fp8<1>(a.in[1], 1024, 6656, ws + WS_WIN8, scr, r, lane, 64.f);
                        else p0_transpose_item<1>(a.in[1], 1024, 6656, (bf16*)(ws + WS_WIN), scr, r, lane); continue; } r -= I_IN;
#else
        if (r < I_IN) { p0_transpose_item<1>(a.in[1], 1024, 6656, (bf16*)(ws + WS_WIN), scr, r, lane); continue; } r -= I_IN;
#endif
        if (r < I_R) { if (MIX_FP8 & 4) p0_transpose_item_fp8<0>(a.in[5], 1024, 1024, ws + WS_WR, scr, r, lane, 64.f); else p0_transpose_item<0>(a.in[5], 1024, 1024, (bf16*)(ws + WS_WR), scr, r, lane); continue; } r -= I_R;
        if (r < I_A) { if (MIX_FP8 & 2) p0_transpose_item_fp8<0>(a.in[7], 512, 1024, ws + WS_WA, scr, r, lane, 64.f); else p0_transpose_item<0>(a.in[7], 512, 1024, (bf16*)(ws + WS_WA), scr, r, lane); continue; } r -= I_A;
        if (MIX_FP8 & 1) p0_transpose_item_fp8<0>(a.in[8], 1024, 1024, ws + WS_WO, scr, r, lane, 64.f); else p0_transpose_item<0>(a.in[8], 1024, 1024, (bf16*)(ws + WS_WO), scr, r, lane);
    }
    {
        const f32x4* x4 = (const f32x4*)a.in[0]; u32x2* xb = (u32x2*)(ws + WS_XB);
#if P1_FP8
#if GATE_FP8
        unsigned* xf8 = (unsigned*)(ws + WS_X8_LO);
#define XF8_AT(i) xf8[(long)(i) + ((i) >= (size_t)16384 * 256 ? ((long)WS_X8_HI - (long)WS_X8_LO - (long)(16 * MiB)) / 4 : 0L)]
#else
        unsigned* xf8 = (unsigned*)a.out;
#define XF8_AT(i) xf8[i]
#endif
        for (size_t i = (size_t)vcu * 512 + tid; i < (size_t)TT * DM / 4; i += (size_t)G * 512) { const f32x4 v = x4[i]; u32x2 o; o.x = cvtpk(v.x, v.y); o.y = cvtpk(v.z, v.w); if (!X_F32_RES) xb[i] = o; XF8_AT(i) = pk_fp8x4(v.x, v.y, v.z, v.w); }
#undef XF8_AT
#else
        for (size_t i = (size_t)vcu * 512 + tid; i < (size_t)TT * DM / 4; i += (size_t)G * 512) { const f32x4 v = x4[i]; u32x2 o; o.x = cvtpk(v.x, v.y); o.y = cvtpk(v.z, v.w); xb[i] = o; }
#endif
    }
    {
        float* rot = (float*)(ws + WS_ROT);
        for (int idx = vcu * 512 + tid; idx < SEQ * 64; idx += G * 512) {
            const int pos = idx >> 6, jr = idx & 63;
            double iv = 1.0; for (int k = 0; k < jr; ++k) iv *= 0.86596432336006535;
            const float ang = (float)pos * (float)iv;
            const double xx = (double)ang; const double qd = __builtin_rint(xx * 0.63661977236758134); const int qi = (int)qd;
            const double r = (xx - qd * 1.5707963267948966) - qd * 6.123233995736766e-17, r2 = r * r;
            const double sp = r * (1.0 + r2 * (-1.0 / 6 + r2 * (1.0 / 120 + r2 * (-1.0 / 5040 + r2 * (1.0 / 362880 + r2 * (-1.0 / 39916800 + r2 * (1.0 / 6227020800.0)))))));
            const double cp = 1.0 + r2 * (-0.5 + r2 * (1.0 / 24 + r2 * (-1.0 / 720 + r2 * (1.0 / 40320 + r2 * (-1.0 / 3628800 + r2 * (1.0 / 479001600.0))))));
            const int qq = qi & 3; const double s = qq == 0 ? sp : (qq == 1 ? cp : (qq == 2 ? -sp : -cp)), c = qq == 0 ? cp : (qq == 1 ? -sp : (qq == 2 ? -cp : sp));
            float* o = rot + ((size_t)pos * 16 + (jr >> 2)) * 8 + (jr & 3); o[0] = (float)c; o[4] = (float)s;
        }
    }
    if (vcu == 0) {
        float* bt = (float*)(ws + WS_BIAS); const float* rb = a.in[6];
        for (int idx = tid; idx < 3 * 8 * 160; idx += 512) { const int p = idx / (8 * 160), h = (idx / 160) % 8, d = idx % 160 - 80; const int dil = p == 0 ? 1 : (p == 1 ? 4 : 16);
            bt[idx] = (d >= -64 && d <= 64) ? rb[t5_bucket(d * dil) * 8 + h] * 1.4426950408889634f : -1e30f; }
    }
}
__device__ __forceinline__ void p0_expert_weights(const Args& a, LAS unsigned char* lds, int vcu, int G, int wave, int lane) {
    unsigned char* ws = a.ws;
    LAS float* scr = (LAS float*)(lds + wave * 16384);
    const int gw = vcu * NWAVES + wave, NGW = G * NWAVES;
    constexpr int I_G = 16 * 16, I_D = 8 * 32, PER_E = 2 * I_G + I_D;
    for (int it = gw; it < 16 * PER_E; it += NGW) {
        const int e = it / PER_E; int r = it - e * PER_E;
#if M1_FP8
        if (r < I_G) { p0_transpose_item_fp8<2>(a.in[15] + (size_t)e * 1024 * 512, 1024, 512, ws + WS_WGU + (size_t)e * 1024 * 1024, scr, r, lane, 64.f); continue; } r -= I_G;
        if (r < I_G) { p0_transpose_item_fp8<3>(a.in[16] + (size_t)e * 1024 * 512, 1024, 512, ws + WS_WGU + (size_t)e * 1024 * 1024, scr, r, lane, 64.f); continue; } r -= I_G;
#else
        if (r < I_G) { p0_transpose_item<2>(a.in[15] + (size_t)e * 1024 * 512, 1024, 512, (bf16*)(ws + WS_WGU) + (size_t)e * 1024 * 1024, scr, r, lane); continue; } r -= I_G;
        if (r < I_G) { p0_transpose_item<3>(a.in[16] + (size_t)e * 1024 * 512, 1024, 512, (bf16*)(ws + WS_WGU) + (size_t)e * 1024 * 1024, scr, r, lane); continue; } r -= I_G;
#endif
        p0_transpose_item_fp8<0>(a.in[17] + (size_t)e * 512 * 1024, 512, 1024, ws + WS_WD + (size_t)e * 1024 * 512, scr, r, lane, 64.f);
    }
    __syncthreads();
}

__device__ __forceinline__ float log2_gamma(const float* dec, int h) {
    const float x = dec[h]; return -__log2f(1.f + __expf(-x));
}
__device__ __forceinline__ void chain_item(const Args& a, LAS unsigned char* lds, int item, int tid, int wid, int lane) {
    unsigned char* ws = a.ws;
    const int b = item >> 4, h = (item >> 2) & 3, dir = (item >> 1) & 1, vh = item & 1;
    const float lg2 = log2_gamma(dir ? a.in[3] : a.in[2], h);
    const float cd = __builtin_amdgcn_exp2f(lg2 * 128.f);
    const int g = lane >> 4, i16 = lane & 15, q = i16 >> 2, p = lane & 3;
    const int wd = wid >> 1, wv = wid & 1;
    const GAS bf16* kr = (const GAS bf16*)(ws + WS_KR); const GAS bf16* vr = (const GAS bf16*)(ws + WS_VR);
    GAS bf16* states = (GAS bf16*)a.out;
    f32x4 acc[2][4];
#pragma unroll
    for (int i = 0; i < 2; ++i)
#pragma unroll
        for (int j = 0; j < 4; ++j) acc[i][j] = (f32x4){0.f, 0.f, 0.f, 0.f};
    const int srow = tid >> 4, sch = tid & 15; const unsigned soff = offb(srow, sch);
    const GAS bf16* kp = kr + ((size_t)b * SEQ + srow) * 512 + h * 128 + sch * 8;
    const GAS bf16* vp = vr + ((size_t)b * SEQ + srow) * 1024 + h * 256 + vh * 128 + sch * 8;
    v4u kq[4], vq[4];
    { const int n0 = dir ? 15 : 0;
#pragma unroll
      for (int j = 0; j < 4; ++j) { kq[j] = *(const GAS v4u*)(kp + (size_t)(n0 * 128 + 32 * j) * 512); vq[j] = *(const GAS v4u*)(vp + (size_t)(n0 * 128 + 32 * j) * 1024); } }
    unsigned abase[2][2], bbase[4][2];
#pragma unroll
    for (int t = 0; t < 2; ++t) { const unsigned r = 8 * g + 4 * t + q;
#pragma unroll
        for (int dt = 0; dt < 2; ++dt) abase[dt][t] = offb(r, 2 * (2 * wd + dt) + (p >> 1)) + 8 * (p & 1);
#pragma unroll
        for (int vt = 0; vt < 4; ++vt) bbase[vt][t] = offb(r, 2 * (4 * wv + vt) + (p >> 1)) + 8 * (p & 1); }
#define CH_STAGE(BUFOFF) do { _Pragma("unroll") for (int j = 0; j < 4; ++j) { \
            const int row = srow + 32 * j; const float z = __builtin_amdgcn_exp2f(lg2 * (float)(dir ? row : 127 - row)); const v4u kv = kq[j]; \
            v4u ko; ko.x = cvtpk(bflo(kv.x) * z, bfhi(kv.x) * z); ko.y = cvtpk(bflo(kv.y) * z, bfhi(kv.y) * z); ko.z = cvtpk(bflo(kv.z) * z, bfhi(kv.z) * z); ko.w = cvtpk(bflo(kv.w) * z, bfhi(kv.w) * z); \
            *(LAS v4u*)(lds + (BUFOFF) + soff + j * 8192) = ko; *(LAS v4u*)(lds + (BUFOFF) + 32768 + soff + j * 8192) = vq[j]; } } while (0)
#define CH_FETCH(NN) do { _Pragma("unroll") for (int j = 0; j < 4; ++j) { kq[j] = *(const GAS v4u*)(kp + (size_t)((NN) * 128 + 32 * j) * 512); vq[j] = *(const GAS v4u*)(vp + (size_t)((NN) * 128 + 32 * j) * 1024); } } while (0)
#define CH_STEP(STEP, CUR, OTH) do { const int step_ = (STEP); const int n_ = dir ? 15 - step_ : step_; \
        GAS bf16* sb_ = states + ((((size_t)(b * 4 + h) * 16 + n_) * 2 + dir) * 256) * 128; \
        _Pragma("unroll") for (int dt = 0; dt < 2; ++dt) _Pragma("unroll") for (int vt = 0; vt < 4; ++vt) { \
            const int v_ = vh * 128 + 64 * wv + 16 * vt + i16, d0_ = 32 * wd + 16 * dt + 4 * g; \
            u32x2 w_; w_.x = pg8::cvt_pk_bf16_acc(acc[dt][vt][0], acc[dt][vt][1]); w_.y = pg8::cvt_pk_bf16_acc(acc[dt][vt][2], acc[dt][vt][3]);   \
            *(GAS u32x2*)(sb_ + (size_t)v_ * 128 + d0_) = w_; } \
        if (step_ < 15) CH_STAGE(OTH); \
        if (step_ < 14) CH_FETCH(dir ? 13 - step_ : step_ + 2); \
        _Pragma("unroll") for (int i = 0; i < 2; ++i) _Pragma("unroll") for (int j = 0; j < 4; ++j) acc[i][j] = acc[i][j] * cd; \
        _Pragma("unroll") for (int ks = 0; ks < 4; ++ks) { bf16x8 af[2], bfr[4]; \
            _Pragma("unroll") for (int dt = 0; dt < 2; ++dt) af[dt] = cat8(ldtr(lds + (CUR) + abase[dt][0] + ks * 8192), ldtr(lds + (CUR) + abase[dt][1] + ks * 8192)); \
            _Pragma("unroll") for (int vt = 0; vt < 4; ++vt) bfr[vt] = cat8(ldtr(lds + (CUR) + 32768 + bbase[vt][0] + ks * 8192), ldtr(lds + (CUR) + 32768 + bbase[vt][1] + ks * 8192)); \
            _Pragma("unroll") for (int dt = 0; dt < 2; ++dt) _Pragma("unroll") for (int vt = 0; vt < 4; ++vt) acc[dt][vt] = MFMA16(af[dt], bfr[vt], acc[dt][vt]); } \
        __syncthreads(); } while (0)
    CH_STAGE(0);
    CH_FETCH(dir ? 14 : 1);
    __syncthreads();
    for (int sp = 0; sp < 8; ++sp) { CH_STEP(2 * sp, 0, 65536); CH_STEP(2 * sp + 1, 65536, 0); }
#undef CH_STEP
#undef CH_STAGE
#undef CH_FETCH
}

constexpr int AT_OST = 135168, AT_SCR = AT_OST + 8 * 2048;
constexpr int ATB_N = 160;
struct AttnLane { unsigned kb[2]; unsigned vb[4]; };
__device__ __forceinline__ AttnLane attn_lane(int lane) {
    const int g = lane >> 4, i16 = lane & 15, q4 = i16 >> 2, p = lane & 3; AttnLane L;
#pragma unroll
    for (int s = 0; s < 2; ++s) L.kb[s] = i16 * 128 + (((4 * s + g) ^ ((i16 >> 1) & 7)) * 16);
    const int sw = (2 * g + (q4 >> 1)) & 3;
#pragma unroll
    for (int c = 0; c < 4; ++c) L.vb[c] = (4 * g + q4) * 128 + ((c ^ sw) * 32) + p * 8;
    return L;
}
__device__ __forceinline__ unsigned kimg_off(int row, int c) { return row * 128 + ((c ^ ((row >> 1) & 7)) * 16); }
__device__ __forceinline__ unsigned vimg_off(int row, int c) { return row * 128 + (((c >> 1) ^ ((row >> 1) & 3)) * 32) + (c & 1) * 16; }
__device__ __forceinline__ void attn_core(const LAS unsigned char* Kimg, const LAS unsigned char* Vimg, int R0, int nrows, unsigned tvalid, const bf16x8 (&qf)[2],
                                          const float (&biasr)[36], const AttnLane& L, f32x4 (&O)[4], float& mx, float& lsum) {
    f32x4 D[9];
#pragma unroll
    for (int kt = 0; kt < 9; ++kt) {
        int R = R0 + 16 * kt; R = R < 0 ? 0 : (R > nrows - 16 ? nrows - 16 : R);
        const LAS unsigned char* kp = Kimg + R * 128;
        const bf16x8 k0 = *(const LAS bf16x8*)(kp + L.kb[0]), k1 = *(const LAS bf16x8*)(kp + L.kb[1]);
        f32x4 d = (f32x4){0.f, 0.f, 0.f, 0.f};
        d = MFMA16(k0, qf[0], d); d = MFMA16(k1, qf[1], d); D[kt] = d;
    }
    mx = -1e30f;
#pragma unroll
    for (int kt = 0; kt < 9; ++kt) {
        const float tb = ((tvalid >> kt) & 1u) ? 0.f : -1e30f;
#pragma unroll
        for (int r = 0; r < 4; ++r) { const float x = D[kt][r] + (biasr[4 * kt + r] + tb); D[kt][r] = x; mx = fmaxf(mx, x); }
    }
    mx = fmaxf(mx, __shfl_xor(mx, 16)); mx = fmaxf(mx, __shfl_xor(mx, 32));
    lsum = 0.f;
#pragma unroll
    for (int kt = 0; kt < 9; ++kt)
#pragma unroll
        for (int r = 0; r < 4; ++r) { const float e = __builtin_amdgcn_exp2f(D[kt][r] - mx); D[kt][r] = e; lsum += e; }
    lsum += __shfl_xor(lsum, 16); lsum += __shfl_xor(lsum, 32);
#pragma unroll
    for (int c = 0; c < 4; ++c) O[c] = (f32x4){0.f, 0.f, 0.f, 0.f};
#pragma unroll
    for (int kk = 0; kk < 5; ++kk) {
        int Ra = R0 + 32 * kk; Ra = Ra < 0 ? 0 : (Ra > nrows - 16 ? nrows - 16 : Ra);
        int Rb = R0 + 32 * kk + 16; Rb = Rb < 0 ? 0 : (Rb > nrows - 16 ? nrows - 16 : Rb);
        if (kk == 4) Rb = Ra;
        const f32x4 e0 = D[2 * kk], e1 = kk < 4 ? D[2 * kk + 1] : (f32x4){0.f, 0.f, 0.f, 0.f};
        v4u pw; pw.x = cvtpk(e0[0], e0[1]); pw.y = cvtpk(e0[2], e0[3]); pw.z = cvtpk(e1[0], e1[1]); pw.w = cvtpk(e1[2], e1[3]);
        const bf16x8 pf = __builtin_bit_cast(bf16x8, pw);
        const LAS unsigned char* va_ = Vimg + Ra * 128; const LAS unsigned char* vb_ = Vimg + Rb * 128;
#pragma unroll
        for (int c = 0; c < 4; ++c) O[c] = MFMA16(pf, cat8(ldtr(va_ + L.vb[c]), ldtr(vb_ + L.vb[c])), O[c]);
    }
}
__device__ __forceinline__ void attn_stage_out(LAS unsigned char* lds, int wid, int lane, const f32x4 (&O)[4], float lsum) {
    const int g = lane >> 4, i16 = lane & 15;
    const float linv = 1.f / lsum;
    LAS bf16* st = (LAS bf16*)(lds + AT_OST + wid * 2048);
#pragma unroll
    for (int r = 0; r < 4; ++r) { const float li = __shfl(linv, 4 * g + r);
#pragma unroll
        for (int c = 0; c < 4; ++c) st[(4 * g + r) * 64 + 16 * c + i16] = (bf16)(cvtpk(O[c][r] * li, 0.f) & 0xffffu); }
}
__device__ __forceinline__ void attn_load_bias(const Args& a, int pat, int h, int lane, float (&biasr)[36]) {
    const GAS float* bt = (const GAS float*)(a.ws + WS_BIAS) + (pat * 8 + h) * ATB_N; const int g = lane >> 4, i16 = lane & 15;
#pragma unroll
    for (int kt = 0; kt < 9; ++kt)
#pragma unroll
        for (int r = 0; r < 4; ++r) biasr[4 * kt + r] = bt[16 * kt + 4 * g + r - 64 - i16 + 80];
}
template <int DIL, int VAR = 0> __device__ __forceinline__ void attn_dil_phase(const Args& a, LAS unsigned char* lds, int vcu, int G, int tid, int wid, int lane) {
    unsigned char* ws = a.ws;
    constexpr int NR = SEQ / DIL, PAT = DIL == 4 ? 1 : 2, CH = NR * 8 / 512, NITEM = NB * 8 * DIL;
    constexpr int NBUF = DIL == 16 ? 2 : 1, BUFB = 2 * NR * 128;
    const GAS bf16* qa = (const GAS bf16*)(ws + WS_QA); const GAS bf16* ka = (const GAS bf16*)(ws + WS_KA); const GAS bf16* va = (const GAS bf16*)(ws + WS_VA);
    bf16* op = (bf16*)(ws + (DIL == 4 ? WS_O2 : WS_O3)); float* lsep = (float*)(ws + (DIL == 4 ? WS_LSE2 : WS_LSE3));
    if (vcu >= NITEM) return;
    const int h = vcu & 7;
    float biasr[36]; attn_load_bias(a, PAT, h, lane, biasr);
    const AttnLane L = attn_lane(lane);
    const int g = lane >> 4, i16 = lane & 15;
    v4u kq[CH], vq[CH]; bf16x8 qn[2];
    auto issue = [&](int item, int gi) {
        const int rho = (item >> 3) % DIL, b = item / (8 * DIL); const size_t rowb = (size_t)b * SEQ;
#pragma unroll
        for (int j = 0; j < CH; ++j) { const int id = tid + 512 * j, row = id >> 3, c = id & 7; const size_t go = (rowb + (size_t)row * DIL + rho) * 512 + h * 64 + c * 8;
            kq[j] = *(const GAS v4u*)(ka + go); vq[j] = *(const GAS v4u*)(va + go); }
        const size_t qpos = rowb + (size_t)(16 * gi + i16) * DIL + rho;
#pragma unroll
        for (int s = 0; s < 2; ++s) qn[s] = *(const GAS bf16x8*)(qa + qpos * 512 + h * 64 + 32 * s + 8 * g);
    };
    issue(vcu, wid);
    int buf = 0;
    for (int item = vcu; item < NITEM; item += G) {
        const int rho = (item >> 3) % DIL, b = item / (8 * DIL); const size_t rowb = (size_t)b * SEQ;
        LAS unsigned char* Kimg = lds + buf * BUFB; LAS unsigned char* Vimg = Kimg + NR * 128;
        if (NBUF == 1) __syncthreads();
#pragma unroll
        for (int j = 0; j < CH; ++j) { const int id = tid + 512 * j, row = id >> 3, c = id & 7;
            *(LAS v4u*)(Kimg + kimg_off(row, c)) = kq[j]; *(LAS v4u*)(Vimg + vimg_off(row, c)) = vq[j]; }
        bf16x8 qf[2] = {qn[0], qn[1]};
        __syncthreads();
        if (NBUF == 2 && item + G < NITEM) issue(item + G, wid);
        for (int gi = wid; gi < NR / 16; gi += 8) {
            const int m0 = 16 * gi;
            if (NBUF == 1 && gi + 8 < NR / 16) {
                const size_t qpos = rowb + (size_t)(m0 + 128 + i16) * DIL + rho;
#pragma unroll
                for (int s = 0; s < 2; ++s) qn[s] = *(const GAS bf16x8*)(qa + qpos * 512 + h * 64 + 32 * s + 8 * g); }
            unsigned tvalid = 0u;
#pragma unroll
            for (int kt = 0; kt < 9; ++kt) { const int t0 = m0 - 64 + 16 * kt; tvalid |= (t0 >= 0 && t0 < NR) ? (1u << kt) : 0u; }
            f32x4 O[4]; float mx, lsum;
            if (VAR == 1) { mx = 0.f; lsum = 1.f;
#pragma unroll
                for (int c = 0; c < 4; ++c) O[c] = (f32x4){__builtin_bit_cast(float, qf[0][0] + c), 0.f, 0.f, 0.f}; }
            else attn_core(Kimg, Vimg, m0 - 64, NR, tvalid, qf, biasr, L, O, mx, lsum);
            attn_stage_out(lds, wid, lane, O, lsum);
            if (g == 0) lsep[(rowb + (size_t)(m0 + i16) * DIL + rho) * 8 + h] = mx + __log2f(lsum);
            asm volatile("s_waitcnt lgkmcnt(0)" ::: "memory");
            { const int q = lane >> 2, qt = lane & 3; const LAS v4u* sp = (const LAS v4u*)(lds + AT_OST + wid * 2048 + q * 128 + qt * 32);
              const v4u x0 = sp[0], x1 = sp[1]; bf16* dst = op + (rowb + (size_t)(m0 + q) * DIL + rho) * 512 + h * 64 + qt * 16;
              *(v4u*)dst = x0; *(v4u*)(dst + 8) = x1; }
            asm volatile("s_waitcnt lgkmcnt(0)" ::: "memory");
            if (NBUF == 1) { qf[0] = qn[0]; qf[1] = qn[1]; }
        }
        if (NBUF == 1 && item + G < NITEM) issue(item + G, wid);
        buf ^= (NBUF - 1);
    }
    __syncthreads();
}
__device__ __forceinline__ void attn_p1_phase(const Args& a, LAS unsigned char* lds, int vcu, int G, int tid, int wid, int lane) {
    unsigned char* ws = a.ws;
    LAS unsigned char* Kimg = lds; LAS unsigned char* Vimg = lds + 384 * 128;
    const GAS bf16* qa = (const GAS bf16*)(ws + WS_QA); const GAS bf16* ka = (const GAS bf16*)(ws + WS_KA); const GAS bf16* va = (const GAS bf16*)(ws + WS_VA);
    const GAS bf16* o2 = (const GAS bf16*)(ws + WS_O2); const GAS bf16* o3 = (const GAS bf16*)(ws + WS_O3);
    const GAS float* lse2 = (const GAS float*)(ws + WS_LSE2); const GAS float* lse3 = (const GAS float*)(ws + WS_LSE3);
    bf16* oa = (bf16*)(ws + WS_OA);
    if (vcu >= 1024) return;
    const int h = vcu & 7;
    float biasr[36]; attn_load_bias(a, 0, h, lane, biasr);
    const AttnLane L = attn_lane(lane);
    const int g = lane >> 4, i16 = lane & 15;
    LAS float* scr = (LAS float*)(lds + AT_SCR) + wid * 16;
    v4u kq[6], vq[6];
    auto issue = [&](int item) { const int b = item >> 6, s0 = ((item >> 3) & 7) * 256; const size_t rowb = (size_t)b * SEQ;
#pragma unroll
        for (int j = 0; j < 6; ++j) { const int id = tid + 512 * j, row = id >> 3, c = id & 7, pos = s0 - 64 + row; const bool ok = pos >= 0 && pos < SEQ;
            const size_t go = (rowb + (size_t)(ok ? pos : 0)) * 512 + h * 64 + c * 8;
            kq[j] = *(const GAS v4u*)(ka + go); vq[j] = *(const GAS v4u*)(va + go);
            if (!ok) { kq[j] = (v4u){0u, 0u, 0u, 0u}; vq[j] = (v4u){0u, 0u, 0u, 0u}; } } };
    issue(vcu);
    for (int item = vcu; item < 1024; item += G) {
        const int b = item >> 6, s0 = ((item >> 3) & 7) * 256; const size_t rowb = (size_t)b * SEQ;
        __syncthreads();
#pragma unroll
        for (int j = 0; j < 6; ++j) { const int id = tid + 512 * j, row = id >> 3, c = id & 7;
            *(LAS v4u*)(Kimg + kimg_off(row, c)) = kq[j]; *(LAS v4u*)(Vimg + vimg_off(row, c)) = vq[j]; }
        __syncthreads();
        if (item + G < 1024) issue(item + G);
        for (int gi = wid; gi < 16; gi += 8) {
            const int m0 = s0 + 16 * gi;
            const int q = lane >> 2, qt = lane & 3; const size_t tq = rowb + m0 + q;
            const v4u a20 = *(const GAS v4u*)(o2 + tq * 512 + h * 64 + qt * 16), a21 = *(const GAS v4u*)(o2 + tq * 512 + h * 64 + qt * 16 + 8);
            const v4u a30 = *(const GAS v4u*)(o3 + tq * 512 + h * 64 + qt * 16), a31 = *(const GAS v4u*)(o3 + tq * 512 + h * 64 + qt * 16 + 8);
            const float l2 = lse2[tq * 8 + h], l3 = lse3[tq * 8 + h];
            bf16x8 qf[2];
#pragma unroll
            for (int s = 0; s < 2; ++s) qf[s] = *(const GAS bf16x8*)(qa + (rowb + m0 + i16) * 512 + h * 64 + 32 * s + 8 * g);
            unsigned tvalid = 0u;
#pragma unroll
            for (int kt = 0; kt < 9; ++kt) { const int t0 = m0 - 64 + 16 * kt; tvalid |= (t0 >= 0 && t0 < SEQ) ? (1u << kt) : 0u; }
            f32x4 O[4]; float mx, lsum;
            attn_core(Kimg, Vimg, 16 * gi, 384, tvalid, qf, biasr, L, O, mx, lsum);
            attn_stage_out(lds, wid, lane, O, lsum);
            if (g == 0) scr[i16] = mx + __log2f(lsum);
            asm volatile("s_waitcnt lgkmcnt(0)" ::: "memory");
            {
                const float l1 = scr[q], M = fmaxf(l1, fmaxf(l2, l3));
                float w1 = __builtin_amdgcn_exp2f(l1 - M), w2 = __builtin_amdgcn_exp2f(l2 - M), w3 = __builtin_amdgcn_exp2f(l3 - M); const float wi = 1.f / (w1 + w2 + w3); w1 *= wi; w2 *= wi; w3 *= wi;
                const LAS v4u* sp = (const LAS v4u*)(lds + AT_OST + wid * 2048 + q * 128 + qt * 32);
                const v4u x0 = sp[0], x1 = sp[1];
                v4u r0, r1;
#define MRG(d, x, y, z) d = cvtpk(w1 * bflo(x) + w2 * bflo(y) + w3 * bflo(z), w1 * bfhi(x) + w2 * bfhi(y) + w3 * bfhi(z))
                MRG(r0.x, x0.x, a20.x, a30.x); MRG(r0.y, x0.y, a20.y, a30.y); MRG(r0.z, x0.z, a20.z, a30.z); MRG(r0.w, x0.w, a20.w, a30.w);
                MRG(r1.x, x1.x, a21.x, a31.x); MRG(r1.y, x1.y, a21.y, a31.y); MRG(r1.z, x1.z, a21.z, a31.z); MRG(r1.w, x1.w, a21.w, a31.w);
#undef MRG
#if MIX_FP8 & 2
                v4u o8;
                o8.x = pk_fp8x4(16.f * bflo(r0.x), 16.f * bfhi(r0.x), 16.f * bflo(r0.y), 16.f * bfhi(r0.y)); o8.y = pk_fp8x4(16.f * bflo(r0.z), 16.f * bfhi(r0.z), 16.f * bflo(r0.w), 16.f * bfhi(r0.w));
                o8.z = pk_fp8x4(16.f * bflo(r1.x), 16.f * bfhi(r1.x), 16.f * bflo(r1.y), 16.f * bfhi(r1.y)); o8.w = pk_fp8x4(16.f * bflo(r1.z), 16.f * bfhi(r1.z), 16.f * bflo(r1.w), 16.f * bfhi(r1.w));
                *(v4u*)((unsigned char*)oa + tq * 512 + h * 64 + qt * 16) = o8;
#else
                bf16* dst = oa + tq * 512 + h * 64 + qt * 16;
                *(v4u*)dst = r0; *(v4u*)(dst + 8) = r1;
#endif
            }
            asm volatile("s_waitcnt lgkmcnt(0)" ::: "memory");
        }
    }
    __syncthreads();
}

#define OPAQUE(x) asm volatile("" : "+v"(x))
template <int VAR = 0> __device__ __forceinline__ void p3_phase(const Args& a, LAS unsigned char* lds, int vcu, int G, int tid, int wid, int lane) {
    unsigned char* ws = a.ws;
    const int g = lane >> 4, i16 = lane & 15, q4 = i16 >> 2, p = lane & 3;
    const GAS bf16* qr = (const GAS bf16*)(ws + WS_QR); const GAS bf16* kr = (const GAS bf16*)(ws + WS_KR); const GAS bf16* vr = (const GAS bf16*)(ws + WS_VR);
    GAS bf16* gr = (GAS bf16*)(ws + WS_GR);
    LAS unsigned char* Kt = lds; LAS unsigned char* Sg = lds + 32768;
    if (vcu >= 1024) return;
    const unsigned kdst = offb(tid >> 4, tid & 15);
    unsigned rfo[4];
    { const unsigned X = ((i16 & 3) << 2) | (i16 >> 2);
#pragma unroll
      for (int s = 0; s < 4; ++s) rfo[s] = 256 * i16 + 16 * (((4 * s) ^ (X & 12)) | (g ^ (X & 3))); }
    v4u sreg[8], kreg[4]; bf16x8 qn[4];
    auto item_ptrs = [&](int item, size_t& tok0, const GAS bf16*& sf, int& h) { const int b = item >> 6; h = (item >> 4) & 3; const int n = item & 15; tok0 = (size_t)b * SEQ + n * 128;
        sf = (const GAS bf16*)a.out + ((((size_t)(b * 4 + h) * 16 + n) * 2 + 0) * 256) * 128; };
    auto issue_k = [&](int item) { size_t tok0; const GAS bf16* sf; int h; item_ptrs(item, tok0, sf, h);
        const GAS bf16* ks_ = kr + (tok0 + (tid >> 4)) * 512 + h * 128 + (tid & 15) * 8;
#pragma unroll
        for (int j = 0; j < 4; ++j) kreg[j] = *(const GAS v4u*)(ks_ + (size_t)j * 32 * 512); };
    auto issue_q = [&](int item) { size_t tok0; const GAS bf16* sf; int h; item_ptrs(item, tok0, sf, h);
#pragma unroll
        for (int s = 0; s < 4; ++s) qn[s] = *(const GAS bf16x8*)(qr + (tok0 + 16 * wid + i16) * 512 + h * 128 + 32 * s + 8 * g); };
    auto issue_state = [&](const GAS bf16* sf, int dirn) { const GAS bf16* sld = sf + (size_t)dirn * 256 * 128 + (size_t)(tid >> 4) * 128 + (tid & 15) * 8;
#pragma unroll
        for (int j = 0; j < 8; ++j) sreg[j] = *(const GAS v4u*)(sld + (size_t)j * 32 * 128); };
    auto write_state = [&]() {
#pragma unroll
        for (int j = 0; j < 8; ++j) *(LAS v4u*)(Sg + (j >> 2) * 32768 + kdst + (j & 3) * 8192) = sreg[j]; };
    { size_t tok0; const GAS bf16* sf; int h; item_ptrs(vcu, tok0, sf, h); issue_k(vcu); issue_q(vcu); issue_state(sf, 0); }
#pragma unroll
    for (int j = 0; j < 4; ++j) *(LAS v4u*)(Kt + kdst + j * 8192) = kreg[j];
    for (int item = vcu; item < 1024; item += G) {
        size_t tok0; const GAS bf16* sf; int h; item_ptrs(item, tok0, sf, h);
        const float lf2 = log2_gamma(a.in[2], h), lb2 = log2_gamma(a.in[3], h);
        bf16x8 qf[4];
#pragma unroll
        for (int s = 0; s < 4; ++s) qf[s] = qn[s];
        const bool has_next = item + G < 1024;
        __syncthreads();
        f32x4 D[8];
#pragma unroll
        for (int jt = 0; jt < 8; ++jt) {
            f32x4 d = (f32x4){0.f, 0.f, 0.f, 0.f};
#pragma unroll
            for (int s = 0; s < 4; ++s) { if (VAR != 1) { const bf16x8 kf = *(const LAS bf16x8*)(Kt + rfo[s] + jt * 4096); d = MFMA16(kf, qf[s], d); } else d[s] = __builtin_bit_cast(float, (int)qf[s][0]); }
            D[jt] = d;
        }
        int iq = 16 * wid + i16; OPAQUE(iq);
        bf16x8 pf[4];
#pragma unroll
        for (int ks = 0; ks < 4; ++ks) {
            float e[8];
#pragma unroll
            for (int t = 0; t < 2; ++t)
#pragma unroll
                for (int r = 0; r < 4; ++r) {
                    const int j = 16 * (2 * ks + t) + 4 * g + r; const float fdf = (float)(iq - j), ad = fabsf(fdf);
                    const float pos = fminf(fmaxf(fdf, 0.f), 1.f), isz = 1.f - fminf(ad, 1.f);
                    const float w = __builtin_amdgcn_exp2f((lb2 + (lf2 - lb2) * pos) * ad) + isz;
                    e[4 * t + r] = D[2 * ks + t][r] * w;
                }
            v4u pw; pw.x = cvtpk(e[0], e[1]); pw.y = cvtpk(e[2], e[3]); pw.z = cvtpk(e[4], e[5]); pw.w = cvtpk(e[6], e[7]);
            pf[ks] = __builtin_bit_cast(bf16x8, pw);
        }
        f32x4 acc[16];
#pragma unroll
        for (int vt = 0; vt < 16; ++vt) acc[vt] = (f32x4){0.f, 0.f, 0.f, 0.f};
#pragma unroll
        for (int dirn = 0; dirn < 2; ++dirn) {
            if (dirn == 1) __syncthreads();
            write_state();
            if (dirn == 0) { issue_state(sf, 1); if (has_next) issue_k(item + G); }
            else {
                if (has_next) {
#pragma unroll
                    for (int j = 0; j < 4; ++j) *(LAS v4u*)(Kt + kdst + j * 8192) = kreg[j]; }
                const GAS bf16* vs_ = vr + (tok0 + (tid >> 5)) * 1024 + h * 256 + (tid & 31) * 8;
#pragma unroll
                for (int j = 0; j < 8; ++j) sreg[j] = *(const GAS v4u*)(vs_ + (size_t)j * 16 * 1024);
            }
            __syncthreads();
#pragma unroll
            for (int vt = 0; vt < 16; ++vt) {
#pragma unroll
                for (int s = 0; s < 4; ++s) { if (VAR != 1) { const bf16x8 sfr = *(const LAS bf16x8*)(Sg + (vt >> 3) * 32768 + rfo[s] + (vt & 7) * 4096); acc[vt] = MFMA16(qf[s], sfr, acc[vt]); } }
            }
            float xs[4];
            { int ib = 16 * wid + 4 * g; OPAQUE(ib);
#pragma unroll
              for (int r = 0; r < 4; ++r) { const float lxf = lf2 * (float)(ib + r + 1), lxb = lb2 * (float)(128 - ib - r); xs[r] = __builtin_amdgcn_exp2f(dirn == 0 ? lxf - lxb : lxb); } }
#pragma unroll
            for (int vt = 0; vt < 16; ++vt)
#pragma unroll
                for (int r = 0; r < 4; ++r) acc[vt][r] *= xs[r];
        }
        __syncthreads();
        { int t2 = tid; OPAQUE(t2); const unsigned vd2 = (unsigned)((t2 & 31) >> 4) * 32768u + offb(t2 >> 5, t2 & 15);
#pragma unroll
          for (int j = 0; j < 8; ++j) *(LAS v4u*)(Sg + vd2 + j * 4096) = sreg[j]; }
        GAS bf16* gp = gr + (tok0 + 16 * wid + (lane >> 5)) * 1024 + h * 256 + (lane & 31) * 8;
#if MIX_FP8 & 4
        GAS unsigned char* ar8 = (GAS unsigned char*)(ws + WS_AR8) + (tok0 + 16 * wid + (lane >> 5)) * 1024 + h * 256 + (lane & 31) * 8;
#endif
        __syncthreads();
        unsigned vbs[8];
        { int l2 = lane; OPAQUE(l2); const unsigned g2 = l2 >> 4, q2 = (l2 & 15) >> 2, p2 = l2 & 3, X = (q2 << 2) | g2;
#pragma unroll
          for (int c = 0; c < 8; ++c) vbs[c] = 256 * (4 * g2 + q2) + 16 * (((2 * c) ^ (X & 14)) | ((p2 >> 1) ^ (X & 1))) + 8 * (p2 & 1); }
#pragma unroll
        for (int vt = 0; vt < 16; ++vt) {
#pragma unroll
            for (int ks = 0; ks < 4; ++ks) { if (VAR != 1) {
                const s16x4 lo = ldtr(Sg + vbs[vt & 7] + (vt >> 3) * 32768 + ks * 8192), hi = ldtr(Sg + vbs[vt & 7] + (vt >> 3) * 32768 + ks * 8192 + 4096);
                acc[vt] = MFMA16(pf[ks], cat8(lo, hi), acc[vt]); }
            }
            asm volatile("" ::: "memory");
        }
        float mu[4], rs[4];
#pragma unroll
        for (int r = 0; r < 4; ++r) {
            float s = 0.f;
#pragma unroll
            for (int vt = 0; vt < 16; ++vt) s += acc[vt][r];
            s += __shfl_xor(s, 1); s += __shfl_xor(s, 2); s += __shfl_xor(s, 4); s += __shfl_xor(s, 8);
            const float m = s * (1.f / 256.f); float qv = 0.f;
#pragma unroll
            for (int vt = 0; vt < 16; ++vt) { const float d = acc[vt][r] - m; qv += d * d; }
            qv += __shfl_xor(qv, 1); qv += __shfl_xor(qv, 2); qv += __shfl_xor(qv, 4); qv += __shfl_xor(qv, 8);
            mu[r] = m; rs[r] = 1.f / sqrtf(qv * (1.f / 256.f) + LN_EPSF);
        }
        v4u greg[8];
#pragma unroll
        for (int j = 0; j < 8; ++j) greg[j] = *(const GAS v4u*)(gp + (size_t)j * 2048);
        __syncthreads();
        if (has_next) { size_t tk; const GAS bf16* sfn; int hn; item_ptrs(item + G, tk, sfn, hn); issue_state(sfn, 0); issue_q(item + G); }
        LAS bf16* st = (LAS bf16*)(Sg + wid * 8192);
        { LAS bf16* sp_ = st + (4 * g) * 256 + i16;
#pragma unroll
          for (int vt = 0; vt < 16; ++vt)
#pragma unroll
              for (int r = 0; r < 4; ++r) sp_[r * 256 + 16 * vt] = (bf16)(cvtpk((acc[vt][r] - mu[r]) * rs[r], 0.f) & 0xffffu); }
        asm volatile("s_waitcnt lgkmcnt(0)" ::: "memory");
        {
            const float* gn = a.in[4] + h * 256; const int ch = lane & 31;
            const f32x4 g0 = *(const f32x4*)(gn + ch * 8), g1 = *(const f32x4*)(gn + ch * 8 + 4);
            const LAS bf16* yp = st + (lane >> 5) * 256 + ch * 8;
#pragma unroll
            for (int j = 0; j < 8; ++j) {
                const v4u y = *(const LAS v4u*)(yp + j * 512); const v4u sg = greg[j];
#if SILU_IN_P3
#define GSW(w, hi) pg8::fsilu((hi) ? bfhi(w) : bflo(w))
#else
#define GSW(w, hi) ((hi) ? bfhi(w) : bflo(w))
#endif
                v4u o; o.x = cvtpk(bflo(y.x) * g0[0] * GSW(sg.x, 0), bfhi(y.x) * g0[1] * GSW(sg.x, 1)); o.y = cvtpk(bflo(y.y) * g0[2] * GSW(sg.y, 0), bfhi(y.y) * g0[3] * GSW(sg.y, 1));
                o.z = cvtpk(bflo(y.z) * g1[0] * GSW(sg.z, 0), bfhi(y.z) * g1[1] * GSW(sg.z, 1)); o.w = cvtpk(bflo(y.w) * g1[2] * GSW(sg.w, 0), bfhi(y.w) * g1[3] * GSW(sg.w, 1));
#undef GSW
#if MIX_FP8 & 4
                u32x2 o8; o8.x = pk_fp8x4(bflo(o.x), bfhi(o.x), bflo(o.y), bfhi(o.y)); o8.y = pk_fp8x4(bflo(o.z), bfhi(o.z), bflo(o.w), bfhi(o.w));
                *(GAS u32x2*)(ar8 + (size_t)j * 2048) = o8;
#else
                *(GAS v4u*)(gp + (size_t)j * 2048) = o;
#endif
            }
        }
        __syncthreads();
    }
}

constexpr int P6_RS = 81920, P6_CNT = P6_RS + 8 * 512, P6_BASE = P6_CNT + 64, P6_ROW = P6_BASE + 64;
#define P6_BUTTERFLY(lg, out) do { float r10[10], r5[5], r3[3], r2[2]; const float z = 0.f; \
    _Pragma("unroll") for (int k = 0; k < 10; ++k) { const float keep = h32 ? lg[10 + k] : lg[k], send = h32 ? lg[k] : lg[10 + k]; r10[k] = keep + __shfl_xor(send, 32); } \
    _Pragma("unroll") for (int k = 0; k < 5; ++k) { const float keep = h16 ? r10[5 + k] : r10[k], send = h16 ? r10[k] : r10[5 + k]; r5[k] = keep + __shfl_xor(send, 16); } \
    { const float keep = h8 ? r5[3] : r5[0], send = h8 ? r5[0] : r5[3]; r3[0] = keep + __shfl_xor(send, 8); } \
    { const float keep = h8 ? r5[4] : r5[1], send = h8 ? r5[1] : r5[4]; r3[1] = keep + __shfl_xor(send, 8); } \
    { const float keep = h8 ? z : r5[2], send = h8 ? r5[2] : z; r3[2] = keep + __shfl_xor(send, 8); } \
    { const float keep = h4 ? r3[2] : r3[0], send = h4 ? r3[0] : r3[2]; r2[0] = keep + __shfl_xor(send, 4); } \
    { const float keep = h4 ? z : r3[1], send = h4 ? r3[1] : z; r2[1] = keep + __shfl_xor(send, 4); } \
    { const float keep = h2 ? r2[1] : r2[0], send = h2 ? r2[0] : r2[1]; out = keep + __shfl_xor(send, 2); } \
    out += __shfl_xor(out, 1); } while (0)
__device__ __forceinline__ void p6a_phase(const Args& a, LAS unsigned char* lds, int vcu, int G, int tid, int wave, int lane) {
    unsigned char* ws = a.ws;
    LAS float* RW = (LAS float*)lds;
    LAS float* RS = (LAS float*)(lds + P6_RS) + wave * 128;
    LAS unsigned* LC = (LAS unsigned*)(lds + P6_CNT); LAS unsigned* LB = (LAS unsigned*)(lds + P6_BASE); LAS unsigned* LR = (LAS unsigned*)(lds + P6_ROW);
    for (int i = tid; i < 1024 * 4; i += 512) { const int c = i >> 2, k = i & 3; RW[k * 1024 + c] = a.in[11][i]; }
    for (int i = tid; i < 1024 * 16; i += 512) { const int c = i >> 4, k = i & 15; RW[(4 + k) * 1024 + c] = a.in[13][i]; }
    const u32x2* pre = (const u32x2*)a.out; u32x2* x1b = (u32x2*)(ws + WS_XB); [[maybe_unused]] unsigned* x1f8 = (unsigned*)(ws + WS_X1F8);
    gu32* ctl = (gu32*)ws;
    int* ltok = (int*)(ws + WS_LTOK); float* tw = (float*)(ws + WS_WSLOT); unsigned* tinfo = (unsigned*)(ws + WS_TINFO);
    const float* g1 = a.in[9]; const float* b1 = a.in[10];
    const bool h32 = (lane & 32) != 0, h16 = (lane & 16) != 0, h8 = (lane & 8) != 0, h4 = (lane & 4) != 0, h2 = (lane & 2) != 0;
#define P6_LOADROW(dst, t_) do { const u32x2* xr_ = pre + (size_t)(t_) * 256 + lane; _Pragma("unroll") for (int j = 0; j < 4; ++j) dst[j] = xr_[64 * j]; } while (0)
#define P6_LN(v, nx, s) do { s = 0.f; _Pragma("unroll") for (int j = 0; j < 4; ++j) { v[j] = (f32x4){bflo(nx[j].x), bfhi(nx[j].x), bflo(nx[j].y), bfhi(nx[j].y)}; s += (v[j].x + v[j].y) + (v[j].z + v[j].w); } } while (0)
#define P6_VAR(v, mean, q) do { q = 0.f; _Pragma("unroll") for (int j = 0; j < 4; ++j) { v[j] = v[j] - mean; q += (v[j].x * v[j].x + v[j].y * v[j].y) + (v[j].z * v[j].z + v[j].w * v[j].w); } } while (0)
#if M1_FP8
#define P6_STORE(v, t_, j) do { u32x2 o_; o_.x = cvtpk(v[j].x, v[j].y); o_.y = cvtpk(v[j].z, v[j].w); x1b[(size_t)(t_) * 256 + lane + 64 * j] = o_; x1f8[(size_t)(t_) * 256 + lane + 64 * j] = pk_fp8x4(v[j].x, v[j].y, v[j].z, v[j].w); } while (0)
#else
#define P6_STORE(v, t_, j) do { u32x2 o_; o_.x = cvtpk(v[j].x, v[j].y); o_.y = cvtpk(v[j].z, v[j].w); x1b[(size_t)(t_) * 256 + lane + 64 * j] = o_; } while (0)
#endif
#define P6_DOT(lg, v, j, k, w) lg[k] += (v[j][0] * w[0] + v[j][1] * w[1]) + (v[j][2] * w[2] + v[j][3] * w[3])
    for (int blk = vcu; blk < TT / 128; blk += G) {
        if (tid < 16) LC[tid] = 0u;
        __syncthreads();
        const int t0 = blk * 128;
        u32x2 nxA[4], nxB[4], nxC[4], nxD[4];
        P6_LOADROW(nxA, t0 + wave); P6_LOADROW(nxB, t0 + wave + 8); P6_LOADROW(nxC, t0 + wave + 16); P6_LOADROW(nxD, t0 + wave + 24);
        for (int rr = 0; rr < 4; ++rr) {
            const int rl0 = wave + 32 * rr, tA = t0 + rl0, tB = tA + 8, tC = tA + 16, tD = tA + 24;
            f32x4 vA[4], vB[4], vC[4], vD[4]; float sA, sB, sC, sD;
            P6_LN(vA, nxA, sA); P6_LN(vB, nxB, sB); P6_LN(vC, nxC, sC); P6_LN(vD, nxD, sD);
            if (rr < 3) { P6_LOADROW(nxA, tA + 32); P6_LOADROW(nxB, tB + 32); P6_LOADROW(nxC, tC + 32); P6_LOADROW(nxD, tD + 32); }
            const float mA = wave_sum(sA) * (1.f / DM), mB = wave_sum(sB) * (1.f / DM), mC = wave_sum(sC) * (1.f / DM), mD = wave_sum(sD) * (1.f / DM);
            float qA, qB, qC, qD;
            P6_VAR(vA, mA, qA); P6_VAR(vB, mB, qB); P6_VAR(vC, mC, qC); P6_VAR(vD, mD, qD);
            const float rA = 1.f / sqrtf(wave_sum(qA) * (1.f / DM) + LN_EPSF), rB = 1.f / sqrtf(wave_sum(qB) * (1.f / DM) + LN_EPSF);
            const float rC = 1.f / sqrtf(wave_sum(qC) * (1.f / DM) + LN_EPSF), rD = 1.f / sqrtf(wave_sum(qD) * (1.f / DM) + LN_EPSF);
            float lgA[20], lgB[20], lgC[20], lgD[20];
#pragma unroll
            for (int k = 0; k < 20; ++k) { lgA[k] = 0.f; lgB[k] = 0.f; lgC[k] = 0.f; lgD[k] = 0.f; }
#pragma unroll
            for (int j = 0; j < 4; ++j) {
                const f32x4 gg = *(const f32x4*)(g1 + 4 * lane + 256 * j), bb = *(const f32x4*)(b1 + 4 * lane + 256 * j);
                vA[j] = vA[j] * rA * gg + bb; vB[j] = vB[j] * rB * gg + bb; vC[j] = vC[j] * rC * gg + bb; vD[j] = vD[j] * rD * gg + bb;
                P6_STORE(vA, tA, j); P6_STORE(vB, tB, j); P6_STORE(vC, tC, j); P6_STORE(vD, tD, j);
#pragma unroll
                for (int k = 0; k < 20; ++k) { const f32x4 w = *(const LAS f32x4*)(RW + k * 1024 + 4 * lane + 256 * j);
                    P6_DOT(lgA, vA, j, k, w); P6_DOT(lgB, vB, j, k, w); P6_DOT(lgC, vC, j, k, w); P6_DOT(lgD, vD, j, k, w); }
            }
            float r1A, r1B, r1C, r1D;
            P6_BUTTERFLY(lgA, r1A); P6_BUTTERFLY(lgB, r1B); P6_BUTTERFLY(lgC, r1C); P6_BUTTERFLY(lgD, r1D);
            {
                const int i3 = h2 ? (h4 ? -1 : 1) : (h4 ? 2 : 0);
                const int i5 = i3 < 0 ? -1 : (h8 ? (i3 == 2 ? -1 : i3 + 3) : i3);
                const int kk = i5 < 0 ? -1 : (h32 ? 10 : 0) + (h16 ? 5 : 0) + i5;
                if (kk >= 0 && (lane & 1) == 0) { RS[kk] = r1A; RS[32 + kk] = r1B; RS[64 + kk] = r1C; RS[96 + kk] = r1D; }
            }
            asm volatile("s_waitcnt lgkmcnt(0)" ::: "memory");
            {
                const int sel = lane & 3; const int rl = rl0 + 8 * sel;
                float tl[20];
#pragma unroll
                for (int k4 = 0; k4 < 5; ++k4) { const f32x4 w = *(const LAS f32x4*)(RS + sel * 32 + 4 * k4); tl[4 * k4] = w[0]; tl[4 * k4 + 1] = w[1]; tl[4 * k4 + 2] = w[2]; tl[4 * k4 + 3] = w[3]; }
                float gl[4];
#pragma unroll
                for (int k = 0; k < 4; ++k) gl[k] = tl[k] + a.in[12][k];
                int gi = 0; float gm = gl[0];
#pragma unroll
                for (int k = 1; k < 4; ++k) if (gl[k] > gm) { gm = gl[k]; gi = k; }
                float gs = 0.f;
#pragma unroll
                for (int k = 0; k < 4; ++k) gs += __expf(gl[k] - gm);
                const float gwt = 1.f / gs;
                float el[4];
#pragma unroll
                for (int k = 0; k < 4; ++k) { const float se = gi == 0 ? tl[4 + k] : (gi == 1 ? tl[8 + k] : (gi == 2 ? tl[12 + k] : tl[16 + k])); el[k] = se + a.in[14][4 * gi + k]; }
                int i1 = 0; float v1 = el[0];
#pragma unroll
                for (int k = 1; k < 4; ++k) if (el[k] > v1) { v1 = el[k]; i1 = k; }
                int i2 = (i1 + 1) & 3; float v2 = -3.0e38f;
#pragma unroll
                for (int k = 0; k < 4; ++k) if (k != i1 && el[k] > v2) { v2 = el[k]; i2 = k; }
                const float ex = __expf(v2 - v1), w1 = gwt / (1.f + ex), w2 = gwt * ex / (1.f + ex);
                if (lane < 4) {
                    const int e1 = 4 * gi + i1, e2 = 4 * gi + i2;
                    const unsigned p1 = __hip_atomic_fetch_add(LC + e1, 1u, __ATOMIC_RELAXED, __HIP_MEMORY_SCOPE_WORKGROUP);
                    const unsigned p2 = __hip_atomic_fetch_add(LC + e2, 1u, __ATOMIC_RELAXED, __HIP_MEMORY_SCOPE_WORKGROUP);
                    LR[rl * 4 + 0] = ((unsigned)e1 << 16) | p1; LR[rl * 4 + 1] = ((unsigned)e2 << 16) | p2; LR[rl * 4 + 2] = __float_as_uint(w1); LR[rl * 4 + 3] = __float_as_uint(w2);
                }
            }
            asm volatile("s_waitcnt lgkmcnt(0)" ::: "memory");
        }
        __syncthreads();
        if (tid < 16) LB[tid] = __hip_atomic_fetch_add(ctl + CW_CNT + 64 * tid, LC[tid], __ATOMIC_RELAXED, __HIP_MEMORY_SCOPE_AGENT);
        __syncthreads();
        if (tid < 256) {
            const int rl = tid >> 1, j = tid & 1; const unsigned rec = LR[rl * 4 + j]; const unsigned e = rec >> 16, pos = LB[e] + (rec & 0xffffu);
            ltok[e * TT + pos] = t0 + rl; tw[2 * (t0 + rl) + j] = __uint_as_float(LR[rl * 4 + 2 + j]); tinfo[2 * (t0 + rl) + j] = (e << 16) | pos;
        }
        __syncthreads();
    }
#undef P6_LOADROW
#undef P6_LN
#undef P6_VAR
#undef P6_STORE
#undef P6_DOT
}
__device__ __forceinline__ void build_tile_tables(const Args& a, LAS unsigned char* lds, int tid) {
    LAS int* ts = (LAS int*)(lds + LDS_TS_OFF); LAS int* te = (LAS int*)(lds + LDS_TE_OFF); LAS int* cn = (LAS int*)(lds + LDS_CNT_OFF);
    gu32* ctl = (gu32*)a.ws;
    if (tid == 0) { int acc = 0;
        for (int e = 0; e < 16; ++e) { ts[e] = acc; const int c = (int)__hip_atomic_load(ctl + CW_CNT + 64 * e, __ATOMIC_RELAXED, __HIP_MEMORY_SCOPE_AGENT); const int nt = (c + 255) >> 8; cn[e] = c;
            for (int k = 0; k < nt; ++k) te[acc + k] = e; acc += nt; }
        ts[16] = acc; }
    __syncthreads();
}
__device__ __forceinline__ void p9_phase(const Args& a, LAS unsigned char* lds, int vcu, int G, int wave, int lane) {
    unsigned char* ws = a.ws;
    const LAS int* ts = (const LAS int*)(lds + LDS_TS_OFF);
    const unsigned* tinfo = (const unsigned*)(ws + WS_TINFO); const u32x2* Y = (const u32x2*)(ws + WS_Y);
    const float* g2 = a.in[18]; const float* b2 = a.in[19];
    const int gw = vcu * NWAVES + wave, NGW = G * NWAVES;
#if Y_FP8
    const unsigned* Y8 = (const unsigned*)(ws + WS_Y); unsigned ny0[4], ny1[4]; u32x2 nxw[4]; float nw0 = 0.f, nw1 = 0.f;
#else
    u32x2 ny0[4], ny1[4], nxw[4]; float nw0 = 0.f, nw1 = 0.f;
#endif
    const float* tw = (const float*)(ws + WS_WSLOT);
    auto issue = [&](int t) {
        const unsigned i0 = tinfo[2 * t], i1 = tinfo[2 * t + 1];
        nw0 = tw[2 * t]; nw1 = tw[2 * t + 1];
        const size_t s0 = (size_t)ts[i0 >> 16] * 256 + (i0 & 0xffffu), s1 = (size_t)ts[i1 >> 16] * 256 + (i1 & 0xffffu);
        const u32x2* xb1 = (const u32x2*)(ws + WS_XB) + (size_t)t * 256 + lane;
#pragma unroll
#if Y_FP8
        for (int j = 0; j < 4; ++j) { ny0[j] = Y8[s0 * 256 + lane + 64 * j]; ny1[j] = Y8[s1 * 256 + lane + 64 * j]; nxw[j] = xb1[64 * j]; }
#else
        for (int j = 0; j < 4; ++j) { ny0[j] = Y[s0 * 256 + lane + 64 * j]; ny1[j] = Y[s1 * 256 + lane + 64 * j]; nxw[j] = xb1[64 * j]; }
#endif
    };
    if (gw < TT) issue(gw);
    for (int t = gw; t < TT; t += NGW) {
        f32x4* xr = (f32x4*)(a.out + (size_t)t * DM) + lane;
#if Y_FP8
        f32x4 v[4]; float s = 0.f; const float w0 = nw0 * 0.0625f, w1 = nw1 * 0.0625f;
#pragma unroll
        for (int j = 0; j < 4; ++j) {
            const unsigned y0 = ny0[j], y1 = ny1[j]; const u32x2 xw = nxw[j];
            typedef float f32x2_ __attribute__((ext_vector_type(2)));
            const f32x2_ a0 = __builtin_amdgcn_cvt_pk_f32_fp8(y0, false), a1 = __builtin_amdgcn_cvt_pk_f32_fp8(y0, true), c0 = __builtin_amdgcn_cvt_pk_f32_fp8(y1, false), c1 = __builtin_amdgcn_cvt_pk_f32_fp8(y1, true);
            f32x4 x = (f32x4){bflo(xw.x), bfhi(xw.x), bflo(xw.y), bfhi(xw.y)} * DN_ALPHA;
            x.x += w0 * a0[0] + w1 * c0[0]; x.y += w0 * a0[1] + w1 * c0[1]; x.z += w0 * a1[0] + w1 * c1[0]; x.w += w0 * a1[1] + w1 * c1[1];
            v[j] = x; s += (x.x + x.y) + (x.z + x.w);
        }
#else
        f32x4 v[4]; float s = 0.f; const float w0 = nw0, w1 = nw1;
#pragma unroll
        for (int j = 0; j < 4; ++j) {
            const u32x2 y0 = ny0[j], y1 = ny1[j], xw = nxw[j];
            f32x4 x = (f32x4){bflo(xw.x), bfhi(xw.x), bflo(xw.y), bfhi(xw.y)} * DN_ALPHA;
            x.x += w0 * bflo(y0.x) + w1 * bflo(y1.x); x.y += w0 * bfhi(y0.x) + w1 * bfhi(y1.x); x.z += w0 * bflo(y0.y) + w1 * bflo(y1.y); x.w += w0 * bfhi(y0.y) + w1 * bfhi(y1.y);
            v[j] = x; s += (x.x + x.y) + (x.z + x.w);
        }
#endif
        if (t + NGW < TT) issue(t + NGW);
        const float mean = wave_sum(s) * (1.f / DM); float s2 = 0.f;
#pragma unroll
        for (int j = 0; j < 4; ++j) { v[j] = v[j] - mean; s2 += (v[j].x * v[j].x + v[j].y * v[j].y) + (v[j].z * v[j].z + v[j].w * v[j].w); }
        const float rstd = 1.f / sqrtf(wave_sum(s2) * (1.f / DM) + LN_EPSF);
#pragma unroll
        for (int j = 0; j < 4; ++j) { const f32x4 gg = *(const f32x4*)(g2 + 4 * lane + 256 * j), bb = *(const f32x4*)(b2 + 4 * lane + 256 * j); xr[64 * j] = v[j] * rstd * gg + bb; }
    }
}

__global__ void __launch_bounds__(NWAVES * 64, 2) mega_fwd(Args args) {
    extern __shared__ __attribute__((aligned(16))) unsigned char lds_raw[];
    LAS unsigned char* lds = (LAS unsigned char*)lds_raw;
    volatile LAS unsigned* MISC = (volatile LAS unsigned*)(lds + MISC_OFF);
    const int tid0 = threadIdx.x, wave = __builtin_amdgcn_readfirstlane(tid0 >> 6);
    const int G = gridDim.x, bx = blockIdx.x, vcu = (G % 8 == 0) ? (bx % 8) * (G / 8) + bx / 8 : bx;
    for (int u = tid0; u < (LDS_BYTES - LDSCTL_OFF) / 4; u += NWAVES * 64) ((LAS unsigned*)(lds + LDSCTL_OFF))[u] = 0u;
    __syncthreads();
    unsigned char* ws = args.ws;
    gu32* ctl = (gu32*)ws;
    const bool bars_on = (args.mask >> 31) != 0u;
    XcdBarrier bar; bar.bar = (unsigned*)(ctl + CW_BAR) + args.bar_region * XCD_BAR_WORDS; bar.x = 0; bar.st = nullptr;
    if (bars_on) bar = xcd_barrier_post((unsigned*)(ctl + CW_BAR) + args.bar_region * XCD_BAR_WORDS, MISC + 8);
    bar.wv = wave;
#define GRID_BAR() do { if (bars_on) xcd_barrier(bar); } while (0)
#ifndef PH_LAST
#define PH_LAST 99
#endif
#define FRESH() int tid = wave * 64 + pg8::lane_id(); asm volatile("" : "+v"(tid)); const int lane = tid & 63; (void)lane
#ifndef RMASK
#define RMASK 0
#endif
#define REP(k) _Pragma("unroll") for (int rep_ = 0; rep_ < 1 + ((RMASK >> (k)) & 1); ++rep_)
#ifndef STAMP_SCALE
#define STAMP_SCALE 1.0f
#endif
#ifdef STAMP_PH
#define ST_B(k) if ((k) == STAMP_PH) { st_a = rt(); }
#define ST_E(k) if ((k) == STAMP_PH) { st_b = rt(); }
#else
#define ST_B(k)
#define ST_E(k)
#endif
#ifdef ONLY
#define EN(k) (ONLY == (k))
#else
#define EN(k) ((args.mask >> (k)) & 1u)
#endif
    unsigned long long st_a = 0, st_b = 0; (void)st_a; (void)st_b;
    REP(0) if (EN(0)) { FRESH(); p0_prologue(args, lds, vcu, G, tid, wave, lane); }
    GRID_BAR();
#ifdef STAGGER_TICKS
    if (EN(1) && (bx & 8)) { const unsigned long long t0_ = rt(); while (rt() - t0_ < STAGGER_TICKS) __builtin_amdgcn_s_sleep(32); }
#endif
    REP(1) if (EN(1)) {
#if P1_FP8
        pg8::EpiHcat E{ws, (const float*)(ws + WS_ROT), 0};
        if (P1_FP8_FROM > 0) {
            pg8::Gemm g{(const pg8::bf16_t*)(ws + WS_XB), (const pg8::bf16_t*)(ws + WS_WIN), TT, 4608, 1024}; pg8::StaticOrder S; S.init(TT, 256 * P1_FP8_FROM, G, bx);
            pg8::gemm_phase<pg8::EpiHcat, pg8::StaticOrder, true, true>(lds, g, S, E, wave);
        }
        {
#if GATE_FP8
            pg8::Gemm g{(const pg8::bf16_t*)(ws + WS_X8_LO), (const pg8::bf16_t*)(ws + WS_WIN8), TT, 4608, 512, 64, (long)WS_X8_HI - (long)WS_X8_LO - (long)(16 * MiB)}; pg8::StaticOrder S;
#else
            pg8::Gemm g{(const pg8::bf16_t*)args.out, (const pg8::bf16_t*)(ws + WS_WIN8), TT, 4608, 512}; pg8::StaticOrder S;
#endif
            S.init(TT, 4608 - 256 * P1_FP8_FROM, G, bx, P1_FP8_FROM);
#if CONV_BG
            pg8::P1Order SB; SB.S = S; SB.cv = pg8::ExpertConv{args.in[15], args.in[16], args.in[17], ws + WS_WGU, ws + WS_WD, vcu * NWAVES + wave, G * NWAVES, vcu % 9};
            pg8::gemm_phase<pg8::EpiHcat, pg8::P1Order, true, true, false, true, 1, 0>(lds, g, SB, E, wave);
            { FRESH();
              for (int k = 0; SB.cv.gw + k * SB.cv.nw < 6144; ++k) { pg8::Unit tu; const bool in_gap = k < 3 && S.next(pg8::P1Order::unit_of(SB.cv.grp, k), tu) && pg8::P1Order::unit_of(SB.cv.grp, k) < 9;
                  if (!in_gap) pg8::expert_conv_item(SB.cv, k, lane); } }
#else
            pg8::gemm_phase<pg8::EpiHcat, pg8::StaticOrder, true, true, false, true, 1, 0>(lds, g, S, E, wave);
#endif
        }
#else
        pg8::Gemm g{(const pg8::bf16_t*)(ws + WS_XB), (const pg8::bf16_t*)(ws + WS_WIN), TT, 4608, 1024}; pg8::StaticOrder S; S.init(TT, 4608, G, bx);
        pg8::EpiHcat E{ws, (const float*)(ws + WS_ROT), 0};
        pg8::gemm_phase<pg8::EpiHcat, pg8::StaticOrder, true, true>(lds, g, S, E, wave);
#endif
    }
    GRID_BAR();
    if (PH_LAST >= 2) {
        REP(2) if (EN(2)) { FRESH(); for (int it = vcu; it < 256; it += G) chain_item(args, lds, it, tid, wave, lane); }
        if (EN(3)) { { FRESH(); attn_dil_phase<16>(args, lds, vcu, G, tid, wave, lane); }
                     { FRESH(); attn_dil_phase<4>(args, lds, vcu, G, tid, wave, lane); } }
    }
    GRID_BAR();
    ST_B(4) if (PH_LAST >= 3 && EN(4)) { FRESH(); p3_phase<0>(args, lds, vcu, G, tid, wave, lane); }
    if (EN(13)) { FRESH(); attn_p1_phase(args, lds, vcu, G, tid, wave, lane); }
    GRID_BAR(); ST_E(4)
#if !CONV_BG
    if (EN(14)) { FRESH(); p0_expert_weights(args, lds, vcu, G, wave, lane); }
#endif
    REP(5) if (PH_LAST >= 4 && EN(5)) {
        pg8::GateOrder S; S.S4.init(TT, 1024, G, bx);
        pg8::EpiHcat E{ws, (const float*)(ws + WS_ROT), 18};
#if GATE_FP8
        pg8::Gemm g{(const pg8::bf16_t*)(ws + WS_X8_LO), (const pg8::bf16_t*)(ws + WS_WIN8 + (size_t)4608 * 1024), TT, 2048, 512, 64, (long)WS_X8_HI - (long)WS_X8_LO - (long)(16 * MiB)};
        pg8::gemm_phase<pg8::EpiHcat, pg8::GateOrder, true, true, false, true, 1, 0>(lds, g, S, E, wave);
#else
        pg8::Gemm g{(const pg8::bf16_t*)(ws + WS_XB), (const pg8::bf16_t*)(ws + WS_WIN) + (size_t)4608 * 1024, TT, 2048, 1024};
        pg8::gemm_phase<pg8::EpiHcat, pg8::GateOrder, true, true>(lds, g, S, E, wave);
#endif
        asm volatile("s_waitcnt vmcnt(0)" ::: "memory"); __syncthreads();
    }
    REP(6) if (PH_LAST >= 5 && EN(6)) {
        pg8::StaticOrder S; S.init(TT, 1024, G, bx);
        { pg8::EpiGate<false> E{(const pg8::bf16_t*)(ws + WS_GATE_A), (pg8::bf16_t*)(ws + WS_MERGED), nullptr};
#if MIX_FP8 & 2
          pg8::Gemm g{(const pg8::bf16_t*)(ws + WS_OA), (const pg8::bf16_t*)(ws + WS_WA), TT, 1024, 256};
          pg8::gemm_phase<pg8::EpiGate<false>, pg8::StaticOrder, true, true, false, true, 1, 3>(lds, g, S, E, wave);
#else
          pg8::Gemm g{(const pg8::bf16_t*)(ws + WS_OA), (const pg8::bf16_t*)(ws + WS_WA), TT, 1024, 512};
          pg8::gemm_phase<pg8::EpiGate<false>, pg8::StaticOrder, true, true>(lds, g, S, E, wave);
#endif
        }
        asm volatile("s_waitcnt vmcnt(0)" ::: "memory"); __syncthreads();
        { typedef pg8::EpiGate<true, (MIX_FP8 & 1) != 0> EpiC;
          EpiC E{(const pg8::bf16_t*)(ws + WS_GATE_R), (pg8::bf16_t*)(ws + WS_MERGED), ws + WS_MERGED8};
#if MIX_FP8 & 4
          pg8::Gemm g{(const pg8::bf16_t*)(ws + WS_AR8), (const pg8::bf16_t*)(ws + WS_WR), TT, 1024, 512};
          pg8::gemm_phase<EpiC, pg8::StaticOrder, true, true, false, true, 1, 0>(lds, g, S, E, wave);
#else
          pg8::Gemm g{(const pg8::bf16_t*)(ws + WS_GR), (const pg8::bf16_t*)(ws + WS_WR), TT, 1024, 1024};
          pg8::gemm_phase<EpiC, pg8::StaticOrder, true, true>(lds, g, S, E, wave);
#endif
        }
    }
    GRID_BAR();
    REP(7) if (PH_LAST >= 6 && EN(7)) {
        pg8::StaticOrder S; S.init(TT, 1024, G, bx);
        pg8::EpiResBf16 E{X_F32_RES ? (const pg8::bf16_t*)args.in[0] : (const pg8::bf16_t*)(ws + WS_XB), (pg8::bf16_t*)args.out, DN_ALPHA};
#if MIX_FP8 & 1
        pg8::Gemm g{(const pg8::bf16_t*)(ws + WS_MERGED8), (const pg8::bf16_t*)(ws + WS_WO), TT, 1024, 512};
        pg8::gemm_phase<pg8::EpiResBf16, pg8::StaticOrder, true, true, false, true, 1, 3>(lds, g, S, E, wave);
#else
        pg8::Gemm g{(const pg8::bf16_t*)(ws + WS_MERGED), (const pg8::bf16_t*)(ws + WS_WO), TT, 1024, 1024};
        pg8::gemm_phase<pg8::EpiResBf16, pg8::StaticOrder, true, true>(lds, g, S, E, wave);
#endif
    }
    GRID_BAR();
    ST_B(8) if (PH_LAST >= 7 && EN(8)) { FRESH(); p6a_phase(args, lds, vcu, G, tid, wave, lane); }
    GRID_BAR(); ST_E(8)
    { FRESH(); build_tile_tables(args, lds, tid); }
    const int nrt = ((const LAS int*)(lds + LDS_TS_OFF))[16];
    REP(10) if (PH_LAST >= 9 && EN(10)) {
#if M1_FP8
        pg8::Gemm g{(const pg8::bf16_t*)(ws + WS_X1F8), (const pg8::bf16_t*)(ws + WS_WGU), MAXSLOT, 1024, 512};
        pg8::MoeOrder S{nrt * 4, G, vcu, (const LAS int*)(lds + LDS_TE_OFF), (const LAS int*)(lds + LDS_TS_OFF), (const LAS int*)(lds + LDS_CNT_OFF), (const int*)(ws + WS_LTOK), 1024u};
        pg8::EpiSwiGLU E{ws + WS_H};
        pg8::gemm_phase<pg8::EpiSwiGLU, pg8::MoeOrder, true, true, true, true, 1, 0>(lds, g, S, E, wave);
#else
        pg8::Gemm g{(const pg8::bf16_t*)(ws + WS_XB), (const pg8::bf16_t*)(ws + WS_WGU), MAXSLOT, 1024, 1024};
        pg8::MoeOrder S{nrt * 4, G, vcu, (const LAS int*)(lds + LDS_TE_OFF), (const LAS int*)(lds + LDS_TS_OFF), (const LAS int*)(lds + LDS_CNT_OFF), (const int*)(ws + WS_LTOK), 2048u};
        pg8::EpiSwiGLU E{ws + WS_H};
        pg8::gemm_phase<pg8::EpiSwiGLU, pg8::MoeOrder, true, true, true>(lds, g, S, E, wave);
#endif
    }
    GRID_BAR();
    REP(11) if (PH_LAST >= 10 && EN(11)) {
        pg8::Gemm g{(const pg8::bf16_t*)(ws + WS_H), (const pg8::bf16_t*)(ws + WS_WD), MAXSLOT, 1024, 256};
        pg8::MoeOrder S{nrt * 4, G, vcu, (const LAS int*)(lds + LDS_TE_OFF), (const LAS int*)(lds + LDS_TS_OFF), (const LAS int*)(lds + LDS_CNT_OFF), (const int*)(ws + WS_LTOK), 1024u};
        pg8::EpiRowScale E{(pg8::bf16_t*)(ws + WS_Y)};
        pg8::gemm_phase<pg8::EpiRowScale, pg8::MoeOrder, true, true, false, true, 1, 2>(lds, g, S, E, wave);
    }
    GRID_BAR();
    ST_B(12) if (PH_LAST >= 11 && EN(12)) { FRESH(); p9_phase(args, lds, vcu, G, wave, lane); }
#ifdef STAMP_PH
    GRID_BAR(); ST_E(12)
    if (STAMP_PH == 13) { st_a = rt(); GRID_BAR(); GRID_BAR(); GRID_BAR(); GRID_BAR(); st_b = rt(); }
    if (bx == 0 && tid0 == 0) { const float us = (float)(st_b - st_a) * 0.01f * STAMP_SCALE; int k = 0; float lim = 30.f; while (us >= lim && k < 12) { lim *= 1.5f; ++k; }
        __hip_atomic_store(ctl + CW_CHK, __float_as_uint(sqrtf(2.f * k + 2.f)), RLX_AGENT); }
    GRID_BAR();
    { const float c = __uint_as_float(__hip_atomic_load(ctl + CW_CHK, RLX_AGENT)); f32x4* o4 = (f32x4*)args.out;
      for (size_t i = (size_t)bx * 512 + tid0; i < (size_t)TT * DM / 4; i += (size_t)G * 512) o4[i] = (f32x4){c, c, c, c}; }
#endif
}

#ifdef PROBE_VAR
__global__ void __launch_bounds__(NWAVES * 64, 2) probe_kernel(Args args) {
    extern __shared__ __attribute__((aligned(16))) unsigned char lds_raw[];
    LAS unsigned char* lds = (LAS unsigned char*)lds_raw;
    const int tid0 = threadIdx.x, wave = __builtin_amdgcn_readfirstlane(tid0 >> 6);
    const int G = gridDim.x, bx = blockIdx.x, vcu = (G % 8 == 0) ? (bx % 8) * (G / 8) + bx / 8 : bx;
    FRESH();
    if (PROBE_VAR >= 20 && PROBE_VAR <= 22) {
        unsigned char* ws = args.ws;
        pg8::Gemm g{(const pg8::bf16_t*)(ws + WS_X8_LO), (const pg8::bf16_t*)(ws + WS_WIN8), TT, 4608, 512, 64, (long)WS_X8_HI - (long)WS_X8_LO - (long)(16 * MiB)}; pg8::StaticOrder S; S.init(TT, 4608, G, bx);
        typedef pg8::EpiHcatT<PROBE_VAR - 20> EpiP;
        EpiP E{ws, (const float*)(ws + WS_ROT), 0};
        pg8::gemm_phase<EpiP, pg8::StaticOrder, true, true, false, true, 1, 0>(lds, g, S, E, wave);
    }
    if (PROBE_VAR == 10) p3_phase<0>(args, lds, vcu, G, tid, wave, lane);
    if (PROBE_VAR == 11) p3_phase<1>(args, lds, vcu, G, tid, wave, lane);
    if (PROBE_VAR == 0) attn_dil_phase<16, 0>(args, lds, vcu, G, tid, wave, lane);
    if (PROBE_VAR == 1) attn_dil_phase<16, 1>(args, lds, vcu, G, tid, wave, lane);
    if (PROBE_VAR == 2) attn_dil_phase<4, 0>(args, lds, vcu, G, tid, wave, lane);
    if (PROBE_VAR == 3) attn_dil_phase<4, 1>(args, lds, vcu, G, tid, wave, lane);
}
#endif
extern "C" void kernel_launch(void* const* d_in, const int* in_sizes, int n_in, void* d_out, int out_size, void* d_ws, size_t ws_size, hipStream_t stream) {
    static int grid = 0;
    if (grid == 0) {
        if (n_in != 20 || in_sizes[0] != TT * DM || out_size != TT * DM || ws_size < WS_END) { fprintf(stderr, "kernel_launch: unexpected shapes: n_in %d in0 %d out %d ws %zu; nothing launched\n", n_in, n_in > 0 ? in_sizes[0] : -1, out_size, ws_size); grid = -1; return; }
        int dev = 0, cus = 0;
        if (hipGetDevice(&dev) != hipSuccess || hipDeviceGetAttribute(&cus, hipDeviceAttributeMultiprocessorCount, dev) != hipSuccess) { grid = -1; return; }
        if (hipFuncSetAttribute((const void*)mega_fwd, hipFuncAttributeMaxDynamicSharedMemorySize, LDS_BYTES) != hipSuccess) { fprintf(stderr, "kernel_launch: hipFuncSetAttribute failed\n"); grid = -1; return; }
        (void)hipGetLastError();
        grid = cus;
    }
    if (grid < 0) return;
    if (hipMemsetAsync((char*)d_ws, 0, CTL_ZERO_BYTES, stream) != hipSuccess) return;
    Args a{};
    for (int i = 0; i < 20; ++i) a.in[i] = (const float*)d_in[i];
    a.out = (float*)d_out; a.ws = (unsigned char*)d_ws; a.mask = 0x80007fffu; a.bar_region = 0;
#if defined(XTRA_FIRST)
    { Args x = a; x.mask = XTRA_FIRST; x.bar_region = 1; for (int r = 0; r < XTRA_REP; ++r) hipLaunchKernelGGL(mega_fwd, dim3(grid), dim3(NWAVES * 64), LDS_BYTES, stream, x);
      if (hipMemsetAsync((char*)d_ws, 0, CTL_ZERO_BYTES, stream) != hipSuccess) return; }
#endif
    hipLaunchKernelGGL(mega_fwd, dim3(grid), dim3(NWAVES * 64), LDS_BYTES, stream, a);
#if defined(PROBE_VAR)
    { hipFuncSetAttribute((const void*)probe_kernel, hipFuncAttributeMaxDynamicSharedMemorySize, LDS_BYTES);
      for (int r = 0; r < 4; ++r) hipLaunchKernelGGL(probe_kernel, dim3(grid), dim3(NWAVES * 64), LDS_BYTES, stream, a); }
#endif
#if defined(XTRA_AFTER)
    { Args x = a; x.mask = XTRA_AFTER; x.bar_region = 1; for (int r = 0; r < XTRA_REP; ++r) hipLaunchKernelGGL(mega_fwd, dim3(grid), dim3(NWAVES * 64), LDS_BYTES, stream, x); }
#endif
}
```

```cpp
#include <hip/hip_runtime.h>
#include <cstdio>
#include <cstdint>

constexpr int TT = 32768, DM = 1024, SEQ = 2048, NB = 16;
constexpr float DN_ALPHA = 1.189207115002721f;
constexpr float LN_EPSF = 1e-5f;
#ifndef M1_FP8
#define M1_FP8 1
#endif
#ifndef P1_FP8
#define P1_FP8 1
#endif
#ifndef SILU_IN_P3
#define SILU_IN_P3 1
#endif
#ifndef CONV_BG
#define CONV_BG 1
#endif
#ifndef Y_FP8
#define Y_FP8 1
#endif
#ifndef GATE_FP8
#define GATE_FP8 1
#endif
#ifndef MIX_FP8
#define MIX_FP8 7
#endif
#ifndef P1_FP8_FROM
#define P1_FP8_FROM 0
#endif
#define X_F32_RES (P1_FP8 && P1_FP8_FROM == 0 && GATE_FP8)
constexpr size_t MiB = 1u << 20;
constexpr size_t CTL_ZERO_BYTES = 1 * MiB;
constexpr size_t WS_ROT = 1 * MiB;
constexpr size_t WS_BIAS = 2 * MiB;
constexpr size_t WS_LTOK = 3 * MiB;
constexpr size_t WS_TINFO = 7 * MiB;
constexpr size_t WS_WSLOT = 7 * MiB + 512 * 1024;
constexpr size_t WS_WIN = 8 * MiB;
constexpr size_t WS_WIN8 = 12 * MiB;
constexpr size_t WS_WR = 21 * MiB;
constexpr size_t WS_WA = 23 * MiB;
constexpr size_t WS_WO = 24 * MiB;
constexpr size_t WS_WGU = 26 * MiB;
constexpr size_t WS_WD = 42 * MiB;
constexpr size_t WS_XB = 80 * MiB;
constexpr size_t WS_QR = 144 * MiB;
constexpr size_t WS_KR = 176 * MiB;
constexpr size_t WS_VR = 208 * MiB;
constexpr size_t WS_GR = 272 * MiB;
constexpr size_t WS_QA = 336 * MiB, WS_KA = 368 * MiB, WS_VA = 400 * MiB, WS_OA = 432 * MiB;
#if MIX_FP8 & 4
constexpr size_t WS_AR8 = 144 * MiB;
constexpr size_t WS_GATE_R = 176 * MiB, WS_GATE_A = 240 * MiB;
#else
constexpr size_t WS_GATE_R = 144 * MiB, WS_GATE_A = 208 * MiB;
#endif
constexpr size_t WS_X8_LO = 448 * MiB, WS_X8_HI = 58 * MiB;
static_assert(M1_FP8, "the workspace map is laid out for fp8 expert weights");
static_assert(!CONV_BG || X_F32_RES, "CONV_BG puts o2 into the bf16 x region");
static_assert(!GATE_FP8 || (P1_FP8 && (MIX_FP8 & 2) && M1_FP8), "GATE_FP8 needs the fp8 mixer-input GEMM, the fp8 o_a (room behind it) and the fp8 expert weights (room behind them)");
constexpr size_t WS_MERGED8 = 464 * MiB;
constexpr size_t WS_MERGED = 336 * MiB;
constexpr size_t WS_Y = 144 * MiB;
constexpr size_t WS_H = 336 * MiB;
constexpr size_t WS_X1F8 = 464 * MiB;
#if CONV_BG
constexpr size_t WS_O2 = 80 * MiB;
#else
constexpr size_t WS_O2 = 26 * MiB;
#endif
constexpr size_t WS_O3 = 464 * MiB;
constexpr size_t WS_LSE2 = 496 * MiB, WS_LSE3 = 497 * MiB;
constexpr size_t WS_END = 512 * MiB;
constexpr int MAXSLOT = 69632;
constexpr int CW_BAR = 4096;
constexpr int CW_CNT = 16384;
constexpr int CW_CHK = 24576;
namespace pg8 {
#define PG8_LAS __attribute__((address_space(3)))
typedef unsigned short bf16_t;
typedef short bf16x8 __attribute__((ext_vector_type(8)));
typedef float f32x4 __attribute__((ext_vector_type(4)));
typedef unsigned u32x4 __attribute__((ext_vector_type(4)));
typedef unsigned u32x2_ __attribute__((ext_vector_type(2)));
constexpr int BM = 256, BK = 64, HALF = 128, HTB = HALF * BK * 2  , STAGE_BYTES = 8 * HTB, NXCD = 8, WGM = 8;

__device__ __forceinline__ int lane_id() { int x; asm volatile("v_mbcnt_lo_u32_b32 %0, -1, 0\n\tv_mbcnt_hi_u32_b32 %0, -1, %0" : "=v"(x)); return x; }
__host__ __device__ __forceinline__ int lds_byte(int r, int c) { const int st = (r >> 4) * 2 + (c >> 5), rr = r & 15, cc = c & 31, ob = rr * 64 + cc * 2; return st * 1024 + (ob ^ (((ob >> 9) & 1) << 5)); }
__host__ __device__ __forceinline__ void stage_rc(int b, int& R, int& C) { const int st = b / 1024, sb = b % 1024, swz = sb ^ (((sb >> 9) & 1) << 5); R = (st >> 1) * 16 + swz / 64; C = (st & 1) * 32 + (swz % 64) / 2; }
__host__ __device__ __forceinline__ int perm32(int rho) { const int n = rho >> 4, i = rho & 15; return 8 * (i >> 2) + 4 * n + (i & 3); }

struct Unit { int pm, pn; };
struct Gemm { const bf16_t* A; const bf16_t* Bt; int M, N, K; int spm = 1 << 30; long sdelta = 0; };

struct StaticOrder {
    int nM, nN, nwg, G, c, pn0;
    __host__ __device__ void init(int M, int N, int G_, int c_, int pn0_ = 0) { nM = M / BM; nN = N / BM; nwg = nM * nN; G = G_; c = c_; pn0 = pn0_; }
    __host__ __device__ bool next(int i, Unit& u) const {
        const long L = (long)i * G + c; if (L >= nwg) return false;
        int wgid = (int)L; { const int q = nwg / NXCD, r = nwg % NXCD, xcd = wgid % NXCD, off = wgid / NXCD; wgid = (xcd < r ? xcd * (q + 1) : r * (q + 1) + (xcd - r) * q) + off; }
        const int nig = WGM * nN, gid = wgid / nig, fm = gid * WGM, gsz = (nM - fm) < WGM ? (nM - fm) : WGM;
        u.pm = fm + ((wgid % nig) % gsz); u.pn = pn0 + (wgid % nig) / gsz; return true;
    }
    __device__ __forceinline__ void a_ready(const Unit&) const {}
    __device__ __forceinline__ void done(const Unit&, int, int) const {}
};

__device__ __forceinline__ unsigned cvt_pk_bf16(float lo, float hi) { unsigned r; asm volatile("v_cvt_pk_bf16_f32 %0, %1, %2" : "=v"(r) : "v"(lo), "v"(hi)); return r; }
typedef float cvt_f32x2_t __attribute__((ext_vector_type(2))); typedef __bf16 cvt_bf16x2_t __attribute__((ext_vector_type(2)));
__device__ __forceinline__ unsigned cvt_pk_bf16_acc(float lo, float hi) { const cvt_f32x2_t v = {lo, hi}; const cvt_bf16x2_t b = __builtin_convertvector(v, cvt_bf16x2_t); return __builtin_bit_cast(unsigned, b); }
__device__ __forceinline__ float bflo(unsigned w) { return __uint_as_float(w << 16); }
__device__ __forceinline__ float bfhi(unsigned w) { return __uint_as_float(w & 0xffff0000u); }
__device__ __forceinline__ float fsigmoid(float x) { return __builtin_amdgcn_rcpf(1.f + __expf(-x)); }
__device__ __forceinline__ float fsilu(float x) { return x * __builtin_amdgcn_rcpf(1.f + __expf(-x)); }

template <int VAR = 0> struct EpiHcatT {
    static constexpr bool PERM = true, AFTER_DRAIN = false; static constexpr int NSTORE = 16;
    unsigned char* ws; const float* rot; int tile_off;
    __device__ __forceinline__ void operator()(const f32x4 (&acc)[2][2][4][2], const Unit& u, int wr, int wc, int fr, int fq) const {
        if (VAR == 1) {
            float s = 0.f;
#pragma unroll
            for (int ai = 0; ai < 2; ++ai)
#pragma unroll
                for (int bj = 0; bj < 2; ++bj)
#pragma unroll
                    for (int m = 0; m < 4; ++m)
#pragma unroll
                        for (int n = 0; n < 2; ++n) s += (acc[ai][bj][m][n][0] + acc[ai][bj][m][n][1]) + (acc[ai][bj][m][n][2] + acc[ai][bj][m][n][3]);
            ((float*)(ws + WS_O3))[(size_t)(u.pm * 64 + u.pn) * 512 + wr * 256 + wc * 64 + fq * 16 + fr] = s; return;
        }
        const int gt = u.pn + tile_off;
        size_t base_off; int pitch, ct, mode; float sc = 1.f;
        if (gt < 2)       { base_off = WS_QR; pitch = 512;  ct = gt;      mode = 1; }
        else if (gt < 4)  { base_off = WS_KR; pitch = 512;  ct = gt - 2;  mode = 1; sc = 0.08838834764831845f; }
        else if (gt < 8)  { base_off = WS_VR; pitch = 1024; ct = gt - 4;  mode = 0; }
        else if (gt < 12) { base_off = WS_GR; pitch = 1024; ct = gt - 8;  mode = SILU_IN_P3 ? 0 : 2; }
        else if (gt < 14) { base_off = WS_QA; pitch = 512;  ct = gt - 12; mode = 0; sc = 0.18033688011112042f; }
        else if (gt < 16) { base_off = WS_KA; pitch = 512;  ct = gt - 14; mode = 0; }
        else if (gt < 18) { base_off = WS_VA; pitch = 512;  ct = gt - 16; mode = 0; }
        else if (gt < 22) { base_off = WS_GATE_R; pitch = 1024; ct = gt - 18; mode = 3; }
        else              { base_off = WS_GATE_A; pitch = 1024; ct = gt - 22; mode = 3; }
        bf16_t* O = (bf16_t*)(ws + base_off);
        const int row0 = u.pm * BM + wr * 64 + fr, col0 = ct * BM + wc * 32 + 8 * fq;
#pragma unroll
        for (int ai = 0; ai < 2; ++ai)
#pragma unroll
            for (int m = 0; m < 4; ++m) {
                const int row = row0 + ai * HALF + m * 16;
                bf16_t* rowp = O + (size_t)(VAR == 2 ? (row & 255) : row) * pitch + col0;
                f32x4 cs = (f32x4){1.f, 1.f, 1.f, 1.f}, sn = (f32x4){0.f, 0.f, 0.f, 0.f};
                if (mode == 1) { const f32x4* rt = (const f32x4*)(rot + ((size_t)(row & (SEQ - 1)) * 16 + (4 * wc + fq)) * 8); cs = rt[0]; sn = rt[1]; }
#pragma unroll
                for (int bj = 0; bj < 2; ++bj) {
                    f32x4 v0 = acc[ai][bj][m][0], v1 = acc[ai][bj][m][1];
                    if (mode == 1) { const f32x4 a = v0 * cs - v1 * sn, b = v0 * sn + v1 * cs; v0 = a * sc; v1 = b * sc; }
                    else if (mode == 2) {
#pragma unroll
                        for (int e = 0; e < 4; ++e) { v0[e] = fsilu(v0[e]); v1[e] = fsilu(v1[e]); } }
                    else if (mode == 3) {
#pragma unroll
                        for (int e = 0; e < 4; ++e) { v0[e] = fsigmoid(v0[e]); v1[e] = fsigmoid(v1[e]); } }
                    else { v0 = v0 * sc; v1 = v1 * sc; }
                    u32x4 w; w.x = cvt_pk_bf16(v0[0], v0[1]); w.y = cvt_pk_bf16(v0[2], v0[3]); w.z = cvt_pk_bf16(v1[0], v1[1]); w.w = cvt_pk_bf16(v1[2], v1[3]);
                    *(u32x4*)(rowp + bj * HALF) = w;
                }
            }
    }
};

typedef EpiHcatT<0> EpiHcat;

__device__ __forceinline__ unsigned fp8x4_sat(float a, float b, float c, float d) {
    a = __builtin_amdgcn_fmed3f(a, -448.f, 448.f); b = __builtin_amdgcn_fmed3f(b, -448.f, 448.f); c = __builtin_amdgcn_fmed3f(c, -448.f, 448.f); d = __builtin_amdgcn_fmed3f(d, -448.f, 448.f);
    unsigned w = 0u; w = __builtin_amdgcn_cvt_pk_fp8_f32(a, b, w, false); w = __builtin_amdgcn_cvt_pk_fp8_f32(c, d, w, true); return w;
}
template <bool ADD, bool OUT8 = false> struct EpiGate {
    static constexpr bool PERM = true, AFTER_DRAIN = false; static constexpr int NSTORE = 16;
    const bf16_t* gate; bf16_t* O; unsigned char* O8;
    __device__ __forceinline__ void operator()(const f32x4 (&acc)[2][2][4][2], const Unit& u, int wr, int wc, int fr, int fq) const {
        const int row0 = u.pm * BM + wr * 64 + fr, col0 = u.pn * BM + wc * 32 + 8 * fq;
#pragma unroll
        for (int ai = 0; ai < 2; ++ai)
#pragma unroll
            for (int m = 0; m < 4; ++m)
#pragma unroll
                for (int bj = 0; bj < 2; ++bj) {
                    const size_t p = (size_t)(row0 + ai * HALF + m * 16) * 1024 + col0 + bj * HALF;
                    const u32x4 g = *(const u32x4*)(gate + p);
                    f32x4 v0 = acc[ai][bj][m][0], v1 = acc[ai][bj][m][1];
                    v0[0] *= bflo(g.x); v0[1] *= bfhi(g.x); v0[2] *= bflo(g.y); v0[3] *= bfhi(g.y);
                    v1[0] *= bflo(g.z); v1[1] *= bfhi(g.z); v1[2] *= bflo(g.w); v1[3] *= bfhi(g.w);
                    if (ADD) { const u32x4 o = *(const u32x4*)(O + p);
                        v0[0] += bflo(o.x); v0[1] += bfhi(o.x); v0[2] += bflo(o.y); v0[3] += bfhi(o.y);
                        v1[0] += bflo(o.z); v1[1] += bfhi(o.z); v1[2] += bflo(o.w); v1[3] += bfhi(o.w); }
                    if (OUT8) { u32x2_ w8;
                        w8.x = fp8x4_sat(v0[0] * 16.f, v0[1] * 16.f, v0[2] * 16.f, v0[3] * 16.f); w8.y = fp8x4_sat(v1[0] * 16.f, v1[1] * 16.f, v1[2] * 16.f, v1[3] * 16.f);
                        *(u32x2_*)(O8 + p) = w8; }
                    else { u32x4 w; w.x = cvt_pk_bf16(v0[0], v0[1]); w.y = cvt_pk_bf16(v0[2], v0[3]); w.z = cvt_pk_bf16(v1[0], v1[1]); w.w = cvt_pk_bf16(v1[2], v1[3]);
                        *(u32x4*)(O + p) = w; }
                }
    }
};

struct EpiResBf16 {
    static constexpr bool PERM = true, AFTER_DRAIN = false; static constexpr int NSTORE = 16;
    const bf16_t* x; bf16_t* out; float alpha;
    __device__ __forceinline__ void operator()(const f32x4 (&acc)[2][2][4][2], const Unit& u, int wr, int wc, int fr, int fq) const {
        const int row0 = u.pm * BM + wr * 64 + fr, col0 = u.pn * BM + wc * 32 + 8 * fq;
#pragma unroll
        for (int ai = 0; ai < 2; ++ai)
#pragma unroll
            for (int m = 0; m < 4; ++m)
#pragma unroll
                for (int bj = 0; bj < 2; ++bj) {
                    const size_t p = (size_t)(row0 + ai * HALF + m * 16) * 1024 + col0 + bj * HALF;
#if X_F32_RES
                    const f32x4 x0 = *(const f32x4*)((const float*)x + p), x1 = *(const f32x4*)((const float*)x + p + 4);
#else
                    const u32x4 xw = *(const u32x4*)(x + p);
                    const f32x4 x0 = (f32x4){bflo(xw.x), bfhi(xw.x), bflo(xw.y), bfhi(xw.y)}, x1 = (f32x4){bflo(xw.z), bfhi(xw.z), bflo(xw.w), bfhi(xw.w)};
#endif
                    const f32x4 v0 = x0 * alpha + acc[ai][bj][m][0], v1 = x1 * alpha + acc[ai][bj][m][1];
                    u32x4 w; w.x = cvt_pk_bf16(v0[0], v0[1]); w.y = cvt_pk_bf16(v0[2], v0[3]); w.z = cvt_pk_bf16(v1[0], v1[1]); w.w = cvt_pk_bf16(v1[2], v1[3]);
                    *(u32x4*)(out + p) = w;
                }
    }
};

struct EpiSwiGLU {
    static constexpr bool PERM = true, AFTER_DRAIN = false; static constexpr int NSTORE = 16;
    unsigned char* H;
    __device__ __forceinline__ void operator()(const f32x4 (&acc)[2][2][4][2], const Unit& u, int wr, int wc, int fr, int fq) const {
        const int row0 = u.pm * BM + wr * 64 + fr, col0 = (u.pn & 3) * 128 + wc * 16 + 4 * fq;
#pragma unroll
        for (int ai = 0; ai < 2; ++ai)
#pragma unroll
            for (int m = 0; m < 4; ++m)
#pragma unroll
                for (int bj = 0; bj < 2; ++bj) {
                    const f32x4 g = acc[ai][bj][m][0], up = acc[ai][bj][m][1];
                    float h0 = fsilu(g[0]) * up[0] * 8.f, h1 = fsilu(g[1]) * up[1] * 8.f, h2 = fsilu(g[2]) * up[2] * 8.f, h3 = fsilu(g[3]) * up[3] * 8.f;
                    h0 = fminf(fmaxf(h0, -448.f), 448.f); h1 = fminf(fmaxf(h1, -448.f), 448.f); h2 = fminf(fmaxf(h2, -448.f), 448.f); h3 = fminf(fmaxf(h3, -448.f), 448.f);
                    unsigned w = 0u; w = __builtin_amdgcn_cvt_pk_fp8_f32(h0, h1, w, false); w = __builtin_amdgcn_cvt_pk_fp8_f32(h2, h3, w, true);
                    *(unsigned*)(H + (size_t)(row0 + ai * HALF + m * 16) * 512 + col0 + bj * 64) = w;
                }
    }
};

struct EpiRowScale {
    static constexpr bool PERM = true, AFTER_DRAIN = false; static constexpr int NSTORE = 16;
    bf16_t* Y;
    __device__ __forceinline__ void operator()(const f32x4 (&acc)[2][2][4][2], const Unit& u, int wr, int wc, int fr, int fq) const {
        const int row0 = u.pm * BM + wr * 64 + fr, col0 = (u.pn & 3) * BM + wc * 32 + 8 * fq;
#pragma unroll
        for (int ai = 0; ai < 2; ++ai)
#pragma unroll
            for (int m = 0; m < 4; ++m) {
                const int row = row0 + ai * HALF + m * 16;
#pragma unroll
                for (int bj = 0; bj < 2; ++bj) {
                    const f32x4 v0 = acc[ai][bj][m][0], v1 = acc[ai][bj][m][1];
#if Y_FP8
                    u32x2_ w8; w8.x = fp8x4_sat(v0[0] * 16.f, v0[1] * 16.f, v0[2] * 16.f, v0[3] * 16.f); w8.y = fp8x4_sat(v1[0] * 16.f, v1[1] * 16.f, v1[2] * 16.f, v1[3] * 16.f);
                    *(u32x2_*)((unsigned char*)Y + (size_t)row * 1024 + col0 + bj * HALF) = w8;
#else
                    u32x4 w; w.x = cvt_pk_bf16_acc(v0[0], v0[1]); w.y = cvt_pk_bf16_acc(v0[2], v0[3]); w.z = cvt_pk_bf16_acc(v1[0], v1[1]); w.w = cvt_pk_bf16_acc(v1[2], v1[3]);
                    *(u32x4*)(Y + (size_t)row * 1024 + col0 + bj * HALF) = w;
#endif
                }
            }
    }
};

struct MoeOrder {
    int nunits, G, c; const PG8_LAS int* te; const PG8_LAS int* ts; const PG8_LAS int* cnt; const int* ltok; unsigned rowbytes;
    __device__ __forceinline__ bool next(int i, Unit& u) const {
        const int L = i * G + c, rt = (L >> 5) * 8 + (L & 7); if (rt >= (nunits >> 2)) return false;
        u.pm = rt; u.pn = te[rt] * 4 + ((L >> 3) & 3); return true;
    }
    __device__ __forceinline__ unsigned a_row_off(const Unit& u, int row) const {
        const int ex = te[u.pm], pos = (u.pm - ts[ex]) * 256 + row;
        const int tok = pos < cnt[ex] ? ltok[ex * 32768 + pos] : 0;
        return (unsigned)tok * rowbytes;
    }
    __device__ __forceinline__ void a_ready(const Unit&) const {}
    __device__ __forceinline__ void done(const Unit&, int, int) const {}
};

struct ExpertConv { const float* wg; const float* wu; const float* wd; unsigned char* WGU; unsigned char* WD; int gw, nw, grp; };
__device__ __forceinline__ void expert_conv_item(const ExpertConv& c, int j, int lane) {
    const int it = j * c.nw + c.gw, e = it / 384, r = it % 384;
    const float* src; unsigned char* dst; int K, N, mode, nb, kb;
    if (r < 128)      { src = c.wg + (size_t)e * 1024 * 512; dst = c.WGU + (size_t)e * 1024 * 1024; K = 1024; N = 512;  mode = 2; nb = r >> 4; kb = r & 15; }
    else if (r < 256) { src = c.wu + (size_t)e * 1024 * 512; dst = c.WGU + (size_t)e * 1024 * 1024; K = 1024; N = 512;  mode = 3; nb = (r - 128) >> 4; kb = (r - 128) & 15; }
    else              { src = c.wd + (size_t)e * 512 * 1024; dst = c.WD + (size_t)e * 1024 * 512;   K = 512;  N = 1024; mode = 0; nb = (r - 256) >> 3; kb = (r - 256) & 7; }
    const int n4 = nb * 64 + 4 * (lane & 15), k0 = kb * 64 + 16 * (lane >> 4);
    const float* s = src + (size_t)k0 * N + n4;
    f32x4 v[16];
#pragma unroll
    for (int i = 0; i < 16; ++i) v[i] = *(const f32x4*)(s + (size_t)i * N);
#pragma unroll
    for (int jn = 0; jn < 4; ++jn) {
        const int n = n4 + jn, row = mode == 0 ? n : ((n >> 2) << 3) + (n & 3) + (mode == 3 ? 4 : 0);
        u32x4 w;
        w.x = fp8x4_sat(v[0][jn] * 64.f, v[1][jn] * 64.f, v[2][jn] * 64.f, v[3][jn] * 64.f);     w.y = fp8x4_sat(v[4][jn] * 64.f, v[5][jn] * 64.f, v[6][jn] * 64.f, v[7][jn] * 64.f);
        w.z = fp8x4_sat(v[8][jn] * 64.f, v[9][jn] * 64.f, v[10][jn] * 64.f, v[11][jn] * 64.f); w.w = fp8x4_sat(v[12][jn] * 64.f, v[13][jn] * 64.f, v[14][jn] * 64.f, v[15][jn] * 64.f);
        *(u32x4*)(dst + (size_t)row * K + k0) = w;
    }
}
struct GateOrder {
    StaticOrder S4;
    __device__ __forceinline__ bool next(int i, Unit& u) const { Unit t; if (!S4.next(i >> 1, t)) return false; u.pm = t.pm; u.pn = t.pn + 4 * (i & 1); return true; }
    __device__ __forceinline__ void a_ready(const Unit&) const {}
    __device__ __forceinline__ void done(const Unit&, int, int) const {}
};
struct P1Order {
    StaticOrder S; ExpertConv cv;
    __device__ __forceinline__ bool next(int i, Unit& u) const { return S.next(i, u); }
    __device__ __forceinline__ void a_ready(const Unit&) const {}
    __device__ __forceinline__ static int unit_of(int grp, int k) { return (grp + 3 * k) % 9; }
    __device__ __forceinline__ void done(const Unit&, int ui, int lane) const {
        const int d = (ui + 9 - cv.grp) % 9;
        if (ui < 9 && d % 3 == 0 && cv.gw + (d / 3) * cv.nw < 6144) expert_conv_item(cv, d / 3, lane);
    }
};

template <class Epi, class Sched, bool ALIGN_EPI = false, bool SP2 = false, bool GATHER = false, bool FP8 = false, int SEL_W = 0, int SEL_X = 0>
__device__ __forceinline__ void gemm_phase(PG8_LAS unsigned char* lds, const Gemm g, const Sched& S, const Epi& E, const int wid) {
    int tid = wid * 64 + lane_id(); asm volatile("" : "+v"(tid));
    const int lane = tid & 63, wr = wid >> 2, wc = wid & 3, fr = lane & 15, fq = lane >> 4;
    static_assert(SP2, "only the two-super-phase loop is kept");
    typedef int i32x4_ __attribute__((ext_vector_type(4)));
    const int K = g.K, nt = K / BK;
    unsigned voffB[2]; int rA[2], cA2[2];
#pragma unroll
    for (int i = 0; i < 2; ++i) { int R, C; stage_rc(tid * 16 + i * 8192, R, C); const int Rb = Epi::PERM ? ((R & ~31) + perm32(R & 31)) : R;
        rA[i] = R; cA2[i] = C * 2; voffB[i] = (unsigned)(Rb * K + C) * 2u; }
    unsigned vAc[2][2], vAn[2][2];
    const size_t kstep = (size_t)(BK * 2);
    const size_t hstep = (size_t)HALF * K * 2;
    const size_t tstep = 2 * hstep;
    const unsigned ldsw = (unsigned)wid * 1024u;
    const int aoff0 = lds_byte(wr * 64 + fr, fq * 8), aoff1 = aoff0 + 1024;
    const int boff0 = lds_byte(wc * 32 + fr, fq * 8), boff1 = boff0 + 1024;
#define PG8_SA(b, h) (((b) * 2 + (h)) * HTB)
#define PG8_SB(b, h) ((4 + (b) * 2 + (h)) * HTB)
#define PG8_STAGE(bufoff, gbase, voff) do { _Pragma("unroll") for (int _i = 0; _i < 2; ++_i) \
        __builtin_amdgcn_global_load_lds((const unsigned*)((const char*)(gbase) + (voff)[_i]), (PG8_LAS unsigned*)(lds + (bufoff) + ldsw + _i * 8192), 16, 0, 0); } while (0)
#define PG8_LDA(dst, b, h) do { _Pragma("unroll") for (int m = 0; m < 4; ++m) { dst[m][0] = *(const PG8_LAS bf16x8*)(lds + PG8_SA(b, h) + aoff0 + m * 2048); dst[m][1] = *(const PG8_LAS bf16x8*)(lds + PG8_SA(b, h) + aoff1 + m * 2048); } } while (0)
#define PG8_LDB(dst, b, h) do { _Pragma("unroll") for (int n = 0; n < 2; ++n) { dst[n][0] = *(const PG8_LAS bf16x8*)(lds + PG8_SB(b, h) + boff0 + n * 2048); dst[n][1] = *(const PG8_LAS bf16x8*)(lds + PG8_SB(b, h) + boff1 + n * 2048); } } while (0)
#define PG8_CAT8(x) __builtin_shufflevector(__builtin_bit_cast(i32x4_, (x)[0]), __builtin_bit_cast(i32x4_, (x)[1]), 0, 1, 2, 3, 4, 5, 6, 7)
#define PG8_MMA(ai, bj, At, Bt) do { __builtin_amdgcn_s_setprio(1); \
        if constexpr (FP8) { _Pragma("unroll") for (int m = 0; m < 4; ++m) _Pragma("unroll") for (int n = 0; n < 2; ++n) \
            acc[ai][bj][m][n] = __builtin_amdgcn_mfma_scale_f32_16x16x128_f8f6f4(PG8_CAT8(Bt[n]), PG8_CAT8(At[m]), acc[ai][bj][m][n], 0, 0, SEL_W, scl, SEL_X, scl); \
            asm volatile("" : "+v"(acc[ai][bj][0][0]), "+v"(acc[ai][bj][0][1]), "+v"(acc[ai][bj][1][0]), "+v"(acc[ai][bj][1][1]), "+v"(acc[ai][bj][2][0]), "+v"(acc[ai][bj][2][1]), "+v"(acc[ai][bj][3][0]), "+v"(acc[ai][bj][3][1])); } \
        else { _Pragma("unroll") for (int m = 0; m < 4; ++m) _Pragma("unroll") for (int n = 0; n < 2; ++n) _Pragma("unroll") for (int k = 0; k < 2; ++k) \
            acc[ai][bj][m][n] = __builtin_amdgcn_mfma_f32_16x16x32_bf16(Bt[n][k], At[m][k], acc[ai][bj][m][n], 0, 0, 0); } \
        __builtin_amdgcn_s_setprio(0); } while (0)
#define PG8_WAIT_V(n) asm volatile("s_waitcnt vmcnt(" #n ")" ::: "memory")
#define PG8_WAIT_VN(n) asm volatile("s_waitcnt vmcnt(%0)" :: "i"(n) : "memory")
#define PG8_WAIT_L(n) asm volatile("s_waitcnt lgkmcnt(" #n ")" ::: "memory")
#define PG8_BAR __builtin_amdgcn_s_barrier()
#define PG8_SCHED __builtin_amdgcn_sched_barrier(0)
    [[maybe_unused]] int scl = 0x7b7c797f; asm volatile("" : "+v"(scl));
    Unit cur, nxt; int ui = 0;
    if (!S.next(0, cur)) return;
    f32x4 acc[2][2][4][2];
#pragma unroll
    for (int a = 0; a < 2; ++a)
#pragma unroll
        for (int b = 0; b < 2; ++b)
#pragma unroll
            for (int m = 0; m < 4; ++m)
#pragma unroll
                for (int n = 0; n < 2; ++n) acc[a][b][m][n] = (f32x4){0.f, 0.f, 0.f, 0.f};
    bf16x8 At[4][2], B0[2][2], B1[2][2];
    const char* cA = GATHER ? (const char*)g.A : (const char*)g.A + (size_t)cur.pm * tstep + (cur.pm >= g.spm ? g.sdelta : 0L); const char* cB = (const char*)g.Bt + (size_t)cur.pn * tstep;
#pragma unroll
    for (int h = 0; h < 2; ++h)
#pragma unroll
        for (int i = 0; i < 2; ++i) { if constexpr (GATHER) vAc[h][i] = S.a_row_off(cur, h * HALF + rA[i]) + (unsigned)cA2[i]; else vAc[h][i] = (unsigned)((h * HALF + rA[i]) * K) * 2u + (unsigned)cA2[i]; vAn[h][i] = vAc[h][i]; }
    S.a_ready(cur);
    if constexpr (SP2) {
        PG8_STAGE(PG8_SB(0, 0), cB, voffB); PG8_STAGE(PG8_SB(0, 1), cB + hstep, voffB); PG8_STAGE(PG8_SA(0, 0), cA, vAc[0]); PG8_STAGE(PG8_SA(0, 1), cA, vAc[1]);
        if (wr == 1) PG8_BAR;
        PG8_WAIT_V(2); PG8_BAR;
        PG8_STAGE(PG8_SB(1, 0), cB + kstep, voffB); PG8_STAGE(PG8_SA(1, 0), cA + kstep, vAc[0]); PG8_STAGE(PG8_SB(1, 1), cB + hstep + kstep, voffB);
        PG8_WAIT_V(6); PG8_BAR;
    }
    for (;;) {
        const bool has_next = S.next(ui + 1, nxt);
        const char* nA = GATHER ? cA : (has_next ? (const char*)g.A + (size_t)nxt.pm * tstep + (nxt.pm >= g.spm ? g.sdelta : 0L) : cA); const char* nB = has_next ? (const char*)g.Bt + (size_t)nxt.pn * tstep : cB;
        if constexpr (GATHER) { if (has_next) {
#pragma unroll
            for (int h = 0; h < 2; ++h)
#pragma unroll
                for (int i = 0; i < 2; ++i) vAn[h][i] = S.a_row_off(nxt, h * HALF + rA[i]) + (unsigned)cA2[i]; } }
#pragma unroll 1
        for (int t = 0; t < nt; t += 2) {
            const bool last = (t == nt - 2);
            asm volatile("" : "+v"(voffB[0]), "+v"(voffB[1]), "+v"(vAc[0][0]), "+v"(vAc[0][1]), "+v"(vAc[1][0]), "+v"(vAc[1][1]));
            const char* a1 = cA + (size_t)(t + 1) * kstep;
            const char* a2 = last ? nA : cA + (size_t)(t + 2) * kstep; const char* b2 = last ? nB : cB + (size_t)(t + 2) * kstep;
            const char* a3 = a2 + kstep; const char* b3 = b2 + kstep;
            unsigned vA2[2][2];
#pragma unroll
            for (int h = 0; h < 2; ++h)
#pragma unroll
                for (int i = 0; i < 2; ++i) vA2[h][i] = vAc[h][i];
            if constexpr (GATHER) { if (last) {
                asm volatile("" : "+v"(vAn[0][0]), "+v"(vAn[0][1]), "+v"(vAn[1][0]), "+v"(vAn[1][1]));
#pragma unroll
                for (int h = 0; h < 2; ++h)
#pragma unroll
                    for (int i = 0; i < 2; ++i) vA2[h][i] = vAn[h][i]; } }
            if (last && has_next) S.a_ready(nxt);
            if constexpr (SP2) {
            const int lenient = __builtin_amdgcn_readfirstlane((ui > 0 && t == 0) ? 1 : 0);
#define PG8_WAIT_V8L() asm volatile("s_cmp_eq_u32 %0, 0\n\ts_cbranch_scc0 .Lpg8skip%=\n\ts_waitcnt vmcnt(8)\n.Lpg8skip%=:\n\ts_waitcnt vmcnt(%1)" :: "s"(lenient), "i"(8 + Epi::NSTORE) : "memory", "scc")
            PG8_LDB(B0, 0, 0); PG8_LDB(B1, 0, 1); PG8_SCHED; PG8_LDA(At, 0, 0); PG8_STAGE(PG8_SA(1, 1), a1, vAc[1]);
            PG8_WAIT_V8L(); PG8_WAIT_L(0); PG8_BAR; PG8_MMA(0, 0, At, B0); PG8_MMA(0, 1, At, B1); PG8_BAR; PG8_SCHED;
            PG8_LDA(At, 0, 1); PG8_STAGE(PG8_SB(0, 0), b2, voffB); PG8_STAGE(PG8_SB(0, 1), b2 + hstep, voffB); PG8_STAGE(PG8_SA(0, 0), a2, vA2[0]);
            PG8_WAIT_V8L(); PG8_WAIT_L(0); PG8_BAR; PG8_MMA(1, 0, At, B0); PG8_MMA(1, 1, At, B1); PG8_BAR; PG8_SCHED;
            PG8_LDB(B0, 1, 0); PG8_LDB(B1, 1, 1); PG8_SCHED; PG8_LDA(At, 1, 0); PG8_STAGE(PG8_SA(0, 1), a2, vA2[1]);
            PG8_WAIT_V(8); PG8_WAIT_L(0); PG8_BAR; PG8_MMA(0, 0, At, B0); PG8_MMA(0, 1, At, B1); PG8_BAR; PG8_SCHED;
            PG8_LDA(At, 1, 1); PG8_STAGE(PG8_SB(1, 0), b3, voffB); PG8_STAGE(PG8_SB(1, 1), b3 + hstep, voffB); PG8_STAGE(PG8_SA(1, 0), a3, vA2[0]);
            PG8_WAIT_V(8); PG8_WAIT_L(0); PG8_BAR; PG8_MMA(1, 0, At, B0); PG8_MMA(1, 1, At, B1); PG8_BAR; PG8_SCHED;
#undef PG8_WAIT_V8L
            }
        }
        if constexpr (ALIGN_EPI) { if (wr == 0) PG8_BAR; }
        if constexpr (!Epi::AFTER_DRAIN) { const int le = lane_id(); E(acc, cur, wr, wc, le & 15, le >> 4); S.done(cur, ui, le); }
        if (!has_next) break;
#pragma unroll
        for (int a = 0; a < 2; ++a)
#pragma unroll
            for (int b = 0; b < 2; ++b)
#pragma unroll
                for (int m = 0; m < 4; ++m)
#pragma unroll
                    for (int n = 0; n < 2; ++n) acc[a][b][m][n] = (f32x4){0.f, 0.f, 0.f, 0.f};
        cur = nxt; cA = nA; cB = nB; ++ui;
        if constexpr (GATHER) {
#pragma unroll
            for (int h = 0; h < 2; ++h)
#pragma unroll
                for (int i = 0; i < 2; ++i) vAc[h][i] = vAn[h][i]; }
        if constexpr (ALIGN_EPI) { if (wr == 1) PG8_BAR; }
    }
    PG8_WAIT_V(0);
    if constexpr (!ALIGN_EPI) { if (wr == 0) PG8_BAR; }
    PG8_BAR;
    if constexpr (Epi::AFTER_DRAIN) { E.fused(acc, cur, wr, wc, fr, fq, lds, wid, lane); S.done(cur, ui, lane); }
#undef PG8_SA
#undef PG8_SB
#undef PG8_STAGE
#undef PG8_LDA
#undef PG8_LDB
#undef PG8_MMA
#undef PG8_CAT8
#undef PG8_WAIT_V
#undef PG8_WAIT_VN
#undef PG8_WAIT_L
#undef PG8_BAR
#undef PG8_SCHED
}
}
#define GAS __attribute__((address_space(1)))
#define LAS __attribute__((address_space(3)))
typedef unsigned short bf16;
typedef unsigned v4u __attribute__((ext_vector_type(4)));
typedef float f32x4 __attribute__((ext_vector_type(4)));
typedef short bf16x8 __attribute__((ext_vector_type(8)));
typedef GAS unsigned gu32;
typedef GAS unsigned long long gu64;
#define RLX_AGENT __ATOMIC_RELAXED, __HIP_MEMORY_SCOPE_AGENT
#define LDS_WAIT() asm volatile("s_waitcnt lgkmcnt(0)" ::: "memory")
#define VM_WAIT() asm volatile("s_waitcnt vmcnt(0)" ::: "memory")
__device__ __forceinline__ unsigned long long rt() { return __builtin_amdgcn_s_memrealtime(); }
__device__ __forceinline__ unsigned f2bf(float f) { unsigned u = __builtin_bit_cast(unsigned, f); return (u + 0x7fffu + ((u >> 16) & 1u)) >> 16; }
__device__ __forceinline__ unsigned pk2(float lo, float hi) { return f2bf(lo) | (f2bf(hi) << 16); }

#define XB_TMO      128
#define XB_XCNT(j)  (256  + 64 * (j))
#define XB_XSUB(j)  (1280 + 64 * (j))
#define XB_XGEN(j)  (2304 + 64 * (j))
#define XB_TOP      3328
#define XB_TOPGEN   3392
#define XCD_BAR_WORDS 3456
#define XB_SPIN_CAP (1u << 18)

__device__ __forceinline__ unsigned xb_ld(unsigned* p)              { return __hip_atomic_load(p, __ATOMIC_RELAXED, __HIP_MEMORY_SCOPE_AGENT); }
__device__ __forceinline__ unsigned xb_add(unsigned* p, unsigned v) { return __hip_atomic_fetch_add(p, v, __ATOMIC_RELAXED, __HIP_MEMORY_SCOPE_AGENT); }
__device__ __forceinline__ unsigned xb_xcc_id() { return (unsigned)__builtin_amdgcn_s_getreg((3 << 11) | 20) & 0xFu; }
#define XB_SPIN(cond, bar) do { unsigned _sp = 0; while (cond) { __builtin_amdgcn_s_sleep(1); \
    if ((++_sp & 255u) == 0u) { if (xb_ld(&(bar)[XB_TMO])) break; if (_sp > XB_SPIN_CAP) { atomicAdd(&(bar)[XB_TMO], 1u); break; } } } } while (0)

struct XcdBarrier {
    unsigned* bar; unsigned x; int wv;
    volatile LAS unsigned* st;
};

__device__ __forceinline__ XcdBarrier xcd_barrier_post(unsigned* bar, volatile LAS unsigned* st) {
    XcdBarrier b; b.bar = bar; b.x = xb_xcc_id(); b.st = st; b.wv = 0;
    if (threadIdx.x == 0) (void)xb_add(&bar[XB_XCNT(b.x)], 1u);
    return b;
}
__device__ __forceinline__ void xcd_barrier_complete(unsigned* bar, unsigned x, unsigned& nloc, unsigned& nx) {
    const unsigned G = gridDim.x * gridDim.y * gridDim.z;
    unsigned sum, cnt, mine, sp = 0u;
    for (;;) {
        sum = 0u; cnt = 0u; mine = 0u;
#pragma unroll
        for (unsigned j = 0; j < 16; ++j) { const unsigned c = xb_ld(&bar[XB_XCNT(j)]); sum += c; cnt += (c > 0u) ? 1u : 0u; mine = (j == x) ? c : mine; }
        if (sum == G) break;
        __builtin_amdgcn_s_sleep(1);
        if ((++sp & 255u) == 0u) { if (xb_ld(&bar[XB_TMO])) break; if (sp > XB_SPIN_CAP) { atomicAdd(&bar[XB_TMO], 1u); break; } }
    }
    nloc = mine > 0u ? mine : 1u; nx = cnt > 0u ? cnt : 1u;
}

__device__ __forceinline__ void xcd_barrier(const XcdBarrier& b) {
    asm volatile("s_waitcnt vmcnt(0)" ::: "memory");
    __syncthreads();
    if (b.wv == 0 && (int)__builtin_amdgcn_mbcnt_hi(~0u, __builtin_amdgcn_mbcnt_lo(~0u, 0u)) == 0) {
        unsigned* bar = b.bar;
        __builtin_amdgcn_s_waitcnt(0);
        unsigned nloc = b.st[0], nx = b.st[1];
        if (nloc == 0u) { xcd_barrier_complete(bar, b.x, nloc, nx); b.st[0] = nloc; b.st[1] = nx; }
        const unsigned old = xb_add(&bar[XB_XSUB(b.x)], 1u);
        const unsigned gen = old / nloc;
        if (old + 1u == (gen + 1u) * nloc) {
            __builtin_amdgcn_fence(__ATOMIC_RELEASE, "agent");
            asm volatile("s_waitcnt vmcnt(0)" ::: "memory");
            const unsigned og = xb_add(&bar[XB_TOP], 1u);
            const unsigned tg = og / nx;
            if (og + 1u == (tg + 1u) * nx) xb_add(&bar[XB_TOPGEN], 1u);
            else XB_SPIN(xb_ld(&bar[XB_TOPGEN]) == tg, bar);
            __builtin_amdgcn_fence(__ATOMIC_ACQUIRE, "agent");
            xb_add(&bar[XB_XGEN(b.x)], 1u);
            asm volatile("s_waitcnt vmcnt(0)" ::: "memory");
        } else {
            XB_SPIN(xb_ld(&bar[XB_XGEN(b.x)]) == gen, bar);
            __builtin_amdgcn_fence(__ATOMIC_ACQUIRE, "agent");
            asm volatile("s_waitcnt vmcnt(0)" ::: "memory");
        }
    }
    __syncthreads();
}


constexpr int NWAVES = 8;
constexpr int RING_BYTES = 131072;
constexpr int LDSCTL_OFF = RING_BYTES, MISC_OFF = LDSCTL_OFF + 320;
constexpr int LDS_TS_OFF = LDSCTL_OFF + 1024;
constexpr int LDS_TE_OFF = LDSCTL_OFF + 2048;
constexpr int LDS_CNT_OFF = LDSCTL_OFF + 1024 + 128;
constexpr int LDS_BYTES = 163840;

typedef short s16x4 __attribute__((ext_vector_type(4)));
typedef unsigned u32x2 __attribute__((ext_vector_type(2)));

struct Args { const float* in[20]; float* out; unsigned char* ws; unsigned mask; int bar_region; };

__device__ __forceinline__ float bflo(unsigned w) { return __uint_as_float(w << 16); }
__device__ __forceinline__ float bfhi(unsigned w) { return __uint_as_float(w & 0xffff0000u); }
__device__ __forceinline__ unsigned cvtpk(float lo, float hi) { return pg8::cvt_pk_bf16(lo, hi); }
__device__ __forceinline__ float wave_sum(float v) {
#pragma unroll
    for (int o = 1; o < 64; o <<= 1) v += __shfl_xor(v, o);
    return v;
}
__device__ __forceinline__ unsigned offb(unsigned row, unsigned ch) { return 256u * row + 16u * (ch ^ (((row & 3u) << 2) | ((row >> 2) & 3u))); }
__device__ __forceinline__ s16x4 ldtr(const LAS unsigned char* p) { return __builtin_amdgcn_ds_read_tr16_b64_v4i16((LAS s16x4*)p); }
__device__ __forceinline__ bf16x8 cat8(s16x4 a, s16x4 b) { return (bf16x8){a[0], a[1], a[2], a[3], b[0], b[1], b[2], b[3]}; }
#define MFMA16(a, b, c) __builtin_amdgcn_mfma_f32_16x16x32_bf16((a), (b), (c), 0, 0, 0)

template <int MODE> __device__ __forceinline__ int dest_row(int n) {
    if (MODE == 1) { if (n >= 1024) return n; const int hb = n & ~127, d = n & 127, jr = d & 63, half = d >> 6; return hb + 8 * (jr >> 2) + 4 * half + (jr & 3); }
    if (MODE == 2) return ((n >> 2) << 3) + (n & 3);
    if (MODE == 3) return ((n >> 2) << 3) + 4 + (n & 3);
    return n;
}
template <int MODE> __device__ __forceinline__ void p0_transpose_item(const float* W, int K, int N, bf16* WT, LAS float* scr, int item, int lane) {
    const int nblk = N / 32, kb = item / nblk, nb = item % nblk, k0 = 64 * kb, n0 = 32 * nb;
    {
        const GAS f32x4* src = (const GAS f32x4*)(W + (size_t)(k0 + (lane >> 3)) * N + n0) + (lane & 7);
        f32x4 t[8];
#pragma unroll
        for (int j = 0; j < 8; ++j) t[j] = src[(size_t)j * 2 * N];
#pragma unroll
        for (int j = 0; j < 8; ++j) { LAS float* d = scr + ((lane >> 3) + 8 * j) * 33 + 4 * (lane & 7); d[0] = t[j].x; d[1] = t[j].y; d[2] = t[j].z; d[3] = t[j].w; }
    }
    LDS_WAIT(); asm volatile("" ::: "memory");
    const int c = lane & 7;
#pragma unroll
    for (int j = 0; j < 4; ++j) { const int n = (lane >> 3) + 8 * j; const LAS float* s = scr + (8 * c) * 33 + n;
        v4u o; o.x = pk2(s[0 * 33], s[1 * 33]); o.y = pk2(s[2 * 33], s[3 * 33]); o.z = pk2(s[4 * 33], s[5 * 33]); o.w = pk2(s[6 * 33], s[7 * 33]);
        *(GAS v4u*)(WT + (size_t)dest_row<MODE>(n0 + n) * K + k0 + 8 * c) = o; }
    LDS_WAIT(); asm volatile("" ::: "memory");
}
__device__ __forceinline__ unsigned pk_fp8x4(float a, float b, float c, float d) {
    a = fminf(fmaxf(a, -448.f), 448.f); b = fminf(fmaxf(b, -448.f), 448.f); c = fminf(fmaxf(c, -448.f), 448.f); d = fminf(fmaxf(d, -448.f), 448.f);
    unsigned w = 0u; w = __builtin_amdgcn_cvt_pk_fp8_f32(a, b, w, false); w = __builtin_amdgcn_cvt_pk_fp8_f32(c, d, w, true); return w;
}
template <int MODE> __device__ __forceinline__ void p0_transpose_item_fp8(const float* W, int K, int N, unsigned char* WT, LAS float* scr, int item, int lane, float scale) {
    const int nblk = N / 32, kb = item / nblk, nb = item % nblk, k0 = 64 * kb, n0 = 32 * nb;
    {
        const GAS f32x4* src = (const GAS f32x4*)(W + (size_t)(k0 + (lane >> 3)) * N + n0) + (lane & 7);
        f32x4 t[8];
#pragma unroll
        for (int j = 0; j < 8; ++j) t[j] = src[(size_t)j * 2 * N];
#pragma unroll
        for (int j = 0; j < 8; ++j) { LAS float* d = scr + ((lane >> 3) + 8 * j) * 33 + 4 * (lane & 7); d[0] = t[j].x; d[1] = t[j].y; d[2] = t[j].z; d[3] = t[j].w; }
    }
    LDS_WAIT(); asm volatile("" ::: "memory");
    const int c = lane & 7;
#pragma unroll
    for (int j = 0; j < 4; ++j) { const int n = (lane >> 3) + 8 * j; const LAS float* s = scr + (8 * c) * 33 + n;
        u32x2 o; o.x = pk_fp8x4(s[0 * 33] * scale, s[1 * 33] * scale, s[2 * 33] * scale, s[3 * 33] * scale); o.y = pk_fp8x4(s[4 * 33] * scale, s[5 * 33] * scale, s[6 * 33] * scale, s[7 * 33] * scale);
        *(GAS u32x2*)(WT + (size_t)dest_row<MODE>(n0 + n) * K + k0 + 8 * c) = o; }
    LDS_WAIT(); asm volatile("" ::: "memory");
}
__device__ __forceinline__ int t5_bucket(int rel) {
    const int n = rel < 0 ? -rel : rel;
    int large = 8 + (n >= 15) + (n >= 27) + (n >= 50) + (n >= 91) + (n >= 166) + (n >= 305) + (n >= 559);
    large = large < 15 ? large : 15;
    return (rel > 0 ? 16 : 0) + (n < 8 ? n : large);
}
__device__ __forceinline__ void p0_prologue(const Args& a, LAS unsigned char* lds, int vcu, int G, int tid, int wave, int lane) {
    unsigned char* ws = a.ws;
    LAS float* scr = (LAS float*)(lds + wave * 16384);
    const int gw = vcu * NWAVES + wave, NGW = G * NWAVES;
    constexpr int I_IN = 16 * 208, I_R = 16 * 32, I_A = 8 * 32, I_O = 16 * 32;
    constexpr int NITEMS = I_IN + I_R + I_A + I_O;
    for (int it = gw; it < NITEMS; it += NGW) {
        int r = it;
#if P1_FP8
        if (r < I_IN) { if ((GATE_FP8 || r % 208 < 144) && r % 208 >= 8 * P1_FP8_FROM) p0_transpose_item_fp8<1>(a.in[1], 1024, 6656, ws + WS_WIN8, scr, r, lane, 64.f);
                        else p0_transpose_item<1>(a.in[1], 1024, 6656, (bf16*)(ws + WS_WIN), scr, r, lane); continue; } r -= I_IN;
#else
        if (r < I_IN) { p0_transpose_item<1>(a.in[1], 1024, 6656, (bf16*)(ws + WS_WIN), scr, r, lane); continue; } r -= I_IN;
#endif
        if (r < I_R) { if (MIX_FP8 & 4) p0_transpose_item_fp8<0>(a.in[5], 1024, 1024, ws + WS_WR, scr, r, lane, 64.f); else p0_transpose_item<0>(a.in[5], 1024, 1024, (bf16*)(ws + WS_WR), scr, r, lane); continue; } r -= I_R;
        if (r < I_A) { if (MIX_FP8 & 2) p0_transpose_item_fp8<0>(a.in[7], 512, 1024, ws + WS_WA, scr, r, lane, 64.f); else p0_transpose_item<0>(a.in[7], 512, 1024, (bf16*)(ws + WS_WA), scr, r, lane); continue; } r -= I_A;
        if (MIX_FP8 & 1) p0_transpose_item_fp8<0>(a.in[8], 1024, 1024, ws + WS_WO, scr, r, lane, 64.f); else p0_transpose_item<0>(a.in[8], 1024, 1024, (bf16*)(ws + WS_WO), scr, r, lane);
    }
    {
        const f32x4* x4 = (const f32x4*)a.in[0]; u32x2* xb = (u32x2*)(ws + WS_XB);
#if P1_FP8
#if GATE_FP8
        unsigned* xf8 = (unsigned*)(ws + WS_X8_LO);
#define XF8_AT(i) xf8[(long)(i) + ((i) >= (size_t)16384 * 256 ? ((long)WS_X8_HI - (long)WS_X8_LO - (long)(16 * MiB)) / 4 : 0L)]
#else
        unsigned* xf8 = (unsigned*)a.out;
#define XF8_AT(i) xf8[i]
#endif
        const size_t n4 = (size_t)TT * DM / 4, st = (size_t)G * 512; size_t i = (size_t)vcu * 512 + tid;
        for (; i + 7 * st < n4; i += 8 * st) {
            f32x4 v[8];
#pragma unroll
            for (int u = 0; u < 8; ++u) v[u] = x4[i + u * st];
#pragma unroll
            for (int u = 0; u < 8; ++u) { if (!X_F32_RES) { u32x2 o; o.x = cvtpk(v[u].x, v[u].y); o.y = cvtpk(v[u].z, v[u].w); xb[i + u * st] = o; } XF8_AT(i + u * st) = pk_fp8x4(v[u].x, v[u].y, v[u].z, v[u].w); }
        }
        for (; i < n4; i += st) { const f32x4 v = x4[i]; if (!X_F32_RES) { u32x2 o; o.x = cvtpk(v.x, v.y); o.y = cvtpk(v.z, v.w); xb[i] = o; } XF8_AT(i) = pk_fp8x4(v.x, v.y, v.z, v.w); }
#undef XF8_AT
#else
        for (size_t i = (size_t)vcu * 512 + tid; i < (size_t)TT * DM / 4; i += (size_t)G * 512) { const f32x4 v = x4[i]; u32x2 o; o.x = cvtpk(v.x, v.y); o.y = cvtpk(v.z, v.w); xb[i] = o; }
#endif
    }
    {
        float* rot = (float*)(ws + WS_ROT);
        for (int idx = vcu * 512 + tid; idx < SEQ * 64; idx += G * 512) {
            const int pos = idx >> 6, jr = idx & 63;
            double iv = 1.0; for (int k = 0; k < jr; ++k) iv *= 0.86596432336006535;
            const float ang = (float)pos * (float)iv;
            const double xx = (double)ang; const double qd = __builtin_rint(xx * 0.63661977236758134); const int qi = (int)qd;
            const double r = (xx - qd * 1.5707963267948966) - qd * 6.123233995736766e-17, r2 = r * r;
            const double sp = r * (1.0 + r2 * (-1.0 / 6 + r2 * (1.0 / 120 + r2 * (-1.0 / 5040 + r2 * (1.0 / 362880 + r2 * (-1.0 / 39916800 + r2 * (1.0 / 6227020800.0)))))));
            const double cp = 1.0 + r2 * (-0.5 + r2 * (1.0 / 24 + r2 * (-1.0 / 720 + r2 * (1.0 / 40320 + r2 * (-1.0 / 3628800 + r2 * (1.0 / 479001600.0))))));
            const int qq = qi & 3; const double s = qq == 0 ? sp : (qq == 1 ? cp : (qq == 2 ? -sp : -cp)), c = qq == 0 ? cp : (qq == 1 ? -sp : (qq == 2 ? -cp : sp));
            float* o = rot + ((size_t)pos * 16 + (jr >> 2)) * 8 + (jr & 3); o[0] = (float)c; o[4] = (float)s;
        }
    }
    if (vcu == 0) {
        float* bt = (float*)(ws + WS_BIAS); const float* rb = a.in[6];
        for (int idx = tid; idx < 3 * 8 * 160; idx += 512) { const int p = idx / (8 * 160), h = (idx / 160) % 8, d = idx % 160 - 80; const int dil = p == 0 ? 1 : (p == 1 ? 4 : 16);
            bt[idx] = (d >= -64 && d <= 64) ? rb[t5_bucket(d * dil) * 8 + h] * 1.4426950408889634f : -1e30f; }
    }
}
__device__ __forceinline__ void p0_expert_weights(const Args& a, LAS unsigned char* lds, int vcu, int G, int wave, int lane) {
    unsigned char* ws = a.ws;
    LAS float* scr = (LAS float*)(lds + wave * 16384);
    const int gw = vcu * NWAVES + wave, NGW = G * NWAVES;
    constexpr int I_G = 16 * 16, I_D = 8 * 32, PER_E = 2 * I_G + I_D;
    for (int it = gw; it < 16 * PER_E; it += NGW) {
        const int e = it / PER_E; int r = it - e * PER_E;
#if M1_FP8
        if (r < I_G) { p0_transpose_item_fp8<2>(a.in[15] + (size_t)e * 1024 * 512, 1024, 512, ws + WS_WGU + (size_t)e * 1024 * 1024, scr, r, lane, 64.f); continue; } r -= I_G;
        if (r < I_G) { p0_transpose_item_fp8<3>(a.in[16] + (size_t)e * 1024 * 512, 1024, 512, ws + WS_WGU + (size_t)e * 1024 * 1024, scr, r, lane, 64.f); continue; } r -= I_G;
#else
        if (r < I_G) { p0_transpose_item<2>(a.in[15] + (size_t)e * 1024 * 512, 1024, 512, (bf16*)(ws + WS_WGU) + (size_t)e * 1024 * 1024, scr, r, lane); continue; } r -= I_G;
        if (r < I_G) { p0_transpose_item<3>(a.in[16] + (size_t)e * 1024 * 512, 1024, 512, (bf16*)(ws + WS_WGU) + (size_t)e * 1024 * 1024, scr, r, lane); continue; } r -= I_G;
#endif
        p0_transpose_item_fp8<0>(a.in[17] + (size_t)e * 512 * 1024, 512, 1024, ws + WS_WD + (size_t)e * 1024 * 512, scr, r, lane, 64.f);
    }
    __syncthreads();
}

__device__ __forceinline__ float log2_gamma(const float* dec, int h) {
    const float x = dec[h]; return -__log2f(1.f + __expf(-x));
}
__device__ __forceinline__ void chain_item(const Args& a, LAS unsigned char* lds, int item, int tid, int wid, int lane) {
    unsigned char* ws = a.ws;
    const int b = item >> 4, h = (item >> 2) & 3, dir = (item >> 1) & 1, vh = item & 1;
    const float lg2 = log2_gamma(dir ? a.in[3] : a.in[2], h);
    const float cd = __builtin_amdgcn_exp2f(lg2 * 128.f);
    const int g = lane >> 4, i16 = lane & 15, q = i16 >> 2, p = lane & 3;
    const int wd = wid >> 1, wv = wid & 1;
    const GAS bf16* kr = (const GAS bf16*)(ws + WS_KR); const GAS bf16* vr = (const GAS bf16*)(ws + WS_VR);
    GAS bf16* states = (GAS bf16*)a.out;
    f32x4 acc[2][4];
#pragma unroll
    for (int i = 0; i < 2; ++i)
#pragma unroll
        for (int j = 0; j < 4; ++j) acc[i][j] = (f32x4){0.f, 0.f, 0.f, 0.f};
    const int srow = tid >> 4, sch = tid & 15; const unsigned soff = offb(srow, sch);
    const GAS bf16* kp = kr + ((size_t)b * SEQ + srow) * 512 + h * 128 + sch * 8;
    const GAS bf16* vp = vr + ((size_t)b * SEQ + srow) * 1024 + h * 256 + vh * 128 + sch * 8;
    v4u kq[4], vq[4];
    { const int n0 = dir ? 15 : 0;
#pragma unroll
      for (int j = 0; j < 4; ++j) { kq[j] = *(const GAS v4u*)(kp + (size_t)(n0 * 128 + 32 * j) * 512); vq[j] = *(const GAS v4u*)(vp + (size_t)(n0 * 128 + 32 * j) * 1024); } }
    unsigned abase[2][2], bbase[4][2];
#pragma unroll
    for (int t = 0; t < 2; ++t) { const unsigned r = 8 * g + 4 * t + q;
#pragma unroll
        for (int dt = 0; dt < 2; ++dt) abase[dt][t] = offb(r, 2 * (2 * wd + dt) + (p >> 1)) + 8 * (p & 1);
#pragma unroll
        for (int vt = 0; vt < 4; ++vt) bbase[vt][t] = offb(r, 2 * (4 * wv + vt) + (p >> 1)) + 8 * (p & 1); }
#define CH_STAGE(BUFOFF) do { _Pragma("unroll") for (int j = 0; j < 4; ++j) { \
            const int row = srow + 32 * j; const float z = __builtin_amdgcn_exp2f(lg2 * (float)(dir ? row : 127 - row)); const v4u kv = kq[j]; \
            v4u ko; ko.x = cvtpk(bflo(kv.x) * z, bfhi(kv.x) * z); ko.y = cvtpk(bflo(kv.y) * z, bfhi(kv.y) * z); ko.z = cvtpk(bflo(kv.z) * z, bfhi(kv.z) * z); ko.w = cvtpk(bflo(kv.w) * z, bfhi(kv.w) * z); \
            *(LAS v4u*)(lds + (BUFOFF) + soff + j * 8192) = ko; *(LAS v4u*)(lds + (BUFOFF) + 32768 + soff + j * 8192) = vq[j]; } } while (0)
#define CH_FETCH(NN) do { _Pragma("unroll") for (int j = 0; j < 4; ++j) { kq[j] = *(const GAS v4u*)(kp + (size_t)((NN) * 128 + 32 * j) * 512); vq[j] = *(const GAS v4u*)(vp + (size_t)((NN) * 128 + 32 * j) * 1024); } } while (0)
#define CH_STEP(STEP, CUR, OTH) do { const int step_ = (STEP); const int n_ = dir ? 15 - step_ : step_; \
        GAS bf16* sb_ = states + ((((size_t)(b * 4 + h) * 16 + n_) * 2 + dir) * 256) * 128; \
        _Pragma("unroll") for (int dt = 0; dt < 2; ++dt) _Pragma("unroll") for (int vt = 0; vt < 4; ++vt) { \
            const int v_ = vh * 128 + 64 * wv + 16 * vt + i16, d0_ = 32 * wd + 16 * dt + 4 * g; \
            u32x2 w_; w_.x = pg8::cvt_pk_bf16_acc(acc[dt][vt][0], acc[dt][vt][1]); w_.y = pg8::cvt_pk_bf16_acc(acc[dt][vt][2], acc[dt][vt][3]);   \
            *(GAS u32x2*)(sb_ + (size_t)v_ * 128 + d0_) = w_; } \
        if (step_ < 15) CH_STAGE(OTH); \
        if (step_ < 14) CH_FETCH(dir ? 13 - step_ : step_ + 2); \
        _Pragma("unroll") for (int i = 0; i < 2; ++i) _Pragma("unroll") for (int j = 0; j < 4; ++j) acc[i][j] = acc[i][j] * cd; \
        _Pragma("unroll") for (int ks = 0; ks < 4; ++ks) { bf16x8 af[2], bfr[4]; \
            _Pragma("unroll") for (int dt = 0; dt < 2; ++dt) af[dt] = cat8(ldtr(lds + (CUR) + abase[dt][0] + ks * 8192), ldtr(lds + (CUR) + abase[dt][1] + ks * 8192)); \
            _Pragma("unroll") for (int vt = 0; vt < 4; ++vt) bfr[vt] = cat8(ldtr(lds + (CUR) + 32768 + bbase[vt][0] + ks * 8192), ldtr(lds + (CUR) + 32768 + bbase[vt][1] + ks * 8192)); \
            _Pragma("unroll") for (int dt = 0; dt < 2; ++dt) _Pragma("unroll") for (int vt = 0; vt < 4; ++vt) acc[dt][vt] = MFMA16(af[dt], bfr[vt], acc[dt][vt]); } \
        __syncthreads(); } while (0)
    CH_STAGE(0);
    CH_FETCH(dir ? 14 : 1);
    __syncthreads();
    for (int sp = 0; sp < 8; ++sp) { CH_STEP(2 * sp, 0, 65536); CH_STEP(2 * sp + 1, 65536, 0); }
#undef CH_STEP
#undef CH_STAGE
#undef CH_FETCH
}

constexpr int AT_OST = 135168, AT_SCR = AT_OST + 8 * 2048;
constexpr int ATB_N = 160;
struct AttnLane { unsigned kb[2]; unsigned vb[4]; };
__device__ __forceinline__ AttnLane attn_lane(int lane) {
    const int g = lane >> 4, i16 = lane & 15, q4 = i16 >> 2, p = lane & 3; AttnLane L;
#pragma unroll
    for (int s = 0; s < 2; ++s) L.kb[s] = i16 * 128 + (((4 * s + g) ^ ((i16 >> 1) & 7)) * 16);
    const int sw = (2 * g + (q4 >> 1)) & 3;
#pragma unroll
    for (int c = 0; c < 4; ++c) L.vb[c] = (4 * g + q4) * 128 + ((c ^ sw) * 32) + p * 8;
    return L;
}
__device__ __forceinline__ unsigned kimg_off(int row, int c) { return row * 128 + ((c ^ ((row >> 1) & 7)) * 16); }
__device__ __forceinline__ unsigned vimg_off(int row, int c) { return row * 128 + (((c >> 1) ^ ((row >> 1) & 3)) * 32) + (c & 1) * 16; }
__device__ __forceinline__ void attn_core(const LAS unsigned char* Kimg, const LAS unsigned char* Vimg, int R0, int nrows, unsigned tvalid, const bf16x8 (&qf)[2],
                                          const float (&biasr)[36], const AttnLane& L, f32x4 (&O)[4], float& mx, float& lsum) {
    f32x4 D[9];
#pragma unroll
    for (int kt = 0; kt < 9; ++kt) {
        int R = R0 + 16 * kt; R = R < 0 ? 0 : (R > nrows - 16 ? nrows - 16 : R);
        const LAS unsigned char* kp = Kimg + R * 128;
        const bf16x8 k0 = *(const LAS bf16x8*)(kp + L.kb[0]), k1 = *(const LAS bf16x8*)(kp + L.kb[1]);
        f32x4 d = (f32x4){0.f, 0.f, 0.f, 0.f};
        d = MFMA16(k0, qf[0], d); d = MFMA16(k1, qf[1], d); D[kt] = d;
    }
    mx = -1e30f;
#pragma unroll
    for (int kt = 0; kt < 9; ++kt) {
        const float tb = ((tvalid >> kt) & 1u) ? 0.f : -1e30f;
#pragma unroll
        for (int r = 0; r < 4; ++r) { const float x = D[kt][r] + (biasr[4 * kt + r] + tb); D[kt][r] = x; mx = fmaxf(mx, x); }
    }
    mx = fmaxf(mx, __shfl_xor(mx, 16)); mx = fmaxf(mx, __shfl_xor(mx, 32));
    lsum = 0.f;
#pragma unroll
    for (int kt = 0; kt < 9; ++kt)
#pragma unroll
        for (int r = 0; r < 4; ++r) { const float e = __builtin_amdgcn_exp2f(D[kt][r] - mx); D[kt][r] = e; lsum += e; }
    lsum += __shfl_xor(lsum, 16); lsum += __shfl_xor(lsum, 32);
#pragma unroll
    for (int c = 0; c < 4; ++c) O[c] = (f32x4){0.f, 0.f, 0.f, 0.f};
#pragma unroll
    for (int kk = 0; kk < 5; ++kk) {
        int Ra = R0 + 32 * kk; Ra = Ra < 0 ? 0 : (Ra > nrows - 16 ? nrows - 16 : Ra);
        int Rb = R0 + 32 * kk + 16; Rb = Rb < 0 ? 0 : (Rb > nrows - 16 ? nrows - 16 : Rb);
        if (kk == 4) Rb = Ra;
        const f32x4 e0 = D[2 * kk], e1 = kk < 4 ? D[2 * kk + 1] : (f32x4){0.f, 0.f, 0.f, 0.f};
        v4u pw; pw.x = cvtpk(e0[0], e0[1]); pw.y = cvtpk(e0[2], e0[3]); pw.z = cvtpk(e1[0], e1[1]); pw.w = cvtpk(e1[2], e1[3]);
        const bf16x8 pf = __builtin_bit_cast(bf16x8, pw);
        const LAS unsigned char* va_ = Vimg + Ra * 128; const LAS unsigned char* vb_ = Vimg + Rb * 128;
#pragma unroll
        for (int c = 0; c < 4; ++c) O[c] = MFMA16(pf, cat8(ldtr(va_ + L.vb[c]), ldtr(vb_ + L.vb[c])), O[c]);
    }
}
__device__ __forceinline__ void attn_stage_out(LAS unsigned char* lds, int wid, int lane, const f32x4 (&O)[4], float lsum) {
    const int g = lane >> 4, i16 = lane & 15;
    const float linv = 1.f / lsum;
    LAS bf16* st = (LAS bf16*)(lds + AT_OST + wid * 2048);
#pragma unroll
    for (int r = 0; r < 4; ++r) { const float li = __shfl(linv, 4 * g + r);
#pragma unroll
        for (int c = 0; c < 4; ++c) st[(4 * g + r) * 64 + 16 * c + i16] = (bf16)(cvtpk(O[c][r] * li, 0.f) & 0xffffu); }
}
__device__ __forceinline__ void attn_load_bias(const Args& a, int pat, int h, int lane, float (&biasr)[36]) {
    const GAS float* bt = (const GAS float*)(a.ws + WS_BIAS) + (pat * 8 + h) * ATB_N; const int g = lane >> 4, i16 = lane & 15;
#pragma unroll
    for (int kt = 0; kt < 9; ++kt)
#pragma unroll
        for (int r = 0; r < 4; ++r) biasr[4 * kt + r] = bt[16 * kt + 4 * g + r - 64 - i16 + 80];
}
template <int DIL, int VAR = 0> __device__ __forceinline__ void attn_dil_phase(const Args& a, LAS unsigned char* lds, int vcu, int G, int tid, int wid, int lane) {
    unsigned char* ws = a.ws;
    constexpr int NR = SEQ / DIL, PAT = DIL == 4 ? 1 : 2, CH = NR * 8 / 512, NITEM = NB * 8 * DIL;
    constexpr int NBUF = DIL == 16 ? 2 : 1, BUFB = 2 * NR * 128;
    const GAS bf16* qa = (const GAS bf16*)(ws + WS_QA); const GAS bf16* ka = (const GAS bf16*)(ws + WS_KA); const GAS bf16* va = (const GAS bf16*)(ws + WS_VA);
    bf16* op = (bf16*)(ws + (DIL == 4 ? WS_O2 : WS_O3)); float* lsep = (float*)(ws + (DIL == 4 ? WS_LSE2 : WS_LSE3));
    if (vcu >= NITEM) return;
    const int h = vcu & 7;
    float biasr[36]; attn_load_bias(a, PAT, h, lane, biasr);
    const AttnLane L = attn_lane(lane);
    const int g = lane >> 4, i16 = lane & 15;
    v4u kq[CH], vq[CH]; bf16x8 qn[2];
    auto issue = [&](int item, int gi) {
        const int rho = (item >> 3) % DIL, b = item / (8 * DIL); const size_t rowb = (size_t)b * SEQ;
#pragma unroll
        for (int j = 0; j < CH; ++j) { const int id = tid + 512 * j, row = id >> 3, c = id & 7; const size_t go = (rowb + (size_t)row * DIL + rho) * 512 + h * 64 + c * 8;
            kq[j] = *(const GAS v4u*)(ka + go); vq[j] = *(const GAS v4u*)(va + go); }
        const size_t qpos = rowb + (size_t)(16 * gi + i16) * DIL + rho;
#pragma unroll
        for (int s = 0; s < 2; ++s) qn[s] = *(const GAS bf16x8*)(qa + qpos * 512 + h * 64 + 32 * s + 8 * g);
    };
    issue(vcu, wid);
    int buf = 0;
    for (int item = vcu; item < NITEM; item += G) {
        const int rho = (item >> 3) % DIL, b = item / (8 * DIL); const size_t rowb = (size_t)b * SEQ;
        LAS unsigned char* Kimg = lds + buf * BUFB; LAS unsigned char* Vimg = Kimg + NR * 128;
        if (NBUF == 1) __syncthreads();
#pragma unroll
        for (int j = 0; j < CH; ++j) { const int id = tid + 512 * j, row = id >> 3, c = id & 7;
            *(LAS v4u*)(Kimg + kimg_off(row, c)) = kq[j]; *(LAS v4u*)(Vimg + vimg_off(row, c)) = vq[j]; }
        bf16x8 qf[2] = {qn[0], qn[1]};
        __syncthreads();
        if (NBUF == 2 && item + G < NITEM) issue(item + G, wid);
        for (int gi = wid; gi < NR / 16; gi += 8) {
            const int m0 = 16 * gi;
            if (NBUF == 1 && gi + 8 < NR / 16) {
                const size_t qpos = rowb + (size_t)(m0 + 128 + i16) * DIL + rho;
#pragma unroll
                for (int s = 0; s < 2; ++s) qn[s] = *(const GAS bf16x8*)(qa + qpos * 512 + h * 64 + 32 * s + 8 * g); }
            unsigned tvalid = 0u;
#pragma unroll
            for (int kt = 0; kt < 9; ++kt) { const int t0 = m0 - 64 + 16 * kt; tvalid |= (t0 >= 0 && t0 < NR) ? (1u << kt) : 0u; }
            f32x4 O[4]; float mx, lsum;
            if (VAR == 1) { mx = 0.f; lsum = 1.f;
#pragma unroll
                for (int c = 0; c < 4; ++c) O[c] = (f32x4){__builtin_bit_cast(float, qf[0][0] + c), 0.f, 0.f, 0.f}; }
            else attn_core(Kimg, Vimg, m0 - 64, NR, tvalid, qf, biasr, L, O, mx, lsum);
            attn_stage_out(lds, wid, lane, O, lsum);
            if (g == 0) lsep[(rowb + (size_t)(m0 + i16) * DIL + rho) * 8 + h] = mx + __log2f(lsum);
            asm volatile("s_waitcnt lgkmcnt(0)" ::: "memory");
            { const int q = lane >> 2, qt = lane & 3; const LAS v4u* sp = (const LAS v4u*)(lds + AT_OST + wid * 2048 + q * 128 + qt * 32);
              const v4u x0 = sp[0], x1 = sp[1]; bf16* dst = op + (rowb + (size_t)(m0 + q) * DIL + rho) * 512 + h * 64 + qt * 16;
              *(v4u*)dst = x0; *(v4u*)(dst + 8) = x1; }
            asm volatile("s_waitcnt lgkmcnt(0)" ::: "memory");
            if (NBUF == 1) { qf[0] = qn[0]; qf[1] = qn[1]; }
        }
        if (NBUF == 1 && item + G < NITEM) issue(item + G, wid);
        buf ^= (NBUF - 1);
    }
    __syncthreads();
}
__device__ __forceinline__ void attn_p1_phase(const Args& a, LAS unsigned char* lds, int vcu, int G, int tid, int wid, int lane) {
    unsigned char* ws = a.ws;
    LAS unsigned char* Kimg = lds; LAS unsigned char* Vimg = lds + 384 * 128;
    const GAS bf16* qa = (const GAS bf16*)(ws + WS_QA); const GAS bf16* ka = (const GAS bf16*)(ws + WS_KA); const GAS bf16* va = (const GAS bf16*)(ws + WS_VA);
    const GAS bf16* o2 = (const GAS bf16*)(ws + WS_O2); const GAS bf16* o3 = (const GAS bf16*)(ws + WS_O3);
    const GAS float* lse2 = (const GAS float*)(ws + WS_LSE2); const GAS float* lse3 = (const GAS float*)(ws + WS_LSE3);
    bf16* oa = (bf16*)(ws + WS_OA);
    if (vcu >= 1024) return;
    const int h = vcu & 7;
    float biasr[36]; attn_load_bias(a, 0, h, lane, biasr);
    const AttnLane L = attn_lane(lane);
    const int g = lane >> 4, i16 = lane & 15;
    LAS float* scr = (LAS float*)(lds + AT_SCR) + wid * 16;
    v4u kq[6], vq[6];
    auto issue = [&](int item) { const int b = item >> 6, s0 = ((item >> 3) & 7) * 256; const size_t rowb = (size_t)b * SEQ;
#pragma unroll
        for (int j = 0; j < 6; ++j) { const int id = tid + 512 * j, row = id >> 3, c = id & 7, pos = s0 - 64 + row; const bool ok = pos >= 0 && pos < SEQ;
            const size_t go = (rowb + (size_t)(ok ? pos : 0)) * 512 + h * 64 + c * 8;
            kq[j] = *(const GAS v4u*)(ka + go); vq[j] = *(const GAS v4u*)(va + go);
            if (!ok) { kq[j] = (v4u){0u, 0u, 0u, 0u}; vq[j] = (v4u){0u, 0u, 0u, 0u}; } } };
    issue(vcu);
    for (int item = vcu; item < 1024; item += G) {
        const int b = item >> 6, s0 = ((item >> 3) & 7) * 256; const size_t rowb = (size_t)b * SEQ;
        __syncthreads();
#pragma unroll
        for (int j = 0; j < 6; ++j) { const int id = tid + 512 * j, row = id >> 3, c = id & 7;
            *(LAS v4u*)(Kimg + kimg_off(row, c)) = kq[j]; *(LAS v4u*)(Vimg + vimg_off(row, c)) = vq[j]; }
        __syncthreads();
        if (item + G < 1024) issue(item + G);
        for (int gi = wid; gi < 16; gi += 8) {
            const int m0 = s0 + 16 * gi;
            const int q = lane >> 2, qt = lane & 3; const size_t tq = rowb + m0 + q;
            const v4u a20 = *(const GAS v4u*)(o2 + tq * 512 + h * 64 + qt * 16), a21 = *(const GAS v4u*)(o2 + tq * 512 + h * 64 + qt * 16 + 8);
            const v4u a30 = *(const GAS v4u*)(o3 + tq * 512 + h * 64 + qt * 16), a31 = *(const GAS v4u*)(o3 + tq * 512 + h * 64 + qt * 16 + 8);
            const float l2 = lse2[tq * 8 + h], l3 = lse3[tq * 8 + h];
            bf16x8 qf[2];
#pragma unroll
            for (int s = 0; s < 2; ++s) qf[s] = *(const GAS bf16x8*)(qa + (rowb + m0 + i16) * 512 + h * 64 + 32 * s + 8 * g);
            unsigned tvalid = 0u;
#pragma unroll
            for (int kt = 0; kt < 9; ++kt) { const int t0 = m0 - 64 + 16 * kt; tvalid |= (t0 >= 0 && t0 < SEQ) ? (1u << kt) : 0u; }
            f32x4 O[4]; float mx, lsum;
            attn_core(Kimg, Vimg, 16 * gi, 384, tvalid, qf, biasr, L, O, mx, lsum);
            attn_stage_out(lds, wid, lane, O, lsum);
            if (g == 0) scr[i16] = mx + __log2f(lsum);
            asm volatile("s_waitcnt lgkmcnt(0)" ::: "memory");
            {
                const float l1 = scr[q], M = fmaxf(l1, fmaxf(l2, l3));
                float w1 = __builtin_amdgcn_exp2f(l1 - M), w2 = __builtin_amdgcn_exp2f(l2 - M), w3 = __builtin_amdgcn_exp2f(l3 - M); const float wi = 1.f / (w1 + w2 + w3); w1 *= wi; w2 *= wi; w3 *= wi;
                const LAS v4u* sp = (const LAS v4u*)(lds + AT_OST + wid * 2048 + q * 128 + qt * 32);
                const v4u x0 = sp[0], x1 = sp[1];
                v4u r0, r1;
#define MRG(d, x, y, z) d = cvtpk(w1 * bflo(x) + w2 * bflo(y) + w3 * bflo(z), w1 * bfhi(x) + w2 * bfhi(y) + w3 * bfhi(z))
                MRG(r0.x, x0.x, a20.x, a30.x); MRG(r0.y, x0.y, a20.y, a30.y); MRG(r0.z, x0.z, a20.z, a30.z); MRG(r0.w, x0.w, a20.w, a30.w);
                MRG(r1.x, x1.x, a21.x, a31.x); MRG(r1.y, x1.y, a21.y, a31.y); MRG(r1.z, x1.z, a21.z, a31.z); MRG(r1.w, x1.w, a21.w, a31.w);
#undef MRG
#if MIX_FP8 & 2
                v4u o8;
                o8.x = pk_fp8x4(16.f * bflo(r0.x), 16.f * bfhi(r0.x), 16.f * bflo(r0.y), 16.f * bfhi(r0.y)); o8.y = pk_fp8x4(16.f * bflo(r0.z), 16.f * bfhi(r0.z), 16.f * bflo(r0.w), 16.f * bfhi(r0.w));
                o8.z = pk_fp8x4(16.f * bflo(r1.x), 16.f * bfhi(r1.x), 16.f * bflo(r1.y), 16.f * bfhi(r1.y)); o8.w = pk_fp8x4(16.f * bflo(r1.z), 16.f * bfhi(r1.z), 16.f * bflo(r1.w), 16.f * bfhi(r1.w));
                *(v4u*)((unsigned char*)oa + tq * 512 + h * 64 + qt * 16) = o8;
#else
                bf16* dst = oa + tq * 512 + h * 64 + qt * 16;
                *(v4u*)dst = r0; *(v4u*)(dst + 8) = r1;
#endif
            }
            asm volatile("s_waitcnt lgkmcnt(0)" ::: "memory");
        }
    }
    __syncthreads();
}

#define OPAQUE(x) asm volatile("" : "+v"(x))
template <int VAR = 0> __device__ __forceinline__ void p3_phase(const Args& a, LAS unsigned char* lds, int vcu, int G, int tid, int wid, int lane) {
    unsigned char* ws = a.ws;
    const int g = lane >> 4, i16 = lane & 15, q4 = i16 >> 2, p = lane & 3;
    const GAS bf16* qr = (const GAS bf16*)(ws + WS_QR); const GAS bf16* kr = (const GAS bf16*)(ws + WS_KR); const GAS bf16* vr = (const GAS bf16*)(ws + WS_VR);
    GAS bf16* gr = (GAS bf16*)(ws + WS_GR);
    LAS unsigned char* Kt = lds; LAS unsigned char* Sg = lds + 32768;
    if (vcu >= 1024) return;
    const unsigned kdst = offb(tid >> 4, tid & 15);
    unsigned rfo[4];
    { const unsigned X = ((i16 & 3) << 2) | (i16 >> 2);
#pragma unroll
      for (int s = 0; s < 4; ++s) rfo[s] = 256 * i16 + 16 * (((4 * s) ^ (X & 12)) | (g ^ (X & 3))); }
    v4u sreg[8], kreg[4]; bf16x8 qn[4];
    auto item_ptrs = [&](int item, size_t& tok0, const GAS bf16*& sf, int& h) { const int b = item >> 6; h = (item >> 4) & 3; const int n = item & 15; tok0 = (size_t)b * SEQ + n * 128;
        sf = (const GAS bf16*)a.out + ((((size_t)(b * 4 + h) * 16 + n) * 2 + 0) * 256) * 128; };
    auto issue_k = [&](int item) { size_t tok0; const GAS bf16* sf; int h; item_ptrs(item, tok0, sf, h);
        const GAS bf16* ks_ = kr + (tok0 + (tid >> 4)) * 512 + h * 128 + (tid & 15) * 8;
#pragma unroll
        for (int j = 0; j < 4; ++j) kreg[j] = *(const GAS v4u*)(ks_ + (size_t)j * 32 * 512); };
    auto issue_q = [&](int item) { size_t tok0; const GAS bf16* sf; int h; item_ptrs(item, tok0, sf, h);
#pragma unroll
        for (int s = 0; s < 4; ++s) qn[s] = *(const GAS bf16x8*)(qr + (tok0 + 16 * wid + i16) * 512 + h * 128 + 32 * s + 8 * g); };
    auto issue_state = [&](const GAS bf16* sf, int dirn) { const GAS bf16* sld = sf + (size_t)dirn * 256 * 128 + (size_t)(tid >> 4) * 128 + (tid & 15) * 8;
#pragma unroll
        for (int j = 0; j < 8; ++j) sreg[j] = *(const GAS v4u*)(sld + (size_t)j * 32 * 128); };
    auto write_state = [&]() {
#pragma unroll
        for (int j = 0; j < 8; ++j) *(LAS v4u*)(Sg + (j >> 2) * 32768 + kdst + (j & 3) * 8192) = sreg[j]; };
    { size_t tok0; const GAS bf16* sf; int h; item_ptrs(vcu, tok0, sf, h); issue_k(vcu); issue_q(vcu); issue_state(sf, 0); }
#pragma unroll
    for (int j = 0; j < 4; ++j) *(LAS v4u*)(Kt + kdst + j * 8192) = kreg[j];
    for (int item = vcu; item < 1024; item += G) {
        size_t tok0; const GAS bf16* sf; int h; item_ptrs(item, tok0, sf, h);
        const float lf2 = log2_gamma(a.in[2], h), lb2 = log2_gamma(a.in[3], h);
        bf16x8 qf[4];
#pragma unroll
        for (int s = 0; s < 4; ++s) qf[s] = qn[s];
        const bool has_next = item + G < 1024;
        __syncthreads();
        f32x4 D[8];
#pragma unroll
        for (int jt = 0; jt < 8; ++jt) {
            f32x4 d = (f32x4){0.f, 0.f, 0.f, 0.f};
#pragma unroll
            for (int s = 0; s < 4; ++s) { if (VAR != 1) { const bf16x8 kf = *(const LAS bf16x8*)(Kt + rfo[s] + jt * 4096); d = MFMA16(kf, qf[s], d); } else d[s] = __builtin_bit_cast(float, (int)qf[s][0]); }
            D[jt] = d;
        }
        int iq = 16 * wid + i16; OPAQUE(iq);
        bf16x8 pf[4];
#pragma unroll
        for (int ks = 0; ks < 4; ++ks) {
            float e[8];
#pragma unroll
            for (int t = 0; t < 2; ++t)
#pragma unroll
                for (int r = 0; r < 4; ++r) {
                    const int j = 16 * (2 * ks + t) + 4 * g + r; const float fdf = (float)(iq - j), ad = fabsf(fdf);
                    const float pos = fminf(fmaxf(fdf, 0.f), 1.f), isz = 1.f - fminf(ad, 1.f);
                    const float w = __builtin_amdgcn_exp2f((lb2 + (lf2 - lb2) * pos) * ad) + isz;
                    e[4 * t + r] = D[2 * ks + t][r] * w;
                }
            v4u pw; pw.x = cvtpk(e[0], e[1]); pw.y = cvtpk(e[2], e[3]); pw.z = cvtpk(e[4], e[5]); pw.w = cvtpk(e[6], e[7]);
            pf[ks] = __builtin_bit_cast(bf16x8, pw);
        }
        f32x4 acc[16];
#pragma unroll
        for (int vt = 0; vt < 16; ++vt) acc[vt] = (f32x4){0.f, 0.f, 0.f, 0.f};
#pragma unroll
        for (int dirn = 0; dirn < 2; ++dirn) {
            if (dirn == 1) __syncthreads();
            write_state();
            if (dirn == 0) { issue_state(sf, 1); if (has_next) issue_k(item + G); }
            else {
                if (has_next) {
#pragma unroll
                    for (int j = 0; j < 4; ++j) *(LAS v4u*)(Kt + kdst + j * 8192) = kreg[j]; }
                const GAS bf16* vs_ = vr + (tok0 + (tid >> 5)) * 1024 + h * 256 + (tid & 31) * 8;
#pragma unroll
                for (int j = 0; j < 8; ++j) sreg[j] = *(const GAS v4u*)(vs_ + (size_t)j * 16 * 1024);
            }
            __syncthreads();
#pragma unroll
            for (int vt = 0; vt < 16; ++vt) {
#pragma unroll
                for (int s = 0; s < 4; ++s) { if (VAR != 1) { const bf16x8 sfr = *(const LAS bf16x8*)(Sg + (vt >> 3) * 32768 + rfo[s] + (vt & 7) * 4096); acc[vt] = MFMA16(qf[s], sfr, acc[vt]); } }
            }
            float xs[4];
            { int ib = 16 * wid + 4 * g; OPAQUE(ib);
#pragma unroll
              for (int r = 0; r < 4; ++r) { const float lxf = lf2 * (float)(ib + r + 1), lxb = lb2 * (float)(128 - ib - r); xs[r] = __builtin_amdgcn_exp2f(dirn == 0 ? lxf - lxb : lxb); } }
#pragma unroll
            for (int vt = 0; vt < 16; ++vt)
#pragma unroll
                for (int r = 0; r < 4; ++r) acc[vt][r] *= xs[r];
        }
        __syncthreads();
        { int t2 = tid; OPAQUE(t2); const unsigned vd2 = (unsigned)((t2 & 31) >> 4) * 32768u + offb(t2 >> 5, t2 & 15);
#pragma unroll
          for (int j = 0; j < 8; ++j) *(LAS v4u*)(Sg + vd2 + j * 4096) = sreg[j]; }
        GAS bf16* gp = gr + (tok0 + 16 * wid + (lane >> 5)) * 1024 + h * 256 + (lane & 31) * 8;
#if MIX_FP8 & 4
        GAS unsigned char* ar8 = (GAS unsigned char*)(ws + WS_AR8) + (tok0 + 16 * wid + (lane >> 5)) * 1024 + h * 256 + (lane & 31) * 8;
#endif
        __syncthreads();
        unsigned vbs[8];
        { int l2 = lane; OPAQUE(l2); const unsigned g2 = l2 >> 4, q2 = (l2 & 15) >> 2, p2 = l2 & 3, X = (q2 << 2) | g2;
#pragma unroll
          for (int c = 0; c < 8; ++c) vbs[c] = 256 * (4 * g2 + q2) + 16 * (((2 * c) ^ (X & 14)) | ((p2 >> 1) ^ (X & 1))) + 8 * (p2 & 1); }
#pragma unroll
        for (int vt = 0; vt < 16; ++vt) {
#pragma unroll
            for (int ks = 0; ks < 4; ++ks) { if (VAR != 1) {
                const s16x4 lo = ldtr(Sg + vbs[vt & 7] + (vt >> 3) * 32768 + ks * 8192), hi = ldtr(Sg + vbs[vt & 7] + (vt >> 3) * 32768 + ks * 8192 + 4096);
                acc[vt] = MFMA16(pf[ks], cat8(lo, hi), acc[vt]); }
            }
            asm volatile("" ::: "memory");
        }
        float mu[4], rs[4];
#pragma unroll
        for (int r = 0; r < 4; ++r) {
            float s = 0.f;
#pragma unroll
            for (int vt = 0; vt < 16; ++vt) s += acc[vt][r];
            s += __shfl_xor(s, 1); s += __shfl_xor(s, 2); s += __shfl_xor(s, 4); s += __shfl_xor(s, 8);
            const float m = s * (1.f / 256.f); float qv = 0.f;
#pragma unroll
            for (int vt = 0; vt < 16; ++vt) { const float d = acc[vt][r] - m; qv += d * d; }
            qv += __shfl_xor(qv, 1); qv += __shfl_xor(qv, 2); qv += __shfl_xor(qv, 4); qv += __shfl_xor(qv, 8);
            mu[r] = m; rs[r] = 1.f / sqrtf(qv * (1.f / 256.f) + LN_EPSF);
        }
        v4u greg[8];
#pragma unroll
        for (int j = 0; j < 8; ++j) greg[j] = *(const GAS v4u*)(gp + (size_t)j * 2048);
        __syncthreads();
        if (has_next) { size_t tk; const GAS bf16* sfn; int hn; item_ptrs(item + G, tk, sfn, hn); issue_state(sfn, 0); issue_q(item + G); }
        LAS bf16* st = (LAS bf16*)(Sg + wid * 8192);
        { LAS bf16* sp_ = st + (4 * g) * 256 + i16;
#pragma unroll
          for (int vt = 0; vt < 16; ++vt)
#pragma unroll
              for (int r = 0; r < 4; ++r) sp_[r * 256 + 16 * vt] = (bf16)(cvtpk((acc[vt][r] - mu[r]) * rs[r], 0.f) & 0xffffu); }
        asm volatile("s_waitcnt lgkmcnt(0)" ::: "memory");
        {
            const float* gn = a.in[4] + h * 256; const int ch = lane & 31;
            const f32x4 g0 = *(const f32x4*)(gn + ch * 8), g1 = *(const f32x4*)(gn + ch * 8 + 4);
            const LAS bf16* yp = st + (lane >> 5) * 256 + ch * 8;
#pragma unroll
            for (int j = 0; j < 8; ++j) {
                const v4u y = *(const LAS v4u*)(yp + j * 512); const v4u sg = greg[j];
#if SILU_IN_P3
#define GSW(w, hi) pg8::fsilu((hi) ? bfhi(w) : bflo(w))
#else
#define GSW(w, hi) ((hi) ? bfhi(w) : bflo(w))
#endif
                v4u o; o.x = cvtpk(bflo(y.x) * g0[0] * GSW(sg.x, 0), bfhi(y.x) * g0[1] * GSW(sg.x, 1)); o.y = cvtpk(bflo(y.y) * g0[2] * GSW(sg.y, 0), bfhi(y.y) * g0[3] * GSW(sg.y, 1));
                o.z = cvtpk(bflo(y.z) * g1[0] * GSW(sg.z, 0), bfhi(y.z) * g1[1] * GSW(sg.z, 1)); o.w = cvtpk(bflo(y.w) * g1[2] * GSW(sg.w, 0), bfhi(y.w) * g1[3] * GSW(sg.w, 1));
#undef GSW
#if MIX_FP8 & 4
                u32x2 o8; o8.x = pk_fp8x4(bflo(o.x), bfhi(o.x), bflo(o.y), bfhi(o.y)); o8.y = pk_fp8x4(bflo(o.z), bfhi(o.z), bflo(o.w), bfhi(o.w));
                *(GAS u32x2*)(ar8 + (size_t)j * 2048) = o8;
#else
                *(GAS v4u*)(gp + (size_t)j * 2048) = o;
#endif
            }
        }
        __syncthreads();
    }
}

constexpr int P6_RS = 81920, P6_CNT = P6_RS + 8 * 512, P6_BASE = P6_CNT + 64, P6_ROW = P6_BASE + 64;
#define P6_BUTTERFLY(lg, out) do { float r10[10], r5[5], r3[3], r2[2]; const float z = 0.f; \
    _Pragma("unroll") for (int k = 0; k < 10; ++k) { const float keep = h32 ? lg[10 + k] : lg[k], send = h32 ? lg[k] : lg[10 + k]; r10[k] = keep + __shfl_xor(send, 32); } \
    _Pragma("unroll") for (int k = 0; k < 5; ++k) { const float keep = h16 ? r10[5 + k] : r10[k], send = h16 ? r10[k] : r10[5 + k]; r5[k] = keep + __shfl_xor(send, 16); } \
    { const float keep = h8 ? r5[3] : r5[0], send = h8 ? r5[0] : r5[3]; r3[0] = keep + __shfl_xor(send, 8); } \
    { const float keep = h8 ? r5[4] : r5[1], send = h8 ? r5[1] : r5[4]; r3[1] = keep + __shfl_xor(send, 8); } \
    { const float keep = h8 ? z : r5[2], send = h8 ? r5[2] : z; r3[2] = keep + __shfl_xor(send, 8); } \
    { const float keep = h4 ? r3[2] : r3[0], send = h4 ? r3[0] : r3[2]; r2[0] = keep + __shfl_xor(send, 4); } \
    { const float keep = h4 ? z : r3[1], send = h4 ? r3[1] : z; r2[1] = keep + __shfl_xor(send, 4); } \
    { const float keep = h2 ? r2[1] : r2[0], send = h2 ? r2[0] : r2[1]; out = keep + __shfl_xor(send, 2); } \
    out += __shfl_xor(out, 1); } while (0)
__device__ __forceinline__ void p6a_phase(const Args& a, LAS unsigned char* lds, int vcu, int G, int tid, int wave, int lane) {
    unsigned char* ws = a.ws;
    LAS float* RW = (LAS float*)lds;
    LAS float* RS = (LAS float*)(lds + P6_RS) + wave * 128;
    LAS unsigned* LC = (LAS unsigned*)(lds + P6_CNT); LAS unsigned* LB = (LAS unsigned*)(lds + P6_BASE); LAS unsigned* LR = (LAS unsigned*)(lds + P6_ROW);
    {
        const f32x4* wgp = (const f32x4*)a.in[11]; const f32x4* wep = (const f32x4*)a.in[13];
        f32x4 gq[2], eq[8];
#pragma unroll
        for (int u = 0; u < 2; ++u) gq[u] = wgp[tid + 512 * u];
#pragma unroll
        for (int u = 0; u < 8; ++u) eq[u] = wep[tid + 512 * u];
#pragma unroll
        for (int u = 0; u < 2; ++u) { const int c = tid + 512 * u;
#pragma unroll
            for (int k = 0; k < 4; ++k) RW[k * 1024 + c] = gq[u][k]; }
#pragma unroll
        for (int u = 0; u < 8; ++u) { const int q = tid + 512 * u, c = q >> 2, k4 = q & 3;
#pragma unroll
            for (int k = 0; k < 4; ++k) RW[(4 + 4 * k4 + k) * 1024 + c] = eq[u][k]; }
    }
    const u32x2* pre = (const u32x2*)a.out; u32x2* x1b = (u32x2*)(ws + WS_XB); [[maybe_unused]] unsigned* x1f8 = (unsigned*)(ws + WS_X1F8);
    gu32* ctl = (gu32*)ws;
    int* ltok = (int*)(ws + WS_LTOK); float* tw = (float*)(ws + WS_WSLOT); unsigned* tinfo = (unsigned*)(ws + WS_TINFO);
    const float* g1 = a.in[9]; const float* b1 = a.in[10];
    const bool h32 = (lane & 32) != 0, h16 = (lane & 16) != 0, h8 = (lane & 8) != 0, h4 = (lane & 4) != 0, h2 = (lane & 2) != 0;
#define P6_LOADROW(dst, t_) do { const u32x2* xr_ = pre + (size_t)(t_) * 256 + lane; _Pragma("unroll") for (int j = 0; j < 4; ++j) dst[j] = xr_[64 * j]; } while (0)
#define P6_LN(v, nx, s) do { s = 0.f; _Pragma("unroll") for (int j = 0; j < 4; ++j) { v[j] = (f32x4){bflo(nx[j].x), bfhi(nx[j].x), bflo(nx[j].y), bfhi(nx[j].y)}; s += (v[j].x + v[j].y) + (v[j].z + v[j].w); } } while (0)
#define P6_VAR(v, mean, q) do { q = 0.f; _Pragma("unroll") for (int j = 0; j < 4; ++j) { v[j] = v[j] - mean; q += (v[j].x * v[j].x + v[j].y * v[j].y) + (v[j].z * v[j].z + v[j].w * v[j].w); } } while (0)
#if M1_FP8
#define P6_STORE(v, t_, j) do { u32x2 o_; o_.x = cvtpk(v[j].x, v[j].y); o_.y = cvtpk(v[j].z, v[j].w); x1b[(size_t)(t_) * 256 + lane + 64 * j] = o_; x1f8[(size_t)(t_) * 256 + lane + 64 * j] = pk_fp8x4(v[j].x, v[j].y, v[j].z, v[j].w); } while (0)
#else
#define P6_STORE(v, t_, j) do { u32x2 o_; o_.x = cvtpk(v[j].x, v[j].y); o_.y = cvtpk(v[j].z, v[j].w); x1b[(size_t)(t_) * 256 + lane + 64 * j] = o_; } while (0)
#endif
#define P6_DOT(lg, v, j, k, w) lg[k] += (v[j][0] * w[0] + v[j][1] * w[1]) + (v[j][2] * w[2] + v[j][3] * w[3])
    for (int blk = vcu; blk < TT / 128; blk += G) {
        if (tid < 16) LC[tid] = 0u;
        __syncthreads();
        const int t0 = blk * 128;
        u32x2 nxA[4], nxB[4], nxC[4], nxD[4];
        P6_LOADROW(nxA, t0 + wave); P6_LOADROW(nxB, t0 + wave + 8); P6_LOADROW(nxC, t0 + wave + 16); P6_LOADROW(nxD, t0 + wave + 24);
        for (int rr = 0; rr < 4; ++rr) {
            const int rl0 = wave + 32 * rr, tA = t0 + rl0, tB = tA + 8, tC = tA + 16, tD = tA + 24;
            f32x4 vA[4], vB[4], vC[4], vD[4]; float sA, sB, sC, sD;
            P6_LN(vA, nxA, sA); P6_LN(vB, nxB, sB); P6_LN(vC, nxC, sC); P6_LN(vD, nxD, sD);
            if (rr < 3) { P6_LOADROW(nxA, tA + 32); P6_LOADROW(nxB, tB + 32); P6_LOADROW(nxC, tC + 32); P6_LOADROW(nxD, tD + 32); }
            const float mA = wave_sum(sA) * (1.f / DM), mB = wave_sum(sB) * (1.f / DM), mC = wave_sum(sC) * (1.f / DM), mD = wave_sum(sD) * (1.f / DM);
            float qA, qB, qC, qD;
            P6_VAR(vA, mA, qA); P6_VAR(vB, mB, qB); P6_VAR(vC, mC, qC); P6_VAR(vD, mD, qD);
            const float rA = 1.f / sqrtf(wave_sum(qA) * (1.f / DM) + LN_EPSF), rB = 1.f / sqrtf(wave_sum(qB) * (1.f / DM) + LN_EPSF);
            const float rC = 1.f / sqrtf(wave_sum(qC) * (1.f / DM) + LN_EPSF), rD = 1.f / sqrtf(wave_sum(qD) * (1.f / DM) + LN_EPSF);
            float lgA[20], lgB[20], lgC[20], lgD[20];
#pragma unroll
            for (int k = 0; k < 20; ++k) { lgA[k] = 0.f; lgB[k] = 0.f; lgC[k] = 0.f; lgD[k] = 0.f; }
#pragma unroll
            for (int j = 0; j < 4; ++j) {
                const f32x4 gg = *(const f32x4*)(g1 + 4 * lane + 256 * j), bb = *(const f32x4*)(b1 + 4 * lane + 256 * j);
                vA[j] = vA[j] * rA * gg + bb; vB[j] = vB[j] * rB * gg + bb; vC[j] = vC[j] * rC * gg + bb; vD[j] = vD[j] * rD * gg + bb;
                P6_STORE(vA, tA, j); P6_STORE(vB, tB, j); P6_STORE(vC, tC, j); P6_STORE(vD, tD, j);
#pragma unroll
                for (int k = 0; k < 20; ++k) { const f32x4 w = *(const LAS f32x4*)(RW + k * 1024 + 4 * lane + 256 * j);
                    P6_DOT(lgA, vA, j, k, w); P6_DOT(lgB, vB, j, k, w); P6_DOT(lgC, vC, j, k, w); P6_DOT(lgD, vD, j, k, w); }
            }
            float r1A, r1B, r1C, r1D;
            P6_BUTTERFLY(lgA, r1A); P6_BUTTERFLY(lgB, r1B); P6_BUTTERFLY(lgC, r1C); P6_BUTTERFLY(lgD, r1D);
            {
                const int i3 = h2 ? (h4 ? -1 : 1) : (h4 ? 2 : 0);
                const int i5 = i3 < 0 ? -1 : (h8 ? (i3 == 2 ? -1 : i3 + 3) : i3);
                const int kk = i5 < 0 ? -1 : (h32 ? 10 : 0) + (h16 ? 5 : 0) + i5;
                if (kk >= 0 && (lane & 1) == 0) { RS[kk] = r1A; RS[32 + kk] = r1B; RS[64 + kk] = r1C; RS[96 + kk] = r1D; }
            }
            asm volatile("s_waitcnt lgkmcnt(0)" ::: "memory");
            {
                const int sel = lane & 3; const int rl = rl0 + 8 * sel;
                float tl[20];
#pragma unroll
                for (int k4 = 0; k4 < 5; ++k4) { const f32x4 w = *(const LAS f32x4*)(RS + sel * 32 + 4 * k4); tl[4 * k4] = w[0]; tl[4 * k4 + 1] = w[1]; tl[4 * k4 + 2] = w[2]; tl[4 * k4 + 3] = w[3]; }
                float gl[4];
#pragma unroll
                for (int k = 0; k < 4; ++k) gl[k] = tl[k] + a.in[12][k];
                int gi = 0; float gm = gl[0];
#pragma unroll
                for (int k = 1; k < 4; ++k) if (gl[k] > gm) { gm = gl[k]; gi = k; }
                float gs = 0.f;
#pragma unroll
                for (int k = 0; k < 4; ++k) gs += __expf(gl[k] - gm);
                const float gwt = 1.f / gs;
                float el[4];
#pragma unroll
                for (int k = 0; k < 4; ++k) { const float se = gi == 0 ? tl[4 + k] : (gi == 1 ? tl[8 + k] : (gi == 2 ? tl[12 + k] : tl[16 + k])); el[k] = se + a.in[14][4 * gi + k]; }
                int i1 = 0; float v1 = el[0];
#pragma unroll
                for (int k = 1; k < 4; ++k) if (el[k] > v1) { v1 = el[k]; i1 = k; }
                int i2 = (i1 + 1) & 3; float v2 = -3.0e38f;
#pragma unroll
                for (int k = 0; k < 4; ++k) if (k != i1 && el[k] > v2) { v2 = el[k]; i2 = k; }
                const float ex = __expf(v2 - v1), w1 = gwt / (1.f + ex), w2 = gwt * ex / (1.f + ex);
                if (lane < 4) {
                    const int e1 = 4 * gi + i1, e2 = 4 * gi + i2;
                    const unsigned p1 = __hip_atomic_fetch_add(LC + e1, 1u, __ATOMIC_RELAXED, __HIP_MEMORY_SCOPE_WORKGROUP);
                    const unsigned p2 = __hip_atomic_fetch_add(LC + e2, 1u, __ATOMIC_RELAXED, __HIP_MEMORY_SCOPE_WORKGROUP);
                    LR[rl * 4 + 0] = ((unsigned)e1 << 16) | p1; LR[rl * 4 + 1] = ((unsigned)e2 << 16) | p2; LR[rl * 4 + 2] = __float_as_uint(w1); LR[rl * 4 + 3] = __float_as_uint(w2);
                }
            }
            asm volatile("s_waitcnt lgkmcnt(0)" ::: "memory");
        }
        __syncthreads();
        if (tid < 16) LB[tid] = __hip_atomic_fetch_add(ctl + CW_CNT + 64 * tid, LC[tid], __ATOMIC_RELAXED, __HIP_MEMORY_SCOPE_AGENT);
        __syncthreads();
        if (tid < 256) {
            const int rl = tid >> 1, j = tid & 1; const unsigned rec = LR[rl * 4 + j]; const unsigned e = rec >> 16, pos = LB[e] + (rec & 0xffffu);
            ltok[e * TT + pos] = t0 + rl; tw[2 * (t0 + rl) + j] = __uint_as_float(LR[rl * 4 + 2 + j]); tinfo[2 * (t0 + rl) + j] = (e << 16) | pos;
        }
        __syncthreads();
    }
#undef P6_LOADROW
#undef P6_LN
#undef P6_VAR
#undef P6_STORE
#undef P6_DOT
}
__device__ __forceinline__ void build_tile_tables(const Args& a, LAS unsigned char* lds, int tid) {
    LAS int* ts = (LAS int*)(lds + LDS_TS_OFF); LAS int* te = (LAS int*)(lds + LDS_TE_OFF); LAS int* cn = (LAS int*)(lds + LDS_CNT_OFF);
    gu32* ctl = (gu32*)a.ws;
    if (tid == 0) { int acc = 0;
        for (int e = 0; e < 16; ++e) { ts[e] = acc; const int c = (int)__hip_atomic_load(ctl + CW_CNT + 64 * e, __ATOMIC_RELAXED, __HIP_MEMORY_SCOPE_AGENT); const int nt = (c + 255) >> 8; cn[e] = c;
            for (int k = 0; k < nt; ++k) te[acc + k] = e; acc += nt; }
        ts[16] = acc; }
    __syncthreads();
}
__device__ __forceinline__ void p9_phase(const Args& a, LAS unsigned char* lds, int vcu, int G, int wave, int lane) {
    unsigned char* ws = a.ws;
    const LAS int* ts = (const LAS int*)(lds + LDS_TS_OFF);
    const unsigned* tinfo = (const unsigned*)(ws + WS_TINFO); const u32x2* Y = (const u32x2*)(ws + WS_Y);
    const float* g2 = a.in[18]; const float* b2 = a.in[19];
    const int gw = vcu * NWAVES + wave, NGW = G * NWAVES;
#if Y_FP8
    const unsigned* Y8 = (const unsigned*)(ws + WS_Y); unsigned ny0[4], ny1[4]; u32x2 nxw[4]; float nw0 = 0.f, nw1 = 0.f;
#else
    u32x2 ny0[4], ny1[4], nxw[4]; float nw0 = 0.f, nw1 = 0.f;
#endif
    const float* tw = (const float*)(ws + WS_WSLOT);
    auto issue = [&](int t) {
        const unsigned i0 = tinfo[2 * t], i1 = tinfo[2 * t + 1];
        nw0 = tw[2 * t]; nw1 = tw[2 * t + 1];
        const size_t s0 = (size_t)ts[i0 >> 16] * 256 + (i0 & 0xffffu), s1 = (size_t)ts[i1 >> 16] * 256 + (i1 & 0xffffu);
        const u32x2* xb1 = (const u32x2*)(ws + WS_XB) + (size_t)t * 256 + lane;
#pragma unroll
#if Y_FP8
        for (int j = 0; j < 4; ++j) { ny0[j] = Y8[s0 * 256 + lane + 64 * j]; ny1[j] = Y8[s1 * 256 + lane + 64 * j]; nxw[j] = xb1[64 * j]; }
#else
        for (int j = 0; j < 4; ++j) { ny0[j] = Y[s0 * 256 + lane + 64 * j]; ny1[j] = Y[s1 * 256 + lane + 64 * j]; nxw[j] = xb1[64 * j]; }
#endif
    };
    if (gw < TT) issue(gw);
    for (int t = gw; t < TT; t += NGW) {
        f32x4* xr = (f32x4*)(a.out + (size_t)t * DM) + lane;
#if Y_FP8
        f32x4 v[4]; float s = 0.f; const float w0 = nw0 * 0.0625f, w1 = nw1 * 0.0625f;
#pragma unroll
        for (int j = 0; j < 4; ++j) {
            const unsigned y0 = ny0[j], y1 = ny1[j]; const u32x2 xw = nxw[j];
            typedef float f32x2_ __attribute__((ext_vector_type(2)));
            const f32x2_ a0 = __builtin_amdgcn_cvt_pk_f32_fp8(y0, false), a1 = __builtin_amdgcn_cvt_pk_f32_fp8(y0, true), c0 = __builtin_amdgcn_cvt_pk_f32_fp8(y1, false), c1 = __builtin_amdgcn_cvt_pk_f32_fp8(y1, true);
            f32x4 x = (f32x4){bflo(xw.x), bfhi(xw.x), bflo(xw.y), bfhi(xw.y)} * DN_ALPHA;
            x.x += w0 * a0[0] + w1 * c0[0]; x.y += w0 * a0[1] + w1 * c0[1]; x.z += w0 * a1[0] + w1 * c1[0]; x.w += w0 * a1[1] + w1 * c1[1];
            v[j] = x; s += (x.x + x.y) + (x.z + x.w);
        }
#else
        f32x4 v[4]; float s = 0.f; const float w0 = nw0, w1 = nw1;
#pragma unroll
        for (int j = 0; j < 4; ++j) {
            const u32x2 y0 = ny0[j], y1 = ny1[j], xw = nxw[j];
            f32x4 x = (f32x4){bflo(xw.x), bfhi(xw.x), bflo(xw.y), bfhi(xw.y)} * DN_ALPHA;
            x.x += w0 * bflo(y0.x) + w1 * bflo(y1.x); x.y += w0 * bfhi(y0.x) + w1 * bfhi(y1.x); x.z += w0 * bflo(y0.y) + w1 * bflo(y1.y); x.w += w0 * bfhi(y0.y) + w1 * bfhi(y1.y);
            v[j] = x; s += (x.x + x.y) + (x.z + x.w);
        }
#endif
        if (t + NGW < TT) issue(t + NGW);
        const float mean = wave_sum(s) * (1.f / DM); float s2 = 0.f;
#pragma unroll
        for (int j = 0; j < 4; ++j) { v[j] = v[j] - mean; s2 += (v[j].x * v[j].x + v[j].y * v[j].y) + (v[j].z * v[j].z + v[j].w * v[j].w); }
        const float rstd = 1.f / sqrtf(wave_sum(s2) * (1.f / DM) + LN_EPSF);
#pragma unroll
        for (int j = 0; j < 4; ++j) { const f32x4 gg = *(const f32x4*)(g2 + 4 * lane + 256 * j), bb = *(const f32x4*)(b2 + 4 * lane + 256 * j); xr[64 * j] = v[j] * rstd * gg + bb; }
    }
}

__global__ void __launch_bounds__(NWAVES * 64, 2) mega_fwd(Args args) {
    extern __shared__ __attribute__((aligned(16))) unsigned char lds_raw[];
    LAS unsigned char* lds = (LAS unsigned char*)lds_raw;
    volatile LAS unsigned* MISC = (volatile LAS unsigned*)(lds + MISC_OFF);
    const int tid0 = threadIdx.x, wave = __builtin_amdgcn_readfirstlane(tid0 >> 6);
    const int G = gridDim.x, bx = blockIdx.x, vcu = (G % 8 == 0) ? (bx % 8) * (G / 8) + bx / 8 : bx;
    for (int u = tid0; u < (LDS_BYTES - LDSCTL_OFF) / 4; u += NWAVES * 64) ((LAS unsigned*)(lds + LDSCTL_OFF))[u] = 0u;
    __syncthreads();
    unsigned char* ws = args.ws;
    gu32* ctl = (gu32*)ws;
    const bool bars_on = (args.mask >> 31) != 0u;
    XcdBarrier bar; bar.bar = (unsigned*)(ctl + CW_BAR) + args.bar_region * XCD_BAR_WORDS; bar.x = 0; bar.st = nullptr;
    if (bars_on) bar = xcd_barrier_post((unsigned*)(ctl + CW_BAR) + args.bar_region * XCD_BAR_WORDS, MISC + 8);
    bar.wv = wave;
#define GRID_BAR() do { if (bars_on) xcd_barrier(bar); } while (0)
#ifndef PH_LAST
#define PH_LAST 99
#endif
#define FRESH() int tid = wave * 64 + pg8::lane_id(); asm volatile("" : "+v"(tid)); const int lane = tid & 63; (void)lane
#ifndef RMASK
#define RMASK 0
#endif
#define REP(k) _Pragma("unroll") for (int rep_ = 0; rep_ < 1 + ((RMASK >> (k)) & 1); ++rep_)
#ifndef STAMP_SCALE
#define STAMP_SCALE 1.0f
#endif
#ifdef STAMP_PH
#define ST_B(k) if ((k) == STAMP_PH) { st_a = rt(); }
#define ST_E(k) if ((k) == STAMP_PH) { st_b = rt(); }
#else
#define ST_B(k)
#define ST_E(k)
#endif
#ifdef ONLY
#define EN(k) (ONLY == (k))
#else
#define EN(k) ((args.mask >> (k)) & 1u)
#endif
    unsigned long long st_a = 0, st_b = 0; (void)st_a; (void)st_b;
    REP(0) if (EN(0)) { FRESH(); p0_prologue(args, lds, vcu, G, tid, wave, lane); }
    GRID_BAR();
#ifdef STAGGER_TICKS
    if (EN(1) && (bx & 8)) { const unsigned long long t0_ = rt(); while (rt() - t0_ < STAGGER_TICKS) __builtin_amdgcn_s_sleep(32); }
#endif
    REP(1) if (EN(1)) {
#if P1_FP8
        pg8::EpiHcat E{ws, (const float*)(ws + WS_ROT), 0};
        if (P1_FP8_FROM > 0) {
            pg8::Gemm g{(const pg8::bf16_t*)(ws + WS_XB), (const pg8::bf16_t*)(ws + WS_WIN), TT, 4608, 1024}; pg8::StaticOrder S; S.init(TT, 256 * P1_FP8_FROM, G, bx);
            pg8::gemm_phase<pg8::EpiHcat, pg8::StaticOrder, true, true>(lds, g, S, E, wave);
        }
        {
#if GATE_FP8
            pg8::Gemm g{(const pg8::bf16_t*)(ws + WS_X8_LO), (const pg8::bf16_t*)(ws + WS_WIN8), TT, 4608, 512, 64, (long)WS_X8_HI - (long)WS_X8_LO - (long)(16 * MiB)}; pg8::StaticOrder S;
#else
            pg8::Gemm g{(const pg8::bf16_t*)args.out, (const pg8::bf16_t*)(ws + WS_WIN8), TT, 4608, 512}; pg8::StaticOrder S;
#endif
            S.init(TT, 4608 - 256 * P1_FP8_FROM, G, bx, P1_FP8_FROM);
#if CONV_BG
            pg8::P1Order SB; SB.S = S; SB.cv = pg8::ExpertConv{args.in[15], args.in[16], args.in[17], ws + WS_WGU, ws + WS_WD, vcu * NWAVES + wave, G * NWAVES, vcu % 9};
            pg8::gemm_phase<pg8::EpiHcat, pg8::P1Order, true, true, false, true, 1, 0>(lds, g, SB, E, wave);
            { FRESH();
              for (int k = 0; SB.cv.gw + k * SB.cv.nw < 6144; ++k) { pg8::Unit tu; const bool in_gap = k < 3 && S.next(pg8::P1Order::unit_of(SB.cv.grp, k), tu) && pg8::P1Order::unit_of(SB.cv.grp, k) < 9;
                  if (!in_gap) pg8::expert_conv_item(SB.cv, k, lane); } }
#else
            pg8::gemm_phase<pg8::EpiHcat, pg8::StaticOrder, true, true, false, true, 1, 0>(lds, g, S, E, wave);
#endif
        }
#else
        pg8::Gemm g{(const pg8::bf16_t*)(ws + WS_XB), (const pg8::bf16_t*)(ws + WS_WIN), TT, 4608, 1024}; pg8::StaticOrder S; S.init(TT, 4608, G, bx);
        pg8::EpiHcat E{ws, (const float*)(ws + WS_ROT), 0};
        pg8::gemm_phase<pg8::EpiHcat, pg8::StaticOrder, true, true>(lds, g, S, E, wave);
#endif
    }
    GRID_BAR();
    if (PH_LAST >= 2) {
        REP(2) if (EN(2)) { FRESH(); for (int it = vcu; it < 256; it += G) chain_item(args, lds, it, tid, wave, lane); }
        if (EN(3)) { { FRESH(); attn_dil_phase<16>(args, lds, vcu, G, tid, wave, lane); }
                     { FRESH(); attn_dil_phase<4>(args, lds, vcu, G, tid, wave, lane); } }
    }
    GRID_BAR();
    ST_B(4) if (PH_LAST >= 3 && EN(4)) { FRESH(); p3_phase<0>(args, lds, vcu, G, tid, wave, lane); }
    if (EN(13)) { FRESH(); attn_p1_phase(args, lds, vcu, G, tid, wave, lane); }
    GRID_BAR(); ST_E(4)
#if !CONV_BG
    if (EN(14)) { FRESH(); p0_expert_weights(args, lds, vcu, G, wave, lane); }
#endif
    REP(5) if (PH_LAST >= 4 && EN(5)) {
        pg8::GateOrder S; S.S4.init(TT, 1024, G, bx);
        pg8::EpiHcat E{ws, (const float*)(ws + WS_ROT), 18};
#if GATE_FP8
        pg8::Gemm g{(const pg8::bf16_t*)(ws + WS_X8_LO), (const pg8::bf16_t*)(ws + WS_WIN8 + (size_t)4608 * 1024), TT, 2048, 512, 64, (long)WS_X8_HI - (long)WS_X8_LO - (long)(16 * MiB)};
        pg8::gemm_phase<pg8::EpiHcat, pg8::GateOrder, true, true, false, true, 1, 0>(lds, g, S, E, wave);
#else
        pg8::Gemm g{(const pg8::bf16_t*)(ws + WS_XB), (const pg8::bf16_t*)(ws + WS_WIN) + (size_t)4608 * 1024, TT, 2048, 1024};
        pg8::gemm_phase<pg8::EpiHcat, pg8::GateOrder, true, true>(lds, g, S, E, wave);
#endif
        asm volatile("s_waitcnt vmcnt(0)" ::: "memory"); __syncthreads();
    }
    REP(6) if (PH_LAST >= 5 && EN(6)) {
        pg8::StaticOrder S; S.init(TT, 1024, G, bx);
        { pg8::EpiGate<false> E{(const pg8::bf16_t*)(ws + WS_GATE_A), (pg8::bf16_t*)(ws + WS_MERGED), nullptr};
#if MIX_FP8 & 2
          pg8::Gemm g{(const pg8::bf16_t*)(ws + WS_OA), (const pg8::bf16_t*)(ws + WS_WA), TT, 1024, 256};
          pg8::gemm_phase<pg8::EpiGate<false>, pg8::StaticOrder, true, true, false, true, 1, 3>(lds, g, S, E, wave);
#else
          pg8::Gemm g{(const pg8::bf16_t*)(ws + WS_OA), (const pg8::bf16_t*)(ws + WS_WA), TT, 1024, 512};
          pg8::gemm_phase<pg8::EpiGate<false>, pg8::StaticOrder, true, true>(lds, g, S, E, wave);
#endif
        }
        asm volatile("s_waitcnt vmcnt(0)" ::: "memory"); __syncthreads();
        { typedef pg8::EpiGate<true, (MIX_FP8 & 1) != 0> EpiC;
          EpiC E{(const pg8::bf16_t*)(ws + WS_GATE_R), (pg8::bf16_t*)(ws + WS_MERGED), ws + WS_MERGED8};
#if MIX_FP8 & 4
          pg8::Gemm g{(const pg8::bf16_t*)(ws + WS_AR8), (const pg8::bf16_t*)(ws + WS_WR), TT, 1024, 512};
          pg8::gemm_phase<EpiC, pg8::StaticOrder, true, true, false, true, 1, 0>(lds, g, S, E, wave);
#else
          pg8::Gemm g{(const pg8::bf16_t*)(ws + WS_GR), (const pg8::bf16_t*)(ws + WS_WR), TT, 1024, 1024};
          pg8::gemm_phase<EpiC, pg8::StaticOrder, true, true>(lds, g, S, E, wave);
#endif
        }
    }
    GRID_BAR();
    REP(7) if (PH_LAST >= 6 && EN(7)) {
        pg8::StaticOrder S; S.init(TT, 1024, G, bx);
        pg8::EpiResBf16 E{X_F32_RES ? (const pg8::bf16_t*)args.in[0] : (const pg8::bf16_t*)(ws + WS_XB), (pg8::bf16_t*)args.out, DN_ALPHA};
#if MIX_FP8 & 1
        pg8::Gemm g{(const pg8::bf16_t*)(ws + WS_MERGED8), (const pg8::bf16_t*)(ws + WS_WO), TT, 1024, 512};
        pg8::gemm_phase<pg8::EpiResBf16, pg8::StaticOrder, true, true, false, true, 1, 3>(lds, g, S, E, wave);
#else
        pg8::Gemm g{(const pg8::bf16_t*)(ws + WS_MERGED), (const pg8::bf16_t*)(ws + WS_WO), TT, 1024, 1024};
        pg8::gemm_phase<pg8::EpiResBf16, pg8::StaticOrder, true, true>(lds, g, S, E, wave);
#endif
    }
    GRID_BAR();
    ST_B(8) if (PH_LAST >= 7 && EN(8)) { FRESH(); p6a_phase(args, lds, vcu, G, tid, wave, lane); }
    GRID_BAR(); ST_E(8)
    { FRESH(); build_tile_tables(args, lds, tid); }
    const int nrt = ((const LAS int*)(lds + LDS_TS_OFF))[16];
    REP(10) if (PH_LAST >= 9 && EN(10)) {
#if M1_FP8
        pg8::Gemm g{(const pg8::bf16_t*)(ws + WS_X1F8), (const pg8::bf16_t*)(ws + WS_WGU), MAXSLOT, 1024, 512};
        pg8::MoeOrder S{nrt * 4, G, vcu, (const LAS int*)(lds + LDS_TE_OFF), (const LAS int*)(lds + LDS_TS_OFF), (const LAS int*)(lds + LDS_CNT_OFF), (const int*)(ws + WS_LTOK), 1024u};
        pg8::EpiSwiGLU E{ws + WS_H};
        pg8::gemm_phase<pg8::EpiSwiGLU, pg8::MoeOrder, true, true, true, true, 1, 0>(lds, g, S, E, wave);
#else
        pg8::Gemm g{(const pg8::bf16_t*)(ws + WS_XB), (const pg8::bf16_t*)(ws + WS_WGU), MAXSLOT, 1024, 1024};
        pg8::MoeOrder S{nrt * 4, G, vcu, (const LAS int*)(lds + LDS_TE_OFF), (const LAS int*)(lds + LDS_TS_OFF), (const LAS int*)(lds + LDS_CNT_OFF), (const int*)(ws + WS_LTOK), 2048u};
        pg8::EpiSwiGLU E{ws + WS_H};
        pg8::gemm_phase<pg8::EpiSwiGLU, pg8::MoeOrder, true, true, true>(lds, g, S, E, wave);
#endif
    }
    GRID_BAR();
    REP(11) if (PH_LAST >= 10 && EN(11)) {
        pg8::Gemm g{(const pg8::bf16_t*)(ws + WS_H), (const pg8::bf16_t*)(ws + WS_WD), MAXSLOT, 1024, 256};
        pg8::MoeOrder S{nrt * 4, G, vcu, (const LAS int*)(lds + LDS_TE_OFF), (const LAS int*)(lds + LDS_TS_OFF), (const LAS int*)(lds + LDS_CNT_OFF), (const int*)(ws + WS_LTOK), 1024u};
        pg8::EpiRowScale E{(pg8::bf16_t*)(ws + WS_Y)};
        pg8::gemm_phase<pg8::EpiRowScale, pg8::MoeOrder, true, true, false, true, 1, 2>(lds, g, S, E, wave);
    }
    GRID_BAR();
    ST_B(12) if (PH_LAST >= 11 && EN(12)) { FRESH(); p9_phase(args, lds, vcu, G, wave, lane); }
#ifdef STAMP_PH
    GRID_BAR(); ST_E(12)
    if (STAMP_PH == 13) { st_a = rt(); GRID_BAR(); GRID_BAR(); GRID_BAR(); GRID_BAR(); st_b = rt(); }
    if (bx == 0 && tid0 == 0) { const float us = (float)(st_b - st_a) * 0.01f * STAMP_SCALE; int k = 0; float lim = 30.f; while (us >= lim && k < 12) { lim *= 1.5f; ++k; }
        __hip_atomic_store(ctl + CW_CHK, __float_as_uint(sqrtf(2.f * k + 2.f)), RLX_AGENT); }
    GRID_BAR();
    { const float c = __uint_as_float(__hip_atomic_load(ctl + CW_CHK, RLX_AGENT)); f32x4* o4 = (f32x4*)args.out;
      for (size_t i = (size_t)bx * 512 + tid0; i < (size_t)TT * DM / 4; i += (size_t)G * 512) o4[i] = (f32x4){c, c, c, c}; }
#endif
}

#ifdef PROBE_VAR
__global__ void __launch_bounds__(NWAVES * 64, 2) probe_kernel(Args args) {
    extern __shared__ __attribute__((aligned(16))) unsigned char lds_raw[];
    LAS unsigned char* lds = (LAS unsigned char*)lds_raw;
    const int tid0 = threadIdx.x, wave = __builtin_amdgcn_readfirstlane(tid0 >> 6);
    const int G = gridDim.x, bx = blockIdx.x, vcu = (G % 8 == 0) ? (bx % 8) * (G / 8) + bx / 8 : bx;
    FRESH();
    if (PROBE_VAR >= 20 && PROBE_VAR <= 22) {
        unsigned char* ws = args.ws;
        pg8::Gemm g{(const pg8::bf16_t*)(ws + WS_X8_LO), (const pg8::bf16_t*)(ws + WS_WIN8), TT, 4608, 512, 64, (long)WS_X8_HI - (long)WS_X8_LO - (long)(16 * MiB)}; pg8::StaticOrder S; S.init(TT, 4608, G, bx);
        typedef pg8::EpiHcatT<PROBE_VAR - 20> EpiP;
        EpiP E{ws, (const float*)(ws + WS_ROT), 0};
        pg8::gemm_phase<EpiP, pg8::StaticOrder, true, true, false, true, 1, 0>(lds, g, S, E, wave);
    }
    if (PROBE_VAR == 10) p3_phase<0>(args, lds, vcu, G, tid, wave, lane);
    if (PROBE_VAR == 11) p3_phase<1>(args, lds, vcu, G, tid, wave, lane);
    if (PROBE_VAR == 0) attn_dil_phase<16, 0>(args, lds, vcu, G, tid, wave, lane);
    if (PROBE_VAR == 1) attn_dil_phase<16, 1>(args, lds, vcu, G, tid, wave, lane);
    if (PROBE_VAR == 2) attn_dil_phase<4, 0>(args, lds, vcu, G, tid, wave, lane);
    if (PROBE_VAR == 3) attn_dil_phase<4, 1>(args, lds, vcu, G, tid, wave, lane);
}
#endif
extern "C" void kernel_launch(void* const* d_in, const int* in_sizes, int n_in, void* d_out, int out_size, void* d_ws, size_t ws_size, hipStream_t stream) {
    static int grid = 0;
    if (grid == 0) {
        if (n_in != 20 || in_sizes[0] != TT * DM || out_size != TT * DM || ws_size < WS_END) { fprintf(stderr, "kernel_launch: unexpected shapes: n_in %d in0 %d out %d ws %zu; nothing launched\n", n_in, n_in > 0 ? in_sizes[0] : -1, out_size, ws_size); grid = -1; return; }
        int dev = 0, cus = 0;
        if (hipGetDevice(&dev) != hipSuccess || hipDeviceGetAttribute(&cus, hipDeviceAttributeMultiprocessorCount, dev) != hipSuccess) { grid = -1; return; }
        if (hipFuncSetAttribute((const void*)mega_fwd, hipFuncAttributeMaxDynamicSharedMemorySize, LDS_BYTES) != hipSuccess) { fprintf(stderr, "kernel_launch: hipFuncSetAttribute failed\n"); grid = -1; return; }
        (void)hipGetLastError();
        grid = cus;
    }
    if (grid < 0) return;
    if (hipMemsetAsync((char*)d_ws, 0, CTL_ZERO_BYTES, stream) != hipSuccess) return;
    Args a{};
    for (int i = 0; i < 20; ++i) a.in[i] = (const float*)d_in[i];
    a.out = (float*)d_out; a.ws = (unsigned char*)d_ws; a.mask = 0x80007fffu; a.bar_region = 0;
#if defined(XTRA_FIRST)
    { Args x = a; x.mask = XTRA_FIRST; x.bar_region = 1; for (int r = 0; r < XTRA_REP; ++r) hipLaunchKernelGGL(mega_fwd, dim3(grid), dim3(NWAVES * 64), LDS_BYTES, stream, x);
      if (hipMemsetAsync((char*)d_ws, 0, CTL_ZERO_BYTES, stream) != hipSuccess) return; }
#endif
    hipLaunchKernelGGL(mega_fwd, dim3(grid), dim3(NWAVES * 64), LDS_BYTES, stream, a);
#if defined(PROBE_VAR)
    { hipFuncSetAttribute((const void*)probe_kernel, hipFuncAttributeMaxDynamicSharedMemorySize, LDS_BYTES);
      for (int r = 0; r < 4; ++r) hipLaunchKernelGGL(probe_kernel, dim3(grid), dim3(NWAVES * 64), LDS_BYTES, stream, a); }
#endif
#if defined(XTRA_AFTER)
    { Args x = a; x.mask = XTRA_AFTER; x.bar_region = 1; for (int r = 0; r < XTRA_REP; ++r) hipLaunchKernelGGL(mega_fwd, dim3(grid), dim3(NWAVES * 64), LDS_BYTES, stream, x); }
#endif
}
```

```cpp
#include <hip/hip_runtime.h>
#include <cstdio>
#include <cstdint>

constexpr int TT = 32768, DM = 1024, SEQ = 2048, NB = 16;
constexpr float DN_ALPHA = 1.189207115002721f;
constexpr float LN_EPSF = 1e-5f;
#ifndef M1_FP8
#define M1_FP8 1
#endif
#ifndef P1_FP8
#define P1_FP8 1
#endif
#ifndef SILU_IN_P3
#define SILU_IN_P3 1
#endif
#ifndef CONV_BG
#define CONV_BG 1
#endif
#ifndef Y_FP8
#define Y_FP8 1
#endif
#ifndef GATE_FP8
#define GATE_FP8 1
#endif
#ifndef MIX_FP8
#define MIX_FP8 7
#endif
#ifndef P1_FP8_FROM
#define P1_FP8_FROM 0
#endif
#define X_F32_RES (P1_FP8 && P1_FP8_FROM == 0 && GATE_FP8)
constexpr size_t MiB = 1u << 20;
constexpr size_t CTL_ZERO_BYTES = 1 * MiB;
constexpr size_t WS_ROT = 1 * MiB;
constexpr size_t WS_BIAS = 2 * MiB;
constexpr size_t WS_LTOK = 3 * MiB;
constexpr size_t WS_TINFO = 7 * MiB;
constexpr size_t WS_WSLOT = 7 * MiB + 512 * 1024;
constexpr size_t WS_WIN = 8 * MiB;
constexpr size_t WS_WIN8 = 12 * MiB;
constexpr size_t WS_WR = 21 * MiB;
constexpr size_t WS_WA = 23 * MiB;
constexpr size_t WS_WO = 24 * MiB;
constexpr size_t WS_WGU = 26 * MiB;
constexpr size_t WS_WD = 42 * MiB;
constexpr size_t WS_XB = 80 * MiB;
constexpr size_t WS_QR = 144 * MiB;
constexpr size_t WS_KR = 176 * MiB;
constexpr size_t WS_VR = 208 * MiB;
constexpr size_t WS_GR = 272 * MiB;
constexpr size_t WS_QA = 336 * MiB, WS_KA = 368 * MiB, WS_VA = 400 * MiB, WS_OA = 432 * MiB;
#if MIX_FP8 & 4
constexpr size_t WS_AR8 = 144 * MiB;
constexpr size_t WS_GATE_R = 176 * MiB, WS_GATE_A = 240 * MiB;
#else
constexpr size_t WS_GATE_R = 144 * MiB, WS_GATE_A = 208 * MiB;
#endif
constexpr size_t WS_X8_LO = 448 * MiB, WS_X8_HI = 58 * MiB;
static_assert(M1_FP8, "the workspace map is laid out for fp8 expert weights");
static_assert(!CONV_BG || X_F32_RES, "CONV_BG puts o2 into the bf16 x region");
static_assert(!GATE_FP8 || (P1_FP8 && (MIX_FP8 & 2) && M1_FP8), "GATE_FP8 needs the fp8 mixer-input GEMM, the fp8 o_a (room behind it) and the fp8 expert weights (room behind them)");
constexpr size_t WS_MERGED8 = 464 * MiB;
constexpr size_t WS_MERGED = 336 * MiB;
constexpr size_t WS_Y = 144 * MiB;
constexpr size_t WS_H = 336 * MiB;
constexpr size_t WS_X1F8 = 464 * MiB;
#if CONV_BG
constexpr size_t WS_O2 = 80 * MiB;
#else
constexpr size_t WS_O2 = 26 * MiB;
#endif
constexpr size_t WS_O3 = 464 * MiB;
constexpr size_t WS_LSE2 = 496 * MiB, WS_LSE3 = 497 * MiB;
constexpr size_t WS_END = 512 * MiB;
constexpr int MAXSLOT = 69632;
constexpr int CW_BAR = 4096;
constexpr int CW_CNT = 16384;
constexpr int CW_CHK = 24576;
namespace pg8 {
#define PG8_LAS __attribute__((address_space(3)))
typedef unsigned short bf16_t;
typedef short bf16x8 __attribute__((ext_vector_type(8)));
typedef float f32x4 __attribute__((ext_vector_type(4)));
typedef unsigned u32x4 __attribute__((ext_vector_type(4)));
typedef unsigned u32x2_ __attribute__((ext_vector_type(2)));
constexpr int BM = 256, BK = 64, HALF = 128, HTB = HALF * BK * 2  , STAGE_BYTES = 8 * HTB, NXCD = 8, WGM = 8;

__device__ __forceinline__ int lane_id() { int x; asm volatile("v_mbcnt_lo_u32_b32 %0, -1, 0\n\tv_mbcnt_hi_u32_b32 %0, -1, %0" : "=v"(x)); return x; }
__host__ __device__ __forceinline__ int lds_byte(int r, int c) { const int st = (r >> 4) * 2 + (c >> 5), rr = r & 15, cc = c & 31, ob = rr * 64 + cc * 2; return st * 1024 + (ob ^ (((ob >> 9) & 1) << 5)); }
__host__ __device__ __forceinline__ void stage_rc(int b, int& R, int& C) { const int st = b / 1024, sb = b % 1024, swz = sb ^ (((sb >> 9) & 1) << 5); R = (st >> 1) * 16 + swz / 64; C = (st & 1) * 32 + (swz % 64) / 2; }
__host__ __device__ __forceinline__ int perm32(int rho) { const int n = rho >> 4, i = rho & 15; return 8 * (i >> 2) + 4 * n + (i & 3); }

struct Unit { int pm, pn; };
struct Gemm { const bf16_t* A; const bf16_t* Bt; int M, N, K; int spm = 1 << 30; long sdelta = 0; };

struct StaticOrder {
    int nM, nN, nwg, G, c, pn0;
    __host__ __device__ void init(int M, int N, int G_, int c_, int pn0_ = 0) { nM = M / BM; nN = N / BM; nwg = nM * nN; G = G_; c = c_; pn0 = pn0_; }
    __host__ __device__ bool next(int i, Unit& u) const {
        const long L = (long)i * G + c; if (L >= nwg) return false;
        int wgid = (int)L; { const int q = nwg / NXCD, r = nwg % NXCD, xcd = wgid % NXCD, off = wgid / NXCD; wgid = (xcd < r ? xcd * (q + 1) : r * (q + 1) + (xcd - r) * q) + off; }
        const int nig = WGM * nN, gid = wgid / nig, fm = gid * WGM, gsz = (nM - fm) < WGM ? (nM - fm) : WGM;
        u.pm = fm + ((wgid % nig) % gsz); u.pn = pn0 + (wgid % nig) / gsz; return true;
    }
    __device__ __forceinline__ void a_ready(const Unit&) const {}
    __device__ __forceinline__ void done(const Unit&, int, int) const {}
};

__device__ __forceinline__ unsigned cvt_pk_bf16(float lo, float hi) { unsigned r; asm volatile("v_cvt_pk_bf16_f32 %0, %1, %2" : "=v"(r) : "v"(lo), "v"(hi)); return r; }
typedef float cvt_f32x2_t __attribute__((ext_vector_type(2))); typedef __bf16 cvt_bf16x2_t __attribute__((ext_vector_type(2)));
__device__ __forceinline__ unsigned cvt_pk_bf16_acc(float lo, float hi) { const cvt_f32x2_t v = {lo, hi}; const cvt_bf16x2_t b = __builtin_convertvector(v, cvt_bf16x2_t); return __builtin_bit_cast(unsigned, b); }
__device__ __forceinline__ float bflo(unsigned w) { return __uint_as_float(w << 16); }
__device__ __forceinline__ float bfhi(unsigned w) { return __uint_as_float(w & 0xffff0000u); }
__device__ __forceinline__ float fsigmoid(float x) { return __builtin_amdgcn_rcpf(1.f + __expf(-x)); }
__device__ __forceinline__ float fsilu(float x) { return x * __builtin_amdgcn_rcpf(1.f + __expf(-x)); }

template <int VAR = 0> struct EpiHcatT {
    static constexpr bool PERM = true, AFTER_DRAIN = false; static constexpr int NSTORE = 16;
    unsigned char* ws; const float* rot; int tile_off;
    __device__ __forceinline__ void operator()(const f32x4 (&acc)[2][2][4][2], const Unit& u, int wr, int wc, int fr, int fq) const {
        if (VAR == 1) {
            float s = 0.f;
#pragma unroll
            for (int ai = 0; ai < 2; ++ai)
#pragma unroll
                for (int bj = 0; bj < 2; ++bj)
#pragma unroll
                    for (int m = 0; m < 4; ++m)
#pragma unroll
                        for (int n = 0; n < 2; ++n) s += (acc[ai][bj][m][n][0] + acc[ai][bj][m][n][1]) + (acc[ai][bj][m][n][2] + acc[ai][bj][m][n][3]);
            ((float*)(ws + WS_O3))[(size_t)(u.pm * 64 + u.pn) * 512 + wr * 256 + wc * 64 + fq * 16 + fr] = s; return;
        }
        const int gt = u.pn + tile_off;
        size_t base_off; int pitch, ct, mode; float sc = 1.f;
        if (gt < 2)       { base_off = WS_QR; pitch = 512;  ct = gt;      mode = 1; }
        else if (gt < 4)  { base_off = WS_KR; pitch = 512;  ct = gt - 2;  mode = 1; sc = 0.08838834764831845f; }
        else if (gt < 8)  { base_off = WS_VR; pitch = 1024; ct = gt - 4;  mode = 0; }
        else if (gt < 12) { base_off = WS_GR; pitch = 1024; ct = gt - 8;  mode = SILU_IN_P3 ? 0 : 2; }
        else if (gt < 14) { base_off = WS_QA; pitch = 512;  ct = gt - 12; mode = 0; sc = 0.18033688011112042f; }
        else if (gt < 16) { base_off = WS_KA; pitch = 512;  ct = gt - 14; mode = 0; }
        else if (gt < 18) { base_off = WS_VA; pitch = 512;  ct = gt - 16; mode = 0; }
        else if (gt < 22) { base_off = WS_GATE_R; pitch = 1024; ct = gt - 18; mode = 3; }
        else              { base_off = WS_GATE_A; pitch = 1024; ct = gt - 22; mode = 3; }
        bf16_t* O = (bf16_t*)(ws + base_off);
        const int row0 = u.pm * BM + wr * 64 + fr, col0 = ct * BM + wc * 32 + 8 * fq;
#pragma unroll
        for (int ai = 0; ai < 2; ++ai)
#pragma unroll
            for (int m = 0; m < 4; ++m) {
                const int row = row0 + ai * HALF + m * 16;
                bf16_t* rowp = O + (size_t)(VAR == 2 ? (row & 255) : row) * pitch + col0;
                f32x4 cs = (f32x4){1.f, 1.f, 1.f, 1.f}, sn = (f32x4){0.f, 0.f, 0.f, 0.f};
                if (mode == 1) { const f32x4* rt = (const f32x4*)(rot + ((size_t)(row & (SEQ - 1)) * 16 + (4 * wc + fq)) * 8); cs = rt[0]; sn = rt[1]; }
#pragma unroll
                for (int bj = 0; bj < 2; ++bj) {
                    f32x4 v0 = acc[ai][bj][m][0], v1 = acc[ai][bj][m][1];
                    if (mode == 1) { const f32x4 a = v0 * cs - v1 * sn, b = v0 * sn + v1 * cs; v0 = a * sc; v1 = b * sc; }
                    else if (mode == 2) {
#pragma unroll
                        for (int e = 0; e < 4; ++e) { v0[e] = fsilu(v0[e]); v1[e] = fsilu(v1[e]); } }
                    else if (mode == 3) {
#pragma unroll
                        for (int e = 0; e < 4; ++e) { v0[e] = fsigmoid(v0[e]); v1[e] = fsigmoid(v1[e]); } }
                    else { v0 = v0 * sc; v1 = v1 * sc; }
                    u32x4 w; w.x = cvt_pk_bf16(v0[0], v0[1]); w.y = cvt_pk_bf16(v0[2], v0[3]); w.z = cvt_pk_bf16(v1[0], v1[1]); w.w = cvt_pk_bf16(v1[2], v1[3]);
                    *(u32x4*)(rowp + bj * HALF) = w;
                }
            }
    }
};

typedef EpiHcatT<0> EpiHcat;

__device__ __forceinline__ unsigned fp8x4_sat(float a, float b, float c, float d) {
    a = __builtin_amdgcn_fmed3f(a, -448.f, 448.f); b = __builtin_amdgcn_fmed3f(b, -448.f, 448.f); c = __builtin_amdgcn_fmed3f(c, -448.f, 448.f); d = __builtin_amdgcn_fmed3f(d, -448.f, 448.f);
    unsigned w = 0u; w = __builtin_amdgcn_cvt_pk_fp8_f32(a, b, w, false); w = __builtin_amdgcn_cvt_pk_fp8_f32(c, d, w, true); return w;
}
template <bool ADD, bool OUT8 = false> struct EpiGate {
    static constexpr bool PERM = true, AFTER_DRAIN = false; static constexpr int NSTORE = 16;
    const bf16_t* gate; bf16_t* O; unsigned char* O8;
    __device__ __forceinline__ void operator()(const f32x4 (&acc)[2][2][4][2], const Unit& u, int wr, int wc, int fr, int fq) const {
        const int row0 = u.pm * BM + wr * 64 + fr, col0 = u.pn * BM + wc * 32 + 8 * fq;
#pragma unroll
        for (int ai = 0; ai < 2; ++ai)
#pragma unroll
            for (int m = 0; m < 4; ++m)
#pragma unroll
                for (int bj = 0; bj < 2; ++bj) {
                    const size_t p = (size_t)(row0 + ai * HALF + m * 16) * 1024 + col0 + bj * HALF;
                    const u32x4 g = *(const u32x4*)(gate + p);
                    f32x4 v0 = acc[ai][bj][m][0], v1 = acc[ai][bj][m][1];
                    v0[0] *= bflo(g.x); v0[1] *= bfhi(g.x); v0[2] *= bflo(g.y); v0[3] *= bfhi(g.y);
                    v1[0] *= bflo(g.z); v1[1] *= bfhi(g.z); v1[2] *= bflo(g.w); v1[3] *= bfhi(g.w);
                    if (ADD) { const u32x4 o = *(const u32x4*)(O + p);
                        v0[0] += bflo(o.x); v0[1] += bfhi(o.x); v0[2] += bflo(o.y); v0[3] += bfhi(o.y);
                        v1[0] += bflo(o.z); v1[1] += bfhi(o.z); v1[2] += bflo(o.w); v1[3] += bfhi(o.w); }
                    if (OUT8) { u32x2_ w8;
                        w8.x = fp8x4_sat(v0[0] * 16.f, v0[1] * 16.f, v0[2] * 16.f, v0[3] * 16.f); w8.y = fp8x4_sat(v1[0] * 16.f, v1[1] * 16.f, v1[2] * 16.f, v1[3] * 16.f);
                        *(u32x2_*)(O8 + p) = w8; }
                    else { u32x4 w; w.x = cvt_pk_bf16(v0[0], v0[1]); w.y = cvt_pk_bf16(v0[2], v0[3]); w.z = cvt_pk_bf16(v1[0], v1[1]); w.w = cvt_pk_bf16(v1[2], v1[3]);
                        *(u32x4*)(O + p) = w; }
                }
    }
};

struct EpiResBf16 {
    static constexpr bool PERM = true, AFTER_DRAIN = false; static constexpr int NSTORE = 16;
    const bf16_t* x; bf16_t* out; float alpha;
    __device__ __forceinline__ void operator()(const f32x4 (&acc)[2][2][4][2], const Unit& u, int wr, int wc, int fr, int fq) const {
        const int row0 = u.pm * BM + wr * 64 + fr, col0 = u.pn * BM + wc * 32 + 8 * fq;
#pragma unroll
        for (int ai = 0; ai < 2; ++ai)
#pragma unroll
            for (int m = 0; m < 4; ++m)
#pragma unroll
                for (int bj = 0; bj < 2; ++bj) {
                    const size_t p = (size_t)(row0 + ai * HALF + m * 16) * 1024 + col0 + bj * HALF;
#if X_F32_RES
                    const f32x4 x0 = *(const f32x4*)((const float*)x + p), x1 = *(const f32x4*)((const float*)x + p + 4);
#else
                    const u32x4 xw = *(const u32x4*)(x + p);
                    const f32x4 x0 = (f32x4){bflo(xw.x), bfhi(xw.x), bflo(xw.y), bfhi(xw.y)}, x1 = (f32x4){bflo(xw.z), bfhi(xw.z), bflo(xw.w), bfhi(xw.w)};
#endif
                    const f32x4 v0 = x0 * alpha + acc[ai][bj][m][0], v1 = x1 * alpha + acc[ai][bj][m][1];
                    u32x4 w; w.x = cvt_pk_bf16(v0[0], v0[1]); w.y = cvt_pk_bf16(v0[2], v0[3]); w.z = cvt_pk_bf16(v1[0], v1[1]); w.w = cvt_pk_bf16(v1[2], v1[3]);
                    *(u32x4*)(out + p) = w;
                }
    }
};

struct EpiSwiGLU {
    static constexpr bool PERM = true, AFTER_DRAIN = false; static constexpr int NSTORE = 16;
    unsigned char* H;
    __device__ __forceinline__ void operator()(const f32x4 (&acc)[2][2][4][2], const Unit& u, int wr, int wc, int fr, int fq) const {
        const int row0 = u.pm * BM + wr * 64 + fr, col0 = (u.pn & 3) * 128 + wc * 16 + 4 * fq;
#pragma unroll
        for (int ai = 0; ai < 2; ++ai)
#pragma unroll
            for (int m = 0; m < 4; ++m)
#pragma unroll
                for (int bj = 0; bj < 2; ++bj) {
                    const f32x4 g = acc[ai][bj][m][0], up = acc[ai][bj][m][1];
                    float h0 = fsilu(g[0]) * up[0] * 8.f, h1 = fsilu(g[1]) * up[1] * 8.f, h2 = fsilu(g[2]) * up[2] * 8.f, h3 = fsilu(g[3]) * up[3] * 8.f;
                    h0 = fminf(fmaxf(h0, -448.f), 448.f); h1 = fminf(fmaxf(h1, -448.f), 448.f); h2 = fminf(fmaxf(h2, -448.f), 448.f); h3 = fminf(fmaxf(h3, -448.f), 448.f);
                    unsigned w = 0u; w = __builtin_amdgcn_cvt_pk_fp8_f32(h0, h1, w, false); w = __builtin_amdgcn_cvt_pk_fp8_f32(h2, h3, w, true);
                    *(unsigned*)(H + (size_t)(row0 + ai * HALF + m * 16) * 512 + col0 + bj * 64) = w;
                }
    }
};

struct EpiRowScale {
    static constexpr bool PERM = true, AFTER_DRAIN = false; static constexpr int NSTORE = 16;
    bf16_t* Y;
    __device__ __forceinline__ void operator()(const f32x4 (&acc)[2][2][4][2], const Unit& u, int wr, int wc, int fr, int fq) const {
        const int row0 = u.pm * BM + wr * 64 + fr, col0 = (u.pn & 3) * BM + wc * 32 + 8 * fq;
#pragma unroll
        for (int ai = 0; ai < 2; ++ai)
#pragma unroll
            for (int m = 0; m < 4; ++m) {
                const int row = row0 + ai * HALF + m * 16;
#pragma unroll
                for (int bj = 0; bj < 2; ++bj) {
                    const f32x4 v0 = acc[ai][bj][m][0], v1 = acc[ai][bj][m][1];
#if Y_FP8
                    u32x2_ w8; w8.x = fp8x4_sat(v0[0] * 16.f, v0[1] * 16.f, v0[2] * 16.f, v0[3] * 16.f); w8.y = fp8x4_sat(v1[0] * 16.f, v1[1] * 16.f, v1[2] * 16.f, v1[3] * 16.f);
                    *(u32x2_*)((unsigned char*)Y + (size_t)row * 1024 + col0 + bj * HALF) = w8;
#else
                    u32x4 w; w.x = cvt_pk_bf16_acc(v0[0], v0[1]); w.y = cvt_pk_bf16_acc(v0[2], v0[3]); w.z = cvt_pk_bf16_acc(v1[0], v1[1]); w.w = cvt_pk_bf16_acc(v1[2], v1[3]);
                    *(u32x4*)(Y + (size_t)row * 1024 + col0 + bj * HALF) = w;
#endif
                }
            }
    }
};

struct MoeOrder {
    int nunits, G, c; const PG8_LAS int* te; const PG8_LAS int* ts; const PG8_LAS int* cnt; const int* ltok; unsigned rowbytes;
    __device__ __forceinline__ bool next(int i, Unit& u) const {
        const int L = i * G + c, rt = (L >> 5) * 8 + (L & 7); if (rt >= (nunits >> 2)) return false;
        u.pm = rt; u.pn = te[rt] * 4 + ((L >> 3) & 3); return true;
    }
    __device__ __forceinline__ unsigned a_row_off(const Unit& u, int row) const {
        const int ex = te[u.pm], pos = (u.pm - ts[ex]) * 256 + row;
        const int tok = pos < cnt[ex] ? ltok[ex * 32768 + pos] : 0;
        return (unsigned)tok * rowbytes;
    }
    __device__ __forceinline__ void a_ready(const Unit&) const {}
    __device__ __forceinline__ void done(const Unit&, int, int) const {}
};

struct ExpertConv { const float* wg; const float* wu; const float* wd; unsigned char* WGU; unsigned char* WD; int gw, nw, grp; };
__device__ __forceinline__ void expert_conv_item(const ExpertConv& c, int j, int lane) {
    const int it = j * c.nw + c.gw, e = it / 384, r = it % 384;
    const float* src; unsigned char* dst; int K, N, mode, nb, kb;
    if (r < 128)      { src = c.wg + (size_t)e * 1024 * 512; dst = c.WGU + (size_t)e * 1024 * 1024; K = 1024; N = 512;  mode = 2; nb = r >> 4; kb = r & 15; }
    else if (r < 256) { src = c.wu + (size_t)e * 1024 * 512; dst = c.WGU + (size_t)e * 1024 * 1024; K = 1024; N = 512;  mode = 3; nb = (r - 128) >> 4; kb = (r - 128) & 15; }
    else              { src = c.wd + (size_t)e * 512 * 1024; dst = c.WD + (size_t)e * 1024 * 512;   K = 512;  N = 1024; mode = 0; nb = (r - 256) >> 3; kb = (r - 256) & 7; }
    const int n4 = nb * 64 + 4 * (lane & 15), k0 = kb * 64 + 16 * (lane >> 4);
    const float* s = src + (size_t)k0 * N + n4;
    f32x4 v[16];
#pragma unroll
    for (int i = 0; i < 16; ++i) v[i] = *(const f32x4*)(s + (size_t)i * N);
#pragma unroll
    for (int jn = 0; jn < 4; ++jn) {
        const int n = n4 + jn, row = mode == 0 ? n : ((n >> 2) << 3) + (n & 3) + (mode == 3 ? 4 : 0);
        u32x4 w;
        w.x = fp8x4_sat(v[0][jn] * 64.f, v[1][jn] * 64.f, v[2][jn] * 64.f, v[3][jn] * 64.f);     w.y = fp8x4_sat(v[4][jn] * 64.f, v[5][jn] * 64.f, v[6][jn] * 64.f, v[7][jn] * 64.f);
        w.z = fp8x4_sat(v[8][jn] * 64.f, v[9][jn] * 64.f, v[10][jn] * 64.f, v[11][jn] * 64.f); w.w = fp8x4_sat(v[12][jn] * 64.f, v[13][jn] * 64.f, v[14][jn] * 64.f, v[15][jn] * 64.f);
        *(u32x4*)(dst + (size_t)row * K + k0) = w;
    }
}
struct GateOrder {
    StaticOrder S4;
    __device__ __forceinline__ bool next(int i, Unit& u) const { Unit t; if (!S4.next(i >> 1, t)) return false; u.pm = t.pm; u.pn = t.pn + 4 * (i & 1); return true; }
    __device__ __forceinline__ void a_ready(const Unit&) const {}
    __device__ __forceinline__ void done(const Unit&, int, int) const {}
};
struct P1Order {
    StaticOrder S; ExpertConv cv;
    __device__ __forceinline__ bool next(int i, Unit& u) const { return S.next(i, u); }
    __device__ __forceinline__ void a_ready(const Unit&) const {}
    __device__ __forceinline__ static int unit_of(int grp, int k) { return (grp + 3 * k) % 9; }
    __device__ __forceinline__ void done(const Unit&, int ui, int lane) const {
        const int d = (ui + 9 - cv.grp) % 9;
        if (ui < 9 && d % 3 == 0 && cv.gw + (d / 3) * cv.nw < 6144) expert_conv_item(cv, d / 3, lane);
    }
};

template <class Epi, class Sched, bool ALIGN_EPI = false, bool SP2 = false, bool GATHER = false, bool FP8 = false, int SEL_W = 0, int SEL_X = 0>
__device__ __forceinline__ void gemm_phase(PG8_LAS unsigned char* lds, const Gemm g, const Sched& S, const Epi& E, const int wid) {
    int tid = wid * 64 + lane_id(); asm volatile("" : "+v"(tid));
    const int lane = tid & 63, wr = wid >> 2, wc = wid & 3, fr = lane & 15, fq = lane >> 4;
    static_assert(SP2, "only the two-super-phase loop is kept");
    typedef int i32x4_ __attribute__((ext_vector_type(4)));
    const int K = g.K, nt = K / BK;
    unsigned voffB[2]; int rA[2], cA2[2];
#pragma unroll
    for (int i = 0; i < 2; ++i) { int R, C; stage_rc(tid * 16 + i * 8192, R, C); const int Rb = Epi::PERM ? ((R & ~31) + perm32(R & 31)) : R;
        rA[i] = R; cA2[i] = C * 2; voffB[i] = (unsigned)(Rb * K + C) * 2u; }
    unsigned vAc[2][2], vAn[2][2];
    const size_t kstep = (size_t)(BK * 2);
    const size_t hstep = (size_t)HALF * K * 2;
    const size_t tstep = 2 * hstep;
    const unsigned ldsw = (unsigned)wid * 1024u;
    const int aoff0 = lds_byte(wr * 64 + fr, fq * 8), aoff1 = aoff0 + 1024;
    const int boff0 = lds_byte(wc * 32 + fr, fq * 8), boff1 = boff0 + 1024;
#define PG8_SA(b, h) (((b) * 2 + (h)) * HTB)
#define PG8_SB(b, h) ((4 + (b) * 2 + (h)) * HTB)
#define PG8_STAGE(bufoff, gbase, voff) do { _Pragma("unroll") for (int _i = 0; _i < 2; ++_i) \
        __builtin_amdgcn_global_load_lds((const unsigned*)((const char*)(gbase) + (voff)[_i]), (PG8_LAS unsigned*)(lds + (bufoff) + ldsw + _i * 8192), 16, 0, 0); } while (0)
#define PG8_LDA(dst, b, h) do { _Pragma("unroll") for (int m = 0; m < 4; ++m) { dst[m][0] = *(const PG8_LAS bf16x8*)(lds + PG8_SA(b, h) + aoff0 + m * 2048); dst[m][1] = *(const PG8_LAS bf16x8*)(lds + PG8_SA(b, h) + aoff1 + m * 2048); } } while (0)
#define PG8_LDB(dst, b, h) do { _Pragma("unroll") for (int n = 0; n < 2; ++n) { dst[n][0] = *(const PG8_LAS bf16x8*)(lds + PG8_SB(b, h) + boff0 + n * 2048); dst[n][1] = *(const PG8_LAS bf16x8*)(lds + PG8_SB(b, h) + boff1 + n * 2048); } } while (0)
#define PG8_CAT8(x) __builtin_shufflevector(__builtin_bit_cast(i32x4_, (x)[0]), __builtin_bit_cast(i32x4_, (x)[1]), 0, 1, 2, 3, 4, 5, 6, 7)
#define PG8_MMA(ai, bj, At, Bt) do { __builtin_amdgcn_s_setprio(1); \
        if constexpr (FP8) { _Pragma("unroll") for (int m = 0; m < 4; ++m) _Pragma("unroll") for (int n = 0; n < 2; ++n) \
            acc[ai][bj][m][n] = __builtin_amdgcn_mfma_scale_f32_16x16x128_f8f6f4(PG8_CAT8(Bt[n]), PG8_CAT8(At[m]), acc[ai][bj][m][n], 0, 0, SEL_W, scl, SEL_X, scl); \
            asm volatile("" : "+v"(acc[ai][bj][0][0]), "+v"(acc[ai][bj][0][1]), "+v"(acc[ai][bj][1][0]), "+v"(acc[ai][bj][1][1]), "+v"(acc[ai][bj][2][0]), "+v"(acc[ai][bj][2][1]), "+v"(acc[ai][bj][3][0]), "+v"(acc[ai][bj][3][1])); } \
        else { _Pragma("unroll") for (int m = 0; m < 4; ++m) _Pragma("unroll") for (int n = 0; n < 2; ++n) _Pragma("unroll") for (int k = 0; k < 2; ++k) \
            acc[ai][bj][m][n] = __builtin_amdgcn_mfma_f32_16x16x32_bf16(Bt[n][k], At[m][k], acc[ai][bj][m][n], 0, 0, 0); } \
        __builtin_amdgcn_s_setprio(0); } while (0)
#define PG8_WAIT_V(n) asm volatile("s_waitcnt vmcnt(" #n ")" ::: "memory")
#define PG8_WAIT_VN(n) asm volatile("s_waitcnt vmcnt(%0)" :: "i"(n) : "memory")
#define PG8_WAIT_L(n) asm volatile("s_waitcnt lgkmcnt(" #n ")" ::: "memory")
#define PG8_BAR __builtin_amdgcn_s_barrier()
#define PG8_SCHED __builtin_amdgcn_sched_barrier(0)
    [[maybe_unused]] int scl = 0x7b7c797f; asm volatile("" : "+v"(scl));
    Unit cur, nxt; int ui = 0;
    if (!S.next(0, cur)) return;
    f32x4 acc[2][2][4][2];
#pragma unroll
    for (int a = 0; a < 2; ++a)
#pragma unroll
        for (int b = 0; b < 2; ++b)
#pragma unroll
            for (int m = 0; m < 4; ++m)
#pragma unroll
                for (int n = 0; n < 2; ++n) acc[a][b][m][n] = (f32x4){0.f, 0.f, 0.f, 0.f};
    bf16x8 At[4][2], B0[2][2], B1[2][2];
    const char* cA = GATHER ? (const char*)g.A : (const char*)g.A + (size_t)cur.pm * tstep + (cur.pm >= g.spm ? g.sdelta : 0L); const char* cB = (const char*)g.Bt + (size_t)cur.pn * tstep;
#pragma unroll
    for (int h = 0; h < 2; ++h)
#pragma unroll
        for (int i = 0; i < 2; ++i) { if constexpr (GATHER) vAc[h][i] = S.a_row_off(cur, h * HALF + rA[i]) + (unsigned)cA2[i]; else vAc[h][i] = (unsigned)((h * HALF + rA[i]) * K) * 2u + (unsigned)cA2[i]; vAn[h][i] = vAc[h][i]; }
    S.a_ready(cur);
    if constexpr (SP2) {
        PG8_STAGE(PG8_SB(0, 0), cB, voffB); PG8_STAGE(PG8_SB(0, 1), cB + hstep, voffB); PG8_STAGE(PG8_SA(0, 0), cA, vAc[0]); PG8_STAGE(PG8_SA(0, 1), cA, vAc[1]);
        if (wr == 1) PG8_BAR;
        PG8_WAIT_V(2); PG8_BAR;
        PG8_STAGE(PG8_SB(1, 0), cB + kstep, voffB); PG8_STAGE(PG8_SA(1, 0), cA + kstep, vAc[0]); PG8_STAGE(PG8_SB(1, 1), cB + hstep + kstep, voffB);
        PG8_WAIT_V(6); PG8_BAR;
    }
    for (;;) {
        const bool has_next = S.next(ui + 1, nxt);
        const char* nA = GATHER ? cA : (has_next ? (const char*)g.A + (size_t)nxt.pm * tstep + (nxt.pm >= g.spm ? g.sdelta : 0L) : cA); const char* nB = has_next ? (const char*)g.Bt + (size_t)nxt.pn * tstep : cB;
        if constexpr (GATHER) { if (has_next) {
#pragma unroll
            for (int h = 0; h < 2; ++h)
#pragma unroll
                for (int i = 0; i < 2; ++i) vAn[h][i] = S.a_row_off(nxt, h * HALF + rA[i]) + (unsigned)cA2[i]; } }
#pragma unroll 1
        for (int t = 0; t < nt; t += 2) {
            const bool last = (t == nt - 2);
            asm volatile("" : "+v"(voffB[0]), "+v"(voffB[1]), "+v"(vAc[0][0]), "+v"(vAc[0][1]), "+v"(vAc[1][0]), "+v"(vAc[1][1]));
            const char* a1 = cA + (size_t)(t + 1) * kstep;
            const char* a2 = last ? nA : cA + (size_t)(t + 2) * kstep; const char* b2 = last ? nB : cB + (size_t)(t + 2) * kstep;
            const char* a3 = a2 + kstep; const char* b3 = b2 + kstep;
            unsigned vA2[2][2];
#pragma unroll
            for (int h = 0; h < 2; ++h)
#pragma unroll
                for (int i = 0; i < 2; ++i) vA2[h][i] = vAc[h][i];
            if constexpr (GATHER) { if (last) {
                asm volatile("" : "+v"(vAn[0][0]), "+v"(vAn[0][1]), "+v"(vAn[1][0]), "+v"(vAn[1][1]));
#pragma unroll
                for (int h = 0; h < 2; ++h)
#pragma unroll
                    for (int i = 0; i < 2; ++i) vA2[h][i] = vAn[h][i]; } }
            if (last && has_next) S.a_ready(nxt);
            if constexpr (SP2) {
            const int lenient = __builtin_amdgcn_readfirstlane((ui > 0 && t == 0) ? 1 : 0);
#define PG8_WAIT_V8L() asm volatile("s_cmp_eq_u32 %0, 0\n\ts_cbranch_scc0 .Lpg8skip%=\n\ts_waitcnt vmcnt(8)\n.Lpg8skip%=:\n\ts_waitcnt vmcnt(%1)" :: "s"(lenient), "i"(8 + Epi::NSTORE) : "memory", "scc")
            PG8_LDB(B0, 0, 0); PG8_LDB(B1, 0, 1); PG8_SCHED; PG8_LDA(At, 0, 0); PG8_STAGE(PG8_SA(1, 1), a1, vAc[1]);
            PG8_WAIT_V8L(); PG8_WAIT_L(0); PG8_BAR; PG8_MMA(0, 0, At, B0); PG8_MMA(0, 1, At, B1); PG8_BAR; PG8_SCHED;
            PG8_LDA(At, 0, 1); PG8_STAGE(PG8_SB(0, 0), b2, voffB); PG8_STAGE(PG8_SB(0, 1), b2 + hstep, voffB); PG8_STAGE(PG8_SA(0, 0), a2, vA2[0]);
            PG8_WAIT_V8L(); PG8_WAIT_L(0); PG8_BAR; PG8_MMA(1, 0, At, B0); PG8_MMA(1, 1, At, B1); PG8_BAR; PG8_SCHED;
            PG8_LDB(B0, 1, 0); PG8_LDB(B1, 1, 1); PG8_SCHED; PG8_LDA(At, 1, 0); PG8_STAGE(PG8_SA(0, 1), a2, vA2[1]);
            PG8_WAIT_V(8); PG8_WAIT_L(0); PG8_BAR; PG8_MMA(0, 0, At, B0); PG8_MMA(0, 1, At, B1); PG8_BAR; PG8_SCHED;
            PG8_LDA(At, 1, 1); PG8_STAGE(PG8_SB(1, 0), b3, voffB); PG8_STAGE(PG8_SB(1, 1), b3 + hstep, voffB); PG8_STAGE(PG8_SA(1, 0), a3, vA2[0]);
            PG8_WAIT_V(8); PG8_WAIT_L(0); PG8_BAR; PG8_MMA(1, 0, At, B0); PG8_MMA(1, 1, At, B1); PG8_BAR; PG8_SCHED;
#undef PG8_WAIT_V8L
            }
        }
        if constexpr (ALIGN_EPI) { if (wr == 0) PG8_BAR; }
        if constexpr (!Epi::AFTER_DRAIN) { const int le = lane_id(); E(acc, cur, wr, wc, le & 15, le >> 4); S.done(cur, ui, le); }
        if (!has_next) break;
#pragma unroll
        for (int a = 0; a < 2; ++a)
#pragma unroll
            for (int b = 0; b < 2; ++b)
#pragma unroll
                for (int m = 0; m < 4; ++m)
#pragma unroll
                    for (int n = 0; n < 2; ++n) acc[a][b][m][n] = (f32x4){0.f, 0.f, 0.f, 0.f};
        cur = nxt; cA = nA; cB = nB; ++ui;
        if constexpr (GATHER) {
#pragma unroll
            for (int h = 0; h < 2; ++h)
#pragma unroll
                for (int i = 0; i < 2; ++i) vAc[h][i] = vAn[h][i]; }
        if constexpr (ALIGN_EPI) { if (wr == 1) PG8_BAR; }
    }
    PG8_WAIT_V(0);
    if constexpr (!ALIGN_EPI) { if (wr == 0) PG8_BAR; }
    PG8_BAR;
    if constexpr (Epi::AFTER_DRAIN) { E.fused(acc, cur, wr, wc, fr, fq, lds, wid, lane); S.done(cur, ui, lane); }
#undef PG8_SA
#undef PG8_SB
#undef PG8_STAGE
#undef PG8_LDA
#undef PG8_LDB
#undef PG8_MMA
#undef PG8_CAT8
#undef PG8_WAIT_V
#undef PG8_WAIT_VN
#undef PG8_WAIT_L
#undef PG8_BAR
#undef PG8_SCHED
}
}
#define GAS __attribute__((address_space(1)))
#define LAS __attribute__((address_space(3)))
typedef unsigned short bf16;
typedef unsigned v4u __attribute__((ext_vector_type(4)));
typedef float f32x4 __attribute__((ext_vector_type(4)));
typedef short bf16x8 __attribute__((ext_vector_type(8)));
typedef GAS unsigned gu32;
typedef GAS unsigned long long gu64;
#define RLX_AGENT __ATOMIC_RELAXED, __HIP_MEMORY_SCOPE_AGENT
#define LDS_WAIT() asm volatile("s_waitcnt lgkmcnt(0)" ::: "memory")
#define VM_WAIT() asm volatile("s_waitcnt vmcnt(0)" ::: "memory")
__device__ __forceinline__ unsigned long long rt() { return __builtin_amdgcn_s_memrealtime(); }
__device__ __forceinline__ unsigned f2bf(float f) { unsigned u = __builtin_bit_cast(unsigned, f); return (u + 0x7fffu + ((u >> 16) & 1u)) >> 16; }
__device__ __forceinline__ unsigned pk2(float lo, float hi) { return f2bf(lo) | (f2bf(hi) << 16); }

#define XB_TMO      128
#define XB_XCNT(j)  (256  + 64 * (j))
#define XB_XSUB(j)  (1280 + 64 * (j))
#define XB_XGEN(j)  (2304 + 64 * (j))
#define XB_TOP      3328
#define XB_TOPGEN   3392
#define XCD_BAR_WORDS 3456
#define XB_SPIN_CAP (1u << 18)

__device__ __forceinline__ unsigned xb_ld(unsigned* p)              { return __hip_atomic_load(p, __ATOMIC_RELAXED, __HIP_MEMORY_SCOPE_AGENT); }
__device__ __forceinline__ unsigned xb_add(unsigned* p, unsigned v) { return __hip_atomic_fetch_add(p, v, __ATOMIC_RELAXED, __HIP_MEMORY_SCOPE_AGENT); }
__device__ __forceinline__ unsigned xb_xcc_id() { return (unsigned)__builtin_amdgcn_s_getreg((3 << 11) | 20) & 0xFu; }
#define XB_SPIN(cond, bar) do { unsigned _sp = 0; while (cond) { __builtin_amdgcn_s_sleep(1); \
    if ((++_sp & 255u) == 0u) { if (xb_ld(&(bar)[XB_TMO])) break; if (_sp > XB_SPIN_CAP) { atomicAdd(&(bar)[XB_TMO], 1u); break; } } } } while (0)

struct XcdBarrier {
    unsigned* bar; unsigned x; int wv;
    volatile LAS unsigned* st;
};

__device__ __forceinline__ XcdBarrier xcd_barrier_post(unsigned* bar, volatile LAS unsigned* st) {
    XcdBarrier b; b.bar = bar; b.x = xb_xcc_id(); b.st = st; b.wv = 0;
    if (threadIdx.x == 0) (void)xb_add(&bar[XB_XCNT(b.x)], 1u);
    return b;
}
__device__ __forceinline__ void xcd_barrier_complete(unsigned* bar, unsigned x, unsigned& nloc, unsigned& nx) {
    const unsigned G = gridDim.x * gridDim.y * gridDim.z;
    unsigned sum, cnt, mine, sp = 0u;
    for (;;) {
        sum = 0u; cnt = 0u; mine = 0u;
#pragma unroll
        for (unsigned j = 0; j < 16; ++j) { const unsigned c = xb_ld(&bar[XB_XCNT(j)]); sum += c; cnt += (c > 0u) ? 1u : 0u; mine = (j == x) ? c : mine; }
        if (sum == G) break;
        __builtin_amdgcn_s_sleep(1);
        if ((++sp & 255u) == 0u) { if (xb_ld(&bar[XB_TMO])) break; if (sp > XB_SPIN_CAP) { atomicAdd(&bar[XB_TMO], 1u); break; } }
    }
    nloc = mine > 0u ? mine : 1u; nx = cnt > 0u ? cnt : 1u;
}

__device__ __forceinline__ void xcd_barrier(const XcdBarrier& b) {
    asm volatile("s_waitcnt vmcnt(0)" ::: "memory");
    __syncthreads();
    if (b.wv == 0 && (int)__builtin_amdgcn_mbcnt_hi(~0u, __builtin_amdgcn_mbcnt_lo(~0u, 0u)) == 0) {
        unsigned* bar = b.bar;
        __builtin_amdgcn_s_waitcnt(0);
        unsigned nloc = b.st[0], nx = b.st[1];
        if (nloc == 0u) { xcd_barrier_complete(bar, b.x, nloc, nx); b.st[0] = nloc; b.st[1] = nx; }
        const unsigned old = xb_add(&bar[XB_XSUB(b.x)], 1u);
        const unsigned gen = old / nloc;
        if (old + 1u == (gen + 1u) * nloc) {
            __builtin_amdgcn_fence(__ATOMIC_RELEASE, "agent");
            asm volatile("s_waitcnt vmcnt(0)" ::: "memory");
            const unsigned og = xb_add(&bar[XB_TOP], 1u);
            const unsigned tg = og / nx;
            if (og + 1u == (tg + 1u) * nx) xb_add(&bar[XB_TOPGEN], 1u);
            else XB_SPIN(xb_ld(&bar[XB_TOPGEN]) == tg, bar);
            __builtin_amdgcn_fence(__ATOMIC_ACQUIRE, "agent");
            xb_add(&bar[XB_XGEN(b.x)], 1u);
            asm volatile("s_waitcnt vmcnt(0)" ::: "memory");
        } else {
            XB_SPIN(xb_ld(&bar[XB_XGEN(b.x)]) == gen, bar);
            __builtin_amdgcn_fence(__ATOMIC_ACQUIRE, "agent");
            asm volatile("s_waitcnt vmcnt(0)" ::: "memory");
        }
    }
    __syncthreads();
}


constexpr int NWAVES = 8;
constexpr int RING_BYTES = 131072;
constexpr int LDSCTL_OFF = RING_BYTES, MISC_OFF = LDSCTL_OFF + 320;
constexpr int LDS_TS_OFF = LDSCTL_OFF + 1024;
constexpr int LDS_TE_OFF = LDSCTL_OFF + 2048;
constexpr int LDS_CNT_OFF = LDSCTL_OFF + 1024 + 128;
constexpr int LDS_BYTES = 163840;

typedef short s16x4 __attribute__((ext_vector_type(4)));
typedef unsigned u32x2 __attribute__((ext_vector_type(2)));

struct Args { const float* in[20]; float* out; unsigned char* ws; unsigned mask; int bar_region; };

__device__ __forceinline__ float bflo(unsigned w) { return __uint_as_float(w << 16); }
__device__ __forceinline__ float bfhi(unsigned w) { return __uint_as_float(w & 0xffff0000u); }
__device__ __forceinline__ unsigned cvtpk(float lo, float hi) { return pg8::cvt_pk_bf16(lo, hi); }
__device__ __forceinline__ float wave_sum(float v) {
#pragma unroll
    for (int o = 1; o < 64; o <<= 1) v += __shfl_xor(v, o);
    return v;
}
__device__ __forceinline__ unsigned offb(unsigned row, unsigned ch) { return 256u * row + 16u * (ch ^ (((row & 3u) << 2) | ((row >> 2) & 3u))); }
__device__ __forceinline__ s16x4 ldtr(const LAS unsigned char* p) { return __builtin_amdgcn_ds_read_tr16_b64_v4i16((LAS s16x4*)p); }
__device__ __forceinline__ bf16x8 cat8(s16x4 a, s16x4 b) { return (bf16x8){a[0], a[1], a[2], a[3], b[0], b[1], b[2], b[3]}; }
#define MFMA16(a, b, c) __builtin_amdgcn_mfma_f32_16x16x32_bf16((a), (b), (c), 0, 0, 0)

template <int MODE> __device__ __forceinline__ int dest_row(int n) {
    if (MODE == 1) { if (n >= 1024) return n; const int hb = n & ~127, d = n & 127, jr = d & 63, half = d >> 6; return hb + 8 * (jr >> 2) + 4 * half + (jr & 3); }
    if (MODE == 2) return ((n >> 2) << 3) + (n & 3);
    if (MODE == 3) return ((n >> 2) << 3) + 4 + (n & 3);
    return n;
}
template <int MODE> __device__ __forceinline__ void p0_transpose_item(const float* W, int K, int N, bf16* WT, LAS float* scr, int item, int lane) {
    const int nblk = N / 32, kb = item / nblk, nb = item % nblk, k0 = 64 * kb, n0 = 32 * nb;
    {
        const GAS f32x4* src = (const GAS f32x4*)(W + (size_t)(k0 + (lane >> 3)) * N + n0) + (lane & 7);
        f32x4 t[8];
#pragma unroll
        for (int j = 0; j < 8; ++j) t[j] = src[(size_t)j * 2 * N];
#pragma unroll
        for (int j = 0; j < 8; ++j) { LAS float* d = scr + ((lane >> 3) + 8 * j) * 33 + 4 * (lane & 7); d[0] = t[j].x; d[1] = t[j].y; d[2] = t[j].z; d[3] = t[j].w; }
    }
    LDS_WAIT(); asm volatile("" ::: "memory");
    const int c = lane & 7;
#pragma unroll
    for (int j = 0; j < 4; ++j) { const int n = (lane >> 3) + 8 * j; const LAS float* s = scr + (8 * c) * 33 + n;
        v4u o; o.x = pk2(s[0 * 33], s[1 * 33]); o.y = pk2(s[2 * 33], s[3 * 33]); o.z = pk2(s[4 * 33], s[5 * 33]); o.w = pk2(s[6 * 33], s[7 * 33]);
        *(GAS v4u*)(WT + (size_t)dest_row<MODE>(n0 + n) * K + k0 + 8 * c) = o; }
    LDS_WAIT(); asm volatile("" ::: "memory");
}
__device__ __forceinline__ unsigned pk_fp8x4(float a, float b, float c, float d) {
    a = fminf(fmaxf(a, -448.f), 448.f); b = fminf(fmaxf(b, -448.f), 448.f); c = fminf(fmaxf(c, -448.f), 448.f); d = fminf(fmaxf(d, -448.f), 448.f);
    unsigned w = 0u; w = __builtin_amdgcn_cvt_pk_fp8_f32(a, b, w, false); w = __builtin_amdgcn_cvt_pk_fp8_f32(c, d, w, true); return w;
}
template <int MODE> __device__ __forceinline__ void p0_transpose_item_fp8(const float* W, int K, int N, unsigned char* WT, LAS float* scr, int item, int lane, float scale) {
    const int nblk = N / 32, kb = item / nblk, nb = item % nblk, k0 = 64 * kb, n0 = 32 * nb;
    {
        const GAS f32x4* src = (const GAS f32x4*)(W + (size_t)(k0 + (lane >> 3)) * N + n0) + (lane & 7);
        f32x4 t[8];
#pragma unroll
        for (int j = 0; j < 8; ++j) t[j] = src[(size_t)j * 2 * N];
#pragma unroll
        for (int j = 0; j < 8; ++j) { LAS float* d = scr + ((lane >> 3) + 8 * j) * 33 + 4 * (lane & 7); d[0] = t[j].x; d[1] = t[j].y; d[2] = t[j].z; d[3] = t[j].w; }
    }
    LDS_WAIT(); asm volatile("" ::: "memory");
    const int c = lane & 7;
#pragma unroll
    for (int j = 0; j < 4; ++j) { const int n = (lane >> 3) + 8 * j; const LAS float* s = scr + (8 * c) * 33 + n;
        u32x2 o; o.x = pk_fp8x4(s[0 * 33] * scale, s[1 * 33] * scale, s[2 * 33] * scale, s[3 * 33] * scale); o.y = pk_fp8x4(s[4 * 33] * scale, s[5 * 33] * scale, s[6 * 33] * scale, s[7 * 33] * scale);
        *(GAS u32x2*)(WT + (size_t)dest_row<MODE>(n0 + n) * K + k0 + 8 * c) = o; }
    LDS_WAIT(); asm volatile("" ::: "memory");
}
__device__ __forceinline__ int t5_bucket(int rel) {
    const int n = rel < 0 ? -rel : rel;
    int large = 8 + (n >= 15) + (n >= 27) + (n >= 50) + (n >= 91) + (n >= 166) + (n >= 305) + (n >= 559);
    large = large < 15 ? large : 15;
    return (rel > 0 ? 16 : 0) + (n < 8 ? n : large);
}
__device__ __forceinline__ void p0_prologue(const Args& a, LAS unsigned char* lds, int vcu, int G, int tid, int wave, int lane) {
    unsigned char* ws = a.ws;
    LAS float* scr = (LAS float*)(lds + wave * 16384);
    const int gw = vcu * NWAVES + wave, NGW = G * NWAVES;
    constexpr int I_IN = 16 * 208, I_R = 16 * 32, I_A = 8 * 32, I_O = 16 * 32;
    constexpr int NITEMS = I_IN + I_R + I_A + I_O;
    for (int it = gw; it < NITEMS; it += NGW) {
        int r = it;
#if P1_FP8
        if (r < I_IN) { if ((GATE_FP8 || r % 208 < 144) && r % 208 >= 8 * P1_FP8_FROM) p0_transpose_item_fp8<1>(a.in[1], 1024, 6656, ws + WS_WIN8, scr, r, lane, 64.f);
                        else p0_transpose_item<1>(a.in[1], 1024, 6656, (bf16*)(ws + WS_WIN), scr, r, lane); continue; } r -= I_IN;
#else
        if (r < I_IN) { p0_transpose_item<1>(a.in[1], 1024, 6656, (bf16*)(ws + WS_WIN), scr, r, lane); continue; } r -= I_IN;
#endif
        if (r < I_R) { if (MIX_FP8 & 4) p0_transpose_item_fp8<0>(a.in[5], 1024, 1024, ws + WS_WR, scr, r, lane, 64.f); else p0_transpose_item<0>(a.in[5], 1024, 1024, (bf16*)(ws + WS_WR), scr, r, lane); continue; } r -= I_R;
        if (r < I_A) { if (MIX_FP8 & 2) p0_transpose_item_fp8<0>(a.in[7], 512, 1024, ws + WS_WA, scr, r, lane, 64.f); else p0_transpose_item<0>(a.in[7], 512, 1024, (bf16*)(ws + WS_WA), scr, r, lane); continue; } r -= I_A;
        if (MIX_FP8 & 1) p0_transpose_item_fp8<0>(a.in[8], 1024, 1024, ws + WS_WO, scr, r, lane, 64.f); else p0_transpose_item<0>(a.in[8], 1024, 1024, (bf16*)(ws + WS_WO), scr, r, lane);
    }
    {
        const f32x4* x4 = (const f32x4*)a.in[0]; u32x2* xb = (u32x2*)(ws + WS_XB);
#if P1_FP8
#if GATE_FP8
        unsigned* xf8 = (unsigned*)(ws + WS_X8_LO);
#define XF8_AT(i) xf8[(long)(i) + ((i) >= (size_t)16384 * 256 ? ((long)WS_X8_HI - (long)WS_X8_LO - (long)(16 * MiB)) / 4 : 0L)]
#else
        unsigned* xf8 = (unsigned*)a.out;
#define XF8_AT(i) xf8[i]
#endif
        const size_t n4 = (size_t)TT * DM / 4, st = (size_t)G * 512; size_t i = (size_t)vcu * 512 + tid;
        for (; i + 7 * st < n4; i += 8 * st) {
            f32x4 v[8];
#pragma unroll
            for (int u = 0; u < 8; ++u) v[u] = x4[i + u * st];
#pragma unroll
            for (int u = 0; u < 8; ++u) { if (!X_F32_RES) { u32x2 o; o.x = cvtpk(v[u].x, v[u].y); o.y = cvtpk(v[u].z, v[u].w); xb[i + u * st] = o; } XF8_AT(i + u * st) = pk_fp8x4(v[u].x, v[u].y, v[u].z, v[u].w); }
        }
        for (; i < n4; i += st) { const f32x4 v = x4[i]; if (!X_F32_RES) { u32x2 o; o.x = cvtpk(v.x, v.y); o.y = cvtpk(v.z, v.w); xb[i] = o; } XF8_AT(i) = pk_fp8x4(v.x, v.y, v.z, v.w); }
#undef XF8_AT
#else
        for (size_t i = (size_t)vcu * 512 + tid; i < (size_t)TT * DM / 4; i += (size_t)G * 512) { const f32x4 v = x4[i]; u32x2 o; o.x = cvtpk(v.x, v.y); o.y = cvtpk(v.z, v.w); xb[i] = o; }
#endif
    }
    {
        float* rot = (float*)(ws + WS_ROT);
        for (int idx = vcu * 512 + tid; idx < SEQ * 64; idx += G * 512) {
            const int pos = idx >> 6, jr = idx & 63;
            double iv = 1.0; for (int k = 0; k < jr; ++k) iv *= 0.86596432336006535;
            const float ang = (float)pos * (float)iv;
            const double xx = (double)ang; const double qd = __builtin_rint(xx * 0.63661977236758134); const int qi = (int)qd;
            const double r = (xx - qd * 1.5707963267948966) - qd * 6.123233995736766e-17, r2 = r * r;
            const double sp = r * (1.0 + r2 * (-1.0 / 6 + r2 * (1.0 / 120 + r2 * (-1.0 / 5040 + r2 * (1.0 / 362880 + r2 * (-1.0 / 39916800 + r2 * (1.0 / 6227020800.0)))))));
            const double cp = 1.0 + r2 * (-0.5 + r2 * (1.0 / 24 + r2 * (-1.0 / 720 + r2 * (1.0 / 40320 + r2 * (-1.0 / 3628800 + r2 * (1.0 / 479001600.0))))));
            const int qq = qi & 3; const double s = qq == 0 ? sp : (qq == 1 ? cp : (qq == 2 ? -sp : -cp)), c = qq == 0 ? cp : (qq == 1 ? -sp : (qq == 2 ? -cp : sp));
            float* o = rot + ((size_t)pos * 16 + (jr >> 2)) * 8 + (jr & 3); o[0] = (float)c; o[4] = (float)s;
        }
    }
    if (vcu == 0) {
        float* bt = (float*)(ws + WS_BIAS); const float* rb = a.in[6];
        for (int idx = tid; idx < 3 * 8 * 160; idx += 512) { const int p = idx / (8 * 160), h = (idx / 160) % 8, d = idx % 160 - 80; const int dil = p == 0 ? 1 : (p == 1 ? 4 : 16);
            bt[idx] = (d >= -64 && d <= 64) ? rb[t5_bucket(d * dil) * 8 + h] * 1.4426950408889634f : -1e30f; }
    }
}
__device__ __forceinline__ void p0_expert_weights(const Args& a, LAS unsigned char* lds, int vcu, int G, int wave, int lane) {
    unsigned char* ws = a.ws;
    LAS float* scr = (LAS float*)(lds + wave * 16384);
    const int gw = vcu * NWAVES + wave, NGW = G * NWAVES;
    constexpr int I_G = 16 * 16, I_D = 8 * 32, PER_E = 2 * I_G + I_D;
    for (int it = gw; it < 16 * PER_E; it += NGW) {
        const int e = it / PER_E; int r = it - e * PER_E;
#if M1_FP8
        if (r < I_G) { p0_transpose_item_fp8<2>(a.in[15] + (size_t)e * 1024 * 512, 1024, 512, ws + WS_WGU + (size_t)e * 1024 * 1024, scr, r, lane, 64.f); continue; } r -= I_G;
        if (r < I_G) { p0_transpose_item_fp8<3>(a.in[16] + (size_t)e * 1024 * 512, 1024, 512, ws + WS_WGU + (size_t)e * 1024 * 1024, scr, r, lane, 64.f); continue; } r -= I_G;
#else
        if (r < I_G) { p0_transpose_item<2>(a.in[15] + (size_t)e * 1024 * 512, 1024, 512, (bf16*)(ws + WS_WGU) + (size_t)e * 1024 * 1024, scr, r, lane); continue; } r -= I_G;
        if (r < I_G) { p0_transpose_item<3>(a.in[16] + (size_t)e * 1024 * 512, 1024, 512, (bf16*)(ws + WS_WGU) + (size_t)e * 1024 * 1024, scr, r, lane); continue; } r -= I_G;
#endif
        p0_transpose_item_fp8<0>(a.in[17] + (size_t)e * 512 * 1024, 512, 1024, ws + WS_WD + (size_t)e * 1024 * 512, scr, r, lane, 64.f);
    }
    __syncthreads();
}

__device__ __forceinline__ float log2_gamma(const float* dec, int h) {
    const float x = dec[h]; return -__log2f(1.f + __expf(-x));
}
__device__ __forceinline__ void chain_item(const Args& a, LAS unsigned char* lds, int item, int tid, int wid, int lane) {
    unsigned char* ws = a.ws;
    const int b = item >> 4, h = (item >> 2) & 3, dir = (item >> 1) & 1, vh = item & 1;
    const float lg2 = log2_gamma(dir ? a.in[3] : a.in[2], h);
    const float cd = __builtin_amdgcn_exp2f(lg2 * 128.f);
    const int g = lane >> 4, i16 = lane & 15, q = i16 >> 2, p = lane & 3;
    const int wd = wid >> 1, wv = wid & 1;
    const GAS bf16* kr = (const GAS bf16*)(ws + WS_KR); const GAS bf16* vr = (const GAS bf16*)(ws + WS_VR);
    GAS bf16* states = (GAS bf16*)a.out;
    f32x4 acc[2][4];
#pragma unroll
    for (int i = 0; i < 2; ++i)
#pragma unroll
        for (int j = 0; j < 4; ++j) acc[i][j] = (f32x4){0.f, 0.f, 0.f, 0.f};
    const int srow = tid >> 4, sch = tid & 15; const unsigned soff = offb(srow, sch);
    const GAS bf16* kp = kr + ((size_t)b * SEQ + srow) * 512 + h * 128 + sch * 8;
    const GAS bf16* vp = vr + ((size_t)b * SEQ + srow) * 1024 + h * 256 + vh * 128 + sch * 8;
    v4u kq[4], vq[4];
    { const int n0 = dir ? 15 : 0;
#pragma unroll
      for (int j = 0; j < 4; ++j) { kq[j] = *(const GAS v4u*)(kp + (size_t)(n0 * 128 + 32 * j) * 512); vq[j] = *(const GAS v4u*)(vp + (size_t)(n0 * 128 + 32 * j) * 1024); } }
    unsigned abase[2][2], bbase[4][2];
#pragma unroll
    for (int t = 0; t < 2; ++t) { const unsigned r = 8 * g + 4 * t + q;
#pragma unroll
        for (int dt = 0; dt < 2; ++dt) abase[dt][t] = offb(r, 2 * (2 * wd + dt) + (p >> 1)) + 8 * (p & 1);
#pragma unroll
        for (int vt = 0; vt < 4; ++vt) bbase[vt][t] = offb(r, 2 * (4 * wv + vt) + (p >> 1)) + 8 * (p & 1); }
#define CH_STAGE(BUFOFF) do { _Pragma("unroll") for (int j = 0; j < 4; ++j) { \
            const int row = srow + 32 * j; const float z = __builtin_amdgcn_exp2f(lg2 * (float)(dir ? row : 127 - row)); const v4u kv = kq[j]; \
            v4u ko; ko.x = cvtpk(bflo(kv.x) * z, bfhi(kv.x) * z); ko.y = cvtpk(bflo(kv.y) * z, bfhi(kv.y) * z); ko.z = cvtpk(bflo(kv.z) * z, bfhi(kv.z) * z); ko.w = cvtpk(bflo(kv.w) * z, bfhi(kv.w) * z); \
            *(LAS v4u*)(lds + (BUFOFF) + soff + j * 8192) = ko; *(LAS v4u*)(lds + (BUFOFF) + 32768 + soff + j * 8192) = vq[j]; } } while (0)
#define CH_FETCH(NN) do { _Pragma("unroll") for (int j = 0; j < 4; ++j) { kq[j] = *(const GAS v4u*)(kp + (size_t)((NN) * 128 + 32 * j) * 512); vq[j] = *(const GAS v4u*)(vp + (size_t)((NN) * 128 + 32 * j) * 1024); } } while (0)
#define CH_STEP(STEP, CUR, OTH) do { const int step_ = (STEP); const int n_ = dir ? 15 - step_ : step_; \
        GAS bf16* sb_ = states + ((((size_t)(b * 4 + h) * 16 + n_) * 2 + dir) * 256) * 128; \
        _Pragma("unroll") for (int dt = 0; dt < 2; ++dt) _Pragma("unroll") for (int vt = 0; vt < 4; ++vt) { \
            const int v_ = vh * 128 + 64 * wv + 16 * vt + i16, d0_ = 32 * wd + 16 * dt + 4 * g; \
            u32x2 w_; w_.x = pg8::cvt_pk_bf16_acc(acc[dt][vt][0], acc[dt][vt][1]); w_.y = pg8::cvt_pk_bf16_acc(acc[dt][vt][2], acc[dt][vt][3]);   \
            *(GAS u32x2*)(sb_ + (size_t)v_ * 128 + d0_) = w_; } \
        if (step_ < 15) CH_STAGE(OTH); \
        if (step_ < 14) CH_FETCH(dir ? 13 - step_ : step_ + 2); \
        _Pragma("unroll") for (int i = 0; i < 2; ++i) _Pragma("unroll") for (int j = 0; j < 4; ++j) acc[i][j] = acc[i][j] * cd; \
        _Pragma("unroll") for (int ks = 0; ks < 4; ++ks) { bf16x8 af[2], bfr[4]; \
            _Pragma("unroll") for (int dt = 0; dt < 2; ++dt) af[dt] = cat8(ldtr(lds + (CUR) + abase[dt][0] + ks * 8192), ldtr(lds + (CUR) + abase[dt][1] + ks * 8192)); \
            _Pragma("unroll") for (int vt = 0; vt < 4; ++vt) bfr[vt] = cat8(ldtr(lds + (CUR) + 32768 + bbase[vt][0] + ks * 8192), ldtr(lds + (CUR) + 32768 + bbase[vt][1] + ks * 8192)); \
            _Pragma("unroll") for (int dt = 0; dt < 2; ++dt) _Pragma("unroll") for (int vt = 0; vt < 4; ++vt) acc[dt][vt] = MFMA16(af[dt], bfr[vt], acc[dt][vt]); } \
        __syncthreads(); } while (0)
    CH_STAGE(0);
    CH_FETCH(dir ? 14 : 1);
    __syncthreads();
    for (int sp = 0; sp < 8; ++sp) { CH_STEP(2 * sp, 0, 65536); CH_STEP(2 * sp + 1, 65536, 0); }
#undef CH_STEP
#undef CH_STAGE
#undef CH_FETCH
}

constexpr int AT_OST = 135168, AT_SCR = AT_OST + 8 * 2048;
constexpr int ATB_N = 160;
struct AttnLane { unsigned kb[2]; unsigned vb[4]; };
__device__ __forceinline__ AttnLane attn_lane(int lane) {
    const int g = lane >> 4, i16 = lane & 15, q4 = i16 >> 2, p = lane & 3; AttnLane L;
#pragma unroll
    for (int s = 0; s < 2; ++s) L.kb[s] = i16 * 128 + (((4 * s + g) ^ ((i16 >> 1) & 7)) * 16);
    const int sw = (2 * g + (q4 >> 1)) & 3;
#pragma unroll
    for (int c = 0; c < 4; ++c) L.vb[c] = (4 * g + q4) * 128 + ((c ^ sw) * 32) + p * 8;
    return L;
}
__device__ __forceinline__ unsigned kimg_off(int row, int c) { return row * 128 + ((c ^ ((row >> 1) & 7)) * 16); }
__device__ __forceinline__ unsigned vimg_off(int row, int c) { return row * 128 + (((c >> 1) ^ ((row >> 1) & 3)) * 32) + (c & 1) * 16; }
__device__ __forceinline__ void attn_core(const LAS unsigned char* Kimg, const LAS unsigned char* Vimg, int R0, int nrows, unsigned tvalid, const bf16x8 (&qf)[2],
                                          const float (&biasr)[36], const AttnLane& L, f32x4 (&O)[4], float& mx, float& lsum) {
    f32x4 D[9];
#pragma unroll
    for (int kt = 0; kt < 9; ++kt) {
        int R = R0 + 16 * kt; R = R < 0 ? 0 : (R > nrows - 16 ? nrows - 16 : R);
        const LAS unsigned char* kp = Kimg + R * 128;
        const bf16x8 k0 = *(const LAS bf16x8*)(kp + L.kb[0]), k1 = *(const LAS bf16x8*)(kp + L.kb[1]);
        f32x4 d = (f32x4){0.f, 0.f, 0.f, 0.f};
        d = MFMA16(k0, qf[0], d); d = MFMA16(k1, qf[1], d); D[kt] = d;
    }
    mx = -1e30f;
#pragma unroll
    for (int kt = 0; kt < 9; ++kt) {
        const float tb = ((tvalid >> kt) & 1u) ? 0.f : -1e30f;
#pragma unroll
        for (int r = 0; r < 4; ++r) { const float x = D[kt][r] + (biasr[4 * kt + r] + tb); D[kt][r] = x; mx = fmaxf(mx, x); }
    }
    mx = fmaxf(mx, __shfl_xor(mx, 16)); mx = fmaxf(mx, __shfl_xor(mx, 32));
    lsum = 0.f;
#pragma unroll
    for (int kt = 0; kt < 9; ++kt)
#pragma unroll
        for (int r = 0; r < 4; ++r) { const float e = __builtin_amdgcn_exp2f(D[kt][r] - mx); D[kt][r] = e; lsum += e; }
    lsum += __shfl_xor(lsum, 16); lsum += __shfl_xor(lsum, 32);
#pragma unroll
    for (int c = 0; c < 4; ++c) O[c] = (f32x4){0.f, 0.f, 0.f, 0.f};
#pragma unroll
    for (int kk = 0; kk < 5; ++kk) {
        int Ra = R0 + 32 * kk; Ra = Ra < 0 ? 0 : (Ra > nrows - 16 ? nrows - 16 : Ra);
        int Rb = R0 + 32 * kk + 16; Rb = Rb < 0 ? 0 : (Rb > nrows - 16 ? nrows - 16 : Rb);
        if (kk == 4) Rb = Ra;
        const f32x4 e0 = D[2 * kk], e1 = kk < 4 ? D[2 * kk + 1] : (f32x4){0.f, 0.f, 0.f, 0.f};
        v4u pw; pw.x = cvtpk(e0[0], e0[1]); pw.y = cvtpk(e0[2], e0[3]); pw.z = cvtpk(e1[0], e1[1]); pw.w = cvtpk(e1[2], e1[3]);
        const bf16x8 pf = __builtin_bit_cast(bf16x8, pw);
        const LAS unsigned char* va_ = Vimg + Ra * 128; const LAS unsigned char* vb_ = Vimg + Rb * 128;
#pragma unroll
        for (int c = 0; c < 4; ++c) O[c] = MFMA16(pf, cat8(ldtr(va_ + L.vb[c]), ldtr(vb_ + L.vb[c])), O[c]);
    }
}
__device__ __forceinline__ void attn_stage_out(LAS unsigned char* lds, int wid, int lane, const f32x4 (&O)[4], float lsum) {
    const int g = lane >> 4, i16 = lane & 15;
    const float linv = 1.f / lsum;
    LAS bf16* st = (LAS bf16*)(lds + AT_OST + wid * 2048);
#pragma unroll
    for (int r = 0; r < 4; ++r) { const float li = __shfl(linv, 4 * g + r);
#pragma unroll
        for (int c = 0; c < 4; ++c) st[(4 * g + r) * 64 + 16 * c + i16] = (bf16)(cvtpk(O[c][r] * li, 0.f) & 0xffffu); }
}
__device__ __forceinline__ void attn_load_bias(const Args& a, int pat, int h, int lane, float (&biasr)[36]) {
    const GAS float* bt = (const GAS float*)(a.ws + WS_BIAS) + (pat * 8 + h) * ATB_N; const int g = lane >> 4, i16 = lane & 15;
#pragma unroll
    for (int kt = 0; kt < 9; ++kt)
#pragma unroll
        for (int r = 0; r < 4; ++r) biasr[4 * kt + r] = bt[16 * kt + 4 * g + r - 64 - i16 + 80];
}
template <int DIL, int VAR = 0> __device__ __forceinline__ void attn_dil_phase(const Args& a, LAS unsigned char* lds, int vcu, int G, int tid, int wid, int lane) {
    unsigned char* ws = a.ws;
    constexpr int NR = SEQ / DIL, PAT = DIL == 4 ? 1 : 2, CH = NR * 8 / 512, NITEM = NB * 8 * DIL;
    constexpr int NBUF = DIL == 16 ? 2 : 1, BUFB = 2 * NR * 128;
    const GAS bf16* qa = (const GAS bf16*)(ws + WS_QA); const GAS bf16* ka = (const GAS bf16*)(ws + WS_KA); const GAS bf16* va = (const GAS bf16*)(ws + WS_VA);
    bf16* op = (bf16*)(ws + (DIL == 4 ? WS_O2 : WS_O3)); float* lsep = (float*)(ws + (DIL == 4 ? WS_LSE2 : WS_LSE3));
    if (vcu >= NITEM) return;
    const int h = vcu & 7;
    float biasr[36]; attn_load_bias(a, PAT, h, lane, biasr);
    const AttnLane L = attn_lane(lane);
    const int g = lane >> 4, i16 = lane & 15;
    v4u kq[CH], vq[CH]; bf16x8 qn[2];
    auto issue = [&](int item, int gi) {
        const int rho = (item >> 3) % DIL, b = item / (8 * DIL); const size_t rowb = (size_t)b * SEQ;
#pragma unroll
        for (int j = 0; j < CH; ++j) { const int id = tid + 512 * j, row = id >> 3, c = id & 7; const size_t go = (rowb + (size_t)row * DIL + rho) * 512 + h * 64 + c * 8;
            kq[j] = *(const GAS v4u*)(ka + go); vq[j] = *(const GAS v4u*)(va + go); }
        const size_t qpos = rowb + (size_t)(16 * gi + i16) * DIL + rho;
#pragma unroll
        for (int s = 0; s < 2; ++s) qn[s] = *(const GAS bf16x8*)(qa + qpos * 512 + h * 64 + 32 * s + 8 * g);
    };
    issue(vcu, wid);
    int buf = 0;
    for (int item = vcu; item < NITEM; item += G) {
        const int rho = (item >> 3) % DIL, b = item / (8 * DIL); const size_t rowb = (size_t)b * SEQ;
        LAS unsigned char* Kimg = lds + buf * BUFB; LAS unsigned char* Vimg = Kimg + NR * 128;
        if (NBUF == 1) __syncthreads();
#pragma unroll
        for (int j = 0; j < CH; ++j) { const int id = tid + 512 * j, row = id >> 3, c = id & 7;
            *(LAS v4u*)(Kimg + kimg_off(row, c)) = kq[j]; *(LAS v4u*)(Vimg + vimg_off(row, c)) = vq[j]; }
        bf16x8 qf[2] = {qn[0], qn[1]};
        __syncthreads();
        if (NBUF == 2 && item + G < NITEM) issue(item + G, wid);
        for (int gi = wid; gi < NR / 16; gi += 8) {
            const int m0 = 16 * gi;
            if (NBUF == 1 && gi + 8 < NR / 16) {
                const size_t qpos = rowb + (size_t)(m0 + 128 + i16) * DIL + rho;
#pragma unroll
                for (int s = 0; s < 2; ++s) qn[s] = *(const GAS bf16x8*)(qa + qpos * 512 + h * 64 + 32 * s + 8 * g); }
            unsigned tvalid = 0u;
#pragma unroll
            for (int kt = 0; kt < 9; ++kt) { const int t0 = m0 - 64 + 16 * kt; tvalid |= (t0 >= 0 && t0 < NR) ? (1u << kt) : 0u; }
            f32x4 O[4]; float mx, lsum;
            if (VAR == 1) { mx = 0.f; lsum = 1.f;
#pragma unroll
                for (int c = 0; c < 4; ++c) O[c] = (f32x4){__builtin_bit_cast(float, qf[0][0] + c), 0.f, 0.f, 0.f}; }
            else attn_core(Kimg, Vimg, m0 - 64, NR, tvalid, qf, biasr, L, O, mx, lsum);
            attn_stage_out(lds, wid, lane, O, lsum);
            if (g == 0) lsep[(rowb + (size_t)(m0 + i16) * DIL + rho) * 8 + h] = mx + __log2f(lsum);
            asm volatile("s_waitcnt lgkmcnt(0)" ::: "memory");
            { const int q = lane >> 2, qt = lane & 3; const LAS v4u* sp = (const LAS v4u*)(lds + AT_OST + wid * 2048 + q * 128 + qt * 32);
              const v4u x0 = sp[0], x1 = sp[1]; bf16* dst = op + (rowb + (size_t)(m0 + q) * DIL + rho) * 512 + h * 64 + qt * 16;
              *(v4u*)dst = x0; *(v4u*)(dst + 8) = x1; }
            asm volatile("s_waitcnt lgkmcnt(0)" ::: "memory");
            if (NBUF == 1) { qf[0] = qn[0]; qf[1] = qn[1]; }
        }
        if (NBUF == 1 && item + G < NITEM) issue(item + G, wid);
        buf ^= (NBUF - 1);
    }
    __syncthreads();
}
__device__ __forceinline__ void attn_p1_phase(const Args& a, LAS unsigned char* lds, int vcu, int G, int tid, int wid, int lane) {
    unsigned char* ws = a.ws;
    LAS unsigned char* Kimg = lds; LAS unsigned char* Vimg = lds + 384 * 128;
    const GAS bf16* qa = (const GAS bf16*)(ws + WS_QA); const GAS bf16* ka = (const GAS bf16*)(ws + WS_KA); const GAS bf16* va = (const GAS bf16*)(ws + WS_VA);
    const GAS bf16* o2 = (const GAS bf16*)(ws + WS_O2); const GAS bf16* o3 = (const GAS bf16*)(ws + WS_O3);
    const GAS float* lse2 = (const GAS float*)(ws + WS_LSE2); const GAS float* lse3 = (const GAS float*)(ws + WS_LSE3);
    bf16* oa = (bf16*)(ws + WS_OA);
    if (vcu >= 1024) return;
    const int h = vcu & 7;
    float biasr[36]; attn_load_bias(a, 0, h, lane, biasr);
    const AttnLane L = attn_lane(lane);
    const int g = lane >> 4, i16 = lane & 15;
    LAS float* scr = (LAS float*)(lds + AT_SCR) + wid * 16;
    v4u kq[6], vq[6];
    auto issue = [&](int item) { const int b = item >> 6, s0 = ((item >> 3) & 7) * 256; const size_t rowb = (size_t)b * SEQ;
#pragma unroll
        for (int j = 0; j < 6; ++j) { const int id = tid + 512 * j, row = id >> 3, c = id & 7, pos = s0 - 64 + row; const bool ok = pos >= 0 && pos < SEQ;
            const size_t go = (rowb + (size_t)(ok ? pos : 0)) * 512 + h * 64 + c * 8;
            kq[j] = *(const GAS v4u*)(ka + go); vq[j] = *(const GAS v4u*)(va + go);
            if (!ok) { kq[j] = (v4u){0u, 0u, 0u, 0u}; vq[j] = (v4u){0u, 0u, 0u, 0u}; } } };
    issue(vcu);
    for (int item = vcu; item < 1024; item += G) {
        const int b = item >> 6, s0 = ((item >> 3) & 7) * 256; const size_t rowb = (size_t)b * SEQ;
        __syncthreads();
#pragma unroll
        for (int j = 0; j < 6; ++j) { const int id = tid + 512 * j, row = id >> 3, c = id & 7;
            *(LAS v4u*)(Kimg + kimg_off(row, c)) = kq[j]; *(LAS v4u*)(Vimg + vimg_off(row, c)) = vq[j]; }
        __syncthreads();
        if (item + G < 1024) issue(item + G);
        for (int gi = wid; gi < 16; gi += 8) {
            const int m0 = s0 + 16 * gi;
            const int q = lane >> 2, qt = lane & 3; const size_t tq = rowb + m0 + q;
            const v4u a20 = *(const GAS v4u*)(o2 + tq * 512 + h * 64 + qt * 16), a21 = *(const GAS v4u*)(o2 + tq * 512 + h * 64 + qt * 16 + 8);
            const v4u a30 = *(const GAS v4u*)(o3 + tq * 512 + h * 64 + qt * 16), a31 = *(const GAS v4u*)(o3 + tq * 512 + h * 64 + qt * 16 + 8);
            const float l2 = lse2[tq * 8 + h], l3 = lse3[tq * 8 + h];
            bf16x8 qf[2];
#pragma unroll
            for (int s = 0; s < 2; ++s) qf[s] = *(const GAS bf16x8*)(qa + (rowb + m0 + i16) * 512 + h * 64 + 32 * s + 8 * g);
            unsigned tvalid = 0u;
#pragma unroll
            for (int kt = 0; kt < 9; ++kt) { const int t0 = m0 - 64 + 16 * kt; tvalid |= (t0 >= 0 && t0 < SEQ) ? (1u << kt) : 0u; }
            f32x4 O[4]; float mx, lsum;
            attn_core(Kimg, Vimg, 16 * gi, 384, tvalid, qf, biasr, L, O, mx, lsum);
            attn_stage_out(lds, wid, lane, O, lsum);
            if (g == 0) scr[i16] = mx + __log2f(lsum);
            asm volatile("s_waitcnt lgkmcnt(0)" ::: "memory");
            {
                const float l1 = scr[q], M = fmaxf(l1, fmaxf(l2, l3));
                float w1 = __builtin_amdgcn_exp2f(l1 - M), w2 = __builtin_amdgcn_exp2f(l2 - M), w3 = __builtin_amdgcn_exp2f(l3 - M); const float wi = 1.f / (w1 + w2 + w3); w1 *= wi; w2 *= wi; w3 *= wi;
                const LAS v4u* sp = (const LAS v4u*)(lds + AT_OST + wid * 2048 + q * 128 + qt * 32);
                const v4u x0 = sp[0], x1 = sp[1];
                v4u r0, r1;
#define MRG(d, x, y, z) d = cvtpk(w1 * bflo(x) + w2 * bflo(y) + w3 * bflo(z), w1 * bfhi(x) + w2 * bfhi(y) + w3 * bfhi(z))
                MRG(r0.x, x0.x, a20.x, a30.x); MRG(r0.y, x0.y, a20.y, a30.y); MRG(r0.z, x0.z, a20.z, a30.z); MRG(r0.w, x0.w, a20.w, a30.w);
                MRG(r1.x, x1.x, a21.x, a31.x); MRG(r1.y, x1.y, a21.y, a31.y); MRG(r1.z, x1.z, a21.z, a31.z); MRG(r1.w, x1.w, a21.w, a31.w);
#undef MRG
#if MIX_FP8 & 2
                v4u o8;
                o8.x = pk_fp8x4(16.f * bflo(r0.x), 16.f * bfhi(r0.x), 16.f * bflo(r0.y), 16.f * bfhi(r0.y)); o8.y = pk_fp8x4(16.f * bflo(r0.z), 16.f * bfhi(r0.z), 16.f * bflo(r0.w), 16.f * bfhi(r0.w));
                o8.z = pk_fp8x4(16.f * bflo(r1.x), 16.f * bfhi(r1.x), 16.f * bflo(r1.y), 16.f * bfhi(r1.y)); o8.w = pk_fp8x4(16.f * bflo(r1.z), 16.f * bfhi(r1.z), 16.f * bflo(r1.w), 16.f * bfhi(r1.w));
                *(v4u*)((unsigned char*)oa + tq * 512 + h * 64 + qt * 16) = o8;
#else
                bf16* dst = oa + tq * 512 + h * 64 + qt * 16;
                *(v4u*)dst = r0; *(v4u*)(dst + 8) = r1;
#endif
            }
            asm volatile("s_waitcnt lgkmcnt(0)" ::: "memory");
        }
    }
    __syncthreads();
}

#define OPAQUE(x) asm volatile("" : "+v"(x))
template <int VAR = 0> __device__ __forceinline__ void p3_phase(const Args& a, LAS unsigned char* lds, int vcu, int G, int tid, int wid, int lane) {
    unsigned char* ws = a.ws;
    const int g = lane >> 4, i16 = lane & 15, q4 = i16 >> 2, p = lane & 3;
    const GAS bf16* qr = (const GAS bf16*)(ws + WS_QR); const GAS bf16* kr = (const GAS bf16*)(ws + WS_KR); const GAS bf16* vr = (const GAS bf16*)(ws + WS_VR);
    GAS bf16* gr = (GAS bf16*)(ws + WS_GR);
    LAS unsigned char* Kt = lds; LAS unsigned char* Sg = lds + 32768;
    if (vcu >= 1024) return;
    const unsigned kdst = offb(tid >> 4, tid & 15);
    unsigned rfo[4];
    { const unsigned X = ((i16 & 3) << 2) | (i16 >> 2);
#pragma unroll
      for (int s = 0; s < 4; ++s) rfo[s] = 256 * i16 + 16 * (((4 * s) ^ (X & 12)) | (g ^ (X & 3))); }
    v4u sreg[8], kreg[4]; bf16x8 qn[4];
    auto item_ptrs = [&](int item, size_t& tok0, const GAS bf16*& sf, int& h) { const int b = item >> 6; h = (item >> 4) & 3; const int n = item & 15; tok0 = (size_t)b * SEQ + n * 128;
        sf = (const GAS bf16*)a.out + ((((size_t)(b * 4 + h) * 16 + n) * 2 + 0) * 256) * 128; };
    auto issue_k = [&](int item) { size_t tok0; const GAS bf16* sf; int h; item_ptrs(item, tok0, sf, h);
        const GAS bf16* ks_ = kr + (tok0 + (tid >> 4)) * 512 + h * 128 + (tid & 15) * 8;
#pragma unroll
        for (int j = 0; j < 4; ++j) kreg[j] = *(const GAS v4u*)(ks_ + (size_t)j * 32 * 512); };
    auto issue_q = [&](int item) { size_t tok0; const GAS bf16* sf; int h; item_ptrs(item, tok0, sf, h);
#pragma unroll
        for (int s = 0; s < 4; ++s) qn[s] = *(const GAS bf16x8*)(qr + (tok0 + 16 * wid + i16) * 512 + h * 128 + 32 * s + 8 * g); };
    auto issue_state = [&](const GAS bf16* sf, int dirn) { const GAS bf16* sld = sf + (size_t)dirn * 256 * 128 + (size_t)(tid >> 4) * 128 + (tid & 15) * 8;
#pragma unroll
        for (int j = 0; j < 8; ++j) sreg[j] = *(const GAS v4u*)(sld + (size_t)j * 32 * 128); };
    auto write_state = [&]() {
#pragma unroll
        for (int j = 0; j < 8; ++j) *(LAS v4u*)(Sg + (j >> 2) * 32768 + kdst + (j & 3) * 8192) = sreg[j]; };
    { size_t tok0; const GAS bf16* sf; int h; item_ptrs(vcu, tok0, sf, h); issue_k(vcu); issue_q(vcu); issue_state(sf, 0); }
#pragma unroll
    for (int j = 0; j < 4; ++j) *(LAS v4u*)(Kt + kdst + j * 8192) = kreg[j];
    for (int item = vcu; item < 1024; item += G) {
        size_t tok0; const GAS bf16* sf; int h; item_ptrs(item, tok0, sf, h);
        const float lf2 = log2_gamma(a.in[2], h), lb2 = log2_gamma(a.in[3], h);
        bf16x8 qf[4];
#pragma unroll
        for (int s = 0; s < 4; ++s) qf[s] = qn[s];
        const bool has_next = item + G < 1024;
        __syncthreads();
        f32x4 D[8];
#pragma unroll
        for (int jt = 0; jt < 8; ++jt) {
            f32x4 d = (f32x4){0.f, 0.f, 0.f, 0.f};
#pragma unroll
            for (int s = 0; s < 4; ++s) { if (VAR != 1) { const bf16x8 kf = *(const LAS bf16x8*)(Kt + rfo[s] + jt * 4096); d = MFMA16(kf, qf[s], d); } else d[s] = __builtin_bit_cast(float, (int)qf[s][0]); }
            D[jt] = d;
        }
        int iq = 16 * wid + i16; OPAQUE(iq);
        bf16x8 pf[4];
#pragma unroll
        for (int ks = 0; ks < 4; ++ks) {
            float e[8];
#pragma unroll
            for (int t = 0; t < 2; ++t)
#pragma unroll
                for (int r = 0; r < 4; ++r) {
                    const int j = 16 * (2 * ks + t) + 4 * g + r; const float fdf = (float)(iq - j), ad = fabsf(fdf);
                    const float pos = fminf(fmaxf(fdf, 0.f), 1.f), isz = 1.f - fminf(ad, 1.f);
                    const float w = __builtin_amdgcn_exp2f((lb2 + (lf2 - lb2) * pos) * ad) + isz;
                    e[4 * t + r] = D[2 * ks + t][r] * w;
                }
            v4u pw; pw.x = cvtpk(e[0], e[1]); pw.y = cvtpk(e[2], e[3]); pw.z = cvtpk(e[4], e[5]); pw.w = cvtpk(e[6], e[7]);
            pf[ks] = __builtin_bit_cast(bf16x8, pw);
        }
        f32x4 acc[16];
#pragma unroll
        for (int vt = 0; vt < 16; ++vt) acc[vt] = (f32x4){0.f, 0.f, 0.f, 0.f};
#pragma unroll
        for (int dirn = 0; dirn < 2; ++dirn) {
            if (dirn == 1) __syncthreads();
            write_state();
            if (dirn == 0) { issue_state(sf, 1); if (has_next) issue_k(item + G); }
            else {
                if (has_next) {
#pragma unroll
                    for (int j = 0; j < 4; ++j) *(LAS v4u*)(Kt + kdst + j * 8192) = kreg[j]; }
                const GAS bf16* vs_ = vr + (tok0 + (tid >> 5)) * 1024 + h * 256 + (tid & 31) * 8;
#pragma unroll
                for (int j = 0; j < 8; ++j) sreg[j] = *(const GAS v4u*)(vs_ + (size_t)j * 16 * 1024);
            }
            __syncthreads();
#pragma unroll
            for (int vt = 0; vt < 16; ++vt) {
#pragma unroll
                for (int s = 0; s < 4; ++s) { if (VAR != 1) { const bf16x8 sfr = *(const LAS bf16x8*)(Sg + (vt >> 3) * 32768 + rfo[s] + (vt & 7) * 4096); acc[vt] = MFMA16(qf[s], sfr, acc[vt]); } }
            }
            float xs[4];
            { int ib = 16 * wid + 4 * g; OPAQUE(ib);
#pragma unroll
              for (int r = 0; r < 4; ++r) { const float lxf = lf2 * (float)(ib + r + 1), lxb = lb2 * (float)(128 - ib - r); xs[r] = __builtin_amdgcn_exp2f(dirn == 0 ? lxf - lxb : lxb); } }
#pragma unroll
            for (int vt = 0; vt < 16; ++vt)
#pragma unroll
                for (int r = 0; r < 4; ++r) acc[vt][r] *= xs[r];
        }
        __syncthreads();
        { int t2 = tid; OPAQUE(t2); const unsigned vd2 = (unsigned)((t2 & 31) >> 4) * 32768u + offb(t2 >> 5, t2 & 15);
#pragma unroll
          for (int j = 0; j < 8; ++j) *(LAS v4u*)(Sg + vd2 + j * 4096) = sreg[j]; }
        GAS bf16* gp = gr + (tok0 + 16 * wid + (lane >> 5)) * 1024 + h * 256 + (lane & 31) * 8;
#if MIX_FP8 & 4
        GAS unsigned char* ar8 = (GAS unsigned char*)(ws + WS_AR8) + (tok0 + 16 * wid + (lane >> 5)) * 1024 + h * 256 + (lane & 31) * 8;
#endif
        __syncthreads();
        unsigned vbs[8];
        { int l2 = lane; OPAQUE(l2); const unsigned g2 = l2 >> 4, q2 = (l2 & 15) >> 2, p2 = l2 & 3, X = (q2 << 2) | g2;
#pragma unroll
          for (int c = 0; c < 8; ++c) vbs[c] = 256 * (4 * g2 + q2) + 16 * (((2 * c) ^ (X & 14)) | ((p2 >> 1) ^ (X & 1))) + 8 * (p2 & 1); }
#pragma unroll
        for (int vt = 0; vt < 16; ++vt) {
#pragma unroll
            for (int ks = 0; ks < 4; ++ks) { if (VAR != 1) {
                const s16x4 lo = ldtr(Sg + vbs[vt & 7] + (vt >> 3) * 32768 + ks * 8192), hi = ldtr(Sg + vbs[vt & 7] + (vt >> 3) * 32768 + ks * 8192 + 4096);
                acc[vt] = MFMA16(pf[ks], cat8(lo, hi), acc[vt]); }
            }
            asm volatile("" ::: "memory");
        }
        float mu[4], rs[4];
#pragma unroll
        for (int r = 0; r < 4; ++r) {
            float s = 0.f;
#pragma unroll
            for (int vt = 0; vt < 16; ++vt) s += acc[vt][r];
            s += __shfl_xor(s, 1); s += __shfl_xor(s, 2); s += __shfl_xor(s, 4); s += __shfl_xor(s, 8);
            const float m = s * (1.f / 256.f); float qv = 0.f;
#pragma unroll
            for (int vt = 0; vt < 16; ++vt) { const float d = acc[vt][r] - m; qv += d * d; }
            qv += __shfl_xor(qv, 1); qv += __shfl_xor(qv, 2); qv += __shfl_xor(qv, 4); qv += __shfl_xor(qv, 8);
            mu[r] = m; rs[r] = 1.f / sqrtf(qv * (1.f / 256.f) + LN_EPSF);
        }
        v4u greg[8];
#pragma unroll
        for (int j = 0; j < 8; ++j) greg[j] = *(const GAS v4u*)(gp + (size_t)j * 2048);
        __syncthreads();
        if (has_next) { size_t tk; const GAS bf16* sfn; int hn; item_ptrs(item + G, tk, sfn, hn); issue_state(sfn, 0); issue_q(item + G); }
        LAS bf16* st = (LAS bf16*)(Sg + wid * 8192);
        { LAS bf16* sp_ = st + (4 * g) * 256 + i16;
#pragma unroll
          for (int vt = 0; vt < 16; ++vt)
#pragma unroll
              for (int r = 0; r < 4; ++r) sp_[r * 256 + 16 * vt] = (bf16)(cvtpk((acc[vt][r] - mu[r]) * rs[r], 0.f) & 0xffffu); }
        asm volatile("s_waitcnt lgkmcnt(0)" ::: "memory");
        {
            const float* gn = a.in[4] + h * 256; const int ch = lane & 31;
            const f32x4 g0 = *(const f32x4*)(gn + ch * 8), g1 = *(const f32x4*)(gn + ch * 8 + 4);
            const LAS bf16* yp = st + (lane >> 5) * 256 + ch * 8;
#pragma unroll
            for (int j = 0; j < 8; ++j) {
                const v4u y = *(const LAS v4u*)(yp + j * 512); const v4u sg = greg[j];
#if SILU_IN_P3
#define GSW(w, hi) pg8::fsilu((hi) ? bfhi(w) : bflo(w))
#else
#define GSW(w, hi) ((hi) ? bfhi(w) : bflo(w))
#endif
                v4u o; o.x = cvtpk(bflo(y.x) * g0[0] * GSW(sg.x, 0), bfhi(y.x) * g0[1] * GSW(sg.x, 1)); o.y = cvtpk(bflo(y.y) * g0[2] * GSW(sg.y, 0), bfhi(y.y) * g0[3] * GSW(sg.y, 1));
                o.z = cvtpk(bflo(y.z) * g1[0] * GSW(sg.z, 0), bfhi(y.z) * g1[1] * GSW(sg.z, 1)); o.w = cvtpk(bflo(y.w) * g1[2] * GSW(sg.w, 0), bfhi(y.w) * g1[3] * GSW(sg.w, 1));
#undef GSW
#if MIX_FP8 & 4
                u32x2 o8; o8.x = pk_fp8x4(bflo(o.x), bfhi(o.x), bflo(o.y), bfhi(o.y)); o8.y = pk_fp8x4(bflo(o.z), bfhi(o.z), bflo(o.w), bfhi(o.w));
                *(GAS u32x2*)(ar8 + (size_t)j * 2048) = o8;
#else
                *(GAS v4u*)(gp + (size_t)j * 2048) = o;
#endif
            }
        }
        __syncthreads();
    }
}

constexpr int P6_RS = 81920, P6_CNT = P6_RS + 8 * 512, P6_BASE = P6_CNT + 64, P6_ROW = P6_BASE + 64;
#define P6_BUTTERFLY(lg, out) do { float r10[10], r5[5], r3[3], r2[2]; const float z = 0.f; \
    _Pragma("unroll") for (int k = 0; k < 10; ++k) { const float keep = h32 ? lg[10 + k] : lg[k], send = h32 ? lg[k] : lg[10 + k]; r10[k] = keep + __shfl_xor(send, 32); } \
    _Pragma("unroll") for (int k = 0; k < 5; ++k) { const float keep = h16 ? r10[5 + k] : r10[k], send = h16 ? r10[k] : r10[5 + k]; r5[k] = keep + __shfl_xor(send, 16); } \
    { const float keep = h8 ? r5[3] : r5[0], send = h8 ? r5[0] : r5[3]; r3[0] = keep + __shfl_xor(send, 8); } \
    { const float keep = h8 ? r5[4] : r5[1], send = h8 ? r5[1] : r5[4]; r3[1] = keep + __shfl_xor(send, 8); } \
    { const float keep = h8 ? z : r5[2], send = h8 ? r5[2] : z; r3[2] = keep + __shfl_xor(send, 8); } \
    { const float keep = h4 ? r3[2] : r3[0], send = h4 ? r3[0] : r3[2]; r2[0] = keep + __shfl_xor(send, 4); } \
    { const float keep = h4 ? z : r3[1], send = h4 ? r3[1] : z; r2[1] = keep + __shfl_xor(send, 4); } \
    { const float keep = h2 ? r2[1] : r2[0], send = h2 ? r2[0] : r2[1]; out = keep + __shfl_xor(send, 2); } \
    out += __shfl_xor(out, 1); } while (0)
__device__ __forceinline__ void p6a_phase(const Args& a, LAS unsigned char* lds, int vcu, int G, int tid, int wave, int lane) {
    unsigned char* ws = a.ws;
    LAS float* RW = (LAS float*)lds;
    LAS float* RS = (LAS float*)(lds + P6_RS) + wave * 128;
    LAS unsigned* LC = (LAS unsigned*)(lds + P6_CNT); LAS unsigned* LB = (LAS unsigned*)(lds + P6_BASE); LAS unsigned* LR = (LAS unsigned*)(lds + P6_ROW);
    {
        const f32x4* wgp = (const f32x4*)a.in[11]; const f32x4* wep = (const f32x4*)a.in[13];
        f32x4 gq[2], eq[8];
#pragma unroll
        for (int u = 0; u < 2; ++u) gq[u] = wgp[tid + 512 * u];
#pragma unroll
        for (int u = 0; u < 8; ++u) eq[u] = wep[tid + 512 * u];
#pragma unroll
        for (int u = 0; u < 2; ++u) { const int c = tid + 512 * u;
#pragma unroll
            for (int k = 0; k < 4; ++k) RW[k * 1024 + c] = gq[u][k]; }
#pragma unroll
        for (int u = 0; u < 8; ++u) { const int q = tid + 512 * u, c = q >> 2, k4 = q & 3;
#pragma unroll
            for (int k = 0; k < 4; ++k) RW[(4 + 4 * k4 + k) * 1024 + c] = eq[u][k]; }
    }
    const u32x2* pre = (const u32x2*)a.out; u32x2* x1b = (u32x2*)(ws + WS_XB); [[maybe_unused]] unsigned* x1f8 = (unsigned*)(ws + WS_X1F8);
    gu32* ctl = (gu32*)ws;
    int* ltok = (int*)(ws + WS_LTOK); float* tw = (float*)(ws + WS_WSLOT); unsigned* tinfo = (unsigned*)(ws + WS_TINFO);
    const float* g1 = a.in[9]; const float* b1 = a.in[10];
    const bool h32 = (lane & 32) != 0, h16 = (lane & 16) != 0, h8 = (lane & 8) != 0, h4 = (lane & 4) != 0, h2 = (lane & 2) != 0;
#define P6_LOADROW(dst, t_) do { const u32x2* xr_ = pre + (size_t)(t_) * 256 + lane; _Pragma("unroll") for (int j = 0; j < 4; ++j) dst[j] = xr_[64 * j]; } while (0)
#define P6_LN(v, nx, s) do { s = 0.f; _Pragma("unroll") for (int j = 0; j < 4; ++j) { v[j] = (f32x4){bflo(nx[j].x), bfhi(nx[j].x), bflo(nx[j].y), bfhi(nx[j].y)}; s += (v[j].x + v[j].y) + (v[j].z + v[j].w); } } while (0)
#define P6_VAR(v, mean, q) do { q = 0.f; _Pragma("unroll") for (int j = 0; j < 4; ++j) { v[j] = v[j] - mean; q += (v[j].x * v[j].x + v[j].y * v[j].y) + (v[j].z * v[j].z + v[j].w * v[j].w); } } while (0)
#if M1_FP8
#define P6_STORE(v, t_, j) do { u32x2 o_; o_.x = cvtpk(v[j].x, v[j].y); o_.y = cvtpk(v[j].z, v[j].w); x1b[(size_t)(t_) * 256 + lane + 64 * j] = o_; x1f8[(size_t)(t_) * 256 + lane + 64 * j] = pk_fp8x4(v[j].x, v[j].y, v[j].z, v[j].w); } while (0)
#else
#define P6_STORE(v, t_, j) do { u32x2 o_; o_.x = cvtpk(v[j].x, v[j].y); o_.y = cvtpk(v[j].z, v[j].w); x1b[(size_t)(t_) * 256 + lane + 64 * j] = o_; } while (0)
#endif
#define P6_DOT(lg, v, j, k, w) lg[k] += (v[j][0] * w[0] + v[j][1] * w[1]) + (v[j][2] * w[2] + v[j][3] * w[3])
    for (int blk = vcu; blk < TT / 128; blk += G) {
        if (tid < 16) LC[tid] = 0u;
        __syncthreads();
        const int t0 = blk * 128;
        u32x2 nxA[4], nxB[4], nxC[4], nxD[4];
        P6_LOADROW(nxA, t0 + wave); P6_LOADROW(nxB, t0 + wave + 8); P6_LOADROW(nxC, t0 + wave + 16); P6_LOADROW(nxD, t0 + wave + 24);
        for (int rr = 0; rr < 4; ++rr) {
            const int rl0 = wave + 32 * rr, tA = t0 + rl0, tB = tA + 8, tC = tA + 16, tD = tA + 24;
            f32x4 vA[4], vB[4], vC[4], vD[4]; float sA, sB, sC, sD;
            P6_LN(vA, nxA, sA); P6_LN(vB, nxB, sB); P6_LN(vC, nxC, sC); P6_LN(vD, nxD, sD);
            if (rr < 3) { P6_LOADROW(nxA, tA + 32); P6_LOADROW(nxB, tB + 32); P6_LOADROW(nxC, tC + 32); P6_LOADROW(nxD, tD + 32); }
            const float mA = wave_sum(sA) * (1.f / DM), mB = wave_sum(sB) * (1.f / DM), mC = wave_sum(sC) * (1.f / DM), mD = wave_sum(sD) * (1.f / DM);
            float qA, qB, qC, qD;
            P6_VAR(vA, mA, qA); P6_VAR(vB, mB, qB); P6_VAR(vC, mC, qC); P6_VAR(vD, mD, qD);
            const float rA = 1.f / sqrtf(wave_sum(qA) * (1.f / DM) + LN_EPSF), rB = 1.f / sqrtf(wave_sum(qB) * (1.f / DM) + LN_EPSF);
            const float rC = 1.f / sqrtf(wave_sum(qC) * (1.f / DM) + LN_EPSF), rD = 1.f / sqrtf(wave_sum(qD) * (1.f / DM) + LN_EPSF);
            typedef float f32x2p __attribute__((ext_vector_type(2)));
            f32x2p lgAB[20], lgCD[20];
#pragma unroll
            for (int k = 0; k < 20; ++k) { lgAB[k] = (f32x2p){0.f, 0.f}; lgCD[k] = (f32x2p){0.f, 0.f}; }
#pragma unroll
            for (int j = 0; j < 4; ++j) {
                const f32x4 gg = *(const f32x4*)(g1 + 4 * lane + 256 * j), bb = *(const f32x4*)(b1 + 4 * lane + 256 * j);
                vA[j] = vA[j] * rA * gg + bb; vB[j] = vB[j] * rB * gg + bb; vC[j] = vC[j] * rC * gg + bb; vD[j] = vD[j] * rD * gg + bb;
                P6_STORE(vA, tA, j); P6_STORE(vB, tB, j); P6_STORE(vC, tC, j); P6_STORE(vD, tD, j);
                f32x2p pab[4], pcd[4];
#pragma unroll
                for (int e = 0; e < 4; ++e) { pab[e] = (f32x2p){vA[j][e], vB[j][e]}; pcd[e] = (f32x2p){vC[j][e], vD[j][e]}; }
#pragma unroll
                for (int k = 0; k < 20; ++k) { const f32x4 w = *(const LAS f32x4*)(RW + k * 1024 + 4 * lane + 256 * j);
#pragma unroll
                    for (int e = 0; e < 4; ++e) { const f32x2p ww = (f32x2p){w[e], w[e]};
                        lgAB[k] = __builtin_elementwise_fma(pab[e], ww, lgAB[k]); lgCD[k] = __builtin_elementwise_fma(pcd[e], ww, lgCD[k]); } }
            }
            float lgA[20], lgB[20], lgC[20], lgD[20];
#pragma unroll
            for (int k = 0; k < 20; ++k) { lgA[k] = lgAB[k].x; lgB[k] = lgAB[k].y; lgC[k] = lgCD[k].x; lgD[k] = lgCD[k].y; }
            float r1A, r1B, r1C, r1D;
            P6_BUTTERFLY(lgA, r1A); P6_BUTTERFLY(lgB, r1B); P6_BUTTERFLY(lgC, r1C); P6_BUTTERFLY(lgD, r1D);
            {
                const int i3 = h2 ? (h4 ? -1 : 1) : (h4 ? 2 : 0);
                const int i5 = i3 < 0 ? -1 : (h8 ? (i3 == 2 ? -1 : i3 + 3) : i3);
                const int kk = i5 < 0 ? -1 : (h32 ? 10 : 0) + (h16 ? 5 : 0) + i5;
                if (kk >= 0 && (lane & 1) == 0) { RS[kk] = r1A; RS[32 + kk] = r1B; RS[64 + kk] = r1C; RS[96 + kk] = r1D; }
            }
            asm volatile("s_waitcnt lgkmcnt(0)" ::: "memory");
            {
                const int sel = lane & 3; const int rl = rl0 + 8 * sel;
                float tl[20];
#pragma unroll
                for (int k4 = 0; k4 < 5; ++k4) { const f32x4 w = *(const LAS f32x4*)(RS + sel * 32 + 4 * k4); tl[4 * k4] = w[0]; tl[4 * k4 + 1] = w[1]; tl[4 * k4 + 2] = w[2]; tl[4 * k4 + 3] = w[3]; }
                float gl[4];
#pragma unroll
                for (int k = 0; k < 4; ++k) gl[k] = tl[k] + a.in[12][k];
                int gi = 0; float gm = gl[0];
#pragma unroll
                for (int k = 1; k < 4; ++k) if (gl[k] > gm) { gm = gl[k]; gi = k; }
                float gs = 0.f;
#pragma unroll
                for (int k = 0; k < 4; ++k) gs += __expf(gl[k] - gm);
                const float gwt = 1.f / gs;
                float el[4];
#pragma unroll
                for (int k = 0; k < 4; ++k) { const float se = gi == 0 ? tl[4 + k] : (gi == 1 ? tl[8 + k] : (gi == 2 ? tl[12 + k] : tl[16 + k])); el[k] = se + a.in[14][4 * gi + k]; }
                int i1 = 0; float v1 = el[0];
#pragma unroll
                for (int k = 1; k < 4; ++k) if (el[k] > v1) { v1 = el[k]; i1 = k; }
                int i2 = (i1 + 1) & 3; float v2 = -3.0e38f;
#pragma unroll
                for (int k = 0; k < 4; ++k) if (k != i1 && el[k] > v2) { v2 = el[k]; i2 = k; }
                const float ex = __expf(v2 - v1), w1 = gwt / (1.f + ex), w2 = gwt * ex / (1.f + ex);
                if (lane < 4) {
                    const int e1 = 4 * gi + i1, e2 = 4 * gi + i2;
                    const unsigned p1 = __hip_atomic_fetch_add(LC + e1, 1u, __ATOMIC_RELAXED, __HIP_MEMORY_SCOPE_WORKGROUP);
                    const unsigned p2 = __hip_atomic_fetch_add(LC + e2, 1u, __ATOMIC_RELAXED, __HIP_MEMORY_SCOPE_WORKGROUP);
                    LR[rl * 4 + 0] = ((unsigned)e1 << 16) | p1; LR[rl * 4 + 1] = ((unsigned)e2 << 16) | p2; LR[rl * 4 + 2] = __float_as_uint(w1); LR[rl * 4 + 3] = __float_as_uint(w2);
                }
            }
            asm volatile("s_waitcnt lgkmcnt(0)" ::: "memory");
        }
        __syncthreads();
        if (tid < 16) LB[tid] = __hip_atomic_fetch_add(ctl + CW_CNT + 64 * tid, LC[tid], __ATOMIC_RELAXED, __HIP_MEMORY_SCOPE_AGENT);
        __syncthreads();
        if (tid < 256) {
            const int rl = tid >> 1, j = tid & 1; const unsigned rec = LR[rl * 4 + j]; const unsigned e = rec >> 16, pos = LB[e] + (rec & 0xffffu);
            ltok[e * TT + pos] = t0 + rl; tw[2 * (t0 + rl) + j] = __uint_as_float(LR[rl * 4 + 2 + j]); tinfo[2 * (t0 + rl) + j] = (e << 16) | pos;
        }
        __syncthreads();
    }
#undef P6_LOADROW
#undef P6_LN
#undef P6_VAR
#undef P6_STORE
#undef P6_DOT
}
__device__ __forceinline__ void build_tile_tables(const Args& a, LAS unsigned char* lds, int tid) {
    LAS int* ts = (LAS int*)(lds + LDS_TS_OFF); LAS int* te = (LAS int*)(lds + LDS_TE_OFF); LAS int* cn = (LAS int*)(lds + LDS_CNT_OFF);
    gu32* ctl = (gu32*)a.ws;
    if (tid == 0) { int acc = 0;
        for (int e = 0; e < 16; ++e) { ts[e] = acc; const int c = (int)__hip_atomic_load(ctl + CW_CNT + 64 * e, __ATOMIC_RELAXED, __HIP_MEMORY_SCOPE_AGENT); const int nt = (c + 255) >> 8; cn[e] = c;
            for (int k = 0; k < nt; ++k) te[acc + k] = e; acc += nt; }
        ts[16] = acc; }
    __syncthreads();
}
__device__ __forceinline__ void p9_phase(const Args& a, LAS unsigned char* lds, int vcu, int G, int wave, int lane) {
    unsigned char* ws = a.ws;
    const LAS int* ts = (const LAS int*)(lds + LDS_TS_OFF);
    const unsigned* tinfo = (const unsigned*)(ws + WS_TINFO); const u32x2* Y = (const u32x2*)(ws + WS_Y);
    const float* g2 = a.in[18]; const float* b2 = a.in[19];
    const int gw = vcu * NWAVES + wave, NGW = G * NWAVES;
#if Y_FP8
    const unsigned* Y8 = (const unsigned*)(ws + WS_Y); unsigned ny0[4], ny1[4]; u32x2 nxw[4]; float nw0 = 0.f, nw1 = 0.f;
#else
    u32x2 ny0[4], ny1[4], nxw[4]; float nw0 = 0.f, nw1 = 0.f;
#endif
    const float* tw = (const float*)(ws + WS_WSLOT);
    auto issue = [&](int t) {
        const unsigned i0 = tinfo[2 * t], i1 = tinfo[2 * t + 1];
        nw0 = tw[2 * t]; nw1 = tw[2 * t + 1];
        const size_t s0 = (size_t)ts[i0 >> 16] * 256 + (i0 & 0xffffu), s1 = (size_t)ts[i1 >> 16] * 256 + (i1 & 0xffffu);
        const u32x2* xb1 = (const u32x2*)(ws + WS_XB) + (size_t)t * 256 + lane;
#pragma unroll
#if Y_FP8
        for (int j = 0; j < 4; ++j) { ny0[j] = Y8[s0 * 256 + lane + 64 * j]; ny1[j] = Y8[s1 * 256 + lane + 64 * j]; nxw[j] = xb1[64 * j]; }
#else
        for (int j = 0; j < 4; ++j) { ny0[j] = Y[s0 * 256 + lane + 64 * j]; ny1[j] = Y[s1 * 256 + lane + 64 * j]; nxw[j] = xb1[64 * j]; }
#endif
    };
    if (gw < TT) issue(gw);
    for (int t = gw; t < TT; t += NGW) {
        f32x4* xr = (f32x4*)(a.out + (size_t)t * DM) + lane;
#if Y_FP8
        f32x4 v[4]; float s = 0.f; const float w0 = nw0 * 0.0625f, w1 = nw1 * 0.0625f;
#pragma unroll
        for (int j = 0; j < 4; ++j) {
            const unsigned y0 = ny0[j], y1 = ny1[j]; const u32x2 xw = nxw[j];
            typedef float f32x2_ __attribute__((ext_vector_type(2)));
            const f32x2_ a0 = __builtin_amdgcn_cvt_pk_f32_fp8(y0, false), a1 = __builtin_amdgcn_cvt_pk_f32_fp8(y0, true), c0 = __builtin_amdgcn_cvt_pk_f32_fp8(y1, false), c1 = __builtin_amdgcn_cvt_pk_f32_fp8(y1, true);
            f32x4 x = (f32x4){bflo(xw.x), bfhi(xw.x), bflo(xw.y), bfhi(xw.y)} * DN_ALPHA;
            x.x += w0 * a0[0] + w1 * c0[0]; x.y += w0 * a0[1] + w1 * c0[1]; x.z += w0 * a1[0] + w1 * c1[0]; x.w += w0 * a1[1] + w1 * c1[1];
            v[j] = x; s += (x.x + x.y) + (x.z + x.w);
        }
#else
        f32x4 v[4]; float s = 0.f; const float w0 = nw0, w1 = nw1;
#pragma unroll
        for (int j = 0; j < 4; ++j) {
            const u32x2 y0 = ny0[j], y1 = ny1[j], xw = nxw[j];
            f32x4 x = (f32x4){bflo(xw.x), bfhi(xw.x), bflo(xw.y), bfhi(xw.y)} * DN_ALPHA;
            x.x += w0 * bflo(y0.x) + w1 * bflo(y1.x); x.y += w0 * bfhi(y0.x) + w1 * bfhi(y1.x); x.z += w0 * bflo(y0.y) + w1 * bflo(y1.y); x.w += w0 * bfhi(y0.y) + w1 * bfhi(y1.y);
            v[j] = x; s += (x.x + x.y) + (x.z + x.w);
        }
#endif
        if (t + NGW < TT) issue(t + NGW);
        const float mean = wave_sum(s) * (1.f / DM); float s2 = 0.f;
#pragma unroll
        for (int j = 0; j < 4; ++j) { v[j] = v[j] - mean; s2 += (v[j].x * v[j].x + v[j].y * v[j].y) + (v[j].z * v[j].z + v[j].w * v[j].w); }
        const float rstd = 1.f / sqrtf(wave_sum(s2) * (1.f / DM) + LN_EPSF);
#pragma unroll
        for (int j = 0; j < 4; ++j) { const f32x4 gg = *(const f32x4*)(g2 + 4 * lane + 256 * j), bb = *(const f32x4*)(b2 + 4 * lane + 256 * j); xr[64 * j] = v[j] * rstd * gg + bb; }
    }
}

__global__ void __launch_bounds__(NWAVES * 64, 2) mega_fwd(Args args) {
    extern __shared__ __attribute__((aligned(16))) unsigned char lds_raw[];
    LAS unsigned char* lds = (LAS unsigned char*)lds_raw;
    volatile LAS unsigned* MISC = (volatile LAS unsigned*)(lds + MISC_OFF);
    const int tid0 = threadIdx.x, wave = __builtin_amdgcn_readfirstlane(tid0 >> 6);
    const int G = gridDim.x, bx = blockIdx.x, vcu = (G % 8 == 0) ? (bx % 8) * (G / 8) + bx / 8 : bx;
    for (int u = tid0; u < (LDS_BYTES - LDSCTL_OFF) / 4; u += NWAVES * 64) ((LAS unsigned*)(lds + LDSCTL_OFF))[u] = 0u;
    __syncthreads();
    unsigned char* ws = args.ws;
    gu32* ctl = (gu32*)ws;
    const bool bars_on = (args.mask >> 31) != 0u;
    XcdBarrier bar; bar.bar = (unsigned*)(ctl + CW_BAR) + args.bar_region * XCD_BAR_WORDS; bar.x = 0; bar.st = nullptr;
    if (bars_on) bar = xcd_barrier_post((unsigned*)(ctl + CW_BAR) + args.bar_region * XCD_BAR_WORDS, MISC + 8);
    bar.wv = wave;
#define GRID_BAR() do { if (bars_on) xcd_barrier(bar); } while (0)
#ifndef PH_LAST
#define PH_LAST 99
#endif
#define FRESH() int tid = wave * 64 + pg8::lane_id(); asm volatile("" : "+v"(tid)); const int lane = tid & 63; (void)lane
#ifndef RMASK
#define RMASK 0
#endif
#define REP(k) _Pragma("unroll") for (int rep_ = 0; rep_ < 1 + ((RMASK >> (k)) & 1); ++rep_)
#ifndef STAMP_SCALE
#define STAMP_SCALE 1.0f
#endif
#ifdef STAMP_PH
#define ST_B(k) if ((k) == STAMP_PH) { st_a = rt(); }
#define ST_E(k) if ((k) == STAMP_PH) { st_b = rt(); }
#else
#define ST_B(k)
#define ST_E(k)
#endif
#ifdef ONLY
#define EN(k) (ONLY == (k))
#else
#define EN(k) ((args.mask >> (k)) & 1u)
#endif
    unsigned long long st_a = 0, st_b = 0; (void)st_a; (void)st_b;
    REP(0) if (EN(0)) { FRESH(); p0_prologue(args, lds, vcu, G, tid, wave, lane); }
    GRID_BAR();
#ifdef STAGGER_TICKS
    if (EN(1) && (bx & 8)) { const unsigned long long t0_ = rt(); while (rt() - t0_ < STAGGER_TICKS) __builtin_amdgcn_s_sleep(32); }
#endif
    REP(1) if (EN(1)) {
#if P1_FP8
        pg8::EpiHcat E{ws, (const float*)(ws + WS_ROT), 0};
        if (P1_FP8_FROM > 0) {
            pg8::Gemm g{(const pg8::bf16_t*)(ws + WS_XB), (const pg8::bf16_t*)(ws + WS_WIN), TT, 4608, 1024}; pg8::StaticOrder S; S.init(TT, 256 * P1_FP8_FROM, G, bx);
            pg8::gemm_phase<pg8::EpiHcat, pg8::StaticOrder, true, true>(lds, g, S, E, wave);
        }
        {
#if GATE_FP8
            pg8::Gemm g{(const pg8::bf16_t*)(ws + WS_X8_LO), (const pg8::bf16_t*)(ws + WS_WIN8), TT, 4608, 512, 64, (long)WS_X8_HI - (long)WS_X8_LO - (long)(16 * MiB)}; pg8::StaticOrder S;
#else
            pg8::Gemm g{(const pg8::bf16_t*)args.out, (const pg8::bf16_t*)(ws + WS_WIN8), TT, 4608, 512}; pg8::StaticOrder S;
#endif
            S.init(TT, 4608 - 256 * P1_FP8_FROM, G, bx, P1_FP8_FROM);
#if CONV_BG
            pg8::P1Order SB; SB.S = S; SB.cv = pg8::ExpertConv{args.in[15], args.in[16], args.in[17], ws + WS_WGU, ws + WS_WD, vcu * NWAVES + wave, G * NWAVES, vcu % 9};
            pg8::gemm_phase<pg8::EpiHcat, pg8::P1Order, true, true, false, true, 1, 0>(lds, g, SB, E, wave);
            { FRESH();
              for (int k = 0; SB.cv.gw + k * SB.cv.nw < 6144; ++k) { pg8::Unit tu; const bool in_gap = k < 3 && S.next(pg8::P1Order::unit_of(SB.cv.grp, k), tu) && pg8::P1Order::unit_of(SB.cv.grp, k) < 9;
                  if (!in_gap) pg8::expert_conv_item(SB.cv, k, lane); } }
#else
            pg8::gemm_phase<pg8::EpiHcat, pg8::StaticOrder, true, true, false, true, 1, 0>(lds, g, S, E, wave);
#endif
        }
#else
        pg8::Gemm g{(const pg8::bf16_t*)(ws + WS_XB), (const pg8::bf16_t*)(ws + WS_WIN), TT, 4608, 1024}; pg8::StaticOrder S; S.init(TT, 4608, G, bx);
        pg8::EpiHcat E{ws, (const float*)(ws + WS_ROT), 0};
        pg8::gemm_phase<pg8::EpiHcat, pg8::StaticOrder, true, true>(lds, g, S, E, wave);
#endif
    }
    GRID_BAR();
    if (PH_LAST >= 2) {
        REP(2) if (EN(2)) { FRESH(); for (int it = vcu; it < 256; it += G) chain_item(args, lds, it, tid, wave, lane); }
        if (EN(3)) { { FRESH(); attn_dil_phase<16>(args, lds, vcu, G, tid, wave, lane); }
                     { FRESH(); attn_dil_phase<4>(args, lds, vcu, G, tid, wave, lane); } }
    }
    GRID_BAR();
    ST_B(4) if (PH_LAST >= 3 && EN(4)) { FRESH(); p3_phase<0>(args, lds, vcu, G, tid, wave, lane); }
    if (EN(13)) { FRESH(); attn_p1_phase(args, lds, vcu, G, tid, wave, lane); }
    GRID_BAR(); ST_E(4)
#if !CONV_BG
    if (EN(14)) { FRESH(); p0_expert_weights(args, lds, vcu, G, wave, lane); }
#endif
    REP(5) if (PH_LAST >= 4 && EN(5)) {
        pg8::GateOrder S; S.S4.init(TT, 1024, G, bx);
        pg8::EpiHcat E{ws, (const float*)(ws + WS_ROT), 18};
#if GATE_FP8
        pg8::Gemm g{(const pg8::bf16_t*)(ws + WS_X8_LO), (const pg8::bf16_t*)(ws + WS_WIN8 + (size_t)4608 * 1024), TT, 2048, 512, 64, (long)WS_X8_HI - (long)WS_X8_LO - (long)(16 * MiB)};
        pg8::gemm_phase<pg8::EpiHcat, pg8::GateOrder, true, true, false, true, 1, 0>(lds, g, S, E, wave);
#else
        pg8::Gemm g{(const pg8::bf16_t*)(ws + WS_XB), (const pg8::bf16_t*)(ws + WS_WIN) + (size_t)4608 * 1024, TT, 2048, 1024};
        pg8::gemm_phase<pg8::EpiHcat, pg8::GateOrder, true, true>(lds, g, S, E, wave);
#endif
        asm volatile("s_waitcnt vmcnt(0)" ::: "memory"); __syncthreads();
    }
    REP(6) if (PH_LAST >= 5 && EN(6)) {
        pg8::StaticOrder S; S.init(TT, 1024, G, bx);
        { pg8::EpiGate<false> E{(const pg8::bf16_t*)(ws + WS_GATE_A), (pg8::bf16_t*)(ws + WS_MERGED), nullptr};
#if MIX_FP8 & 2
          pg8::Gemm g{(const pg8::bf16_t*)(ws + WS_OA), (const pg8::bf16_t*)(ws + WS_WA), TT, 1024, 256};
          pg8::gemm_phase<pg8::EpiGate<false>, pg8::StaticOrder, true, true, false, true, 1, 3>(lds, g, S, E, wave);
#else
          pg8::Gemm g{(const pg8::bf16_t*)(ws + WS_OA), (const pg8::bf16_t*)(ws + WS_WA), TT, 1024, 512};
          pg8::gemm_phase<pg8::EpiGate<false>, pg8::StaticOrder, true, true>(lds, g, S, E, wave);
#endif
        }
        asm volatile("s_waitcnt vmcnt(0)" ::: "memory"); __syncthreads();
        { typedef pg8::EpiGate<true, (MIX_FP8 & 1) != 0> EpiC;
          EpiC E{(const pg8::bf16_t*)(ws + WS_GATE_R), (pg8::bf16_t*)(ws + WS_MERGED), ws + WS_MERGED8};
#if MIX_FP8 & 4
          pg8::Gemm g{(const pg8::bf16_t*)(ws + WS_AR8), (const pg8::bf16_t*)(ws + WS_WR), TT, 1024, 512};
          pg8::gemm_phase<EpiC, pg8::StaticOrder, true, true, false, true, 1, 0>(lds, g, S, E, wave);
#else
          pg8::Gemm g{(const pg8::bf16_t*)(ws + WS_GR), (const pg8::bf16_t*)(ws + WS_WR), TT, 1024, 1024};
          pg8::gemm_phase<EpiC, pg8::StaticOrder, true, true>(lds, g, S, E, wave);
#endif
        }
    }
    GRID_BAR();
    REP(7) if (PH_LAST >= 6 && EN(7)) {
        pg8::StaticOrder S; S.init(TT, 1024, G, bx);
        pg8::EpiResBf16 E{X_F32_RES ? (const pg8::bf16_t*)args.in[0] : (const pg8::bf16_t*)(ws + WS_XB), (pg8::bf16_t*)args.out, DN_ALPHA};
#if MIX_FP8 & 1
        pg8::Gemm g{(const pg8::bf16_t*)(ws + WS_MERGED8), (const pg8::bf16_t*)(ws + WS_WO), TT, 1024, 512};
        pg8::gemm_phase<pg8::EpiResBf16, pg8::StaticOrder, true, true, false, true, 1, 3>(lds, g, S, E, wave);
#else
        pg8::Gemm g{(const pg8::bf16_t*)(ws + WS_MERGED), (const pg8::bf16_t*)(ws + WS_WO), TT, 1024, 1024};
        pg8::gemm_phase<pg8::EpiResBf16, pg8::StaticOrder, true, true>(lds, g, S, E, wave);
#endif
    }
    GRID_BAR();
    ST_B(8) if (PH_LAST >= 7 && EN(8)) { FRESH(); p6a_phase(args, lds, vcu, G, tid, wave, lane); }
    GRID_BAR(); ST_E(8)
    { FRESH(); build_tile_tables(args, lds, tid); }
    const int nrt = ((const LAS int*)(lds + LDS_TS_OFF))[16];
    REP(10) if (PH_LAST >= 9 && EN(10)) {
#if M1_FP8
        pg8::Gemm g{(const pg8::bf16_t*)(ws + WS_X1F8), (const pg8::bf16_t*)(ws + WS_WGU), MAXSLOT, 1024, 512};
        pg8::MoeOrder S{nrt * 4, G, vcu, (const LAS int*)(lds + LDS_TE_OFF), (const LAS int*)(lds + LDS_TS_OFF), (const LAS int*)(lds + LDS_CNT_OFF), (const int*)(ws + WS_LTOK), 1024u};
        pg8::EpiSwiGLU E{ws + WS_H};
        pg8::gemm_phase<pg8::EpiSwiGLU, pg8::MoeOrder, true, true, true, true, 1, 0>(lds, g, S, E, wave);
#else
        pg8::Gemm g{(const pg8::bf16_t*)(ws + WS_XB), (const pg8::bf16_t*)(ws + WS_WGU), MAXSLOT, 1024, 1024};
        pg8::MoeOrder S{nrt * 4, G, vcu, (const LAS int*)(lds + LDS_TE_OFF), (const LAS int*)(lds + LDS_TS_OFF), (const LAS int*)(lds + LDS_CNT_OFF), (const int*)(ws + WS_LTOK), 2048u};
        pg8::EpiSwiGLU E{ws + WS_H};
        pg8::gemm_phase<pg8::EpiSwiGLU, pg8::MoeOrder, true, true, true>(lds, g, S, E, wave);
#endif
    }
    GRID_BAR();
    REP(11) if (PH_LAST >= 10 && EN(11)) {
        pg8::Gemm g{(const pg8::bf16_t*)(ws + WS_H), (const pg8::bf16_t*)(ws + WS_WD), MAXSLOT, 1024, 256};
        pg8::MoeOrder S{nrt * 4, G, vcu, (const LAS int*)(lds + LDS_TE_OFF), (const LAS int*)(lds + LDS_TS_OFF), (const LAS int*)(lds + LDS_CNT_OFF), (const int*)(ws + WS_LTOK), 1024u};
        pg8::EpiRowScale E{(pg8::bf16_t*)(ws + WS_Y)};
        pg8::gemm_phase<pg8::EpiRowScale, pg8::MoeOrder, true, true, false, true, 1, 2>(lds, g, S, E, wave);
    }
    GRID_BAR();
    ST_B(12) if (PH_LAST >= 11 && EN(12)) { FRESH(); p9_phase(args, lds, vcu, G, wave, lane); }
#ifdef STAMP_PH
    GRID_BAR(); ST_E(12)
    if (STAMP_PH == 13) { st_a = rt(); GRID_BAR(); GRID_BAR(); GRID_BAR(); GRID_BAR(); st_b = rt(); }
    if (bx == 0 && tid0 == 0) { const float us = (float)(st_b - st_a) * 0.01f * STAMP_SCALE; int k = 0; float lim = 30.f; while (us >= lim && k < 12) { lim *= 1.5f; ++k; }
        __hip_atomic_store(ctl + CW_CHK, __float_as_uint(sqrtf(2.f * k + 2.f)), RLX_AGENT); }
    GRID_BAR();
    { const float c = __uint_as_float(__hip_atomic_load(ctl + CW_CHK, RLX_AGENT)); f32x4* o4 = (f32x4*)args.out;
      for (size_t i = (size_t)bx * 512 + tid0; i < (size_t)TT * DM / 4; i += (size_t)G * 512) o4[i] = (f32x4){c, c, c, c}; }
#endif
}

#ifdef PROBE_VAR
__global__ void __launch_bounds__(NWAVES * 64, 2) probe_kernel(Args args) {
    extern __shared__ __attribute__((aligned(16))) unsigned char lds_raw[];
    LAS unsigned char* lds = (LAS unsigned char*)lds_raw;
    const int tid0 = threadIdx.x, wave = __builtin_amdgcn_readfirstlane(tid0 >> 6);
    const int G = gridDim.x, bx = blockIdx.x, vcu = (G % 8 == 0) ? (bx % 8) * (G / 8) + bx / 8 : bx;
    FRESH();
    if (PROBE_VAR >= 20 && PROBE_VAR <= 22) {
        unsigned char* ws = args.ws;
        pg8::Gemm g{(const pg8::bf16_t*)(ws + WS_X8_LO), (const pg8::bf16_t*)(ws + WS_WIN8), TT, 4608, 512, 64, (long)WS_X8_HI - (long)WS_X8_LO - (long)(16 * MiB)}; pg8::StaticOrder S; S.init(TT, 4608, G, bx);
        typedef pg8::EpiHcatT<PROBE_VAR - 20> EpiP;
        EpiP E{ws, (const float*)(ws + WS_ROT), 0};
        pg8::gemm_phase<EpiP, pg8::StaticOrder, true, true, false, true, 1, 0>(lds, g, S, E, wave);
    }
    if (PROBE_VAR == 10) p3_phase<0>(args, lds, vcu, G, tid, wave, lane);
    if (PROBE_VAR == 11) p3_phase<1>(args, lds, vcu, G, tid, wave, lane);
    if (PROBE_VAR == 0) attn_dil_phase<16, 0>(args, lds, vcu, G, tid, wave, lane);
    if (PROBE_VAR == 1) attn_dil_phase<16, 1>(args, lds, vcu, G, tid, wave, lane);
    if (PROBE_VAR == 2) attn_dil_phase<4, 0>(args, lds, vcu, G, tid, wave, lane);
    if (PROBE_VAR == 3) attn_dil_phase<4, 1>(args, lds, vcu, G, tid, wave, lane);
}
#endif
extern "C" void kernel_launch(void* const* d_in, const int* in_sizes, int n_in, void* d_out, int out_size, void* d_ws, size_t ws_size, hipStream_t stream) {
    static int grid = 0;
    if (grid == 0) {
        if (n_in != 20 || in_sizes[0] != TT * DM || out_size != TT * DM || ws_size < WS_END) { fprintf(stderr, "kernel_launch: unexpected shapes: n_in %d in0 %d out %d ws %zu; nothing launched\n", n_in, n_in > 0 ? in_sizes[0] : -1, out_size, ws_size); grid = -1; return; }
        int dev = 0, cus = 0;
        if (hipGetDevice(&dev) != hipSuccess || hipDeviceGetAttribute(&cus, hipDeviceAttributeMultiprocessorCount, dev) != hipSuccess) { grid = -1; return; }
        if (hipFuncSetAttribute((const void*)mega_fwd, hipFuncAttributeMaxDynamicSharedMemorySize, LDS_BYTES) != hipSuccess) { fprintf(stderr, "kernel_launch: hipFuncSetAttribute failed\n"); grid = -1; return; }
        (void)hipGetLastError();
        grid = cus;
    }
    if (grid < 0) return;
    if (hipMemsetAsync((char*)d_ws, 0, CTL_ZERO_BYTES, stream) != hipSuccess) return;
    Args a{};
    for (int i = 0; i < 20; ++i) a.in[i] = (const float*)d_in[i];
    a.out = (float*)d_out; a.ws = (unsigned char*)d_ws; a.mask = 0x80007fffu; a.bar_region = 0;
#if defined(XTRA_FIRST)
    { Args x = a; x.mask = XTRA_FIRST; x.bar_region = 1; for (int r = 0; r < XTRA_REP; ++r) hipLaunchKernelGGL(mega_fwd, dim3(grid), dim3(NWAVES * 64), LDS_BYTES, stream, x);
      if (hipMemsetAsync((char*)d_ws, 0, CTL_ZERO_BYTES, stream) != hipSuccess) return; }
#endif
    hipLaunchKernelGGL(mega_fwd, dim3(grid), dim3(NWAVES * 64), LDS_BYTES, stream, a);
#if defined(PROBE_VAR)
    { hipFuncSetAttribute((const void*)probe_kernel, hipFuncAttributeMaxDynamicSharedMemorySize, LDS_BYTES);
      for (int r = 0; r < 4; ++r) hipLaunchKernelGGL(probe_kernel, dim3(grid), dim3(NWAVES * 64), LDS_BYTES, stream, a); }
#endif
#if defined(XTRA_AFTER)
    { Args x = a; x.mask = XTRA_AFTER; x.bar_region = 1; for (int r = 0; r < XTRA_REP; ++r) hipLaunchKernelGGL(mega_fwd, dim3(grid), dim3(NWAVES * 64), LDS_BYTES, stream, x); }
#endif
}
```

```cpp
#define STATE_FP8 1
#include <hip/hip_runtime.h>
#include <cstdio>
#include <cstdint>

constexpr int TT = 32768, DM = 1024, SEQ = 2048, NB = 16;
constexpr float DN_ALPHA = 1.189207115002721f;
constexpr float LN_EPSF = 1e-5f;
#ifndef M1_FP8
#define M1_FP8 1
#endif
#ifndef P1_FP8
#define P1_FP8 1
#endif
#ifndef STATE_FP8
#define STATE_FP8 0
#endif
#ifndef SILU_IN_P3
#define SILU_IN_P3 1
#endif
#ifndef CONV_BG
#define CONV_BG 1
#endif
#ifndef Y_FP8
#define Y_FP8 1
#endif
#ifndef GATE_FP8
#define GATE_FP8 1
#endif
#ifndef MIX_FP8
#define MIX_FP8 7
#endif
#ifndef P1_FP8_FROM
#define P1_FP8_FROM 0
#endif
#define X_F32_RES (P1_FP8 && P1_FP8_FROM == 0 && GATE_FP8)
constexpr size_t MiB = 1u << 20;
constexpr size_t CTL_ZERO_BYTES = 1 * MiB;
constexpr size_t WS_ROT = 1 * MiB;
constexpr size_t WS_BIAS = 2 * MiB;
constexpr size_t WS_LTOK = 3 * MiB;
constexpr size_t WS_TINFO = 7 * MiB;
constexpr size_t WS_WSLOT = 7 * MiB + 512 * 1024;
constexpr size_t WS_WIN = 8 * MiB;
constexpr size_t WS_WIN8 = 12 * MiB;
constexpr size_t WS_WR = 21 * MiB;
constexpr size_t WS_WA = 23 * MiB;
constexpr size_t WS_WO = 24 * MiB;
constexpr size_t WS_WGU = 26 * MiB;
constexpr size_t WS_WD = 42 * MiB;
constexpr size_t WS_XB = 80 * MiB;
constexpr size_t WS_QR = 144 * MiB;
constexpr size_t WS_KR = 176 * MiB;
constexpr size_t WS_VR = 208 * MiB;
constexpr size_t WS_GR = 272 * MiB;
constexpr size_t WS_QA = 336 * MiB, WS_KA = 368 * MiB, WS_VA = 400 * MiB, WS_OA = 432 * MiB;
#if MIX_FP8 & 4
constexpr size_t WS_AR8 = 144 * MiB;
constexpr size_t WS_GATE_R = 176 * MiB, WS_GATE_A = 240 * MiB;
#else
constexpr size_t WS_GATE_R = 144 * MiB, WS_GATE_A = 208 * MiB;
#endif
constexpr size_t WS_X8_LO = 448 * MiB, WS_X8_HI = 58 * MiB;
static_assert(M1_FP8, "the workspace map is laid out for fp8 expert weights");
static_assert(!CONV_BG || X_F32_RES, "CONV_BG puts o2 into the bf16 x region");
static_assert(!GATE_FP8 || (P1_FP8 && (MIX_FP8 & 2) && M1_FP8), "GATE_FP8 needs the fp8 mixer-input GEMM, the fp8 o_a (room behind it) and the fp8 expert weights (room behind them)");
constexpr size_t WS_MERGED8 = 464 * MiB;
constexpr size_t WS_MERGED = 336 * MiB;
constexpr size_t WS_Y = 144 * MiB;
constexpr size_t WS_H = 336 * MiB;
constexpr size_t WS_X1F8 = 464 * MiB;
#if CONV_BG
constexpr size_t WS_O2 = 80 * MiB;
#else
constexpr size_t WS_O2 = 26 * MiB;
#endif
constexpr size_t WS_O3 = 464 * MiB;
constexpr size_t WS_LSE2 = 496 * MiB, WS_LSE3 = 497 * MiB;
constexpr size_t WS_END = 512 * MiB;
constexpr int MAXSLOT = 69632;
constexpr int CW_BAR = 4096;
constexpr int CW_CNT = 16384;
constexpr int CW_CHK = 24576;
namespace pg8 {
#define PG8_LAS __attribute__((address_space(3)))
typedef unsigned short bf16_t;
typedef short bf16x8 __attribute__((ext_vector_type(8)));
typedef float f32x4 __attribute__((ext_vector_type(4)));
typedef unsigned u32x4 __attribute__((ext_vector_type(4)));
typedef unsigned u32x2_ __attribute__((ext_vector_type(2)));
constexpr int BM = 256, BK = 64, HALF = 128, HTB = HALF * BK * 2  , STAGE_BYTES = 8 * HTB, NXCD = 8, WGM = 8;

__device__ __forceinline__ int lane_id() { int x; asm volatile("v_mbcnt_lo_u32_b32 %0, -1, 0\n\tv_mbcnt_hi_u32_b32 %0, -1, %0" : "=v"(x)); return x; }
__host__ __device__ __forceinline__ int lds_byte(int r, int c) { const int st = (r >> 4) * 2 + (c >> 5), rr = r & 15, cc = c & 31, ob = rr * 64 + cc * 2; return st * 1024 + (ob ^ (((ob >> 9) & 1) << 5)); }
__host__ __device__ __forceinline__ void stage_rc(int b, int& R, int& C) { const int st = b / 1024, sb = b % 1024, swz = sb ^ (((sb >> 9) & 1) << 5); R = (st >> 1) * 16 + swz / 64; C = (st & 1) * 32 + (swz % 64) / 2; }
__host__ __device__ __forceinline__ int perm32(int rho) { const int n = rho >> 4, i = rho & 15; return 8 * (i >> 2) + 4 * n + (i & 3); }

struct Unit { int pm, pn; };
struct Gemm { const bf16_t* A; const bf16_t* Bt; int M, N, K; int spm = 1 << 30; long sdelta = 0; };

struct StaticOrder {
    int nM, nN, nwg, G, c, pn0;
    __host__ __device__ void init(int M, int N, int G_, int c_, int pn0_ = 0) { nM = M / BM; nN = N / BM; nwg = nM * nN; G = G_; c = c_; pn0 = pn0_; }
    __host__ __device__ bool next(int i, Unit& u) const {
        const long L = (long)i * G + c; if (L >= nwg) return false;
        int wgid = (int)L; { const int q = nwg / NXCD, r = nwg % NXCD, xcd = wgid % NXCD, off = wgid / NXCD; wgid = (xcd < r ? xcd * (q + 1) : r * (q + 1) + (xcd - r) * q) + off; }
        const int nig = WGM * nN, gid = wgid / nig, fm = gid * WGM, gsz = (nM - fm) < WGM ? (nM - fm) : WGM;
        u.pm = fm + ((wgid % nig) % gsz); u.pn = pn0 + (wgid % nig) / gsz; return true;
    }
    __device__ __forceinline__ void a_ready(const Unit&) const {}
    __device__ __forceinline__ void done(const Unit&, int, int) const {}
};

__device__ __forceinline__ unsigned cvt_pk_bf16(float lo, float hi) { unsigned r; asm volatile("v_cvt_pk_bf16_f32 %0, %1, %2" : "=v"(r) : "v"(lo), "v"(hi)); return r; }
typedef float cvt_f32x2_t __attribute__((ext_vector_type(2))); typedef __bf16 cvt_bf16x2_t __attribute__((ext_vector_type(2)));
__device__ __forceinline__ unsigned cvt_pk_bf16_acc(float lo, float hi) { const cvt_f32x2_t v = {lo, hi}; const cvt_bf16x2_t b = __builtin_convertvector(v, cvt_bf16x2_t); return __builtin_bit_cast(unsigned, b); }
__device__ __forceinline__ float bflo(unsigned w) { return __uint_as_float(w << 16); }
__device__ __forceinline__ float bfhi(unsigned w) { return __uint_as_float(w & 0xffff0000u); }
__device__ __forceinline__ float fsigmoid(float x) { return __builtin_amdgcn_rcpf(1.f + __expf(-x)); }
__device__ __forceinline__ float fsilu(float x) { return x * __builtin_amdgcn_rcpf(1.f + __expf(-x)); }

template <int VAR = 0> struct EpiHcatT {
    static constexpr bool PERM = true, AFTER_DRAIN = false; static constexpr int NSTORE = 16;
    unsigned char* ws; const float* rot; int tile_off;
    __device__ __forceinline__ void operator()(const f32x4 (&acc)[2][2][4][2], const Unit& u, int wr, int wc, int fr, int fq) const {
        if (VAR == 1) {
            float s = 0.f;
#pragma unroll
            for (int ai = 0; ai < 2; ++ai)
#pragma unroll
                for (int bj = 0; bj < 2; ++bj)
#pragma unroll
                    for (int m = 0; m < 4; ++m)
#pragma unroll
                        for (int n = 0; n < 2; ++n) s += (acc[ai][bj][m][n][0] + acc[ai][bj][m][n][1]) + (acc[ai][bj][m][n][2] + acc[ai][bj][m][n][3]);
            ((float*)(ws + WS_O3))[(size_t)(u.pm * 64 + u.pn) * 512 + wr * 256 + wc * 64 + fq * 16 + fr] = s; return;
        }
        const int gt = u.pn + tile_off;
        size_t base_off; int pitch, ct, mode; float sc = 1.f;
        if (gt < 2)       { base_off = WS_QR; pitch = 512;  ct = gt;      mode = 1; }
        else if (gt < 4)  { base_off = WS_KR; pitch = 512;  ct = gt - 2;  mode = 1; sc = 0.08838834764831845f; }
        else if (gt < 8)  { base_off = WS_VR; pitch = 1024; ct = gt - 4;  mode = 0; }
        else if (gt < 12) { base_off = WS_GR; pitch = 1024; ct = gt - 8;  mode = SILU_IN_P3 ? 0 : 2; }
        else if (gt < 14) { base_off = WS_QA; pitch = 512;  ct = gt - 12; mode = 0; sc = 0.18033688011112042f; }
        else if (gt < 16) { base_off = WS_KA; pitch = 512;  ct = gt - 14; mode = 0; }
        else if (gt < 18) { base_off = WS_VA; pitch = 512;  ct = gt - 16; mode = 0; }
        else if (gt < 22) { base_off = WS_GATE_R; pitch = 1024; ct = gt - 18; mode = 3; }
        else              { base_off = WS_GATE_A; pitch = 1024; ct = gt - 22; mode = 3; }
        bf16_t* O = (bf16_t*)(ws + base_off);
        const int row0 = u.pm * BM + wr * 64 + fr, col0 = ct * BM + wc * 32 + 8 * fq;
#pragma unroll
        for (int ai = 0; ai < 2; ++ai)
#pragma unroll
            for (int m = 0; m < 4; ++m) {
                const int row = row0 + ai * HALF + m * 16;
                bf16_t* rowp = O + (size_t)(VAR == 2 ? (row & 255) : row) * pitch + col0;
                f32x4 cs = (f32x4){1.f, 1.f, 1.f, 1.f}, sn = (f32x4){0.f, 0.f, 0.f, 0.f};
                if (mode == 1) { const f32x4* rt = (const f32x4*)(rot + ((size_t)(row & (SEQ - 1)) * 16 + (4 * wc + fq)) * 8); cs = rt[0]; sn = rt[1]; }
#pragma unroll
                for (int bj = 0; bj < 2; ++bj) {
                    f32x4 v0 = acc[ai][bj][m][0], v1 = acc[ai][bj][m][1];
                    if (mode == 1) { const f32x4 a = v0 * cs - v1 * sn, b = v0 * sn + v1 * cs; v0 = a * sc; v1 = b * sc; }
                    else if (mode == 2) {
#pragma unroll
                        for (int e = 0; e < 4; ++e) { v0[e] = fsilu(v0[e]); v1[e] = fsilu(v1[e]); } }
                    else if (mode == 3) {
#pragma unroll
                        for (int e = 0; e < 4; ++e) { v0[e] = fsigmoid(v0[e]); v1[e] = fsigmoid(v1[e]); } }
                    else { v0 = v0 * sc; v1 = v1 * sc; }
                    u32x4 w; w.x = cvt_pk_bf16(v0[0], v0[1]); w.y = cvt_pk_bf16(v0[2], v0[3]); w.z = cvt_pk_bf16(v1[0], v1[1]); w.w = cvt_pk_bf16(v1[2], v1[3]);
                    *(u32x4*)(rowp + bj * HALF) = w;
                }
            }
    }
};

typedef EpiHcatT<0> EpiHcat;

__device__ __forceinline__ unsigned fp8x4_sat(float a, float b, float c, float d) {
    a = __builtin_amdgcn_fmed3f(a, -448.f, 448.f); b = __builtin_amdgcn_fmed3f(b, -448.f, 448.f); c = __builtin_amdgcn_fmed3f(c, -448.f, 448.f); d = __builtin_amdgcn_fmed3f(d, -448.f, 448.f);
    unsigned w = 0u; w = __builtin_amdgcn_cvt_pk_fp8_f32(a, b, w, false); w = __builtin_amdgcn_cvt_pk_fp8_f32(c, d, w, true); return w;
}
template <bool ADD, bool OUT8 = false> struct EpiGate {
    static constexpr bool PERM = true, AFTER_DRAIN = false; static constexpr int NSTORE = 16;
    const bf16_t* gate; bf16_t* O; unsigned char* O8;
    __device__ __forceinline__ void operator()(const f32x4 (&acc)[2][2][4][2], const Unit& u, int wr, int wc, int fr, int fq) const {
        const int row0 = u.pm * BM + wr * 64 + fr, col0 = u.pn * BM + wc * 32 + 8 * fq;
#pragma unroll
        for (int ai = 0; ai < 2; ++ai)
#pragma unroll
            for (int m = 0; m < 4; ++m)
#pragma unroll
                for (int bj = 0; bj < 2; ++bj) {
                    const size_t p = (size_t)(row0 + ai * HALF + m * 16) * 1024 + col0 + bj * HALF;
                    const u32x4 g = *(const u32x4*)(gate + p);
                    f32x4 v0 = acc[ai][bj][m][0], v1 = acc[ai][bj][m][1];
                    v0[0] *= bflo(g.x); v0[1] *= bfhi(g.x); v0[2] *= bflo(g.y); v0[3] *= bfhi(g.y);
                    v1[0] *= bflo(g.z); v1[1] *= bfhi(g.z); v1[2] *= bflo(g.w); v1[3] *= bfhi(g.w);
                    if (ADD) { const u32x4 o = *(const u32x4*)(O + p);
                        v0[0] += bflo(o.x); v0[1] += bfhi(o.x); v0[2] += bflo(o.y); v0[3] += bfhi(o.y);
                        v1[0] += bflo(o.z); v1[1] += bfhi(o.z); v1[2] += bflo(o.w); v1[3] += bfhi(o.w); }
                    if (OUT8) { u32x2_ w8;
                        w8.x = fp8x4_sat(v0[0] * 16.f, v0[1] * 16.f, v0[2] * 16.f, v0[3] * 16.f); w8.y = fp8x4_sat(v1[0] * 16.f, v1[1] * 16.f, v1[2] * 16.f, v1[3] * 16.f);
                        *(u32x2_*)(O8 + p) = w8; }
                    else { u32x4 w; w.x = cvt_pk_bf16(v0[0], v0[1]); w.y = cvt_pk_bf16(v0[2], v0[3]); w.z = cvt_pk_bf16(v1[0], v1[1]); w.w = cvt_pk_bf16(v1[2], v1[3]);
                        *(u32x4*)(O + p) = w; }
                }
    }
};

struct EpiResBf16 {
    static constexpr bool PERM = true, AFTER_DRAIN = false; static constexpr int NSTORE = 16;
    const bf16_t* x; bf16_t* out; float alpha;
    __device__ __forceinline__ void operator()(const f32x4 (&acc)[2][2][4][2], const Unit& u, int wr, int wc, int fr, int fq) const {
        const int row0 = u.pm * BM + wr * 64 + fr, col0 = u.pn * BM + wc * 32 + 8 * fq;
#pragma unroll
        for (int ai = 0; ai < 2; ++ai)
#pragma unroll
            for (int m = 0; m < 4; ++m)
#pragma unroll
                for (int bj = 0; bj < 2; ++bj) {
                    const size_t p = (size_t)(row0 + ai * HALF + m * 16) * 1024 + col0 + bj * HALF;
#if X_F32_RES
                    const f32x4 x0 = *(const f32x4*)((const float*)x + p), x1 = *(const f32x4*)((const float*)x + p + 4);
#else
                    const u32x4 xw = *(const u32x4*)(x + p);
                    const f32x4 x0 = (f32x4){bflo(xw.x), bfhi(xw.x), bflo(xw.y), bfhi(xw.y)}, x1 = (f32x4){bflo(xw.z), bfhi(xw.z), bflo(xw.w), bfhi(xw.w)};
#endif
                    const f32x4 v0 = x0 * alpha + acc[ai][bj][m][0], v1 = x1 * alpha + acc[ai][bj][m][1];
                    u32x4 w; w.x = cvt_pk_bf16(v0[0], v0[1]); w.y = cvt_pk_bf16(v0[2], v0[3]); w.z = cvt_pk_bf16(v1[0], v1[1]); w.w = cvt_pk_bf16(v1[2], v1[3]);
                    *(u32x4*)(out + p) = w;
                }
    }
};

struct EpiSwiGLU {
    static constexpr bool PERM = true, AFTER_DRAIN = false; static constexpr int NSTORE = 16;
    unsigned char* H;
    __device__ __forceinline__ void operator()(const f32x4 (&acc)[2][2][4][2], const Unit& u, int wr, int wc, int fr, int fq) const {
        const int row0 = u.pm * BM + wr * 64 + fr, col0 = (u.pn & 3) * 128 + wc * 16 + 4 * fq;
#pragma unroll
        for (int ai = 0; ai < 2; ++ai)
#pragma unroll
            for (int m = 0; m < 4; ++m)
#pragma unroll
                for (int bj = 0; bj < 2; ++bj) {
                    const f32x4 g = acc[ai][bj][m][0], up = acc[ai][bj][m][1];
                    float h0 = fsilu(g[0]) * up[0] * 8.f, h1 = fsilu(g[1]) * up[1] * 8.f, h2 = fsilu(g[2]) * up[2] * 8.f, h3 = fsilu(g[3]) * up[3] * 8.f;
                    h0 = fminf(fmaxf(h0, -448.f), 448.f); h1 = fminf(fmaxf(h1, -448.f), 448.f); h2 = fminf(fmaxf(h2, -448.f), 448.f); h3 = fminf(fmaxf(h3, -448.f), 448.f);
                    unsigned w = 0u; w = __builtin_amdgcn_cvt_pk_fp8_f32(h0, h1, w, false); w = __builtin_amdgcn_cvt_pk_fp8_f32(h2, h3, w, true);
                    *(unsigned*)(H + (size_t)(row0 + ai * HALF + m * 16) * 512 + col0 + bj * 64) = w;
                }
    }
};

struct EpiRowScale {
    static constexpr bool PERM = true, AFTER_DRAIN = false; static constexpr int NSTORE = 16;
    bf16_t* Y;
    __device__ __forceinline__ void operator()(const f32x4 (&acc)[2][2][4][2], const Unit& u, int wr, int wc, int fr, int fq) const {
        const int row0 = u.pm * BM + wr * 64 + fr, col0 = (u.pn & 3) * BM + wc * 32 + 8 * fq;
#pragma unroll
        for (int ai = 0; ai < 2; ++ai)
#pragma unroll
            for (int m = 0; m < 4; ++m) {
                const int row = row0 + ai * HALF + m * 16;
#pragma unroll
                for (int bj = 0; bj < 2; ++bj) {
                    const f32x4 v0 = acc[ai][bj][m][0], v1 = acc[ai][bj][m][1];
#if Y_FP8
                    u32x2_ w8; w8.x = fp8x4_sat(v0[0] * 16.f, v0[1] * 16.f, v0[2] * 16.f, v0[3] * 16.f); w8.y = fp8x4_sat(v1[0] * 16.f, v1[1] * 16.f, v1[2] * 16.f, v1[3] * 16.f);
                    *(u32x2_*)((unsigned char*)Y + (size_t)row * 1024 + col0 + bj * HALF) = w8;
#else
                    u32x4 w; w.x = cvt_pk_bf16_acc(v0[0], v0[1]); w.y = cvt_pk_bf16_acc(v0[2], v0[3]); w.z = cvt_pk_bf16_acc(v1[0], v1[1]); w.w = cvt_pk_bf16_acc(v1[2], v1[3]);
                    *(u32x4*)(Y + (size_t)row * 1024 + col0 + bj * HALF) = w;
#endif
                }
            }
    }
};

struct MoeOrder {
    int nunits, G, c; const PG8_LAS int* te; const PG8_LAS int* ts; const PG8_LAS int* cnt; const int* ltok; unsigned rowbytes;
    __device__ __forceinline__ bool next(int i, Unit& u) const {
        const int L = i * G + c, rt = (L >> 5) * 8 + (L & 7); if (rt >= (nunits >> 2)) return false;
        u.pm = rt; u.pn = te[rt] * 4 + ((L >> 3) & 3); return true;
    }
    __device__ __forceinline__ unsigned a_row_off(const Unit& u, int row) const {
        const int ex = te[u.pm], pos = (u.pm - ts[ex]) * 256 + row;
        const int tok = pos < cnt[ex] ? ltok[ex * 32768 + pos] : 0;
        return (unsigned)tok * rowbytes;
    }
    __device__ __forceinline__ void a_ready(const Unit&) const {}
    __device__ __forceinline__ void done(const Unit&, int, int) const {}
};

struct ExpertConv { const float* wg; const float* wu; const float* wd; unsigned char* WGU; unsigned char* WD; int gw, nw, grp; };
__device__ __forceinline__ void expert_conv_item(const ExpertConv& c, int j, int lane) {
    const int it = j * c.nw + c.gw, e = it / 384, r = it % 384;
    const float* src; unsigned char* dst; int K, N, mode, nb, kb;
    if (r < 128)      { src = c.wg + (size_t)e * 1024 * 512; dst = c.WGU + (size_t)e * 1024 * 1024; K = 1024; N = 512;  mode = 2; nb = r >> 4; kb = r & 15; }
    else if (r < 256) { src = c.wu + (size_t)e * 1024 * 512; dst = c.WGU + (size_t)e * 1024 * 1024; K = 1024; N = 512;  mode = 3; nb = (r - 128) >> 4; kb = (r - 128) & 15; }
    else              { src = c.wd + (size_t)e * 512 * 1024; dst = c.WD + (size_t)e * 1024 * 512;   K = 512;  N = 1024; mode = 0; nb = (r - 256) >> 3; kb = (r - 256) & 7; }
    const int n4 = nb * 64 + 4 * (lane & 15), k0 = kb * 64 + 16 * (lane >> 4);
    const float* s = src + (size_t)k0 * N + n4;
    f32x4 v[16];
#pragma unroll
    for (int i = 0; i < 16; ++i) v[i] = *(const f32x4*)(s + (size_t)i * N);
#pragma unroll
    for (int jn = 0; jn < 4; ++jn) {
        const int n = n4 + jn, row = mode == 0 ? n : ((n >> 2) << 3) + (n & 3) + (mode == 3 ? 4 : 0);
        u32x4 w;
        w.x = fp8x4_sat(v[0][jn] * 64.f, v[1][jn] * 64.f, v[2][jn] * 64.f, v[3][jn] * 64.f);     w.y = fp8x4_sat(v[4][jn] * 64.f, v[5][jn] * 64.f, v[6][jn] * 64.f, v[7][jn] * 64.f);
        w.z = fp8x4_sat(v[8][jn] * 64.f, v[9][jn] * 64.f, v[10][jn] * 64.f, v[11][jn] * 64.f); w.w = fp8x4_sat(v[12][jn] * 64.f, v[13][jn] * 64.f, v[14][jn] * 64.f, v[15][jn] * 64.f);
        *(u32x4*)(dst + (size_t)row * K + k0) = w;
    }
}
struct GateOrder {
    StaticOrder S4;
    __device__ __forceinline__ bool next(int i, Unit& u) const { Unit t; if (!S4.next(i >> 1, t)) return false; u.pm = t.pm; u.pn = t.pn + 4 * (i & 1); return true; }
    __device__ __forceinline__ void a_ready(const Unit&) const {}
    __device__ __forceinline__ void done(const Unit&, int, int) const {}
};
struct P1Order {
    StaticOrder S; ExpertConv cv;
    __device__ __forceinline__ bool next(int i, Unit& u) const { return S.next(i, u); }
    __device__ __forceinline__ void a_ready(const Unit&) const {}
    __device__ __forceinline__ static int unit_of(int grp, int k) { return (grp + 3 * k) % 9; }
    __device__ __forceinline__ void done(const Unit&, int ui, int lane) const {
        const int d = (ui + 9 - cv.grp) % 9;
        if (ui < 9 && d % 3 == 0 && cv.gw + (d / 3) * cv.nw < 6144) expert_conv_item(cv, d / 3, lane);
    }
};

template <class Epi, class Sched, bool ALIGN_EPI = false, bool SP2 = false, bool GATHER = false, bool FP8 = false, int SEL_W = 0, int SEL_X = 0>
__device__ __forceinline__ void gemm_phase(PG8_LAS unsigned char* lds, const Gemm g, const Sched& S, const Epi& E, const int wid) {
    int tid = wid * 64 + lane_id(); asm volatile("" : "+v"(tid));
    const int lane = tid & 63, wr = wid >> 2, wc = wid & 3, fr = lane & 15, fq = lane >> 4;
    static_assert(SP2, "only the two-super-phase loop is kept");
    typedef int i32x4_ __attribute__((ext_vector_type(4)));
    const int K = g.K, nt = K / BK;
    unsigned voffB[2]; int rA[2], cA2[2];
#pragma unroll
    for (int i = 0; i < 2; ++i) { int R, C; stage_rc(tid * 16 + i * 8192, R, C); const int Rb = Epi::PERM ? ((R & ~31) + perm32(R & 31)) : R;
        rA[i] = R; cA2[i] = C * 2; voffB[i] = (unsigned)(Rb * K + C) * 2u; }
    unsigned vAc[2][2], vAn[2][2];
    const size_t kstep = (size_t)(BK * 2);
    const size_t hstep = (size_t)HALF * K * 2;
    const size_t tstep = 2 * hstep;
    const unsigned ldsw = (unsigned)wid * 1024u;
    const int aoff0 = lds_byte(wr * 64 + fr, fq * 8), aoff1 = aoff0 + 1024;
    const int boff0 = lds_byte(wc * 32 + fr, fq * 8), boff1 = boff0 + 1024;
#define PG8_SA(b, h) (((b) * 2 + (h)) * HTB)
#define PG8_SB(b, h) ((4 + (b) * 2 + (h)) * HTB)
#define PG8_STAGE(bufoff, gbase, voff) do { _Pragma("unroll") for (int _i = 0; _i < 2; ++_i) \
        __builtin_amdgcn_global_load_lds((const unsigned*)((const char*)(gbase) + (voff)[_i]), (PG8_LAS unsigned*)(lds + (bufoff) + ldsw + _i * 8192), 16, 0, 0); } while (0)
#define PG8_LDA(dst, b, h) do { _Pragma("unroll") for (int m = 0; m < 4; ++m) { dst[m][0] = *(const PG8_LAS bf16x8*)(lds + PG8_SA(b, h) + aoff0 + m * 2048); dst[m][1] = *(const PG8_LAS bf16x8*)(lds + PG8_SA(b, h) + aoff1 + m * 2048); } } while (0)
#define PG8_LDB(dst, b, h) do { _Pragma("unroll") for (int n = 0; n < 2; ++n) { dst[n][0] = *(const PG8_LAS bf16x8*)(lds + PG8_SB(b, h) + boff0 + n * 2048); dst[n][1] = *(const PG8_LAS bf16x8*)(lds + PG8_SB(b, h) + boff1 + n * 2048); } } while (0)
#define PG8_CAT8(x) __builtin_shufflevector(__builtin_bit_cast(i32x4_, (x)[0]), __builtin_bit_cast(i32x4_, (x)[1]), 0, 1, 2, 3, 4, 5, 6, 7)
#define PG8_MMA(ai, bj, At, Bt) do { __builtin_amdgcn_s_setprio(1); \
        if constexpr (FP8) { _Pragma("unroll") for (int m = 0; m < 4; ++m) _Pragma("unroll") for (int n = 0; n < 2; ++n) \
            acc[ai][bj][m][n] = __builtin_amdgcn_mfma_scale_f32_16x16x128_f8f6f4(PG8_CAT8(Bt[n]), PG8_CAT8(At[m]), acc[ai][bj][m][n], 0, 0, SEL_W, scl, SEL_X, scl); \
            asm volatile("" : "+v"(acc[ai][bj][0][0]), "+v"(acc[ai][bj][0][1]), "+v"(acc[ai][bj][1][0]), "+v"(acc[ai][bj][1][1]), "+v"(acc[ai][bj][2][0]), "+v"(acc[ai][bj][2][1]), "+v"(acc[ai][bj][3][0]), "+v"(acc[ai][bj][3][1])); } \
        else { _Pragma("unroll") for (int m = 0; m < 4; ++m) _Pragma("unroll") for (int n = 0; n < 2; ++n) _Pragma("unroll") for (int k = 0; k < 2; ++k) \
            acc[ai][bj][m][n] = __builtin_amdgcn_mfma_f32_16x16x32_bf16(Bt[n][k], At[m][k], acc[ai][bj][m][n], 0, 0, 0); } \
        __builtin_amdgcn_s_setprio(0); } while (0)
#define PG8_WAIT_V(n) asm volatile("s_waitcnt vmcnt(" #n ")" ::: "memory")
#define PG8_WAIT_VN(n) asm volatile("s_waitcnt vmcnt(%0)" :: "i"(n) : "memory")
#define PG8_WAIT_L(n) asm volatile("s_waitcnt lgkmcnt(" #n ")" ::: "memory")
#define PG8_BAR __builtin_amdgcn_s_barrier()
#define PG8_SCHED __builtin_amdgcn_sched_barrier(0)
    [[maybe_unused]] int scl = 0x7b7c797f; asm volatile("" : "+v"(scl));
    Unit cur, nxt; int ui = 0;
    if (!S.next(0, cur)) return;
    f32x4 acc[2][2][4][2];
#pragma unroll
    for (int a = 0; a < 2; ++a)
#pragma unroll
        for (int b = 0; b < 2; ++b)
#pragma unroll
            for (int m = 0; m < 4; ++m)
#pragma unroll
                for (int n = 0; n < 2; ++n) acc[a][b][m][n] = (f32x4){0.f, 0.f, 0.f, 0.f};
    bf16x8 At[4][2], B0[2][2], B1[2][2];
    const char* cA = GATHER ? (const char*)g.A : (const char*)g.A + (size_t)cur.pm * tstep + (cur.pm >= g.spm ? g.sdelta : 0L); const char* cB = (const char*)g.Bt + (size_t)cur.pn * tstep;
#pragma unroll
    for (int h = 0; h < 2; ++h)
#pragma unroll
        for (int i = 0; i < 2; ++i) { if constexpr (GATHER) vAc[h][i] = S.a_row_off(cur, h * HALF + rA[i]) + (unsigned)cA2[i]; else vAc[h][i] = (unsigned)((h * HALF + rA[i]) * K) * 2u + (unsigned)cA2[i]; vAn[h][i] = vAc[h][i]; }
    S.a_ready(cur);
    if constexpr (SP2) {
        PG8_STAGE(PG8_SB(0, 0), cB, voffB); PG8_STAGE(PG8_SB(0, 1), cB + hstep, voffB); PG8_STAGE(PG8_SA(0, 0), cA, vAc[0]); PG8_STAGE(PG8_SA(0, 1), cA, vAc[1]);
        if (wr == 1) PG8_BAR;
        PG8_WAIT_V(2); PG8_BAR;
        PG8_STAGE(PG8_SB(1, 0), cB + kstep, voffB); PG8_STAGE(PG8_SA(1, 0), cA + kstep, vAc[0]); PG8_STAGE(PG8_SB(1, 1), cB + hstep + kstep, voffB);
        PG8_WAIT_V(6); PG8_BAR;
    }
    for (;;) {
        const bool has_next = S.next(ui + 1, nxt);
        const char* nA = GATHER ? cA : (has_next ? (const char*)g.A + (size_t)nxt.pm * tstep + (nxt.pm >= g.spm ? g.sdelta : 0L) : cA); const char* nB = has_next ? (const char*)g.Bt + (size_t)nxt.pn * tstep : cB;
        if constexpr (GATHER) { if (has_next) {
#pragma unroll
            for (int h = 0; h < 2; ++h)
#pragma unroll
                for (int i = 0; i < 2; ++i) vAn[h][i] = S.a_row_off(nxt, h * HALF + rA[i]) + (unsigned)cA2[i]; } }
#pragma unroll 1
        for (int t = 0; t < nt; t += 2) {
            const bool last = (t == nt - 2);
            asm volatile("" : "+v"(voffB[0]), "+v"(voffB[1]), "+v"(vAc[0][0]), "+v"(vAc[0][1]), "+v"(vAc[1][0]), "+v"(vAc[1][1]));
            const char* a1 = cA + (size_t)(t + 1) * kstep;
            const char* a2 = last ? nA : cA + (size_t)(t + 2) * kstep; const char* b2 = last ? nB : cB + (size_t)(t + 2) * kstep;
            const char* a3 = a2 + kstep; const char* b3 = b2 + kstep;
            unsigned vA2[2][2];
#pragma unroll
            for (int h = 0; h < 2; ++h)
#pragma unroll
                for (int i = 0; i < 2; ++i) vA2[h][i] = vAc[h][i];
            if constexpr (GATHER) { if (last) {
                asm volatile("" : "+v"(vAn[0][0]), "+v"(vAn[0][1]), "+v"(vAn[1][0]), "+v"(vAn[1][1]));
#pragma unroll
                for (int h = 0; h < 2; ++h)
#pragma unroll
                    for (int i = 0; i < 2; ++i) vA2[h][i] = vAn[h][i]; } }
            if (last && has_next) S.a_ready(nxt);
            if constexpr (SP2) {
            const int lenient = __builtin_amdgcn_readfirstlane((ui > 0 && t == 0) ? 1 : 0);
#define PG8_WAIT_V8L() asm volatile("s_cmp_eq_u32 %0, 0\n\ts_cbranch_scc0 .Lpg8skip%=\n\ts_waitcnt vmcnt(8)\n.Lpg8skip%=:\n\ts_waitcnt vmcnt(%1)" :: "s"(lenient), "i"(8 + Epi::NSTORE) : "memory", "scc")
            PG8_LDB(B0, 0, 0); PG8_LDB(B1, 0, 1); PG8_SCHED; PG8_LDA(At, 0, 0); PG8_STAGE(PG8_SA(1, 1), a1, vAc[1]);
            PG8_WAIT_V8L(); PG8_WAIT_L(0); PG8_BAR; PG8_MMA(0, 0, At, B0); PG8_MMA(0, 1, At, B1); PG8_BAR; PG8_SCHED;
            PG8_LDA(At, 0, 1); PG8_STAGE(PG8_SB(0, 0), b2, voffB); PG8_STAGE(PG8_SB(0, 1), b2 + hstep, voffB); PG8_STAGE(PG8_SA(0, 0), a2, vA2[0]);
            PG8_WAIT_V8L(); PG8_WAIT_L(0); PG8_BAR; PG8_MMA(1, 0, At, B0); PG8_MMA(1, 1, At, B1); PG8_BAR; PG8_SCHED;
            PG8_LDB(B0, 1, 0); PG8_LDB(B1, 1, 1); PG8_SCHED; PG8_LDA(At, 1, 0); PG8_STAGE(PG8_SA(0, 1), a2, vA2[1]);
            PG8_WAIT_V(8); PG8_WAIT_L(0); PG8_BAR; PG8_MMA(0, 0, At, B0); PG8_MMA(0, 1, At, B1); PG8_BAR; PG8_SCHED;
            PG8_LDA(At, 1, 1); PG8_STAGE(PG8_SB(1, 0), b3, voffB); PG8_STAGE(PG8_SB(1, 1), b3 + hstep, voffB); PG8_STAGE(PG8_SA(1, 0), a3, vA2[0]);
            PG8_WAIT_V(8); PG8_WAIT_L(0); PG8_BAR; PG8_MMA(1, 0, At, B0); PG8_MMA(1, 1, At, B1); PG8_BAR; PG8_SCHED;
#undef PG8_WAIT_V8L
            }
        }
        if constexpr (ALIGN_EPI) { if (wr == 0) PG8_BAR; }
        if constexpr (!Epi::AFTER_DRAIN) { const int le = lane_id(); E(acc, cur, wr, wc, le & 15, le >> 4); S.done(cur, ui, le); }
        if (!has_next) break;
#pragma unroll
        for (int a = 0; a < 2; ++a)
#pragma unroll
            for (int b = 0; b < 2; ++b)
#pragma unroll
                for (int m = 0; m < 4; ++m)
#pragma unroll
                    for (int n = 0; n < 2; ++n) acc[a][b][m][n] = (f32x4){0.f, 0.f, 0.f, 0.f};
        cur = nxt; cA = nA; cB = nB; ++ui;
        if constexpr (GATHER) {
#pragma unroll
            for (int h = 0; h < 2; ++h)
#pragma unroll
                for (int i = 0; i < 2; ++i) vAc[h][i] = vAn[h][i]; }
        if constexpr (ALIGN_EPI) { if (wr == 1) PG8_BAR; }
    }
    PG8_WAIT_V(0);
    if constexpr (!ALIGN_EPI) { if (wr == 0) PG8_BAR; }
    PG8_BAR;
    if constexpr (Epi::AFTER_DRAIN) { E.fused(acc, cur, wr, wc, fr, fq, lds, wid, lane); S.done(cur, ui, lane); }
#undef PG8_SA
#undef PG8_SB
#undef PG8_STAGE
#undef PG8_LDA
#undef PG8_LDB
#undef PG8_MMA
#undef PG8_CAT8
#undef PG8_WAIT_V
#undef PG8_WAIT_VN
#undef PG8_WAIT_L
#undef PG8_BAR
#undef PG8_SCHED
}
}
#define GAS __attribute__((address_space(1)))
#define LAS __attribute__((address_space(3)))
typedef unsigned short bf16;
typedef unsigned v4u __attribute__((ext_vector_type(4)));
typedef float f32x4 __attribute__((ext_vector_type(4)));
typedef short bf16x8 __attribute__((ext_vector_type(8)));
typedef GAS unsigned gu32;
typedef GAS unsigned long long gu64;
#define RLX_AGENT __ATOMIC_RELAXED, __HIP_MEMORY_SCOPE_AGENT
#define LDS_WAIT() asm volatile("s_waitcnt lgkmcnt(0)" ::: "memory")
#define VM_WAIT() asm volatile("s_waitcnt vmcnt(0)" ::: "memory")
__device__ __forceinline__ unsigned long long rt() { return __builtin_amdgcn_s_memrealtime(); }
__device__ __forceinline__ unsigned f2bf(float f) { unsigned u = __builtin_bit_cast(unsigned, f); return (u + 0x7fffu + ((u >> 16) & 1u)) >> 16; }
__device__ __forceinline__ unsigned pk2(float lo, float hi) { return f2bf(lo) | (f2bf(hi) << 16); }

#define XB_TMO      128
#define XB_XCNT(j)  (256  + 64 * (j))
#define XB_XSUB(j)  (1280 + 64 * (j))
#define XB_XGEN(j)  (2304 + 64 * (j))
#define XB_TOP      3328
#define XB_TOPGEN   3392
#define XCD_BAR_WORDS 3456
#define XB_SPIN_CAP (1u << 18)

__device__ __forceinline__ unsigned xb_ld(unsigned* p)              { return __hip_atomic_load(p, __ATOMIC_RELAXED, __HIP_MEMORY_SCOPE_AGENT); }
__device__ __forceinline__ unsigned xb_add(unsigned* p, unsigned v) { return __hip_atomic_fetch_add(p, v, __ATOMIC_RELAXED, __HIP_MEMORY_SCOPE_AGENT); }
__device__ __forceinline__ unsigned xb_xcc_id() { return (unsigned)__builtin_amdgcn_s_getreg((3 << 11) | 20) & 0xFu; }
#define XB_SPIN(cond, bar) do { unsigned _sp = 0; while (cond) { __builtin_amdgcn_s_sleep(1); \
    if ((++_sp & 255u) == 0u) { if (xb_ld(&(bar)[XB_TMO])) break; if (_sp > XB_SPIN_CAP) { atomicAdd(&(bar)[XB_TMO], 1u); break; } } } } while (0)

struct XcdBarrier {
    unsigned* bar; unsigned x; int wv;
    volatile LAS unsigned* st;
};

__device__ __forceinline__ XcdBarrier xcd_barrier_post(unsigned* bar, volatile LAS unsigned* st) {
    XcdBarrier b; b.bar = bar; b.x = xb_xcc_id(); b.st = st; b.wv = 0;
    if (threadIdx.x == 0) (void)xb_add(&bar[XB_XCNT(b.x)], 1u);
    return b;
}
__device__ __forceinline__ void xcd_barrier_complete(unsigned* bar, unsigned x, unsigned& nloc, unsigned& nx) {
    const unsigned G = gridDim.x * gridDim.y * gridDim.z;
    unsigned sum, cnt, mine, sp = 0u;
    for (;;) {
        sum = 0u; cnt = 0u; mine = 0u;
#pragma unroll
        for (unsigned j = 0; j < 16; ++j) { const unsigned c = xb_ld(&bar[XB_XCNT(j)]); sum += c; cnt += (c > 0u) ? 1u : 0u; mine = (j == x) ? c : mine; }
        if (sum == G) break;
        __builtin_amdgcn_s_sleep(1);
        if ((++sp & 255u) == 0u) { if (xb_ld(&bar[XB_TMO])) break; if (sp > XB_SPIN_CAP) { atomicAdd(&bar[XB_TMO], 1u); break; } }
    }
    nloc = mine > 0u ? mine : 1u; nx = cnt > 0u ? cnt : 1u;
}

__device__ __forceinline__ void xcd_barrier(const XcdBarrier& b) {
    asm volatile("s_waitcnt vmcnt(0)" ::: "memory");
    __syncthreads();
    if (b.wv == 0 && (int)__builtin_amdgcn_mbcnt_hi(~0u, __builtin_amdgcn_mbcnt_lo(~0u, 0u)) == 0) {
        unsigned* bar = b.bar;
        __builtin_amdgcn_s_waitcnt(0);
        unsigned nloc = b.st[0], nx = b.st[1];
        if (nloc == 0u) { xcd_barrier_complete(bar, b.x, nloc, nx); b.st[0] = nloc; b.st[1] = nx; }
        const unsigned old = xb_add(&bar[XB_XSUB(b.x)], 1u);
        const unsigned gen = old / nloc;
        if (old + 1u == (gen + 1u) * nloc) {
            __builtin_amdgcn_fence(__ATOMIC_RELEASE, "agent");
            asm volatile("s_waitcnt vmcnt(0)" ::: "memory");
            const unsigned og = xb_add(&bar[XB_TOP], 1u);
            const unsigned tg = og / nx;
            if (og + 1u == (tg + 1u) * nx) xb_add(&bar[XB_TOPGEN], 1u);
            else XB_SPIN(xb_ld(&bar[XB_TOPGEN]) == tg, bar);
            __builtin_amdgcn_fence(__ATOMIC_ACQUIRE, "agent");
            xb_add(&bar[XB_XGEN(b.x)], 1u);
            asm volatile("s_waitcnt vmcnt(0)" ::: "memory");
        } else {
            XB_SPIN(xb_ld(&bar[XB_XGEN(b.x)]) == gen, bar);
            __builtin_amdgcn_fence(__ATOMIC_ACQUIRE, "agent");
            asm volatile("s_waitcnt vmcnt(0)" ::: "memory");
        }
    }
    __syncthreads();
}


constexpr int NWAVES = 8;
constexpr int RING_BYTES = 131072;
constexpr int LDSCTL_OFF = RING_BYTES, MISC_OFF = LDSCTL_OFF + 320;
constexpr int LDS_TS_OFF = LDSCTL_OFF + 1024;
constexpr int LDS_TE_OFF = LDSCTL_OFF + 2048;
constexpr int LDS_CNT_OFF = LDSCTL_OFF + 1024 + 128;
constexpr int LDS_BYTES = 163840;

typedef short s16x4 __attribute__((ext_vector_type(4)));
typedef unsigned u32x2 __attribute__((ext_vector_type(2)));

struct Args { const float* in[20]; float* out; unsigned char* ws; unsigned mask; int bar_region; };

__device__ __forceinline__ float bflo(unsigned w) { return __uint_as_float(w << 16); }
__device__ __forceinline__ float bfhi(unsigned w) { return __uint_as_float(w & 0xffff0000u); }
__device__ __forceinline__ unsigned cvtpk(float lo, float hi) { return pg8::cvt_pk_bf16(lo, hi); }
__device__ __forceinline__ float wave_sum(float v) {
#pragma unroll
    for (int o = 1; o < 64; o <<= 1) v += __shfl_xor(v, o);
    return v;
}
__device__ __forceinline__ unsigned offb(unsigned row, unsigned ch) { return 256u * row + 16u * (ch ^ (((row & 3u) << 2) | ((row >> 2) & 3u))); }
__device__ __forceinline__ s16x4 ldtr(const LAS unsigned char* p) { return __builtin_amdgcn_ds_read_tr16_b64_v4i16((LAS s16x4*)p); }
__device__ __forceinline__ bf16x8 cat8(s16x4 a, s16x4 b) { return (bf16x8){a[0], a[1], a[2], a[3], b[0], b[1], b[2], b[3]}; }
#define MFMA16(a, b, c) __builtin_amdgcn_mfma_f32_16x16x32_bf16((a), (b), (c), 0, 0, 0)

template <int MODE> __device__ __forceinline__ int dest_row(int n) {
    if (MODE == 1) { if (n >= 1024) return n; const int hb = n & ~127, d = n & 127, jr = d & 63, half = d >> 6; return hb + 8 * (jr >> 2) + 4 * half + (jr & 3); }
    if (MODE == 2) return ((n >> 2) << 3) + (n & 3);
    if (MODE == 3) return ((n >> 2) << 3) + 4 + (n & 3);
    return n;
}
template <int MODE> __device__ __forceinline__ void p0_transpose_item(const float* W, int K, int N, bf16* WT, LAS float* scr, int item, int lane) {
    const int nblk = N / 32, kb = item / nblk, nb = item % nblk, k0 = 64 * kb, n0 = 32 * nb;
    {
        const GAS f32x4* src = (const GAS f32x4*)(W + (size_t)(k0 + (lane >> 3)) * N + n0) + (lane & 7);
        f32x4 t[8];
#pragma unroll
        for (int j = 0; j < 8; ++j) t[j] = src[(size_t)j * 2 * N];
#pragma unroll
        for (int j = 0; j < 8; ++j) { LAS float* d = scr + ((lane >> 3) + 8 * j) * 33 + 4 * (lane & 7); d[0] = t[j].x; d[1] = t[j].y; d[2] = t[j].z; d[3] = t[j].w; }
    }
    LDS_WAIT(); asm volatile("" ::: "memory");
    const int c = lane & 7;
#pragma unroll
    for (int j = 0; j < 4; ++j) { const int n = (lane >> 3) + 8 * j; const LAS float* s = scr + (8 * c) * 33 + n;
        v4u o; o.x = pk2(s[0 * 33], s[1 * 33]); o.y = pk2(s[2 * 33], s[3 * 33]); o.z = pk2(s[4 * 33], s[5 * 33]); o.w = pk2(s[6 * 33], s[7 * 33]);
        *(GAS v4u*)(WT + (size_t)dest_row<MODE>(n0 + n) * K + k0 + 8 * c) = o; }
    LDS_WAIT(); asm volatile("" ::: "memory");
}
__device__ __forceinline__ unsigned pk_fp8x4(float a, float b, float c, float d) {
    a = fminf(fmaxf(a, -448.f), 448.f); b = fminf(fmaxf(b, -448.f), 448.f); c = fminf(fmaxf(c, -448.f), 448.f); d = fminf(fmaxf(d, -448.f), 448.f);
    unsigned w = 0u; w = __builtin_amdgcn_cvt_pk_fp8_f32(a, b, w, false); w = __builtin_amdgcn_cvt_pk_fp8_f32(c, d, w, true); return w;
}
template <int MODE> __device__ __forceinline__ void p0_transpose_item_fp8(const float* W, int K, int N, unsigned char* WT, LAS float* scr, int item, int lane, float scale) {
    const int nblk = N / 32, kb = item / nblk, nb = item % nblk, k0 = 64 * kb, n0 = 32 * nb;
    {
        const GAS f32x4* src = (const GAS f32x4*)(W + (size_t)(k0 + (lane >> 3)) * N + n0) + (lane & 7);
        f32x4 t[8];
#pragma unroll
        for (int j = 0; j < 8; ++j) t[j] = src[(size_t)j * 2 * N];
#pragma unroll
        for (int j = 0; j < 8; ++j) { LAS float* d = scr + ((lane >> 3) + 8 * j) * 33 + 4 * (lane & 7); d[0] = t[j].x; d[1] = t[j].y; d[2] = t[j].z; d[3] = t[j].w; }
    }
    LDS_WAIT(); asm volatile("" ::: "memory");
    const int c = lane & 7;
#pragma unroll
    for (int j = 0; j < 4; ++j) { const int n = (lane >> 3) + 8 * j; const LAS float* s = scr + (8 * c) * 33 + n;
        u32x2 o; o.x = pk_fp8x4(s[0 * 33] * scale, s[1 * 33] * scale, s[2 * 33] * scale, s[3 * 33] * scale); o.y = pk_fp8x4(s[4 * 33] * scale, s[5 * 33] * scale, s[6 * 33] * scale, s[7 * 33] * scale);
        *(GAS u32x2*)(WT + (size_t)dest_row<MODE>(n0 + n) * K + k0 + 8 * c) = o; }
    LDS_WAIT(); asm volatile("" ::: "memory");
}
__device__ __forceinline__ int t5_bucket(int rel) {
    const int n = rel < 0 ? -rel : rel;
    int large = 8 + (n >= 15) + (n >= 27) + (n >= 50) + (n >= 91) + (n >= 166) + (n >= 305) + (n >= 559);
    large = large < 15 ? large : 15;
    return (rel > 0 ? 16 : 0) + (n < 8 ? n : large);
}
__device__ __forceinline__ void p0_prologue(const Args& a, LAS unsigned char* lds, int vcu, int G, int tid, int wave, int lane) {
    unsigned char* ws = a.ws;
    LAS float* scr = (LAS float*)(lds + wave * 16384);
    const int gw = vcu * NWAVES + wave, NGW = G * NWAVES;
    constexpr int I_IN = 16 * 208, I_R = 16 * 32, I_A = 8 * 32, I_O = 16 * 32;
    constexpr int NITEMS = I_IN + I_R + I_A + I_O;
    for (int it = gw; it < NITEMS; it += NGW) {
        int r = it;
#if P1_FP8
        if (r < I_IN) { if ((GATE_FP8 || r % 208 < 144) && r % 208 >= 8 * P1_FP8_FROM) p0_transpose_item_fp8<1>(a.in[1], 1024, 6656, ws + WS_WIN8, scr, r, lane, 64.f);
                        else p0_transpose_item<1>(a.in[1], 1024, 6656, (bf16*)(ws + WS_WIN), scr, r, lane); continue; } r -= I_IN;
#else
        if (r < I_IN) { p0_transpose_item<1>(a.in[1], 1024, 6656, (bf16*)(ws + WS_WIN), scr, r, lane); continue; } r -= I_IN;
#endif
        if (r < I_R) { if (MIX_FP8 & 4) p0_transpose_item_fp8<0>(a.in[5], 1024, 1024, ws + WS_WR, scr, r, lane, 64.f); else p0_transpose_item<0>(a.in[5], 1024, 1024, (bf16*)(ws + WS_WR), scr, r, lane); continue; } r -= I_R;
        if (r < I_A) { if (MIX_FP8 & 2) p0_transpose_item_fp8<0>(a.in[7], 512, 1024, ws + WS_WA, scr, r, lane, 64.f); else p0_transpose_item<0>(a.in[7], 512, 1024, (bf16*)(ws + WS_WA), scr, r, lane); continue; } r -= I_A;
        if (MIX_FP8 & 1) p0_transpose_item_fp8<0>(a.in[8], 1024, 1024, ws + WS_WO, scr, r, lane, 64.f); else p0_transpose_item<0>(a.in[8], 1024, 1024, (bf16*)(ws + WS_WO), scr, r, lane);
    }
    {
        const f32x4* x4 = (const f32x4*)a.in[0]; u32x2* xb = (u32x2*)(ws + WS_XB);
#if P1_FP8
#if GATE_FP8
        unsigned* xf8 = (unsigned*)(ws + WS_X8_LO);
#define XF8_AT(i) xf8[(long)(i) + ((i) >= (size_t)16384 * 256 ? ((long)WS_X8_HI - (long)WS_X8_LO - (long)(16 * MiB)) / 4 : 0L)]
#else
        unsigned* xf8 = (unsigned*)a.out;
#define XF8_AT(i) xf8[i]
#endif
        const size_t n4 = (size_t)TT * DM / 4, st = (size_t)G * 512; size_t i = (size_t)vcu * 512 + tid;
        for (; i + 7 * st < n4; i += 8 * st) {
            f32x4 v[8];
#pragma unroll
            for (int u = 0; u < 8; ++u) v[u] = x4[i + u * st];
#pragma unroll
            for (int u = 0; u < 8; ++u) { if (!X_F32_RES) { u32x2 o; o.x = cvtpk(v[u].x, v[u].y); o.y = cvtpk(v[u].z, v[u].w); xb[i + u * st] = o; } XF8_AT(i + u * st) = pk_fp8x4(v[u].x, v[u].y, v[u].z, v[u].w); }
        }
        for (; i < n4; i += st) { const f32x4 v = x4[i]; if (!X_F32_RES) { u32x2 o; o.x = cvtpk(v.x, v.y); o.y = cvtpk(v.z, v.w); xb[i] = o; } XF8_AT(i) = pk_fp8x4(v.x, v.y, v.z, v.w); }
#undef XF8_AT
#else
        for (size_t i = (size_t)vcu * 512 + tid; i < (size_t)TT * DM / 4; i += (size_t)G * 512) { const f32x4 v = x4[i]; u32x2 o; o.x = cvtpk(v.x, v.y); o.y = cvtpk(v.z, v.w); xb[i] = o; }
#endif
    }
    {
        float* rot = (float*)(ws + WS_ROT);
        for (int idx = vcu * 512 + tid; idx < SEQ * 64; idx += G * 512) {
            const int pos = idx >> 6, jr = idx & 63;
            double iv = 1.0; for (int k = 0; k < jr; ++k) iv *= 0.86596432336006535;
            const float ang = (float)pos * (float)iv;
            const double xx = (double)ang; const double qd = __builtin_rint(xx * 0.63661977236758134); const int qi = (int)qd;
            const double r = (xx - qd * 1.5707963267948966) - qd * 6.123233995736766e-17, r2 = r * r;
            const double sp = r * (1.0 + r2 * (-1.0 / 6 + r2 * (1.0 / 120 + r2 * (-1.0 / 5040 + r2 * (1.0 / 362880 + r2 * (-1.0 / 39916800 + r2 * (1.0 / 6227020800.0)))))));
            const double cp = 1.0 + r2 * (-0.5 + r2 * (1.0 / 24 + r2 * (-1.0 / 720 + r2 * (1.0 / 40320 + r2 * (-1.0 / 3628800 + r2 * (1.0 / 479001600.0))))));
            const int qq = qi & 3; const double s = qq == 0 ? sp : (qq == 1 ? cp : (qq == 2 ? -sp : -cp)), c = qq == 0 ? cp : (qq == 1 ? -sp : (qq == 2 ? -cp : sp));
            float* o = rot + ((size_t)pos * 16 + (jr >> 2)) * 8 + (jr & 3); o[0] = (float)c; o[4] = (float)s;
        }
    }
    if (vcu == 0) {
        float* bt = (float*)(ws + WS_BIAS); const float* rb = a.in[6];
        for (int idx = tid; idx < 3 * 8 * 160; idx += 512) { const int p = idx / (8 * 160), h = (idx / 160) % 8, d = idx % 160 - 80; const int dil = p == 0 ? 1 : (p == 1 ? 4 : 16);
            bt[idx] = (d >= -64 && d <= 64) ? rb[t5_bucket(d * dil) * 8 + h] * 1.4426950408889634f : -1e30f; }
    }
}
__device__ __forceinline__ void p0_expert_weights(const Args& a, LAS unsigned char* lds, int vcu, int G, int wave, int lane) {
    unsigned char* ws = a.ws;
    LAS float* scr = (LAS float*)(lds + wave * 16384);
    const int gw = vcu * NWAVES + wave, NGW = G * NWAVES;
    constexpr int I_G = 16 * 16, I_D = 8 * 32, PER_E = 2 * I_G + I_D;
    for (int it = gw; it < 16 * PER_E; it += NGW) {
        const int e = it / PER_E; int r = it - e * PER_E;
#if M1_FP8
        if (r < I_G) { p0_transpose_item_fp8<2>(a.in[15] + (size_t)e * 1024 * 512, 1024, 512, ws + WS_WGU + (size_t)e * 1024 * 1024, scr, r, lane, 64.f); continue; } r -= I_G;
        if (r < I_G) { p0_transpose_item_fp8<3>(a.in[16] + (size_t)e * 1024 * 512, 1024, 512, ws + WS_WGU + (size_t)e * 1024 * 1024, scr, r, lane, 64.f); continue; } r -= I_G;
#else
        if (r < I_G) { p0_transpose_item<2>(a.in[15] + (size_t)e * 1024 * 512, 1024, 512, (bf16*)(ws + WS_WGU) + (size_t)e * 1024 * 1024, scr, r, lane); continue; } r -= I_G;
        if (r < I_G) { p0_transpose_item<3>(a.in[16] + (size_t)e * 1024 * 512, 1024, 512, (bf16*)(ws + WS_WGU) + (size_t)e * 1024 * 1024, scr, r, lane); continue; } r -= I_G;
#endif
        p0_transpose_item_fp8<0>(a.in[17] + (size_t)e * 512 * 1024, 512, 1024, ws + WS_WD + (size_t)e * 1024 * 512, scr, r, lane, 64.f);
    }
    __syncthreads();
}

__device__ __forceinline__ float log2_gamma(const float* dec, int h) {
    const float x = dec[h]; return -__log2f(1.f + __expf(-x));
}
__device__ __forceinline__ void chain_item(const Args& a, LAS unsigned char* lds, int item, int tid, int wid, int lane) {
    unsigned char* ws = a.ws;
    const int b = item >> 4, h = (item >> 2) & 3, dir = (item >> 1) & 1, vh = item & 1;
    const float lg2 = log2_gamma(dir ? a.in[3] : a.in[2], h);
    const float cd = __builtin_amdgcn_exp2f(lg2 * 128.f);
    const int g = lane >> 4, i16 = lane & 15, q = i16 >> 2, p = lane & 3;
    const int wd = wid >> 1, wv = wid & 1;
    const GAS bf16* kr = (const GAS bf16*)(ws + WS_KR); const GAS bf16* vr = (const GAS bf16*)(ws + WS_VR);
    GAS bf16* states = (GAS bf16*)a.out;
    f32x4 acc[2][4];
#pragma unroll
    for (int i = 0; i < 2; ++i)
#pragma unroll
        for (int j = 0; j < 4; ++j) acc[i][j] = (f32x4){0.f, 0.f, 0.f, 0.f};
    const int srow = tid >> 4, sch = tid & 15; const unsigned soff = offb(srow, sch);
    const GAS bf16* kp = kr + ((size_t)b * SEQ + srow) * 512 + h * 128 + sch * 8;
    const GAS bf16* vp = vr + ((size_t)b * SEQ + srow) * 1024 + h * 256 + vh * 128 + sch * 8;
    v4u kq[4], vq[4];
    { const int n0 = dir ? 15 : 0;
#pragma unroll
      for (int j = 0; j < 4; ++j) { kq[j] = *(const GAS v4u*)(kp + (size_t)(n0 * 128 + 32 * j) * 512); vq[j] = *(const GAS v4u*)(vp + (size_t)(n0 * 128 + 32 * j) * 1024); } }
    unsigned abase[2][2], bbase[4][2];
#pragma unroll
    for (int t = 0; t < 2; ++t) { const unsigned r = 8 * g + 4 * t + q;
#pragma unroll
        for (int dt = 0; dt < 2; ++dt) abase[dt][t] = offb(r, 2 * (2 * wd + dt) + (p >> 1)) + 8 * (p & 1);
#pragma unroll
        for (int vt = 0; vt < 4; ++vt) bbase[vt][t] = offb(r, 2 * (4 * wv + vt) + (p >> 1)) + 8 * (p & 1); }
#define CH_STAGE(BUFOFF) do { _Pragma("unroll") for (int j = 0; j < 4; ++j) { \
            const int row = srow + 32 * j; const float z = __builtin_amdgcn_exp2f(lg2 * (float)(dir ? row : 127 - row)); const v4u kv = kq[j]; \
            v4u ko; ko.x = cvtpk(bflo(kv.x) * z, bfhi(kv.x) * z); ko.y = cvtpk(bflo(kv.y) * z, bfhi(kv.y) * z); ko.z = cvtpk(bflo(kv.z) * z, bfhi(kv.z) * z); ko.w = cvtpk(bflo(kv.w) * z, bfhi(kv.w) * z); \
            *(LAS v4u*)(lds + (BUFOFF) + soff + j * 8192) = ko; *(LAS v4u*)(lds + (BUFOFF) + 32768 + soff + j * 8192) = vq[j]; } } while (0)
#define CH_FETCH(NN) do { _Pragma("unroll") for (int j = 0; j < 4; ++j) { kq[j] = *(const GAS v4u*)(kp + (size_t)((NN) * 128 + 32 * j) * 512); vq[j] = *(const GAS v4u*)(vp + (size_t)((NN) * 128 + 32 * j) * 1024); } } while (0)
#define CH_STEP(STEP, CUR, OTH) do { const int step_ = (STEP); const int n_ = dir ? 15 - step_ : step_; \
        GAS bf16* sb_ = states + ((((size_t)(b * 4 + h) * 16 + n_) * 2 + dir) * 256) * 128; \
        _Pragma("unroll") for (int dt = 0; dt < 2; ++dt) _Pragma("unroll") for (int vt = 0; vt < 4; ++vt) { \
            const int v_ = vh * 128 + 64 * wv + 16 * vt + i16, d0_ = 32 * wd + 16 * dt + 4 * g; \
            if (STATE_FP8) { *(GAS unsigned*)((GAS unsigned char*)states + (((((size_t)(b * 4 + h) * 16 + n_) * 2 + dir) * 256) + v_) * 128 + d0_) = pg8::fp8x4_sat(acc[dt][vt][0] * 16.f, acc[dt][vt][1] * 16.f, acc[dt][vt][2] * 16.f, acc[dt][vt][3] * 16.f); }   \
            else { u32x2 w_; w_.x = pg8::cvt_pk_bf16_acc(acc[dt][vt][0], acc[dt][vt][1]); w_.y = pg8::cvt_pk_bf16_acc(acc[dt][vt][2], acc[dt][vt][3]);   \
            *(GAS u32x2*)(sb_ + (size_t)v_ * 128 + d0_) = w_; } } \
        if (step_ < 15) CH_STAGE(OTH); \
        if (step_ < 14) CH_FETCH(dir ? 13 - step_ : step_ + 2); \
        _Pragma("unroll") for (int i = 0; i < 2; ++i) _Pragma("unroll") for (int j = 0; j < 4; ++j) acc[i][j] = acc[i][j] * cd; \
        _Pragma("unroll") for (int ks = 0; ks < 4; ++ks) { bf16x8 af[2], bfr[4]; \
            _Pragma("unroll") for (int dt = 0; dt < 2; ++dt) af[dt] = cat8(ldtr(lds + (CUR) + abase[dt][0] + ks * 8192), ldtr(lds + (CUR) + abase[dt][1] + ks * 8192)); \
            _Pragma("unroll") for (int vt = 0; vt < 4; ++vt) bfr[vt] = cat8(ldtr(lds + (CUR) + 32768 + bbase[vt][0] + ks * 8192), ldtr(lds + (CUR) + 32768 + bbase[vt][1] + ks * 8192)); \
            _Pragma("unroll") for (int dt = 0; dt < 2; ++dt) _Pragma("unroll") for (int vt = 0; vt < 4; ++vt) acc[dt][vt] = MFMA16(af[dt], bfr[vt], acc[dt][vt]); } \
        __syncthreads(); } while (0)
    CH_STAGE(0);
    CH_FETCH(dir ? 14 : 1);
    __syncthreads();
    for (int sp = 0; sp < 8; ++sp) { CH_STEP(2 * sp, 0, 65536); CH_STEP(2 * sp + 1, 65536, 0); }
#undef CH_STEP
#undef CH_STAGE
#undef CH_FETCH
}

constexpr int AT_OST = 135168, AT_SCR = AT_OST + 8 * 2048;
constexpr int ATB_N = 160;
struct AttnLane { unsigned kb[2]; unsigned vb[4]; };
__device__ __forceinline__ AttnLane attn_lane(int lane) {
    const int g = lane >> 4, i16 = lane & 15, q4 = i16 >> 2, p = lane & 3; AttnLane L;
#pragma unroll
    for (int s = 0; s < 2; ++s) L.kb[s] = i16 * 128 + (((4 * s + g) ^ ((i16 >> 1) & 7)) * 16);
    const int sw = (2 * g + (q4 >> 1)) & 3;
#pragma unroll
    for (int c = 0; c < 4; ++c) L.vb[c] = (4 * g + q4) * 128 + ((c ^ sw) * 32) + p * 8;
    return L;
}
__device__ __forceinline__ unsigned kimg_off(int row, int c) { return row * 128 + ((c ^ ((row >> 1) & 7)) * 16); }
__device__ __forceinline__ unsigned vimg_off(int row, int c) { return row * 128 + (((c >> 1) ^ ((row >> 1) & 3)) * 32) + (c & 1) * 16; }
__device__ __forceinline__ void attn_core(const LAS unsigned char* Kimg, const LAS unsigned char* Vimg, int R0, int nrows, unsigned tvalid, const bf16x8 (&qf)[2],
                                          const float (&biasr)[36], const AttnLane& L, f32x4 (&O)[4], float& mx, float& lsum) {
    f32x4 D[9];
#pragma unroll
    for (int kt = 0; kt < 9; ++kt) {
        int R = R0 + 16 * kt; R = R < 0 ? 0 : (R > nrows - 16 ? nrows - 16 : R);
        const LAS unsigned char* kp = Kimg + R * 128;
        const bf16x8 k0 = *(const LAS bf16x8*)(kp + L.kb[0]), k1 = *(const LAS bf16x8*)(kp + L.kb[1]);
        f32x4 d = (f32x4){0.f, 0.f, 0.f, 0.f};
        d = MFMA16(k0, qf[0], d); d = MFMA16(k1, qf[1], d); D[kt] = d;
    }
    mx = -1e30f;
#pragma unroll
    for (int kt = 0; kt < 9; ++kt) {
        const float tb = ((tvalid >> kt) & 1u) ? 0.f : -1e30f;
#pragma unroll
        for (int r = 0; r < 4; ++r) { const float x = D[kt][r] + (biasr[4 * kt + r] + tb); D[kt][r] = x; mx = fmaxf(mx, x); }
    }
    mx = fmaxf(mx, __shfl_xor(mx, 16)); mx = fmaxf(mx, __shfl_xor(mx, 32));
    lsum = 0.f;
#pragma unroll
    for (int kt = 0; kt < 9; ++kt)
#pragma unroll
        for (int r = 0; r < 4; ++r) { const float e = __builtin_amdgcn_exp2f(D[kt][r] - mx); D[kt][r] = e; lsum += e; }
    lsum += __shfl_xor(lsum, 16); lsum += __shfl_xor(lsum, 32);
#pragma unroll
    for (int c = 0; c < 4; ++c) O[c] = (f32x4){0.f, 0.f, 0.f, 0.f};
#pragma unroll
    for (int kk = 0; kk < 5; ++kk) {
        int Ra = R0 + 32 * kk; Ra = Ra < 0 ? 0 : (Ra > nrows - 16 ? nrows - 16 : Ra);
        int Rb = R0 + 32 * kk + 16; Rb = Rb < 0 ? 0 : (Rb > nrows - 16 ? nrows - 16 : Rb);
        if (kk == 4) Rb = Ra;
        const f32x4 e0 = D[2 * kk], e1 = kk < 4 ? D[2 * kk + 1] : (f32x4){0.f, 0.f, 0.f, 0.f};
        v4u pw; pw.x = cvtpk(e0[0], e0[1]); pw.y = cvtpk(e0[2], e0[3]); pw.z = cvtpk(e1[0], e1[1]); pw.w = cvtpk(e1[2], e1[3]);
        const bf16x8 pf = __builtin_bit_cast(bf16x8, pw);
        const LAS unsigned char* va_ = Vimg + Ra * 128; const LAS unsigned char* vb_ = Vimg + Rb * 128;
#pragma unroll
        for (int c = 0; c < 4; ++c) O[c] = MFMA16(pf, cat8(ldtr(va_ + L.vb[c]), ldtr(vb_ + L.vb[c])), O[c]);
    }
}
__device__ __forceinline__ void attn_stage_out(LAS unsigned char* lds, int wid, int lane, const f32x4 (&O)[4], float lsum) {
    const int g = lane >> 4, i16 = lane & 15;
    const float linv = 1.f / lsum;
    LAS bf16* st = (LAS bf16*)(lds + AT_OST + wid * 2048);
#pragma unroll
    for (int r = 0; r < 4; ++r) { const float li = __shfl(linv, 4 * g + r);
#pragma unroll
        for (int c = 0; c < 4; ++c) st[(4 * g + r) * 64 + 16 * c + i16] = (bf16)(cvtpk(O[c][r] * li, 0.f) & 0xffffu); }
}
__device__ __forceinline__ void attn_load_bias(const Args& a, int pat, int h, int lane, float (&biasr)[36]) {
    const GAS float* bt = (const GAS float*)(a.ws + WS_BIAS) + (pat * 8 + h) * ATB_N; const int g = lane >> 4, i16 = lane & 15;
#pragma unroll
    for (int kt = 0; kt < 9; ++kt)
#pragma unroll
        for (int r = 0; r < 4; ++r) biasr[4 * kt + r] = bt[16 * kt + 4 * g + r - 64 - i16 + 80];
}
template <int DIL, int VAR = 0> __device__ __forceinline__ void attn_dil_phase(const Args& a, LAS unsigned char* lds, int vcu, int G, int tid, int wid, int lane) {
    unsigned char* ws = a.ws;
    constexpr int NR = SEQ / DIL, PAT = DIL == 4 ? 1 : 2, CH = NR * 8 / 512, NITEM = NB * 8 * DIL;
    constexpr int NBUF = DIL == 16 ? 2 : 1, BUFB = 2 * NR * 128;
    const GAS bf16* qa = (const GAS bf16*)(ws + WS_QA); const GAS bf16* ka = (const GAS bf16*)(ws + WS_KA); const GAS bf16* va = (const GAS bf16*)(ws + WS_VA);
    bf16* op = (bf16*)(ws + (DIL == 4 ? WS_O2 : WS_O3)); float* lsep = (float*)(ws + (DIL == 4 ? WS_LSE2 : WS_LSE3));
    if (vcu >= NITEM) return;
    const int h = vcu & 7;
    float biasr[36]; attn_load_bias(a, PAT, h, lane, biasr);
    const AttnLane L = attn_lane(lane);
    const int g = lane >> 4, i16 = lane & 15;
    v4u kq[CH], vq[CH]; bf16x8 qn[2];
    auto issue = [&](int item, int gi) {
        const int rho = (item >> 3) % DIL, b = item / (8 * DIL); const size_t rowb = (size_t)b * SEQ;
#pragma unroll
        for (int j = 0; j < CH; ++j) { const int id = tid + 512 * j, row = id >> 3, c = id & 7; const size_t go = (rowb + (size_t)row * DIL + rho) * 512 + h * 64 + c * 8;
            kq[j] = *(const GAS v4u*)(ka + go); vq[j] = *(const GAS v4u*)(va + go); }
        const size_t qpos = rowb + (size_t)(16 * gi + i16) * DIL + rho;
#pragma unroll
        for (int s = 0; s < 2; ++s) qn[s] = *(const GAS bf16x8*)(qa + qpos * 512 + h * 64 + 32 * s + 8 * g);
    };
    issue(vcu, wid);
    int buf = 0;
    for (int item = vcu; item < NITEM; item += G) {
        const int rho = (item >> 3) % DIL, b = item / (8 * DIL); const size_t rowb = (size_t)b * SEQ;
        LAS unsigned char* Kimg = lds + buf * BUFB; LAS unsigned char* Vimg = Kimg + NR * 128;
        if (NBUF == 1) __syncthreads();
#pragma unroll
        for (int j = 0; j < CH; ++j) { const int id = tid + 512 * j, row = id >> 3, c = id & 7;
            *(LAS v4u*)(Kimg + kimg_off(row, c)) = kq[j]; *(LAS v4u*)(Vimg + vimg_off(row, c)) = vq[j]; }
        bf16x8 qf[2] = {qn[0], qn[1]};
        __syncthreads();
        if (NBUF == 2 && item + G < NITEM) issue(item + G, wid);
        for (int gi = wid; gi < NR / 16; gi += 8) {
            const int m0 = 16 * gi;
            if (NBUF == 1 && gi + 8 < NR / 16) {
                const size_t qpos = rowb + (size_t)(m0 + 128 + i16) * DIL + rho;
#pragma unroll
                for (int s = 0; s < 2; ++s) qn[s] = *(const GAS bf16x8*)(qa + qpos * 512 + h * 64 + 32 * s + 8 * g); }
            unsigned tvalid = 0u;
#pragma unroll
            for (int kt = 0; kt < 9; ++kt) { const int t0 = m0 - 64 + 16 * kt; tvalid |= (t0 >= 0 && t0 < NR) ? (1u << kt) : 0u; }
            f32x4 O[4]; float mx, lsum;
            if (VAR == 1) { mx = 0.f; lsum = 1.f;
#pragma unroll
                for (int c = 0; c < 4; ++c) O[c] = (f32x4){__builtin_bit_cast(float, qf[0][0] + c), 0.f, 0.f, 0.f}; }
            else attn_core(Kimg, Vimg, m0 - 64, NR, tvalid, qf, biasr, L, O, mx, lsum);
            attn_stage_out(lds, wid, lane, O, lsum);
            if (g == 0) lsep[(rowb + (size_t)(m0 + i16) * DIL + rho) * 8 + h] = mx + __log2f(lsum);
            asm volatile("s_waitcnt lgkmcnt(0)" ::: "memory");
            { const int q = lane >> 2, qt = lane & 3; const LAS v4u* sp = (const LAS v4u*)(lds + AT_OST + wid * 2048 + q * 128 + qt * 32);
              const v4u x0 = sp[0], x1 = sp[1]; bf16* dst = op + (rowb + (size_t)(m0 + q) * DIL + rho) * 512 + h * 64 + qt * 16;
              *(v4u*)dst = x0; *(v4u*)(dst + 8) = x1; }
            asm volatile("s_waitcnt lgkmcnt(0)" ::: "memory");
            if (NBUF == 1) { qf[0] = qn[0]; qf[1] = qn[1]; }
        }
        if (NBUF == 1 && item + G < NITEM) issue(item + G, wid);
        buf ^= (NBUF - 1);
    }
    __syncthreads();
}
__device__ __forceinline__ void attn_p1_phase(const Args& a, LAS unsigned char* lds, int vcu, int G, int tid, int wid, int lane) {
    unsigned char* ws = a.ws;
    LAS unsigned char* Kimg = lds; LAS unsigned char* Vimg = lds + 384 * 128;
    const GAS bf16* qa = (const GAS bf16*)(ws + WS_QA); const GAS bf16* ka = (const GAS bf16*)(ws + WS_KA); const GAS bf16* va = (const GAS bf16*)(ws + WS_VA);
    const GAS bf16* o2 = (const GAS bf16*)(ws + WS_O2); const GAS bf16* o3 = (const GAS bf16*)(ws + WS_O3);
    const GAS float* lse2 = (const GAS float*)(ws + WS_LSE2); const GAS float* lse3 = (const GAS float*)(ws + WS_LSE3);
    bf16* oa = (bf16*)(ws + WS_OA);
    if (vcu >= 1024) return;
    const int h = vcu & 7;
    float biasr[36]; attn_load_bias(a, 0, h, lane, biasr);
    const AttnLane L = attn_lane(lane);
    const int g = lane >> 4, i16 = lane & 15;
    LAS float* scr = (LAS float*)(lds + AT_SCR) + wid * 16;
    v4u kq[6], vq[6];
    auto issue = [&](int item) { const int b = item >> 6, s0 = ((item >> 3) & 7) * 256; const size_t rowb = (size_t)b * SEQ;
#pragma unroll
        for (int j = 0; j < 6; ++j) { const int id = tid + 512 * j, row = id >> 3, c = id & 7, pos = s0 - 64 + row; const bool ok = pos >= 0 && pos < SEQ;
            const size_t go = (rowb + (size_t)(ok ? pos : 0)) * 512 + h * 64 + c * 8;
            kq[j] = *(const GAS v4u*)(ka + go); vq[j] = *(const GAS v4u*)(va + go);
            if (!ok) { kq[j] = (v4u){0u, 0u, 0u, 0u}; vq[j] = (v4u){0u, 0u, 0u, 0u}; } } };
    issue(vcu);
    for (int item = vcu; item < 1024; item += G) {
        const int b = item >> 6, s0 = ((item >> 3) & 7) * 256; const size_t rowb = (size_t)b * SEQ;
        __syncthreads();
#pragma unroll
        for (int j = 0; j < 6; ++j) { const int id = tid + 512 * j, row = id >> 3, c = id & 7;
            *(LAS v4u*)(Kimg + kimg_off(row, c)) = kq[j]; *(LAS v4u*)(Vimg + vimg_off(row, c)) = vq[j]; }
        __syncthreads();
        if (item + G < 1024) issue(item + G);
        for (int gi = wid; gi < 16; gi += 8) {
            const int m0 = s0 + 16 * gi;
            const int q = lane >> 2, qt = lane & 3; const size_t tq = rowb + m0 + q;
            const v4u a20 = *(const GAS v4u*)(o2 + tq * 512 + h * 64 + qt * 16), a21 = *(const GAS v4u*)(o2 + tq * 512 + h * 64 + qt * 16 + 8);
            const v4u a30 = *(const GAS v4u*)(o3 + tq * 512 + h * 64 + qt * 16), a31 = *(const GAS v4u*)(o3 + tq * 512 + h * 64 + qt * 16 + 8);
            const float l2 = lse2[tq * 8 + h], l3 = lse3[tq * 8 + h];
            bf16x8 qf[2];
#pragma unroll
            for (int s = 0; s < 2; ++s) qf[s] = *(const GAS bf16x8*)(qa + (rowb + m0 + i16) * 512 + h * 64 + 32 * s + 8 * g);
            unsigned tvalid = 0u;
#pragma unroll
            for (int kt = 0; kt < 9; ++kt) { const int t0 = m0 - 64 + 16 * kt; tvalid |= (t0 >= 0 && t0 < SEQ) ? (1u << kt) : 0u; }
            f32x4 O[4]; float mx, lsum;
            attn_core(Kimg, Vimg, 16 * gi, 384, tvalid, qf, biasr, L, O, mx, lsum);
            attn_stage_out(lds, wid, lane, O, lsum);
            if (g == 0) scr[i16] = mx + __log2f(lsum);
            asm volatile("s_waitcnt lgkmcnt(0)" ::: "memory");
            {
                const float l1 = scr[q], M = fmaxf(l1, fmaxf(l2, l3));
                float w1 = __builtin_amdgcn_exp2f(l1 - M), w2 = __builtin_amdgcn_exp2f(l2 - M), w3 = __builtin_amdgcn_exp2f(l3 - M); const float wi = 1.f / (w1 + w2 + w3); w1 *= wi; w2 *= wi; w3 *= wi;
                const LAS v4u* sp = (const LAS v4u*)(lds + AT_OST + wid * 2048 + q * 128 + qt * 32);
                const v4u x0 = sp[0], x1 = sp[1];
                v4u r0, r1;
#define MRG(d, x, y, z) d = cvtpk(w1 * bflo(x) + w2 * bflo(y) + w3 * bflo(z), w1 * bfhi(x) + w2 * bfhi(y) + w3 * bfhi(z))
                MRG(r0.x, x0.x, a20.x, a30.x); MRG(r0.y, x0.y, a20.y, a30.y); MRG(r0.z, x0.z, a20.z, a30.z); MRG(r0.w, x0.w, a20.w, a30.w);
                MRG(r1.x, x1.x, a21.x, a31.x); MRG(r1.y, x1.y, a21.y, a31.y); MRG(r1.z, x1.z, a21.z, a31.z); MRG(r1.w, x1.w, a21.w, a31.w);
#undef MRG
#if MIX_FP8 & 2
                v4u o8;
                o8.x = pk_fp8x4(16.f * bflo(r0.x), 16.f * bfhi(r0.x), 16.f * bflo(r0.y), 16.f * bfhi(r0.y)); o8.y = pk_fp8x4(16.f * bflo(r0.z), 16.f * bfhi(r0.z), 16.f * bflo(r0.w), 16.f * bfhi(r0.w));
                o8.z = pk_fp8x4(16.f * bflo(r1.x), 16.f * bfhi(r1.x), 16.f * bflo(r1.y), 16.f * bfhi(r1.y)); o8.w = pk_fp8x4(16.f * bflo(r1.z), 16.f * bfhi(r1.z), 16.f * bflo(r1.w), 16.f * bfhi(r1.w));
                *(v4u*)((unsigned char*)oa + tq * 512 + h * 64 + qt * 16) = o8;
#else
                bf16* dst = oa + tq * 512 + h * 64 + qt * 16;
                *(v4u*)dst = r0; *(v4u*)(dst + 8) = r1;
#endif
            }
            asm volatile("s_waitcnt lgkmcnt(0)" ::: "memory");
        }
    }
    __syncthreads();
}

#define OPAQUE(x) asm volatile("" : "+v"(x))
template <int VAR = 0> __device__ __forceinline__ void p3_phase(const Args& a, LAS unsigned char* lds, int vcu, int G, int tid, int wid, int lane) {
    unsigned char* ws = a.ws;
    const int g = lane >> 4, i16 = lane & 15, q4 = i16 >> 2, p = lane & 3;
    const GAS bf16* qr = (const GAS bf16*)(ws + WS_QR); const GAS bf16* kr = (const GAS bf16*)(ws + WS_KR); const GAS bf16* vr = (const GAS bf16*)(ws + WS_VR);
    GAS bf16* gr = (GAS bf16*)(ws + WS_GR);
    LAS unsigned char* Kt = lds; LAS unsigned char* Sg = lds + 32768;
    if (vcu >= 1024) return;
    const unsigned kdst = offb(tid >> 4, tid & 15);
    unsigned rfo[4];
    { const unsigned X = ((i16 & 3) << 2) | (i16 >> 2);
#pragma unroll
      for (int s = 0; s < 4; ++s) rfo[s] = 256 * i16 + 16 * (((4 * s) ^ (X & 12)) | (g ^ (X & 3))); }
    v4u sreg[8], kreg[4]; bf16x8 qn[4];
    auto item_ptrs = [&](int item, size_t& tok0, const GAS bf16*& sf, int& h) { const int b = item >> 6; h = (item >> 4) & 3; const int n = item & 15; tok0 = (size_t)b * SEQ + n * 128;
        sf = (const GAS bf16*)((const GAS unsigned char*)a.out + ((((size_t)(b * 4 + h) * 16 + n) * 2 + 0) * 256) * 128 * (STATE_FP8 ? 1 : 2)); };
    auto issue_k = [&](int item) { size_t tok0; const GAS bf16* sf; int h; item_ptrs(item, tok0, sf, h);
        const GAS bf16* ks_ = kr + (tok0 + (tid >> 4)) * 512 + h * 128 + (tid & 15) * 8;
#pragma unroll
        for (int j = 0; j < 4; ++j) kreg[j] = *(const GAS v4u*)(ks_ + (size_t)j * 32 * 512); };
    auto issue_q = [&](int item) { size_t tok0; const GAS bf16* sf; int h; item_ptrs(item, tok0, sf, h);
#pragma unroll
        for (int s = 0; s < 4; ++s) qn[s] = *(const GAS bf16x8*)(qr + (tok0 + 16 * wid + i16) * 512 + h * 128 + 32 * s + 8 * g); };
#if STATE_FP8
    auto issue_state = [&](const GAS bf16* sf, int dirn) { const GAS unsigned char* sld = (const GAS unsigned char*)sf + (size_t)dirn * 256 * 128 + (size_t)(tid >> 4) * 128 + (tid & 15) * 8;
#pragma unroll
        for (int j = 0; j < 4; ++j) { const u32x2 lo = *(const GAS u32x2*)(sld + (size_t)(2 * j) * 32 * 128), hi = *(const GAS u32x2*)(sld + (size_t)(2 * j + 1) * 32 * 128); sreg[j] = (v4u){lo.x, lo.y, hi.x, hi.y}; } };
    auto write_state = [&]() {
#pragma unroll
        for (int j = 0; j < 8; ++j) { typedef float f2_ __attribute__((ext_vector_type(2)));
            const unsigned w0 = (j & 1) ? sreg[j >> 1].z : sreg[j >> 1].x, w1 = (j & 1) ? sreg[j >> 1].w : sreg[j >> 1].y;
            const f2_ a0 = __builtin_amdgcn_cvt_pk_f32_fp8(w0, false), a1 = __builtin_amdgcn_cvt_pk_f32_fp8(w0, true), a2 = __builtin_amdgcn_cvt_pk_f32_fp8(w1, false), a3 = __builtin_amdgcn_cvt_pk_f32_fp8(w1, true);
            v4u o; o.x = cvtpk(a0[0], a0[1]); o.y = cvtpk(a1[0], a1[1]); o.z = cvtpk(a2[0], a2[1]); o.w = cvtpk(a3[0], a3[1]);
            *(LAS v4u*)(Sg + (j >> 2) * 32768 + kdst + (j & 3) * 8192) = o; asm volatile("" ::: "memory"); } };
#else
    auto issue_state = [&](const GAS bf16* sf, int dirn) { const GAS bf16* sld = sf + (size_t)dirn * 256 * 128 + (size_t)(tid >> 4) * 128 + (tid & 15) * 8;
#pragma unroll
        for (int j = 0; j < 8; ++j) sreg[j] = *(const GAS v4u*)(sld + (size_t)j * 32 * 128); };
    auto write_state = [&]() {
#pragma unroll
        for (int j = 0; j < 8; ++j) *(LAS v4u*)(Sg + (j >> 2) * 32768 + kdst + (j & 3) * 8192) = sreg[j]; };
#endif
    { size_t tok0; const GAS bf16* sf; int h; item_ptrs(vcu, tok0, sf, h); issue_k(vcu); issue_q(vcu); issue_state(sf, 0); }
#pragma unroll
    for (int j = 0; j < 4; ++j) *(LAS v4u*)(Kt + kdst + j * 8192) = kreg[j];
    for (int item = vcu; item < 1024; item += G) {
        size_t tok0; const GAS bf16* sf; int h; item_ptrs(item, tok0, sf, h);
        const float lf2 = log2_gamma(a.in[2], h), lb2 = log2_gamma(a.in[3], h);
        bf16x8 qf[4];
#pragma unroll
        for (int s = 0; s < 4; ++s) qf[s] = qn[s];
        const bool has_next = item + G < 1024;
        __syncthreads();
        f32x4 D[8];
#pragma unroll
        for (int jt = 0; jt < 8; ++jt) {
            f32x4 d = (f32x4){0.f, 0.f, 0.f, 0.f};
#pragma unroll
            for (int s = 0; s < 4; ++s) { if (VAR != 1) { const bf16x8 kf = *(const LAS bf16x8*)(Kt + rfo[s] + jt * 4096); d = MFMA16(kf, qf[s], d); } else d[s] = __builtin_bit_cast(float, (int)qf[s][0]); }
            D[jt] = d;
        }
        int iq = 16 * wid + i16; OPAQUE(iq);
        bf16x8 pf[4];
#pragma unroll
        for (int ks = 0; ks < 4; ++ks) {
            float e[8];
#pragma unroll
            for (int t = 0; t < 2; ++t)
#pragma unroll
                for (int r = 0; r < 4; ++r) {
                    const int j = 16 * (2 * ks + t) + 4 * g + r; const float fdf = (float)(iq - j), ad = fabsf(fdf);
                    const float pos = fminf(fmaxf(fdf, 0.f), 1.f), isz = 1.f - fminf(ad, 1.f);
                    const float w = __builtin_amdgcn_exp2f((lb2 + (lf2 - lb2) * pos) * ad) + isz;
                    e[4 * t + r] = D[2 * ks + t][r] * w;
                }
            v4u pw; pw.x = cvtpk(e[0], e[1]); pw.y = cvtpk(e[2], e[3]); pw.z = cvtpk(e[4], e[5]); pw.w = cvtpk(e[6], e[7]);
            pf[ks] = __builtin_bit_cast(bf16x8, pw);
        }
        f32x4 acc[16];
#pragma unroll
        for (int vt = 0; vt < 16; ++vt) acc[vt] = (f32x4){0.f, 0.f, 0.f, 0.f};
#pragma unroll
        for (int dirn = 0; dirn < 2; ++dirn) {
            if (dirn == 1) __syncthreads();
            write_state();
            if (dirn == 0) { issue_state(sf, 1); if (has_next) issue_k(item + G); }
            else {
                if (has_next) {
#pragma unroll
                    for (int j = 0; j < 4; ++j) *(LAS v4u*)(Kt + kdst + j * 8192) = kreg[j]; }
                const GAS bf16* vs_ = vr + (tok0 + (tid >> 5)) * 1024 + h * 256 + (tid & 31) * 8;
#pragma unroll
                for (int j = 0; j < 8; ++j) sreg[j] = *(const GAS v4u*)(vs_ + (size_t)j * 16 * 1024);
            }
            __syncthreads();
#pragma unroll
            for (int vt = 0; vt < 16; ++vt) {
#pragma unroll
                for (int s = 0; s < 4; ++s) { if (VAR != 1) { const bf16x8 sfr = *(const LAS bf16x8*)(Sg + (vt >> 3) * 32768 + rfo[s] + (vt & 7) * 4096); acc[vt] = MFMA16(qf[s], sfr, acc[vt]); } }
            }
            float xs[4];
            { int ib = 16 * wid + 4 * g; OPAQUE(ib);
#pragma unroll
              for (int r = 0; r < 4; ++r) { const float lxf = lf2 * (float)(ib + r + 1), lxb = lb2 * (float)(128 - ib - r); xs[r] = __builtin_amdgcn_exp2f(dirn == 0 ? lxf - lxb : lxb - (STATE_FP8 ? 4.f : 0.f)); } }
#pragma unroll
            for (int vt = 0; vt < 16; ++vt)
#pragma unroll
                for (int r = 0; r < 4; ++r) acc[vt][r] *= xs[r];
        }
        __syncthreads();
        { int t2 = tid; OPAQUE(t2); const unsigned vd2 = (unsigned)((t2 & 31) >> 4) * 32768u + offb(t2 >> 5, t2 & 15);
#pragma unroll
          for (int j = 0; j < 8; ++j) *(LAS v4u*)(Sg + vd2 + j * 4096) = sreg[j]; }
        GAS bf16* gp = gr + (tok0 + 16 * wid + (lane >> 5)) * 1024 + h * 256 + (lane & 31) * 8;
#if MIX_FP8 & 4
        GAS unsigned char* ar8 = (GAS unsigned char*)(ws + WS_AR8) + (tok0 + 16 * wid + (lane >> 5)) * 1024 + h * 256 + (lane & 31) * 8;
#endif
        __syncthreads();
        unsigned vbs[8];
        { int l2 = lane; OPAQUE(l2); const unsigned g2 = l2 >> 4, q2 = (l2 & 15) >> 2, p2 = l2 & 3, X = (q2 << 2) | g2;
#pragma unroll
          for (int c = 0; c < 8; ++c) vbs[c] = 256 * (4 * g2 + q2) + 16 * (((2 * c) ^ (X & 14)) | ((p2 >> 1) ^ (X & 1))) + 8 * (p2 & 1); }
#pragma unroll
        for (int vt = 0; vt < 16; ++vt) {
#pragma unroll
            for (int ks = 0; ks < 4; ++ks) { if (VAR != 1) {
                const s16x4 lo = ldtr(Sg + vbs[vt & 7] + (vt >> 3) * 32768 + ks * 8192), hi = ldtr(Sg + vbs[vt & 7] + (vt >> 3) * 32768 + ks * 8192 + 4096);
                acc[vt] = MFMA16(pf[ks], cat8(lo, hi), acc[vt]); }
            }
            asm volatile("" ::: "memory");
        }
        float mu[4], rs[4];
#pragma unroll
        for (int r = 0; r < 4; ++r) {
            float s = 0.f;
#pragma unroll
            for (int vt = 0; vt < 16; ++vt) s += acc[vt][r];
            s += __shfl_xor(s, 1); s += __shfl_xor(s, 2); s += __shfl_xor(s, 4); s += __shfl_xor(s, 8);
            const float m = s * (1.f / 256.f); float qv = 0.f;
#pragma unroll
            for (int vt = 0; vt < 16; ++vt) { const float d = acc[vt][r] - m; qv += d * d; }
            qv += __shfl_xor(qv, 1); qv += __shfl_xor(qv, 2); qv += __shfl_xor(qv, 4); qv += __shfl_xor(qv, 8);
            mu[r] = m; rs[r] = 1.f / sqrtf(qv * (1.f / 256.f) + LN_EPSF);
        }
        v4u greg[8];
#pragma unroll
        for (int j = 0; j < 8; ++j) greg[j] = *(const GAS v4u*)(gp + (size_t)j * 2048);
        __syncthreads();
        if (has_next) { size_t tk; const GAS bf16* sfn; int hn; item_ptrs(item + G, tk, sfn, hn); issue_state(sfn, 0); issue_q(item + G); }
        LAS bf16* st = (LAS bf16*)(Sg + wid * 8192);
        { LAS bf16* sp_ = st + (4 * g) * 256 + i16;
#pragma unroll
          for (int vt = 0; vt < 16; ++vt)
#pragma unroll
              for (int r = 0; r < 4; ++r) sp_[r * 256 + 16 * vt] = (bf16)(cvtpk((acc[vt][r] - mu[r]) * rs[r], 0.f) & 0xffffu); }
        asm volatile("s_waitcnt lgkmcnt(0)" ::: "memory");
        {
            const float* gn = a.in[4] + h * 256; const int ch = lane & 31;
            const f32x4 g0 = *(const f32x4*)(gn + ch * 8), g1 = *(const f32x4*)(gn + ch * 8 + 4);
            const LAS bf16* yp = st + (lane >> 5) * 256 + ch * 8;
#pragma unroll
            for (int j = 0; j < 8; ++j) {
                const v4u y = *(const LAS v4u*)(yp + j * 512); const v4u sg = greg[j];
#if SILU_IN_P3
#define GSW(w, hi) pg8::fsilu((hi) ? bfhi(w) : bflo(w))
#else
#define GSW(w, hi) ((hi) ? bfhi(w) : bflo(w))
#endif
                v4u o; o.x = cvtpk(bflo(y.x) * g0[0] * GSW(sg.x, 0), bfhi(y.x) * g0[1] * GSW(sg.x, 1)); o.y = cvtpk(bflo(y.y) * g0[2] * GSW(sg.y, 0), bfhi(y.y) * g0[3] * GSW(sg.y, 1));
                o.z = cvtpk(bflo(y.z) * g1[0] * GSW(sg.z, 0), bfhi(y.z) * g1[1] * GSW(sg.z, 1)); o.w = cvtpk(bflo(y.w) * g1[2] * GSW(sg.w, 0), bfhi(y.w) * g1[3] * GSW(sg.w, 1));
#undef GSW
#if MIX_FP8 & 4
                u32x2 o8; o8.x = pk_fp8x4(bflo(o.x), bfhi(o.x), bflo(o.y), bfhi(o.y)); o8.y = pk_fp8x4(bflo(o.z), bfhi(o.z), bflo(o.w), bfhi(o.w));
                *(GAS u32x2*)(ar8 + (size_t)j * 2048) = o8;
#else
                *(GAS v4u*)(gp + (size_t)j * 2048) = o;
#endif
            }
        }
        __syncthreads();
    }
}

constexpr int P6_RS = 81920, P6_CNT = P6_RS + 8 * 512, P6_BASE = P6_CNT + 64, P6_ROW = P6_BASE + 64;
#define P6_BUTTERFLY(lg, out) do { float r10[10], r5[5], r3[3], r2[2]; const float z = 0.f; \
    _Pragma("unroll") for (int k = 0; k < 10; ++k) { const float keep = h32 ? lg[10 + k] : lg[k], send = h32 ? lg[k] : lg[10 + k]; r10[k] = keep + __shfl_xor(send, 32); } \
    _Pragma("unroll") for (int k = 0; k < 5; ++k) { const float keep = h16 ? r10[5 + k] : r10[k], send = h16 ? r10[k] : r10[5 + k]; r5[k] = keep + __shfl_xor(send, 16); } \
    { const float keep = h8 ? r5[3] : r5[0], send = h8 ? r5[0] : r5[3]; r3[0] = keep + __shfl_xor(send, 8); } \
    { const float keep = h8 ? r5[4] : r5[1], send = h8 ? r5[1] : r5[4]; r3[1] = keep + __shfl_xor(send, 8); } \
    { const float keep = h8 ? z : r5[2], send = h8 ? r5[2] : z; r3[2] = keep + __shfl_xor(send, 8); } \
    { const float keep = h4 ? r3[2] : r3[0], send = h4 ? r3[0] : r3[2]; r2[0] = keep + __shfl_xor(send, 4); } \
    { const float keep = h4 ? z : r3[1], send = h4 ? r3[1] : z; r2[1] = keep + __shfl_xor(send, 4); } \
    { const float keep = h2 ? r2[1] : r2[0], send = h2 ? r2[0] : r2[1]; out = keep + __shfl_xor(send, 2); } \
    out += __shfl_xor(out, 1); } while (0)
__device__ __forceinline__ void p6a_phase(const Args& a, LAS unsigned char* lds, int vcu, int G, int tid, int wave, int lane) {
    unsigned char* ws = a.ws;
    LAS float* RW = (LAS float*)lds;
    LAS float* RS = (LAS float*)(lds + P6_RS) + wave * 128;
    LAS unsigned* LC = (LAS unsigned*)(lds + P6_CNT); LAS unsigned* LB = (LAS unsigned*)(lds + P6_BASE); LAS unsigned* LR = (LAS unsigned*)(lds + P6_ROW);
    {
        const f32x4* wgp = (const f32x4*)a.in[11]; const f32x4* wep = (const f32x4*)a.in[13];
        f32x4 gq[2], eq[8];
#pragma unroll
        for (int u = 0; u < 2; ++u) gq[u] = wgp[tid + 512 * u];
#pragma unroll
        for (int u = 0; u < 8; ++u) eq[u] = wep[tid + 512 * u];
#pragma unroll
        for (int u = 0; u < 2; ++u) { const int c = tid + 512 * u;
#pragma unroll
            for (int k = 0; k < 4; ++k) RW[k * 1024 + c] = gq[u][k]; }
#pragma unroll
        for (int u = 0; u < 8; ++u) { const int q = tid + 512 * u, c = q >> 2, k4 = q & 3;
#pragma unroll
            for (int k = 0; k < 4; ++k) RW[(4 + 4 * k4 + k) * 1024 + c] = eq[u][k]; }
    }
    const u32x2* pre = (const u32x2*)a.out; u32x2* x1b = (u32x2*)(ws + WS_XB); [[maybe_unused]] unsigned* x1f8 = (unsigned*)(ws + WS_X1F8);
    gu32* ctl = (gu32*)ws;
    int* ltok = (int*)(ws + WS_LTOK); float* tw = (float*)(ws + WS_WSLOT); unsigned* tinfo = (unsigned*)(ws + WS_TINFO);
    const float* g1 = a.in[9]; const float* b1 = a.in[10];
    const bool h32 = (lane & 32) != 0, h16 = (lane & 16) != 0, h8 = (lane & 8) != 0, h4 = (lane & 4) != 0, h2 = (lane & 2) != 0;
#define P6_LOADROW(dst, t_) do { const u32x2* xr_ = pre + (size_t)(t_) * 256 + lane; _Pragma("unroll") for (int j = 0; j < 4; ++j) dst[j] = xr_[64 * j]; } while (0)
#define P6_LN(v, nx, s) do { s = 0.f; _Pragma("unroll") for (int j = 0; j < 4; ++j) { v[j] = (f32x4){bflo(nx[j].x), bfhi(nx[j].x), bflo(nx[j].y), bfhi(nx[j].y)}; s += (v[j].x + v[j].y) + (v[j].z + v[j].w); } } while (0)
#define P6_VAR(v, mean, q) do { q = 0.f; _Pragma("unroll") for (int j = 0; j < 4; ++j) { v[j] = v[j] - mean; q += (v[j].x * v[j].x + v[j].y * v[j].y) + (v[j].z * v[j].z + v[j].w * v[j].w); } } while (0)
#if M1_FP8
#define P6_STORE(v, t_, j) do { u32x2 o_; o_.x = cvtpk(v[j].x, v[j].y); o_.y = cvtpk(v[j].z, v[j].w); x1b[(size_t)(t_) * 256 + lane + 64 * j] = o_; x1f8[(size_t)(t_) * 256 + lane + 64 * j] = pk_fp8x4(v[j].x, v[j].y, v[j].z, v[j].w); } while (0)
#else
#define P6_STORE(v, t_, j) do { u32x2 o_; o_.x = cvtpk(v[j].x, v[j].y); o_.y = cvtpk(v[j].z, v[j].w); x1b[(size_t)(t_) * 256 + lane + 64 * j] = o_; } while (0)
#endif
#define P6_DOT(lg, v, j, k, w) lg[k] += (v[j][0] * w[0] + v[j][1] * w[1]) + (v[j][2] * w[2] + v[j][3] * w[3])
    for (int blk = vcu; blk < TT / 128; blk += G) {
        if (tid < 16) LC[tid] = 0u;
        __syncthreads();
        const int t0 = blk * 128;
        u32x2 nxA[4], nxB[4], nxC[4], nxD[4];
        P6_LOADROW(nxA, t0 + wave); P6_LOADROW(nxB, t0 + wave + 8); P6_LOADROW(nxC, t0 + wave + 16); P6_LOADROW(nxD, t0 + wave + 24);
        for (int rr = 0; rr < 4; ++rr) {
            const int rl0 = wave + 32 * rr, tA = t0 + rl0, tB = tA + 8, tC = tA + 16, tD = tA + 24;
            f32x4 vA[4], vB[4], vC[4], vD[4]; float sA, sB, sC, sD;
            P6_LN(vA, nxA, sA); P6_LN(vB, nxB, sB); P6_LN(vC, nxC, sC); P6_LN(vD, nxD, sD);
            if (rr < 3) { P6_LOADROW(nxA, tA + 32); P6_LOADROW(nxB, tB + 32); P6_LOADROW(nxC, tC + 32); P6_LOADROW(nxD, tD + 32); }
            const float mA = wave_sum(sA) * (1.f / DM), mB = wave_sum(sB) * (1.f / DM), mC = wave_sum(sC) * (1.f / DM), mD = wave_sum(sD) * (1.f / DM);
            float qA, qB, qC, qD;
            P6_VAR(vA, mA, qA); P6_VAR(vB, mB, qB); P6_VAR(vC, mC, qC); P6_VAR(vD, mD, qD);
            const float rA = 1.f / sqrtf(wave_sum(qA) * (1.f / DM) + LN_EPSF), rB = 1.f / sqrtf(wave_sum(qB) * (1.f / DM) + LN_EPSF);
            const float rC = 1.f / sqrtf(wave_sum(qC) * (1.f / DM) + LN_EPSF), rD = 1.f / sqrtf(wave_sum(qD) * (1.f / DM) + LN_EPSF);
            typedef float f32x2p __attribute__((ext_vector_type(2)));
            f32x2p lgAB[20], lgCD[20];
#pragma unroll
            for (int k = 0; k < 20; ++k) { lgAB[k] = (f32x2p){0.f, 0.f}; lgCD[k] = (f32x2p){0.f, 0.f}; }
#pragma unroll
            for (int j = 0; j < 4; ++j) {
                const f32x4 gg = *(const f32x4*)(g1 + 4 * lane + 256 * j), bb = *(const f32x4*)(b1 + 4 * lane + 256 * j);
                vA[j] = vA[j] * rA * gg + bb; vB[j] = vB[j] * rB * gg + bb; vC[j] = vC[j] * rC * gg + bb; vD[j] = vD[j] * rD * gg + bb;
                P6_STORE(vA, tA, j); P6_STORE(vB, tB, j); P6_STORE(vC, tC, j); P6_STORE(vD, tD, j);
                f32x2p pab[4], pcd[4];
#pragma unroll
                for (int e = 0; e < 4; ++e) { pab[e] = (f32x2p){vA[j][e], vB[j][e]}; pcd[e] = (f32x2p){vC[j][e], vD[j][e]}; }
#pragma unroll
                for (int k = 0; k < 20; ++k) { const f32x4 w = *(const LAS f32x4*)(RW + k * 1024 + 4 * lane + 256 * j);
#pragma unroll
                    for (int e = 0; e < 4; ++e) { const f32x2p ww = (f32x2p){w[e], w[e]};
                        lgAB[k] = __builtin_elementwise_fma(pab[e], ww, lgAB[k]); lgCD[k] = __builtin_elementwise_fma(pcd[e], ww, lgCD[k]); } }
            }
            float lgA[20], lgB[20], lgC[20], lgD[20];
#pragma unroll
            for (int k = 0; k < 20; ++k) { lgA[k] = lgAB[k].x; lgB[k] = lgAB[k].y; lgC[k] = lgCD[k].x; lgD[k] = lgCD[k].y; }
            float r1A, r1B, r1C, r1D;
            P6_BUTTERFLY(lgA, r1A); P6_BUTTERFLY(lgB, r1B); P6_BUTTERFLY(lgC, r1C); P6_BUTTERFLY(lgD, r1D);
            {
                const int i3 = h2 ? (h4 ? -1 : 1) : (h4 ? 2 : 0);
                const int i5 = i3 < 0 ? -1 : (h8 ? (i3 == 2 ? -1 : i3 + 3) : i3);
                const int kk = i5 < 0 ? -1 : (h32 ? 10 : 0) + (h16 ? 5 : 0) + i5;
                if (kk >= 0 && (lane & 1) == 0) { RS[kk] = r1A; RS[32 + kk] = r1B; RS[64 + kk] = r1C; RS[96 + kk] = r1D; }
            }
            asm volatile("s_waitcnt lgkmcnt(0)" ::: "memory");
            {
                const int sel = lane & 3; const int rl = rl0 + 8 * sel;
                float tl[20];
#pragma unroll
                for (int k4 = 0; k4 < 5; ++k4) { const f32x4 w = *(const LAS f32x4*)(RS + sel * 32 + 4 * k4); tl[4 * k4] = w[0]; tl[4 * k4 + 1] = w[1]; tl[4 * k4 + 2] = w[2]; tl[4 * k4 + 3] = w[3]; }
                float gl[4];
#pragma unroll
                for (int k = 0; k < 4; ++k) gl[k] = tl[k] + a.in[12][k];
                int gi = 0; float gm = gl[0];
#pragma unroll
                for (int k = 1; k < 4; ++k) if (gl[k] > gm) { gm = gl[k]; gi = k; }
                float gs = 0.f;
#pragma unroll
                for (int k = 0; k < 4; ++k) gs += __expf(gl[k] - gm);
                const float gwt = 1.f / gs;
                float el[4];
#pragma unroll
                for (int k = 0; k < 4; ++k) { const float se = gi == 0 ? tl[4 + k] : (gi == 1 ? tl[8 + k] : (gi == 2 ? tl[12 + k] : tl[16 + k])); el[k] = se + a.in[14][4 * gi + k]; }
                int i1 = 0; float v1 = el[0];
#pragma unroll
                for (int k = 1; k < 4; ++k) if (el[k] > v1) { v1 = el[k]; i1 = k; }
                int i2 = (i1 + 1) & 3; float v2 = -3.0e38f;
#pragma unroll
                for (int k = 0; k < 4; ++k) if (k != i1 && el[k] > v2) { v2 = el[k]; i2 = k; }
                const float ex = __expf(v2 - v1), w1 = gwt / (1.f + ex), w2 = gwt * ex / (1.f + ex);
                if (lane < 4) {
                    const int e1 = 4 * gi + i1, e2 = 4 * gi + i2;
                    const unsigned p1 = __hip_atomic_fetch_add(LC + e1, 1u, __ATOMIC_RELAXED, __HIP_MEMORY_SCOPE_WORKGROUP);
                    const unsigned p2 = __hip_atomic_fetch_add(LC + e2, 1u, __ATOMIC_RELAXED, __HIP_MEMORY_SCOPE_WORKGROUP);
                    LR[rl * 4 + 0] = ((unsigned)e1 << 16) | p1; LR[rl * 4 + 1] = ((unsigned)e2 << 16) | p2; LR[rl * 4 + 2] = __float_as_uint(w1); LR[rl * 4 + 3] = __float_as_uint(w2);
                }
            }
            asm volatile("s_waitcnt lgkmcnt(0)" ::: "memory");
        }
        __syncthreads();
        if (tid < 16) LB[tid] = __hip_atomic_fetch_add(ctl + CW_CNT + 64 * tid, LC[tid], __ATOMIC_RELAXED, __HIP_MEMORY_SCOPE_AGENT);
        __syncthreads();
        if (tid < 256) {
            const int rl = tid >> 1, j = tid & 1; const unsigned rec = LR[rl * 4 + j]; const unsigned e = rec >> 16, pos = LB[e] + (rec & 0xffffu);
            ltok[e * TT + pos] = t0 + rl; tw[2 * (t0 + rl) + j] = __uint_as_float(LR[rl * 4 + 2 + j]); tinfo[2 * (t0 + rl) + j] = (e << 16) | pos;
        }
        __syncthreads();
    }
#undef P6_LOADROW
#undef P6_LN
#undef P6_VAR
#undef P6_STORE
#undef P6_DOT
}
__device__ __forceinline__ void build_tile_tables(const Args& a, LAS unsigned char* lds, int tid) {
    LAS int* ts = (LAS int*)(lds + LDS_TS_OFF); LAS int* te = (LAS int*)(lds + LDS_TE_OFF); LAS int* cn = (LAS int*)(lds + LDS_CNT_OFF);
    gu32* ctl = (gu32*)a.ws;
    if (tid == 0) { int acc = 0;
        for (int e = 0; e < 16; ++e) { ts[e] = acc; const int c = (int)__hip_atomic_load(ctl + CW_CNT + 64 * e, __ATOMIC_RELAXED, __HIP_MEMORY_SCOPE_AGENT); const int nt = (c + 255) >> 8; cn[e] = c;
            for (int k = 0; k < nt; ++k) te[acc + k] = e; acc += nt; }
        ts[16] = acc; }
    __syncthreads();
}
__device__ __forceinline__ void p9_phase(const Args& a, LAS unsigned char* lds, int vcu, int G, int wave, int lane) {
    unsigned char* ws = a.ws;
    const LAS int* ts = (const LAS int*)(lds + LDS_TS_OFF);
    const unsigned* tinfo = (const unsigned*)(ws + WS_TINFO); const u32x2* Y = (const u32x2*)(ws + WS_Y);
    const float* g2 = a.in[18]; const float* b2 = a.in[19];
    const int gw = vcu * NWAVES + wave, NGW = G * NWAVES;
#if Y_FP8
    const unsigned* Y8 = (const unsigned*)(ws + WS_Y); unsigned ny0[4], ny1[4]; u32x2 nxw[4]; float nw0 = 0.f, nw1 = 0.f;
#else
    u32x2 ny0[4], ny1[4], nxw[4]; float nw0 = 0.f, nw1 = 0.f;
#endif
    const float* tw = (const float*)(ws + WS_WSLOT);
    auto issue = [&](int t) {
        const unsigned i0 = tinfo[2 * t], i1 = tinfo[2 * t + 1];
        nw0 = tw[2 * t]; nw1 = tw[2 * t + 1];
        const size_t s0 = (size_t)ts[i0 >> 16] * 256 + (i0 & 0xffffu), s1 = (size_t)ts[i1 >> 16] * 256 + (i1 & 0xffffu);
        const u32x2* xb1 = (const u32x2*)(ws + WS_XB) + (size_t)t * 256 + lane;
#pragma unroll
#if Y_FP8
        for (int j = 0; j < 4; ++j) { ny0[j] = Y8[s0 * 256 + lane + 64 * j]; ny1[j] = Y8[s1 * 256 + lane + 64 * j]; nxw[j] = xb1[64 * j]; }
#else
        for (int j = 0; j < 4; ++j) { ny0[j] = Y[s0 * 256 + lane + 64 * j]; ny1[j] = Y[s1 * 256 + lane + 64 * j]; nxw[j] = xb1[64 * j]; }
#endif
    };
    if (gw < TT) issue(gw);
    for (int t = gw; t < TT; t += NGW) {
        f32x4* xr = (f32x4*)(a.out + (size_t)t * DM) + lane;
#if Y_FP8
        f32x4 v[4]; float s = 0.f; const float w0 = nw0 * 0.0625f, w1 = nw1 * 0.0625f;
#pragma unroll
        for (int j = 0; j < 4; ++j) {
            const unsigned y0 = ny0[j], y1 = ny1[j]; const u32x2 xw = nxw[j];
            typedef float f32x2_ __attribute__((ext_vector_type(2)));
            const f32x2_ a0 = __builtin_amdgcn_cvt_pk_f32_fp8(y0, false), a1 = __builtin_amdgcn_cvt_pk_f32_fp8(y0, true), c0 = __builtin_amdgcn_cvt_pk_f32_fp8(y1, false), c1 = __builtin_amdgcn_cvt_pk_f32_fp8(y1, true);
            f32x4 x = (f32x4){bflo(xw.x), bfhi(xw.x), bflo(xw.y), bfhi(xw.y)} * DN_ALPHA;
            x.x += w0 * a0[0] + w1 * c0[0]; x.y += w0 * a0[1] + w1 * c0[1]; x.z += w0 * a1[0] + w1 * c1[0]; x.w += w0 * a1[1] + w1 * c1[1];
            v[j] = x; s += (x.x + x.y) + (x.z + x.w);
        }
#else
        f32x4 v[4]; float s = 0.f; const float w0 = nw0, w1 = nw1;
#pragma unroll
        for (int j = 0; j < 4; ++j) {
            const u32x2 y0 = ny0[j], y1 = ny1[j], xw = nxw[j];
            f32x4 x = (f32x4){bflo(xw.x), bfhi(xw.x), bflo(xw.y), bfhi(xw.y)} * DN_ALPHA;
            x.x += w0 * bflo(y0.x) + w1 * bflo(y1.x); x.y += w0 * bfhi(y0.x) + w1 * bfhi(y1.x); x.z += w0 * bflo(y0.y) + w1 * bflo(y1.y); x.w += w0 * bfhi(y0.y) + w1 * bfhi(y1.y);
            v[j] = x; s += (x.x + x.y) + (x.z + x.w);
        }
#endif
        if (t + NGW < TT) issue(t + NGW);
        const float mean = wave_sum(s) * (1.f / DM); float s2 = 0.f;
#pragma unroll
        for (int j = 0; j < 4; ++j) { v[j] = v[j] - mean; s2 += (v[j].x * v[j].x + v[j].y * v[j].y) + (v[j].z * v[j].z + v[j].w * v[j].w); }
        const float rstd = 1.f / sqrtf(wave_sum(s2) * (1.f / DM) + LN_EPSF);
#pragma unroll
        for (int j = 0; j < 4; ++j) { const f32x4 gg = *(const f32x4*)(g2 + 4 * lane + 256 * j), bb = *(const f32x4*)(b2 + 4 * lane + 256 * j); xr[64 * j] = v[j] * rstd * gg + bb; }
    }
}

__global__ void __launch_bounds__(NWAVES * 64, 2) mega_fwd(Args args) {
    extern __shared__ __attribute__((aligned(16))) unsigned char lds_raw[];
    LAS unsigned char* lds = (LAS unsigned char*)lds_raw;
    volatile LAS unsigned* MISC = (volatile LAS unsigned*)(lds + MISC_OFF);
    const int tid0 = threadIdx.x, wave = __builtin_amdgcn_readfirstlane(tid0 >> 6);
    const int G = gridDim.x, bx = blockIdx.x, vcu = (G % 8 == 0) ? (bx % 8) * (G / 8) + bx / 8 : bx;
    for (int u = tid0; u < (LDS_BYTES - LDSCTL_OFF) / 4; u += NWAVES * 64) ((LAS unsigned*)(lds + LDSCTL_OFF))[u] = 0u;
    __syncthreads();
    unsigned char* ws = args.ws;
    gu32* ctl = (gu32*)ws;
    const bool bars_on = (args.mask >> 31) != 0u;
    XcdBarrier bar; bar.bar = (unsigned*)(ctl + CW_BAR) + args.bar_region * XCD_BAR_WORDS; bar.x = 0; bar.st = nullptr;
    if (bars_on) bar = xcd_barrier_post((unsigned*)(ctl + CW_BAR) + args.bar_region * XCD_BAR_WORDS, MISC + 8);
    bar.wv = wave;
#define GRID_BAR() do { if (bars_on) xcd_barrier(bar); } while (0)
#ifndef PH_LAST
#define PH_LAST 99
#endif
#define FRESH() int tid = wave * 64 + pg8::lane_id(); asm volatile("" : "+v"(tid)); const int lane = tid & 63; (void)lane
#ifndef RMASK
#define RMASK 0
#endif
#define REP(k) _Pragma("unroll") for (int rep_ = 0; rep_ < 1 + ((RMASK >> (k)) & 1); ++rep_)
#ifndef STAMP_SCALE
#define STAMP_SCALE 1.0f
#endif
#ifdef STAMP_PH
#define ST_B(k) if ((k) == STAMP_PH) { st_a = rt(); }
#define ST_E(k) if ((k) == STAMP_PH) { st_b = rt(); }
#else
#define ST_B(k)
#define ST_E(k)
#endif
#ifdef ONLY
#define EN(k) (ONLY == (k))
#else
#define EN(k) ((args.mask >> (k)) & 1u)
#endif
    unsigned long long st_a = 0, st_b = 0; (void)st_a; (void)st_b;
    REP(0) if (EN(0)) { FRESH(); p0_prologue(args, lds, vcu, G, tid, wave, lane); }
    GRID_BAR();
#ifdef STAGGER_TICKS
    if (EN(1) && (bx & 8)) { const unsigned long long t0_ = rt(); while (rt() - t0_ < STAGGER_TICKS) __builtin_amdgcn_s_sleep(32); }
#endif
    REP(1) if (EN(1)) {
#if P1_FP8
        pg8::EpiHcat E{ws, (const float*)(ws + WS_ROT), 0};
        if (P1_FP8_FROM > 0) {
            pg8::Gemm g{(const pg8::bf16_t*)(ws + WS_XB), (const pg8::bf16_t*)(ws + WS_WIN), TT, 4608, 1024}; pg8::StaticOrder S; S.init(TT, 256 * P1_FP8_FROM, G, bx);
            pg8::gemm_phase<pg8::EpiHcat, pg8::StaticOrder, true, true>(lds, g, S, E, wave);
        }
        {
#if GATE_FP8
            pg8::Gemm g{(const pg8::bf16_t*)(ws + WS_X8_LO), (const pg8::bf16_t*)(ws + WS_WIN8), TT, 4608, 512, 64, (long)WS_X8_HI - (long)WS_X8_LO - (long)(16 * MiB)}; pg8::StaticOrder S;
#else
            pg8::Gemm g{(const pg8::bf16_t*)args.out, (const pg8::bf16_t*)(ws + WS_WIN8), TT, 4608, 512}; pg8::StaticOrder S;
#endif
            S.init(TT, 4608 - 256 * P1_FP8_FROM, G, bx, P1_FP8_FROM);
#if CONV_BG
            pg8::P1Order SB; SB.S = S; SB.cv = pg8::ExpertConv{args.in[15], args.in[16], args.in[17], ws + WS_WGU, ws + WS_WD, vcu * NWAVES + wave, G * NWAVES, vcu % 9};
            pg8::gemm_phase<pg8::EpiHcat, pg8::P1Order, true, true, false, true, 1, 0>(lds, g, SB, E, wave);
            { FRESH();
              for (int k = 0; SB.cv.gw + k * SB.cv.nw < 6144; ++k) { pg8::Unit tu; const bool in_gap = k < 3 && S.next(pg8::P1Order::unit_of(SB.cv.grp, k), tu) && pg8::P1Order::unit_of(SB.cv.grp, k) < 9;
                  if (!in_gap) pg8::expert_conv_item(SB.cv, k, lane); } }
#else
            pg8::gemm_phase<pg8::EpiHcat, pg8::StaticOrder, true, true, false, true, 1, 0>(lds, g, S, E, wave);
#endif
        }
#else
        pg8::Gemm g{(const pg8::bf16_t*)(ws + WS_XB), (const pg8::bf16_t*)(ws + WS_WIN), TT, 4608, 1024}; pg8::StaticOrder S; S.init(TT, 4608, G, bx);
        pg8::EpiHcat E{ws, (const float*)(ws + WS_ROT), 0};
        pg8::gemm_phase<pg8::EpiHcat, pg8::StaticOrder, true, true>(lds, g, S, E, wave);
#endif
    }
    GRID_BAR();
    if (PH_LAST >= 2) {
        REP(2) if (EN(2)) { FRESH(); for (int it = vcu; it < 256; it += G) chain_item(args, lds, it, tid, wave, lane); }
        if (EN(3)) { { FRESH(); attn_dil_phase<16>(args, lds, vcu, G, tid, wave, lane); }
                     { FRESH(); attn_dil_phase<4>(args, lds, vcu, G, tid, wave, lane); } }
    }
    GRID_BAR();
    ST_B(4) if (PH_LAST >= 3 && EN(4)) { FRESH(); p3_phase<0>(args, lds, vcu, G, tid, wave, lane); }
    if (EN(13)) { FRESH(); attn_p1_phase(args, lds, vcu, G, tid, wave, lane); }
    GRID_BAR(); ST_E(4)
#if !CONV_BG
    if (EN(14)) { FRESH(); p0_expert_weights(args, lds, vcu, G, wave, lane); }
#endif
    REP(5) if (PH_LAST >= 4 && EN(5)) {
        pg8::GateOrder S; S.S4.init(TT, 1024, G, bx);
        pg8::EpiHcat E{ws, (const float*)(ws + WS_ROT), 18};
#if GATE_FP8
        pg8::Gemm g{(const pg8::bf16_t*)(ws + WS_X8_LO), (const pg8::bf16_t*)(ws + WS_WIN8 + (size_t)4608 * 1024), TT, 2048, 512, 64, (long)WS_X8_HI - (long)WS_X8_LO - (long)(16 * MiB)};
        pg8::gemm_phase<pg8::EpiHcat, pg8::GateOrder, true, true, false, true, 1, 0>(lds, g, S, E, wave);
#else
        pg8::Gemm g{(const pg8::bf16_t*)(ws + WS_XB), (const pg8::bf16_t*)(ws + WS_WIN) + (size_t)4608 * 1024, TT, 2048, 1024};
        pg8::gemm_phase<pg8::EpiHcat, pg8::GateOrder, true, true>(lds, g, S, E, wave);
#endif
        asm volatile("s_waitcnt vmcnt(0)" ::: "memory"); __syncthreads();
    }
    REP(6) if (PH_LAST >= 5 && EN(6)) {
        pg8::StaticOrder S; S.init(TT, 1024, G, bx);
        { pg8::EpiGate<false> E{(const pg8::bf16_t*)(ws + WS_GATE_A), (pg8::bf16_t*)(ws + WS_MERGED), nullptr};
#if MIX_FP8 & 2
          pg8::Gemm g{(const pg8::bf16_t*)(ws + WS_OA), (const pg8::bf16_t*)(ws + WS_WA), TT, 1024, 256};
          pg8::gemm_phase<pg8::EpiGate<false>, pg8::StaticOrder, true, true, false, true, 1, 3>(lds, g, S, E, wave);
#else
          pg8::Gemm g{(const pg8::bf16_t*)(ws + WS_OA), (const pg8::bf16_t*)(ws + WS_WA), TT, 1024, 512};
          pg8::gemm_phase<pg8::EpiGate<false>, pg8::StaticOrder, true, true>(lds, g, S, E, wave);
#endif
        }
        asm volatile("s_waitcnt vmcnt(0)" ::: "memory"); __syncthreads();
        { typedef pg8::EpiGate<true, (MIX_FP8 & 1) != 0> EpiC;
          EpiC E{(const pg8::bf16_t*)(ws + WS_GATE_R), (pg8::bf16_t*)(ws + WS_MERGED), ws + WS_MERGED8};
#if MIX_FP8 & 4
          pg8::Gemm g{(const pg8::bf16_t*)(ws + WS_AR8), (const pg8::bf16_t*)(ws + WS_WR), TT, 1024, 512};
          pg8::gemm_phase<EpiC, pg8::StaticOrder, true, true, false, true, 1, 0>(lds, g, S, E, wave);
#else
          pg8::Gemm g{(const pg8::bf16_t*)(ws + WS_GR), (const pg8::bf16_t*)(ws + WS_WR), TT, 1024, 1024};
          pg8::gemm_phase<EpiC, pg8::StaticOrder, true, true>(lds, g, S, E, wave);
#endif
        }
    }
    GRID_BAR();
    REP(7) if (PH_LAST >= 6 && EN(7)) {
        pg8::StaticOrder S; S.init(TT, 1024, G, bx);
        pg8::EpiResBf16 E{X_F32_RES ? (const pg8::bf16_t*)args.in[0] : (const pg8::bf16_t*)(ws + WS_XB), (pg8::bf16_t*)args.out, DN_ALPHA};
#if MIX_FP8 & 1
        pg8::Gemm g{(const pg8::bf16_t*)(ws + WS_MERGED8), (const pg8::bf16_t*)(ws + WS_WO), TT, 1024, 512};
        pg8::gemm_phase<pg8::EpiResBf16, pg8::StaticOrder, true, true, false, true, 1, 3>(lds, g, S, E, wave);
#else
        pg8::Gemm g{(const pg8::bf16_t*)(ws + WS_MERGED), (const pg8::bf16_t*)(ws + WS_WO), TT, 1024, 1024};
        pg8::gemm_phase<pg8::EpiResBf16, pg8::StaticOrder, true, true>(lds, g, S, E, wave);
#endif
    }
    GRID_BAR();
    ST_B(8) if (PH_LAST >= 7 && EN(8)) { FRESH(); p6a_phase(args, lds, vcu, G, tid, wave, lane); }
    GRID_BAR(); ST_E(8)
    { FRESH(); build_tile_tables(args, lds, tid); }
    const int nrt = ((const LAS int*)(lds + LDS_TS_OFF))[16];
    REP(10) if (PH_LAST >= 9 && EN(10)) {
#if M1_FP8
        pg8::Gemm g{(const pg8::bf16_t*)(ws + WS_X1F8), (const pg8::bf16_t*)(ws + WS_WGU), MAXSLOT, 1024, 512};
        pg8::MoeOrder S{nrt * 4, G, vcu, (const LAS int*)(lds + LDS_TE_OFF), (const LAS int*)(lds + LDS_TS_OFF), (const LAS int*)(lds + LDS_CNT_OFF), (const int*)(ws + WS_LTOK), 1024u};
        pg8::EpiSwiGLU E{ws + WS_H};
        pg8::gemm_phase<pg8::EpiSwiGLU, pg8::MoeOrder, true, true, true, true, 1, 0>(lds, g, S, E, wave);
#else
        pg8::Gemm g{(const pg8::bf16_t*)(ws + WS_XB), (const pg8::bf16_t*)(ws + WS_WGU), MAXSLOT, 1024, 1024};
        pg8::MoeOrder S{nrt * 4, G, vcu, (const LAS int*)(lds + LDS_TE_OFF), (const LAS int*)(lds + LDS_TS_OFF), (const LAS int*)(lds + LDS_CNT_OFF), (const int*)(ws + WS_LTOK), 2048u};
        pg8::EpiSwiGLU E{ws + WS_H};
        pg8::gemm_phase<pg8::EpiSwiGLU, pg8::MoeOrder, true, true, true>(lds, g, S, E, wave);
#endif
    }
    GRID_BAR();
    REP(11) if (PH_LAST >= 10 && EN(11)) {
        pg8::Gemm g{(const pg8::bf16_t*)(ws + WS_H), (const pg8::bf16_t*)(ws + WS_WD), MAXSLOT, 1024, 256};
        pg8::MoeOrder S{nrt * 4, G, vcu, (const LAS int*)(lds + LDS_TE_OFF), (const LAS int*)(lds + LDS_TS_OFF), (const LAS int*)(lds + LDS_CNT_OFF), (const int*)(ws + WS_LTOK), 1024u};
        pg8::EpiRowScale E{(pg8::bf16_t*)(ws + WS_Y)};
        pg8::gemm_phase<pg8::EpiRowScale, pg8::MoeOrder, true, true, false, true, 1, 2>(lds, g, S, E, wave);
    }
    GRID_BAR();
    ST_B(12) if (PH_LAST >= 11 && EN(12)) { FRESH(); p9_phase(args, lds, vcu, G, wave, lane); }
#ifdef STAMP_PH
    GRID_BAR(); ST_E(12)
    if (STAMP_PH == 13) { st_a = rt(); GRID_BAR(); GRID_BAR(); GRID_BAR(); GRID_BAR(); st_b = rt(); }
    if (bx == 0 && tid0 == 0) { const float us = (float)(st_b - st_a) * 0.01f * STAMP_SCALE; int k = 0; float lim = 30.f; while (us >= lim && k < 12) { lim *= 1.5f; ++k; }
        __hip_atomic_store(ctl + CW_CHK, __float_as_uint(sqrtf(2.f * k + 2.f)), RLX_AGENT); }
    GRID_BAR();
    { const float c = __uint_as_float(__hip_atomic_load(ctl + CW_CHK, RLX_AGENT)); f32x4* o4 = (f32x4*)args.out;
      for (size_t i = (size_t)bx * 512 + tid0; i < (size_t)TT * DM / 4; i += (size_t)G * 512) o4[i] = (f32x4){c, c, c, c}; }
#endif
}

#ifdef PROBE_VAR
__global__ void __launch_bounds__(NWAVES * 64, 2) probe_kernel(Args args) {
    extern __shared__ __attribute__((aligned(16))) unsigned char lds_raw[];
    LAS unsigned char* lds = (LAS unsigned char*)lds_raw;
    const int tid0 = threadIdx.x, wave = __builtin_amdgcn_readfirstlane(tid0 >> 6);
    const int G = gridDim.x, bx = blockIdx.x, vcu = (G % 8 == 0) ? (bx % 8) * (G / 8) + bx / 8 : bx;
    FRESH();
    if (PROBE_VAR >= 20 && PROBE_VAR <= 22) {
        unsigned char* ws = args.ws;
        pg8::Gemm g{(const pg8::bf16_t*)(ws + WS_X8_LO), (const pg8::bf16_t*)(ws + WS_WIN8), TT, 4608, 512, 64, (long)WS_X8_HI - (long)WS_X8_LO - (long)(16 * MiB)}; pg8::StaticOrder S; S.init(TT, 4608, G, bx);
        typedef pg8::EpiHcatT<PROBE_VAR - 20> EpiP;
        EpiP E{ws, (const float*)(ws + WS_ROT), 0};
        pg8::gemm_phase<EpiP, pg8::StaticOrder, true, true, false, true, 1, 0>(lds, g, S, E, wave);
    }
    if (PROBE_VAR == 10) p3_phase<0>(args, lds, vcu, G, tid, wave, lane);
    if (PROBE_VAR == 11) p3_phase<1>(args, lds, vcu, G, tid, wave, lane);
    if (PROBE_VAR == 0) attn_dil_phase<16, 0>(args, lds, vcu, G, tid, wave, lane);
    if (PROBE_VAR == 1) attn_dil_phase<16, 1>(args, lds, vcu, G, tid, wave, lane);
    if (PROBE_VAR == 2) attn_dil_phase<4, 0>(args, lds, vcu, G, tid, wave, lane);
    if (PROBE_VAR == 3) attn_dil_phase<4, 1>(args, lds, vcu, G, tid, wave, lane);
}
#endif
extern "C" void kernel_launch(void* const* d_in, const int* in_sizes, int n_in, void* d_out, int out_size, void* d_ws, size_t ws_size, hipStream_t stream) {
    static int grid = 0;
    if (grid == 0) {
        if (n_in != 20 || in_sizes[0] != TT * DM || out_size != TT * DM || ws_size < WS_END) { fprintf(stderr, "kernel_launch: unexpected shapes: n_in %d in0 %d out %d ws %zu; nothing launched\n", n_in, n_in > 0 ? in_sizes[0] : -1, out_size, ws_size); grid = -1; return; }
        int dev = 0, cus = 0;
        if (hipGetDevice(&dev) != hipSuccess || hipDeviceGetAttribute(&cus, hipDeviceAttributeMultiprocessorCount, dev) != hipSuccess) { grid = -1; return; }
        if (hipFuncSetAttribute((const void*)mega_fwd, hipFuncAttributeMaxDynamicSharedMemorySize, LDS_BYTES) != hipSuccess) { fprintf(stderr, "kernel_launch: hipFuncSetAttribute failed\n"); grid = -1; return; }
        (void)hipGetLastError();
        grid = cus;
    }
    if (grid < 0) return;
    if (hipMemsetAsync((char*)d_ws, 0, CTL_ZERO_BYTES, stream) != hipSuccess) return;
    Args a{};
    for (int i = 0; i < 20; ++i) a.in[i] = (const float*)d_in[i];
    a.out = (float*)d_out; a.ws = (unsigned char*)d_ws; a.mask = 0x80007fffu; a.bar_region = 0;
#if defined(XTRA_FIRST)
    { Args x = a; x.mask = XTRA_FIRST; x.bar_region = 1; for (int r = 0; r < XTRA_REP; ++r) hipLaunchKernelGGL(mega_fwd, dim3(grid), dim3(NWAVES * 64), LDS_BYTES, stream, x);
      if (hipMemsetAsync((char*)d_ws, 0, CTL_ZERO_BYTES, stream) != hipSuccess) return; }
#endif
    hipLaunchKernelGGL(mega_fwd, dim3(grid), dim3(NWAVES * 64), LDS_BYTES, stream, a);
#if defined(PROBE_VAR)
    { hipFuncSetAttribute((const void*)probe_kernel, hipFuncAttributeMaxDynamicSharedMemorySize, LDS_BYTES);
      for (int r = 0; r < 4; ++r) hipLaunchKernelGGL(probe_kernel, dim3(grid), dim3(NWAVES * 64), LDS_BYTES, stream, a); }
#endif
#if defined(XTRA_AFTER)
    { Args x = a; x.mask = XTRA_AFTER; x.bar_region = 1; for (int r = 0; r < XTRA_REP; ++r) hipLaunchKernelGGL(mega_fwd, dim3(grid), dim3(NWAVES * 64), LDS_BYTES, stream, x); }
#endif
}
```

```cpp
#define O23_FP8 1
#include <hip/hip_runtime.h>
#include <cstdio>
#include <cstdint>

constexpr int TT = 32768, DM = 1024, SEQ = 2048, NB = 16;
constexpr float DN_ALPHA = 1.189207115002721f;
constexpr float LN_EPSF = 1e-5f;
#ifndef M1_FP8
#define M1_FP8 1
#endif
#ifndef P1_FP8
#define P1_FP8 1
#endif
#ifndef O23_FP8
#define O23_FP8 0
#endif
#ifndef STATE_FP8
#define STATE_FP8 1
#endif
#ifndef SILU_IN_P3
#define SILU_IN_P3 1
#endif
#ifndef CONV_BG
#define CONV_BG 1
#endif
#ifndef Y_FP8
#define Y_FP8 1
#endif
#ifndef GATE_FP8
#define GATE_FP8 1
#endif
#ifndef MIX_FP8
#define MIX_FP8 7
#endif
#ifndef P1_FP8_FROM
#define P1_FP8_FROM 0
#endif
#define X_F32_RES (P1_FP8 && P1_FP8_FROM == 0 && GATE_FP8)
constexpr size_t MiB = 1u << 20;
constexpr size_t CTL_ZERO_BYTES = 1 * MiB;
constexpr size_t WS_ROT = 1 * MiB;
constexpr size_t WS_BIAS = 2 * MiB;
constexpr size_t WS_LTOK = 3 * MiB;
constexpr size_t WS_TINFO = 7 * MiB;
constexpr size_t WS_WSLOT = 7 * MiB + 512 * 1024;
constexpr size_t WS_WIN = 8 * MiB;
constexpr size_t WS_WIN8 = 12 * MiB;
constexpr size_t WS_WR = 21 * MiB;
constexpr size_t WS_WA = 23 * MiB;
constexpr size_t WS_WO = 24 * MiB;
constexpr size_t WS_WGU = 26 * MiB;
constexpr size_t WS_WD = 42 * MiB;
constexpr size_t WS_XB = 80 * MiB;
constexpr size_t WS_QR = 144 * MiB;
constexpr size_t WS_KR = 176 * MiB;
constexpr size_t WS_VR = 208 * MiB;
constexpr size_t WS_GR = 272 * MiB;
constexpr size_t WS_QA = 336 * MiB, WS_KA = 368 * MiB, WS_VA = 400 * MiB, WS_OA = 432 * MiB;
#if MIX_FP8 & 4
constexpr size_t WS_AR8 = 144 * MiB;
constexpr size_t WS_GATE_R = 176 * MiB, WS_GATE_A = 240 * MiB;
#else
constexpr size_t WS_GATE_R = 144 * MiB, WS_GATE_A = 208 * MiB;
#endif
constexpr size_t WS_X8_LO = 448 * MiB, WS_X8_HI = 58 * MiB;
static_assert(M1_FP8, "the workspace map is laid out for fp8 expert weights");
static_assert(!CONV_BG || X_F32_RES, "CONV_BG puts o2 into the bf16 x region");
static_assert(!GATE_FP8 || (P1_FP8 && (MIX_FP8 & 2) && M1_FP8), "GATE_FP8 needs the fp8 mixer-input GEMM, the fp8 o_a (room behind it) and the fp8 expert weights (room behind them)");
constexpr size_t WS_MERGED8 = 464 * MiB;
constexpr size_t WS_MERGED = 336 * MiB;
constexpr size_t WS_Y = 144 * MiB;
constexpr size_t WS_H = 336 * MiB;
constexpr size_t WS_X1F8 = 464 * MiB;
#if CONV_BG
constexpr size_t WS_O2 = 80 * MiB;
#else
constexpr size_t WS_O2 = 26 * MiB;
#endif
constexpr size_t WS_O3 = 464 * MiB;
constexpr size_t WS_LSE2 = 496 * MiB, WS_LSE3 = 497 * MiB;
constexpr size_t WS_END = 512 * MiB;
constexpr int MAXSLOT = 69632;
constexpr int CW_BAR = 4096;
constexpr int CW_CNT = 16384;
constexpr int CW_CHK = 24576;
namespace pg8 {
#define PG8_LAS __attribute__((address_space(3)))
typedef unsigned short bf16_t;
typedef short bf16x8 __attribute__((ext_vector_type(8)));
typedef float f32x4 __attribute__((ext_vector_type(4)));
typedef unsigned u32x4 __attribute__((ext_vector_type(4)));
typedef unsigned u32x2_ __attribute__((ext_vector_type(2)));
constexpr int BM = 256, BK = 64, HALF = 128, HTB = HALF * BK * 2  , STAGE_BYTES = 8 * HTB, NXCD = 8, WGM = 8;

__device__ __forceinline__ int lane_id() { int x; asm volatile("v_mbcnt_lo_u32_b32 %0, -1, 0\n\tv_mbcnt_hi_u32_b32 %0, -1, %0" : "=v"(x)); return x; }
__host__ __device__ __forceinline__ int lds_byte(int r, int c) { const int st = (r >> 4) * 2 + (c >> 5), rr = r & 15, cc = c & 31, ob = rr * 64 + cc * 2; return st * 1024 + (ob ^ (((ob >> 9) & 1) << 5)); }
__host__ __device__ __forceinline__ void stage_rc(int b, int& R, int& C) { const int st = b / 1024, sb = b % 1024, swz = sb ^ (((sb >> 9) & 1) << 5); R = (st >> 1) * 16 + swz / 64; C = (st & 1) * 32 + (swz % 64) / 2; }
__host__ __device__ __forceinline__ int perm32(int rho) { const int n = rho >> 4, i = rho & 15; return 8 * (i >> 2) + 4 * n + (i & 3); }

struct Unit { int pm, pn; };
struct Gemm { const bf16_t* A; const bf16_t* Bt; int M, N, K; int spm = 1 << 30; long sdelta = 0; };

struct StaticOrder {
    int nM, nN, nwg, G, c, pn0;
    __host__ __device__ void init(int M, int N, int G_, int c_, int pn0_ = 0) { nM = M / BM; nN = N / BM; nwg = nM * nN; G = G_; c = c_; pn0 = pn0_; }
    __host__ __device__ bool next(int i, Unit& u) const {
        const long L = (long)i * G + c; if (L >= nwg) return false;
        int wgid = (int)L; { const int q = nwg / NXCD, r = nwg % NXCD, xcd = wgid % NXCD, off = wgid / NXCD; wgid = (xcd < r ? xcd * (q + 1) : r * (q + 1) + (xcd - r) * q) + off; }
        const int nig = WGM * nN, gid = wgid / nig, fm = gid * WGM, gsz = (nM - fm) < WGM ? (nM - fm) : WGM;
        u.pm = fm + ((wgid % nig) % gsz); u.pn = pn0 + (wgid % nig) / gsz; return true;
    }
    __device__ __forceinline__ void a_ready(const Unit&) const {}
    __device__ __forceinline__ void done(const Unit&, int, int) const {}
};

__device__ __forceinline__ unsigned cvt_pk_bf16(float lo, float hi) { unsigned r; asm volatile("v_cvt_pk_bf16_f32 %0, %1, %2" : "=v"(r) : "v"(lo), "v"(hi)); return r; }
typedef float cvt_f32x2_t __attribute__((ext_vector_type(2))); typedef __bf16 cvt_bf16x2_t __attribute__((ext_vector_type(2)));
__device__ __forceinline__ unsigned cvt_pk_bf16_acc(float lo, float hi) { const cvt_f32x2_t v = {lo, hi}; const cvt_bf16x2_t b = __builtin_convertvector(v, cvt_bf16x2_t); return __builtin_bit_cast(unsigned, b); }
__device__ __forceinline__ float bflo(unsigned w) { return __uint_as_float(w << 16); }
__device__ __forceinline__ float bfhi(unsigned w) { return __uint_as_float(w & 0xffff0000u); }
__device__ __forceinline__ float fsigmoid(float x) { return __builtin_amdgcn_rcpf(1.f + __expf(-x)); }
__device__ __forceinline__ float fsilu(float x) { return x * __builtin_amdgcn_rcpf(1.f + __expf(-x)); }

template <int VAR = 0> struct EpiHcatT {
    static constexpr bool PERM = true, AFTER_DRAIN = false; static constexpr int NSTORE = 16;
    unsigned char* ws; const float* rot; int tile_off;
    __device__ __forceinline__ void operator()(const f32x4 (&acc)[2][2][4][2], const Unit& u, int wr, int wc, int fr, int fq) const {
        if (VAR == 1) {
            float s = 0.f;
#pragma unroll
            for (int ai = 0; ai < 2; ++ai)
#pragma unroll
                for (int bj = 0; bj < 2; ++bj)
#pragma unroll
                    for (int m = 0; m < 4; ++m)
#pragma unroll
                        for (int n = 0; n < 2; ++n) s += (acc[ai][bj][m][n][0] + acc[ai][bj][m][n][1]) + (acc[ai][bj][m][n][2] + acc[ai][bj][m][n][3]);
            ((float*)(ws + WS_O3))[(size_t)(u.pm * 64 + u.pn) * 512 + wr * 256 + wc * 64 + fq * 16 + fr] = s; return;
        }
        const int gt = u.pn + tile_off;
        size_t base_off; int pitch, ct, mode; float sc = 1.f;
        if (gt < 2)       { base_off = WS_QR; pitch = 512;  ct = gt;      mode = 1; }
        else if (gt < 4)  { base_off = WS_KR; pitch = 512;  ct = gt - 2;  mode = 1; sc = 0.08838834764831845f; }
        else if (gt < 8)  { base_off = WS_VR; pitch = 1024; ct = gt - 4;  mode = 0; }
        else if (gt < 12) { base_off = WS_GR; pitch = 1024; ct = gt - 8;  mode = SILU_IN_P3 ? 0 : 2; }
        else if (gt < 14) { base_off = WS_QA; pitch = 512;  ct = gt - 12; mode = 0; sc = 0.18033688011112042f; }
        else if (gt < 16) { base_off = WS_KA; pitch = 512;  ct = gt - 14; mode = 0; }
        else if (gt < 18) { base_off = WS_VA; pitch = 512;  ct = gt - 16; mode = 0; }
        else if (gt < 22) { base_off = WS_GATE_R; pitch = 1024; ct = gt - 18; mode = 3; }
        else              { base_off = WS_GATE_A; pitch = 1024; ct = gt - 22; mode = 3; }
        bf16_t* O = (bf16_t*)(ws + base_off);
        const int row0 = u.pm * BM + wr * 64 + fr, col0 = ct * BM + wc * 32 + 8 * fq;
#pragma unroll
        for (int ai = 0; ai < 2; ++ai)
#pragma unroll
            for (int m = 0; m < 4; ++m) {
                const int row = row0 + ai * HALF + m * 16;
                bf16_t* rowp = O + (size_t)(VAR == 2 ? (row & 255) : row) * pitch + col0;
                f32x4 cs = (f32x4){1.f, 1.f, 1.f, 1.f}, sn = (f32x4){0.f, 0.f, 0.f, 0.f};
                if (mode == 1) { const f32x4* rt = (const f32x4*)(rot + ((size_t)(row & (SEQ - 1)) * 16 + (4 * wc + fq)) * 8); cs = rt[0]; sn = rt[1]; }
#pragma unroll
                for (int bj = 0; bj < 2; ++bj) {
                    f32x4 v0 = acc[ai][bj][m][0], v1 = acc[ai][bj][m][1];
                    if (mode == 1) { const f32x4 a = v0 * cs - v1 * sn, b = v0 * sn + v1 * cs; v0 = a * sc; v1 = b * sc; }
                    else if (mode == 2) {
#pragma unroll
                        for (int e = 0; e < 4; ++e) { v0[e] = fsilu(v0[e]); v1[e] = fsilu(v1[e]); } }
                    else if (mode == 3) {
#pragma unroll
                        for (int e = 0; e < 4; ++e) { v0[e] = fsigmoid(v0[e]); v1[e] = fsigmoid(v1[e]); } }
                    else { v0 = v0 * sc; v1 = v1 * sc; }
                    u32x4 w; w.x = cvt_pk_bf16(v0[0], v0[1]); w.y = cvt_pk_bf16(v0[2], v0[3]); w.z = cvt_pk_bf16(v1[0], v1[1]); w.w = cvt_pk_bf16(v1[2], v1[3]);
                    *(u32x4*)(rowp + bj * HALF) = w;
                }
            }
    }
};

typedef EpiHcatT<0> EpiHcat;

__device__ __forceinline__ unsigned fp8x4_sat(float a, float b, float c, float d) {
    a = __builtin_amdgcn_fmed3f(a, -448.f, 448.f); b = __builtin_amdgcn_fmed3f(b, -448.f, 448.f); c = __builtin_amdgcn_fmed3f(c, -448.f, 448.f); d = __builtin_amdgcn_fmed3f(d, -448.f, 448.f);
    unsigned w = 0u; w = __builtin_amdgcn_cvt_pk_fp8_f32(a, b, w, false); w = __builtin_amdgcn_cvt_pk_fp8_f32(c, d, w, true); return w;
}
template <bool ADD, bool OUT8 = false> struct EpiGate {
    static constexpr bool PERM = true, AFTER_DRAIN = false; static constexpr int NSTORE = 16;
    const bf16_t* gate; bf16_t* O; unsigned char* O8;
    __device__ __forceinline__ void operator()(const f32x4 (&acc)[2][2][4][2], const Unit& u, int wr, int wc, int fr, int fq) const {
        const int row0 = u.pm * BM + wr * 64 + fr, col0 = u.pn * BM + wc * 32 + 8 * fq;
#pragma unroll
        for (int ai = 0; ai < 2; ++ai)
#pragma unroll
            for (int m = 0; m < 4; ++m)
#pragma unroll
                for (int bj = 0; bj < 2; ++bj) {
                    const size_t p = (size_t)(row0 + ai * HALF + m * 16) * 1024 + col0 + bj * HALF;
                    const u32x4 g = *(const u32x4*)(gate + p);
                    f32x4 v0 = acc[ai][bj][m][0], v1 = acc[ai][bj][m][1];
                    v0[0] *= bflo(g.x); v0[1] *= bfhi(g.x); v0[2] *= bflo(g.y); v0[3] *= bfhi(g.y);
                    v1[0] *= bflo(g.z); v1[1] *= bfhi(g.z); v1[2] *= bflo(g.w); v1[3] *= bfhi(g.w);
                    if (ADD) { const u32x4 o = *(const u32x4*)(O + p);
                        v0[0] += bflo(o.x); v0[1] += bfhi(o.x); v0[2] += bflo(o.y); v0[3] += bfhi(o.y);
                        v1[0] += bflo(o.z); v1[1] += bfhi(o.z); v1[2] += bflo(o.w); v1[3] += bfhi(o.w); }
                    if (OUT8) { u32x2_ w8;
                        w8.x = fp8x4_sat(v0[0] * 16.f, v0[1] * 16.f, v0[2] * 16.f, v0[3] * 16.f); w8.y = fp8x4_sat(v1[0] * 16.f, v1[1] * 16.f, v1[2] * 16.f, v1[3] * 16.f);
                        *(u32x2_*)(O8 + p) = w8; }
                    else { u32x4 w; w.x = cvt_pk_bf16(v0[0], v0[1]); w.y = cvt_pk_bf16(v0[2], v0[3]); w.z = cvt_pk_bf16(v1[0], v1[1]); w.w = cvt_pk_bf16(v1[2], v1[3]);
                        *(u32x4*)(O + p) = w; }
                }
    }
};

struct EpiResBf16 {
    static constexpr bool PERM = true, AFTER_DRAIN = false; static constexpr int NSTORE = 16;
    const bf16_t* x; bf16_t* out; float alpha;
    __device__ __forceinline__ void operator()(const f32x4 (&acc)[2][2][4][2], const Unit& u, int wr, int wc, int fr, int fq) const {
        const int row0 = u.pm * BM + wr * 64 + fr, col0 = u.pn * BM + wc * 32 + 8 * fq;
#pragma unroll
        for (int ai = 0; ai < 2; ++ai)
#pragma unroll
            for (int m = 0; m < 4; ++m)
#pragma unroll
                for (int bj = 0; bj < 2; ++bj) {
                    const size_t p = (size_t)(row0 + ai * HALF + m * 16) * 1024 + col0 + bj * HALF;
#if X_F32_RES
                    const f32x4 x0 = *(const f32x4*)((const float*)x + p), x1 = *(const f32x4*)((const float*)x + p + 4);
#else
                    const u32x4 xw = *(const u32x4*)(x + p);
                    const f32x4 x0 = (f32x4){bflo(xw.x), bfhi(xw.x), bflo(xw.y), bfhi(xw.y)}, x1 = (f32x4){bflo(xw.z), bfhi(xw.z), bflo(xw.w), bfhi(xw.w)};
#endif
                    const f32x4 v0 = x0 * alpha + acc[ai][bj][m][0], v1 = x1 * alpha + acc[ai][bj][m][1];
                    u32x4 w; w.x = cvt_pk_bf16(v0[0], v0[1]); w.y = cvt_pk_bf16(v0[2], v0[3]); w.z = cvt_pk_bf16(v1[0], v1[1]); w.w = cvt_pk_bf16(v1[2], v1[3]);
                    *(u32x4*)(out + p) = w;
                }
    }
};

struct EpiSwiGLU {
    static constexpr bool PERM = true, AFTER_DRAIN = false; static constexpr int NSTORE = 16;
    unsigned char* H;
    __device__ __forceinline__ void operator()(const f32x4 (&acc)[2][2][4][2], const Unit& u, int wr, int wc, int fr, int fq) const {
        const int row0 = u.pm * BM + wr * 64 + fr, col0 = (u.pn & 3) * 128 + wc * 16 + 4 * fq;
#pragma unroll
        for (int ai = 0; ai < 2; ++ai)
#pragma unroll
            for (int m = 0; m < 4; ++m)
#pragma unroll
                for (int bj = 0; bj < 2; ++bj) {
                    const f32x4 g = acc[ai][bj][m][0], up = acc[ai][bj][m][1];
                    float h0 = fsilu(g[0]) * up[0] * 8.f, h1 = fsilu(g[1]) * up[1] * 8.f, h2 = fsilu(g[2]) * up[2] * 8.f, h3 = fsilu(g[3]) * up[3] * 8.f;
                    h0 = fminf(fmaxf(h0, -448.f), 448.f); h1 = fminf(fmaxf(h1, -448.f), 448.f); h2 = fminf(fmaxf(h2, -448.f), 448.f); h3 = fminf(fmaxf(h3, -448.f), 448.f);
                    unsigned w = 0u; w = __builtin_amdgcn_cvt_pk_fp8_f32(h0, h1, w, false); w = __builtin_amdgcn_cvt_pk_fp8_f32(h2, h3, w, true);
                    *(unsigned*)(H + (size_t)(row0 + ai * HALF + m * 16) * 512 + col0 + bj * 64) = w;
                }
    }
};

struct EpiRowScale {
    static constexpr bool PERM = true, AFTER_DRAIN = false; static constexpr int NSTORE = 16;
    bf16_t* Y;
    __device__ __forceinline__ void operator()(const f32x4 (&acc)[2][2][4][2], const Unit& u, int wr, int wc, int fr, int fq) const {
        const int row0 = u.pm * BM + wr * 64 + fr, col0 = (u.pn & 3) * BM + wc * 32 + 8 * fq;
#pragma unroll
        for (int ai = 0; ai < 2; ++ai)
#pragma unroll
            for (int m = 0; m < 4; ++m) {
                const int row = row0 + ai * HALF + m * 16;
#pragma unroll
                for (int bj = 0; bj < 2; ++bj) {
                    const f32x4 v0 = acc[ai][bj][m][0], v1 = acc[ai][bj][m][1];
#if Y_FP8
                    u32x2_ w8; w8.x = fp8x4_sat(v0[0] * 16.f, v0[1] * 16.f, v0[2] * 16.f, v0[3] * 16.f); w8.y = fp8x4_sat(v1[0] * 16.f, v1[1] * 16.f, v1[2] * 16.f, v1[3] * 16.f);
                    *(u32x2_*)((unsigned char*)Y + (size_t)row * 1024 + col0 + bj * HALF) = w8;
#else
                    u32x4 w; w.x = cvt_pk_bf16_acc(v0[0], v0[1]); w.y = cvt_pk_bf16_acc(v0[2], v0[3]); w.z = cvt_pk_bf16_acc(v1[0], v1[1]); w.w = cvt_pk_bf16_acc(v1[2], v1[3]);
                    *(u32x4*)(Y + (size_t)row * 1024 + col0 + bj * HALF) = w;
#endif
                }
            }
    }
};

struct MoeOrder {
    int nunits, G, c; const PG8_LAS int* te; const PG8_LAS int* ts; const PG8_LAS int* cnt; const int* ltok; unsigned rowbytes;
    __device__ __forceinline__ bool next(int i, Unit& u) const {
        const int L = i * G + c, rt = (L >> 5) * 8 + (L & 7); if (rt >= (nunits >> 2)) return false;
        u.pm = rt; u.pn = te[rt] * 4 + ((L >> 3) & 3); return true;
    }
    __device__ __forceinline__ unsigned a_row_off(const Unit& u, int row) const {
        const int ex = te[u.pm], pos = (u.pm - ts[ex]) * 256 + row;
        const int tok = pos < cnt[ex] ? ltok[ex * 32768 + pos] : 0;
        return (unsigned)tok * rowbytes;
    }
    __device__ __forceinline__ void a_ready(const Unit&) const {}
    __device__ __forceinline__ void done(const Unit&, int, int) const {}
};

struct ExpertConv { const float* wg; const float* wu; const float* wd; unsigned char* WGU; unsigned char* WD; int gw, nw, grp; };
__device__ __forceinline__ void expert_conv_item(const ExpertConv& c, int j, int lane) {
    const int it = j * c.nw + c.gw, e = it / 384, r = it % 384;
    const float* src; unsigned char* dst; int K, N, mode, nb, kb;
    if (r < 128)      { src = c.wg + (size_t)e * 1024 * 512; dst = c.WGU + (size_t)e * 1024 * 1024; K = 1024; N = 512;  mode = 2; nb = r >> 4; kb = r & 15; }
    else if (r < 256) { src = c.wu + (size_t)e * 1024 * 512; dst = c.WGU + (size_t)e * 1024 * 1024; K = 1024; N = 512;  mode = 3; nb = (r - 128) >> 4; kb = (r - 128) & 15; }
    else              { src = c.wd + (size_t)e * 512 * 1024; dst = c.WD + (size_t)e * 1024 * 512;   K = 512;  N = 1024; mode = 0; nb = (r - 256) >> 3; kb = (r - 256) & 7; }
    const int n4 = nb * 64 + 4 * (lane & 15), k0 = kb * 64 + 16 * (lane >> 4);
    const float* s = src + (size_t)k0 * N + n4;
    f32x4 v[16];
#pragma unroll
    for (int i = 0; i < 16; ++i) v[i] = *(const f32x4*)(s + (size_t)i * N);
#pragma unroll
    for (int jn = 0; jn < 4; ++jn) {
        const int n = n4 + jn, row = mode == 0 ? n : ((n >> 2) << 3) + (n & 3) + (mode == 3 ? 4 : 0);
        u32x4 w;
        w.x = fp8x4_sat(v[0][jn] * 64.f, v[1][jn] * 64.f, v[2][jn] * 64.f, v[3][jn] * 64.f);     w.y = fp8x4_sat(v[4][jn] * 64.f, v[5][jn] * 64.f, v[6][jn] * 64.f, v[7][jn] * 64.f);
        w.z = fp8x4_sat(v[8][jn] * 64.f, v[9][jn] * 64.f, v[10][jn] * 64.f, v[11][jn] * 64.f); w.w = fp8x4_sat(v[12][jn] * 64.f, v[13][jn] * 64.f, v[14][jn] * 64.f, v[15][jn] * 64.f);
        *(u32x4*)(dst + (size_t)row * K + k0) = w;
    }
}
struct GateOrder {
    StaticOrder S4;
    __device__ __forceinline__ bool next(int i, Unit& u) const { Unit t; if (!S4.next(i >> 1, t)) return false; u.pm = t.pm; u.pn = t.pn + 4 * (i & 1); return true; }
    __device__ __forceinline__ void a_ready(const Unit&) const {}
    __device__ __forceinline__ void done(const Unit&, int, int) const {}
};
struct P1Order {
    StaticOrder S; ExpertConv cv;
    __device__ __forceinline__ bool next(int i, Unit& u) const { return S.next(i, u); }
    __device__ __forceinline__ void a_ready(const Unit&) const {}
    __device__ __forceinline__ static int unit_of(int grp, int k) { return (grp + 3 * k) % 9; }
    __device__ __forceinline__ void done(const Unit&, int ui, int lane) const {
        const int d = (ui + 9 - cv.grp) % 9;
        if (ui < 9 && d % 3 == 0 && cv.gw + (d / 3) * cv.nw < 6144) expert_conv_item(cv, d / 3, lane);
    }
};

template <class Epi, class Sched, bool ALIGN_EPI = false, bool SP2 = false, bool GATHER = false, bool FP8 = false, int SEL_W = 0, int SEL_X = 0>
__device__ __forceinline__ void gemm_phase(PG8_LAS unsigned char* lds, const Gemm g, const Sched& S, const Epi& E, const int wid) {
    int tid = wid * 64 + lane_id(); asm volatile("" : "+v"(tid));
    const int lane = tid & 63, wr = wid >> 2, wc = wid & 3, fr = lane & 15, fq = lane >> 4;
    static_assert(SP2, "only the two-super-phase loop is kept");
    typedef int i32x4_ __attribute__((ext_vector_type(4)));
    const int K = g.K, nt = K / BK;
    unsigned voffB[2]; int rA[2], cA2[2];
#pragma unroll
    for (int i = 0; i < 2; ++i) { int R, C; stage_rc(tid * 16 + i * 8192, R, C); const int Rb = Epi::PERM ? ((R & ~31) + perm32(R & 31)) : R;
        rA[i] = R; cA2[i] = C * 2; voffB[i] = (unsigned)(Rb * K + C) * 2u; }
    unsigned vAc[2][2], vAn[2][2];
    const size_t kstep = (size_t)(BK * 2);
    const size_t hstep = (size_t)HALF * K * 2;
    const size_t tstep = 2 * hstep;
    const unsigned ldsw = (unsigned)wid * 1024u;
    const int aoff0 = lds_byte(wr * 64 + fr, fq * 8), aoff1 = aoff0 + 1024;
    const int boff0 = lds_byte(wc * 32 + fr, fq * 8), boff1 = boff0 + 1024;
#define PG8_SA(b, h) (((b) * 2 + (h)) * HTB)
#define PG8_SB(b, h) ((4 + (b) * 2 + (h)) * HTB)
#define PG8_STAGE(bufoff, gbase, voff) do { _Pragma("unroll") for (int _i = 0; _i < 2; ++_i) \
        __builtin_amdgcn_global_load_lds((const unsigned*)((const char*)(gbase) + (voff)[_i]), (PG8_LAS unsigned*)(lds + (bufoff) + ldsw + _i * 8192), 16, 0, 0); } while (0)
#define PG8_LDA(dst, b, h) do { _Pragma("unroll") for (int m = 0; m < 4; ++m) { dst[m][0] = *(const PG8_LAS bf16x8*)(lds + PG8_SA(b, h) + aoff0 + m * 2048); dst[m][1] = *(const PG8_LAS bf16x8*)(lds + PG8_SA(b, h) + aoff1 + m * 2048); } } while (0)
#define PG8_LDB(dst, b, h) do { _Pragma("unroll") for (int n = 0; n < 2; ++n) { dst[n][0] = *(const PG8_LAS bf16x8*)(lds + PG8_SB(b, h) + boff0 + n * 2048); dst[n][1] = *(const PG8_LAS bf16x8*)(lds + PG8_SB(b, h) + boff1 + n * 2048); } } while (0)
#define PG8_CAT8(x) __builtin_shufflevector(__builtin_bit_cast(i32x4_, (x)[0]), __builtin_bit_cast(i32x4_, (x)[1]), 0, 1, 2, 3, 4, 5, 6, 7)
#define PG8_MMA(ai, bj, At, Bt) do { __builtin_amdgcn_s_setprio(1); \
        if constexpr (FP8) { _Pragma("unroll") for (int m = 0; m < 4; ++m) _Pragma("unroll") for (int n = 0; n < 2; ++n) \
            acc[ai][bj][m][n] = __builtin_amdgcn_mfma_scale_f32_16x16x128_f8f6f4(PG8_CAT8(Bt[n]), PG8_CAT8(At[m]), acc[ai][bj][m][n], 0, 0, SEL_W, scl, SEL_X, scl); \
            asm volatile("" : "+v"(acc[ai][bj][0][0]), "+v"(acc[ai][bj][0][1]), "+v"(acc[ai][bj][1][0]), "+v"(acc[ai][bj][1][1]), "+v"(acc[ai][bj][2][0]), "+v"(acc[ai][bj][2][1]), "+v"(acc[ai][bj][3][0]), "+v"(acc[ai][bj][3][1])); } \
        else { _Pragma("unroll") for (int m = 0; m < 4; ++m) _Pragma("unroll") for (int n = 0; n < 2; ++n) _Pragma("unroll") for (int k = 0; k < 2; ++k) \
            acc[ai][bj][m][n] = __builtin_amdgcn_mfma_f32_16x16x32_bf16(Bt[n][k], At[m][k], acc[ai][bj][m][n], 0, 0, 0); } \
        __builtin_amdgcn_s_setprio(0); } while (0)
#define PG8_WAIT_V(n) asm volatile("s_waitcnt vmcnt(" #n ")" ::: "memory")
#define PG8_WAIT_VN(n) asm volatile("s_waitcnt vmcnt(%0)" :: "i"(n) : "memory")
#define PG8_WAIT_L(n) asm volatile("s_waitcnt lgkmcnt(" #n ")" ::: "memory")
#define PG8_BAR __builtin_amdgcn_s_barrier()
#define PG8_SCHED __builtin_amdgcn_sched_barrier(0)
    [[maybe_unused]] int scl = 0x7b7c797f; asm volatile("" : "+v"(scl));
    Unit cur, nxt; int ui = 0;
    if (!S.next(0, cur)) return;
    f32x4 acc[2][2][4][2];
#pragma unroll
    for (int a = 0; a < 2; ++a)
#pragma unroll
        for (int b = 0; b < 2; ++b)
#pragma unroll
            for (int m = 0; m < 4; ++m)
#pragma unroll
                for (int n = 0; n < 2; ++n) acc[a][b][m][n] = (f32x4){0.f, 0.f, 0.f, 0.f};
    bf16x8 At[4][2], B0[2][2], B1[2][2];
    const char* cA = GATHER ? (const char*)g.A : (const char*)g.A + (size_t)cur.pm * tstep + (cur.pm >= g.spm ? g.sdelta : 0L); const char* cB = (const char*)g.Bt + (size_t)cur.pn * tstep;
#pragma unroll
    for (int h = 0; h < 2; ++h)
#pragma unroll
        for (int i = 0; i < 2; ++i) { if constexpr (GATHER) vAc[h][i] = S.a_row_off(cur, h * HALF + rA[i]) + (unsigned)cA2[i]; else vAc[h][i] = (unsigned)((h * HALF + rA[i]) * K) * 2u + (unsigned)cA2[i]; vAn[h][i] = vAc[h][i]; }
    S.a_ready(cur);
    if constexpr (SP2) {
        PG8_STAGE(PG8_SB(0, 0), cB, voffB); PG8_STAGE(PG8_SB(0, 1), cB + hstep, voffB); PG8_STAGE(PG8_SA(0, 0), cA, vAc[0]); PG8_STAGE(PG8_SA(0, 1), cA, vAc[1]);
        if (wr == 1) PG8_BAR;
        PG8_WAIT_V(2); PG8_BAR;
        PG8_STAGE(PG8_SB(1, 0), cB + kstep, voffB); PG8_STAGE(PG8_SA(1, 0), cA + kstep, vAc[0]); PG8_STAGE(PG8_SB(1, 1), cB + hstep + kstep, voffB);
        PG8_WAIT_V(6); PG8_BAR;
    }
    for (;;) {
        const bool has_next = S.next(ui + 1, nxt);
        const char* nA = GATHER ? cA : (has_next ? (const char*)g.A + (size_t)nxt.pm * tstep + (nxt.pm >= g.spm ? g.sdelta : 0L) : cA); const char* nB = has_next ? (const char*)g.Bt + (size_t)nxt.pn * tstep : cB;
        if constexpr (GATHER) { if (has_next) {
#pragma unroll
            for (int h = 0; h < 2; ++h)
#pragma unroll
                for (int i = 0; i < 2; ++i) vAn[h][i] = S.a_row_off(nxt, h * HALF + rA[i]) + (unsigned)cA2[i]; } }
#pragma unroll 1
        for (int t = 0; t < nt; t += 2) {
            const bool last = (t == nt - 2);
            asm volatile("" : "+v"(voffB[0]), "+v"(voffB[1]), "+v"(vAc[0][0]), "+v"(vAc[0][1]), "+v"(vAc[1][0]), "+v"(vAc[1][1]));
            const char* a1 = cA + (size_t)(t + 1) * kstep;
            const char* a2 = last ? nA : cA + (size_t)(t + 2) * kstep; const char* b2 = last ? nB : cB + (size_t)(t + 2) * kstep;
            const char* a3 = a2 + kstep; const char* b3 = b2 + kstep;
            unsigned vA2[2][2];
#pragma unroll
            for (int h = 0; h < 2; ++h)
#pragma unroll
                for (int i = 0; i < 2; ++i) vA2[h][i] = vAc[h][i];
            if constexpr (GATHER) { if (last) {
                asm volatile("" : "+v"(vAn[0][0]), "+v"(vAn[0][1]), "+v"(vAn[1][0]), "+v"(vAn[1][1]));
#pragma unroll
                for (int h = 0; h < 2; ++h)
#pragma unroll
                    for (int i = 0; i < 2; ++i) vA2[h][i] = vAn[h][i]; } }
            if (last && has_next) S.a_ready(nxt);
            if constexpr (SP2) {
            const int lenient = __builtin_amdgcn_readfirstlane((ui > 0 && t == 0) ? 1 : 0);
#define PG8_WAIT_V8L() asm volatile("s_cmp_eq_u32 %0, 0\n\ts_cbranch_scc0 .Lpg8skip%=\n\ts_waitcnt vmcnt(8)\n.Lpg8skip%=:\n\ts_waitcnt vmcnt(%1)" :: "s"(lenient), "i"(8 + Epi::NSTORE) : "memory", "scc")
            PG8_LDB(B0, 0, 0); PG8_LDB(B1, 0, 1); PG8_SCHED; PG8_LDA(At, 0, 0); PG8_STAGE(PG8_SA(1, 1), a1, vAc[1]);
            PG8_WAIT_V8L(); PG8_WAIT_L(0); PG8_BAR; PG8_MMA(0, 0, At, B0); PG8_MMA(0, 1, At, B1); PG8_BAR; PG8_SCHED;
            PG8_LDA(At, 0, 1); PG8_STAGE(PG8_SB(0, 0), b2, voffB); PG8_STAGE(PG8_SB(0, 1), b2 + hstep, voffB); PG8_STAGE(PG8_SA(0, 0), a2, vA2[0]);
            PG8_WAIT_V8L(); PG8_WAIT_L(0); PG8_BAR; PG8_MMA(1, 0, At, B0); PG8_MMA(1, 1, At, B1); PG8_BAR; PG8_SCHED;
            PG8_LDB(B0, 1, 0); PG8_LDB(B1, 1, 1); PG8_SCHED; PG8_LDA(At, 1, 0); PG8_STAGE(PG8_SA(0, 1), a2, vA2[1]);
            PG8_WAIT_V(8); PG8_WAIT_L(0); PG8_BAR; PG8_MMA(0, 0, At, B0); PG8_MMA(0, 1, At, B1); PG8_BAR; PG8_SCHED;
            PG8_LDA(At, 1, 1); PG8_STAGE(PG8_SB(1, 0), b3, voffB); PG8_STAGE(PG8_SB(1, 1), b3 + hstep, voffB); PG8_STAGE(PG8_SA(1, 0), a3, vA2[0]);
            PG8_WAIT_V(8); PG8_WAIT_L(0); PG8_BAR; PG8_MMA(1, 0, At, B0); PG8_MMA(1, 1, At, B1); PG8_BAR; PG8_SCHED;
#undef PG8_WAIT_V8L
            }
        }
        if constexpr (ALIGN_EPI) { if (wr == 0) PG8_BAR; }
        if constexpr (!Epi::AFTER_DRAIN) { const int le = lane_id(); E(acc, cur, wr, wc, le & 15, le >> 4); S.done(cur, ui, le); }
        if (!has_next) break;
#pragma unroll
        for (int a = 0; a < 2; ++a)
#pragma unroll
            for (int b = 0; b < 2; ++b)
#pragma unroll
                for (int m = 0; m < 4; ++m)
#pragma unroll
                    for (int n = 0; n < 2; ++n) acc[a][b][m][n] = (f32x4){0.f, 0.f, 0.f, 0.f};
        cur = nxt; cA = nA; cB = nB; ++ui;
        if constexpr (GATHER) {
#pragma unroll
            for (int h = 0; h < 2; ++h)
#pragma unroll
                for (int i = 0; i < 2; ++i) vAc[h][i] = vAn[h][i]; }
        if constexpr (ALIGN_EPI) { if (wr == 1) PG8_BAR; }
    }
    PG8_WAIT_V(0);
    if constexpr (!ALIGN_EPI) { if (wr == 0) PG8_BAR; }
    PG8_BAR;
    if constexpr (Epi::AFTER_DRAIN) { E.fused(acc, cur, wr, wc, fr, fq, lds, wid, lane); S.done(cur, ui, lane); }
#undef PG8_SA
#undef PG8_SB
#undef PG8_STAGE
#undef PG8_LDA
#undef PG8_LDB
#undef PG8_MMA
#undef PG8_CAT8
#undef PG8_WAIT_V
#undef PG8_WAIT_VN
#undef PG8_WAIT_L
#undef PG8_BAR
#undef PG8_SCHED
}
}
#define GAS __attribute__((address_space(1)))
#define LAS __attribute__((address_space(3)))
typedef unsigned short bf16;
typedef unsigned v4u __attribute__((ext_vector_type(4)));
typedef float f32x4 __attribute__((ext_vector_type(4)));
typedef short bf16x8 __attribute__((ext_vector_type(8)));
typedef GAS unsigned gu32;
typedef GAS unsigned long long gu64;
#define RLX_AGENT __ATOMIC_RELAXED, __HIP_MEMORY_SCOPE_AGENT
#define LDS_WAIT() asm volatile("s_waitcnt lgkmcnt(0)" ::: "memory")
#define VM_WAIT() asm volatile("s_waitcnt vmcnt(0)" ::: "memory")
__device__ __forceinline__ unsigned long long rt() { return __builtin_amdgcn_s_memrealtime(); }
__device__ __forceinline__ unsigned f2bf(float f) { unsigned u = __builtin_bit_cast(unsigned, f); return (u + 0x7fffu + ((u >> 16) & 1u)) >> 16; }
__device__ __forceinline__ unsigned pk2(float lo, float hi) { return f2bf(lo) | (f2bf(hi) << 16); }

#define XB_TMO      128
#define XB_XCNT(j)  (256  + 64 * (j))
#define XB_XSUB(j)  (1280 + 64 * (j))
#define XB_XGEN(j)  (2304 + 64 * (j))
#define XB_TOP      3328
#define XB_TOPGEN   3392
#define XCD_BAR_WORDS 3456
#define XB_SPIN_CAP (1u << 18)

__device__ __forceinline__ unsigned xb_ld(unsigned* p)              { return __hip_atomic_load(p, __ATOMIC_RELAXED, __HIP_MEMORY_SCOPE_AGENT); }
__device__ __forceinline__ unsigned xb_add(unsigned* p, unsigned v) { return __hip_atomic_fetch_add(p, v, __ATOMIC_RELAXED, __HIP_MEMORY_SCOPE_AGENT); }
__device__ __forceinline__ unsigned xb_xcc_id() { return (unsigned)__builtin_amdgcn_s_getreg((3 << 11) | 20) & 0xFu; }
#define XB_SPIN(cond, bar) do { unsigned _sp = 0; while (cond) { __builtin_amdgcn_s_sleep(1); \
    if ((++_sp & 255u) == 0u) { if (xb_ld(&(bar)[XB_TMO])) break; if (_sp > XB_SPIN_CAP) { atomicAdd(&(bar)[XB_TMO], 1u); break; } } } } while (0)

struct XcdBarrier {
    unsigned* bar; unsigned x; int wv;
    volatile LAS unsigned* st;
};

__device__ __forceinline__ XcdBarrier xcd_barrier_post(unsigned* bar, volatile LAS unsigned* st) {
    XcdBarrier b; b.bar = bar; b.x = xb_xcc_id(); b.st = st; b.wv = 0;
    if (threadIdx.x == 0) (void)xb_add(&bar[XB_XCNT(b.x)], 1u);
    return b;
}
__device__ __forceinline__ void xcd_barrier_complete(unsigned* bar, unsigned x, unsigned& nloc, unsigned& nx) {
    const unsigned G = gridDim.x * gridDim.y * gridDim.z;
    unsigned sum, cnt, mine, sp = 0u;
    for (;;) {
        sum = 0u; cnt = 0u; mine = 0u;
#pragma unroll
        for (unsigned j = 0; j < 16; ++j) { const unsigned c = xb_ld(&bar[XB_XCNT(j)]); sum += c; cnt += (c > 0u) ? 1u : 0u; mine = (j == x) ? c : mine; }
        if (sum == G) break;
        __builtin_amdgcn_s_sleep(1);
        if ((++sp & 255u) == 0u) { if (xb_ld(&bar[XB_TMO])) break; if (sp > XB_SPIN_CAP) { atomicAdd(&bar[XB_TMO], 1u); break; } }
    }
    nloc = mine > 0u ? mine : 1u; nx = cnt > 0u ? cnt : 1u;
}

__device__ __forceinline__ void xcd_barrier(const XcdBarrier& b) {
    asm volatile("s_waitcnt vmcnt(0)" ::: "memory");
    __syncthreads();
    if (b.wv == 0 && (int)__builtin_amdgcn_mbcnt_hi(~0u, __builtin_amdgcn_mbcnt_lo(~0u, 0u)) == 0) {
        unsigned* bar = b.bar;
        __builtin_amdgcn_s_waitcnt(0);
        unsigned nloc = b.st[0], nx = b.st[1];
        if (nloc == 0u) { xcd_barrier_complete(bar, b.x, nloc, nx); b.st[0] = nloc; b.st[1] = nx; }
        const unsigned old = xb_add(&bar[XB_XSUB(b.x)], 1u);
        const unsigned gen = old / nloc;
        if (old + 1u == (gen + 1u) * nloc) {
            __builtin_amdgcn_fence(__ATOMIC_RELEASE, "agent");
            asm volatile("s_waitcnt vmcnt(0)" ::: "memory");
            const unsigned og = xb_add(&bar[XB_TOP], 1u);
            const unsigned tg = og / nx;
            if (og + 1u == (tg + 1u) * nx) xb_add(&bar[XB_TOPGEN], 1u);
            else XB_SPIN(xb_ld(&bar[XB_TOPGEN]) == tg, bar);
            __builtin_amdgcn_fence(__ATOMIC_ACQUIRE, "agent");
            xb_add(&bar[XB_XGEN(b.x)], 1u);
            asm volatile("s_waitcnt vmcnt(0)" ::: "memory");
        } else {
            XB_SPIN(xb_ld(&bar[XB_XGEN(b.x)]) == gen, bar);
            __builtin_amdgcn_fence(__ATOMIC_ACQUIRE, "agent");
            asm volatile("s_waitcnt vmcnt(0)" ::: "memory");
        }
    }
    __syncthreads();
}


constexpr int NWAVES = 8;
constexpr int RING_BYTES = 131072;
constexpr int LDSCTL_OFF = RING_BYTES, MISC_OFF = LDSCTL_OFF + 320;
constexpr int LDS_TS_OFF = LDSCTL_OFF + 1024;
constexpr int LDS_TE_OFF = LDSCTL_OFF + 2048;
constexpr int LDS_CNT_OFF = LDSCTL_OFF + 1024 + 128;
constexpr int LDS_BYTES = 163840;

typedef short s16x4 __attribute__((ext_vector_type(4)));
typedef unsigned u32x2 __attribute__((ext_vector_type(2)));

struct Args { const float* in[20]; float* out; unsigned char* ws; unsigned mask; int bar_region; };

__device__ __forceinline__ float bflo(unsigned w) { return __uint_as_float(w << 16); }
__device__ __forceinline__ float bfhi(unsigned w) { return __uint_as_float(w & 0xffff0000u); }
__device__ __forceinline__ unsigned cvtpk(float lo, float hi) { return pg8::cvt_pk_bf16(lo, hi); }
__device__ __forceinline__ float wave_sum(float v) {
#pragma unroll
    for (int o = 1; o < 64; o <<= 1) v += __shfl_xor(v, o);
    return v;
}
__device__ __forceinline__ unsigned offb(unsigned row, unsigned ch) { return 256u * row + 16u * (ch ^ (((row & 3u) << 2) | ((row >> 2) & 3u))); }
__device__ __forceinline__ s16x4 ldtr(const LAS unsigned char* p) { return __builtin_amdgcn_ds_read_tr16_b64_v4i16((LAS s16x4*)p); }
__device__ __forceinline__ bf16x8 cat8(s16x4 a, s16x4 b) { return (bf16x8){a[0], a[1], a[2], a[3], b[0], b[1], b[2], b[3]}; }
#define MFMA16(a, b, c) __builtin_amdgcn_mfma_f32_16x16x32_bf16((a), (b), (c), 0, 0, 0)

template <int MODE> __device__ __forceinline__ int dest_row(int n) {
    if (MODE == 1) { if (n >= 1024) return n; const int hb = n & ~127, d = n & 127, jr = d & 63, half = d >> 6; return hb + 8 * (jr >> 2) + 4 * half + (jr & 3); }
    if (MODE == 2) return ((n >> 2) << 3) + (n & 3);
    if (MODE == 3) return ((n >> 2) << 3) + 4 + (n & 3);
    return n;
}
template <int MODE> __device__ __forceinline__ void p0_transpose_item(const float* W, int K, int N, bf16* WT, LAS float* scr, int item, int lane) {
    const int nblk = N / 32, kb = item / nblk, nb = item % nblk, k0 = 64 * kb, n0 = 32 * nb;
    {
        const GAS f32x4* src = (const GAS f32x4*)(W + (size_t)(k0 + (lane >> 3)) * N + n0) + (lane & 7);
        f32x4 t[8];
#pragma unroll
        for (int j = 0; j < 8; ++j) t[j] = src[(size_t)j * 2 * N];
#pragma unroll
        for (int j = 0; j < 8; ++j) { LAS float* d = scr + ((lane >> 3) + 8 * j) * 33 + 4 * (lane & 7); d[0] = t[j].x; d[1] = t[j].y; d[2] = t[j].z; d[3] = t[j].w; }
    }
    LDS_WAIT(); asm volatile("" ::: "memory");
    const int c = lane & 7;
#pragma unroll
    for (int j = 0; j < 4; ++j) { const int n = (lane >> 3) + 8 * j; const LAS float* s = scr + (8 * c) * 33 + n;
        v4u o; o.x = pk2(s[0 * 33], s[1 * 33]); o.y = pk2(s[2 * 33], s[3 * 33]); o.z = pk2(s[4 * 33], s[5 * 33]); o.w = pk2(s[6 * 33], s[7 * 33]);
        *(GAS v4u*)(WT + (size_t)dest_row<MODE>(n0 + n) * K + k0 + 8 * c) = o; }
    LDS_WAIT(); asm volatile("" ::: "memory");
}
__device__ __forceinline__ unsigned pk_fp8x4(float a, float b, float c, float d) {
    a = fminf(fmaxf(a, -448.f), 448.f); b = fminf(fmaxf(b, -448.f), 448.f); c = fminf(fmaxf(c, -448.f), 448.f); d = fminf(fmaxf(d, -448.f), 448.f);
    unsigned w = 0u; w = __builtin_amdgcn_cvt_pk_fp8_f32(a, b, w, false); w = __builtin_amdgcn_cvt_pk_fp8_f32(c, d, w, true); return w;
}
template <int MODE> __device__ __forceinline__ void p0_transpose_item_fp8(const float* W, int K, int N, unsigned char* WT, LAS float* scr, int item, int lane, float scale) {
    const int nblk = N / 32, kb = item / nblk, nb = item % nblk, k0 = 64 * kb, n0 = 32 * nb;
    {
        const GAS f32x4* src = (const GAS f32x4*)(W + (size_t)(k0 + (lane >> 3)) * N + n0) + (lane & 7);
        f32x4 t[8];
#pragma unroll
        for (int j = 0; j < 8; ++j) t[j] = src[(size_t)j * 2 * N];
#pragma unroll
        for (int j = 0; j < 8; ++j) { LAS float* d = scr + ((lane >> 3) + 8 * j) * 33 + 4 * (lane & 7); d[0] = t[j].x; d[1] = t[j].y; d[2] = t[j].z; d[3] = t[j].w; }
    }
    LDS_WAIT(); asm volatile("" ::: "memory");
    const int c = lane & 7;
#pragma unroll
    for (int j = 0; j < 4; ++j) { const int n = (lane >> 3) + 8 * j; const LAS float* s = scr + (8 * c) * 33 + n;
        u32x2 o; o.x = pk_fp8x4(s[0 * 33] * scale, s[1 * 33] * scale, s[2 * 33] * scale, s[3 * 33] * scale); o.y = pk_fp8x4(s[4 * 33] * scale, s[5 * 33] * scale, s[6 * 33] * scale, s[7 * 33] * scale);
        *(GAS u32x2*)(WT + (size_t)dest_row<MODE>(n0 + n) * K + k0 + 8 * c) = o; }
    LDS_WAIT(); asm volatile("" ::: "memory");
}
__device__ __forceinline__ int t5_bucket(int rel) {
    const int n = rel < 0 ? -rel : rel;
    int large = 8 + (n >= 15) + (n >= 27) + (n >= 50) + (n >= 91) + (n >= 166) + (n >= 305) + (n >= 559);
    large = large < 15 ? large : 15;
    return (rel > 0 ? 16 : 0) + (n < 8 ? n : large);
}
__device__ __forceinline__ void p0_prologue(const Args& a, LAS unsigned char* lds, int vcu, int G, int tid, int wave, int lane) {
    unsigned char* ws = a.ws;
    LAS float* scr = (LAS float*)(lds + wave * 16384);
    const int gw = vcu * NWAVES + wave, NGW = G * NWAVES;
    constexpr int I_IN = 16 * 208, I_R = 16 * 32, I_A = 8 * 32, I_O = 16 * 32;
    constexpr int NITEMS = I_IN + I_R + I_A + I_O;
    for (int it = gw; it < NITEMS; it += NGW) {
        int r = it;
#if P1_FP8
        if (r < I_IN) { if ((GATE_FP8 || r % 208 < 144) && r % 208 >= 8 * P1_FP8_FROM) p0_transpose_item_fp8<1>(a.in[1], 1024, 6656, ws + WS_WIN8, scr, r, lane, 64.f);
                        else p0_transpose_item<1>(a.in[1], 1024, 6656, (bf16*)(ws + WS_WIN), scr, r, lane); continue; } r -= I_IN;
#else
        if (r < I_IN) { p0_transpose_item<1>(a.in[1], 1024, 6656, (bf16*)(ws + WS_WIN), scr, r, lane); continue; } r -= I_IN;
#endif
        if (r < I_R) { if (MIX_FP8 & 4) p0_transpose_item_fp8<0>(a.in[5], 1024, 1024, ws + WS_WR, scr, r, lane, 64.f); else p0_transpose_item<0>(a.in[5], 1024, 1024, (bf16*)(ws + WS_WR), scr, r, lane); continue; } r -= I_R;
        if (r < I_A) { if (MIX_FP8 & 2) p0_transpose_item_fp8<0>(a.in[7], 512, 1024, ws + WS_WA, scr, r, lane, 64.f); else p0_transpose_item<0>(a.in[7], 512, 1024, (bf16*)(ws + WS_WA), scr, r, lane); continue; } r -= I_A;
        if (MIX_FP8 & 1) p0_transpose_item_fp8<0>(a.in[8], 1024, 1024, ws + WS_WO, scr, r, lane, 64.f); else p0_transpose_item<0>(a.in[8], 1024, 1024, (bf16*)(ws + WS_WO), scr, r, lane);
    }
    {
        const f32x4* x4 = (const f32x4*)a.in[0]; u32x2* xb = (u32x2*)(ws + WS_XB);
#if P1_FP8
#if GATE_FP8
        unsigned* xf8 = (unsigned*)(ws + WS_X8_LO);
#define XF8_AT(i) xf8[(long)(i) + ((i) >= (size_t)16384 * 256 ? ((long)WS_X8_HI - (long)WS_X8_LO - (long)(16 * MiB)) / 4 : 0L)]
#else
        unsigned* xf8 = (unsigned*)a.out;
#define XF8_AT(i) xf8[i]
#endif
        const size_t n4 = (size_t)TT * DM / 4, st = (size_t)G * 512; size_t i = (size_t)vcu * 512 + tid;
        for (; i + 7 * st < n4; i += 8 * st) {
            f32x4 v[8];
#pragma unroll
            for (int u = 0; u < 8; ++u) v[u] = x4[i + u * st];
#pragma unroll
            for (int u = 0; u < 8; ++u) { if (!X_F32_RES) { u32x2 o; o.x = cvtpk(v[u].x, v[u].y); o.y = cvtpk(v[u].z, v[u].w); xb[i + u * st] = o; } XF8_AT(i + u * st) = pk_fp8x4(v[u].x, v[u].y, v[u].z, v[u].w); }
        }
        for (; i < n4; i += st) { const f32x4 v = x4[i]; if (!X_F32_RES) { u32x2 o; o.x = cvtpk(v.x, v.y); o.y = cvtpk(v.z, v.w); xb[i] = o; } XF8_AT(i) = pk_fp8x4(v.x, v.y, v.z, v.w); }
#undef XF8_AT
#else
        for (size_t i = (size_t)vcu * 512 + tid; i < (size_t)TT * DM / 4; i += (size_t)G * 512) { const f32x4 v = x4[i]; u32x2 o; o.x = cvtpk(v.x, v.y); o.y = cvtpk(v.z, v.w); xb[i] = o; }
#endif
    }
    {
        float* rot = (float*)(ws + WS_ROT);
        for (int idx = vcu * 512 + tid; idx < SEQ * 64; idx += G * 512) {
            const int pos = idx >> 6, jr = idx & 63;
            double iv = 1.0; for (int k = 0; k < jr; ++k) iv *= 0.86596432336006535;
            const float ang = (float)pos * (float)iv;
            const double xx = (double)ang; const double qd = __builtin_rint(xx * 0.63661977236758134); const int qi = (int)qd;
            const double r = (xx - qd * 1.5707963267948966) - qd * 6.123233995736766e-17, r2 = r * r;
            const double sp = r * (1.0 + r2 * (-1.0 / 6 + r2 * (1.0 / 120 + r2 * (-1.0 / 5040 + r2 * (1.0 / 362880 + r2 * (-1.0 / 39916800 + r2 * (1.0 / 6227020800.0)))))));
            const double cp = 1.0 + r2 * (-0.5 + r2 * (1.0 / 24 + r2 * (-1.0 / 720 + r2 * (1.0 / 40320 + r2 * (-1.0 / 3628800 + r2 * (1.0 / 479001600.0))))));
            const int qq = qi & 3; const double s = qq == 0 ? sp : (qq == 1 ? cp : (qq == 2 ? -sp : -cp)), c = qq == 0 ? cp : (qq == 1 ? -sp : (qq == 2 ? -cp : sp));
            float* o = rot + ((size_t)pos * 16 + (jr >> 2)) * 8 + (jr & 3); o[0] = (float)c; o[4] = (float)s;
        }
    }
    if (vcu == 0) {
        float* bt = (float*)(ws + WS_BIAS); const float* rb = a.in[6];
        for (int idx = tid; idx < 3 * 8 * 160; idx += 512) { const int p = idx / (8 * 160), h = (idx / 160) % 8, d = idx % 160 - 80; const int dil = p == 0 ? 1 : (p == 1 ? 4 : 16);
            bt[idx] = (d >= -64 && d <= 64) ? rb[t5_bucket(d * dil) * 8 + h] * 1.4426950408889634f : -1e30f; }
    }
}
__device__ __forceinline__ void p0_expert_weights(const Args& a, LAS unsigned char* lds, int vcu, int G, int wave, int lane) {
    unsigned char* ws = a.ws;
    LAS float* scr = (LAS float*)(lds + wave * 16384);
    const int gw = vcu * NWAVES + wave, NGW = G * NWAVES;
    constexpr int I_G = 16 * 16, I_D = 8 * 32, PER_E = 2 * I_G + I_D;
    for (int it = gw; it < 16 * PER_E; it += NGW) {
        const int e = it / PER_E; int r = it - e * PER_E;
#if M1_FP8
        if (r < I_G) { p0_transpose_item_fp8<2>(a.in[15] + (size_t)e * 1024 * 512, 1024, 512, ws + WS_WGU + (size_t)e * 1024 * 1024, scr, r, lane, 64.f); continue; } r -= I_G;
        if (r < I_G) { p0_transpose_item_fp8<3>(a.in[16] + (size_t)e * 1024 * 512, 1024, 512, ws + WS_WGU + (size_t)e * 1024 * 1024, scr, r, lane, 64.f); continue; } r -= I_G;
#else
        if (r < I_G) { p0_transpose_item<2>(a.in[15] + (size_t)e * 1024 * 512, 1024, 512, (bf16*)(ws + WS_WGU) + (size_t)e * 1024 * 1024, scr, r, lane); continue; } r -= I_G;
        if (r < I_G) { p0_transpose_item<3>(a.in[16] + (size_t)e * 1024 * 512, 1024, 512, (bf16*)(ws + WS_WGU) + (size_t)e * 1024 * 1024, scr, r, lane); continue; } r -= I_G;
#endif
        p0_transpose_item_fp8<0>(a.in[17] + (size_t)e * 512 * 1024, 512, 1024, ws + WS_WD + (size_t)e * 1024 * 512, scr, r, lane, 64.f);
    }
    __syncthreads();
}

__device__ __forceinline__ float log2_gamma(const float* dec, int h) {
    const float x = dec[h]; return -__log2f(1.f + __expf(-x));
}
__device__ __forceinline__ void chain_item(const Args& a, LAS unsigned char* lds, int item, int tid, int wid, int lane) {
    unsigned char* ws = a.ws;
    const int b = item >> 4, h = (item >> 2) & 3, dir = (item >> 1) & 1, vh = item & 1;
    const float lg2 = log2_gamma(dir ? a.in[3] : a.in[2], h);
    const float cd = __builtin_amdgcn_exp2f(lg2 * 128.f);
    const int g = lane >> 4, i16 = lane & 15, q = i16 >> 2, p = lane & 3;
    const int wd = wid >> 1, wv = wid & 1;
    const GAS bf16* kr = (const GAS bf16*)(ws + WS_KR); const GAS bf16* vr = (const GAS bf16*)(ws + WS_VR);
    GAS bf16* states = (GAS bf16*)a.out;
    f32x4 acc[2][4];
#pragma unroll
    for (int i = 0; i < 2; ++i)
#pragma unroll
        for (int j = 0; j < 4; ++j) acc[i][j] = (f32x4){0.f, 0.f, 0.f, 0.f};
    const int srow = tid >> 4, sch = tid & 15; const unsigned soff = offb(srow, sch);
    const GAS bf16* kp = kr + ((size_t)b * SEQ + srow) * 512 + h * 128 + sch * 8;
    const GAS bf16* vp = vr + ((size_t)b * SEQ + srow) * 1024 + h * 256 + vh * 128 + sch * 8;
    v4u kq[4], vq[4];
    { const int n0 = dir ? 15 : 0;
#pragma unroll
      for (int j = 0; j < 4; ++j) { kq[j] = *(const GAS v4u*)(kp + (size_t)(n0 * 128 + 32 * j) * 512); vq[j] = *(const GAS v4u*)(vp + (size_t)(n0 * 128 + 32 * j) * 1024); } }
    unsigned abase[2][2], bbase[4][2];
#pragma unroll
    for (int t = 0; t < 2; ++t) { const unsigned r = 8 * g + 4 * t + q;
#pragma unroll
        for (int dt = 0; dt < 2; ++dt) abase[dt][t] = offb(r, 2 * (2 * wd + dt) + (p >> 1)) + 8 * (p & 1);
#pragma unroll
        for (int vt = 0; vt < 4; ++vt) bbase[vt][t] = offb(r, 2 * (4 * wv + vt) + (p >> 1)) + 8 * (p & 1); }
#define CH_STAGE(BUFOFF) do { _Pragma("unroll") for (int j = 0; j < 4; ++j) { \
            const int row = srow + 32 * j; const float z = __builtin_amdgcn_exp2f(lg2 * (float)(dir ? row : 127 - row)); const v4u kv = kq[j]; \
            v4u ko; ko.x = cvtpk(bflo(kv.x) * z, bfhi(kv.x) * z); ko.y = cvtpk(bflo(kv.y) * z, bfhi(kv.y) * z); ko.z = cvtpk(bflo(kv.z) * z, bfhi(kv.z) * z); ko.w = cvtpk(bflo(kv.w) * z, bfhi(kv.w) * z); \
            *(LAS v4u*)(lds + (BUFOFF) + soff + j * 8192) = ko; *(LAS v4u*)(lds + (BUFOFF) + 32768 + soff + j * 8192) = vq[j]; } } while (0)
#define CH_FETCH(NN) do { _Pragma("unroll") for (int j = 0; j < 4; ++j) { kq[j] = *(const GAS v4u*)(kp + (size_t)((NN) * 128 + 32 * j) * 512); vq[j] = *(const GAS v4u*)(vp + (size_t)((NN) * 128 + 32 * j) * 1024); } } while (0)
#define CH_STEP(STEP, CUR, OTH) do { const int step_ = (STEP); const int n_ = dir ? 15 - step_ : step_; \
        GAS bf16* sb_ = states + ((((size_t)(b * 4 + h) * 16 + n_) * 2 + dir) * 256) * 128; \
        _Pragma("unroll") for (int dt = 0; dt < 2; ++dt) _Pragma("unroll") for (int vt = 0; vt < 4; ++vt) { \
            const int v_ = vh * 128 + 64 * wv + 16 * vt + i16, d0_ = 32 * wd + 16 * dt + 4 * g; \
            if (STATE_FP8) { *(GAS unsigned*)((GAS unsigned char*)states + (((((size_t)(b * 4 + h) * 16 + n_) * 2 + dir) * 256) + v_) * 128 + d0_) = pg8::fp8x4_sat(acc[dt][vt][0] * 16.f, acc[dt][vt][1] * 16.f, acc[dt][vt][2] * 16.f, acc[dt][vt][3] * 16.f); }   \
            else { u32x2 w_; w_.x = pg8::cvt_pk_bf16_acc(acc[dt][vt][0], acc[dt][vt][1]); w_.y = pg8::cvt_pk_bf16_acc(acc[dt][vt][2], acc[dt][vt][3]);   \
            *(GAS u32x2*)(sb_ + (size_t)v_ * 128 + d0_) = w_; } } \
        if (step_ < 15) CH_STAGE(OTH); \
        if (step_ < 14) CH_FETCH(dir ? 13 - step_ : step_ + 2); \
        _Pragma("unroll") for (int i = 0; i < 2; ++i) _Pragma("unroll") for (int j = 0; j < 4; ++j) acc[i][j] = acc[i][j] * cd; \
        _Pragma("unroll") for (int ks = 0; ks < 4; ++ks) { bf16x8 af[2], bfr[4]; \
            _Pragma("unroll") for (int dt = 0; dt < 2; ++dt) af[dt] = cat8(ldtr(lds + (CUR) + abase[dt][0] + ks * 8192), ldtr(lds + (CUR) + abase[dt][1] + ks * 8192)); \
            _Pragma("unroll") for (int vt = 0; vt < 4; ++vt) bfr[vt] = cat8(ldtr(lds + (CUR) + 32768 + bbase[vt][0] + ks * 8192), ldtr(lds + (CUR) + 32768 + bbase[vt][1] + ks * 8192)); \
            _Pragma("unroll") for (int dt = 0; dt < 2; ++dt) _Pragma("unroll") for (int vt = 0; vt < 4; ++vt) acc[dt][vt] = MFMA16(af[dt], bfr[vt], acc[dt][vt]); } \
        __syncthreads(); } while (0)
    CH_STAGE(0);
    CH_FETCH(dir ? 14 : 1);
    __syncthreads();
    for (int sp = 0; sp < 8; ++sp) { CH_STEP(2 * sp, 0, 65536); CH_STEP(2 * sp + 1, 65536, 0); }
#undef CH_STEP
#undef CH_STAGE
#undef CH_FETCH
}

constexpr int AT_OST = 135168, AT_SCR = AT_OST + 8 * 2048;
constexpr int ATB_N = 160;
struct AttnLane { unsigned kb[2]; unsigned vb[4]; };
__device__ __forceinline__ AttnLane attn_lane(int lane) {
    const int g = lane >> 4, i16 = lane & 15, q4 = i16 >> 2, p = lane & 3; AttnLane L;
#pragma unroll
    for (int s = 0; s < 2; ++s) L.kb[s] = i16 * 128 + (((4 * s + g) ^ ((i16 >> 1) & 7)) * 16);
    const int sw = (2 * g + (q4 >> 1)) & 3;
#pragma unroll
    for (int c = 0; c < 4; ++c) L.vb[c] = (4 * g + q4) * 128 + ((c ^ sw) * 32) + p * 8;
    return L;
}
__device__ __forceinline__ unsigned kimg_off(int row, int c) { return row * 128 + ((c ^ ((row >> 1) & 7)) * 16); }
__device__ __forceinline__ unsigned vimg_off(int row, int c) { return row * 128 + (((c >> 1) ^ ((row >> 1) & 3)) * 32) + (c & 1) * 16; }
__device__ __forceinline__ void attn_core(const LAS unsigned char* Kimg, const LAS unsigned char* Vimg, int R0, int nrows, unsigned tvalid, const bf16x8 (&qf)[2],
                                          const float (&biasr)[36], const AttnLane& L, f32x4 (&O)[4], float& mx, float& lsum) {
    f32x4 D[9];
#pragma unroll
    for (int kt = 0; kt < 9; ++kt) {
        int R = R0 + 16 * kt; R = R < 0 ? 0 : (R > nrows - 16 ? nrows - 16 : R);
        const LAS unsigned char* kp = Kimg + R * 128;
        const bf16x8 k0 = *(const LAS bf16x8*)(kp + L.kb[0]), k1 = *(const LAS bf16x8*)(kp + L.kb[1]);
        f32x4 d = (f32x4){0.f, 0.f, 0.f, 0.f};
        d = MFMA16(k0, qf[0], d); d = MFMA16(k1, qf[1], d); D[kt] = d;
    }
    mx = -1e30f;
#pragma unroll
    for (int kt = 0; kt < 9; ++kt) {
        const float tb = ((tvalid >> kt) & 1u) ? 0.f : -1e30f;
#pragma unroll
        for (int r = 0; r < 4; ++r) { const float x = D[kt][r] + (biasr[4 * kt + r] + tb); D[kt][r] = x; mx = fmaxf(mx, x); }
    }
    mx = fmaxf(mx, __shfl_xor(mx, 16)); mx = fmaxf(mx, __shfl_xor(mx, 32));
    lsum = 0.f;
#pragma unroll
    for (int kt = 0; kt < 9; ++kt)
#pragma unroll
        for (int r = 0; r < 4; ++r) { const float e = __builtin_amdgcn_exp2f(D[kt][r] - mx); D[kt][r] = e; lsum += e; }
    lsum += __shfl_xor(lsum, 16); lsum += __shfl_xor(lsum, 32);
#pragma unroll
    for (int c = 0; c < 4; ++c) O[c] = (f32x4){0.f, 0.f, 0.f, 0.f};
#pragma unroll
    for (int kk = 0; kk < 5; ++kk) {
        int Ra = R0 + 32 * kk; Ra = Ra < 0 ? 0 : (Ra > nrows - 16 ? nrows - 16 : Ra);
        int Rb = R0 + 32 * kk + 16; Rb = Rb < 0 ? 0 : (Rb > nrows - 16 ? nrows - 16 : Rb);
        if (kk == 4) Rb = Ra;
        const f32x4 e0 = D[2 * kk], e1 = kk < 4 ? D[2 * kk + 1] : (f32x4){0.f, 0.f, 0.f, 0.f};
        v4u pw; pw.x = cvtpk(e0[0], e0[1]); pw.y = cvtpk(e0[2], e0[3]); pw.z = cvtpk(e1[0], e1[1]); pw.w = cvtpk(e1[2], e1[3]);
        const bf16x8 pf = __builtin_bit_cast(bf16x8, pw);
        const LAS unsigned char* va_ = Vimg + Ra * 128; const LAS unsigned char* vb_ = Vimg + Rb * 128;
#pragma unroll
        for (int c = 0; c < 4; ++c) O[c] = MFMA16(pf, cat8(ldtr(va_ + L.vb[c]), ldtr(vb_ + L.vb[c])), O[c]);
    }
}
__device__ __forceinline__ void attn_stage_out(LAS unsigned char* lds, int wid, int lane, const f32x4 (&O)[4], float lsum) {
    const int g = lane >> 4, i16 = lane & 15;
    const float linv = 1.f / lsum;
    LAS bf16* st = (LAS bf16*)(lds + AT_OST + wid * 2048);
#pragma unroll
    for (int r = 0; r < 4; ++r) { const float li = __shfl(linv, 4 * g + r);
#pragma unroll
        for (int c = 0; c < 4; ++c) st[(4 * g + r) * 64 + 16 * c + i16] = (bf16)(cvtpk(O[c][r] * li, 0.f) & 0xffffu); }
}
__device__ __forceinline__ void attn_load_bias(const Args& a, int pat, int h, int lane, float (&biasr)[36]) {
    const GAS float* bt = (const GAS float*)(a.ws + WS_BIAS) + (pat * 8 + h) * ATB_N; const int g = lane >> 4, i16 = lane & 15;
#pragma unroll
    for (int kt = 0; kt < 9; ++kt)
#pragma unroll
        for (int r = 0; r < 4; ++r) biasr[4 * kt + r] = bt[16 * kt + 4 * g + r - 64 - i16 + 80];
}
template <int DIL, int VAR = 0> __device__ __forceinline__ void attn_dil_phase(const Args& a, LAS unsigned char* lds, int vcu, int G, int tid, int wid, int lane) {
    unsigned char* ws = a.ws;
    constexpr int NR = SEQ / DIL, PAT = DIL == 4 ? 1 : 2, CH = NR * 8 / 512, NITEM = NB * 8 * DIL;
    constexpr int NBUF = DIL == 16 ? 2 : 1, BUFB = 2 * NR * 128;
    const GAS bf16* qa = (const GAS bf16*)(ws + WS_QA); const GAS bf16* ka = (const GAS bf16*)(ws + WS_KA); const GAS bf16* va = (const GAS bf16*)(ws + WS_VA);
    bf16* op = (bf16*)(ws + (DIL == 4 ? WS_O2 : WS_O3)); float* lsep = (float*)(ws + (DIL == 4 ? WS_LSE2 : WS_LSE3));
    if (vcu >= NITEM) return;
    const int h = vcu & 7;
    float biasr[36]; attn_load_bias(a, PAT, h, lane, biasr);
    const AttnLane L = attn_lane(lane);
    const int g = lane >> 4, i16 = lane & 15;
    v4u kq[CH], vq[CH]; bf16x8 qn[2];
    auto issue = [&](int item, int gi) {
        const int rho = (item >> 3) % DIL, b = item / (8 * DIL); const size_t rowb = (size_t)b * SEQ;
#pragma unroll
        for (int j = 0; j < CH; ++j) { const int id = tid + 512 * j, row = id >> 3, c = id & 7; const size_t go = (rowb + (size_t)row * DIL + rho) * 512 + h * 64 + c * 8;
            kq[j] = *(const GAS v4u*)(ka + go); vq[j] = *(const GAS v4u*)(va + go); }
        const size_t qpos = rowb + (size_t)(16 * gi + i16) * DIL + rho;
#pragma unroll
        for (int s = 0; s < 2; ++s) qn[s] = *(const GAS bf16x8*)(qa + qpos * 512 + h * 64 + 32 * s + 8 * g);
    };
    issue(vcu, wid);
    int buf = 0;
    for (int item = vcu; item < NITEM; item += G) {
        const int rho = (item >> 3) % DIL, b = item / (8 * DIL); const size_t rowb = (size_t)b * SEQ;
        LAS unsigned char* Kimg = lds + buf * BUFB; LAS unsigned char* Vimg = Kimg + NR * 128;
        if (NBUF == 1) __syncthreads();
#pragma unroll
        for (int j = 0; j < CH; ++j) { const int id = tid + 512 * j, row = id >> 3, c = id & 7;
            *(LAS v4u*)(Kimg + kimg_off(row, c)) = kq[j]; *(LAS v4u*)(Vimg + vimg_off(row, c)) = vq[j]; }
        bf16x8 qf[2] = {qn[0], qn[1]};
        __syncthreads();
        if (NBUF == 2 && item + G < NITEM) issue(item + G, wid);
        for (int gi = wid; gi < NR / 16; gi += 8) {
            const int m0 = 16 * gi;
            if (NBUF == 1 && gi + 8 < NR / 16) {
                const size_t qpos = rowb + (size_t)(m0 + 128 + i16) * DIL + rho;
#pragma unroll
                for (int s = 0; s < 2; ++s) qn[s] = *(const GAS bf16x8*)(qa + qpos * 512 + h * 64 + 32 * s + 8 * g); }
            unsigned tvalid = 0u;
#pragma unroll
            for (int kt = 0; kt < 9; ++kt) { const int t0 = m0 - 64 + 16 * kt; tvalid |= (t0 >= 0 && t0 < NR) ? (1u << kt) : 0u; }
            f32x4 O[4]; float mx, lsum;
            if (VAR == 1) { mx = 0.f; lsum = 1.f;
#pragma unroll
                for (int c = 0; c < 4; ++c) O[c] = (f32x4){__builtin_bit_cast(float, qf[0][0] + c), 0.f, 0.f, 0.f}; }
            else attn_core(Kimg, Vimg, m0 - 64, NR, tvalid, qf, biasr, L, O, mx, lsum);
            attn_stage_out(lds, wid, lane, O, lsum);
            if (g == 0) lsep[(rowb + (size_t)(m0 + i16) * DIL + rho) * 8 + h] = mx + __log2f(lsum);
            asm volatile("s_waitcnt lgkmcnt(0)" ::: "memory");
            { const int q = lane >> 2, qt = lane & 3; const LAS v4u* sp = (const LAS v4u*)(lds + AT_OST + wid * 2048 + q * 128 + qt * 32);
              const v4u x0 = sp[0], x1 = sp[1];
#if O23_FP8
              v4u o8;
              o8.x = pk_fp8x4(16.f * bflo(x0.x), 16.f * bfhi(x0.x), 16.f * bflo(x0.y), 16.f * bfhi(x0.y)); o8.y = pk_fp8x4(16.f * bflo(x0.z), 16.f * bfhi(x0.z), 16.f * bflo(x0.w), 16.f * bfhi(x0.w));
              o8.z = pk_fp8x4(16.f * bflo(x1.x), 16.f * bfhi(x1.x), 16.f * bflo(x1.y), 16.f * bfhi(x1.y)); o8.w = pk_fp8x4(16.f * bflo(x1.z), 16.f * bfhi(x1.z), 16.f * bflo(x1.w), 16.f * bfhi(x1.w));
              *(v4u*)((unsigned char*)op + (rowb + (size_t)(m0 + q) * DIL + rho) * 512 + h * 64 + qt * 16) = o8; }
#else
              bf16* dst = op + (rowb + (size_t)(m0 + q) * DIL + rho) * 512 + h * 64 + qt * 16;
              *(v4u*)dst = x0; *(v4u*)(dst + 8) = x1; }
#endif
            asm volatile("s_waitcnt lgkmcnt(0)" ::: "memory");
            if (NBUF == 1) { qf[0] = qn[0]; qf[1] = qn[1]; }
        }
        if (NBUF == 1 && item + G < NITEM) issue(item + G, wid);
        buf ^= (NBUF - 1);
    }
    __syncthreads();
}
__device__ __forceinline__ void attn_p1_phase(const Args& a, LAS unsigned char* lds, int vcu, int G, int tid, int wid, int lane) {
    unsigned char* ws = a.ws;
    LAS unsigned char* Kimg = lds; LAS unsigned char* Vimg = lds + 384 * 128;
    const GAS bf16* qa = (const GAS bf16*)(ws + WS_QA); const GAS bf16* ka = (const GAS bf16*)(ws + WS_KA); const GAS bf16* va = (const GAS bf16*)(ws + WS_VA);
    const GAS bf16* o2 = (const GAS bf16*)(ws + WS_O2); const GAS bf16* o3 = (const GAS bf16*)(ws + WS_O3);
    const GAS float* lse2 = (const GAS float*)(ws + WS_LSE2); const GAS float* lse3 = (const GAS float*)(ws + WS_LSE3);
    bf16* oa = (bf16*)(ws + WS_OA);
    if (vcu >= 1024) return;
    const int h = vcu & 7;
    float biasr[36]; attn_load_bias(a, 0, h, lane, biasr);
    const AttnLane L = attn_lane(lane);
    const int g = lane >> 4, i16 = lane & 15;
    LAS float* scr = (LAS float*)(lds + AT_SCR) + wid * 16;
    v4u kq[6], vq[6];
    auto issue = [&](int item) { const int b = item >> 6, s0 = ((item >> 3) & 7) * 256; const size_t rowb = (size_t)b * SEQ;
#pragma unroll
        for (int j = 0; j < 6; ++j) { const int id = tid + 512 * j, row = id >> 3, c = id & 7, pos = s0 - 64 + row; const bool ok = pos >= 0 && pos < SEQ;
            const size_t go = (rowb + (size_t)(ok ? pos : 0)) * 512 + h * 64 + c * 8;
            kq[j] = *(const GAS v4u*)(ka + go); vq[j] = *(const GAS v4u*)(va + go);
            if (!ok) { kq[j] = (v4u){0u, 0u, 0u, 0u}; vq[j] = (v4u){0u, 0u, 0u, 0u}; } } };
    issue(vcu);
    for (int item = vcu; item < 1024; item += G) {
        const int b = item >> 6, s0 = ((item >> 3) & 7) * 256; const size_t rowb = (size_t)b * SEQ;
        __syncthreads();
#pragma unroll
        for (int j = 0; j < 6; ++j) { const int id = tid + 512 * j, row = id >> 3, c = id & 7;
            *(LAS v4u*)(Kimg + kimg_off(row, c)) = kq[j]; *(LAS v4u*)(Vimg + vimg_off(row, c)) = vq[j]; }
        __syncthreads();
        if (item + G < 1024) issue(item + G);
        for (int gi = wid; gi < 16; gi += 8) {
            const int m0 = s0 + 16 * gi;
            const int q = lane >> 2, qt = lane & 3; const size_t tq = rowb + m0 + q;
#if O23_FP8
            const v4u a2q = *(const GAS v4u*)((const GAS unsigned char*)o2 + tq * 512 + h * 64 + qt * 16), a3q = *(const GAS v4u*)((const GAS unsigned char*)o3 + tq * 512 + h * 64 + qt * 16);
#else
            const v4u a20 = *(const GAS v4u*)(o2 + tq * 512 + h * 64 + qt * 16), a21 = *(const GAS v4u*)(o2 + tq * 512 + h * 64 + qt * 16 + 8);
            const v4u a30 = *(const GAS v4u*)(o3 + tq * 512 + h * 64 + qt * 16), a31 = *(const GAS v4u*)(o3 + tq * 512 + h * 64 + qt * 16 + 8);
#endif
            const float l2 = lse2[tq * 8 + h], l3 = lse3[tq * 8 + h];
            bf16x8 qf[2];
#pragma unroll
            for (int s = 0; s < 2; ++s) qf[s] = *(const GAS bf16x8*)(qa + (rowb + m0 + i16) * 512 + h * 64 + 32 * s + 8 * g);
            unsigned tvalid = 0u;
#pragma unroll
            for (int kt = 0; kt < 9; ++kt) { const int t0 = m0 - 64 + 16 * kt; tvalid |= (t0 >= 0 && t0 < SEQ) ? (1u << kt) : 0u; }
            f32x4 O[4]; float mx, lsum;
            attn_core(Kimg, Vimg, 16 * gi, 384, tvalid, qf, biasr, L, O, mx, lsum);
            attn_stage_out(lds, wid, lane, O, lsum);
            if (g == 0) scr[i16] = mx + __log2f(lsum);
            asm volatile("s_waitcnt lgkmcnt(0)" ::: "memory");
            {
                const float l1 = scr[q], M = fmaxf(l1, fmaxf(l2, l3));
                float w1 = __builtin_amdgcn_exp2f(l1 - M), w2 = __builtin_amdgcn_exp2f(l2 - M), w3 = __builtin_amdgcn_exp2f(l3 - M); const float wi = 1.f / (w1 + w2 + w3); w1 *= wi; w2 *= wi; w3 *= wi;
                const LAS v4u* sp = (const LAS v4u*)(lds + AT_OST + wid * 2048 + q * 128 + qt * 32);
                const v4u x0 = sp[0], x1 = sp[1];
                v4u r0, r1;
#if O23_FP8
                { typedef float f2_ __attribute__((ext_vector_type(2))); const float w2s = w2 * 0.0625f, w3s = w3 * 0.0625f;
#define MRG8(d, x, yw, zw, hi) { const f2_ y_ = __builtin_amdgcn_cvt_pk_f32_fp8(yw, hi), z_ = __builtin_amdgcn_cvt_pk_f32_fp8(zw, hi); d = cvtpk(w1 * bflo(x) + w2s * y_[0] + w3s * z_[0], w1 * bfhi(x) + w2s * y_[1] + w3s * z_[1]); }
                MRG8(r0.x, x0.x, a2q.x, a3q.x, false) MRG8(r0.y, x0.y, a2q.x, a3q.x, true) MRG8(r0.z, x0.z, a2q.y, a3q.y, false) MRG8(r0.w, x0.w, a2q.y, a3q.y, true)
                MRG8(r1.x, x1.x, a2q.z, a3q.z, false) MRG8(r1.y, x1.y, a2q.z, a3q.z, true) MRG8(r1.z, x1.z, a2q.w, a3q.w, false) MRG8(r1.w, x1.w, a2q.w, a3q.w, true)
#undef MRG8
                }
#else
#define MRG(d, x, y, z) d = cvtpk(w1 * bflo(x) + w2 * bflo(y) + w3 * bflo(z), w1 * bfhi(x) + w2 * bfhi(y) + w3 * bfhi(z))
                MRG(r0.x, x0.x, a20.x, a30.x); MRG(r0.y, x0.y, a20.y, a30.y); MRG(r0.z, x0.z, a20.z, a30.z); MRG(r0.w, x0.w, a20.w, a30.w);
                MRG(r1.x, x1.x, a21.x, a31.x); MRG(r1.y, x1.y, a21.y, a31.y); MRG(r1.z, x1.z, a21.z, a31.z); MRG(r1.w, x1.w, a21.w, a31.w);
#undef MRG
#endif
#if MIX_FP8 & 2
                v4u o8;
                o8.x = pk_fp8x4(16.f * bflo(r0.x), 16.f * bfhi(r0.x), 16.f * bflo(r0.y), 16.f * bfhi(r0.y)); o8.y = pk_fp8x4(16.f * bflo(r0.z), 16.f * bfhi(r0.z), 16.f * bflo(r0.w), 16.f * bfhi(r0.w));
                o8.z = pk_fp8x4(16.f * bflo(r1.x), 16.f * bfhi(r1.x), 16.f * bflo(r1.y), 16.f * bfhi(r1.y)); o8.w = pk_fp8x4(16.f * bflo(r1.z), 16.f * bfhi(r1.z), 16.f * bflo(r1.w), 16.f * bfhi(r1.w));
                *(v4u*)((unsigned char*)oa + tq * 512 + h * 64 + qt * 16) = o8;
#else
                bf16* dst = oa + tq * 512 + h * 64 + qt * 16;
                *(v4u*)dst = r0; *(v4u*)(dst + 8) = r1;
#endif
            }
            asm volatile("s_waitcnt lgkmcnt(0)" ::: "memory");
        }
    }
    __syncthreads();
}

#define OPAQUE(x) asm volatile("" : "+v"(x))
template <int VAR = 0> __device__ __forceinline__ void p3_phase(const Args& a, LAS unsigned char* lds, int vcu, int G, int tid, int wid, int lane) {
    unsigned char* ws = a.ws;
    const int g = lane >> 4, i16 = lane & 15, q4 = i16 >> 2, p = lane & 3;
    const GAS bf16* qr = (const GAS bf16*)(ws + WS_QR); const GAS bf16* kr = (const GAS bf16*)(ws + WS_KR); const GAS bf16* vr = (const GAS bf16*)(ws + WS_VR);
    GAS bf16* gr = (GAS bf16*)(ws + WS_GR);
    LAS unsigned char* Kt = lds; LAS unsigned char* Sg = lds + 32768;
    if (vcu >= 1024) return;
    const unsigned kdst = offb(tid >> 4, tid & 15);
    unsigned rfo[4];
    { const unsigned X = ((i16 & 3) << 2) | (i16 >> 2);
#pragma unroll
      for (int s = 0; s < 4; ++s) rfo[s] = 256 * i16 + 16 * (((4 * s) ^ (X & 12)) | (g ^ (X & 3))); }
    v4u sreg[8], kreg[4]; bf16x8 qn[4];
    auto item_ptrs = [&](int item, size_t& tok0, const GAS bf16*& sf, int& h) { const int b = item >> 6; h = (item >> 4) & 3; const int n = item & 15; tok0 = (size_t)b * SEQ + n * 128;
        sf = (const GAS bf16*)((const GAS unsigned char*)a.out + ((((size_t)(b * 4 + h) * 16 + n) * 2 + 0) * 256) * 128 * (STATE_FP8 ? 1 : 2)); };
    auto issue_k = [&](int item) { size_t tok0; const GAS bf16* sf; int h; item_ptrs(item, tok0, sf, h);
        const GAS bf16* ks_ = kr + (tok0 + (tid >> 4)) * 512 + h * 128 + (tid & 15) * 8;
#pragma unroll
        for (int j = 0; j < 4; ++j) kreg[j] = *(const GAS v4u*)(ks_ + (size_t)j * 32 * 512); };
    auto issue_q = [&](int item) { size_t tok0; const GAS bf16* sf; int h; item_ptrs(item, tok0, sf, h);
#pragma unroll
        for (int s = 0; s < 4; ++s) qn[s] = *(const GAS bf16x8*)(qr + (tok0 + 16 * wid + i16) * 512 + h * 128 + 32 * s + 8 * g); };
#if STATE_FP8
    auto issue_state = [&](const GAS bf16* sf, int dirn) { const GAS unsigned char* sld = (const GAS unsigned char*)sf + (size_t)dirn * 256 * 128 + (size_t)(tid >> 4) * 128 + (tid & 15) * 8;
#pragma unroll
        for (int j = 0; j < 4; ++j) { const u32x2 lo = *(const GAS u32x2*)(sld + (size_t)(2 * j) * 32 * 128), hi = *(const GAS u32x2*)(sld + (size_t)(2 * j + 1) * 32 * 128); sreg[j] = (v4u){lo.x, lo.y, hi.x, hi.y}; } };
    auto write_state = [&]() {
#pragma unroll
        for (int j = 0; j < 8; ++j) { typedef float f2_ __attribute__((ext_vector_type(2)));
            const unsigned w0 = (j & 1) ? sreg[j >> 1].z : sreg[j >> 1].x, w1 = (j & 1) ? sreg[j >> 1].w : sreg[j >> 1].y;
            const f2_ a0 = __builtin_amdgcn_cvt_pk_f32_fp8(w0, false), a1 = __builtin_amdgcn_cvt_pk_f32_fp8(w0, true), a2 = __builtin_amdgcn_cvt_pk_f32_fp8(w1, false), a3 = __builtin_amdgcn_cvt_pk_f32_fp8(w1, true);
            v4u o; o.x = cvtpk(a0[0], a0[1]); o.y = cvtpk(a1[0], a1[1]); o.z = cvtpk(a2[0], a2[1]); o.w = cvtpk(a3[0], a3[1]);
            *(LAS v4u*)(Sg + (j >> 2) * 32768 + kdst + (j & 3) * 8192) = o; asm volatile("" ::: "memory"); } };
#else
    auto issue_state = [&](const GAS bf16* sf, int dirn) { const GAS bf16* sld = sf + (size_t)dirn * 256 * 128 + (size_t)(tid >> 4) * 128 + (tid & 15) * 8;
#pragma unroll
        for (int j = 0; j < 8; ++j) sreg[j] = *(const GAS v4u*)(sld + (size_t)j * 32 * 128); };
    auto write_state = [&]() {
#pragma unroll
        for (int j = 0; j < 8; ++j) *(LAS v4u*)(Sg + (j >> 2) * 32768 + kdst + (j & 3) * 8192) = sreg[j]; };
#endif
    { size_t tok0; const GAS bf16* sf; int h; item_ptrs(vcu, tok0, sf, h); issue_k(vcu); issue_q(vcu); issue_state(sf, 0); }
#pragma unroll
    for (int j = 0; j < 4; ++j) *(LAS v4u*)(Kt + kdst + j * 8192) = kreg[j];
    for (int item = vcu; item < 1024; item += G) {
        size_t tok0; const GAS bf16* sf; int h; item_ptrs(item, tok0, sf, h);
        const float lf2 = log2_gamma(a.in[2], h), lb2 = log2_gamma(a.in[3], h);
        bf16x8 qf[4];
#pragma unroll
        for (int s = 0; s < 4; ++s) qf[s] = qn[s];
        const bool has_next = item + G < 1024;
        __syncthreads();
        f32x4 D[8];
#pragma unroll
        for (int jt = 0; jt < 8; ++jt) {
            f32x4 d = (f32x4){0.f, 0.f, 0.f, 0.f};
#pragma unroll
            for (int s = 0; s < 4; ++s) { if (VAR != 1) { const bf16x8 kf = *(const LAS bf16x8*)(Kt + rfo[s] + jt * 4096); d = MFMA16(kf, qf[s], d); } else d[s] = __builtin_bit_cast(float, (int)qf[s][0]); }
            D[jt] = d;
        }
        int iq = 16 * wid + i16; OPAQUE(iq);
        bf16x8 pf[4];
#pragma unroll
        for (int ks = 0; ks < 4; ++ks) {
            float e[8];
#pragma unroll
            for (int t = 0; t < 2; ++t)
#pragma unroll
                for (int r = 0; r < 4; ++r) {
                    const int j = 16 * (2 * ks + t) + 4 * g + r; const float fdf = (float)(iq - j), ad = fabsf(fdf);
                    const float pos = fminf(fmaxf(fdf, 0.f), 1.f), isz = 1.f - fminf(ad, 1.f);
                    const float w = __builtin_amdgcn_exp2f((lb2 + (lf2 - lb2) * pos) * ad) + isz;
                    e[4 * t + r] = D[2 * ks + t][r] * w;
                }
            v4u pw; pw.x = cvtpk(e[0], e[1]); pw.y = cvtpk(e[2], e[3]); pw.z = cvtpk(e[4], e[5]); pw.w = cvtpk(e[6], e[7]);
            pf[ks] = __builtin_bit_cast(bf16x8, pw);
        }
        f32x4 acc[16];
#pragma unroll
        for (int vt = 0; vt < 16; ++vt) acc[vt] = (f32x4){0.f, 0.f, 0.f, 0.f};
#pragma unroll
        for (int dirn = 0; dirn < 2; ++dirn) {
            if (dirn == 1) __syncthreads();
            write_state();
            if (dirn == 0) { issue_state(sf, 1); if (has_next) issue_k(item + G); }
            else {
                if (has_next) {
#pragma unroll
                    for (int j = 0; j < 4; ++j) *(LAS v4u*)(Kt + kdst + j * 8192) = kreg[j]; }
                const GAS bf16* vs_ = vr + (tok0 + (tid >> 5)) * 1024 + h * 256 + (tid & 31) * 8;
#pragma unroll
                for (int j = 0; j < 8; ++j) sreg[j] = *(const GAS v4u*)(vs_ + (size_t)j * 16 * 1024);
            }
            __syncthreads();
#pragma unroll
            for (int vt = 0; vt < 16; ++vt) {
#pragma unroll
                for (int s = 0; s < 4; ++s) { if (VAR != 1) { const bf16x8 sfr = *(const LAS bf16x8*)(Sg + (vt >> 3) * 32768 + rfo[s] + (vt & 7) * 4096); acc[vt] = MFMA16(qf[s], sfr, acc[vt]); } }
            }
            float xs[4];
            { int ib = 16 * wid + 4 * g; OPAQUE(ib);
#pragma unroll
              for (int r = 0; r < 4; ++r) { const float lxf = lf2 * (float)(ib + r + 1), lxb = lb2 * (float)(128 - ib - r); xs[r] = __builtin_amdgcn_exp2f(dirn == 0 ? lxf - lxb : lxb - (STATE_FP8 ? 4.f : 0.f)); } }
#pragma unroll
            for (int vt = 0; vt < 16; ++vt)
#pragma unroll
                for (int r = 0; r < 4; ++r) acc[vt][r] *= xs[r];
        }
        __syncthreads();
        { int t2 = tid; OPAQUE(t2); const unsigned vd2 = (unsigned)((t2 & 31) >> 4) * 32768u + offb(t2 >> 5, t2 & 15);
#pragma unroll
          for (int j = 0; j < 8; ++j) *(LAS v4u*)(Sg + vd2 + j * 4096) = sreg[j]; }
        GAS bf16* gp = gr + (tok0 + 16 * wid + (lane >> 5)) * 1024 + h * 256 + (lane & 31) * 8;
#if MIX_FP8 & 4
        GAS unsigned char* ar8 = (GAS unsigned char*)(ws + WS_AR8) + (tok0 + 16 * wid + (lane >> 5)) * 1024 + h * 256 + (lane & 31) * 8;
#endif
        __syncthreads();
        unsigned vbs[8];
        { int l2 = lane; OPAQUE(l2); const unsigned g2 = l2 >> 4, q2 = (l2 & 15) >> 2, p2 = l2 & 3, X = (q2 << 2) | g2;
#pragma unroll
          for (int c = 0; c < 8; ++c) vbs[c] = 256 * (4 * g2 + q2) + 16 * (((2 * c) ^ (X & 14)) | ((p2 >> 1) ^ (X & 1))) + 8 * (p2 & 1); }
#pragma unroll
        for (int vt = 0; vt < 16; ++vt) {
#pragma unroll
            for (int ks = 0; ks < 4; ++ks) { if (VAR != 1) {
                const s16x4 lo = ldtr(Sg + vbs[vt & 7] + (vt >> 3) * 32768 + ks * 8192), hi = ldtr(Sg + vbs[vt & 7] + (vt >> 3) * 32768 + ks * 8192 + 4096);
                acc[vt] = MFMA16(pf[ks], cat8(lo, hi), acc[vt]); }
            }
            asm volatile("" ::: "memory");
        }
        float mu[4], rs[4];
#pragma unroll
        for (int r = 0; r < 4; ++r) {
            float s = 0.f;
#pragma unroll
            for (int vt = 0; vt < 16; ++vt) s += acc[vt][r];
            s += __shfl_xor(s, 1); s += __shfl_xor(s, 2); s += __shfl_xor(s, 4); s += __shfl_xor(s, 8);
            const float m = s * (1.f / 256.f); float qv = 0.f;
#pragma unroll
            for (int vt = 0; vt < 16; ++vt) { const float d = acc[vt][r] - m; qv += d * d; }
            qv += __shfl_xor(qv, 1); qv += __shfl_xor(qv, 2); qv += __shfl_xor(qv, 4); qv += __shfl_xor(qv, 8);
            mu[r] = m; rs[r] = 1.f / sqrtf(qv * (1.f / 256.f) + LN_EPSF);
        }
        v4u greg[8];
#pragma unroll
        for (int j = 0; j < 8; ++j) greg[j] = *(const GAS v4u*)(gp + (size_t)j * 2048);
        __syncthreads();
        if (has_next) { size_t tk; const GAS bf16* sfn; int hn; item_ptrs(item + G, tk, sfn, hn); issue_state(sfn, 0); issue_q(item + G); }
        LAS bf16* st = (LAS bf16*)(Sg + wid * 8192);
        { LAS bf16* sp_ = st + (4 * g) * 256 + i16;
#pragma unroll
          for (int vt = 0; vt < 16; ++vt)
#pragma unroll
              for (int r = 0; r < 4; ++r) sp_[r * 256 + 16 * vt] = (bf16)(cvtpk((acc[vt][r] - mu[r]) * rs[r], 0.f) & 0xffffu); }
        asm volatile("s_waitcnt lgkmcnt(0)" ::: "memory");
        {
            const float* gn = a.in[4] + h * 256; const int ch = lane & 31;
            const f32x4 g0 = *(const f32x4*)(gn + ch * 8), g1 = *(const f32x4*)(gn + ch * 8 + 4);
            const LAS bf16* yp = st + (lane >> 5) * 256 + ch * 8;
#pragma unroll
            for (int j = 0; j < 8; ++j) {
                const v4u y = *(const LAS v4u*)(yp + j * 512); const v4u sg = greg[j];
#if SILU_IN_P3
#define GSW(w, hi) pg8::fsilu((hi) ? bfhi(w) : bflo(w))
#else
#define GSW(w, hi) ((hi) ? bfhi(w) : bflo(w))
#endif
                v4u o; o.x = cvtpk(bflo(y.x) * g0[0] * GSW(sg.x, 0), bfhi(y.x) * g0[1] * GSW(sg.x, 1)); o.y = cvtpk(bflo(y.y) * g0[2] * GSW(sg.y, 0), bfhi(y.y) * g0[3] * GSW(sg.y, 1));
                o.z = cvtpk(bflo(y.z) * g1[0] * GSW(sg.z, 0), bfhi(y.z) * g1[1] * GSW(sg.z, 1)); o.w = cvtpk(bflo(y.w) * g1[2] * GSW(sg.w, 0), bfhi(y.w) * g1[3] * GSW(sg.w, 1));
#undef GSW
#if MIX_FP8 & 4
                u32x2 o8; o8.x = pk_fp8x4(bflo(o.x), bfhi(o.x), bflo(o.y), bfhi(o.y)); o8.y = pk_fp8x4(bflo(o.z), bfhi(o.z), bflo(o.w), bfhi(o.w));
                *(GAS u32x2*)(ar8 + (size_t)j * 2048) = o8;
#else
                *(GAS v4u*)(gp + (size_t)j * 2048) = o;
#endif
            }
        }
        __syncthreads();
    }
}

constexpr int P6_RS = 81920, P6_CNT = P6_RS + 8 * 512, P6_BASE = P6_CNT + 64, P6_ROW = P6_BASE + 64;
#define P6_BUTTERFLY(lg, out) do { float r10[10], r5[5], r3[3], r2[2]; const float z = 0.f; \
    _Pragma("unroll") for (int k = 0; k < 10; ++k) { const float keep = h32 ? lg[10 + k] : lg[k], send = h32 ? lg[k] : lg[10 + k]; r10[k] = keep + __shfl_xor(send, 32); } \
    _Pragma("unroll") for (int k = 0; k < 5; ++k) { const float keep = h16 ? r10[5 + k] : r10[k], send = h16 ? r10[k] : r10[5 + k]; r5[k] = keep + __shfl_xor(send, 16); } \
    { const float keep = h8 ? r5[3] : r5[0], send = h8 ? r5[0] : r5[3]; r3[0] = keep + __shfl_xor(send, 8); } \
    { const float keep = h8 ? r5[4] : r5[1], send = h8 ? r5[1] : r5[4]; r3[1] = keep + __shfl_xor(send, 8); } \
    { const float keep = h8 ? z : r5[2], send = h8 ? r5[2] : z; r3[2] = keep + __shfl_xor(send, 8); } \
    { const float keep = h4 ? r3[2] : r3[0], send = h4 ? r3[0] : r3[2]; r2[0] = keep + __shfl_xor(send, 4); } \
    { const float keep = h4 ? z : r3[1], send = h4 ? r3[1] : z; r2[1] = keep + __shfl_xor(send, 4); } \
    { const float keep = h2 ? r2[1] : r2[0], send = h2 ? r2[0] : r2[1]; out = keep + __shfl_xor(send, 2); } \
    out += __shfl_xor(out, 1); } while (0)
__device__ __forceinline__ void p6a_phase(const Args& a, LAS unsigned char* lds, int vcu, int G, int tid, int wave, int lane) {
    unsigned char* ws = a.ws;
    LAS float* RW = (LAS float*)lds;
    LAS float* RS = (LAS float*)(lds + P6_RS) + wave * 128;
    LAS unsigned* LC = (LAS unsigned*)(lds + P6_CNT); LAS unsigned* LB = (LAS unsigned*)(lds + P6_BASE); LAS unsigned* LR = (LAS unsigned*)(lds + P6_ROW);
    {
        const f32x4* wgp = (const f32x4*)a.in[11]; const f32x4* wep = (const f32x4*)a.in[13];
        f32x4 gq[2], eq[8];
#pragma unroll
        for (int u = 0; u < 2; ++u) gq[u] = wgp[tid + 512 * u];
#pragma unroll
        for (int u = 0; u < 8; ++u) eq[u] = wep[tid + 512 * u];
#pragma unroll
        for (int u = 0; u < 2; ++u) { const int c = tid + 512 * u;
#pragma unroll
            for (int k = 0; k < 4; ++k) RW[k * 1024 + c] = gq[u][k]; }
#pragma unroll
        for (int u = 0; u < 8; ++u) { const int q = tid + 512 * u, c = q >> 2, k4 = q & 3;
#pragma unroll
            for (int k = 0; k < 4; ++k) RW[(4 + 4 * k4 + k) * 1024 + c] = eq[u][k]; }
    }
    const u32x2* pre = (const u32x2*)a.out; u32x2* x1b = (u32x2*)(ws + WS_XB); [[maybe_unused]] unsigned* x1f8 = (unsigned*)(ws + WS_X1F8);
    gu32* ctl = (gu32*)ws;
    int* ltok = (int*)(ws + WS_LTOK); float* tw = (float*)(ws + WS_WSLOT); unsigned* tinfo = (unsigned*)(ws + WS_TINFO);
    const float* g1 = a.in[9]; const float* b1 = a.in[10];
    const bool h32 = (lane & 32) != 0, h16 = (lane & 16) != 0, h8 = (lane & 8) != 0, h4 = (lane & 4) != 0, h2 = (lane & 2) != 0;
#define P6_LOADROW(dst, t_) do { const u32x2* xr_ = pre + (size_t)(t_) * 256 + lane; _Pragma("unroll") for (int j = 0; j < 4; ++j) dst[j] = xr_[64 * j]; } while (0)
#define P6_LN(v, nx, s) do { s = 0.f; _Pragma("unroll") for (int j = 0; j < 4; ++j) { v[j] = (f32x4){bflo(nx[j].x), bfhi(nx[j].x), bflo(nx[j].y), bfhi(nx[j].y)}; s += (v[j].x + v[j].y) + (v[j].z + v[j].w); } } while (0)
#define P6_VAR(v, mean, q) do { q = 0.f; _Pragma("unroll") for (int j = 0; j < 4; ++j) { v[j] = v[j] - mean; q += (v[j].x * v[j].x + v[j].y * v[j].y) + (v[j].z * v[j].z + v[j].w * v[j].w); } } while (0)
#if M1_FP8
#define P6_STORE(v, t_, j) do { u32x2 o_; o_.x = cvtpk(v[j].x, v[j].y); o_.y = cvtpk(v[j].z, v[j].w); x1b[(size_t)(t_) * 256 + lane + 64 * j] = o_; x1f8[(size_t)(t_) * 256 + lane + 64 * j] = pk_fp8x4(v[j].x, v[j].y, v[j].z, v[j].w); } while (0)
#else
#define P6_STORE(v, t_, j) do { u32x2 o_; o_.x = cvtpk(v[j].x, v[j].y); o_.y = cvtpk(v[j].z, v[j].w); x1b[(size_t)(t_) * 256 + lane + 64 * j] = o_; } while (0)
#endif
#define P6_DOT(lg, v, j, k, w) lg[k] += (v[j][0] * w[0] + v[j][1] * w[1]) + (v[j][2] * w[2] + v[j][3] * w[3])
    for (int blk = vcu; blk < TT / 128; blk += G) {
        if (tid < 16) LC[tid] = 0u;
        __syncthreads();
        const int t0 = blk * 128;
        u32x2 nxA[4], nxB[4], nxC[4], nxD[4];
        P6_LOADROW(nxA, t0 + wave); P6_LOADROW(nxB, t0 + wave + 8); P6_LOADROW(nxC, t0 + wave + 16); P6_LOADROW(nxD, t0 + wave + 24);
        for (int rr = 0; rr < 4; ++rr) {
            const int rl0 = wave + 32 * rr, tA = t0 + rl0, tB = tA + 8, tC = tA + 16, tD = tA + 24;
            f32x4 vA[4], vB[4], vC[4], vD[4]; float sA, sB, sC, sD;
            P6_LN(vA, nxA, sA); P6_LN(vB, nxB, sB); P6_LN(vC, nxC, sC); P6_LN(vD, nxD, sD);
            if (rr < 3) { P6_LOADROW(nxA, tA + 32); P6_LOADROW(nxB, tB + 32); P6_LOADROW(nxC, tC + 32); P6_LOADROW(nxD, tD + 32); }
            const float mA = wave_sum(sA) * (1.f / DM), mB = wave_sum(sB) * (1.f / DM), mC = wave_sum(sC) * (1.f / DM), mD = wave_sum(sD) * (1.f / DM);
            float qA, qB, qC, qD;
            P6_VAR(vA, mA, qA); P6_VAR(vB, mB, qB); P6_VAR(vC, mC, qC); P6_VAR(vD, mD, qD);
            const float rA = 1.f / sqrtf(wave_sum(qA) * (1.f / DM) + LN_EPSF), rB = 1.f / sqrtf(wave_sum(qB) * (1.f / DM) + LN_EPSF);
            const float rC = 1.f / sqrtf(wave_sum(qC) * (1.f / DM) + LN_EPSF), rD = 1.f / sqrtf(wave_sum(qD) * (1.f / DM) + LN_EPSF);
            typedef float f32x2p __attribute__((ext_vector_type(2)));
            f32x2p lgAB[20], lgCD[20];
#pragma unroll
            for (int k = 0; k < 20; ++k) { lgAB[k] = (f32x2p){0.f, 0.f}; lgCD[k] = (f32x2p){0.f, 0.f}; }
#pragma unroll
            for (int j = 0; j < 4; ++j) {
                const f32x4 gg = *(const f32x4*)(g1 + 4 * lane + 256 * j), bb = *(const f32x4*)(b1 + 4 * lane + 256 * j);
                vA[j] = vA[j] * rA * gg + bb; vB[j] = vB[j] * rB * gg + bb; vC[j] = vC[j] * rC * gg + bb; vD[j] = vD[j] * rD * gg + bb;
                P6_STORE(vA, tA, j); P6_STORE(vB, tB, j); P6_STORE(vC, tC, j); P6_STORE(vD, tD, j);
                f32x2p pab[4], pcd[4];
#pragma unroll
                for (int e = 0; e < 4; ++e) { pab[e] = (f32x2p){vA[j][e], vB[j][e]}; pcd[e] = (f32x2p){vC[j][e], vD[j][e]}; }
#pragma unroll
                for (int k = 0; k < 20; ++k) { const f32x4 w = *(const LAS f32x4*)(RW + k * 1024 + 4 * lane + 256 * j);
#pragma unroll
                    for (int e = 0; e < 4; ++e) { const f32x2p ww = (f32x2p){w[e], w[e]};
                        lgAB[k] = __builtin_elementwise_fma(pab[e], ww, lgAB[k]); lgCD[k] = __builtin_elementwise_fma(pcd[e], ww, lgCD[k]); } }
            }
            float lgA[20], lgB[20], lgC[20], lgD[20];
#pragma unroll
            for (int k = 0; k < 20; ++k) { lgA[k] = lgAB[k].x; lgB[k] = lgAB[k].y; lgC[k] = lgCD[k].x; lgD[k] = lgCD[k].y; }
            float r1A, r1B, r1C, r1D;
            P6_BUTTERFLY(lgA, r1A); P6_BUTTERFLY(lgB, r1B); P6_BUTTERFLY(lgC, r1C); P6_BUTTERFLY(lgD, r1D);
            {
                const int i3 = h2 ? (h4 ? -1 : 1) : (h4 ? 2 : 0);
                const int i5 = i3 < 0 ? -1 : (h8 ? (i3 == 2 ? -1 : i3 + 3) : i3);
                const int kk = i5 < 0 ? -1 : (h32 ? 10 : 0) + (h16 ? 5 : 0) + i5;
                if (kk >= 0 && (lane & 1) == 0) { RS[kk] = r1A; RS[32 + kk] = r1B; RS[64 + kk] = r1C; RS[96 + kk] = r1D; }
            }
            asm volatile("s_waitcnt lgkmcnt(0)" ::: "memory");
            {
                const int sel = lane & 3; const int rl = rl0 + 8 * sel;
                float tl[20];
#pragma unroll
                for (int k4 = 0; k4 < 5; ++k4) { const f32x4 w = *(const LAS f32x4*)(RS + sel * 32 + 4 * k4); tl[4 * k4] = w[0]; tl[4 * k4 + 1] = w[1]; tl[4 * k4 + 2] = w[2]; tl[4 * k4 + 3] = w[3]; }
                float gl[4];
#pragma unroll
                for (int k = 0; k < 4; ++k) gl[k] = tl[k] + a.in[12][k];
                int gi = 0; float gm = gl[0];
#pragma unroll
                for (int k = 1; k < 4; ++k) if (gl[k] > gm) { gm = gl[k]; gi = k; }
                float gs = 0.f;
#pragma unroll
                for (int k = 0; k < 4; ++k) gs += __expf(gl[k] - gm);
                const float gwt = 1.f / gs;
                float el[4];
#pragma unroll
                for (int k = 0; k < 4; ++k) { const float se = gi == 0 ? tl[4 + k] : (gi == 1 ? tl[8 + k] : (gi == 2 ? tl[12 + k] : tl[16 + k])); el[k] = se + a.in[14][4 * gi + k]; }
                int i1 = 0; float v1 = el[0];
#pragma unroll
                for (int k = 1; k < 4; ++k) if (el[k] > v1) { v1 = el[k]; i1 = k; }
                int i2 = (i1 + 1) & 3; float v2 = -3.0e38f;
#pragma unroll
                for (int k = 0; k < 4; ++k) if (k != i1 && el[k] > v2) { v2 = el[k]; i2 = k; }
                const float ex = __expf(v2 - v1), w1 = gwt / (1.f + ex), w2 = gwt * ex / (1.f + ex);
                if (lane < 4) {
                    const int e1 = 4 * gi + i1, e2 = 4 * gi + i2;
                    const unsigned p1 = __hip_atomic_fetch_add(LC + e1, 1u, __ATOMIC_RELAXED, __HIP_MEMORY_SCOPE_WORKGROUP);
                    const unsigned p2 = __hip_atomic_fetch_add(LC + e2, 1u, __ATOMIC_RELAXED, __HIP_MEMORY_SCOPE_WORKGROUP);
                    LR[rl * 4 + 0] = ((unsigned)e1 << 16) | p1; LR[rl * 4 + 1] = ((unsigned)e2 << 16) | p2; LR[rl * 4 + 2] = __float_as_uint(w1); LR[rl * 4 + 3] = __float_as_uint(w2);
                }
            }
            asm volatile("s_waitcnt lgkmcnt(0)" ::: "memory");
        }
        __syncthreads();
        if (tid < 16) LB[tid] = __hip_atomic_fetch_add(ctl + CW_CNT + 64 * tid, LC[tid], __ATOMIC_RELAXED, __HIP_MEMORY_SCOPE_AGENT);
        __syncthreads();
        if (tid < 256) {
            const int rl = tid >> 1, j = tid & 1; const unsigned rec = LR[rl * 4 + j]; const unsigned e = rec >> 16, pos = LB[e] + (rec & 0xffffu);
            ltok[e * TT + pos] = t0 + rl; tw[2 * (t0 + rl) + j] = __uint_as_float(LR[rl * 4 + 2 + j]); tinfo[2 * (t0 + rl) + j] = (e << 16) | pos;
        }
        __syncthreads();
    }
#undef P6_LOADROW
#undef P6_LN
#undef P6_VAR
#undef P6_STORE
#undef P6_DOT
}
__device__ __forceinline__ void build_tile_tables(const Args& a, LAS unsigned char* lds, int tid) {
    LAS int* ts = (LAS int*)(lds + LDS_TS_OFF); LAS int* te = (LAS int*)(lds + LDS_TE_OFF); LAS int* cn = (LAS int*)(lds + LDS_CNT_OFF);
    gu32* ctl = (gu32*)a.ws;
    if (tid == 0) { int acc = 0;
        for (int e = 0; e < 16; ++e) { ts[e] = acc; const int c = (int)__hip_atomic_load(ctl + CW_CNT + 64 * e, __ATOMIC_RELAXED, __HIP_MEMORY_SCOPE_AGENT); const int nt = (c + 255) >> 8; cn[e] = c;
            for (int k = 0; k < nt; ++k) te[acc + k] = e; acc += nt; }
        ts[16] = acc; }
    __syncthreads();
}
__device__ __forceinline__ void p9_phase(const Args& a, LAS unsigned char* lds, int vcu, int G, int wave, int lane) {
    unsigned char* ws = a.ws;
    const LAS int* ts = (const LAS int*)(lds + LDS_TS_OFF);
    const unsigned* tinfo = (const unsigned*)(ws + WS_TINFO); const u32x2* Y = (const u32x2*)(ws + WS_Y);
    const float* g2 = a.in[18]; const float* b2 = a.in[19];
    const int gw = vcu * NWAVES + wave, NGW = G * NWAVES;
#if Y_FP8
    const unsigned* Y8 = (const unsigned*)(ws + WS_Y); unsigned ny0[4], ny1[4]; u32x2 nxw[4]; float nw0 = 0.f, nw1 = 0.f;
#else
    u32x2 ny0[4], ny1[4], nxw[4]; float nw0 = 0.f, nw1 = 0.f;
#endif
    const float* tw = (const float*)(ws + WS_WSLOT);
    auto issue = [&](int t) {
        const unsigned i0 = tinfo[2 * t], i1 = tinfo[2 * t + 1];
        nw0 = tw[2 * t]; nw1 = tw[2 * t + 1];
        const size_t s0 = (size_t)ts[i0 >> 16] * 256 + (i0 & 0xffffu), s1 = (size_t)ts[i1 >> 16] * 256 + (i1 & 0xffffu);
        const u32x2* xb1 = (const u32x2*)(ws + WS_XB) + (size_t)t * 256 + lane;
#pragma unroll
#if Y_FP8
        for (int j = 0; j < 4; ++j) { ny0[j] = Y8[s0 * 256 + lane + 64 * j]; ny1[j] = Y8[s1 * 256 + lane + 64 * j]; nxw[j] = xb1[64 * j]; }
#else
        for (int j = 0; j < 4; ++j) { ny0[j] = Y[s0 * 256 + lane + 64 * j]; ny1[j] = Y[s1 * 256 + lane + 64 * j]; nxw[j] = xb1[64 * j]; }
#endif
    };
    if (gw < TT) issue(gw);
    for (int t = gw; t < TT; t += NGW) {
        f32x4* xr = (f32x4*)(a.out + (size_t)t * DM) + lane;
#if Y_FP8
        f32x4 v[4]; float s = 0.f; const float w0 = nw0 * 0.0625f, w1 = nw1 * 0.0625f;
#pragma unroll
        for (int j = 0; j < 4; ++j) {
            const unsigned y0 = ny0[j], y1 = ny1[j]; const u32x2 xw = nxw[j];
            typedef float f32x2_ __attribute__((ext_vector_type(2)));
            const f32x2_ a0 = __builtin_amdgcn_cvt_pk_f32_fp8(y0, false), a1 = __builtin_amdgcn_cvt_pk_f32_fp8(y0, true), c0 = __builtin_amdgcn_cvt_pk_f32_fp8(y1, false), c1 = __builtin_amdgcn_cvt_pk_f32_fp8(y1, true);
            f32x4 x = (f32x4){bflo(xw.x), bfhi(xw.x), bflo(xw.y), bfhi(xw.y)} * DN_ALPHA;
            x.x += w0 * a0[0] + w1 * c0[0]; x.y += w0 * a0[1] + w1 * c0[1]; x.z += w0 * a1[0] + w1 * c1[0]; x.w += w0 * a1[1] + w1 * c1[1];
            v[j] = x; s += (x.x + x.y) + (x.z + x.w);
        }
#else
        f32x4 v[4]; float s = 0.f; const float w0 = nw0, w1 = nw1;
#pragma unroll
        for (int j = 0; j < 4; ++j) {
            const u32x2 y0 = ny0[j], y1 = ny1[j], xw = nxw[j];
            f32x4 x = (f32x4){bflo(xw.x), bfhi(xw.x), bflo(xw.y), bfhi(xw.y)} * DN_ALPHA;
            x.x += w0 * bflo(y0.x) + w1 * bflo(y1.x); x.y += w0 * bfhi(y0.x) + w1 * bfhi(y1.x); x.z += w0 * bflo(y0.y) + w1 * bflo(y1.y); x.w += w0 * bfhi(y0.y) + w1 * bfhi(y1.y);
            v[j] = x; s += (x.x + x.y) + (x.z + x.w);
        }
#endif
        if (t + NGW < TT) issue(t + NGW);
        const float mean = wave_sum(s) * (1.f / DM); float s2 = 0.f;
#pragma unroll
        for (int j = 0; j < 4; ++j) { v[j] = v[j] - mean; s2 += (v[j].x * v[j].x + v[j].y * v[j].y) + (v[j].z * v[j].z + v[j].w * v[j].w); }
        const float rstd = 1.f / sqrtf(wave_sum(s2) * (1.f / DM) + LN_EPSF);
#pragma unroll
        for (int j = 0; j < 4; ++j) { const f32x4 gg = *(const f32x4*)(g2 + 4 * lane + 256 * j), bb = *(const f32x4*)(b2 + 4 * lane + 256 * j); xr[64 * j] = v[j] * rstd * gg + bb; }
    }
}

__global__ void __launch_bounds__(NWAVES * 64, 2) mega_fwd(Args args) {
    extern __shared__ __attribute__((aligned(16))) unsigned char lds_raw[];
    LAS unsigned char* lds = (LAS unsigned char*)lds_raw;
    volatile LAS unsigned* MISC = (volatile LAS unsigned*)(lds + MISC_OFF);
    const int tid0 = threadIdx.x, wave = __builtin_amdgcn_readfirstlane(tid0 >> 6);
    const int G = gridDim.x, bx = blockIdx.x, vcu = (G % 8 == 0) ? (bx % 8) * (G / 8) + bx / 8 : bx;
    for (int u = tid0; u < (LDS_BYTES - LDSCTL_OFF) / 4; u += NWAVES * 64) ((LAS unsigned*)(lds + LDSCTL_OFF))[u] = 0u;
    __syncthreads();
    unsigned char* ws = args.ws;
    gu32* ctl = (gu32*)ws;
    const bool bars_on = (args.mask >> 31) != 0u;
    XcdBarrier bar; bar.bar = (unsigned*)(ctl + CW_BAR) + args.bar_region * XCD_BAR_WORDS; bar.x = 0; bar.st = nullptr;
    if (bars_on) bar = xcd_barrier_post((unsigned*)(ctl + CW_BAR) + args.bar_region * XCD_BAR_WORDS, MISC + 8);
    bar.wv = wave;
#define GRID_BAR() do { if (bars_on) xcd_barrier(bar); } while (0)
#ifndef PH_LAST
#define PH_LAST 99
#endif
#define FRESH() int tid = wave * 64 + pg8::lane_id(); asm volatile("" : "+v"(tid)); const int lane = tid & 63; (void)lane
#ifndef RMASK
#define RMASK 0
#endif
#define REP(k) _Pragma("unroll") for (int rep_ = 0; rep_ < 1 + ((RMASK >> (k)) & 1); ++rep_)
#ifndef STAMP_SCALE
#define STAMP_SCALE 1.0f
#endif
#ifdef STAMP_PH
#define ST_B(k) if ((k) == STAMP_PH) { st_a = rt(); }
#define ST_E(k) if ((k) == STAMP_PH) { st_b = rt(); }
#else
#define ST_B(k)
#define ST_E(k)
#endif
#ifdef ONLY
#define EN(k) (ONLY == (k))
#else
#define EN(k) ((args.mask >> (k)) & 1u)
#endif
    unsigned long long st_a = 0, st_b = 0; (void)st_a; (void)st_b;
    REP(0) if (EN(0)) { FRESH(); p0_prologue(args, lds, vcu, G, tid, wave, lane); }
    GRID_BAR();
#ifdef STAGGER_TICKS
    if (EN(1) && (bx & 8)) { const unsigned long long t0_ = rt(); while (rt() - t0_ < STAGGER_TICKS) __builtin_amdgcn_s_sleep(32); }
#endif
    REP(1) if (EN(1)) {
#if P1_FP8
        pg8::EpiHcat E{ws, (const float*)(ws + WS_ROT), 0};
        if (P1_FP8_FROM > 0) {
            pg8::Gemm g{(const pg8::bf16_t*)(ws + WS_XB), (const pg8::bf16_t*)(ws + WS_WIN), TT, 4608, 1024}; pg8::StaticOrder S; S.init(TT, 256 * P1_FP8_FROM, G, bx);
            pg8::gemm_phase<pg8::EpiHcat, pg8::StaticOrder, true, true>(lds, g, S, E, wave);
        }
        {
#if GATE_FP8
            pg8::Gemm g{(const pg8::bf16_t*)(ws + WS_X8_LO), (const pg8::bf16_t*)(ws + WS_WIN8), TT, 4608, 512, 64, (long)WS_X8_HI - (long)WS_X8_LO - (long)(16 * MiB)}; pg8::StaticOrder S;
#else
            pg8::Gemm g{(const pg8::bf16_t*)args.out, (const pg8::bf16_t*)(ws + WS_WIN8), TT, 4608, 512}; pg8::StaticOrder S;
#endif
            S.init(TT, 4608 - 256 * P1_FP8_FROM, G, bx, P1_FP8_FROM);
#if CONV_BG
            pg8::P1Order SB; SB.S = S; SB.cv = pg8::ExpertConv{args.in[15], args.in[16], args.in[17], ws + WS_WGU, ws + WS_WD, vcu * NWAVES + wave, G * NWAVES, vcu % 9};
            pg8::gemm_phase<pg8::EpiHcat, pg8::P1Order, true, true, false, true, 1, 0>(lds, g, SB, E, wave);
            { FRESH();
              for (int k = 0; SB.cv.gw + k * SB.cv.nw < 6144; ++k) { pg8::Unit tu; const bool in_gap = k < 3 && S.next(pg8::P1Order::unit_of(SB.cv.grp, k), tu) && pg8::P1Order::unit_of(SB.cv.grp, k) < 9;
                  if (!in_gap) pg8::expert_conv_item(SB.cv, k, lane); } }
#else
            pg8::gemm_phase<pg8::EpiHcat, pg8::StaticOrder, true, true, false, true, 1, 0>(lds, g, S, E, wave);
#endif
        }
#else
        pg8::Gemm g{(const pg8::bf16_t*)(ws + WS_XB), (const pg8::bf16_t*)(ws + WS_WIN), TT, 4608, 1024}; pg8::StaticOrder S; S.init(TT, 4608, G, bx);
        pg8::EpiHcat E{ws, (const float*)(ws + WS_ROT), 0};
        pg8::gemm_phase<pg8::EpiHcat, pg8::StaticOrder, true, true>(lds, g, S, E, wave);
#endif
    }
    GRID_BAR();
    if (PH_LAST >= 2) {
        REP(2) if (EN(2)) { FRESH(); for (int it = vcu; it < 256; it += G) chain_item(args, lds, it, tid, wave, lane); }
        if (EN(3)) { { FRESH(); attn_dil_phase<16>(args, lds, vcu, G, tid, wave, lane); }
                     { FRESH(); attn_dil_phase<4>(args, lds, vcu, G, tid, wave, lane); } }
    }
    GRID_BAR();
    ST_B(4) if (PH_LAST >= 3 && EN(4)) { FRESH(); p3_phase<0>(args, lds, vcu, G, tid, wave, lane); }
    if (EN(13)) { FRESH(); attn_p1_phase(args, lds, vcu, G, tid, wave, lane); }
    GRID_BAR(); ST_E(4)
#if !CONV_BG
    if (EN(14)) { FRESH(); p0_expert_weights(args, lds, vcu, G, wave, lane); }
#endif
    REP(5) if (PH_LAST >= 4 && EN(5)) {
        pg8::GateOrder S; S.S4.init(TT, 1024, G, bx);
        pg8::EpiHcat E{ws, (const float*)(ws + WS_ROT), 18};
#if GATE_FP8
        pg8::Gemm g{(const pg8::bf16_t*)(ws + WS_X8_LO), (const pg8::bf16_t*)(ws + WS_WIN8 + (size_t)4608 * 1024), TT, 2048, 512, 64, (long)WS_X8_HI - (long)WS_X8_LO - (long)(16 * MiB)};
        pg8::gemm_phase<pg8::EpiHcat, pg8::GateOrder, true, true, false, true, 1, 0>(lds, g, S, E, wave);
#else
        pg8::Gemm g{(const pg8::bf16_t*)(ws + WS_XB), (const pg8::bf16_t*)(ws + WS_WIN) + (size_t)4608 * 1024, TT, 2048, 1024};
        pg8::gemm_phase<pg8::EpiHcat, pg8::GateOrder, true, true>(lds, g, S, E, wave);
#endif
        asm volatile("s_waitcnt vmcnt(0)" ::: "memory"); __syncthreads();
    }
    REP(6) if (PH_LAST >= 5 && EN(6)) {
        pg8::StaticOrder S; S.init(TT, 1024, G, bx);
        { pg8::EpiGate<false> E{(const pg8::bf16_t*)(ws + WS_GATE_A), (pg8::bf16_t*)(ws + WS_MERGED), nullptr};
#if MIX_FP8 & 2
          pg8::Gemm g{(const pg8::bf16_t*)(ws + WS_OA), (const pg8::bf16_t*)(ws + WS_WA), TT, 1024, 256};
          pg8::gemm_phase<pg8::EpiGate<false>, pg8::StaticOrder, true, true, false, true, 1, 3>(lds, g, S, E, wave);
#else
          pg8::Gemm g{(const pg8::bf16_t*)(ws + WS_OA), (const pg8::bf16_t*)(ws + WS_WA), TT, 1024, 512};
          pg8::gemm_phase<pg8::EpiGate<false>, pg8::StaticOrder, true, true>(lds, g, S, E, wave);
#endif
        }
        asm volatile("s_waitcnt vmcnt(0)" ::: "memory"); __syncthreads();
        { typedef pg8::EpiGate<true, (MIX_FP8 & 1) != 0> EpiC;
          EpiC E{(const pg8::bf16_t*)(ws + WS_GATE_R), (pg8::bf16_t*)(ws + WS_MERGED), ws + WS_MERGED8};
#if MIX_FP8 & 4
          pg8::Gemm g{(const pg8::bf16_t*)(ws + WS_AR8), (const pg8::bf16_t*)(ws + WS_WR), TT, 1024, 512};
          pg8::gemm_phase<EpiC, pg8::StaticOrder, true, true, false, true, 1, 0>(lds, g, S, E, wave);
#else
          pg8::Gemm g{(const pg8::bf16_t*)(ws + WS_GR), (const pg8::bf16_t*)(ws + WS_WR), TT, 1024, 1024};
          pg8::gemm_phase<EpiC, pg8::StaticOrder, true, true>(lds, g, S, E, wave);
#endif
        }
    }
    GRID_BAR();
    REP(7) if (PH_LAST >= 6 && EN(7)) {
        pg8::StaticOrder S; S.init(TT, 1024, G, bx);
        pg8::EpiResBf16 E{X_F32_RES ? (const pg8::bf16_t*)args.in[0] : (const pg8::bf16_t*)(ws + WS_XB), (pg8::bf16_t*)args.out, DN_ALPHA};
#if MIX_FP8 & 1
        pg8::Gemm g{(const pg8::bf16_t*)(ws + WS_MERGED8), (const pg8::bf16_t*)(ws + WS_WO), TT, 1024, 512};
        pg8::gemm_phase<pg8::EpiResBf16, pg8::StaticOrder, true, true, false, true, 1, 3>(lds, g, S, E, wave);
#else
        pg8::Gemm g{(const pg8::bf16_t*)(ws + WS_MERGED), (const pg8::bf16_t*)(ws + WS_WO), TT, 1024, 1024};
        pg8::gemm_phase<pg8::EpiResBf16, pg8::StaticOrder, true, true>(lds, g, S, E, wave);
#endif
    }
    GRID_BAR();
    ST_B(8) if (PH_LAST >= 7 && EN(8)) { FRESH(); p6a_phase(args, lds, vcu, G, tid, wave, lane); }
    GRID_BAR(); ST_E(8)
    { FRESH(); build_tile_tables(args, lds, tid); }
    const int nrt = ((const LAS int*)(lds + LDS_TS_OFF))[16];
    REP(10) if (PH_LAST >= 9 && EN(10)) {
#if M1_FP8
        pg8::Gemm g{(const pg8::bf16_t*)(ws + WS_X1F8), (const pg8::bf16_t*)(ws + WS_WGU), MAXSLOT, 1024, 512};
        pg8::MoeOrder S{nrt * 4, G, vcu, (const LAS int*)(lds + LDS_TE_OFF), (const LAS int*)(lds + LDS_TS_OFF), (const LAS int*)(lds + LDS_CNT_OFF), (const int*)(ws + WS_LTOK), 1024u};
        pg8::EpiSwiGLU E{ws + WS_H};
        pg8::gemm_phase<pg8::EpiSwiGLU, pg8::MoeOrder, true, true, true, true, 1, 0>(lds, g, S, E, wave);
#else
        pg8::Gemm g{(const pg8::bf16_t*)(ws + WS_XB), (const pg8::bf16_t*)(ws + WS_WGU), MAXSLOT, 1024, 1024};
        pg8::MoeOrder S{nrt * 4, G, vcu, (const LAS int*)(lds + LDS_TE_OFF), (const LAS int*)(lds + LDS_TS_OFF), (const LAS int*)(lds + LDS_CNT_OFF), (const int*)(ws + WS_LTOK), 2048u};
        pg8::EpiSwiGLU E{ws + WS_H};
        pg8::gemm_phase<pg8::EpiSwiGLU, pg8::MoeOrder, true, true, true>(lds, g, S, E, wave);
#endif
    }
    GRID_BAR();
    REP(11) if (PH_LAST >= 10 && EN(11)) {
        pg8::Gemm g{(const pg8::bf16_t*)(ws + WS_H), (const pg8::bf16_t*)(ws + WS_WD), MAXSLOT, 1024, 256};
        pg8::MoeOrder S{nrt * 4, G, vcu, (const LAS int*)(lds + LDS_TE_OFF), (const LAS int*)(lds + LDS_TS_OFF), (const LAS int*)(lds + LDS_CNT_OFF), (const int*)(ws + WS_LTOK), 1024u};
        pg8::EpiRowScale E{(pg8::bf16_t*)(ws + WS_Y)};
        pg8::gemm_phase<pg8::EpiRowScale, pg8::MoeOrder, true, true, false, true, 1, 2>(lds, g, S, E, wave);
    }
    GRID_BAR();
    ST_B(12) if (PH_LAST >= 11 && EN(12)) { FRESH(); p9_phase(args, lds, vcu, G, wave, lane); }
#ifdef STAMP_PH
    GRID_BAR(); ST_E(12)
    if (STAMP_PH == 13) { st_a = rt(); GRID_BAR(); GRID_BAR(); GRID_BAR(); GRID_BAR(); st_b = rt(); }
    if (bx == 0 && tid0 == 0) { const float us = (float)(st_b - st_a) * 0.01f * STAMP_SCALE; int k = 0; float lim = 30.f; while (us >= lim && k < 12) { lim *= 1.5f; ++k; }
        __hip_atomic_store(ctl + CW_CHK, __float_as_uint(sqrtf(2.f * k + 2.f)), RLX_AGENT); }
    GRID_BAR();
    { const float c = __uint_as_float(__hip_atomic_load(ctl + CW_CHK, RLX_AGENT)); f32x4* o4 = (f32x4*)args.out;
      for (size_t i = (size_t)bx * 512 + tid0; i < (size_t)TT * DM / 4; i += (size_t)G * 512) o4[i] = (f32x4){c, c, c, c}; }
#endif
}

#ifdef PROBE_VAR
__global__ void __launch_bounds__(NWAVES * 64, 2) probe_kernel(Args args) {
    extern __shared__ __attribute__((aligned(16))) unsigned char lds_raw[];
    LAS unsigned char* lds = (LAS unsigned char*)lds_raw;
    const int tid0 = threadIdx.x, wave = __builtin_amdgcn_readfirstlane(tid0 >> 6);
    const int G = gridDim.x, bx = blockIdx.x, vcu = (G % 8 == 0) ? (bx % 8) * (G / 8) + bx / 8 : bx;
    FRESH();
    if (PROBE_VAR >= 20 && PROBE_VAR <= 22) {
        unsigned char* ws = args.ws;
        pg8::Gemm g{(const pg8::bf16_t*)(ws + WS_X8_LO), (const pg8::bf16_t*)(ws + WS_WIN8), TT, 4608, 512, 64, (long)WS_X8_HI - (long)WS_X8_LO - (long)(16 * MiB)}; pg8::StaticOrder S; S.init(TT, 4608, G, bx);
        typedef pg8::EpiHcatT<PROBE_VAR - 20> EpiP;
        EpiP E{ws, (const float*)(ws + WS_ROT), 0};
        pg8::gemm_phase<EpiP, pg8::StaticOrder, true, true, false, true, 1, 0>(lds, g, S, E, wave);
    }
    if (PROBE_VAR == 10) p3_phase<0>(args, lds, vcu, G, tid, wave, lane);
    if (PROBE_VAR == 11) p3_phase<1>(args, lds, vcu, G, tid, wave, lane);
    if (PROBE_VAR == 0) attn_dil_phase<16, 0>(args, lds, vcu, G, tid, wave, lane);
    if (PROBE_VAR == 1) attn_dil_phase<16, 1>(args, lds, vcu, G, tid, wave, lane);
    if (PROBE_VAR == 2) attn_dil_phase<4, 0>(args, lds, vcu, G, tid, wave, lane);
    if (PROBE_VAR == 3) attn_dil_phase<4, 1>(args, lds, vcu, G, tid, wave, lane);
}
#endif
extern "C" void kernel_launch(void* const* d_in, const int* in_sizes, int n_in, void* d_out, int out_size, void* d_ws, size_t ws_size, hipStream_t stream) {
    static int grid = 0;
    if (grid == 0) {
        if (n_in != 20 || in_sizes[0] != TT * DM || out_size != TT * DM || ws_size < WS_END) { fprintf(stderr, "kernel_launch: unexpected shapes: n_in %d in0 %d out %d ws %zu; nothing launched\n", n_in, n_in > 0 ? in_sizes[0] : -1, out_size, ws_size); grid = -1; return; }
        int dev = 0, cus = 0;
        if (hipGetDevice(&dev) != hipSuccess || hipDeviceGetAttribute(&cus, hipDeviceAttributeMultiprocessorCount, dev) != hipSuccess) { grid = -1; return; }
        if (hipFuncSetAttribute((const void*)mega_fwd, hipFuncAttributeMaxDynamicSharedMemorySize, LDS_BYTES) != hipSuccess) { fprintf(stderr, "kernel_launch: hipFuncSetAttribute failed\n"); grid = -1; return; }
        (void)hipGetLastError();
        grid = cus;
    }
    if (grid < 0) return;
    if (hipMemsetAsync((char*)d_ws, 0, CTL_ZERO_BYTES, stream) != hipSuccess) return;
    Args a{};
    for (int i = 0; i < 20; ++i) a.in[i] = (const float*)d_in[i];
    a.out = (float*)d_out; a.ws = (unsigned char*)d_ws; a.mask = 0x80007fffu; a.bar_region = 0;
#if defined(XTRA_FIRST)
    { Args x = a; x.mask = XTRA_FIRST; x.bar_region = 1; for (int r = 0; r < XTRA_REP; ++r) hipLaunchKernelGGL(mega_fwd, dim3(grid), dim3(NWAVES * 64), LDS_BYTES, stream, x);
      if (hipMemsetAsync((char*)d_ws, 0, CTL_ZERO_BYTES, stream) != hipSuccess) return; }
#endif
    hipLaunchKernelGGL(mega_fwd, dim3(grid), dim3(NWAVES * 64), LDS_BYTES, stream, a);
#if defined(PROBE_VAR)
    { hipFuncSetAttribute((const void*)probe_kernel, hipFuncAttributeMaxDynamicSharedMemorySize, LDS_BYTES);
      for (int r = 0; r < 4; ++r) hipLaunchKernelGGL(probe_kernel, dim3(grid), dim3(NWAVES * 64), LDS_BYTES, stream, a); }
#endif
#if defined(XTRA_AFTER)
    { Args x = a; x.mask = XTRA_AFTER; x.bar_region = 1; for (int r = 0; r < XTRA_REP; ++r) hipLaunchKernelGGL(mega_fwd, dim3(grid), dim3(NWAVES * 64), LDS_BYTES, stream, x); }
#endif
}
```

```cpp
#include <hip/hip_runtime.h>
#include <cstdio>
#include <cstdint>

constexpr int TT = 32768, DM = 1024, SEQ = 2048, NB = 16;
constexpr float DN_ALPHA = 1.189207115002721f;
constexpr float LN_EPSF = 1e-5f;
#ifndef M1_FP8
#define M1_FP8 1
#endif
#ifndef P1_FP8
#define P1_FP8 1
#endif
#ifndef ATT_FP8
#define ATT_FP8 1
#endif
#ifndef O23_FP8
#define O23_FP8 1
#endif
#ifndef STATE_FP8
#define STATE_FP8 1
#endif
#ifndef SILU_IN_P3
#define SILU_IN_P3 1
#endif
#ifndef CONV_BG
#define CONV_BG 1
#endif
#ifndef Y_FP8
#define Y_FP8 1
#endif
#ifndef GATE_FP8
#define GATE_FP8 1
#endif
#ifndef MIX_FP8
#define MIX_FP8 7
#endif
#ifndef P1_FP8_FROM
#define P1_FP8_FROM 0
#endif
#define X_F32_RES (P1_FP8 && P1_FP8_FROM == 0 && GATE_FP8)
constexpr size_t MiB = 1u << 20;
constexpr size_t CTL_ZERO_BYTES = 1 * MiB;
constexpr size_t WS_ROT = 1 * MiB;
constexpr size_t WS_BIAS = 2 * MiB;
constexpr size_t WS_LTOK = 3 * MiB;
constexpr size_t WS_TINFO = 7 * MiB;
constexpr size_t WS_WSLOT = 7 * MiB + 512 * 1024;
constexpr size_t WS_WIN = 8 * MiB;
constexpr size_t WS_WIN8 = 12 * MiB;
constexpr size_t WS_WR = 21 * MiB;
constexpr size_t WS_WA = 23 * MiB;
constexpr size_t WS_WO = 24 * MiB;
constexpr size_t WS_WGU = 26 * MiB;
constexpr size_t WS_WD = 42 * MiB;
constexpr size_t WS_XB = 80 * MiB;
constexpr size_t WS_QR = 144 * MiB;
constexpr size_t WS_KR = 176 * MiB;
constexpr size_t WS_VR = 208 * MiB;
constexpr size_t WS_GR = 272 * MiB;
constexpr size_t WS_QA = 336 * MiB, WS_KA = 368 * MiB, WS_VA = 400 * MiB, WS_OA = 432 * MiB;
#if MIX_FP8 & 4
constexpr size_t WS_AR8 = 144 * MiB;
constexpr size_t WS_GATE_R = 176 * MiB, WS_GATE_A = 240 * MiB;
#else
constexpr size_t WS_GATE_R = 144 * MiB, WS_GATE_A = 208 * MiB;
#endif
constexpr size_t WS_X8_LO = 448 * MiB, WS_X8_HI = 58 * MiB;
static_assert(M1_FP8, "the workspace map is laid out for fp8 expert weights");
static_assert(!CONV_BG || X_F32_RES, "CONV_BG puts o2 into the bf16 x region");
static_assert(!GATE_FP8 || (P1_FP8 && (MIX_FP8 & 2) && M1_FP8), "GATE_FP8 needs the fp8 mixer-input GEMM, the fp8 o_a (room behind it) and the fp8 expert weights (room behind them)");
constexpr size_t WS_MERGED8 = 464 * MiB;
constexpr size_t WS_MERGED = 336 * MiB;
constexpr size_t WS_Y = 144 * MiB;
constexpr size_t WS_H = 336 * MiB;
constexpr size_t WS_X1F8 = 464 * MiB;
#if CONV_BG
constexpr size_t WS_O2 = 80 * MiB;
#else
constexpr size_t WS_O2 = 26 * MiB;
#endif
constexpr size_t WS_O3 = 464 * MiB;
constexpr size_t WS_LSE2 = 496 * MiB, WS_LSE3 = 497 * MiB;
constexpr size_t WS_END = 512 * MiB;
constexpr int MAXSLOT = 69632;
constexpr int CW_BAR = 4096;
constexpr int CW_CNT = 16384;
constexpr int CW_CHK = 24576;
namespace pg8 {
#define PG8_LAS __attribute__((address_space(3)))
typedef unsigned short bf16_t;
typedef short bf16x8 __attribute__((ext_vector_type(8)));
typedef float f32x4 __attribute__((ext_vector_type(4)));
typedef unsigned u32x4 __attribute__((ext_vector_type(4)));
typedef unsigned u32x2_ __attribute__((ext_vector_type(2)));
constexpr int BM = 256, BK = 64, HALF = 128, HTB = HALF * BK * 2  , STAGE_BYTES = 8 * HTB, NXCD = 8, WGM = 8;

__device__ __forceinline__ int lane_id() { int x; asm volatile("v_mbcnt_lo_u32_b32 %0, -1, 0\n\tv_mbcnt_hi_u32_b32 %0, -1, %0" : "=v"(x)); return x; }
__host__ __device__ __forceinline__ int lds_byte(int r, int c) { const int st = (r >> 4) * 2 + (c >> 5), rr = r & 15, cc = c & 31, ob = rr * 64 + cc * 2; return st * 1024 + (ob ^ (((ob >> 9) & 1) << 5)); }
__host__ __device__ __forceinline__ void stage_rc(int b, int& R, int& C) { const int st = b / 1024, sb = b % 1024, swz = sb ^ (((sb >> 9) & 1) << 5); R = (st >> 1) * 16 + swz / 64; C = (st & 1) * 32 + (swz % 64) / 2; }
__host__ __device__ __forceinline__ int perm32(int rho) { const int n = rho >> 4, i = rho & 15; return 8 * (i >> 2) + 4 * n + (i & 3); }

struct Unit { int pm, pn; };
struct Gemm { const bf16_t* A; const bf16_t* Bt; int M, N, K; int spm = 1 << 30; long sdelta = 0; };

struct StaticOrder {
    int nM, nN, nwg, G, c, pn0;
    __host__ __device__ void init(int M, int N, int G_, int c_, int pn0_ = 0) { nM = M / BM; nN = N / BM; nwg = nM * nN; G = G_; c = c_; pn0 = pn0_; }
    __host__ __device__ bool next(int i, Unit& u) const {
        const long L = (long)i * G + c; if (L >= nwg) return false;
        int wgid = (int)L; { const int q = nwg / NXCD, r = nwg % NXCD, xcd = wgid % NXCD, off = wgid / NXCD; wgid = (xcd < r ? xcd * (q + 1) : r * (q + 1) + (xcd - r) * q) + off; }
        const int nig = WGM * nN, gid = wgid / nig, fm = gid * WGM, gsz = (nM - fm) < WGM ? (nM - fm) : WGM;
        u.pm = fm + ((wgid % nig) % gsz); u.pn = pn0 + (wgid % nig) / gsz; return true;
    }
    __device__ __forceinline__ void a_ready(const Unit&) const {}
    __device__ __forceinline__ void done(const Unit&, int, int) const {}
};

__device__ __forceinline__ unsigned cvt_pk_bf16(float lo, float hi) { unsigned r; asm volatile("v_cvt_pk_bf16_f32 %0, %1, %2" : "=v"(r) : "v"(lo), "v"(hi)); return r; }
typedef float cvt_f32x2_t __attribute__((ext_vector_type(2))); typedef __bf16 cvt_bf16x2_t __attribute__((ext_vector_type(2)));
__device__ __forceinline__ unsigned cvt_pk_bf16_acc(float lo, float hi) { const cvt_f32x2_t v = {lo, hi}; const cvt_bf16x2_t b = __builtin_convertvector(v, cvt_bf16x2_t); return __builtin_bit_cast(unsigned, b); }
__device__ __forceinline__ float bflo(unsigned w) { return __uint_as_float(w << 16); }
__device__ __forceinline__ float bfhi(unsigned w) { return __uint_as_float(w & 0xffff0000u); }
__device__ __forceinline__ float fsigmoid(float x) { return __builtin_amdgcn_rcpf(1.f + __expf(-x)); }
__device__ __forceinline__ float fsilu(float x) { return x * __builtin_amdgcn_rcpf(1.f + __expf(-x)); }

__device__ __forceinline__ unsigned fp8x4_sat(float a, float b, float c, float d) {
    a = __builtin_amdgcn_fmed3f(a, -448.f, 448.f); b = __builtin_amdgcn_fmed3f(b, -448.f, 448.f); c = __builtin_amdgcn_fmed3f(c, -448.f, 448.f); d = __builtin_amdgcn_fmed3f(d, -448.f, 448.f);
    unsigned w = 0u; w = __builtin_amdgcn_cvt_pk_fp8_f32(a, b, w, false); w = __builtin_amdgcn_cvt_pk_fp8_f32(c, d, w, true); return w;
}
template <int VAR = 0> struct EpiHcatT {
    static constexpr bool PERM = true, AFTER_DRAIN = false; static constexpr int NSTORE = 16;
    unsigned char* ws; const float* rot; int tile_off;
    __device__ __forceinline__ void operator()(const f32x4 (&acc)[2][2][4][2], const Unit& u, int wr, int wc, int fr, int fq) const {
        if (VAR == 1) {
            float s = 0.f;
#pragma unroll
            for (int ai = 0; ai < 2; ++ai)
#pragma unroll
                for (int bj = 0; bj < 2; ++bj)
#pragma unroll
                    for (int m = 0; m < 4; ++m)
#pragma unroll
                        for (int n = 0; n < 2; ++n) s += (acc[ai][bj][m][n][0] + acc[ai][bj][m][n][1]) + (acc[ai][bj][m][n][2] + acc[ai][bj][m][n][3]);
            ((float*)(ws + WS_O3))[(size_t)(u.pm * 64 + u.pn) * 512 + wr * 256 + wc * 64 + fq * 16 + fr] = s; return;
        }
        const int gt = u.pn + tile_off;
        size_t base_off; int pitch, ct, mode; float sc = 1.f;
        if (gt < 2)       { base_off = WS_QR; pitch = 512;  ct = gt;      mode = 1; }
        else if (gt < 4)  { base_off = WS_KR; pitch = 512;  ct = gt - 2;  mode = 1; sc = 0.08838834764831845f; }
        else if (gt < 8)  { base_off = WS_VR; pitch = 1024; ct = gt - 4;  mode = 0; }
        else if (gt < 12) { base_off = WS_GR; pitch = 1024; ct = gt - 8;  mode = SILU_IN_P3 ? 0 : 2; }
        else if (gt < 14) { base_off = WS_QA; pitch = 512;  ct = gt - 12; mode = ATT_FP8 ? 4 : 0; sc = 0.18033688011112042f; }
        else if (gt < 16) { base_off = WS_KA; pitch = 512;  ct = gt - 14; mode = ATT_FP8 ? 4 : 0; }
        else if (gt < 18) { base_off = WS_VA; pitch = 512;  ct = gt - 16; mode = ATT_FP8 ? 4 : 0; }
        else if (gt < 22) { base_off = WS_GATE_R; pitch = 1024; ct = gt - 18; mode = 3; }
        else              { base_off = WS_GATE_A; pitch = 1024; ct = gt - 22; mode = 3; }
        bf16_t* O = (bf16_t*)(ws + base_off);
        const int row0 = u.pm * BM + wr * 64 + fr, col0 = ct * BM + wc * 32 + 8 * fq;
#pragma unroll
        for (int ai = 0; ai < 2; ++ai)
#pragma unroll
            for (int m = 0; m < 4; ++m) {
                const int row = row0 + ai * HALF + m * 16;
                bf16_t* rowp = O + (size_t)(VAR == 2 ? (row & 255) : row) * pitch + col0;
                f32x4 cs = (f32x4){1.f, 1.f, 1.f, 1.f}, sn = (f32x4){0.f, 0.f, 0.f, 0.f};
                if (mode == 1) { const f32x4* rt = (const f32x4*)(rot + ((size_t)(row & (SEQ - 1)) * 16 + (4 * wc + fq)) * 8); cs = rt[0]; sn = rt[1]; }
#pragma unroll
                for (int bj = 0; bj < 2; ++bj) {
                    f32x4 v0 = acc[ai][bj][m][0], v1 = acc[ai][bj][m][1];
                    if (mode == 1) { const f32x4 a = v0 * cs - v1 * sn, b = v0 * sn + v1 * cs; v0 = a * sc; v1 = b * sc; }
                    else if (mode == 2) {
#pragma unroll
                        for (int e = 0; e < 4; ++e) { v0[e] = fsilu(v0[e]); v1[e] = fsilu(v1[e]); } }
                    else if (mode == 3) {
#pragma unroll
                        for (int e = 0; e < 4; ++e) { v0[e] = fsigmoid(v0[e]); v1[e] = fsigmoid(v1[e]); } }
                    else { v0 = v0 * sc; v1 = v1 * sc; }
                    if (mode == 4) { u32x2_ w8; w8.x = fp8x4_sat(v0[0], v0[1], v0[2], v0[3]); w8.y = fp8x4_sat(v1[0], v1[1], v1[2], v1[3]);
                        *(u32x2_*)((unsigned char*)O + (size_t)(VAR == 2 ? (row & 255) : row) * pitch + col0 + bj * HALF) = w8; }
                    else { u32x4 w; w.x = cvt_pk_bf16(v0[0], v0[1]); w.y = cvt_pk_bf16(v0[2], v0[3]); w.z = cvt_pk_bf16(v1[0], v1[1]); w.w = cvt_pk_bf16(v1[2], v1[3]);
                        *(u32x4*)(rowp + bj * HALF) = w; }
                }
            }
    }
};

typedef EpiHcatT<0> EpiHcat;

template <bool ADD, bool OUT8 = false> struct EpiGate {
    static constexpr bool PERM = true, AFTER_DRAIN = false; static constexpr int NSTORE = 16;
    const bf16_t* gate; bf16_t* O; unsigned char* O8;
    __device__ __forceinline__ void operator()(const f32x4 (&acc)[2][2][4][2], const Unit& u, int wr, int wc, int fr, int fq) const {
        const int row0 = u.pm * BM + wr * 64 + fr, col0 = u.pn * BM + wc * 32 + 8 * fq;
#pragma unroll
        for (int ai = 0; ai < 2; ++ai)
#pragma unroll
            for (int m = 0; m < 4; ++m)
#pragma unroll
                for (int bj = 0; bj < 2; ++bj) {
                    const size_t p = (size_t)(row0 + ai * HALF + m * 16) * 1024 + col0 + bj * HALF;
                    const u32x4 g = *(const u32x4*)(gate + p);
                    f32x4 v0 = acc[ai][bj][m][0], v1 = acc[ai][bj][m][1];
                    v0[0] *= bflo(g.x); v0[1] *= bfhi(g.x); v0[2] *= bflo(g.y); v0[3] *= bfhi(g.y);
                    v1[0] *= bflo(g.z); v1[1] *= bfhi(g.z); v1[2] *= bflo(g.w); v1[3] *= bfhi(g.w);
                    if (ADD) { const u32x4 o = *(const u32x4*)(O + p);
                        v0[0] += bflo(o.x); v0[1] += bfhi(o.x); v0[2] += bflo(o.y); v0[3] += bfhi(o.y);
                        v1[0] += bflo(o.z); v1[1] += bfhi(o.z); v1[2] += bflo(o.w); v1[3] += bfhi(o.w); }
                    if (OUT8) { u32x2_ w8;
                        w8.x = fp8x4_sat(v0[0] * 16.f, v0[1] * 16.f, v0[2] * 16.f, v0[3] * 16.f); w8.y = fp8x4_sat(v1[0] * 16.f, v1[1] * 16.f, v1[2] * 16.f, v1[3] * 16.f);
                        *(u32x2_*)(O8 + p) = w8; }
                    else { u32x4 w; w.x = cvt_pk_bf16(v0[0], v0[1]); w.y = cvt_pk_bf16(v0[2], v0[3]); w.z = cvt_pk_bf16(v1[0], v1[1]); w.w = cvt_pk_bf16(v1[2], v1[3]);
                        *(u32x4*)(O + p) = w; }
                }
    }
};

struct EpiResBf16 {
    static constexpr bool PERM = true, AFTER_DRAIN = false; static constexpr int NSTORE = 16;
    const bf16_t* x; bf16_t* out; float alpha;
    __device__ __forceinline__ void operator()(const f32x4 (&acc)[2][2][4][2], const Unit& u, int wr, int wc, int fr, int fq) const {
        const int row0 = u.pm * BM + wr * 64 + fr, col0 = u.pn * BM + wc * 32 + 8 * fq;
#pragma unroll
        for (int ai = 0; ai < 2; ++ai)
#pragma unroll
            for (int m = 0; m < 4; ++m)
#pragma unroll
                for (int bj = 0; bj < 2; ++bj) {
                    const size_t p = (size_t)(row0 + ai * HALF + m * 16) * 1024 + col0 + bj * HALF;
#if X_F32_RES
                    const f32x4 x0 = *(const f32x4*)((const float*)x + p), x1 = *(const f32x4*)((const float*)x + p + 4);
#else
                    const u32x4 xw = *(const u32x4*)(x + p);
                    const f32x4 x0 = (f32x4){bflo(xw.x), bfhi(xw.x), bflo(xw.y), bfhi(xw.y)}, x1 = (f32x4){bflo(xw.z), bfhi(xw.z), bflo(xw.w), bfhi(xw.w)};
#endif
                    const f32x4 v0 = x0 * alpha + acc[ai][bj][m][0], v1 = x1 * alpha + acc[ai][bj][m][1];
                    u32x4 w; w.x = cvt_pk_bf16(v0[0], v0[1]); w.y = cvt_pk_bf16(v0[2], v0[3]); w.z = cvt_pk_bf16(v1[0], v1[1]); w.w = cvt_pk_bf16(v1[2], v1[3]);
                    *(u32x4*)(out + p) = w;
                }
    }
};

struct EpiSwiGLU {
    static constexpr bool PERM = true, AFTER_DRAIN = false; static constexpr int NSTORE = 16;
    unsigned char* H;
    __device__ __forceinline__ void operator()(const f32x4 (&acc)[2][2][4][2], const Unit& u, int wr, int wc, int fr, int fq) const {
        const int row0 = u.pm * BM + wr * 64 + fr, col0 = (u.pn & 3) * 128 + wc * 16 + 4 * fq;
#pragma unroll
        for (int ai = 0; ai < 2; ++ai)
#pragma unroll
            for (int m = 0; m < 4; ++m)
#pragma unroll
                for (int bj = 0; bj < 2; ++bj) {
                    const f32x4 g = acc[ai][bj][m][0], up = acc[ai][bj][m][1];
                    float h0 = fsilu(g[0]) * up[0] * 8.f, h1 = fsilu(g[1]) * up[1] * 8.f, h2 = fsilu(g[2]) * up[2] * 8.f, h3 = fsilu(g[3]) * up[3] * 8.f;
                    h0 = fminf(fmaxf(h0, -448.f), 448.f); h1 = fminf(fmaxf(h1, -448.f), 448.f); h2 = fminf(fmaxf(h2, -448.f), 448.f); h3 = fminf(fmaxf(h3, -448.f), 448.f);
                    unsigned w = 0u; w = __builtin_amdgcn_cvt_pk_fp8_f32(h0, h1, w, false); w = __builtin_amdgcn_cvt_pk_fp8_f32(h2, h3, w, true);
                    *(unsigned*)(H + (size_t)(row0 + ai * HALF + m * 16) * 512 + col0 + bj * 64) = w;
                }
    }
};

struct EpiRowScale {
    static constexpr bool PERM = true, AFTER_DRAIN = false; static constexpr int NSTORE = 16;
    bf16_t* Y;
    __device__ __forceinline__ void operator()(const f32x4 (&acc)[2][2][4][2], const Unit& u, int wr, int wc, int fr, int fq) const {
        const int row0 = u.pm * BM + wr * 64 + fr, col0 = (u.pn & 3) * BM + wc * 32 + 8 * fq;
#pragma unroll
        for (int ai = 0; ai < 2; ++ai)
#pragma unroll
            for (int m = 0; m < 4; ++m) {
                const int row = row0 + ai * HALF + m * 16;
#pragma unroll
                for (int bj = 0; bj < 2; ++bj) {
                    const f32x4 v0 = acc[ai][bj][m][0], v1 = acc[ai][bj][m][1];
#if Y_FP8
                    u32x2_ w8; w8.x = fp8x4_sat(v0[0] * 16.f, v0[1] * 16.f, v0[2] * 16.f, v0[3] * 16.f); w8.y = fp8x4_sat(v1[0] * 16.f, v1[1] * 16.f, v1[2] * 16.f, v1[3] * 16.f);
                    *(u32x2_*)((unsigned char*)Y + (size_t)row * 1024 + col0 + bj * HALF) = w8;
#else
                    u32x4 w; w.x = cvt_pk_bf16_acc(v0[0], v0[1]); w.y = cvt_pk_bf16_acc(v0[2], v0[3]); w.z = cvt_pk_bf16_acc(v1[0], v1[1]); w.w = cvt_pk_bf16_acc(v1[2], v1[3]);
                    *(u32x4*)(Y + (size_t)row * 1024 + col0 + bj * HALF) = w;
#endif
                }
            }
    }
};

struct MoeOrder {
    int nunits, G, c; const PG8_LAS int* te; const PG8_LAS int* ts; const PG8_LAS int* cnt; const int* ltok; unsigned rowbytes;
    __device__ __forceinline__ bool next(int i, Unit& u) const {
        const int L = i * G + c, rt = (L >> 5) * 8 + (L & 7); if (rt >= (nunits >> 2)) return false;
        u.pm = rt; u.pn = te[rt] * 4 + ((L >> 3) & 3); return true;
    }
    __device__ __forceinline__ unsigned a_row_off(const Unit& u, int row) const {
        const int ex = te[u.pm], pos = (u.pm - ts[ex]) * 256 + row;
        const int tok = pos < cnt[ex] ? ltok[ex * 32768 + pos] : 0;
        return (unsigned)tok * rowbytes;
    }
    __device__ __forceinline__ void a_ready(const Unit&) const {}
    __device__ __forceinline__ void done(const Unit&, int, int) const {}
};

struct ExpertConv { const float* wg; const float* wu; const float* wd; unsigned char* WGU; unsigned char* WD; int gw, nw, grp; };
__device__ __forceinline__ void expert_conv_item(const ExpertConv& c, int j, int lane) {
    const int it = j * c.nw + c.gw, e = it / 384, r = it % 384;
    const float* src; unsigned char* dst; int K, N, mode, nb, kb;
    if (r < 128)      { src = c.wg + (size_t)e * 1024 * 512; dst = c.WGU + (size_t)e * 1024 * 1024; K = 1024; N = 512;  mode = 2; nb = r >> 4; kb = r & 15; }
    else if (r < 256) { src = c.wu + (size_t)e * 1024 * 512; dst = c.WGU + (size_t)e * 1024 * 1024; K = 1024; N = 512;  mode = 3; nb = (r - 128) >> 4; kb = (r - 128) & 15; }
    else              { src = c.wd + (size_t)e * 512 * 1024; dst = c.WD + (size_t)e * 1024 * 512;   K = 512;  N = 1024; mode = 0; nb = (r - 256) >> 3; kb = (r - 256) & 7; }
    const int n4 = nb * 64 + 4 * (lane & 15), k0 = kb * 64 + 16 * (lane >> 4);
    const float* s = src + (size_t)k0 * N + n4;
    f32x4 v[16];
#pragma unroll
    for (int i = 0; i < 16; ++i) v[i] = *(const f32x4*)(s + (size_t)i * N);
#pragma unroll
    for (int jn = 0; jn < 4; ++jn) {
        const int n = n4 + jn, row = mode == 0 ? n : ((n >> 2) << 3) + (n & 3) + (mode == 3 ? 4 : 0);
        u32x4 w;
        w.x = fp8x4_sat(v[0][jn] * 64.f, v[1][jn] * 64.f, v[2][jn] * 64.f, v[3][jn] * 64.f);     w.y = fp8x4_sat(v[4][jn] * 64.f, v[5][jn] * 64.f, v[6][jn] * 64.f, v[7][jn] * 64.f);
        w.z = fp8x4_sat(v[8][jn] * 64.f, v[9][jn] * 64.f, v[10][jn] * 64.f, v[11][jn] * 64.f); w.w = fp8x4_sat(v[12][jn] * 64.f, v[13][jn] * 64.f, v[14][jn] * 64.f, v[15][jn] * 64.f);
        *(u32x4*)(dst + (size_t)row * K + k0) = w;
    }
}
struct GateOrder {
    StaticOrder S4;
    __device__ __forceinline__ bool next(int i, Unit& u) const { Unit t; if (!S4.next(i >> 1, t)) return false; u.pm = t.pm; u.pn = t.pn + 4 * (i & 1); return true; }
    __device__ __forceinline__ void a_ready(const Unit&) const {}
    __device__ __forceinline__ void done(const Unit&, int, int) const {}
};
struct P1Order {
    StaticOrder S; ExpertConv cv;
    __device__ __forceinline__ bool next(int i, Unit& u) const { return S.next(i, u); }
    __device__ __forceinline__ void a_ready(const Unit&) const {}
    __device__ __forceinline__ static int unit_of(int grp, int k) { return (grp + 3 * k) % 9; }
    __device__ __forceinline__ void done(const Unit&, int ui, int lane) const {
        const int d = (ui + 9 - cv.grp) % 9;
        if (ui < 9 && d % 3 == 0 && cv.gw + (d / 3) * cv.nw < 6144) expert_conv_item(cv, d / 3, lane);
    }
};

template <class Epi, class Sched, bool ALIGN_EPI = false, bool SP2 = false, bool GATHER = false, bool FP8 = false, int SEL_W = 0, int SEL_X = 0>
__device__ __forceinline__ void gemm_phase(PG8_LAS unsigned char* lds, const Gemm g, const Sched& S, const Epi& E, const int wid) {
    int tid = wid * 64 + lane_id(); asm volatile("" : "+v"(tid));
    const int lane = tid & 63, wr = wid >> 2, wc = wid & 3, fr = lane & 15, fq = lane >> 4;
    static_assert(SP2, "only the two-super-phase loop is kept");
    typedef int i32x4_ __attribute__((ext_vector_type(4)));
    const int K = g.K, nt = K / BK;
    unsigned voffB[2]; int rA[2], cA2[2];
#pragma unroll
    for (int i = 0; i < 2; ++i) { int R, C; stage_rc(tid * 16 + i * 8192, R, C); const int Rb = Epi::PERM ? ((R & ~31) + perm32(R & 31)) : R;
        rA[i] = R; cA2[i] = C * 2; voffB[i] = (unsigned)(Rb * K + C) * 2u; }
    unsigned vAc[2][2], vAn[2][2];
    const size_t kstep = (size_t)(BK * 2);
    const size_t hstep = (size_t)HALF * K * 2;
    const size_t tstep = 2 * hstep;
    const unsigned ldsw = (unsigned)wid * 1024u;
    const int aoff0 = lds_byte(wr * 64 + fr, fq * 8), aoff1 = aoff0 + 1024;
    const int boff0 = lds_byte(wc * 32 + fr, fq * 8), boff1 = boff0 + 1024;
#define PG8_SA(b, h) (((b) * 2 + (h)) * HTB)
#define PG8_SB(b, h) ((4 + (b) * 2 + (h)) * HTB)
#define PG8_STAGE(bufoff, gbase, voff) do { _Pragma("unroll") for (int _i = 0; _i < 2; ++_i) \
        __builtin_amdgcn_global_load_lds((const unsigned*)((const char*)(gbase) + (voff)[_i]), (PG8_LAS unsigned*)(lds + (bufoff) + ldsw + _i * 8192), 16, 0, 0); } while (0)
#define PG8_LDA(dst, b, h) do { _Pragma("unroll") for (int m = 0; m < 4; ++m) { dst[m][0] = *(const PG8_LAS bf16x8*)(lds + PG8_SA(b, h) + aoff0 + m * 2048); dst[m][1] = *(const PG8_LAS bf16x8*)(lds + PG8_SA(b, h) + aoff1 + m * 2048); } } while (0)
#define PG8_LDB(dst, b, h) do { _Pragma("unroll") for (int n = 0; n < 2; ++n) { dst[n][0] = *(const PG8_LAS bf16x8*)(lds + PG8_SB(b, h) + boff0 + n * 2048); dst[n][1] = *(const PG8_LAS bf16x8*)(lds + PG8_SB(b, h) + boff1 + n * 2048); } } while (0)
#define PG8_CAT8(x) __builtin_shufflevector(__builtin_bit_cast(i32x4_, (x)[0]), __builtin_bit_cast(i32x4_, (x)[1]), 0, 1, 2, 3, 4, 5, 6, 7)
#define PG8_MMA(ai, bj, At, Bt) do { __builtin_amdgcn_s_setprio(1); \
        if constexpr (FP8) { _Pragma("unroll") for (int m = 0; m < 4; ++m) _Pragma("unroll") for (int n = 0; n < 2; ++n) \
            acc[ai][bj][m][n] = __builtin_amdgcn_mfma_scale_f32_16x16x128_f8f6f4(PG8_CAT8(Bt[n]), PG8_CAT8(At[m]), acc[ai][bj][m][n], 0, 0, SEL_W, scl, SEL_X, scl); \
            asm volatile("" : "+v"(acc[ai][bj][0][0]), "+v"(acc[ai][bj][0][1]), "+v"(acc[ai][bj][1][0]), "+v"(acc[ai][bj][1][1]), "+v"(acc[ai][bj][2][0]), "+v"(acc[ai][bj][2][1]), "+v"(acc[ai][bj][3][0]), "+v"(acc[ai][bj][3][1])); } \
        else { _Pragma("unroll") for (int m = 0; m < 4; ++m) _Pragma("unroll") for (int n = 0; n < 2; ++n) _Pragma("unroll") for (int k = 0; k < 2; ++k) \
            acc[ai][bj][m][n] = __builtin_amdgcn_mfma_f32_16x16x32_bf16(Bt[n][k], At[m][k], acc[ai][bj][m][n], 0, 0, 0); } \
        __builtin_amdgcn_s_setprio(0); } while (0)
#define PG8_WAIT_V(n) asm volatile("s_waitcnt vmcnt(" #n ")" ::: "memory")
#define PG8_WAIT_VN(n) asm volatile("s_waitcnt vmcnt(%0)" :: "i"(n) : "memory")
#define PG8_WAIT_L(n) asm volatile("s_waitcnt lgkmcnt(" #n ")" ::: "memory")
#define PG8_BAR __builtin_amdgcn_s_barrier()
#define PG8_SCHED __builtin_amdgcn_sched_barrier(0)
    [[maybe_unused]] int scl = 0x7b7c797f; asm volatile("" : "+v"(scl));
    Unit cur, nxt; int ui = 0;
    if (!S.next(0, cur)) return;
    f32x4 acc[2][2][4][2];
#pragma unroll
    for (int a = 0; a < 2; ++a)
#pragma unroll
        for (int b = 0; b < 2; ++b)
#pragma unroll
            for (int m = 0; m < 4; ++m)
#pragma unroll
                for (int n = 0; n < 2; ++n) acc[a][b][m][n] = (f32x4){0.f, 0.f, 0.f, 0.f};
    bf16x8 At[4][2], B0[2][2], B1[2][2];
    const char* cA = GATHER ? (const char*)g.A : (const char*)g.A + (size_t)cur.pm * tstep + (cur.pm >= g.spm ? g.sdelta : 0L); const char* cB = (const char*)g.Bt + (size_t)cur.pn * tstep;
#pragma unroll
    for (int h = 0; h < 2; ++h)
#pragma unroll
        for (int i = 0; i < 2; ++i) { if constexpr (GATHER) vAc[h][i] = S.a_row_off(cur, h * HALF + rA[i]) + (unsigned)cA2[i]; else vAc[h][i] = (unsigned)((h * HALF + rA[i]) * K) * 2u + (unsigned)cA2[i]; vAn[h][i] = vAc[h][i]; }
    S.a_ready(cur);
    if constexpr (SP2) {
        PG8_STAGE(PG8_SB(0, 0), cB, voffB); PG8_STAGE(PG8_SB(0, 1), cB + hstep, voffB); PG8_STAGE(PG8_SA(0, 0), cA, vAc[0]); PG8_STAGE(PG8_SA(0, 1), cA, vAc[1]);
        if (wr == 1) PG8_BAR;
        PG8_WAIT_V(2); PG8_BAR;
        PG8_STAGE(PG8_SB(1, 0), cB + kstep, voffB); PG8_STAGE(PG8_SA(1, 0), cA + kstep, vAc[0]); PG8_STAGE(PG8_SB(1, 1), cB + hstep + kstep, voffB);
        PG8_WAIT_V(6); PG8_BAR;
    }
    for (;;) {
        const bool has_next = S.next(ui + 1, nxt);
        const char* nA = GATHER ? cA : (has_next ? (const char*)g.A + (size_t)nxt.pm * tstep + (nxt.pm >= g.spm ? g.sdelta : 0L) : cA); const char* nB = has_next ? (const char*)g.Bt + (size_t)nxt.pn * tstep : cB;
        if constexpr (GATHER) { if (has_next) {
#pragma unroll
            for (int h = 0; h < 2; ++h)
#pragma unroll
                for (int i = 0; i < 2; ++i) vAn[h][i] = S.a_row_off(nxt, h * HALF + rA[i]) + (unsigned)cA2[i]; } }
#pragma unroll 1
        for (int t = 0; t < nt; t += 2) {
            const bool last = (t == nt - 2);
            asm volatile("" : "+v"(voffB[0]), "+v"(voffB[1]), "+v"(vAc[0][0]), "+v"(vAc[0][1]), "+v"(vAc[1][0]), "+v"(vAc[1][1]));
            const char* a1 = cA + (size_t)(t + 1) * kstep;
            const char* a2 = last ? nA : cA + (size_t)(t + 2) * kstep; const char* b2 = last ? nB : cB + (size_t)(t + 2) * kstep;
            const char* a3 = a2 + kstep; const char* b3 = b2 + kstep;
            unsigned vA2[2][2];
#pragma unroll
            for (int h = 0; h < 2; ++h)
#pragma unroll
                for (int i = 0; i < 2; ++i) vA2[h][i] = vAc[h][i];
            if constexpr (GATHER) { if (last) {
                asm volatile("" : "+v"(vAn[0][0]), "+v"(vAn[0][1]), "+v"(vAn[1][0]), "+v"(vAn[1][1]));
#pragma unroll
                for (int h = 0; h < 2; ++h)
#pragma unroll
                    for (int i = 0; i < 2; ++i) vA2[h][i] = vAn[h][i]; } }
            if (last && has_next) S.a_ready(nxt);
            if constexpr (SP2) {
            const int lenient = __builtin_amdgcn_readfirstlane((ui > 0 && t == 0) ? 1 : 0);
#define PG8_WAIT_V8L() asm volatile("s_cmp_eq_u32 %0, 0\n\ts_cbranch_scc0 .Lpg8skip%=\n\ts_waitcnt vmcnt(8)\n.Lpg8skip%=:\n\ts_waitcnt vmcnt(%1)" :: "s"(lenient), "i"(8 + Epi::NSTORE) : "memory", "scc")
            PG8_LDB(B0, 0, 0); PG8_LDB(B1, 0, 1); PG8_SCHED; PG8_LDA(At, 0, 0); PG8_STAGE(PG8_SA(1, 1), a1, vAc[1]);
            PG8_WAIT_V8L(); PG8_WAIT_L(0); PG8_BAR; PG8_MMA(0, 0, At, B0); PG8_MMA(0, 1, At, B1); PG8_BAR; PG8_SCHED;
            PG8_LDA(At, 0, 1); PG8_STAGE(PG8_SB(0, 0), b2, voffB); PG8_STAGE(PG8_SB(0, 1), b2 + hstep, voffB); PG8_STAGE(PG8_SA(0, 0), a2, vA2[0]);
            PG8_WAIT_V8L(); PG8_WAIT_L(0); PG8_BAR; PG8_MMA(1, 0, At, B0); PG8_MMA(1, 1, At, B1); PG8_BAR; PG8_SCHED;
            PG8_LDB(B0, 1, 0); PG8_LDB(B1, 1, 1); PG8_SCHED; PG8_LDA(At, 1, 0); PG8_STAGE(PG8_SA(0, 1), a2, vA2[1]);
            PG8_WAIT_V(8); PG8_WAIT_L(0); PG8_BAR; PG8_MMA(0, 0, At, B0); PG8_MMA(0, 1, At, B1); PG8_BAR; PG8_SCHED;
            PG8_LDA(At, 1, 1); PG8_STAGE(PG8_SB(1, 0), b3, voffB); PG8_STAGE(PG8_SB(1, 1), b3 + hstep, voffB); PG8_STAGE(PG8_SA(1, 0), a3, vA2[0]);
            PG8_WAIT_V(8); PG8_WAIT_L(0); PG8_BAR; PG8_MMA(1, 0, At, B0); PG8_MMA(1, 1, At, B1); PG8_BAR; PG8_SCHED;
#undef PG8_WAIT_V8L
            }
        }
        if constexpr (ALIGN_EPI) { if (wr == 0) PG8_BAR; }
        if constexpr (!Epi::AFTER_DRAIN) { const int le = lane_id(); E(acc, cur, wr, wc, le & 15, le >> 4); S.done(cur, ui, le); }
        if (!has_next) break;
#pragma unroll
        for (int a = 0; a < 2; ++a)
#pragma unroll
            for (int b = 0; b < 2; ++b)
#pragma unroll
                for (int m = 0; m < 4; ++m)
#pragma unroll
                    for (int n = 0; n < 2; ++n) acc[a][b][m][n] = (f32x4){0.f, 0.f, 0.f, 0.f};
        cur = nxt; cA = nA; cB = nB; ++ui;
        if constexpr (GATHER) {
#pragma unroll
            for (int h = 0; h < 2; ++h)
#pragma unroll
                for (int i = 0; i < 2; ++i) vAc[h][i] = vAn[h][i]; }
        if constexpr (ALIGN_EPI) { if (wr == 1) PG8_BAR; }
    }
    PG8_WAIT_V(0);
    if constexpr (!ALIGN_EPI) { if (wr == 0) PG8_BAR; }
    PG8_BAR;
    if constexpr (Epi::AFTER_DRAIN) { E.fused(acc, cur, wr, wc, fr, fq, lds, wid, lane); S.done(cur, ui, lane); }
#undef PG8_SA
#undef PG8_SB
#undef PG8_STAGE
#undef PG8_LDA
#undef PG8_LDB
#undef PG8_MMA
#undef PG8_CAT8
#undef PG8_WAIT_V
#undef PG8_WAIT_VN
#undef PG8_WAIT_L
#undef PG8_BAR
#undef PG8_SCHED
}
}
#define GAS __attribute__((address_space(1)))
#define LAS __attribute__((address_space(3)))
typedef unsigned short bf16;
typedef unsigned v4u __attribute__((ext_vector_type(4)));
typedef float f32x4 __attribute__((ext_vector_type(4)));
typedef short bf16x8 __attribute__((ext_vector_type(8)));
typedef GAS unsigned gu32;
typedef GAS unsigned long long gu64;
#define RLX_AGENT __ATOMIC_RELAXED, __HIP_MEMORY_SCOPE_AGENT
#define LDS_WAIT() asm volatile("s_waitcnt lgkmcnt(0)" ::: "memory")
#define VM_WAIT() asm volatile("s_waitcnt vmcnt(0)" ::: "memory")
__device__ __forceinline__ unsigned long long rt() { return __builtin_amdgcn_s_memrealtime(); }
__device__ __forceinline__ unsigned f2bf(float f) { unsigned u = __builtin_bit_cast(unsigned, f); return (u + 0x7fffu + ((u >> 16) & 1u)) >> 16; }
__device__ __forceinline__ unsigned pk2(float lo, float hi) { return f2bf(lo) | (f2bf(hi) << 16); }

#define XB_TMO      128
#define XB_XCNT(j)  (256  + 64 * (j))
#define XB_XSUB(j)  (1280 + 64 * (j))
#define XB_XGEN(j)  (2304 + 64 * (j))
#define XB_TOP      3328
#define XB_TOPGEN   3392
#define XCD_BAR_WORDS 3456
#define XB_SPIN_CAP (1u << 18)

__device__ __forceinline__ unsigned xb_ld(unsigned* p)              { return __hip_atomic_load(p, __ATOMIC_RELAXED, __HIP_MEMORY_SCOPE_AGENT); }
__device__ __forceinline__ unsigned xb_add(unsigned* p, unsigned v) { return __hip_atomic_fetch_add(p, v, __ATOMIC_RELAXED, __HIP_MEMORY_SCOPE_AGENT); }
__device__ __forceinline__ unsigned xb_xcc_id() { return (unsigned)__builtin_amdgcn_s_getreg((3 << 11) | 20) & 0xFu; }
#define XB_SPIN(cond, bar) do { unsigned _sp = 0; while (cond) { __builtin_amdgcn_s_sleep(1); \
    if ((++_sp & 255u) == 0u) { if (xb_ld(&(bar)[XB_TMO])) break; if (_sp > XB_SPIN_CAP) { atomicAdd(&(bar)[XB_TMO], 1u); break; } } } } while (0)

struct XcdBarrier {
    unsigned* bar; unsigned x; int wv;
    volatile LAS unsigned* st;
};

__device__ __forceinline__ XcdBarrier xcd_barrier_post(unsigned* bar, volatile LAS unsigned* st) {
    XcdBarrier b; b.bar = bar; b.x = xb_xcc_id(); b.st = st; b.wv = 0;
    if (threadIdx.x == 0) (void)xb_add(&bar[XB_XCNT(b.x)], 1u);
    return b;
}
__device__ __forceinline__ void xcd_barrier_complete(unsigned* bar, unsigned x, unsigned& nloc, unsigned& nx) {
    const unsigned G = gridDim.x * gridDim.y * gridDim.z;
    unsigned sum, cnt, mine, sp = 0u;
    for (;;) {
        sum = 0u; cnt = 0u; mine = 0u;
#pragma unroll
        for (unsigned j = 0; j < 16; ++j) { const unsigned c = xb_ld(&bar[XB_XCNT(j)]); sum += c; cnt += (c > 0u) ? 1u : 0u; mine = (j == x) ? c : mine; }
        if (sum == G) break;
        __builtin_amdgcn_s_sleep(1);
        if ((++sp & 255u) == 0u) { if (xb_ld(&bar[XB_TMO])) break; if (sp > XB_SPIN_CAP) { atomicAdd(&bar[XB_TMO], 1u); break; } }
    }
    nloc = mine > 0u ? mine : 1u; nx = cnt > 0u ? cnt : 1u;
}

__device__ __forceinline__ void xcd_barrier(const XcdBarrier& b) {
    asm volatile("s_waitcnt vmcnt(0)" ::: "memory");
    __syncthreads();
    if (b.wv == 0 && (int)__builtin_amdgcn_mbcnt_hi(~0u, __builtin_amdgcn_mbcnt_lo(~0u, 0u)) == 0) {
        unsigned* bar = b.bar;
        __builtin_amdgcn_s_waitcnt(0);
        unsigned nloc = b.st[0], nx = b.st[1];
        if (nloc == 0u) { xcd_barrier_complete(bar, b.x, nloc, nx); b.st[0] = nloc; b.st[1] = nx; }
        const unsigned old = xb_add(&bar[XB_XSUB(b.x)], 1u);
        const unsigned gen = old / nloc;
        if (old + 1u == (gen + 1u) * nloc) {
            __builtin_amdgcn_fence(__ATOMIC_RELEASE, "agent");
            asm volatile("s_waitcnt vmcnt(0)" ::: "memory");
            const unsigned og = xb_add(&bar[XB_TOP], 1u);
            const unsigned tg = og / nx;
            if (og + 1u == (tg + 1u) * nx) xb_add(&bar[XB_TOPGEN], 1u);
            else XB_SPIN(xb_ld(&bar[XB_TOPGEN]) == tg, bar);
            __builtin_amdgcn_fence(__ATOMIC_ACQUIRE, "agent");
            xb_add(&bar[XB_XGEN(b.x)], 1u);
            asm volatile("s_waitcnt vmcnt(0)" ::: "memory");
        } else {
            XB_SPIN(xb_ld(&bar[XB_XGEN(b.x)]) == gen, bar);
            __builtin_amdgcn_fence(__ATOMIC_ACQUIRE, "agent");
            asm volatile("s_waitcnt vmcnt(0)" ::: "memory");
        }
    }
    __syncthreads();
}


constexpr int NWAVES = 8;
constexpr int RING_BYTES = 131072;
constexpr int LDSCTL_OFF = RING_BYTES, MISC_OFF = LDSCTL_OFF + 320;
constexpr int LDS_TS_OFF = LDSCTL_OFF + 1024;
constexpr int LDS_TE_OFF = LDSCTL_OFF + 2048;
constexpr int LDS_CNT_OFF = LDSCTL_OFF + 1024 + 128;
constexpr int LDS_BYTES = 163840;

typedef short s16x4 __attribute__((ext_vector_type(4)));
typedef unsigned u32x2 __attribute__((ext_vector_type(2)));

struct Args { const float* in[20]; float* out; unsigned char* ws; unsigned mask; int bar_region; };

__device__ __forceinline__ float bflo(unsigned w) { return __uint_as_float(w << 16); }
__device__ __forceinline__ float bfhi(unsigned w) { return __uint_as_float(w & 0xffff0000u); }
__device__ __forceinline__ unsigned cvtpk(float lo, float hi) { return pg8::cvt_pk_bf16(lo, hi); }
__device__ __forceinline__ float wave_sum(float v) {
#pragma unroll
    for (int o = 1; o < 64; o <<= 1) v += __shfl_xor(v, o);
    return v;
}
__device__ __forceinline__ unsigned offb(unsigned row, unsigned ch) { return 256u * row + 16u * (ch ^ (((row & 3u) << 2) | ((row >> 2) & 3u))); }
__device__ __forceinline__ s16x4 ldtr(const LAS unsigned char* p) { return __builtin_amdgcn_ds_read_tr16_b64_v4i16((LAS s16x4*)p); }
__device__ __forceinline__ bf16x8 cat8(s16x4 a, s16x4 b) { return (bf16x8){a[0], a[1], a[2], a[3], b[0], b[1], b[2], b[3]}; }
#define MFMA16(a, b, c) __builtin_amdgcn_mfma_f32_16x16x32_bf16((a), (b), (c), 0, 0, 0)

template <int MODE> __device__ __forceinline__ int dest_row(int n) {
    if (MODE == 1) { if (n >= 1024) return n; const int hb = n & ~127, d = n & 127, jr = d & 63, half = d >> 6; return hb + 8 * (jr >> 2) + 4 * half + (jr & 3); }
    if (MODE == 2) return ((n >> 2) << 3) + (n & 3);
    if (MODE == 3) return ((n >> 2) << 3) + 4 + (n & 3);
    return n;
}
template <int MODE> __device__ __forceinline__ void p0_transpose_item(const float* W, int K, int N, bf16* WT, LAS float* scr, int item, int lane) {
    const int nblk = N / 32, kb = item / nblk, nb = item % nblk, k0 = 64 * kb, n0 = 32 * nb;
    {
        const GAS f32x4* src = (const GAS f32x4*)(W + (size_t)(k0 + (lane >> 3)) * N + n0) + (lane & 7);
        f32x4 t[8];
#pragma unroll
        for (int j = 0; j < 8; ++j) t[j] = src[(size_t)j * 2 * N];
#pragma unroll
        for (int j = 0; j < 8; ++j) { LAS float* d = scr + ((lane >> 3) + 8 * j) * 33 + 4 * (lane & 7); d[0] = t[j].x; d[1] = t[j].y; d[2] = t[j].z; d[3] = t[j].w; }
    }
    LDS_WAIT(); asm volatile("" ::: "memory");
    const int c = lane & 7;
#pragma unroll
    for (int j = 0; j < 4; ++j) { const int n = (lane >> 3) + 8 * j; const LAS float* s = scr + (8 * c) * 33 + n;
        v4u o; o.x = pk2(s[0 * 33], s[1 * 33]); o.y = pk2(s[2 * 33], s[3 * 33]); o.z = pk2(s[4 * 33], s[5 * 33]); o.w = pk2(s[6 * 33], s[7 * 33]);
        *(GAS v4u*)(WT + (size_t)dest_row<MODE>(n0 + n) * K + k0 + 8 * c) = o; }
    LDS_WAIT(); asm volatile("" ::: "memory");
}
__device__ __forceinline__ unsigned pk_fp8x4(float a, float b, float c, float d) {
    a = fminf(fmaxf(a, -448.f), 448.f); b = fminf(fmaxf(b, -448.f), 448.f); c = fminf(fmaxf(c, -448.f), 448.f); d = fminf(fmaxf(d, -448.f), 448.f);
    unsigned w = 0u; w = __builtin_amdgcn_cvt_pk_fp8_f32(a, b, w, false); w = __builtin_amdgcn_cvt_pk_fp8_f32(c, d, w, true); return w;
}
__device__ __forceinline__ v4u fp8x8_to_bf16x8(u32x2 w) { typedef float f2_ __attribute__((ext_vector_type(2)));
    const f2_ a0 = __builtin_amdgcn_cvt_pk_f32_fp8(w.x, false), a1 = __builtin_amdgcn_cvt_pk_f32_fp8(w.x, true), a2 = __builtin_amdgcn_cvt_pk_f32_fp8(w.y, false), a3 = __builtin_amdgcn_cvt_pk_f32_fp8(w.y, true);
    v4u o; o.x = cvtpk(a0[0], a0[1]); o.y = cvtpk(a1[0], a1[1]); o.z = cvtpk(a2[0], a2[1]); o.w = cvtpk(a3[0], a3[1]); return o; }
template <int MODE> __device__ __forceinline__ void p0_transpose_item_fp8(const float* W, int K, int N, unsigned char* WT, LAS float* scr, int item, int lane, float scale) {
    const int nblk = N / 32, kb = item / nblk, nb = item % nblk, k0 = 64 * kb, n0 = 32 * nb;
    {
        const GAS f32x4* src = (const GAS f32x4*)(W + (size_t)(k0 + (lane >> 3)) * N + n0) + (lane & 7);
        f32x4 t[8];
#pragma unroll
        for (int j = 0; j < 8; ++j) t[j] = src[(size_t)j * 2 * N];
#pragma unroll
        for (int j = 0; j < 8; ++j) { LAS float* d = scr + ((lane >> 3) + 8 * j) * 33 + 4 * (lane & 7); d[0] = t[j].x; d[1] = t[j].y; d[2] = t[j].z; d[3] = t[j].w; }
    }
    LDS_WAIT(); asm volatile("" ::: "memory");
    const int c = lane & 7;
#pragma unroll
    for (int j = 0; j < 4; ++j) { const int n = (lane >> 3) + 8 * j; const LAS float* s = scr + (8 * c) * 33 + n;
        u32x2 o; o.x = pk_fp8x4(s[0 * 33] * scale, s[1 * 33] * scale, s[2 * 33] * scale, s[3 * 33] * scale); o.y = pk_fp8x4(s[4 * 33] * scale, s[5 * 33] * scale, s[6 * 33] * scale, s[7 * 33] * scale);
        *(GAS u32x2*)(WT + (size_t)dest_row<MODE>(n0 + n) * K + k0 + 8 * c) = o; }
    LDS_WAIT(); asm volatile("" ::: "memory");
}
__device__ __forceinline__ int t5_bucket(int rel) {
    const int n = rel < 0 ? -rel : rel;
    int large = 8 + (n >= 15) + (n >= 27) + (n >= 50) + (n >= 91) + (n >= 166) + (n >= 305) + (n >= 559);
    large = large < 15 ? large : 15;
    return (rel > 0 ? 16 : 0) + (n < 8 ? n : large);
}
__device__ __forceinline__ void p0_prologue(const Args& a, LAS unsigned char* lds, int vcu, int G, int tid, int wave, int lane) {
    unsigned char* ws = a.ws;
    LAS float* scr = (LAS float*)(lds + wave * 16384);
    const int gw = vcu * NWAVES + wave, NGW = G * NWAVES;
    constexpr int I_IN = 16 * 208, I_R = 16 * 32, I_A = 8 * 32, I_O = 16 * 32;
    constexpr int NITEMS = I_IN + I_R + I_A + I_O;
    for (int it = gw; it < NITEMS; it += NGW) {
        int r = it;
#if P1_FP8
        if (r < I_IN) { if ((GATE_FP8 || r % 208 < 144) && r % 208 >= 8 * P1_FP8_FROM) p0_transpose_item_fp8<1>(a.in[1], 1024, 6656, ws + WS_WIN8, scr, r, lane, 64.f);
                        else p0_transpose_item<1>(a.in[1], 1024, 6656, (bf16*)(ws + WS_WIN), scr, r, lane); continue; } r -= I_IN;
#else
        if (r < I_IN) { p0_transpose_item<1>(a.in[1], 1024, 6656, (bf16*)(ws + WS_WIN), scr, r, lane); continue; } r -= I_IN;
#endif
        if (r < I_R) { if (MIX_FP8 & 4) p0_transpose_item_fp8<0>(a.in[5], 1024, 1024, ws + WS_WR, scr, r, lane, 64.f); else p0_transpose_item<0>(a.in[5], 1024, 1024, (bf16*)(ws + WS_WR), scr, r, lane); continue; } r -= I_R;
        if (r < I_A) { if (MIX_FP8 & 2) p0_transpose_item_fp8<0>(a.in[7], 512, 1024, ws + WS_WA, scr, r, lane, 64.f); else p0_transpose_item<0>(a.in[7], 512, 1024, (bf16*)(ws + WS_WA), scr, r, lane); continue; } r -= I_A;
        if (MIX_FP8 & 1) p0_transpose_item_fp8<0>(a.in[8], 1024, 1024, ws + WS_WO, scr, r, lane, 64.f); else p0_transpose_item<0>(a.in[8], 1024, 1024, (bf16*)(ws + WS_WO), scr, r, lane);
    }
    {
        const f32x4* x4 = (const f32x4*)a.in[0]; u32x2* xb = (u32x2*)(ws + WS_XB);
#if P1_FP8
#if GATE_FP8
        unsigned* xf8 = (unsigned*)(ws + WS_X8_LO);
#define XF8_AT(i) xf8[(long)(i) + ((i) >= (size_t)16384 * 256 ? ((long)WS_X8_HI - (long)WS_X8_LO - (long)(16 * MiB)) / 4 : 0L)]
#else
        unsigned* xf8 = (unsigned*)a.out;
#define XF8_AT(i) xf8[i]
#endif
        const size_t n4 = (size_t)TT * DM / 4, st = (size_t)G * 512; size_t i = (size_t)vcu * 512 + tid;
        for (; i + 7 * st < n4; i += 8 * st) {
            f32x4 v[8];
#pragma unroll
            for (int u = 0; u < 8; ++u) v[u] = x4[i + u * st];
#pragma unroll
            for (int u = 0; u < 8; ++u) { if (!X_F32_RES) { u32x2 o; o.x = cvtpk(v[u].x, v[u].y); o.y = cvtpk(v[u].z, v[u].w); xb[i + u * st] = o; } XF8_AT(i + u * st) = pk_fp8x4(v[u].x, v[u].y, v[u].z, v[u].w); }
        }
        for (; i < n4; i += st) { const f32x4 v = x4[i]; if (!X_F32_RES) { u32x2 o; o.x = cvtpk(v.x, v.y); o.y = cvtpk(v.z, v.w); xb[i] = o; } XF8_AT(i) = pk_fp8x4(v.x, v.y, v.z, v.w); }
#undef XF8_AT
#else
        for (size_t i = (size_t)vcu * 512 + tid; i < (size_t)TT * DM / 4; i += (size_t)G * 512) { const f32x4 v = x4[i]; u32x2 o; o.x = cvtpk(v.x, v.y); o.y = cvtpk(v.z, v.w); xb[i] = o; }
#endif
    }
    {
        float* rot = (float*)(ws + WS_ROT);
        for (int idx = vcu * 512 + tid; idx < SEQ * 64; idx += G * 512) {
            const int pos = idx >> 6, jr = idx & 63;
            double iv = 1.0; for (int k = 0; k < jr; ++k) iv *= 0.86596432336006535;
            const float ang = (float)pos * (float)iv;
            const double xx = (double)ang; const double qd = __builtin_rint(xx * 0.63661977236758134); const int qi = (int)qd;
            const double r = (xx - qd * 1.5707963267948966) - qd * 6.123233995736766e-17, r2 = r * r;
            const double sp = r * (1.0 + r2 * (-1.0 / 6 + r2 * (1.0 / 120 + r2 * (-1.0 / 5040 + r2 * (1.0 / 362880 + r2 * (-1.0 / 39916800 + r2 * (1.0 / 6227020800.0)))))));
            const double cp = 1.0 + r2 * (-0.5 + r2 * (1.0 / 24 + r2 * (-1.0 / 720 + r2 * (1.0 / 40320 + r2 * (-1.0 / 3628800 + r2 * (1.0 / 479001600.0))))));
            const int qq = qi & 3; const double s = qq == 0 ? sp : (qq == 1 ? cp : (qq == 2 ? -sp : -cp)), c = qq == 0 ? cp : (qq == 1 ? -sp : (qq == 2 ? -cp : sp));
            float* o = rot + ((size_t)pos * 16 + (jr >> 2)) * 8 + (jr & 3); o[0] = (float)c; o[4] = (float)s;
        }
    }
    if (vcu == 0) {
        float* bt = (float*)(ws + WS_BIAS); const float* rb = a.in[6];
        for (int idx = tid; idx < 3 * 8 * 160; idx += 512) { const int p = idx / (8 * 160), h = (idx / 160) % 8, d = idx % 160 - 80; const int dil = p == 0 ? 1 : (p == 1 ? 4 : 16);
            bt[idx] = (d >= -64 && d <= 64) ? rb[t5_bucket(d * dil) * 8 + h] * 1.4426950408889634f : -1e30f; }
    }
}
__device__ __forceinline__ void p0_expert_weights(const Args& a, LAS unsigned char* lds, int vcu, int G, int wave, int lane) {
    unsigned char* ws = a.ws;
    LAS float* scr = (LAS float*)(lds + wave * 16384);
    const int gw = vcu * NWAVES + wave, NGW = G * NWAVES;
    constexpr int I_G = 16 * 16, I_D = 8 * 32, PER_E = 2 * I_G + I_D;
    for (int it = gw; it < 16 * PER_E; it += NGW) {
        const int e = it / PER_E; int r = it - e * PER_E;
#if M1_FP8
        if (r < I_G) { p0_transpose_item_fp8<2>(a.in[15] + (size_t)e * 1024 * 512, 1024, 512, ws + WS_WGU + (size_t)e * 1024 * 1024, scr, r, lane, 64.f); continue; } r -= I_G;
        if (r < I_G) { p0_transpose_item_fp8<3>(a.in[16] + (size_t)e * 1024 * 512, 1024, 512, ws + WS_WGU + (size_t)e * 1024 * 1024, scr, r, lane, 64.f); continue; } r -= I_G;
#else
        if (r < I_G) { p0_transpose_item<2>(a.in[15] + (size_t)e * 1024 * 512, 1024, 512, (bf16*)(ws + WS_WGU) + (size_t)e * 1024 * 1024, scr, r, lane); continue; } r -= I_G;
        if (r < I_G) { p0_transpose_item<3>(a.in[16] + (size_t)e * 1024 * 512, 1024, 512, (bf16*)(ws + WS_WGU) + (size_t)e * 1024 * 1024, scr, r, lane); continue; } r -= I_G;
#endif
        p0_transpose_item_fp8<0>(a.in[17] + (size_t)e * 512 * 1024, 512, 1024, ws + WS_WD + (size_t)e * 1024 * 512, scr, r, lane, 64.f);
    }
    __syncthreads();
}

__device__ __forceinline__ float log2_gamma(const float* dec, int h) {
    const float x = dec[h]; return -__log2f(1.f + __expf(-x));
}
__device__ __forceinline__ void chain_item(const Args& a, LAS unsigned char* lds, int item, int tid, int wid, int lane) {
    unsigned char* ws = a.ws;
    const int b = item >> 4, h = (item >> 2) & 3, dir = (item >> 1) & 1, vh = item & 1;
    const float lg2 = log2_gamma(dir ? a.in[3] : a.in[2], h);
    const float cd = __builtin_amdgcn_exp2f(lg2 * 128.f);
    const int g = lane >> 4, i16 = lane & 15, q = i16 >> 2, p = lane & 3;
    const int wd = wid >> 1, wv = wid & 1;
    const GAS bf16* kr = (const GAS bf16*)(ws + WS_KR); const GAS bf16* vr = (const GAS bf16*)(ws + WS_VR);
    GAS bf16* states = (GAS bf16*)a.out;
    f32x4 acc[2][4];
#pragma unroll
    for (int i = 0; i < 2; ++i)
#pragma unroll
        for (int j = 0; j < 4; ++j) acc[i][j] = (f32x4){0.f, 0.f, 0.f, 0.f};
    const int srow = tid >> 4, sch = tid & 15; const unsigned soff = offb(srow, sch);
    const GAS bf16* kp = kr + ((size_t)b * SEQ + srow) * 512 + h * 128 + sch * 8;
    const GAS bf16* vp = vr + ((size_t)b * SEQ + srow) * 1024 + h * 256 + vh * 128 + sch * 8;
    v4u kq[4], vq[4];
    { const int n0 = dir ? 15 : 0;
#pragma unroll
      for (int j = 0; j < 4; ++j) { kq[j] = *(const GAS v4u*)(kp + (size_t)(n0 * 128 + 32 * j) * 512); vq[j] = *(const GAS v4u*)(vp + (size_t)(n0 * 128 + 32 * j) * 1024); } }
    unsigned abase[2][2], bbase[4][2];
#pragma unroll
    for (int t = 0; t < 2; ++t) { const unsigned r = 8 * g + 4 * t + q;
#pragma unroll
        for (int dt = 0; dt < 2; ++dt) abase[dt][t] = offb(r, 2 * (2 * wd + dt) + (p >> 1)) + 8 * (p & 1);
#pragma unroll
        for (int vt = 0; vt < 4; ++vt) bbase[vt][t] = offb(r, 2 * (4 * wv + vt) + (p >> 1)) + 8 * (p & 1); }
#define CH_STAGE(BUFOFF) do { _Pragma("unroll") for (int j = 0; j < 4; ++j) { \
            const int row = srow + 32 * j; const float z = __builtin_amdgcn_exp2f(lg2 * (float)(dir ? row : 127 - row)); const v4u kv = kq[j]; \
            v4u ko; ko.x = cvtpk(bflo(kv.x) * z, bfhi(kv.x) * z); ko.y = cvtpk(bflo(kv.y) * z, bfhi(kv.y) * z); ko.z = cvtpk(bflo(kv.z) * z, bfhi(kv.z) * z); ko.w = cvtpk(bflo(kv.w) * z, bfhi(kv.w) * z); \
            *(LAS v4u*)(lds + (BUFOFF) + soff + j * 8192) = ko; *(LAS v4u*)(lds + (BUFOFF) + 32768 + soff + j * 8192) = vq[j]; } } while (0)
#define CH_FETCH(NN) do { _Pragma("unroll") for (int j = 0; j < 4; ++j) { kq[j] = *(const GAS v4u*)(kp + (size_t)((NN) * 128 + 32 * j) * 512); vq[j] = *(const GAS v4u*)(vp + (size_t)((NN) * 128 + 32 * j) * 1024); } } while (0)
#define CH_STEP(STEP, CUR, OTH) do { const int step_ = (STEP); const int n_ = dir ? 15 - step_ : step_; \
        GAS bf16* sb_ = states + ((((size_t)(b * 4 + h) * 16 + n_) * 2 + dir) * 256) * 128; \
        _Pragma("unroll") for (int dt = 0; dt < 2; ++dt) _Pragma("unroll") for (int vt = 0; vt < 4; ++vt) { \
            const int v_ = vh * 128 + 64 * wv + 16 * vt + i16, d0_ = 32 * wd + 16 * dt + 4 * g; \
            if (STATE_FP8) { *(GAS unsigned*)((GAS unsigned char*)states + (((((size_t)(b * 4 + h) * 16 + n_) * 2 + dir) * 256) + v_) * 128 + d0_) = pg8::fp8x4_sat(acc[dt][vt][0] * 16.f, acc[dt][vt][1] * 16.f, acc[dt][vt][2] * 16.f, acc[dt][vt][3] * 16.f); }   \
            else { u32x2 w_; w_.x = pg8::cvt_pk_bf16_acc(acc[dt][vt][0], acc[dt][vt][1]); w_.y = pg8::cvt_pk_bf16_acc(acc[dt][vt][2], acc[dt][vt][3]);   \
            *(GAS u32x2*)(sb_ + (size_t)v_ * 128 + d0_) = w_; } } \
        if (step_ < 15) CH_STAGE(OTH); \
        if (step_ < 14) CH_FETCH(dir ? 13 - step_ : step_ + 2); \
        _Pragma("unroll") for (int i = 0; i < 2; ++i) _Pragma("unroll") for (int j = 0; j < 4; ++j) acc[i][j] = acc[i][j] * cd; \
        _Pragma("unroll") for (int ks = 0; ks < 4; ++ks) { bf16x8 af[2], bfr[4]; \
            _Pragma("unroll") for (int dt = 0; dt < 2; ++dt) af[dt] = cat8(ldtr(lds + (CUR) + abase[dt][0] + ks * 8192), ldtr(lds + (CUR) + abase[dt][1] + ks * 8192)); \
            _Pragma("unroll") for (int vt = 0; vt < 4; ++vt) bfr[vt] = cat8(ldtr(lds + (CUR) + 32768 + bbase[vt][0] + ks * 8192), ldtr(lds + (CUR) + 32768 + bbase[vt][1] + ks * 8192)); \
            _Pragma("unroll") for (int dt = 0; dt < 2; ++dt) _Pragma("unroll") for (int vt = 0; vt < 4; ++vt) acc[dt][vt] = MFMA16(af[dt], bfr[vt], acc[dt][vt]); } \
        __syncthreads(); } while (0)
    CH_STAGE(0);
    CH_FETCH(dir ? 14 : 1);
    __syncthreads();
    for (int sp = 0; sp < 8; ++sp) { CH_STEP(2 * sp, 0, 65536); CH_STEP(2 * sp + 1, 65536, 0); }
#undef CH_STEP
#undef CH_STAGE
#undef CH_FETCH
}

constexpr int AT_OST = 135168, AT_SCR = AT_OST + 8 * 2048;
constexpr int ATB_N = 160;
struct AttnLane { unsigned kb[2]; unsigned vb[4]; };
__device__ __forceinline__ AttnLane attn_lane(int lane) {
    const int g = lane >> 4, i16 = lane & 15, q4 = i16 >> 2, p = lane & 3; AttnLane L;
#pragma unroll
    for (int s = 0; s < 2; ++s) L.kb[s] = i16 * 128 + (((4 * s + g) ^ ((i16 >> 1) & 7)) * 16);
    const int sw = (2 * g + (q4 >> 1)) & 3;
#pragma unroll
    for (int c = 0; c < 4; ++c) L.vb[c] = (4 * g + q4) * 128 + ((c ^ sw) * 32) + p * 8;
    return L;
}
__device__ __forceinline__ unsigned kimg_off(int row, int c) { return row * 128 + ((c ^ ((row >> 1) & 7)) * 16); }
__device__ __forceinline__ unsigned vimg_off(int row, int c) { return row * 128 + (((c >> 1) ^ ((row >> 1) & 3)) * 32) + (c & 1) * 16; }
__device__ __forceinline__ void attn_core(const LAS unsigned char* Kimg, const LAS unsigned char* Vimg, int R0, int nrows, unsigned tvalid, const bf16x8 (&qf)[2],
                                          const float (&biasr)[36], const AttnLane& L, f32x4 (&O)[4], float& mx, float& lsum) {
    f32x4 D[9];
#pragma unroll
    for (int kt = 0; kt < 9; ++kt) {
        int R = R0 + 16 * kt; R = R < 0 ? 0 : (R > nrows - 16 ? nrows - 16 : R);
        const LAS unsigned char* kp = Kimg + R * 128;
        const bf16x8 k0 = *(const LAS bf16x8*)(kp + L.kb[0]), k1 = *(const LAS bf16x8*)(kp + L.kb[1]);
        f32x4 d = (f32x4){0.f, 0.f, 0.f, 0.f};
        d = MFMA16(k0, qf[0], d); d = MFMA16(k1, qf[1], d); D[kt] = d;
    }
    mx = -1e30f;
#pragma unroll
    for (int kt = 0; kt < 9; ++kt) {
        const float tb = ((tvalid >> kt) & 1u) ? 0.f : -1e30f;
#pragma unroll
        for (int r = 0; r < 4; ++r) { const float x = D[kt][r] + (biasr[4 * kt + r] + tb); D[kt][r] = x; mx = fmaxf(mx, x); }
    }
    mx = fmaxf(mx, __shfl_xor(mx, 16)); mx = fmaxf(mx, __shfl_xor(mx, 32));
    lsum = 0.f;
#pragma unroll
    for (int kt = 0; kt < 9; ++kt)
#pragma unroll
        for (int r = 0; r < 4; ++r) { const float e = __builtin_amdgcn_exp2f(D[kt][r] - mx); D[kt][r] = e; lsum += e; }
    lsum += __shfl_xor(lsum, 16); lsum += __shfl_xor(lsum, 32);
#pragma unroll
    for (int c = 0; c < 4; ++c) O[c] = (f32x4){0.f, 0.f, 0.f, 0.f};
#pragma unroll
    for (int kk = 0; kk < 5; ++kk) {
        int Ra = R0 + 32 * kk; Ra = Ra < 0 ? 0 : (Ra > nrows - 16 ? nrows - 16 : Ra);
        int Rb = R0 + 32 * kk + 16; Rb = Rb < 0 ? 0 : (Rb > nrows - 16 ? nrows - 16 : Rb);
        if (kk == 4) Rb = Ra;
        const f32x4 e0 = D[2 * kk], e1 = kk < 4 ? D[2 * kk + 1] : (f32x4){0.f, 0.f, 0.f, 0.f};
        v4u pw; pw.x = cvtpk(e0[0], e0[1]); pw.y = cvtpk(e0[2], e0[3]); pw.z = cvtpk(e1[0], e1[1]); pw.w = cvtpk(e1[2], e1[3]);
        const bf16x8 pf = __builtin_bit_cast(bf16x8, pw);
        const LAS unsigned char* va_ = Vimg + Ra * 128; const LAS unsigned char* vb_ = Vimg + Rb * 128;
#pragma unroll
        for (int c = 0; c < 4; ++c) O[c] = MFMA16(pf, cat8(ldtr(va_ + L.vb[c]), ldtr(vb_ + L.vb[c])), O[c]);
    }
}
__device__ __forceinline__ void attn_stage_out(LAS unsigned char* lds, int wid, int lane, const f32x4 (&O)[4], float lsum) {
    const int g = lane >> 4, i16 = lane & 15;
    const float linv = 1.f / lsum;
    LAS bf16* st = (LAS bf16*)(lds + AT_OST + wid * 2048);
#pragma unroll
    for (int r = 0; r < 4; ++r) { const float li = __shfl(linv, 4 * g + r);
#pragma unroll
        for (int c = 0; c < 4; ++c) st[(4 * g + r) * 64 + 16 * c + i16] = (bf16)(cvtpk(O[c][r] * li, 0.f) & 0xffffu); }
}
__device__ __forceinline__ void attn_load_bias(const Args& a, int pat, int h, int lane, float (&biasr)[36]) {
    const GAS float* bt = (const GAS float*)(a.ws + WS_BIAS) + (pat * 8 + h) * ATB_N; const int g = lane >> 4, i16 = lane & 15;
#pragma unroll
    for (int kt = 0; kt < 9; ++kt)
#pragma unroll
        for (int r = 0; r < 4; ++r) biasr[4 * kt + r] = bt[16 * kt + 4 * g + r - 64 - i16 + 80];
}
#if ATT_FP8
typedef u32x2 att_raw_t;
#define ATT_LD(base, off) (*(const GAS u32x2*)((const GAS unsigned char*)(base) + (off)))
#define ATT_WIDE(r) fp8x8_to_bf16x8(r)
#define ATT_ZERO ((u32x2){0u, 0u})
#else
typedef v4u att_raw_t;
#define ATT_LD(base, off) (*(const GAS v4u*)((base) + (off)))
#define ATT_WIDE(r) (r)
#define ATT_ZERO ((v4u){0u, 0u, 0u, 0u})
#endif
template <int DIL, int VAR = 0> __device__ __forceinline__ void attn_dil_phase(const Args& a, LAS unsigned char* lds, int vcu, int G, int tid, int wid, int lane) {
    unsigned char* ws = a.ws;
    constexpr int NR = SEQ / DIL, PAT = DIL == 4 ? 1 : 2, CH = NR * 8 / 512, NITEM = NB * 8 * DIL;
    constexpr int NBUF = DIL == 16 ? 2 : 1, BUFB = 2 * NR * 128;
    const GAS bf16* qa = (const GAS bf16*)(ws + WS_QA); const GAS bf16* ka = (const GAS bf16*)(ws + WS_KA); const GAS bf16* va = (const GAS bf16*)(ws + WS_VA);
    bf16* op = (bf16*)(ws + (DIL == 4 ? WS_O2 : WS_O3)); float* lsep = (float*)(ws + (DIL == 4 ? WS_LSE2 : WS_LSE3));
    if (vcu >= NITEM) return;
    const int h = vcu & 7;
    float biasr[36]; attn_load_bias(a, PAT, h, lane, biasr);
    const AttnLane L = attn_lane(lane);
    const int g = lane >> 4, i16 = lane & 15;
    att_raw_t kq[CH], vq[CH], qn[2];
    auto issue = [&](int item, int gi) {
        const int rho = (item >> 3) % DIL, b = item / (8 * DIL); const size_t rowb = (size_t)b * SEQ;
#pragma unroll
        for (int j = 0; j < CH; ++j) { const int id = tid + 512 * j, row = id >> 3, c = id & 7; const size_t go = (rowb + (size_t)row * DIL + rho) * 512 + h * 64 + c * 8;
            kq[j] = ATT_LD(ka, go); vq[j] = ATT_LD(va, go); }
        const size_t qpos = rowb + (size_t)(16 * gi + i16) * DIL + rho;
#pragma unroll
        for (int s = 0; s < 2; ++s) qn[s] = ATT_LD(qa, qpos * 512 + h * 64 + 32 * s + 8 * g);
    };
    issue(vcu, wid);
    int buf = 0;
    for (int item = vcu; item < NITEM; item += G) {
        const int rho = (item >> 3) % DIL, b = item / (8 * DIL); const size_t rowb = (size_t)b * SEQ;
        LAS unsigned char* Kimg = lds + buf * BUFB; LAS unsigned char* Vimg = Kimg + NR * 128;
        if (NBUF == 1) __syncthreads();
#pragma unroll
        for (int j = 0; j < CH; ++j) { const int id = tid + 512 * j, row = id >> 3, c = id & 7;
            *(LAS v4u*)(Kimg + kimg_off(row, c)) = ATT_WIDE(kq[j]); *(LAS v4u*)(Vimg + vimg_off(row, c)) = ATT_WIDE(vq[j]); }
        bf16x8 qf[2] = {__builtin_bit_cast(bf16x8, ATT_WIDE(qn[0])), __builtin_bit_cast(bf16x8, ATT_WIDE(qn[1]))};
        __syncthreads();
        if (NBUF == 2 && item + G < NITEM) issue(item + G, wid);
        for (int gi = wid; gi < NR / 16; gi += 8) {
            const int m0 = 16 * gi;
            if (NBUF == 1 && gi + 8 < NR / 16) {
                const size_t qpos = rowb + (size_t)(m0 + 128 + i16) * DIL + rho;
#pragma unroll
                for (int s = 0; s < 2; ++s) qn[s] = ATT_LD(qa, qpos * 512 + h * 64 + 32 * s + 8 * g); }
            unsigned tvalid = 0u;
#pragma unroll
            for (int kt = 0; kt < 9; ++kt) { const int t0 = m0 - 64 + 16 * kt; tvalid |= (t0 >= 0 && t0 < NR) ? (1u << kt) : 0u; }
            f32x4 O[4]; float mx, lsum;
            if (VAR == 1) { mx = 0.f; lsum = 1.f;
#pragma unroll
                for (int c = 0; c < 4; ++c) O[c] = (f32x4){__builtin_bit_cast(float, qf[0][0] + c), 0.f, 0.f, 0.f}; }
            else attn_core(Kimg, Vimg, m0 - 64, NR, tvalid, qf, biasr, L, O, mx, lsum);
            attn_stage_out(lds, wid, lane, O, lsum);
            if (g == 0) lsep[(rowb + (size_t)(m0 + i16) * DIL + rho) * 8 + h] = mx + __log2f(lsum);
            asm volatile("s_waitcnt lgkmcnt(0)" ::: "memory");
            { const int q = lane >> 2, qt = lane & 3; const LAS v4u* sp = (const LAS v4u*)(lds + AT_OST + wid * 2048 + q * 128 + qt * 32);
              const v4u x0 = sp[0], x1 = sp[1];
#if O23_FP8
              v4u o8;
              o8.x = pk_fp8x4(16.f * bflo(x0.x), 16.f * bfhi(x0.x), 16.f * bflo(x0.y), 16.f * bfhi(x0.y)); o8.y = pk_fp8x4(16.f * bflo(x0.z), 16.f * bfhi(x0.z), 16.f * bflo(x0.w), 16.f * bfhi(x0.w));
              o8.z = pk_fp8x4(16.f * bflo(x1.x), 16.f * bfhi(x1.x), 16.f * bflo(x1.y), 16.f * bfhi(x1.y)); o8.w = pk_fp8x4(16.f * bflo(x1.z), 16.f * bfhi(x1.z), 16.f * bflo(x1.w), 16.f * bfhi(x1.w));
              *(v4u*)((unsigned char*)op + (rowb + (size_t)(m0 + q) * DIL + rho) * 512 + h * 64 + qt * 16) = o8; }
#else
              bf16* dst = op + (rowb + (size_t)(m0 + q) * DIL + rho) * 512 + h * 64 + qt * 16;
              *(v4u*)dst = x0; *(v4u*)(dst + 8) = x1; }
#endif
            asm volatile("s_waitcnt lgkmcnt(0)" ::: "memory");
            if (NBUF == 1) { qf[0] = __builtin_bit_cast(bf16x8, ATT_WIDE(qn[0])); qf[1] = __builtin_bit_cast(bf16x8, ATT_WIDE(qn[1])); }
        }
        if (NBUF == 1 && item + G < NITEM) issue(item + G, wid);
        buf ^= (NBUF - 1);
    }
    __syncthreads();
}
__device__ __forceinline__ void attn_p1_phase(const Args& a, LAS unsigned char* lds, int vcu, int G, int tid, int wid, int lane) {
    unsigned char* ws = a.ws;
    LAS unsigned char* Kimg = lds; LAS unsigned char* Vimg = lds + 384 * 128;
    const GAS bf16* qa = (const GAS bf16*)(ws + WS_QA); const GAS bf16* ka = (const GAS bf16*)(ws + WS_KA); const GAS bf16* va = (const GAS bf16*)(ws + WS_VA);
    const GAS bf16* o2 = (const GAS bf16*)(ws + WS_O2); const GAS bf16* o3 = (const GAS bf16*)(ws + WS_O3);
    const GAS float* lse2 = (const GAS float*)(ws + WS_LSE2); const GAS float* lse3 = (const GAS float*)(ws + WS_LSE3);
    bf16* oa = (bf16*)(ws + WS_OA);
    if (vcu >= 1024) return;
    const int h = vcu & 7;
    float biasr[36]; attn_load_bias(a, 0, h, lane, biasr);
    const AttnLane L = attn_lane(lane);
    const int g = lane >> 4, i16 = lane & 15;
    LAS float* scr = (LAS float*)(lds + AT_SCR) + wid * 16;
    att_raw_t kq[6], vq[6];
    auto issue = [&](int item) { const int b = item >> 6, s0 = ((item >> 3) & 7) * 256; const size_t rowb = (size_t)b * SEQ;
#pragma unroll
        for (int j = 0; j < 6; ++j) { const int id = tid + 512 * j, row = id >> 3, c = id & 7, pos = s0 - 64 + row; const bool ok = pos >= 0 && pos < SEQ;
            const size_t go = (rowb + (size_t)(ok ? pos : 0)) * 512 + h * 64 + c * 8;
            kq[j] = ATT_LD(ka, go); vq[j] = ATT_LD(va, go);
            if (!ok) { kq[j] = ATT_ZERO; vq[j] = ATT_ZERO; } } };
    issue(vcu);
    for (int item = vcu; item < 1024; item += G) {
        const int b = item >> 6, s0 = ((item >> 3) & 7) * 256; const size_t rowb = (size_t)b * SEQ;
        __syncthreads();
#pragma unroll
        for (int j = 0; j < 6; ++j) { const int id = tid + 512 * j, row = id >> 3, c = id & 7;
            *(LAS v4u*)(Kimg + kimg_off(row, c)) = ATT_WIDE(kq[j]); *(LAS v4u*)(Vimg + vimg_off(row, c)) = ATT_WIDE(vq[j]); }
        __syncthreads();
        if (item + G < 1024) issue(item + G);
        for (int gi = wid; gi < 16; gi += 8) {
            const int m0 = s0 + 16 * gi;
            const int q = lane >> 2, qt = lane & 3; const size_t tq = rowb + m0 + q;
#if O23_FP8
            const v4u a2q = *(const GAS v4u*)((const GAS unsigned char*)o2 + tq * 512 + h * 64 + qt * 16), a3q = *(const GAS v4u*)((const GAS unsigned char*)o3 + tq * 512 + h * 64 + qt * 16);
#else
            const v4u a20 = *(const GAS v4u*)(o2 + tq * 512 + h * 64 + qt * 16), a21 = *(const GAS v4u*)(o2 + tq * 512 + h * 64 + qt * 16 + 8);
            const v4u a30 = *(const GAS v4u*)(o3 + tq * 512 + h * 64 + qt * 16), a31 = *(const GAS v4u*)(o3 + tq * 512 + h * 64 + qt * 16 + 8);
#endif
            const float l2 = lse2[tq * 8 + h], l3 = lse3[tq * 8 + h];
            bf16x8 qf[2];
#pragma unroll
            for (int s = 0; s < 2; ++s) qf[s] = __builtin_bit_cast(bf16x8, ATT_WIDE(ATT_LD(qa, (rowb + m0 + i16) * 512 + h * 64 + 32 * s + 8 * g)));
            unsigned tvalid = 0u;
#pragma unroll
            for (int kt = 0; kt < 9; ++kt) { const int t0 = m0 - 64 + 16 * kt; tvalid |= (t0 >= 0 && t0 < SEQ) ? (1u << kt) : 0u; }
            f32x4 O[4]; float mx, lsum;
            attn_core(Kimg, Vimg, 16 * gi, 384, tvalid, qf, biasr, L, O, mx, lsum);
            attn_stage_out(lds, wid, lane, O, lsum);
            if (g == 0) scr[i16] = mx + __log2f(lsum);
            asm volatile("s_waitcnt lgkmcnt(0)" ::: "memory");
            {
                const float l1 = scr[q], M = fmaxf(l1, fmaxf(l2, l3));
                float w1 = __builtin_amdgcn_exp2f(l1 - M), w2 = __builtin_amdgcn_exp2f(l2 - M), w3 = __builtin_amdgcn_exp2f(l3 - M); const float wi = 1.f / (w1 + w2 + w3); w1 *= wi; w2 *= wi; w3 *= wi;
                const LAS v4u* sp = (const LAS v4u*)(lds + AT_OST + wid * 2048 + q * 128 + qt * 32);
                const v4u x0 = sp[0], x1 = sp[1];
                v4u r0, r1;
#if O23_FP8
                { typedef float f2_ __attribute__((ext_vector_type(2))); const float w2s = w2 * 0.0625f, w3s = w3 * 0.0625f;
#define MRG8(d, x, yw, zw, hi) { const f2_ y_ = __builtin_amdgcn_cvt_pk_f32_fp8(yw, hi), z_ = __builtin_amdgcn_cvt_pk_f32_fp8(zw, hi); d = cvtpk(w1 * bflo(x) + w2s * y_[0] + w3s * z_[0], w1 * bfhi(x) + w2s * y_[1] + w3s * z_[1]); }
                MRG8(r0.x, x0.x, a2q.x, a3q.x, false) MRG8(r0.y, x0.y, a2q.x, a3q.x, true) MRG8(r0.z, x0.z, a2q.y, a3q.y, false) MRG8(r0.w, x0.w, a2q.y, a3q.y, true)
                MRG8(r1.x, x1.x, a2q.z, a3q.z, false) MRG8(r1.y, x1.y, a2q.z, a3q.z, true) MRG8(r1.z, x1.z, a2q.w, a3q.w, false) MRG8(r1.w, x1.w, a2q.w, a3q.w, true)
#undef MRG8
                }
#else
#define MRG(d, x, y, z) d = cvtpk(w1 * bflo(x) + w2 * bflo(y) + w3 * bflo(z), w1 * bfhi(x) + w2 * bfhi(y) + w3 * bfhi(z))
                MRG(r0.x, x0.x, a20.x, a30.x); MRG(r0.y, x0.y, a20.y, a30.y); MRG(r0.z, x0.z, a20.z, a30.z); MRG(r0.w, x0.w, a20.w, a30.w);
                MRG(r1.x, x1.x, a21.x, a31.x); MRG(r1.y, x1.y, a21.y, a31.y); MRG(r1.z, x1.z, a21.z, a31.z); MRG(r1.w, x1.w, a21.w, a31.w);
#undef MRG
#endif
#if MIX_FP8 & 2
                v4u o8;
                o8.x = pk_fp8x4(16.f * bflo(r0.x), 16.f * bfhi(r0.x), 16.f * bflo(r0.y), 16.f * bfhi(r0.y)); o8.y = pk_fp8x4(16.f * bflo(r0.z), 16.f * bfhi(r0.z), 16.f * bflo(r0.w), 16.f * bfhi(r0.w));
                o8.z = pk_fp8x4(16.f * bflo(r1.x), 16.f * bfhi(r1.x), 16.f * bflo(r1.y), 16.f * bfhi(r1.y)); o8.w = pk_fp8x4(16.f * bflo(r1.z), 16.f * bfhi(r1.z), 16.f * bflo(r1.w), 16.f * bfhi(r1.w));
                *(v4u*)((unsigned char*)oa + tq * 512 + h * 64 + qt * 16) = o8;
#else
                bf16* dst = oa + tq * 512 + h * 64 + qt * 16;
                *(v4u*)dst = r0; *(v4u*)(dst + 8) = r1;
#endif
            }
            asm volatile("s_waitcnt lgkmcnt(0)" ::: "memory");
        }
    }
    __syncthreads();
}

#define OPAQUE(x) asm volatile("" : "+v"(x))
template <int VAR = 0> __device__ __forceinline__ void p3_phase(const Args& a, LAS unsigned char* lds, int vcu, int G, int tid, int wid, int lane) {
    unsigned char* ws = a.ws;
    const int g = lane >> 4, i16 = lane & 15, q4 = i16 >> 2, p = lane & 3;
    const GAS bf16* qr = (const GAS bf16*)(ws + WS_QR); const GAS bf16* kr = (const GAS bf16*)(ws + WS_KR); const GAS bf16* vr = (const GAS bf16*)(ws + WS_VR);
    GAS bf16* gr = (GAS bf16*)(ws + WS_GR);
    LAS unsigned char* Kt = lds; LAS unsigned char* Sg = lds + 32768;
    if (vcu >= 1024) return;
    const unsigned kdst = offb(tid >> 4, tid & 15);
    unsigned rfo[4];
    { const unsigned X = ((i16 & 3) << 2) | (i16 >> 2);
#pragma unroll
      for (int s = 0; s < 4; ++s) rfo[s] = 256 * i16 + 16 * (((4 * s) ^ (X & 12)) | (g ^ (X & 3))); }
    v4u sreg[8], kreg[4]; bf16x8 qn[4];
    auto item_ptrs = [&](int item, size_t& tok0, const GAS bf16*& sf, int& h) { const int b = item >> 6; h = (item >> 4) & 3; const int n = item & 15; tok0 = (size_t)b * SEQ + n * 128;
        sf = (const GAS bf16*)((const GAS unsigned char*)a.out + ((((size_t)(b * 4 + h) * 16 + n) * 2 + 0) * 256) * 128 * (STATE_FP8 ? 1 : 2)); };
    auto issue_k = [&](int item) { size_t tok0; const GAS bf16* sf; int h; item_ptrs(item, tok0, sf, h);
        const GAS bf16* ks_ = kr + (tok0 + (tid >> 4)) * 512 + h * 128 + (tid & 15) * 8;
#pragma unroll
        for (int j = 0; j < 4; ++j) kreg[j] = *(const GAS v4u*)(ks_ + (size_t)j * 32 * 512); };
    auto issue_q = [&](int item) { size_t tok0; const GAS bf16* sf; int h; item_ptrs(item, tok0, sf, h);
#pragma unroll
        for (int s = 0; s < 4; ++s) qn[s] = *(const GAS bf16x8*)(qr + (tok0 + 16 * wid + i16) * 512 + h * 128 + 32 * s + 8 * g); };
#if STATE_FP8
    auto issue_state = [&](const GAS bf16* sf, int dirn) { const GAS unsigned char* sld = (const GAS unsigned char*)sf + (size_t)dirn * 256 * 128 + (size_t)(tid >> 4) * 128 + (tid & 15) * 8;
#pragma unroll
        for (int j = 0; j < 4; ++j) { const u32x2 lo = *(const GAS u32x2*)(sld + (size_t)(2 * j) * 32 * 128), hi = *(const GAS u32x2*)(sld + (size_t)(2 * j + 1) * 32 * 128); sreg[j] = (v4u){lo.x, lo.y, hi.x, hi.y}; } };
    auto write_state = [&]() {
#pragma unroll
        for (int j = 0; j < 8; ++j) { typedef float f2_ __attribute__((ext_vector_type(2)));
            const unsigned w0 = (j & 1) ? sreg[j >> 1].z : sreg[j >> 1].x, w1 = (j & 1) ? sreg[j >> 1].w : sreg[j >> 1].y;
            const f2_ a0 = __builtin_amdgcn_cvt_pk_f32_fp8(w0, false), a1 = __builtin_amdgcn_cvt_pk_f32_fp8(w0, true), a2 = __builtin_amdgcn_cvt_pk_f32_fp8(w1, false), a3 = __builtin_amdgcn_cvt_pk_f32_fp8(w1, true);
            v4u o; o.x = cvtpk(a0[0], a0[1]); o.y = cvtpk(a1[0], a1[1]); o.z = cvtpk(a2[0], a2[1]); o.w = cvtpk(a3[0], a3[1]);
            *(LAS v4u*)(Sg + (j >> 2) * 32768 + kdst + (j & 3) * 8192) = o; asm volatile("" ::: "memory"); } };
#else
    auto issue_state = [&](const GAS bf16* sf, int dirn) { const GAS bf16* sld = sf + (size_t)dirn * 256 * 128 + (size_t)(tid >> 4) * 128 + (tid & 15) * 8;
#pragma unroll
        for (int j = 0; j < 8; ++j) sreg[j] = *(const GAS v4u*)(sld + (size_t)j * 32 * 128); };
    auto write_state = [&]() {
#pragma unroll
        for (int j = 0; j < 8; ++j) *(LAS v4u*)(Sg + (j >> 2) * 32768 + kdst + (j & 3) * 8192) = sreg[j]; };
#endif
    { size_t tok0; const GAS bf16* sf; int h; item_ptrs(vcu, tok0, sf, h); issue_k(vcu); issue_q(vcu); issue_state(sf, 0); }
#pragma unroll
    for (int j = 0; j < 4; ++j) *(LAS v4u*)(Kt + kdst + j * 8192) = kreg[j];
    for (int item = vcu; item < 1024; item += G) {
        size_t tok0; const GAS bf16* sf; int h; item_ptrs(item, tok0, sf, h);
        const float lf2 = log2_gamma(a.in[2], h), lb2 = log2_gamma(a.in[3], h);
        bf16x8 qf[4];
#pragma unroll
        for (int s = 0; s < 4; ++s) qf[s] = qn[s];
        const bool has_next = item + G < 1024;
        __syncthreads();
        f32x4 D[8];
#pragma unroll
        for (int jt = 0; jt < 8; ++jt) {
            f32x4 d = (f32x4){0.f, 0.f, 0.f, 0.f};
#pragma unroll
            for (int s = 0; s < 4; ++s) { if (VAR != 1) { const bf16x8 kf = *(const LAS bf16x8*)(Kt + rfo[s] + jt * 4096); d = MFMA16(kf, qf[s], d); } else d[s] = __builtin_bit_cast(float, (int)qf[s][0]); }
            D[jt] = d;
        }
        int iq = 16 * wid + i16; OPAQUE(iq);
        bf16x8 pf[4];
#pragma unroll
        for (int ks = 0; ks < 4; ++ks) {
            float e[8];
#pragma unroll
            for (int t = 0; t < 2; ++t)
#pragma unroll
                for (int r = 0; r < 4; ++r) {
                    const int j = 16 * (2 * ks + t) + 4 * g + r; const float fdf = (float)(iq - j), ad = fabsf(fdf);
                    const float pos = fminf(fmaxf(fdf, 0.f), 1.f), isz = 1.f - fminf(ad, 1.f);
                    const float w = __builtin_amdgcn_exp2f((lb2 + (lf2 - lb2) * pos) * ad) + isz;
                    e[4 * t + r] = D[2 * ks + t][r] * w;
                }
            v4u pw; pw.x = cvtpk(e[0], e[1]); pw.y = cvtpk(e[2], e[3]); pw.z = cvtpk(e[4], e[5]); pw.w = cvtpk(e[6], e[7]);
            pf[ks] = __builtin_bit_cast(bf16x8, pw);
        }
        f32x4 acc[16];
#pragma unroll
        for (int vt = 0; vt < 16; ++vt) acc[vt] = (f32x4){0.f, 0.f, 0.f, 0.f};
#pragma unroll
        for (int dirn = 0; dirn < 2; ++dirn) {
            if (dirn == 1) __syncthreads();
            write_state();
            if (dirn == 0) { issue_state(sf, 1); if (has_next) issue_k(item + G); }
            else {
                if (has_next) {
#pragma unroll
                    for (int j = 0; j < 4; ++j) *(LAS v4u*)(Kt + kdst + j * 8192) = kreg[j]; }
                const GAS bf16* vs_ = vr + (tok0 + (tid >> 5)) * 1024 + h * 256 + (tid & 31) * 8;
#pragma unroll
                for (int j = 0; j < 8; ++j) sreg[j] = *(const GAS v4u*)(vs_ + (size_t)j * 16 * 1024);
            }
            __syncthreads();
#pragma unroll
            for (int vt = 0; vt < 16; ++vt) {
#pragma unroll
                for (int s = 0; s < 4; ++s) { if (VAR != 1) { const bf16x8 sfr = *(const LAS bf16x8*)(Sg + (vt >> 3) * 32768 + rfo[s] + (vt & 7) * 4096); acc[vt] = MFMA16(qf[s], sfr, acc[vt]); } }
            }
            float xs[4];
            { int ib = 16 * wid + 4 * g; OPAQUE(ib);
#pragma unroll
              for (int r = 0; r < 4; ++r) { const float lxf = lf2 * (float)(ib + r + 1), lxb = lb2 * (float)(128 - ib - r); xs[r] = __builtin_amdgcn_exp2f(dirn == 0 ? lxf - lxb : lxb - (STATE_FP8 ? 4.f : 0.f)); } }
#pragma unroll
            for (int vt = 0; vt < 16; ++vt)
#pragma unroll
                for (int r = 0; r < 4; ++r) acc[vt][r] *= xs[r];
        }
        __syncthreads();
        { int t2 = tid; OPAQUE(t2); const unsigned vd2 = (unsigned)((t2 & 31) >> 4) * 32768u + offb(t2 >> 5, t2 & 15);
#pragma unroll
          for (int j = 0; j < 8; ++j) *(LAS v4u*)(Sg + vd2 + j * 4096) = sreg[j]; }
        GAS bf16* gp = gr + (tok0 + 16 * wid + (lane >> 5)) * 1024 + h * 256 + (lane & 31) * 8;
#if MIX_FP8 & 4
        GAS unsigned char* ar8 = (GAS unsigned char*)(ws + WS_AR8) + (tok0 + 16 * wid + (lane >> 5)) * 1024 + h * 256 + (lane & 31) * 8;
#endif
        __syncthreads();
        unsigned vbs[8];
        { int l2 = lane; OPAQUE(l2); const unsigned g2 = l2 >> 4, q2 = (l2 & 15) >> 2, p2 = l2 & 3, X = (q2 << 2) | g2;
#pragma unroll
          for (int c = 0; c < 8; ++c) vbs[c] = 256 * (4 * g2 + q2) + 16 * (((2 * c) ^ (X & 14)) | ((p2 >> 1) ^ (X & 1))) + 8 * (p2 & 1); }
#pragma unroll
        for (int vt = 0; vt < 16; ++vt) {
#pragma unroll
            for (int ks = 0; ks < 4; ++ks) { if (VAR != 1) {
                const s16x4 lo = ldtr(Sg + vbs[vt & 7] + (vt >> 3) * 32768 + ks * 8192), hi = ldtr(Sg + vbs[vt & 7] + (vt >> 3) * 32768 + ks * 8192 + 4096);
                acc[vt] = MFMA16(pf[ks], cat8(lo, hi), acc[vt]); }
            }
            asm volatile("" ::: "memory");
        }
        float mu[4], rs[4];
#pragma unroll
        for (int r = 0; r < 4; ++r) {
            float s = 0.f;
#pragma unroll
            for (int vt = 0; vt < 16; ++vt) s += acc[vt][r];
            s += __shfl_xor(s, 1); s += __shfl_xor(s, 2); s += __shfl_xor(s, 4); s += __shfl_xor(s, 8);
            const float m = s * (1.f / 256.f); float qv = 0.f;
#pragma unroll
            for (int vt = 0; vt < 16; ++vt) { const float d = acc[vt][r] - m; qv += d * d; }
            qv += __shfl_xor(qv, 1); qv += __shfl_xor(qv, 2); qv += __shfl_xor(qv, 4); qv += __shfl_xor(qv, 8);
            mu[r] = m; rs[r] = 1.f / sqrtf(qv * (1.f / 256.f) + LN_EPSF);
        }
        v4u greg[8];
#pragma unroll
        for (int j = 0; j < 8; ++j) greg[j] = *(const GAS v4u*)(gp + (size_t)j * 2048);
        __syncthreads();
        if (has_next) { size_t tk; const GAS bf16* sfn; int hn; item_ptrs(item + G, tk, sfn, hn); issue_state(sfn, 0); issue_q(item + G); }
        LAS bf16* st = (LAS bf16*)(Sg + wid * 8192);
        { LAS bf16* sp_ = st + (4 * g) * 256 + i16;
#pragma unroll
          for (int vt = 0; vt < 16; ++vt)
#pragma unroll
              for (int r = 0; r < 4; ++r) sp_[r * 256 + 16 * vt] = (bf16)(cvtpk((acc[vt][r] - mu[r]) * rs[r], 0.f) & 0xffffu); }
        asm volatile("s_waitcnt lgkmcnt(0)" ::: "memory");
        {
            const float* gn = a.in[4] + h * 256; const int ch = lane & 31;
            const f32x4 g0 = *(const f32x4*)(gn + ch * 8), g1 = *(const f32x4*)(gn + ch * 8 + 4);
            const LAS bf16* yp = st + (lane >> 5) * 256 + ch * 8;
#pragma unroll
            for (int j = 0; j < 8; ++j) {
                const v4u y = *(const LAS v4u*)(yp + j * 512); const v4u sg = greg[j];
#if SILU_IN_P3
#define GSW(w, hi) pg8::fsilu((hi) ? bfhi(w) : bflo(w))
#else
#define GSW(w, hi) ((hi) ? bfhi(w) : bflo(w))
#endif
                v4u o; o.x = cvtpk(bflo(y.x) * g0[0] * GSW(sg.x, 0), bfhi(y.x) * g0[1] * GSW(sg.x, 1)); o.y = cvtpk(bflo(y.y) * g0[2] * GSW(sg.y, 0), bfhi(y.y) * g0[3] * GSW(sg.y, 1));
                o.z = cvtpk(bflo(y.z) * g1[0] * GSW(sg.z, 0), bfhi(y.z) * g1[1] * GSW(sg.z, 1)); o.w = cvtpk(bflo(y.w) * g1[2] * GSW(sg.w, 0), bfhi(y.w) * g1[3] * GSW(sg.w, 1));
#undef GSW
#if MIX_FP8 & 4
                u32x2 o8; o8.x = pk_fp8x4(bflo(o.x), bfhi(o.x), bflo(o.y), bfhi(o.y)); o8.y = pk_fp8x4(bflo(o.z), bfhi(o.z), bflo(o.w), bfhi(o.w));
                *(GAS u32x2*)(ar8 + (size_t)j * 2048) = o8;
#else
                *(GAS v4u*)(gp + (size_t)j * 2048) = o;
#endif
            }
        }
        __syncthreads();
    }
}

constexpr int P6_RS = 81920, P6_CNT = P6_RS + 8 * 512, P6_BASE = P6_CNT + 64, P6_ROW = P6_BASE + 64;
#define P6_BUTTERFLY(lg, out) do { float r10[10], r5[5], r3[3], r2[2]; const float z = 0.f; \
    _Pragma("unroll") for (int k = 0; k < 10; ++k) { const float keep = h32 ? lg[10 + k] : lg[k], send = h32 ? lg[k] : lg[10 + k]; r10[k] = keep + __shfl_xor(send, 32); } \
    _Pragma("unroll") for (int k = 0; k < 5; ++k) { const float keep = h16 ? r10[5 + k] : r10[k], send = h16 ? r10[k] : r10[5 + k]; r5[k] = keep + __shfl_xor(send, 16); } \
    { const float keep = h8 ? r5[3] : r5[0], send = h8 ? r5[0] : r5[3]; r3[0] = keep + __shfl_xor(send, 8); } \
    { const float keep = h8 ? r5[4] : r5[1], send = h8 ? r5[1] : r5[4]; r3[1] = keep + __shfl_xor(send, 8); } \
    { const float keep = h8 ? z : r5[2], send = h8 ? r5[2] : z; r3[2] = keep + __shfl_xor(send, 8); } \
    { const float keep = h4 ? r3[2] : r3[0], send = h4 ? r3[0] : r3[2]; r2[0] = keep + __shfl_xor(send, 4); } \
    { const float keep = h4 ? z : r3[1], send = h4 ? r3[1] : z; r2[1] = keep + __shfl_xor(send, 4); } \
    { const float keep = h2 ? r2[1] : r2[0], send = h2 ? r2[0] : r2[1]; out = keep + __shfl_xor(send, 2); } \
    out += __shfl_xor(out, 1); } while (0)
__device__ __forceinline__ void p6a_phase(const Args& a, LAS unsigned char* lds, int vcu, int G, int tid, int wave, int lane) {
    unsigned char* ws = a.ws;
    LAS float* RW = (LAS float*)lds;
    LAS float* RS = (LAS float*)(lds + P6_RS) + wave * 128;
    LAS unsigned* LC = (LAS unsigned*)(lds + P6_CNT); LAS unsigned* LB = (LAS unsigned*)(lds + P6_BASE); LAS unsigned* LR = (LAS unsigned*)(lds + P6_ROW);
    {
        const f32x4* wgp = (const f32x4*)a.in[11]; const f32x4* wep = (const f32x4*)a.in[13];
        f32x4 gq[2], eq[8];
#pragma unroll
        for (int u = 0; u < 2; ++u) gq[u] = wgp[tid + 512 * u];
#pragma unroll
        for (int u = 0; u < 8; ++u) eq[u] = wep[tid + 512 * u];
#pragma unroll
        for (int u = 0; u < 2; ++u) { const int c = tid + 512 * u;
#pragma unroll
            for (int k = 0; k < 4; ++k) RW[k * 1024 + c] = gq[u][k]; }
#pragma unroll
        for (int u = 0; u < 8; ++u) { const int q = tid + 512 * u, c = q >> 2, k4 = q & 3;
#pragma unroll
            for (int k = 0; k < 4; ++k) RW[(4 + 4 * k4 + k) * 1024 + c] = eq[u][k]; }
    }
    const u32x2* pre = (const u32x2*)a.out; u32x2* x1b = (u32x2*)(ws + WS_XB); [[maybe_unused]] unsigned* x1f8 = (unsigned*)(ws + WS_X1F8);
    gu32* ctl = (gu32*)ws;
    int* ltok = (int*)(ws + WS_LTOK); float* tw = (float*)(ws + WS_WSLOT); unsigned* tinfo = (unsigned*)(ws + WS_TINFO);
    const float* g1 = a.in[9]; const float* b1 = a.in[10];
    const bool h32 = (lane & 32) != 0, h16 = (lane & 16) != 0, h8 = (lane & 8) != 0, h4 = (lane & 4) != 0, h2 = (lane & 2) != 0;
#define P6_LOADROW(dst, t_) do { const u32x2* xr_ = pre + (size_t)(t_) * 256 + lane; _Pragma("unroll") for (int j = 0; j < 4; ++j) dst[j] = xr_[64 * j]; } while (0)
#define P6_LN(v, nx, s) do { s = 0.f; _Pragma("unroll") for (int j = 0; j < 4; ++j) { v[j] = (f32x4){bflo(nx[j].x), bfhi(nx[j].x), bflo(nx[j].y), bfhi(nx[j].y)}; s += (v[j].x + v[j].y) + (v[j].z + v[j].w); } } while (0)
#define P6_VAR(v, mean, q) do { q = 0.f; _Pragma("unroll") for (int j = 0; j < 4; ++j) { v[j] = v[j] - mean; q += (v[j].x * v[j].x + v[j].y * v[j].y) + (v[j].z * v[j].z + v[j].w * v[j].w); } } while (0)
#if M1_FP8
#define P6_STORE(v, t_, j) do { u32x2 o_; o_.x = cvtpk(v[j].x, v[j].y); o_.y = cvtpk(v[j].z, v[j].w); x1b[(size_t)(t_) * 256 + lane + 64 * j] = o_; x1f8[(size_t)(t_) * 256 + lane + 64 * j] = pk_fp8x4(v[j].x, v[j].y, v[j].z, v[j].w); } while (0)
#else
#define P6_STORE(v, t_, j) do { u32x2 o_; o_.x = cvtpk(v[j].x, v[j].y); o_.y = cvtpk(v[j].z, v[j].w); x1b[(size_t)(t_) * 256 + lane + 64 * j] = o_; } while (0)
#endif
#define P6_DOT(lg, v, j, k, w) lg[k] += (v[j][0] * w[0] + v[j][1] * w[1]) + (v[j][2] * w[2] + v[j][3] * w[3])
    for (int blk = vcu; blk < TT / 128; blk += G) {
        if (tid < 16) LC[tid] = 0u;
        __syncthreads();
        const int t0 = blk * 128;
        u32x2 nxA[4], nxB[4], nxC[4], nxD[4];
        P6_LOADROW(nxA, t0 + wave); P6_LOADROW(nxB, t0 + wave + 8); P6_LOADROW(nxC, t0 + wave + 16); P6_LOADROW(nxD, t0 + wave + 24);
        for (int rr = 0; rr < 4; ++rr) {
            const int rl0 = wave + 32 * rr, tA = t0 + rl0, tB = tA + 8, tC = tA + 16, tD = tA + 24;
            f32x4 vA[4], vB[4], vC[4], vD[4]; float sA, sB, sC, sD;
            P6_LN(vA, nxA, sA); P6_LN(vB, nxB, sB); P6_LN(vC, nxC, sC); P6_LN(vD, nxD, sD);
            if (rr < 3) { P6_LOADROW(nxA, tA + 32); P6_LOADROW(nxB, tB + 32); P6_LOADROW(nxC, tC + 32); P6_LOADROW(nxD, tD + 32); }
            const float mA = wave_sum(sA) * (1.f / DM), mB = wave_sum(sB) * (1.f / DM), mC = wave_sum(sC) * (1.f / DM), mD = wave_sum(sD) * (1.f / DM);
            float qA, qB, qC, qD;
            P6_VAR(vA, mA, qA); P6_VAR(vB, mB, qB); P6_VAR(vC, mC, qC); P6_VAR(vD, mD, qD);
            const float rA = 1.f / sqrtf(wave_sum(qA) * (1.f / DM) + LN_EPSF), rB = 1.f / sqrtf(wave_sum(qB) * (1.f / DM) + LN_EPSF);
            const float rC = 1.f / sqrtf(wave_sum(qC) * (1.f / DM) + LN_EPSF), rD = 1.f / sqrtf(wave_sum(qD) * (1.f / DM) + LN_EPSF);
            typedef float f32x2p __attribute__((ext_vector_type(2)));
            f32x2p lgAB[20], lgCD[20];
#pragma unroll
            for (int k = 0; k < 20; ++k) { lgAB[k] = (f32x2p){0.f, 0.f}; lgCD[k] = (f32x2p){0.f, 0.f}; }
#pragma unroll
            for (int j = 0; j < 4; ++j) {
                const f32x4 gg = *(const f32x4*)(g1 + 4 * lane + 256 * j), bb = *(const f32x4*)(b1 + 4 * lane + 256 * j);
                vA[j] = vA[j] * rA * gg + bb; vB[j] = vB[j] * rB * gg + bb; vC[j] = vC[j] * rC * gg + bb; vD[j] = vD[j] * rD * gg + bb;
                P6_STORE(vA, tA, j); P6_STORE(vB, tB, j); P6_STORE(vC, tC, j); P6_STORE(vD, tD, j);
                f32x2p pab[4], pcd[4];
#pragma unroll
                for (int e = 0; e < 4; ++e) { pab[e] = (f32x2p){vA[j][e], vB[j][e]}; pcd[e] = (f32x2p){vC[j][e], vD[j][e]}; }
#pragma unroll
                for (int k = 0; k < 20; ++k) { const f32x4 w = *(const LAS f32x4*)(RW + k * 1024 + 4 * lane + 256 * j);
#pragma unroll
                    for (int e = 0; e < 4; ++e) { const f32x2p ww = (f32x2p){w[e], w[e]};
                        lgAB[k] = __builtin_elementwise_fma(pab[e], ww, lgAB[k]); lgCD[k] = __builtin_elementwise_fma(pcd[e], ww, lgCD[k]); } }
            }
            float lgA[20], lgB[20], lgC[20], lgD[20];
#pragma unroll
            for (int k = 0; k < 20; ++k) { lgA[k] = lgAB[k].x; lgB[k] = lgAB[k].y; lgC[k] = lgCD[k].x; lgD[k] = lgCD[k].y; }
            float r1A, r1B, r1C, r1D;
            P6_BUTTERFLY(lgA, r1A); P6_BUTTERFLY(lgB, r1B); P6_BUTTERFLY(lgC, r1C); P6_BUTTERFLY(lgD, r1D);
            {
                const int i3 = h2 ? (h4 ? -1 : 1) : (h4 ? 2 : 0);
                const int i5 = i3 < 0 ? -1 : (h8 ? (i3 == 2 ? -1 : i3 + 3) : i3);
                const int kk = i5 < 0 ? -1 : (h32 ? 10 : 0) + (h16 ? 5 : 0) + i5;
                if (kk >= 0 && (lane & 1) == 0) { RS[kk] = r1A; RS[32 + kk] = r1B; RS[64 + kk] = r1C; RS[96 + kk] = r1D; }
            }
            asm volatile("s_waitcnt lgkmcnt(0)" ::: "memory");
            {
                const int sel = lane & 3; const int rl = rl0 + 8 * sel;
                float tl[20];
#pragma unroll
                for (int k4 = 0; k4 < 5; ++k4) { const f32x4 w = *(const LAS f32x4*)(RS + sel * 32 + 4 * k4); tl[4 * k4] = w[0]; tl[4 * k4 + 1] = w[1]; tl[4 * k4 + 2] = w[2]; tl[4 * k4 + 3] = w[3]; }
                float gl[4];
#pragma unroll
                for (int k = 0; k < 4; ++k) gl[k] = tl[k] + a.in[12][k];
                int gi = 0; float gm = gl[0];
#pragma unroll
                for (int k = 1; k < 4; ++k) if (gl[k] > gm) { gm = gl[k]; gi = k; }
                float gs = 0.f;
#pragma unroll
                for (int k = 0; k < 4; ++k) gs += __expf(gl[k] - gm);
                const float gwt = 1.f / gs;
                float el[4];
#pragma unroll
                for (int k = 0; k < 4; ++k) { const float se = gi == 0 ? tl[4 + k] : (gi == 1 ? tl[8 + k] : (gi == 2 ? tl[12 + k] : tl[16 + k])); el[k] = se + a.in[14][4 * gi + k]; }
                int i1 = 0; float v1 = el[0];
#pragma unroll
                for (int k = 1; k < 4; ++k) if (el[k] > v1) { v1 = el[k]; i1 = k; }
                int i2 = (i1 + 1) & 3; float v2 = -3.0e38f;
#pragma unroll
                for (int k = 0; k < 4; ++k) if (k != i1 && el[k] > v2) { v2 = el[k]; i2 = k; }
                const float ex = __expf(v2 - v1), w1 = gwt / (1.f + ex), w2 = gwt * ex / (1.f + ex);
                if (lane < 4) {
                    const int e1 = 4 * gi + i1, e2 = 4 * gi + i2;
                    const unsigned p1 = __hip_atomic_fetch_add(LC + e1, 1u, __ATOMIC_RELAXED, __HIP_MEMORY_SCOPE_WORKGROUP);
                    const unsigned p2 = __hip_atomic_fetch_add(LC + e2, 1u, __ATOMIC_RELAXED, __HIP_MEMORY_SCOPE_WORKGROUP);
                    LR[rl * 4 + 0] = ((unsigned)e1 << 16) | p1; LR[rl * 4 + 1] = ((unsigned)e2 << 16) | p2; LR[rl * 4 + 2] = __float_as_uint(w1); LR[rl * 4 + 3] = __float_as_uint(w2);
                }
            }
            asm volatile("s_waitcnt lgkmcnt(0)" ::: "memory");
        }
        __syncthreads();
        if (tid < 16) LB[tid] = __hip_atomic_fetch_add(ctl + CW_CNT + 64 * tid, LC[tid], __ATOMIC_RELAXED, __HIP_MEMORY_SCOPE_AGENT);
        __syncthreads();
        if (tid < 256) {
            const int rl = tid >> 1, j = tid & 1; const unsigned rec = LR[rl * 4 + j]; const unsigned e = rec >> 16, pos = LB[e] + (rec & 0xffffu);
            ltok[e * TT + pos] = t0 + rl; tw[2 * (t0 + rl) + j] = __uint_as_float(LR[rl * 4 + 2 + j]); tinfo[2 * (t0 + rl) + j] = (e << 16) | pos;
        }
        __syncthreads();
    }
#undef P6_LOADROW
#undef P6_LN
#undef P6_VAR
#undef P6_STORE
#undef P6_DOT
}
__device__ __forceinline__ void build_tile_tables(const Args& a, LAS unsigned char* lds, int tid) {
    LAS int* ts = (LAS int*)(lds + LDS_TS_OFF); LAS int* te = (LAS int*)(lds + LDS_TE_OFF); LAS int* cn = (LAS int*)(lds + LDS_CNT_OFF);
    gu32* ctl = (gu32*)a.ws;
    if (tid == 0) { int acc = 0;
        for (int e = 0; e < 16; ++e) { ts[e] = acc; const int c = (int)__hip_atomic_load(ctl + CW_CNT + 64 * e, __ATOMIC_RELAXED, __HIP_MEMORY_SCOPE_AGENT); const int nt = (c + 255) >> 8; cn[e] = c;
            for (int k = 0; k < nt; ++k) te[acc + k] = e; acc += nt; }
        ts[16] = acc; }
    __syncthreads();
}
__device__ __forceinline__ void p9_phase(const Args& a, LAS unsigned char* lds, int vcu, int G, int wave, int lane) {
    unsigned char* ws = a.ws;
    const LAS int* ts = (const LAS int*)(lds + LDS_TS_OFF);
    const unsigned* tinfo = (const unsigned*)(ws + WS_TINFO); const u32x2* Y = (const u32x2*)(ws + WS_Y);
    const float* g2 = a.in[18]; const float* b2 = a.in[19];
    const int gw = vcu * NWAVES + wave, NGW = G * NWAVES;
#if Y_FP8
    const unsigned* Y8 = (const unsigned*)(ws + WS_Y); unsigned ny0[4], ny1[4]; u32x2 nxw[4]; float nw0 = 0.f, nw1 = 0.f;
#else
    u32x2 ny0[4], ny1[4], nxw[4]; float nw0 = 0.f, nw1 = 0.f;
#endif
    const float* tw = (const float*)(ws + WS_WSLOT);
    auto issue = [&](int t) {
        const unsigned i0 = tinfo[2 * t], i1 = tinfo[2 * t + 1];
        nw0 = tw[2 * t]; nw1 = tw[2 * t + 1];
        const size_t s0 = (size_t)ts[i0 >> 16] * 256 + (i0 & 0xffffu), s1 = (size_t)ts[i1 >> 16] * 256 + (i1 & 0xffffu);
        const u32x2* xb1 = (const u32x2*)(ws + WS_XB) + (size_t)t * 256 + lane;
#pragma unroll
#if Y_FP8
        for (int j = 0; j < 4; ++j) { ny0[j] = Y8[s0 * 256 + lane + 64 * j]; ny1[j] = Y8[s1 * 256 + lane + 64 * j]; nxw[j] = xb1[64 * j]; }
#else
        for (int j = 0; j < 4; ++j) { ny0[j] = Y[s0 * 256 + lane + 64 * j]; ny1[j] = Y[s1 * 256 + lane + 64 * j]; nxw[j] = xb1[64 * j]; }
#endif
    };
    if (gw < TT) issue(gw);
    for (int t = gw; t < TT; t += NGW) {
        f32x4* xr = (f32x4*)(a.out + (size_t)t * DM) + lane;
#if Y_FP8
        f32x4 v[4]; float s = 0.f; const float w0 = nw0 * 0.0625f, w1 = nw1 * 0.0625f;
#pragma unroll
        for (int j = 0; j < 4; ++j) {
            const unsigned y0 = ny0[j], y1 = ny1[j]; const u32x2 xw = nxw[j];
            typedef float f32x2_ __attribute__((ext_vector_type(2)));
            const f32x2_ a0 = __builtin_amdgcn_cvt_pk_f32_fp8(y0, false), a1 = __builtin_amdgcn_cvt_pk_f32_fp8(y0, true), c0 = __builtin_amdgcn_cvt_pk_f32_fp8(y1, false), c1 = __builtin_amdgcn_cvt_pk_f32_fp8(y1, true);
            f32x4 x = (f32x4){bflo(xw.x), bfhi(xw.x), bflo(xw.y), bfhi(xw.y)} * DN_ALPHA;
            x.x += w0 * a0[0] + w1 * c0[0]; x.y += w0 * a0[1] + w1 * c0[1]; x.z += w0 * a1[0] + w1 * c1[0]; x.w += w0 * a1[1] + w1 * c1[1];
            v[j] = x; s += (x.x + x.y) + (x.z + x.w);
        }
#else
        f32x4 v[4]; float s = 0.f; const float w0 = nw0, w1 = nw1;
#pragma unroll
        for (int j = 0; j < 4; ++j) {
            const u32x2 y0 = ny0[j], y1 = ny1[j], xw = nxw[j];
            f32x4 x = (f32x4){bflo(xw.x), bfhi(xw.x), bflo(xw.y), bfhi(xw.y)} * DN_ALPHA;
            x.x += w0 * bflo(y0.x) + w1 * bflo(y1.x); x.y += w0 * bfhi(y0.x) + w1 * bfhi(y1.x); x.z += w0 * bflo(y0.y) + w1 * bflo(y1.y); x.w += w0 * bfhi(y0.y) + w1 * bfhi(y1.y);
            v[j] = x; s += (x.x + x.y) + (x.z + x.w);
        }
#endif
        if (t + NGW < TT) issue(t + NGW);
        const float mean = wave_sum(s) * (1.f / DM); float s2 = 0.f;
#pragma unroll
        for (int j = 0; j < 4; ++j) { v[j] = v[j] - mean; s2 += (v[j].x * v[j].x + v[j].y * v[j].y) + (v[j].z * v[j].z + v[j].w * v[j].w); }
        const float rstd = 1.f / sqrtf(wave_sum(s2) * (1.f / DM) + LN_EPSF);
#pragma unroll
        for (int j = 0; j < 4; ++j) { const f32x4 gg = *(const f32x4*)(g2 + 4 * lane + 256 * j), bb = *(const f32x4*)(b2 + 4 * lane + 256 * j); xr[64 * j] = v[j] * rstd * gg + bb; }
    }
}

__global__ void __launch_bounds__(NWAVES * 64, 2) mega_fwd(Args args) {
    extern __shared__ __attribute__((aligned(16))) unsigned char lds_raw[];
    LAS unsigned char* lds = (LAS unsigned char*)lds_raw;
    volatile LAS unsigned* MISC = (volatile LAS unsigned*)(lds + MISC_OFF);
    const int tid0 = threadIdx.x, wave = __builtin_amdgcn_readfirstlane(tid0 >> 6);
    const int G = gridDim.x, bx = blockIdx.x, vcu = (G % 8 == 0) ? (bx % 8) * (G / 8) + bx / 8 : bx;
    for (int u = tid0; u < (LDS_BYTES - LDSCTL_OFF) / 4; u += NWAVES * 64) ((LAS unsigned*)(lds + LDSCTL_OFF))[u] = 0u;
    __syncthreads();
    unsigned char* ws = args.ws;
    gu32* ctl = (gu32*)ws;
    const bool bars_on = (args.mask >> 31) != 0u;
    XcdBarrier bar; bar.bar = (unsigned*)(ctl + CW_BAR) + args.bar_region * XCD_BAR_WORDS; bar.x = 0; bar.st = nullptr;
    if (bars_on) bar = xcd_barrier_post((unsigned*)(ctl + CW_BAR) + args.bar_region * XCD_BAR_WORDS, MISC + 8);
    bar.wv = wave;
#define GRID_BAR() do { if (bars_on) xcd_barrier(bar); } while (0)
#ifndef PH_LAST
#define PH_LAST 99
#endif
#define FRESH() int tid = wave * 64 + pg8::lane_id(); asm volatile("" : "+v"(tid)); const int lane = tid & 63; (void)lane
#ifndef RMASK
#define RMASK 0
#endif
#define REP(k) _Pragma("unroll") for (int rep_ = 0; rep_ < 1 + ((RMASK >> (k)) & 1); ++rep_)
#ifndef STAMP_SCALE
#define STAMP_SCALE 1.0f
#endif
#ifdef STAMP_PH
#define ST_B(k) if ((k) == STAMP_PH) { st_a = rt(); }
#define ST_E(k) if ((k) == STAMP_PH) { st_b = rt(); }
#else
#define ST_B(k)
#define ST_E(k)
#endif
#ifdef ONLY
#define EN(k) (ONLY == (k))
#else
#define EN(k) ((args.mask >> (k)) & 1u)
#endif
    unsigned long long st_a = 0, st_b = 0; (void)st_a; (void)st_b;
    REP(0) if (EN(0)) { FRESH(); p0_prologue(args, lds, vcu, G, tid, wave, lane); }
    GRID_BAR();
#ifdef STAGGER_TICKS
    if (EN(1) && (bx & 8)) { const unsigned long long t0_ = rt(); while (rt() - t0_ < STAGGER_TICKS) __builtin_amdgcn_s_sleep(32); }
#endif
    REP(1) if (EN(1)) {
#if P1_FP8
        pg8::EpiHcat E{ws, (const float*)(ws + WS_ROT), 0};
        if (P1_FP8_FROM > 0) {
            pg8::Gemm g{(const pg8::bf16_t*)(ws + WS_XB), (const pg8::bf16_t*)(ws + WS_WIN), TT, 4608, 1024}; pg8::StaticOrder S; S.init(TT, 256 * P1_FP8_FROM, G, bx);
            pg8::gemm_phase<pg8::EpiHcat, pg8::StaticOrder, true, true>(lds, g, S, E, wave);
        }
        {
#if GATE_FP8
            pg8::Gemm g{(const pg8::bf16_t*)(ws + WS_X8_LO), (const pg8::bf16_t*)(ws + WS_WIN8), TT, 4608, 512, 64, (long)WS_X8_HI - (long)WS_X8_LO - (long)(16 * MiB)}; pg8::StaticOrder S;
#else
            pg8::Gemm g{(const pg8::bf16_t*)args.out, (const pg8::bf16_t*)(ws + WS_WIN8), TT, 4608, 512}; pg8::StaticOrder S;
#endif
            S.init(TT, 4608 - 256 * P1_FP8_FROM, G, bx, P1_FP8_FROM);
#if CONV_BG
            pg8::P1Order SB; SB.S = S; SB.cv = pg8::ExpertConv{args.in[15], args.in[16], args.in[17], ws + WS_WGU, ws + WS_WD, vcu * NWAVES + wave, G * NWAVES, vcu % 9};
            pg8::gemm_phase<pg8::EpiHcat, pg8::P1Order, true, true, false, true, 1, 0>(lds, g, SB, E, wave);
            { FRESH();
              for (int k = 0; SB.cv.gw + k * SB.cv.nw < 6144; ++k) { pg8::Unit tu; const bool in_gap = k < 3 && S.next(pg8::P1Order::unit_of(SB.cv.grp, k), tu) && pg8::P1Order::unit_of(SB.cv.grp, k) < 9;
                  if (!in_gap) pg8::expert_conv_item(SB.cv, k, lane); } }
#else
            pg8::gemm_phase<pg8::EpiHcat, pg8::StaticOrder, true, true, false, true, 1, 0>(lds, g, S, E, wave);
#endif
        }
#else
        pg8::Gemm g{(const pg8::bf16_t*)(ws + WS_XB), (const pg8::bf16_t*)(ws + WS_WIN), TT, 4608, 1024}; pg8::StaticOrder S; S.init(TT, 4608, G, bx);
        pg8::EpiHcat E{ws, (const float*)(ws + WS_ROT), 0};
        pg8::gemm_phase<pg8::EpiHcat, pg8::StaticOrder, true, true>(lds, g, S, E, wave);
#endif
    }
    GRID_BAR();
    if (PH_LAST >= 2) {
        REP(2) if (EN(2)) { FRESH(); for (int it = vcu; it < 256; it += G) chain_item(args, lds, it, tid, wave, lane); }
        if (EN(3)) { { FRESH(); attn_dil_phase<16>(args, lds, vcu, G, tid, wave, lane); }
                     { FRESH(); attn_dil_phase<4>(args, lds, vcu, G, tid, wave, lane); } }
    }
    GRID_BAR();
    ST_B(4) if (PH_LAST >= 3 && EN(4)) { FRESH(); p3_phase<0>(args, lds, vcu, G, tid, wave, lane); }
    if (EN(13)) { FRESH(); attn_p1_phase(args, lds, vcu, G, tid, wave, lane); }
    GRID_BAR(); ST_E(4)
#if !CONV_BG
    if (EN(14)) { FRESH(); p0_expert_weights(args, lds, vcu, G, wave, lane); }
#endif
    REP(5) if (PH_LAST >= 4 && EN(5)) {
        pg8::GateOrder S; S.S4.init(TT, 1024, G, bx);
        pg8::EpiHcat E{ws, (const float*)(ws + WS_ROT), 18};
#if GATE_FP8
        pg8::Gemm g{(const pg8::bf16_t*)(ws + WS_X8_LO), (const pg8::bf16_t*)(ws + WS_WIN8 + (size_t)4608 * 1024), TT, 2048, 512, 64, (long)WS_X8_HI - (long)WS_X8_LO - (long)(16 * MiB)};
        pg8::gemm_phase<pg8::EpiHcat, pg8::GateOrder, true, true, false, true, 1, 0>(lds, g, S, E, wave);
#else
        pg8::Gemm g{(const pg8::bf16_t*)(ws + WS_XB), (const pg8::bf16_t*)(ws + WS_WIN) + (size_t)4608 * 1024, TT, 2048, 1024};
        pg8::gemm_phase<pg8::EpiHcat, pg8::GateOrder, true, true>(lds, g, S, E, wave);
#endif
        asm volatile("s_waitcnt vmcnt(0)" ::: "memory"); __syncthreads();
    }
    REP(6) if (PH_LAST >= 5 && EN(6)) {
        pg8::StaticOrder S; S.init(TT, 1024, G, bx);
        { pg8::EpiGate<false> E{(const pg8::bf16_t*)(ws + WS_GATE_A), (pg8::bf16_t*)(ws + WS_MERGED), nullptr};
#if MIX_FP8 & 2
          pg8::Gemm g{(const pg8::bf16_t*)(ws + WS_OA), (const pg8::bf16_t*)(ws + WS_WA), TT, 1024, 256};
          pg8::gemm_phase<pg8::EpiGate<false>, pg8::StaticOrder, true, true, false, true, 1, 3>(lds, g, S, E, wave);
#else
          pg8::Gemm g{(const pg8::bf16_t*)(ws + WS_OA), (const pg8::bf16_t*)(ws + WS_WA), TT, 1024, 512};
          pg8::gemm_phase<pg8::EpiGate<false>, pg8::StaticOrder, true, true>(lds, g, S, E, wave);
#endif
        }
        asm volatile("s_waitcnt vmcnt(0)" ::: "memory"); __syncthreads();
        { typedef pg8::EpiGate<true, (MIX_FP8 & 1) != 0> EpiC;
          EpiC E{(const pg8::bf16_t*)(ws + WS_GATE_R), (pg8::bf16_t*)(ws + WS_MERGED), ws + WS_MERGED8};
#if MIX_FP8 & 4
          pg8::Gemm g{(const pg8::bf16_t*)(ws + WS_AR8), (const pg8::bf16_t*)(ws + WS_WR), TT, 1024, 512};
          pg8::gemm_phase<EpiC, pg8::StaticOrder, true, true, false, true, 1, 0>(lds, g, S, E, wave);
#else
          pg8::Gemm g{(const pg8::bf16_t*)(ws + WS_GR), (const pg8::bf16_t*)(ws + WS_WR), TT, 1024, 1024};
          pg8::gemm_phase<EpiC, pg8::StaticOrder, true, true>(lds, g, S, E, wave);
#endif
        }
    }
    GRID_BAR();
    REP(7) if (PH_LAST >= 6 && EN(7)) {
        pg8::StaticOrder S; S.init(TT, 1024, G, bx);
        pg8::EpiResBf16 E{X_F32_RES ? (const pg8::bf16_t*)args.in[0] : (const pg8::bf16_t*)(ws + WS_XB), (pg8::bf16_t*)args.out, DN_ALPHA};
#if MIX_FP8 & 1
        pg8::Gemm g{(const pg8::bf16_t*)(ws + WS_MERGED8), (const pg8::bf16_t*)(ws + WS_WO), TT, 1024, 512};
        pg8::gemm_phase<pg8::EpiResBf16, pg8::StaticOrder, true, true, false, true, 1, 3>(lds, g, S, E, wave);
#else
        pg8::Gemm g{(const pg8::bf16_t*)(ws + WS_MERGED), (const pg8::bf16_t*)(ws + WS_WO), TT, 1024, 1024};
        pg8::gemm_phase<pg8::EpiResBf16, pg8::StaticOrder, true, true>(lds, g, S, E, wave);
#endif
    }
    GRID_BAR();
    ST_B(8) if (PH_LAST >= 7 && EN(8)) { FRESH(); p6a_phase(args, lds, vcu, G, tid, wave, lane); }
    GRID_BAR(); ST_E(8)
    { FRESH(); build_tile_tables(args, lds, tid); }
    const int nrt = ((const LAS int*)(lds + LDS_TS_OFF))[16];
    REP(10) if (PH_LAST >= 9 && EN(10)) {
#if M1_FP8
        pg8::Gemm g{(const pg8::bf16_t*)(ws + WS_X1F8), (const pg8::bf16_t*)(ws + WS_WGU), MAXSLOT, 1024, 512};
        pg8::MoeOrder S{nrt * 4, G, vcu, (const LAS int*)(lds + LDS_TE_OFF), (const LAS int*)(lds + LDS_TS_OFF), (const LAS int*)(lds + LDS_CNT_OFF), (const int*)(ws + WS_LTOK), 1024u};
        pg8::EpiSwiGLU E{ws + WS_H};
        pg8::gemm_phase<pg8::EpiSwiGLU, pg8::MoeOrder, true, true, true, true, 1, 0>(lds, g, S, E, wave);
#else
        pg8::Gemm g{(const pg8::bf16_t*)(ws + WS_XB), (const pg8::bf16_t*)(ws + WS_WGU), MAXSLOT, 1024, 1024};
        pg8::MoeOrder S{nrt * 4, G, vcu, (const LAS int*)(lds + LDS_TE_OFF), (const LAS int*)(lds + LDS_TS_OFF), (const LAS int*)(lds + LDS_CNT_OFF), (const int*)(ws + WS_LTOK), 2048u};
        pg8::EpiSwiGLU E{ws + WS_H};
        pg8::gemm_phase<pg8::EpiSwiGLU, pg8::MoeOrder, true, true, true>(lds, g, S, E, wave);
#endif
    }
    GRID_BAR();
    REP(11) if (PH_LAST >= 10 && EN(11)) {
        pg8::Gemm g{(const pg8::bf16_t*)(ws + WS_H), (const pg8::bf16_t*)(ws + WS_WD), MAXSLOT, 1024, 256};
        pg8::MoeOrder S{nrt * 4, G, vcu, (const LAS int*)(lds + LDS_TE_OFF), (const LAS int*)(lds + LDS_TS_OFF), (const LAS int*)(lds + LDS_CNT_OFF), (const int*)(ws + WS_LTOK), 1024u};
        pg8::EpiRowScale E{(pg8::bf16_t*)(ws + WS_Y)};
        pg8::gemm_phase<pg8::EpiRowScale, pg8::MoeOrder, true, true, false, true, 1, 2>(lds, g, S, E, wave);
    }
    GRID_BAR();
    ST_B(12) if (PH_LAST >= 11 && EN(12)) { FRESH(); p9_phase(args, lds, vcu, G, wave, lane); }
#ifdef STAMP_PH
    GRID_BAR(); ST_E(12)
    if (STAMP_PH == 13) { st_a = rt(); GRID_BAR(); GRID_BAR(); GRID_BAR(); GRID_BAR(); st_b = rt(); }
    if (bx == 0 && tid0 == 0) { const float us = (float)(st_b - st_a) * 0.01f * STAMP_SCALE; int k = 0; float lim = 30.f; while (us >= lim && k < 12) { lim *= 1.5f; ++k; }
        __hip_atomic_store(ctl + CW_CHK, __float_as_uint(sqrtf(2.f * k + 2.f)), RLX_AGENT); }
    GRID_BAR();
    { const float c = __uint_as_float(__hip_atomic_load(ctl + CW_CHK, RLX_AGENT)); f32x4* o4 = (f32x4*)args.out;
      for (size_t i = (size_t)bx * 512 + tid0; i < (size_t)TT * DM / 4; i += (size_t)G * 512) o4[i] = (f32x4){c, c, c, c}; }
#endif
}

#ifdef PROBE_VAR
__global__ void __launch_bounds__(NWAVES * 64, 2) probe_kernel(Args args) {
    extern __shared__ __attribute__((aligned(16))) unsigned char lds_raw[];
    LAS unsigned char* lds = (LAS unsigned char*)lds_raw;
    const int tid0 = threadIdx.x, wave = __builtin_amdgcn_readfirstlane(tid0 >> 6);
    const int G = gridDim.x, bx = blockIdx.x, vcu = (G % 8 == 0) ? (bx % 8) * (G / 8) + bx / 8 : bx;
    FRESH();
    if (PROBE_VAR >= 20 && PROBE_VAR <= 22) {
        unsigned char* ws = args.ws;
        pg8::Gemm g{(const pg8::bf16_t*)(ws + WS_X8_LO), (const pg8::bf16_t*)(ws + WS_WIN8), TT, 4608, 512, 64, (long)WS_X8_HI - (long)WS_X8_LO - (long)(16 * MiB)}; pg8::StaticOrder S; S.init(TT, 4608, G, bx);
        typedef pg8::EpiHcatT<PROBE_VAR - 20> EpiP;
        EpiP E{ws, (const float*)(ws + WS_ROT), 0};
        pg8::gemm_phase<EpiP, pg8::StaticOrder, true, true, false, true, 1, 0>(lds, g, S, E, wave);
    }
    if (PROBE_VAR == 10) p3_phase<0>(args, lds, vcu, G, tid, wave, lane);
    if (PROBE_VAR == 11) p3_phase<1>(args, lds, vcu, G, tid, wave, lane);
    if (PROBE_VAR == 0) attn_dil_phase<16, 0>(args, lds, vcu, G, tid, wave, lane);
    if (PROBE_VAR == 1) attn_dil_phase<16, 1>(args, lds, vcu, G, tid, wave, lane);
    if (PROBE_VAR == 2) attn_dil_phase<4, 0>(args, lds, vcu, G, tid, wave, lane);
    if (PROBE_VAR == 3) attn_dil_phase<4, 1>(args, lds, vcu, G, tid, wave, lane);
}
#endif
extern "C" void kernel_launch(void* const* d_in, const int* in_sizes, int n_in, void* d_out, int out_size, void* d_ws, size_t ws_size, hipStream_t stream) {
    static int grid = 0;
    if (grid == 0) {
        if (n_in != 20 || in_sizes[0] != TT * DM || out_size != TT * DM || ws_size < WS_END) { fprintf(stderr, "kernel_launch: unexpected shapes: n_in %d in0 %d out %d ws %zu; nothing launched\n", n_in, n_in > 0 ? in_sizes[0] : -1, out_size, ws_size); grid = -1; return; }
        int dev = 0, cus = 0;
        if (hipGetDevice(&dev) != hipSuccess || hipDeviceGetAttribute(&cus, hipDeviceAttributeMultiprocessorCount, dev) != hipSuccess) { grid = -1; return; }
        if (hipFuncSetAttribute((const void*)mega_fwd, hipFuncAttributeMaxDynamicSharedMemorySize, LDS_BYTES) != hipSuccess) { fprintf(stderr, "kernel_launch: hipFuncSetAttribute failed\n"); grid = -1; return; }
        (void)hipGetLastError();
        grid = cus;
    }
    if (grid < 0) return;
    if (hipMemsetAsync((char*)d_ws, 0, CTL_ZERO_BYTES, stream) != hipSuccess) return;
    Args a{};
    for (int i = 0; i < 20; ++i) a.in[i] = (const float*)d_in[i];
    a.out = (float*)d_out; a.ws = (unsigned char*)d_ws; a.mask = 0x80007fffu; a.bar_region = 0;
#if defined(XTRA_FIRST)
    { Args x = a; x.mask = XTRA_FIRST; x.bar_region = 1; for (int r = 0; r < XTRA_REP; ++r) hipLaunchKernelGGL(mega_fwd, dim3(grid), dim3(NWAVES * 64), LDS_BYTES, stream, x);
      if (hipMemsetAsync((char*)d_ws, 0, CTL_ZERO_BYTES, stream) != hipSuccess) return; }
#endif
    hipLaunchKernelGGL(mega_fwd, dim3(grid), dim3(NWAVES * 64), LDS_BYTES, stream, a);
#if defined(PROBE_VAR)
    { hipFuncSetAttribute((const void*)probe_kernel, hipFuncAttributeMaxDynamicSharedMemorySize, LDS_BYTES);
      for (int r = 0; r < 4; ++r) hipLaunchKernelGGL(probe_kernel, dim3(grid), dim3(NWAVES * 64), LDS_BYTES, stream, a); }
#endif
#if defined(XTRA_AFTER)
    { Args x = a; x.mask = XTRA_AFTER; x.bar_region = 1; for (int r = 0; r < XTRA_REP; ++r) hipLaunchKernelGGL(mega_fwd, dim3(grid), dim3(NWAVES * 64), LDS_BYTES, stream, x); }
#endif
}
```

```cpp
#include <hip/hip_runtime.h>
#include <cstdio>
#include <cstdint>

constexpr int TT = 32768, DM = 1024, SEQ = 2048, NB = 16;
constexpr float DN_ALPHA = 1.189207115002721f;
constexpr float LN_EPSF = 1e-5f;
#ifndef M1_FP8
#define M1_FP8 1
#endif
#ifndef P1_FP8
#define P1_FP8 1
#endif
#ifndef ATT_FP8
#define ATT_FP8 1
#endif
#ifndef O23_FP8
#define O23_FP8 1
#endif
#ifndef STATE_FP8
#define STATE_FP8 1
#endif
#ifndef SILU_IN_P3
#define SILU_IN_P3 1
#endif
#ifndef CONV_BG
#define CONV_BG 1
#endif
#ifndef Y_FP8
#define Y_FP8 1
#endif
#ifndef GATE_FP8
#define GATE_FP8 1
#endif
#ifndef MIX_FP8
#define MIX_FP8 7
#endif
#ifndef P1_FP8_FROM
#define P1_FP8_FROM 0
#endif
#define X_F32_RES (P1_FP8 && P1_FP8_FROM == 0 && GATE_FP8)
constexpr size_t MiB = 1u << 20;
constexpr size_t CTL_ZERO_BYTES = 1 * MiB;
constexpr size_t WS_ROT = 1 * MiB;
constexpr size_t WS_BIAS = 2 * MiB;
constexpr size_t WS_LTOK = 3 * MiB;
constexpr size_t WS_TINFO = 7 * MiB;
constexpr size_t WS_WSLOT = 7 * MiB + 512 * 1024;
constexpr size_t WS_WIN = 8 * MiB;
constexpr size_t WS_WIN8 = 12 * MiB;
constexpr size_t WS_WR = 21 * MiB;
constexpr size_t WS_WA = 23 * MiB;
constexpr size_t WS_WO = 24 * MiB;
constexpr size_t WS_WGU = 26 * MiB;
constexpr size_t WS_WD = 42 * MiB;
constexpr size_t WS_XB = 80 * MiB;
constexpr size_t WS_QR = 144 * MiB;
constexpr size_t WS_KR = 176 * MiB;
constexpr size_t WS_VR = 208 * MiB;
constexpr size_t WS_GR = 272 * MiB;
constexpr size_t WS_QA = 336 * MiB, WS_KA = 368 * MiB, WS_VA = 400 * MiB, WS_OA = 432 * MiB;
#if MIX_FP8 & 4
constexpr size_t WS_AR8 = 144 * MiB;
constexpr size_t WS_GATE_R = 176 * MiB, WS_GATE_A = 240 * MiB;
#else
constexpr size_t WS_GATE_R = 144 * MiB, WS_GATE_A = 208 * MiB;
#endif
constexpr size_t WS_X8_LO = 448 * MiB, WS_X8_HI = 58 * MiB;
static_assert(M1_FP8, "the workspace map is laid out for fp8 expert weights");
static_assert(!CONV_BG || X_F32_RES, "CONV_BG puts o2 into the bf16 x region");
static_assert(!GATE_FP8 || (P1_FP8 && (MIX_FP8 & 2) && M1_FP8), "GATE_FP8 needs the fp8 mixer-input GEMM, the fp8 o_a (room behind it) and the fp8 expert weights (room behind them)");
constexpr size_t WS_MERGED8 = 464 * MiB;
constexpr size_t WS_MERGED = 336 * MiB;
constexpr size_t WS_Y = 144 * MiB;
constexpr size_t WS_H = 336 * MiB;
constexpr size_t WS_X1F8 = 464 * MiB;
#if CONV_BG
constexpr size_t WS_O2 = 80 * MiB;
#else
constexpr size_t WS_O2 = 26 * MiB;
#endif
constexpr size_t WS_O3 = 464 * MiB;
constexpr size_t WS_LSE2 = 496 * MiB, WS_LSE3 = 497 * MiB;
constexpr size_t WS_END = 512 * MiB;
constexpr int MAXSLOT = 69632;
constexpr int CW_BAR = 4096;
constexpr int CW_CNT = 16384;
constexpr int CW_CHK = 24576;
namespace pg8 {
#define PG8_LAS __attribute__((address_space(3)))
typedef unsigned short bf16_t;
typedef short bf16x8 __attribute__((ext_vector_type(8)));
typedef float f32x4 __attribute__((ext_vector_type(4)));
typedef unsigned u32x4 __attribute__((ext_vector_type(4)));
typedef unsigned u32x2_ __attribute__((ext_vector_type(2)));
constexpr int BM = 256, BK = 64, HALF = 128, HTB = HALF * BK * 2  , STAGE_BYTES = 8 * HTB, NXCD = 8, WGM = 8;

__device__ __forceinline__ int lane_id() { int x; asm volatile("v_mbcnt_lo_u32_b32 %0, -1, 0\n\tv_mbcnt_hi_u32_b32 %0, -1, %0" : "=v"(x)); return x; }
__host__ __device__ __forceinline__ int lds_byte(int r, int c) { const int st = (r >> 4) * 2 + (c >> 5), rr = r & 15, cc = c & 31, ob = rr * 64 + cc * 2; return st * 1024 + (ob ^ (((ob >> 9) & 1) << 5)); }
__host__ __device__ __forceinline__ void stage_rc(int b, int& R, int& C) { const int st = b / 1024, sb = b % 1024, swz = sb ^ (((sb >> 9) & 1) << 5); R = (st >> 1) * 16 + swz / 64; C = (st & 1) * 32 + (swz % 64) / 2; }
__host__ __device__ __forceinline__ int perm32(int rho) { const int n = rho >> 4, i = rho & 15; return 8 * (i >> 2) + 4 * n + (i & 3); }

struct Unit { int pm, pn; };
struct Gemm { const bf16_t* A; const bf16_t* Bt; int M, N, K; int spm = 1 << 30; long sdelta = 0; };

struct StaticOrder {
    int nM, nN, nwg, G, c, pn0;
    __host__ __device__ void init(int M, int N, int G_, int c_, int pn0_ = 0) { nM = M / BM; nN = N / BM; nwg = nM * nN; G = G_; c = c_; pn0 = pn0_; }
    __host__ __device__ bool next(int i, Unit& u) const {
        const long L = (long)i * G + c; if (L >= nwg) return false;
        int wgid = (int)L; { const int q = nwg / NXCD, r = nwg % NXCD, xcd = wgid % NXCD, off = wgid / NXCD; wgid = (xcd < r ? xcd * (q + 1) : r * (q + 1) + (xcd - r) * q) + off; }
        const int nig = WGM * nN, gid = wgid / nig, fm = gid * WGM, gsz = (nM - fm) < WGM ? (nM - fm) : WGM;
        u.pm = fm + ((wgid % nig) % gsz); u.pn = pn0 + (wgid % nig) / gsz; return true;
    }
    __device__ __forceinline__ void a_ready(const Unit&) const {}
    __device__ __forceinline__ void done(const Unit&, int, int) const {}
};

__device__ __forceinline__ unsigned cvt_pk_bf16(float lo, float hi) { unsigned r; asm volatile("v_cvt_pk_bf16_f32 %0, %1, %2" : "=v"(r) : "v"(lo), "v"(hi)); return r; }
typedef float cvt_f32x2_t __attribute__((ext_vector_type(2))); typedef __bf16 cvt_bf16x2_t __attribute__((ext_vector_type(2)));
__device__ __forceinline__ unsigned cvt_pk_bf16_acc(float lo, float hi) { const cvt_f32x2_t v = {lo, hi}; const cvt_bf16x2_t b = __builtin_convertvector(v, cvt_bf16x2_t); return __builtin_bit_cast(unsigned, b); }
__device__ __forceinline__ float bflo(unsigned w) { return __uint_as_float(w << 16); }
__device__ __forceinline__ float bfhi(unsigned w) { return __uint_as_float(w & 0xffff0000u); }
__device__ __forceinline__ float fsigmoid(float x) { return __builtin_amdgcn_rcpf(1.f + __expf(-x)); }
__device__ __forceinline__ float fsilu(float x) { return x * __builtin_amdgcn_rcpf(1.f + __expf(-x)); }

__device__ __forceinline__ unsigned fp8x4_sat(float a, float b, float c, float d) {
    a = __builtin_amdgcn_fmed3f(a, -448.f, 448.f); b = __builtin_amdgcn_fmed3f(b, -448.f, 448.f); c = __builtin_amdgcn_fmed3f(c, -448.f, 448.f); d = __builtin_amdgcn_fmed3f(d, -448.f, 448.f);
    unsigned w = 0u; w = __builtin_amdgcn_cvt_pk_fp8_f32(a, b, w, false); w = __builtin_amdgcn_cvt_pk_fp8_f32(c, d, w, true); return w;
}
template <int VAR = 0> struct EpiHcatT {
    static constexpr bool PERM = true, AFTER_DRAIN = false; static constexpr int NSTORE = 16;
    unsigned char* ws; const float* rot; int tile_off;
    __device__ __forceinline__ void operator()(const f32x4 (&acc)[2][2][4][2], const Unit& u, int wr, int wc, int fr, int fq) const {
        if (VAR == 1) {
            float s = 0.f;
#pragma unroll
            for (int ai = 0; ai < 2; ++ai)
#pragma unroll
                for (int bj = 0; bj < 2; ++bj)
#pragma unroll
                    for (int m = 0; m < 4; ++m)
#pragma unroll
                        for (int n = 0; n < 2; ++n) s += (acc[ai][bj][m][n][0] + acc[ai][bj][m][n][1]) + (acc[ai][bj][m][n][2] + acc[ai][bj][m][n][3]);
            ((float*)(ws + WS_O3))[(size_t)(u.pm * 64 + u.pn) * 512 + wr * 256 + wc * 64 + fq * 16 + fr] = s; return;
        }
        const int gt = u.pn + tile_off;
        size_t base_off; int pitch, ct, mode; float sc = 1.f;
        if (gt < 2)       { base_off = WS_QR; pitch = 512;  ct = gt;      mode = 1; }
        else if (gt < 4)  { base_off = WS_KR; pitch = 512;  ct = gt - 2;  mode = 1; sc = 0.08838834764831845f; }
        else if (gt < 8)  { base_off = WS_VR; pitch = 1024; ct = gt - 4;  mode = 0; }
        else if (gt < 12) { base_off = WS_GR; pitch = 1024; ct = gt - 8;  mode = SILU_IN_P3 ? 0 : 2; }
        else if (gt < 14) { base_off = WS_QA; pitch = 512;  ct = gt - 12; mode = ATT_FP8 ? 4 : 0; sc = 0.18033688011112042f; }
        else if (gt < 16) { base_off = WS_KA; pitch = 512;  ct = gt - 14; mode = ATT_FP8 ? 4 : 0; }
        else if (gt < 18) { base_off = WS_VA; pitch = 512;  ct = gt - 16; mode = ATT_FP8 ? 4 : 0; }
        else if (gt < 22) { base_off = WS_GATE_R; pitch = 1024; ct = gt - 18; mode = 3; }
        else              { base_off = WS_GATE_A; pitch = 1024; ct = gt - 22; mode = 3; }
        bf16_t* O = (bf16_t*)(ws + base_off);
        const int row0 = u.pm * BM + wr * 64 + fr, col0 = ct * BM + wc * 32 + 8 * fq;
#pragma unroll
        for (int ai = 0; ai < 2; ++ai)
#pragma unroll
            for (int m = 0; m < 4; ++m) {
                const int row = row0 + ai * HALF + m * 16;
                bf16_t* rowp = O + (size_t)(VAR == 2 ? (row & 255) : row) * pitch + col0;
                f32x4 cs = (f32x4){1.f, 1.f, 1.f, 1.f}, sn = (f32x4){0.f, 0.f, 0.f, 0.f};
                if (mode == 1) { const f32x4* rt = (const f32x4*)(rot + ((size_t)(row & (SEQ - 1)) * 16 + (4 * wc + fq)) * 8); cs = rt[0]; sn = rt[1]; }
#pragma unroll
                for (int bj = 0; bj < 2; ++bj) {
                    f32x4 v0 = acc[ai][bj][m][0], v1 = acc[ai][bj][m][1];
                    if (mode == 1) { const f32x4 a = v0 * cs - v1 * sn, b = v0 * sn + v1 * cs; v0 = a * sc; v1 = b * sc; }
                    else if (mode == 2) {
#pragma unroll
                        for (int e = 0; e < 4; ++e) { v0[e] = fsilu(v0[e]); v1[e] = fsilu(v1[e]); } }
                    else if (mode == 3) {
#pragma unroll
                        for (int e = 0; e < 4; ++e) { v0[e] = fsigmoid(v0[e]); v1[e] = fsigmoid(v1[e]); } }
                    else { v0 = v0 * sc; v1 = v1 * sc; }
                    if (mode == 4) { u32x2_ w8; w8.x = fp8x4_sat(v0[0], v0[1], v0[2], v0[3]); w8.y = fp8x4_sat(v1[0], v1[1], v1[2], v1[3]);
                        *(u32x2_*)((unsigned char*)O + (size_t)(VAR == 2 ? (row & 255) : row) * pitch + col0 + bj * HALF) = w8; }
                    else { u32x4 w; w.x = cvt_pk_bf16(v0[0], v0[1]); w.y = cvt_pk_bf16(v0[2], v0[3]); w.z = cvt_pk_bf16(v1[0], v1[1]); w.w = cvt_pk_bf16(v1[2], v1[3]);
                        *(u32x4*)(rowp + bj * HALF) = w; }
                }
            }
    }
};

typedef EpiHcatT<0> EpiHcat;

template <bool ADD, bool OUT8 = false> struct EpiGate {
    static constexpr bool PERM = true, AFTER_DRAIN = false; static constexpr int NSTORE = 16;
    const bf16_t* gate; bf16_t* O; unsigned char* O8;
    __device__ __forceinline__ void operator()(const f32x4 (&acc)[2][2][4][2], const Unit& u, int wr, int wc, int fr, int fq) const {
        const int row0 = u.pm * BM + wr * 64 + fr, col0 = u.pn * BM + wc * 32 + 8 * fq;
#pragma unroll
        for (int ai = 0; ai < 2; ++ai)
#pragma unroll
            for (int m = 0; m < 4; ++m)
#pragma unroll
                for (int bj = 0; bj < 2; ++bj) {
                    const size_t p = (size_t)(row0 + ai * HALF + m * 16) * 1024 + col0 + bj * HALF;
                    const u32x4 g = *(const u32x4*)(gate + p);
                    f32x4 v0 = acc[ai][bj][m][0], v1 = acc[ai][bj][m][1];
                    v0[0] *= bflo(g.x); v0[1] *= bfhi(g.x); v0[2] *= bflo(g.y); v0[3] *= bfhi(g.y);
                    v1[0] *= bflo(g.z); v1[1] *= bfhi(g.z); v1[2] *= bflo(g.w); v1[3] *= bfhi(g.w);
                    if (ADD) { const u32x4 o = *(const u32x4*)(O + p);
                        v0[0] += bflo(o.x); v0[1] += bfhi(o.x); v0[2] += bflo(o.y); v0[3] += bfhi(o.y);
                        v1[0] += bflo(o.z); v1[1] += bfhi(o.z); v1[2] += bflo(o.w); v1[3] += bfhi(o.w); }
                    if (OUT8) { u32x2_ w8;
                        w8.x = fp8x4_sat(v0[0] * 16.f, v0[1] * 16.f, v0[2] * 16.f, v0[3] * 16.f); w8.y = fp8x4_sat(v1[0] * 16.f, v1[1] * 16.f, v1[2] * 16.f, v1[3] * 16.f);
                        *(u32x2_*)(O8 + p) = w8; }
                    else { u32x4 w; w.x = cvt_pk_bf16(v0[0], v0[1]); w.y = cvt_pk_bf16(v0[2], v0[3]); w.z = cvt_pk_bf16(v1[0], v1[1]); w.w = cvt_pk_bf16(v1[2], v1[3]);
                        *(u32x4*)(O + p) = w; }
                }
    }
};

struct EpiResBf16 {
    static constexpr bool PERM = true, AFTER_DRAIN = false; static constexpr int NSTORE = 16;
    const bf16_t* x; bf16_t* out; float alpha;
    __device__ __forceinline__ void operator()(const f32x4 (&acc)[2][2][4][2], const Unit& u, int wr, int wc, int fr, int fq) const {
        const int row0 = u.pm * BM + wr * 64 + fr, col0 = u.pn * BM + wc * 32 + 8 * fq;
#pragma unroll
        for (int ai = 0; ai < 2; ++ai)
#pragma unroll
            for (int m = 0; m < 4; ++m)
#pragma unroll
                for (int bj = 0; bj < 2; ++bj) {
                    const size_t p = (size_t)(row0 + ai * HALF + m * 16) * 1024 + col0 + bj * HALF;
#if X_F32_RES
                    const f32x4 x0 = *(const f32x4*)((const float*)x + p), x1 = *(const f32x4*)((const float*)x + p + 4);
#else
                    const u32x4 xw = *(const u32x4*)(x + p);
                    const f32x4 x0 = (f32x4){bflo(xw.x), bfhi(xw.x), bflo(xw.y), bfhi(xw.y)}, x1 = (f32x4){bflo(xw.z), bfhi(xw.z), bflo(xw.w), bfhi(xw.w)};
#endif
                    const f32x4 v0 = x0 * alpha + acc[ai][bj][m][0], v1 = x1 * alpha + acc[ai][bj][m][1];
                    u32x4 w; w.x = cvt_pk_bf16(v0[0], v0[1]); w.y = cvt_pk_bf16(v0[2], v0[3]); w.z = cvt_pk_bf16(v1[0], v1[1]); w.w = cvt_pk_bf16(v1[2], v1[3]);
                    *(u32x4*)(out + p) = w;
                }
    }
};

struct EpiSwiGLU {
    static constexpr bool PERM = true, AFTER_DRAIN = false; static constexpr int NSTORE = 16;
    unsigned char* H;
    __device__ __forceinline__ void operator()(const f32x4 (&acc)[2][2][4][2], const Unit& u, int wr, int wc, int fr, int fq) const {
        const int row0 = u.pm * BM + wr * 64 + fr, col0 = (u.pn & 3) * 128 + wc * 16 + 4 * fq;
#pragma unroll
        for (int ai = 0; ai < 2; ++ai)
#pragma unroll
            for (int m = 0; m < 4; ++m)
#pragma unroll
                for (int bj = 0; bj < 2; ++bj) {
                    const f32x4 g = acc[ai][bj][m][0], up = acc[ai][bj][m][1];
                    float h0 = fsilu(g[0]) * up[0] * 8.f, h1 = fsilu(g[1]) * up[1] * 8.f, h2 = fsilu(g[2]) * up[2] * 8.f, h3 = fsilu(g[3]) * up[3] * 8.f;
                    h0 = fminf(fmaxf(h0, -448.f), 448.f); h1 = fminf(fmaxf(h1, -448.f), 448.f); h2 = fminf(fmaxf(h2, -448.f), 448.f); h3 = fminf(fmaxf(h3, -448.f), 448.f);
                    unsigned w = 0u; w = __builtin_amdgcn_cvt_pk_fp8_f32(h0, h1, w, false); w = __builtin_amdgcn_cvt_pk_fp8_f32(h2, h3, w, true);
                    *(unsigned*)(H + (size_t)(row0 + ai * HALF + m * 16) * 512 + col0 + bj * 64) = w;
                }
    }
};

struct EpiRowScale {
    static constexpr bool PERM = true, AFTER_DRAIN = false; static constexpr int NSTORE = 16;
    bf16_t* Y;
    __device__ __forceinline__ void operator()(const f32x4 (&acc)[2][2][4][2], const Unit& u, int wr, int wc, int fr, int fq) const {
        const int row0 = u.pm * BM + wr * 64 + fr, col0 = (u.pn & 3) * BM + wc * 32 + 8 * fq;
#pragma unroll
        for (int ai = 0; ai < 2; ++ai)
#pragma unroll
            for (int m = 0; m < 4; ++m) {
                const int row = row0 + ai * HALF + m * 16;
#pragma unroll
                for (int bj = 0; bj < 2; ++bj) {
                    const f32x4 v0 = acc[ai][bj][m][0], v1 = acc[ai][bj][m][1];
#if Y_FP8
                    u32x2_ w8; w8.x = fp8x4_sat(v0[0] * 16.f, v0[1] * 16.f, v0[2] * 16.f, v0[3] * 16.f); w8.y = fp8x4_sat(v1[0] * 16.f, v1[1] * 16.f, v1[2] * 16.f, v1[3] * 16.f);
                    *(u32x2_*)((unsigned char*)Y + (size_t)row * 1024 + col0 + bj * HALF) = w8;
#else
                    u32x4 w; w.x = cvt_pk_bf16_acc(v0[0], v0[1]); w.y = cvt_pk_bf16_acc(v0[2], v0[3]); w.z = cvt_pk_bf16_acc(v1[0], v1[1]); w.w = cvt_pk_bf16_acc(v1[2], v1[3]);
                    *(u32x4*)(Y + (size_t)row * 1024 + col0 + bj * HALF) = w;
#endif
                }
            }
    }
};

struct MoeOrder {
    int nunits, G, c; const PG8_LAS int* te; const PG8_LAS int* ts; const PG8_LAS int* cnt; const int* ltok; unsigned rowbytes;
    __device__ __forceinline__ bool next(int i, Unit& u) const {
        const int L = i * G + c, rt = (L >> 5) * 8 + (L & 7); if (rt >= (nunits >> 2)) return false;
        u.pm = rt; u.pn = te[rt] * 4 + ((L >> 3) & 3); return true;
    }
    __device__ __forceinline__ unsigned a_row_off(const Unit& u, int row) const {
        const int ex = te[u.pm], pos = (u.pm - ts[ex]) * 256 + row;
        const int tok = pos < cnt[ex] ? ltok[ex * 32768 + pos] : 0;
        return (unsigned)tok * rowbytes;
    }
    __device__ __forceinline__ void a_ready(const Unit&) const {}
    __device__ __forceinline__ void done(const Unit&, int, int) const {}
};

struct ExpertConv { const float* wg; const float* wu; const float* wd; unsigned char* WGU; unsigned char* WD; int gw, nw, grp; };
__device__ __forceinline__ void expert_conv_item(const ExpertConv& c, int j, int lane) {
    const int it = j * c.nw + c.gw, e = it / 384, r = it % 384;
    const float* src; unsigned char* dst; int K, N, mode, nb, kb;
    if (r < 128)      { src = c.wg + (size_t)e * 1024 * 512; dst = c.WGU + (size_t)e * 1024 * 1024; K = 1024; N = 512;  mode = 2; nb = r >> 4; kb = r & 15; }
    else if (r < 256) { src = c.wu + (size_t)e * 1024 * 512; dst = c.WGU + (size_t)e * 1024 * 1024; K = 1024; N = 512;  mode = 3; nb = (r - 128) >> 4; kb = (r - 128) & 15; }
    else              { src = c.wd + (size_t)e * 512 * 1024; dst = c.WD + (size_t)e * 1024 * 512;   K = 512;  N = 1024; mode = 0; nb = (r - 256) >> 3; kb = (r - 256) & 7; }
    const int n4 = nb * 64 + 4 * (lane & 15), k0 = kb * 64 + 16 * (lane >> 4);
    const float* s = src + (size_t)k0 * N + n4;
    f32x4 v[16];
#pragma unroll
    for (int i = 0; i < 16; ++i) v[i] = *(const f32x4*)(s + (size_t)i * N);
#pragma unroll
    for (int jn = 0; jn < 4; ++jn) {
        const int n = n4 + jn, row = mode == 0 ? n : ((n >> 2) << 3) + (n & 3) + (mode == 3 ? 4 : 0);
        u32x4 w;
        w.x = fp8x4_sat(v[0][jn] * 64.f, v[1][jn] * 64.f, v[2][jn] * 64.f, v[3][jn] * 64.f);     w.y = fp8x4_sat(v[4][jn] * 64.f, v[5][jn] * 64.f, v[6][jn] * 64.f, v[7][jn] * 64.f);
        w.z = fp8x4_sat(v[8][jn] * 64.f, v[9][jn] * 64.f, v[10][jn] * 64.f, v[11][jn] * 64.f); w.w = fp8x4_sat(v[12][jn] * 64.f, v[13][jn] * 64.f, v[14][jn] * 64.f, v[15][jn] * 64.f);
        *(u32x4*)(dst + (size_t)row * K + k0) = w;
    }
}
struct GateOrder {
    StaticOrder S4;
    __device__ __forceinline__ bool next(int i, Unit& u) const { Unit t; if (!S4.next(i >> 1, t)) return false; u.pm = t.pm; u.pn = t.pn + 4 * (i & 1); return true; }
    __device__ __forceinline__ void a_ready(const Unit&) const {}
    __device__ __forceinline__ void done(const Unit&, int, int) const {}
};
struct P1Order {
    StaticOrder S; ExpertConv cv;
    __device__ __forceinline__ bool next(int i, Unit& u) const { return S.next(i, u); }
    __device__ __forceinline__ void a_ready(const Unit&) const {}
    __device__ __forceinline__ static int unit_of(int grp, int k) { return (grp + 3 * k) % 9; }
    __device__ __forceinline__ void done(const Unit&, int ui, int lane) const {
        const int d = (ui + 9 - cv.grp) % 9;
        if (ui < 9 && d % 3 == 0 && cv.gw + (d / 3) * cv.nw < 6144) expert_conv_item(cv, d / 3, lane);
    }
};

template <class Epi, class Sched, bool ALIGN_EPI = false, bool SP2 = false, bool GATHER = false, bool FP8 = false, int SEL_W = 0, int SEL_X = 0>
__device__ __forceinline__ void gemm_phase(PG8_LAS unsigned char* lds, const Gemm g, const Sched& S, const Epi& E, const int wid) {
    int tid = wid * 64 + lane_id(); asm volatile("" : "+v"(tid));
    const int lane = tid & 63, wr = wid >> 2, wc = wid & 3, fr = lane & 15, fq = lane >> 4;
    static_assert(SP2, "only the two-super-phase loop is kept");
    typedef int i32x4_ __attribute__((ext_vector_type(4)));
    const int K = g.K, nt = K / BK;
    unsigned voffB[2]; int rA[2], cA2[2];
#pragma unroll
    for (int i = 0; i < 2; ++i) { int R, C; stage_rc(tid * 16 + i * 8192, R, C); const int Rb = Epi::PERM ? ((R & ~31) + perm32(R & 31)) : R;
        rA[i] = R; cA2[i] = C * 2; voffB[i] = (unsigned)(Rb * K + C) * 2u; }
    unsigned vAc[2][2], vAn[2][2];
    const size_t kstep = (size_t)(BK * 2);
    const size_t hstep = (size_t)HALF * K * 2;
    const size_t tstep = 2 * hstep;
    const unsigned ldsw = (unsigned)wid * 1024u;
    const int aoff0 = lds_byte(wr * 64 + fr, fq * 8), aoff1 = aoff0 + 1024;
    const int boff0 = lds_byte(wc * 32 + fr, fq * 8), boff1 = boff0 + 1024;
#define PG8_SA(b, h) (((b) * 2 + (h)) * HTB)
#define PG8_SB(b, h) ((4 + (b) * 2 + (h)) * HTB)
#define PG8_STAGE(bufoff, gbase, voff) do { _Pragma("unroll") for (int _i = 0; _i < 2; ++_i) \
        __builtin_amdgcn_global_load_lds((const unsigned*)((const char*)(gbase) + (voff)[_i]), (PG8_LAS unsigned*)(lds + (bufoff) + ldsw + _i * 8192), 16, 0, 0); } while (0)
#define PG8_LDA(dst, b, h) do { _Pragma("unroll") for (int m = 0; m < 4; ++m) { dst[m][0] = *(const PG8_LAS bf16x8*)(lds + PG8_SA(b, h) + aoff0 + m * 2048); dst[m][1] = *(const PG8_LAS bf16x8*)(lds + PG8_SA(b, h) + aoff1 + m * 2048); } } while (0)
#define PG8_LDB(dst, b, h) do { _Pragma("unroll") for (int n = 0; n < 2; ++n) { dst[n][0] = *(const PG8_LAS bf16x8*)(lds + PG8_SB(b, h) + boff0 + n * 2048); dst[n][1] = *(const PG8_LAS bf16x8*)(lds + PG8_SB(b, h) + boff1 + n * 2048); } } while (0)
#define PG8_CAT8(x) __builtin_shufflevector(__builtin_bit_cast(i32x4_, (x)[0]), __builtin_bit_cast(i32x4_, (x)[1]), 0, 1, 2, 3, 4, 5, 6, 7)
#define PG8_MMA(ai, bj, At, Bt) do { __builtin_amdgcn_s_setprio(1); \
        if constexpr (FP8) { _Pragma("unroll") for (int m = 0; m < 4; ++m) _Pragma("unroll") for (int n = 0; n < 2; ++n) \
            acc[ai][bj][m][n] = __builtin_amdgcn_mfma_scale_f32_16x16x128_f8f6f4(PG8_CAT8(Bt[n]), PG8_CAT8(At[m]), acc[ai][bj][m][n], 0, 0, SEL_W, scl, SEL_X, scl); \
            asm volatile("" : "+v"(acc[ai][bj][0][0]), "+v"(acc[ai][bj][0][1]), "+v"(acc[ai][bj][1][0]), "+v"(acc[ai][bj][1][1]), "+v"(acc[ai][bj][2][0]), "+v"(acc[ai][bj][2][1]), "+v"(acc[ai][bj][3][0]), "+v"(acc[ai][bj][3][1])); } \
        else { _Pragma("unroll") for (int m = 0; m < 4; ++m) _Pragma("unroll") for (int n = 0; n < 2; ++n) _Pragma("unroll") for (int k = 0; k < 2; ++k) \
            acc[ai][bj][m][n] = __builtin_amdgcn_mfma_f32_16x16x32_bf16(Bt[n][k], At[m][k], acc[ai][bj][m][n], 0, 0, 0); } \
        __builtin_amdgcn_s_setprio(0); } while (0)
#define PG8_WAIT_V(n) asm volatile("s_waitcnt vmcnt(" #n ")" ::: "memory")
#define PG8_WAIT_VN(n) asm volatile("s_waitcnt vmcnt(%0)" :: "i"(n) : "memory")
#define PG8_WAIT_L(n) asm volatile("s_waitcnt lgkmcnt(" #n ")" ::: "memory")
#define PG8_BAR __builtin_amdgcn_s_barrier()
#define PG8_SCHED __builtin_amdgcn_sched_barrier(0)
    [[maybe_unused]] int scl = 0x7b7c797f; asm volatile("" : "+v"(scl));
    Unit cur, nxt; int ui = 0;
    if (!S.next(0, cur)) return;
    f32x4 acc[2][2][4][2];
#pragma unroll
    for (int a = 0; a < 2; ++a)
#pragma unroll
        for (int b = 0; b < 2; ++b)
#pragma unroll
            for (int m = 0; m < 4; ++m)
#pragma unroll
                for (int n = 0; n < 2; ++n) acc[a][b][m][n] = (f32x4){0.f, 0.f, 0.f, 0.f};
    bf16x8 At[4][2], B0[2][2], B1[2][2];
    const char* cA = GATHER ? (const char*)g.A : (const char*)g.A + (size_t)cur.pm * tstep + (cur.pm >= g.spm ? g.sdelta : 0L); const char* cB = (const char*)g.Bt + (size_t)cur.pn * tstep;
#pragma unroll
    for (int h = 0; h < 2; ++h)
#pragma unroll
        for (int i = 0; i < 2; ++i) { if constexpr (GATHER) vAc[h][i] = S.a_row_off(cur, h * HALF + rA[i]) + (unsigned)cA2[i]; else vAc[h][i] = (unsigned)((h * HALF + rA[i]) * K) * 2u + (unsigned)cA2[i]; vAn[h][i] = vAc[h][i]; }
    S.a_ready(cur);
    if constexpr (SP2) {
        PG8_STAGE(PG8_SB(0, 0), cB, voffB); PG8_STAGE(PG8_SB(0, 1), cB + hstep, voffB); PG8_STAGE(PG8_SA(0, 0), cA, vAc[0]); PG8_STAGE(PG8_SA(0, 1), cA, vAc[1]);
        if (wr == 1) PG8_BAR;
        PG8_WAIT_V(2); PG8_BAR;
        PG8_STAGE(PG8_SB(1, 0), cB + kstep, voffB); PG8_STAGE(PG8_SA(1, 0), cA + kstep, vAc[0]); PG8_STAGE(PG8_SB(1, 1), cB + hstep + kstep, voffB);
        PG8_WAIT_V(6); PG8_BAR;
    }
    for (;;) {
        const bool has_next = S.next(ui + 1, nxt);
        const char* nA = GATHER ? cA : (has_next ? (const char*)g.A + (size_t)nxt.pm * tstep + (nxt.pm >= g.spm ? g.sdelta : 0L) : cA); const char* nB = has_next ? (const char*)g.Bt + (size_t)nxt.pn * tstep : cB;
        if constexpr (GATHER) { if (has_next) {
#pragma unroll
            for (int h = 0; h < 2; ++h)
#pragma unroll
                for (int i = 0; i < 2; ++i) vAn[h][i] = S.a_row_off(nxt, h * HALF + rA[i]) + (unsigned)cA2[i]; } }
#pragma unroll 1
        for (int t = 0; t < nt; t += 2) {
            const bool last = (t == nt - 2);
            asm volatile("" : "+v"(voffB[0]), "+v"(voffB[1]), "+v"(vAc[0][0]), "+v"(vAc[0][1]), "+v"(vAc[1][0]), "+v"(vAc[1][1]));
            const char* a1 = cA + (size_t)(t + 1) * kstep;
            const char* a2 = last ? nA : cA + (size_t)(t + 2) * kstep; const char* b2 = last ? nB : cB + (size_t)(t + 2) * kstep;
            const char* a3 = a2 + kstep; const char* b3 = b2 + kstep;
            unsigned vA2[2][2];
#pragma unroll
            for (int h = 0; h < 2; ++h)
#pragma unroll
                for (int i = 0; i < 2; ++i) vA2[h][i] = vAc[h][i];
            if constexpr (GATHER) { if (last) {
                asm volatile("" : "+v"(vAn[0][0]), "+v"(vAn[0][1]), "+v"(vAn[1][0]), "+v"(vAn[1][1]));
#pragma unroll
                for (int h = 0; h < 2; ++h)
#pragma unroll
                    for (int i = 0; i < 2; ++i) vA2[h][i] = vAn[h][i]; } }
            if (last && has_next) S.a_ready(nxt);
            if constexpr (SP2) {
            const int lenient = __builtin_amdgcn_readfirstlane((ui > 0 && t == 0) ? 1 : 0);
#define PG8_WAIT_V8L() asm volatile("s_cmp_eq_u32 %0, 0\n\ts_cbranch_scc0 .Lpg8skip%=\n\ts_waitcnt vmcnt(8)\n.Lpg8skip%=:\n\ts_waitcnt vmcnt(%1)" :: "s"(lenient), "i"(8 + Epi::NSTORE) : "memory", "scc")
            PG8_LDB(B0, 0, 0); PG8_LDB(B1, 0, 1); PG8_SCHED; PG8_LDA(At, 0, 0); PG8_STAGE(PG8_SA(1, 1), a1, vAc[1]);
            PG8_WAIT_V8L(); PG8_WAIT_L(0); PG8_BAR; PG8_MMA(0, 0, At, B0); PG8_MMA(0, 1, At, B1); PG8_BAR; PG8_SCHED;
            PG8_LDA(At, 0, 1); PG8_STAGE(PG8_SB(0, 0), b2, voffB); PG8_STAGE(PG8_SB(0, 1), b2 + hstep, voffB); PG8_STAGE(PG8_SA(0, 0), a2, vA2[0]);
            PG8_WAIT_V8L(); PG8_WAIT_L(0); PG8_BAR; PG8_MMA(1, 0, At, B0); PG8_MMA(1, 1, At, B1); PG8_BAR; PG8_SCHED;
            PG8_LDB(B0, 1, 0); PG8_LDB(B1, 1, 1); PG8_SCHED; PG8_LDA(At, 1, 0); PG8_STAGE(PG8_SA(0, 1), a2, vA2[1]);
            PG8_WAIT_V(8); PG8_WAIT_L(0); PG8_BAR; PG8_MMA(0, 0, At, B0); PG8_MMA(0, 1, At, B1); PG8_BAR; PG8_SCHED;
            PG8_LDA(At, 1, 1); PG8_STAGE(PG8_SB(1, 0), b3, voffB); PG8_STAGE(PG8_SB(1, 1), b3 + hstep, voffB); PG8_STAGE(PG8_SA(1, 0), a3, vA2[0]);
            PG8_WAIT_V(8); PG8_WAIT_L(0); PG8_BAR; PG8_MMA(1, 0, At, B0); PG8_MMA(1, 1, At, B1); PG8_BAR; PG8_SCHED;
#undef PG8_WAIT_V8L
            }
        }
        if constexpr (ALIGN_EPI) { if (wr == 0) PG8_BAR; }
        if constexpr (!Epi::AFTER_DRAIN) { const int le = lane_id(); E(acc, cur, wr, wc, le & 15, le >> 4); S.done(cur, ui, le); }
        if (!has_next) break;
#pragma unroll
        for (int a = 0; a < 2; ++a)
#pragma unroll
            for (int b = 0; b < 2; ++b)
#pragma unroll
                for (int m = 0; m < 4; ++m)
#pragma unroll
                    for (int n = 0; n < 2; ++n) acc[a][b][m][n] = (f32x4){0.f, 0.f, 0.f, 0.f};
        cur = nxt; cA = nA; cB = nB; ++ui;
        if constexpr (GATHER) {
#pragma unroll
            for (int h = 0; h < 2; ++h)
#pragma unroll
                for (int i = 0; i < 2; ++i) vAc[h][i] = vAn[h][i]; }
        if constexpr (ALIGN_EPI) { if (wr == 1) PG8_BAR; }
    }
    PG8_WAIT_V(0);
    if constexpr (!ALIGN_EPI) { if (wr == 0) PG8_BAR; }
    PG8_BAR;
    if constexpr (Epi::AFTER_DRAIN) { E.fused(acc, cur, wr, wc, fr, fq, lds, wid, lane); S.done(cur, ui, lane); }
#undef PG8_SA
#undef PG8_SB
#undef PG8_STAGE
#undef PG8_LDA
#undef PG8_LDB
#undef PG8_MMA
#undef PG8_CAT8
#undef PG8_WAIT_V
#undef PG8_WAIT_VN
#undef PG8_WAIT_L
#undef PG8_BAR
#undef PG8_SCHED
}
}
#define GAS __attribute__((address_space(1)))
#define LAS __attribute__((address_space(3)))
typedef unsigned short bf16;
typedef unsigned v4u __attribute__((ext_vector_type(4)));
typedef float f32x4 __attribute__((ext_vector_type(4)));
typedef short bf16x8 __attribute__((ext_vector_type(8)));
typedef GAS unsigned gu32;
typedef GAS unsigned long long gu64;
#define RLX_AGENT __ATOMIC_RELAXED, __HIP_MEMORY_SCOPE_AGENT
#define LDS_WAIT() asm volatile("s_waitcnt lgkmcnt(0)" ::: "memory")
#define VM_WAIT() asm volatile("s_waitcnt vmcnt(0)" ::: "memory")
__device__ __forceinline__ unsigned long long rt() { return __builtin_amdgcn_s_memrealtime(); }
__device__ __forceinline__ unsigned f2bf(float f) { unsigned u = __builtin_bit_cast(unsigned, f); return (u + 0x7fffu + ((u >> 16) & 1u)) >> 16; }
__device__ __forceinline__ unsigned pk2(float lo, float hi) { return f2bf(lo) | (f2bf(hi) << 16); }

#define XB_TMO      128
#define XB_XCNT(j)  (256  + 64 * (j))
#define XB_XSUB(j)  (1280 + 64 * (j))
#define XB_XGEN(j)  (2304 + 64 * (j))
#define XB_TOP      3328
#define XB_TOPGEN   3392
#define XCD_BAR_WORDS 3456
#define XB_SPIN_CAP (1u << 18)

__device__ __forceinline__ unsigned xb_ld(unsigned* p)              { return __hip_atomic_load(p, __ATOMIC_RELAXED, __HIP_MEMORY_SCOPE_AGENT); }
__device__ __forceinline__ unsigned xb_add(unsigned* p, unsigned v) { return __hip_atomic_fetch_add(p, v, __ATOMIC_RELAXED, __HIP_MEMORY_SCOPE_AGENT); }
__device__ __forceinline__ unsigned xb_xcc_id() { return (unsigned)__builtin_amdgcn_s_getreg((3 << 11) | 20) & 0xFu; }
#define XB_SPIN(cond, bar) do { unsigned _sp = 0; while (cond) { __builtin_amdgcn_s_sleep(1); \
    if ((++_sp & 255u) == 0u) { if (xb_ld(&(bar)[XB_TMO])) break; if (_sp > XB_SPIN_CAP) { atomicAdd(&(bar)[XB_TMO], 1u); break; } } } } while (0)

struct XcdBarrier {
    unsigned* bar; unsigned x; int wv;
    volatile LAS unsigned* st;
};

__device__ __forceinline__ XcdBarrier xcd_barrier_post(unsigned* bar, volatile LAS unsigned* st) {
    XcdBarrier b; b.bar = bar; b.x = xb_xcc_id(); b.st = st; b.wv = 0;
    if (threadIdx.x == 0) (void)xb_add(&bar[XB_XCNT(b.x)], 1u);
    return b;
}
__device__ __forceinline__ void xcd_barrier_complete(unsigned* bar, unsigned x, unsigned& nloc, unsigned& nx) {
    const unsigned G = gridDim.x * gridDim.y * gridDim.z;
    unsigned sum, cnt, mine, sp = 0u;
    for (;;) {
        sum = 0u; cnt = 0u; mine = 0u;
#pragma unroll
        for (unsigned j = 0; j < 16; ++j) { const unsigned c = xb_ld(&bar[XB_XCNT(j)]); sum += c; cnt += (c > 0u) ? 1u : 0u; mine = (j == x) ? c : mine; }
        if (sum == G) break;
        __builtin_amdgcn_s_sleep(1);
        if ((++sp & 255u) == 0u) { if (xb_ld(&bar[XB_TMO])) break; if (sp > XB_SPIN_CAP) { atomicAdd(&bar[XB_TMO], 1u); break; } }
    }
    nloc = mine > 0u ? mine : 1u; nx = cnt > 0u ? cnt : 1u;
}

__device__ __forceinline__ void xcd_barrier(const XcdBarrier& b) {
    asm volatile("s_waitcnt vmcnt(0)" ::: "memory");
    __syncthreads();
    if (b.wv == 0 && (int)__builtin_amdgcn_mbcnt_hi(~0u, __builtin_amdgcn_mbcnt_lo(~0u, 0u)) == 0) {
        unsigned* bar = b.bar;
        __builtin_amdgcn_s_waitcnt(0);
        unsigned nloc = b.st[0], nx = b.st[1];
        if (nloc == 0u) { xcd_barrier_complete(bar, b.x, nloc, nx); b.st[0] = nloc; b.st[1] = nx; }
        const unsigned old = xb_add(&bar[XB_XSUB(b.x)], 1u);
        const unsigned gen = old / nloc;
        if (old + 1u == (gen + 1u) * nloc) {
            __builtin_amdgcn_fence(__ATOMIC_RELEASE, "agent");
            asm volatile("s_waitcnt vmcnt(0)" ::: "memory");
            const unsigned og = xb_add(&bar[XB_TOP], 1u);
            const unsigned tg = og / nx;
            if (og + 1u == (tg + 1u) * nx) xb_add(&bar[XB_TOPGEN], 1u);
            else XB_SPIN(xb_ld(&bar[XB_TOPGEN]) == tg, bar);
            __builtin_amdgcn_fence(__ATOMIC_ACQUIRE, "agent");
            xb_add(&bar[XB_XGEN(b.x)], 1u);
            asm volatile("s_waitcnt vmcnt(0)" ::: "memory");
        } else {
            __builtin_amdgcn_fence(__ATOMIC_ACQUIRE, "agent");
            asm volatile("s_waitcnt vmcnt(0)" ::: "memory");
            XB_SPIN(xb_ld(&bar[XB_XGEN(b.x)]) == gen, bar);
        }
    }
    __syncthreads();
}


constexpr int NWAVES = 8;
constexpr int RING_BYTES = 131072;
constexpr int LDSCTL_OFF = RING_BYTES, MISC_OFF = LDSCTL_OFF + 320;
constexpr int LDS_TS_OFF = LDSCTL_OFF + 1024;
constexpr int LDS_TE_OFF = LDSCTL_OFF + 2048;
constexpr int LDS_CNT_OFF = LDSCTL_OFF + 1024 + 128;
constexpr int LDS_BYTES = 163840;

typedef short s16x4 __attribute__((ext_vector_type(4)));
typedef unsigned u32x2 __attribute__((ext_vector_type(2)));

struct Args { const float* in[20]; float* out; unsigned char* ws; unsigned mask; int bar_region; };

__device__ __forceinline__ float bflo(unsigned w) { return __uint_as_float(w << 16); }
__device__ __forceinline__ float bfhi(unsigned w) { return __uint_as_float(w & 0xffff0000u); }
__device__ __forceinline__ unsigned cvtpk(float lo, float hi) { return pg8::cvt_pk_bf16(lo, hi); }
__device__ __forceinline__ float wave_sum(float v) {
#pragma unroll
    for (int o = 1; o < 64; o <<= 1) v += __shfl_xor(v, o);
    return v;
}
__device__ __forceinline__ unsigned offb(unsigned row, unsigned ch) { return 256u * row + 16u * (ch ^ (((row & 3u) << 2) | ((row >> 2) & 3u))); }
__device__ __forceinline__ s16x4 ldtr(const LAS unsigned char* p) { return __builtin_amdgcn_ds_read_tr16_b64_v4i16((LAS s16x4*)p); }
__device__ __forceinline__ bf16x8 cat8(s16x4 a, s16x4 b) { return (bf16x8){a[0], a[1], a[2], a[3], b[0], b[1], b[2], b[3]}; }
#define MFMA16(a, b, c) __builtin_amdgcn_mfma_f32_16x16x32_bf16((a), (b), (c), 0, 0, 0)

template <int MODE> __device__ __forceinline__ int dest_row(int n) {
    if (MODE == 1) { if (n >= 1024) return n; const int hb = n & ~127, d = n & 127, jr = d & 63, half = d >> 6; return hb + 8 * (jr >> 2) + 4 * half + (jr & 3); }
    if (MODE == 2) return ((n >> 2) << 3) + (n & 3);
    if (MODE == 3) return ((n >> 2) << 3) + 4 + (n & 3);
    return n;
}
template <int MODE> __device__ __forceinline__ void p0_transpose_item(const float* W, int K, int N, bf16* WT, LAS float* scr, int item, int lane) {
    const int nblk = N / 32, kb = item / nblk, nb = item % nblk, k0 = 64 * kb, n0 = 32 * nb;
    {
        const GAS f32x4* src = (const GAS f32x4*)(W + (size_t)(k0 + (lane >> 3)) * N + n0) + (lane & 7);
        f32x4 t[8];
#pragma unroll
        for (int j = 0; j < 8; ++j) t[j] = src[(size_t)j * 2 * N];
#pragma unroll
        for (int j = 0; j < 8; ++j) { LAS float* d = scr + ((lane >> 3) + 8 * j) * 33 + 4 * (lane & 7); d[0] = t[j].x; d[1] = t[j].y; d[2] = t[j].z; d[3] = t[j].w; }
    }
    LDS_WAIT(); asm volatile("" ::: "memory");
    const int c = lane & 7;
#pragma unroll
    for (int j = 0; j < 4; ++j) { const int n = (lane >> 3) + 8 * j; const LAS float* s = scr + (8 * c) * 33 + n;
        v4u o; o.x = pk2(s[0 * 33], s[1 * 33]); o.y = pk2(s[2 * 33], s[3 * 33]); o.z = pk2(s[4 * 33], s[5 * 33]); o.w = pk2(s[6 * 33], s[7 * 33]);
        *(GAS v4u*)(WT + (size_t)dest_row<MODE>(n0 + n) * K + k0 + 8 * c) = o; }
    LDS_WAIT(); asm volatile("" ::: "memory");
}
__device__ __forceinline__ unsigned pk_fp8x4(float a, float b, float c, float d) {
    a = fminf(fmaxf(a, -448.f), 448.f); b = fminf(fmaxf(b, -448.f), 448.f); c = fminf(fmaxf(c, -448.f), 448.f); d = fminf(fmaxf(d, -448.f), 448.f);
    unsigned w = 0u; w = __builtin_amdgcn_cvt_pk_fp8_f32(a, b, w, false); w = __builtin_amdgcn_cvt_pk_fp8_f32(c, d, w, true); return w;
}
__device__ __forceinline__ v4u fp8x8_to_bf16x8(u32x2 w) { typedef float f2_ __attribute__((ext_vector_type(2)));
    const f2_ a0 = __builtin_amdgcn_cvt_pk_f32_fp8(w.x, false), a1 = __builtin_amdgcn_cvt_pk_f32_fp8(w.x, true), a2 = __builtin_amdgcn_cvt_pk_f32_fp8(w.y, false), a3 = __builtin_amdgcn_cvt_pk_f32_fp8(w.y, true);
    v4u o; o.x = cvtpk(a0[0], a0[1]); o.y = cvtpk(a1[0], a1[1]); o.z = cvtpk(a2[0], a2[1]); o.w = cvtpk(a3[0], a3[1]); return o; }
template <int MODE> __device__ __forceinline__ void p0_transpose_item_fp8(const float* W, int K, int N, unsigned char* WT, LAS float* scr, int item, int lane, float scale) {
    const int nblk = N / 32, kb = item / nblk, nb = item % nblk, k0 = 64 * kb, n0 = 32 * nb;
    {
        const GAS f32x4* src = (const GAS f32x4*)(W + (size_t)(k0 + (lane >> 3)) * N + n0) + (lane & 7);
        f32x4 t[8];
#pragma unroll
        for (int j = 0; j < 8; ++j) t[j] = src[(size_t)j * 2 * N];
#pragma unroll
        for (int j = 0; j < 8; ++j) { LAS float* d = scr + ((lane >> 3) + 8 * j) * 33 + 4 * (lane & 7); d[0] = t[j].x; d[1] = t[j].y; d[2] = t[j].z; d[3] = t[j].w; }
    }
    LDS_WAIT(); asm volatile("" ::: "memory");
    const int c = lane & 7;
#pragma unroll
    for (int j = 0; j < 4; ++j) { const int n = (lane >> 3) + 8 * j; const LAS float* s = scr + (8 * c) * 33 + n;
        u32x2 o; o.x = pk_fp8x4(s[0 * 33] * scale, s[1 * 33] * scale, s[2 * 33] * scale, s[3 * 33] * scale); o.y = pk_fp8x4(s[4 * 33] * scale, s[5 * 33] * scale, s[6 * 33] * scale, s[7 * 33] * scale);
        *(GAS u32x2*)(WT + (size_t)dest_row<MODE>(n0 + n) * K + k0 + 8 * c) = o; }
    LDS_WAIT(); asm volatile("" ::: "memory");
}
__device__ __forceinline__ int t5_bucket(int rel) {
    const int n = rel < 0 ? -rel : rel;
    int large = 8 + (n >= 15) + (n >= 27) + (n >= 50) + (n >= 91) + (n >= 166) + (n >= 305) + (n >= 559);
    large = large < 15 ? large : 15;
    return (rel > 0 ? 16 : 0) + (n < 8 ? n : large);
}
__device__ __forceinline__ void p0_prologue(const Args& a, LAS unsigned char* lds, int vcu, int G, int tid, int wave, int lane) {
    unsigned char* ws = a.ws;
    LAS float* scr = (LAS float*)(lds + wave * 16384);
    const int gw = vcu * NWAVES + wave, NGW = G * NWAVES;
    constexpr int I_IN = 16 * 208, I_R = 16 * 32, I_A = 8 * 32, I_O = 16 * 32;
    constexpr int NITEMS = I_IN + I_R + I_A + I_O;
    for (int it = gw; it < NITEMS; it += NGW) {
        int r = it;
#if P1_FP8
        if (r < I_IN) { if ((GATE_FP8 || r % 208 < 144) && r % 208 >= 8 * P1_FP8_FROM) p0_transpose_item_fp8<1>(a.in[1], 1024, 6656, ws + WS_WIN8, scr, r, lane, 64.f);
                        else p0_transpose_item<1>(a.in[1], 1024, 6656, (bf16*)(ws + WS_WIN), scr, r, lane); continue; } r -= I_IN;
#else
        if (r < I_IN) { p0_transpose_item<1>(a.in[1], 1024, 6656, (bf16*)(ws + WS_WIN), scr, r, lane); continue; } r -= I_IN;
#endif
        if (r < I_R) { if (MIX_FP8 & 4) p0_transpose_item_fp8<0>(a.in[5], 1024, 1024, ws + WS_WR, scr, r, lane, 64.f); else p0_transpose_item<0>(a.in[5], 1024, 1024, (bf16*)(ws + WS_WR), scr, r, lane); continue; } r -= I_R;
        if (r < I_A) { if (MIX_FP8 & 2) p0_transpose_item_fp8<0>(a.in[7], 512, 1024, ws + WS_WA, scr, r, lane, 64.f); else p0_transpose_item<0>(a.in[7], 512, 1024, (bf16*)(ws + WS_WA), scr, r, lane); continue; } r -= I_A;
        if (MIX_FP8 & 1) p0_transpose_item_fp8<0>(a.in[8], 1024, 1024, ws + WS_WO, scr, r, lane, 64.f); else p0_transpose_item<0>(a.in[8], 1024, 1024, (bf16*)(ws + WS_WO), scr, r, lane);
    }
    {
        const f32x4* x4 = (const f32x4*)a.in[0]; u32x2* xb = (u32x2*)(ws + WS_XB);
#if P1_FP8
#if GATE_FP8
        unsigned* xf8 = (unsigned*)(ws + WS_X8_LO);
#define XF8_AT(i) xf8[(long)(i) + ((i) >= (size_t)16384 * 256 ? ((long)WS_X8_HI - (long)WS_X8_LO - (long)(16 * MiB)) / 4 : 0L)]
#else
        unsigned* xf8 = (unsigned*)a.out;
#define XF8_AT(i) xf8[i]
#endif
        const size_t n4 = (size_t)TT * DM / 4, st = (size_t)G * 512; size_t i = (size_t)vcu * 512 + tid;
        for (; i + 7 * st < n4; i += 8 * st) {
            f32x4 v[8];
#pragma unroll
            for (int u = 0; u < 8; ++u) v[u] = x4[i + u * st];
#pragma unroll
            for (int u = 0; u < 8; ++u) { if (!X_F32_RES) { u32x2 o; o.x = cvtpk(v[u].x, v[u].y); o.y = cvtpk(v[u].z, v[u].w); xb[i + u * st] = o; } XF8_AT(i + u * st) = pk_fp8x4(v[u].x, v[u].y, v[u].z, v[u].w); }
        }
        for (; i < n4; i += st) { const f32x4 v = x4[i]; if (!X_F32_RES) { u32x2 o; o.x = cvtpk(v.x, v.y); o.y = cvtpk(v.z, v.w); xb[i] = o; } XF8_AT(i) = pk_fp8x4(v.x, v.y, v.z, v.w); }
#undef XF8_AT
#else
        for (size_t i = (size_t)vcu * 512 + tid; i < (size_t)TT * DM / 4; i += (size_t)G * 512) { const f32x4 v = x4[i]; u32x2 o; o.x = cvtpk(v.x, v.y); o.y = cvtpk(v.z, v.w); xb[i] = o; }
#endif
    }
    {
        float* rot = (float*)(ws + WS_ROT);
        for (int idx = vcu * 512 + tid; idx < SEQ * 64; idx += G * 512) {
            const int pos = idx >> 6, jr = idx & 63;
            double iv = 1.0; for (int k = 0; k < jr; ++k) iv *= 0.86596432336006535;
            const float ang = (float)pos * (float)iv;
            const double xx = (double)ang; const double qd = __builtin_rint(xx * 0.63661977236758134); const int qi = (int)qd;
            const double r = (xx - qd * 1.5707963267948966) - qd * 6.123233995736766e-17, r2 = r * r;
            const double sp = r * (1.0 + r2 * (-1.0 / 6 + r2 * (1.0 / 120 + r2 * (-1.0 / 5040 + r2 * (1.0 / 362880 + r2 * (-1.0 / 39916800 + r2 * (1.0 / 6227020800.0)))))));
            const double cp = 1.0 + r2 * (-0.5 + r2 * (1.0 / 24 + r2 * (-1.0 / 720 + r2 * (1.0 / 40320 + r2 * (-1.0 / 3628800 + r2 * (1.0 / 479001600.0))))));
            const int qq = qi & 3; const double s = qq == 0 ? sp : (qq == 1 ? cp : (qq == 2 ? -sp : -cp)), c = qq == 0 ? cp : (qq == 1 ? -sp : (qq == 2 ? -cp : sp));
            float* o = rot + ((size_t)pos * 16 + (jr >> 2)) * 8 + (jr & 3); o[0] = (float)c; o[4] = (float)s;
        }
    }
    if (vcu == 0) {
        float* bt = (float*)(ws + WS_BIAS); const float* rb = a.in[6];
        for (int idx = tid; idx < 3 * 8 * 160; idx += 512) { const int p = idx / (8 * 160), h = (idx / 160) % 8, d = idx % 160 - 80; const int dil = p == 0 ? 1 : (p == 1 ? 4 : 16);
            bt[idx] = (d >= -64 && d <= 64) ? rb[t5_bucket(d * dil) * 8 + h] * 1.4426950408889634f : -1e30f; }
    }
}
__device__ __forceinline__ void p0_expert_weights(const Args& a, LAS unsigned char* lds, int vcu, int G, int wave, int lane) {
    unsigned char* ws = a.ws;
    LAS float* scr = (LAS float*)(lds + wave * 16384);
    const int gw = vcu * NWAVES + wave, NGW = G * NWAVES;
    constexpr int I_G = 16 * 16, I_D = 8 * 32, PER_E = 2 * I_G + I_D;
    for (int it = gw; it < 16 * PER_E; it += NGW) {
        const int e = it / PER_E; int r = it - e * PER_E;
#if M1_FP8
        if (r < I_G) { p0_transpose_item_fp8<2>(a.in[15] + (size_t)e * 1024 * 512, 1024, 512, ws + WS_WGU + (size_t)e * 1024 * 1024, scr, r, lane, 64.f); continue; } r -= I_G;
        if (r < I_G) { p0_transpose_item_fp8<3>(a.in[16] + (size_t)e * 1024 * 512, 1024, 512, ws + WS_WGU + (size_t)e * 1024 * 1024, scr, r, lane, 64.f); continue; } r -= I_G;
#else
        if (r < I_G) { p0_transpose_item<2>(a.in[15] + (size_t)e * 1024 * 512, 1024, 512, (bf16*)(ws + WS_WGU) + (size_t)e * 1024 * 1024, scr, r, lane); continue; } r -= I_G;
        if (r < I_G) { p0_transpose_item<3>(a.in[16] + (size_t)e * 1024 * 512, 1024, 512, (bf16*)(ws + WS_WGU) + (size_t)e * 1024 * 1024, scr, r, lane); continue; } r -= I_G;
#endif
        p0_transpose_item_fp8<0>(a.in[17] + (size_t)e * 512 * 1024, 512, 1024, ws + WS_WD + (size_t)e * 1024 * 512, scr, r, lane, 64.f);
    }
    __syncthreads();
}

__device__ __forceinline__ float log2_gamma(const float* dec, int h) {
    const float x = dec[h]; return -__log2f(1.f + __expf(-x));
}
__device__ __forceinline__ void chain_item(const Args& a, LAS unsigned char* lds, int item, int tid, int wid, int lane) {
    unsigned char* ws = a.ws;
    const int b = item >> 4, h = (item >> 2) & 3, dir = (item >> 1) & 1, vh = item & 1;
    const float lg2 = log2_gamma(dir ? a.in[3] : a.in[2], h);
    const float cd = __builtin_amdgcn_exp2f(lg2 * 128.f);
    const int g = lane >> 4, i16 = lane & 15, q = i16 >> 2, p = lane & 3;
    const int wd = wid >> 1, wv = wid & 1;
    const GAS bf16* kr = (const GAS bf16*)(ws + WS_KR); const GAS bf16* vr = (const GAS bf16*)(ws + WS_VR);
    GAS bf16* states = (GAS bf16*)a.out;
    f32x4 acc[2][4];
#pragma unroll
    for (int i = 0; i < 2; ++i)
#pragma unroll
        for (int j = 0; j < 4; ++j) acc[i][j] = (f32x4){0.f, 0.f, 0.f, 0.f};
    const int srow = tid >> 4, sch = tid & 15; const unsigned soff = offb(srow, sch);
    const GAS bf16* kp = kr + ((size_t)b * SEQ + srow) * 512 + h * 128 + sch * 8;
    const GAS bf16* vp = vr + ((size_t)b * SEQ + srow) * 1024 + h * 256 + vh * 128 + sch * 8;
    v4u kq[4], vq[4];
    { const int n0 = dir ? 15 : 0;
#pragma unroll
      for (int j = 0; j < 4; ++j) { kq[j] = *(const GAS v4u*)(kp + (size_t)(n0 * 128 + 32 * j) * 512); vq[j] = *(const GAS v4u*)(vp + (size_t)(n0 * 128 + 32 * j) * 1024); } }
    unsigned abase[2][2], bbase[4][2];
#pragma unroll
    for (int t = 0; t < 2; ++t) { const unsigned r = 8 * g + 4 * t + q;
#pragma unroll
        for (int dt = 0; dt < 2; ++dt) abase[dt][t] = offb(r, 2 * (2 * wd + dt) + (p >> 1)) + 8 * (p & 1);
#pragma unroll
        for (int vt = 0; vt < 4; ++vt) bbase[vt][t] = offb(r, 2 * (4 * wv + vt) + (p >> 1)) + 8 * (p & 1); }
#define CH_STAGE(BUFOFF) do { _Pragma("unroll") for (int j = 0; j < 4; ++j) { \
            const int row = srow + 32 * j; const float z = __builtin_amdgcn_exp2f(lg2 * (float)(dir ? row : 127 - row)); const v4u kv = kq[j]; \
            v4u ko; ko.x = cvtpk(bflo(kv.x) * z, bfhi(kv.x) * z); ko.y = cvtpk(bflo(kv.y) * z, bfhi(kv.y) * z); ko.z = cvtpk(bflo(kv.z) * z, bfhi(kv.z) * z); ko.w = cvtpk(bflo(kv.w) * z, bfhi(kv.w) * z); \
            *(LAS v4u*)(lds + (BUFOFF) + soff + j * 8192) = ko; *(LAS v4u*)(lds + (BUFOFF) + 32768 + soff + j * 8192) = vq[j]; } } while (0)
#define CH_FETCH(NN) do { _Pragma("unroll") for (int j = 0; j < 4; ++j) { kq[j] = *(const GAS v4u*)(kp + (size_t)((NN) * 128 + 32 * j) * 512); vq[j] = *(const GAS v4u*)(vp + (size_t)((NN) * 128 + 32 * j) * 1024); } } while (0)
#define CH_STEP(STEP, CUR, OTH) do { const int step_ = (STEP); const int n_ = dir ? 15 - step_ : step_; \
        GAS bf16* sb_ = states + ((((size_t)(b * 4 + h) * 16 + n_) * 2 + dir) * 256) * 128; \
        _Pragma("unroll") for (int dt = 0; dt < 2; ++dt) _Pragma("unroll") for (int vt = 0; vt < 4; ++vt) { \
            const int v_ = vh * 128 + 64 * wv + 16 * vt + i16, d0_ = 32 * wd + 16 * dt + 4 * g; \
            if (STATE_FP8) { *(GAS unsigned*)((GAS unsigned char*)states + (((((size_t)(b * 4 + h) * 16 + n_) * 2 + dir) * 256) + v_) * 128 + d0_) = pg8::fp8x4_sat(acc[dt][vt][0] * 16.f, acc[dt][vt][1] * 16.f, acc[dt][vt][2] * 16.f, acc[dt][vt][3] * 16.f); }   \
            else { u32x2 w_; w_.x = pg8::cvt_pk_bf16_acc(acc[dt][vt][0], acc[dt][vt][1]); w_.y = pg8::cvt_pk_bf16_acc(acc[dt][vt][2], acc[dt][vt][3]);   \
            *(GAS u32x2*)(sb_ + (size_t)v_ * 128 + d0_) = w_; } } \
        if (step_ < 15) CH_STAGE(OTH); \
        if (step_ < 14) CH_FETCH(dir ? 13 - step_ : step_ + 2); \
        _Pragma("unroll") for (int i = 0; i < 2; ++i) _Pragma("unroll") for (int j = 0; j < 4; ++j) acc[i][j] = acc[i][j] * cd; \
        _Pragma("unroll") for (int ks = 0; ks < 4; ++ks) { bf16x8 af[2], bfr[4]; \
            _Pragma("unroll") for (int dt = 0; dt < 2; ++dt) af[dt] = cat8(ldtr(lds + (CUR) + abase[dt][0] + ks * 8192), ldtr(lds + (CUR) + abase[dt][1] + ks * 8192)); \
            _Pragma("unroll") for (int vt = 0; vt < 4; ++vt) bfr[vt] = cat8(ldtr(lds + (CUR) + 32768 + bbase[vt][0] + ks * 8192), ldtr(lds + (CUR) + 32768 + bbase[vt][1] + ks * 8192)); \
            _Pragma("unroll") for (int dt = 0; dt < 2; ++dt) _Pragma("unroll") for (int vt = 0; vt < 4; ++vt) acc[dt][vt] = MFMA16(af[dt], bfr[vt], acc[dt][vt]); } \
        __syncthreads(); } while (0)
    CH_STAGE(0);
    CH_FETCH(dir ? 14 : 1);
    __syncthreads();
    for (int sp = 0; sp < 8; ++sp) { CH_STEP(2 * sp, 0, 65536); CH_STEP(2 * sp + 1, 65536, 0); }
#undef CH_STEP
#undef CH_STAGE
#undef CH_FETCH
}

constexpr int AT_OST = 135168, AT_SCR = AT_OST + 8 * 2048;
constexpr int ATB_N = 160;
struct AttnLane { unsigned kb[2]; unsigned vb[4]; };
__device__ __forceinline__ AttnLane attn_lane(int lane) {
    const int g = lane >> 4, i16 = lane & 15, q4 = i16 >> 2, p = lane & 3; AttnLane L;
#pragma unroll
    for (int s = 0; s < 2; ++s) L.kb[s] = i16 * 128 + (((4 * s + g) ^ ((i16 >> 1) & 7)) * 16);
    const int sw = (2 * g + (q4 >> 1)) & 3;
#pragma unroll
    for (int c = 0; c < 4; ++c) L.vb[c] = (4 * g + q4) * 128 + ((c ^ sw) * 32) + p * 8;
    return L;
}
__device__ __forceinline__ unsigned kimg_off(int row, int c) { return row * 128 + ((c ^ ((row >> 1) & 7)) * 16); }
__device__ __forceinline__ unsigned vimg_off(int row, int c) { return row * 128 + (((c >> 1) ^ ((row >> 1) & 3)) * 32) + (c & 1) * 16; }
__device__ __forceinline__ void attn_core(const LAS unsigned char* Kimg, const LAS unsigned char* Vimg, int R0, int nrows, unsigned tvalid, const bf16x8 (&qf)[2],
                                          const float (&biasr)[36], const AttnLane& L, f32x4 (&O)[4], float& mx, float& lsum) {
    f32x4 D[9];
#pragma unroll
    for (int kt = 0; kt < 9; ++kt) {
        int R = R0 + 16 * kt; R = R < 0 ? 0 : (R > nrows - 16 ? nrows - 16 : R);
        const LAS unsigned char* kp = Kimg + R * 128;
        const bf16x8 k0 = *(const LAS bf16x8*)(kp + L.kb[0]), k1 = *(const LAS bf16x8*)(kp + L.kb[1]);
        f32x4 d = (f32x4){0.f, 0.f, 0.f, 0.f};
        d = MFMA16(k0, qf[0], d); d = MFMA16(k1, qf[1], d); D[kt] = d;
    }
    mx = -1e30f;
#pragma unroll
    for (int kt = 0; kt < 9; ++kt) {
        const float tb = ((tvalid >> kt) & 1u) ? 0.f : -1e30f;
#pragma unroll
        for (int r = 0; r < 4; ++r) { const float x = D[kt][r] + (biasr[4 * kt + r] + tb); D[kt][r] = x; mx = fmaxf(mx, x); }
    }
    mx = fmaxf(mx, __shfl_xor(mx, 16)); mx = fmaxf(mx, __shfl_xor(mx, 32));
    lsum = 0.f;
#pragma unroll
    for (int kt = 0; kt < 9; ++kt)
#pragma unroll
        for (int r = 0; r < 4; ++r) { const float e = __builtin_amdgcn_exp2f(D[kt][r] - mx); D[kt][r] = e; lsum += e; }
    lsum += __shfl_xor(lsum, 16); lsum += __shfl_xor(lsum, 32);
#pragma unroll
    for (int c = 0; c < 4; ++c) O[c] = (f32x4){0.f, 0.f, 0.f, 0.f};
#pragma unroll
    for (int kk = 0; kk < 5; ++kk) {
        int Ra = R0 + 32 * kk; Ra = Ra < 0 ? 0 : (Ra > nrows - 16 ? nrows - 16 : Ra);
        int Rb = R0 + 32 * kk + 16; Rb = Rb < 0 ? 0 : (Rb > nrows - 16 ? nrows - 16 : Rb);
        if (kk == 4) Rb = Ra;
        const f32x4 e0 = D[2 * kk], e1 = kk < 4 ? D[2 * kk + 1] : (f32x4){0.f, 0.f, 0.f, 0.f};
        v4u pw; pw.x = cvtpk(e0[0], e0[1]); pw.y = cvtpk(e0[2], e0[3]); pw.z = cvtpk(e1[0], e1[1]); pw.w = cvtpk(e1[2], e1[3]);
        const bf16x8 pf = __builtin_bit_cast(bf16x8, pw);
        const LAS unsigned char* va_ = Vimg + Ra * 128; const LAS unsigned char* vb_ = Vimg + Rb * 128;
#pragma unroll
        for (int c = 0; c < 4; ++c) O[c] = MFMA16(pf, cat8(ldtr(va_ + L.vb[c]), ldtr(vb_ + L.vb[c])), O[c]);
    }
}
__device__ __forceinline__ void attn_stage_out(LAS unsigned char* lds, int wid, int lane, const f32x4 (&O)[4], float lsum) {
    const int g = lane >> 4, i16 = lane & 15;
    const float linv = 1.f / lsum;
    LAS bf16* st = (LAS bf16*)(lds + AT_OST + wid * 2048);
#pragma unroll
    for (int r = 0; r < 4; ++r) { const float li = __shfl(linv, 4 * g + r);
#pragma unroll
        for (int c = 0; c < 4; ++c) st[(4 * g + r) * 64 + 16 * c + i16] = (bf16)(cvtpk(O[c][r] * li, 0.f) & 0xffffu); }
}
__device__ __forceinline__ void attn_load_bias(const Args& a, int pat, int h, int lane, float (&biasr)[36]) {
    const GAS float* bt = (const GAS float*)(a.ws + WS_BIAS) + (pat * 8 + h) * ATB_N; const int g = lane >> 4, i16 = lane & 15;
#pragma unroll
    for (int kt = 0; kt < 9; ++kt)
#pragma unroll
        for (int r = 0; r < 4; ++r) biasr[4 * kt + r] = bt[16 * kt + 4 * g + r - 64 - i16 + 80];
}
#if ATT_FP8
typedef u32x2 att_raw_t;
#define ATT_LD(base, off) (*(const GAS u32x2*)((const GAS unsigned char*)(base) + (off)))
#define ATT_WIDE(r) fp8x8_to_bf16x8(r)
#define ATT_ZERO ((u32x2){0u, 0u})
#else
typedef v4u att_raw_t;
#define ATT_LD(base, off) (*(const GAS v4u*)((base) + (off)))
#define ATT_WIDE(r) (r)
#define ATT_ZERO ((v4u){0u, 0u, 0u, 0u})
#endif
template <int DIL, int VAR = 0> __device__ __forceinline__ void attn_dil_phase(const Args& a, LAS unsigned char* lds, int vcu, int G, int tid, int wid, int lane) {
    unsigned char* ws = a.ws;
    constexpr int NR = SEQ / DIL, PAT = DIL == 4 ? 1 : 2, CH = NR * 8 / 512, NITEM = NB * 8 * DIL;
    constexpr int NBUF = DIL == 16 ? 2 : 1, BUFB = 2 * NR * 128;
    const GAS bf16* qa = (const GAS bf16*)(ws + WS_QA); const GAS bf16* ka = (const GAS bf16*)(ws + WS_KA); const GAS bf16* va = (const GAS bf16*)(ws + WS_VA);
    bf16* op = (bf16*)(ws + (DIL == 4 ? WS_O2 : WS_O3)); float* lsep = (float*)(ws + (DIL == 4 ? WS_LSE2 : WS_LSE3));
    if (vcu >= NITEM) return;
    const int h = vcu & 7;
    float biasr[36]; attn_load_bias(a, PAT, h, lane, biasr);
    const AttnLane L = attn_lane(lane);
    const int g = lane >> 4, i16 = lane & 15;
    att_raw_t kq[CH], vq[CH], qn[2];
    auto issue = [&](int item, int gi) {
        const int rho = (item >> 3) % DIL, b = item / (8 * DIL); const size_t rowb = (size_t)b * SEQ;
#pragma unroll
        for (int j = 0; j < CH; ++j) { const int id = tid + 512 * j, row = id >> 3, c = id & 7; const size_t go = (rowb + (size_t)row * DIL + rho) * 512 + h * 64 + c * 8;
            kq[j] = ATT_LD(ka, go); vq[j] = ATT_LD(va, go); }
        const size_t qpos = rowb + (size_t)(16 * gi + i16) * DIL + rho;
#pragma unroll
        for (int s = 0; s < 2; ++s) qn[s] = ATT_LD(qa, qpos * 512 + h * 64 + 32 * s + 8 * g);
    };
    issue(vcu, wid);
    int buf = 0;
    for (int item = vcu; item < NITEM; item += G) {
        const int rho = (item >> 3) % DIL, b = item / (8 * DIL); const size_t rowb = (size_t)b * SEQ;
        LAS unsigned char* Kimg = lds + buf * BUFB; LAS unsigned char* Vimg = Kimg + NR * 128;
        if (NBUF == 1) __syncthreads();
#pragma unroll
        for (int j = 0; j < CH; ++j) { const int id = tid + 512 * j, row = id >> 3, c = id & 7;
            *(LAS v4u*)(Kimg + kimg_off(row, c)) = ATT_WIDE(kq[j]); *(LAS v4u*)(Vimg + vimg_off(row, c)) = ATT_WIDE(vq[j]); }
        bf16x8 qf[2] = {__builtin_bit_cast(bf16x8, ATT_WIDE(qn[0])), __builtin_bit_cast(bf16x8, ATT_WIDE(qn[1]))};
        __syncthreads();
        if (NBUF == 2 && item + G < NITEM) issue(item + G, wid);
        for (int gi = wid; gi < NR / 16; gi += 8) {
            const int m0 = 16 * gi;
            if (NBUF == 1 && gi + 8 < NR / 16) {
                const size_t qpos = rowb + (size_t)(m0 + 128 + i16) * DIL + rho;
#pragma unroll
                for (int s = 0; s < 2; ++s) qn[s] = ATT_LD(qa, qpos * 512 + h * 64 + 32 * s + 8 * g); }
            unsigned tvalid = 0u;
#pragma unroll
            for (int kt = 0; kt < 9; ++kt) { const int t0 = m0 - 64 + 16 * kt; tvalid |= (t0 >= 0 && t0 < NR) ? (1u << kt) : 0u; }
            f32x4 O[4]; float mx, lsum;
            if (VAR == 1) { mx = 0.f; lsum = 1.f;
#pragma unroll
                for (int c = 0; c < 4; ++c) O[c] = (f32x4){__builtin_bit_cast(float, qf[0][0] + c), 0.f, 0.f, 0.f}; }
            else attn_core(Kimg, Vimg, m0 - 64, NR, tvalid, qf, biasr, L, O, mx, lsum);
            attn_stage_out(lds, wid, lane, O, lsum);
            if (g == 0) lsep[(rowb + (size_t)(m0 + i16) * DIL + rho) * 8 + h] = mx + __log2f(lsum);
            asm volatile("s_waitcnt lgkmcnt(0)" ::: "memory");
            { const int q = lane >> 2, qt = lane & 3; const LAS v4u* sp = (const LAS v4u*)(lds + AT_OST + wid * 2048 + q * 128 + qt * 32);
              const v4u x0 = sp[0], x1 = sp[1];
#if O23_FP8
              v4u o8;
              o8.x = pk_fp8x4(16.f * bflo(x0.x), 16.f * bfhi(x0.x), 16.f * bflo(x0.y), 16.f * bfhi(x0.y)); o8.y = pk_fp8x4(16.f * bflo(x0.z), 16.f * bfhi(x0.z), 16.f * bflo(x0.w), 16.f * bfhi(x0.w));
              o8.z = pk_fp8x4(16.f * bflo(x1.x), 16.f * bfhi(x1.x), 16.f * bflo(x1.y), 16.f * bfhi(x1.y)); o8.w = pk_fp8x4(16.f * bflo(x1.z), 16.f * bfhi(x1.z), 16.f * bflo(x1.w), 16.f * bfhi(x1.w));
              *(v4u*)((unsigned char*)op + (rowb + (size_t)(m0 + q) * DIL + rho) * 512 + h * 64 + qt * 16) = o8; }
#else
              bf16* dst = op + (rowb + (size_t)(m0 + q) * DIL + rho) * 512 + h * 64 + qt * 16;
              *(v4u*)dst = x0; *(v4u*)(dst + 8) = x1; }
#endif
            asm volatile("s_waitcnt lgkmcnt(0)" ::: "memory");
            if (NBUF == 1) { qf[0] = __builtin_bit_cast(bf16x8, ATT_WIDE(qn[0])); qf[1] = __builtin_bit_cast(bf16x8, ATT_WIDE(qn[1])); }
        }
        if (NBUF == 1 && item + G < NITEM) issue(item + G, wid);
        buf ^= (NBUF - 1);
    }
    __syncthreads();
}
__device__ __forceinline__ void attn_p1_phase(const Args& a, LAS unsigned char* lds, int vcu, int G, int tid, int wid, int lane) {
    unsigned char* ws = a.ws;
    LAS unsigned char* Kimg = lds; LAS unsigned char* Vimg = lds + 384 * 128;
    const GAS bf16* qa = (const GAS bf16*)(ws + WS_QA); const GAS bf16* ka = (const GAS bf16*)(ws + WS_KA); const GAS bf16* va = (const GAS bf16*)(ws + WS_VA);
    const GAS bf16* o2 = (const GAS bf16*)(ws + WS_O2); const GAS bf16* o3 = (const GAS bf16*)(ws + WS_O3);
    const GAS float* lse2 = (const GAS float*)(ws + WS_LSE2); const GAS float* lse3 = (const GAS float*)(ws + WS_LSE3);
    bf16* oa = (bf16*)(ws + WS_OA);
    if (vcu >= 1024) return;
    const int h = vcu & 7;
    float biasr[36]; attn_load_bias(a, 0, h, lane, biasr);
    const AttnLane L = attn_lane(lane);
    const int g = lane >> 4, i16 = lane & 15;
    LAS float* scr = (LAS float*)(lds + AT_SCR) + wid * 16;
    att_raw_t kq[6], vq[6];
    auto issue = [&](int item) { const int b = item >> 6, s0 = ((item >> 3) & 7) * 256; const size_t rowb = (size_t)b * SEQ;
#pragma unroll
        for (int j = 0; j < 6; ++j) { const int id = tid + 512 * j, row = id >> 3, c = id & 7, pos = s0 - 64 + row; const bool ok = pos >= 0 && pos < SEQ;
            const size_t go = (rowb + (size_t)(ok ? pos : 0)) * 512 + h * 64 + c * 8;
            kq[j] = ATT_LD(ka, go); vq[j] = ATT_LD(va, go);
            if (!ok) { kq[j] = ATT_ZERO; vq[j] = ATT_ZERO; } } };
    issue(vcu);
    for (int item = vcu; item < 1024; item += G) {
        const int b = item >> 6, s0 = ((item >> 3) & 7) * 256; const size_t rowb = (size_t)b * SEQ;
        __syncthreads();
#pragma unroll
        for (int j = 0; j < 6; ++j) { const int id = tid + 512 * j, row = id >> 3, c = id & 7;
            *(LAS v4u*)(Kimg + kimg_off(row, c)) = ATT_WIDE(kq[j]); *(LAS v4u*)(Vimg + vimg_off(row, c)) = ATT_WIDE(vq[j]); }
        __syncthreads();
        if (item + G < 1024) issue(item + G);
        for (int gi = wid; gi < 16; gi += 8) {
            const int m0 = s0 + 16 * gi;
            const int q = lane >> 2, qt = lane & 3; const size_t tq = rowb + m0 + q;
#if O23_FP8
            const v4u a2q = *(const GAS v4u*)((const GAS unsigned char*)o2 + tq * 512 + h * 64 + qt * 16), a3q = *(const GAS v4u*)((const GAS unsigned char*)o3 + tq * 512 + h * 64 + qt * 16);
#else
            const v4u a20 = *(const GAS v4u*)(o2 + tq * 512 + h * 64 + qt * 16), a21 = *(const GAS v4u*)(o2 + tq * 512 + h * 64 + qt * 16 + 8);
            const v4u a30 = *(const GAS v4u*)(o3 + tq * 512 + h * 64 + qt * 16), a31 = *(const GAS v4u*)(o3 + tq * 512 + h * 64 + qt * 16 + 8);
#endif
            const float l2 = lse2[tq * 8 + h], l3 = lse3[tq * 8 + h];
            bf16x8 qf[2];
#pragma unroll
            for (int s = 0; s < 2; ++s) qf[s] = __builtin_bit_cast(bf16x8, ATT_WIDE(ATT_LD(qa, (rowb + m0 + i16) * 512 + h * 64 + 32 * s + 8 * g)));
            unsigned tvalid = 0u;
#pragma unroll
            for (int kt = 0; kt < 9; ++kt) { const int t0 = m0 - 64 + 16 * kt; tvalid |= (t0 >= 0 && t0 < SEQ) ? (1u << kt) : 0u; }
            f32x4 O[4]; float mx, lsum;
            attn_core(Kimg, Vimg, 16 * gi, 384, tvalid, qf, biasr, L, O, mx, lsum);
            attn_stage_out(lds, wid, lane, O, lsum);
            if (g == 0) scr[i16] = mx + __log2f(lsum);
            asm volatile("s_waitcnt lgkmcnt(0)" ::: "memory");
            {
                const float l1 = scr[q], M = fmaxf(l1, fmaxf(l2, l3));
                float w1 = __builtin_amdgcn_exp2f(l1 - M), w2 = __builtin_amdgcn_exp2f(l2 - M), w3 = __builtin_amdgcn_exp2f(l3 - M); const float wi = 1.f / (w1 + w2 + w3); w1 *= wi; w2 *= wi; w3 *= wi;
                const LAS v4u* sp = (const LAS v4u*)(lds + AT_OST + wid * 2048 + q * 128 + qt * 32);
                const v4u x0 = sp[0], x1 = sp[1];
                v4u r0, r1;
#if O23_FP8
                { typedef float f2_ __attribute__((ext_vector_type(2))); const float w2s = w2 * 0.0625f, w3s = w3 * 0.0625f;
#define MRG8(d, x, yw, zw, hi) { const f2_ y_ = __builtin_amdgcn_cvt_pk_f32_fp8(yw, hi), z_ = __builtin_amdgcn_cvt_pk_f32_fp8(zw, hi); d = cvtpk(w1 * bflo(x) + w2s * y_[0] + w3s * z_[0], w1 * bfhi(x) + w2s * y_[1] + w3s * z_[1]); }
                MRG8(r0.x, x0.x, a2q.x, a3q.x, false) MRG8(r0.y, x0.y, a2q.x, a3q.x, true) MRG8(r0.z, x0.z, a2q.y, a3q.y, false) MRG8(r0.w, x0.w, a2q.y, a3q.y, true)
                MRG8(r1.x, x1.x, a2q.z, a3q.z, false) MRG8(r1.y, x1.y, a2q.z, a3q.z, true) MRG8(r1.z, x1.z, a2q.w, a3q.w, false) MRG8(r1.w, x1.w, a2q.w, a3q.w, true)
#undef MRG8
                }
#else
#define MRG(d, x, y, z) d = cvtpk(w1 * bflo(x) + w2 * bflo(y) + w3 * bflo(z), w1 * bfhi(x) + w2 * bfhi(y) + w3 * bfhi(z))
                MRG(r0.x, x0.x, a20.x, a30.x); MRG(r0.y, x0.y, a20.y, a30.y); MRG(r0.z, x0.z, a20.z, a30.z); MRG(r0.w, x0.w, a20.w, a30.w);
                MRG(r1.x, x1.x, a21.x, a31.x); MRG(r1.y, x1.y, a21.y, a31.y); MRG(r1.z, x1.z, a21.z, a31.z); MRG(r1.w, x1.w, a21.w, a31.w);
#undef MRG
#endif
#if MIX_FP8 & 2
                v4u o8;
                o8.x = pk_fp8x4(16.f * bflo(r0.x), 16.f * bfhi(r0.x), 16.f * bflo(r0.y), 16.f * bfhi(r0.y)); o8.y = pk_fp8x4(16.f * bflo(r0.z), 16.f * bfhi(r0.z), 16.f * bflo(r0.w), 16.f * bfhi(r0.w));
                o8.z = pk_fp8x4(16.f * bflo(r1.x), 16.f * bfhi(r1.x), 16.f * bflo(r1.y), 16.f * bfhi(r1.y)); o8.w = pk_fp8x4(16.f * bflo(r1.z), 16.f * bfhi(r1.z), 16.f * bflo(r1.w), 16.f * bfhi(r1.w));
                *(v4u*)((unsigned char*)oa + tq * 512 + h * 64 + qt * 16) = o8;
#else
                bf16* dst = oa + tq * 512 + h * 64 + qt * 16;
                *(v4u*)dst = r0; *(v4u*)(dst + 8) = r1;
#endif
            }
            asm volatile("s_waitcnt lgkmcnt(0)" ::: "memory");
        }
    }
    __syncthreads();
}

#define OPAQUE(x) asm volatile("" : "+v"(x))
template <int VAR = 0> __device__ __forceinline__ void p3_phase(const Args& a, LAS unsigned char* lds, int vcu, int G, int tid, int wid, int lane) {
    unsigned char* ws = a.ws;
    const int g = lane >> 4, i16 = lane & 15, q4 = i16 >> 2, p = lane & 3;
    const GAS bf16* qr = (const GAS bf16*)(ws + WS_QR); const GAS bf16* kr = (const GAS bf16*)(ws + WS_KR); const GAS bf16* vr = (const GAS bf16*)(ws + WS_VR);
    GAS bf16* gr = (GAS bf16*)(ws + WS_GR);
    LAS unsigned char* Kt = lds; LAS unsigned char* Sg = lds + 32768;
    if (vcu >= 1024) return;
    const unsigned kdst = offb(tid >> 4, tid & 15);
    unsigned rfo[4];
    { const unsigned X = ((i16 & 3) << 2) | (i16 >> 2);
#pragma unroll
      for (int s = 0; s < 4; ++s) rfo[s] = 256 * i16 + 16 * (((4 * s) ^ (X & 12)) | (g ^ (X & 3))); }
    v4u sreg[8], kreg[4]; bf16x8 qn[4];
    auto item_ptrs = [&](int item, size_t& tok0, const GAS bf16*& sf, int& h) { const int b = item >> 6; h = (item >> 4) & 3; const int n = item & 15; tok0 = (size_t)b * SEQ + n * 128;
        sf = (const GAS bf16*)((const GAS unsigned char*)a.out + ((((size_t)(b * 4 + h) * 16 + n) * 2 + 0) * 256) * 128 * (STATE_FP8 ? 1 : 2)); };
    auto issue_k = [&](int item) { size_t tok0; const GAS bf16* sf; int h; item_ptrs(item, tok0, sf, h);
        const GAS bf16* ks_ = kr + (tok0 + (tid >> 4)) * 512 + h * 128 + (tid & 15) * 8;
#pragma unroll
        for (int j = 0; j < 4; ++j) kreg[j] = *(const GAS v4u*)(ks_ + (size_t)j * 32 * 512); };
    auto issue_q = [&](int item) { size_t tok0; const GAS bf16* sf; int h; item_ptrs(item, tok0, sf, h);
#pragma unroll
        for (int s = 0; s < 4; ++s) qn[s] = *(const GAS bf16x8*)(qr + (tok0 + 16 * wid + i16) * 512 + h * 128 + 32 * s + 8 * g); };
#if STATE_FP8
    auto issue_state = [&](const GAS bf16* sf, int dirn) { const GAS unsigned char* sld = (const GAS unsigned char*)sf + (size_t)dirn * 256 * 128 + (size_t)(tid >> 4) * 128 + (tid & 15) * 8;
#pragma unroll
        for (int j = 0; j < 4; ++j) { const u32x2 lo = *(const GAS u32x2*)(sld + (size_t)(2 * j) * 32 * 128), hi = *(const GAS u32x2*)(sld + (size_t)(2 * j + 1) * 32 * 128); sreg[j] = (v4u){lo.x, lo.y, hi.x, hi.y}; } };
    auto write_state = [&]() {
#pragma unroll
        for (int j = 0; j < 8; ++j) { typedef float f2_ __attribute__((ext_vector_type(2)));
            const unsigned w0 = (j & 1) ? sreg[j >> 1].z : sreg[j >> 1].x, w1 = (j & 1) ? sreg[j >> 1].w : sreg[j >> 1].y;
            const f2_ a0 = __builtin_amdgcn_cvt_pk_f32_fp8(w0, false), a1 = __builtin_amdgcn_cvt_pk_f32_fp8(w0, true), a2 = __builtin_amdgcn_cvt_pk_f32_fp8(w1, false), a3 = __builtin_amdgcn_cvt_pk_f32_fp8(w1, true);
            v4u o; o.x = cvtpk(a0[0], a0[1]); o.y = cvtpk(a1[0], a1[1]); o.z = cvtpk(a2[0], a2[1]); o.w = cvtpk(a3[0], a3[1]);
            *(LAS v4u*)(Sg + (j >> 2) * 32768 + kdst + (j & 3) * 8192) = o; asm volatile("" ::: "memory"); } };
#else
    auto issue_state = [&](const GAS bf16* sf, int dirn) { const GAS bf16* sld = sf + (size_t)dirn * 256 * 128 + (size_t)(tid >> 4) * 128 + (tid & 15) * 8;
#pragma unroll
        for (int j = 0; j < 8; ++j) sreg[j] = *(const GAS v4u*)(sld + (size_t)j * 32 * 128); };
    auto write_state = [&]() {
#pragma unroll
        for (int j = 0; j < 8; ++j) *(LAS v4u*)(Sg + (j >> 2) * 32768 + kdst + (j & 3) * 8192) = sreg[j]; };
#endif
    { size_t tok0; const GAS bf16* sf; int h; item_ptrs(vcu, tok0, sf, h); issue_k(vcu); issue_q(vcu); issue_state(sf, 0); }
#pragma unroll
    for (int j = 0; j < 4; ++j) *(LAS v4u*)(Kt + kdst + j * 8192) = kreg[j];
    for (int item = vcu; item < 1024; item += G) {
        size_t tok0; const GAS bf16* sf; int h; item_ptrs(item, tok0, sf, h);
        const float lf2 = log2_gamma(a.in[2], h), lb2 = log2_gamma(a.in[3], h);
        bf16x8 qf[4];
#pragma unroll
        for (int s = 0; s < 4; ++s) qf[s] = qn[s];
        const bool has_next = item + G < 1024;
        __syncthreads();
        f32x4 D[8];
#pragma unroll
        for (int jt = 0; jt < 8; ++jt) {
            f32x4 d = (f32x4){0.f, 0.f, 0.f, 0.f};
#pragma unroll
            for (int s = 0; s < 4; ++s) { if (VAR != 1) { const bf16x8 kf = *(const LAS bf16x8*)(Kt + rfo[s] + jt * 4096); d = MFMA16(kf, qf[s], d); } else d[s] = __builtin_bit_cast(float, (int)qf[s][0]); }
            D[jt] = d;
        }
        int iq = 16 * wid + i16; OPAQUE(iq);
        bf16x8 pf[4];
#pragma unroll
        for (int ks = 0; ks < 4; ++ks) {
            float e[8];
#pragma unroll
            for (int t = 0; t < 2; ++t)
#pragma unroll
                for (int r = 0; r < 4; ++r) {
                    const int j = 16 * (2 * ks + t) + 4 * g + r; const float fdf = (float)(iq - j), ad = fabsf(fdf);
                    const float pos = fminf(fmaxf(fdf, 0.f), 1.f), isz = 1.f - fminf(ad, 1.f);
                    const float w = __builtin_amdgcn_exp2f((lb2 + (lf2 - lb2) * pos) * ad) + isz;
                    e[4 * t + r] = D[2 * ks + t][r] * w;
                }
            v4u pw; pw.x = cvtpk(e[0], e[1]); pw.y = cvtpk(e[2], e[3]); pw.z = cvtpk(e[4], e[5]); pw.w = cvtpk(e[6], e[7]);
            pf[ks] = __builtin_bit_cast(bf16x8, pw);
        }
        f32x4 acc[16];
#pragma unroll
        for (int vt = 0; vt < 16; ++vt) acc[vt] = (f32x4){0.f, 0.f, 0.f, 0.f};
#pragma unroll
        for (int dirn = 0; dirn < 2; ++dirn) {
            if (dirn == 1) __syncthreads();
            write_state();
            if (dirn == 0) { issue_state(sf, 1); if (has_next) issue_k(item + G); }
            else {
                if (has_next) {
#pragma unroll
                    for (int j = 0; j < 4; ++j) *(LAS v4u*)(Kt + kdst + j * 8192) = kreg[j]; }
                const GAS bf16* vs_ = vr + (tok0 + (tid >> 5)) * 1024 + h * 256 + (tid & 31) * 8;
#pragma unroll
                for (int j = 0; j < 8; ++j) sreg[j] = *(const GAS v4u*)(vs_ + (size_t)j * 16 * 1024);
            }
            __syncthreads();
#pragma unroll
            for (int vt = 0; vt < 16; ++vt) {
#pragma unroll
                for (int s = 0; s < 4; ++s) { if (VAR != 1) { const bf16x8 sfr = *(const LAS bf16x8*)(Sg + (vt >> 3) * 32768 + rfo[s] + (vt & 7) * 4096); acc[vt] = MFMA16(qf[s], sfr, acc[vt]); } }
            }
            float xs[4];
            { int ib = 16 * wid + 4 * g; OPAQUE(ib);
#pragma unroll
              for (int r = 0; r < 4; ++r) { const float lxf = lf2 * (float)(ib + r + 1), lxb = lb2 * (float)(128 - ib - r); xs[r] = __builtin_amdgcn_exp2f(dirn == 0 ? lxf - lxb : lxb - (STATE_FP8 ? 4.f : 0.f)); } }
#pragma unroll
            for (int vt = 0; vt < 16; ++vt)
#pragma unroll
                for (int r = 0; r < 4; ++r) acc[vt][r] *= xs[r];
        }
        __syncthreads();
        { int t2 = tid; OPAQUE(t2); const unsigned vd2 = (unsigned)((t2 & 31) >> 4) * 32768u + offb(t2 >> 5, t2 & 15);
#pragma unroll
          for (int j = 0; j < 8; ++j) *(LAS v4u*)(Sg + vd2 + j * 4096) = sreg[j]; }
        GAS bf16* gp = gr + (tok0 + 16 * wid + (lane >> 5)) * 1024 + h * 256 + (lane & 31) * 8;
#if MIX_FP8 & 4
        GAS unsigned char* ar8 = (GAS unsigned char*)(ws + WS_AR8) + (tok0 + 16 * wid + (lane >> 5)) * 1024 + h * 256 + (lane & 31) * 8;
#endif
        __syncthreads();
        unsigned vbs[8];
        { int l2 = lane; OPAQUE(l2); const unsigned g2 = l2 >> 4, q2 = (l2 & 15) >> 2, p2 = l2 & 3, X = (q2 << 2) | g2;
#pragma unroll
          for (int c = 0; c < 8; ++c) vbs[c] = 256 * (4 * g2 + q2) + 16 * (((2 * c) ^ (X & 14)) | ((p2 >> 1) ^ (X & 1))) + 8 * (p2 & 1); }
#pragma unroll
        for (int vt = 0; vt < 16; ++vt) {
#pragma unroll
            for (int ks = 0; ks < 4; ++ks) { if (VAR != 1) {
                const s16x4 lo = ldtr(Sg + vbs[vt & 7] + (vt >> 3) * 32768 + ks * 8192), hi = ldtr(Sg + vbs[vt & 7] + (vt >> 3) * 32768 + ks * 8192 + 4096);
                acc[vt] = MFMA16(pf[ks], cat8(lo, hi), acc[vt]); }
            }
            asm volatile("" ::: "memory");
        }
        float mu[4], rs[4];
#pragma unroll
        for (int r = 0; r < 4; ++r) {
            float s = 0.f;
#pragma unroll
            for (int vt = 0; vt < 16; ++vt) s += acc[vt][r];
            s += __shfl_xor(s, 1); s += __shfl_xor(s, 2); s += __shfl_xor(s, 4); s += __shfl_xor(s, 8);
            const float m = s * (1.f / 256.f); float qv = 0.f;
#pragma unroll
            for (int vt = 0; vt < 16; ++vt) { const float d = acc[vt][r] - m; qv += d * d; }
            qv += __shfl_xor(qv, 1); qv += __shfl_xor(qv, 2); qv += __shfl_xor(qv, 4); qv += __shfl_xor(qv, 8);
            mu[r] = m; rs[r] = 1.f / sqrtf(qv * (1.f / 256.f) + LN_EPSF);
        }
        v4u greg[8];
#pragma unroll
        for (int j = 0; j < 8; ++j) greg[j] = *(const GAS v4u*)(gp + (size_t)j * 2048);
        __syncthreads();
        if (has_next) { size_t tk; const GAS bf16* sfn; int hn; item_ptrs(item + G, tk, sfn, hn); issue_state(sfn, 0); issue_q(item + G); }
        LAS bf16* st = (LAS bf16*)(Sg + wid * 8192);
        { LAS bf16* sp_ = st + (4 * g) * 256 + i16;
#pragma unroll
          for (int vt = 0; vt < 16; ++vt)
#pragma unroll
              for (int r = 0; r < 4; ++r) sp_[r * 256 + 16 * vt] = (bf16)(cvtpk((acc[vt][r] - mu[r]) * rs[r], 0.f) & 0xffffu); }
        asm volatile("s_waitcnt lgkmcnt(0)" ::: "memory");
        {
            const float* gn = a.in[4] + h * 256; const int ch = lane & 31;
            const f32x4 g0 = *(const f32x4*)(gn + ch * 8), g1 = *(const f32x4*)(gn + ch * 8 + 4);
            const LAS bf16* yp = st + (lane >> 5) * 256 + ch * 8;
#pragma unroll
            for (int j = 0; j < 8; ++j) {
                const v4u y = *(const LAS v4u*)(yp + j * 512); const v4u sg = greg[j];
#if SILU_IN_P3
#define GSW(w, hi) pg8::fsilu((hi) ? bfhi(w) : bflo(w))
#else
#define GSW(w, hi) ((hi) ? bfhi(w) : bflo(w))
#endif
                v4u o; o.x = cvtpk(bflo(y.x) * g0[0] * GSW(sg.x, 0), bfhi(y.x) * g0[1] * GSW(sg.x, 1)); o.y = cvtpk(bflo(y.y) * g0[2] * GSW(sg.y, 0), bfhi(y.y) * g0[3] * GSW(sg.y, 1));
                o.z = cvtpk(bflo(y.z) * g1[0] * GSW(sg.z, 0), bfhi(y.z) * g1[1] * GSW(sg.z, 1)); o.w = cvtpk(bflo(y.w) * g1[2] * GSW(sg.w, 0), bfhi(y.w) * g1[3] * GSW(sg.w, 1));
#undef GSW
#if MIX_FP8 & 4
                u32x2 o8; o8.x = pk_fp8x4(bflo(o.x), bfhi(o.x), bflo(o.y), bfhi(o.y)); o8.y = pk_fp8x4(bflo(o.z), bfhi(o.z), bflo(o.w), bfhi(o.w));
                *(GAS u32x2*)(ar8 + (size_t)j * 2048) = o8;
#else
                *(GAS v4u*)(gp + (size_t)j * 2048) = o;
#endif
            }
        }
        __syncthreads();
    }
}

constexpr int P6_RS = 81920, P6_CNT = P6_RS + 8 * 512, P6_BASE = P6_CNT + 64, P6_ROW = P6_BASE + 64;
#define P6_BUTTERFLY(lg, out) do { float r10[10], r5[5], r3[3], r2[2]; const float z = 0.f; \
    _Pragma("unroll") for (int k = 0; k < 10; ++k) { const float keep = h32 ? lg[10 + k] : lg[k], send = h32 ? lg[k] : lg[10 + k]; r10[k] = keep + __shfl_xor(send, 32); } \
    _Pragma("unroll") for (int k = 0; k < 5; ++k) { const float keep = h16 ? r10[5 + k] : r10[k], send = h16 ? r10[k] : r10[5 + k]; r5[k] = keep + __shfl_xor(send, 16); } \
    { const float keep = h8 ? r5[3] : r5[0], send = h8 ? r5[0] : r5[3]; r3[0] = keep + __shfl_xor(send, 8); } \
    { const float keep = h8 ? r5[4] : r5[1], send = h8 ? r5[1] : r5[4]; r3[1] = keep + __shfl_xor(send, 8); } \
    { const float keep = h8 ? z : r5[2], send = h8 ? r5[2] : z; r3[2] = keep + __shfl_xor(send, 8); } \
    { const float keep = h4 ? r3[2] : r3[0], send = h4 ? r3[0] : r3[2]; r2[0] = keep + __shfl_xor(send, 4); } \
    { const float keep = h4 ? z : r3[1], send = h4 ? r3[1] : z; r2[1] = keep + __shfl_xor(send, 4); } \
    { const float keep = h2 ? r2[1] : r2[0], send = h2 ? r2[0] : r2[1]; out = keep + __shfl_xor(send, 2); } \
    out += __shfl_xor(out, 1); } while (0)
__device__ __forceinline__ void p6a_phase(const Args& a, LAS unsigned char* lds, int vcu, int G, int tid, int wave, int lane) {
    unsigned char* ws = a.ws;
    LAS float* RW = (LAS float*)lds;
    LAS float* RS = (LAS float*)(lds + P6_RS) + wave * 128;
    LAS unsigned* LC = (LAS unsigned*)(lds + P6_CNT); LAS unsigned* LB = (LAS unsigned*)(lds + P6_BASE); LAS unsigned* LR = (LAS unsigned*)(lds + P6_ROW);
    {
        const f32x4* wgp = (const f32x4*)a.in[11]; const f32x4* wep = (const f32x4*)a.in[13];
        f32x4 gq[2], eq[8];
#pragma unroll
        for (int u = 0; u < 2; ++u) gq[u] = wgp[tid + 512 * u];
#pragma unroll
        for (int u = 0; u < 8; ++u) eq[u] = wep[tid + 512 * u];
#pragma unroll
        for (int u = 0; u < 2; ++u) { const int c = tid + 512 * u;
#pragma unroll
            for (int k = 0; k < 4; ++k) RW[k * 1024 + c] = gq[u][k]; }
#pragma unroll
        for (int u = 0; u < 8; ++u) { const int q = tid + 512 * u, c = q >> 2, k4 = q & 3;
#pragma unroll
            for (int k = 0; k < 4; ++k) RW[(4 + 4 * k4 + k) * 1024 + c] = eq[u][k]; }
    }
    const u32x2* pre = (const u32x2*)a.out; u32x2* x1b = (u32x2*)(ws + WS_XB); [[maybe_unused]] unsigned* x1f8 = (unsigned*)(ws + WS_X1F8);
    gu32* ctl = (gu32*)ws;
    int* ltok = (int*)(ws + WS_LTOK); float* tw = (float*)(ws + WS_WSLOT); unsigned* tinfo = (unsigned*)(ws + WS_TINFO);
    const float* g1 = a.in[9]; const float* b1 = a.in[10];
    const bool h32 = (lane & 32) != 0, h16 = (lane & 16) != 0, h8 = (lane & 8) != 0, h4 = (lane & 4) != 0, h2 = (lane & 2) != 0;
#define P6_LOADROW(dst, t_) do { const u32x2* xr_ = pre + (size_t)(t_) * 256 + lane; _Pragma("unroll") for (int j = 0; j < 4; ++j) dst[j] = xr_[64 * j]; } while (0)
#define P6_LN(v, nx, s) do { s = 0.f; _Pragma("unroll") for (int j = 0; j < 4; ++j) { v[j] = (f32x4){bflo(nx[j].x), bfhi(nx[j].x), bflo(nx[j].y), bfhi(nx[j].y)}; s += (v[j].x + v[j].y) + (v[j].z + v[j].w); } } while (0)
#define P6_VAR(v, mean, q) do { q = 0.f; _Pragma("unroll") for (int j = 0; j < 4; ++j) { v[j] = v[j] - mean; q += (v[j].x * v[j].x + v[j].y * v[j].y) + (v[j].z * v[j].z + v[j].w * v[j].w); } } while (0)
#if M1_FP8
#define P6_STORE(v, t_, j) do { u32x2 o_; o_.x = cvtpk(v[j].x, v[j].y); o_.y = cvtpk(v[j].z, v[j].w); x1b[(size_t)(t_) * 256 + lane + 64 * j] = o_; x1f8[(size_t)(t_) * 256 + lane + 64 * j] = pk_fp8x4(v[j].x, v[j].y, v[j].z, v[j].w); } while (0)
#else
#define P6_STORE(v, t_, j) do { u32x2 o_; o_.x = cvtpk(v[j].x, v[j].y); o_.y = cvtpk(v[j].z, v[j].w); x1b[(size_t)(t_) * 256 + lane + 64 * j] = o_; } while (0)
#endif
#define P6_DOT(lg, v, j, k, w) lg[k] += (v[j][0] * w[0] + v[j][1] * w[1]) + (v[j][2] * w[2] + v[j][3] * w[3])
    for (int blk = vcu; blk < TT / 128; blk += G) {
        if (tid < 16) LC[tid] = 0u;
        __syncthreads();
        const int t0 = blk * 128;
        u32x2 nxA[4], nxB[4], nxC[4], nxD[4];
        P6_LOADROW(nxA, t0 + wave); P6_LOADROW(nxB, t0 + wave + 8); P6_LOADROW(nxC, t0 + wave + 16); P6_LOADROW(nxD, t0 + wave + 24);
        for (int rr = 0; rr < 4; ++rr) {
            const int rl0 = wave + 32 * rr, tA = t0 + rl0, tB = tA + 8, tC = tA + 16, tD = tA + 24;
            f32x4 vA[4], vB[4], vC[4], vD[4]; float sA, sB, sC, sD;
            P6_LN(vA, nxA, sA); P6_LN(vB, nxB, sB); P6_LN(vC, nxC, sC); P6_LN(vD, nxD, sD);
            if (rr < 3) { P6_LOADROW(nxA, tA + 32); P6_LOADROW(nxB, tB + 32); P6_LOADROW(nxC, tC + 32); P6_LOADROW(nxD, tD + 32); }
            const float mA = wave_sum(sA) * (1.f / DM), mB = wave_sum(sB) * (1.f / DM), mC = wave_sum(sC) * (1.f / DM), mD = wave_sum(sD) * (1.f / DM);
            float qA, qB, qC, qD;
            P6_VAR(vA, mA, qA); P6_VAR(vB, mB, qB); P6_VAR(vC, mC, qC); P6_VAR(vD, mD, qD);
            const float rA = 1.f / sqrtf(wave_sum(qA) * (1.f / DM) + LN_EPSF), rB = 1.f / sqrtf(wave_sum(qB) * (1.f / DM) + LN_EPSF);
            const float rC = 1.f / sqrtf(wave_sum(qC) * (1.f / DM) + LN_EPSF), rD = 1.f / sqrtf(wave_sum(qD) * (1.f / DM) + LN_EPSF);
            typedef float f32x2p __attribute__((ext_vector_type(2)));
            f32x2p lgAB[20], lgCD[20];
#pragma unroll
            for (int k = 0; k < 20; ++k) { lgAB[k] = (f32x2p){0.f, 0.f}; lgCD[k] = (f32x2p){0.f, 0.f}; }
#pragma unroll
            for (int j = 0; j < 4; ++j) {
                const f32x4 gg = *(const f32x4*)(g1 + 4 * lane + 256 * j), bb = *(const f32x4*)(b1 + 4 * lane + 256 * j);
                vA[j] = vA[j] * rA * gg + bb; vB[j] = vB[j] * rB * gg + bb; vC[j] = vC[j] * rC * gg + bb; vD[j] = vD[j] * rD * gg + bb;
                P6_STORE(vA, tA, j); P6_STORE(vB, tB, j); P6_STORE(vC, tC, j); P6_STORE(vD, tD, j);
                f32x2p pab[4], pcd[4];
#pragma unroll
                for (int e = 0; e < 4; ++e) { pab[e] = (f32x2p){vA[j][e], vB[j][e]}; pcd[e] = (f32x2p){vC[j][e], vD[j][e]}; }
#pragma unroll
                for (int k = 0; k < 20; ++k) { const f32x4 w = *(const LAS f32x4*)(RW + k * 1024 + 4 * lane + 256 * j);
#pragma unroll
                    for (int e = 0; e < 4; ++e) { const f32x2p ww = (f32x2p){w[e], w[e]};
                        lgAB[k] = __builtin_elementwise_fma(pab[e], ww, lgAB[k]); lgCD[k] = __builtin_elementwise_fma(pcd[e], ww, lgCD[k]); } }
            }
            float lgA[20], lgB[20], lgC[20], lgD[20];
#pragma unroll
            for (int k = 0; k < 20; ++k) { lgA[k] = lgAB[k].x; lgB[k] = lgAB[k].y; lgC[k] = lgCD[k].x; lgD[k] = lgCD[k].y; }
            float r1A, r1B, r1C, r1D;
            P6_BUTTERFLY(lgA, r1A); P6_BUTTERFLY(lgB, r1B); P6_BUTTERFLY(lgC, r1C); P6_BUTTERFLY(lgD, r1D);
            {
                const int i3 = h2 ? (h4 ? -1 : 1) : (h4 ? 2 : 0);
                const int i5 = i3 < 0 ? -1 : (h8 ? (i3 == 2 ? -1 : i3 + 3) : i3);
                const int kk = i5 < 0 ? -1 : (h32 ? 10 : 0) + (h16 ? 5 : 0) + i5;
                if (kk >= 0 && (lane & 1) == 0) { RS[kk] = r1A; RS[32 + kk] = r1B; RS[64 + kk] = r1C; RS[96 + kk] = r1D; }
            }
            asm volatile("s_waitcnt lgkmcnt(0)" ::: "memory");
            {
                const int sel = lane & 3; const int rl = rl0 + 8 * sel;
                float tl[20];
#pragma unroll
                for (int k4 = 0; k4 < 5; ++k4) { const f32x4 w = *(const LAS f32x4*)(RS + sel * 32 + 4 * k4); tl[4 * k4] = w[0]; tl[4 * k4 + 1] = w[1]; tl[4 * k4 + 2] = w[2]; tl[4 * k4 + 3] = w[3]; }
                float gl[4];
#pragma unroll
                for (int k = 0; k < 4; ++k) gl[k] = tl[k] + a.in[12][k];
                int gi = 0; float gm = gl[0];
#pragma unroll
                for (int k = 1; k < 4; ++k) if (gl[k] > gm) { gm = gl[k]; gi = k; }
                float gs = 0.f;
#pragma unroll
                for (int k = 0; k < 4; ++k) gs += __expf(gl[k] - gm);
                const float gwt = 1.f / gs;
                float el[4];
#pragma unroll
                for (int k = 0; k < 4; ++k) { const float se = gi == 0 ? tl[4 + k] : (gi == 1 ? tl[8 + k] : (gi == 2 ? tl[12 + k] : tl[16 + k])); el[k] = se + a.in[14][4 * gi + k]; }
                int i1 = 0; float v1 = el[0];
#pragma unroll
                for (int k = 1; k < 4; ++k) if (el[k] > v1) { v1 = el[k]; i1 = k; }
                int i2 = (i1 + 1) & 3; float v2 = -3.0e38f;
#pragma unroll
                for (int k = 0; k < 4; ++k) if (k != i1 && el[k] > v2) { v2 = el[k]; i2 = k; }
                const float ex = __expf(v2 - v1), w1 = gwt / (1.f + ex), w2 = gwt * ex / (1.f + ex);
                if (lane < 4) {
                    const int e1 = 4 * gi + i1, e2 = 4 * gi + i2;
                    const unsigned p1 = __hip_atomic_fetch_add(LC + e1, 1u, __ATOMIC_RELAXED, __HIP_MEMORY_SCOPE_WORKGROUP);
                    const unsigned p2 = __hip_atomic_fetch_add(LC + e2, 1u, __ATOMIC_RELAXED, __HIP_MEMORY_SCOPE_WORKGROUP);
                    LR[rl * 4 + 0] = ((unsigned)e1 << 16) | p1; LR[rl * 4 + 1] = ((unsigned)e2 << 16) | p2; LR[rl * 4 + 2] = __float_as_uint(w1); LR[rl * 4 + 3] = __float_as_uint(w2);
                }
            }
            asm volatile("s_waitcnt lgkmcnt(0)" ::: "memory");
        }
        __syncthreads();
        if (tid < 16) LB[tid] = __hip_atomic_fetch_add(ctl + CW_CNT + 64 * tid, LC[tid], __ATOMIC_RELAXED, __HIP_MEMORY_SCOPE_AGENT);
        __syncthreads();
        if (tid < 256) {
            const int rl = tid >> 1, j = tid & 1; const unsigned rec = LR[rl * 4 + j]; const unsigned e = rec >> 16, pos = LB[e] + (rec & 0xffffu);
            ltok[e * TT + pos] = t0 + rl; tw[2 * (t0 + rl) + j] = __uint_as_float(LR[rl * 4 + 2 + j]); tinfo[2 * (t0 + rl) + j] = (e << 16) | pos;
        }
        __syncthreads();
    }
#undef P6_LOADROW
#undef P6_LN
#undef P6_VAR
#undef P6_STORE
#undef P6_DOT
}
__device__ __forceinline__ void build_tile_tables(const Args& a, LAS unsigned char* lds, int tid) {
    LAS int* ts = (LAS int*)(lds + LDS_TS_OFF); LAS int* te = (LAS int*)(lds + LDS_TE_OFF); LAS int* cn = (LAS int*)(lds + LDS_CNT_OFF);
    gu32* ctl = (gu32*)a.ws;
    if (tid == 0) { int acc = 0;
        for (int e = 0; e < 16; ++e) { ts[e] = acc; const int c = (int)__hip_atomic_load(ctl + CW_CNT + 64 * e, __ATOMIC_RELAXED, __HIP_MEMORY_SCOPE_AGENT); const int nt = (c + 255) >> 8; cn[e] = c;
            for (int k = 0; k < nt; ++k) te[acc + k] = e; acc += nt; }
        ts[16] = acc; }
    __syncthreads();
}
__device__ __forceinline__ void p9_phase(const Args& a, LAS unsigned char* lds, int vcu, int G, int wave, int lane) {
    unsigned char* ws = a.ws;
    const LAS int* ts = (const LAS int*)(lds + LDS_TS_OFF);
    const unsigned* tinfo = (const unsigned*)(ws + WS_TINFO); const u32x2* Y = (const u32x2*)(ws + WS_Y);
    const float* g2 = a.in[18]; const float* b2 = a.in[19];
    const int gw = vcu * NWAVES + wave, NGW = G * NWAVES;
#if Y_FP8
    const unsigned* Y8 = (const unsigned*)(ws + WS_Y); unsigned ny0[4], ny1[4]; u32x2 nxw[4]; float nw0 = 0.f, nw1 = 0.f;
#else
    u32x2 ny0[4], ny1[4], nxw[4]; float nw0 = 0.f, nw1 = 0.f;
#endif
    const float* tw = (const float*)(ws + WS_WSLOT);
    auto issue = [&](int t) {
        const unsigned i0 = tinfo[2 * t], i1 = tinfo[2 * t + 1];
        nw0 = tw[2 * t]; nw1 = tw[2 * t + 1];
        const size_t s0 = (size_t)ts[i0 >> 16] * 256 + (i0 & 0xffffu), s1 = (size_t)ts[i1 >> 16] * 256 + (i1 & 0xffffu);
        const u32x2* xb1 = (const u32x2*)(ws + WS_XB) + (size_t)t * 256 + lane;
#pragma unroll
#if Y_FP8
        for (int j = 0; j < 4; ++j) { ny0[j] = Y8[s0 * 256 + lane + 64 * j]; ny1[j] = Y8[s1 * 256 + lane + 64 * j]; nxw[j] = xb1[64 * j]; }
#else
        for (int j = 0; j < 4; ++j) { ny0[j] = Y[s0 * 256 + lane + 64 * j]; ny1[j] = Y[s1 * 256 + lane + 64 * j]; nxw[j] = xb1[64 * j]; }
#endif
    };
    if (gw < TT) issue(gw);
    for (int t = gw; t < TT; t += NGW) {
        f32x4* xr = (f32x4*)(a.out + (size_t)t * DM) + lane;
#if Y_FP8
        f32x4 v[4]; float s = 0.f; const float w0 = nw0 * 0.0625f, w1 = nw1 * 0.0625f;
#pragma unroll
        for (int j = 0; j < 4; ++j) {
            const unsigned y0 = ny0[j], y1 = ny1[j]; const u32x2 xw = nxw[j];
            typedef float f32x2_ __attribute__((ext_vector_type(2)));
            const f32x2_ a0 = __builtin_amdgcn_cvt_pk_f32_fp8(y0, false), a1 = __builtin_amdgcn_cvt_pk_f32_fp8(y0, true), c0 = __builtin_amdgcn_cvt_pk_f32_fp8(y1, false), c1 = __builtin_amdgcn_cvt_pk_f32_fp8(y1, true);
            f32x4 x = (f32x4){bflo(xw.x), bfhi(xw.x), bflo(xw.y), bfhi(xw.y)} * DN_ALPHA;
            x.x += w0 * a0[0] + w1 * c0[0]; x.y += w0 * a0[1] + w1 * c0[1]; x.z += w0 * a1[0] + w1 * c1[0]; x.w += w0 * a1[1] + w1 * c1[1];
            v[j] = x; s += (x.x + x.y) + (x.z + x.w);
        }
#else
        f32x4 v[4]; float s = 0.f; const float w0 = nw0, w1 = nw1;
#pragma unroll
        for (int j = 0; j < 4; ++j) {
            const u32x2 y0 = ny0[j], y1 = ny1[j], xw = nxw[j];
            f32x4 x = (f32x4){bflo(xw.x), bfhi(xw.x), bflo(xw.y), bfhi(xw.y)} * DN_ALPHA;
            x.x += w0 * bflo(y0.x) + w1 * bflo(y1.x); x.y += w0 * bfhi(y0.x) + w1 * bfhi(y1.x); x.z += w0 * bflo(y0.y) + w1 * bflo(y1.y); x.w += w0 * bfhi(y0.y) + w1 * bfhi(y1.y);
            v[j] = x; s += (x.x + x.y) + (x.z + x.w);
        }
#endif
        if (t + NGW < TT) issue(t + NGW);
        const float mean = wave_sum(s) * (1.f / DM); float s2 = 0.f;
#pragma unroll
        for (int j = 0; j < 4; ++j) { v[j] = v[j] - mean; s2 += (v[j].x * v[j].x + v[j].y * v[j].y) + (v[j].z * v[j].z + v[j].w * v[j].w); }
        const float rstd = 1.f / sqrtf(wave_sum(s2) * (1.f / DM) + LN_EPSF);
#pragma unroll
        for (int j = 0; j < 4; ++j) { const f32x4 gg = *(const f32x4*)(g2 + 4 * lane + 256 * j), bb = *(const f32x4*)(b2 + 4 * lane + 256 * j); xr[64 * j] = v[j] * rstd * gg + bb; }
    }
}

__global__ void __launch_bounds__(NWAVES * 64, 2) mega_fwd(Args args) {
    extern __shared__ __attribute__((aligned(16))) unsigned char lds_raw[];
    LAS unsigned char* lds = (LAS unsigned char*)lds_raw;
    volatile LAS unsigned* MISC = (volatile LAS unsigned*)(lds + MISC_OFF);
    const int tid0 = threadIdx.x, wave = __builtin_amdgcn_readfirstlane(tid0 >> 6);
    const int G = gridDim.x, bx = blockIdx.x, vcu = (G % 8 == 0) ? (bx % 8) * (G / 8) + bx / 8 : bx;
    for (int u = tid0; u < (LDS_BYTES - LDSCTL_OFF) / 4; u += NWAVES * 64) ((LAS unsigned*)(lds + LDSCTL_OFF))[u] = 0u;
    __syncthreads();
    unsigned char* ws = args.ws;
    gu32* ctl = (gu32*)ws;
    const bool bars_on = (args.mask >> 31) != 0u;
    XcdBarrier bar; bar.bar = (unsigned*)(ctl + CW_BAR) + args.bar_region * XCD_BAR_WORDS; bar.x = 0; bar.st = nullptr;
    if (bars_on) bar = xcd_barrier_post((unsigned*)(ctl + CW_BAR) + args.bar_region * XCD_BAR_WORDS, MISC + 8);
    bar.wv = wave;
#define GRID_BAR() do { if (bars_on) xcd_barrier(bar); } while (0)
#ifndef PH_LAST
#define PH_LAST 99
#endif
#define FRESH() int tid = wave * 64 + pg8::lane_id(); asm volatile("" : "+v"(tid)); const int lane = tid & 63; (void)lane
#ifndef RMASK
#define RMASK 0
#endif
#define REP(k) _Pragma("unroll") for (int rep_ = 0; rep_ < 1 + ((RMASK >> (k)) & 1); ++rep_)
#ifndef STAMP_SCALE
#define STAMP_SCALE 1.0f
#endif
#ifdef STAMP_PH
#define ST_B(k) if ((k) == STAMP_PH) { st_a = rt(); }
#define ST_E(k) if ((k) == STAMP_PH) { st_b = rt(); }
#else
#define ST_B(k)
#define ST_E(k)
#endif
#ifdef ONLY
#define EN(k) (ONLY == (k))
#else
#define EN(k) ((args.mask >> (k)) & 1u)
#endif
    unsigned long long st_a = 0, st_b = 0; (void)st_a; (void)st_b;
    REP(0) if (EN(0)) { FRESH(); p0_prologue(args, lds, vcu, G, tid, wave, lane); }
    GRID_BAR();
#ifdef STAGGER_TICKS
    if (EN(1) && (bx & 8)) { const unsigned long long t0_ = rt(); while (rt() - t0_ < STAGGER_TICKS) __builtin_amdgcn_s_sleep(32); }
#endif
    REP(1) if (EN(1)) {
#if P1_FP8
        pg8::EpiHcat E{ws, (const float*)(ws + WS_ROT), 0};
        if (P1_FP8_FROM > 0) {
            pg8::Gemm g{(const pg8::bf16_t*)(ws + WS_XB), (const pg8::bf16_t*)(ws + WS_WIN), TT, 4608, 1024}; pg8::StaticOrder S; S.init(TT, 256 * P1_FP8_FROM, G, bx);
            pg8::gemm_phase<pg8::EpiHcat, pg8::StaticOrder, true, true>(lds, g, S, E, wave);
        }
        {
#if GATE_FP8
            pg8::Gemm g{(const pg8::bf16_t*)(ws + WS_X8_LO), (const pg8::bf16_t*)(ws + WS_WIN8), TT, 4608, 512, 64, (long)WS_X8_HI - (long)WS_X8_LO - (long)(16 * MiB)}; pg8::StaticOrder S;
#else
            pg8::Gemm g{(const pg8::bf16_t*)args.out, (const pg8::bf16_t*)(ws + WS_WIN8), TT, 4608, 512}; pg8::StaticOrder S;
#endif
            S.init(TT, 4608 - 256 * P1_FP8_FROM, G, bx, P1_FP8_FROM);
#if CONV_BG
            pg8::P1Order SB; SB.S = S; SB.cv = pg8::ExpertConv{args.in[15], args.in[16], args.in[17], ws + WS_WGU, ws + WS_WD, vcu * NWAVES + wave, G * NWAVES, vcu % 9};
            pg8::gemm_phase<pg8::EpiHcat, pg8::P1Order, true, true, false, true, 1, 0>(lds, g, SB, E, wave);
            { FRESH();
              for (int k = 0; SB.cv.gw + k * SB.cv.nw < 6144; ++k) { pg8::Unit tu; const bool in_gap = k < 3 && S.next(pg8::P1Order::unit_of(SB.cv.grp, k), tu) && pg8::P1Order::unit_of(SB.cv.grp, k) < 9;
                  if (!in_gap) pg8::expert_conv_item(SB.cv, k, lane); } }
#else
            pg8::gemm_phase<pg8::EpiHcat, pg8::StaticOrder, true, true, false, true, 1, 0>(lds, g, S, E, wave);
#endif
        }
#else
        pg8::Gemm g{(const pg8::bf16_t*)(ws + WS_XB), (const pg8::bf16_t*)(ws + WS_WIN), TT, 4608, 1024}; pg8::StaticOrder S; S.init(TT, 4608, G, bx);
        pg8::EpiHcat E{ws, (const float*)(ws + WS_ROT), 0};
        pg8::gemm_phase<pg8::EpiHcat, pg8::StaticOrder, true, true>(lds, g, S, E, wave);
#endif
    }
    GRID_BAR();
    if (PH_LAST >= 2) {
        REP(2) if (EN(2)) { FRESH(); for (int it = vcu; it < 256; it += G) chain_item(args, lds, it, tid, wave, lane); }
        if (EN(3)) { { FRESH(); attn_dil_phase<16>(args, lds, vcu, G, tid, wave, lane); }
                     { FRESH(); attn_dil_phase<4>(args, lds, vcu, G, tid, wave, lane); } }
    }
    GRID_BAR();
    ST_B(4) if (PH_LAST >= 3 && EN(4)) { FRESH(); p3_phase<0>(args, lds, vcu, G, tid, wave, lane); }
    if (EN(13)) { FRESH(); attn_p1_phase(args, lds, vcu, G, tid, wave, lane); }
    GRID_BAR(); ST_E(4)
#if !CONV_BG
    if (EN(14)) { FRESH(); p0_expert_weights(args, lds, vcu, G, wave, lane); }
#endif
    REP(5) if (PH_LAST >= 4 && EN(5)) {
        pg8::GateOrder S; S.S4.init(TT, 1024, G, bx);
        pg8::EpiHcat E{ws, (const float*)(ws + WS_ROT), 18};
#if GATE_FP8
        pg8::Gemm g{(const pg8::bf16_t*)(ws + WS_X8_LO), (const pg8::bf16_t*)(ws + WS_WIN8 + (size_t)4608 * 1024), TT, 2048, 512, 64, (long)WS_X8_HI - (long)WS_X8_LO - (long)(16 * MiB)};
        pg8::gemm_phase<pg8::EpiHcat, pg8::GateOrder, true, true, false, true, 1, 0>(lds, g, S, E, wave);
#else
        pg8::Gemm g{(const pg8::bf16_t*)(ws + WS_XB), (const pg8::bf16_t*)(ws + WS_WIN) + (size_t)4608 * 1024, TT, 2048, 1024};
        pg8::gemm_phase<pg8::EpiHcat, pg8::GateOrder, true, true>(lds, g, S, E, wave);
#endif
        asm volatile("s_waitcnt vmcnt(0)" ::: "memory"); __syncthreads();
    }
    REP(6) if (PH_LAST >= 5 && EN(6)) {
        pg8::StaticOrder S; S.init(TT, 1024, G, bx);
        { pg8::EpiGate<false> E{(const pg8::bf16_t*)(ws + WS_GATE_A), (pg8::bf16_t*)(ws + WS_MERGED), nullptr};
#if MIX_FP8 & 2
          pg8::Gemm g{(const pg8::bf16_t*)(ws + WS_OA), (const pg8::bf16_t*)(ws + WS_WA), TT, 1024, 256};
          pg8::gemm_phase<pg8::EpiGate<false>, pg8::StaticOrder, true, true, false, true, 1, 3>(lds, g, S, E, wave);
#else
          pg8::Gemm g{(const pg8::bf16_t*)(ws + WS_OA), (const pg8::bf16_t*)(ws + WS_WA), TT, 1024, 512};
          pg8::gemm_phase<pg8::EpiGate<false>, pg8::StaticOrder, true, true>(lds, g, S, E, wave);
#endif
        }
        asm volatile("s_waitcnt vmcnt(0)" ::: "memory"); __syncthreads();
        { typedef pg8::EpiGate<true, (MIX_FP8 & 1) != 0> EpiC;
          EpiC E{(const pg8::bf16_t*)(ws + WS_GATE_R), (pg8::bf16_t*)(ws + WS_MERGED), ws + WS_MERGED8};
#if MIX_FP8 & 4
          pg8::Gemm g{(const pg8::bf16_t*)(ws + WS_AR8), (const pg8::bf16_t*)(ws + WS_WR), TT, 1024, 512};
          pg8::gemm_phase<EpiC, pg8::StaticOrder, true, true, false, true, 1, 0>(lds, g, S, E, wave);
#else
          pg8::Gemm g{(const pg8::bf16_t*)(ws + WS_GR), (const pg8::bf16_t*)(ws + WS_WR), TT, 1024, 1024};
          pg8::gemm_phase<EpiC, pg8::StaticOrder, true, true>(lds, g, S, E, wave);
#endif
        }
    }
    GRID_BAR();
    REP(7) if (PH_LAST >= 6 && EN(7)) {
        pg8::StaticOrder S; S.init(TT, 1024, G, bx);
        pg8::EpiResBf16 E{X_F32_RES ? (const pg8::bf16_t*)args.in[0] : (const pg8::bf16_t*)(ws + WS_XB), (pg8::bf16_t*)args.out, DN_ALPHA};
#if MIX_FP8 & 1
        pg8::Gemm g{(const pg8::bf16_t*)(ws + WS_MERGED8), (const pg8::bf16_t*)(ws + WS_WO), TT, 1024, 512};
        pg8::gemm_phase<pg8::EpiResBf16, pg8::StaticOrder, true, true, false, true, 1, 3>(lds, g, S, E, wave);
#else
        pg8::Gemm g{(const pg8::bf16_t*)(ws + WS_MERGED), (const pg8::bf16_t*)(ws + WS_WO), TT, 1024, 1024};
        pg8::gemm_phase<pg8::EpiResBf16, pg8::StaticOrder, true, true>(lds, g, S, E, wave);
#endif
    }
    GRID_BAR();
    ST_B(8) if (PH_LAST >= 7 && EN(8)) { FRESH(); p6a_phase(args, lds, vcu, G, tid, wave, lane); }
    GRID_BAR(); ST_E(8)
    { FRESH(); build_tile_tables(args, lds, tid); }
    const int nrt = ((const LAS int*)(lds + LDS_TS_OFF))[16];
    REP(10) if (PH_LAST >= 9 && EN(10)) {
#if M1_FP8
        pg8::Gemm g{(const pg8::bf16_t*)(ws + WS_X1F8), (const pg8::bf16_t*)(ws + WS_WGU), MAXSLOT, 1024, 512};
        pg8::MoeOrder S{nrt * 4, G, vcu, (const LAS int*)(lds + LDS_TE_OFF), (const LAS int*)(lds + LDS_TS_OFF), (const LAS int*)(lds + LDS_CNT_OFF), (const int*)(ws + WS_LTOK), 1024u};
        pg8::EpiSwiGLU E{ws + WS_H};
        pg8::gemm_phase<pg8::EpiSwiGLU, pg8::MoeOrder, true, true, true, true, 1, 0>(lds, g, S, E, wave);
#else
        pg8::Gemm g{(const pg8::bf16_t*)(ws + WS_XB), (const pg8::bf16_t*)(ws + WS_WGU), MAXSLOT, 1024, 1024};
        pg8::MoeOrder S{nrt * 4, G, vcu, (const LAS int*)(lds + LDS_TE_OFF), (const LAS int*)(lds + LDS_TS_OFF), (const LAS int*)(lds + LDS_CNT_OFF), (const int*)(ws + WS_LTOK), 2048u};
        pg8::EpiSwiGLU E{ws + WS_H};
        pg8::gemm_phase<pg8::EpiSwiGLU, pg8::MoeOrder, true, true, true>(lds, g, S, E, wave);
#endif
    }
    GRID_BAR();
    REP(11) if (PH_LAST >= 10 && EN(11)) {
        pg8::Gemm g{(const pg8::bf16_t*)(ws + WS_H), (const pg8::bf16_t*)(ws + WS_WD), MAXSLOT, 1024, 256};
        pg8::MoeOrder S{nrt * 4, G, vcu, (const LAS int*)(lds + LDS_TE_OFF), (const LAS int*)(lds + LDS_TS_OFF), (const LAS int*)(lds + LDS_CNT_OFF), (const int*)(ws + WS_LTOK), 1024u};
        pg8::EpiRowScale E{(pg8::bf16_t*)(ws + WS_Y)};
        pg8::gemm_phase<pg8::EpiRowScale, pg8::MoeOrder, true, true, false, true, 1, 2>(lds, g, S, E, wave);
    }
    GRID_BAR();
    ST_B(12) if (PH_LAST >= 11 && EN(12)) { FRESH(); p9_phase(args, lds, vcu, G, wave, lane); }
#ifdef STAMP_PH
    GRID_BAR(); ST_E(12)
    if (STAMP_PH == 13) { st_a = rt(); GRID_BAR(); GRID_BAR(); GRID_BAR(); GRID_BAR(); st_b = rt(); }
    if (bx == 0 && tid0 == 0) { const float us = (float)(st_b - st_a) * 0.01f * STAMP_SCALE; int k = 0; float lim = 30.f; while (us >= lim && k < 12) { lim *= 1.5f; ++k; }
        __hip_atomic_store(ctl + CW_CHK, __float_as_uint(sqrtf(2.f * k + 2.f)), RLX_AGENT); }
    GRID_BAR();
    { const float c = __uint_as_float(__hip_atomic_load(ctl + CW_CHK, RLX_AGENT)); f32x4* o4 = (f32x4*)args.out;
      for (size_t i = (size_t)bx * 512 + tid0; i < (size_t)TT * DM / 4; i += (size_t)G * 512) o4[i] = (f32x4){c, c, c, c}; }
#endif
}

#ifdef PROBE_VAR
__global__ void __launch_bounds__(NWAVES * 64, 2) probe_kernel(Args args) {
    extern __shared__ __attribute__((aligned(16))) unsigned char lds_raw[];
    LAS unsigned char* lds = (LAS unsigned char*)lds_raw;
    const int tid0 = threadIdx.x, wave = __builtin_amdgcn_readfirstlane(tid0 >> 6);
    const int G = gridDim.x, bx = blockIdx.x, vcu = (G % 8 == 0) ? (bx % 8) * (G / 8) + bx / 8 : bx;
    FRESH();
    if (PROBE_VAR >= 20 && PROBE_VAR <= 22) {
        unsigned char* ws = args.ws;
        pg8::Gemm g{(const pg8::bf16_t*)(ws + WS_X8_LO), (const pg8::bf16_t*)(ws + WS_WIN8), TT, 4608, 512, 64, (long)WS_X8_HI - (long)WS_X8_LO - (long)(16 * MiB)}; pg8::StaticOrder S; S.init(TT, 4608, G, bx);
        typedef pg8::EpiHcatT<PROBE_VAR - 20> EpiP;
        EpiP E{ws, (const float*)(ws + WS_ROT), 0};
        pg8::gemm_phase<EpiP, pg8::StaticOrder, true, true, false, true, 1, 0>(lds, g, S, E, wave);
    }
    if (PROBE_VAR == 10) p3_phase<0>(args, lds, vcu, G, tid, wave, lane);
    if (PROBE_VAR == 11) p3_phase<1>(args, lds, vcu, G, tid, wave, lane);
    if (PROBE_VAR == 0) attn_dil_phase<16, 0>(args, lds, vcu, G, tid, wave, lane);
    if (PROBE_VAR == 1) attn_dil_phase<16, 1>(args, lds, vcu, G, tid, wave, lane);
    if (PROBE_VAR == 2) attn_dil_phase<4, 0>(args, lds, vcu, G, tid, wave, lane);
    if (PROBE_VAR == 3) attn_dil_phase<4, 1>(args, lds, vcu, G, tid, wave, lane);
}
#endif
extern "C" void kernel_launch(void* const* d_in, const int* in_sizes, int n_in, void* d_out, int out_size, void* d_ws, size_t ws_size, hipStream_t stream) {
    static int grid = 0;
    if (grid == 0) {
        if (n_in != 20 || in_sizes[0] != TT * DM || out_size != TT * DM || ws_size < WS_END) { fprintf(stderr, "kernel_launch: unexpected shapes: n_in %d in0 %d out %d ws %zu; nothing launched\n", n_in, n_in > 0 ? in_sizes[0] : -1, out_size, ws_size); grid = -1; return; }
        int dev = 0, cus = 0;
        if (hipGetDevice(&dev) != hipSuccess || hipDeviceGetAttribute(&cus, hipDeviceAttributeMultiprocessorCount, dev) != hipSuccess) { grid = -1; return; }
        if (hipFuncSetAttribute((const void*)mega_fwd, hipFuncAttributeMaxDynamicSharedMemorySize, LDS_BYTES) != hipSuccess) { fprintf(stderr, "kernel_launch: hipFuncSetAttribute failed\n"); grid = -1; return; }
        (void)hipGetLastError();
        grid = cus;
    }
    if (grid < 0) return;
    if (hipMemsetAsync((char*)d_ws, 0, CTL_ZERO_BYTES, stream) != hipSuccess) return;
    Args a{};
    for (int i = 0; i < 20; ++i) a.in[i] = (const float*)d_in[i];
    a.out = (float*)d_out; a.ws = (unsigned char*)d_ws; a.mask = 0x80007fffu; a.bar_region = 0;
#if defined(XTRA_FIRST)
    { Args x = a; x.mask = XTRA_FIRST; x.bar_region = 1; for (int r = 0; r < XTRA_REP; ++r) hipLaunchKernelGGL(mega_fwd, dim3(grid), dim3(NWAVES * 64), LDS_BYTES, stream, x);
      if (hipMemsetAsync((char*)d_ws, 0, CTL_ZERO_BYTES, stream) != hipSuccess) return; }
#endif
    hipLaunchKernelGGL(mega_fwd, dim3(grid), dim3(NWAVES * 64), LDS_BYTES, stream, a);
#if defined(PROBE_VAR)
    { hipFuncSetAttribute((const void*)probe_kernel, hipFuncAttributeMaxDynamicSharedMemorySize, LDS_BYTES);
      for (int r = 0; r < 4; ++r) hipLaunchKernelGGL(probe_kernel, dim3(grid), dim3(NWAVES * 64), LDS_BYTES, stream, a); }
#endif
#if defined(XTRA_AFTER)
    { Args x = a; x.mask = XTRA_AFTER; x.bar_region = 1; for (int r = 0; r < XTRA_REP; ++r) hipLaunchKernelGGL(mega_fwd, dim3(grid), dim3(NWAVES * 64), LDS_BYTES, stream, x); }
#endif
}
```

```cpp
#define GATE_U8 1
#include <hip/hip_runtime.h>
#include <cstdio>
#include <cstdint>

constexpr int TT = 32768, DM = 1024, SEQ = 2048, NB = 16;
constexpr float DN_ALPHA = 1.189207115002721f;
constexpr float LN_EPSF = 1e-5f;
#ifndef M1_FP8
#define M1_FP8 1
#endif
#ifndef P1_FP8
#define P1_FP8 1
#endif
#ifndef GATE_U8
#define GATE_U8 0
#endif
#ifndef ATT_FP8
#define ATT_FP8 1
#endif
#ifndef O23_FP8
#define O23_FP8 1
#endif
#ifndef STATE_FP8
#define STATE_FP8 1
#endif
#ifndef SILU_IN_P3
#define SILU_IN_P3 1
#endif
#ifndef CONV_BG
#define CONV_BG 1
#endif
#ifndef Y_FP8
#define Y_FP8 1
#endif
#ifndef GATE_FP8
#define GATE_FP8 1
#endif
#ifndef MIX_FP8
#define MIX_FP8 7
#endif
#ifndef P1_FP8_FROM
#define P1_FP8_FROM 0
#endif
#define X_F32_RES (P1_FP8 && P1_FP8_FROM == 0 && GATE_FP8)
constexpr size_t MiB = 1u << 20;
constexpr size_t CTL_ZERO_BYTES = 1 * MiB;
constexpr size_t WS_ROT = 1 * MiB;
constexpr size_t WS_BIAS = 2 * MiB;
constexpr size_t WS_LTOK = 3 * MiB;
constexpr size_t WS_TINFO = 7 * MiB;
constexpr size_t WS_WSLOT = 7 * MiB + 512 * 1024;
constexpr size_t WS_WIN = 8 * MiB;
constexpr size_t WS_WIN8 = 12 * MiB;
constexpr size_t WS_WR = 21 * MiB;
constexpr size_t WS_WA = 23 * MiB;
constexpr size_t WS_WO = 24 * MiB;
constexpr size_t WS_WGU = 26 * MiB;
constexpr size_t WS_WD = 42 * MiB;
constexpr size_t WS_XB = 80 * MiB;
constexpr size_t WS_QR = 144 * MiB;
constexpr size_t WS_KR = 176 * MiB;
constexpr size_t WS_VR = 208 * MiB;
constexpr size_t WS_GR = 272 * MiB;
constexpr size_t WS_QA = 336 * MiB, WS_KA = 368 * MiB, WS_VA = 400 * MiB, WS_OA = 432 * MiB;
#if MIX_FP8 & 4
constexpr size_t WS_AR8 = 144 * MiB;
constexpr size_t WS_GATE_R = 176 * MiB, WS_GATE_A = 240 * MiB;
#else
constexpr size_t WS_GATE_R = 144 * MiB, WS_GATE_A = 208 * MiB;
#endif
constexpr size_t WS_X8_LO = 448 * MiB, WS_X8_HI = 58 * MiB;
static_assert(M1_FP8, "the workspace map is laid out for fp8 expert weights");
static_assert(!CONV_BG || X_F32_RES, "CONV_BG puts o2 into the bf16 x region");
static_assert(!GATE_FP8 || (P1_FP8 && (MIX_FP8 & 2) && M1_FP8), "GATE_FP8 needs the fp8 mixer-input GEMM, the fp8 o_a (room behind it) and the fp8 expert weights (room behind them)");
constexpr size_t WS_MERGED8 = 464 * MiB;
constexpr size_t WS_MERGED = 336 * MiB;
constexpr size_t WS_Y = 144 * MiB;
constexpr size_t WS_H = 336 * MiB;
constexpr size_t WS_X1F8 = 464 * MiB;
#if CONV_BG
constexpr size_t WS_O2 = 80 * MiB;
#else
constexpr size_t WS_O2 = 26 * MiB;
#endif
constexpr size_t WS_O3 = 464 * MiB;
constexpr size_t WS_LSE2 = 496 * MiB, WS_LSE3 = 497 * MiB;
constexpr size_t WS_END = 512 * MiB;
constexpr int MAXSLOT = 69632;
constexpr int CW_BAR = 4096;
constexpr int CW_CNT = 16384;
constexpr int CW_CHK = 24576;
namespace pg8 {
#define PG8_LAS __attribute__((address_space(3)))
typedef unsigned short bf16_t;
typedef short bf16x8 __attribute__((ext_vector_type(8)));
typedef float f32x4 __attribute__((ext_vector_type(4)));
typedef unsigned u32x4 __attribute__((ext_vector_type(4)));
typedef unsigned u32x2_ __attribute__((ext_vector_type(2)));
constexpr int BM = 256, BK = 64, HALF = 128, HTB = HALF * BK * 2  , STAGE_BYTES = 8 * HTB, NXCD = 8, WGM = 8;

__device__ __forceinline__ int lane_id() { int x; asm volatile("v_mbcnt_lo_u32_b32 %0, -1, 0\n\tv_mbcnt_hi_u32_b32 %0, -1, %0" : "=v"(x)); return x; }
__host__ __device__ __forceinline__ int lds_byte(int r, int c) { const int st = (r >> 4) * 2 + (c >> 5), rr = r & 15, cc = c & 31, ob = rr * 64 + cc * 2; return st * 1024 + (ob ^ (((ob >> 9) & 1) << 5)); }
__host__ __device__ __forceinline__ void stage_rc(int b, int& R, int& C) { const int st = b / 1024, sb = b % 1024, swz = sb ^ (((sb >> 9) & 1) << 5); R = (st >> 1) * 16 + swz / 64; C = (st & 1) * 32 + (swz % 64) / 2; }
__host__ __device__ __forceinline__ int perm32(int rho) { const int n = rho >> 4, i = rho & 15; return 8 * (i >> 2) + 4 * n + (i & 3); }

struct Unit { int pm, pn; };
struct Gemm { const bf16_t* A; const bf16_t* Bt; int M, N, K; int spm = 1 << 30; long sdelta = 0; };

struct StaticOrder {
    int nM, nN, nwg, G, c, pn0;
    __host__ __device__ void init(int M, int N, int G_, int c_, int pn0_ = 0) { nM = M / BM; nN = N / BM; nwg = nM * nN; G = G_; c = c_; pn0 = pn0_; }
    __host__ __device__ bool next(int i, Unit& u) const {
        const long L = (long)i * G + c; if (L >= nwg) return false;
        int wgid = (int)L; { const int q = nwg / NXCD, r = nwg % NXCD, xcd = wgid % NXCD, off = wgid / NXCD; wgid = (xcd < r ? xcd * (q + 1) : r * (q + 1) + (xcd - r) * q) + off; }
        const int nig = WGM * nN, gid = wgid / nig, fm = gid * WGM, gsz = (nM - fm) < WGM ? (nM - fm) : WGM;
        u.pm = fm + ((wgid % nig) % gsz); u.pn = pn0 + (wgid % nig) / gsz; return true;
    }
    __device__ __forceinline__ void a_ready(const Unit&) const {}
    __device__ __forceinline__ void done(const Unit&, int, int) const {}
};

__device__ __forceinline__ unsigned cvt_pk_bf16(float lo, float hi) { unsigned r; asm volatile("v_cvt_pk_bf16_f32 %0, %1, %2" : "=v"(r) : "v"(lo), "v"(hi)); return r; }
typedef float cvt_f32x2_t __attribute__((ext_vector_type(2))); typedef __bf16 cvt_bf16x2_t __attribute__((ext_vector_type(2)));
__device__ __forceinline__ unsigned cvt_pk_bf16_acc(float lo, float hi) { const cvt_f32x2_t v = {lo, hi}; const cvt_bf16x2_t b = __builtin_convertvector(v, cvt_bf16x2_t); return __builtin_bit_cast(unsigned, b); }
__device__ __forceinline__ float bflo(unsigned w) { return __uint_as_float(w << 16); }
__device__ __forceinline__ float bfhi(unsigned w) { return __uint_as_float(w & 0xffff0000u); }
__device__ __forceinline__ float fsigmoid(float x) { return __builtin_amdgcn_rcpf(1.f + __expf(-x)); }
__device__ __forceinline__ float fsilu(float x) { return x * __builtin_amdgcn_rcpf(1.f + __expf(-x)); }

__device__ __forceinline__ unsigned fp8x4_sat(float a, float b, float c, float d) {
    a = __builtin_amdgcn_fmed3f(a, -448.f, 448.f); b = __builtin_amdgcn_fmed3f(b, -448.f, 448.f); c = __builtin_amdgcn_fmed3f(c, -448.f, 448.f); d = __builtin_amdgcn_fmed3f(d, -448.f, 448.f);
    unsigned w = 0u; w = __builtin_amdgcn_cvt_pk_fp8_f32(a, b, w, false); w = __builtin_amdgcn_cvt_pk_fp8_f32(c, d, w, true); return w;
}
template <int VAR = 0> struct EpiHcatT {
    static constexpr bool PERM = true, AFTER_DRAIN = false; static constexpr int NSTORE = 16;
    unsigned char* ws; const float* rot; int tile_off;
    __device__ __forceinline__ void operator()(const f32x4 (&acc)[2][2][4][2], const Unit& u, int wr, int wc, int fr, int fq) const {
        if (VAR == 1) {
            float s = 0.f;
#pragma unroll
            for (int ai = 0; ai < 2; ++ai)
#pragma unroll
                for (int bj = 0; bj < 2; ++bj)
#pragma unroll
                    for (int m = 0; m < 4; ++m)
#pragma unroll
                        for (int n = 0; n < 2; ++n) s += (acc[ai][bj][m][n][0] + acc[ai][bj][m][n][1]) + (acc[ai][bj][m][n][2] + acc[ai][bj][m][n][3]);
            ((float*)(ws + WS_O3))[(size_t)(u.pm * 64 + u.pn) * 512 + wr * 256 + wc * 64 + fq * 16 + fr] = s; return;
        }
        const int gt = u.pn + tile_off;
        size_t base_off; int pitch, ct, mode; float sc = 1.f;
        if (gt < 2)       { base_off = WS_QR; pitch = 512;  ct = gt;      mode = 1; }
        else if (gt < 4)  { base_off = WS_KR; pitch = 512;  ct = gt - 2;  mode = 1; sc = 0.08838834764831845f; }
        else if (gt < 8)  { base_off = WS_VR; pitch = 1024; ct = gt - 4;  mode = 0; }
        else if (gt < 12) { base_off = WS_GR; pitch = 1024; ct = gt - 8;  mode = SILU_IN_P3 ? 0 : 2; }
        else if (gt < 14) { base_off = WS_QA; pitch = 512;  ct = gt - 12; mode = ATT_FP8 ? 4 : 0; sc = 0.18033688011112042f; }
        else if (gt < 16) { base_off = WS_KA; pitch = 512;  ct = gt - 14; mode = ATT_FP8 ? 4 : 0; }
        else if (gt < 18) { base_off = WS_VA; pitch = 512;  ct = gt - 16; mode = ATT_FP8 ? 4 : 0; }
        else if (gt < 22) { base_off = WS_GATE_R; pitch = 1024; ct = gt - 18; mode = 3; }
        else              { base_off = WS_GATE_A; pitch = 1024; ct = gt - 22; mode = 3; }
        bf16_t* O = (bf16_t*)(ws + base_off);
        const int row0 = u.pm * BM + wr * 64 + fr, col0 = ct * BM + wc * 32 + 8 * fq;
#pragma unroll
        for (int ai = 0; ai < 2; ++ai)
#pragma unroll
            for (int m = 0; m < 4; ++m) {
                const int row = row0 + ai * HALF + m * 16;
                bf16_t* rowp = O + (size_t)(VAR == 2 ? (row & 255) : row) * pitch + col0;
                f32x4 cs = (f32x4){1.f, 1.f, 1.f, 1.f}, sn = (f32x4){0.f, 0.f, 0.f, 0.f};
                if (mode == 1) { const f32x4* rt = (const f32x4*)(rot + ((size_t)(row & (SEQ - 1)) * 16 + (4 * wc + fq)) * 8); cs = rt[0]; sn = rt[1]; }
#pragma unroll
                for (int bj = 0; bj < 2; ++bj) {
                    f32x4 v0 = acc[ai][bj][m][0], v1 = acc[ai][bj][m][1];
                    if (mode == 1) { const f32x4 a = v0 * cs - v1 * sn, b = v0 * sn + v1 * cs; v0 = a * sc; v1 = b * sc; }
                    else if (mode == 2) {
#pragma unroll
                        for (int e = 0; e < 4; ++e) { v0[e] = fsilu(v0[e]); v1[e] = fsilu(v1[e]); } }
                    else if (mode == 3) {
#pragma unroll
                        for (int e = 0; e < 4; ++e) { v0[e] = fsigmoid(v0[e]); v1[e] = fsigmoid(v1[e]); } }
                    else { v0 = v0 * sc; v1 = v1 * sc; }
                    if (mode == 4) { u32x2_ w8; w8.x = fp8x4_sat(v0[0], v0[1], v0[2], v0[3]); w8.y = fp8x4_sat(v1[0], v1[1], v1[2], v1[3]);
                        *(u32x2_*)((unsigned char*)O + (size_t)(VAR == 2 ? (row & 255) : row) * pitch + col0 + bj * HALF) = w8; }
                    else if (GATE_U8 && mode == 3) { u32x2_ w8; w8.x = 0u; w8.y = 0u;
#pragma unroll
                        for (int e4 = 0; e4 < 4; ++e4) { w8.x = __builtin_amdgcn_cvt_pk_u8_f32(v0[e4] * 255.f, e4, w8.x); w8.y = __builtin_amdgcn_cvt_pk_u8_f32(v1[e4] * 255.f, e4, w8.y); }
                        *(u32x2_*)((unsigned char*)O + (size_t)row * pitch + col0 + bj * HALF) = w8; }
                    else { u32x4 w; w.x = cvt_pk_bf16(v0[0], v0[1]); w.y = cvt_pk_bf16(v0[2], v0[3]); w.z = cvt_pk_bf16(v1[0], v1[1]); w.w = cvt_pk_bf16(v1[2], v1[3]);
                        *(u32x4*)(rowp + bj * HALF) = w; }
                }
            }
    }
};

typedef EpiHcatT<0> EpiHcat;

template <bool ADD, bool OUT8 = false> struct EpiGate {
    static constexpr bool PERM = true, AFTER_DRAIN = false; static constexpr int NSTORE = 16;
    const bf16_t* gate; bf16_t* O; unsigned char* O8;
    __device__ __forceinline__ void operator()(const f32x4 (&acc)[2][2][4][2], const Unit& u, int wr, int wc, int fr, int fq) const {
        const int row0 = u.pm * BM + wr * 64 + fr, col0 = u.pn * BM + wc * 32 + 8 * fq;
#pragma unroll
        for (int ai = 0; ai < 2; ++ai)
#pragma unroll
            for (int m = 0; m < 4; ++m)
#pragma unroll
                for (int bj = 0; bj < 2; ++bj) {
                    const size_t p = (size_t)(row0 + ai * HALF + m * 16) * 1024 + col0 + bj * HALF;
                    f32x4 v0 = acc[ai][bj][m][0], v1 = acc[ai][bj][m][1];
#if GATE_U8
                    { const u32x2_ g8 = *(const u32x2_*)((const unsigned char*)gate + p); constexpr float c255 = 1.f / 255.f;
#pragma unroll
                      for (int e4 = 0; e4 < 4; ++e4) { v0[e4] *= (float)((g8.x >> (8 * e4)) & 0xffu) * c255; v1[e4] *= (float)((g8.y >> (8 * e4)) & 0xffu) * c255; } }
#else
                    const u32x4 g = *(const u32x4*)(gate + p);
                    v0[0] *= bflo(g.x); v0[1] *= bfhi(g.x); v0[2] *= bflo(g.y); v0[3] *= bfhi(g.y);
                    v1[0] *= bflo(g.z); v1[1] *= bfhi(g.z); v1[2] *= bflo(g.w); v1[3] *= bfhi(g.w);
#endif
                    if (ADD) { const u32x4 o = *(const u32x4*)(O + p);
                        v0[0] += bflo(o.x); v0[1] += bfhi(o.x); v0[2] += bflo(o.y); v0[3] += bfhi(o.y);
                        v1[0] += bflo(o.z); v1[1] += bfhi(o.z); v1[2] += bflo(o.w); v1[3] += bfhi(o.w); }
                    if (OUT8) { u32x2_ w8;
                        w8.x = fp8x4_sat(v0[0] * 16.f, v0[1] * 16.f, v0[2] * 16.f, v0[3] * 16.f); w8.y = fp8x4_sat(v1[0] * 16.f, v1[1] * 16.f, v1[2] * 16.f, v1[3] * 16.f);
                        *(u32x2_*)(O8 + p) = w8; }
                    else { u32x4 w; w.x = cvt_pk_bf16(v0[0], v0[1]); w.y = cvt_pk_bf16(v0[2], v0[3]); w.z = cvt_pk_bf16(v1[0], v1[1]); w.w = cvt_pk_bf16(v1[2], v1[3]);
                        *(u32x4*)(O + p) = w; }
                }
    }
};

struct EpiResBf16 {
    static constexpr bool PERM = true, AFTER_DRAIN = false; static constexpr int NSTORE = 16;
    const bf16_t* x; bf16_t* out; float alpha;
    __device__ __forceinline__ void operator()(const f32x4 (&acc)[2][2][4][2], const Unit& u, int wr, int wc, int fr, int fq) const {
        const int row0 = u.pm * BM + wr * 64 + fr, col0 = u.pn * BM + wc * 32 + 8 * fq;
#pragma unroll
        for (int ai = 0; ai < 2; ++ai)
#pragma unroll
            for (int m = 0; m < 4; ++m)
#pragma unroll
                for (int bj = 0; bj < 2; ++bj) {
                    const size_t p = (size_t)(row0 + ai * HALF + m * 16) * 1024 + col0 + bj * HALF;
#if X_F32_RES
                    const f32x4 x0 = *(const f32x4*)((const float*)x + p), x1 = *(const f32x4*)((const float*)x + p + 4);
#else
                    const u32x4 xw = *(const u32x4*)(x + p);
                    const f32x4 x0 = (f32x4){bflo(xw.x), bfhi(xw.x), bflo(xw.y), bfhi(xw.y)}, x1 = (f32x4){bflo(xw.z), bfhi(xw.z), bflo(xw.w), bfhi(xw.w)};
#endif
                    const f32x4 v0 = x0 * alpha + acc[ai][bj][m][0], v1 = x1 * alpha + acc[ai][bj][m][1];
                    u32x4 w; w.x = cvt_pk_bf16(v0[0], v0[1]); w.y = cvt_pk_bf16(v0[2], v0[3]); w.z = cvt_pk_bf16(v1[0], v1[1]); w.w = cvt_pk_bf16(v1[2], v1[3]);
                    *(u32x4*)(out + p) = w;
                }
    }
};

struct EpiSwiGLU {
    static constexpr bool PERM = true, AFTER_DRAIN = false; static constexpr int NSTORE = 16;
    unsigned char* H;
    __device__ __forceinline__ void operator()(const f32x4 (&acc)[2][2][4][2], const Unit& u, int wr, int wc, int fr, int fq) const {
        const int row0 = u.pm * BM + wr * 64 + fr, col0 = (u.pn & 3) * 128 + wc * 16 + 4 * fq;
#pragma unroll
        for (int ai = 0; ai < 2; ++ai)
#pragma unroll
            for (int m = 0; m < 4; ++m)
#pragma unroll
                for (int bj = 0; bj < 2; ++bj) {
                    const f32x4 g = acc[ai][bj][m][0], up = acc[ai][bj][m][1];
                    float h0 = fsilu(g[0]) * up[0] * 8.f, h1 = fsilu(g[1]) * up[1] * 8.f, h2 = fsilu(g[2]) * up[2] * 8.f, h3 = fsilu(g[3]) * up[3] * 8.f;
                    h0 = fminf(fmaxf(h0, -448.f), 448.f); h1 = fminf(fmaxf(h1, -448.f), 448.f); h2 = fminf(fmaxf(h2, -448.f), 448.f); h3 = fminf(fmaxf(h3, -448.f), 448.f);
                    unsigned w = 0u; w = __builtin_amdgcn_cvt_pk_fp8_f32(h0, h1, w, false); w = __builtin_amdgcn_cvt_pk_fp8_f32(h2, h3, w, true);
                    *(unsigned*)(H + (size_t)(row0 + ai * HALF + m * 16) * 512 + col0 + bj * 64) = w;
                }
    }
};

struct EpiRowScale {
    static constexpr bool PERM = true, AFTER_DRAIN = false; static constexpr int NSTORE = 16;
    bf16_t* Y;
    __device__ __forceinline__ void operator()(const f32x4 (&acc)[2][2][4][2], const Unit& u, int wr, int wc, int fr, int fq) const {
        const int row0 = u.pm * BM + wr * 64 + fr, col0 = (u.pn & 3) * BM + wc * 32 + 8 * fq;
#pragma unroll
        for (int ai = 0; ai < 2; ++ai)
#pragma unroll
            for (int m = 0; m < 4; ++m) {
                const int row = row0 + ai * HALF + m * 16;
#pragma unroll
                for (int bj = 0; bj < 2; ++bj) {
                    const f32x4 v0 = acc[ai][bj][m][0], v1 = acc[ai][bj][m][1];
#if Y_FP8
                    u32x2_ w8; w8.x = fp8x4_sat(v0[0] * 16.f, v0[1] * 16.f, v0[2] * 16.f, v0[3] * 16.f); w8.y = fp8x4_sat(v1[0] * 16.f, v1[1] * 16.f, v1[2] * 16.f, v1[3] * 16.f);
                    *(u32x2_*)((unsigned char*)Y + (size_t)row * 1024 + col0 + bj * HALF) = w8;
#else
                    u32x4 w; w.x = cvt_pk_bf16_acc(v0[0], v0[1]); w.y = cvt_pk_bf16_acc(v0[2], v0[3]); w.z = cvt_pk_bf16_acc(v1[0], v1[1]); w.w = cvt_pk_bf16_acc(v1[2], v1[3]);
                    *(u32x4*)(Y + (size_t)row * 1024 + col0 + bj * HALF) = w;
#endif
                }
            }
    }
};

struct MoeOrder {
    int nunits, G, c; const PG8_LAS int* te; const PG8_LAS int* ts; const PG8_LAS int* cnt; const int* ltok; unsigned rowbytes;
    __device__ __forceinline__ bool next(int i, Unit& u) const {
        const int L = i * G + c, rt = (L >> 5) * 8 + (L & 7); if (rt >= (nunits >> 2)) return false;
        u.pm = rt; u.pn = te[rt] * 4 + ((L >> 3) & 3); return true;
    }
    __device__ __forceinline__ unsigned a_row_off(const Unit& u, int row) const {
        const int ex = te[u.pm], pos = (u.pm - ts[ex]) * 256 + row;
        const int tok = pos < cnt[ex] ? ltok[ex * 32768 + pos] : 0;
        return (unsigned)tok * rowbytes;
    }
    __device__ __forceinline__ void a_ready(const Unit&) const {}
    __device__ __forceinline__ void done(const Unit&, int, int) const {}
};

struct ExpertConv { const float* wg; const float* wu; const float* wd; unsigned char* WGU; unsigned char* WD; int gw, nw, grp; };
__device__ __forceinline__ void expert_conv_item(const ExpertConv& c, int j, int lane) {
    const int it = j * c.nw + c.gw, e = it / 384, r = it % 384;
    const float* src; unsigned char* dst; int K, N, mode, nb, kb;
    if (r < 128)      { src = c.wg + (size_t)e * 1024 * 512; dst = c.WGU + (size_t)e * 1024 * 1024; K = 1024; N = 512;  mode = 2; nb = r >> 4; kb = r & 15; }
    else if (r < 256) { src = c.wu + (size_t)e * 1024 * 512; dst = c.WGU + (size_t)e * 1024 * 1024; K = 1024; N = 512;  mode = 3; nb = (r - 128) >> 4; kb = (r - 128) & 15; }
    else              { src = c.wd + (size_t)e * 512 * 1024; dst = c.WD + (size_t)e * 1024 * 512;   K = 512;  N = 1024; mode = 0; nb = (r - 256) >> 3; kb = (r - 256) & 7; }
    const int n4 = nb * 64 + 4 * (lane & 15), k0 = kb * 64 + 16 * (lane >> 4);
    const float* s = src + (size_t)k0 * N + n4;
    f32x4 v[16];
#pragma unroll
    for (int i = 0; i < 16; ++i) v[i] = *(const f32x4*)(s + (size_t)i * N);
#pragma unroll
    for (int jn = 0; jn < 4; ++jn) {
        const int n = n4 + jn, row = mode == 0 ? n : ((n >> 2) << 3) + (n & 3) + (mode == 3 ? 4 : 0);
        u32x4 w;
        w.x = fp8x4_sat(v[0][jn] * 64.f, v[1][jn] * 64.f, v[2][jn] * 64.f, v[3][jn] * 64.f);     w.y = fp8x4_sat(v[4][jn] * 64.f, v[5][jn] * 64.f, v[6][jn] * 64.f, v[7][jn] * 64.f);
        w.z = fp8x4_sat(v[8][jn] * 64.f, v[9][jn] * 64.f, v[10][jn] * 64.f, v[11][jn] * 64.f); w.w = fp8x4_sat(v[12][jn] * 64.f, v[13][jn] * 64.f, v[14][jn] * 64.f, v[15][jn] * 64.f);
        *(u32x4*)(dst + (size_t)row * K + k0) = w;
    }
}
struct GateOrder {
    StaticOrder S4;
    __device__ __forceinline__ bool next(int i, Unit& u) const { Unit t; if (!S4.next(i >> 1, t)) return false; u.pm = t.pm; u.pn = t.pn + 4 * (i & 1); return true; }
    __device__ __forceinline__ void a_ready(const Unit&) const {}
    __device__ __forceinline__ void done(const Unit&, int, int) const {}
};
struct P1Order {
    StaticOrder S; ExpertConv cv;
    __device__ __forceinline__ bool next(int i, Unit& u) const { return S.next(i, u); }
    __device__ __forceinline__ void a_ready(const Unit&) const {}
    __device__ __forceinline__ static int unit_of(int grp, int k) { return (grp + 3 * k) % 9; }
    __device__ __forceinline__ void done(const Unit&, int ui, int lane) const {
        const int d = (ui + 9 - cv.grp) % 9;
        if (ui < 9 && d % 3 == 0 && cv.gw + (d / 3) * cv.nw < 6144) expert_conv_item(cv, d / 3, lane);
    }
};

template <class Epi, class Sched, bool ALIGN_EPI = false, bool SP2 = false, bool GATHER = false, bool FP8 = false, int SEL_W = 0, int SEL_X = 0>
__device__ __forceinline__ void gemm_phase(PG8_LAS unsigned char* lds, const Gemm g, const Sched& S, const Epi& E, const int wid) {
    int tid = wid * 64 + lane_id(); asm volatile("" : "+v"(tid));
    const int lane = tid & 63, wr = wid >> 2, wc = wid & 3, fr = lane & 15, fq = lane >> 4;
    static_assert(SP2, "only the two-super-phase loop is kept");
    typedef int i32x4_ __attribute__((ext_vector_type(4)));
    const int K = g.K, nt = K / BK;
    unsigned voffB[2]; int rA[2], cA2[2];
#pragma unroll
    for (int i = 0; i < 2; ++i) { int R, C; stage_rc(tid * 16 + i * 8192, R, C); const int Rb = Epi::PERM ? ((R & ~31) + perm32(R & 31)) : R;
        rA[i] = R; cA2[i] = C * 2; voffB[i] = (unsigned)(Rb * K + C) * 2u; }
    unsigned vAc[2][2], vAn[2][2];
    const size_t kstep = (size_t)(BK * 2);
    const size_t hstep = (size_t)HALF * K * 2;
    const size_t tstep = 2 * hstep;
    const unsigned ldsw = (unsigned)wid * 1024u;
    const int aoff0 = lds_byte(wr * 64 + fr, fq * 8), aoff1 = aoff0 + 1024;
    const int boff0 = lds_byte(wc * 32 + fr, fq * 8), boff1 = boff0 + 1024;
#define PG8_SA(b, h) (((b) * 2 + (h)) * HTB)
#define PG8_SB(b, h) ((4 + (b) * 2 + (h)) * HTB)
#define PG8_STAGE(bufoff, gbase, voff) do { _Pragma("unroll") for (int _i = 0; _i < 2; ++_i) \
        __builtin_amdgcn_global_load_lds((const unsigned*)((const char*)(gbase) + (voff)[_i]), (PG8_LAS unsigned*)(lds + (bufoff) + ldsw + _i * 8192), 16, 0, 0); } while (0)
#define PG8_LDA(dst, b, h) do { _Pragma("unroll") for (int m = 0; m < 4; ++m) { dst[m][0] = *(const PG8_LAS bf16x8*)(lds + PG8_SA(b, h) + aoff0 + m * 2048); dst[m][1] = *(const PG8_LAS bf16x8*)(lds + PG8_SA(b, h) + aoff1 + m * 2048); } } while (0)
#define PG8_LDB(dst, b, h) do { _Pragma("unroll") for (int n = 0; n < 2; ++n) { dst[n][0] = *(const PG8_LAS bf16x8*)(lds + PG8_SB(b, h) + boff0 + n * 2048); dst[n][1] = *(const PG8_LAS bf16x8*)(lds + PG8_SB(b, h) + boff1 + n * 2048); } } while (0)
#define PG8_CAT8(x) __builtin_shufflevector(__builtin_bit_cast(i32x4_, (x)[0]), __builtin_bit_cast(i32x4_, (x)[1]), 0, 1, 2, 3, 4, 5, 6, 7)
#define PG8_MMA(ai, bj, At, Bt) do { __builtin_amdgcn_s_setprio(1); \
        if constexpr (FP8) { _Pragma("unroll") for (int m = 0; m < 4; ++m) _Pragma("unroll") for (int n = 0; n < 2; ++n) \
            acc[ai][bj][m][n] = __builtin_amdgcn_mfma_scale_f32_16x16x128_f8f6f4(PG8_CAT8(Bt[n]), PG8_CAT8(At[m]), acc[ai][bj][m][n], 0, 0, SEL_W, scl, SEL_X, scl); \
            asm volatile("" : "+v"(acc[ai][bj][0][0]), "+v"(acc[ai][bj][0][1]), "+v"(acc[ai][bj][1][0]), "+v"(acc[ai][bj][1][1]), "+v"(acc[ai][bj][2][0]), "+v"(acc[ai][bj][2][1]), "+v"(acc[ai][bj][3][0]), "+v"(acc[ai][bj][3][1])); } \
        else { _Pragma("unroll") for (int m = 0; m < 4; ++m) _Pragma("unroll") for (int n = 0; n < 2; ++n) _Pragma("unroll") for (int k = 0; k < 2; ++k) \
            acc[ai][bj][m][n] = __builtin_amdgcn_mfma_f32_16x16x32_bf16(Bt[n][k], At[m][k], acc[ai][bj][m][n], 0, 0, 0); } \
        __builtin_amdgcn_s_setprio(0); } while (0)
#define PG8_WAIT_V(n) asm volatile("s_waitcnt vmcnt(" #n ")" ::: "memory")
#define PG8_WAIT_VN(n) asm volatile("s_waitcnt vmcnt(%0)" :: "i"(n) : "memory")
#define PG8_WAIT_L(n) asm volatile("s_waitcnt lgkmcnt(" #n ")" ::: "memory")
#define PG8_BAR __builtin_amdgcn_s_barrier()
#define PG8_SCHED __builtin_amdgcn_sched_barrier(0)
    [[maybe_unused]] int scl = 0x7b7c797f; asm volatile("" : "+v"(scl));
    Unit cur, nxt; int ui = 0;
    if (!S.next(0, cur)) return;
    f32x4 acc[2][2][4][2];
#pragma unroll
    for (int a = 0; a < 2; ++a)
#pragma unroll
        for (int b = 0; b < 2; ++b)
#pragma unroll
            for (int m = 0; m < 4; ++m)
#pragma unroll
                for (int n = 0; n < 2; ++n) acc[a][b][m][n] = (f32x4){0.f, 0.f, 0.f, 0.f};
    bf16x8 At[4][2], B0[2][2], B1[2][2];
    const char* cA = GATHER ? (const char*)g.A : (const char*)g.A + (size_t)cur.pm * tstep + (cur.pm >= g.spm ? g.sdelta : 0L); const char* cB = (const char*)g.Bt + (size_t)cur.pn * tstep;
#pragma unroll
    for (int h = 0; h < 2; ++h)
#pragma unroll
        for (int i = 0; i < 2; ++i) { if constexpr (GATHER) vAc[h][i] = S.a_row_off(cur, h * HALF + rA[i]) + (unsigned)cA2[i]; else vAc[h][i] = (unsigned)((h * HALF + rA[i]) * K) * 2u + (unsigned)cA2[i]; vAn[h][i] = vAc[h][i]; }
    S.a_ready(cur);
    if constexpr (SP2) {
        PG8_STAGE(PG8_SB(0, 0), cB, voffB); PG8_STAGE(PG8_SB(0, 1), cB + hstep, voffB); PG8_STAGE(PG8_SA(0, 0), cA, vAc[0]); PG8_STAGE(PG8_SA(0, 1), cA, vAc[1]);
        if (wr == 1) PG8_BAR;
        PG8_WAIT_V(2); PG8_BAR;
        PG8_STAGE(PG8_SB(1, 0), cB + kstep, voffB); PG8_STAGE(PG8_SA(1, 0), cA + kstep, vAc[0]); PG8_STAGE(PG8_SB(1, 1), cB + hstep + kstep, voffB);
        PG8_WAIT_V(6); PG8_BAR;
    }
    for (;;) {
        const bool has_next = S.next(ui + 1, nxt);
        const char* nA = GATHER ? cA : (has_next ? (const char*)g.A + (size_t)nxt.pm * tstep + (nxt.pm >= g.spm ? g.sdelta : 0L) : cA); const char* nB = has_next ? (const char*)g.Bt + (size_t)nxt.pn * tstep : cB;
        if constexpr (GATHER) { if (has_next) {
#pragma unroll
            for (int h = 0; h < 2; ++h)
#pragma unroll
                for (int i = 0; i < 2; ++i) vAn[h][i] = S.a_row_off(nxt, h * HALF + rA[i]) + (unsigned)cA2[i]; } }
#pragma unroll 1
        for (int t = 0; t < nt; t += 2) {
            const bool last = (t == nt - 2);
            asm volatile("" : "+v"(voffB[0]), "+v"(voffB[1]), "+v"(vAc[0][0]), "+v"(vAc[0][1]), "+v"(vAc[1][0]), "+v"(vAc[1][1]));
            const char* a1 = cA + (size_t)(t + 1) * kstep;
            const char* a2 = last ? nA : cA + (size_t)(t + 2) * kstep; const char* b2 = last ? nB : cB + (size_t)(t + 2) * kstep;
            const char* a3 = a2 + kstep; const char* b3 = b2 + kstep;
            unsigned vA2[2][2];
#pragma unroll
            for (int h = 0; h < 2; ++h)
#pragma unroll
                for (int i = 0; i < 2; ++i) vA2[h][i] = vAc[h][i];
            if constexpr (GATHER) { if (last) {
                asm volatile("" : "+v"(vAn[0][0]), "+v"(vAn[0][1]), "+v"(vAn[1][0]), "+v"(vAn[1][1]));
#pragma unroll
                for (int h = 0; h < 2; ++h)
#pragma unroll
                    for (int i = 0; i < 2; ++i) vA2[h][i] = vAn[h][i]; } }
            if (last && has_next) S.a_ready(nxt);
            if constexpr (SP2) {
            const int lenient = __builtin_amdgcn_readfirstlane((ui > 0 && t == 0) ? 1 : 0);
#define PG8_WAIT_V8L() asm volatile("s_cmp_eq_u32 %0, 0\n\ts_cbranch_scc0 .Lpg8skip%=\n\ts_waitcnt vmcnt(8)\n.Lpg8skip%=:\n\ts_waitcnt vmcnt(%1)" :: "s"(lenient), "i"(8 + Epi::NSTORE) : "memory", "scc")
            PG8_LDB(B0, 0, 0); PG8_LDB(B1, 0, 1); PG8_SCHED; PG8_LDA(At, 0, 0); PG8_STAGE(PG8_SA(1, 1), a1, vAc[1]);
            PG8_WAIT_V8L(); PG8_WAIT_L(0); PG8_BAR; PG8_MMA(0, 0, At, B0); PG8_MMA(0, 1, At, B1); PG8_BAR; PG8_SCHED;
            PG8_LDA(At, 0, 1); PG8_STAGE(PG8_SB(0, 0), b2, voffB); PG8_STAGE(PG8_SB(0, 1), b2 + hstep, voffB); PG8_STAGE(PG8_SA(0, 0), a2, vA2[0]);
            PG8_WAIT_V8L(); PG8_WAIT_L(0); PG8_BAR; PG8_MMA(1, 0, At, B0); PG8_MMA(1, 1, At, B1); PG8_BAR; PG8_SCHED;
            PG8_LDB(B0, 1, 0); PG8_LDB(B1, 1, 1); PG8_SCHED; PG8_LDA(At, 1, 0); PG8_STAGE(PG8_SA(0, 1), a2, vA2[1]);
            PG8_WAIT_V(8); PG8_WAIT_L(0); PG8_BAR; PG8_MMA(0, 0, At, B0); PG8_MMA(0, 1, At, B1); PG8_BAR; PG8_SCHED;
            PG8_LDA(At, 1, 1); PG8_STAGE(PG8_SB(1, 0), b3, voffB); PG8_STAGE(PG8_SB(1, 1), b3 + hstep, voffB); PG8_STAGE(PG8_SA(1, 0), a3, vA2[0]);
            PG8_WAIT_V(8); PG8_WAIT_L(0); PG8_BAR; PG8_MMA(1, 0, At, B0); PG8_MMA(1, 1, At, B1); PG8_BAR; PG8_SCHED;
#undef PG8_WAIT_V8L
            }
        }
        if constexpr (ALIGN_EPI) { if (wr == 0) PG8_BAR; }
        if constexpr (!Epi::AFTER_DRAIN) { const int le = lane_id(); E(acc, cur, wr, wc, le & 15, le >> 4); S.done(cur, ui, le); }
        if (!has_next) break;
#pragma unroll
        for (int a = 0; a < 2; ++a)
#pragma unroll
            for (int b = 0; b < 2; ++b)
#pragma unroll
                for (int m = 0; m < 4; ++m)
#pragma unroll
                    for (int n = 0; n < 2; ++n) acc[a][b][m][n] = (f32x4){0.f, 0.f, 0.f, 0.f};
        cur = nxt; cA = nA; cB = nB; ++ui;
        if constexpr (GATHER) {
#pragma unroll
            for (int h = 0; h < 2; ++h)
#pragma unroll
                for (int i = 0; i < 2; ++i) vAc[h][i] = vAn[h][i]; }
        if constexpr (ALIGN_EPI) { if (wr == 1) PG8_BAR; }
    }
    PG8_WAIT_V(0);
    if constexpr (!ALIGN_EPI) { if (wr == 0) PG8_BAR; }
    PG8_BAR;
    if constexpr (Epi::AFTER_DRAIN) { E.fused(acc, cur, wr, wc, fr, fq, lds, wid, lane); S.done(cur, ui, lane); }
#undef PG8_SA
#undef PG8_SB
#undef PG8_STAGE
#undef PG8_LDA
#undef PG8_LDB
#undef PG8_MMA
#undef PG8_CAT8
#undef PG8_WAIT_V
#undef PG8_WAIT_VN
#undef PG8_WAIT_L
#undef PG8_BAR
#undef PG8_SCHED
}
}
#define GAS __attribute__((address_space(1)))
#define LAS __attribute__((address_space(3)))
typedef unsigned short bf16;
typedef unsigned v4u __attribute__((ext_vector_type(4)));
typedef float f32x4 __attribute__((ext_vector_type(4)));
typedef short bf16x8 __attribute__((ext_vector_type(8)));
typedef GAS unsigned gu32;
typedef GAS unsigned long long gu64;
#define RLX_AGENT __ATOMIC_RELAXED, __HIP_MEMORY_SCOPE_AGENT
#define LDS_WAIT() asm volatile("s_waitcnt lgkmcnt(0)" ::: "memory")
#define VM_WAIT() asm volatile("s_waitcnt vmcnt(0)" ::: "memory")
__device__ __forceinline__ unsigned long long rt() { return __builtin_amdgcn_s_memrealtime(); }
__device__ __forceinline__ unsigned f2bf(float f) { unsigned u = __builtin_bit_cast(unsigned, f); return (u + 0x7fffu + ((u >> 16) & 1u)) >> 16; }
__device__ __forceinline__ unsigned pk2(float lo, float hi) { return f2bf(lo) | (f2bf(hi) << 16); }

#define XB_TMO      128
#define XB_XCNT(j)  (256  + 64 * (j))
#define XB_XSUB(j)  (1280 + 64 * (j))
#define XB_XGEN(j)  (2304 + 64 * (j))
#define XB_TOP      3328
#define XB_TOPGEN   3392
#define XCD_BAR_WORDS 3456
#define XB_SPIN_CAP (1u << 18)

__device__ __forceinline__ unsigned xb_ld(unsigned* p)              { return __hip_atomic_load(p, __ATOMIC_RELAXED, __HIP_MEMORY_SCOPE_AGENT); }
__device__ __forceinline__ unsigned xb_add(unsigned* p, unsigned v) { return __hip_atomic_fetch_add(p, v, __ATOMIC_RELAXED, __HIP_MEMORY_SCOPE_AGENT); }
__device__ __forceinline__ unsigned xb_xcc_id() { return (unsigned)__builtin_amdgcn_s_getreg((3 << 11) | 20) & 0xFu; }
#define XB_SPIN(cond, bar) do { unsigned _sp = 0; while (cond) { __builtin_amdgcn_s_sleep(1); \
    if ((++_sp & 255u) == 0u) { if (xb_ld(&(bar)[XB_TMO])) break; if (_sp > XB_SPIN_CAP) { atomicAdd(&(bar)[XB_TMO], 1u); break; } } } } while (0)

struct XcdBarrier {
    unsigned* bar; unsigned x; int wv;
    volatile LAS unsigned* st;
};

__device__ __forceinline__ XcdBarrier xcd_barrier_post(unsigned* bar, volatile LAS unsigned* st) {
    XcdBarrier b; b.bar = bar; b.x = xb_xcc_id(); b.st = st; b.wv = 0;
    if (threadIdx.x == 0) (void)xb_add(&bar[XB_XCNT(b.x)], 1u);
    return b;
}
__device__ __forceinline__ void xcd_barrier_complete(unsigned* bar, unsigned x, unsigned& nloc, unsigned& nx) {
    const unsigned G = gridDim.x * gridDim.y * gridDim.z;
    unsigned sum, cnt, mine, sp = 0u;
    for (;;) {
        sum = 0u; cnt = 0u; mine = 0u;
#pragma unroll
        for (unsigned j = 0; j < 16; ++j) { const unsigned c = xb_ld(&bar[XB_XCNT(j)]); sum += c; cnt += (c > 0u) ? 1u : 0u; mine = (j == x) ? c : mine; }
        if (sum == G) break;
        __builtin_amdgcn_s_sleep(1);
        if ((++sp & 255u) == 0u) { if (xb_ld(&bar[XB_TMO])) break; if (sp > XB_SPIN_CAP) { atomicAdd(&bar[XB_TMO], 1u); break; } }
    }
    nloc = mine > 0u ? mine : 1u; nx = cnt > 0u ? cnt : 1u;
}

__device__ __forceinline__ void xcd_barrier(const XcdBarrier& b) {
    asm volatile("s_waitcnt vmcnt(0)" ::: "memory");
    __syncthreads();
    if (b.wv == 0 && (int)__builtin_amdgcn_mbcnt_hi(~0u, __builtin_amdgcn_mbcnt_lo(~0u, 0u)) == 0) {
        unsigned* bar = b.bar;
        __builtin_amdgcn_s_waitcnt(0);
        unsigned nloc = b.st[0], nx = b.st[1];
        if (nloc == 0u) { xcd_barrier_complete(bar, b.x, nloc, nx); b.st[0] = nloc; b.st[1] = nx; }
        const unsigned old = xb_add(&bar[XB_XSUB(b.x)], 1u);
        const unsigned gen = old / nloc;
        if (old + 1u == (gen + 1u) * nloc) {
            __builtin_amdgcn_fence(__ATOMIC_RELEASE, "agent");
            asm volatile("s_waitcnt vmcnt(0)" ::: "memory");
            const unsigned og = xb_add(&bar[XB_TOP], 1u);
            const unsigned tg = og / nx;
            if (og + 1u == (tg + 1u) * nx) xb_add(&bar[XB_TOPGEN], 1u);
            else XB_SPIN(xb_ld(&bar[XB_TOPGEN]) == tg, bar);
            __builtin_amdgcn_fence(__ATOMIC_ACQUIRE, "agent");
            xb_add(&bar[XB_XGEN(b.x)], 1u);
            asm volatile("s_waitcnt vmcnt(0)" ::: "memory");
        } else {
            __builtin_amdgcn_fence(__ATOMIC_ACQUIRE, "agent");
            asm volatile("s_waitcnt vmcnt(0)" ::: "memory");
            XB_SPIN(xb_ld(&bar[XB_XGEN(b.x)]) == gen, bar);
        }
    }
    __syncthreads();
}


constexpr int NWAVES = 8;
constexpr int RING_BYTES = 131072;
constexpr int LDSCTL_OFF = RING_BYTES, MISC_OFF = LDSCTL_OFF + 320;
constexpr int LDS_TS_OFF = LDSCTL_OFF + 1024;
constexpr int LDS_TE_OFF = LDSCTL_OFF + 2048;
constexpr int LDS_CNT_OFF = LDSCTL_OFF + 1024 + 128;
constexpr int LDS_BYTES = 163840;

typedef short s16x4 __attribute__((ext_vector_type(4)));
typedef unsigned u32x2 __attribute__((ext_vector_type(2)));

struct Args { const float* in[20]; float* out; unsigned char* ws; unsigned mask; int bar_region; };

__device__ __forceinline__ float bflo(unsigned w) { return __uint_as_float(w << 16); }
__device__ __forceinline__ float bfhi(unsigned w) { return __uint_as_float(w & 0xffff0000u); }
__device__ __forceinline__ unsigned cvtpk(float lo, float hi) { return pg8::cvt_pk_bf16(lo, hi); }
__device__ __forceinline__ float wave_sum(float v) {
#pragma unroll
    for (int o = 1; o < 64; o <<= 1) v += __shfl_xor(v, o);
    return v;
}
__device__ __forceinline__ unsigned offb(unsigned row, unsigned ch) { return 256u * row + 16u * (ch ^ (((row & 3u) << 2) | ((row >> 2) & 3u))); }
__device__ __forceinline__ s16x4 ldtr(const LAS unsigned char* p) { return __builtin_amdgcn_ds_read_tr16_b64_v4i16((LAS s16x4*)p); }
__device__ __forceinline__ bf16x8 cat8(s16x4 a, s16x4 b) { return (bf16x8){a[0], a[1], a[2], a[3], b[0], b[1], b[2], b[3]}; }
#define MFMA16(a, b, c) __builtin_amdgcn_mfma_f32_16x16x32_bf16((a), (b), (c), 0, 0, 0)

template <int MODE> __device__ __forceinline__ int dest_row(int n) {
    if (MODE == 1) { if (n >= 1024) return n; const int hb = n & ~127, d = n & 127, jr = d & 63, half = d >> 6; return hb + 8 * (jr >> 2) + 4 * half + (jr & 3); }
    if (MODE == 2) return ((n >> 2) << 3) + (n & 3);
    if (MODE == 3) return ((n >> 2) << 3) + 4 + (n & 3);
    return n;
}
template <int MODE> __device__ __forceinline__ void p0_transpose_item(const float* W, int K, int N, bf16* WT, LAS float* scr, int item, int lane) {
    const int nblk = N / 32, kb = item / nblk, nb = item % nblk, k0 = 64 * kb, n0 = 32 * nb;
    {
        const GAS f32x4* src = (const GAS f32x4*)(W + (size_t)(k0 + (lane >> 3)) * N + n0) + (lane & 7);
        f32x4 t[8];
#pragma unroll
        for (int j = 0; j < 8; ++j) t[j] = src[(size_t)j * 2 * N];
#pragma unroll
        for (int j = 0; j < 8; ++j) { LAS float* d = scr + ((lane >> 3) + 8 * j) * 33 + 4 * (lane & 7); d[0] = t[j].x; d[1] = t[j].y; d[2] = t[j].z; d[3] = t[j].w; }
    }
    LDS_WAIT(); asm volatile("" ::: "memory");
    const int c = lane & 7;
#pragma unroll
    for (int j = 0; j < 4; ++j) { const int n = (lane >> 3) + 8 * j; const LAS float* s = scr + (8 * c) * 33 + n;
        v4u o; o.x = pk2(s[0 * 33], s[1 * 33]); o.y = pk2(s[2 * 33], s[3 * 33]); o.z = pk2(s[4 * 33], s[5 * 33]); o.w = pk2(s[6 * 33], s[7 * 33]);
        *(GAS v4u*)(WT + (size_t)dest_row<MODE>(n0 + n) * K + k0 + 8 * c) = o; }
    LDS_WAIT(); asm volatile("" ::: "memory");
}
__device__ __forceinline__ unsigned pk_fp8x4(float a, float b, float c, float d) {
    a = fminf(fmaxf(a, -448.f), 448.f); b = fminf(fmaxf(b, -448.f), 448.f); c = fminf(fmaxf(c, -448.f), 448.f); d = fminf(fmaxf(d, -448.f), 448.f);
    unsigned w = 0u; w = __builtin_amdgcn_cvt_pk_fp8_f32(a, b, w, false); w = __builtin_amdgcn_cvt_pk_fp8_f32(c, d, w, true); return w;
}
__device__ __forceinline__ v4u fp8x8_to_bf16x8(u32x2 w) { typedef float f2_ __attribute__((ext_vector_type(2)));
    const f2_ a0 = __builtin_amdgcn_cvt_pk_f32_fp8(w.x, false), a1 = __builtin_amdgcn_cvt_pk_f32_fp8(w.x, true), a2 = __builtin_amdgcn_cvt_pk_f32_fp8(w.y, false), a3 = __builtin_amdgcn_cvt_pk_f32_fp8(w.y, true);
    v4u o; o.x = cvtpk(a0[0], a0[1]); o.y = cvtpk(a1[0], a1[1]); o.z = cvtpk(a2[0], a2[1]); o.w = cvtpk(a3[0], a3[1]); return o; }
template <int MODE> __device__ __forceinline__ void p0_transpose_item_fp8(const float* W, int K, int N, unsigned char* WT, LAS float* scr, int item, int lane, float scale) {
    const int nblk = N / 32, kb = item / nblk, nb = item % nblk, k0 = 64 * kb, n0 = 32 * nb;
    {
        const GAS f32x4* src = (const GAS f32x4*)(W + (size_t)(k0 + (lane >> 3)) * N + n0) + (lane & 7);
        f32x4 t[8];
#pragma unroll
        for (int j = 0; j < 8; ++j) t[j] = src[(size_t)j * 2 * N];
#pragma unroll
        for (int j = 0; j < 8; ++j) { LAS float* d = scr + ((lane >> 3) + 8 * j) * 33 + 4 * (lane & 7); d[0] = t[j].x; d[1] = t[j].y; d[2] = t[j].z; d[3] = t[j].w; }
    }
    LDS_WAIT(); asm volatile("" ::: "memory");
    const int c = lane & 7;
#pragma unroll
    for (int j = 0; j < 4; ++j) { const int n = (lane >> 3) + 8 * j; const LAS float* s = scr + (8 * c) * 33 + n;
        u32x2 o; o.x = pk_fp8x4(s[0 * 33] * scale, s[1 * 33] * scale, s[2 * 33] * scale, s[3 * 33] * scale); o.y = pk_fp8x4(s[4 * 33] * scale, s[5 * 33] * scale, s[6 * 33] * scale, s[7 * 33] * scale);
        *(GAS u32x2*)(WT + (size_t)dest_row<MODE>(n0 + n) * K + k0 + 8 * c) = o; }
    LDS_WAIT(); asm volatile("" ::: "memory");
}
__device__ __forceinline__ int t5_bucket(int rel) {
    const int n = rel < 0 ? -rel : rel;
    int large = 8 + (n >= 15) + (n >= 27) + (n >= 50) + (n >= 91) + (n >= 166) + (n >= 305) + (n >= 559);
    large = large < 15 ? large : 15;
    return (rel > 0 ? 16 : 0) + (n < 8 ? n : large);
}
__device__ __forceinline__ void p0_prologue(const Args& a, LAS unsigned char* lds, int vcu, int G, int tid, int wave, int lane) {
    unsigned char* ws = a.ws;
    LAS float* scr = (LAS float*)(lds + wave * 16384);
    const int gw = vcu * NWAVES + wave, NGW = G * NWAVES;
    constexpr int I_IN = 16 * 208, I_R = 16 * 32, I_A = 8 * 32, I_O = 16 * 32;
    constexpr int NITEMS = I_IN + I_R + I_A + I_O;
    for (int it = gw; it < NITEMS; it += NGW) {
        int r = it;
#if P1_FP8
        if (r < I_IN) { if ((GATE_FP8 || r % 208 < 144) && r % 208 >= 8 * P1_FP8_FROM) p0_transpose_item_fp8<1>(a.in[1], 1024, 6656, ws + WS_WIN8, scr, r, lane, 64.f);
                        else p0_transpose_item<1>(a.in[1], 1024, 6656, (bf16*)(ws + WS_WIN), scr, r, lane); continue; } r -= I_IN;
#else
        if (r < I_IN) { p0_transpose_item<1>(a.in[1], 1024, 6656, (bf16*)(ws + WS_WIN), scr, r, lane); continue; } r -= I_IN;
#endif
        if (r < I_R) { if (MIX_FP8 & 4) p0_transpose_item_fp8<0>(a.in[5], 1024, 1024, ws + WS_WR, scr, r, lane, 64.f); else p0_transpose_item<0>(a.in[5], 1024, 1024, (bf16*)(ws + WS_WR), scr, r, lane); continue; } r -= I_R;
        if (r < I_A) { if (MIX_FP8 & 2) p0_transpose_item_fp8<0>(a.in[7], 512, 1024, ws + WS_WA, scr, r, lane, 64.f); else p0_transpose_item<0>(a.in[7], 512, 1024, (bf16*)(ws + WS_WA), scr, r, lane); continue; } r -= I_A;
        if (MIX_FP8 & 1) p0_transpose_item_fp8<0>(a.in[8], 1024, 1024, ws + WS_WO, scr, r, lane, 64.f); else p0_transpose_item<0>(a.in[8], 1024, 1024, (bf16*)(ws + WS_WO), scr, r, lane);
    }
    {
        const f32x4* x4 = (const f32x4*)a.in[0]; u32x2* xb = (u32x2*)(ws + WS_XB);
#if P1_FP8
#if GATE_FP8
        unsigned* xf8 = (unsigned*)(ws + WS_X8_LO);
#define XF8_AT(i) xf8[(long)(i) + ((i) >= (size_t)16384 * 256 ? ((long)WS_X8_HI - (long)WS_X8_LO - (long)(16 * MiB)) / 4 : 0L)]
#else
        unsigned* xf8 = (unsigned*)a.out;
#define XF8_AT(i) xf8[i]
#endif
        const size_t n4 = (size_t)TT * DM / 4, st = (size_t)G * 512; size_t i = (size_t)vcu * 512 + tid;
        for (; i + 7 * st < n4; i += 8 * st) {
            f32x4 v[8];
#pragma unroll
            for (int u = 0; u < 8; ++u) v[u] = x4[i + u * st];
#pragma unroll
            for (int u = 0; u < 8; ++u) { if (!X_F32_RES) { u32x2 o; o.x = cvtpk(v[u].x, v[u].y); o.y = cvtpk(v[u].z, v[u].w); xb[i + u * st] = o; } XF8_AT(i + u * st) = pk_fp8x4(v[u].x, v[u].y, v[u].z, v[u].w); }
        }
        for (; i < n4; i += st) { const f32x4 v = x4[i]; if (!X_F32_RES) { u32x2 o; o.x = cvtpk(v.x, v.y); o.y = cvtpk(v.z, v.w); xb[i] = o; } XF8_AT(i) = pk_fp8x4(v.x, v.y, v.z, v.w); }
#undef XF8_AT
#else
        for (size_t i = (size_t)vcu * 512 + tid; i < (size_t)TT * DM / 4; i += (size_t)G * 512) { const f32x4 v = x4[i]; u32x2 o; o.x = cvtpk(v.x, v.y); o.y = cvtpk(v.z, v.w); xb[i] = o; }
#endif
    }
    {
        float* rot = (float*)(ws + WS_ROT);
        for (int idx = vcu * 512 + tid; idx < SEQ * 64; idx += G * 512) {
            const int pos = idx >> 6, jr = idx & 63;
            double iv = 1.0; for (int k = 0; k < jr; ++k) iv *= 0.86596432336006535;
            const float ang = (float)pos * (float)iv;
            const double xx = (double)ang; const double qd = __builtin_rint(xx * 0.63661977236758134); const int qi = (int)qd;
            const double r = (xx - qd * 1.5707963267948966) - qd * 6.123233995736766e-17, r2 = r * r;
            const double sp = r * (1.0 + r2 * (-1.0 / 6 + r2 * (1.0 / 120 + r2 * (-1.0 / 5040 + r2 * (1.0 / 362880 + r2 * (-1.0 / 39916800 + r2 * (1.0 / 6227020800.0)))))));
            const double cp = 1.0 + r2 * (-0.5 + r2 * (1.0 / 24 + r2 * (-1.0 / 720 + r2 * (1.0 / 40320 + r2 * (-1.0 / 3628800 + r2 * (1.0 / 479001600.0))))));
            const int qq = qi & 3; const double s = qq == 0 ? sp : (qq == 1 ? cp : (qq == 2 ? -sp : -cp)), c = qq == 0 ? cp : (qq == 1 ? -sp : (qq == 2 ? -cp : sp));
            float* o = rot + ((size_t)pos * 16 + (jr >> 2)) * 8 + (jr & 3); o[0] = (float)c; o[4] = (float)s;
        }
    }
    if (vcu == 0) {
        float* bt = (float*)(ws + WS_BIAS); const float* rb = a.in[6];
        for (int idx = tid; idx < 3 * 8 * 160; idx += 512) { const int p = idx / (8 * 160), h = (idx / 160) % 8, d = idx % 160 - 80; const int dil = p == 0 ? 1 : (p == 1 ? 4 : 16);
            bt[idx] = (d >= -64 && d <= 64) ? rb[t5_bucket(d * dil) * 8 + h] * 1.4426950408889634f : -1e30f; }
    }
}
__device__ __forceinline__ void p0_expert_weights(const Args& a, LAS unsigned char* lds, int vcu, int G, int wave, int lane) {
    unsigned char* ws = a.ws;
    LAS float* scr = (LAS float*)(lds + wave * 16384);
    const int gw = vcu * NWAVES + wave, NGW = G * NWAVES;
    constexpr int I_G = 16 * 16, I_D = 8 * 32, PER_E = 2 * I_G + I_D;
    for (int it = gw; it < 16 * PER_E; it += NGW) {
        const int e = it / PER_E; int r = it - e * PER_E;
#if M1_FP8
        if (r < I_G) { p0_transpose_item_fp8<2>(a.in[15] + (size_t)e * 1024 * 512, 1024, 512, ws + WS_WGU + (size_t)e * 1024 * 1024, scr, r, lane, 64.f); continue; } r -= I_G;
        if (r < I_G) { p0_transpose_item_fp8<3>(a.in[16] + (size_t)e * 1024 * 512, 1024, 512, ws + WS_WGU + (size_t)e * 1024 * 1024, scr, r, lane, 64.f); continue; } r -= I_G;
#else
        if (r < I_G) { p0_transpose_item<2>(a.in[15] + (size_t)e * 1024 * 512, 1024, 512, (bf16*)(ws + WS_WGU) + (size_t)e * 1024 * 1024, scr, r, lane); continue; } r -= I_G;
        if (r < I_G) { p0_transpose_item<3>(a.in[16] + (size_t)e * 1024 * 512, 1024, 512, (bf16*)(ws + WS_WGU) + (size_t)e * 1024 * 1024, scr, r, lane); continue; } r -= I_G;
#endif
        p0_transpose_item_fp8<0>(a.in[17] + (size_t)e * 512 * 1024, 512, 1024, ws + WS_WD + (size_t)e * 1024 * 512, scr, r, lane, 64.f);
    }
    __syncthreads();
}

__device__ __forceinline__ float log2_gamma(const float* dec, int h) {
    const float x = dec[h]; return -__log2f(1.f + __expf(-x));
}
__device__ __forceinline__ void chain_item(const Args& a, LAS unsigned char* lds, int item, int tid, int wid, int lane) {
    unsigned char* ws = a.ws;
    const int b = item >> 4, h = (item >> 2) & 3, dir = (item >> 1) & 1, vh = item & 1;
    const float lg2 = log2_gamma(dir ? a.in[3] : a.in[2], h);
    const float cd = __builtin_amdgcn_exp2f(lg2 * 128.f);
    const int g = lane >> 4, i16 = lane & 15, q = i16 >> 2, p = lane & 3;
    const int wd = wid >> 1, wv = wid & 1;
    const GAS bf16* kr = (const GAS bf16*)(ws + WS_KR); const GAS bf16* vr = (const GAS bf16*)(ws + WS_VR);
    GAS bf16* states = (GAS bf16*)a.out;
    f32x4 acc[2][4];
#pragma unroll
    for (int i = 0; i < 2; ++i)
#pragma unroll
        for (int j = 0; j < 4; ++j) acc[i][j] = (f32x4){0.f, 0.f, 0.f, 0.f};
    const int srow = tid >> 4, sch = tid & 15; const unsigned soff = offb(srow, sch);
    const GAS bf16* kp = kr + ((size_t)b * SEQ + srow) * 512 + h * 128 + sch * 8;
    const GAS bf16* vp = vr + ((size_t)b * SEQ + srow) * 1024 + h * 256 + vh * 128 + sch * 8;
    v4u kq[4], vq[4];
    { const int n0 = dir ? 15 : 0;
#pragma unroll
      for (int j = 0; j < 4; ++j) { kq[j] = *(const GAS v4u*)(kp + (size_t)(n0 * 128 + 32 * j) * 512); vq[j] = *(const GAS v4u*)(vp + (size_t)(n0 * 128 + 32 * j) * 1024); } }
    unsigned abase[2][2], bbase[4][2];
#pragma unroll
    for (int t = 0; t < 2; ++t) { const unsigned r = 8 * g + 4 * t + q;
#pragma unroll
        for (int dt = 0; dt < 2; ++dt) abase[dt][t] = offb(r, 2 * (2 * wd + dt) + (p >> 1)) + 8 * (p & 1);
#pragma unroll
        for (int vt = 0; vt < 4; ++vt) bbase[vt][t] = offb(r, 2 * (4 * wv + vt) + (p >> 1)) + 8 * (p & 1); }
#define CH_STAGE(BUFOFF) do { _Pragma("unroll") for (int j = 0; j < 4; ++j) { \
            const int row = srow + 32 * j; const float z = __builtin_amdgcn_exp2f(lg2 * (float)(dir ? row : 127 - row)); const v4u kv = kq[j]; \
            v4u ko; ko.x = cvtpk(bflo(kv.x) * z, bfhi(kv.x) * z); ko.y = cvtpk(bflo(kv.y) * z, bfhi(kv.y) * z); ko.z = cvtpk(bflo(kv.z) * z, bfhi(kv.z) * z); ko.w = cvtpk(bflo(kv.w) * z, bfhi(kv.w) * z); \
            *(LAS v4u*)(lds + (BUFOFF) + soff + j * 8192) = ko; *(LAS v4u*)(lds + (BUFOFF) + 32768 + soff + j * 8192) = vq[j]; } } while (0)
#define CH_FETCH(NN) do { _Pragma("unroll") for (int j = 0; j < 4; ++j) { kq[j] = *(const GAS v4u*)(kp + (size_t)((NN) * 128 + 32 * j) * 512); vq[j] = *(const GAS v4u*)(vp + (size_t)((NN) * 128 + 32 * j) * 1024); } } while (0)
#define CH_STEP(STEP, CUR, OTH) do { const int step_ = (STEP); const int n_ = dir ? 15 - step_ : step_; \
        GAS bf16* sb_ = states + ((((size_t)(b * 4 + h) * 16 + n_) * 2 + dir) * 256) * 128; \
        _Pragma("unroll") for (int dt = 0; dt < 2; ++dt) _Pragma("unroll") for (int vt = 0; vt < 4; ++vt) { \
            const int v_ = vh * 128 + 64 * wv + 16 * vt + i16, d0_ = 32 * wd + 16 * dt + 4 * g; \
            if (STATE_FP8) { *(GAS unsigned*)((GAS unsigned char*)states + (((((size_t)(b * 4 + h) * 16 + n_) * 2 + dir) * 256) + v_) * 128 + d0_) = pg8::fp8x4_sat(acc[dt][vt][0] * 16.f, acc[dt][vt][1] * 16.f, acc[dt][vt][2] * 16.f, acc[dt][vt][3] * 16.f); }   \
            else { u32x2 w_; w_.x = pg8::cvt_pk_bf16_acc(acc[dt][vt][0], acc[dt][vt][1]); w_.y = pg8::cvt_pk_bf16_acc(acc[dt][vt][2], acc[dt][vt][3]);   \
            *(GAS u32x2*)(sb_ + (size_t)v_ * 128 + d0_) = w_; } } \
        if (step_ < 15) CH_STAGE(OTH); \
        if (step_ < 14) CH_FETCH(dir ? 13 - step_ : step_ + 2); \
        _Pragma("unroll") for (int i = 0; i < 2; ++i) _Pragma("unroll") for (int j = 0; j < 4; ++j) acc[i][j] = acc[i][j] * cd; \
        _Pragma("unroll") for (int ks = 0; ks < 4; ++ks) { bf16x8 af[2], bfr[4]; \
            _Pragma("unroll") for (int dt = 0; dt < 2; ++dt) af[dt] = cat8(ldtr(lds + (CUR) + abase[dt][0] + ks * 8192), ldtr(lds + (CUR) + abase[dt][1] + ks * 8192)); \
            _Pragma("unroll") for (int vt = 0; vt < 4; ++vt) bfr[vt] = cat8(ldtr(lds + (CUR) + 32768 + bbase[vt][0] + ks * 8192), ldtr(lds + (CUR) + 32768 + bbase[vt][1] + ks * 8192)); \
            _Pragma("unroll") for (int dt = 0; dt < 2; ++dt) _Pragma("unroll") for (int vt = 0; vt < 4; ++vt) acc[dt][vt] = MFMA16(af[dt], bfr[vt], acc[dt][vt]); } \
        __syncthreads(); } while (0)
    CH_STAGE(0);
    CH_FETCH(dir ? 14 : 1);
    __syncthreads();
    for (int sp = 0; sp < 8; ++sp) { CH_STEP(2 * sp, 0, 65536); CH_STEP(2 * sp + 1, 65536, 0); }
#undef CH_STEP
#undef CH_STAGE
#undef CH_FETCH
}

constexpr int AT_OST = 135168, AT_SCR = AT_OST + 8 * 2048;
constexpr int ATB_N = 160;
struct AttnLane { unsigned kb[2]; unsigned vb[4]; };
__device__ __forceinline__ AttnLane attn_lane(int lane) {
    const int g = lane >> 4, i16 = lane & 15, q4 = i16 >> 2, p = lane & 3; AttnLane L;
#pragma unroll
    for (int s = 0; s < 2; ++s) L.kb[s] = i16 * 128 + (((4 * s + g) ^ ((i16 >> 1) & 7)) * 16);
    const int sw = (2 * g + (q4 >> 1)) & 3;
#pragma unroll
    for (int c = 0; c < 4; ++c) L.vb[c] = (4 * g + q4) * 128 + ((c ^ sw) * 32) + p * 8;
    return L;
}
__device__ __forceinline__ unsigned kimg_off(int row, int c) { return row * 128 + ((c ^ ((row >> 1) & 7)) * 16); }
__device__ __forceinline__ unsigned vimg_off(int row, int c) { return row * 128 + (((c >> 1) ^ ((row >> 1) & 3)) * 32) + (c & 1) * 16; }
__device__ __forceinline__ void attn_core(const LAS unsigned char* Kimg, const LAS unsigned char* Vimg, int R0, int nrows, unsigned tvalid, const bf16x8 (&qf)[2],
                                          const float (&biasr)[36], const AttnLane& L, f32x4 (&O)[4], float& mx, float& lsum) {
    f32x4 D[9];
#pragma unroll
    for (int kt = 0; kt < 9; ++kt) {
        int R = R0 + 16 * kt; R = R < 0 ? 0 : (R > nrows - 16 ? nrows - 16 : R);
        const LAS unsigned char* kp = Kimg + R * 128;
        const bf16x8 k0 = *(const LAS bf16x8*)(kp + L.kb[0]), k1 = *(const LAS bf16x8*)(kp + L.kb[1]);
        f32x4 d = (f32x4){0.f, 0.f, 0.f, 0.f};
        d = MFMA16(k0, qf[0], d); d = MFMA16(k1, qf[1], d); D[kt] = d;
    }
    mx = -1e30f;
#pragma unroll
    for (int kt = 0; kt < 9; ++kt) {
        const float tb = ((tvalid >> kt) & 1u) ? 0.f : -1e30f;
#pragma unroll
        for (int r = 0; r < 4; ++r) { const float x = D[kt][r] + (biasr[4 * kt + r] + tb); D[kt][r] = x; mx = fmaxf(mx, x); }
    }
    mx = fmaxf(mx, __shfl_xor(mx, 16)); mx = fmaxf(mx, __shfl_xor(mx, 32));
    lsum = 0.f;
#pragma unroll
    for (int kt = 0; kt < 9; ++kt)
#pragma unroll
        for (int r = 0; r < 4; ++r) { const float e = __builtin_amdgcn_exp2f(D[kt][r] - mx); D[kt][r] = e; lsum += e; }
    lsum += __shfl_xor(lsum, 16); lsum += __shfl_xor(lsum, 32);
#pragma unroll
    for (int c = 0; c < 4; ++c) O[c] = (f32x4){0.f, 0.f, 0.f, 0.f};
#pragma unroll
    for (int kk = 0; kk < 5; ++kk) {
        int Ra = R0 + 32 * kk; Ra = Ra < 0 ? 0 : (Ra > nrows - 16 ? nrows - 16 : Ra);
        int Rb = R0 + 32 * kk + 16; Rb = Rb < 0 ? 0 : (Rb > nrows - 16 ? nrows - 16 : Rb);
        if (kk == 4) Rb = Ra;
        const f32x4 e0 = D[2 * kk], e1 = kk < 4 ? D[2 * kk + 1] : (f32x4){0.f, 0.f, 0.f, 0.f};
        v4u pw; pw.x = cvtpk(e0[0], e0[1]); pw.y = cvtpk(e0[2], e0[3]); pw.z = cvtpk(e1[0], e1[1]); pw.w = cvtpk(e1[2], e1[3]);
        const bf16x8 pf = __builtin_bit_cast(bf16x8, pw);
        const LAS unsigned char* va_ = Vimg + Ra * 128; const LAS unsigned char* vb_ = Vimg + Rb * 128;
#pragma unroll
        for (int c = 0; c < 4; ++c) O[c] = MFMA16(pf, cat8(ldtr(va_ + L.vb[c]), ldtr(vb_ + L.vb[c])), O[c]);
    }
}
__device__ __forceinline__ void attn_stage_out(LAS unsigned char* lds, int wid, int lane, const f32x4 (&O)[4], float lsum) {
    const int g = lane >> 4, i16 = lane & 15;
    const float linv = 1.f / lsum;
    LAS bf16* st = (LAS bf16*)(lds + AT_OST + wid * 2048);
#pragma unroll
    for (int r = 0; r < 4; ++r) { const float li = __shfl(linv, 4 * g + r);
#pragma unroll
        for (int c = 0; c < 4; ++c) st[(4 * g + r) * 64 + 16 * c + i16] = (bf16)(cvtpk(O[c][r] * li, 0.f) & 0xffffu); }
}
__device__ __forceinline__ void attn_load_bias(const Args& a, int pat, int h, int lane, float (&biasr)[36]) {
    const GAS float* bt = (const GAS float*)(a.ws + WS_BIAS) + (pat * 8 + h) * ATB_N; const int g = lane >> 4, i16 = lane & 15;
#pragma unroll
    for (int kt = 0; kt < 9; ++kt)
#pragma unroll
        for (int r = 0; r < 4; ++r) biasr[4 * kt + r] = bt[16 * kt + 4 * g + r - 64 - i16 + 80];
}
#if ATT_FP8
typedef u32x2 att_raw_t;
#define ATT_LD(base, off) (*(const GAS u32x2*)((const GAS unsigned char*)(base) + (off)))
#define ATT_WIDE(r) fp8x8_to_bf16x8(r)
#define ATT_ZERO ((u32x2){0u, 0u})
#else
typedef v4u att_raw_t;
#define ATT_LD(base, off) (*(const GAS v4u*)((base) + (off)))
#define ATT_WIDE(r) (r)
#define ATT_ZERO ((v4u){0u, 0u, 0u, 0u})
#endif
template <int DIL, int VAR = 0> __device__ __forceinline__ void attn_dil_phase(const Args& a, LAS unsigned char* lds, int vcu, int G, int tid, int wid, int lane) {
    unsigned char* ws = a.ws;
    constexpr int NR = SEQ / DIL, PAT = DIL == 4 ? 1 : 2, CH = NR * 8 / 512, NITEM = NB * 8 * DIL;
    constexpr int NBUF = DIL == 16 ? 2 : 1, BUFB = 2 * NR * 128;
    const GAS bf16* qa = (const GAS bf16*)(ws + WS_QA); const GAS bf16* ka = (const GAS bf16*)(ws + WS_KA); const GAS bf16* va = (const GAS bf16*)(ws + WS_VA);
    bf16* op = (bf16*)(ws + (DIL == 4 ? WS_O2 : WS_O3)); float* lsep = (float*)(ws + (DIL == 4 ? WS_LSE2 : WS_LSE3));
    if (vcu >= NITEM) return;
    const int h = vcu & 7;
    float biasr[36]; attn_load_bias(a, PAT, h, lane, biasr);
    const AttnLane L = attn_lane(lane);
    const int g = lane >> 4, i16 = lane & 15;
    att_raw_t kq[CH], vq[CH], qn[2];
    auto issue = [&](int item, int gi) {
        const int rho = (item >> 3) % DIL, b = item / (8 * DIL); const size_t rowb = (size_t)b * SEQ;
#pragma unroll
        for (int j = 0; j < CH; ++j) { const int id = tid + 512 * j, row = id >> 3, c = id & 7; const size_t go = (rowb + (size_t)row * DIL + rho) * 512 + h * 64 + c * 8;
            kq[j] = ATT_LD(ka, go); vq[j] = ATT_LD(va, go); }
        const size_t qpos = rowb + (size_t)(16 * gi + i16) * DIL + rho;
#pragma unroll
        for (int s = 0; s < 2; ++s) qn[s] = ATT_LD(qa, qpos * 512 + h * 64 + 32 * s + 8 * g);
    };
    issue(vcu, wid);
    int buf = 0;
    for (int item = vcu; item < NITEM; item += G) {
        const int rho = (item >> 3) % DIL, b = item / (8 * DIL); const size_t rowb = (size_t)b * SEQ;
        LAS unsigned char* Kimg = lds + buf * BUFB; LAS unsigned char* Vimg = Kimg + NR * 128;
        if (NBUF == 1) __syncthreads();
#pragma unroll
        for (int j = 0; j < CH; ++j) { const int id = tid + 512 * j, row = id >> 3, c = id & 7;
            *(LAS v4u*)(Kimg + kimg_off(row, c)) = ATT_WIDE(kq[j]); *(LAS v4u*)(Vimg + vimg_off(row, c)) = ATT_WIDE(vq[j]); }
        bf16x8 qf[2] = {__builtin_bit_cast(bf16x8, ATT_WIDE(qn[0])), __builtin_bit_cast(bf16x8, ATT_WIDE(qn[1]))};
        __syncthreads();
        if (NBUF == 2 && item + G < NITEM) issue(item + G, wid);
        for (int gi = wid; gi < NR / 16; gi += 8) {
            const int m0 = 16 * gi;
            if (NBUF == 1 && gi + 8 < NR / 16) {
                const size_t qpos = rowb + (size_t)(m0 + 128 + i16) * DIL + rho;
#pragma unroll
                for (int s = 0; s < 2; ++s) qn[s] = ATT_LD(qa, qpos * 512 + h * 64 + 32 * s + 8 * g); }
            unsigned tvalid = 0u;
#pragma unroll
            for (int kt = 0; kt < 9; ++kt) { const int t0 = m0 - 64 + 16 * kt; tvalid |= (t0 >= 0 && t0 < NR) ? (1u << kt) : 0u; }
            f32x4 O[4]; float mx, lsum;
            if (VAR == 1) { mx = 0.f; lsum = 1.f;
#pragma unroll
                for (int c = 0; c < 4; ++c) O[c] = (f32x4){__builtin_bit_cast(float, qf[0][0] + c), 0.f, 0.f, 0.f}; }
            else attn_core(Kimg, Vimg, m0 - 64, NR, tvalid, qf, biasr, L, O, mx, lsum);
            attn_stage_out(lds, wid, lane, O, lsum);
            if (g == 0) lsep[(rowb + (size_t)(m0 + i16) * DIL + rho) * 8 + h] = mx + __log2f(lsum);
            asm volatile("s_waitcnt lgkmcnt(0)" ::: "memory");
            { const int q = lane >> 2, qt = lane & 3; const LAS v4u* sp = (const LAS v4u*)(lds + AT_OST + wid * 2048 + q * 128 + qt * 32);
              const v4u x0 = sp[0], x1 = sp[1];
#if O23_FP8
              v4u o8;
              o8.x = pk_fp8x4(16.f * bflo(x0.x), 16.f * bfhi(x0.x), 16.f * bflo(x0.y), 16.f * bfhi(x0.y)); o8.y = pk_fp8x4(16.f * bflo(x0.z), 16.f * bfhi(x0.z), 16.f * bflo(x0.w), 16.f * bfhi(x0.w));
              o8.z = pk_fp8x4(16.f * bflo(x1.x), 16.f * bfhi(x1.x), 16.f * bflo(x1.y), 16.f * bfhi(x1.y)); o8.w = pk_fp8x4(16.f * bflo(x1.z), 16.f * bfhi(x1.z), 16.f * bflo(x1.w), 16.f * bfhi(x1.w));
              *(v4u*)((unsigned char*)op + (rowb + (size_t)(m0 + q) * DIL + rho) * 512 + h * 64 + qt * 16) = o8; }
#else
              bf16* dst = op + (rowb + (size_t)(m0 + q) * DIL + rho) * 512 + h * 64 + qt * 16;
              *(v4u*)dst = x0; *(v4u*)(dst + 8) = x1; }
#endif
            asm volatile("s_waitcnt lgkmcnt(0)" ::: "memory");
            if (NBUF == 1) { qf[0] = __builtin_bit_cast(bf16x8, ATT_WIDE(qn[0])); qf[1] = __builtin_bit_cast(bf16x8, ATT_WIDE(qn[1])); }
        }
        if (NBUF == 1 && item + G < NITEM) issue(item + G, wid);
        buf ^= (NBUF - 1);
    }
    __syncthreads();
}
__device__ __forceinline__ void attn_p1_phase(const Args& a, LAS unsigned char* lds, int vcu, int G, int tid, int wid, int lane) {
    unsigned char* ws = a.ws;
    LAS unsigned char* Kimg = lds; LAS unsigned char* Vimg = lds + 384 * 128;
    const GAS bf16* qa = (const GAS bf16*)(ws + WS_QA); const GAS bf16* ka = (const GAS bf16*)(ws + WS_KA); const GAS bf16* va = (const GAS bf16*)(ws + WS_VA);
    const GAS bf16* o2 = (const GAS bf16*)(ws + WS_O2); const GAS bf16* o3 = (const GAS bf16*)(ws + WS_O3);
    const GAS float* lse2 = (const GAS float*)(ws + WS_LSE2); const GAS float* lse3 = (const GAS float*)(ws + WS_LSE3);
    bf16* oa = (bf16*)(ws + WS_OA);
    if (vcu >= 1024) return;
    const int h = vcu & 7;
    float biasr[36]; attn_load_bias(a, 0, h, lane, biasr);
    const AttnLane L = attn_lane(lane);
    const int g = lane >> 4, i16 = lane & 15;
    LAS float* scr = (LAS float*)(lds + AT_SCR) + wid * 16;
    att_raw_t kq[6], vq[6];
    auto issue = [&](int item) { const int b = item >> 6, s0 = ((item >> 3) & 7) * 256; const size_t rowb = (size_t)b * SEQ;
#pragma unroll
        for (int j = 0; j < 6; ++j) { const int id = tid + 512 * j, row = id >> 3, c = id & 7, pos = s0 - 64 + row; const bool ok = pos >= 0 && pos < SEQ;
            const size_t go = (rowb + (size_t)(ok ? pos : 0)) * 512 + h * 64 + c * 8;
            kq[j] = ATT_LD(ka, go); vq[j] = ATT_LD(va, go);
            if (!ok) { kq[j] = ATT_ZERO; vq[j] = ATT_ZERO; } } };
    issue(vcu);
    for (int item = vcu; item < 1024; item += G) {
        const int b = item >> 6, s0 = ((item >> 3) & 7) * 256; const size_t rowb = (size_t)b * SEQ;
        __syncthreads();
#pragma unroll
        for (int j = 0; j < 6; ++j) { const int id = tid + 512 * j, row = id >> 3, c = id & 7;
            *(LAS v4u*)(Kimg + kimg_off(row, c)) = ATT_WIDE(kq[j]); *(LAS v4u*)(Vimg + vimg_off(row, c)) = ATT_WIDE(vq[j]); }
        __syncthreads();
        if (item + G < 1024) issue(item + G);
        for (int gi = wid; gi < 16; gi += 8) {
            const int m0 = s0 + 16 * gi;
            const int q = lane >> 2, qt = lane & 3; const size_t tq = rowb + m0 + q;
#if O23_FP8
            const v4u a2q = *(const GAS v4u*)((const GAS unsigned char*)o2 + tq * 512 + h * 64 + qt * 16), a3q = *(const GAS v4u*)((const GAS unsigned char*)o3 + tq * 512 + h * 64 + qt * 16);
#else
            const v4u a20 = *(const GAS v4u*)(o2 + tq * 512 + h * 64 + qt * 16), a21 = *(const GAS v4u*)(o2 + tq * 512 + h * 64 + qt * 16 + 8);
            const v4u a30 = *(const GAS v4u*)(o3 + tq * 512 + h * 64 + qt * 16), a31 = *(const GAS v4u*)(o3 + tq * 512 + h * 64 + qt * 16 + 8);
#endif
            const float l2 = lse2[tq * 8 + h], l3 = lse3[tq * 8 + h];
            bf16x8 qf[2];
#pragma unroll
            for (int s = 0; s < 2; ++s) qf[s] = __builtin_bit_cast(bf16x8, ATT_WIDE(ATT_LD(qa, (rowb + m0 + i16) * 512 + h * 64 + 32 * s + 8 * g)));
            unsigned tvalid = 0u;
#pragma unroll
            for (int kt = 0; kt < 9; ++kt) { const int t0 = m0 - 64 + 16 * kt; tvalid |= (t0 >= 0 && t0 < SEQ) ? (1u << kt) : 0u; }
            f32x4 O[4]; float mx, lsum;
            attn_core(Kimg, Vimg, 16 * gi, 384, tvalid, qf, biasr, L, O, mx, lsum);
            attn_stage_out(lds, wid, lane, O, lsum);
            if (g == 0) scr[i16] = mx + __log2f(lsum);
            asm volatile("s_waitcnt lgkmcnt(0)" ::: "memory");
            {
                const float l1 = scr[q], M = fmaxf(l1, fmaxf(l2, l3));
                float w1 = __builtin_amdgcn_exp2f(l1 - M), w2 = __builtin_amdgcn_exp2f(l2 - M), w3 = __builtin_amdgcn_exp2f(l3 - M); const float wi = 1.f / (w1 + w2 + w3); w1 *= wi; w2 *= wi; w3 *= wi;
                const LAS v4u* sp = (const LAS v4u*)(lds + AT_OST + wid * 2048 + q * 128 + qt * 32);
                const v4u x0 = sp[0], x1 = sp[1];
                v4u r0, r1;
#if O23_FP8
                { typedef float f2_ __attribute__((ext_vector_type(2))); const float w2s = w2 * 0.0625f, w3s = w3 * 0.0625f;
#define MRG8(d, x, yw, zw, hi) { const f2_ y_ = __builtin_amdgcn_cvt_pk_f32_fp8(yw, hi), z_ = __builtin_amdgcn_cvt_pk_f32_fp8(zw, hi); d = cvtpk(w1 * bflo(x) + w2s * y_[0] + w3s * z_[0], w1 * bfhi(x) + w2s * y_[1] + w3s * z_[1]); }
                MRG8(r0.x, x0.x, a2q.x, a3q.x, false) MRG8(r0.y, x0.y, a2q.x, a3q.x, true) MRG8(r0.z, x0.z, a2q.y, a3q.y, false) MRG8(r0.w, x0.w, a2q.y, a3q.y, true)
                MRG8(r1.x, x1.x, a2q.z, a3q.z, false) MRG8(r1.y, x1.y, a2q.z, a3q.z, true) MRG8(r1.z, x1.z, a2q.w, a3q.w, false) MRG8(r1.w, x1.w, a2q.w, a3q.w, true)
#undef MRG8
                }
#else
#define MRG(d, x, y, z) d = cvtpk(w1 * bflo(x) + w2 * bflo(y) + w3 * bflo(z), w1 * bfhi(x) + w2 * bfhi(y) + w3 * bfhi(z))
                MRG(r0.x, x0.x, a20.x, a30.x); MRG(r0.y, x0.y, a20.y, a30.y); MRG(r0.z, x0.z, a20.z, a30.z); MRG(r0.w, x0.w, a20.w, a30.w);
                MRG(r1.x, x1.x, a21.x, a31.x); MRG(r1.y, x1.y, a21.y, a31.y); MRG(r1.z, x1.z, a21.z, a31.z); MRG(r1.w, x1.w, a21.w, a31.w);
#undef MRG
#endif
#if MIX_FP8 & 2
                v4u o8;
                o8.x = pk_fp8x4(16.f * bflo(r0.x), 16.f * bfhi(r0.x), 16.f * bflo(r0.y), 16.f * bfhi(r0.y)); o8.y = pk_fp8x4(16.f * bflo(r0.z), 16.f * bfhi(r0.z), 16.f * bflo(r0.w), 16.f * bfhi(r0.w));
                o8.z = pk_fp8x4(16.f * bflo(r1.x), 16.f * bfhi(r1.x), 16.f * bflo(r1.y), 16.f * bfhi(r1.y)); o8.w = pk_fp8x4(16.f * bflo(r1.z), 16.f * bfhi(r1.z), 16.f * bflo(r1.w), 16.f * bfhi(r1.w));
                *(v4u*)((unsigned char*)oa + tq * 512 + h * 64 + qt * 16) = o8;
#else
                bf16* dst = oa + tq * 512 + h * 64 + qt * 16;
                *(v4u*)dst = r0; *(v4u*)(dst + 8) = r1;
#endif
            }
            asm volatile("s_waitcnt lgkmcnt(0)" ::: "memory");
        }
    }
    __syncthreads();
}

#define OPAQUE(x) asm volatile("" : "+v"(x))
template <int VAR = 0> __device__ __forceinline__ void p3_phase(const Args& a, LAS unsigned char* lds, int vcu, int G, int tid, int wid, int lane) {
    unsigned char* ws = a.ws;
    const int g = lane >> 4, i16 = lane & 15, q4 = i16 >> 2, p = lane & 3;
    const GAS bf16* qr = (const GAS bf16*)(ws + WS_QR); const GAS bf16* kr = (const GAS bf16*)(ws + WS_KR); const GAS bf16* vr = (const GAS bf16*)(ws + WS_VR);
    GAS bf16* gr = (GAS bf16*)(ws + WS_GR);
    LAS unsigned char* Kt = lds; LAS unsigned char* Sg = lds + 32768;
    if (vcu >= 1024) return;
    const unsigned kdst = offb(tid >> 4, tid & 15);
    unsigned rfo[4];
    { const unsigned X = ((i16 & 3) << 2) | (i16 >> 2);
#pragma unroll
      for (int s = 0; s < 4; ++s) rfo[s] = 256 * i16 + 16 * (((4 * s) ^ (X & 12)) | (g ^ (X & 3))); }
    v4u sreg[8], kreg[4]; bf16x8 qn[4];
    auto item_ptrs = [&](int item, size_t& tok0, const GAS bf16*& sf, int& h) { const int b = item >> 6; h = (item >> 4) & 3; const int n = item & 15; tok0 = (size_t)b * SEQ + n * 128;
        sf = (const GAS bf16*)((const GAS unsigned char*)a.out + ((((size_t)(b * 4 + h) * 16 + n) * 2 + 0) * 256) * 128 * (STATE_FP8 ? 1 : 2)); };
    auto issue_k = [&](int item) { size_t tok0; const GAS bf16* sf; int h; item_ptrs(item, tok0, sf, h);
        const GAS bf16* ks_ = kr + (tok0 + (tid >> 4)) * 512 + h * 128 + (tid & 15) * 8;
#pragma unroll
        for (int j = 0; j < 4; ++j) kreg[j] = *(const GAS v4u*)(ks_ + (size_t)j * 32 * 512); };
    auto issue_q = [&](int item) { size_t tok0; const GAS bf16* sf; int h; item_ptrs(item, tok0, sf, h);
#pragma unroll
        for (int s = 0; s < 4; ++s) qn[s] = *(const GAS bf16x8*)(qr + (tok0 + 16 * wid + i16) * 512 + h * 128 + 32 * s + 8 * g); };
#if STATE_FP8
    auto issue_state = [&](const GAS bf16* sf, int dirn) { const GAS unsigned char* sld = (const GAS unsigned char*)sf + (size_t)dirn * 256 * 128 + (size_t)(tid >> 4) * 128 + (tid & 15) * 8;
#pragma unroll
        for (int j = 0; j < 4; ++j) { const u32x2 lo = *(const GAS u32x2*)(sld + (size_t)(2 * j) * 32 * 128), hi = *(const GAS u32x2*)(sld + (size_t)(2 * j + 1) * 32 * 128); sreg[j] = (v4u){lo.x, lo.y, hi.x, hi.y}; } };
    auto write_state = [&]() {
#pragma unroll
        for (int j = 0; j < 8; ++j) { typedef float f2_ __attribute__((ext_vector_type(2)));
            const unsigned w0 = (j & 1) ? sreg[j >> 1].z : sreg[j >> 1].x, w1 = (j & 1) ? sreg[j >> 1].w : sreg[j >> 1].y;
            const f2_ a0 = __builtin_amdgcn_cvt_pk_f32_fp8(w0, false), a1 = __builtin_amdgcn_cvt_pk_f32_fp8(w0, true), a2 = __builtin_amdgcn_cvt_pk_f32_fp8(w1, false), a3 = __builtin_amdgcn_cvt_pk_f32_fp8(w1, true);
            v4u o; o.x = cvtpk(a0[0], a0[1]); o.y = cvtpk(a1[0], a1[1]); o.z = cvtpk(a2[0], a2[1]); o.w = cvtpk(a3[0], a3[1]);
            *(LAS v4u*)(Sg + (j >> 2) * 32768 + kdst + (j & 3) * 8192) = o; asm volatile("" ::: "memory"); } };
#else
    auto issue_state = [&](const GAS bf16* sf, int dirn) { const GAS bf16* sld = sf + (size_t)dirn * 256 * 128 + (size_t)(tid >> 4) * 128 + (tid & 15) * 8;
#pragma unroll
        for (int j = 0; j < 8; ++j) sreg[j] = *(const GAS v4u*)(sld + (size_t)j * 32 * 128); };
    auto write_state = [&]() {
#pragma unroll
        for (int j = 0; j < 8; ++j) *(LAS v4u*)(Sg + (j >> 2) * 32768 + kdst + (j & 3) * 8192) = sreg[j]; };
#endif
    { size_t tok0; const GAS bf16* sf; int h; item_ptrs(vcu, tok0, sf, h); issue_k(vcu); issue_q(vcu); issue_state(sf, 0); }
#pragma unroll
    for (int j = 0; j < 4; ++j) *(LAS v4u*)(Kt + kdst + j * 8192) = kreg[j];
    for (int item = vcu; item < 1024; item += G) {
        size_t tok0; const GAS bf16* sf; int h; item_ptrs(item, tok0, sf, h);
        const float lf2 = log2_gamma(a.in[2], h), lb2 = log2_gamma(a.in[3], h);
        bf16x8 qf[4];
#pragma unroll
        for (int s = 0; s < 4; ++s) qf[s] = qn[s];
        const bool has_next = item + G < 1024;
        __syncthreads();
        f32x4 D[8];
#pragma unroll
        for (int jt = 0; jt < 8; ++jt) {
            f32x4 d = (f32x4){0.f, 0.f, 0.f, 0.f};
#pragma unroll
            for (int s = 0; s < 4; ++s) { if (VAR != 1) { const bf16x8 kf = *(const LAS bf16x8*)(Kt + rfo[s] + jt * 4096); d = MFMA16(kf, qf[s], d); } else d[s] = __builtin_bit_cast(float, (int)qf[s][0]); }
            D[jt] = d;
        }
        int iq = 16 * wid + i16; OPAQUE(iq);
        bf16x8 pf[4];
#pragma unroll
        for (int ks = 0; ks < 4; ++ks) {
            float e[8];
#pragma unroll
            for (int t = 0; t < 2; ++t)
#pragma unroll
                for (int r = 0; r < 4; ++r) {
                    const int j = 16 * (2 * ks + t) + 4 * g + r; const float fdf = (float)(iq - j), ad = fabsf(fdf);
                    const float pos = fminf(fmaxf(fdf, 0.f), 1.f), isz = 1.f - fminf(ad, 1.f);
                    const float w = __builtin_amdgcn_exp2f((lb2 + (lf2 - lb2) * pos) * ad) + isz;
                    e[4 * t + r] = D[2 * ks + t][r] * w;
                }
            v4u pw; pw.x = cvtpk(e[0], e[1]); pw.y = cvtpk(e[2], e[3]); pw.z = cvtpk(e[4], e[5]); pw.w = cvtpk(e[6], e[7]);
            pf[ks] = __builtin_bit_cast(bf16x8, pw);
        }
        f32x4 acc[16];
#pragma unroll
        for (int vt = 0; vt < 16; ++vt) acc[vt] = (f32x4){0.f, 0.f, 0.f, 0.f};
#pragma unroll
        for (int dirn = 0; dirn < 2; ++dirn) {
            if (dirn == 1) __syncthreads();
            write_state();
            if (dirn == 0) { issue_state(sf, 1); if (has_next) issue_k(item + G); }
            else {
                if (has_next) {
#pragma unroll
                    for (int j = 0; j < 4; ++j) *(LAS v4u*)(Kt + kdst + j * 8192) = kreg[j]; }
                const GAS bf16* vs_ = vr + (tok0 + (tid >> 5)) * 1024 + h * 256 + (tid & 31) * 8;
#pragma unroll
                for (int j = 0; j < 8; ++j) sreg[j] = *(const GAS v4u*)(vs_ + (size_t)j * 16 * 1024);
            }
            __syncthreads();
#pragma unroll
            for (int vt = 0; vt < 16; ++vt) {
#pragma unroll
                for (int s = 0; s < 4; ++s) { if (VAR != 1) { const bf16x8 sfr = *(const LAS bf16x8*)(Sg + (vt >> 3) * 32768 + rfo[s] + (vt & 7) * 4096); acc[vt] = MFMA16(qf[s], sfr, acc[vt]); } }
            }
            float xs[4];
            { int ib = 16 * wid + 4 * g; OPAQUE(ib);
#pragma unroll
              for (int r = 0; r < 4; ++r) { const float lxf = lf2 * (float)(ib + r + 1), lxb = lb2 * (float)(128 - ib - r); xs[r] = __builtin_amdgcn_exp2f(dirn == 0 ? lxf - lxb : lxb - (STATE_FP8 ? 4.f : 0.f)); } }
#pragma unroll
            for (int vt = 0; vt < 16; ++vt)
#pragma unroll
                for (int r = 0; r < 4; ++r) acc[vt][r] *= xs[r];
        }
        __syncthreads();
        { int t2 = tid; OPAQUE(t2); const unsigned vd2 = (unsigned)((t2 & 31) >> 4) * 32768u + offb(t2 >> 5, t2 & 15);
#pragma unroll
          for (int j = 0; j < 8; ++j) *(LAS v4u*)(Sg + vd2 + j * 4096) = sreg[j]; }
        GAS bf16* gp = gr + (tok0 + 16 * wid + (lane >> 5)) * 1024 + h * 256 + (lane & 31) * 8;
#if MIX_FP8 & 4
        GAS unsigned char* ar8 = (GAS unsigned char*)(ws + WS_AR8) + (tok0 + 16 * wid + (lane >> 5)) * 1024 + h * 256 + (lane & 31) * 8;
#endif
        __syncthreads();
        unsigned vbs[8];
        { int l2 = lane; OPAQUE(l2); const unsigned g2 = l2 >> 4, q2 = (l2 & 15) >> 2, p2 = l2 & 3, X = (q2 << 2) | g2;
#pragma unroll
          for (int c = 0; c < 8; ++c) vbs[c] = 256 * (4 * g2 + q2) + 16 * (((2 * c) ^ (X & 14)) | ((p2 >> 1) ^ (X & 1))) + 8 * (p2 & 1); }
#pragma unroll
        for (int vt = 0; vt < 16; ++vt) {
#pragma unroll
            for (int ks = 0; ks < 4; ++ks) { if (VAR != 1) {
                const s16x4 lo = ldtr(Sg + vbs[vt & 7] + (vt >> 3) * 32768 + ks * 8192), hi = ldtr(Sg + vbs[vt & 7] + (vt >> 3) * 32768 + ks * 8192 + 4096);
                acc[vt] = MFMA16(pf[ks], cat8(lo, hi), acc[vt]); }
            }
            asm volatile("" ::: "memory");
        }
        float mu[4], rs[4];
#pragma unroll
        for (int r = 0; r < 4; ++r) {
            float s = 0.f;
#pragma unroll
            for (int vt = 0; vt < 16; ++vt) s += acc[vt][r];
            s += __shfl_xor(s, 1); s += __shfl_xor(s, 2); s += __shfl_xor(s, 4); s += __shfl_xor(s, 8);
            const float m = s * (1.f / 256.f); float qv = 0.f;
#pragma unroll
            for (int vt = 0; vt < 16; ++vt) { const float d = acc[vt][r] - m; qv += d * d; }
            qv += __shfl_xor(qv, 1); qv += __shfl_xor(qv, 2); qv += __shfl_xor(qv, 4); qv += __shfl_xor(qv, 8);
            mu[r] = m; rs[r] = 1.f / sqrtf(qv * (1.f / 256.f) + LN_EPSF);
        }
        v4u greg[8];
#pragma unroll
        for (int j = 0; j < 8; ++j) greg[j] = *(const GAS v4u*)(gp + (size_t)j * 2048);
        __syncthreads();
        if (has_next) { size_t tk; const GAS bf16* sfn; int hn; item_ptrs(item + G, tk, sfn, hn); issue_state(sfn, 0); issue_q(item + G); }
        LAS bf16* st = (LAS bf16*)(Sg + wid * 8192);
        { LAS bf16* sp_ = st + (4 * g) * 256 + i16;
#pragma unroll
          for (int vt = 0; vt < 16; ++vt)
#pragma unroll
              for (int r = 0; r < 4; ++r) sp_[r * 256 + 16 * vt] = (bf16)(cvtpk((acc[vt][r] - mu[r]) * rs[r], 0.f) & 0xffffu); }
        asm volatile("s_waitcnt lgkmcnt(0)" ::: "memory");
        {
            const float* gn = a.in[4] + h * 256; const int ch = lane & 31;
            const f32x4 g0 = *(const f32x4*)(gn + ch * 8), g1 = *(const f32x4*)(gn + ch * 8 + 4);
            const LAS bf16* yp = st + (lane >> 5) * 256 + ch * 8;
#pragma unroll
            for (int j = 0; j < 8; ++j) {
                const v4u y = *(const LAS v4u*)(yp + j * 512); const v4u sg = greg[j];
#if SILU_IN_P3
#define GSW(w, hi) pg8::fsilu((hi) ? bfhi(w) : bflo(w))
#else
#define GSW(w, hi) ((hi) ? bfhi(w) : bflo(w))
#endif
                v4u o; o.x = cvtpk(bflo(y.x) * g0[0] * GSW(sg.x, 0), bfhi(y.x) * g0[1] * GSW(sg.x, 1)); o.y = cvtpk(bflo(y.y) * g0[2] * GSW(sg.y, 0), bfhi(y.y) * g0[3] * GSW(sg.y, 1));
                o.z = cvtpk(bflo(y.z) * g1[0] * GSW(sg.z, 0), bfhi(y.z) * g1[1] * GSW(sg.z, 1)); o.w = cvtpk(bflo(y.w) * g1[2] * GSW(sg.w, 0), bfhi(y.w) * g1[3] * GSW(sg.w, 1));
#undef GSW
#if MIX_FP8 & 4
                u32x2 o8; o8.x = pk_fp8x4(bflo(o.x), bfhi(o.x), bflo(o.y), bfhi(o.y)); o8.y = pk_fp8x4(bflo(o.z), bfhi(o.z), bflo(o.w), bfhi(o.w));
                *(GAS u32x2*)(ar8 + (size_t)j * 2048) = o8;
#else
                *(GAS v4u*)(gp + (size_t)j * 2048) = o;
#endif
            }
        }
        __syncthreads();
    }
}

constexpr int P6_RS = 81920, P6_CNT = P6_RS + 8 * 512, P6_BASE = P6_CNT + 64, P6_ROW = P6_BASE + 64;
#define P6_BUTTERFLY(lg, out) do { float r10[10], r5[5], r3[3], r2[2]; const float z = 0.f; \
    _Pragma("unroll") for (int k = 0; k < 10; ++k) { const float keep = h32 ? lg[10 + k] : lg[k], send = h32 ? lg[k] : lg[10 + k]; r10[k] = keep + __shfl_xor(send, 32); } \
    _Pragma("unroll") for (int k = 0; k < 5; ++k) { const float keep = h16 ? r10[5 + k] : r10[k], send = h16 ? r10[k] : r10[5 + k]; r5[k] = keep + __shfl_xor(send, 16); } \
    { const float keep = h8 ? r5[3] : r5[0], send = h8 ? r5[0] : r5[3]; r3[0] = keep + __shfl_xor(send, 8); } \
    { const float keep = h8 ? r5[4] : r5[1], send = h8 ? r5[1] : r5[4]; r3[1] = keep + __shfl_xor(send, 8); } \
    { const float keep = h8 ? z : r5[2], send = h8 ? r5[2] : z; r3[2] = keep + __shfl_xor(send, 8); } \
    { const float keep = h4 ? r3[2] : r3[0], send = h4 ? r3[0] : r3[2]; r2[0] = keep + __shfl_xor(send, 4); } \
    { const float keep = h4 ? z : r3[1], send = h4 ? r3[1] : z; r2[1] = keep + __shfl_xor(send, 4); } \
    { const float keep = h2 ? r2[1] : r2[0], send = h2 ? r2[0] : r2[1]; out = keep + __shfl_xor(send, 2); } \
    out += __shfl_xor(out, 1); } while (0)
__device__ __forceinline__ void p6a_phase(const Args& a, LAS unsigned char* lds, int vcu, int G, int tid, int wave, int lane) {
    unsigned char* ws = a.ws;
    LAS float* RW = (LAS float*)lds;
    LAS float* RS = (LAS float*)(lds + P6_RS) + wave * 128;
    LAS unsigned* LC = (LAS unsigned*)(lds + P6_CNT); LAS unsigned* LB = (LAS unsigned*)(lds + P6_BASE); LAS unsigned* LR = (LAS unsigned*)(lds + P6_ROW);
    {
        const f32x4* wgp = (const f32x4*)a.in[11]; const f32x4* wep = (const f32x4*)a.in[13];
        f32x4 gq[2], eq[8];
#pragma unroll
        for (int u = 0; u < 2; ++u) gq[u] = wgp[tid + 512 * u];
#pragma unroll
        for (int u = 0; u < 8; ++u) eq[u] = wep[tid + 512 * u];
#pragma unroll
        for (int u = 0; u < 2; ++u) { const int c = tid + 512 * u;
#pragma unroll
            for (int k = 0; k < 4; ++k) RW[k * 1024 + c] = gq[u][k]; }
#pragma unroll
        for (int u = 0; u < 8; ++u) { const int q = tid + 512 * u, c = q >> 2, k4 = q & 3;
#pragma unroll
            for (int k = 0; k < 4; ++k) RW[(4 + 4 * k4 + k) * 1024 + c] = eq[u][k]; }
    }
    const u32x2* pre = (const u32x2*)a.out; u32x2* x1b = (u32x2*)(ws + WS_XB); [[maybe_unused]] unsigned* x1f8 = (unsigned*)(ws + WS_X1F8);
    gu32* ctl = (gu32*)ws;
    int* ltok = (int*)(ws + WS_LTOK); float* tw = (float*)(ws + WS_WSLOT); unsigned* tinfo = (unsigned*)(ws + WS_TINFO);
    const float* g1 = a.in[9]; const float* b1 = a.in[10];
    const bool h32 = (lane & 32) != 0, h16 = (lane & 16) != 0, h8 = (lane & 8) != 0, h4 = (lane & 4) != 0, h2 = (lane & 2) != 0;
#define P6_LOADROW(dst, t_) do { const u32x2* xr_ = pre + (size_t)(t_) * 256 + lane; _Pragma("unroll") for (int j = 0; j < 4; ++j) dst[j] = xr_[64 * j]; } while (0)
#define P6_LN(v, nx, s) do { s = 0.f; _Pragma("unroll") for (int j = 0; j < 4; ++j) { v[j] = (f32x4){bflo(nx[j].x), bfhi(nx[j].x), bflo(nx[j].y), bfhi(nx[j].y)}; s += (v[j].x + v[j].y) + (v[j].z + v[j].w); } } while (0)
#define P6_VAR(v, mean, q) do { q = 0.f; _Pragma("unroll") for (int j = 0; j < 4; ++j) { v[j] = v[j] - mean; q += (v[j].x * v[j].x + v[j].y * v[j].y) + (v[j].z * v[j].z + v[j].w * v[j].w); } } while (0)
#if M1_FP8
#define P6_STORE(v, t_, j) do { u32x2 o_; o_.x = cvtpk(v[j].x, v[j].y); o_.y = cvtpk(v[j].z, v[j].w); x1b[(size_t)(t_) * 256 + lane + 64 * j] = o_; x1f8[(size_t)(t_) * 256 + lane + 64 * j] = pk_fp8x4(v[j].x, v[j].y, v[j].z, v[j].w); } while (0)
#else
#define P6_STORE(v, t_, j) do { u32x2 o_; o_.x = cvtpk(v[j].x, v[j].y); o_.y = cvtpk(v[j].z, v[j].w); x1b[(size_t)(t_) * 256 + lane + 64 * j] = o_; } while (0)
#endif
#define P6_DOT(lg, v, j, k, w) lg[k] += (v[j][0] * w[0] + v[j][1] * w[1]) + (v[j][2] * w[2] + v[j][3] * w[3])
    for (int blk = vcu; blk < TT / 128; blk += G) {
        if (tid < 16) LC[tid] = 0u;
        __syncthreads();
        const int t0 = blk * 128;
        u32x2 nxA[4], nxB[4], nxC[4], nxD[4];
        P6_LOADROW(nxA, t0 + wave); P6_LOADROW(nxB, t0 + wave + 8); P6_LOADROW(nxC, t0 + wave + 16); P6_LOADROW(nxD, t0 + wave + 24);
        for (int rr = 0; rr < 4; ++rr) {
            const int rl0 = wave + 32 * rr, tA = t0 + rl0, tB = tA + 8, tC = tA + 16, tD = tA + 24;
            f32x4 vA[4], vB[4], vC[4], vD[4]; float sA, sB, sC, sD;
            P6_LN(vA, nxA, sA); P6_LN(vB, nxB, sB); P6_LN(vC, nxC, sC); P6_LN(vD, nxD, sD);
            if (rr < 3) { P6_LOADROW(nxA, tA + 32); P6_LOADROW(nxB, tB + 32); P6_LOADROW(nxC, tC + 32); P6_LOADROW(nxD, tD + 32); }
            const float mA = wave_sum(sA) * (1.f / DM), mB = wave_sum(sB) * (1.f / DM), mC = wave_sum(sC) * (1.f / DM), mD = wave_sum(sD) * (1.f / DM);
            float qA, qB, qC, qD;
            P6_VAR(vA, mA, qA); P6_VAR(vB, mB, qB); P6_VAR(vC, mC, qC); P6_VAR(vD, mD, qD);
            const float rA = 1.f / sqrtf(wave_sum(qA) * (1.f / DM) + LN_EPSF), rB = 1.f / sqrtf(wave_sum(qB) * (1.f / DM) + LN_EPSF);
            const float rC = 1.f / sqrtf(wave_sum(qC) * (1.f / DM) + LN_EPSF), rD = 1.f / sqrtf(wave_sum(qD) * (1.f / DM) + LN_EPSF);
            typedef float f32x2p __attribute__((ext_vector_type(2)));
            f32x2p lgAB[20], lgCD[20];
#pragma unroll
            for (int k = 0; k < 20; ++k) { lgAB[k] = (f32x2p){0.f, 0.f}; lgCD[k] = (f32x2p){0.f, 0.f}; }
#pragma unroll
            for (int j = 0; j < 4; ++j) {
                const f32x4 gg = *(const f32x4*)(g1 + 4 * lane + 256 * j), bb = *(const f32x4*)(b1 + 4 * lane + 256 * j);
                vA[j] = vA[j] * rA * gg + bb; vB[j] = vB[j] * rB * gg + bb; vC[j] = vC[j] * rC * gg + bb; vD[j] = vD[j] * rD * gg + bb;
                P6_STORE(vA, tA, j); P6_STORE(vB, tB, j); P6_STORE(vC, tC, j); P6_STORE(vD, tD, j);
                f32x2p pab[4], pcd[4];
#pragma unroll
                for (int e = 0; e < 4; ++e) { pab[e] = (f32x2p){vA[j][e], vB[j][e]}; pcd[e] = (f32x2p){vC[j][e], vD[j][e]}; }
#pragma unroll
                for (int k = 0; k < 20; ++k) { const f32x4 w = *(const LAS f32x4*)(RW + k * 1024 + 4 * lane + 256 * j);
#pragma unroll
                    for (int e = 0; e < 4; ++e) { const f32x2p ww = (f32x2p){w[e], w[e]};
                        lgAB[k] = __builtin_elementwise_fma(pab[e], ww, lgAB[k]); lgCD[k] = __builtin_elementwise_fma(pcd[e], ww, lgCD[k]); } }
            }
            float lgA[20], lgB[20], lgC[20], lgD[20];
#pragma unroll
            for (int k = 0; k < 20; ++k) { lgA[k] = lgAB[k].x; lgB[k] = lgAB[k].y; lgC[k] = lgCD[k].x; lgD[k] = lgCD[k].y; }
            float r1A, r1B, r1C, r1D;
            P6_BUTTERFLY(lgA, r1A); P6_BUTTERFLY(lgB, r1B); P6_BUTTERFLY(lgC, r1C); P6_BUTTERFLY(lgD, r1D);
            {
                const int i3 = h2 ? (h4 ? -1 : 1) : (h4 ? 2 : 0);
                const int i5 = i3 < 0 ? -1 : (h8 ? (i3 == 2 ? -1 : i3 + 3) : i3);
                const int kk = i5 < 0 ? -1 : (h32 ? 10 : 0) + (h16 ? 5 : 0) + i5;
                if (kk >= 0 && (lane & 1) == 0) { RS[kk] = r1A; RS[32 + kk] = r1B; RS[64 + kk] = r1C; RS[96 + kk] = r1D; }
            }
            asm volatile("s_waitcnt lgkmcnt(0)" ::: "memory");
            {
                const int sel = lane & 3; const int rl = rl0 + 8 * sel;
                float tl[20];
#pragma unroll
                for (int k4 = 0; k4 < 5; ++k4) { const f32x4 w = *(const LAS f32x4*)(RS + sel * 32 + 4 * k4); tl[4 * k4] = w[0]; tl[4 * k4 + 1] = w[1]; tl[4 * k4 + 2] = w[2]; tl[4 * k4 + 3] = w[3]; }
                float gl[4];
#pragma unroll
                for (int k = 0; k < 4; ++k) gl[k] = tl[k] + a.in[12][k];
                int gi = 0; float gm = gl[0];
#pragma unroll
                for (int k = 1; k < 4; ++k) if (gl[k] > gm) { gm = gl[k]; gi = k; }
                float gs = 0.f;
#pragma unroll
                for (int k = 0; k < 4; ++k) gs += __expf(gl[k] - gm);
                const float gwt = 1.f / gs;
                float el[4];
#pragma unroll
                for (int k = 0; k < 4; ++k) { const float se = gi == 0 ? tl[4 + k] : (gi == 1 ? tl[8 + k] : (gi == 2 ? tl[12 + k] : tl[16 + k])); el[k] = se + a.in[14][4 * gi + k]; }
                int i1 = 0; float v1 = el[0];
#pragma unroll
                for (int k = 1; k < 4; ++k) if (el[k] > v1) { v1 = el[k]; i1 = k; }
                int i2 = (i1 + 1) & 3; float v2 = -3.0e38f;
#pragma unroll
                for (int k = 0; k < 4; ++k) if (k != i1 && el[k] > v2) { v2 = el[k]; i2 = k; }
                const float ex = __expf(v2 - v1), w1 = gwt / (1.f + ex), w2 = gwt * ex / (1.f + ex);
                if (lane < 4) {
                    const int e1 = 4 * gi + i1, e2 = 4 * gi + i2;
                    const unsigned p1 = __hip_atomic_fetch_add(LC + e1, 1u, __ATOMIC_RELAXED, __HIP_MEMORY_SCOPE_WORKGROUP);
                    const unsigned p2 = __hip_atomic_fetch_add(LC + e2, 1u, __ATOMIC_RELAXED, __HIP_MEMORY_SCOPE_WORKGROUP);
                    LR[rl * 4 + 0] = ((unsigned)e1 << 16) | p1; LR[rl * 4 + 1] = ((unsigned)e2 << 16) | p2; LR[rl * 4 + 2] = __float_as_uint(w1); LR[rl * 4 + 3] = __float_as_uint(w2);
                }
            }
            asm volatile("s_waitcnt lgkmcnt(0)" ::: "memory");
        }
        __syncthreads();
        if (tid < 16) LB[tid] = __hip_atomic_fetch_add(ctl + CW_CNT + 64 * tid, LC[tid], __ATOMIC_RELAXED, __HIP_MEMORY_SCOPE_AGENT);
        __syncthreads();
        if (tid < 256) {
            const int rl = tid >> 1, j = tid & 1; const unsigned rec = LR[rl * 4 + j]; const unsigned e = rec >> 16, pos = LB[e] + (rec & 0xffffu);
            ltok[e * TT + pos] = t0 + rl; tw[2 * (t0 + rl) + j] = __uint_as_float(LR[rl * 4 + 2 + j]); tinfo[2 * (t0 + rl) + j] = (e << 16) | pos;
        }
        __syncthreads();
    }
#undef P6_LOADROW
#undef P6_LN
#undef P6_VAR
#undef P6_STORE
#undef P6_DOT
}
__device__ __forceinline__ void build_tile_tables(const Args& a, LAS unsigned char* lds, int tid) {
    LAS int* ts = (LAS int*)(lds + LDS_TS_OFF); LAS int* te = (LAS int*)(lds + LDS_TE_OFF); LAS int* cn = (LAS int*)(lds + LDS_CNT_OFF);
    gu32* ctl = (gu32*)a.ws;
    if (tid == 0) { int acc = 0;
        for (int e = 0; e < 16; ++e) { ts[e] = acc; const int c = (int)__hip_atomic_load(ctl + CW_CNT + 64 * e, __ATOMIC_RELAXED, __HIP_MEMORY_SCOPE_AGENT); const int nt = (c + 255) >> 8; cn[e] = c;
            for (int k = 0; k < nt; ++k) te[acc + k] = e; acc += nt; }
        ts[16] = acc; }
    __syncthreads();
}
__device__ __forceinline__ void p9_phase(const Args& a, LAS unsigned char* lds, int vcu, int G, int wave, int lane) {
    unsigned char* ws = a.ws;
    const LAS int* ts = (const LAS int*)(lds + LDS_TS_OFF);
    const unsigned* tinfo = (const unsigned*)(ws + WS_TINFO); const u32x2* Y = (const u32x2*)(ws + WS_Y);
    const float* g2 = a.in[18]; const float* b2 = a.in[19];
    const int gw = vcu * NWAVES + wave, NGW = G * NWAVES;
#if Y_FP8
    const unsigned* Y8 = (const unsigned*)(ws + WS_Y); unsigned ny0[4], ny1[4]; u32x2 nxw[4]; float nw0 = 0.f, nw1 = 0.f;
#else
    u32x2 ny0[4], ny1[4], nxw[4]; float nw0 = 0.f, nw1 = 0.f;
#endif
    const float* tw = (const float*)(ws + WS_WSLOT);
    auto issue = [&](int t) {
        const unsigned i0 = tinfo[2 * t], i1 = tinfo[2 * t + 1];
        nw0 = tw[2 * t]; nw1 = tw[2 * t + 1];
        const size_t s0 = (size_t)ts[i0 >> 16] * 256 + (i0 & 0xffffu), s1 = (size_t)ts[i1 >> 16] * 256 + (i1 & 0xffffu);
        const u32x2* xb1 = (const u32x2*)(ws + WS_XB) + (size_t)t * 256 + lane;
#pragma unroll
#if Y_FP8
        for (int j = 0; j < 4; ++j) { ny0[j] = Y8[s0 * 256 + lane + 64 * j]; ny1[j] = Y8[s1 * 256 + lane + 64 * j]; nxw[j] = xb1[64 * j]; }
#else
        for (int j = 0; j < 4; ++j) { ny0[j] = Y[s0 * 256 + lane + 64 * j]; ny1[j] = Y[s1 * 256 + lane + 64 * j]; nxw[j] = xb1[64 * j]; }
#endif
    };
    if (gw < TT) issue(gw);
    for (int t = gw; t < TT; t += NGW) {
        f32x4* xr = (f32x4*)(a.out + (size_t)t * DM) + lane;
#if Y_FP8
        f32x4 v[4]; float s = 0.f; const float w0 = nw0 * 0.0625f, w1 = nw1 * 0.0625f;
#pragma unroll
        for (int j = 0; j < 4; ++j) {
            const unsigned y0 = ny0[j], y1 = ny1[j]; const u32x2 xw = nxw[j];
            typedef float f32x2_ __attribute__((ext_vector_type(2)));
            const f32x2_ a0 = __builtin_amdgcn_cvt_pk_f32_fp8(y0, false), a1 = __builtin_amdgcn_cvt_pk_f32_fp8(y0, true), c0 = __builtin_amdgcn_cvt_pk_f32_fp8(y1, false), c1 = __builtin_amdgcn_cvt_pk_f32_fp8(y1, true);
            f32x4 x = (f32x4){bflo(xw.x), bfhi(xw.x), bflo(xw.y), bfhi(xw.y)} * DN_ALPHA;
            x.x += w0 * a0[0] + w1 * c0[0]; x.y += w0 * a0[1] + w1 * c0[1]; x.z += w0 * a1[0] + w1 * c1[0]; x.w += w0 * a1[1] + w1 * c1[1];
            v[j] = x; s += (x.x + x.y) + (x.z + x.w);
        }
#else
        f32x4 v[4]; float s = 0.f; const float w0 = nw0, w1 = nw1;
#pragma unroll
        for (int j = 0; j < 4; ++j) {
            const u32x2 y0 = ny0[j], y1 = ny1[j], xw = nxw[j];
            f32x4 x = (f32x4){bflo(xw.x), bfhi(xw.x), bflo(xw.y), bfhi(xw.y)} * DN_ALPHA;
            x.x += w0 * bflo(y0.x) + w1 * bflo(y1.x); x.y += w0 * bfhi(y0.x) + w1 * bfhi(y1.x); x.z += w0 * bflo(y0.y) + w1 * bflo(y1.y); x.w += w0 * bfhi(y0.y) + w1 * bfhi(y1.y);
            v[j] = x; s += (x.x + x.y) + (x.z + x.w);
        }
#endif
        if (t + NGW < TT) issue(t + NGW);
        const float mean = wave_sum(s) * (1.f / DM); float s2 = 0.f;
#pragma unroll
        for (int j = 0; j < 4; ++j) { v[j] = v[j] - mean; s2 += (v[j].x * v[j].x + v[j].y * v[j].y) + (v[j].z * v[j].z + v[j].w * v[j].w); }
        const float rstd = 1.f / sqrtf(wave_sum(s2) * (1.f / DM) + LN_EPSF);
#pragma unroll
        for (int j = 0; j < 4; ++j) { const f32x4 gg = *(const f32x4*)(g2 + 4 * lane + 256 * j), bb = *(const f32x4*)(b2 + 4 * lane + 256 * j); xr[64 * j] = v[j] * rstd * gg + bb; }
    }
}

__global__ void __launch_bounds__(NWAVES * 64, 2) mega_fwd(Args args) {
    extern __shared__ __attribute__((aligned(16))) unsigned char lds_raw[];
    LAS unsigned char* lds = (LAS unsigned char*)lds_raw;
    volatile LAS unsigned* MISC = (volatile LAS unsigned*)(lds + MISC_OFF);
    const int tid0 = threadIdx.x, wave = __builtin_amdgcn_readfirstlane(tid0 >> 6);
    const int G = gridDim.x, bx = blockIdx.x, vcu = (G % 8 == 0) ? (bx % 8) * (G / 8) + bx / 8 : bx;
    for (int u = tid0; u < (LDS_BYTES - LDSCTL_OFF) / 4; u += NWAVES * 64) ((LAS unsigned*)(lds + LDSCTL_OFF))[u] = 0u;
    __syncthreads();
    unsigned char* ws = args.ws;
    gu32* ctl = (gu32*)ws;
    const bool bars_on = (args.mask >> 31) != 0u;
    XcdBarrier bar; bar.bar = (unsigned*)(ctl + CW_BAR) + args.bar_region * XCD_BAR_WORDS; bar.x = 0; bar.st = nullptr;
    if (bars_on) bar = xcd_barrier_post((unsigned*)(ctl + CW_BAR) + args.bar_region * XCD_BAR_WORDS, MISC + 8);
    bar.wv = wave;
#define GRID_BAR() do { if (bars_on) xcd_barrier(bar); } while (0)
#ifndef PH_LAST
#define PH_LAST 99
#endif
#define FRESH() int tid = wave * 64 + pg8::lane_id(); asm volatile("" : "+v"(tid)); const int lane = tid & 63; (void)lane
#ifndef RMASK
#define RMASK 0
#endif
#define REP(k) _Pragma("unroll") for (int rep_ = 0; rep_ < 1 + ((RMASK >> (k)) & 1); ++rep_)
#ifndef STAMP_SCALE
#define STAMP_SCALE 1.0f
#endif
#ifdef STAMP_PH
#define ST_B(k) if ((k) == STAMP_PH) { st_a = rt(); }
#define ST_E(k) if ((k) == STAMP_PH) { st_b = rt(); }
#else
#define ST_B(k)
#define ST_E(k)
#endif
#ifdef ONLY
#define EN(k) (ONLY == (k))
#else
#define EN(k) ((args.mask >> (k)) & 1u)
#endif
    unsigned long long st_a = 0, st_b = 0; (void)st_a; (void)st_b;
    REP(0) if (EN(0)) { FRESH(); p0_prologue(args, lds, vcu, G, tid, wave, lane); }
    GRID_BAR();
#ifdef STAGGER_TICKS
    if (EN(1) && (bx & 8)) { const unsigned long long t0_ = rt(); while (rt() - t0_ < STAGGER_TICKS) __builtin_amdgcn_s_sleep(32); }
#endif
    REP(1) if (EN(1)) {
#if P1_FP8
        pg8::EpiHcat E{ws, (const float*)(ws + WS_ROT), 0};
        if (P1_FP8_FROM > 0) {
            pg8::Gemm g{(const pg8::bf16_t*)(ws + WS_XB), (const pg8::bf16_t*)(ws + WS_WIN), TT, 4608, 1024}; pg8::StaticOrder S; S.init(TT, 256 * P1_FP8_FROM, G, bx);
            pg8::gemm_phase<pg8::EpiHcat, pg8::StaticOrder, true, true>(lds, g, S, E, wave);
        }
        {
#if GATE_FP8
            pg8::Gemm g{(const pg8::bf16_t*)(ws + WS_X8_LO), (const pg8::bf16_t*)(ws + WS_WIN8), TT, 4608, 512, 64, (long)WS_X8_HI - (long)WS_X8_LO - (long)(16 * MiB)}; pg8::StaticOrder S;
#else
            pg8::Gemm g{(const pg8::bf16_t*)args.out, (const pg8::bf16_t*)(ws + WS_WIN8), TT, 4608, 512}; pg8::StaticOrder S;
#endif
            S.init(TT, 4608 - 256 * P1_FP8_FROM, G, bx, P1_FP8_FROM);
#if CONV_BG
            pg8::P1Order SB; SB.S = S; SB.cv = pg8::ExpertConv{args.in[15], args.in[16], args.in[17], ws + WS_WGU, ws + WS_WD, vcu * NWAVES + wave, G * NWAVES, vcu % 9};
            pg8::gemm_phase<pg8::EpiHcat, pg8::P1Order, true, true, false, true, 1, 0>(lds, g, SB, E, wave);
            { FRESH();
              for (int k = 0; SB.cv.gw + k * SB.cv.nw < 6144; ++k) { pg8::Unit tu; const bool in_gap = k < 3 && S.next(pg8::P1Order::unit_of(SB.cv.grp, k), tu) && pg8::P1Order::unit_of(SB.cv.grp, k) < 9;
                  if (!in_gap) pg8::expert_conv_item(SB.cv, k, lane); } }
#else
            pg8::gemm_phase<pg8::EpiHcat, pg8::StaticOrder, true, true, false, true, 1, 0>(lds, g, S, E, wave);
#endif
        }
#else
        pg8::Gemm g{(const pg8::bf16_t*)(ws + WS_XB), (const pg8::bf16_t*)(ws + WS_WIN), TT, 4608, 1024}; pg8::StaticOrder S; S.init(TT, 4608, G, bx);
        pg8::EpiHcat E{ws, (const float*)(ws + WS_ROT), 0};
        pg8::gemm_phase<pg8::EpiHcat, pg8::StaticOrder, true, true>(lds, g, S, E, wave);
#endif
    }
    GRID_BAR();
    if (PH_LAST >= 2) {
        REP(2) if (EN(2)) { FRESH(); for (int it = vcu; it < 256; it += G) chain_item(args, lds, it, tid, wave, lane); }
        if (EN(3)) { { FRESH(); attn_dil_phase<16>(args, lds, vcu, G, tid, wave, lane); }
                     { FRESH(); attn_dil_phase<4>(args, lds, vcu, G, tid, wave, lane); } }
    }
    GRID_BAR();
    ST_B(4) if (PH_LAST >= 3 && EN(4)) { FRESH(); p3_phase<0>(args, lds, vcu, G, tid, wave, lane); }
    if (EN(13)) { FRESH(); attn_p1_phase(args, lds, vcu, G, tid, wave, lane); }
    GRID_BAR(); ST_E(4)
#if !CONV_BG
    if (EN(14)) { FRESH(); p0_expert_weights(args, lds, vcu, G, wave, lane); }
#endif
    REP(5) if (PH_LAST >= 4 && EN(5)) {
        pg8::GateOrder S; S.S4.init(TT, 1024, G, bx);
        pg8::EpiHcat E{ws, (const float*)(ws + WS_ROT), 18};
#if GATE_FP8
        pg8::Gemm g{(const pg8::bf16_t*)(ws + WS_X8_LO), (const pg8::bf16_t*)(ws + WS_WIN8 + (size_t)4608 * 1024), TT, 2048, 512, 64, (long)WS_X8_HI - (long)WS_X8_LO - (long)(16 * MiB)};
        pg8::gemm_phase<pg8::EpiHcat, pg8::GateOrder, true, true, false, true, 1, 0>(lds, g, S, E, wave);
#else
        pg8::Gemm g{(const pg8::bf16_t*)(ws + WS_XB), (const pg8::bf16_t*)(ws + WS_WIN) + (size_t)4608 * 1024, TT, 2048, 1024};
        pg8::gemm_phase<pg8::EpiHcat, pg8::GateOrder, true, true>(lds, g, S, E, wave);
#endif
        asm volatile("s_waitcnt vmcnt(0)" ::: "memory"); __syncthreads();
    }
    REP(6) if (PH_LAST >= 5 && EN(6)) {
        pg8::StaticOrder S; S.init(TT, 1024, G, bx);
        { pg8::EpiGate<false> E{(const pg8::bf16_t*)(ws + WS_GATE_A), (pg8::bf16_t*)(ws + WS_MERGED), nullptr};
#if MIX_FP8 & 2
          pg8::Gemm g{(const pg8::bf16_t*)(ws + WS_OA), (const pg8::bf16_t*)(ws + WS_WA), TT, 1024, 256};
          pg8::gemm_phase<pg8::EpiGate<false>, pg8::StaticOrder, true, true, false, true, 1, 3>(lds, g, S, E, wave);
#else
          pg8::Gemm g{(const pg8::bf16_t*)(ws + WS_OA), (const pg8::bf16_t*)(ws + WS_WA), TT, 1024, 512};
          pg8::gemm_phase<pg8::EpiGate<false>, pg8::StaticOrder, true, true>(lds, g, S, E, wave);
#endif
        }
        asm volatile("s_waitcnt vmcnt(0)" ::: "memory"); __syncthreads();
        { typedef pg8::EpiGate<true, (MIX_FP8 & 1) != 0> EpiC;
          EpiC E{(const pg8::bf16_t*)(ws + WS_GATE_R), (pg8::bf16_t*)(ws + WS_MERGED), ws + WS_MERGED8};
#if MIX_FP8 & 4
          pg8::Gemm g{(const pg8::bf16_t*)(ws + WS_AR8), (const pg8::bf16_t*)(ws + WS_WR), TT, 1024, 512};
          pg8::gemm_phase<EpiC, pg8::StaticOrder, true, true, false, true, 1, 0>(lds, g, S, E, wave);
#else
          pg8::Gemm g{(const pg8::bf16_t*)(ws + WS_GR), (const pg8::bf16_t*)(ws + WS_WR), TT, 1024, 1024};
          pg8::gemm_phase<EpiC, pg8::StaticOrder, true, true>(lds, g, S, E, wave);
#endif
        }
    }
    GRID_BAR();
    REP(7) if (PH_LAST >= 6 && EN(7)) {
        pg8::StaticOrder S; S.init(TT, 1024, G, bx);
        pg8::EpiResBf16 E{X_F32_RES ? (const pg8::bf16_t*)args.in[0] : (const pg8::bf16_t*)(ws + WS_XB), (pg8::bf16_t*)args.out, DN_ALPHA};
#if MIX_FP8 & 1
        pg8::Gemm g{(const pg8::bf16_t*)(ws + WS_MERGED8), (const pg8::bf16_t*)(ws + WS_WO), TT, 1024, 512};
        pg8::gemm_phase<pg8::EpiResBf16, pg8::StaticOrder, true, true, false, true, 1, 3>(lds, g, S, E, wave);
#else
        pg8::Gemm g{(const pg8::bf16_t*)(ws + WS_MERGED), (const pg8::bf16_t*)(ws + WS_WO), TT, 1024, 1024};
        pg8::gemm_phase<pg8::EpiResBf16, pg8::StaticOrder, true, true>(lds, g, S, E, wave);
#endif
    }
    GRID_BAR();
    ST_B(8) if (PH_LAST >= 7 && EN(8)) { FRESH(); p6a_phase(args, lds, vcu, G, tid, wave, lane); }
    GRID_BAR(); ST_E(8)
    { FRESH(); build_tile_tables(args, lds, tid); }
    const int nrt = ((const LAS int*)(lds + LDS_TS_OFF))[16];
    REP(10) if (PH_LAST >= 9 && EN(10)) {
#if M1_FP8
        pg8::Gemm g{(const pg8::bf16_t*)(ws + WS_X1F8), (const pg8::bf16_t*)(ws + WS_WGU), MAXSLOT, 1024, 512};
        pg8::MoeOrder S{nrt * 4, G, vcu, (const LAS int*)(lds + LDS_TE_OFF), (const LAS int*)(lds + LDS_TS_OFF), (const LAS int*)(lds + LDS_CNT_OFF), (const int*)(ws + WS_LTOK), 1024u};
        pg8::EpiSwiGLU E{ws + WS_H};
        pg8::gemm_phase<pg8::EpiSwiGLU, pg8::MoeOrder, true, true, true, true, 1, 0>(lds, g, S, E, wave);
#else
        pg8::Gemm g{(const pg8::bf16_t*)(ws + WS_XB), (const pg8::bf16_t*)(ws + WS_WGU), MAXSLOT, 1024, 1024};
        pg8::MoeOrder S{nrt * 4, G, vcu, (const LAS int*)(lds + LDS_TE_OFF), (const LAS int*)(lds + LDS_TS_OFF), (const LAS int*)(lds + LDS_CNT_OFF), (const int*)(ws + WS_LTOK), 2048u};
        pg8::EpiSwiGLU E{ws + WS_H};
        pg8::gemm_phase<pg8::EpiSwiGLU, pg8::MoeOrder, true, true, true>(lds, g, S, E, wave);
#endif
    }
    GRID_BAR();
    REP(11) if (PH_LAST >= 10 && EN(11)) {
        pg8::Gemm g{(const pg8::bf16_t*)(ws + WS_H), (const pg8::bf16_t*)(ws + WS_WD), MAXSLOT, 1024, 256};
        pg8::MoeOrder S{nrt * 4, G, vcu, (const LAS int*)(lds + LDS_TE_OFF), (const LAS int*)(lds + LDS_TS_OFF), (const LAS int*)(lds + LDS_CNT_OFF), (const int*)(ws + WS_LTOK), 1024u};
        pg8::EpiRowScale E{(pg8::bf16_t*)(ws + WS_Y)};
        pg8::gemm_phase<pg8::EpiRowScale, pg8::MoeOrder, true, true, false, true, 1, 2>(lds, g, S, E, wave);
    }
    GRID_BAR();
    ST_B(12) if (PH_LAST >= 11 && EN(12)) { FRESH(); p9_phase(args, lds, vcu, G, wave, lane); }
#ifdef STAMP_PH
    GRID_BAR(); ST_E(12)
    if (STAMP_PH == 13) { st_a = rt(); GRID_BAR(); GRID_BAR(); GRID_BAR(); GRID_BAR(); st_b = rt(); }
    if (bx == 0 && tid0 == 0) { const float us = (float)(st_b - st_a) * 0.01f * STAMP_SCALE; int k = 0; float lim = 30.f; while (us >= lim && k < 12) { lim *= 1.5f; ++k; }
        __hip_atomic_store(ctl + CW_CHK, __float_as_uint(sqrtf(2.f * k + 2.f)), RLX_AGENT); }
    GRID_BAR();
    { const float c = __uint_as_float(__hip_atomic_load(ctl + CW_CHK, RLX_AGENT)); f32x4* o4 = (f32x4*)args.out;
      for (size_t i = (size_t)bx * 512 + tid0; i < (size_t)TT * DM / 4; i += (size_t)G * 512) o4[i] = (f32x4){c, c, c, c}; }
#endif
}

#ifdef PROBE_VAR
__global__ void __launch_bounds__(NWAVES * 64, 2) probe_kernel(Args args) {
    extern __shared__ __attribute__((aligned(16))) unsigned char lds_raw[];
    LAS unsigned char* lds = (LAS unsigned char*)lds_raw;
    const int tid0 = threadIdx.x, wave = __builtin_amdgcn_readfirstlane(tid0 >> 6);
    const int G = gridDim.x, bx = blockIdx.x, vcu = (G % 8 == 0) ? (bx % 8) * (G / 8) + bx / 8 : bx;
    FRESH();
    if (PROBE_VAR >= 20 && PROBE_VAR <= 22) {
        unsigned char* ws = args.ws;
        pg8::Gemm g{(const pg8::bf16_t*)(ws + WS_X8_LO), (const pg8::bf16_t*)(ws + WS_WIN8), TT, 4608, 512, 64, (long)WS_X8_HI - (long)WS_X8_LO - (long)(16 * MiB)}; pg8::StaticOrder S; S.init(TT, 4608, G, bx);
        typedef pg8::EpiHcatT<PROBE_VAR - 20> EpiP;
        EpiP E{ws, (const float*)(ws + WS_ROT), 0};
        pg8::gemm_phase<EpiP, pg8::StaticOrder, true, true, false, true, 1, 0>(lds, g, S, E, wave);
    }
    if (PROBE_VAR == 10) p3_phase<0>(args, lds, vcu, G, tid, wave, lane);
    if (PROBE_VAR == 11) p3_phase<1>(args, lds, vcu, G, tid, wave, lane);
    if (PROBE_VAR == 0) attn_dil_phase<16, 0>(args, lds, vcu, G, tid, wave, lane);
    if (PROBE_VAR == 1) attn_dil_phase<16, 1>(args, lds, vcu, G, tid, wave, lane);
    if (PROBE_VAR == 2) attn_dil_phase<4, 0>(args, lds, vcu, G, tid, wave, lane);
    if (PROBE_VAR == 3) attn_dil_phase<4, 1>(args, lds, vcu, G, tid, wave, lane);
}
#endif
extern "C" void kernel_launch(void* const* d_in, const int* in_sizes, int n_in, void* d_out, int out_size, void* d_ws, size_t ws_size, hipStream_t stream) {
    static int grid = 0;
    if (grid == 0) {
        if (n_in != 20 || in_sizes[0] != TT * DM || out_size != TT * DM || ws_size < WS_END) { fprintf(stderr, "kernel_launch: unexpected shapes: n_in %d in0 %d out %d ws %zu; nothing launched\n", n_in, n_in > 0 ? in_sizes[0] : -1, out_size, ws_size); grid = -1; return; }
        int dev = 0, cus = 0;
        if (hipGetDevice(&dev) != hipSuccess || hipDeviceGetAttribute(&cus, hipDeviceAttributeMultiprocessorCount, dev) != hipSuccess) { grid = -1; return; }
        if (hipFuncSetAttribute((const void*)mega_fwd, hipFuncAttributeMaxDynamicSharedMemorySize, LDS_BYTES) != hipSuccess) { fprintf(stderr, "kernel_launch: hipFuncSetAttribute failed\n"); grid = -1; return; }
        (void)hipGetLastError();
        grid = cus;
    }
    if (grid < 0) return;
    if (hipMemsetAsync((char*)d_ws, 0, CTL_ZERO_BYTES, stream) != hipSuccess) return;
    Args a{};
    for (int i = 0; i < 20; ++i) a.in[i] = (const float*)d_in[i];
    a.out = (float*)d_out; a.ws = (unsigned char*)d_ws; a.mask = 0x80007fffu; a.bar_region = 0;
#if defined(XTRA_FIRST)
    { Args x = a; x.mask = XTRA_FIRST; x.bar_region = 1; for (int r = 0; r < XTRA_REP; ++r) hipLaunchKernelGGL(mega_fwd, dim3(grid), dim3(NWAVES * 64), LDS_BYTES, stream, x);
      if (hipMemsetAsync((char*)d_ws, 0, CTL_ZERO_BYTES, stream) != hipSuccess) return; }
#endif
    hipLaunchKernelGGL(mega_fwd, dim3(grid), dim3(NWAVES * 64), LDS_BYTES, stream, a);
#if defined(PROBE_VAR)
    { hipFuncSetAttribute((const void*)probe_kernel, hipFuncAttributeMaxDynamicSharedMemorySize, LDS_BYTES);
      for (int r = 0; r < 4; ++r) hipLaunchKernelGGL(probe_kernel, dim3(grid), dim3(NWAVES * 64), LDS_BYTES, stream, a); }
#endif
#if defined(XTRA_AFTER)
    { Args x = a; x.mask = XTRA_AFTER; x.bar_region = 1; for (int r = 0; r < XTRA_REP; ++r) hipLaunchKernelGGL(mega_fwd, dim3(grid), dim3(NWAVES * 64), LDS_BYTES, stream, x); }
#endif
}
```

```cpp
#define PART_FP8 1
#include <hip/hip_runtime.h>
#include <cstdio>
#include <cstdint>

constexpr int TT = 32768, DM = 1024, SEQ = 2048, NB = 16;
constexpr float DN_ALPHA = 1.189207115002721f;
constexpr float LN_EPSF = 1e-5f;
#ifndef M1_FP8
#define M1_FP8 1
#endif
#ifndef P1_FP8
#define P1_FP8 1
#endif
#ifndef PART_FP8
#define PART_FP8 0
#endif
#ifndef GATE_U8
#define GATE_U8 1
#endif
#ifndef ATT_FP8
#define ATT_FP8 1
#endif
#ifndef O23_FP8
#define O23_FP8 1
#endif
#ifndef STATE_FP8
#define STATE_FP8 1
#endif
#ifndef SILU_IN_P3
#define SILU_IN_P3 1
#endif
#ifndef CONV_BG
#define CONV_BG 1
#endif
#ifndef Y_FP8
#define Y_FP8 1
#endif
#ifndef GATE_FP8
#define GATE_FP8 1
#endif
#ifndef MIX_FP8
#define MIX_FP8 7
#endif
#ifndef P1_FP8_FROM
#define P1_FP8_FROM 0
#endif
#define X_F32_RES (P1_FP8 && P1_FP8_FROM == 0 && GATE_FP8)
constexpr size_t MiB = 1u << 20;
constexpr size_t CTL_ZERO_BYTES = 1 * MiB;
constexpr size_t WS_ROT = 1 * MiB;
constexpr size_t WS_BIAS = 2 * MiB;
constexpr size_t WS_LTOK = 3 * MiB;
constexpr size_t WS_TINFO = 7 * MiB;
constexpr size_t WS_WSLOT = 7 * MiB + 512 * 1024;
constexpr size_t WS_WIN = 8 * MiB;
constexpr size_t WS_WIN8 = 12 * MiB;
constexpr size_t WS_WR = 21 * MiB;
constexpr size_t WS_WA = 23 * MiB;
constexpr size_t WS_WO = 24 * MiB;
constexpr size_t WS_WGU = 26 * MiB;
constexpr size_t WS_WD = 42 * MiB;
constexpr size_t WS_XB = 80 * MiB;
constexpr size_t WS_QR = 144 * MiB;
constexpr size_t WS_KR = 176 * MiB;
constexpr size_t WS_VR = 208 * MiB;
constexpr size_t WS_GR = 272 * MiB;
constexpr size_t WS_QA = 336 * MiB, WS_KA = 368 * MiB, WS_VA = 400 * MiB, WS_OA = 432 * MiB;
#if MIX_FP8 & 4
constexpr size_t WS_AR8 = 144 * MiB;
constexpr size_t WS_GATE_R = 176 * MiB, WS_GATE_A = 240 * MiB;
#else
constexpr size_t WS_GATE_R = 144 * MiB, WS_GATE_A = 208 * MiB;
#endif
constexpr size_t WS_X8_LO = 448 * MiB, WS_X8_HI = 58 * MiB;
static_assert(!PART_FP8 || (MIX_FP8 & 1), "PART_FP8: the bf16 output path of P4c would read its own fp8 partial buffer format");
static_assert(M1_FP8, "the workspace map is laid out for fp8 expert weights");
static_assert(!CONV_BG || X_F32_RES, "CONV_BG puts o2 into the bf16 x region");
static_assert(!GATE_FP8 || (P1_FP8 && (MIX_FP8 & 2) && M1_FP8), "GATE_FP8 needs the fp8 mixer-input GEMM, the fp8 o_a (room behind it) and the fp8 expert weights (room behind them)");
constexpr size_t WS_MERGED8 = 464 * MiB;
constexpr size_t WS_MERGED = 336 * MiB;
constexpr size_t WS_Y = 144 * MiB;
constexpr size_t WS_H = 336 * MiB;
constexpr size_t WS_X1F8 = 464 * MiB;
#if CONV_BG
constexpr size_t WS_O2 = 80 * MiB;
#else
constexpr size_t WS_O2 = 26 * MiB;
#endif
constexpr size_t WS_O3 = 464 * MiB;
constexpr size_t WS_LSE2 = 496 * MiB, WS_LSE3 = 497 * MiB;
constexpr size_t WS_END = 512 * MiB;
constexpr int MAXSLOT = 69632;
constexpr int CW_BAR = 4096;
constexpr int CW_CNT = 16384;
constexpr int CW_CHK = 24576;
namespace pg8 {
#define PG8_LAS __attribute__((address_space(3)))
typedef unsigned short bf16_t;
typedef short bf16x8 __attribute__((ext_vector_type(8)));
typedef float f32x4 __attribute__((ext_vector_type(4)));
typedef unsigned u32x4 __attribute__((ext_vector_type(4)));
typedef unsigned u32x2_ __attribute__((ext_vector_type(2)));
constexpr int BM = 256, BK = 64, HALF = 128, HTB = HALF * BK * 2  , STAGE_BYTES = 8 * HTB, NXCD = 8, WGM = 8;

__device__ __forceinline__ int lane_id() { int x; asm volatile("v_mbcnt_lo_u32_b32 %0, -1, 0\n\tv_mbcnt_hi_u32_b32 %0, -1, %0" : "=v"(x)); return x; }
__host__ __device__ __forceinline__ int lds_byte(int r, int c) { const int st = (r >> 4) * 2 + (c >> 5), rr = r & 15, cc = c & 31, ob = rr * 64 + cc * 2; return st * 1024 + (ob ^ (((ob >> 9) & 1) << 5)); }
__host__ __device__ __forceinline__ void stage_rc(int b, int& R, int& C) { const int st = b / 1024, sb = b % 1024, swz = sb ^ (((sb >> 9) & 1) << 5); R = (st >> 1) * 16 + swz / 64; C = (st & 1) * 32 + (swz % 64) / 2; }
__host__ __device__ __forceinline__ int perm32(int rho) { const int n = rho >> 4, i = rho & 15; return 8 * (i >> 2) + 4 * n + (i & 3); }

struct Unit { int pm, pn; };
struct Gemm { const bf16_t* A; const bf16_t* Bt; int M, N, K; int spm = 1 << 30; long sdelta = 0; };

struct StaticOrder {
    int nM, nN, nwg, G, c, pn0;
    __host__ __device__ void init(int M, int N, int G_, int c_, int pn0_ = 0) { nM = M / BM; nN = N / BM; nwg = nM * nN; G = G_; c = c_; pn0 = pn0_; }
    __host__ __device__ bool next(int i, Unit& u) const {
        const long L = (long)i * G + c; if (L >= nwg) return false;
        int wgid = (int)L; { const int q = nwg / NXCD, r = nwg % NXCD, xcd = wgid % NXCD, off = wgid / NXCD; wgid = (xcd < r ? xcd * (q + 1) : r * (q + 1) + (xcd - r) * q) + off; }
        const int nig = WGM * nN, gid = wgid / nig, fm = gid * WGM, gsz = (nM - fm) < WGM ? (nM - fm) : WGM;
        u.pm = fm + ((wgid % nig) % gsz); u.pn = pn0 + (wgid % nig) / gsz; return true;
    }
    __device__ __forceinline__ void a_ready(const Unit&) const {}
    __device__ __forceinline__ void done(const Unit&, int, int) const {}
};

__device__ __forceinline__ unsigned cvt_pk_bf16(float lo, float hi) { unsigned r; asm volatile("v_cvt_pk_bf16_f32 %0, %1, %2" : "=v"(r) : "v"(lo), "v"(hi)); return r; }
typedef float cvt_f32x2_t __attribute__((ext_vector_type(2))); typedef __bf16 cvt_bf16x2_t __attribute__((ext_vector_type(2)));
__device__ __forceinline__ unsigned cvt_pk_bf16_acc(float lo, float hi) { const cvt_f32x2_t v = {lo, hi}; const cvt_bf16x2_t b = __builtin_convertvector(v, cvt_bf16x2_t); return __builtin_bit_cast(unsigned, b); }
__device__ __forceinline__ float bflo(unsigned w) { return __uint_as_float(w << 16); }
__device__ __forceinline__ float bfhi(unsigned w) { return __uint_as_float(w & 0xffff0000u); }
__device__ __forceinline__ float fsigmoid(float x) { return __builtin_amdgcn_rcpf(1.f + __expf(-x)); }
__device__ __forceinline__ float fsilu(float x) { return x * __builtin_amdgcn_rcpf(1.f + __expf(-x)); }

__device__ __forceinline__ unsigned fp8x4_sat(float a, float b, float c, float d) {
    a = __builtin_amdgcn_fmed3f(a, -448.f, 448.f); b = __builtin_amdgcn_fmed3f(b, -448.f, 448.f); c = __builtin_amdgcn_fmed3f(c, -448.f, 448.f); d = __builtin_amdgcn_fmed3f(d, -448.f, 448.f);
    unsigned w = 0u; w = __builtin_amdgcn_cvt_pk_fp8_f32(a, b, w, false); w = __builtin_amdgcn_cvt_pk_fp8_f32(c, d, w, true); return w;
}
template <int VAR = 0> struct EpiHcatT {
    static constexpr bool PERM = true, AFTER_DRAIN = false; static constexpr int NSTORE = 16;
    unsigned char* ws; const float* rot; int tile_off;
    __device__ __forceinline__ void operator()(const f32x4 (&acc)[2][2][4][2], const Unit& u, int wr, int wc, int fr, int fq) const {
        if (VAR == 1) {
            float s = 0.f;
#pragma unroll
            for (int ai = 0; ai < 2; ++ai)
#pragma unroll
                for (int bj = 0; bj < 2; ++bj)
#pragma unroll
                    for (int m = 0; m < 4; ++m)
#pragma unroll
                        for (int n = 0; n < 2; ++n) s += (acc[ai][bj][m][n][0] + acc[ai][bj][m][n][1]) + (acc[ai][bj][m][n][2] + acc[ai][bj][m][n][3]);
            ((float*)(ws + WS_O3))[(size_t)(u.pm * 64 + u.pn) * 512 + wr * 256 + wc * 64 + fq * 16 + fr] = s; return;
        }
        const int gt = u.pn + tile_off;
        size_t base_off; int pitch, ct, mode; float sc = 1.f;
        if (gt < 2)       { base_off = WS_QR; pitch = 512;  ct = gt;      mode = 1; }
        else if (gt < 4)  { base_off = WS_KR; pitch = 512;  ct = gt - 2;  mode = 1; sc = 0.08838834764831845f; }
        else if (gt < 8)  { base_off = WS_VR; pitch = 1024; ct = gt - 4;  mode = 0; }
        else if (gt < 12) { base_off = WS_GR; pitch = 1024; ct = gt - 8;  mode = SILU_IN_P3 ? 0 : 2; }
        else if (gt < 14) { base_off = WS_QA; pitch = 512;  ct = gt - 12; mode = ATT_FP8 ? 4 : 0; sc = 0.18033688011112042f; }
        else if (gt < 16) { base_off = WS_KA; pitch = 512;  ct = gt - 14; mode = ATT_FP8 ? 4 : 0; }
        else if (gt < 18) { base_off = WS_VA; pitch = 512;  ct = gt - 16; mode = ATT_FP8 ? 4 : 0; }
        else if (gt < 22) { base_off = WS_GATE_R; pitch = 1024; ct = gt - 18; mode = 3; }
        else              { base_off = WS_GATE_A; pitch = 1024; ct = gt - 22; mode = 3; }
        bf16_t* O = (bf16_t*)(ws + base_off);
        const int row0 = u.pm * BM + wr * 64 + fr, col0 = ct * BM + wc * 32 + 8 * fq;
#pragma unroll
        for (int ai = 0; ai < 2; ++ai)
#pragma unroll
            for (int m = 0; m < 4; ++m) {
                const int row = row0 + ai * HALF + m * 16;
                bf16_t* rowp = O + (size_t)(VAR == 2 ? (row & 255) : row) * pitch + col0;
                f32x4 cs = (f32x4){1.f, 1.f, 1.f, 1.f}, sn = (f32x4){0.f, 0.f, 0.f, 0.f};
                if (mode == 1) { const f32x4* rt = (const f32x4*)(rot + ((size_t)(row & (SEQ - 1)) * 16 + (4 * wc + fq)) * 8); cs = rt[0]; sn = rt[1]; }
#pragma unroll
                for (int bj = 0; bj < 2; ++bj) {
                    f32x4 v0 = acc[ai][bj][m][0], v1 = acc[ai][bj][m][1];
                    if (mode == 1) { const f32x4 a = v0 * cs - v1 * sn, b = v0 * sn + v1 * cs; v0 = a * sc; v1 = b * sc; }
                    else if (mode == 2) {
#pragma unroll
                        for (int e = 0; e < 4; ++e) { v0[e] = fsilu(v0[e]); v1[e] = fsilu(v1[e]); } }
                    else if (mode == 3) {
#pragma unroll
                        for (int e = 0; e < 4; ++e) { v0[e] = fsigmoid(v0[e]); v1[e] = fsigmoid(v1[e]); } }
                    else { v0 = v0 * sc; v1 = v1 * sc; }
                    if (mode == 4) { u32x2_ w8; w8.x = fp8x4_sat(v0[0], v0[1], v0[2], v0[3]); w8.y = fp8x4_sat(v1[0], v1[1], v1[2], v1[3]);
                        *(u32x2_*)((unsigned char*)O + (size_t)(VAR == 2 ? (row & 255) : row) * pitch + col0 + bj * HALF) = w8; }
                    else if (GATE_U8 && mode == 3) { u32x2_ w8; w8.x = 0u; w8.y = 0u;
#pragma unroll
                        for (int e4 = 0; e4 < 4; ++e4) { w8.x = __builtin_amdgcn_cvt_pk_u8_f32(v0[e4] * 255.f, e4, w8.x); w8.y = __builtin_amdgcn_cvt_pk_u8_f32(v1[e4] * 255.f, e4, w8.y); }
                        *(u32x2_*)((unsigned char*)O + (size_t)row * pitch + col0 + bj * HALF) = w8; }
                    else { u32x4 w; w.x = cvt_pk_bf16(v0[0], v0[1]); w.y = cvt_pk_bf16(v0[2], v0[3]); w.z = cvt_pk_bf16(v1[0], v1[1]); w.w = cvt_pk_bf16(v1[2], v1[3]);
                        *(u32x4*)(rowp + bj * HALF) = w; }
                }
            }
    }
};

typedef EpiHcatT<0> EpiHcat;

template <bool ADD, bool OUT8 = false> struct EpiGate {
    static constexpr bool PERM = true, AFTER_DRAIN = false; static constexpr int NSTORE = 16;
    const bf16_t* gate; bf16_t* O; unsigned char* O8;
    __device__ __forceinline__ void operator()(const f32x4 (&acc)[2][2][4][2], const Unit& u, int wr, int wc, int fr, int fq) const {
        const int row0 = u.pm * BM + wr * 64 + fr, col0 = u.pn * BM + wc * 32 + 8 * fq;
#pragma unroll
        for (int ai = 0; ai < 2; ++ai)
#pragma unroll
            for (int m = 0; m < 4; ++m)
#pragma unroll
                for (int bj = 0; bj < 2; ++bj) {
                    const size_t p = (size_t)(row0 + ai * HALF + m * 16) * 1024 + col0 + bj * HALF;
                    f32x4 v0 = acc[ai][bj][m][0], v1 = acc[ai][bj][m][1];
#if GATE_U8
                    { const u32x2_ g8 = *(const u32x2_*)((const unsigned char*)gate + p); constexpr float c255 = 1.f / 255.f;
#pragma unroll
                      for (int e4 = 0; e4 < 4; ++e4) { v0[e4] *= (float)((g8.x >> (8 * e4)) & 0xffu) * c255; v1[e4] *= (float)((g8.y >> (8 * e4)) & 0xffu) * c255; } }
#else
                    const u32x4 g = *(const u32x4*)(gate + p);
                    v0[0] *= bflo(g.x); v0[1] *= bfhi(g.x); v0[2] *= bflo(g.y); v0[3] *= bfhi(g.y);
                    v1[0] *= bflo(g.z); v1[1] *= bfhi(g.z); v1[2] *= bflo(g.w); v1[3] *= bfhi(g.w);
#endif
#if PART_FP8
                    if (ADD) { const u32x2_ o8 = *(const u32x2_*)((const unsigned char*)O + p); typedef float f2_ __attribute__((ext_vector_type(2)));
                        const f2_ a0 = __builtin_amdgcn_cvt_pk_f32_fp8(o8.x, false), a1 = __builtin_amdgcn_cvt_pk_f32_fp8(o8.x, true), a2 = __builtin_amdgcn_cvt_pk_f32_fp8(o8.y, false), a3 = __builtin_amdgcn_cvt_pk_f32_fp8(o8.y, true);
                        v0[0] += a0[0] * 0.0625f; v0[1] += a0[1] * 0.0625f; v0[2] += a1[0] * 0.0625f; v0[3] += a1[1] * 0.0625f;
                        v1[0] += a2[0] * 0.0625f; v1[1] += a2[1] * 0.0625f; v1[2] += a3[0] * 0.0625f; v1[3] += a3[1] * 0.0625f; }
#else
                    if (ADD) { const u32x4 o = *(const u32x4*)(O + p);
                        v0[0] += bflo(o.x); v0[1] += bfhi(o.x); v0[2] += bflo(o.y); v0[3] += bfhi(o.y);
                        v1[0] += bflo(o.z); v1[1] += bfhi(o.z); v1[2] += bflo(o.w); v1[3] += bfhi(o.w); }
#endif
                    if (OUT8) { u32x2_ w8;
                        w8.x = fp8x4_sat(v0[0] * 16.f, v0[1] * 16.f, v0[2] * 16.f, v0[3] * 16.f); w8.y = fp8x4_sat(v1[0] * 16.f, v1[1] * 16.f, v1[2] * 16.f, v1[3] * 16.f);
                        *(u32x2_*)(O8 + p) = w8; }
                    else if (PART_FP8) { u32x2_ w8;
                        w8.x = fp8x4_sat(v0[0] * 16.f, v0[1] * 16.f, v0[2] * 16.f, v0[3] * 16.f); w8.y = fp8x4_sat(v1[0] * 16.f, v1[1] * 16.f, v1[2] * 16.f, v1[3] * 16.f);
                        *(u32x2_*)((unsigned char*)O + p) = w8; }
                    else { u32x4 w; w.x = cvt_pk_bf16(v0[0], v0[1]); w.y = cvt_pk_bf16(v0[2], v0[3]); w.z = cvt_pk_bf16(v1[0], v1[1]); w.w = cvt_pk_bf16(v1[2], v1[3]);
                        *(u32x4*)(O + p) = w; }
                }
    }
};

struct EpiResBf16 {
    static constexpr bool PERM = true, AFTER_DRAIN = false; static constexpr int NSTORE = 16;
    const bf16_t* x; bf16_t* out; float alpha;
    __device__ __forceinline__ void operator()(const f32x4 (&acc)[2][2][4][2], const Unit& u, int wr, int wc, int fr, int fq) const {
        const int row0 = u.pm * BM + wr * 64 + fr, col0 = u.pn * BM + wc * 32 + 8 * fq;
#pragma unroll
        for (int ai = 0; ai < 2; ++ai)
#pragma unroll
            for (int m = 0; m < 4; ++m)
#pragma unroll
                for (int bj = 0; bj < 2; ++bj) {
                    const size_t p = (size_t)(row0 + ai * HALF + m * 16) * 1024 + col0 + bj * HALF;
#if X_F32_RES
                    const f32x4 x0 = *(const f32x4*)((const float*)x + p), x1 = *(const f32x4*)((const float*)x + p + 4);
#else
                    const u32x4 xw = *(const u32x4*)(x + p);
                    const f32x4 x0 = (f32x4){bflo(xw.x), bfhi(xw.x), bflo(xw.y), bfhi(xw.y)}, x1 = (f32x4){bflo(xw.z), bfhi(xw.z), bflo(xw.w), bfhi(xw.w)};
#endif
                    const f32x4 v0 = x0 * alpha + acc[ai][bj][m][0], v1 = x1 * alpha + acc[ai][bj][m][1];
                    u32x4 w; w.x = cvt_pk_bf16(v0[0], v0[1]); w.y = cvt_pk_bf16(v0[2], v0[3]); w.z = cvt_pk_bf16(v1[0], v1[1]); w.w = cvt_pk_bf16(v1[2], v1[3]);
                    *(u32x4*)(out + p) = w;
                }
    }
};

struct EpiSwiGLU {
    static constexpr bool PERM = true, AFTER_DRAIN = false; static constexpr int NSTORE = 16;
    unsigned char* H;
    __device__ __forceinline__ void operator()(const f32x4 (&acc)[2][2][4][2], const Unit& u, int wr, int wc, int fr, int fq) const {
        const int row0 = u.pm * BM + wr * 64 + fr, col0 = (u.pn & 3) * 128 + wc * 16 + 4 * fq;
#pragma unroll
        for (int ai = 0; ai < 2; ++ai)
#pragma unroll
            for (int m = 0; m < 4; ++m)
#pragma unroll
                for (int bj = 0; bj < 2; ++bj) {
                    const f32x4 g = acc[ai][bj][m][0], up = acc[ai][bj][m][1];
                    float h0 = fsilu(g[0]) * up[0] * 8.f, h1 = fsilu(g[1]) * up[1] * 8.f, h2 = fsilu(g[2]) * up[2] * 8.f, h3 = fsilu(g[3]) * up[3] * 8.f;
                    h0 = fminf(fmaxf(h0, -448.f), 448.f); h1 = fminf(fmaxf(h1, -448.f), 448.f); h2 = fminf(fmaxf(h2, -448.f), 448.f); h3 = fminf(fmaxf(h3, -448.f), 448.f);
                    unsigned w = 0u; w = __builtin_amdgcn_cvt_pk_fp8_f32(h0, h1, w, false); w = __builtin_amdgcn_cvt_pk_fp8_f32(h2, h3, w, true);
                    *(unsigned*)(H + (size_t)(row0 + ai * HALF + m * 16) * 512 + col0 + bj * 64) = w;
                }
    }
};

struct EpiRowScale {
    static constexpr bool PERM = true, AFTER_DRAIN = false; static constexpr int NSTORE = 16;
    bf16_t* Y;
    __device__ __forceinline__ void operator()(const f32x4 (&acc)[2][2][4][2], const Unit& u, int wr, int wc, int fr, int fq) const {
        const int row0 = u.pm * BM + wr * 64 + fr, col0 = (u.pn & 3) * BM + wc * 32 + 8 * fq;
#pragma unroll
        for (int ai = 0; ai < 2; ++ai)
#pragma unroll
            for (int m = 0; m < 4; ++m) {
                const int row = row0 + ai * HALF + m * 16;
#pragma unroll
                for (int bj = 0; bj < 2; ++bj) {
                    const f32x4 v0 = acc[ai][bj][m][0], v1 = acc[ai][bj][m][1];
#if Y_FP8
                    u32x2_ w8; w8.x = fp8x4_sat(v0[0] * 16.f, v0[1] * 16.f, v0[2] * 16.f, v0[3] * 16.f); w8.y = fp8x4_sat(v1[0] * 16.f, v1[1] * 16.f, v1[2] * 16.f, v1[3] * 16.f);
                    *(u32x2_*)((unsigned char*)Y + (size_t)row * 1024 + col0 + bj * HALF) = w8;
#else
                    u32x4 w; w.x = cvt_pk_bf16_acc(v0[0], v0[1]); w.y = cvt_pk_bf16_acc(v0[2], v0[3]); w.z = cvt_pk_bf16_acc(v1[0], v1[1]); w.w = cvt_pk_bf16_acc(v1[2], v1[3]);
                    *(u32x4*)(Y + (size_t)row * 1024 + col0 + bj * HALF) = w;
#endif
                }
            }
    }
};

struct MoeOrder {
    int nunits, G, c; const PG8_LAS int* te; const PG8_LAS int* ts; const PG8_LAS int* cnt; const int* ltok; unsigned rowbytes;
    __device__ __forceinline__ bool next(int i, Unit& u) const {
        const int L = i * G + c, rt = (L >> 5) * 8 + (L & 7); if (rt >= (nunits >> 2)) return false;
        u.pm = rt; u.pn = te[rt] * 4 + ((L >> 3) & 3); return true;
    }
    __device__ __forceinline__ unsigned a_row_off(const Unit& u, int row) const {
        const int ex = te[u.pm], pos = (u.pm - ts[ex]) * 256 + row;
        const int tok = pos < cnt[ex] ? ltok[ex * 32768 + pos] : 0;
        return (unsigned)tok * rowbytes;
    }
    __device__ __forceinline__ void a_ready(const Unit&) const {}
    __device__ __forceinline__ void done(const Unit&, int, int) const {}
};

struct ExpertConv { const float* wg; const float* wu; const float* wd; unsigned char* WGU; unsigned char* WD; int gw, nw, grp; };
__device__ __forceinline__ void expert_conv_item(const ExpertConv& c, int j, int lane) {
    const int it = j * c.nw + c.gw, e = it / 384, r = it % 384;
    const float* src; unsigned char* dst; int K, N, mode, nb, kb;
    if (r < 128)      { src = c.wg + (size_t)e * 1024 * 512; dst = c.WGU + (size_t)e * 1024 * 1024; K = 1024; N = 512;  mode = 2; nb = r >> 4; kb = r & 15; }
    else if (r < 256) { src = c.wu + (size_t)e * 1024 * 512; dst = c.WGU + (size_t)e * 1024 * 1024; K = 1024; N = 512;  mode = 3; nb = (r - 128) >> 4; kb = (r - 128) & 15; }
    else              { src = c.wd + (size_t)e * 512 * 1024; dst = c.WD + (size_t)e * 1024 * 512;   K = 512;  N = 1024; mode = 0; nb = (r - 256) >> 3; kb = (r - 256) & 7; }
    const int n4 = nb * 64 + 4 * (lane & 15), k0 = kb * 64 + 16 * (lane >> 4);
    const float* s = src + (size_t)k0 * N + n4;
    f32x4 v[16];
#pragma unroll
    for (int i = 0; i < 16; ++i) v[i] = *(const f32x4*)(s + (size_t)i * N);
#pragma unroll
    for (int jn = 0; jn < 4; ++jn) {
        const int n = n4 + jn, row = mode == 0 ? n : ((n >> 2) << 3) + (n & 3) + (mode == 3 ? 4 : 0);
        u32x4 w;
        w.x = fp8x4_sat(v[0][jn] * 64.f, v[1][jn] * 64.f, v[2][jn] * 64.f, v[3][jn] * 64.f);     w.y = fp8x4_sat(v[4][jn] * 64.f, v[5][jn] * 64.f, v[6][jn] * 64.f, v[7][jn] * 64.f);
        w.z = fp8x4_sat(v[8][jn] * 64.f, v[9][jn] * 64.f, v[10][jn] * 64.f, v[11][jn] * 64.f); w.w = fp8x4_sat(v[12][jn] * 64.f, v[13][jn] * 64.f, v[14][jn] * 64.f, v[15][jn] * 64.f);
        *(u32x4*)(dst + (size_t)row * K + k0) = w;
    }
}
struct GateOrder {
    StaticOrder S4;
    __device__ __forceinline__ bool next(int i, Unit& u) const { Unit t; if (!S4.next(i >> 1, t)) return false; u.pm = t.pm; u.pn = t.pn + 4 * (i & 1); return true; }
    __device__ __forceinline__ void a_ready(const Unit&) const {}
    __device__ __forceinline__ void done(const Unit&, int, int) const {}
};
struct P1Order {
    StaticOrder S; ExpertConv cv;
    __device__ __forceinline__ bool next(int i, Unit& u) const { return S.next(i, u); }
    __device__ __forceinline__ void a_ready(const Unit&) const {}
    __device__ __forceinline__ static int unit_of(int grp, int k) { return (grp + 3 * k) % 9; }
    __device__ __forceinline__ void done(const Unit&, int ui, int lane) const {
        const int d = (ui + 9 - cv.grp) % 9;
        if (ui < 9 && d % 3 == 0 && cv.gw + (d / 3) * cv.nw < 6144) expert_conv_item(cv, d / 3, lane);
    }
};

template <class Epi, class Sched, bool ALIGN_EPI = false, bool SP2 = false, bool GATHER = false, bool FP8 = false, int SEL_W = 0, int SEL_X = 0>
__device__ __forceinline__ void gemm_phase(PG8_LAS unsigned char* lds, const Gemm g, const Sched& S, const Epi& E, const int wid) {
    int tid = wid * 64 + lane_id(); asm volatile("" : "+v"(tid));
    const int lane = tid & 63, wr = wid >> 2, wc = wid & 3, fr = lane & 15, fq = lane >> 4;
    static_assert(SP2, "only the two-super-phase loop is kept");
    typedef int i32x4_ __attribute__((ext_vector_type(4)));
    const int K = g.K, nt = K / BK;
    unsigned voffB[2]; int rA[2], cA2[2];
#pragma unroll
    for (int i = 0; i < 2; ++i) { int R, C; stage_rc(tid * 16 + i * 8192, R, C); const int Rb = Epi::PERM ? ((R & ~31) + perm32(R & 31)) : R;
        rA[i] = R; cA2[i] = C * 2; voffB[i] = (unsigned)(Rb * K + C) * 2u; }
    unsigned vAc[2][2], vAn[2][2];
    const size_t kstep = (size_t)(BK * 2);
    const size_t hstep = (size_t)HALF * K * 2;
    const size_t tstep = 2 * hstep;
    const unsigned ldsw = (unsigned)wid * 1024u;
    const int aoff0 = lds_byte(wr * 64 + fr, fq * 8), aoff1 = aoff0 + 1024;
    const int boff0 = lds_byte(wc * 32 + fr, fq * 8), boff1 = boff0 + 1024;
#define PG8_SA(b, h) (((b) * 2 + (h)) * HTB)
#define PG8_SB(b, h) ((4 + (b) * 2 + (h)) * HTB)
#define PG8_STAGE(bufoff, gbase, voff) do { _Pragma("unroll") for (int _i = 0; _i < 2; ++_i) \
        __builtin_amdgcn_global_load_lds((const unsigned*)((const char*)(gbase) + (voff)[_i]), (PG8_LAS unsigned*)(lds + (bufoff) + ldsw + _i * 8192), 16, 0, 0); } while (0)
#define PG8_LDA(dst, b, h) do { _Pragma("unroll") for (int m = 0; m < 4; ++m) { dst[m][0] = *(const PG8_LAS bf16x8*)(lds + PG8_SA(b, h) + aoff0 + m * 2048); dst[m][1] = *(const PG8_LAS bf16x8*)(lds + PG8_SA(b, h) + aoff1 + m * 2048); } } while (0)
#define PG8_LDB(dst, b, h) do { _Pragma("unroll") for (int n = 0; n < 2; ++n) { dst[n][0] = *(const PG8_LAS bf16x8*)(lds + PG8_SB(b, h) + boff0 + n * 2048); dst[n][1] = *(const PG8_LAS bf16x8*)(lds + PG8_SB(b, h) + boff1 + n * 2048); } } while (0)
#define PG8_CAT8(x) __builtin_shufflevector(__builtin_bit_cast(i32x4_, (x)[0]), __builtin_bit_cast(i32x4_, (x)[1]), 0, 1, 2, 3, 4, 5, 6, 7)
#define PG8_MMA(ai, bj, At, Bt) do { __builtin_amdgcn_s_setprio(1); \
        if constexpr (FP8) { _Pragma("unroll") for (int m = 0; m < 4; ++m) _Pragma("unroll") for (int n = 0; n < 2; ++n) \
            acc[ai][bj][m][n] = __builtin_amdgcn_mfma_scale_f32_16x16x128_f8f6f4(PG8_CAT8(Bt[n]), PG8_CAT8(At[m]), acc[ai][bj][m][n], 0, 0, SEL_W, scl, SEL_X, scl); \
            asm volatile("" : "+v"(acc[ai][bj][0][0]), "+v"(acc[ai][bj][0][1]), "+v"(acc[ai][bj][1][0]), "+v"(acc[ai][bj][1][1]), "+v"(acc[ai][bj][2][0]), "+v"(acc[ai][bj][2][1]), "+v"(acc[ai][bj][3][0]), "+v"(acc[ai][bj][3][1])); } \
        else { _Pragma("unroll") for (int m = 0; m < 4; ++m) _Pragma("unroll") for (int n = 0; n < 2; ++n) _Pragma("unroll") for (int k = 0; k < 2; ++k) \
            acc[ai][bj][m][n] = __builtin_amdgcn_mfma_f32_16x16x32_bf16(Bt[n][k], At[m][k], acc[ai][bj][m][n], 0, 0, 0); } \
        __builtin_amdgcn_s_setprio(0); } while (0)
#define PG8_WAIT_V(n) asm volatile("s_waitcnt vmcnt(" #n ")" ::: "memory")
#define PG8_WAIT_VN(n) asm volatile("s_waitcnt vmcnt(%0)" :: "i"(n) : "memory")
#define PG8_WAIT_L(n) asm volatile("s_waitcnt lgkmcnt(" #n ")" ::: "memory")
#define PG8_BAR __builtin_amdgcn_s_barrier()
#define PG8_SCHED __builtin_amdgcn_sched_barrier(0)
    [[maybe_unused]] int scl = 0x7b7c797f; asm volatile("" : "+v"(scl));
    Unit cur, nxt; int ui = 0;
    if (!S.next(0, cur)) return;
    f32x4 acc[2][2][4][2];
#pragma unroll
    for (int a = 0; a < 2; ++a)
#pragma unroll
        for (int b = 0; b < 2; ++b)
#pragma unroll
            for (int m = 0; m < 4; ++m)
#pragma unroll
                for (int n = 0; n < 2; ++n) acc[a][b][m][n] = (f32x4){0.f, 0.f, 0.f, 0.f};
    bf16x8 At[4][2], B0[2][2], B1[2][2];
    const char* cA = GATHER ? (const char*)g.A : (const char*)g.A + (size_t)cur.pm * tstep + (cur.pm >= g.spm ? g.sdelta : 0L); const char* cB = (const char*)g.Bt + (size_t)cur.pn * tstep;
#pragma unroll
    for (int h = 0; h < 2; ++h)
#pragma unroll
        for (int i = 0; i < 2; ++i) { if constexpr (GATHER) vAc[h][i] = S.a_row_off(cur, h * HALF + rA[i]) + (unsigned)cA2[i]; else vAc[h][i] = (unsigned)((h * HALF + rA[i]) * K) * 2u + (unsigned)cA2[i]; vAn[h][i] = vAc[h][i]; }
    S.a_ready(cur);
    if constexpr (SP2) {
        PG8_STAGE(PG8_SB(0, 0), cB, voffB); PG8_STAGE(PG8_SB(0, 1), cB + hstep, voffB); PG8_STAGE(PG8_SA(0, 0), cA, vAc[0]); PG8_STAGE(PG8_SA(0, 1), cA, vAc[1]);
        if (wr == 1) PG8_BAR;
        PG8_WAIT_V(2); PG8_BAR;
        PG8_STAGE(PG8_SB(1, 0), cB + kstep, voffB); PG8_STAGE(PG8_SA(1, 0), cA + kstep, vAc[0]); PG8_STAGE(PG8_SB(1, 1), cB + hstep + kstep, voffB);
        PG8_WAIT_V(6); PG8_BAR;
    }
    for (;;) {
        const bool has_next = S.next(ui + 1, nxt);
        const char* nA = GATHER ? cA : (has_next ? (const char*)g.A + (size_t)nxt.pm * tstep + (nxt.pm >= g.spm ? g.sdelta : 0L) : cA); const char* nB = has_next ? (const char*)g.Bt + (size_t)nxt.pn * tstep : cB;
        if constexpr (GATHER) { if (has_next) {
#pragma unroll
            for (int h = 0; h < 2; ++h)
#pragma unroll
                for (int i = 0; i < 2; ++i) vAn[h][i] = S.a_row_off(nxt, h * HALF + rA[i]) + (unsigned)cA2[i]; } }
#pragma unroll 1
        for (int t = 0; t < nt; t += 2) {
            const bool last = (t == nt - 2);
            asm volatile("" : "+v"(voffB[0]), "+v"(voffB[1]), "+v"(vAc[0][0]), "+v"(vAc[0][1]), "+v"(vAc[1][0]), "+v"(vAc[1][1]));
            const char* a1 = cA + (size_t)(t + 1) * kstep;
            const char* a2 = last ? nA : cA + (size_t)(t + 2) * kstep; const char* b2 = last ? nB : cB + (size_t)(t + 2) * kstep;
            const char* a3 = a2 + kstep; const char* b3 = b2 + kstep;
            unsigned vA2[2][2];
#pragma unroll
            for (int h = 0; h < 2; ++h)
#pragma unroll
                for (int i = 0; i < 2; ++i) vA2[h][i] = vAc[h][i];
            if constexpr (GATHER) { if (last) {
                asm volatile("" : "+v"(vAn[0][0]), "+v"(vAn[0][1]), "+v"(vAn[1][0]), "+v"(vAn[1][1]));
#pragma unroll
                for (int h = 0; h < 2; ++h)
#pragma unroll
                    for (int i = 0; i < 2; ++i) vA2[h][i] = vAn[h][i]; } }
            if (last && has_next) S.a_ready(nxt);
            if constexpr (SP2) {
            const int lenient = __builtin_amdgcn_readfirstlane((ui > 0 && t == 0) ? 1 : 0);
#define PG8_WAIT_V8L() asm volatile("s_cmp_eq_u32 %0, 0\n\ts_cbranch_scc0 .Lpg8skip%=\n\ts_waitcnt vmcnt(8)\n.Lpg8skip%=:\n\ts_waitcnt vmcnt(%1)" :: "s"(lenient), "i"(8 + Epi::NSTORE) : "memory", "scc")
            PG8_LDB(B0, 0, 0); PG8_LDB(B1, 0, 1); PG8_SCHED; PG8_LDA(At, 0, 0); PG8_STAGE(PG8_SA(1, 1), a1, vAc[1]);
            PG8_WAIT_V8L(); PG8_WAIT_L(0); PG8_BAR; PG8_MMA(0, 0, At, B0); PG8_MMA(0, 1, At, B1); PG8_BAR; PG8_SCHED;
            PG8_LDA(At, 0, 1); PG8_STAGE(PG8_SB(0, 0), b2, voffB); PG8_STAGE(PG8_SB(0, 1), b2 + hstep, voffB); PG8_STAGE(PG8_SA(0, 0), a2, vA2[0]);
            PG8_WAIT_V8L(); PG8_WAIT_L(0); PG8_BAR; PG8_MMA(1, 0, At, B0); PG8_MMA(1, 1, At, B1); PG8_BAR; PG8_SCHED;
            PG8_LDB(B0, 1, 0); PG8_LDB(B1, 1, 1); PG8_SCHED; PG8_LDA(At, 1, 0); PG8_STAGE(PG8_SA(0, 1), a2, vA2[1]);
            PG8_WAIT_V(8); PG8_WAIT_L(0); PG8_BAR; PG8_MMA(0, 0, At, B0); PG8_MMA(0, 1, At, B1); PG8_BAR; PG8_SCHED;
            PG8_LDA(At, 1, 1); PG8_STAGE(PG8_SB(1, 0), b3, voffB); PG8_STAGE(PG8_SB(1, 1), b3 + hstep, voffB); PG8_STAGE(PG8_SA(1, 0), a3, vA2[0]);
            PG8_WAIT_V(8); PG8_WAIT_L(0); PG8_BAR; PG8_MMA(1, 0, At, B0); PG8_MMA(1, 1, At, B1); PG8_BAR; PG8_SCHED;
#undef PG8_WAIT_V8L
            }
        }
        if constexpr (ALIGN_EPI) { if (wr == 0) PG8_BAR; }
        if constexpr (!Epi::AFTER_DRAIN) { const int le = lane_id(); E(acc, cur, wr, wc, le & 15, le >> 4); S.done(cur, ui, le); }
        if (!has_next) break;
#pragma unroll
        for (int a = 0; a < 2; ++a)
#pragma unroll
            for (int b = 0; b < 2; ++b)
#pragma unroll
                for (int m = 0; m < 4; ++m)
#pragma unroll
                    for (int n = 0; n < 2; ++n) acc[a][b][m][n] = (f32x4){0.f, 0.f, 0.f, 0.f};
        cur = nxt; cA = nA; cB = nB; ++ui;
        if constexpr (GATHER) {
#pragma unroll
            for (int h = 0; h < 2; ++h)
#pragma unroll
                for (int i = 0; i < 2; ++i) vAc[h][i] = vAn[h][i]; }
        if constexpr (ALIGN_EPI) { if (wr == 1) PG8_BAR; }
    }
    PG8_WAIT_V(0);
    if constexpr (!ALIGN_EPI) { if (wr == 0) PG8_BAR; }
    PG8_BAR;
    if constexpr (Epi::AFTER_DRAIN) { E.fused(acc, cur, wr, wc, fr, fq, lds, wid, lane); S.done(cur, ui, lane); }
#undef PG8_SA
#undef PG8_SB
#undef PG8_STAGE
#undef PG8_LDA
#undef PG8_LDB
#undef PG8_MMA
#undef PG8_CAT8
#undef PG8_WAIT_V
#undef PG8_WAIT_VN
#undef PG8_WAIT_L
#undef PG8_BAR
#undef PG8_SCHED
}
}
#define GAS __attribute__((address_space(1)))
#define LAS __attribute__((address_space(3)))
typedef unsigned short bf16;
typedef unsigned v4u __attribute__((ext_vector_type(4)));
typedef float f32x4 __attribute__((ext_vector_type(4)));
typedef short bf16x8 __attribute__((ext_vector_type(8)));
typedef GAS unsigned gu32;
typedef GAS unsigned long long gu64;
#define RLX_AGENT __ATOMIC_RELAXED, __HIP_MEMORY_SCOPE_AGENT
#define LDS_WAIT() asm volatile("s_waitcnt lgkmcnt(0)" ::: "memory")
#define VM_WAIT() asm volatile("s_waitcnt vmcnt(0)" ::: "memory")
__device__ __forceinline__ unsigned long long rt() { return __builtin_amdgcn_s_memrealtime(); }
__device__ __forceinline__ unsigned f2bf(float f) { unsigned u = __builtin_bit_cast(unsigned, f); return (u + 0x7fffu + ((u >> 16) & 1u)) >> 16; }
__device__ __forceinline__ unsigned pk2(float lo, float hi) { return f2bf(lo) | (f2bf(hi) << 16); }

#define XB_TMO      128
#define XB_XCNT(j)  (256  + 64 * (j))
#define XB_XSUB(j)  (1280 + 64 * (j))
#define XB_XGEN(j)  (2304 + 64 * (j))
#define XB_TOP      3328
#define XB_TOPGEN   3392
#define XCD_BAR_WORDS 3456
#define XB_SPIN_CAP (1u << 18)

__device__ __forceinline__ unsigned xb_ld(unsigned* p)              { return __hip_atomic_load(p, __ATOMIC_RELAXED, __HIP_MEMORY_SCOPE_AGENT); }
__device__ __forceinline__ unsigned xb_add(unsigned* p, unsigned v) { return __hip_atomic_fetch_add(p, v, __ATOMIC_RELAXED, __HIP_MEMORY_SCOPE_AGENT); }
__device__ __forceinline__ unsigned xb_xcc_id() { return (unsigned)__builtin_amdgcn_s_getreg((3 << 11) | 20) & 0xFu; }
#define XB_SPIN(cond, bar) do { unsigned _sp = 0; while (cond) { __builtin_amdgcn_s_sleep(1); \
    if ((++_sp & 255u) == 0u) { if (xb_ld(&(bar)[XB_TMO])) break; if (_sp > XB_SPIN_CAP) { atomicAdd(&(bar)[XB_TMO], 1u); break; } } } } while (0)

struct XcdBarrier {
    unsigned* bar; unsigned x; int wv;
    volatile LAS unsigned* st;
};

__device__ __forceinline__ XcdBarrier xcd_barrier_post(unsigned* bar, volatile LAS unsigned* st) {
    XcdBarrier b; b.bar = bar; b.x = xb_xcc_id(); b.st = st; b.wv = 0;
    if (threadIdx.x == 0) (void)xb_add(&bar[XB_XCNT(b.x)], 1u);
    return b;
}
__device__ __forceinline__ void xcd_barrier_complete(unsigned* bar, unsigned x, unsigned& nloc, unsigned& nx) {
    const unsigned G = gridDim.x * gridDim.y * gridDim.z;
    unsigned sum, cnt, mine, sp = 0u;
    for (;;) {
        sum = 0u; cnt = 0u; mine = 0u;
#pragma unroll
        for (unsigned j = 0; j < 16; ++j) { const unsigned c = xb_ld(&bar[XB_XCNT(j)]); sum += c; cnt += (c > 0u) ? 1u : 0u; mine = (j == x) ? c : mine; }
        if (sum == G) break;
        __builtin_amdgcn_s_sleep(1);
        if ((++sp & 255u) == 0u) { if (xb_ld(&bar[XB_TMO])) break; if (sp > XB_SPIN_CAP) { atomicAdd(&bar[XB_TMO], 1u); break; } }
    }
    nloc = mine > 0u ? mine : 1u; nx = cnt > 0u ? cnt : 1u;
}

__device__ __forceinline__ void xcd_barrier(const XcdBarrier& b) {
    asm volatile("s_waitcnt vmcnt(0)" ::: "memory");
    __syncthreads();
    if (b.wv == 0 && (int)__builtin_amdgcn_mbcnt_hi(~0u, __builtin_amdgcn_mbcnt_lo(~0u, 0u)) == 0) {
        unsigned* bar = b.bar;
        __builtin_amdgcn_s_waitcnt(0);
        unsigned nloc = b.st[0], nx = b.st[1];
        if (nloc == 0u) { xcd_barrier_complete(bar, b.x, nloc, nx); b.st[0] = nloc; b.st[1] = nx; }
        const unsigned old = xb_add(&bar[XB_XSUB(b.x)], 1u);
        const unsigned gen = old / nloc;
        if (old + 1u == (gen + 1u) * nloc) {
            __builtin_amdgcn_fence(__ATOMIC_RELEASE, "agent");
            asm volatile("s_waitcnt vmcnt(0)" ::: "memory");
            const unsigned og = xb_add(&bar[XB_TOP], 1u);
            const unsigned tg = og / nx;
            if (og + 1u == (tg + 1u) * nx) xb_add(&bar[XB_TOPGEN], 1u);
            else XB_SPIN(xb_ld(&bar[XB_TOPGEN]) == tg, bar);
            __builtin_amdgcn_fence(__ATOMIC_ACQUIRE, "agent");
            xb_add(&bar[XB_XGEN(b.x)], 1u);
            asm volatile("s_waitcnt vmcnt(0)" ::: "memory");
        } else {
            __builtin_amdgcn_fence(__ATOMIC_ACQUIRE, "agent");
            asm volatile("s_waitcnt vmcnt(0)" ::: "memory");
            XB_SPIN(xb_ld(&bar[XB_XGEN(b.x)]) == gen, bar);
        }
    }
    __syncthreads();
}


constexpr int NWAVES = 8;
constexpr int RING_BYTES = 131072;
constexpr int LDSCTL_OFF = RING_BYTES, MISC_OFF = LDSCTL_OFF + 320;
constexpr int LDS_TS_OFF = LDSCTL_OFF + 1024;
constexpr int LDS_TE_OFF = LDSCTL_OFF + 2048;
constexpr int LDS_CNT_OFF = LDSCTL_OFF + 1024 + 128;
constexpr int LDS_BYTES = 163840;

typedef short s16x4 __attribute__((ext_vector_type(4)));
typedef unsigned u32x2 __attribute__((ext_vector_type(2)));

struct Args { const float* in[20]; float* out; unsigned char* ws; unsigned mask; int bar_region; };

__device__ __forceinline__ float bflo(unsigned w) { return __uint_as_float(w << 16); }
__device__ __forceinline__ float bfhi(unsigned w) { return __uint_as_float(w & 0xffff0000u); }
__device__ __forceinline__ unsigned cvtpk(float lo, float hi) { return pg8::cvt_pk_bf16(lo, hi); }
__device__ __forceinline__ float wave_sum(float v) {
#pragma unroll
    for (int o = 1; o < 64; o <<= 1) v += __shfl_xor(v, o);
    return v;
}
__device__ __forceinline__ unsigned offb(unsigned row, unsigned ch) { return 256u * row + 16u * (ch ^ (((row & 3u) << 2) | ((row >> 2) & 3u))); }
__device__ __forceinline__ s16x4 ldtr(const LAS unsigned char* p) { return __builtin_amdgcn_ds_read_tr16_b64_v4i16((LAS s16x4*)p); }
__device__ __forceinline__ bf16x8 cat8(s16x4 a, s16x4 b) { return (bf16x8){a[0], a[1], a[2], a[3], b[0], b[1], b[2], b[3]}; }
#define MFMA16(a, b, c) __builtin_amdgcn_mfma_f32_16x16x32_bf16((a), (b), (c), 0, 0, 0)

template <int MODE> __device__ __forceinline__ int dest_row(int n) {
    if (MODE == 1) { if (n >= 1024) return n; const int hb = n & ~127, d = n & 127, jr = d & 63, half = d >> 6; return hb + 8 * (jr >> 2) + 4 * half + (jr & 3); }
    if (MODE == 2) return ((n >> 2) << 3) + (n & 3);
    if (MODE == 3) return ((n >> 2) << 3) + 4 + (n & 3);
    return n;
}
template <int MODE> __device__ __forceinline__ void p0_transpose_item(const float* W, int K, int N, bf16* WT, LAS float* scr, int item, int lane) {
    const int nblk = N / 32, kb = item / nblk, nb = item % nblk, k0 = 64 * kb, n0 = 32 * nb;
    {
        const GAS f32x4* src = (const GAS f32x4*)(W + (size_t)(k0 + (lane >> 3)) * N + n0) + (lane & 7);
        f32x4 t[8];
#pragma unroll
        for (int j = 0; j < 8; ++j) t[j] = src[(size_t)j * 2 * N];
#pragma unroll
        for (int j = 0; j < 8; ++j) { LAS float* d = scr + ((lane >> 3) + 8 * j) * 33 + 4 * (lane & 7); d[0] = t[j].x; d[1] = t[j].y; d[2] = t[j].z; d[3] = t[j].w; }
    }
    LDS_WAIT(); asm volatile("" ::: "memory");
    const int c = lane & 7;
#pragma unroll
    for (int j = 0; j < 4; ++j) { const int n = (lane >> 3) + 8 * j; const LAS float* s = scr + (8 * c) * 33 + n;
        v4u o; o.x = pk2(s[0 * 33], s[1 * 33]); o.y = pk2(s[2 * 33], s[3 * 33]); o.z = pk2(s[4 * 33], s[5 * 33]); o.w = pk2(s[6 * 33], s[7 * 33]);
        *(GAS v4u*)(WT + (size_t)dest_row<MODE>(n0 + n) * K + k0 + 8 * c) = o; }
    LDS_WAIT(); asm volatile("" ::: "memory");
}
__device__ __forceinline__ unsigned pk_fp8x4(float a, float b, float c, float d) {
    a = fminf(fmaxf(a, -448.f), 448.f); b = fminf(fmaxf(b, -448.f), 448.f); c = fminf(fmaxf(c, -448.f), 448.f); d = fminf(fmaxf(d, -448.f), 448.f);
    unsigned w = 0u; w = __builtin_amdgcn_cvt_pk_fp8_f32(a, b, w, false); w = __builtin_amdgcn_cvt_pk_fp8_f32(c, d, w, true); return w;
}
__device__ __forceinline__ v4u fp8x8_to_bf16x8(u32x2 w) { typedef float f2_ __attribute__((ext_vector_type(2)));
    const f2_ a0 = __builtin_amdgcn_cvt_pk_f32_fp8(w.x, false), a1 = __builtin_amdgcn_cvt_pk_f32_fp8(w.x, true), a2 = __builtin_amdgcn_cvt_pk_f32_fp8(w.y, false), a3 = __builtin_amdgcn_cvt_pk_f32_fp8(w.y, true);
    v4u o; o.x = cvtpk(a0[0], a0[1]); o.y = cvtpk(a1[0], a1[1]); o.z = cvtpk(a2[0], a2[1]); o.w = cvtpk(a3[0], a3[1]); return o; }
template <int MODE> __device__ __forceinline__ void p0_transpose_item_fp8(const float* W, int K, int N, unsigned char* WT, LAS float* scr, int item, int lane, float scale) {
    const int nblk = N / 32, kb = item / nblk, nb = item % nblk, k0 = 64 * kb, n0 = 32 * nb;
    {
        const GAS f32x4* src = (const GAS f32x4*)(W + (size_t)(k0 + (lane >> 3)) * N + n0) + (lane & 7);
        f32x4 t[8];
#pragma unroll
        for (int j = 0; j < 8; ++j) t[j] = src[(size_t)j * 2 * N];
#pragma unroll
        for (int j = 0; j < 8; ++j) { LAS float* d = scr + ((lane >> 3) + 8 * j) * 33 + 4 * (lane & 7); d[0] = t[j].x; d[1] = t[j].y; d[2] = t[j].z; d[3] = t[j].w; }
    }
    LDS_WAIT(); asm volatile("" ::: "memory");
    const int c = lane & 7;
#pragma unroll
    for (int j = 0; j < 4; ++j) { const int n = (lane >> 3) + 8 * j; const LAS float* s = scr + (8 * c) * 33 + n;
        u32x2 o; o.x = pk_fp8x4(s[0 * 33] * scale, s[1 * 33] * scale, s[2 * 33] * scale, s[3 * 33] * scale); o.y = pk_fp8x4(s[4 * 33] * scale, s[5 * 33] * scale, s[6 * 33] * scale, s[7 * 33] * scale);
        *(GAS u32x2*)(WT + (size_t)dest_row<MODE>(n0 + n) * K + k0 + 8 * c) = o; }
    LDS_WAIT(); asm volatile("" ::: "memory");
}
__device__ __forceinline__ int t5_bucket(int rel) {
    const int n = rel < 0 ? -rel : rel;
    int large = 8 + (n >= 15) + (n >= 27) + (n >= 50) + (n >= 91) + (n >= 166) + (n >= 305) + (n >= 559);
    large = large < 15 ? large : 15;
    return (rel > 0 ? 16 : 0) + (n < 8 ? n : large);
}
__device__ __forceinline__ void p0_prologue(const Args& a, LAS unsigned char* lds, int vcu, int G, int tid, int wave, int lane) {
    unsigned char* ws = a.ws;
    LAS float* scr = (LAS float*)(lds + wave * 16384);
    const int gw = vcu * NWAVES + wave, NGW = G * NWAVES;
    constexpr int I_IN = 16 * 208, I_R = 16 * 32, I_A = 8 * 32, I_O = 16 * 32;
    constexpr int NITEMS = I_IN + I_R + I_A + I_O;
    for (int it = gw; it < NITEMS; it += NGW) {
        int r = it;
#if P1_FP8
        if (r < I_IN) { if ((GATE_FP8 || r % 208 < 144) && r % 208 >= 8 * P1_FP8_FROM) p0_transpose_item_fp8<1>(a.in[1], 1024, 6656, ws + WS_WIN8, scr, r, lane, 64.f);
                        else p0_transpose_item<1>(a.in[1], 1024, 6656, (bf16*)(ws + WS_WIN), scr, r, lane); continue; } r -= I_IN;
#else
        if (r < I_IN) { p0_transpose_item<1>(a.in[1], 1024, 6656, (bf16*)(ws + WS_WIN), scr, r, lane); continue; } r -= I_IN;
#endif
        if (r < I_R) { if (MIX_FP8 & 4) p0_transpose_item_fp8<0>(a.in[5], 1024, 1024, ws + WS_WR, scr, r, lane, 64.f); else p0_transpose_item<0>(a.in[5], 1024, 1024, (bf16*)(ws + WS_WR), scr, r, lane); continue; } r -= I_R;
        if (r < I_A) { if (MIX_FP8 & 2) p0_transpose_item_fp8<0>(a.in[7], 512, 1024, ws + WS_WA, scr, r, lane, 64.f); else p0_transpose_item<0>(a.in[7], 512, 1024, (bf16*)(ws + WS_WA), scr, r, lane); continue; } r -= I_A;
        if (MIX_FP8 & 1) p0_transpose_item_fp8<0>(a.in[8], 1024, 1024, ws + WS_WO, scr, r, lane, 64.f); else p0_transpose_item<0>(a.in[8], 1024, 1024, (bf16*)(ws + WS_WO), scr, r, lane);
    }
    {
        const f32x4* x4 = (const f32x4*)a.in[0]; u32x2* xb = (u32x2*)(ws + WS_XB);
#if P1_FP8
#if GATE_FP8
        unsigned* xf8 = (unsigned*)(ws + WS_X8_LO);
#define XF8_AT(i) xf8[(long)(i) + ((i) >= (size_t)16384 * 256 ? ((long)WS_X8_HI - (long)WS_X8_LO - (long)(16 * MiB)) / 4 : 0L)]
#else
        unsigned* xf8 = (unsigned*)a.out;
#define XF8_AT(i) xf8[i]
#endif
        const size_t n4 = (size_t)TT * DM / 4, st = (size_t)G * 512; size_t i = (size_t)vcu * 512 + tid;
        for (; i + 7 * st < n4; i += 8 * st) {
            f32x4 v[8];
#pragma unroll
            for (int u = 0; u < 8; ++u) v[u] = x4[i + u * st];
#pragma unroll
            for (int u = 0; u < 8; ++u) { if (!X_F32_RES) { u32x2 o; o.x = cvtpk(v[u].x, v[u].y); o.y = cvtpk(v[u].z, v[u].w); xb[i + u * st] = o; } XF8_AT(i + u * st) = pk_fp8x4(v[u].x, v[u].y, v[u].z, v[u].w); }
        }
        for (; i < n4; i += st) { const f32x4 v = x4[i]; if (!X_F32_RES) { u32x2 o; o.x = cvtpk(v.x, v.y); o.y = cvtpk(v.z, v.w); xb[i] = o; } XF8_AT(i) = pk_fp8x4(v.x, v.y, v.z, v.w); }
#undef XF8_AT
#else
        for (size_t i = (size_t)vcu * 512 + tid; i < (size_t)TT * DM / 4; i += (size_t)G * 512) { const f32x4 v = x4[i]; u32x2 o; o.x = cvtpk(v.x, v.y); o.y = cvtpk(v.z, v.w); xb[i] = o; }
#endif
    }
    {
        float* rot = (float*)(ws + WS_ROT);
        for (int idx = vcu * 512 + tid; idx < SEQ * 64; idx += G * 512) {
            const int pos = idx >> 6, jr = idx & 63;
            double iv = 1.0; for (int k = 0; k < jr; ++k) iv *= 0.86596432336006535;
            const float ang = (float)pos * (float)iv;
            const double xx = (double)ang; const double qd = __builtin_rint(xx * 0.63661977236758134); const int qi = (int)qd;
            const double r = (xx - qd * 1.5707963267948966) - qd * 6.123233995736766e-17, r2 = r * r;
            const double sp = r * (1.0 + r2 * (-1.0 / 6 + r2 * (1.0 / 120 + r2 * (-1.0 / 5040 + r2 * (1.0 / 362880 + r2 * (-1.0 / 39916800 + r2 * (1.0 / 6227020800.0)))))));
            const double cp = 1.0 + r2 * (-0.5 + r2 * (1.0 / 24 + r2 * (-1.0 / 720 + r2 * (1.0 / 40320 + r2 * (-1.0 / 3628800 + r2 * (1.0 / 479001600.0))))));
            const int qq = qi & 3; const double s = qq == 0 ? sp : (qq == 1 ? cp : (qq == 2 ? -sp : -cp)), c = qq == 0 ? cp : (qq == 1 ? -sp : (qq == 2 ? -cp : sp));
            float* o = rot + ((size_t)pos * 16 + (jr >> 2)) * 8 + (jr & 3); o[0] = (float)c; o[4] = (float)s;
        }
    }
    if (vcu == 0) {
        float* bt = (float*)(ws + WS_BIAS); const float* rb = a.in[6];
        for (int idx = tid; idx < 3 * 8 * 160; idx += 512) { const int p = idx / (8 * 160), h = (idx / 160) % 8, d = idx % 160 - 80; const int dil = p == 0 ? 1 : (p == 1 ? 4 : 16);
            bt[idx] = (d >= -64 && d <= 64) ? rb[t5_bucket(d * dil) * 8 + h] * 1.4426950408889634f : -1e30f; }
    }
}
__device__ __forceinline__ void p0_expert_weights(const Args& a, LAS unsigned char* lds, int vcu, int G, int wave, int lane) {
    unsigned char* ws = a.ws;
    LAS float* scr = (LAS float*)(lds + wave * 16384);
    const int gw = vcu * NWAVES + wave, NGW = G * NWAVES;
    constexpr int I_G = 16 * 16, I_D = 8 * 32, PER_E = 2 * I_G + I_D;
    for (int it = gw; it < 16 * PER_E; it += NGW) {
        const int e = it / PER_E; int r = it - e * PER_E;
#if M1_FP8
        if (r < I_G) { p0_transpose_item_fp8<2>(a.in[15] + (size_t)e * 1024 * 512, 1024, 512, ws + WS_WGU + (size_t)e * 1024 * 1024, scr, r, lane, 64.f); continue; } r -= I_G;
        if (r < I_G) { p0_transpose_item_fp8<3>(a.in[16] + (size_t)e * 1024 * 512, 1024, 512, ws + WS_WGU + (size_t)e * 1024 * 1024, scr, r, lane, 64.f); continue; } r -= I_G;
#else
        if (r < I_G) { p0_transpose_item<2>(a.in[15] + (size_t)e * 1024 * 512, 1024, 512, (bf16*)(ws + WS_WGU) + (size_t)e * 1024 * 1024, scr, r, lane); continue; } r -= I_G;
        if (r < I_G) { p0_transpose_item<3>(a.in[16] + (size_t)e * 1024 * 512, 1024, 512, (bf16*)(ws + WS_WGU) + (size_t)e * 1024 * 1024, scr, r, lane); continue; } r -= I_G;
#endif
        p0_transpose_item_fp8<0>(a.in[17] + (size_t)e * 512 * 1024, 512, 1024, ws + WS_WD + (size_t)e * 1024 * 512, scr, r, lane, 64.f);
    }
    __syncthreads();
}

__device__ __forceinline__ float log2_gamma(const float* dec, int h) {
    const float x = dec[h]; return -__log2f(1.f + __expf(-x));
}
__device__ __forceinline__ void chain_item(const Args& a, LAS unsigned char* lds, int item, int tid, int wid, int lane) {
    unsigned char* ws = a.ws;
    const int b = item >> 4, h = (item >> 2) & 3, dir = (item >> 1) & 1, vh = item & 1;
    const float lg2 = log2_gamma(dir ? a.in[3] : a.in[2], h);
    const float cd = __builtin_amdgcn_exp2f(lg2 * 128.f);
    const int g = lane >> 4, i16 = lane & 15, q = i16 >> 2, p = lane & 3;
    const int wd = wid >> 1, wv = wid & 1;
    const GAS bf16* kr = (const GAS bf16*)(ws + WS_KR); const GAS bf16* vr = (const GAS bf16*)(ws + WS_VR);
    GAS bf16* states = (GAS bf16*)a.out;
    f32x4 acc[2][4];
#pragma unroll
    for (int i = 0; i < 2; ++i)
#pragma unroll
        for (int j = 0; j < 4; ++j) acc[i][j] = (f32x4){0.f, 0.f, 0.f, 0.f};
    const int srow = tid >> 4, sch = tid & 15; const unsigned soff = offb(srow, sch);
    const GAS bf16* kp = kr + ((size_t)b * SEQ + srow) * 512 + h * 128 + sch * 8;
    const GAS bf16* vp = vr + ((size_t)b * SEQ + srow) * 1024 + h * 256 + vh * 128 + sch * 8;
    v4u kq[4], vq[4];
    { const int n0 = dir ? 15 : 0;
#pragma unroll
      for (int j = 0; j < 4; ++j) { kq[j] = *(const GAS v4u*)(kp + (size_t)(n0 * 128 + 32 * j) * 512); vq[j] = *(const GAS v4u*)(vp + (size_t)(n0 * 128 + 32 * j) * 1024); } }
    unsigned abase[2][2], bbase[4][2];
#pragma unroll
    for (int t = 0; t < 2; ++t) { const unsigned r = 8 * g + 4 * t + q;
#pragma unroll
        for (int dt = 0; dt < 2; ++dt) abase[dt][t] = offb(r, 2 * (2 * wd + dt) + (p >> 1)) + 8 * (p & 1);
#pragma unroll
        for (int vt = 0; vt < 4; ++vt) bbase[vt][t] = offb(r, 2 * (4 * wv + vt) + (p >> 1)) + 8 * (p & 1); }
#define CH_STAGE(BUFOFF) do { _Pragma("unroll") for (int j = 0; j < 4; ++j) { \
            const int row = srow + 32 * j; const float z = __builtin_amdgcn_exp2f(lg2 * (float)(dir ? row : 127 - row)); const v4u kv = kq[j]; \
            v4u ko; ko.x = cvtpk(bflo(kv.x) * z, bfhi(kv.x) * z); ko.y = cvtpk(bflo(kv.y) * z, bfhi(kv.y) * z); ko.z = cvtpk(bflo(kv.z) * z, bfhi(kv.z) * z); ko.w = cvtpk(bflo(kv.w) * z, bfhi(kv.w) * z); \
            *(LAS v4u*)(lds + (BUFOFF) + soff + j * 8192) = ko; *(LAS v4u*)(lds + (BUFOFF) + 32768 + soff + j * 8192) = vq[j]; } } while (0)
#define CH_FETCH(NN) do { _Pragma("unroll") for (int j = 0; j < 4; ++j) { kq[j] = *(const GAS v4u*)(kp + (size_t)((NN) * 128 + 32 * j) * 512); vq[j] = *(const GAS v4u*)(vp + (size_t)((NN) * 128 + 32 * j) * 1024); } } while (0)
#define CH_STEP(STEP, CUR, OTH) do { const int step_ = (STEP); const int n_ = dir ? 15 - step_ : step_; \
        GAS bf16* sb_ = states + ((((size_t)(b * 4 + h) * 16 + n_) * 2 + dir) * 256) * 128; \
        _Pragma("unroll") for (int dt = 0; dt < 2; ++dt) _Pragma("unroll") for (int vt = 0; vt < 4; ++vt) { \
            const int v_ = vh * 128 + 64 * wv + 16 * vt + i16, d0_ = 32 * wd + 16 * dt + 4 * g; \
            if (STATE_FP8) { *(GAS unsigned*)((GAS unsigned char*)states + (((((size_t)(b * 4 + h) * 16 + n_) * 2 + dir) * 256) + v_) * 128 + d0_) = pg8::fp8x4_sat(acc[dt][vt][0] * 16.f, acc[dt][vt][1] * 16.f, acc[dt][vt][2] * 16.f, acc[dt][vt][3] * 16.f); }   \
            else { u32x2 w_; w_.x = pg8::cvt_pk_bf16_acc(acc[dt][vt][0], acc[dt][vt][1]); w_.y = pg8::cvt_pk_bf16_acc(acc[dt][vt][2], acc[dt][vt][3]);   \
            *(GAS u32x2*)(sb_ + (size_t)v_ * 128 + d0_) = w_; } } \
        if (step_ < 15) CH_STAGE(OTH); \
        if (step_ < 14) CH_FETCH(dir ? 13 - step_ : step_ + 2); \
        _Pragma("unroll") for (int i = 0; i < 2; ++i) _Pragma("unroll") for (int j = 0; j < 4; ++j) acc[i][j] = acc[i][j] * cd; \
        _Pragma("unroll") for (int ks = 0; ks < 4; ++ks) { bf16x8 af[2], bfr[4]; \
            _Pragma("unroll") for (int dt = 0; dt < 2; ++dt) af[dt] = cat8(ldtr(lds + (CUR) + abase[dt][0] + ks * 8192), ldtr(lds + (CUR) + abase[dt][1] + ks * 8192)); \
            _Pragma("unroll") for (int vt = 0; vt < 4; ++vt) bfr[vt] = cat8(ldtr(lds + (CUR) + 32768 + bbase[vt][0] + ks * 8192), ldtr(lds + (CUR) + 32768 + bbase[vt][1] + ks * 8192)); \
            _Pragma("unroll") for (int dt = 0; dt < 2; ++dt) _Pragma("unroll") for (int vt = 0; vt < 4; ++vt) acc[dt][vt] = MFMA16(af[dt], bfr[vt], acc[dt][vt]); } \
        __syncthreads(); } while (0)
    CH_STAGE(0);
    CH_FETCH(dir ? 14 : 1);
    __syncthreads();
    for (int sp = 0; sp < 8; ++sp) { CH_STEP(2 * sp, 0, 65536); CH_STEP(2 * sp + 1, 65536, 0); }
#undef CH_STEP
#undef CH_STAGE
#undef CH_FETCH
}

constexpr int AT_OST = 135168, AT_SCR = AT_OST + 8 * 2048;
constexpr int ATB_N = 160;
struct AttnLane { unsigned kb[2]; unsigned vb[4]; };
__device__ __forceinline__ AttnLane attn_lane(int lane) {
    const int g = lane >> 4, i16 = lane & 15, q4 = i16 >> 2, p = lane & 3; AttnLane L;
#pragma unroll
    for (int s = 0; s < 2; ++s) L.kb[s] = i16 * 128 + (((4 * s + g) ^ ((i16 >> 1) & 7)) * 16);
    const int sw = (2 * g + (q4 >> 1)) & 3;
#pragma unroll
    for (int c = 0; c < 4; ++c) L.vb[c] = (4 * g + q4) * 128 + ((c ^ sw) * 32) + p * 8;
    return L;
}
__device__ __forceinline__ unsigned kimg_off(int row, int c) { return row * 128 + ((c ^ ((row >> 1) & 7)) * 16); }
__device__ __forceinline__ unsigned vimg_off(int row, int c) { return row * 128 + (((c >> 1) ^ ((row >> 1) & 3)) * 32) + (c & 1) * 16; }
__device__ __forceinline__ void attn_core(const LAS unsigned char* Kimg, const LAS unsigned char* Vimg, int R0, int nrows, unsigned tvalid, const bf16x8 (&qf)[2],
                                          const float (&biasr)[36], const AttnLane& L, f32x4 (&O)[4], float& mx, float& lsum) {
    f32x4 D[9];
#pragma unroll
    for (int kt = 0; kt < 9; ++kt) {
        int R = R0 + 16 * kt; R = R < 0 ? 0 : (R > nrows - 16 ? nrows - 16 : R);
        const LAS unsigned char* kp = Kimg + R * 128;
        const bf16x8 k0 = *(const LAS bf16x8*)(kp + L.kb[0]), k1 = *(const LAS bf16x8*)(kp + L.kb[1]);
        f32x4 d = (f32x4){0.f, 0.f, 0.f, 0.f};
        d = MFMA16(k0, qf[0], d); d = MFMA16(k1, qf[1], d); D[kt] = d;
    }
    mx = -1e30f;
#pragma unroll
    for (int kt = 0; kt < 9; ++kt) {
        const float tb = ((tvalid >> kt) & 1u) ? 0.f : -1e30f;
#pragma unroll
        for (int r = 0; r < 4; ++r) { const float x = D[kt][r] + (biasr[4 * kt + r] + tb); D[kt][r] = x; mx = fmaxf(mx, x); }
    }
    mx = fmaxf(mx, __shfl_xor(mx, 16)); mx = fmaxf(mx, __shfl_xor(mx, 32));
    lsum = 0.f;
#pragma unroll
    for (int kt = 0; kt < 9; ++kt)
#pragma unroll
        for (int r = 0; r < 4; ++r) { const float e = __builtin_amdgcn_exp2f(D[kt][r] - mx); D[kt][r] = e; lsum += e; }
    lsum += __shfl_xor(lsum, 16); lsum += __shfl_xor(lsum, 32);
#pragma unroll
    for (int c = 0; c < 4; ++c) O[c] = (f32x4){0.f, 0.f, 0.f, 0.f};
#pragma unroll
    for (int kk = 0; kk < 5; ++kk) {
        int Ra = R0 + 32 * kk; Ra = Ra < 0 ? 0 : (Ra > nrows - 16 ? nrows - 16 : Ra);
        int Rb = R0 + 32 * kk + 16; Rb = Rb < 0 ? 0 : (Rb > nrows - 16 ? nrows - 16 : Rb);
        if (kk == 4) Rb = Ra;
        const f32x4 e0 = D[2 * kk], e1 = kk < 4 ? D[2 * kk + 1] : (f32x4){0.f, 0.f, 0.f, 0.f};
        v4u pw; pw.x = cvtpk(e0[0], e0[1]); pw.y = cvtpk(e0[2], e0[3]); pw.z = cvtpk(e1[0], e1[1]); pw.w = cvtpk(e1[2], e1[3]);
        const bf16x8 pf = __builtin_bit_cast(bf16x8, pw);
        const LAS unsigned char* va_ = Vimg + Ra * 128; const LAS unsigned char* vb_ = Vimg + Rb * 128;
#pragma unroll
        for (int c = 0; c < 4; ++c) O[c] = MFMA16(pf, cat8(ldtr(va_ + L.vb[c]), ldtr(vb_ + L.vb[c])), O[c]);
    }
}
__device__ __forceinline__ void attn_stage_out(LAS unsigned char* lds, int wid, int lane, const f32x4 (&O)[4], float lsum) {
    const int g = lane >> 4, i16 = lane & 15;
    const float linv = 1.f / lsum;
    LAS bf16* st = (LAS bf16*)(lds + AT_OST + wid * 2048);
#pragma unroll
    for (int r = 0; r < 4; ++r) { const float li = __shfl(linv, 4 * g + r);
#pragma unroll
        for (int c = 0; c < 4; ++c) st[(4 * g + r) * 64 + 16 * c + i16] = (bf16)(cvtpk(O[c][r] * li, 0.f) & 0xffffu); }
}
__device__ __forceinline__ void attn_load_bias(const Args& a, int pat, int h, int lane, float (&biasr)[36]) {
    const GAS float* bt = (const GAS float*)(a.ws + WS_BIAS) + (pat * 8 + h) * ATB_N; const int g = lane >> 4, i16 = lane & 15;
#pragma unroll
    for (int kt = 0; kt < 9; ++kt)
#pragma unroll
        for (int r = 0; r < 4; ++r) biasr[4 * kt + r] = bt[16 * kt + 4 * g + r - 64 - i16 + 80];
}
#if ATT_FP8
typedef u32x2 att_raw_t;
#define ATT_LD(base, off) (*(const GAS u32x2*)((const GAS unsigned char*)(base) + (off)))
#define ATT_WIDE(r) fp8x8_to_bf16x8(r)
#define ATT_ZERO ((u32x2){0u, 0u})
#else
typedef v4u att_raw_t;
#define ATT_LD(base, off) (*(const GAS v4u*)((base) + (off)))
#define ATT_WIDE(r) (r)
#define ATT_ZERO ((v4u){0u, 0u, 0u, 0u})
#endif
template <int DIL, int VAR = 0> __device__ __forceinline__ void attn_dil_phase(const Args& a, LAS unsigned char* lds, int vcu, int G, int tid, int wid, int lane) {
    unsigned char* ws = a.ws;
    constexpr int NR = SEQ / DIL, PAT = DIL == 4 ? 1 : 2, CH = NR * 8 / 512, NITEM = NB * 8 * DIL;
    constexpr int NBUF = DIL == 16 ? 2 : 1, BUFB = 2 * NR * 128;
    const GAS bf16* qa = (const GAS bf16*)(ws + WS_QA); const GAS bf16* ka = (const GAS bf16*)(ws + WS_KA); const GAS bf16* va = (const GAS bf16*)(ws + WS_VA);
    bf16* op = (bf16*)(ws + (DIL == 4 ? WS_O2 : WS_O3)); float* lsep = (float*)(ws + (DIL == 4 ? WS_LSE2 : WS_LSE3));
    if (vcu >= NITEM) return;
    const int h = vcu & 7;
    float biasr[36]; attn_load_bias(a, PAT, h, lane, biasr);
    const AttnLane L = attn_lane(lane);
    const int g = lane >> 4, i16 = lane & 15;
    att_raw_t kq[CH], vq[CH], qn[2];
    auto issue = [&](int item, int gi) {
        const int rho = (item >> 3) % DIL, b = item / (8 * DIL); const size_t rowb = (size_t)b * SEQ;
#pragma unroll
        for (int j = 0; j < CH; ++j) { const int id = tid + 512 * j, row = id >> 3, c = id & 7; const size_t go = (rowb + (size_t)row * DIL + rho) * 512 + h * 64 + c * 8;
            kq[j] = ATT_LD(ka, go); vq[j] = ATT_LD(va, go); }
        const size_t qpos = rowb + (size_t)(16 * gi + i16) * DIL + rho;
#pragma unroll
        for (int s = 0; s < 2; ++s) qn[s] = ATT_LD(qa, qpos * 512 + h * 64 + 32 * s + 8 * g);
    };
    issue(vcu, wid);
    int buf = 0;
    for (int item = vcu; item < NITEM; item += G) {
        const int rho = (item >> 3) % DIL, b = item / (8 * DIL); const size_t rowb = (size_t)b * SEQ;
        LAS unsigned char* Kimg = lds + buf * BUFB; LAS unsigned char* Vimg = Kimg + NR * 128;
        if (NBUF == 1) __syncthreads();
#pragma unroll
        for (int j = 0; j < CH; ++j) { const int id = tid + 512 * j, row = id >> 3, c = id & 7;
            *(LAS v4u*)(Kimg + kimg_off(row, c)) = ATT_WIDE(kq[j]); *(LAS v4u*)(Vimg + vimg_off(row, c)) = ATT_WIDE(vq[j]); }
        bf16x8 qf[2] = {__builtin_bit_cast(bf16x8, ATT_WIDE(qn[0])), __builtin_bit_cast(bf16x8, ATT_WIDE(qn[1]))};
        __syncthreads();
        if (NBUF == 2 && item + G < NITEM) issue(item + G, wid);
        for (int gi = wid; gi < NR / 16; gi += 8) {
            const int m0 = 16 * gi;
            if (NBUF == 1 && gi + 8 < NR / 16) {
                const size_t qpos = rowb + (size_t)(m0 + 128 + i16) * DIL + rho;
#pragma unroll
                for (int s = 0; s < 2; ++s) qn[s] = ATT_LD(qa, qpos * 512 + h * 64 + 32 * s + 8 * g); }
            unsigned tvalid = 0u;
#pragma unroll
            for (int kt = 0; kt < 9; ++kt) { const int t0 = m0 - 64 + 16 * kt; tvalid |= (t0 >= 0 && t0 < NR) ? (1u << kt) : 0u; }
            f32x4 O[4]; float mx, lsum;
            if (VAR == 1) { mx = 0.f; lsum = 1.f;
#pragma unroll
                for (int c = 0; c < 4; ++c) O[c] = (f32x4){__builtin_bit_cast(float, qf[0][0] + c), 0.f, 0.f, 0.f}; }
            else attn_core(Kimg, Vimg, m0 - 64, NR, tvalid, qf, biasr, L, O, mx, lsum);
            attn_stage_out(lds, wid, lane, O, lsum);
            if (g == 0) lsep[(rowb + (size_t)(m0 + i16) * DIL + rho) * 8 + h] = mx + __log2f(lsum);
            asm volatile("s_waitcnt lgkmcnt(0)" ::: "memory");
            { const int q = lane >> 2, qt = lane & 3; const LAS v4u* sp = (const LAS v4u*)(lds + AT_OST + wid * 2048 + q * 128 + qt * 32);
              const v4u x0 = sp[0], x1 = sp[1];
#if O23_FP8
              v4u o8;
              o8.x = pk_fp8x4(16.f * bflo(x0.x), 16.f * bfhi(x0.x), 16.f * bflo(x0.y), 16.f * bfhi(x0.y)); o8.y = pk_fp8x4(16.f * bflo(x0.z), 16.f * bfhi(x0.z), 16.f * bflo(x0.w), 16.f * bfhi(x0.w));
              o8.z = pk_fp8x4(16.f * bflo(x1.x), 16.f * bfhi(x1.x), 16.f * bflo(x1.y), 16.f * bfhi(x1.y)); o8.w = pk_fp8x4(16.f * bflo(x1.z), 16.f * bfhi(x1.z), 16.f * bflo(x1.w), 16.f * bfhi(x1.w));
              *(v4u*)((unsigned char*)op + (rowb + (size_t)(m0 + q) * DIL + rho) * 512 + h * 64 + qt * 16) = o8; }
#else
              bf16* dst = op + (rowb + (size_t)(m0 + q) * DIL + rho) * 512 + h * 64 + qt * 16;
              *(v4u*)dst = x0; *(v4u*)(dst + 8) = x1; }
#endif
            asm volatile("s_waitcnt lgkmcnt(0)" ::: "memory");
            if (NBUF == 1) { qf[0] = __builtin_bit_cast(bf16x8, ATT_WIDE(qn[0])); qf[1] = __builtin_bit_cast(bf16x8, ATT_WIDE(qn[1])); }
        }
        if (NBUF == 1 && item + G < NITEM) issue(item + G, wid);
        buf ^= (NBUF - 1);
    }
    __syncthreads();
}
__device__ __forceinline__ void attn_p1_phase(const Args& a, LAS unsigned char* lds, int vcu, int G, int tid, int wid, int lane) {
    unsigned char* ws = a.ws;
    LAS unsigned char* Kimg = lds; LAS unsigned char* Vimg = lds + 384 * 128;
    const GAS bf16* qa = (const GAS bf16*)(ws + WS_QA); const GAS bf16* ka = (const GAS bf16*)(ws + WS_KA); const GAS bf16* va = (const GAS bf16*)(ws + WS_VA);
    const GAS bf16* o2 = (const GAS bf16*)(ws + WS_O2); const GAS bf16* o3 = (const GAS bf16*)(ws + WS_O3);
    const GAS float* lse2 = (const GAS float*)(ws + WS_LSE2); const GAS float* lse3 = (const GAS float*)(ws + WS_LSE3);
    bf16* oa = (bf16*)(ws + WS_OA);
    if (vcu >= 1024) return;
    const int h = vcu & 7;
    float biasr[36]; attn_load_bias(a, 0, h, lane, biasr);
    const AttnLane L = attn_lane(lane);
    const int g = lane >> 4, i16 = lane & 15;
    LAS float* scr = (LAS float*)(lds + AT_SCR) + wid * 16;
    att_raw_t kq[6], vq[6];
    auto issue = [&](int item) { const int b = item >> 6, s0 = ((item >> 3) & 7) * 256; const size_t rowb = (size_t)b * SEQ;
#pragma unroll
        for (int j = 0; j < 6; ++j) { const int id = tid + 512 * j, row = id >> 3, c = id & 7, pos = s0 - 64 + row; const bool ok = pos >= 0 && pos < SEQ;
            const size_t go = (rowb + (size_t)(ok ? pos : 0)) * 512 + h * 64 + c * 8;
            kq[j] = ATT_LD(ka, go); vq[j] = ATT_LD(va, go);
            if (!ok) { kq[j] = ATT_ZERO; vq[j] = ATT_ZERO; } } };
    issue(vcu);
    for (int item = vcu; item < 1024; item += G) {
        const int b = item >> 6, s0 = ((item >> 3) & 7) * 256; const size_t rowb = (size_t)b * SEQ;
        __syncthreads();
#pragma unroll
        for (int j = 0; j < 6; ++j) { const int id = tid + 512 * j, row = id >> 3, c = id & 7;
            *(LAS v4u*)(Kimg + kimg_off(row, c)) = ATT_WIDE(kq[j]); *(LAS v4u*)(Vimg + vimg_off(row, c)) = ATT_WIDE(vq[j]); }
        __syncthreads();
        if (item + G < 1024) issue(item + G);
        for (int gi = wid; gi < 16; gi += 8) {
            const int m0 = s0 + 16 * gi;
            const int q = lane >> 2, qt = lane & 3; const size_t tq = rowb + m0 + q;
#if O23_FP8
            const v4u a2q = *(const GAS v4u*)((const GAS unsigned char*)o2 + tq * 512 + h * 64 + qt * 16), a3q = *(const GAS v4u*)((const GAS unsigned char*)o3 + tq * 512 + h * 64 + qt * 16);
#else
            const v4u a20 = *(const GAS v4u*)(o2 + tq * 512 + h * 64 + qt * 16), a21 = *(const GAS v4u*)(o2 + tq * 512 + h * 64 + qt * 16 + 8);
            const v4u a30 = *(const GAS v4u*)(o3 + tq * 512 + h * 64 + qt * 16), a31 = *(const GAS v4u*)(o3 + tq * 512 + h * 64 + qt * 16 + 8);
#endif
            const float l2 = lse2[tq * 8 + h], l3 = lse3[tq * 8 + h];
            bf16x8 qf[2];
#pragma unroll
            for (int s = 0; s < 2; ++s) qf[s] = __builtin_bit_cast(bf16x8, ATT_WIDE(ATT_LD(qa, (rowb + m0 + i16) * 512 + h * 64 + 32 * s + 8 * g)));
            unsigned tvalid = 0u;
#pragma unroll
            for (int kt = 0; kt < 9; ++kt) { const int t0 = m0 - 64 + 16 * kt; tvalid |= (t0 >= 0 && t0 < SEQ) ? (1u << kt) : 0u; }
            f32x4 O[4]; float mx, lsum;
            attn_core(Kimg, Vimg, 16 * gi, 384, tvalid, qf, biasr, L, O, mx, lsum);
            attn_stage_out(lds, wid, lane, O, lsum);
            if (g == 0) scr[i16] = mx + __log2f(lsum);
            asm volatile("s_waitcnt lgkmcnt(0)" ::: "memory");
            {
                const float l1 = scr[q], M = fmaxf(l1, fmaxf(l2, l3));
                float w1 = __builtin_amdgcn_exp2f(l1 - M), w2 = __builtin_amdgcn_exp2f(l2 - M), w3 = __builtin_amdgcn_exp2f(l3 - M); const float wi = 1.f / (w1 + w2 + w3); w1 *= wi; w2 *= wi; w3 *= wi;
                const LAS v4u* sp = (const LAS v4u*)(lds + AT_OST + wid * 2048 + q * 128 + qt * 32);
                const v4u x0 = sp[0], x1 = sp[1];
                v4u r0, r1;
#if O23_FP8
                { typedef float f2_ __attribute__((ext_vector_type(2))); const float w2s = w2 * 0.0625f, w3s = w3 * 0.0625f;
#define MRG8(d, x, yw, zw, hi) { const f2_ y_ = __builtin_amdgcn_cvt_pk_f32_fp8(yw, hi), z_ = __builtin_amdgcn_cvt_pk_f32_fp8(zw, hi); d = cvtpk(w1 * bflo(x) + w2s * y_[0] + w3s * z_[0], w1 * bfhi(x) + w2s * y_[1] + w3s * z_[1]); }
                MRG8(r0.x, x0.x, a2q.x, a3q.x, false) MRG8(r0.y, x0.y, a2q.x, a3q.x, true) MRG8(r0.z, x0.z, a2q.y, a3q.y, false) MRG8(r0.w, x0.w, a2q.y, a3q.y, true)
                MRG8(r1.x, x1.x, a2q.z, a3q.z, false) MRG8(r1.y, x1.y, a2q.z, a3q.z, true) MRG8(r1.z, x1.z, a2q.w, a3q.w, false) MRG8(r1.w, x1.w, a2q.w, a3q.w, true)
#undef MRG8
                }
#else
#define MRG(d, x, y, z) d = cvtpk(w1 * bflo(x) + w2 * bflo(y) + w3 * bflo(z), w1 * bfhi(x) + w2 * bfhi(y) + w3 * bfhi(z))
                MRG(r0.x, x0.x, a20.x, a30.x); MRG(r0.y, x0.y, a20.y, a30.y); MRG(r0.z, x0.z, a20.z, a30.z); MRG(r0.w, x0.w, a20.w, a30.w);
                MRG(r1.x, x1.x, a21.x, a31.x); MRG(r1.y, x1.y, a21.y, a31.y); MRG(r1.z, x1.z, a21.z, a31.z); MRG(r1.w, x1.w, a21.w, a31.w);
#undef MRG
#endif
#if MIX_FP8 & 2
                v4u o8;
                o8.x = pk_fp8x4(16.f * bflo(r0.x), 16.f * bfhi(r0.x), 16.f * bflo(r0.y), 16.f * bfhi(r0.y)); o8.y = pk_fp8x4(16.f * bflo(r0.z), 16.f * bfhi(r0.z), 16.f * bflo(r0.w), 16.f * bfhi(r0.w));
                o8.z = pk_fp8x4(16.f * bflo(r1.x), 16.f * bfhi(r1.x), 16.f * bflo(r1.y), 16.f * bfhi(r1.y)); o8.w = pk_fp8x4(16.f * bflo(r1.z), 16.f * bfhi(r1.z), 16.f * bflo(r1.w), 16.f * bfhi(r1.w));
                *(v4u*)((unsigned char*)oa + tq * 512 + h * 64 + qt * 16) = o8;
#else
                bf16* dst = oa + tq * 512 + h * 64 + qt * 16;
                *(v4u*)dst = r0; *(v4u*)(dst + 8) = r1;
#endif
            }
            asm volatile("s_waitcnt lgkmcnt(0)" ::: "memory");
        }
    }
    __syncthreads();
}

#define OPAQUE(x) asm volatile("" : "+v"(x))
template <int VAR = 0> __device__ __forceinline__ void p3_phase(const Args& a, LAS unsigned char* lds, int vcu, int G, int tid, int wid, int lane) {
    unsigned char* ws = a.ws;
    const int g = lane >> 4, i16 = lane & 15, q4 = i16 >> 2, p = lane & 3;
    const GAS bf16* qr = (const GAS bf16*)(ws + WS_QR); const GAS bf16* kr = (const GAS bf16*)(ws + WS_KR); const GAS bf16* vr = (const GAS bf16*)(ws + WS_VR);
    GAS bf16* gr = (GAS bf16*)(ws + WS_GR);
    LAS unsigned char* Kt = lds; LAS unsigned char* Sg = lds + 32768;
    if (vcu >= 1024) return;
    const unsigned kdst = offb(tid >> 4, tid & 15);
    unsigned rfo[4];
    { const unsigned X = ((i16 & 3) << 2) | (i16 >> 2);
#pragma unroll
      for (int s = 0; s < 4; ++s) rfo[s] = 256 * i16 + 16 * (((4 * s) ^ (X & 12)) | (g ^ (X & 3))); }
    v4u sreg[8], kreg[4]; bf16x8 qn[4];
    auto item_ptrs = [&](int item, size_t& tok0, const GAS bf16*& sf, int& h) { const int b = item >> 6; h = (item >> 4) & 3; const int n = item & 15; tok0 = (size_t)b * SEQ + n * 128;
        sf = (const GAS bf16*)((const GAS unsigned char*)a.out + ((((size_t)(b * 4 + h) * 16 + n) * 2 + 0) * 256) * 128 * (STATE_FP8 ? 1 : 2)); };
    auto issue_k = [&](int item) { size_t tok0; const GAS bf16* sf; int h; item_ptrs(item, tok0, sf, h);
        const GAS bf16* ks_ = kr + (tok0 + (tid >> 4)) * 512 + h * 128 + (tid & 15) * 8;
#pragma unroll
        for (int j = 0; j < 4; ++j) kreg[j] = *(const GAS v4u*)(ks_ + (size_t)j * 32 * 512); };
    auto issue_q = [&](int item) { size_t tok0; const GAS bf16* sf; int h; item_ptrs(item, tok0, sf, h);
#pragma unroll
        for (int s = 0; s < 4; ++s) qn[s] = *(const GAS bf16x8*)(qr + (tok0 + 16 * wid + i16) * 512 + h * 128 + 32 * s + 8 * g); };
#if STATE_FP8
    auto issue_state = [&](const GAS bf16* sf, int dirn) { const GAS unsigned char* sld = (const GAS unsigned char*)sf + (size_t)dirn * 256 * 128 + (size_t)(tid >> 4) * 128 + (tid & 15) * 8;
#pragma unroll
        for (int j = 0; j < 4; ++j) { const u32x2 lo = *(const GAS u32x2*)(sld + (size_t)(2 * j) * 32 * 128), hi = *(const GAS u32x2*)(sld + (size_t)(2 * j + 1) * 32 * 128); sreg[j] = (v4u){lo.x, lo.y, hi.x, hi.y}; } };
    auto write_state = [&]() {
#pragma unroll
        for (int j = 0; j < 8; ++j) { typedef float f2_ __attribute__((ext_vector_type(2)));
            const unsigned w0 = (j & 1) ? sreg[j >> 1].z : sreg[j >> 1].x, w1 = (j & 1) ? sreg[j >> 1].w : sreg[j >> 1].y;
            const f2_ a0 = __builtin_amdgcn_cvt_pk_f32_fp8(w0, false), a1 = __builtin_amdgcn_cvt_pk_f32_fp8(w0, true), a2 = __builtin_amdgcn_cvt_pk_f32_fp8(w1, false), a3 = __builtin_amdgcn_cvt_pk_f32_fp8(w1, true);
            v4u o; o.x = cvtpk(a0[0], a0[1]); o.y = cvtpk(a1[0], a1[1]); o.z = cvtpk(a2[0], a2[1]); o.w = cvtpk(a3[0], a3[1]);
            *(LAS v4u*)(Sg + (j >> 2) * 32768 + kdst + (j & 3) * 8192) = o; asm volatile("" ::: "memory"); } };
#else
    auto issue_state = [&](const GAS bf16* sf, int dirn) { const GAS bf16* sld = sf + (size_t)dirn * 256 * 128 + (size_t)(tid >> 4) * 128 + (tid & 15) * 8;
#pragma unroll
        for (int j = 0; j < 8; ++j) sreg[j] = *(const GAS v4u*)(sld + (size_t)j * 32 * 128); };
    auto write_state = [&]() {
#pragma unroll
        for (int j = 0; j < 8; ++j) *(LAS v4u*)(Sg + (j >> 2) * 32768 + kdst + (j & 3) * 8192) = sreg[j]; };
#endif
    { size_t tok0; const GAS bf16* sf; int h; item_ptrs(vcu, tok0, sf, h); issue_k(vcu); issue_q(vcu); issue_state(sf, 0); }
#pragma unroll
    for (int j = 0; j < 4; ++j) *(LAS v4u*)(Kt + kdst + j * 8192) = kreg[j];
    for (int item = vcu; item < 1024; item += G) {
        size_t tok0; const GAS bf16* sf; int h; item_ptrs(item, tok0, sf, h);
        const float lf2 = log2_gamma(a.in[2], h), lb2 = log2_gamma(a.in[3], h);
        bf16x8 qf[4];
#pragma unroll
        for (int s = 0; s < 4; ++s) qf[s] = qn[s];
        const bool has_next = item + G < 1024;
        __syncthreads();
        f32x4 D[8];
#pragma unroll
        for (int jt = 0; jt < 8; ++jt) {
            f32x4 d = (f32x4){0.f, 0.f, 0.f, 0.f};
#pragma unroll
            for (int s = 0; s < 4; ++s) { if (VAR != 1) { const bf16x8 kf = *(const LAS bf16x8*)(Kt + rfo[s] + jt * 4096); d = MFMA16(kf, qf[s], d); } else d[s] = __builtin_bit_cast(float, (int)qf[s][0]); }
            D[jt] = d;
        }
        int iq = 16 * wid + i16; OPAQUE(iq);
        bf16x8 pf[4];
#pragma unroll
        for (int ks = 0; ks < 4; ++ks) {
            float e[8];
#pragma unroll
            for (int t = 0; t < 2; ++t)
#pragma unroll
                for (int r = 0; r < 4; ++r) {
                    const int j = 16 * (2 * ks + t) + 4 * g + r; const float fdf = (float)(iq - j), ad = fabsf(fdf);
                    const float pos = fminf(fmaxf(fdf, 0.f), 1.f), isz = 1.f - fminf(ad, 1.f);
                    const float w = __builtin_amdgcn_exp2f((lb2 + (lf2 - lb2) * pos) * ad) + isz;
                    e[4 * t + r] = D[2 * ks + t][r] * w;
                }
            v4u pw; pw.x = cvtpk(e[0], e[1]); pw.y = cvtpk(e[2], e[3]); pw.z = cvtpk(e[4], e[5]); pw.w = cvtpk(e[6], e[7]);
            pf[ks] = __builtin_bit_cast(bf16x8, pw);
        }
        f32x4 acc[16];
#pragma unroll
        for (int vt = 0; vt < 16; ++vt) acc[vt] = (f32x4){0.f, 0.f, 0.f, 0.f};
#pragma unroll
        for (int dirn = 0; dirn < 2; ++dirn) {
            if (dirn == 1) __syncthreads();
            write_state();
            if (dirn == 0) { issue_state(sf, 1); if (has_next) issue_k(item + G); }
            else {
                if (has_next) {
#pragma unroll
                    for (int j = 0; j < 4; ++j) *(LAS v4u*)(Kt + kdst + j * 8192) = kreg[j]; }
                const GAS bf16* vs_ = vr + (tok0 + (tid >> 5)) * 1024 + h * 256 + (tid & 31) * 8;
#pragma unroll
                for (int j = 0; j < 8; ++j) sreg[j] = *(const GAS v4u*)(vs_ + (size_t)j * 16 * 1024);
            }
            __syncthreads();
#pragma unroll
            for (int vt = 0; vt < 16; ++vt) {
#pragma unroll
                for (int s = 0; s < 4; ++s) { if (VAR != 1) { const bf16x8 sfr = *(const LAS bf16x8*)(Sg + (vt >> 3) * 32768 + rfo[s] + (vt & 7) * 4096); acc[vt] = MFMA16(qf[s], sfr, acc[vt]); } }
            }
            float xs[4];
            { int ib = 16 * wid + 4 * g; OPAQUE(ib);
#pragma unroll
              for (int r = 0; r < 4; ++r) { const float lxf = lf2 * (float)(ib + r + 1), lxb = lb2 * (float)(128 - ib - r); xs[r] = __builtin_amdgcn_exp2f(dirn == 0 ? lxf - lxb : lxb - (STATE_FP8 ? 4.f : 0.f)); } }
#pragma unroll
            for (int vt = 0; vt < 16; ++vt)
#pragma unroll
                for (int r = 0; r < 4; ++r) acc[vt][r] *= xs[r];
        }
        __syncthreads();
        { int t2 = tid; OPAQUE(t2); const unsigned vd2 = (unsigned)((t2 & 31) >> 4) * 32768u + offb(t2 >> 5, t2 & 15);
#pragma unroll
          for (int j = 0; j < 8; ++j) *(LAS v4u*)(Sg + vd2 + j * 4096) = sreg[j]; }
        GAS bf16* gp = gr + (tok0 + 16 * wid + (lane >> 5)) * 1024 + h * 256 + (lane & 31) * 8;
#if MIX_FP8 & 4
        GAS unsigned char* ar8 = (GAS unsigned char*)(ws + WS_AR8) + (tok0 + 16 * wid + (lane >> 5)) * 1024 + h * 256 + (lane & 31) * 8;
#endif
        __syncthreads();
        unsigned vbs[8];
        { int l2 = lane; OPAQUE(l2); const unsigned g2 = l2 >> 4, q2 = (l2 & 15) >> 2, p2 = l2 & 3, X = (q2 << 2) | g2;
#pragma unroll
          for (int c = 0; c < 8; ++c) vbs[c] = 256 * (4 * g2 + q2) + 16 * (((2 * c) ^ (X & 14)) | ((p2 >> 1) ^ (X & 1))) + 8 * (p2 & 1); }
#pragma unroll
        for (int vt = 0; vt < 16; ++vt) {
#pragma unroll
            for (int ks = 0; ks < 4; ++ks) { if (VAR != 1) {
                const s16x4 lo = ldtr(Sg + vbs[vt & 7] + (vt >> 3) * 32768 + ks * 8192), hi = ldtr(Sg + vbs[vt & 7] + (vt >> 3) * 32768 + ks * 8192 + 4096);
                acc[vt] = MFMA16(pf[ks], cat8(lo, hi), acc[vt]); }
            }
            asm volatile("" ::: "memory");
        }
        float mu[4], rs[4];
#pragma unroll
        for (int r = 0; r < 4; ++r) {
            float s = 0.f;
#pragma unroll
            for (int vt = 0; vt < 16; ++vt) s += acc[vt][r];
            s += __shfl_xor(s, 1); s += __shfl_xor(s, 2); s += __shfl_xor(s, 4); s += __shfl_xor(s, 8);
            const float m = s * (1.f / 256.f); float qv = 0.f;
#pragma unroll
            for (int vt = 0; vt < 16; ++vt) { const float d = acc[vt][r] - m; qv += d * d; }
            qv += __shfl_xor(qv, 1); qv += __shfl_xor(qv, 2); qv += __shfl_xor(qv, 4); qv += __shfl_xor(qv, 8);
            mu[r] = m; rs[r] = 1.f / sqrtf(qv * (1.f / 256.f) + LN_EPSF);
        }
        v4u greg[8];
#pragma unroll
        for (int j = 0; j < 8; ++j) greg[j] = *(const GAS v4u*)(gp + (size_t)j * 2048);
        __syncthreads();
        if (has_next) { size_t tk; const GAS bf16* sfn; int hn; item_ptrs(item + G, tk, sfn, hn); issue_state(sfn, 0); issue_q(item + G); }
        LAS bf16* st = (LAS bf16*)(Sg + wid * 8192);
        { LAS bf16* sp_ = st + (4 * g) * 256 + i16;
#pragma unroll
          for (int vt = 0; vt < 16; ++vt)
#pragma unroll
              for (int r = 0; r < 4; ++r) sp_[r * 256 + 16 * vt] = (bf16)(cvtpk((acc[vt][r] - mu[r]) * rs[r], 0.f) & 0xffffu); }
        asm volatile("s_waitcnt lgkmcnt(0)" ::: "memory");
        {
            const float* gn = a.in[4] + h * 256; const int ch = lane & 31;
            const f32x4 g0 = *(const f32x4*)(gn + ch * 8), g1 = *(const f32x4*)(gn + ch * 8 + 4);
            const LAS bf16* yp = st + (lane >> 5) * 256 + ch * 8;
#pragma unroll
            for (int j = 0; j < 8; ++j) {
                const v4u y = *(const LAS v4u*)(yp + j * 512); const v4u sg = greg[j];
#if SILU_IN_P3
#define GSW(w, hi) pg8::fsilu((hi) ? bfhi(w) : bflo(w))
#else
#define GSW(w, hi) ((hi) ? bfhi(w) : bflo(w))
#endif
                v4u o; o.x = cvtpk(bflo(y.x) * g0[0] * GSW(sg.x, 0), bfhi(y.x) * g0[1] * GSW(sg.x, 1)); o.y = cvtpk(bflo(y.y) * g0[2] * GSW(sg.y, 0), bfhi(y.y) * g0[3] * GSW(sg.y, 1));
                o.z = cvtpk(bflo(y.z) * g1[0] * GSW(sg.z, 0), bfhi(y.z) * g1[1] * GSW(sg.z, 1)); o.w = cvtpk(bflo(y.w) * g1[2] * GSW(sg.w, 0), bfhi(y.w) * g1[3] * GSW(sg.w, 1));
#undef GSW
#if MIX_FP8 & 4
                u32x2 o8; o8.x = pk_fp8x4(bflo(o.x), bfhi(o.x), bflo(o.y), bfhi(o.y)); o8.y = pk_fp8x4(bflo(o.z), bfhi(o.z), bflo(o.w), bfhi(o.w));
                *(GAS u32x2*)(ar8 + (size_t)j * 2048) = o8;
#else
                *(GAS v4u*)(gp + (size_t)j * 2048) = o;
#endif
            }
        }
        __syncthreads();
    }
}

constexpr int P6_RS = 81920, P6_CNT = P6_RS + 8 * 512, P6_BASE = P6_CNT + 64, P6_ROW = P6_BASE + 64;
#define P6_BUTTERFLY(lg, out) do { float r10[10], r5[5], r3[3], r2[2]; const float z = 0.f; \
    _Pragma("unroll") for (int k = 0; k < 10; ++k) { const float keep = h32 ? lg[10 + k] : lg[k], send = h32 ? lg[k] : lg[10 + k]; r10[k] = keep + __shfl_xor(send, 32); } \
    _Pragma("unroll") for (int k = 0; k < 5; ++k) { const float keep = h16 ? r10[5 + k] : r10[k], send = h16 ? r10[k] : r10[5 + k]; r5[k] = keep + __shfl_xor(send, 16); } \
    { const float keep = h8 ? r5[3] : r5[0], send = h8 ? r5[0] : r5[3]; r3[0] = keep + __shfl_xor(send, 8); } \
    { const float keep = h8 ? r5[4] : r5[1], send = h8 ? r5[1] : r5[4]; r3[1] = keep + __shfl_xor(send, 8); } \
    { const float keep = h8 ? z : r5[2], send = h8 ? r5[2] : z; r3[2] = keep + __shfl_xor(send, 8); } \
    { const float keep = h4 ? r3[2] : r3[0], send = h4 ? r3[0] : r3[2]; r2[0] = keep + __shfl_xor(send, 4); } \
    { const float keep = h4 ? z : r3[1], send = h4 ? r3[1] : z; r2[1] = keep + __shfl_xor(send, 4); } \
    { const float keep = h2 ? r2[1] : r2[0], send = h2 ? r2[0] : r2[1]; out = keep + __shfl_xor(send, 2); } \
    out += __shfl_xor(out, 1); } while (0)
__device__ __forceinline__ void p6a_phase(const Args& a, LAS unsigned char* lds, int vcu, int G, int tid, int wave, int lane) {
    unsigned char* ws = a.ws;
    LAS float* RW = (LAS float*)lds;
    LAS float* RS = (LAS float*)(lds + P6_RS) + wave * 128;
    LAS unsigned* LC = (LAS unsigned*)(lds + P6_CNT); LAS unsigned* LB = (LAS unsigned*)(lds + P6_BASE); LAS unsigned* LR = (LAS unsigned*)(lds + P6_ROW);
    {
        const f32x4* wgp = (const f32x4*)a.in[11]; const f32x4* wep = (const f32x4*)a.in[13];
        f32x4 gq[2], eq[8];
#pragma unroll
        for (int u = 0; u < 2; ++u) gq[u] = wgp[tid + 512 * u];
#pragma unroll
        for (int u = 0; u < 8; ++u) eq[u] = wep[tid + 512 * u];
#pragma unroll
        for (int u = 0; u < 2; ++u) { const int c = tid + 512 * u;
#pragma unroll
            for (int k = 0; k < 4; ++k) RW[k * 1024 + c] = gq[u][k]; }
#pragma unroll
        for (int u = 0; u < 8; ++u) { const int q = tid + 512 * u, c = q >> 2, k4 = q & 3;
#pragma unroll
            for (int k = 0; k < 4; ++k) RW[(4 + 4 * k4 + k) * 1024 + c] = eq[u][k]; }
    }
    const u32x2* pre = (const u32x2*)a.out; u32x2* x1b = (u32x2*)(ws + WS_XB); [[maybe_unused]] unsigned* x1f8 = (unsigned*)(ws + WS_X1F8);
    gu32* ctl = (gu32*)ws;
    int* ltok = (int*)(ws + WS_LTOK); float* tw = (float*)(ws + WS_WSLOT); unsigned* tinfo = (unsigned*)(ws + WS_TINFO);
    const float* g1 = a.in[9]; const float* b1 = a.in[10];
    const bool h32 = (lane & 32) != 0, h16 = (lane & 16) != 0, h8 = (lane & 8) != 0, h4 = (lane & 4) != 0, h2 = (lane & 2) != 0;
#define P6_LOADROW(dst, t_) do { const u32x2* xr_ = pre + (size_t)(t_) * 256 + lane; _Pragma("unroll") for (int j = 0; j < 4; ++j) dst[j] = xr_[64 * j]; } while (0)
#define P6_LN(v, nx, s) do { s = 0.f; _Pragma("unroll") for (int j = 0; j < 4; ++j) { v[j] = (f32x4){bflo(nx[j].x), bfhi(nx[j].x), bflo(nx[j].y), bfhi(nx[j].y)}; s += (v[j].x + v[j].y) + (v[j].z + v[j].w); } } while (0)
#define P6_VAR(v, mean, q) do { q = 0.f; _Pragma("unroll") for (int j = 0; j < 4; ++j) { v[j] = v[j] - mean; q += (v[j].x * v[j].x + v[j].y * v[j].y) + (v[j].z * v[j].z + v[j].w * v[j].w); } } while (0)
#if M1_FP8
#define P6_STORE(v, t_, j) do { u32x2 o_; o_.x = cvtpk(v[j].x, v[j].y); o_.y = cvtpk(v[j].z, v[j].w); x1b[(size_t)(t_) * 256 + lane + 64 * j] = o_; x1f8[(size_t)(t_) * 256 + lane + 64 * j] = pk_fp8x4(v[j].x, v[j].y, v[j].z, v[j].w); } while (0)
#else
#define P6_STORE(v, t_, j) do { u32x2 o_; o_.x = cvtpk(v[j].x, v[j].y); o_.y = cvtpk(v[j].z, v[j].w); x1b[(size_t)(t_) * 256 + lane + 64 * j] = o_; } while (0)
#endif
#define P6_DOT(lg, v, j, k, w) lg[k] += (v[j][0] * w[0] + v[j][1] * w[1]) + (v[j][2] * w[2] + v[j][3] * w[3])
    for (int blk = vcu; blk < TT / 128; blk += G) {
        if (tid < 16) LC[tid] = 0u;
        __syncthreads();
        const int t0 = blk * 128;
        u32x2 nxA[4], nxB[4], nxC[4], nxD[4];
        P6_LOADROW(nxA, t0 + wave); P6_LOADROW(nxB, t0 + wave + 8); P6_LOADROW(nxC, t0 + wave + 16); P6_LOADROW(nxD, t0 + wave + 24);
        for (int rr = 0; rr < 4; ++rr) {
            const int rl0 = wave + 32 * rr, tA = t0 + rl0, tB = tA + 8, tC = tA + 16, tD = tA + 24;
            f32x4 vA[4], vB[4], vC[4], vD[4]; float sA, sB, sC, sD;
            P6_LN(vA, nxA, sA); P6_LN(vB, nxB, sB); P6_LN(vC, nxC, sC); P6_LN(vD, nxD, sD);
            if (rr < 3) { P6_LOADROW(nxA, tA + 32); P6_LOADROW(nxB, tB + 32); P6_LOADROW(nxC, tC + 32); P6_LOADROW(nxD, tD + 32); }
            const float mA = wave_sum(sA) * (1.f / DM), mB = wave_sum(sB) * (1.f / DM), mC = wave_sum(sC) * (1.f / DM), mD = wave_sum(sD) * (1.f / DM);
            float qA, qB, qC, qD;
            P6_VAR(vA, mA, qA); P6_VAR(vB, mB, qB); P6_VAR(vC, mC, qC); P6_VAR(vD, mD, qD);
            const float rA = 1.f / sqrtf(wave_sum(qA) * (1.f / DM) + LN_EPSF), rB = 1.f / sqrtf(wave_sum(qB) * (1.f / DM) + LN_EPSF);
            const float rC = 1.f / sqrtf(wave_sum(qC) * (1.f / DM) + LN_EPSF), rD = 1.f / sqrtf(wave_sum(qD) * (1.f / DM) + LN_EPSF);
            typedef float f32x2p __attribute__((ext_vector_type(2)));
            f32x2p lgAB[20], lgCD[20];
#pragma unroll
            for (int k = 0; k < 20; ++k) { lgAB[k] = (f32x2p){0.f, 0.f}; lgCD[k] = (f32x2p){0.f, 0.f}; }
#pragma unroll
            for (int j = 0; j < 4; ++j) {
                const f32x4 gg = *(const f32x4*)(g1 + 4 * lane + 256 * j), bb = *(const f32x4*)(b1 + 4 * lane + 256 * j);
                vA[j] = vA[j] * rA * gg + bb; vB[j] = vB[j] * rB * gg + bb; vC[j] = vC[j] * rC * gg + bb; vD[j] = vD[j] * rD * gg + bb;
                P6_STORE(vA, tA, j); P6_STORE(vB, tB, j); P6_STORE(vC, tC, j); P6_STORE(vD, tD, j);
                f32x2p pab[4], pcd[4];
#pragma unroll
                for (int e = 0; e < 4; ++e) { pab[e] = (f32x2p){vA[j][e], vB[j][e]}; pcd[e] = (f32x2p){vC[j][e], vD[j][e]}; }
#pragma unroll
                for (int k = 0; k < 20; ++k) { const f32x4 w = *(const LAS f32x4*)(RW + k * 1024 + 4 * lane + 256 * j);
#pragma unroll
                    for (int e = 0; e < 4; ++e) { const f32x2p ww = (f32x2p){w[e], w[e]};
                        lgAB[k] = __builtin_elementwise_fma(pab[e], ww, lgAB[k]); lgCD[k] = __builtin_elementwise_fma(pcd[e], ww, lgCD[k]); } }
            }
            float lgA[20], lgB[20], lgC[20], lgD[20];
#pragma unroll
            for (int k = 0; k < 20; ++k) { lgA[k] = lgAB[k].x; lgB[k] = lgAB[k].y; lgC[k] = lgCD[k].x; lgD[k] = lgCD[k].y; }
            float r1A, r1B, r1C, r1D;
            P6_BUTTERFLY(lgA, r1A); P6_BUTTERFLY(lgB, r1B); P6_BUTTERFLY(lgC, r1C); P6_BUTTERFLY(lgD, r1D);
            {
                const int i3 = h2 ? (h4 ? -1 : 1) : (h4 ? 2 : 0);
                const int i5 = i3 < 0 ? -1 : (h8 ? (i3 == 2 ? -1 : i3 + 3) : i3);
                const int kk = i5 < 0 ? -1 : (h32 ? 10 : 0) + (h16 ? 5 : 0) + i5;
                if (kk >= 0 && (lane & 1) == 0) { RS[kk] = r1A; RS[32 + kk] = r1B; RS[64 + kk] = r1C; RS[96 + kk] = r1D; }
            }
            asm volatile("s_waitcnt lgkmcnt(0)" ::: "memory");
            {
                const int sel = lane & 3; const int rl = rl0 + 8 * sel;
                float tl[20];
#pragma unroll
                for (int k4 = 0; k4 < 5; ++k4) { const f32x4 w = *(const LAS f32x4*)(RS + sel * 32 + 4 * k4); tl[4 * k4] = w[0]; tl[4 * k4 + 1] = w[1]; tl[4 * k4 + 2] = w[2]; tl[4 * k4 + 3] = w[3]; }
                float gl[4];
#pragma unroll
                for (int k = 0; k < 4; ++k) gl[k] = tl[k] + a.in[12][k];
                int gi = 0; float gm = gl[0];
#pragma unroll
                for (int k = 1; k < 4; ++k) if (gl[k] > gm) { gm = gl[k]; gi = k; }
                float gs = 0.f;
#pragma unroll
                for (int k = 0; k < 4; ++k) gs += __expf(gl[k] - gm);
                const float gwt = 1.f / gs;
                float el[4];
#pragma unroll
                for (int k = 0; k < 4; ++k) { const float se = gi == 0 ? tl[4 + k] : (gi == 1 ? tl[8 + k] : (gi == 2 ? tl[12 + k] : tl[16 + k])); el[k] = se + a.in[14][4 * gi + k]; }
                int i1 = 0; float v1 = el[0];
#pragma unroll
                for (int k = 1; k < 4; ++k) if (el[k] > v1) { v1 = el[k]; i1 = k; }
                int i2 = (i1 + 1) & 3; float v2 = -3.0e38f;
#pragma unroll
                for (int k = 0; k < 4; ++k) if (k != i1 && el[k] > v2) { v2 = el[k]; i2 = k; }
                const float ex = __expf(v2 - v1), w1 = gwt / (1.f + ex), w2 = gwt * ex / (1.f + ex);
                if (lane < 4) {
                    const int e1 = 4 * gi + i1, e2 = 4 * gi + i2;
                    const unsigned p1 = __hip_atomic_fetch_add(LC + e1, 1u, __ATOMIC_RELAXED, __HIP_MEMORY_SCOPE_WORKGROUP);
                    const unsigned p2 = __hip_atomic_fetch_add(LC + e2, 1u, __ATOMIC_RELAXED, __HIP_MEMORY_SCOPE_WORKGROUP);
                    LR[rl * 4 + 0] = ((unsigned)e1 << 16) | p1; LR[rl * 4 + 1] = ((unsigned)e2 << 16) | p2; LR[rl * 4 + 2] = __float_as_uint(w1); LR[rl * 4 + 3] = __float_as_uint(w2);
                }
            }
            asm volatile("s_waitcnt lgkmcnt(0)" ::: "memory");
        }
        __syncthreads();
        if (tid < 16) LB[tid] = __hip_atomic_fetch_add(ctl + CW_CNT + 64 * tid, LC[tid], __ATOMIC_RELAXED, __HIP_MEMORY_SCOPE_AGENT);
        __syncthreads();
        if (tid < 256) {
            const int rl = tid >> 1, j = tid & 1; const unsigned rec = LR[rl * 4 + j]; const unsigned e = rec >> 16, pos = LB[e] + (rec & 0xffffu);
            ltok[e * TT + pos] = t0 + rl; tw[2 * (t0 + rl) + j] = __uint_as_float(LR[rl * 4 + 2 + j]); tinfo[2 * (t0 + rl) + j] = (e << 16) | pos;
        }
        __syncthreads();
    }
#undef P6_LOADROW
#undef P6_LN
#undef P6_VAR
#undef P6_STORE
#undef P6_DOT
}
__device__ __forceinline__ void build_tile_tables(const Args& a, LAS unsigned char* lds, int tid) {
    LAS int* ts = (LAS int*)(lds + LDS_TS_OFF); LAS int* te = (LAS int*)(lds + LDS_TE_OFF); LAS int* cn = (LAS int*)(lds + LDS_CNT_OFF);
    gu32* ctl = (gu32*)a.ws;
    if (tid == 0) { int acc = 0;
        for (int e = 0; e < 16; ++e) { ts[e] = acc; const int c = (int)__hip_atomic_load(ctl + CW_CNT + 64 * e, __ATOMIC_RELAXED, __HIP_MEMORY_SCOPE_AGENT); const int nt = (c + 255) >> 8; cn[e] = c;
            for (int k = 0; k < nt; ++k) te[acc + k] = e; acc += nt; }
        ts[16] = acc; }
    __syncthreads();
}
__device__ __forceinline__ void p9_phase(const Args& a, LAS unsigned char* lds, int vcu, int G, int wave, int lane) {
    unsigned char* ws = a.ws;
    const LAS int* ts = (const LAS int*)(lds + LDS_TS_OFF);
    const unsigned* tinfo = (const unsigned*)(ws + WS_TINFO); const u32x2* Y = (const u32x2*)(ws + WS_Y);
    const float* g2 = a.in[18]; const float* b2 = a.in[19];
    const int gw = vcu * NWAVES + wave, NGW = G * NWAVES;
#if Y_FP8
    const unsigned* Y8 = (const unsigned*)(ws + WS_Y); unsigned ny0[4], ny1[4]; u32x2 nxw[4]; float nw0 = 0.f, nw1 = 0.f;
#else
    u32x2 ny0[4], ny1[4], nxw[4]; float nw0 = 0.f, nw1 = 0.f;
#endif
    const float* tw = (const float*)(ws + WS_WSLOT);
    auto issue = [&](int t) {
        const unsigned i0 = tinfo[2 * t], i1 = tinfo[2 * t + 1];
        nw0 = tw[2 * t]; nw1 = tw[2 * t + 1];
        const size_t s0 = (size_t)ts[i0 >> 16] * 256 + (i0 & 0xffffu), s1 = (size_t)ts[i1 >> 16] * 256 + (i1 & 0xffffu);
        const u32x2* xb1 = (const u32x2*)(ws + WS_XB) + (size_t)t * 256 + lane;
#pragma unroll
#if Y_FP8
        for (int j = 0; j < 4; ++j) { ny0[j] = Y8[s0 * 256 + lane + 64 * j]; ny1[j] = Y8[s1 * 256 + lane + 64 * j]; nxw[j] = xb1[64 * j]; }
#else
        for (int j = 0; j < 4; ++j) { ny0[j] = Y[s0 * 256 + lane + 64 * j]; ny1[j] = Y[s1 * 256 + lane + 64 * j]; nxw[j] = xb1[64 * j]; }
#endif
    };
    if (gw < TT) issue(gw);
    for (int t = gw; t < TT; t += NGW) {
        f32x4* xr = (f32x4*)(a.out + (size_t)t * DM) + lane;
#if Y_FP8
        f32x4 v[4]; float s = 0.f; const float w0 = nw0 * 0.0625f, w1 = nw1 * 0.0625f;
#pragma unroll
        for (int j = 0; j < 4; ++j) {
            const unsigned y0 = ny0[j], y1 = ny1[j]; const u32x2 xw = nxw[j];
            typedef float f32x2_ __attribute__((ext_vector_type(2)));
            const f32x2_ a0 = __builtin_amdgcn_cvt_pk_f32_fp8(y0, false), a1 = __builtin_amdgcn_cvt_pk_f32_fp8(y0, true), c0 = __builtin_amdgcn_cvt_pk_f32_fp8(y1, false), c1 = __builtin_amdgcn_cvt_pk_f32_fp8(y1, true);
            f32x4 x = (f32x4){bflo(xw.x), bfhi(xw.x), bflo(xw.y), bfhi(xw.y)} * DN_ALPHA;
            x.x += w0 * a0[0] + w1 * c0[0]; x.y += w0 * a0[1] + w1 * c0[1]; x.z += w0 * a1[0] + w1 * c1[0]; x.w += w0 * a1[1] + w1 * c1[1];
            v[j] = x; s += (x.x + x.y) + (x.z + x.w);
        }
#else
        f32x4 v[4]; float s = 0.f; const float w0 = nw0, w1 = nw1;
#pragma unroll
        for (int j = 0; j < 4; ++j) {
            const u32x2 y0 = ny0[j], y1 = ny1[j], xw = nxw[j];
            f32x4 x = (f32x4){bflo(xw.x), bfhi(xw.x), bflo(xw.y), bfhi(xw.y)} * DN_ALPHA;
            x.x += w0 * bflo(y0.x) + w1 * bflo(y1.x); x.y += w0 * bfhi(y0.x) + w1 * bfhi(y1.x); x.z += w0 * bflo(y0.y) + w1 * bflo(y1.y); x.w += w0 * bfhi(y0.y) + w1 * bfhi(y1.y);
            v[j] = x; s += (x.x + x.y) + (x.z + x.w);
        }
#endif
        if (t + NGW < TT) issue(t + NGW);
        const float mean = wave_sum(s) * (1.f / DM); float s2 = 0.f;
#pragma unroll
        for (int j = 0; j < 4; ++j) { v[j] = v[j] - mean; s2 += (v[j].x * v[j].x + v[j].y * v[j].y) + (v[j].z * v[j].z + v[j].w * v[j].w); }
        const float rstd = 1.f / sqrtf(wave_sum(s2) * (1.f / DM) + LN_EPSF);
#pragma unroll
        for (int j = 0; j < 4; ++j) { const f32x4 gg = *(const f32x4*)(g2 + 4 * lane + 256 * j), bb = *(const f32x4*)(b2 + 4 * lane + 256 * j); xr[64 * j] = v[j] * rstd * gg + bb; }
    }
}

__global__ void __launch_bounds__(NWAVES * 64, 2) mega_fwd(Args args) {
    extern __shared__ __attribute__((aligned(16))) unsigned char lds_raw[];
    LAS unsigned char* lds = (LAS unsigned char*)lds_raw;
    volatile LAS unsigned* MISC = (volatile LAS unsigned*)(lds + MISC_OFF);
    const int tid0 = threadIdx.x, wave = __builtin_amdgcn_readfirstlane(tid0 >> 6);
    const int G = gridDim.x, bx = blockIdx.x, vcu = (G % 8 == 0) ? (bx % 8) * (G / 8) + bx / 8 : bx;
    for (int u = tid0; u < (LDS_BYTES - LDSCTL_OFF) / 4; u += NWAVES * 64) ((LAS unsigned*)(lds + LDSCTL_OFF))[u] = 0u;
    __syncthreads();
    unsigned char* ws = args.ws;
    gu32* ctl = (gu32*)ws;
    const bool bars_on = (args.mask >> 31) != 0u;
    XcdBarrier bar; bar.bar = (unsigned*)(ctl + CW_BAR) + args.bar_region * XCD_BAR_WORDS; bar.x = 0; bar.st = nullptr;
    if (bars_on) bar = xcd_barrier_post((unsigned*)(ctl + CW_BAR) + args.bar_region * XCD_BAR_WORDS, MISC + 8);
    bar.wv = wave;
#define GRID_BAR() do { if (bars_on) xcd_barrier(bar); } while (0)
#ifndef PH_LAST
#define PH_LAST 99
#endif
#define FRESH() int tid = wave * 64 + pg8::lane_id(); asm volatile("" : "+v"(tid)); const int lane = tid & 63; (void)lane
#ifndef RMASK
#define RMASK 0
#endif
#define REP(k) _Pragma("unroll") for (int rep_ = 0; rep_ < 1 + ((RMASK >> (k)) & 1); ++rep_)
#ifndef STAMP_SCALE
#define STAMP_SCALE 1.0f
#endif
#ifdef STAMP_PH
#define ST_B(k) if ((k) == STAMP_PH) { st_a = rt(); }
#define ST_E(k) if ((k) == STAMP_PH) { st_b = rt(); }
#else
#define ST_B(k)
#define ST_E(k)
#endif
#ifdef ONLY
#define EN(k) (ONLY == (k))
#else
#define EN(k) ((args.mask >> (k)) & 1u)
#endif
    unsigned long long st_a = 0, st_b = 0; (void)st_a; (void)st_b;
    REP(0) if (EN(0)) { FRESH(); p0_prologue(args, lds, vcu, G, tid, wave, lane); }
    GRID_BAR();
#ifdef STAGGER_TICKS
    if (EN(1) && (bx & 8)) { const unsigned long long t0_ = rt(); while (rt() - t0_ < STAGGER_TICKS) __builtin_amdgcn_s_sleep(32); }
#endif
    REP(1) if (EN(1)) {
#if P1_FP8
        pg8::EpiHcat E{ws, (const float*)(ws + WS_ROT), 0};
        if (P1_FP8_FROM > 0) {
            pg8::Gemm g{(const pg8::bf16_t*)(ws + WS_XB), (const pg8::bf16_t*)(ws + WS_WIN), TT, 4608, 1024}; pg8::StaticOrder S; S.init(TT, 256 * P1_FP8_FROM, G, bx);
            pg8::gemm_phase<pg8::EpiHcat, pg8::StaticOrder, true, true>(lds, g, S, E, wave);
        }
        {
#if GATE_FP8
            pg8::Gemm g{(const pg8::bf16_t*)(ws + WS_X8_LO), (const pg8::bf16_t*)(ws + WS_WIN8), TT, 4608, 512, 64, (long)WS_X8_HI - (long)WS_X8_LO - (long)(16 * MiB)}; pg8::StaticOrder S;
#else
            pg8::Gemm g{(const pg8::bf16_t*)args.out, (const pg8::bf16_t*)(ws + WS_WIN8), TT, 4608, 512}; pg8::StaticOrder S;
#endif
            S.init(TT, 4608 - 256 * P1_FP8_FROM, G, bx, P1_FP8_FROM);
#if CONV_BG
            pg8::P1Order SB; SB.S = S; SB.cv = pg8::ExpertConv{args.in[15], args.in[16], args.in[17], ws + WS_WGU, ws + WS_WD, vcu * NWAVES + wave, G * NWAVES, vcu % 9};
            pg8::gemm_phase<pg8::EpiHcat, pg8::P1Order, true, true, false, true, 1, 0>(lds, g, SB, E, wave);
            { FRESH();
              for (int k = 0; SB.cv.gw + k * SB.cv.nw < 6144; ++k) { pg8::Unit tu; const bool in_gap = k < 3 && S.next(pg8::P1Order::unit_of(SB.cv.grp, k), tu) && pg8::P1Order::unit_of(SB.cv.grp, k) < 9;
                  if (!in_gap) pg8::expert_conv_item(SB.cv, k, lane); } }
#else
            pg8::gemm_phase<pg8::EpiHcat, pg8::StaticOrder, true, true, false, true, 1, 0>(lds, g, S, E, wave);
#endif
        }
#else
        pg8::Gemm g{(const pg8::bf16_t*)(ws + WS_XB), (const pg8::bf16_t*)(ws + WS_WIN), TT, 4608, 1024}; pg8::StaticOrder S; S.init(TT, 4608, G, bx);
        pg8::EpiHcat E{ws, (const float*)(ws + WS_ROT), 0};
        pg8::gemm_phase<pg8::EpiHcat, pg8::StaticOrder, true, true>(lds, g, S, E, wave);
#endif
    }
    GRID_BAR();
    if (PH_LAST >= 2) {
        REP(2) if (EN(2)) { FRESH(); for (int it = vcu; it < 256; it += G) chain_item(args, lds, it, tid, wave, lane); }
        if (EN(3)) { { FRESH(); attn_dil_phase<16>(args, lds, vcu, G, tid, wave, lane); }
                     { FRESH(); attn_dil_phase<4>(args, lds, vcu, G, tid, wave, lane); } }
    }
    GRID_BAR();
    ST_B(4) if (PH_LAST >= 3 && EN(4)) { FRESH(); p3_phase<0>(args, lds, vcu, G, tid, wave, lane); }
    if (EN(13)) { FRESH(); attn_p1_phase(args, lds, vcu, G, tid, wave, lane); }
    GRID_BAR(); ST_E(4)
#if !CONV_BG
    if (EN(14)) { FRESH(); p0_expert_weights(args, lds, vcu, G, wave, lane); }
#endif
    REP(5) if (PH_LAST >= 4 && EN(5)) {
        pg8::GateOrder S; S.S4.init(TT, 1024, G, bx);
        pg8::EpiHcat E{ws, (const float*)(ws + WS_ROT), 18};
#if GATE_FP8
        pg8::Gemm g{(const pg8::bf16_t*)(ws + WS_X8_LO), (const pg8::bf16_t*)(ws + WS_WIN8 + (size_t)4608 * 1024), TT, 2048, 512, 64, (long)WS_X8_HI - (long)WS_X8_LO - (long)(16 * MiB)};
        pg8::gemm_phase<pg8::EpiHcat, pg8::GateOrder, true, true, false, true, 1, 0>(lds, g, S, E, wave);
#else
        pg8::Gemm g{(const pg8::bf16_t*)(ws + WS_XB), (const pg8::bf16_t*)(ws + WS_WIN) + (size_t)4608 * 1024, TT, 2048, 1024};
        pg8::gemm_phase<pg8::EpiHcat, pg8::GateOrder, true, true>(lds, g, S, E, wave);
#endif
        asm volatile("s_waitcnt vmcnt(0)" ::: "memory"); __syncthreads();
    }
    REP(6) if (PH_LAST >= 5 && EN(6)) {
        pg8::StaticOrder S; S.init(TT, 1024, G, bx);
        { pg8::EpiGate<false> E{(const pg8::bf16_t*)(ws + WS_GATE_A), (pg8::bf16_t*)(ws + WS_MERGED), nullptr};
#if MIX_FP8 & 2
          pg8::Gemm g{(const pg8::bf16_t*)(ws + WS_OA), (const pg8::bf16_t*)(ws + WS_WA), TT, 1024, 256};
          pg8::gemm_phase<pg8::EpiGate<false>, pg8::StaticOrder, true, true, false, true, 1, 3>(lds, g, S, E, wave);
#else
          pg8::Gemm g{(const pg8::bf16_t*)(ws + WS_OA), (const pg8::bf16_t*)(ws + WS_WA), TT, 1024, 512};
          pg8::gemm_phase<pg8::EpiGate<false>, pg8::StaticOrder, true, true>(lds, g, S, E, wave);
#endif
        }
        asm volatile("s_waitcnt vmcnt(0)" ::: "memory"); __syncthreads();
        { typedef pg8::EpiGate<true, (MIX_FP8 & 1) != 0> EpiC;
          EpiC E{(const pg8::bf16_t*)(ws + WS_GATE_R), (pg8::bf16_t*)(ws + WS_MERGED), ws + WS_MERGED8};
#if MIX_FP8 & 4
          pg8::Gemm g{(const pg8::bf16_t*)(ws + WS_AR8), (const pg8::bf16_t*)(ws + WS_WR), TT, 1024, 512};
          pg8::gemm_phase<EpiC, pg8::StaticOrder, true, true, false, true, 1, 0>(lds, g, S, E, wave);
#else
          pg8::Gemm g{(const pg8::bf16_t*)(ws + WS_GR), (const pg8::bf16_t*)(ws + WS_WR), TT, 1024, 1024};
          pg8::gemm_phase<EpiC, pg8::StaticOrder, true, true>(lds, g, S, E, wave);
#endif
        }
    }
    GRID_BAR();
    REP(7) if (PH_LAST >= 6 && EN(7)) {
        pg8::StaticOrder S; S.init(TT, 1024, G, bx);
        pg8::EpiResBf16 E{X_F32_RES ? (const pg8::bf16_t*)args.in[0] : (const pg8::bf16_t*)(ws + WS_XB), (pg8::bf16_t*)args.out, DN_ALPHA};
#if MIX_FP8 & 1
        pg8::Gemm g{(const pg8::bf16_t*)(ws + WS_MERGED8), (const pg8::bf16_t*)(ws + WS_WO), TT, 1024, 512};
        pg8::gemm_phase<pg8::EpiResBf16, pg8::StaticOrder, true, true, false, true, 1, 3>(lds, g, S, E, wave);
#else
        pg8::Gemm g{(const pg8::bf16_t*)(ws + WS_MERGED), (const pg8::bf16_t*)(ws + WS_WO), TT, 1024, 1024};
        pg8::gemm_phase<pg8::EpiResBf16, pg8::StaticOrder, true, true>(lds, g, S, E, wave);
#endif
    }
    GRID_BAR();
    ST_B(8) if (PH_LAST >= 7 && EN(8)) { FRESH(); p6a_phase(args, lds, vcu, G, tid, wave, lane); }
    GRID_BAR(); ST_E(8)
    { FRESH(); build_tile_tables(args, lds, tid); }
    const int nrt = ((const LAS int*)(lds + LDS_TS_OFF))[16];
    REP(10) if (PH_LAST >= 9 && EN(10)) {
#if M1_FP8
        pg8::Gemm g{(const pg8::bf16_t*)(ws + WS_X1F8), (const pg8::bf16_t*)(ws + WS_WGU), MAXSLOT, 1024, 512};
        pg8::MoeOrder S{nrt * 4, G, vcu, (const LAS int*)(lds + LDS_TE_OFF), (const LAS int*)(lds + LDS_TS_OFF), (const LAS int*)(lds + LDS_CNT_OFF), (const int*)(ws + WS_LTOK), 1024u};
        pg8::EpiSwiGLU E{ws + WS_H};
        pg8::gemm_phase<pg8::EpiSwiGLU, pg8::MoeOrder, true, true, true, true, 1, 0>(lds, g, S, E, wave);
#else
        pg8::Gemm g{(const pg8::bf16_t*)(ws + WS_XB), (const pg8::bf16_t*)(ws + WS_WGU), MAXSLOT, 1024, 1024};
        pg8::MoeOrder S{nrt * 4, G, vcu, (const LAS int*)(lds + LDS_TE_OFF), (const LAS int*)(lds + LDS_TS_OFF), (const LAS int*)(lds + LDS_CNT_OFF), (const int*)(ws + WS_LTOK), 2048u};
        pg8::EpiSwiGLU E{ws + WS_H};
        pg8::gemm_phase<pg8::EpiSwiGLU, pg8::MoeOrder, true, true, true>(lds, g, S, E, wave);
#endif
    }
    GRID_BAR();
    REP(11) if (PH_LAST >= 10 && EN(11)) {
        pg8::Gemm g{(const pg8::bf16_t*)(ws + WS_H), (const pg8::bf16_t*)(ws + WS_WD), MAXSLOT, 1024, 256};
        pg8::MoeOrder S{nrt * 4, G, vcu, (const LAS int*)(lds + LDS_TE_OFF), (const LAS int*)(lds + LDS_TS_OFF), (const LAS int*)(lds + LDS_CNT_OFF), (const int*)(ws + WS_LTOK), 1024u};
        pg8::EpiRowScale E{(pg8::bf16_t*)(ws + WS_Y)};
        pg8::gemm_phase<pg8::EpiRowScale, pg8::MoeOrder, true, true, false, true, 1, 2>(lds, g, S, E, wave);
    }
    GRID_BAR();
    ST_B(12) if (PH_LAST >= 11 && EN(12)) { FRESH(); p9_phase(args, lds, vcu, G, wave, lane); }
#ifdef STAMP_PH
    GRID_BAR(); ST_E(12)
    if (STAMP_PH == 13) { st_a = rt(); GRID_BAR(); GRID_BAR(); GRID_BAR(); GRID_BAR(); st_b = rt(); }
    if (bx == 0 && tid0 == 0) { const float us = (float)(st_b - st_a) * 0.01f * STAMP_SCALE; int k = 0; float lim = 30.f; while (us >= lim && k < 12) { lim *= 1.5f; ++k; }
        __hip_atomic_store(ctl + CW_CHK, __float_as_uint(sqrtf(2.f * k + 2.f)), RLX_AGENT); }
    GRID_BAR();
    { const float c = __uint_as_float(__hip_atomic_load(ctl + CW_CHK, RLX_AGENT)); f32x4* o4 = (f32x4*)args.out;
      for (size_t i = (size_t)bx * 512 + tid0; i < (size_t)TT * DM / 4; i += (size_t)G * 512) o4[i] = (f32x4){c, c, c, c}; }
#endif
}

#ifdef PROBE_VAR
__global__ void __launch_bounds__(NWAVES * 64, 2) probe_kernel(Args args) {
    extern __shared__ __attribute__((aligned(16))) unsigned char lds_raw[];
    LAS unsigned char* lds = (LAS unsigned char*)lds_raw;
    const int tid0 = threadIdx.x, wave = __builtin_amdgcn_readfirstlane(tid0 >> 6);
    const int G = gridDim.x, bx = blockIdx.x, vcu = (G % 8 == 0) ? (bx % 8) * (G / 8) + bx / 8 : bx;
    FRESH();
    if (PROBE_VAR >= 20 && PROBE_VAR <= 22) {
        unsigned char* ws = args.ws;
        pg8::Gemm g{(const pg8::bf16_t*)(ws + WS_X8_LO), (const pg8::bf16_t*)(ws + WS_WIN8), TT, 4608, 512, 64, (long)WS_X8_HI - (long)WS_X8_LO - (long)(16 * MiB)}; pg8::StaticOrder S; S.init(TT, 4608, G, bx);
        typedef pg8::EpiHcatT<PROBE_VAR - 20> EpiP;
        EpiP E{ws, (const float*)(ws + WS_ROT), 0};
        pg8::gemm_phase<EpiP, pg8::StaticOrder, true, true, false, true, 1, 0>(lds, g, S, E, wave);
    }
    if (PROBE_VAR == 10) p3_phase<0>(args, lds, vcu, G, tid, wave, lane);
    if (PROBE_VAR == 11) p3_phase<1>(args, lds, vcu, G, tid, wave, lane);
    if (PROBE_VAR == 0) attn_dil_phase<16, 0>(args, lds, vcu, G, tid, wave, lane);
    if (PROBE_VAR == 1) attn_dil_phase<16, 1>(args, lds, vcu, G, tid, wave, lane);
    if (PROBE_VAR == 2) attn_dil_phase<4, 0>(args, lds, vcu, G, tid, wave, lane);
    if (PROBE_VAR == 3) attn_dil_phase<4, 1>(args, lds, vcu, G, tid, wave, lane);
}
#endif
extern "C" void kernel_launch(void* const* d_in, const int* in_sizes, int n_in, void* d_out, int out_size, void* d_ws, size_t ws_size, hipStream_t stream) {
    static int grid = 0;
    if (grid == 0) {
        if (n_in != 20 || in_sizes[0] != TT * DM || out_size != TT * DM || ws_size < WS_END) { fprintf(stderr, "kernel_launch: unexpected shapes: n_in %d in0 %d out %d ws %zu; nothing launched\n", n_in, n_in > 0 ? in_sizes[0] : -1, out_size, ws_size); grid = -1; return; }
        int dev = 0, cus = 0;
        if (hipGetDevice(&dev) != hipSuccess || hipDeviceGetAttribute(&cus, hipDeviceAttributeMultiprocessorCount, dev) != hipSuccess) { grid = -1; return; }
        if (hipFuncSetAttribute((const void*)mega_fwd, hipFuncAttributeMaxDynamicSharedMemorySize, LDS_BYTES) != hipSuccess) { fprintf(stderr, "kernel_launch: hipFuncSetAttribute failed\n"); grid = -1; return; }
        (void)hipGetLastError();
        grid = cus;
    }
    if (grid < 0) return;
    if (hipMemsetAsync((char*)d_ws, 0, CTL_ZERO_BYTES, stream) != hipSuccess) return;
    Args a{};
    for (int i = 0; i < 20; ++i) a.in[i] = (const float*)d_in[i];
    a.out = (float*)d_out; a.ws = (unsigned char*)d_ws; a.mask = 0x80007fffu; a.bar_region = 0;
#if defined(XTRA_FIRST)
    { Args x = a; x.mask = XTRA_FIRST; x.bar_region = 1; for (int r = 0; r < XTRA_REP; ++r) hipLaunchKernelGGL(mega_fwd, dim3(grid), dim3(NWAVES * 64), LDS_BYTES, stream, x);
      if (hipMemsetAsync((char*)d_ws, 0, CTL_ZERO_BYTES, stream) != hipSuccess) return; }
#endif
    hipLaunchKernelGGL(mega_fwd, dim3(grid), dim3(NWAVES * 64), LDS_BYTES, stream, a);
#if defined(PROBE_VAR)
    { hipFuncSetAttribute((const void*)probe_kernel, hipFuncAttributeMaxDynamicSharedMemorySize, LDS_BYTES);
      for (int r = 0; r < 4; ++r) hipLaunchKernelGGL(probe_kernel, dim3(grid), dim3(NWAVES * 64), LDS_BYTES, stream, a); }
#endif
#if defined(XTRA_AFTER)
    { Args x = a; x.mask = XTRA_AFTER; x.bar_region = 1; for (int r = 0; r < XTRA_REP; ++r) hipLaunchKernelGGL(mega_fwd, dim3(grid), dim3(NWAVES * 64), LDS_BYTES, stream, x); }
#endif
}
```

```cpp
#include <hip/hip_runtime.h>
#include <cstdio>
#include <cstdint>

constexpr int TT = 32768, DM = 1024, SEQ = 2048, NB = 16;
constexpr float DN_ALPHA = 1.189207115002721f;
constexpr float LN_EPSF = 1e-5f;
#ifndef M1_FP8
#define M1_FP8 1
#endif
#ifndef P1_FP8
#define P1_FP8 1
#endif
#ifndef EPI_EARLY
#define EPI_EARLY 1
#endif
#ifndef PART_FP8
#define PART_FP8 1
#endif
#ifndef GATE_U8
#define GATE_U8 1
#endif
#ifndef ATT_FP8
#define ATT_FP8 1
#endif
#ifndef O23_FP8
#define O23_FP8 1
#endif
#ifndef STATE_FP8
#define STATE_FP8 1
#endif
#ifndef SILU_IN_P3
#define SILU_IN_P3 1
#endif
#ifndef CONV_BG
#define CONV_BG 1
#endif
#ifndef Y_FP8
#define Y_FP8 1
#endif
#ifndef GATE_FP8
#define GATE_FP8 1
#endif
#ifndef MIX_FP8
#define MIX_FP8 7
#endif
#ifndef P1_FP8_FROM
#define P1_FP8_FROM 0
#endif
#define X_F32_RES (P1_FP8 && P1_FP8_FROM == 0 && GATE_FP8)
constexpr size_t MiB = 1u << 20;
constexpr size_t CTL_ZERO_BYTES = 1 * MiB;
constexpr size_t WS_ROT = 1 * MiB;
constexpr size_t WS_BIAS = 2 * MiB;
constexpr size_t WS_LTOK = 3 * MiB;
constexpr size_t WS_TINFO = 7 * MiB;
constexpr size_t WS_WSLOT = 7 * MiB + 512 * 1024;
constexpr size_t WS_WIN = 8 * MiB;
constexpr size_t WS_WIN8 = 12 * MiB;
constexpr size_t WS_WR = 21 * MiB;
constexpr size_t WS_WA = 23 * MiB;
constexpr size_t WS_WO = 24 * MiB;
constexpr size_t WS_WGU = 26 * MiB;
constexpr size_t WS_WD = 42 * MiB;
constexpr size_t WS_XB = 80 * MiB;
constexpr size_t WS_QR = 144 * MiB;
constexpr size_t WS_KR = 176 * MiB;
constexpr size_t WS_VR = 208 * MiB;
constexpr size_t WS_GR = 272 * MiB;
constexpr size_t WS_QA = 336 * MiB, WS_KA = 368 * MiB, WS_VA = 400 * MiB, WS_OA = 432 * MiB;
#if MIX_FP8 & 4
constexpr size_t WS_AR8 = 144 * MiB;
constexpr size_t WS_GATE_R = 176 * MiB, WS_GATE_A = 240 * MiB;
#else
constexpr size_t WS_GATE_R = 144 * MiB, WS_GATE_A = 208 * MiB;
#endif
constexpr size_t WS_X8_LO = 448 * MiB, WS_X8_HI = 58 * MiB;
static_assert(!PART_FP8 || (MIX_FP8 & 1), "PART_FP8: the bf16 output path of P4c would read its own fp8 partial buffer format");
static_assert(M1_FP8, "the workspace map is laid out for fp8 expert weights");
static_assert(!CONV_BG || X_F32_RES, "CONV_BG puts o2 into the bf16 x region");
static_assert(!GATE_FP8 || (P1_FP8 && (MIX_FP8 & 2) && M1_FP8), "GATE_FP8 needs the fp8 mixer-input GEMM, the fp8 o_a (room behind it) and the fp8 expert weights (room behind them)");
constexpr size_t WS_MERGED8 = 464 * MiB;
constexpr size_t WS_MERGED = 336 * MiB;
constexpr size_t WS_Y = 144 * MiB;
constexpr size_t WS_H = 336 * MiB;
constexpr size_t WS_X1F8 = 400 * MiB;
#if CONV_BG
constexpr size_t WS_O2 = 80 * MiB;
#else
constexpr size_t WS_O2 = 26 * MiB;
#endif
constexpr size_t WS_O3 = 464 * MiB;
constexpr size_t WS_LSE2 = 496 * MiB, WS_LSE3 = 497 * MiB;
constexpr size_t WS_END = 512 * MiB;
constexpr int MAXSLOT = 69632;
constexpr int CW_BAR = 4096;
constexpr int CW_CNT = 16384;
constexpr int CW_CHK = 24576;
namespace pg8 {
#define PG8_LAS __attribute__((address_space(3)))
typedef unsigned short bf16_t;
typedef short bf16x8 __attribute__((ext_vector_type(8)));
typedef float f32x4 __attribute__((ext_vector_type(4)));
typedef unsigned u32x4 __attribute__((ext_vector_type(4)));
typedef unsigned u32x2_ __attribute__((ext_vector_type(2)));
constexpr int BM = 256, BK = 64, HALF = 128, HTB = HALF * BK * 2  , STAGE_BYTES = 8 * HTB, NXCD = 8, WGM = 8;

__device__ __forceinline__ int lane_id() { int x; asm volatile("v_mbcnt_lo_u32_b32 %0, -1, 0\n\tv_mbcnt_hi_u32_b32 %0, -1, %0" : "=v"(x)); return x; }
__host__ __device__ __forceinline__ int lds_byte(int r, int c) { const int st = (r >> 4) * 2 + (c >> 5), rr = r & 15, cc = c & 31, ob = rr * 64 + cc * 2; return st * 1024 + (ob ^ (((ob >> 9) & 1) << 5)); }
__host__ __device__ __forceinline__ void stage_rc(int b, int& R, int& C) { const int st = b / 1024, sb = b % 1024, swz = sb ^ (((sb >> 9) & 1) << 5); R = (st >> 1) * 16 + swz / 64; C = (st & 1) * 32 + (swz % 64) / 2; }
__host__ __device__ __forceinline__ int perm32(int rho) { const int n = rho >> 4, i = rho & 15; return 8 * (i >> 2) + 4 * n + (i & 3); }

struct Unit { int pm, pn; };
struct Gemm { const bf16_t* A; const bf16_t* Bt; int M, N, K; int spm = 1 << 30; long sdelta = 0; };

struct StaticOrder {
    int nM, nN, nwg, G, c, pn0;
    __host__ __device__ void init(int M, int N, int G_, int c_, int pn0_ = 0) { nM = M / BM; nN = N / BM; nwg = nM * nN; G = G_; c = c_; pn0 = pn0_; }
    __host__ __device__ bool next(int i, Unit& u) const {
        const long L = (long)i * G + c; if (L >= nwg) return false;
        int wgid = (int)L; { const int q = nwg / NXCD, r = nwg % NXCD, xcd = wgid % NXCD, off = wgid / NXCD; wgid = (xcd < r ? xcd * (q + 1) : r * (q + 1) + (xcd - r) * q) + off; }
        const int nig = WGM * nN, gid = wgid / nig, fm = gid * WGM, gsz = (nM - fm) < WGM ? (nM - fm) : WGM;
        u.pm = fm + ((wgid % nig) % gsz); u.pn = pn0 + (wgid % nig) / gsz; return true;
    }
    __device__ __forceinline__ void a_ready(const Unit&) const {}
    __device__ __forceinline__ void done(const Unit&, int, int) const {}
};

__device__ __forceinline__ unsigned cvt_pk_bf16(float lo, float hi) { unsigned r; asm volatile("v_cvt_pk_bf16_f32 %0, %1, %2" : "=v"(r) : "v"(lo), "v"(hi)); return r; }
typedef float cvt_f32x2_t __attribute__((ext_vector_type(2))); typedef __bf16 cvt_bf16x2_t __attribute__((ext_vector_type(2)));
__device__ __forceinline__ unsigned cvt_pk_bf16_acc(float lo, float hi) { const cvt_f32x2_t v = {lo, hi}; const cvt_bf16x2_t b = __builtin_convertvector(v, cvt_bf16x2_t); return __builtin_bit_cast(unsigned, b); }
__device__ __forceinline__ float bflo(unsigned w) { return __uint_as_float(w << 16); }
__device__ __forceinline__ float bfhi(unsigned w) { return __uint_as_float(w & 0xffff0000u); }
__device__ __forceinline__ float fsigmoid(float x) { return __builtin_amdgcn_rcpf(1.f + __expf(-x)); }
__device__ __forceinline__ float fsilu(float x) { return x * __builtin_amdgcn_rcpf(1.f + __expf(-x)); }

__device__ __forceinline__ unsigned fp8x4_sat(float a, float b, float c, float d) {
    a = __builtin_amdgcn_fmed3f(a, -448.f, 448.f); b = __builtin_amdgcn_fmed3f(b, -448.f, 448.f); c = __builtin_amdgcn_fmed3f(c, -448.f, 448.f); d = __builtin_amdgcn_fmed3f(d, -448.f, 448.f);
    unsigned w = 0u; w = __builtin_amdgcn_cvt_pk_fp8_f32(a, b, w, false); w = __builtin_amdgcn_cvt_pk_fp8_f32(c, d, w, true); return w;
}
template <int VAR = 0> struct EpiHcatT {
    static constexpr bool PERM = true, AFTER_DRAIN = false; static constexpr int NSTORE = 16;
    unsigned char* ws; const float* rot; int tile_off;
    __device__ __forceinline__ void operator()(const f32x4 (&acc)[2][2][4][2], const Unit& u, int wr, int wc, int fr, int fq) const {
        if (VAR == 1) {
            float s = 0.f;
#pragma unroll
            for (int ai = 0; ai < 2; ++ai)
#pragma unroll
                for (int bj = 0; bj < 2; ++bj)
#pragma unroll
                    for (int m = 0; m < 4; ++m)
#pragma unroll
                        for (int n = 0; n < 2; ++n) s += (acc[ai][bj][m][n][0] + acc[ai][bj][m][n][1]) + (acc[ai][bj][m][n][2] + acc[ai][bj][m][n][3]);
            ((float*)(ws + WS_O3))[(size_t)(u.pm * 64 + u.pn) * 512 + wr * 256 + wc * 64 + fq * 16 + fr] = s; return;
        }
        const int gt = u.pn + tile_off;
        size_t base_off; int pitch, ct, mode; float sc = 1.f;
        if (gt < 2)       { base_off = WS_QR; pitch = 512;  ct = gt;      mode = 1; }
        else if (gt < 4)  { base_off = WS_KR; pitch = 512;  ct = gt - 2;  mode = 1; sc = 0.08838834764831845f; }
        else if (gt < 8)  { base_off = WS_VR; pitch = 1024; ct = gt - 4;  mode = 0; }
        else if (gt < 12) { base_off = WS_GR; pitch = 1024; ct = gt - 8;  mode = SILU_IN_P3 ? 0 : 2; }
        else if (gt < 14) { base_off = WS_QA; pitch = 512;  ct = gt - 12; mode = ATT_FP8 ? 4 : 0; sc = 0.18033688011112042f; }
        else if (gt < 16) { base_off = WS_KA; pitch = 512;  ct = gt - 14; mode = ATT_FP8 ? 4 : 0; }
        else if (gt < 18) { base_off = WS_VA; pitch = 512;  ct = gt - 16; mode = ATT_FP8 ? 4 : 0; }
        else if (gt < 22) { base_off = WS_GATE_R; pitch = 1024; ct = gt - 18; mode = 3; }
        else              { base_off = WS_GATE_A; pitch = 1024; ct = gt - 22; mode = 3; }
        bf16_t* O = (bf16_t*)(ws + base_off);
        const int row0 = u.pm * BM + wr * 64 + fr, col0 = ct * BM + wc * 32 + 8 * fq;
#if EPI_EARLY
        f32x4 csq[2][4], snq[2][4];
        if (mode == 1) {
#pragma unroll
            for (int ai = 0; ai < 2; ++ai)
#pragma unroll
                for (int m = 0; m < 4; ++m) { const int row = row0 + ai * HALF + m * 16; const f32x4* rt = (const f32x4*)(rot + ((size_t)(row & (SEQ - 1)) * 16 + (4 * wc + fq)) * 8); csq[ai][m] = rt[0]; snq[ai][m] = rt[1]; }
        }
#endif
#pragma unroll
        for (int ai = 0; ai < 2; ++ai)
#pragma unroll
            for (int m = 0; m < 4; ++m) {
                const int row = row0 + ai * HALF + m * 16;
                bf16_t* rowp = O + (size_t)(VAR == 2 ? (row & 255) : row) * pitch + col0;
                f32x4 cs = (f32x4){1.f, 1.f, 1.f, 1.f}, sn = (f32x4){0.f, 0.f, 0.f, 0.f};
#if EPI_EARLY
                if (mode == 1) { cs = csq[ai][m]; sn = snq[ai][m]; }
#else
                if (mode == 1) { const f32x4* rt = (const f32x4*)(rot + ((size_t)(row & (SEQ - 1)) * 16 + (4 * wc + fq)) * 8); cs = rt[0]; sn = rt[1]; }
#endif
#pragma unroll
                for (int bj = 0; bj < 2; ++bj) {
                    f32x4 v0 = acc[ai][bj][m][0], v1 = acc[ai][bj][m][1];
                    if (mode == 1) { const f32x4 a = v0 * cs - v1 * sn, b = v0 * sn + v1 * cs; v0 = a * sc; v1 = b * sc; }
                    else if (mode == 2) {
#pragma unroll
                        for (int e = 0; e < 4; ++e) { v0[e] = fsilu(v0[e]); v1[e] = fsilu(v1[e]); } }
                    else if (mode == 3) {
#pragma unroll
                        for (int e = 0; e < 4; ++e) { v0[e] = fsigmoid(v0[e]); v1[e] = fsigmoid(v1[e]); } }
                    else { v0 = v0 * sc; v1 = v1 * sc; }
                    if (mode == 4) { u32x2_ w8; w8.x = fp8x4_sat(v0[0], v0[1], v0[2], v0[3]); w8.y = fp8x4_sat(v1[0], v1[1], v1[2], v1[3]);
                        *(u32x2_*)((unsigned char*)O + (size_t)(VAR == 2 ? (row & 255) : row) * pitch + col0 + bj * HALF) = w8; }
                    else if (GATE_U8 && mode == 3) { u32x2_ w8; w8.x = 0u; w8.y = 0u;
#pragma unroll
                        for (int e4 = 0; e4 < 4; ++e4) { w8.x = __builtin_amdgcn_cvt_pk_u8_f32(v0[e4] * 255.f, e4, w8.x); w8.y = __builtin_amdgcn_cvt_pk_u8_f32(v1[e4] * 255.f, e4, w8.y); }
                        *(u32x2_*)((unsigned char*)O + (size_t)row * pitch + col0 + bj * HALF) = w8; }
                    else { u32x4 w; w.x = cvt_pk_bf16(v0[0], v0[1]); w.y = cvt_pk_bf16(v0[2], v0[3]); w.z = cvt_pk_bf16(v1[0], v1[1]); w.w = cvt_pk_bf16(v1[2], v1[3]);
                        *(u32x4*)(rowp + bj * HALF) = w; }
                }
            }
    }
};

typedef EpiHcatT<0> EpiHcat;

template <bool ADD, bool OUT8 = false> struct EpiGate {
    static constexpr bool PERM = true, AFTER_DRAIN = false; static constexpr int NSTORE = 16;
    const bf16_t* gate; bf16_t* O; unsigned char* O8;
    __device__ __forceinline__ void operator()(const f32x4 (&acc)[2][2][4][2], const Unit& u, int wr, int wc, int fr, int fq) const {
        const int row0 = u.pm * BM + wr * 64 + fr, col0 = u.pn * BM + wc * 32 + 8 * fq;
#if GATE_U8 && PART_FP8 && EPI_EARLY
        u32x2_ gq[2][4][2], oq[2][4][2];
#pragma unroll
        for (int ai = 0; ai < 2; ++ai)
#pragma unroll
            for (int m = 0; m < 4; ++m)
#pragma unroll
                for (int bj = 0; bj < 2; ++bj) { const size_t p = (size_t)(row0 + ai * HALF + m * 16) * 1024 + col0 + bj * HALF;
                    gq[ai][m][bj] = *(const u32x2_*)((const unsigned char*)gate + p); if (ADD) oq[ai][m][bj] = *(const u32x2_*)((const unsigned char*)O + p); }
#pragma unroll
        for (int ai = 0; ai < 2; ++ai)
#pragma unroll
            for (int m = 0; m < 4; ++m)
#pragma unroll
                for (int bj = 0; bj < 2; ++bj) {
                    const size_t p = (size_t)(row0 + ai * HALF + m * 16) * 1024 + col0 + bj * HALF;
                    f32x4 v0 = acc[ai][bj][m][0], v1 = acc[ai][bj][m][1];
                    { const u32x2_ g8 = gq[ai][m][bj]; constexpr float c255 = 1.f / 255.f;
#pragma unroll
                      for (int e4 = 0; e4 < 4; ++e4) { v0[e4] *= (float)((g8.x >> (8 * e4)) & 0xffu) * c255; v1[e4] *= (float)((g8.y >> (8 * e4)) & 0xffu) * c255; } }
                    if (ADD) { const u32x2_ o8 = oq[ai][m][bj]; typedef float f2_ __attribute__((ext_vector_type(2)));
                        const f2_ a0 = __builtin_amdgcn_cvt_pk_f32_fp8(o8.x, false), a1 = __builtin_amdgcn_cvt_pk_f32_fp8(o8.x, true), a2 = __builtin_amdgcn_cvt_pk_f32_fp8(o8.y, false), a3 = __builtin_amdgcn_cvt_pk_f32_fp8(o8.y, true);
                        v0[0] += a0[0] * 0.0625f; v0[1] += a0[1] * 0.0625f; v0[2] += a1[0] * 0.0625f; v0[3] += a1[1] * 0.0625f;
                        v1[0] += a2[0] * 0.0625f; v1[1] += a2[1] * 0.0625f; v1[2] += a3[0] * 0.0625f; v1[3] += a3[1] * 0.0625f; }
                    u32x2_ w8; w8.x = fp8x4_sat(v0[0] * 16.f, v0[1] * 16.f, v0[2] * 16.f, v0[3] * 16.f); w8.y = fp8x4_sat(v1[0] * 16.f, v1[1] * 16.f, v1[2] * 16.f, v1[3] * 16.f);
                    if (OUT8) *(u32x2_*)(O8 + p) = w8; else *(u32x2_*)((unsigned char*)O + p) = w8;
                }
        return;
#endif
#pragma unroll
        for (int ai = 0; ai < 2; ++ai)
#pragma unroll
            for (int m = 0; m < 4; ++m)
#pragma unroll
                for (int bj = 0; bj < 2; ++bj) {
                    const size_t p = (size_t)(row0 + ai * HALF + m * 16) * 1024 + col0 + bj * HALF;
                    f32x4 v0 = acc[ai][bj][m][0], v1 = acc[ai][bj][m][1];
#if GATE_U8
                    { const u32x2_ g8 = *(const u32x2_*)((const unsigned char*)gate + p); constexpr float c255 = 1.f / 255.f;
#pragma unroll
                      for (int e4 = 0; e4 < 4; ++e4) { v0[e4] *= (float)((g8.x >> (8 * e4)) & 0xffu) * c255; v1[e4] *= (float)((g8.y >> (8 * e4)) & 0xffu) * c255; } }
#else
                    const u32x4 g = *(const u32x4*)(gate + p);
                    v0[0] *= bflo(g.x); v0[1] *= bfhi(g.x); v0[2] *= bflo(g.y); v0[3] *= bfhi(g.y);
                    v1[0] *= bflo(g.z); v1[1] *= bfhi(g.z); v1[2] *= bflo(g.w); v1[3] *= bfhi(g.w);
#endif
#if PART_FP8
                    if (ADD) { const u32x2_ o8 = *(const u32x2_*)((const unsigned char*)O + p); typedef float f2_ __attribute__((ext_vector_type(2)));
                        const f2_ a0 = __builtin_amdgcn_cvt_pk_f32_fp8(o8.x, false), a1 = __builtin_amdgcn_cvt_pk_f32_fp8(o8.x, true), a2 = __builtin_amdgcn_cvt_pk_f32_fp8(o8.y, false), a3 = __builtin_amdgcn_cvt_pk_f32_fp8(o8.y, true);
                        v0[0] += a0[0] * 0.0625f; v0[1] += a0[1] * 0.0625f; v0[2] += a1[0] * 0.0625f; v0[3] += a1[1] * 0.0625f;
                        v1[0] += a2[0] * 0.0625f; v1[1] += a2[1] * 0.0625f; v1[2] += a3[0] * 0.0625f; v1[3] += a3[1] * 0.0625f; }
#else
                    if (ADD) { const u32x4 o = *(const u32x4*)(O + p);
                        v0[0] += bflo(o.x); v0[1] += bfhi(o.x); v0[2] += bflo(o.y); v0[3] += bfhi(o.y);
                        v1[0] += bflo(o.z); v1[1] += bfhi(o.z); v1[2] += bflo(o.w); v1[3] += bfhi(o.w); }
#endif
                    if (OUT8) { u32x2_ w8;
                        w8.x = fp8x4_sat(v0[0] * 16.f, v0[1] * 16.f, v0[2] * 16.f, v0[3] * 16.f); w8.y = fp8x4_sat(v1[0] * 16.f, v1[1] * 16.f, v1[2] * 16.f, v1[3] * 16.f);
                        *(u32x2_*)(O8 + p) = w8; }
                    else if (PART_FP8) { u32x2_ w8;
                        w8.x = fp8x4_sat(v0[0] * 16.f, v0[1] * 16.f, v0[2] * 16.f, v0[3] * 16.f); w8.y = fp8x4_sat(v1[0] * 16.f, v1[1] * 16.f, v1[2] * 16.f, v1[3] * 16.f);
                        *(u32x2_*)((unsigned char*)O + p) = w8; }
                    else { u32x4 w; w.x = cvt_pk_bf16(v0[0], v0[1]); w.y = cvt_pk_bf16(v0[2], v0[3]); w.z = cvt_pk_bf16(v1[0], v1[1]); w.w = cvt_pk_bf16(v1[2], v1[3]);
                        *(u32x4*)(O + p) = w; }
                }
    }
};

struct EpiResBf16 {
    static constexpr bool PERM = true, AFTER_DRAIN = false; static constexpr int NSTORE = 16;
    const bf16_t* x; bf16_t* out; float alpha;
    __device__ __forceinline__ void operator()(const f32x4 (&acc)[2][2][4][2], const Unit& u, int wr, int wc, int fr, int fq) const {
        const int row0 = u.pm * BM + wr * 64 + fr, col0 = u.pn * BM + wc * 32 + 8 * fq;
#if X_F32_RES && EPI_EARLY
#pragma unroll
        for (int ai = 0; ai < 2; ++ai) {
            f32x4 xq[4][2][2];
#pragma unroll
            for (int m = 0; m < 4; ++m)
#pragma unroll
                for (int bj = 0; bj < 2; ++bj) { const size_t p = (size_t)(row0 + ai * HALF + m * 16) * 1024 + col0 + bj * HALF;
                    xq[m][bj][0] = *(const f32x4*)((const float*)x + p); xq[m][bj][1] = *(const f32x4*)((const float*)x + p + 4); }
#pragma unroll
            for (int m = 0; m < 4; ++m)
#pragma unroll
                for (int bj = 0; bj < 2; ++bj) { const size_t p = (size_t)(row0 + ai * HALF + m * 16) * 1024 + col0 + bj * HALF;
                    const f32x4 v0 = xq[m][bj][0] * alpha + acc[ai][bj][m][0], v1 = xq[m][bj][1] * alpha + acc[ai][bj][m][1];
                    u32x4 w; w.x = cvt_pk_bf16(v0[0], v0[1]); w.y = cvt_pk_bf16(v0[2], v0[3]); w.z = cvt_pk_bf16(v1[0], v1[1]); w.w = cvt_pk_bf16(v1[2], v1[3]);
                    *(u32x4*)(out + p) = w; }
        }
        return;
#endif
#pragma unroll
        for (int ai = 0; ai < 2; ++ai)
#pragma unroll
            for (int m = 0; m < 4; ++m)
#pragma unroll
                for (int bj = 0; bj < 2; ++bj) {
                    const size_t p = (size_t)(row0 + ai * HALF + m * 16) * 1024 + col0 + bj * HALF;
#if X_F32_RES
                    const f32x4 x0 = *(const f32x4*)((const float*)x + p), x1 = *(const f32x4*)((const float*)x + p + 4);
#else
                    const u32x4 xw = *(const u32x4*)(x + p);
                    const f32x4 x0 = (f32x4){bflo(xw.x), bfhi(xw.x), bflo(xw.y), bfhi(xw.y)}, x1 = (f32x4){bflo(xw.z), bfhi(xw.z), bflo(xw.w), bfhi(xw.w)};
#endif
                    const f32x4 v0 = x0 * alpha + acc[ai][bj][m][0], v1 = x1 * alpha + acc[ai][bj][m][1];
                    u32x4 w; w.x = cvt_pk_bf16(v0[0], v0[1]); w.y = cvt_pk_bf16(v0[2], v0[3]); w.z = cvt_pk_bf16(v1[0], v1[1]); w.w = cvt_pk_bf16(v1[2], v1[3]);
                    *(u32x4*)(out + p) = w;
                }
    }
};

struct EpiSwiGLU {
    static constexpr bool PERM = true, AFTER_DRAIN = false; static constexpr int NSTORE = 16;
    unsigned char* H;
    __device__ __forceinline__ void operator()(const f32x4 (&acc)[2][2][4][2], const Unit& u, int wr, int wc, int fr, int fq) const {
        const int row0 = u.pm * BM + wr * 64 + fr, col0 = (u.pn & 3) * 128 + wc * 16 + 4 * fq;
#pragma unroll
        for (int ai = 0; ai < 2; ++ai)
#pragma unroll
            for (int m = 0; m < 4; ++m)
#pragma unroll
                for (int bj = 0; bj < 2; ++bj) {
                    const f32x4 g = acc[ai][bj][m][0], up = acc[ai][bj][m][1];
                    float h0 = fsilu(g[0]) * up[0] * 8.f, h1 = fsilu(g[1]) * up[1] * 8.f, h2 = fsilu(g[2]) * up[2] * 8.f, h3 = fsilu(g[3]) * up[3] * 8.f;
                    h0 = fminf(fmaxf(h0, -448.f), 448.f); h1 = fminf(fmaxf(h1, -448.f), 448.f); h2 = fminf(fmaxf(h2, -448.f), 448.f); h3 = fminf(fmaxf(h3, -448.f), 448.f);
                    unsigned w = 0u; w = __builtin_amdgcn_cvt_pk_fp8_f32(h0, h1, w, false); w = __builtin_amdgcn_cvt_pk_fp8_f32(h2, h3, w, true);
                    *(unsigned*)(H + (size_t)(row0 + ai * HALF + m * 16) * 512 + col0 + bj * 64) = w;
                }
    }
};

struct EpiRowScale {
    static constexpr bool PERM = true, AFTER_DRAIN = false; static constexpr int NSTORE = 16;
    bf16_t* Y;
    __device__ __forceinline__ void operator()(const f32x4 (&acc)[2][2][4][2], const Unit& u, int wr, int wc, int fr, int fq) const {
        const int row0 = u.pm * BM + wr * 64 + fr, col0 = (u.pn & 3) * BM + wc * 32 + 8 * fq;
#pragma unroll
        for (int ai = 0; ai < 2; ++ai)
#pragma unroll
            for (int m = 0; m < 4; ++m) {
                const int row = row0 + ai * HALF + m * 16;
#pragma unroll
                for (int bj = 0; bj < 2; ++bj) {
                    const f32x4 v0 = acc[ai][bj][m][0], v1 = acc[ai][bj][m][1];
#if Y_FP8
                    u32x2_ w8; w8.x = fp8x4_sat(v0[0] * 16.f, v0[1] * 16.f, v0[2] * 16.f, v0[3] * 16.f); w8.y = fp8x4_sat(v1[0] * 16.f, v1[1] * 16.f, v1[2] * 16.f, v1[3] * 16.f);
                    *(u32x2_*)((unsigned char*)Y + (size_t)row * 1024 + col0 + bj * HALF) = w8;
#else
                    u32x4 w; w.x = cvt_pk_bf16_acc(v0[0], v0[1]); w.y = cvt_pk_bf16_acc(v0[2], v0[3]); w.z = cvt_pk_bf16_acc(v1[0], v1[1]); w.w = cvt_pk_bf16_acc(v1[2], v1[3]);
                    *(u32x4*)(Y + (size_t)row * 1024 + col0 + bj * HALF) = w;
#endif
                }
            }
    }
};

struct MoeOrder {
    int nunits, G, c; const PG8_LAS int* te; const PG8_LAS int* ts; const PG8_LAS int* cnt; const int* ltok; unsigned rowbytes;
    __device__ __forceinline__ bool next(int i, Unit& u) const {
        const int L = i * G + c, rt = (L >> 5) * 8 + (L & 7); if (rt >= (nunits >> 2)) return false;
        u.pm = rt; u.pn = te[rt] * 4 + ((L >> 3) & 3); return true;
    }
    __device__ __forceinline__ unsigned a_row_off(const Unit& u, int row) const {
        const int ex = te[u.pm], pos = (u.pm - ts[ex]) * 256 + row;
        const int tok = pos < cnt[ex] ? ltok[ex * 32768 + pos] : 0;
        return (unsigned)tok * rowbytes;
    }
    __device__ __forceinline__ void a_ready(const Unit&) const {}
    __device__ __forceinline__ void done(const Unit&, int, int) const {}
};

struct ExpertConv { const float* wg; const float* wu; const float* wd; unsigned char* WGU; unsigned char* WD; int gw, nw, grp; };
__device__ __forceinline__ void expert_conv_item(const ExpertConv& c, int j, int lane) {
    const int it = j * c.nw + c.gw, e = it / 384, r = it % 384;
    const float* src; unsigned char* dst; int K, N, mode, nb, kb;
    if (r < 128)      { src = c.wg + (size_t)e * 1024 * 512; dst = c.WGU + (size_t)e * 1024 * 1024; K = 1024; N = 512;  mode = 2; nb = r & 15; kb = r >> 4; }
    else if (r < 256) { src = c.wu + (size_t)e * 1024 * 512; dst = c.WGU + (size_t)e * 1024 * 1024; K = 1024; N = 512;  mode = 3; nb = (r - 128) & 15; kb = (r - 128) >> 4; }
    else              { src = c.wd + (size_t)e * 512 * 1024; dst = c.WD + (size_t)e * 1024 * 512;   K = 512;  N = 1024; mode = 0; nb = (r - 256) & 31; kb = (r - 256) >> 5; }
    const int n4 = nb * 32 + 4 * (lane & 7), k0 = kb * 128 + 16 * (lane >> 3);
    const float* s = src + (size_t)k0 * N + n4;
    f32x4 v[16];
#pragma unroll
    for (int i = 0; i < 16; ++i) v[i] = *(const f32x4*)(s + (size_t)i * N);
#pragma unroll
    for (int jn = 0; jn < 4; ++jn) {
        const int n = n4 + jn, row = mode == 0 ? n : ((n >> 2) << 3) + (n & 3) + (mode == 3 ? 4 : 0);
        u32x4 w;
        w.x = fp8x4_sat(v[0][jn] * 64.f, v[1][jn] * 64.f, v[2][jn] * 64.f, v[3][jn] * 64.f);     w.y = fp8x4_sat(v[4][jn] * 64.f, v[5][jn] * 64.f, v[6][jn] * 64.f, v[7][jn] * 64.f);
        w.z = fp8x4_sat(v[8][jn] * 64.f, v[9][jn] * 64.f, v[10][jn] * 64.f, v[11][jn] * 64.f); w.w = fp8x4_sat(v[12][jn] * 64.f, v[13][jn] * 64.f, v[14][jn] * 64.f, v[15][jn] * 64.f);
        *(u32x4*)(dst + (size_t)row * K + k0) = w;
    }
}
struct GateOrder {
    StaticOrder S4;
    __device__ __forceinline__ bool next(int i, Unit& u) const { Unit t; if (!S4.next(i >> 1, t)) return false; u.pm = t.pm; u.pn = t.pn + 4 * (i & 1); return true; }
    __device__ __forceinline__ void a_ready(const Unit&) const {}
    __device__ __forceinline__ void done(const Unit&, int, int) const {}
};
struct P1Order {
    StaticOrder S; ExpertConv cv;
    __device__ __forceinline__ bool next(int i, Unit& u) const { return S.next(i, u); }
    __device__ __forceinline__ void a_ready(const Unit&) const {}
    __device__ __forceinline__ static int unit_of(int grp, int k) { return (grp + 3 * k) % 9; }
    __device__ __forceinline__ void done(const Unit&, int ui, int lane) const {
        const int d = (ui + 9 - cv.grp) % 9;
        if (ui < 9 && d % 3 == 0 && cv.gw + (d / 3) * cv.nw < 6144) expert_conv_item(cv, d / 3, lane);
    }
};

template <class Epi, class Sched, bool ALIGN_EPI = false, bool SP2 = false, bool GATHER = false, bool FP8 = false, int SEL_W = 0, int SEL_X = 0>
__device__ __forceinline__ void gemm_phase(PG8_LAS unsigned char* lds, const Gemm g, const Sched& S, const Epi& E, const int wid) {
    int tid = wid * 64 + lane_id(); asm volatile("" : "+v"(tid));
    const int lane = tid & 63, wr = wid >> 2, wc = wid & 3, fr = lane & 15, fq = lane >> 4;
    static_assert(SP2, "only the two-super-phase loop is kept");
    typedef int i32x4_ __attribute__((ext_vector_type(4)));
    const int K = g.K, nt = K / BK;
    unsigned voffB[2]; int rA[2], cA2[2];
#pragma unroll
    for (int i = 0; i < 2; ++i) { int R, C; stage_rc(tid * 16 + i * 8192, R, C); const int Rb = Epi::PERM ? ((R & ~31) + perm32(R & 31)) : R;
        rA[i] = R; cA2[i] = C * 2; voffB[i] = (unsigned)(Rb * K + C) * 2u; }
    unsigned vAc[2][2], vAn[2][2];
    const size_t kstep = (size_t)(BK * 2);
    const size_t hstep = (size_t)HALF * K * 2;
    const size_t tstep = 2 * hstep;
    const unsigned ldsw = (unsigned)wid * 1024u;
    const int aoff0 = lds_byte(wr * 64 + fr, fq * 8), aoff1 = aoff0 + 1024;
    const int boff0 = lds_byte(wc * 32 + fr, fq * 8), boff1 = boff0 + 1024;
#define PG8_SA(b, h) (((b) * 2 + (h)) * HTB)
#define PG8_SB(b, h) ((4 + (b) * 2 + (h)) * HTB)
#define PG8_STAGE(bufoff, gbase, voff) do { _Pragma("unroll") for (int _i = 0; _i < 2; ++_i) \
        __builtin_amdgcn_global_load_lds((const unsigned*)((const char*)(gbase) + (voff)[_i]), (PG8_LAS unsigned*)(lds + (bufoff) + ldsw + _i * 8192), 16, 0, 0); } while (0)
#define PG8_LDA(dst, b, h) do { _Pragma("unroll") for (int m = 0; m < 4; ++m) { dst[m][0] = *(const PG8_LAS bf16x8*)(lds + PG8_SA(b, h) + aoff0 + m * 2048); dst[m][1] = *(const PG8_LAS bf16x8*)(lds + PG8_SA(b, h) + aoff1 + m * 2048); } } while (0)
#define PG8_LDB(dst, b, h) do { _Pragma("unroll") for (int n = 0; n < 2; ++n) { dst[n][0] = *(const PG8_LAS bf16x8*)(lds + PG8_SB(b, h) + boff0 + n * 2048); dst[n][1] = *(const PG8_LAS bf16x8*)(lds + PG8_SB(b, h) + boff1 + n * 2048); } } while (0)
#define PG8_CAT8(x) __builtin_shufflevector(__builtin_bit_cast(i32x4_, (x)[0]), __builtin_bit_cast(i32x4_, (x)[1]), 0, 1, 2, 3, 4, 5, 6, 7)
#define PG8_MMA(ai, bj, At, Bt) do { __builtin_amdgcn_s_setprio(1); \
        if constexpr (FP8) { _Pragma("unroll") for (int m = 0; m < 4; ++m) _Pragma("unroll") for (int n = 0; n < 2; ++n) \
            acc[ai][bj][m][n] = __builtin_amdgcn_mfma_scale_f32_16x16x128_f8f6f4(PG8_CAT8(Bt[n]), PG8_CAT8(At[m]), acc[ai][bj][m][n], 0, 0, SEL_W, scl, SEL_X, scl); \
            asm volatile("" : "+v"(acc[ai][bj][0][0]), "+v"(acc[ai][bj][0][1]), "+v"(acc[ai][bj][1][0]), "+v"(acc[ai][bj][1][1]), "+v"(acc[ai][bj][2][0]), "+v"(acc[ai][bj][2][1]), "+v"(acc[ai][bj][3][0]), "+v"(acc[ai][bj][3][1])); } \
        else { _Pragma("unroll") for (int m = 0; m < 4; ++m) _Pragma("unroll") for (int n = 0; n < 2; ++n) _Pragma("unroll") for (int k = 0; k < 2; ++k) \
            acc[ai][bj][m][n] = __builtin_amdgcn_mfma_f32_16x16x32_bf16(Bt[n][k], At[m][k], acc[ai][bj][m][n], 0, 0, 0); } \
        __builtin_amdgcn_s_setprio(0); } while (0)
#define PG8_WAIT_V(n) asm volatile("s_waitcnt vmcnt(" #n ")" ::: "memory")
#define PG8_WAIT_VN(n) asm volatile("s_waitcnt vmcnt(%0)" :: "i"(n) : "memory")
#define PG8_WAIT_L(n) asm volatile("s_waitcnt lgkmcnt(" #n ")" ::: "memory")
#define PG8_BAR __builtin_amdgcn_s_barrier()
#define PG8_SCHED __builtin_amdgcn_sched_barrier(0)
    [[maybe_unused]] int scl = 0x7b7c797f; asm volatile("" : "+v"(scl));
    Unit cur, nxt; int ui = 0;
    if (!S.next(0, cur)) return;
    f32x4 acc[2][2][4][2];
#pragma unroll
    for (int a = 0; a < 2; ++a)
#pragma unroll
        for (int b = 0; b < 2; ++b)
#pragma unroll
            for (int m = 0; m < 4; ++m)
#pragma unroll
                for (int n = 0; n < 2; ++n) acc[a][b][m][n] = (f32x4){0.f, 0.f, 0.f, 0.f};
    bf16x8 At[4][2], B0[2][2], B1[2][2];
    const char* cA = GATHER ? (const char*)g.A : (const char*)g.A + (size_t)cur.pm * tstep + (cur.pm >= g.spm ? g.sdelta : 0L); const char* cB = (const char*)g.Bt + (size_t)cur.pn * tstep;
#pragma unroll
    for (int h = 0; h < 2; ++h)
#pragma unroll
        for (int i = 0; i < 2; ++i) { if constexpr (GATHER) vAc[h][i] = S.a_row_off(cur, h * HALF + rA[i]) + (unsigned)cA2[i]; else vAc[h][i] = (unsigned)((h * HALF + rA[i]) * K) * 2u + (unsigned)cA2[i]; vAn[h][i] = vAc[h][i]; }
    S.a_ready(cur);
    if constexpr (SP2) {
        PG8_STAGE(PG8_SB(0, 0), cB, voffB); PG8_STAGE(PG8_SB(0, 1), cB + hstep, voffB); PG8_STAGE(PG8_SA(0, 0), cA, vAc[0]); PG8_STAGE(PG8_SA(0, 1), cA, vAc[1]);
        if (wr == 1) PG8_BAR;
        PG8_WAIT_V(2); PG8_BAR;
        PG8_STAGE(PG8_SB(1, 0), cB + kstep, voffB); PG8_STAGE(PG8_SA(1, 0), cA + kstep, vAc[0]); PG8_STAGE(PG8_SB(1, 1), cB + hstep + kstep, voffB);
        PG8_WAIT_V(6); PG8_BAR;
    }
    for (;;) {
        const bool has_next = S.next(ui + 1, nxt);
        const char* nA = GATHER ? cA : (has_next ? (const char*)g.A + (size_t)nxt.pm * tstep + (nxt.pm >= g.spm ? g.sdelta : 0L) : cA); const char* nB = has_next ? (const char*)g.Bt + (size_t)nxt.pn * tstep : cB;
        if constexpr (GATHER) { if (has_next) {
#pragma unroll
            for (int h = 0; h < 2; ++h)
#pragma unroll
                for (int i = 0; i < 2; ++i) vAn[h][i] = S.a_row_off(nxt, h * HALF + rA[i]) + (unsigned)cA2[i]; } }
#pragma unroll 1
        for (int t = 0; t < nt; t += 2) {
            const bool last = (t == nt - 2);
            asm volatile("" : "+v"(voffB[0]), "+v"(voffB[1]), "+v"(vAc[0][0]), "+v"(vAc[0][1]), "+v"(vAc[1][0]), "+v"(vAc[1][1]));
            const char* a1 = cA + (size_t)(t + 1) * kstep;
            const char* a2 = last ? nA : cA + (size_t)(t + 2) * kstep; const char* b2 = last ? nB : cB + (size_t)(t + 2) * kstep;
            const char* a3 = a2 + kstep; const char* b3 = b2 + kstep;
            unsigned vA2[2][2];
#pragma unroll
            for (int h = 0; h < 2; ++h)
#pragma unroll
                for (int i = 0; i < 2; ++i) vA2[h][i] = vAc[h][i];
            if constexpr (GATHER) { if (last) {
                asm volatile("" : "+v"(vAn[0][0]), "+v"(vAn[0][1]), "+v"(vAn[1][0]), "+v"(vAn[1][1]));
#pragma unroll
                for (int h = 0; h < 2; ++h)
#pragma unroll
                    for (int i = 0; i < 2; ++i) vA2[h][i] = vAn[h][i]; } }
            if (last && has_next) S.a_ready(nxt);
            if constexpr (SP2) {
            const int lenient = __builtin_amdgcn_readfirstlane((ui > 0 && t == 0) ? 1 : 0);
#define PG8_WAIT_V8L() asm volatile("s_cmp_eq_u32 %0, 0\n\ts_cbranch_scc0 .Lpg8skip%=\n\ts_waitcnt vmcnt(8)\n.Lpg8skip%=:\n\ts_waitcnt vmcnt(%1)" :: "s"(lenient), "i"(8 + Epi::NSTORE) : "memory", "scc")
            PG8_LDB(B0, 0, 0); PG8_LDB(B1, 0, 1); PG8_SCHED; PG8_LDA(At, 0, 0); PG8_STAGE(PG8_SA(1, 1), a1, vAc[1]);
            PG8_WAIT_V8L(); PG8_WAIT_L(0); PG8_BAR; PG8_MMA(0, 0, At, B0); PG8_MMA(0, 1, At, B1); PG8_BAR; PG8_SCHED;
            PG8_LDA(At, 0, 1); PG8_STAGE(PG8_SB(0, 0), b2, voffB); PG8_STAGE(PG8_SB(0, 1), b2 + hstep, voffB); PG8_STAGE(PG8_SA(0, 0), a2, vA2[0]);
            PG8_WAIT_V8L(); PG8_WAIT_L(0); PG8_BAR; PG8_MMA(1, 0, At, B0); PG8_MMA(1, 1, At, B1); PG8_BAR; PG8_SCHED;
            PG8_LDB(B0, 1, 0); PG8_LDB(B1, 1, 1); PG8_SCHED; PG8_LDA(At, 1, 0); PG8_STAGE(PG8_SA(0, 1), a2, vA2[1]);
            PG8_WAIT_V(8); PG8_WAIT_L(0); PG8_BAR; PG8_MMA(0, 0, At, B0); PG8_MMA(0, 1, At, B1); PG8_BAR; PG8_SCHED;
            PG8_LDA(At, 1, 1); PG8_STAGE(PG8_SB(1, 0), b3, voffB); PG8_STAGE(PG8_SB(1, 1), b3 + hstep, voffB); PG8_STAGE(PG8_SA(1, 0), a3, vA2[0]);
            PG8_WAIT_V(8); PG8_WAIT_L(0); PG8_BAR; PG8_MMA(1, 0, At, B0); PG8_MMA(1, 1, At, B1); PG8_BAR; PG8_SCHED;
#undef PG8_WAIT_V8L
            }
        }
        if constexpr (ALIGN_EPI) { if (wr == 0) PG8_BAR; }
        if constexpr (!Epi::AFTER_DRAIN) { const int le = lane_id(); E(acc, cur, wr, wc, le & 15, le >> 4); S.done(cur, ui, le); }
        if (!has_next) break;
#pragma unroll
        for (int a = 0; a < 2; ++a)
#pragma unroll
            for (int b = 0; b < 2; ++b)
#pragma unroll
                for (int m = 0; m < 4; ++m)
#pragma unroll
                    for (int n = 0; n < 2; ++n) acc[a][b][m][n] = (f32x4){0.f, 0.f, 0.f, 0.f};
        cur = nxt; cA = nA; cB = nB; ++ui;
        if constexpr (GATHER) {
#pragma unroll
            for (int h = 0; h < 2; ++h)
#pragma unroll
                for (int i = 0; i < 2; ++i) vAc[h][i] = vAn[h][i]; }
        if constexpr (ALIGN_EPI) { if (wr == 1) PG8_BAR; }
    }
    PG8_WAIT_V(0);
    if constexpr (!ALIGN_EPI) { if (wr == 0) PG8_BAR; }
    PG8_BAR;
    if constexpr (Epi::AFTER_DRAIN) { E.fused(acc, cur, wr, wc, fr, fq, lds, wid, lane); S.done(cur, ui, lane); }
#undef PG8_SA
#undef PG8_SB
#undef PG8_STAGE
#undef PG8_LDA
#undef PG8_LDB
#undef PG8_MMA
#undef PG8_CAT8
#undef PG8_WAIT_V
#undef PG8_WAIT_VN
#undef PG8_WAIT_L
#undef PG8_BAR
#undef PG8_SCHED
}
}
#define GAS __attribute__((address_space(1)))
#define LAS __attribute__((address_space(3)))
typedef unsigned short bf16;
typedef unsigned v4u __attribute__((ext_vector_type(4)));
typedef float f32x4 __attribute__((ext_vector_type(4)));
typedef short bf16x8 __attribute__((ext_vector_type(8)));
typedef GAS unsigned gu32;
typedef GAS unsigned long long gu64;
#define RLX_AGENT __ATOMIC_RELAXED, __HIP_MEMORY_SCOPE_AGENT
#define LDS_WAIT() asm volatile("s_waitcnt lgkmcnt(0)" ::: "memory")
#define VM_WAIT() asm volatile("s_waitcnt vmcnt(0)" ::: "memory")
__device__ __forceinline__ unsigned long long rt() { return __builtin_amdgcn_s_memrealtime(); }
__device__ __forceinline__ unsigned f2bf(float f) { unsigned u = __builtin_bit_cast(unsigned, f); return (u + 0x7fffu + ((u >> 16) & 1u)) >> 16; }
__device__ __forceinline__ unsigned pk2(float lo, float hi) { return f2bf(lo) | (f2bf(hi) << 16); }

#define XB_TMO      128
#define XB_MIS      64
#define XB_XCNT(j)  (256  + 64 * (j))
#define XB_XSUB(j)  (1280 + 64 * (j))
#define XB_XGEN(j)  (2304 + 64 * (j))
#define XB_TOP      3328
#define XB_TOPGEN   3392
#define XCD_BAR_WORDS 3456
#define XB_SPIN_CAP (1u << 18)

__device__ __forceinline__ unsigned xb_ld(unsigned* p)              { return __hip_atomic_load(p, __ATOMIC_RELAXED, __HIP_MEMORY_SCOPE_AGENT); }
__device__ __forceinline__ unsigned xb_add(unsigned* p, unsigned v) { return __hip_atomic_fetch_add(p, v, __ATOMIC_RELAXED, __HIP_MEMORY_SCOPE_AGENT); }
__device__ __forceinline__ unsigned xb_xcc_id() { return (unsigned)__builtin_amdgcn_s_getreg((3 << 11) | 20) & 0xFu; }
#define XB_SPIN(cond, bar) do { unsigned _sp = 0; while (cond) { __builtin_amdgcn_s_sleep(1); \
    if ((++_sp & 255u) == 0u) { if (xb_ld(&(bar)[XB_TMO])) break; if (_sp > XB_SPIN_CAP) { atomicAdd(&(bar)[XB_TMO], 1u); break; } } } } while (0)

struct XcdBarrier {
    unsigned* bar; unsigned x; int wv;
    volatile LAS unsigned* st;
};

__device__ __forceinline__ XcdBarrier xcd_barrier_post(unsigned* bar, volatile LAS unsigned* st) {
    XcdBarrier b; b.bar = bar; b.x = xb_xcc_id(); b.st = st; b.wv = 0;
    if (threadIdx.x == 0) (void)xb_add(&bar[XB_XCNT(b.x)], 1u);
    return b;
}
__device__ __forceinline__ void xcd_barrier_complete(unsigned* bar, unsigned x, unsigned& nloc, unsigned& nx) {
    const unsigned G = gridDim.x * gridDim.y * gridDim.z;
    unsigned sum, cnt, mine, sp = 0u;
    for (;;) {
        sum = 0u; cnt = 0u; mine = 0u;
#pragma unroll
        for (unsigned j = 0; j < 16; ++j) { const unsigned c = xb_ld(&bar[XB_XCNT(j)]); sum += c; cnt += (c > 0u) ? 1u : 0u; mine = (j == x) ? c : mine; }
        if (sum == G) break;
        __builtin_amdgcn_s_sleep(1);
        if ((++sp & 255u) == 0u) { if (xb_ld(&bar[XB_TMO])) break; if (sp > XB_SPIN_CAP) { atomicAdd(&bar[XB_TMO], 1u); break; } }
    }
    nloc = mine > 0u ? mine : 1u; nx = cnt > 0u ? cnt : 1u;
}

__device__ __forceinline__ void xcd_barrier(const XcdBarrier& b) {
    asm volatile("s_waitcnt vmcnt(0)" ::: "memory");
    __syncthreads();
    if (b.wv == 0 && (int)__builtin_amdgcn_mbcnt_hi(~0u, __builtin_amdgcn_mbcnt_lo(~0u, 0u)) == 0) {
        unsigned* bar = b.bar;
        __builtin_amdgcn_s_waitcnt(0);
        unsigned nloc = b.st[0], nx = b.st[1];
        if (nloc == 0u) { xcd_barrier_complete(bar, b.x, nloc, nx); b.st[0] = nloc; b.st[1] = nx; }
        const unsigned old = xb_add(&bar[XB_XSUB(b.x)], 1u);
        const unsigned gen = old / nloc;
        if (old + 1u == (gen + 1u) * nloc) {
            asm volatile("buffer_wbl2 sc1\n\tbuffer_inv sc1\n\ts_waitcnt vmcnt(0)" ::: "memory");
            const unsigned og = xb_add(&bar[XB_TOP], 1u);
            const unsigned tg = og / nx;
            if (og + 1u == (tg + 1u) * nx) xb_add(&bar[XB_TOPGEN], 1u);
            else XB_SPIN(xb_ld(&bar[XB_TOPGEN]) == tg, bar);
        } else {
            __builtin_amdgcn_fence(__ATOMIC_ACQUIRE, "agent");
            asm volatile("s_waitcnt vmcnt(0)" ::: "memory");
            XB_SPIN(xb_ld(&bar[XB_TOPGEN]) == gen, bar);
        }
        if (b.st[2] == 0u) b.st[2] = 1u + (xb_ld(&bar[XB_MIS]) == 0u ? 1u : 0u);
    }
    __syncthreads();
}
__device__ __forceinline__ void xcd_group_barrier(const XcdBarrier& b) {
    if (b.st[2] != 2u) { xcd_barrier(b); return; }
    asm volatile("s_waitcnt vmcnt(0)" ::: "memory");
    __syncthreads();
    if (b.wv == 0 && (int)__builtin_amdgcn_mbcnt_hi(~0u, __builtin_amdgcn_mbcnt_lo(~0u, 0u)) == 0) {
        unsigned* bar = b.bar; const unsigned nloc = b.st[0];
        const unsigned old = xb_add(&bar[XB_XGEN(b.x)], 1u), lgen = old / nloc;
        __builtin_amdgcn_fence(__ATOMIC_ACQUIRE, "agent");
        asm volatile("s_waitcnt vmcnt(0)" ::: "memory");
        XB_SPIN(xb_ld(&bar[XB_XGEN(b.x)]) < nloc * (lgen + 1u), bar);
    }
    __syncthreads();
}


constexpr int NWAVES = 8;
constexpr int RING_BYTES = 131072;
constexpr int LDSCTL_OFF = RING_BYTES, MISC_OFF = LDSCTL_OFF + 320;
constexpr int LDS_TS_OFF = LDSCTL_OFF + 1024;
constexpr int LDS_TE_OFF = LDSCTL_OFF + 2048;
constexpr int LDS_CNT_OFF = LDSCTL_OFF + 1024 + 128;
constexpr int LDS_BYTES = 163840;

typedef short s16x4 __attribute__((ext_vector_type(4)));
typedef unsigned u32x2 __attribute__((ext_vector_type(2)));

struct Args { const float* in[20]; float* out; unsigned char* ws; unsigned mask; int bar_region; };

__device__ __forceinline__ float bflo(unsigned w) { return __uint_as_float(w << 16); }
__device__ __forceinline__ float bfhi(unsigned w) { return __uint_as_float(w & 0xffff0000u); }
__device__ __forceinline__ unsigned cvtpk(float lo, float hi) { return pg8::cvt_pk_bf16(lo, hi); }
__device__ __forceinline__ float wave_sum(float v) {
#pragma unroll
    for (int o = 1; o < 64; o <<= 1) v += __shfl_xor(v, o);
    return v;
}
__device__ __forceinline__ unsigned offb(unsigned row, unsigned ch) { return 256u * row + 16u * (ch ^ (((row & 3u) << 2) | ((row >> 2) & 3u))); }
__device__ __forceinline__ s16x4 ldtr(const LAS unsigned char* p) { return __builtin_amdgcn_ds_read_tr16_b64_v4i16((LAS s16x4*)p); }
__device__ __forceinline__ bf16x8 cat8(s16x4 a, s16x4 b) { return (bf16x8){a[0], a[1], a[2], a[3], b[0], b[1], b[2], b[3]}; }
#define MFMA16(a, b, c) __builtin_amdgcn_mfma_f32_16x16x32_bf16((a), (b), (c), 0, 0, 0)

template <int MODE> __device__ __forceinline__ int dest_row(int n) {
    if (MODE == 1) { if (n >= 1024) return n; const int hb = n & ~127, d = n & 127, jr = d & 63, half = d >> 6; return hb + 8 * (jr >> 2) + 4 * half + (jr & 3); }
    if (MODE == 2) return ((n >> 2) << 3) + (n & 3);
    if (MODE == 3) return ((n >> 2) << 3) + 4 + (n & 3);
    return n;
}
template <int MODE> __device__ __forceinline__ void p0_transpose_item(const float* W, int K, int N, bf16* WT, LAS float* scr, int item, int lane) {
    const int nblk = N / 32, kb = item / nblk, nb = item % nblk, k0 = 64 * kb, n0 = 32 * nb;
    {
        const GAS f32x4* src = (const GAS f32x4*)(W + (size_t)(k0 + (lane >> 3)) * N + n0) + (lane & 7);
        f32x4 t[8];
#pragma unroll
        for (int j = 0; j < 8; ++j) t[j] = src[(size_t)j * 2 * N];
#pragma unroll
        for (int j = 0; j < 8; ++j) { LAS float* d = scr + ((lane >> 3) + 8 * j) * 33 + 4 * (lane & 7); d[0] = t[j].x; d[1] = t[j].y; d[2] = t[j].z; d[3] = t[j].w; }
    }
    LDS_WAIT(); asm volatile("" ::: "memory");
    const int c = lane & 7;
#pragma unroll
    for (int j = 0; j < 4; ++j) { const int n = (lane >> 3) + 8 * j; const LAS float* s = scr + (8 * c) * 33 + n;
        v4u o; o.x = pk2(s[0 * 33], s[1 * 33]); o.y = pk2(s[2 * 33], s[3 * 33]); o.z = pk2(s[4 * 33], s[5 * 33]); o.w = pk2(s[6 * 33], s[7 * 33]);
        *(GAS v4u*)(WT + (size_t)dest_row<MODE>(n0 + n) * K + k0 + 8 * c) = o; }
    LDS_WAIT(); asm volatile("" ::: "memory");
}
__device__ __forceinline__ unsigned pk_fp8x4(float a, float b, float c, float d) {
    a = fminf(fmaxf(a, -448.f), 448.f); b = fminf(fmaxf(b, -448.f), 448.f); c = fminf(fmaxf(c, -448.f), 448.f); d = fminf(fmaxf(d, -448.f), 448.f);
    unsigned w = 0u; w = __builtin_amdgcn_cvt_pk_fp8_f32(a, b, w, false); w = __builtin_amdgcn_cvt_pk_fp8_f32(c, d, w, true); return w;
}
__device__ __forceinline__ v4u fp8x8_to_bf16x8(u32x2 w) { typedef float f2_ __attribute__((ext_vector_type(2)));
    const f2_ a0 = __builtin_amdgcn_cvt_pk_f32_fp8(w.x, false), a1 = __builtin_amdgcn_cvt_pk_f32_fp8(w.x, true), a2 = __builtin_amdgcn_cvt_pk_f32_fp8(w.y, false), a3 = __builtin_amdgcn_cvt_pk_f32_fp8(w.y, true);
    v4u o; o.x = cvtpk(a0[0], a0[1]); o.y = cvtpk(a1[0], a1[1]); o.z = cvtpk(a2[0], a2[1]); o.w = cvtpk(a3[0], a3[1]); return o; }
template <int MODE> __device__ __forceinline__ void p0_transpose_item_fp8(const float* W, int K, int N, unsigned char* WT, LAS float* scr, int item, int lane, float scale) {
    const int nblk = N / 32, kb = item / nblk, nb = item % nblk, k0 = 64 * kb, n0 = 32 * nb;
    {
        const GAS f32x4* src = (const GAS f32x4*)(W + (size_t)(k0 + (lane >> 3)) * N + n0) + (lane & 7);
        f32x4 t[8];
#pragma unroll
        for (int j = 0; j < 8; ++j) t[j] = src[(size_t)j * 2 * N];
#pragma unroll
        for (int j = 0; j < 8; ++j) { LAS float* d = scr + ((lane >> 3) + 8 * j) * 33 + 4 * (lane & 7); d[0] = t[j].x; d[1] = t[j].y; d[2] = t[j].z; d[3] = t[j].w; }
    }
    LDS_WAIT(); asm volatile("" ::: "memory");
    const int c = lane & 7;
#pragma unroll
    for (int j = 0; j < 4; ++j) { const int n = (lane >> 3) + 8 * j; const LAS float* s = scr + (8 * c) * 33 + n;
        u32x2 o; o.x = pk_fp8x4(s[0 * 33] * scale, s[1 * 33] * scale, s[2 * 33] * scale, s[3 * 33] * scale); o.y = pk_fp8x4(s[4 * 33] * scale, s[5 * 33] * scale, s[6 * 33] * scale, s[7 * 33] * scale);
        *(GAS u32x2*)(WT + (size_t)dest_row<MODE>(n0 + n) * K + k0 + 8 * c) = o; }
    LDS_WAIT(); asm volatile("" ::: "memory");
}
__device__ __forceinline__ int t5_bucket(int rel) {
    const int n = rel < 0 ? -rel : rel;
    int large = 8 + (n >= 15) + (n >= 27) + (n >= 50) + (n >= 91) + (n >= 166) + (n >= 305) + (n >= 559);
    large = large < 15 ? large : 15;
    return (rel > 0 ? 16 : 0) + (n < 8 ? n : large);
}
__device__ __forceinline__ void p0_prologue(const Args& a, LAS unsigned char* lds, int vcu, int G, int tid, int wave, int lane) {
    unsigned char* ws = a.ws;
    LAS float* scr = (LAS float*)(lds + wave * 16384);
    const int gw = vcu * NWAVES + wave, NGW = G * NWAVES;
    constexpr int I_IN = 16 * 208, I_R = 16 * 32, I_A = 8 * 32, I_O = 16 * 32;
    constexpr int NITEMS = I_IN + I_R + I_A + I_O;
    for (int it = gw; it < NITEMS; it += NGW) {
        int r = it;
#if P1_FP8
        if (r < I_IN) { if ((GATE_FP8 || r % 208 < 144) && r % 208 >= 8 * P1_FP8_FROM) p0_transpose_item_fp8<1>(a.in[1], 1024, 6656, ws + WS_WIN8, scr, r, lane, 64.f);
                        else p0_transpose_item<1>(a.in[1], 1024, 6656, (bf16*)(ws + WS_WIN), scr, r, lane); continue; } r -= I_IN;
#else
        if (r < I_IN) { p0_transpose_item<1>(a.in[1], 1024, 6656, (bf16*)(ws + WS_WIN), scr, r, lane); continue; } r -= I_IN;
#endif
        if (r < I_R) { if (MIX_FP8 & 4) p0_transpose_item_fp8<0>(a.in[5], 1024, 1024, ws + WS_WR, scr, r, lane, 64.f); else p0_transpose_item<0>(a.in[5], 1024, 1024, (bf16*)(ws + WS_WR), scr, r, lane); continue; } r -= I_R;
        if (r < I_A) { if (MIX_FP8 & 2) p0_transpose_item_fp8<0>(a.in[7], 512, 1024, ws + WS_WA, scr, r, lane, 64.f); else p0_transpose_item<0>(a.in[7], 512, 1024, (bf16*)(ws + WS_WA), scr, r, lane); continue; } r -= I_A;
        if (MIX_FP8 & 1) p0_transpose_item_fp8<0>(a.in[8], 1024, 1024, ws + WS_WO, scr, r, lane, 64.f); else p0_transpose_item<0>(a.in[8], 1024, 1024, (bf16*)(ws + WS_WO), scr, r, lane);
    }
    {
        const f32x4* x4 = (const f32x4*)a.in[0]; u32x2* xb = (u32x2*)(ws + WS_XB);
#if P1_FP8
#if GATE_FP8
        unsigned* xf8 = (unsigned*)(ws + WS_X8_LO);
#define XF8_AT(i) xf8[(long)(i) + ((i) >= (size_t)16384 * 256 ? ((long)WS_X8_HI - (long)WS_X8_LO - (long)(16 * MiB)) / 4 : 0L)]
#else
        unsigned* xf8 = (unsigned*)a.out;
#define XF8_AT(i) xf8[i]
#endif
        const size_t n4 = (size_t)TT * DM / 4, st = (size_t)G * 512; size_t i = (size_t)vcu * 512 + tid;
        for (; i + 7 * st < n4; i += 8 * st) {
            f32x4 v[8];
#pragma unroll
            for (int u = 0; u < 8; ++u) v[u] = x4[i + u * st];
#pragma unroll
            for (int u = 0; u < 8; ++u) { if (!X_F32_RES) { u32x2 o; o.x = cvtpk(v[u].x, v[u].y); o.y = cvtpk(v[u].z, v[u].w); xb[i + u * st] = o; } XF8_AT(i + u * st) = pk_fp8x4(v[u].x, v[u].y, v[u].z, v[u].w); }
        }
        for (; i < n4; i += st) { const f32x4 v = x4[i]; if (!X_F32_RES) { u32x2 o; o.x = cvtpk(v.x, v.y); o.y = cvtpk(v.z, v.w); xb[i] = o; } XF8_AT(i) = pk_fp8x4(v.x, v.y, v.z, v.w); }
#undef XF8_AT
#else
        for (size_t i = (size_t)vcu * 512 + tid; i < (size_t)TT * DM / 4; i += (size_t)G * 512) { const f32x4 v = x4[i]; u32x2 o; o.x = cvtpk(v.x, v.y); o.y = cvtpk(v.z, v.w); xb[i] = o; }
#endif
    }
    {
        float* rot = (float*)(ws + WS_ROT);
        for (int idx = vcu * 512 + tid; idx < SEQ * 64; idx += G * 512) {
            const int pos = idx >> 6, jr = idx & 63;
            double iv = 1.0; for (int k = 0; k < jr; ++k) iv *= 0.86596432336006535;
            const float ang = (float)pos * (float)iv;
            const double xx = (double)ang; const double qd = __builtin_rint(xx * 0.63661977236758134); const int qi = (int)qd;
            const double r = (xx - qd * 1.5707963267948966) - qd * 6.123233995736766e-17, r2 = r * r;
            const double sp = r * (1.0 + r2 * (-1.0 / 6 + r2 * (1.0 / 120 + r2 * (-1.0 / 5040 + r2 * (1.0 / 362880 + r2 * (-1.0 / 39916800 + r2 * (1.0 / 6227020800.0)))))));
            const double cp = 1.0 + r2 * (-0.5 + r2 * (1.0 / 24 + r2 * (-1.0 / 720 + r2 * (1.0 / 40320 + r2 * (-1.0 / 3628800 + r2 * (1.0 / 479001600.0))))));
            const int qq = qi & 3; const double s = qq == 0 ? sp : (qq == 1 ? cp : (qq == 2 ? -sp : -cp)), c = qq == 0 ? cp : (qq == 1 ? -sp : (qq == 2 ? -cp : sp));
            float* o = rot + ((size_t)pos * 16 + (jr >> 2)) * 8 + (jr & 3); o[0] = (float)c; o[4] = (float)s;
        }
    }
    if (vcu == 0) {
        float* bt = (float*)(ws + WS_BIAS); const float* rb = a.in[6];
        for (int idx = tid; idx < 3 * 8 * 160; idx += 512) { const int p = idx / (8 * 160), h = (idx / 160) % 8, d = idx % 160 - 80; const int dil = p == 0 ? 1 : (p == 1 ? 4 : 16);
            bt[idx] = (d >= -64 && d <= 64) ? rb[t5_bucket(d * dil) * 8 + h] * 1.4426950408889634f : -1e30f; }
    }
}
__device__ __forceinline__ void p0_expert_weights(const Args& a, LAS unsigned char* lds, int vcu, int G, int wave, int lane) {
    unsigned char* ws = a.ws;
    LAS float* scr = (LAS float*)(lds + wave * 16384);
    const int gw = vcu * NWAVES + wave, NGW = G * NWAVES;
    constexpr int I_G = 16 * 16, I_D = 8 * 32, PER_E = 2 * I_G + I_D;
    for (int it = gw; it < 16 * PER_E; it += NGW) {
        const int e = it / PER_E; int r = it - e * PER_E;
#if M1_FP8
        if (r < I_G) { p0_transpose_item_fp8<2>(a.in[15] + (size_t)e * 1024 * 512, 1024, 512, ws + WS_WGU + (size_t)e * 1024 * 1024, scr, r, lane, 64.f); continue; } r -= I_G;
        if (r < I_G) { p0_transpose_item_fp8<3>(a.in[16] + (size_t)e * 1024 * 512, 1024, 512, ws + WS_WGU + (size_t)e * 1024 * 1024, scr, r, lane, 64.f); continue; } r -= I_G;
#else
        if (r < I_G) { p0_transpose_item<2>(a.in[15] + (size_t)e * 1024 * 512, 1024, 512, (bf16*)(ws + WS_WGU) + (size_t)e * 1024 * 1024, scr, r, lane); continue; } r -= I_G;
        if (r < I_G) { p0_transpose_item<3>(a.in[16] + (size_t)e * 1024 * 512, 1024, 512, (bf16*)(ws + WS_WGU) + (size_t)e * 1024 * 1024, scr, r, lane); continue; } r -= I_G;
#endif
        p0_transpose_item_fp8<0>(a.in[17] + (size_t)e * 512 * 1024, 512, 1024, ws + WS_WD + (size_t)e * 1024 * 512, scr, r, lane, 64.f);
    }
    __syncthreads();
}

__device__ __forceinline__ float log2_gamma(const float* dec, int h) {
    const float x = dec[h]; return -__log2f(1.f + __expf(-x));
}
__device__ __forceinline__ void chain_item(const Args& a, LAS unsigned char* lds, int item, int tid, int wid, int lane) {
    unsigned char* ws = a.ws;
    const int b = item >> 4, h = (item >> 2) & 3, dir = (item >> 1) & 1, vh = item & 1;
    const float lg2 = log2_gamma(dir ? a.in[3] : a.in[2], h);
    const float cd = __builtin_amdgcn_exp2f(lg2 * 128.f);
    const int g = lane >> 4, i16 = lane & 15, q = i16 >> 2, p = lane & 3;
    const int wd = wid >> 1, wv = wid & 1;
    const GAS bf16* kr = (const GAS bf16*)(ws + WS_KR); const GAS bf16* vr = (const GAS bf16*)(ws + WS_VR);
    GAS bf16* states = (GAS bf16*)a.out;
    f32x4 acc[2][4];
#pragma unroll
    for (int i = 0; i < 2; ++i)
#pragma unroll
        for (int j = 0; j < 4; ++j) acc[i][j] = (f32x4){0.f, 0.f, 0.f, 0.f};
    const int srow = tid >> 4, sch = tid & 15; const unsigned soff = offb(srow, sch);
    const GAS bf16* kp = kr + ((size_t)b * SEQ + srow) * 512 + h * 128 + sch * 8;
    const GAS bf16* vp = vr + ((size_t)b * SEQ + srow) * 1024 + h * 256 + vh * 128 + sch * 8;
    v4u kq[4], vq[4];
    { const int n0 = dir ? 15 : 0;
#pragma unroll
      for (int j = 0; j < 4; ++j) { kq[j] = *(const GAS v4u*)(kp + (size_t)(n0 * 128 + 32 * j) * 512); vq[j] = *(const GAS v4u*)(vp + (size_t)(n0 * 128 + 32 * j) * 1024); } }
    unsigned abase[2][2], bbase[4][2];
#pragma unroll
    for (int t = 0; t < 2; ++t) { const unsigned r = 8 * g + 4 * t + q;
#pragma unroll
        for (int dt = 0; dt < 2; ++dt) abase[dt][t] = offb(r, 2 * (2 * wd + dt) + (p >> 1)) + 8 * (p & 1);
#pragma unroll
        for (int vt = 0; vt < 4; ++vt) bbase[vt][t] = offb(r, 2 * (4 * wv + vt) + (p >> 1)) + 8 * (p & 1); }
#define CH_STAGE(BUFOFF) do { _Pragma("unroll") for (int j = 0; j < 4; ++j) { \
            const int row = srow + 32 * j; const float z = __builtin_amdgcn_exp2f(lg2 * (float)(dir ? row : 127 - row)); const v4u kv = kq[j]; \
            v4u ko; ko.x = cvtpk(bflo(kv.x) * z, bfhi(kv.x) * z); ko.y = cvtpk(bflo(kv.y) * z, bfhi(kv.y) * z); ko.z = cvtpk(bflo(kv.z) * z, bfhi(kv.z) * z); ko.w = cvtpk(bflo(kv.w) * z, bfhi(kv.w) * z); \
            *(LAS v4u*)(lds + (BUFOFF) + soff + j * 8192) = ko; *(LAS v4u*)(lds + (BUFOFF) + 32768 + soff + j * 8192) = vq[j]; } } while (0)
#define CH_FETCH(NN) do { _Pragma("unroll") for (int j = 0; j < 4; ++j) { kq[j] = *(const GAS v4u*)(kp + (size_t)((NN) * 128 + 32 * j) * 512); vq[j] = *(const GAS v4u*)(vp + (size_t)((NN) * 128 + 32 * j) * 1024); } } while (0)
#define CH_STEP(STEP, CUR, OTH) do { const int step_ = (STEP); const int n_ = dir ? 15 - step_ : step_; \
        GAS bf16* sb_ = states + ((((size_t)(b * 4 + h) * 16 + n_) * 2 + dir) * 256) * 128; \
        _Pragma("unroll") for (int dt = 0; dt < 2; ++dt) _Pragma("unroll") for (int vt = 0; vt < 4; ++vt) { \
            const int v_ = vh * 128 + 64 * wv + 16 * vt + i16, d0_ = 32 * wd + 16 * dt + 4 * g; \
            if (STATE_FP8) { *(GAS unsigned*)((GAS unsigned char*)states + (((((size_t)(b * 4 + h) * 16 + n_) * 2 + dir) * 256) + v_) * 128 + d0_) = pg8::fp8x4_sat(acc[dt][vt][0] * 16.f, acc[dt][vt][1] * 16.f, acc[dt][vt][2] * 16.f, acc[dt][vt][3] * 16.f); }   \
            else { u32x2 w_; w_.x = pg8::cvt_pk_bf16_acc(acc[dt][vt][0], acc[dt][vt][1]); w_.y = pg8::cvt_pk_bf16_acc(acc[dt][vt][2], acc[dt][vt][3]);   \
            *(GAS u32x2*)(sb_ + (size_t)v_ * 128 + d0_) = w_; } } \
        if (step_ < 15) CH_STAGE(OTH); \
        if (step_ < 14) CH_FETCH(dir ? 13 - step_ : step_ + 2); \
        _Pragma("unroll") for (int i = 0; i < 2; ++i) _Pragma("unroll") for (int j = 0; j < 4; ++j) acc[i][j] = acc[i][j] * cd; \
        _Pragma("unroll") for (int ks = 0; ks < 4; ++ks) { bf16x8 af[2], bfr[4]; \
            _Pragma("unroll") for (int dt = 0; dt < 2; ++dt) af[dt] = cat8(ldtr(lds + (CUR) + abase[dt][0] + ks * 8192), ldtr(lds + (CUR) + abase[dt][1] + ks * 8192)); \
            _Pragma("unroll") for (int vt = 0; vt < 4; ++vt) bfr[vt] = cat8(ldtr(lds + (CUR) + 32768 + bbase[vt][0] + ks * 8192), ldtr(lds + (CUR) + 32768 + bbase[vt][1] + ks * 8192)); \
            _Pragma("unroll") for (int dt = 0; dt < 2; ++dt) _Pragma("unroll") for (int vt = 0; vt < 4; ++vt) acc[dt][vt] = MFMA16(af[dt], bfr[vt], acc[dt][vt]); } \
        __syncthreads(); } while (0)
    CH_STAGE(0);
    CH_FETCH(dir ? 14 : 1);
    __syncthreads();
    for (int sp = 0; sp < 8; ++sp) { CH_STEP(2 * sp, 0, 65536); CH_STEP(2 * sp + 1, 65536, 0); }
#undef CH_STEP
#undef CH_STAGE
#undef CH_FETCH
}

constexpr int AT_OST = 135168, AT_SCR = AT_OST + 8 * 2048;
constexpr int ATB_N = 160;
struct AttnLane { unsigned kb[2]; unsigned vb[4]; };
__device__ __forceinline__ AttnLane attn_lane(int lane) {
    const int g = lane >> 4, i16 = lane & 15, q4 = i16 >> 2, p = lane & 3; AttnLane L;
#pragma unroll
    for (int s = 0; s < 2; ++s) L.kb[s] = i16 * 128 + (((4 * s + g) ^ ((i16 >> 1) & 7)) * 16);
    const int sw = (2 * g + (q4 >> 1)) & 3;
#pragma unroll
    for (int c = 0; c < 4; ++c) L.vb[c] = (4 * g + q4) * 128 + ((c ^ sw) * 32) + p * 8;
    return L;
}
__device__ __forceinline__ unsigned kimg_off(int row, int c) { return row * 128 + ((c ^ ((row >> 1) & 7)) * 16); }
__device__ __forceinline__ unsigned vimg_off(int row, int c) { return row * 128 + (((c >> 1) ^ ((row >> 1) & 3)) * 32) + (c & 1) * 16; }
__device__ __forceinline__ void attn_core(const LAS unsigned char* Kimg, const LAS unsigned char* Vimg, int R0, int nrows, unsigned tvalid, const bf16x8 (&qf)[2],
                                          const float (&biasr)[36], const AttnLane& L, f32x4 (&O)[4], float& mx, float& lsum) {
    f32x4 D[9];
#pragma unroll
    for (int kt = 0; kt < 9; ++kt) {
        int R = R0 + 16 * kt; R = R < 0 ? 0 : (R > nrows - 16 ? nrows - 16 : R);
        const LAS unsigned char* kp = Kimg + R * 128;
        const bf16x8 k0 = *(const LAS bf16x8*)(kp + L.kb[0]), k1 = *(const LAS bf16x8*)(kp + L.kb[1]);
        f32x4 d = (f32x4){0.f, 0.f, 0.f, 0.f};
        d = MFMA16(k0, qf[0], d); d = MFMA16(k1, qf[1], d); D[kt] = d;
    }
    mx = -1e30f;
#pragma unroll
    for (int kt = 0; kt < 9; ++kt) {
        const float tb = ((tvalid >> kt) & 1u) ? 0.f : -1e30f;
#pragma unroll
        for (int r = 0; r < 4; ++r) { const float x = D[kt][r] + (biasr[4 * kt + r] + tb); D[kt][r] = x; mx = fmaxf(mx, x); }
    }
    mx = fmaxf(mx, __shfl_xor(mx, 16)); mx = fmaxf(mx, __shfl_xor(mx, 32));
    lsum = 0.f;
#pragma unroll
    for (int kt = 0; kt < 9; ++kt)
#pragma unroll
        for (int r = 0; r < 4; ++r) { const float e = __builtin_amdgcn_exp2f(D[kt][r] - mx); D[kt][r] = e; lsum += e; }
    lsum += __shfl_xor(lsum, 16); lsum += __shfl_xor(lsum, 32);
#pragma unroll
    for (int c = 0; c < 4; ++c) O[c] = (f32x4){0.f, 0.f, 0.f, 0.f};
#pragma unroll
    for (int kk = 0; kk < 5; ++kk) {
        int Ra = R0 + 32 * kk; Ra = Ra < 0 ? 0 : (Ra > nrows - 16 ? nrows - 16 : Ra);
        int Rb = R0 + 32 * kk + 16; Rb = Rb < 0 ? 0 : (Rb > nrows - 16 ? nrows - 16 : Rb);
        if (kk == 4) Rb = Ra;
        const f32x4 e0 = D[2 * kk], e1 = kk < 4 ? D[2 * kk + 1] : (f32x4){0.f, 0.f, 0.f, 0.f};
        v4u pw; pw.x = cvtpk(e0[0], e0[1]); pw.y = cvtpk(e0[2], e0[3]); pw.z = cvtpk(e1[0], e1[1]); pw.w = cvtpk(e1[2], e1[3]);
        const bf16x8 pf = __builtin_bit_cast(bf16x8, pw);
        const LAS unsigned char* va_ = Vimg + Ra * 128; const LAS unsigned char* vb_ = Vimg + Rb * 128;
#pragma unroll
        for (int c = 0; c < 4; ++c) O[c] = MFMA16(pf, cat8(ldtr(va_ + L.vb[c]), ldtr(vb_ + L.vb[c])), O[c]);
    }
}
__device__ __forceinline__ void attn_stage_out(LAS unsigned char* lds, int wid, int lane, const f32x4 (&O)[4], float lsum) {
    const int g = lane >> 4, i16 = lane & 15;
    const float linv = 1.f / lsum;
    LAS bf16* st = (LAS bf16*)(lds + AT_OST + wid * 2048);
#pragma unroll
    for (int r = 0; r < 4; ++r) { const float li = __shfl(linv, 4 * g + r);
#pragma unroll
        for (int c = 0; c < 4; ++c) st[(4 * g + r) * 64 + 16 * c + i16] = (bf16)(cvtpk(O[c][r] * li, 0.f) & 0xffffu); }
}
__device__ __forceinline__ void attn_load_bias(const Args& a, int pat, int h, int lane, float (&biasr)[36]) {
    const GAS float* bt = (const GAS float*)(a.ws + WS_BIAS) + (pat * 8 + h) * ATB_N; const int g = lane >> 4, i16 = lane & 15;
#pragma unroll
    for (int kt = 0; kt < 9; ++kt)
#pragma unroll
        for (int r = 0; r < 4; ++r) biasr[4 * kt + r] = bt[16 * kt + 4 * g + r - 64 - i16 + 80];
}
#if ATT_FP8
typedef u32x2 att_raw_t;
#define ATT_LD(base, off) (*(const GAS u32x2*)((const GAS unsigned char*)(base) + (off)))
#define ATT_WIDE(r) fp8x8_to_bf16x8(r)
#define ATT_ZERO ((u32x2){0u, 0u})
#else
typedef v4u att_raw_t;
#define ATT_LD(base, off) (*(const GAS v4u*)((base) + (off)))
#define ATT_WIDE(r) (r)
#define ATT_ZERO ((v4u){0u, 0u, 0u, 0u})
#endif
template <int DIL, int VAR = 0> __device__ __forceinline__ void attn_dil_phase(const Args& a, LAS unsigned char* lds, int vcu, int G, int tid, int wid, int lane) {
    unsigned char* ws = a.ws;
    constexpr int NR = SEQ / DIL, PAT = DIL == 4 ? 1 : 2, CH = NR * 8 / 512, NITEM = NB * 8 * DIL;
    constexpr int NBUF = DIL == 16 ? 2 : 1, BUFB = 2 * NR * 128;
    const GAS bf16* qa = (const GAS bf16*)(ws + WS_QA); const GAS bf16* ka = (const GAS bf16*)(ws + WS_KA); const GAS bf16* va = (const GAS bf16*)(ws + WS_VA);
    bf16* op = (bf16*)(ws + (DIL == 4 ? WS_O2 : WS_O3)); float* lsep = (float*)(ws + (DIL == 4 ? WS_LSE2 : WS_LSE3));
    if (vcu >= NITEM) return;
    const int h = vcu & 7;
    float biasr[36]; attn_load_bias(a, PAT, h, lane, biasr);
    const AttnLane L = attn_lane(lane);
    const int g = lane >> 4, i16 = lane & 15;
    att_raw_t kq[CH], vq[CH], qn[2];
    auto issue = [&](int item, int gi) {
        const int rho = (item >> 3) % DIL, b = item / (8 * DIL); const size_t rowb = (size_t)b * SEQ;
#pragma unroll
        for (int j = 0; j < CH; ++j) { const int id = tid + 512 * j, row = id >> 3, c = id & 7; const size_t go = (rowb + (size_t)row * DIL + rho) * 512 + h * 64 + c * 8;
            kq[j] = ATT_LD(ka, go); vq[j] = ATT_LD(va, go); }
        const size_t qpos = rowb + (size_t)(16 * gi + i16) * DIL + rho;
#pragma unroll
        for (int s = 0; s < 2; ++s) qn[s] = ATT_LD(qa, qpos * 512 + h * 64 + 32 * s + 8 * g);
    };
    issue(vcu, wid);
    int buf = 0;
    for (int item = vcu; item < NITEM; item += G) {
        const int rho = (item >> 3) % DIL, b = item / (8 * DIL); const size_t rowb = (size_t)b * SEQ;
        LAS unsigned char* Kimg = lds + buf * BUFB; LAS unsigned char* Vimg = Kimg + NR * 128;
        if (NBUF == 1) __syncthreads();
#pragma unroll
        for (int j = 0; j < CH; ++j) { const int id = tid + 512 * j, row = id >> 3, c = id & 7;
            *(LAS v4u*)(Kimg + kimg_off(row, c)) = ATT_WIDE(kq[j]); *(LAS v4u*)(Vimg + vimg_off(row, c)) = ATT_WIDE(vq[j]); }
        bf16x8 qf[2] = {__builtin_bit_cast(bf16x8, ATT_WIDE(qn[0])), __builtin_bit_cast(bf16x8, ATT_WIDE(qn[1]))};
        __syncthreads();
        if (NBUF == 2 && item + G < NITEM) issue(item + G, wid);
        for (int gi = wid; gi < NR / 16; gi += 8) {
            const int m0 = 16 * gi;
            if (NBUF == 1 && gi + 8 < NR / 16) {
                const size_t qpos = rowb + (size_t)(m0 + 128 + i16) * DIL + rho;
#pragma unroll
                for (int s = 0; s < 2; ++s) qn[s] = ATT_LD(qa, qpos * 512 + h * 64 + 32 * s + 8 * g); }
            unsigned tvalid = 0u;
#pragma unroll
            for (int kt = 0; kt < 9; ++kt) { const int t0 = m0 - 64 + 16 * kt; tvalid |= (t0 >= 0 && t0 < NR) ? (1u << kt) : 0u; }
            f32x4 O[4]; float mx, lsum;
            if (VAR == 1) { mx = 0.f; lsum = 1.f;
#pragma unroll
                for (int c = 0; c < 4; ++c) O[c] = (f32x4){__builtin_bit_cast(float, qf[0][0] + c), 0.f, 0.f, 0.f}; }
            else attn_core(Kimg, Vimg, m0 - 64, NR, tvalid, qf, biasr, L, O, mx, lsum);
            attn_stage_out(lds, wid, lane, O, lsum);
            if (g == 0) lsep[(rowb + (size_t)(m0 + i16) * DIL + rho) * 8 + h] = mx + __log2f(lsum);
            asm volatile("s_waitcnt lgkmcnt(0)" ::: "memory");
            { const int q = lane >> 2, qt = lane & 3; const LAS v4u* sp = (const LAS v4u*)(lds + AT_OST + wid * 2048 + q * 128 + qt * 32);
              const v4u x0 = sp[0], x1 = sp[1];
#if O23_FP8
              v4u o8;
              o8.x = pk_fp8x4(16.f * bflo(x0.x), 16.f * bfhi(x0.x), 16.f * bflo(x0.y), 16.f * bfhi(x0.y)); o8.y = pk_fp8x4(16.f * bflo(x0.z), 16.f * bfhi(x0.z), 16.f * bflo(x0.w), 16.f * bfhi(x0.w));
              o8.z = pk_fp8x4(16.f * bflo(x1.x), 16.f * bfhi(x1.x), 16.f * bflo(x1.y), 16.f * bfhi(x1.y)); o8.w = pk_fp8x4(16.f * bflo(x1.z), 16.f * bfhi(x1.z), 16.f * bflo(x1.w), 16.f * bfhi(x1.w));
              *(v4u*)((unsigned char*)op + (rowb + (size_t)(m0 + q) * DIL + rho) * 512 + h * 64 + qt * 16) = o8; }
#else
              bf16* dst = op + (rowb + (size_t)(m0 + q) * DIL + rho) * 512 + h * 64 + qt * 16;
              *(v4u*)dst = x0; *(v4u*)(dst + 8) = x1; }
#endif
            asm volatile("s_waitcnt lgkmcnt(0)" ::: "memory");
            if (NBUF == 1) { qf[0] = __builtin_bit_cast(bf16x8, ATT_WIDE(qn[0])); qf[1] = __builtin_bit_cast(bf16x8, ATT_WIDE(qn[1])); }
        }
        if (NBUF == 1 && item + G < NITEM) issue(item + G, wid);
        buf ^= (NBUF - 1);
    }
    __syncthreads();
}
__device__ __forceinline__ void attn_p1_phase(const Args& a, LAS unsigned char* lds, int vcu, int G, int tid, int wid, int lane) {
    unsigned char* ws = a.ws;
    LAS unsigned char* Kimg = lds; LAS unsigned char* Vimg = lds + 384 * 128;
    const GAS bf16* qa = (const GAS bf16*)(ws + WS_QA); const GAS bf16* ka = (const GAS bf16*)(ws + WS_KA); const GAS bf16* va = (const GAS bf16*)(ws + WS_VA);
    const GAS bf16* o2 = (const GAS bf16*)(ws + WS_O2); const GAS bf16* o3 = (const GAS bf16*)(ws + WS_O3);
    const GAS float* lse2 = (const GAS float*)(ws + WS_LSE2); const GAS float* lse3 = (const GAS float*)(ws + WS_LSE3);
    bf16* oa = (bf16*)(ws + WS_OA);
    if (vcu >= 1024) return;
    const int h = vcu & 7;
    float biasr[36]; attn_load_bias(a, 0, h, lane, biasr);
    const AttnLane L = attn_lane(lane);
    const int g = lane >> 4, i16 = lane & 15;
    LAS float* scr = (LAS float*)(lds + AT_SCR) + wid * 16;
    att_raw_t kq[6], vq[6];
    auto issue = [&](int item) { const int b = item >> 6, s0 = ((item >> 3) & 7) * 256; const size_t rowb = (size_t)b * SEQ;
#pragma unroll
        for (int j = 0; j < 6; ++j) { const int id = tid + 512 * j, row = id >> 3, c = id & 7, pos = s0 - 64 + row; const bool ok = pos >= 0 && pos < SEQ;
            const size_t go = (rowb + (size_t)(ok ? pos : 0)) * 512 + h * 64 + c * 8;
            kq[j] = ATT_LD(ka, go); vq[j] = ATT_LD(va, go);
            if (!ok) { kq[j] = ATT_ZERO; vq[j] = ATT_ZERO; } } };
    issue(vcu);
    for (int item = vcu; item < 1024; item += G) {
        const int b = item >> 6, s0 = ((item >> 3) & 7) * 256; const size_t rowb = (size_t)b * SEQ;
        __syncthreads();
#pragma unroll
        for (int j = 0; j < 6; ++j) { const int id = tid + 512 * j, row = id >> 3, c = id & 7;
            *(LAS v4u*)(Kimg + kimg_off(row, c)) = ATT_WIDE(kq[j]); *(LAS v4u*)(Vimg + vimg_off(row, c)) = ATT_WIDE(vq[j]); }
        __syncthreads();
        if (item + G < 1024) issue(item + G);
        for (int gi = wid; gi < 16; gi += 8) {
            const int m0 = s0 + 16 * gi;
            const int q = lane >> 2, qt = lane & 3; const size_t tq = rowb + m0 + q;
#if O23_FP8
            const v4u a2q = *(const GAS v4u*)((const GAS unsigned char*)o2 + tq * 512 + h * 64 + qt * 16), a3q = *(const GAS v4u*)((const GAS unsigned char*)o3 + tq * 512 + h * 64 + qt * 16);
#else
            const v4u a20 = *(const GAS v4u*)(o2 + tq * 512 + h * 64 + qt * 16), a21 = *(const GAS v4u*)(o2 + tq * 512 + h * 64 + qt * 16 + 8);
            const v4u a30 = *(const GAS v4u*)(o3 + tq * 512 + h * 64 + qt * 16), a31 = *(const GAS v4u*)(o3 + tq * 512 + h * 64 + qt * 16 + 8);
#endif
            const float l2 = lse2[tq * 8 + h], l3 = lse3[tq * 8 + h];
            bf16x8 qf[2];
#pragma unroll
            for (int s = 0; s < 2; ++s) qf[s] = __builtin_bit_cast(bf16x8, ATT_WIDE(ATT_LD(qa, (rowb + m0 + i16) * 512 + h * 64 + 32 * s + 8 * g)));
            unsigned tvalid = 0u;
#pragma unroll
            for (int kt = 0; kt < 9; ++kt) { const int t0 = m0 - 64 + 16 * kt; tvalid |= (t0 >= 0 && t0 < SEQ) ? (1u << kt) : 0u; }
            f32x4 O[4]; float mx, lsum;
            attn_core(Kimg, Vimg, 16 * gi, 384, tvalid, qf, biasr, L, O, mx, lsum);
            attn_stage_out(lds, wid, lane, O, lsum);
            if (g == 0) scr[i16] = mx + __log2f(lsum);
            asm volatile("s_waitcnt lgkmcnt(0)" ::: "memory");
            {
                const float l1 = scr[q], M = fmaxf(l1, fmaxf(l2, l3));
                float w1 = __builtin_amdgcn_exp2f(l1 - M), w2 = __builtin_amdgcn_exp2f(l2 - M), w3 = __builtin_amdgcn_exp2f(l3 - M); const float wi = 1.f / (w1 + w2 + w3); w1 *= wi; w2 *= wi; w3 *= wi;
                const LAS v4u* sp = (const LAS v4u*)(lds + AT_OST + wid * 2048 + q * 128 + qt * 32);
                const v4u x0 = sp[0], x1 = sp[1];
                v4u r0, r1;
#if O23_FP8
                { typedef float f2_ __attribute__((ext_vector_type(2))); const float w2s = w2 * 0.0625f, w3s = w3 * 0.0625f;
#define MRG8(d, x, yw, zw, hi) { const f2_ y_ = __builtin_amdgcn_cvt_pk_f32_fp8(yw, hi), z_ = __builtin_amdgcn_cvt_pk_f32_fp8(zw, hi); d = cvtpk(w1 * bflo(x) + w2s * y_[0] + w3s * z_[0], w1 * bfhi(x) + w2s * y_[1] + w3s * z_[1]); }
                MRG8(r0.x, x0.x, a2q.x, a3q.x, false) MRG8(r0.y, x0.y, a2q.x, a3q.x, true) MRG8(r0.z, x0.z, a2q.y, a3q.y, false) MRG8(r0.w, x0.w, a2q.y, a3q.y, true)
                MRG8(r1.x, x1.x, a2q.z, a3q.z, false) MRG8(r1.y, x1.y, a2q.z, a3q.z, true) MRG8(r1.z, x1.z, a2q.w, a3q.w, false) MRG8(r1.w, x1.w, a2q.w, a3q.w, true)
#undef MRG8
                }
#else
#define MRG(d, x, y, z) d = cvtpk(w1 * bflo(x) + w2 * bflo(y) + w3 * bflo(z), w1 * bfhi(x) + w2 * bfhi(y) + w3 * bfhi(z))
                MRG(r0.x, x0.x, a20.x, a30.x); MRG(r0.y, x0.y, a20.y, a30.y); MRG(r0.z, x0.z, a20.z, a30.z); MRG(r0.w, x0.w, a20.w, a30.w);
                MRG(r1.x, x1.x, a21.x, a31.x); MRG(r1.y, x1.y, a21.y, a31.y); MRG(r1.z, x1.z, a21.z, a31.z); MRG(r1.w, x1.w, a21.w, a31.w);
#undef MRG
#endif
#if MIX_FP8 & 2
                v4u o8;
                o8.x = pk_fp8x4(16.f * bflo(r0.x), 16.f * bfhi(r0.x), 16.f * bflo(r0.y), 16.f * bfhi(r0.y)); o8.y = pk_fp8x4(16.f * bflo(r0.z), 16.f * bfhi(r0.z), 16.f * bflo(r0.w), 16.f * bfhi(r0.w));
                o8.z = pk_fp8x4(16.f * bflo(r1.x), 16.f * bfhi(r1.x), 16.f * bflo(r1.y), 16.f * bfhi(r1.y)); o8.w = pk_fp8x4(16.f * bflo(r1.z), 16.f * bfhi(r1.z), 16.f * bflo(r1.w), 16.f * bfhi(r1.w));
                *(v4u*)((unsigned char*)oa + tq * 512 + h * 64 + qt * 16) = o8;
#else
                bf16* dst = oa + tq * 512 + h * 64 + qt * 16;
                *(v4u*)dst = r0; *(v4u*)(dst + 8) = r1;
#endif
            }
            asm volatile("s_waitcnt lgkmcnt(0)" ::: "memory");
        }
    }
    __syncthreads();
}

#define OPAQUE(x) asm volatile("" : "+v"(x))
template <int VAR = 0> __device__ __forceinline__ void p3_phase(const Args& a, LAS unsigned char* lds, int vcu, int G, int tid, int wid, int lane) {
    unsigned char* ws = a.ws;
    const int g = lane >> 4, i16 = lane & 15, q4 = i16 >> 2, p = lane & 3;
    const GAS bf16* qr = (const GAS bf16*)(ws + WS_QR); const GAS bf16* kr = (const GAS bf16*)(ws + WS_KR); const GAS bf16* vr = (const GAS bf16*)(ws + WS_VR);
    GAS bf16* gr = (GAS bf16*)(ws + WS_GR);
    LAS unsigned char* Kt = lds; LAS unsigned char* Sg = lds + 32768;
    if (vcu >= 1024) return;
    const unsigned kdst = offb(tid >> 4, tid & 15);
    unsigned rfo[4];
    { const unsigned X = ((i16 & 3) << 2) | (i16 >> 2);
#pragma unroll
      for (int s = 0; s < 4; ++s) rfo[s] = 256 * i16 + 16 * (((4 * s) ^ (X & 12)) | (g ^ (X & 3))); }
    v4u sreg[8], kreg[4]; bf16x8 qn[4];
    auto item_ptrs = [&](int item, size_t& tok0, const GAS bf16*& sf, int& h) { const int b = item >> 6; h = (item >> 4) & 3; const int n = item & 15; tok0 = (size_t)b * SEQ + n * 128;
        sf = (const GAS bf16*)((const GAS unsigned char*)a.out + ((((size_t)(b * 4 + h) * 16 + n) * 2 + 0) * 256) * 128 * (STATE_FP8 ? 1 : 2)); };
    auto issue_k = [&](int item) { size_t tok0; const GAS bf16* sf; int h; item_ptrs(item, tok0, sf, h);
        const GAS bf16* ks_ = kr + (tok0 + (tid >> 4)) * 512 + h * 128 + (tid & 15) * 8;
#pragma unroll
        for (int j = 0; j < 4; ++j) kreg[j] = *(const GAS v4u*)(ks_ + (size_t)j * 32 * 512); };
    auto issue_q = [&](int item) { size_t tok0; const GAS bf16* sf; int h; item_ptrs(item, tok0, sf, h);
#pragma unroll
        for (int s = 0; s < 4; ++s) qn[s] = *(const GAS bf16x8*)(qr + (tok0 + 16 * wid + i16) * 512 + h * 128 + 32 * s + 8 * g); };
#if STATE_FP8
    auto issue_state = [&](const GAS bf16* sf, int dirn) { const GAS unsigned char* sld = (const GAS unsigned char*)sf + (size_t)dirn * 256 * 128 + (size_t)(tid >> 4) * 128 + (tid & 15) * 8;
#pragma unroll
        for (int j = 0; j < 4; ++j) { const u32x2 lo = *(const GAS u32x2*)(sld + (size_t)(2 * j) * 32 * 128), hi = *(const GAS u32x2*)(sld + (size_t)(2 * j + 1) * 32 * 128); sreg[j] = (v4u){lo.x, lo.y, hi.x, hi.y}; } };
    auto write_state = [&]() {
#pragma unroll
        for (int j = 0; j < 8; ++j) { typedef float f2_ __attribute__((ext_vector_type(2)));
            const unsigned w0 = (j & 1) ? sreg[j >> 1].z : sreg[j >> 1].x, w1 = (j & 1) ? sreg[j >> 1].w : sreg[j >> 1].y;
            const f2_ a0 = __builtin_amdgcn_cvt_pk_f32_fp8(w0, false), a1 = __builtin_amdgcn_cvt_pk_f32_fp8(w0, true), a2 = __builtin_amdgcn_cvt_pk_f32_fp8(w1, false), a3 = __builtin_amdgcn_cvt_pk_f32_fp8(w1, true);
            v4u o; o.x = cvtpk(a0[0], a0[1]); o.y = cvtpk(a1[0], a1[1]); o.z = cvtpk(a2[0], a2[1]); o.w = cvtpk(a3[0], a3[1]);
            *(LAS v4u*)(Sg + (j >> 2) * 32768 + kdst + (j & 3) * 8192) = o; asm volatile("" ::: "memory"); } };
#else
    auto issue_state = [&](const GAS bf16* sf, int dirn) { const GAS bf16* sld = sf + (size_t)dirn * 256 * 128 + (size_t)(tid >> 4) * 128 + (tid & 15) * 8;
#pragma unroll
        for (int j = 0; j < 8; ++j) sreg[j] = *(const GAS v4u*)(sld + (size_t)j * 32 * 128); };
    auto write_state = [&]() {
#pragma unroll
        for (int j = 0; j < 8; ++j) *(LAS v4u*)(Sg + (j >> 2) * 32768 + kdst + (j & 3) * 8192) = sreg[j]; };
#endif
    { size_t tok0; const GAS bf16* sf; int h; item_ptrs(vcu, tok0, sf, h); issue_k(vcu); issue_q(vcu); issue_state(sf, 0); }
#pragma unroll
    for (int j = 0; j < 4; ++j) *(LAS v4u*)(Kt + kdst + j * 8192) = kreg[j];
    for (int item = vcu; item < 1024; item += G) {
        size_t tok0; const GAS bf16* sf; int h; item_ptrs(item, tok0, sf, h);
        const float lf2 = log2_gamma(a.in[2], h), lb2 = log2_gamma(a.in[3], h);
        bf16x8 qf[4];
#pragma unroll
        for (int s = 0; s < 4; ++s) qf[s] = qn[s];
        const bool has_next = item + G < 1024;
        __syncthreads();
        f32x4 D[8];
#pragma unroll
        for (int jt = 0; jt < 8; ++jt) {
            f32x4 d = (f32x4){0.f, 0.f, 0.f, 0.f};
#pragma unroll
            for (int s = 0; s < 4; ++s) { if (VAR != 1) { const bf16x8 kf = *(const LAS bf16x8*)(Kt + rfo[s] + jt * 4096); d = MFMA16(kf, qf[s], d); } else d[s] = __builtin_bit_cast(float, (int)qf[s][0]); }
            D[jt] = d;
        }
        int iq = 16 * wid + i16; OPAQUE(iq);
        bf16x8 pf[4];
#pragma unroll
        for (int ks = 0; ks < 4; ++ks) {
            float e[8];
#pragma unroll
            for (int t = 0; t < 2; ++t)
#pragma unroll
                for (int r = 0; r < 4; ++r) {
                    const int j = 16 * (2 * ks + t) + 4 * g + r; const float fdf = (float)(iq - j), ad = fabsf(fdf);
                    const float pos = fminf(fmaxf(fdf, 0.f), 1.f), isz = 1.f - fminf(ad, 1.f);
                    const float w = __builtin_amdgcn_exp2f((lb2 + (lf2 - lb2) * pos) * ad) + isz;
                    e[4 * t + r] = D[2 * ks + t][r] * w;
                }
            v4u pw; pw.x = cvtpk(e[0], e[1]); pw.y = cvtpk(e[2], e[3]); pw.z = cvtpk(e[4], e[5]); pw.w = cvtpk(e[6], e[7]);
            pf[ks] = __builtin_bit_cast(bf16x8, pw);
        }
        f32x4 acc[16];
#pragma unroll
        for (int vt = 0; vt < 16; ++vt) acc[vt] = (f32x4){0.f, 0.f, 0.f, 0.f};
#pragma unroll
        for (int dirn = 0; dirn < 2; ++dirn) {
            if (dirn == 1) __syncthreads();
            write_state();
            if (dirn == 0) { issue_state(sf, 1); if (has_next) issue_k(item + G); }
            else {
                if (has_next) {
#pragma unroll
                    for (int j = 0; j < 4; ++j) *(LAS v4u*)(Kt + kdst + j * 8192) = kreg[j]; }
                const GAS bf16* vs_ = vr + (tok0 + (tid >> 5)) * 1024 + h * 256 + (tid & 31) * 8;
#pragma unroll
                for (int j = 0; j < 8; ++j) sreg[j] = *(const GAS v4u*)(vs_ + (size_t)j * 16 * 1024);
            }
            __syncthreads();
#pragma unroll
            for (int vt = 0; vt < 16; ++vt) {
#pragma unroll
                for (int s = 0; s < 4; ++s) { if (VAR != 1) { const bf16x8 sfr = *(const LAS bf16x8*)(Sg + (vt >> 3) * 32768 + rfo[s] + (vt & 7) * 4096); acc[vt] = MFMA16(qf[s], sfr, acc[vt]); } }
            }
            float xs[4];
            { int ib = 16 * wid + 4 * g; OPAQUE(ib);
#pragma unroll
              for (int r = 0; r < 4; ++r) { const float lxf = lf2 * (float)(ib + r + 1), lxb = lb2 * (float)(128 - ib - r); xs[r] = __builtin_amdgcn_exp2f(dirn == 0 ? lxf - lxb : lxb - (STATE_FP8 ? 4.f : 0.f)); } }
#pragma unroll
            for (int vt = 0; vt < 16; ++vt)
#pragma unroll
                for (int r = 0; r < 4; ++r) acc[vt][r] *= xs[r];
        }
        __syncthreads();
        { int t2 = tid; OPAQUE(t2); const unsigned vd2 = (unsigned)((t2 & 31) >> 4) * 32768u + offb(t2 >> 5, t2 & 15);
#pragma unroll
          for (int j = 0; j < 8; ++j) *(LAS v4u*)(Sg + vd2 + j * 4096) = sreg[j]; }
        GAS bf16* gp = gr + (tok0 + 16 * wid + (lane >> 5)) * 1024 + h * 256 + (lane & 31) * 8;
#if MIX_FP8 & 4
        GAS unsigned char* ar8 = (GAS unsigned char*)(ws + WS_AR8) + (tok0 + 16 * wid + (lane >> 5)) * 1024 + h * 256 + (lane & 31) * 8;
#endif
        __syncthreads();
        unsigned vbs[8];
        { int l2 = lane; OPAQUE(l2); const unsigned g2 = l2 >> 4, q2 = (l2 & 15) >> 2, p2 = l2 & 3, X = (q2 << 2) | g2;
#pragma unroll
          for (int c = 0; c < 8; ++c) vbs[c] = 256 * (4 * g2 + q2) + 16 * (((2 * c) ^ (X & 14)) | ((p2 >> 1) ^ (X & 1))) + 8 * (p2 & 1); }
#pragma unroll
        for (int vt = 0; vt < 16; ++vt) {
#pragma unroll
            for (int ks = 0; ks < 4; ++ks) { if (VAR != 1) {
                const s16x4 lo = ldtr(Sg + vbs[vt & 7] + (vt >> 3) * 32768 + ks * 8192), hi = ldtr(Sg + vbs[vt & 7] + (vt >> 3) * 32768 + ks * 8192 + 4096);
                acc[vt] = MFMA16(pf[ks], cat8(lo, hi), acc[vt]); }
            }
            asm volatile("" ::: "memory");
        }
        float mu[4], rs[4];
#pragma unroll
        for (int r = 0; r < 4; ++r) {
            float s = 0.f;
#pragma unroll
            for (int vt = 0; vt < 16; ++vt) s += acc[vt][r];
            s += __shfl_xor(s, 1); s += __shfl_xor(s, 2); s += __shfl_xor(s, 4); s += __shfl_xor(s, 8);
            const float m = s * (1.f / 256.f); float qv = 0.f;
#pragma unroll
            for (int vt = 0; vt < 16; ++vt) { const float d = acc[vt][r] - m; qv += d * d; }
            qv += __shfl_xor(qv, 1); qv += __shfl_xor(qv, 2); qv += __shfl_xor(qv, 4); qv += __shfl_xor(qv, 8);
            mu[r] = m; rs[r] = 1.f / sqrtf(qv * (1.f / 256.f) + LN_EPSF);
        }
        v4u greg[8];
#pragma unroll
        for (int j = 0; j < 8; ++j) greg[j] = *(const GAS v4u*)(gp + (size_t)j * 2048);
        __syncthreads();
        if (has_next) { size_t tk; const GAS bf16* sfn; int hn; item_ptrs(item + G, tk, sfn, hn); issue_state(sfn, 0); issue_q(item + G); }
        LAS bf16* st = (LAS bf16*)(Sg + wid * 8192);
        { LAS bf16* sp_ = st + (4 * g) * 256 + i16;
#pragma unroll
          for (int vt = 0; vt < 16; ++vt)
#pragma unroll
              for (int r = 0; r < 4; ++r) sp_[r * 256 + 16 * vt] = (bf16)(cvtpk((acc[vt][r] - mu[r]) * rs[r], 0.f) & 0xffffu); }
        asm volatile("s_waitcnt lgkmcnt(0)" ::: "memory");
        {
            const float* gn = a.in[4] + h * 256; const int ch = lane & 31;
            const f32x4 g0 = *(const f32x4*)(gn + ch * 8), g1 = *(const f32x4*)(gn + ch * 8 + 4);
            const LAS bf16* yp = st + (lane >> 5) * 256 + ch * 8;
#pragma unroll
            for (int j = 0; j < 8; ++j) {
                const v4u y = *(const LAS v4u*)(yp + j * 512); const v4u sg = greg[j];
#if SILU_IN_P3
#define GSW(w, hi) pg8::fsilu((hi) ? bfhi(w) : bflo(w))
#else
#define GSW(w, hi) ((hi) ? bfhi(w) : bflo(w))
#endif
                v4u o; o.x = cvtpk(bflo(y.x) * g0[0] * GSW(sg.x, 0), bfhi(y.x) * g0[1] * GSW(sg.x, 1)); o.y = cvtpk(bflo(y.y) * g0[2] * GSW(sg.y, 0), bfhi(y.y) * g0[3] * GSW(sg.y, 1));
                o.z = cvtpk(bflo(y.z) * g1[0] * GSW(sg.z, 0), bfhi(y.z) * g1[1] * GSW(sg.z, 1)); o.w = cvtpk(bflo(y.w) * g1[2] * GSW(sg.w, 0), bfhi(y.w) * g1[3] * GSW(sg.w, 1));
#undef GSW
#if MIX_FP8 & 4
                u32x2 o8; o8.x = pk_fp8x4(bflo(o.x), bfhi(o.x), bflo(o.y), bfhi(o.y)); o8.y = pk_fp8x4(bflo(o.z), bfhi(o.z), bflo(o.w), bfhi(o.w));
                *(GAS u32x2*)(ar8 + (size_t)j * 2048) = o8;
#else
                *(GAS v4u*)(gp + (size_t)j * 2048) = o;
#endif
            }
        }
        __syncthreads();
    }
}

constexpr int P6_RS = 81920, P6_CNT = P6_RS + 8 * 512, P6_BASE = P6_CNT + 64, P6_ROW = P6_BASE + 64;
#define P6_BUTTERFLY(lg, out) do { float r10[10], r5[5], r3[3], r2[2]; const float z = 0.f; \
    _Pragma("unroll") for (int k = 0; k < 10; ++k) { const float keep = h32 ? lg[10 + k] : lg[k], send = h32 ? lg[k] : lg[10 + k]; r10[k] = keep + __shfl_xor(send, 32); } \
    _Pragma("unroll") for (int k = 0; k < 5; ++k) { const float keep = h16 ? r10[5 + k] : r10[k], send = h16 ? r10[k] : r10[5 + k]; r5[k] = keep + __shfl_xor(send, 16); } \
    { const float keep = h8 ? r5[3] : r5[0], send = h8 ? r5[0] : r5[3]; r3[0] = keep + __shfl_xor(send, 8); } \
    { const float keep = h8 ? r5[4] : r5[1], send = h8 ? r5[1] : r5[4]; r3[1] = keep + __shfl_xor(send, 8); } \
    { const float keep = h8 ? z : r5[2], send = h8 ? r5[2] : z; r3[2] = keep + __shfl_xor(send, 8); } \
    { const float keep = h4 ? r3[2] : r3[0], send = h4 ? r3[0] : r3[2]; r2[0] = keep + __shfl_xor(send, 4); } \
    { const float keep = h4 ? z : r3[1], send = h4 ? r3[1] : z; r2[1] = keep + __shfl_xor(send, 4); } \
    { const float keep = h2 ? r2[1] : r2[0], send = h2 ? r2[0] : r2[1]; out = keep + __shfl_xor(send, 2); } \
    out += __shfl_xor(out, 1); } while (0)
__device__ __forceinline__ void p6a_phase(const Args& a, LAS unsigned char* lds, int vcu, int G, int tid, int wave, int lane) {
    unsigned char* ws = a.ws;
    LAS float* RW = (LAS float*)lds;
    LAS float* RS = (LAS float*)(lds + P6_RS) + wave * 128;
    LAS unsigned* LC = (LAS unsigned*)(lds + P6_CNT); LAS unsigned* LB = (LAS unsigned*)(lds + P6_BASE); LAS unsigned* LR = (LAS unsigned*)(lds + P6_ROW);
    {
        const f32x4* wgp = (const f32x4*)a.in[11]; const f32x4* wep = (const f32x4*)a.in[13];
        f32x4 gq[2], eq[8];
#pragma unroll
        for (int u = 0; u < 2; ++u) gq[u] = wgp[tid + 512 * u];
#pragma unroll
        for (int u = 0; u < 8; ++u) eq[u] = wep[tid + 512 * u];
#pragma unroll
        for (int u = 0; u < 2; ++u) { const int c = tid + 512 * u;
#pragma unroll
            for (int k = 0; k < 4; ++k) RW[k * 1024 + c] = gq[u][k]; }
#pragma unroll
        for (int u = 0; u < 8; ++u) { const int q = tid + 512 * u, c = q >> 2, k4 = q & 3;
#pragma unroll
            for (int k = 0; k < 4; ++k) RW[(4 + 4 * k4 + k) * 1024 + c] = eq[u][k]; }
    }
    const u32x2* pre = (const u32x2*)a.out; u32x2* x1b = (u32x2*)(ws + WS_XB); [[maybe_unused]] unsigned* x1f8 = (unsigned*)(ws + WS_X1F8);
    gu32* ctl = (gu32*)ws;
    int* ltok = (int*)(ws + WS_LTOK); float* tw = (float*)(ws + WS_WSLOT); unsigned* tinfo = (unsigned*)(ws + WS_TINFO);
    const float* g1 = a.in[9]; const float* b1 = a.in[10];
    const bool h32 = (lane & 32) != 0, h16 = (lane & 16) != 0, h8 = (lane & 8) != 0, h4 = (lane & 4) != 0, h2 = (lane & 2) != 0;
#define P6_LOADROW(dst, t_) do { const u32x2* xr_ = pre + (size_t)(t_) * 256 + lane; _Pragma("unroll") for (int j = 0; j < 4; ++j) dst[j] = xr_[64 * j]; } while (0)
#define P6_LN(v, nx, s) do { s = 0.f; _Pragma("unroll") for (int j = 0; j < 4; ++j) { v[j] = (f32x4){bflo(nx[j].x), bfhi(nx[j].x), bflo(nx[j].y), bfhi(nx[j].y)}; s += (v[j].x + v[j].y) + (v[j].z + v[j].w); } } while (0)
#define P6_VAR(v, mean, q) do { q = 0.f; _Pragma("unroll") for (int j = 0; j < 4; ++j) { v[j] = v[j] - mean; q += (v[j].x * v[j].x + v[j].y * v[j].y) + (v[j].z * v[j].z + v[j].w * v[j].w); } } while (0)
#if M1_FP8
#define P6_STORE(v, t_, j) do { u32x2 o_; o_.x = cvtpk(v[j].x, v[j].y); o_.y = cvtpk(v[j].z, v[j].w); x1b[(size_t)(t_) * 256 + lane + 64 * j] = o_; x1f8[(size_t)(t_) * 256 + lane + 64 * j] = pk_fp8x4(v[j].x, v[j].y, v[j].z, v[j].w); } while (0)
#else
#define P6_STORE(v, t_, j) do { u32x2 o_; o_.x = cvtpk(v[j].x, v[j].y); o_.y = cvtpk(v[j].z, v[j].w); x1b[(size_t)(t_) * 256 + lane + 64 * j] = o_; } while (0)
#endif
#define P6_DOT(lg, v, j, k, w) lg[k] += (v[j][0] * w[0] + v[j][1] * w[1]) + (v[j][2] * w[2] + v[j][3] * w[3])
    for (int blk = vcu; blk < TT / 128; blk += G) {
        if (tid < 16) LC[tid] = 0u;
        __syncthreads();
        const int t0 = blk * 128;
        u32x2 nxA[4], nxB[4], nxC[4], nxD[4];
        P6_LOADROW(nxA, t0 + wave); P6_LOADROW(nxB, t0 + wave + 8); P6_LOADROW(nxC, t0 + wave + 16); P6_LOADROW(nxD, t0 + wave + 24);
        for (int rr = 0; rr < 4; ++rr) {
            const int rl0 = wave + 32 * rr, tA = t0 + rl0, tB = tA + 8, tC = tA + 16, tD = tA + 24;
            f32x4 vA[4], vB[4], vC[4], vD[4]; float sA, sB, sC, sD;
            P6_LN(vA, nxA, sA); P6_LN(vB, nxB, sB); P6_LN(vC, nxC, sC); P6_LN(vD, nxD, sD);
            if (rr < 3) { P6_LOADROW(nxA, tA + 32); P6_LOADROW(nxB, tB + 32); P6_LOADROW(nxC, tC + 32); P6_LOADROW(nxD, tD + 32); }
            const float mA = wave_sum(sA) * (1.f / DM), mB = wave_sum(sB) * (1.f / DM), mC = wave_sum(sC) * (1.f / DM), mD = wave_sum(sD) * (1.f / DM);
            float qA, qB, qC, qD;
            P6_VAR(vA, mA, qA); P6_VAR(vB, mB, qB); P6_VAR(vC, mC, qC); P6_VAR(vD, mD, qD);
            const float rA = 1.f / sqrtf(wave_sum(qA) * (1.f / DM) + LN_EPSF), rB = 1.f / sqrtf(wave_sum(qB) * (1.f / DM) + LN_EPSF);
            const float rC = 1.f / sqrtf(wave_sum(qC) * (1.f / DM) + LN_EPSF), rD = 1.f / sqrtf(wave_sum(qD) * (1.f / DM) + LN_EPSF);
            typedef float f32x2p __attribute__((ext_vector_type(2)));
            f32x2p lgAB[20], lgCD[20];
#pragma unroll
            for (int k = 0; k < 20; ++k) { lgAB[k] = (f32x2p){0.f, 0.f}; lgCD[k] = (f32x2p){0.f, 0.f}; }
#pragma unroll
            for (int j = 0; j < 4; ++j) {
                const f32x4 gg = *(const f32x4*)(g1 + 4 * lane + 256 * j), bb = *(const f32x4*)(b1 + 4 * lane + 256 * j);
                vA[j] = vA[j] * rA * gg + bb; vB[j] = vB[j] * rB * gg + bb; vC[j] = vC[j] * rC * gg + bb; vD[j] = vD[j] * rD * gg + bb;
                P6_STORE(vA, tA, j); P6_STORE(vB, tB, j); P6_STORE(vC, tC, j); P6_STORE(vD, tD, j);
                f32x2p pab[4], pcd[4];
#pragma unroll
                for (int e = 0; e < 4; ++e) { pab[e] = (f32x2p){vA[j][e], vB[j][e]}; pcd[e] = (f32x2p){vC[j][e], vD[j][e]}; }
#pragma unroll
                for (int k = 0; k < 20; ++k) { const f32x4 w = *(const LAS f32x4*)(RW + k * 1024 + 4 * lane + 256 * j);
#pragma unroll
                    for (int e = 0; e < 4; ++e) { const f32x2p ww = (f32x2p){w[e], w[e]};
                        lgAB[k] = __builtin_elementwise_fma(pab[e], ww, lgAB[k]); lgCD[k] = __builtin_elementwise_fma(pcd[e], ww, lgCD[k]); } }
            }
            float lgA[20], lgB[20], lgC[20], lgD[20];
#pragma unroll
            for (int k = 0; k < 20; ++k) { lgA[k] = lgAB[k].x; lgB[k] = lgAB[k].y; lgC[k] = lgCD[k].x; lgD[k] = lgCD[k].y; }
            float r1A, r1B, r1C, r1D;
            P6_BUTTERFLY(lgA, r1A); P6_BUTTERFLY(lgB, r1B); P6_BUTTERFLY(lgC, r1C); P6_BUTTERFLY(lgD, r1D);
            {
                const int i3 = h2 ? (h4 ? -1 : 1) : (h4 ? 2 : 0);
                const int i5 = i3 < 0 ? -1 : (h8 ? (i3 == 2 ? -1 : i3 + 3) : i3);
                const int kk = i5 < 0 ? -1 : (h32 ? 10 : 0) + (h16 ? 5 : 0) + i5;
                if (kk >= 0 && (lane & 1) == 0) { RS[kk] = r1A; RS[32 + kk] = r1B; RS[64 + kk] = r1C; RS[96 + kk] = r1D; }
            }
            asm volatile("s_waitcnt lgkmcnt(0)" ::: "memory");
            {
                const int sel = lane & 3; const int rl = rl0 + 8 * sel;
                float tl[20];
#pragma unroll
                for (int k4 = 0; k4 < 5; ++k4) { const f32x4 w = *(const LAS f32x4*)(RS + sel * 32 + 4 * k4); tl[4 * k4] = w[0]; tl[4 * k4 + 1] = w[1]; tl[4 * k4 + 2] = w[2]; tl[4 * k4 + 3] = w[3]; }
                float gl[4];
#pragma unroll
                for (int k = 0; k < 4; ++k) gl[k] = tl[k] + a.in[12][k];
                int gi = 0; float gm = gl[0];
#pragma unroll
                for (int k = 1; k < 4; ++k) if (gl[k] > gm) { gm = gl[k]; gi = k; }
                float gs = 0.f;
#pragma unroll
                for (int k = 0; k < 4; ++k) gs += __expf(gl[k] - gm);
                const float gwt = 1.f / gs;
                float el[4];
#pragma unroll
                for (int k = 0; k < 4; ++k) { const float se = gi == 0 ? tl[4 + k] : (gi == 1 ? tl[8 + k] : (gi == 2 ? tl[12 + k] : tl[16 + k])); el[k] = se + a.in[14][4 * gi + k]; }
                int i1 = 0; float v1 = el[0];
#pragma unroll
                for (int k = 1; k < 4; ++k) if (el[k] > v1) { v1 = el[k]; i1 = k; }
                int i2 = (i1 + 1) & 3; float v2 = -3.0e38f;
#pragma unroll
                for (int k = 0; k < 4; ++k) if (k != i1 && el[k] > v2) { v2 = el[k]; i2 = k; }
                const float ex = __expf(v2 - v1), w1 = gwt / (1.f + ex), w2 = gwt * ex / (1.f + ex);
                if (lane < 4) {
                    const int e1 = 4 * gi + i1, e2 = 4 * gi + i2;
                    const unsigned p1 = __hip_atomic_fetch_add(LC + e1, 1u, __ATOMIC_RELAXED, __HIP_MEMORY_SCOPE_WORKGROUP);
                    const unsigned p2 = __hip_atomic_fetch_add(LC + e2, 1u, __ATOMIC_RELAXED, __HIP_MEMORY_SCOPE_WORKGROUP);
                    LR[rl * 4 + 0] = ((unsigned)e1 << 16) | p1; LR[rl * 4 + 1] = ((unsigned)e2 << 16) | p2; LR[rl * 4 + 2] = __float_as_uint(w1); LR[rl * 4 + 3] = __float_as_uint(w2);
                }
            }
            asm volatile("s_waitcnt lgkmcnt(0)" ::: "memory");
        }
        __syncthreads();
        if (tid < 16) LB[tid] = __hip_atomic_fetch_add(ctl + CW_CNT + 64 * tid, LC[tid], __ATOMIC_RELAXED, __HIP_MEMORY_SCOPE_AGENT);
        __syncthreads();
        if (tid < 256) {
            const int rl = tid >> 1, j = tid & 1; const unsigned rec = LR[rl * 4 + j]; const unsigned e = rec >> 16, pos = LB[e] + (rec & 0xffffu);
            ltok[e * TT + pos] = t0 + rl; tw[2 * (t0 + rl) + j] = __uint_as_float(LR[rl * 4 + 2 + j]); tinfo[2 * (t0 + rl) + j] = (e << 16) | pos;
        }
        __syncthreads();
    }
#undef P6_LOADROW
#undef P6_LN
#undef P6_VAR
#undef P6_STORE
#undef P6_DOT
}
__device__ __forceinline__ void build_tile_tables(const Args& a, LAS unsigned char* lds, int tid) {
    LAS int* ts = (LAS int*)(lds + LDS_TS_OFF); LAS int* te = (LAS int*)(lds + LDS_TE_OFF); LAS int* cn = (LAS int*)(lds + LDS_CNT_OFF);
    gu32* ctl = (gu32*)a.ws;
    if (tid < 16) cn[tid] = (int)__hip_atomic_load(ctl + CW_CNT + 64 * tid, __ATOMIC_RELAXED, __HIP_MEMORY_SCOPE_AGENT);
    __syncthreads();
    int start[17]; start[0] = 0;
#pragma unroll
    for (int e = 0; e < 16; ++e) start[e + 1] = start[e] + ((cn[e] + 255) >> 8);
    if (tid < 17) { int v = 0;
#pragma unroll
        for (int e = 0; e < 17; ++e) v = (tid == e) ? start[e] : v;
        ts[tid] = v; }
    if (tid < start[16]) { int ex = 0;
#pragma unroll
        for (int e = 1; e < 16; ++e) ex += (tid >= start[e]) ? 1 : 0;
        te[tid] = ex; }
    __syncthreads();
}
__device__ __forceinline__ void p9_phase(const Args& a, LAS unsigned char* lds, int vcu, int G, int wave, int lane) {
    unsigned char* ws = a.ws;
    const LAS int* ts = (const LAS int*)(lds + LDS_TS_OFF);
    const unsigned* tinfo = (const unsigned*)(ws + WS_TINFO); const u32x2* Y = (const u32x2*)(ws + WS_Y);
    const float* g2 = a.in[18]; const float* b2 = a.in[19];
    const int gw = vcu * NWAVES + wave, NGW = G * NWAVES;
#if Y_FP8
    const unsigned* Y8 = (const unsigned*)(ws + WS_Y); unsigned ny0[4], ny1[4]; u32x2 nxw[4]; float nw0 = 0.f, nw1 = 0.f;
#else
    u32x2 ny0[4], ny1[4], nxw[4]; float nw0 = 0.f, nw1 = 0.f;
#endif
    const float* tw = (const float*)(ws + WS_WSLOT);
    auto issue = [&](int t) {
        const unsigned i0 = tinfo[2 * t], i1 = tinfo[2 * t + 1];
        nw0 = tw[2 * t]; nw1 = tw[2 * t + 1];
        const size_t s0 = (size_t)ts[i0 >> 16] * 256 + (i0 & 0xffffu), s1 = (size_t)ts[i1 >> 16] * 256 + (i1 & 0xffffu);
        const u32x2* xb1 = (const u32x2*)(ws + WS_XB) + (size_t)t * 256 + lane;
#pragma unroll
#if Y_FP8
        for (int j = 0; j < 4; ++j) { ny0[j] = Y8[s0 * 256 + lane + 64 * j]; ny1[j] = Y8[s1 * 256 + lane + 64 * j]; nxw[j] = xb1[64 * j]; }
#else
        for (int j = 0; j < 4; ++j) { ny0[j] = Y[s0 * 256 + lane + 64 * j]; ny1[j] = Y[s1 * 256 + lane + 64 * j]; nxw[j] = xb1[64 * j]; }
#endif
    };
    if (gw < TT) issue(gw);
    for (int t = gw; t < TT; t += NGW) {
        f32x4* xr = (f32x4*)(a.out + (size_t)t * DM) + lane;
#if Y_FP8
        f32x4 v[4]; float s = 0.f; const float w0 = nw0 * 0.0625f, w1 = nw1 * 0.0625f;
#pragma unroll
        for (int j = 0; j < 4; ++j) {
            const unsigned y0 = ny0[j], y1 = ny1[j]; const u32x2 xw = nxw[j];
            typedef float f32x2_ __attribute__((ext_vector_type(2)));
            const f32x2_ a0 = __builtin_amdgcn_cvt_pk_f32_fp8(y0, false), a1 = __builtin_amdgcn_cvt_pk_f32_fp8(y0, true), c0 = __builtin_amdgcn_cvt_pk_f32_fp8(y1, false), c1 = __builtin_amdgcn_cvt_pk_f32_fp8(y1, true);
            f32x4 x = (f32x4){bflo(xw.x), bfhi(xw.x), bflo(xw.y), bfhi(xw.y)} * DN_ALPHA;
            x.x += w0 * a0[0] + w1 * c0[0]; x.y += w0 * a0[1] + w1 * c0[1]; x.z += w0 * a1[0] + w1 * c1[0]; x.w += w0 * a1[1] + w1 * c1[1];
            v[j] = x; s += (x.x + x.y) + (x.z + x.w);
        }
#else
        f32x4 v[4]; float s = 0.f; const float w0 = nw0, w1 = nw1;
#pragma unroll
        for (int j = 0; j < 4; ++j) {
            const u32x2 y0 = ny0[j], y1 = ny1[j], xw = nxw[j];
            f32x4 x = (f32x4){bflo(xw.x), bfhi(xw.x), bflo(xw.y), bfhi(xw.y)} * DN_ALPHA;
            x.x += w0 * bflo(y0.x) + w1 * bflo(y1.x); x.y += w0 * bfhi(y0.x) + w1 * bfhi(y1.x); x.z += w0 * bflo(y0.y) + w1 * bflo(y1.y); x.w += w0 * bfhi(y0.y) + w1 * bfhi(y1.y);
            v[j] = x; s += (x.x + x.y) + (x.z + x.w);
        }
#endif
        if (t + NGW < TT) issue(t + NGW);
        const float mean = wave_sum(s) * (1.f / DM); float s2 = 0.f;
#pragma unroll
        for (int j = 0; j < 4; ++j) { v[j] = v[j] - mean; s2 += (v[j].x * v[j].x + v[j].y * v[j].y) + (v[j].z * v[j].z + v[j].w * v[j].w); }
        const float rstd = 1.f / sqrtf(wave_sum(s2) * (1.f / DM) + LN_EPSF);
#pragma unroll
        for (int j = 0; j < 4; ++j) { const f32x4 gg = *(const f32x4*)(g2 + 4 * lane + 256 * j), bb = *(const f32x4*)(b2 + 4 * lane + 256 * j); xr[64 * j] = v[j] * rstd * gg + bb; }
    }
}

__global__ void __launch_bounds__(NWAVES * 64, 2) mega_fwd(Args args) {
    extern __shared__ __attribute__((aligned(16))) unsigned char lds_raw[];
    LAS unsigned char* lds = (LAS unsigned char*)lds_raw;
    volatile LAS unsigned* MISC = (volatile LAS unsigned*)(lds + MISC_OFF);
    const int tid0 = threadIdx.x, wave = __builtin_amdgcn_readfirstlane(tid0 >> 6);
    const int G = gridDim.x, bx = blockIdx.x, vcu = (G % 8 == 0) ? (bx % 8) * (G / 8) + bx / 8 : bx;
    for (int u = tid0; u < (LDS_BYTES - LDSCTL_OFF) / 4; u += NWAVES * 64) ((LAS unsigned*)(lds + LDSCTL_OFF))[u] = 0u;
    __syncthreads();
    unsigned char* ws = args.ws;
    gu32* ctl = (gu32*)ws;
    const bool bars_on = (args.mask >> 31) != 0u;
    XcdBarrier bar; bar.bar = (unsigned*)(ctl + CW_BAR) + args.bar_region * XCD_BAR_WORDS; bar.x = 0; bar.st = nullptr;
    if (bars_on) bar = xcd_barrier_post((unsigned*)(ctl + CW_BAR) + args.bar_region * XCD_BAR_WORDS, MISC + 8);
    bar.wv = wave;
    if (bars_on && tid0 == 0 && (G != 256 || bar.x != (unsigned)(bx % 8))) (void)xb_add(bar.bar + XB_MIS, 1u);
#define GROUP_BAR() do { if (bars_on) xcd_group_barrier(bar); } while (0)
#define GRID_BAR() do { if (bars_on) xcd_barrier(bar); } while (0)
#ifndef PH_LAST
#define PH_LAST 99
#endif
#define FRESH() int tid = wave * 64 + pg8::lane_id(); asm volatile("" : "+v"(tid)); const int lane = tid & 63; (void)lane
#ifndef RMASK
#define RMASK 0
#endif
#define REP(k) _Pragma("unroll") for (int rep_ = 0; rep_ < 1 + ((RMASK >> (k)) & 1); ++rep_)
#ifndef STAMP_SCALE
#define STAMP_SCALE 1.0f
#endif
#ifdef STAMP_PH
#define ST_B(k) if ((k) == STAMP_PH) { st_a = rt(); }
#define ST_E(k) if ((k) == STAMP_PH) { st_b = rt(); }
#else
#define ST_B(k)
#define ST_E(k)
#endif
#ifdef ONLY
#define EN(k) (ONLY == (k))
#else
#define EN(k) ((args.mask >> (k)) & 1u)
#endif
    unsigned long long st_a = 0, st_b = 0; (void)st_a; (void)st_b;
    REP(0) if (EN(0)) { FRESH(); p0_prologue(args, lds, vcu, G, tid, wave, lane); }
    GRID_BAR();
#ifdef STAGGER_TICKS
    if (EN(1) && (bx & 8)) { const unsigned long long t0_ = rt(); while (rt() - t0_ < STAGGER_TICKS) __builtin_amdgcn_s_sleep(32); }
#endif
    REP(1) if (EN(1)) {
#if P1_FP8
        pg8::EpiHcat E{ws, (const float*)(ws + WS_ROT), 0};
        if (P1_FP8_FROM > 0) {
            pg8::Gemm g{(const pg8::bf16_t*)(ws + WS_XB), (const pg8::bf16_t*)(ws + WS_WIN), TT, 4608, 1024}; pg8::StaticOrder S; S.init(TT, 256 * P1_FP8_FROM, G, bx);
            pg8::gemm_phase<pg8::EpiHcat, pg8::StaticOrder, true, true>(lds, g, S, E, wave);
        }
        {
#if GATE_FP8
            pg8::Gemm g{(const pg8::bf16_t*)(ws + WS_X8_LO), (const pg8::bf16_t*)(ws + WS_WIN8), TT, 4608, 512, 64, (long)WS_X8_HI - (long)WS_X8_LO - (long)(16 * MiB)}; pg8::StaticOrder S;
#else
            pg8::Gemm g{(const pg8::bf16_t*)args.out, (const pg8::bf16_t*)(ws + WS_WIN8), TT, 4608, 512}; pg8::StaticOrder S;
#endif
            S.init(TT, 4608 - 256 * P1_FP8_FROM, G, bx, P1_FP8_FROM);
#if CONV_BG
            pg8::P1Order SB; SB.S = S; SB.cv = pg8::ExpertConv{args.in[15], args.in[16], args.in[17], ws + WS_WGU, ws + WS_WD, vcu * NWAVES + wave, G * NWAVES, vcu % 9};
            pg8::gemm_phase<pg8::EpiHcat, pg8::P1Order, true, true, false, true, 1, 0>(lds, g, SB, E, wave);
            { FRESH();
              for (int k = 0; SB.cv.gw + k * SB.cv.nw < 6144; ++k) { pg8::Unit tu; const bool in_gap = k < 3 && S.next(pg8::P1Order::unit_of(SB.cv.grp, k), tu) && pg8::P1Order::unit_of(SB.cv.grp, k) < 9;
                  if (!in_gap) pg8::expert_conv_item(SB.cv, k, lane); } }
#else
            pg8::gemm_phase<pg8::EpiHcat, pg8::StaticOrder, true, true, false, true, 1, 0>(lds, g, S, E, wave);
#endif
        }
#else
        pg8::Gemm g{(const pg8::bf16_t*)(ws + WS_XB), (const pg8::bf16_t*)(ws + WS_WIN), TT, 4608, 1024}; pg8::StaticOrder S; S.init(TT, 4608, G, bx);
        pg8::EpiHcat E{ws, (const float*)(ws + WS_ROT), 0};
        pg8::gemm_phase<pg8::EpiHcat, pg8::StaticOrder, true, true>(lds, g, S, E, wave);
#endif
    }
    GRID_BAR();
    if (PH_LAST >= 2) {
        REP(2) if (EN(2)) { FRESH(); for (int it = vcu; it < 256; it += G) chain_item(args, lds, it, tid, wave, lane); }
        if (EN(3)) { { FRESH(); attn_dil_phase<16>(args, lds, vcu, G, tid, wave, lane); }
                     { FRESH(); attn_dil_phase<4>(args, lds, vcu, G, tid, wave, lane); } }
    }
    GRID_BAR();
    ST_B(4) if (PH_LAST >= 3 && EN(4)) { FRESH(); p3_phase<0>(args, lds, vcu, G, tid, wave, lane); }
    if (EN(13)) { FRESH(); attn_p1_phase(args, lds, vcu, G, tid, wave, lane); }
    GRID_BAR(); ST_E(4)
#if !CONV_BG
    if (EN(14)) { FRESH(); p0_expert_weights(args, lds, vcu, G, wave, lane); }
#endif
    REP(5) if (PH_LAST >= 4 && EN(5)) {
        pg8::GateOrder S; S.S4.init(TT, 1024, G, bx);
        pg8::EpiHcat E{ws, (const float*)(ws + WS_ROT), 18};
#if GATE_FP8
        pg8::Gemm g{(const pg8::bf16_t*)(ws + WS_X8_LO), (const pg8::bf16_t*)(ws + WS_WIN8 + (size_t)4608 * 1024), TT, 2048, 512, 64, (long)WS_X8_HI - (long)WS_X8_LO - (long)(16 * MiB)};
        pg8::gemm_phase<pg8::EpiHcat, pg8::GateOrder, true, true, false, true, 1, 0>(lds, g, S, E, wave);
#else
        pg8::Gemm g{(const pg8::bf16_t*)(ws + WS_XB), (const pg8::bf16_t*)(ws + WS_WIN) + (size_t)4608 * 1024, TT, 2048, 1024};
        pg8::gemm_phase<pg8::EpiHcat, pg8::GateOrder, true, true>(lds, g, S, E, wave);
#endif
        asm volatile("s_waitcnt vmcnt(0)" ::: "memory"); __syncthreads();
    }
    REP(6) if (PH_LAST >= 5 && EN(6)) {
        pg8::StaticOrder S; S.init(TT, 1024, G, bx);
        { pg8::EpiGate<false> E{(const pg8::bf16_t*)(ws + WS_GATE_A), (pg8::bf16_t*)(ws + WS_MERGED), nullptr};
#if MIX_FP8 & 2
          pg8::Gemm g{(const pg8::bf16_t*)(ws + WS_OA), (const pg8::bf16_t*)(ws + WS_WA), TT, 1024, 256};
          pg8::gemm_phase<pg8::EpiGate<false>, pg8::StaticOrder, true, true, false, true, 1, 3>(lds, g, S, E, wave);
#else
          pg8::Gemm g{(const pg8::bf16_t*)(ws + WS_OA), (const pg8::bf16_t*)(ws + WS_WA), TT, 1024, 512};
          pg8::gemm_phase<pg8::EpiGate<false>, pg8::StaticOrder, true, true>(lds, g, S, E, wave);
#endif
        }
        asm volatile("s_waitcnt vmcnt(0)" ::: "memory"); __syncthreads();
        { typedef pg8::EpiGate<true, (MIX_FP8 & 1) != 0> EpiC;
          EpiC E{(const pg8::bf16_t*)(ws + WS_GATE_R), (pg8::bf16_t*)(ws + WS_MERGED), ws + WS_MERGED8};
#if MIX_FP8 & 4
          pg8::Gemm g{(const pg8::bf16_t*)(ws + WS_AR8), (const pg8::bf16_t*)(ws + WS_WR), TT, 1024, 512};
          pg8::gemm_phase<EpiC, pg8::StaticOrder, true, true, false, true, 1, 0>(lds, g, S, E, wave);
#else
          pg8::Gemm g{(const pg8::bf16_t*)(ws + WS_GR), (const pg8::bf16_t*)(ws + WS_WR), TT, 1024, 1024};
          pg8::gemm_phase<EpiC, pg8::StaticOrder, true, true>(lds, g, S, E, wave);
#endif
        }
    }
    GROUP_BAR();
    REP(7) if (PH_LAST >= 6 && EN(7)) {
        pg8::StaticOrder S; S.init(TT, 1024, G, bx);
        pg8::EpiResBf16 E{X_F32_RES ? (const pg8::bf16_t*)args.in[0] : (const pg8::bf16_t*)(ws + WS_XB), (pg8::bf16_t*)args.out, DN_ALPHA};
#if MIX_FP8 & 1
        pg8::Gemm g{(const pg8::bf16_t*)(ws + WS_MERGED8), (const pg8::bf16_t*)(ws + WS_WO), TT, 1024, 512};
        pg8::gemm_phase<pg8::EpiResBf16, pg8::StaticOrder, true, true, false, true, 1, 3>(lds, g, S, E, wave);
#else
        pg8::Gemm g{(const pg8::bf16_t*)(ws + WS_MERGED), (const pg8::bf16_t*)(ws + WS_WO), TT, 1024, 1024};
        pg8::gemm_phase<pg8::EpiResBf16, pg8::StaticOrder, true, true>(lds, g, S, E, wave);
#endif
    }
    GROUP_BAR();
    ST_B(8) if (PH_LAST >= 7 && EN(8)) { FRESH(); p6a_phase(args, lds, vcu, G, tid, wave, lane); }
    GRID_BAR(); ST_E(8)
    { FRESH(); build_tile_tables(args, lds, tid); }
    const int nrt = ((const LAS int*)(lds + LDS_TS_OFF))[16];
    REP(10) if (PH_LAST >= 9 && EN(10)) {
#if M1_FP8
        pg8::Gemm g{(const pg8::bf16_t*)(ws + WS_X1F8), (const pg8::bf16_t*)(ws + WS_WGU), MAXSLOT, 1024, 512};
        pg8::MoeOrder S{nrt * 4, G, vcu, (const LAS int*)(lds + LDS_TE_OFF), (const LAS int*)(lds + LDS_TS_OFF), (const LAS int*)(lds + LDS_CNT_OFF), (const int*)(ws + WS_LTOK), 1024u};
        pg8::EpiSwiGLU E{ws + WS_H};
        pg8::gemm_phase<pg8::EpiSwiGLU, pg8::MoeOrder, true, true, true, true, 1, 0>(lds, g, S, E, wave);
#else
        pg8::Gemm g{(const pg8::bf16_t*)(ws + WS_XB), (const pg8::bf16_t*)(ws + WS_WGU), MAXSLOT, 1024, 1024};
        pg8::MoeOrder S{nrt * 4, G, vcu, (const LAS int*)(lds + LDS_TE_OFF), (const LAS int*)(lds + LDS_TS_OFF), (const LAS int*)(lds + LDS_CNT_OFF), (const int*)(ws + WS_LTOK), 2048u};
        pg8::EpiSwiGLU E{ws + WS_H};
        pg8::gemm_phase<pg8::EpiSwiGLU, pg8::MoeOrder, true, true, true>(lds, g, S, E, wave);
#endif
    }
    GROUP_BAR();
    REP(11) if (PH_LAST >= 10 && EN(11)) {
        pg8::Gemm g{(const pg8::bf16_t*)(ws + WS_H), (const pg8::bf16_t*)(ws + WS_WD), MAXSLOT, 1024, 256};
        pg8::MoeOrder S{nrt * 4, G, vcu, (const LAS int*)(lds + LDS_TE_OFF), (const LAS int*)(lds + LDS_TS_OFF), (const LAS int*)(lds + LDS_CNT_OFF), (const int*)(ws + WS_LTOK), 1024u};
        pg8::EpiRowScale E{(pg8::bf16_t*)(ws + WS_Y)};
        pg8::gemm_phase<pg8::EpiRowScale, pg8::MoeOrder, true, true, false, true, 1, 2>(lds, g, S, E, wave);
    }
    GRID_BAR();
    ST_B(12) if (PH_LAST >= 11 && EN(12)) { FRESH(); p9_phase(args, lds, vcu, G, wave, lane); }
#ifdef STAMP_PH
    GRID_BAR(); ST_E(12)
    if (STAMP_PH == 13) { st_a = rt(); GRID_BAR(); GRID_BAR(); GRID_BAR(); GRID_BAR(); st_b = rt(); }
    if (bx == 0 && tid0 == 0) { const float us = (float)(st_b - st_a) * 0.01f * STAMP_SCALE; int k = 0; float lim = 30.f; while (us >= lim && k < 12) { lim *= 1.5f; ++k; }
        __hip_atomic_store(ctl + CW_CHK, __float_as_uint(sqrtf(2.f * k + 2.f)), RLX_AGENT); }
    GRID_BAR();
    { const float c = __uint_as_float(__hip_atomic_load(ctl + CW_CHK, RLX_AGENT)); f32x4* o4 = (f32x4*)args.out;
      for (size_t i = (size_t)bx * 512 + tid0; i < (size_t)TT * DM / 4; i += (size_t)G * 512) o4[i] = (f32x4){c, c, c, c}; }
#endif
}

#ifdef PROBE_VAR
__global__ void __launch_bounds__(NWAVES * 64, 2) probe_kernel(Args args) {
    extern __shared__ __attribute__((aligned(16))) unsigned char lds_raw[];
    LAS unsigned char* lds = (LAS unsigned char*)lds_raw;
    const int tid0 = threadIdx.x, wave = __builtin_amdgcn_readfirstlane(tid0 >> 6);
    const int G = gridDim.x, bx = blockIdx.x, vcu = (G % 8 == 0) ? (bx % 8) * (G / 8) + bx / 8 : bx;
    FRESH();
    if (PROBE_VAR >= 20 && PROBE_VAR <= 22) {
        unsigned char* ws = args.ws;
        pg8::Gemm g{(const pg8::bf16_t*)(ws + WS_X8_LO), (const pg8::bf16_t*)(ws + WS_WIN8), TT, 4608, 512, 64, (long)WS_X8_HI - (long)WS_X8_LO - (long)(16 * MiB)}; pg8::StaticOrder S; S.init(TT, 4608, G, bx);
        typedef pg8::EpiHcatT<PROBE_VAR - 20> EpiP;
        EpiP E{ws, (const float*)(ws + WS_ROT), 0};
        pg8::gemm_phase<EpiP, pg8::StaticOrder, true, true, false, true, 1, 0>(lds, g, S, E, wave);
    }
    if (PROBE_VAR == 10) p3_phase<0>(args, lds, vcu, G, tid, wave, lane);
    if (PROBE_VAR == 11) p3_phase<1>(args, lds, vcu, G, tid, wave, lane);
    if (PROBE_VAR == 0) attn_dil_phase<16, 0>(args, lds, vcu, G, tid, wave, lane);
    if (PROBE_VAR == 1) attn_dil_phase<16, 1>(args, lds, vcu, G, tid, wave, lane);
    if (PROBE_VAR == 2) attn_dil_phase<4, 0>(args, lds, vcu, G, tid, wave, lane);
    if (PROBE_VAR == 3) attn_dil_phase<4, 1>(args, lds, vcu, G, tid, wave, lane);
}
#endif
extern "C" void kernel_launch(void* const* d_in, const int* in_sizes, int n_in, void* d_out, int out_size, void* d_ws, size_t ws_size, hipStream_t stream) {
    static int grid = 0;
    if (grid == 0) {
        if (n_in != 20 || in_sizes[0] != TT * DM || out_size != TT * DM || ws_size < WS_END) { fprintf(stderr, "kernel_launch: unexpected shapes: n_in %d in0 %d out %d ws %zu; nothing launched\n", n_in, n_in > 0 ? in_sizes[0] : -1, out_size, ws_size); grid = -1; return; }
        int dev = 0, cus = 0;
        if (hipGetDevice(&dev) != hipSuccess || hipDeviceGetAttribute(&cus, hipDeviceAttributeMultiprocessorCount, dev) != hipSuccess) { grid = -1; return; }
        if (hipFuncSetAttribute((const void*)mega_fwd, hipFuncAttributeMaxDynamicSharedMemorySize, LDS_BYTES) != hipSuccess) { fprintf(stderr, "kernel_launch: hipFuncSetAttribute failed\n"); grid = -1; return; }
        (void)hipGetLastError();
        grid = cus;
    }
    if (grid < 0) return;
    if (hipMemsetAsync((char*)d_ws, 0, CTL_ZERO_BYTES, stream) != hipSuccess) return;
    Args a{};
    for (int i = 0; i < 20; ++i) a.in[i] = (const float*)d_in[i];
    a.out = (float*)d_out; a.ws = (unsigned char*)d_ws; a.mask = 0x80007fffu; a.bar_region = 0;
#if defined(XTRA_FIRST)
    { Args x = a; x.mask = XTRA_FIRST; x.bar_region = 1; for (int r = 0; r < XTRA_REP; ++r) hipLaunchKernelGGL(mega_fwd, dim3(grid), dim3(NWAVES * 64), LDS_BYTES, stream, x);
      if (hipMemsetAsync((char*)d_ws, 0, CTL_ZERO_BYTES, stream) != hipSuccess) return; }
#endif
    hipLaunchKernelGGL(mega_fwd, dim3(grid), dim3(NWAVES * 64), LDS_BYTES, stream, a);
#if defined(PROBE_VAR)
    { hipFuncSetAttribute((const void*)probe_kernel, hipFuncAttributeMaxDynamicSharedMemorySize, LDS_BYTES);
      for (int r = 0; r < 4; ++r) hipLaunchKernelGGL(probe_kernel, dim3(grid), dim3(NWAVES * 64), LDS_BYTES, stream, a); }
#endif
#if defined(XTRA_AFTER)
    { Args x = a; x.mask = XTRA_AFTER; x.bar_region = 1; for (int r = 0; r < XTRA_REP; ++r) hipLaunchKernelGGL(mega_fwd, dim3(grid), dim3(NWAVES * 64), LDS_BYTES, stream, x); }
#endif
}
```
